# Optimizing an MI355X kernel written in HIP

```python
import jax, jax.numpy as jnp
from jax import lax
import numpy as np

D_MODEL = 2048
BATCH = 4
SEQ = 4096
DEPTH = 2

GRID_W = 64
ROPE_THETA = 10000.0
EPS = 1e-6
HEAD_DIM = 128
D_MIX = D_MODEL
Q_BLOCK = 128
A_HEADS = 6
A_KV_HEADS = 2
B_HEADS = 6
B_Q_LORA = 384
B_KV_LORA = 256
B_QK_NOPE = 128
B_QK_ROPE = 64
B_V_DIM = 128
C_HEADS = 4
C_DQK = 128
C_DV = 128
CONV_W = 5
MLSTM_CHUNK = 64
C_N_GATES = 4 * C_HEADS
PROJ_WIDTHS = (A_HEADS * HEAD_DIM, A_KV_HEADS * HEAD_DIM, A_KV_HEADS * HEAD_DIM,
               B_Q_LORA, B_KV_LORA, B_QK_ROPE,
               C_HEADS * C_DQK, C_HEADS * C_DQK, C_HEADS * C_DV, C_HEADS * C_DV, C_N_GATES)
PROJ_DIM = sum(PROJ_WIDTHS)
N_EXPERTS = 64
TOP_K = 6
EXPERT_FF = 512
SHARED_FF = 512
ROUTED_SCALE = 2.5
MOE_BLOCK = 128
N_MOD = 6

kernel_name = "hybrid_gqa_mla_mlstm_moe_encoder"


def rms_norm(x, gain):
    xf = x.astype(jnp.float32)
    y = xf * lax.rsqrt(jnp.mean(xf * xf, axis=-1, keepdims=True) + EPS)
    return (y * gain.astype(jnp.float32)).astype(x.dtype)


def axial_rope_tables(S, rot_dim):
    rows = S // GRID_W
    row = jnp.repeat(jnp.arange(rows, dtype=jnp.float32), GRID_W)
    col = jnp.tile(jnp.arange(GRID_W, dtype=jnp.float32), rows)
    axis_dim = rot_dim // 2
    inv_freq = ROPE_THETA ** (-jnp.arange(0, axis_dim, 2, dtype=jnp.float32) / axis_dim)
    ang_r = row[:, None] * inv_freq
    ang_c = col[:, None] * inv_freq
    return (jnp.cos(ang_r), jnp.sin(ang_r), jnp.cos(ang_c), jnp.sin(ang_c))


def _rotate(x, cos, sin):
    x1, x2 = jnp.split(x, 2, axis=-1)
    cos = cos.astype(x.dtype)
    sin = sin.astype(x.dtype)
    return jnp.concatenate([x1 * cos - x2 * sin, x2 * cos + x1 * sin], axis=-1)


def apply_axial_rope(x, tabs):
    cos_r, sin_r, cos_c, sin_c = tabs
    half = x.shape[-1] // 2
    return jnp.concatenate([_rotate(x[..., :half], cos_r, sin_r),
                            _rotate(x[..., half:], cos_c, sin_c)], axis=-1)


def gqa_attention(q, k, v):
    B, KVH, G, S, D = q.shape
    nb = S // Q_BLOCK
    qb = jnp.moveaxis(q.reshape(B, KVH, G, nb, Q_BLOCK, D), 3, 0)

    def one_block(qblk):
        s = jnp.einsum('bkgqd,bksd->bkgqs', qblk, k).astype(jnp.float32) * (D ** -0.5)
        p = jax.nn.softmax(s, axis=-1).astype(v.dtype)
        return jnp.einsum('bkgqs,bksd->bkgqd', p, v)

    o = lax.map(one_block, qb)
    return jnp.moveaxis(o, 0, 3).reshape(B, KVH * G, S, D)


def mla_attention(q_nope, q_rope, k_nope, k_rope, v):
    B, H, S, dn = q_nope.shape
    dr = q_rope.shape[-1]
    nb = S // Q_BLOCK
    scale = (dn + dr) ** -0.5
    qn = jnp.moveaxis(q_nope.reshape(B, H, nb, Q_BLOCK, dn), 2, 0)
    qr = jnp.moveaxis(q_rope.reshape(B, H, nb, Q_BLOCK, dr), 2, 0)

    def one_block(args):
        qn_b, qr_b = args
        s = (jnp.einsum('bhqd,bhsd->bhqs', qn_b, k_nope)
             + jnp.einsum('bhqd,bsd->bhqs', qr_b, k_rope)).astype(jnp.float32) * scale
        p = jax.nn.softmax(s, axis=-1).astype(v.dtype)
        return jnp.einsum('bhqs,bhsd->bhqd', p, v)

    o = lax.map(one_block, (qn, qr))
    return jnp.moveaxis(o, 0, 2).reshape(B, H, S, v.shape[-1])


def centred_depthwise_conv(x, w, b):
    C = x.shape[-1]
    pad = CONV_W // 2
    y = lax.conv_general_dilated(x, w.astype(x.dtype)[:, None, :], (1,), [(pad, pad)],
                                 dimension_numbers=('NWC', 'WIO', 'NWC'), feature_group_count=C)
    return y + b.astype(x.dtype)


def mlstm_chunkwise(q, k, v, log_i, log_f):
    B, H, S, dk = q.shape
    dv = v.shape[-1]
    L = MLSTM_CHUNK
    nc = S // L
    q = q.reshape(B, H, nc, L, dk)
    k = k.reshape(B, H, nc, L, dk)
    v = v.reshape(B, H, nc, L, dv)
    log_i = log_i.reshape(B, H, nc, L)
    log_f = log_f.reshape(B, H, nc, L)
    b = jnp.cumsum(log_f, axis=-1)
    g = b[..., -1]
    a = g[..., None] - b + log_i

    def chunk_step(carry, xs):
        C, n, m = carry
        g_c, a_c, k_c, v_c = xs
        m_new = jnp.maximum(g_c + m, jnp.max(a_c, axis=-1))
        decay = jnp.exp(g_c + m - m_new)
        wk = jnp.exp(a_c - m_new[..., None])[..., None] * k_c
        C_new = decay[..., None, None] * C + jnp.einsum('bhld,bhlv->bhdv', wk, v_c)
        n_new = decay[..., None] * n + jnp.sum(wk, axis=2)
        return (C_new, n_new, m_new), (C, n, m)

    init = (jnp.zeros((B, H, dk, dv), jnp.float32), jnp.zeros((B, H, dk), jnp.float32),
            jnp.zeros((B, H), jnp.float32))
    xs = (jnp.moveaxis(g, 2, 0), jnp.moveaxis(a, 2, 0), jnp.moveaxis(k, 2, 0), jnp.moveaxis(v, 2, 0))
    _, (C_prev, n_prev, m_prev) = lax.scan(chunk_step, init, xs)
    C_prev = jnp.moveaxis(C_prev, 0, 2)
    n_prev = jnp.moveaxis(n_prev, 0, 2)
    m_prev = jnp.moveaxis(m_prev, 0, 2)

    seen = jnp.tril(jnp.ones((L, L), dtype=bool))
    d = b[..., :, None] - b[..., None, :] + log_i[..., None, :]
    d = jnp.where(seen, d, -jnp.inf)
    m_inter = b + m_prev[..., None]
    m_j = jnp.maximum(m_inter, jnp.max(d, axis=-1))
    s = jnp.einsum('bhcjd,bhcsd->bhcjs', q, k) * jnp.exp(d - m_j[..., None])
    inter = jnp.exp(m_inter - m_j)
    num = (jnp.einsum('bhcjs,bhcsv->bhcjv', s, v)
           + inter[..., None] * jnp.einsum('bhcjd,bhcdv->bhcjv', q, C_prev))
    den = jnp.sum(s, axis=-1) + inter * jnp.einsum('bhcjd,bhcd->bhcj', q, n_prev)
    h = num / jnp.maximum(jnp.abs(den), jnp.exp(-m_j))[..., None]
    return h.reshape(B, H, S, dv)


def hybrid_mixer(h, w_in, a_q_gain, a_k_gain, b_cq_gain, b_ckv_gain, w_uq, w_ukv,
                 c_conv_w, c_conv_b, c_gate_b, head_out_gain, w_out, rope_a, rope_b):
    B, S, _ = h.shape
    proj = h @ w_in
    offs = np.cumsum(PROJ_WIDTHS)[:-1].tolist()
    a_q, a_k, a_v, b_cq, b_ckv, b_kr, c_q, c_k, c_v, c_o, c_g = jnp.split(proj, offs, axis=-1)

    q = rms_norm(a_q.reshape(B, S, A_HEADS, HEAD_DIM), a_q_gain).transpose(0, 2, 1, 3)
    k = rms_norm(a_k.reshape(B, S, A_KV_HEADS, HEAD_DIM), a_k_gain).transpose(0, 2, 1, 3)
    v = a_v.reshape(B, S, A_KV_HEADS, HEAD_DIM).transpose(0, 2, 1, 3)
    q = apply_axial_rope(q, rope_a).reshape(B, A_KV_HEADS, A_HEADS // A_KV_HEADS, S, HEAD_DIM)
    k = apply_axial_rope(k, rope_a)
    y_a = gqa_attention(q, k, v).transpose(0, 2, 1, 3).reshape(B, S, A_HEADS * HEAD_DIM)

    cq = (rms_norm(b_cq, b_cq_gain) @ w_uq).reshape(B, S, B_HEADS, B_QK_NOPE + B_QK_ROPE)
    cq = cq.transpose(0, 2, 1, 3)
    q_nope = cq[..., :B_QK_NOPE]
    q_rope = apply_axial_rope(cq[..., B_QK_NOPE:], rope_b)
    kv = (rms_norm(b_ckv, b_ckv_gain) @ w_ukv).reshape(B, S, B_HEADS, B_QK_NOPE + B_V_DIM)
    kv = kv.transpose(0, 2, 1, 3)
    k_nope = kv[..., :B_QK_NOPE]
    v_b = kv[..., B_QK_NOPE:]
    k_rope = apply_axial_rope(b_kr, rope_b)
    y_b = mla_attention(q_nope, q_rope, k_nope, k_rope, v_b).transpose(0, 2, 1, 3)
    y_b = y_b.reshape(B, S, B_HEADS * B_V_DIM)

    qk = jax.nn.silu(centred_depthwise_conv(jnp.concatenate([c_q, c_k], axis=-1), c_conv_w, c_conv_b))
    qc, kc = jnp.split(qk, 2, axis=-1)
    to_heads = lambda t: t.reshape(B, S, C_HEADS, -1).transpose(0, 2, 1, 3).astype(jnp.float32)
    qc = to_heads(qc)
    kc = to_heads(kc) * (C_DQK ** -0.5)
    vc = to_heads(c_v)
    gates = (c_g + c_gate_b).astype(jnp.float32).reshape(B, S, 4, C_HEADS).transpose(2, 0, 3, 1)
    i_fw, f_fw, i_bw, f_bw = gates[0], gates[1], gates[2], gates[3]
    flip = lambda t: jnp.flip(t, axis=2)
    h_fw = mlstm_chunkwise(qc, kc, vc, i_fw, jax.nn.log_sigmoid(f_fw))
    h_bw = flip(mlstm_chunkwise(flip(qc), flip(kc), flip(vc), flip(i_bw), flip(jax.nn.log_sigmoid(f_bw))))
    y_c = (h_fw + h_bw).transpose(0, 2, 1, 3).reshape(B, S, C_HEADS * C_DV).astype(h.dtype)

    n_heads_total = D_MIX // HEAD_DIM
    y = jnp.concatenate([y_a, y_b, y_c], axis=-1).reshape(B, S, n_heads_total, HEAD_DIM)
    y = rms_norm(y, head_out_gain.reshape(n_heads_total, HEAD_DIM)).reshape(B, S, D_MIX)
    attn_w = (A_HEADS + B_HEADS) * HEAD_DIM
    y = jnp.concatenate([y[..., :attn_w], y[..., attn_w:] * jax.nn.sigmoid(c_o)], axis=-1)
    return y @ w_out


def moe_ffn(h, router_w, router_bias, w_gate, w_up, w_down, ws_gate, ws_up, ws_down):
    T, D = h.shape
    E = router_w.shape[1]
    scores = jax.nn.sigmoid((h @ router_w).astype(jnp.float32))
    _, idx = lax.top_k(scores + router_bias.astype(jnp.float32), TOP_K)
    sel = jnp.take_along_axis(scores, idx, axis=1)
    gates = sel / jnp.sum(sel, axis=-1, keepdims=True) * ROUTED_SCALE

    TK = T * TOP_K
    flat_e = idx.reshape(-1)
    flat_tok = jnp.arange(TK, dtype=jnp.int32) // TOP_K
    flat_g = gates.reshape(-1)
    order = jnp.argsort(flat_e)
    se, stok, sg = flat_e[order], flat_tok[order], flat_g[order]
    counts = jnp.bincount(flat_e, length=E)
    padded = (counts + MOE_BLOCK - 1) // MOE_BLOCK * MOE_BLOCK
    start = jnp.cumsum(counts) - counts
    pend = jnp.cumsum(padded)
    pstart = pend - padded
    dest = pstart[se] + jnp.arange(TK, dtype=jnp.int32) - start[se]
    n_blocks = TK // MOE_BLOCK + E
    P = n_blocks * MOE_BLOCK
    buf_tok = jnp.zeros((P,), jnp.int32).at[dest].set(stok)
    buf_g = jnp.zeros((P,), jnp.float32).at[dest].set(sg)
    blk_e = jnp.minimum(jnp.searchsorted(pend, jnp.arange(n_blocks, dtype=jnp.int32) * MOE_BLOCK,
                                         side='right'), E - 1).astype(jnp.int32)

    def block_step(out, blk):
        tok, g, e = blk
        xb = h[tok]
        a = jax.nn.silu(xb @ w_gate[e]) * (xb @ w_up[e])
        y = (a @ w_down[e]) * g[:, None].astype(a.dtype)
        return out.at[tok].add(y), None

    routed, _ = lax.scan(block_step, jnp.zeros_like(h),
                         (buf_tok.reshape(n_blocks, MOE_BLOCK), buf_g.reshape(n_blocks, MOE_BLOCK), blk_e))
    shared = (jax.nn.silu(h @ ws_gate) * (h @ ws_up)) @ ws_down
    return shared + routed


def setup_inputs(seed: int = 0) -> dict:
    key = jax.random.key(seed)
    ks = jax.random.split(key, 32)
    f32 = jnp.float32
    nrm = lambda k, shape, std: jax.random.normal(k, shape, f32) * std
    gain = lambda k, shape: 1.0 + 0.02 * jax.random.normal(k, shape, f32)
    L, D = DEPTH, D_MODEL
    i_bias = 0.1 * jax.random.normal(ks[13], (L, 2, C_HEADS), f32)
    f_bias = jnp.linspace(3.0, 6.0, C_HEADS, dtype=f32) + 0.1 * jax.random.normal(ks[14], (L, 2, C_HEADS), f32)
    c_gate_b = jnp.concatenate([i_bias[:, 0], f_bias[:, 0], i_bias[:, 1], f_bias[:, 1]], axis=-1)
    return {
        "x": jax.random.normal(ks[0], (BATCH, SEQ, D), f32),
        "c": jax.random.normal(ks[1], (BATCH, D), f32),
        "ada_w": nrm(ks[2], (L, D, N_MOD * D), 0.5 * D ** -0.5),
        "ada_b": nrm(ks[3], (L, N_MOD * D), 0.02),
        "pre_mix_gain": gain(ks[4], (L, D)),
        "w_in": nrm(ks[5], (L, D, PROJ_DIM), D ** -0.5),
        "a_q_gain": gain(ks[6], (L, HEAD_DIM)),
        "a_k_gain": gain(ks[7], (L, HEAD_DIM)),
        "b_cq_gain": gain(ks[8], (L, B_Q_LORA)),
        "b_ckv_gain": gain(ks[9], (L, B_KV_LORA)),
        "w_uq": nrm(ks[10], (L, B_Q_LORA, B_HEADS * (B_QK_NOPE + B_QK_ROPE)), B_Q_LORA ** -0.5),
        "w_ukv": nrm(ks[11], (L, B_KV_LORA, B_HEADS * (B_QK_NOPE + B_V_DIM)), B_KV_LORA ** -0.5),
        "c_conv_w": nrm(ks[12], (L, CONV_W, 2 * C_HEADS * C_DQK), CONV_W ** -0.5),
        "c_conv_b": nrm(ks[15], (L, 2 * C_HEADS * C_DQK), 0.02),
        "c_gate_b": c_gate_b,
        "head_out_gain": gain(ks[16], (L, D_MIX)),
        "w_out": nrm(ks[17], (L, D_MIX, D), D_MIX ** -0.5),
        "post_mix_gain": gain(ks[18], (L, D)),
        "pre_ffn_gain": gain(ks[19], (L, D)),
        "router_w": nrm(ks[20], (L, D, N_EXPERTS), D ** -0.5),
        "router_bias": nrm(ks[21], (L, N_EXPERTS), 0.01),
        "exp_w_gate": nrm(ks[22], (L, N_EXPERTS, D, EXPERT_FF), D ** -0.5),
        "exp_w_up": nrm(ks[23], (L, N_EXPERTS, D, EXPERT_FF), D ** -0.5),
        "exp_w_down": nrm(ks[24], (L, N_EXPERTS, EXPERT_FF, D), EXPERT_FF ** -0.5),
        "sh_w_gate": nrm(ks[25], (L, D, SHARED_FF), D ** -0.5),
        "sh_w_up": nrm(ks[26], (L, D, SHARED_FF), D ** -0.5),
        "sh_w_down": nrm(ks[27], (L, SHARED_FF, D), SHARED_FF ** -0.5),
        "post_ffn_gain": gain(ks[28], (L, D)),
    }


def reference(x, c, ada_w, ada_b, pre_mix_gain, w_in, a_q_gain, a_k_gain, b_cq_gain, b_ckv_gain,
              w_uq, w_ukv, c_conv_w, c_conv_b, c_gate_b, head_out_gain, w_out, post_mix_gain,
              pre_ffn_gain, router_w, router_bias, exp_w_gate, exp_w_up, exp_w_down,
              sh_w_gate, sh_w_up, sh_w_down, post_ffn_gain):
    B, S, D = x.shape
    rope_a = axial_rope_tables(S, HEAD_DIM)
    rope_b = axial_rope_tables(S, B_QK_ROPE)
    c_act = jax.nn.silu(c)
    for l in range(DEPTH):
        mod = (c_act @ ada_w[l] + ada_b[l]).reshape(B, N_MOD, D)[:, :, None, :]
        sh1, sc1, g1, sh2, sc2, g2 = [mod[:, i] for i in range(N_MOD)]
        h = rms_norm(x, pre_mix_gain[l]) * (1.0 + sc1) + sh1
        y = hybrid_mixer(h, w_in[l], a_q_gain[l], a_k_gain[l], b_cq_gain[l], b_ckv_gain[l],
                         w_uq[l], w_ukv[l], c_conv_w[l], c_conv_b[l], c_gate_b[l],
                         head_out_gain[l], w_out[l], rope_a, rope_b)
        x = x + g1 * rms_norm(y, post_mix_gain[l])
        h = rms_norm(x, pre_ffn_gain[l]) * (1.0 + sc2) + sh2
        y = moe_ffn(h.reshape(B * S, D), router_w[l], router_bias[l], exp_w_gate[l], exp_w_up[l],
                    exp_w_down[l], sh_w_gate[l], sh_w_up[l], sh_w_down[l]).reshape(B, S, D)
        x = x + g2 * rms_norm(y, post_ffn_gain[l])
    return x
```

```cpp
#include <hip/hip_runtime.h>
#include <stdint.h>
#include <math.h>

namespace nv {
constexpr int D = 2048, NB = 4, S = 4096, T = NB * S, DEPTH = 2;
constexpr int PROJ = 4048;
constexpr int O_AQ = 0, O_AK = 768, O_AV = 1024, O_BCQ = 1280, O_BCKV = 1664, O_BKR = 1920, O_CQ = 1984, O_CK = 2496, O_CV = 3008, O_CO = 3520, O_CG = 4032;
constexpr int NE = 64, TOPK = 6, FF = 512;
constexpr float EPS = 1e-6f;
constexpr int CAP = 16384;

__device__ __forceinline__ float sigmoidf_(float x) { return 1.f / (1.f + expf(-x)); }
__device__ __forceinline__ float siluf_(float x) { return x / (1.f + expf(-x)); }

__device__ __forceinline__ float block_sum256(float v, float* red) {
    for (int o = 32; o >= 1; o >>= 1) v += __shfl_xor(v, o);
    __syncthreads();
    if ((threadIdx.x & 63) == 0) red[threadIdx.x >> 6] = v;
    __syncthreads();
    float r = red[0] + red[1] + red[2] + red[3];
    return r;
}

__global__ __launch_bounds__(256) void k_mod(const float* c, const float* ada_w, const float* ada_b, float* mod) {
    __shared__ float cs[4 * 2048];
    for (int i = threadIdx.x; i < 4 * 2048; i += 256) cs[i] = siluf_(c[i]);
    __syncthreads();
    const int n = blockIdx.x * 256 + threadIdx.x, l = blockIdx.y;
    const float* w = ada_w + (size_t)l * 2048 * 12288 + n;
    float a0 = 0, a1 = 0, a2 = 0, a3 = 0;
    for (int k = 0; k < 2048; ++k) { const float wv = w[(size_t)k * 12288]; a0 += cs[k] * wv; a1 += cs[2048 + k] * wv; a2 += cs[4096 + k] * wv; a3 += cs[6144 + k] * wv; }
    const float b = ada_b[l * 12288 + n];
    mod[((size_t)l * 4 + 0) * 12288 + n] = a0 + b; mod[((size_t)l * 4 + 1) * 12288 + n] = a1 + b;
    mod[((size_t)l * 4 + 2) * 12288 + n] = a2 + b; mod[((size_t)l * 4 + 3) * 12288 + n] = a3 + b;
}

__global__ void k_rope_tab(float* cosA, float* sinA, float* cosB, float* sinB) {
    const int i = blockIdx.x * blockDim.x + threadIdx.x;
    if (i < 64 * 32) { const int p = i / 32, f = i % 32; const float inv = powf(10000.f, -(float)(2 * f) / 64.f); const float a = (float)p * inv; cosA[i] = cosf(a); sinA[i] = sinf(a); }
    if (i < 64 * 16) { const int p = i / 16, f = i % 16; const float inv = powf(10000.f, -(float)(2 * f) / 32.f); const float a = (float)p * inv; cosB[i] = cosf(a); sinB[i] = sinf(a); }
}

__global__ __launch_bounds__(256) void k_prenorm(const float* x, const float* gain, const float* sc, const float* sh, float* h) {
    __shared__ float red[4];
    const int t = blockIdx.x, b = t / S;
    const float* xr = x + (size_t)t * D; float v[8]; float ss = 0;
    for (int i = 0; i < 8; ++i) { v[i] = xr[threadIdx.x + i * 256]; ss += v[i] * v[i]; }
    ss = block_sum256(ss, red);
    const float r = rsqrtf(ss / D + EPS);
    for (int i = 0; i < 8; ++i) { const int d = threadIdx.x + i * 256; h[(size_t)t * D + d] = v[i] * r * gain[d] * (1.f + sc[b * 12288 + d]) + sh[b * 12288 + d]; }
}

struct GA {
    const float* A; const float* B; float* C; const int* cnt; const int* start; const int* gather; const int* scat; const float* scal;
    long long bstride; long long gstride;
    int lda, ldb, ldc, M, N, K, z0, pad;
};
__global__ __launch_bounds__(256) void k_gemm(GA a) {
    __shared__ float As[16][132];
    __shared__ float Bs[16][132];
    const int z = blockIdx.z + a.z0;
    const int M = a.cnt ? a.cnt[z] : a.M;
    const int bm = blockIdx.y * 128, bn = blockIdx.x * 128;
    if (bm >= M) return;
    const int rowoff = a.start ? a.start[z] : 0;
    const float* B = a.B + (size_t)z * a.bstride;
    const int tx = threadIdx.x & 15, ty = threadIdx.x >> 4;
    float acc[8][8];
#pragma unroll
    for (int i = 0; i < 8; ++i)
#pragma unroll
        for (int j = 0; j < 8; ++j) acc[i][j] = 0.f;
    const int ak = threadIdx.x & 15, ar = threadIdx.x >> 4;
    size_t arow[8]; bool aval[8];
#pragma unroll
    for (int i = 0; i < 8; ++i) { const int m = bm + ar + 16 * i; aval[i] = m < M; size_t r = 0;
        if (aval[i]) r = a.gather ? (size_t)a.gather[(size_t)z * a.gstride + m] : (size_t)(rowoff + m);
        arow[i] = r * a.lda; }
    const int bk = threadIdx.x >> 4, bnn = (threadIdx.x & 15) * 8;
    for (int k0 = 0; k0 < a.K; k0 += 16) {
#pragma unroll
        for (int i = 0; i < 8; ++i) As[ak][ar + 16 * i] = aval[i] ? a.A[arow[i] + k0 + ak] : 0.f;
#pragma unroll
        for (int j = 0; j < 8; ++j) { const int n = bn + bnn + j; Bs[bk][bnn + j] = (n < a.N) ? B[(size_t)(k0 + bk) * a.ldb + n] : 0.f; }
        __syncthreads();
#pragma unroll
        for (int k = 0; k < 16; ++k) {
            float av[8], bv[8];
#pragma unroll
            for (int i = 0; i < 8; ++i) av[i] = As[k][ty * 8 + i];
#pragma unroll
            for (int j = 0; j < 8; ++j) bv[j] = Bs[k][tx * 8 + j];
#pragma unroll
            for (int i = 0; i < 8; ++i)
#pragma unroll
                for (int j = 0; j < 8; ++j) acc[i][j] += av[i] * bv[j];
        }
        __syncthreads();
    }
#pragma unroll
    for (int i = 0; i < 8; ++i) {
        const int m = bm + ty * 8 + i; if (m >= M) continue;
        if (a.scat) {
            const size_t r = (size_t)a.scat[(size_t)z * a.gstride + m]; const float sc = a.scal[(size_t)z * a.gstride + m];
#pragma unroll
            for (int j = 0; j < 8; ++j) { const int n = bn + tx * 8 + j; if (n < a.N) a.C[r * a.ldc + n] += sc * acc[i][j]; }
        } else {
            const size_t r = (size_t)(rowoff + m);
#pragma unroll
            for (int j = 0; j < 8; ++j) { const int n = bn + tx * 8 + j; if (n < a.N) a.C[r * a.ldc + n] = acc[i][j]; }
        }
    }
}

__global__ __launch_bounds__(256) void k_postproj(const float* proj, const float* aq_gain, const float* ak_gain, const float* cq_gain, const float* ckv_gain,
                                                   const float* cosA, const float* sinA, const float* cosB, const float* sinB,
                                                   float* QA, float* KA, float* CQN, float* CKVN, float* KR) {
    __shared__ float red[4];
    __shared__ float buf[1024];
    const int t = blockIdx.x, s = t % S, prow = s / 64, pcol = s % 64, tid = threadIdx.x;
    const float* p = proj + (size_t)t * PROJ;
    for (int i = tid; i < 1024; i += 256) buf[i] = p[i];
    __syncthreads();
    for (int hd = 0; hd < 8; ++hd) {
        float v = (tid < 128) ? buf[hd * 128 + tid] : 0.f;
        float ss = block_sum256(v * v, red);
        const float r = rsqrtf(ss / 128.f + EPS);
        if (tid < 128) {
            const float* g = hd < 6 ? aq_gain : ak_gain;
            const int half = tid >> 6, j = tid & 63, f = j & 31, part = j >> 5;
            const int pos = half ? pcol : prow;
            const float cs = cosA[pos * 32 + f], sn = sinA[pos * 32 + f];
            const int i1 = hd * 128 + half * 64 + f, i2 = i1 + 32;
            const float x1 = buf[i1] * r * g[half * 64 + f], x2 = buf[i2] * r * g[half * 64 + 32 + f];
            const float o = part == 0 ? (x1 * cs - x2 * sn) : (x2 * cs + x1 * sn);
            if (hd < 6) QA[(size_t)t * 768 + hd * 128 + tid] = o; else KA[(size_t)t * 256 + (hd - 6) * 128 + tid] = o;
        }
        __syncthreads();
    }
    {
        float v0 = p[O_BCQ + tid], v1 = (tid < 128) ? p[O_BCQ + 256 + tid] : 0.f;
        float ss = block_sum256(v0 * v0 + v1 * v1, red);
        const float r = rsqrtf(ss / 384.f + EPS);
        CQN[(size_t)t * 384 + tid] = v0 * r * cq_gain[tid];
        if (tid < 128) CQN[(size_t)t * 384 + 256 + tid] = v1 * r * cq_gain[256 + tid];
    }
    {
        float v0 = p[O_BCKV + tid];
        float ss = block_sum256(v0 * v0, red);
        const float r = rsqrtf(ss / 256.f + EPS);
        CKVN[(size_t)t * 256 + tid] = v0 * r * ckv_gain[tid];
    }
    if (tid < 64) {
        const int half = tid >> 5, j = tid & 31, f = j & 15, part = j >> 4;
        const int pos = half ? pcol : prow;
        const float cs = cosB[pos * 16 + f], sn = sinB[pos * 16 + f];
        const float x1 = p[O_BKR + half * 32 + f], x2 = p[O_BKR + half * 32 + 16 + f];
        KR[(size_t)t * 64 + tid] = part == 0 ? (x1 * cs - x2 * sn) : (x2 * cs + x1 * sn);
    }
}
__global__ __launch_bounds__(256) void k_rope_qb(float* QB, const float* cosB, const float* sinB) {
    const int t = blockIdx.x, s = t % S, prow = s / 64, pcol = s % 64, tid = threadIdx.x;
    if (tid < 192) {
        const int hd = tid / 32, j = tid % 32, half = j >> 4, f = j & 15;
        const int pos = half ? pcol : prow;
        const float cs = cosB[pos * 16 + f], sn = sinB[pos * 16 + f];
        float* q = QB + (size_t)t * 1152 + hd * 192 + 128 + half * 32;
        const float x1 = q[f], x2 = q[16 + f];
        q[f] = x1 * cs - x2 * sn; q[16 + f] = x2 * cs + x1 * sn;
    }
}
__global__ __launch_bounds__(256) void k_conv(const float* proj, const float* cw, const float* cb, float* QC, float* KC) {
    const int t = blockIdx.x, s = t % S;
    for (int c = threadIdx.x; c < 1024; c += 256) {
        float acc = cb[c];
        for (int j = 0; j < 5; ++j) { const int ss = s + j - 2; if (ss >= 0 && ss < S) acc += proj[(size_t)(t + j - 2) * PROJ + O_CQ + c] * cw[j * 1024 + c]; }
        const float y = siluf_(acc);
        if (c < 512) QC[(size_t)t * 512 + c] = y; else KC[(size_t)t * 512 + c - 512] = y * 0.08838834764831845f;
    }
}

struct AA { const float* q; const float* k1; const float* k2; const float* v; float* o; int ldq, qhs, ldk1, k1hs, d1, ldk2, d2, ldv, vhs, ldo, ohs, group; float scale; int pad; };
__global__ __launch_bounds__(256) void k_attn(AA a) {
    extern __shared__ float sm[];
    const int w = threadIdx.x >> 6, lane = threadIdx.x & 63;
    float* qs = sm + w * 192; float* ps = sm + 4 * 192 + w * S;
    const int s = blockIdx.x * 4 + w, h = blockIdx.y, b = blockIdx.z, kvh = h / a.group;
    const size_t tq = (size_t)b * S + s;
    const int dq = a.d1 + a.d2;
    for (int d = lane; d < dq; d += 64) qs[d] = a.q[tq * a.ldq + h * a.qhs + d];
    __syncthreads();
    float mx = -1e30f;
    for (int key = lane; key < S; key += 64) {
        const size_t tk = (size_t)b * S + key;
        const float* kp = a.k1 + tk * a.ldk1 + kvh * a.k1hs; float acc = 0;
        for (int d = 0; d < a.d1; d += 4) { const float4 kv = *(const float4*)(kp + d); acc += qs[d] * kv.x + qs[d + 1] * kv.y + qs[d + 2] * kv.z + qs[d + 3] * kv.w; }
        if (a.d2) { const float* kp2 = a.k2 + tk * a.ldk2;
            for (int d = 0; d < a.d2; d += 4) { const float4 kv = *(const float4*)(kp2 + d); acc += qs[a.d1 + d] * kv.x + qs[a.d1 + d + 1] * kv.y + qs[a.d1 + d + 2] * kv.z + qs[a.d1 + d + 3] * kv.w; } }
        acc *= a.scale; ps[key] = acc; mx = fmaxf(mx, acc);
    }
    for (int o = 32; o >= 1; o >>= 1) mx = fmaxf(mx, __shfl_xor(mx, o));
    float sum = 0;
    for (int key = lane; key < S; key += 64) { const float e = expf(ps[key] - mx); ps[key] = e; sum += e; }
    for (int o = 32; o >= 1; o >>= 1) sum += __shfl_xor(sum, o);
    __syncthreads();
    float o0 = 0, o1 = 0;
    const float* vp = a.v + (size_t)b * S * a.ldv + kvh * a.vhs + lane;
    for (int key = 0; key < S; ++key) { const float pk = ps[key]; o0 += pk * vp[(size_t)key * a.ldv]; o1 += pk * vp[(size_t)key * a.ldv + 64]; }
    const float inv = 1.f / sum;
    a.o[tq * a.ldo + h * a.ohs + lane] = o0 * inv; a.o[tq * a.ldo + h * a.ohs + 64 + lane] = o1 * inv;
}

__global__ __launch_bounds__(256) void k_mlstm(const float* QC, const float* KC, const float* proj, const float* gate_b, float* YCAT, int dir) {
    __shared__ float qs[16][128], ks[16][128], vs[16][128], gi[16], gf[16];
    __shared__ float part[2][128]; __shared__ float dred[4];
    const int h = blockIdx.x, b = blockIdx.y, tid = threadIdx.x, dv = tid & 127, half = tid >> 7;
    float C[64];
#pragma unroll
    for (int i = 0; i < 64; ++i) C[i] = 0.f;
    float nst = 0.f;
    float m = 0.f;
    const float bi = gate_b[(dir * 2 + 0) * 4 + h], bf = gate_b[(dir * 2 + 1) * 4 + h];
    for (int s0 = 0; s0 < S; s0 += 16) {
        __syncthreads();
        for (int i = tid; i < 16 * 128; i += 256) { const int st = i >> 7, d = i & 127; const int s = dir ? (S - 1 - (s0 + st)) : (s0 + st); const size_t t = (size_t)b * S + s;
            qs[st][d] = QC[t * 512 + h * 128 + d]; ks[st][d] = KC[t * 512 + h * 128 + d]; vs[st][d] = proj[t * PROJ + O_CV + h * 128 + d]; }
        if (tid < 16) { const int s = dir ? (S - 1 - (s0 + tid)) : (s0 + tid); const size_t t = (size_t)b * S + s;
            gi[tid] = proj[t * PROJ + O_CG + (dir * 2 + 0) * 4 + h] + bi;
            const float f = proj[t * PROJ + O_CG + (dir * 2 + 1) * 4 + h] + bf; gf[tid] = fminf(f, 0.f) - log1pf(expf(-fabsf(f))); }
        __syncthreads();
        for (int st = 0; st < 16; ++st) {
            const float logi = gi[st], logf = gf[st];
            const float mn = fmaxf(logf + m, logi); const float fd = expf(logf + m - mn), iw = expf(logi - mn); m = mn;
            const float vv = vs[st][dv] * iw; float num = 0.f;
#pragma unroll
            for (int i = 0; i < 64; ++i) { C[i] = fd * C[i] + vv * ks[st][half * 64 + i]; num += C[i] * qs[st][half * 64 + i]; }
            float dp = 0.f;
            if (tid < 128) { nst = fd * nst + iw * ks[st][tid]; dp = nst * qs[st][tid]; }
            for (int o = 32; o >= 1; o >>= 1) dp += __shfl_xor(dp, o);
            part[half][dv] = num; if ((tid & 63) == 0) dred[tid >> 6] = dp;
            __syncthreads();
            if (tid < 128) { const float den = dred[0] + dred[1]; const float hh = (part[0][tid] + part[1][tid]) / fmaxf(fabsf(den), expf(-mn));
                const int s = dir ? (S - 1 - (s0 + st)) : (s0 + st); float* o = YCAT + ((size_t)b * S + s) * 2048 + 1536 + h * 128 + tid;
                if (dir) *o += hh; else *o = hh; }
            __syncthreads();
        }
    }
}

__global__ __launch_bounds__(256) void k_merge(const float* YCAT, const float* gain, const float* proj, float* YM) {
    const int t = blockIdx.x, w = threadIdx.x >> 6, lane = threadIdx.x & 63;
    for (int hd = w; hd < 16; hd += 4) {
        const float a0 = YCAT[(size_t)t * 2048 + hd * 128 + lane], a1 = YCAT[(size_t)t * 2048 + hd * 128 + 64 + lane];
        float ss = a0 * a0 + a1 * a1; for (int o = 32; o >= 1; o >>= 1) ss += __shfl_xor(ss, o);
        const float r = rsqrtf(ss / 128.f + EPS);
        float y0 = a0 * r * gain[hd * 128 + lane], y1 = a1 * r * gain[hd * 128 + 64 + lane];
        if (hd >= 12) { const int c = (hd - 12) * 128 + lane; y0 *= sigmoidf_(proj[(size_t)t * PROJ + O_CO + c]); y1 *= sigmoidf_(proj[(size_t)t * PROJ + O_CO + c + 64]); }
        YM[(size_t)t * 2048 + hd * 128 + lane] = y0; YM[(size_t)t * 2048 + hd * 128 + 64 + lane] = y1;
    }
}
__global__ __launch_bounds__(256) void k_resid(const float* xi, const float* y, const float* gain1, const float* g, float* xo, const float* gain2, const float* sc, const float* sh, float* h) {
    __shared__ float red[4];
    const int t = blockIdx.x, b = t / S;
    float yv[8], xv[8]; float ss = 0;
    for (int i = 0; i < 8; ++i) { yv[i] = y[(size_t)t * D + threadIdx.x + i * 256]; ss += yv[i] * yv[i]; }
    ss = block_sum256(ss, red);
    const float r = rsqrtf(ss / D + EPS); float s2 = 0;
    for (int i = 0; i < 8; ++i) { const int d = threadIdx.x + i * 256; xv[i] = xi[(size_t)t * D + d] + g[b * 12288 + d] * (yv[i] * r * gain1[d]); xo[(size_t)t * D + d] = xv[i]; s2 += xv[i] * xv[i]; }
    if (h) { s2 = block_sum256(s2, red); const float r2 = rsqrtf(s2 / D + EPS);
        for (int i = 0; i < 8; ++i) { const int d = threadIdx.x + i * 256; h[(size_t)t * D + d] = xv[i] * r2 * gain2[d] * (1.f + sc[b * 12288 + d]) + sh[b * 12288 + d]; } }
}
__global__ __launch_bounds__(256) void k_topk(const float* logits, const float* rbias, int* cnt, int* list_tok, float* list_g) {
    const int t = blockIdx.x * 256 + threadIdx.x; if (t >= T) return;
    float sc[64];
    unsigned long long taken = 0ull; int sel[6]; float sv[6]; float sum = 0;
    for (int k = 0; k < 6; ++k) { float best = -1e30f; int bi = 0;
        for (int e = 0; e < 64; ++e) { const float s = sigmoidf_(logits[(size_t)t * 64 + e]); const float v = s + rbias[e]; if (!((taken >> e) & 1ull) && v > best) { best = v; bi = e; } }
        taken |= 1ull << bi; sel[k] = bi; sv[k] = sigmoidf_(logits[(size_t)t * 64 + bi]); sum += sv[k]; }
    (void)sc;
    for (int k = 0; k < 6; ++k) { const int e = sel[k]; const int pos = atomicAdd(&cnt[e], 1); list_tok[(size_t)e * CAP + pos] = t; list_g[(size_t)e * CAP + pos] = sv[k] / sum * 2.5f; }
}
__global__ void k_scan(const int* cnt, int* start) { if (threadIdx.x == 0) { int a = 0; for (int e = 0; e < 64; ++e) { start[e] = a; a += cnt[e]; } start[64] = a; } }
__global__ __launch_bounds__(256) void k_act(float* hg, const float* hu, size_t n) { for (size_t i = (size_t)blockIdx.x * 256 + threadIdx.x; i < n; i += (size_t)gridDim.x * 256) hg[i] = siluf_(hg[i]) * hu[i]; }

static void gemm(hipStream_t st, const float* A, int lda, const float* B, int ldb, float* C, int ldc, int M, int N, int K) {
    GA a{}; a.A = A; a.lda = lda; a.B = B; a.ldb = ldb; a.bstride = 0; a.C = C; a.ldc = ldc; a.M = M; a.N = N; a.K = K; a.z0 = 0;
    hipLaunchKernelGGL(k_gemm, dim3((N + 127) / 128, (M + 127) / 128, 1), dim3(256), 0, st, a);
}

static void forward(void* const* d_in, float* out, char* ws, hipStream_t st) {
    const float* x_in = (const float*)d_in[0]; const float* c = (const float*)d_in[1];
    const float* ada_w = (const float*)d_in[2]; const float* ada_b = (const float*)d_in[3]; const float* pre_mix_gain = (const float*)d_in[4];
    const float* w_in = (const float*)d_in[5]; const float* a_q_gain = (const float*)d_in[6]; const float* a_k_gain = (const float*)d_in[7];
    const float* b_cq_gain = (const float*)d_in[8]; const float* b_ckv_gain = (const float*)d_in[9]; const float* w_uq = (const float*)d_in[10]; const float* w_ukv = (const float*)d_in[11];
    const float* c_conv_w = (const float*)d_in[12]; const float* c_conv_b = (const float*)d_in[13]; const float* c_gate_b = (const float*)d_in[14];
    const float* head_out_gain = (const float*)d_in[15]; const float* w_out = (const float*)d_in[16]; const float* post_mix_gain = (const float*)d_in[17];
    const float* pre_ffn_gain = (const float*)d_in[18]; const float* router_w = (const float*)d_in[19]; const float* router_bias = (const float*)d_in[20];
    const float* exp_w_gate = (const float*)d_in[21]; const float* exp_w_up = (const float*)d_in[22]; const float* exp_w_down = (const float*)d_in[23];
    const float* sh_w_gate = (const float*)d_in[24]; const float* sh_w_up = (const float*)d_in[25]; const float* sh_w_down = (const float*)d_in[26]; const float* post_ffn_gain = (const float*)d_in[27];
    size_t off = 0; auto alloc = [&](size_t bytes) { char* p = ws + off; off += (bytes + 255) / 256 * 256; return p; };
    float* mod = (float*)alloc((size_t)2 * 4 * 12288 * 4);
    float* cosA = (float*)alloc(64 * 32 * 4); float* sinA = (float*)alloc(64 * 32 * 4); float* cosB = (float*)alloc(64 * 16 * 4); float* sinB = (float*)alloc(64 * 16 * 4);
    int* cnt = (int*)alloc(256); int* start = (int*)alloc(512);
    int* list_tok = (int*)alloc((size_t)NE * CAP * 4); float* list_g = (float*)alloc((size_t)NE * CAP * 4);
    float* X = (float*)alloc((size_t)T * D * 4);
    float* H = (float*)alloc((size_t)T * D * 4);
    float* PRJ = (float*)alloc((size_t)T * PROJ * 4);
    float* QA = (float*)alloc((size_t)T * 768 * 4); float* KA = (float*)alloc((size_t)T * 256 * 4);
    float* CQN = (float*)alloc((size_t)T * 384 * 4); float* CKVN = (float*)alloc((size_t)T * 256 * 4); float* KR = (float*)alloc((size_t)T * 64 * 4);
    float* QB = (float*)alloc((size_t)T * 1152 * 4); float* KVB = (float*)alloc((size_t)T * 1536 * 4);
    float* QC = (float*)alloc((size_t)T * 512 * 4); float* KC = (float*)alloc((size_t)T * 512 * 4);
    float* YCAT = (float*)alloc((size_t)T * D * 4); float* Y = (float*)alloc((size_t)T * D * 4);
    float* LOG = (float*)alloc((size_t)T * 64 * 4);
    float* HG = (float*)alloc((size_t)T * 6 * FF * 4); float* HU = (float*)alloc((size_t)T * 6 * FF * 4);
    float* SG = (float*)alloc((size_t)T * FF * 4); float* SU = (float*)alloc((size_t)T * FF * 4);

    hipLaunchKernelGGL(k_mod, dim3(48, 2), dim3(256), 0, st, c, ada_w, ada_b, mod);
    hipLaunchKernelGGL(k_rope_tab, dim3(8), dim3(256), 0, st, cosA, sinA, cosB, sinB);
    static bool attr = false; if (!attr) { hipFuncSetAttribute((const void*)k_attn, hipFuncAttributeMaxDynamicSharedMemorySize, (4 * 192 + 4 * S) * 4); attr = true; }
    const float* xcur = x_in;
    for (int l = 0; l < DEPTH; ++l) {
        const float* md = mod + (size_t)l * 4 * 12288;
        const float* sh1 = md + 0 * 2048; const float* sc1 = md + 1 * 2048; const float* g1 = md + 2 * 2048; const float* sh2 = md + 3 * 2048; const float* sc2 = md + 4 * 2048; const float* g2 = md + 5 * 2048;
        hipLaunchKernelGGL(k_prenorm, dim3(T), dim3(256), 0, st, xcur, pre_mix_gain + l * D, sc1, sh1, H);
        gemm(st, H, D, w_in + (size_t)l * D * PROJ, PROJ, PRJ, PROJ, T, PROJ, D);
        hipLaunchKernelGGL(k_postproj, dim3(T), dim3(256), 0, st, PRJ, a_q_gain + l * 128, a_k_gain + l * 128, b_cq_gain + l * 384, b_ckv_gain + l * 256, cosA, sinA, cosB, sinB, QA, KA, CQN, CKVN, KR);
        gemm(st, CQN, 384, w_uq + (size_t)l * 384 * 1152, 1152, QB, 1152, T, 1152, 384);
        gemm(st, CKVN, 256, w_ukv + (size_t)l * 256 * 1536, 1536, KVB, 1536, T, 1536, 256);
        hipLaunchKernelGGL(k_rope_qb, dim3(T), dim3(256), 0, st, QB, cosB, sinB);
        hipLaunchKernelGGL(k_conv, dim3(T), dim3(256), 0, st, PRJ, c_conv_w + (size_t)l * 5 * 1024, c_conv_b + l * 1024, QC, KC);
        { AA a{}; a.q = QA; a.ldq = 768; a.qhs = 128; a.k1 = KA; a.ldk1 = 256; a.k1hs = 128; a.d1 = 128; a.k2 = nullptr; a.ldk2 = 0; a.d2 = 0; a.v = PRJ + O_AV; a.ldv = PROJ; a.vhs = 128; a.o = YCAT; a.ldo = 2048; a.ohs = 128; a.group = 3; a.scale = 0.08838834764831845f;
          hipLaunchKernelGGL(k_attn, dim3(S / 4, 6, NB), dim3(256), (4 * 192 + 4 * S) * 4, st, a); }
        { AA a{}; a.q = QB; a.ldq = 1152; a.qhs = 192; a.k1 = KVB; a.ldk1 = 1536; a.k1hs = 256; a.d1 = 128; a.k2 = KR; a.ldk2 = 64; a.d2 = 64; a.v = KVB + 128; a.ldv = 1536; a.vhs = 256; a.o = YCAT + 768; a.ldo = 2048; a.ohs = 128; a.group = 1; a.scale = 0.07216878364870322f;
          hipLaunchKernelGGL(k_attn, dim3(S / 4, 6, NB), dim3(256), (4 * 192 + 4 * S) * 4, st, a); }
        hipLaunchKernelGGL(k_mlstm, dim3(4, NB), dim3(256), 0, st, QC, KC, PRJ, c_gate_b + l * 16, YCAT, 0);
        hipLaunchKernelGGL(k_mlstm, dim3(4, NB), dim3(256), 0, st, QC, KC, PRJ, c_gate_b + l * 16, YCAT, 1);
        hipLaunchKernelGGL(k_merge, dim3(T), dim3(256), 0, st, YCAT, head_out_gain + l * D, PRJ, H);
        gemm(st, H, D, w_out + (size_t)l * D * D, D, Y, D, T, D, D);
        hipLaunchKernelGGL(k_resid, dim3(T), dim3(256), 0, st, xcur, Y, post_mix_gain + l * D, g1, X, pre_ffn_gain + l * D, sc2, sh2, H);
        xcur = X;
        gemm(st, H, D, router_w + (size_t)l * D * 64, 64, LOG, 64, T, 64, D);
        hipMemsetAsync(cnt, 0, 256, st);
        hipLaunchKernelGGL(k_topk, dim3(T / 256), dim3(256), 0, st, LOG, router_bias + l * 64, cnt, list_tok, list_g);
        hipLaunchKernelGGL(k_scan, dim3(1), dim3(64), 0, st, cnt, start);
        gemm(st, H, D, sh_w_gate + (size_t)l * D * FF, FF, SG, FF, T, FF, D);
        gemm(st, H, D, sh_w_up + (size_t)l * D * FF, FF, SU, FF, T, FF, D);
        hipLaunchKernelGGL(k_act, dim3(2048), dim3(256), 0, st, SG, SU, (size_t)T * FF);
        gemm(st, SG, FF, sh_w_down + (size_t)l * FF * D, D, Y, D, T, D, FF);
        { GA a{}; a.A = H; a.lda = D; a.B = exp_w_gate + (size_t)l * NE * D * FF; a.ldb = FF; a.bstride = (long long)D * FF; a.C = HG; a.ldc = FF; a.M = 0; a.N = FF; a.K = D; a.cnt = cnt; a.start = start; a.gather = list_tok; a.gstride = CAP; a.z0 = 0;
          hipLaunchKernelGGL(k_gemm, dim3(FF / 128, CAP / 128, NE), dim3(256), 0, st, a);
          a.B = exp_w_up + (size_t)l * NE * D * FF; a.C = HU;
          hipLaunchKernelGGL(k_gemm, dim3(FF / 128, CAP / 128, NE), dim3(256), 0, st, a); }
        hipLaunchKernelGGL(k_act, dim3(2048), dim3(256), 0, st, HG, HU, (size_t)T * 6 * FF);
        for (int e = 0; e < NE; ++e) { GA a{}; a.A = HG; a.lda = FF; a.B = exp_w_down + (size_t)l * NE * FF * D; a.ldb = D; a.bstride = (long long)FF * D; a.C = Y; a.ldc = D; a.M = 0; a.N = D; a.K = FF; a.cnt = cnt; a.start = start; a.gather = nullptr; a.gstride = CAP; a.scat = list_tok; a.scal = list_g; a.z0 = e;
          hipLaunchKernelGGL(k_gemm, dim3(D / 128, CAP / 128, 1), dim3(256), 0, st, a); }
        float* xo = (l == DEPTH - 1) ? out : X;
        hipLaunchKernelGGL(k_resid, dim3(T), dim3(256), 0, st, xcur, Y, post_ffn_gain + l * D, g2, xo, (const float*)nullptr, (const float*)nullptr, (const float*)nullptr, (float*)nullptr);
        xcur = xo;
    }
}
}

extern "C" void kernel_launch(void* const* d_in, const int* in_sizes, int n_in, void* d_out, int out_size, void* d_ws, size_t ws_size, hipStream_t stream) {
    nv::forward(d_in, (float*)d_out, (char*)d_ws, stream);
}
```

```cpp
#include <hip/hip_runtime.h>
#include <stdint.h>
#include <math.h>

namespace nv {
constexpr int D = 2048, NB = 4, S = 4096, T = NB * S, DEPTH = 2;
constexpr int PROJ = 4048;
constexpr int O_AQ = 0, O_AK = 768, O_AV = 1024, O_BCQ = 1280, O_BCKV = 1664, O_BKR = 1920, O_CQ = 1984, O_CK = 2496, O_CV = 3008, O_CO = 3520, O_CG = 4032;
constexpr int NE = 64, TOPK = 6, FF = 512;
constexpr float EPS = 1e-6f;
constexpr int CAP = 16384;

__device__ __forceinline__ float sigmoidf_(float x) { return 1.f / (1.f + expf(-x)); }
__device__ __forceinline__ float siluf_(float x) { return x / (1.f + expf(-x)); }

__device__ __forceinline__ float block_sum256(float v, float* red) {
    for (int o = 32; o >= 1; o >>= 1) v += __shfl_xor(v, o);
    __syncthreads();
    if ((threadIdx.x & 63) == 0) red[threadIdx.x >> 6] = v;
    __syncthreads();
    float r = red[0] + red[1] + red[2] + red[3];
    return r;
}

__global__ __launch_bounds__(256) void k_mod(const float* c, const float* ada_w, const float* ada_b, float* mod) {
    __shared__ float cs[4 * 2048];
    for (int i = threadIdx.x; i < 4 * 2048; i += 256) cs[i] = siluf_(c[i]);
    __syncthreads();
    const int n = blockIdx.x * 256 + threadIdx.x, l = blockIdx.y;
    const float* w = ada_w + (size_t)l * 2048 * 12288 + n;
    float a0 = 0, a1 = 0, a2 = 0, a3 = 0;
    for (int k = 0; k < 2048; ++k) { const float wv = w[(size_t)k * 12288]; a0 += cs[k] * wv; a1 += cs[2048 + k] * wv; a2 += cs[4096 + k] * wv; a3 += cs[6144 + k] * wv; }
    const float b = ada_b[l * 12288 + n];
    mod[((size_t)l * 4 + 0) * 12288 + n] = a0 + b; mod[((size_t)l * 4 + 1) * 12288 + n] = a1 + b;
    mod[((size_t)l * 4 + 2) * 12288 + n] = a2 + b; mod[((size_t)l * 4 + 3) * 12288 + n] = a3 + b;
}

__global__ void k_rope_tab(float* cosA, float* sinA, float* cosB, float* sinB) {
    const int i = blockIdx.x * blockDim.x + threadIdx.x;
    if (i < 64 * 32) { const int p = i / 32, f = i % 32; const float inv = powf(10000.f, -(float)(2 * f) / 64.f); const float a = (float)p * inv; cosA[i] = cosf(a); sinA[i] = sinf(a); }
    if (i < 64 * 16) { const int p = i / 16, f = i % 16; const float inv = powf(10000.f, -(float)(2 * f) / 32.f); const float a = (float)p * inv; cosB[i] = cosf(a); sinB[i] = sinf(a); }
}

__global__ __launch_bounds__(256) void k_prenorm(const float* x, const float* gain, const float* sc, const float* sh, float* h) {
    __shared__ float red[4];
    const int t = blockIdx.x, b = t / S;
    const float* xr = x + (size_t)t * D; float v[8]; float ss = 0;
    for (int i = 0; i < 8; ++i) { v[i] = xr[threadIdx.x + i * 256]; ss += v[i] * v[i]; }
    ss = block_sum256(ss, red);
    const float r = rsqrtf(ss / D + EPS);
    for (int i = 0; i < 8; ++i) { const int d = threadIdx.x + i * 256; h[(size_t)t * D + d] = v[i] * r * gain[d] * (1.f + sc[b * 12288 + d]) + sh[b * 12288 + d]; }
}

struct GA {
    const float* A; const float* B; float* C; const int* cnt; const int* start; const int* gather; const int* scat; const float* scal;
    long long bstride; long long gstride;
    int lda, ldb, ldc, M, N, K, z0, pad;
};
__global__ __launch_bounds__(256) void k_gemm(GA a) {
    __shared__ float As[16][132];
    __shared__ float Bs[16][132];
    const int z = blockIdx.z + a.z0;
    const int M = a.cnt ? a.cnt[z] : a.M;
    const int bm = blockIdx.y * 128, bn = blockIdx.x * 128;
    if (bm >= M) return;
    const int rowoff = a.start ? a.start[z] : 0;
    const float* B = a.B + (size_t)z * a.bstride;
    const int tx = threadIdx.x & 15, ty = threadIdx.x >> 4;
    float acc[8][8];
#pragma unroll
    for (int i = 0; i < 8; ++i)
#pragma unroll
        for (int j = 0; j < 8; ++j) acc[i][j] = 0.f;
    const int ak = threadIdx.x & 15, ar = threadIdx.x >> 4;
    size_t arow[8]; bool aval[8];
#pragma unroll
    for (int i = 0; i < 8; ++i) { const int m = bm + ar + 16 * i; aval[i] = m < M; size_t r = 0;
        if (aval[i]) r = a.gather ? (size_t)a.gather[(size_t)z * a.gstride + m] : (size_t)(rowoff + m);
        arow[i] = r * a.lda; }
    const int bk = threadIdx.x >> 4, bnn = (threadIdx.x & 15) * 8;
    for (int k0 = 0; k0 < a.K; k0 += 16) {
#pragma unroll
        for (int i = 0; i < 8; ++i) As[ak][ar + 16 * i] = aval[i] ? a.A[arow[i] + k0 + ak] : 0.f;
#pragma unroll
        for (int j = 0; j < 8; ++j) { const int n = bn + bnn + j; Bs[bk][bnn + j] = (n < a.N) ? B[(size_t)(k0 + bk) * a.ldb + n] : 0.f; }
        __syncthreads();
#pragma unroll
        for (int k = 0; k < 16; ++k) {
            float av[8], bv[8];
#pragma unroll
            for (int i = 0; i < 8; ++i) av[i] = As[k][ty * 8 + i];
#pragma unroll
            for (int j = 0; j < 8; ++j) bv[j] = Bs[k][tx * 8 + j];
#pragma unroll
            for (int i = 0; i < 8; ++i)
#pragma unroll
                for (int j = 0; j < 8; ++j) acc[i][j] += av[i] * bv[j];
        }
        __syncthreads();
    }
#pragma unroll
    for (int i = 0; i < 8; ++i) {
        const int m = bm + ty * 8 + i; if (m >= M) continue;
        if (a.scat) {
            const size_t r = (size_t)a.scat[(size_t)z * a.gstride + m]; const float sc = a.scal[(size_t)z * a.gstride + m];
#pragma unroll
            for (int j = 0; j < 8; ++j) { const int n = bn + tx * 8 + j; if (n < a.N) a.C[r * a.ldc + n] += sc * acc[i][j]; }
        } else {
            const size_t r = (size_t)(rowoff + m);
#pragma unroll
            for (int j = 0; j < 8; ++j) { const int n = bn + tx * 8 + j; if (n < a.N) a.C[r * a.ldc + n] = acc[i][j]; }
        }
    }
}

__global__ __launch_bounds__(256) void k_postproj(const float* proj, const float* aq_gain, const float* ak_gain, const float* cq_gain, const float* ckv_gain,
                                                   const float* cosA, const float* sinA, const float* cosB, const float* sinB,
                                                   float* QA, float* KA, float* CQN, float* CKVN, float* KR) {
    __shared__ float red[4];
    __shared__ float buf[1024];
    const int t = blockIdx.x, s = t % S, prow = s / 64, pcol = s % 64, tid = threadIdx.x;
    const float* p = proj + (size_t)t * PROJ;
    for (int i = tid; i < 1024; i += 256) buf[i] = p[i];
    __syncthreads();
    for (int hd = 0; hd < 8; ++hd) {
        float v = (tid < 128) ? buf[hd * 128 + tid] : 0.f;
        float ss = block_sum256(v * v, red);
        const float r = rsqrtf(ss / 128.f + EPS);
        if (tid < 128) {
            const float* g = hd < 6 ? aq_gain : ak_gain;
            const int half = tid >> 6, j = tid & 63, f = j & 31, part = j >> 5;
            const int pos = half ? pcol : prow;
            const float cs = cosA[pos * 32 + f], sn = sinA[pos * 32 + f];
            const int i1 = hd * 128 + half * 64 + f, i2 = i1 + 32;
            const float x1 = buf[i1] * r * g[half * 64 + f], x2 = buf[i2] * r * g[half * 64 + 32 + f];
            const float o = part == 0 ? (x1 * cs - x2 * sn) : (x2 * cs + x1 * sn);
            if (hd < 6) QA[(size_t)t * 768 + hd * 128 + tid] = o; else KA[(size_t)t * 256 + (hd - 6) * 128 + tid] = o;
        }
        __syncthreads();
    }
    {
        float v0 = p[O_BCQ + tid], v1 = (tid < 128) ? p[O_BCQ + 256 + tid] : 0.f;
        float ss = block_sum256(v0 * v0 + v1 * v1, red);
        const float r = rsqrtf(ss / 384.f + EPS);
        CQN[(size_t)t * 384 + tid] = v0 * r * cq_gain[tid];
        if (tid < 128) CQN[(size_t)t * 384 + 256 + tid] = v1 * r * cq_gain[256 + tid];
    }
    {
        float v0 = p[O_BCKV + tid];
        float ss = block_sum256(v0 * v0, red);
        const float r = rsqrtf(ss / 256.f + EPS);
        CKVN[(size_t)t * 256 + tid] = v0 * r * ckv_gain[tid];
    }
    if (tid < 64) {
        const int half = tid >> 5, j = tid & 31, f = j & 15, part = j >> 4;
        const int pos = half ? pcol : prow;
        const float cs = cosB[pos * 16 + f], sn = sinB[pos * 16 + f];
        const float x1 = p[O_BKR + half * 32 + f], x2 = p[O_BKR + half * 32 + 16 + f];
        KR[(size_t)t * 64 + tid] = part == 0 ? (x1 * cs - x2 * sn) : (x2 * cs + x1 * sn);
    }
}
__global__ __launch_bounds__(256) void k_rope_qb(float* QB, const float* cosB, const float* sinB) {
    const int t = blockIdx.x, s = t % S, prow = s / 64, pcol = s % 64, tid = threadIdx.x;
    if (tid < 192) {
        const int hd = tid / 32, j = tid % 32, half = j >> 4, f = j & 15;
        const int pos = half ? pcol : prow;
        const float cs = cosB[pos * 16 + f], sn = sinB[pos * 16 + f];
        float* q = QB + (size_t)t * 1152 + hd * 192 + 128 + half * 32;
        const float x1 = q[f], x2 = q[16 + f];
        q[f] = x1 * cs - x2 * sn; q[16 + f] = x2 * cs + x1 * sn;
    }
}
__global__ __launch_bounds__(256) void k_conv(const float* proj, const float* cw, const float* cb, float* QC, float* KC) {
    const int t = blockIdx.x, s = t % S;
    for (int c = threadIdx.x; c < 1024; c += 256) {
        float acc = cb[c];
        for (int j = 0; j < 5; ++j) { const int ss = s + j - 2; if (ss >= 0 && ss < S) acc += proj[(size_t)(t + j - 2) * PROJ + O_CQ + c] * cw[j * 1024 + c]; }
        const float y = siluf_(acc);
        if (c < 512) QC[(size_t)t * 512 + c] = y; else KC[(size_t)t * 512 + c - 512] = y * 0.08838834764831845f;
    }
}

struct AA { const float* q; const float* k1; const float* k2; const float* v; float* o; int ldq, qhs, ldk1, k1hs, d1, ldk2, d2, ldv, vhs, ldo, ohs, group; float scale; int pad; };
__global__ __launch_bounds__(256) void k_attn(AA a) {
    extern __shared__ float sm[];
    const int w = threadIdx.x >> 6, lane = threadIdx.x & 63;
    float* qs = sm + w * 192; float* ps = sm + 4 * 192 + w * S;
    const int s = blockIdx.x * 4 + w, h = blockIdx.y, b = blockIdx.z, kvh = h / a.group;
    const size_t tq = (size_t)b * S + s;
    const int dq = a.d1 + a.d2;
    for (int d = lane; d < dq; d += 64) qs[d] = a.q[tq * a.ldq + h * a.qhs + d];
    __syncthreads();
    float mx = -1e30f;
    for (int key = lane; key < S; key += 64) {
        const size_t tk = (size_t)b * S + key;
        const float* kp = a.k1 + tk * a.ldk1 + kvh * a.k1hs; float acc = 0;
        for (int d = 0; d < a.d1; d += 4) { const float4 kv = *(const float4*)(kp + d); acc += qs[d] * kv.x + qs[d + 1] * kv.y + qs[d + 2] * kv.z + qs[d + 3] * kv.w; }
        if (a.d2) { const float* kp2 = a.k2 + tk * a.ldk2;
            for (int d = 0; d < a.d2; d += 4) { const float4 kv = *(const float4*)(kp2 + d); acc += qs[a.d1 + d] * kv.x + qs[a.d1 + d + 1] * kv.y + qs[a.d1 + d + 2] * kv.z + qs[a.d1 + d + 3] * kv.w; } }
        acc *= a.scale; ps[key] = acc; mx = fmaxf(mx, acc);
    }
    for (int o = 32; o >= 1; o >>= 1) mx = fmaxf(mx, __shfl_xor(mx, o));
    float sum = 0;
    for (int key = lane; key < S; key += 64) { const float e = expf(ps[key] - mx); ps[key] = e; sum += e; }
    for (int o = 32; o >= 1; o >>= 1) sum += __shfl_xor(sum, o);
    __syncthreads();
    float o0 = 0, o1 = 0;
    const float* vp = a.v + (size_t)b * S * a.ldv + kvh * a.vhs + lane;
    for (int key = 0; key < S; ++key) { const float pk = ps[key]; o0 += pk * vp[(size_t)key * a.ldv]; o1 += pk * vp[(size_t)key * a.ldv + 64]; }
    const float inv = 1.f / sum;
    a.o[tq * a.ldo + h * a.ohs + lane] = o0 * inv; a.o[tq * a.ldo + h * a.ohs + 64 + lane] = o1 * inv;
}

__global__ __launch_bounds__(256) void k_mlstm(const float* QC, const float* KC, const float* proj, const float* gate_b, float* YCAT, int dir) {
    __shared__ float qs[16][128], ks[16][128], vs[16][128], gi[16], gf[16];
    __shared__ float part[2][128]; __shared__ float dred[4];
    const int h = blockIdx.x, b = blockIdx.y, tid = threadIdx.x, dv = tid & 127, half = tid >> 7;
    float C[64];
#pragma unroll
    for (int i = 0; i < 64; ++i) C[i] = 0.f;
    float nst = 0.f;
    float m = 0.f;
    const float bi = gate_b[(dir * 2 + 0) * 4 + h], bf = gate_b[(dir * 2 + 1) * 4 + h];
    for (int s0 = 0; s0 < S; s0 += 16) {
        __syncthreads();
        for (int i = tid; i < 16 * 128; i += 256) { const int st = i >> 7, d = i & 127; const int s = dir ? (S - 1 - (s0 + st)) : (s0 + st); const size_t t = (size_t)b * S + s;
            qs[st][d] = QC[t * 512 + h * 128 + d]; ks[st][d] = KC[t * 512 + h * 128 + d]; vs[st][d] = proj[t * PROJ + O_CV + h * 128 + d]; }
        if (tid < 16) { const int s = dir ? (S - 1 - (s0 + tid)) : (s0 + tid); const size_t t = (size_t)b * S + s;
            gi[tid] = proj[t * PROJ + O_CG + (dir * 2 + 0) * 4 + h] + bi;
            const float f = proj[t * PROJ + O_CG + (dir * 2 + 1) * 4 + h] + bf; gf[tid] = fminf(f, 0.f) - log1pf(expf(-fabsf(f))); }
        __syncthreads();
        for (int st = 0; st < 16; ++st) {
            const float logi = gi[st], logf = gf[st];
            const float mn = fmaxf(logf + m, logi); const float fd = expf(logf + m - mn), iw = expf(logi - mn); m = mn;
            const float vv = vs[st][dv] * iw; float num = 0.f;
#pragma unroll
            for (int i = 0; i < 64; ++i) { C[i] = fd * C[i] + vv * ks[st][half * 64 + i]; num += C[i] * qs[st][half * 64 + i]; }
            float dp = 0.f;
            if (tid < 128) { nst = fd * nst + iw * ks[st][tid]; dp = nst * qs[st][tid]; }
            for (int o = 32; o >= 1; o >>= 1) dp += __shfl_xor(dp, o);
            part[half][dv] = num; if ((tid & 63) == 0) dred[tid >> 6] = dp;
            __syncthreads();
            if (tid < 128) { const float den = dred[0] + dred[1]; const float hh = (part[0][tid] + part[1][tid]) / fmaxf(fabsf(den), expf(-mn));
                const int s = dir ? (S - 1 - (s0 + st)) : (s0 + st); float* o = YCAT + ((size_t)b * S + s) * 2048 + 1536 + h * 128 + tid;
                if (dir) *o += hh; else *o = hh; }
            __syncthreads();
        }
    }
}

__global__ __launch_bounds__(256) void k_merge(const float* YCAT, const float* gain, const float* proj, float* YM) {
    const int t = blockIdx.x, w = threadIdx.x >> 6, lane = threadIdx.x & 63;
    for (int hd = w; hd < 16; hd += 4) {
        const float a0 = YCAT[(size_t)t * 2048 + hd * 128 + lane], a1 = YCAT[(size_t)t * 2048 + hd * 128 + 64 + lane];
        float ss = a0 * a0 + a1 * a1; for (int o = 32; o >= 1; o >>= 1) ss += __shfl_xor(ss, o);
        const float r = rsqrtf(ss / 128.f + EPS);
        float y0 = a0 * r * gain[hd * 128 + lane], y1 = a1 * r * gain[hd * 128 + 64 + lane];
        if (hd >= 12) { const int c = (hd - 12) * 128 + lane; y0 *= sigmoidf_(proj[(size_t)t * PROJ + O_CO + c]); y1 *= sigmoidf_(proj[(size_t)t * PROJ + O_CO + c + 64]); }
        YM[(size_t)t * 2048 + hd * 128 + lane] = y0; YM[(size_t)t * 2048 + hd * 128 + 64 + lane] = y1;
    }
}
__global__ __launch_bounds__(256) void k_resid(const float* xi, const float* y, const float* gain1, const float* g, float* xo, const float* gain2, const float* sc, const float* sh, float* h) {
    __shared__ float red[4];
    const int t = blockIdx.x, b = t / S;
    float yv[8], xv[8]; float ss = 0;
    for (int i = 0; i < 8; ++i) { yv[i] = y[(size_t)t * D + threadIdx.x + i * 256]; ss += yv[i] * yv[i]; }
    ss = block_sum256(ss, red);
    const float r = rsqrtf(ss / D + EPS); float s2 = 0;
    for (int i = 0; i < 8; ++i) { const int d = threadIdx.x + i * 256; xv[i] = xi[(size_t)t * D + d] + g[b * 12288 + d] * (yv[i] * r * gain1[d]); xo[(size_t)t * D + d] = xv[i]; s2 += xv[i] * xv[i]; }
    if (h) { s2 = block_sum256(s2, red); const float r2 = rsqrtf(s2 / D + EPS);
        for (int i = 0; i < 8; ++i) { const int d = threadIdx.x + i * 256; h[(size_t)t * D + d] = xv[i] * r2 * gain2[d] * (1.f + sc[b * 12288 + d]) + sh[b * 12288 + d]; } }
}
__global__ __launch_bounds__(256) void k_topk(const float* logits, const float* rbias, int* cnt, int* list_tok, float* list_g) {
    const int t = blockIdx.x * 256 + threadIdx.x; if (t >= T) return;
    float sc[64];
    unsigned long long taken = 0ull; int sel[6]; float sv[6]; float sum = 0;
    for (int k = 0; k < 6; ++k) { float best = -1e30f; int bi = 0;
        for (int e = 0; e < 64; ++e) { const float s = sigmoidf_(logits[(size_t)t * 64 + e]); const float v = s + rbias[e]; if (!((taken >> e) & 1ull) && v > best) { best = v; bi = e; } }
        taken |= 1ull << bi; sel[k] = bi; sv[k] = sigmoidf_(logits[(size_t)t * 64 + bi]); sum += sv[k]; }
    (void)sc;
    for (int k = 0; k < 6; ++k) { const int e = sel[k]; const int pos = atomicAdd(&cnt[e], 1); list_tok[(size_t)e * CAP + pos] = t; list_g[(size_t)e * CAP + pos] = sv[k] / sum * 2.5f; }
}
__global__ void k_scan(const int* cnt, int* start) { if (threadIdx.x == 0) { int a = 0; for (int e = 0; e < 64; ++e) { start[e] = a; a += cnt[e]; } start[64] = a; } }
__global__ __launch_bounds__(256) void k_act(float* hg, const float* hu, size_t n) { for (size_t i = (size_t)blockIdx.x * 256 + threadIdx.x; i < n; i += (size_t)gridDim.x * 256) hg[i] = siluf_(hg[i]) * hu[i]; }

}
namespace fx {
#define FX_LAS __attribute__((address_space(3)))
typedef unsigned short bf16_t;
typedef short bf16x8 __attribute__((ext_vector_type(8)));
typedef short s16x4 __attribute__((ext_vector_type(4)));
typedef float f32x4 __attribute__((ext_vector_type(4)));
typedef float f32x16 __attribute__((ext_vector_type(16)));
typedef unsigned u32x4 __attribute__((ext_vector_type(4)));
typedef unsigned u32x2 __attribute__((ext_vector_type(2)));
typedef float f32x2 __attribute__((ext_vector_type(2)));

constexpr int D = 2048, NB = 4, S = 4096, T = NB * S, DEPTH = 2;
constexpr int NE = 64, FF = 512;
constexpr float EPS = 1e-6f;
constexpr int PW = 4096;
constexpr int O_AQ = 0, O_AK = 768, O_AV = 1024, O_BCQ = 1280, O_BCKV = 1664, O_BKR = 1920, O_CQ = 1984, O_CK = 2496, O_CV = 3008, O_CO = 3520, O_CG = 4032;

typedef __bf16 bf16x2_t __attribute__((ext_vector_type(2)));
__device__ __forceinline__ unsigned cvt_pk_bf16(float lo, float hi) { const bf16x2_t r = __builtin_convertvector((f32x2){lo, hi}, bf16x2_t); return __builtin_bit_cast(unsigned, r); }
__device__ __forceinline__ float bf2f(bf16_t b) { return __uint_as_float(((unsigned)b) << 16); }
__device__ __forceinline__ float bflo(unsigned w) { return __uint_as_float(w << 16); }
__device__ __forceinline__ float bfhi(unsigned w) { return __uint_as_float(w & 0xffff0000u); }
__device__ __forceinline__ bf16_t f2bf(float f) { return (bf16_t)(cvt_pk_bf16(f, 0.f) & 0xffffu); }
__device__ __forceinline__ float sigmoid_f(float x) { return 1.f / (1.f + __expf(-x)); }
__device__ __forceinline__ float silu_f(float x) { return x / (1.f + __expf(-x)); }
__device__ __forceinline__ float wave_sum(float v) { for (int o = 32; o >= 1; o >>= 1) v += __shfl_xor(v, o); return v; }
__device__ __forceinline__ float wave_max(float v) { for (int o = 32; o >= 1; o >>= 1) v = fmaxf(v, __shfl_xor(v, o)); return v; }

struct CvtSeg { const float* src; bf16_t* dst; long long sstride, dstride; int ld, nsrc, K, ntn, nbatch, G, GS, off; };
__device__ __forceinline__ void cvt_seg(const CvtSeg sg, FX_LAS unsigned* my, int gwave, int nwaves, int& rot) {
    const int lane = threadIdx.x & 63;
    const int ktn = sg.K / 64, per = ktn * sg.ntn, total = per * sg.nbatch;
    int first = (gwave - rot) % nwaves; if (first < 0) first += nwaves;
    for (int tile = first; tile < total; tile += nwaves) {
        const int b = tile / per, r = tile - b * per, nt = r / ktn, kt = r - nt * ktn;
        const float* src = sg.src + (size_t)b * sg.sstride + (size_t)(kt * 64) * sg.ld + nt * 64 + lane;
        const bool ok = nt * 64 + lane < sg.nsrc;
#pragma unroll 8
        for (int kk = 0; kk < 64; kk += 2) {
            const float v0 = ok ? src[(size_t)kk * sg.ld] : 0.f, v1 = ok ? src[(size_t)(kk + 1) * sg.ld] : 0.f;
            my[lane * 33 + (kk >> 1)] = cvt_pk_bf16(v0, v1);
        }
        asm volatile("s_waitcnt lgkmcnt(0)" ::: "memory");
        bf16_t* dst = sg.dst + (size_t)b * sg.dstride;
#pragma unroll
        for (int i = 0; i < 8; ++i) {
            const int nl = (lane >> 3) + 8 * i, c = lane & 7, n = nt * 64 + nl;
            u32x4 w; w.x = my[nl * 33 + 4 * c]; w.y = my[nl * 33 + 4 * c + 1]; w.z = my[nl * 33 + 4 * c + 2]; w.w = my[nl * 33 + 4 * c + 3];
            const int row = (n / sg.G) * sg.GS + (n % sg.G) + sg.off;
            *(u32x4*)(dst + (size_t)row * sg.K + kt * 64 + 8 * c) = w;
        }
        asm volatile("s_waitcnt lgkmcnt(0)" ::: "memory");
    }
    rot = (rot + total) % nwaves;
}

constexpr int BM = 256, BK = 64, HALF = 128, HTB = HALF * BK * 2, STAGE_BYTES = 8 * HTB, NXCD = 8, WGM = 8;
__host__ __device__ __forceinline__ int lds_byte(int r, int c) { const int st = (r >> 4) * 2 + (c >> 5), rr = r & 15, cc = c & 31, ob = rr * 64 + cc * 2; return st * 1024 + (ob ^ (((ob >> 9) & 1) << 5)); }
__host__ __device__ __forceinline__ void stage_rc(int b, int& R, int& C) { const int st = b / 1024, sb = b % 1024, swz = sb ^ (((sb >> 9) & 1) << 5); R = (st >> 1) * 16 + swz / 64; C = (st & 1) * 32 + (swz % 64) / 2; }
__host__ __device__ __forceinline__ int perm32(int rho) { const int n = rho >> 4, i = rho & 15; return 8 * (i >> 2) + 4 * n + (i & 3); }
struct Unit { int pm, pn, e; };
struct DenseSched {
    int nM, nN, nwg, G, c; int lda_b; const char* Bt; int K;
    __device__ void init(int M, int N, int G_, int c_, int lda_bytes, const void* Bt_, int K_) { nM = M / BM; nN = N / BM; nwg = nM * nN; G = G_; c = c_; lda_b = lda_bytes; Bt = (const char*)Bt_; K = K_; }
    __device__ __forceinline__ bool next(int i, Unit& u) const {
        const long L = (long)i * G + c; if (L >= nwg) return false;
        int wgid = (int)L; { const int q = nwg / NXCD, r = nwg % NXCD, xcd = wgid % NXCD, off = wgid / NXCD; wgid = (xcd < r ? xcd * (q + 1) : r * (q + 1) + (xcd - r) * q) + off; }
        const int nig = WGM * nN, gid = wgid / nig, fm = gid * WGM, gsz = (nM - fm) < WGM ? (nM - fm) : WGM;
        u.pm = fm + ((wgid % nig) % gsz); u.pn = (wgid % nig) / gsz; u.e = 0; return true;
    }
    __device__ __forceinline__ unsigned a_row_off(const Unit& u, int R) const { return (unsigned)(u.pm * BM + R) * (unsigned)lda_b; }
    __device__ __forceinline__ const char* b_ptr(const Unit& u) const { return Bt + (size_t)u.pn * BM * K * 2; }
};

template <class Epi, class Sched>
__device__ __forceinline__ void gemm_phase(FX_LAS unsigned char* lds, const char* Abase, const int K, const Sched& S, const Epi& E) {
    const int tid = threadIdx.x, wid = __builtin_amdgcn_readfirstlane(tid >> 6), lane = tid & 63, wr = wid >> 2, wc = wid & 3, fr = lane & 15, fq = lane >> 4;
    const int nt = K / BK;
    int Rr[2], Cc[2]; unsigned voffB[2];
#pragma unroll
    for (int i = 0; i < 2; ++i) { int R, C; stage_rc(tid * 16 + i * 8192, R, C); Rr[i] = R; Cc[i] = C; const int Rb = Epi::PERM ? ((R & ~31) + perm32(R & 31)) : R; voffB[i] = (unsigned)(Rb * K + C) * 2u; }
    const size_t hstepB = (size_t)HALF * K * 2;
    const unsigned ldsw = (unsigned)wid * 1024u;
    const int aoff = lds_byte(wr * 64 + fr, fq * 8), boff = lds_byte(wc * 32 + fr, fq * 8);
#define FX_SA(b, h) (((b) * 2 + (h)) * HTB)
#define FX_SB(b, h) ((4 + (b) * 2 + (h)) * HTB)
#define FX_STAGE_A(bufoff, o0, o1, kb) do { \
        __builtin_amdgcn_global_load_lds((const unsigned*)(Abase + (size_t)(o0) + (size_t)(kb)), (FX_LAS unsigned*)(lds + (bufoff) + ldsw), 16, 0, 0); \
        __builtin_amdgcn_global_load_lds((const unsigned*)(Abase + (size_t)(o1) + (size_t)(kb)), (FX_LAS unsigned*)(lds + (bufoff) + ldsw + 8192), 16, 0, 0); } while (0)
#define FX_STAGE_B(bufoff, gbase) do { _Pragma("unroll") for (int _i = 0; _i < 2; ++_i) \
        __builtin_amdgcn_global_load_lds((const unsigned*)((const char*)(gbase) + voffB[_i]), (FX_LAS unsigned*)(lds + (bufoff) + ldsw + _i * 8192), 16, 0, 0); } while (0)
#define FX_LDA(dst, b, h) do { _Pragma("unroll") for (int m = 0; m < 4; ++m) _Pragma("unroll") for (int k = 0; k < 2; ++k) dst[m][k] = *(const FX_LAS bf16x8*)(lds + FX_SA(b, h) + aoff + m * 2048 + k * 1024); } while (0)
#define FX_LDB(dst, b, h) do { _Pragma("unroll") for (int n = 0; n < 2; ++n) _Pragma("unroll") for (int k = 0; k < 2; ++k) dst[n][k] = *(const FX_LAS bf16x8*)(lds + FX_SB(b, h) + boff + n * 2048 + k * 1024); } while (0)
#define FX_MMA(ai, bj, At, Bt) do { __builtin_amdgcn_s_setprio(1); _Pragma("unroll") for (int m = 0; m < 4; ++m) _Pragma("unroll") for (int n = 0; n < 2; ++n) _Pragma("unroll") for (int k = 0; k < 2; ++k) \
        acc[ai][bj][m][n] = __builtin_amdgcn_mfma_f32_16x16x32_bf16(Bt[n][k], At[m][k], acc[ai][bj][m][n], 0, 0, 0); __builtin_amdgcn_s_setprio(0); } while (0)
#define FX_WAIT_V(n) asm volatile("s_waitcnt vmcnt(" #n ")" ::: "memory")
#define FX_WAIT_L(n) asm volatile("s_waitcnt lgkmcnt(" #n ")" ::: "memory")
#define FX_BAR __builtin_amdgcn_s_barrier()
#define FX_SCHED __builtin_amdgcn_sched_barrier(0)
    Unit cur, nxt; int ui = 0;
    if (!S.next(0, cur)) return;
    f32x4 acc[2][2][4][2];
#pragma unroll
    for (int a = 0; a < 2; ++a)
#pragma unroll
        for (int b = 0; b < 2; ++b)
#pragma unroll
            for (int m = 0; m < 4; ++m)
#pragma unroll
                for (int n = 0; n < 2; ++n) acc[a][b][m][n] = (f32x4){0.f, 0.f, 0.f, 0.f};
    bf16x8 At[4][2], B0[2][2], B1[2][2];
    unsigned c00, c01, c10, c11, n00, n01, n10, n11;
    c00 = S.a_row_off(cur, Rr[0]) + Cc[0] * 2; c01 = S.a_row_off(cur, Rr[1]) + Cc[1] * 2; c10 = S.a_row_off(cur, HALF + Rr[0]) + Cc[0] * 2; c11 = S.a_row_off(cur, HALF + Rr[1]) + Cc[1] * 2;
    const char* cB = S.b_ptr(cur);
    const unsigned kstep = BK * 2;
    FX_STAGE_B(FX_SB(0, 0), cB); FX_STAGE_A(FX_SA(0, 0), c00, c01, 0); FX_STAGE_B(FX_SB(0, 1), cB + hstepB); FX_STAGE_A(FX_SA(0, 1), c10, c11, 0);
    if (wr == 1) FX_BAR;
    FX_WAIT_V(4); FX_BAR;
    FX_STAGE_B(FX_SB(1, 0), cB + kstep); FX_STAGE_A(FX_SA(1, 0), c00, c01, kstep); FX_STAGE_B(FX_SB(1, 1), cB + hstepB + kstep);
    FX_WAIT_V(6); FX_BAR;
    for (;;) {
        const bool has_next = S.next(ui + 1, nxt);
        if (!has_next) nxt = cur;
        n00 = S.a_row_off(nxt, Rr[0]) + Cc[0] * 2; n01 = S.a_row_off(nxt, Rr[1]) + Cc[1] * 2; n10 = S.a_row_off(nxt, HALF + Rr[0]) + Cc[0] * 2; n11 = S.a_row_off(nxt, HALF + Rr[1]) + Cc[1] * 2;
        const char* nB = S.b_ptr(nxt);
        for (int t = 0; t < nt; t += 2) {
            const bool last = (t == nt - 2);
            const unsigned k1 = (unsigned)(t + 1) * kstep;
            const unsigned k2 = last ? 0u : (unsigned)(t + 2) * kstep, k3 = k2 + kstep;
            const unsigned a00 = last ? n00 : c00, a01 = last ? n01 : c01, a10 = last ? n10 : c10, a11 = last ? n11 : c11;
            const char* b2 = last ? nB : cB + k2; const char* b3 = b2 + kstep;
            FX_LDB(B0, 0, 0); FX_SCHED; FX_LDA(At, 0, 0); FX_STAGE_A(FX_SA(1, 1), c10, c11, k1);
            FX_WAIT_L(8); FX_BAR; FX_WAIT_L(0); FX_MMA(0, 0, At, B0); FX_BAR; FX_SCHED;
            FX_LDB(B1, 0, 1); FX_STAGE_B(FX_SB(0, 0), b2);
            FX_BAR; FX_WAIT_L(0); FX_MMA(0, 1, At, B1); FX_BAR;
            FX_LDA(At, 0, 1); FX_STAGE_A(FX_SA(0, 0), a00, a01, k2);
            FX_BAR; FX_WAIT_L(0); FX_MMA(1, 0, At, B0); FX_BAR; FX_SCHED;
            FX_STAGE_B(FX_SB(0, 1), b2 + hstepB);
            FX_WAIT_V(6); FX_BAR; FX_MMA(1, 1, At, B1); FX_BAR;
            FX_LDB(B0, 1, 0); FX_SCHED; FX_LDA(At, 1, 0); FX_STAGE_A(FX_SA(0, 1), a10, a11, k2);
            FX_WAIT_L(8); FX_BAR; FX_WAIT_L(0); FX_MMA(0, 0, At, B0); FX_BAR; FX_SCHED;
            FX_LDB(B1, 1, 1); FX_STAGE_B(FX_SB(1, 0), b3);
            FX_BAR; FX_WAIT_L(0); FX_MMA(0, 1, At, B1); FX_BAR;
            FX_LDA(At, 1, 1); FX_STAGE_A(FX_SA(1, 0), a00, a01, k3);
            FX_BAR; FX_WAIT_L(0); FX_MMA(1, 0, At, B0); FX_BAR; FX_SCHED;
            FX_STAGE_B(FX_SB(1, 1), b3 + hstepB);
            FX_WAIT_V(6); FX_BAR; FX_MMA(1, 1, At, B1); FX_BAR;
        }
        E(acc, cur, wr, wc, fr, fq);
        if (!has_next) break;
#pragma unroll
        for (int a = 0; a < 2; ++a)
#pragma unroll
            for (int b = 0; b < 2; ++b)
#pragma unroll
                for (int m = 0; m < 4; ++m)
#pragma unroll
                    for (int n = 0; n < 2; ++n) acc[a][b][m][n] = (f32x4){0.f, 0.f, 0.f, 0.f};
        cur = nxt; cB = nB; c00 = n00; c01 = n01; c10 = n10; c11 = n11; ++ui;
    }
    FX_WAIT_V(0);
    if (wr == 0) FX_BAR;
    FX_BAR;
}

struct EpiBf16 {
    static constexpr bool PERM = true;
    bf16_t* O; float* gates; int ldc; int pad;
    __device__ __forceinline__ void operator()(const f32x4 (&acc)[2][2][4][2], const Unit& u, int wr, int wc, int fr, int fq) const {
        const int row0 = u.pm * BM + wr * 64 + fr, col0 = u.pn * BM + wc * 32 + 8 * fq;
#pragma unroll
        for (int ai = 0; ai < 2; ++ai)
#pragma unroll
            for (int m = 0; m < 4; ++m) { const int row = row0 + ai * HALF + m * 16; bf16_t* rowp = O + (size_t)row * ldc + col0;
#pragma unroll
                for (int bj = 0; bj < 2; ++bj) { const f32x4 v0 = acc[ai][bj][m][0], v1 = acc[ai][bj][m][1];
                    u32x4 w; w.x = cvt_pk_bf16(v0[0], v0[1]); w.y = cvt_pk_bf16(v0[2], v0[3]); w.z = cvt_pk_bf16(v1[0], v1[1]); w.w = cvt_pk_bf16(v1[2], v1[3]);
                    *(u32x4*)(rowp + bj * HALF) = w; }
                if (gates && u.pn == 15 && wc == 2 && fq < 2) { float* g = gates + (size_t)row * 16 + 8 * fq; *(f32x4*)g = acc[ai][1][m][0]; *(f32x4*)(g + 4) = acc[ai][1][m][1]; } }
    }
};
}
namespace fx {
constexpr int RT = 16;
constexpr int H2S_LD = 2052;
constexpr int P7_LDS = RT * H2S_LD * 4 + 512;
constexpr int PTOT = 131072;
constexpr int NTILE_MAX = PTOT / 256;

__device__ __forceinline__ void coef_phase(const float* mod, const float* pre_mix_gain, const float* post_mix_gain, const float* pre_ffn_gain, const float* post_ffn_gain, float* coef, int gtid, int nthr) {
    for (int i = gtid; i < 2 * 4 * 2048; i += nthr) { const int d = i & 2047, b = (i >> 11) & 3, l = i >> 13;
        const float* m = mod + ((size_t)l * 4 + b) * 12288; float* c = coef + ((size_t)l * 4 + b) * 6 * 2048;
        c[0 * 2048 + d] = m[2 * 2048 + d] * post_mix_gain[l * 2048 + d];
        c[1 * 2048 + d] = pre_ffn_gain[l * 2048 + d] * (1.f + m[4 * 2048 + d]);
        c[2 * 2048 + d] = m[3 * 2048 + d];
        c[3 * 2048 + d] = m[5 * 2048 + d] * post_ffn_gain[l * 2048 + d];
        c[4 * 2048 + d] = pre_mix_gain[l * 2048 + d] * (1.f + m[1 * 2048 + d]);
        c[5 * 2048 + d] = m[0 * 2048 + d]; }
}

__device__ __forceinline__ void p7_phase(FX_LAS unsigned char* lds, const float* xin, const bf16_t* Y, const float* coef_l  , const float* router_w, const float* router_bias,
                                         float* XRES, bf16_t* HA, int* SELE, float* SELG, int* CNT, int* WGBASE, int wg, int nwg) {
    const int tid = threadIdx.x, wid = tid >> 6, lane = tid & 63;
    FX_LAS float* h2s = (FX_LAS float*)lds;
    FX_LAS int* hist = (FX_LAS int*)(lds + RT * H2S_LD * 4);
    if (tid < 64) hist[tid] = 0;
    __syncthreads();
    for (int unit = wg; unit < T / RT; unit += nwg) {
#pragma unroll 1
        for (int tt = 0; tt < 2; ++tt) {
            const int tok = 2 * wid + tt, t = unit * RT + tok, b = t / S;
            const float* cf = coef_l + (size_t)b * 6 * 2048;
            float xv[32]; float yv[32]; float ssy = 0.f;
#pragma unroll
            for (int i = 0; i < 4; ++i) { const int c = i * 512 + lane * 8;
                const u32x4 yw = *(const u32x4*)(Y + (size_t)t * 2048 + c);
                yv[i * 8 + 0] = bflo(yw.x); yv[i * 8 + 1] = bfhi(yw.x); yv[i * 8 + 2] = bflo(yw.y); yv[i * 8 + 3] = bfhi(yw.y); yv[i * 8 + 4] = bflo(yw.z); yv[i * 8 + 5] = bfhi(yw.z); yv[i * 8 + 6] = bflo(yw.w); yv[i * 8 + 7] = bfhi(yw.w);
                const f32x4 x0 = *(const f32x4*)(xin + (size_t)t * 2048 + c), x1 = *(const f32x4*)(xin + (size_t)t * 2048 + c + 4);
                xv[i * 8 + 0] = x0[0]; xv[i * 8 + 1] = x0[1]; xv[i * 8 + 2] = x0[2]; xv[i * 8 + 3] = x0[3]; xv[i * 8 + 4] = x1[0]; xv[i * 8 + 5] = x1[1]; xv[i * 8 + 6] = x1[2]; xv[i * 8 + 7] = x1[3];
#pragma unroll
                for (int j = 0; j < 8; ++j) ssy += yv[i * 8 + j] * yv[i * 8 + j]; }
            ssy = wave_sum(ssy);
            const float ry = rsqrtf(ssy * (1.f / 2048.f) + EPS); float ssx = 0.f;
#pragma unroll
            for (int i = 0; i < 4; ++i) { const int c = i * 512 + lane * 8;
                const f32x4 a0 = *(const f32x4*)(cf + c), a1 = *(const f32x4*)(cf + c + 4);
#pragma unroll
                for (int j = 0; j < 4; ++j) { xv[i * 8 + j] += a0[j] * (yv[i * 8 + j] * ry); xv[i * 8 + 4 + j] += a1[j] * (yv[i * 8 + 4 + j] * ry); }
#pragma unroll
                for (int j = 0; j < 8; ++j) ssx += xv[i * 8 + j] * xv[i * 8 + j];
                *(f32x4*)(XRES + (size_t)t * 2048 + c) = (f32x4){xv[i * 8 + 0], xv[i * 8 + 1], xv[i * 8 + 2], xv[i * 8 + 3]};
                *(f32x4*)(XRES + (size_t)t * 2048 + c + 4) = (f32x4){xv[i * 8 + 4], xv[i * 8 + 5], xv[i * 8 + 6], xv[i * 8 + 7]}; }
            ssx = wave_sum(ssx);
            const float rx = rsqrtf(ssx * (1.f / 2048.f) + EPS);
#pragma unroll
            for (int i = 0; i < 4; ++i) { const int c = i * 512 + lane * 8;
                const f32x4 b0 = *(const f32x4*)(cf + 2048 + c), b1 = *(const f32x4*)(cf + 2048 + c + 4), c0 = *(const f32x4*)(cf + 4096 + c), c1 = *(const f32x4*)(cf + 4096 + c + 4);
                float hv[8];
#pragma unroll
                for (int j = 0; j < 4; ++j) { hv[j] = xv[i * 8 + j] * rx * b0[j] + c0[j]; hv[4 + j] = xv[i * 8 + 4 + j] * rx * b1[j] + c1[j]; }
                u32x4 w; w.x = cvt_pk_bf16(hv[0], hv[1]); w.y = cvt_pk_bf16(hv[2], hv[3]); w.z = cvt_pk_bf16(hv[4], hv[5]); w.w = cvt_pk_bf16(hv[6], hv[7]);
                *(u32x4*)(HA + (size_t)t * 2048 + c) = w;
                *(FX_LAS f32x4*)(h2s + tok * H2S_LD + c) = (f32x4){hv[0], hv[1], hv[2], hv[3]};
                *(FX_LAS f32x4*)(h2s + tok * H2S_LD + c + 4) = (f32x4){hv[4], hv[5], hv[6], hv[7]}; }
        }
        __syncthreads();
        f32x4 acc[4];
#pragma unroll
        for (int j = 0; j < 4; ++j) acc[j] = (f32x4){0.f, 0.f, 0.f, 0.f};
        { const int i16 = lane & 15, g = lane >> 4;
#pragma unroll 4
          for (int ks = 0; ks < 64; ++ks) { const int k = 256 * wid + 4 * ks + g;
            const float a = h2s[i16 * H2S_LD + k];
            const f32x4 bw = *(const f32x4*)(router_w + (size_t)k * 64 + 4 * i16);
            acc[0] = __builtin_amdgcn_mfma_f32_16x16x4f32(a, bw[0], acc[0], 0, 0, 0);
            acc[1] = __builtin_amdgcn_mfma_f32_16x16x4f32(a, bw[1], acc[1], 0, 0, 0);
            acc[2] = __builtin_amdgcn_mfma_f32_16x16x4f32(a, bw[2], acc[2], 0, 0, 0);
            acc[3] = __builtin_amdgcn_mfma_f32_16x16x4f32(a, bw[3], acc[3], 0, 0, 0); } }
        __syncthreads();
        { FX_LAS float* part = h2s; const int i16 = lane & 15, g = lane >> 4;
#pragma unroll
          for (int j = 0; j < 4; ++j)
#pragma unroll
            for (int r = 0; r < 4; ++r) part[(wid * 16 + 4 * g + r) * 64 + 4 * i16 + j] = acc[j][r]; }
        __syncthreads();
#pragma unroll 1
        for (int tt = 0; tt < 2; ++tt) {
            const int tok = 2 * wid + tt, t = unit * RT + tok;
            float lg = 0.f;
#pragma unroll
            for (int w = 0; w < 8; ++w) lg += h2s[(w * 16 + tok) * 64 + lane];
            const float score = 1.f / (1.f + expf(-lg));
            float v = score + router_bias[lane];
            int my_e = 0; float my_s = 0.f, sum = 0.f;
#pragma unroll
            for (int k = 0; k < 6; ++k) {
                const float m = wave_max(v);
                const unsigned long long bal = __ballot(v == m);
                const int win = __ffsll((long long)bal) - 1;
                const float sw = __shfl(score, win);
                sum += sw; if (lane == k) { my_e = win; my_s = sw; }
                if (lane == win) v = -3.0e38f;
            }
            if (lane < 6) { SELE[(size_t)t * 6 + lane] = my_e; SELG[(size_t)t * 6 + lane] = my_s / sum * 2.5f; __hip_atomic_fetch_add(hist + my_e, 1, __ATOMIC_RELAXED, __HIP_MEMORY_SCOPE_WORKGROUP); }
        }
        __syncthreads();
    }
    if (tid < 64) { const int hv = hist[tid]; const int base = atomicAdd(CNT + tid, hv); WGBASE[wg * 64 + tid] = base; }
}

__device__ __forceinline__ void p8_phase(FX_LAS unsigned char* lds, const int* SELE, const float* SELG, const int* CNT, const int* WGBASE, int* ROWTOK, float* ROWG, int* SLOT, int wg, int nwg) {
    const int tid = threadIdx.x;
    FX_LAS int* pstart = (FX_LAS int*)lds; FX_LAS int* off = pstart + 80;
    if (tid == 0) { int a = 16384; for (int e = 0; e < 64; ++e) { pstart[e] = a; a += (CNT[e] + 255) & ~255; } pstart[64] = a; }
    __syncthreads();
    if (tid < 64) off[tid] = pstart[tid] + WGBASE[wg * 64 + tid];
    __syncthreads();
    for (int unit = wg; unit < T / RT; unit += nwg) {
        if (tid < RT * 6) { const int t = unit * RT + tid / 6, k = tid % 6; const int e = SELE[(size_t)t * 6 + k];
            const int pos = __hip_atomic_fetch_add(off + e, 1, __ATOMIC_RELAXED, __HIP_MEMORY_SCOPE_WORKGROUP);
            ROWTOK[pos] = t; ROWG[pos] = SELG[(size_t)t * 6 + k]; SLOT[(size_t)t * 6 + k] = pos; }
    }
    for (int e = wg; e < 64; e += nwg) { const int a = pstart[e] + CNT[e], b = pstart[e + 1]; for (int r = a + tid; r < b; r += 512) { ROWTOK[r] = 0; ROWG[r] = 0.f; } }
    for (int r = wg * 512 + tid; r < 16384; r += nwg * 512) { ROWTOK[r] = r; ROWG[r] = 1.f; }
}

struct MoeSched {
    FX_LAS const unsigned char* tile_e; int ntiles, npn, nunits, G, c;
    const int* rowtok; int lda_b; const char* Bt; size_t estride_b, pnstride_b;
    __device__ __forceinline__ bool next(int i, Unit& u) const {
        const long L = (long)i * G + c; if (L >= nunits) return false;
        int id = (int)L; { const int q = nunits / NXCD, r = nunits % NXCD, xcd = id % NXCD, off = id / NXCD; id = (xcd < r ? xcd * (q + 1) : r * (q + 1) + (xcd - r) * q) + off; }
        u.pm = id / npn; u.pn = id - u.pm * npn; u.e = tile_e[u.pm]; return true;
    }
    __device__ __forceinline__ unsigned a_row_off(const Unit& u, int R) const { const int row = u.pm * BM + R; return (unsigned)(rowtok ? rowtok[row] : row) * (unsigned)lda_b; }
    __device__ __forceinline__ const char* b_ptr(const Unit& u) const { return Bt + (size_t)u.e * estride_b + (size_t)u.pn * pnstride_b; }
};
__device__ __forceinline__ int moe_sched_build(FX_LAS unsigned char* tab, const int* CNT) {
    FX_LAS int* nt = (FX_LAS int*)(tab + 512);
    if (threadIdx.x == 0) { int tl = 64; for (int e = 0; e < 64; ++e) { const int n = (CNT[e] + 255) >> 8; for (int j = 0; j < n; ++j) tab[tl + j] = (unsigned char)e; tl += n; } nt[0] = tl; }
    if (threadIdx.x < 64) tab[threadIdx.x] = 64;
    __syncthreads();
    return nt[0];
}
struct EpiGateUp {
    static constexpr bool PERM = true;
    bf16_t* HID;
    __device__ __forceinline__ void operator()(const f32x4 (&acc)[2][2][4][2], const Unit& u, int wr, int wc, int fr, int fq) const {
        const int row0 = u.pm * BM + wr * 64 + fr, col0 = u.pn * 128 + wc * 32 + 8 * fq;
#pragma unroll
        for (int ai = 0; ai < 2; ++ai)
#pragma unroll
            for (int m = 0; m < 4; ++m) { const int row = row0 + ai * HALF + m * 16;
                float o[8];
#pragma unroll
                for (int n = 0; n < 2; ++n)
#pragma unroll
                    for (int j = 0; j < 4; ++j) { const float g = acc[ai][0][m][n][j], up = acc[ai][1][m][n][j]; o[n * 4 + j] = g / (1.f + __expf(-g)) * up; }
                u32x4 w; w.x = cvt_pk_bf16(o[0], o[1]); w.y = cvt_pk_bf16(o[2], o[3]); w.z = cvt_pk_bf16(o[4], o[5]); w.w = cvt_pk_bf16(o[6], o[7]);
                *(u32x4*)(HID + (size_t)row * 512 + col0) = w; }
    }
};
struct EpiDown {
    static constexpr bool PERM = true;
    bf16_t* YR; const float* ROWG;
    __device__ __forceinline__ void operator()(const f32x4 (&acc)[2][2][4][2], const Unit& u, int wr, int wc, int fr, int fq) const {
        const int row0 = u.pm * BM + wr * 64 + fr, col0 = u.pn * BM + wc * 32 + 8 * fq;
#pragma unroll
        for (int ai = 0; ai < 2; ++ai)
#pragma unroll
            for (int m = 0; m < 4; ++m) { const int row = row0 + ai * HALF + m * 16; const float g = ROWG[row]; bf16_t* rowp = YR + (size_t)row * 2048 + col0;
#pragma unroll
                for (int bj = 0; bj < 2; ++bj) { const f32x4 v0 = acc[ai][bj][m][0] * g, v1 = acc[ai][bj][m][1] * g;
                    u32x4 w; w.x = cvt_pk_bf16(v0[0], v0[1]); w.y = cvt_pk_bf16(v0[2], v0[3]); w.z = cvt_pk_bf16(v1[0], v1[1]); w.w = cvt_pk_bf16(v1[2], v1[3]);
                    *(u32x4*)(rowp + bj * HALF) = w; } }
    }
};
__device__ __forceinline__ void p9_phase(FX_LAS unsigned char* lds, const bf16_t* HA, const bf16_t* WGU, const int* CNT, const int* ROWTOK, bf16_t* HID, int wg, int nwg) {
    FX_LAS unsigned char* tab = lds + STAGE_BYTES;
    const int ntiles = moe_sched_build(tab, CNT);
    MoeSched Sc; Sc.tile_e = tab; Sc.ntiles = ntiles; Sc.npn = 4; Sc.nunits = ntiles * 4; Sc.G = nwg; Sc.c = wg; Sc.rowtok = ROWTOK; Sc.lda_b = 4096; Sc.Bt = (const char*)WGU; Sc.estride_b = (size_t)1024 * 2048 * 2; Sc.pnstride_b = (size_t)256 * 2048 * 2;
    EpiGateUp E; E.HID = HID;
    gemm_phase<EpiGateUp, MoeSched>(lds, (const char*)HA, 2048, Sc, E);
}
__device__ __forceinline__ void p10_phase(FX_LAS unsigned char* lds, const bf16_t* HID, const bf16_t* WDN, const int* CNT, const float* ROWG, bf16_t* YR, int wg, int nwg) {
    FX_LAS unsigned char* tab = lds + STAGE_BYTES;
    const int ntiles = moe_sched_build(tab, CNT);
    MoeSched Sc; Sc.tile_e = tab; Sc.ntiles = ntiles; Sc.npn = 8; Sc.nunits = ntiles * 8; Sc.G = nwg; Sc.c = wg; Sc.rowtok = nullptr; Sc.lda_b = 1024; Sc.Bt = (const char*)WDN; Sc.estride_b = (size_t)2048 * 512 * 2; Sc.pnstride_b = (size_t)256 * 512 * 2;
    EpiDown E; E.YR = YR; E.ROWG = ROWG;
    gemm_phase<EpiDown, MoeSched>(lds, (const char*)HID, 512, Sc, E);
}
__device__ __forceinline__ void p11_phase(const float* x1, const bf16_t* YR, const int* SLOT, const float* coef_l, const float* coef_next  , float* xout, bf16_t* HA, int wg, int nwg) {
    const int wid = threadIdx.x >> 6, lane = threadIdx.x & 63;
    for (int t = wg * 8 + wid; t < T; t += nwg * 8) {
        const int b = t / S; const float* cf = coef_l + (size_t)b * 6 * 2048;
        int rows[7]; rows[0] = t;
#pragma unroll
        for (int k = 0; k < 6; ++k) rows[k + 1] = SLOT[(size_t)t * 6 + k];
        float yv[32];
#pragma unroll
        for (int j = 0; j < 32; ++j) yv[j] = 0.f;
#pragma unroll
        for (int k = 0; k < 7; ++k)
#pragma unroll
            for (int i = 0; i < 4; ++i) { const u32x4 w = *(const u32x4*)(YR + (size_t)rows[k] * 2048 + i * 512 + lane * 8);
                yv[i * 8 + 0] += bflo(w.x); yv[i * 8 + 1] += bfhi(w.x); yv[i * 8 + 2] += bflo(w.y); yv[i * 8 + 3] += bfhi(w.y); yv[i * 8 + 4] += bflo(w.z); yv[i * 8 + 5] += bfhi(w.z); yv[i * 8 + 6] += bflo(w.w); yv[i * 8 + 7] += bfhi(w.w); }
        float ss = 0.f;
#pragma unroll
        for (int j = 0; j < 32; ++j) ss += yv[j] * yv[j];
        ss = wave_sum(ss); const float ry = rsqrtf(ss * (1.f / 2048.f) + EPS); float ssx = 0.f;
#pragma unroll
        for (int i = 0; i < 4; ++i) { const int c = i * 512 + lane * 8;
            const f32x4 d0 = *(const f32x4*)(cf + 3 * 2048 + c), d1 = *(const f32x4*)(cf + 3 * 2048 + c + 4);
            const f32x4 x0 = *(const f32x4*)(x1 + (size_t)t * 2048 + c), x1v = *(const f32x4*)(x1 + (size_t)t * 2048 + c + 4);
#pragma unroll
            for (int j = 0; j < 4; ++j) { yv[i * 8 + j] = x0[j] + d0[j] * (yv[i * 8 + j] * ry); yv[i * 8 + 4 + j] = x1v[j] + d1[j] * (yv[i * 8 + 4 + j] * ry); }
#pragma unroll
            for (int j = 0; j < 8; ++j) ssx += yv[i * 8 + j] * yv[i * 8 + j];
            *(f32x4*)(xout + (size_t)t * 2048 + c) = (f32x4){yv[i * 8 + 0], yv[i * 8 + 1], yv[i * 8 + 2], yv[i * 8 + 3]};
            *(f32x4*)(xout + (size_t)t * 2048 + c + 4) = (f32x4){yv[i * 8 + 4], yv[i * 8 + 5], yv[i * 8 + 6], yv[i * 8 + 7]}; }
        if (coef_next) { const float* cn = coef_next + (size_t)b * 6 * 2048; ssx = wave_sum(ssx); const float rx = rsqrtf(ssx * (1.f / 2048.f) + EPS);
#pragma unroll
            for (int i = 0; i < 4; ++i) { const int c = i * 512 + lane * 8;
                const f32x4 e0 = *(const f32x4*)(cn + 4 * 2048 + c), e1 = *(const f32x4*)(cn + 4 * 2048 + c + 4), f0 = *(const f32x4*)(cn + 5 * 2048 + c), f1 = *(const f32x4*)(cn + 5 * 2048 + c + 4);
                float hv[8];
#pragma unroll
                for (int j = 0; j < 4; ++j) { hv[j] = yv[i * 8 + j] * rx * e0[j] + f0[j]; hv[4 + j] = yv[i * 8 + 4 + j] * rx * e1[j] + f1[j]; }
                u32x4 w; w.x = cvt_pk_bf16(hv[0], hv[1]); w.y = cvt_pk_bf16(hv[2], hv[3]); w.z = cvt_pk_bf16(hv[4], hv[5]); w.w = cvt_pk_bf16(hv[6], hv[7]);
                *(u32x4*)(HA + (size_t)t * 2048 + c) = w; } }
    }
}
}
namespace fx {
#ifndef FX_SD_A
#define FX_SD_A 2
#endif
#ifndef FX_SD_B
#define FX_SD_B 1
#endif
#define FX_SBAR() __builtin_amdgcn_sched_barrier(0)
__device__ __forceinline__ int crow(int r, int hi) { return (r & 3) + 8 * (r >> 2) + 4 * hi; }
__device__ __forceinline__ int v_st(int k, int c) { const int kk = (k & ~0xC) | ((k & 4) << 1) | ((k & 8) >> 1); return ((kk >> 3) * 4 + (c >> 5)) * 512 + ((kk & 7) * 32 + (c & 31)) * 2; }
__device__ __forceinline__ int v_rd_base(int lane) { return ((lane & 3) << 3) | (((lane >> 2) & 3) << 6) | (((lane >> 4) & 1) << 5) | (((lane >> 5) & 1) << 8); }
constexpr int v_rd_off(int d0, int ks, int half) { return d0 * 512 + ks * 4096 + half * 2048; }
template <int OFF> __device__ __forceinline__ s16x4 tr_read(int vb) { s16x4 r; asm volatile("ds_read_b64_tr_b16 %0, %1 offset:%2" : "=&v"(r) : "v"(vb), "i"(OFF) : "memory"); return r; }
#define FX_PK(L, H) (bf16x8){L[0], L[1], L[2], L[3], H[0], H[1], H[2], H[3]}
template <int D0> __device__ __forceinline__ void pv_one(f32x16& od, int vb, bf16x8 pa0, bf16x8 pa1, bf16x8 pa2, bf16x8 pa3) {
    const s16x4 l0 = tr_read<v_rd_off(D0, 0, 0)>(vb), h0 = tr_read<v_rd_off(D0, 0, 1)>(vb), l1 = tr_read<v_rd_off(D0, 1, 0)>(vb), h1 = tr_read<v_rd_off(D0, 1, 1)>(vb);
    const s16x4 l2 = tr_read<v_rd_off(D0, 2, 0)>(vb), h2 = tr_read<v_rd_off(D0, 2, 1)>(vb), l3 = tr_read<v_rd_off(D0, 3, 0)>(vb), h3 = tr_read<v_rd_off(D0, 3, 1)>(vb);
    asm volatile("s_waitcnt lgkmcnt(0)" ::: "memory"); FX_SBAR();
    od = __builtin_amdgcn_mfma_f32_32x32x16_bf16(pa0, FX_PK(l0, h0), od, 0, 0, 0);
    od = __builtin_amdgcn_mfma_f32_32x32x16_bf16(pa1, FX_PK(l1, h1), od, 0, 0, 0);
    od = __builtin_amdgcn_mfma_f32_32x32x16_bf16(pa2, FX_PK(l2, h2), od, 0, 0, 0);
    od = __builtin_amdgcn_mfma_f32_32x32x16_bf16(pa3, FX_PK(l3, h3), od, 0, 0, 0);
}
__device__ __forceinline__ void pv_d0(f32x16* o, int vb, bf16x8 pa0, bf16x8 pa1, bf16x8 pa2, bf16x8 pa3) {
    pv_one<0>(o[0], vb, pa0, pa1, pa2, pa3); pv_one<1>(o[1], vb, pa0, pa1, pa2, pa3); pv_one<2>(o[2], vb, pa0, pa1, pa2, pa3); pv_one<3>(o[3], vb, pa0, pa1, pa2, pa3);
}
#define FX_PK4(P, BASE, OUT) do { unsigned a0 = cvt_pk_bf16(P[BASE + 0], P[BASE + 1]), a1 = cvt_pk_bf16(P[BASE + 2], P[BASE + 3]);   \
    unsigned b0 = cvt_pk_bf16(P[BASE + 4], P[BASE + 5]), b1 = cvt_pk_bf16(P[BASE + 6], P[BASE + 7]);                              \
    auto r0 = __builtin_amdgcn_permlane32_swap(a0, b0, false, false); auto r1 = __builtin_amdgcn_permlane32_swap(a1, b1, false, false); \
    u32x4 w = {r0[0], r1[0], r0[1], r1[1]}; OUT = *reinterpret_cast<bf16x8*>(&w); } while (0)

template <int DQK> struct AttnC {
    static constexpr int NQ = DQK / 16, KROW = DQK * 2, SHM_V = 64 * 128 * 2, SHM_K = 64 * DQK * 2, NQR = 8  , QX = (NQ - NQR) * 8 * 64 * 16, SHM = 2 * SHM_V + 2 * SHM_K + 8 * 64 * 4 + QX;
    static constexpr float SCALE = DQK == 128 ? 0.088388347648318440f : 0.072168783648703220f;
    static constexpr float THR = 8.f;
};
#define FX_KSWZ(row, colB) ((row) * C::KROW + ((colB) ^ (((row) & 7) << 4)))

template <int DQK> __device__ __forceinline__ void partialSM(f32x16& p0, f32x16& p1, float& m_reg, float& mn, float& alpha) {
    using C = AttnC<DQK>;
    constexpr float Cc = C::SCALE * 1.4426950408889634f;
    float pmax = p0[0];
#pragma unroll
    for (int r = 1; r < 16; ++r) pmax = fmaxf(pmax, p0[r]);
#pragma unroll
    for (int r = 0; r < 16; ++r) pmax = fmaxf(pmax, p1[r]);
    { auto rr = __builtin_amdgcn_permlane32_swap(__float_as_uint(pmax), __float_as_uint(pmax), false, false); pmax = fmaxf(__uint_as_float(rr[0]), __uint_as_float(rr[1])); }
    if (__builtin_expect(__all(pmax - m_reg <= C::THR / C::SCALE), 1)) { mn = m_reg; alpha = 1.f; }
    else { mn = fmaxf(m_reg, pmax); alpha = __builtin_amdgcn_exp2f((m_reg - mn) * Cc); m_reg = mn; }
    const float mnC = -mn * Cc;
#pragma unroll
    for (int r = 0; r < 16; ++r) p0[r] = fmaf(p0[r], Cc, mnC);
#pragma unroll
    for (int r = 0; r < 16; ++r) p1[r] = fmaf(p1[r], Cc, mnC);
#pragma unroll
    for (int r = 0; r < 16; ++r) p0[r] = __builtin_amdgcn_exp2f(p0[r]);
}
__device__ __forceinline__ void finishSM(f32x16& p0, f32x16& p1, float alpha, float& l_reg, bf16x8& pa0, bf16x8& pa1, bf16x8& pa2, bf16x8& pa3) {
#pragma unroll
    for (int r = 0; r < 16; ++r) p1[r] = __builtin_amdgcn_exp2f(p1[r]);
    float ps = 0;
#pragma unroll
    for (int r = 0; r < 16; ++r) ps += p0[r];
#pragma unroll
    for (int r = 0; r < 16; ++r) ps += p1[r];
    { auto rr = __builtin_amdgcn_permlane32_swap(__float_as_uint(ps), __float_as_uint(ps), false, false); ps = __uint_as_float(rr[0]) + __uint_as_float(rr[1]); }
    l_reg = l_reg * alpha + ps;
    FX_PK4(p0, 0, pa0); FX_PK4(p0, 8, pa1); FX_PK4(p1, 0, pa2); FX_PK4(p1, 8, pa3);
}
template <int DQK> __device__ __forceinline__ void qkt(f32x16& p0, f32x16& p1, const char* Ks, const bf16x8* qr, const char* qx  , int r32, int hi) {
    using C = AttnC<DQK>;
    p0 = f32x16{}; p1 = f32x16{};
#pragma unroll
    for (int d0 = 0; d0 < C::NQ; ++d0) { const int cb = (d0 * 16 + hi * 8) * 2;
        const bf16x8 qf = d0 < C::NQR ? qr[d0 < C::NQR ? d0 : 0] : *reinterpret_cast<const bf16x8*>(qx + (d0 - C::NQR) * 1024);
        const bf16x8 b0 = *reinterpret_cast<const bf16x8*>(Ks + FX_KSWZ(r32, cb));
        const bf16x8 b1 = *reinterpret_cast<const bf16x8*>(Ks + FX_KSWZ(32 + r32, cb));
        p0 = __builtin_amdgcn_mfma_f32_32x32x16_bf16(b0, qf, p0, 0, 0, 0);
        p1 = __builtin_amdgcn_mfma_f32_32x32x16_bf16(b1, qf, p1, 0, 0, 0); }
}

template <int DQK, int SD, int LDQ, int LDK1, int LDK2, int LDV>
__device__ __forceinline__ void attn_unit(const bf16_t* __restrict__ Qb, const bf16_t* __restrict__ K1, const bf16_t* __restrict__ K2, const bf16_t* __restrict__ Vh,
                                          bf16_t* __restrict__ Ob, const float* __restrict__ gain, int seq, char* lds) {
    using C = AttnC<DQK>;
    int tid_ = threadIdx.x; asm volatile("" : "+v"(tid_));
    const int tid = tid_, wid = tid >> 6, lane = tid & 63, r32 = lane & 31, hi = lane >> 5;
    char* V_lds = lds; char* K_lds = lds + 2 * C::SHM_V;
    float* ws = (float*)(lds + 2 * C::SHM_V + 2 * C::SHM_K) + wid * 64; float* li_l = ws; float* al_l = ws + 32;
    float m_reg = -1e30f, l_reg = 0; f32x16 o[4] = {}; bf16x8 qr[C::NQR];
    char* qx = lds + 2 * C::SHM_V + 2 * C::SHM_K + 8 * 64 * 4 + wid * ((C::NQ - C::NQR) * 1024) + lane * 16;
    const bf16_t* Qw = Qb + (long)(wid * 32 + r32) * LDQ + hi * 8;
#pragma unroll
    for (int d0 = 0; d0 < C::NQR; ++d0) qr[d0] = *reinterpret_cast<const bf16x8*>(Qw + d0 * 16);
#pragma unroll
    for (int d0 = C::NQR; d0 < C::NQ; ++d0) *reinterpret_cast<bf16x8*>(qx + (d0 - C::NQR) * 1024) = *reinterpret_cast<const bf16x8*>(Qw + d0 * 16);
    const int sr = tid >> 4, sc = (tid & 15) * 8, vst0 = v_st(sr, sc), vst1 = v_st(32 + sr, sc);
    const int vb0 = (int)(uintptr_t)V_lds + v_rd_base(lane);
    const int xr = tid >> 3, xc = (tid & 7) * 8;
    struct { bf16x8 vs0, vs1, ks0, ks1, kx; } sr_[SD];
#define FX_SLOAD(i, k0) do { sr_[i].vs0 = *reinterpret_cast<const bf16x8*>(&Vh[(long)((k0) + sr) * LDV + sc]); sr_[i].vs1 = *reinterpret_cast<const bf16x8*>(&Vh[(long)((k0) + 32 + sr) * LDV + sc]); \
    sr_[i].ks0 = *reinterpret_cast<const bf16x8*>(&K1[(long)((k0) + sr) * LDK1 + sc]); sr_[i].ks1 = *reinterpret_cast<const bf16x8*>(&K1[(long)((k0) + 32 + sr) * LDK1 + sc]); \
    if (DQK == 192) sr_[i].kx = *reinterpret_cast<const bf16x8*>(&K2[(long)((k0) + xr) * LDK2 + xc]); } while (0)
#define FX_SWRITE(b, i) do { *(bf16x8*)(V_lds + (b) * C::SHM_V + vst0) = sr_[i].vs0; *(bf16x8*)(V_lds + (b) * C::SHM_V + vst1) = sr_[i].vs1; const int kc = sc * 2; \
    *(bf16x8*)(K_lds + (b) * C::SHM_K + FX_KSWZ(sr, kc)) = sr_[i].ks0; *(bf16x8*)(K_lds + (b) * C::SHM_K + FX_KSWZ(32 + sr, kc)) = sr_[i].ks1; \
    if (DQK == 192) *(bf16x8*)(K_lds + (b) * C::SHM_K + FX_KSWZ(xr, 256 + xc * 2)) = sr_[i].kx; } while (0)
#define FX_SWAIT() do { if (SD == 1) asm volatile("s_waitcnt vmcnt(0)" ::: "memory"); else if (DQK == 192) asm volatile("s_waitcnt vmcnt(5)" ::: "memory"); else asm volatile("s_waitcnt vmcnt(4)" ::: "memory"); } while (0)
#define FX_RESC(a) do { if (__any((a) < 1.f)) { if (hi == 0) al_l[r32] = (a); asm volatile("s_waitcnt lgkmcnt(0)" ::: "memory"); \
    _Pragma("unroll") for (int d = 0; d < 4; ++d) _Pragma("unroll") for (int r = 0; r < 16; ++r) o[d][r] *= al_l[crow(r, hi)]; } } while (0)
    f32x16 pA0, pA1, pB0, pB1; float mnA, mnB, alA, alB; bf16x8 pa0, pa1, pa2, pa3; const int NT = seq / 64;
    constexpr int SE = 0, SO = SD - 1;
    FX_SLOAD(SE, 0); asm volatile("s_waitcnt vmcnt(0)" ::: "memory"); FX_SWRITE(0, SE); __syncthreads();
    qkt<DQK>(pA0, pA1, K_lds, qr, qx, r32, hi); partialSM<DQK>(pA0, pA1, m_reg, mnA, alA);
    FX_SLOAD(SO, 64); if (SD == 2) { if (2 < NT) FX_SLOAD(SE, 128); }
    FX_SWAIT(); FX_SWRITE(1, SO); __syncthreads();
    for (int j = 1; j + 1 < NT; j += 2) {
        FX_SBAR(); qkt<DQK>(pB0, pB1, K_lds + C::SHM_K, qr, qx, r32, hi);
        finishSM(pA0, pA1, alA, l_reg, pa0, pa1, pa2, pa3); FX_SBAR();
        FX_SLOAD(SO, (j + SD) * 64); FX_SBAR();
        pv_d0(o, vb0, pa0, pa1, pa2, pa3); partialSM<DQK>(pB0, pB1, m_reg, mnB, alB);
        __syncthreads(); FX_SWAIT(); FX_SWRITE(0, SE);
        FX_RESC(alB); __syncthreads();
        FX_SBAR(); qkt<DQK>(pA0, pA1, K_lds, qr, qx, r32, hi);
        finishSM(pB0, pB1, alB, l_reg, pa0, pa1, pa2, pa3); FX_SBAR();
        if (SD == 1 || j + 3 < NT) FX_SLOAD(SE, (j + 1 + SD) * 64); FX_SBAR();
        pv_d0(o, vb0 + C::SHM_V, pa0, pa1, pa2, pa3); partialSM<DQK>(pA0, pA1, m_reg, mnA, alA);
        __syncthreads(); FX_SWAIT(); FX_SWRITE(1, SO);
        FX_RESC(alA); __syncthreads();
    }
    FX_SBAR(); qkt<DQK>(pB0, pB1, K_lds + C::SHM_K, qr, qx, r32, hi);
    finishSM(pA0, pA1, alA, l_reg, pa0, pa1, pa2, pa3); FX_SBAR();
    pv_d0(o, vb0, pa0, pa1, pa2, pa3); partialSM<DQK>(pB0, pB1, m_reg, mnB, alB);
    __syncthreads(); FX_RESC(alB);
    finishSM(pB0, pB1, alB, l_reg, pa0, pa1, pa2, pa3); FX_SBAR();
    pv_d0(o, vb0 + C::SHM_V, pa0, pa1, pa2, pa3);
    if (hi == 0) li_l[r32] = l_reg; asm volatile("s_waitcnt lgkmcnt(0)" ::: "memory");
    int r32e = r32; asm volatile("" : "+v"(r32e));
    float g4[4];
#pragma unroll
    for (int d0 = 0; d0 < 4; ++d0) g4[d0] = gain[d0 * 32 + r32e];
    bf16_t* Ow = Ob + (long)(wid * 32) * 2048;
#pragma unroll
    for (int r = 0; r < 16; ++r) { const float rl = __builtin_amdgcn_rcpf(li_l[crow(r, hi)]);
        float ss = 0.f;
#pragma unroll
        for (int d0 = 0; d0 < 4; ++d0) { o[d0][r] *= rl; ss += o[d0][r] * o[d0][r]; }
        ss += __shfl_xor(ss, 1); ss += __shfl_xor(ss, 2); ss += __shfl_xor(ss, 4); ss += __shfl_xor(ss, 8); ss += __shfl_xor(ss, 16);
        const float rn = rsqrtf(ss * (1.f / 128.f) + EPS); const int orow = crow(r, hi);
#pragma unroll
        for (int d0 = 0; d0 < 4; ++d0) Ow[(long)orow * 2048 + d0 * 32 + r32e] = f2bf(o[d0][r] * rn * g4[d0]); }
    __syncthreads();
#undef FX_SLOAD
#undef FX_SWRITE
#undef FX_SWAIT
#undef FX_RESC
}

__device__ __forceinline__ void attn_gqa_unit(int u, const bf16_t* QA, const bf16_t* KA, const bf16_t* PROJ, bf16_t* YM, const float* hog, char* lds) {
    const int qb = u & 15, hh = (u >> 4) % 6, b = u / 96, kvh = hh / 3;
    const size_t t0 = (size_t)b * S;
    attn_unit<128, FX_SD_A, 768, 256, 0, PW>(QA + (t0 + qb * 256) * 768 + hh * 128, KA + t0 * 256 + kvh * 128, nullptr, PROJ + t0 * PW + O_AV + kvh * 128,
                                    YM + (t0 + qb * 256) * 2048 + hh * 128, hog + hh * 128, S, lds);
}
__device__ __forceinline__ void attn_mla_unit(int u, const bf16_t* QB, const bf16_t* KVB, const bf16_t* KR, bf16_t* YM, const float* hog, char* lds) {
    const int qb = u & 15, hh = (u >> 4) % 6, b = u / 96;
    const size_t t0 = (size_t)b * S;
    attn_unit<192, FX_SD_B, 1280, 1536, 64, 1536>(QB + (t0 + qb * 256) * 1280 + hh * 192, KVB + t0 * 1536 + hh * 256, KR + t0 * 64, KVB + t0 * 1536 + hh * 256 + 128,
                                         YM + (t0 + qb * 256) * 2048 + 768 + hh * 128, hog + 768 + hh * 128, S, lds);
}
}
namespace fx {
constexpr int P3_LDS = 4096 + 2048 + 65536 + 32768;
constexpr float KSCALE = 0.08838834764831845f;
__device__ __forceinline__ float logsigmoid_f(float f) { return fminf(f, 0.f) - log1pf(__expf(-fabsf(f))); }
__device__ __forceinline__ float wave_scan_incl(float v, int lane) {
#pragma unroll
    for (int o = 1; o < 64; o <<= 1) { const float t = __shfl_up(v, o); if (lane >= o) v += t; }
    return v;
}
__device__ __forceinline__ float wave_scanmax_incl(float v, int lane) {
#pragma unroll
    for (int o = 1; o < 64; o <<= 1) { const float t = __shfl_up(v, o); if (lane >= o) v = fmaxf(v, t); }
    return v;
}
__device__ __forceinline__ float wave_rscanmax_incl(float v, int lane) {
#pragma unroll
    for (int o = 1; o < 64; o <<= 1) { const float t = __shfl_down(v, o); if (lane + o < 64) v = fmaxf(v, t); }
    return v;
}

struct P3Args {
    const bf16_t* PROJ; const float* GATES; const float* gate_b; const float* conv_w; const float* conv_b;
    const float* aq_gain; const float* ak_gain; const float* cq_gain; const float* ckv_gain;
    const float* cosA; const float* sinA; const float* cosB; const float* sinB;
    bf16_t* QA; bf16_t* KA; bf16_t* CQN; bf16_t* CKVN; bf16_t* KR; bf16_t* QC; bf16_t* KC; bf16_t* KCT; float* NLOC; float* GSC;
};
__device__ __forceinline__ void p3_phase(FX_LAS unsigned char* lds_, const P3Args& a, int wg, int nwg) {
    char* lds = (char*)lds_;
    float* gat = (float*)lds; float* wts = (float*)(lds + 4096); char* ktile = lds + 6144; char* wv = lds + 6144 + 65536;
#ifdef FX_ZERO_LDS
    for (int i = threadIdx.x; i < P3_LDS / 4; i += 512) ((unsigned*)lds)[i] = 0u;
    __syncthreads();
#endif
    for (int unit = wg; unit < T / 64; unit += nwg) {
        int tid_ = threadIdx.x; asm volatile("" : "+v"(tid_));
        const int tid = tid_, wid = tid >> 6, lane = tid & 63;
        const int b = unit >> 6, co = unit & 63; const size_t t0 = (size_t)unit * 64;
        for (int i = tid; i < 1024; i += 512) gat[i] = a.GATES[t0 * 16 + i] + a.gate_b[i & 15];
        __syncthreads();
        { const int dir = wid >> 2, h = wid & 3;
          const float logi = gat[lane * 16 + (dir * 2) * 4 + h], logf = logsigmoid_f(gat[lane * 16 + (dir * 2 + 1) * 4 + h]);
          const float pre = wave_scan_incl(logf, lane), g = __shfl(pre, 63);
          const float bb = dir ? (g - pre + logf) : pre;
          const float av = g - bb + logi, mloc = wave_max(av);
          wts[wid * 64 + lane] = __expf(av - mloc);
          if (lane == 0) { const int chain = (b * 4 + h) * 2 + dir, ci = dir ? 63 - co : co; a.GSC[(chain * 64 + ci) * 2] = g; a.GSC[(chain * 64 + ci) * 2 + 1] = mloc; } }
        __syncthreads();
        { const int c0 = 2 * tid; const bool isk = c0 >= 512; const int hk = (c0 - 512) >> 7, dk = (c0 - 512) & 127;
          float w0[5], w1[5];
#pragma unroll
          for (int j = 0; j < 5; ++j) { w0[j] = a.conv_w[j * 1024 + c0]; w1[j] = a.conv_w[j * 1024 + c0 + 1]; }
          const float cb0 = a.conv_b[c0], cb1 = a.conv_b[c0 + 1];
          float x0[5], x1[5];
          const bf16_t* src = a.PROJ + t0 * PW + O_CQ + c0;
#pragma unroll
          for (int j = 0; j < 4; ++j) { const int sa = co * 64 + j - 2; unsigned w = 0u; if (sa >= 0 && sa < S) w = *(const unsigned*)(src + (long)(j - 2) * PW); x0[j + 1] = bflo(w); x1[j + 1] = bfhi(w); }
          float nf0 = 0.f, nf1 = 0.f, nb0 = 0.f, nb1 = 0.f;
#pragma unroll 4
          for (int s = 0; s < 64; ++s) {
#pragma unroll
              for (int j = 0; j < 4; ++j) { x0[j] = x0[j + 1]; x1[j] = x1[j + 1]; }
              { const int sa = co * 64 + s + 2; unsigned w = 0u; if (sa < S) w = *(const unsigned*)(src + (long)(s + 2) * PW); x0[4] = bflo(w); x1[4] = bfhi(w); }
              float y0 = cb0, y1 = cb1;
#pragma unroll
              for (int j = 0; j < 5; ++j) { y0 += w0[j] * x0[j]; y1 += w1[j] * x1[j]; }
              y0 = silu_f(y0); y1 = silu_f(y1);
              if (!isk) { *(unsigned*)(a.QC + (t0 + s) * 512 + c0) = cvt_pk_bf16(y0, y1); }
              else { y0 *= KSCALE; y1 *= KSCALE; const unsigned pk = cvt_pk_bf16(y0, y1);
                  *(unsigned*)(a.KC + (t0 + s) * 512 + (c0 - 512)) = pk;
                  *(unsigned*)(ktile + hk * 16384 + v_st(s, dk & ~7) + (dk & 7) * 2) = pk;
                  const float k0 = bflo(pk), k1 = bfhi(pk); const float wf = wts[hk * 64 + s], wb = wts[(4 + hk) * 64 + s];
                  nf0 += wf * k0; nf1 += wf * k1; nb0 += wb * k0; nb1 += wb * k1; }
          }
          if (isk) { const int chf = (b * 4 + hk) * 2, chb = chf + 1;
              *(f32x2*)(a.NLOC + ((size_t)chf * 64 + co) * 128 + dk) = (f32x2){nf0, nf1};
              *(f32x2*)(a.NLOC + ((size_t)chb * 64 + (63 - co)) * 128 + dk) = (f32x2){nb0, nb1}; } }
        __syncthreads();
#pragma unroll 1
        for (int h = 0; h < 4; ++h) {
            { const int sr = tid >> 4, sc = (tid & 15) * 8;
#pragma unroll
              for (int rr = 0; rr < 2; ++rr) { const int s = sr + 32 * rr;
                const u32x4 vw = *(const u32x4*)(a.PROJ + (t0 + s) * PW + O_CV + h * 128 + sc);
                const float wf = wts[h * 64 + s], wb = wts[(4 + h) * 64 + s];
                float v[8] = {bflo(vw.x), bfhi(vw.x), bflo(vw.y), bfhi(vw.y), bflo(vw.z), bfhi(vw.z), bflo(vw.w), bfhi(vw.w)};
                u32x4 of, ob;
                of.x = cvt_pk_bf16(v[0] * wf, v[1] * wf); of.y = cvt_pk_bf16(v[2] * wf, v[3] * wf); of.z = cvt_pk_bf16(v[4] * wf, v[5] * wf); of.w = cvt_pk_bf16(v[6] * wf, v[7] * wf);
                ob.x = cvt_pk_bf16(v[0] * wb, v[1] * wb); ob.y = cvt_pk_bf16(v[2] * wb, v[3] * wb); ob.z = cvt_pk_bf16(v[4] * wb, v[5] * wb); ob.w = cvt_pk_bf16(v[6] * wb, v[7] * wb);
                *(u32x4*)(wv + v_st(s, sc)) = of; *(u32x4*)(wv + 16384 + v_st(s, sc)) = ob; } }
            __syncthreads();
            { const int dir = wid >> 2, mb = wid & 3, r32 = lane & 31, hi = lane >> 5;
              const int va = (int)(uintptr_t)(wv + dir * 16384) + v_rd_base(lane) + mb * 512;
              const int kb = (int)(uintptr_t)(ktile + h * 16384) + v_rd_base(lane);
              f32x16 acc[4] = {};
#define FX_KC_STEP(KS) do { \
              const s16x4 al = tr_read<v_rd_off(0, KS, 0)>(va), ah = tr_read<v_rd_off(0, KS, 1)>(va); \
              const s16x4 b0l = tr_read<v_rd_off(0, KS, 0)>(kb), b0h = tr_read<v_rd_off(0, KS, 1)>(kb), b1l = tr_read<v_rd_off(1, KS, 0)>(kb), b1h = tr_read<v_rd_off(1, KS, 1)>(kb); \
              const s16x4 b2l = tr_read<v_rd_off(2, KS, 0)>(kb), b2h = tr_read<v_rd_off(2, KS, 1)>(kb), b3l = tr_read<v_rd_off(3, KS, 0)>(kb), b3h = tr_read<v_rd_off(3, KS, 1)>(kb); \
              asm volatile("s_waitcnt lgkmcnt(0)" ::: "memory"); FX_SBAR(); \
              const bf16x8 af = FX_PK(al, ah); \
              acc[0] = __builtin_amdgcn_mfma_f32_32x32x16_bf16(af, FX_PK(b0l, b0h), acc[0], 0, 0, 0); acc[1] = __builtin_amdgcn_mfma_f32_32x32x16_bf16(af, FX_PK(b1l, b1h), acc[1], 0, 0, 0); \
              acc[2] = __builtin_amdgcn_mfma_f32_32x32x16_bf16(af, FX_PK(b2l, b2h), acc[2], 0, 0, 0); acc[3] = __builtin_amdgcn_mfma_f32_32x32x16_bf16(af, FX_PK(b3l, b3h), acc[3], 0, 0, 0); } while (0)
              FX_KC_STEP(0); FX_KC_STEP(1); FX_KC_STEP(2); FX_KC_STEP(3);
#undef FX_KC_STEP
              const int chain = (b * 4 + h) * 2 + dir, ci = dir ? 63 - co : co;
              bf16_t* dst = a.KCT + ((size_t)chain * 64 + ci) * 16384 + (size_t)(mb * 32) * 128 + r32;
#pragma unroll
              for (int r = 0; r < 16; ++r) { const int v = crow(r, hi);
#pragma unroll
                  for (int nb = 0; nb < 4; ++nb) dst[v * 128 + nb * 32] = f2bf(acc[nb][r]); } }
            __syncthreads();
        }
        { const int f = lane & 31, hf = lane >> 5;
#pragma unroll 2
          for (int it = wid; it < 512; it += 8) { const int s = it >> 3, hd = it & 7; const size_t t = t0 + s;
            const bf16_t* src = a.PROJ + t * PW + hd * 128 + hf * 64;
            float x1 = bf2f(src[f]), x2 = bf2f(src[32 + f]);
            const float ss = wave_sum(x1 * x1 + x2 * x2), r = rsqrtf(ss * (1.f / 128.f) + EPS);
            const float* g = hd < 6 ? a.aq_gain : a.ak_gain;
            x1 *= r * g[hf * 64 + f]; x2 *= r * g[hf * 64 + 32 + f];
            const int pos = hf ? s : co; const float cs = a.cosA[pos * 32 + f], sn = a.sinA[pos * 32 + f];
            bf16_t* dst = hd < 6 ? a.QA + t * 768 + hd * 128 + hf * 64 : a.KA + t * 256 + (hd - 6) * 128 + hf * 64;
            dst[f] = f2bf(x1 * cs - x2 * sn); dst[32 + f] = f2bf(x2 * cs + x1 * sn); } }
        for (int s = wid; s < 64; s += 8) { const size_t t = t0 + s; const bf16_t* p = a.PROJ + t * PW;
            float q[6]; float ss = 0.f;
#pragma unroll
            for (int i = 0; i < 3; ++i) { const unsigned w = *(const unsigned*)(p + O_BCQ + i * 128 + lane * 2); q[2 * i] = bflo(w); q[2 * i + 1] = bfhi(w); ss += q[2 * i] * q[2 * i] + q[2 * i + 1] * q[2 * i + 1]; }
            ss = wave_sum(ss); float r = rsqrtf(ss * (1.f / 384.f) + EPS);
#pragma unroll
            for (int i = 0; i < 3; ++i) { const int c = i * 128 + lane * 2; *(unsigned*)(a.CQN + t * 384 + c) = cvt_pk_bf16(q[2 * i] * r * a.cq_gain[c], q[2 * i + 1] * r * a.cq_gain[c + 1]); }
            float kv[4]; ss = 0.f;
#pragma unroll
            for (int i = 0; i < 2; ++i) { const unsigned w = *(const unsigned*)(p + O_BCKV + i * 128 + lane * 2); kv[2 * i] = bflo(w); kv[2 * i + 1] = bfhi(w); ss += kv[2 * i] * kv[2 * i] + kv[2 * i + 1] * kv[2 * i + 1]; }
            ss = wave_sum(ss); r = rsqrtf(ss * (1.f / 256.f) + EPS);
#pragma unroll
            for (int i = 0; i < 2; ++i) { const int c = i * 128 + lane * 2; *(unsigned*)(a.CKVN + t * 256 + c) = cvt_pk_bf16(kv[2 * i] * r * a.ckv_gain[c], kv[2 * i + 1] * r * a.ckv_gain[c + 1]); }
            if (lane < 32) { const int f = lane & 15, hf = lane >> 4; const int pos = hf ? s : co; const float cs = a.cosB[pos * 16 + f], sn = a.sinB[pos * 16 + f];
                const float x1 = bf2f(p[O_BKR + hf * 32 + f]), x2 = bf2f(p[O_BKR + hf * 32 + 16 + f]);
                a.KR[t * 64 + hf * 32 + f] = f2bf(x1 * cs - x2 * sn); a.KR[t * 64 + hf * 32 + 16 + f] = f2bf(x2 * cs + x1 * sn); } }
        __syncthreads();
    }
}

__device__ __forceinline__ void scan_phase(const bf16_t* KCT, const float* NLOC, const float* GSC, bf16_t* CPREV, float* NPREV, float* MPREV, int gtid, int nthr) {
    for (int item = gtid; item < 32 * 4096; item += nthr) {
        const int chain = item >> 12, e4 = item & 4095;
        const u32x2* src = (const u32x2*)(KCT + (size_t)chain * 64 * 16384) + e4; u32x2* dst = (u32x2*)(CPREV + (size_t)chain * 64 * 16384) + e4;
        const float* gs = GSC + (size_t)chain * 128;
        const bool don = e4 < 128;
        float c0 = 0.f, c1 = 0.f, c2 = 0.f, c3 = 0.f, nn = 0.f, m = 0.f;
#pragma unroll 1
        for (int cb = 0; cb < 64; cb += 8) {
            u32x2 kc[8]; float nl[8];
#pragma unroll
            for (int j = 0; j < 8; ++j) { kc[j] = src[(size_t)(cb + j) * 4096]; nl[j] = don ? NLOC[((size_t)chain * 64 + cb + j) * 128 + e4] : 0.f; }
#pragma unroll
            for (int j = 0; j < 8; ++j) { const int ci = cb + j; const float g = gs[ci * 2], ml = gs[ci * 2 + 1];
                u32x2 o; o.x = cvt_pk_bf16(c0, c1); o.y = cvt_pk_bf16(c2, c3); dst[(size_t)ci * 4096] = o;
                if (don) NPREV[((size_t)chain * 64 + ci) * 128 + e4] = nn;
                if (e4 == 0) MPREV[chain * 64 + ci] = m;
                const float mn = fmaxf(g + m, ml), dec = __expf(g + m - mn), sl = __expf(ml - mn); m = mn;
                c0 = dec * c0 + sl * bflo(kc[j].x); c1 = dec * c1 + sl * bfhi(kc[j].x); c2 = dec * c2 + sl * bflo(kc[j].y); c3 = dec * c3 + sl * bfhi(kc[j].y);
                nn = dec * nn + sl * nl[j]; }
        }
    }
}

constexpr int MC_K = 0, MC_V = 16384, MC_CT = 32768, MC_HS = 98304, MC_HS_LD = 132, MC_SM = MC_HS + 64 * MC_HS_LD * 4, MC_LDS = MC_SM + 4096;
struct McArgs { const bf16_t* PROJ; const float* GATES; const float* gate_b; const bf16_t* QC; const bf16_t* KC; const bf16_t* CPREV; const float* NPREV; const float* MPREV; const float* hog; bf16_t* YM; };
__device__ __forceinline__ void mlstm_c_phase(FX_LAS unsigned char* lds_, const McArgs& a, int wg, int nwg) {
    char* lds = (char*)lds_;
    using C = AttnC<128>;
    float* hs = (float*)(lds + MC_HS);
#ifdef FX_ZERO_LDS
    for (int i = threadIdx.x; i < MC_LDS / 4; i += 512) ((unsigned*)lds)[i] = 0u;
    __syncthreads();
#endif
    float* sm = (float*)(lds + MC_SM);
    for (int unit = wg; unit < NB * 4 * 64; unit += nwg) {
        int tid_ = threadIdx.x; asm volatile("" : "+v"(tid_));
        const int tid = tid_, wid = tid >> 6, lane = tid & 63, r32 = lane & 31, hi = lane >> 5;
        const int co = unit & 63, h = (unit >> 6) & 3, b = unit >> 8; const size_t t0 = (size_t)b * S + co * 64;
        if (wid < 2) { const int dir = wid; const int chain = (b * 4 + h) * 2 + dir, ci = dir ? 63 - co : co;
            const float logi = a.GATES[(t0 + lane) * 16 + (dir * 2) * 4 + h] + a.gate_b[(dir * 2) * 4 + h];
            const float logf = logsigmoid_f(a.GATES[(t0 + lane) * 16 + (dir * 2 + 1) * 4 + h] + a.gate_b[(dir * 2 + 1) * 4 + h]);
            const float pre = wave_scan_incl(logf, lane), g = __shfl(pre, 63);
            const float bb = dir ? (g - pre + logf) : pre;
            const float u = logi - bb;
            const float M = dir ? wave_rscanmax_incl(u, lane) : wave_scanmax_incl(u, lane);
            const float mp = a.MPREV[chain * 64 + ci], mmj = fmaxf(mp, M);
            sm[dir * 64 + lane] = u; sm[128 + dir * 64 + lane] = mmj; sm[256 + dir * 64 + lane] = __expf(mp - mmj); sm[384 + dir * 64 + lane] = __expf(-(bb + mmj));
            sm[512 + dir * 128 + lane] = a.NPREV[((size_t)chain * 64 + ci) * 128 + lane]; sm[512 + dir * 128 + 64 + lane] = a.NPREV[((size_t)chain * 64 + ci) * 128 + 64 + lane]; }
        { const int sr = tid >> 4, sc = (tid & 15) * 8;
#pragma unroll
          for (int rr = 0; rr < 2; ++rr) { const int s = sr + 32 * rr;
            *(bf16x8*)(lds + MC_K + FX_KSWZ(s, sc * 2)) = *(const bf16x8*)(a.KC + (t0 + s) * 512 + h * 128 + sc);
            *(bf16x8*)(lds + MC_V + v_st(s, sc)) = *(const bf16x8*)(a.PROJ + (t0 + s) * PW + O_CV + h * 128 + sc); }
#pragma unroll
          for (int dir = 0; dir < 2; ++dir) { const int chain = (b * 4 + h) * 2 + dir, ci = dir ? 63 - co : co; const bf16_t* ct = a.CPREV + ((size_t)chain * 64 + ci) * 16384;
#pragma unroll
            for (int rr = 0; rr < 4; ++rr) { const int v = sr + 32 * rr; *(bf16x8*)(lds + MC_CT + dir * 32768 + FX_KSWZ(v, sc * 2)) = *(const bf16x8*)(ct + v * 128 + sc); } } }
        __syncthreads();
        { const int dir = wid >> 2, rb = (wid >> 1) & 1, cb = wid & 1, j = rb * 32 + r32;
          bf16x8 qr[8];
          const bf16_t* Qw = a.QC + (t0 + j) * 512 + h * 128 + hi * 8;
#pragma unroll
          for (int d0 = 0; d0 < 8; ++d0) qr[d0] = *reinterpret_cast<const bf16x8*>(Qw + d0 * 16);
          f32x16 p0, p1;
          qkt<128>(p0, p1, lds + MC_K, qr, nullptr, r32, hi);
          const float mmj = sm[128 + dir * 64 + j], inter = sm[256 + dir * 64 + j], emn = sm[384 + dir * 64 + j];
          float dsum = 0.f;
#pragma unroll
          for (int r = 0; r < 16; ++r) { const int s0 = crow(r, hi), s1 = 32 + s0;
              const bool v0 = dir ? (s0 >= j) : (s0 <= j), v1 = dir ? (s1 >= j) : (s1 <= j);
              const float w0 = v0 ? __expf(sm[dir * 64 + s0] - mmj) : 0.f, w1 = v1 ? __expf(sm[dir * 64 + s1] - mmj) : 0.f;
              p0[r] *= w0; p1[r] *= w1; dsum += p0[r] + p1[r]; }
          float qn = 0.f;
#pragma unroll
          for (int d0 = 0; d0 < 8; ++d0) { const float* np = sm + 512 + dir * 128 + d0 * 16 + hi * 8; const u32x4 w = *reinterpret_cast<const u32x4*>(&qr[d0]);
              qn += bflo(w.x) * np[0] + bfhi(w.x) * np[1] + bflo(w.y) * np[2] + bfhi(w.y) * np[3] + bflo(w.z) * np[4] + bfhi(w.z) * np[5] + bflo(w.w) * np[6] + bfhi(w.w) * np[7]; }
          { auto rr = __builtin_amdgcn_permlane32_swap(__float_as_uint(dsum), __float_as_uint(dsum), false, false); dsum = __uint_as_float(rr[0]) + __uint_as_float(rr[1]); }
          { auto rr = __builtin_amdgcn_permlane32_swap(__float_as_uint(qn), __float_as_uint(qn), false, false); qn = __uint_as_float(rr[0]) + __uint_as_float(rr[1]); }
          const float den = dsum + inter * qn;
          if (hi == 0) sm[768 + wid * 32 + r32] = 1.f / fmaxf(fabsf(den), emn);
          bf16x8 pa0, pa1, pa2, pa3;
          FX_PK4(p0, 0, pa0); FX_PK4(p0, 8, pa1); FX_PK4(p1, 0, pa2); FX_PK4(p1, 8, pa3);
          f32x16 o[2] = {};
          const int vb = (int)(uintptr_t)(lds + MC_V) + v_rd_base(lane) + cb * 1024;
          pv_one<0>(o[0], vb, pa0, pa1, pa2, pa3); pv_one<1>(o[1], vb, pa0, pa1, pa2, pa3);
          const char* ctb = lds + MC_CT + dir * 32768;
#pragma unroll
          for (int ks = 0; ks < 8; ++ks) { const u32x4 w = *reinterpret_cast<const u32x4*>(&qr[ks]); u32x4 sq;
              sq.x = cvt_pk_bf16(bflo(w.x) * inter, bfhi(w.x) * inter); sq.y = cvt_pk_bf16(bflo(w.y) * inter, bfhi(w.y) * inter); sq.z = cvt_pk_bf16(bflo(w.z) * inter, bfhi(w.z) * inter); sq.w = cvt_pk_bf16(bflo(w.w) * inter, bfhi(w.w) * inter);
              const bf16x8 qs = *reinterpret_cast<const bf16x8*>(&sq); const int colB = (ks * 16 + hi * 8) * 2;
              const bf16x8 c0f = *reinterpret_cast<const bf16x8*>(ctb + FX_KSWZ((2 * cb) * 32 + r32, colB));
              const bf16x8 c1f = *reinterpret_cast<const bf16x8*>(ctb + FX_KSWZ((2 * cb + 1) * 32 + r32, colB));
              o[0] = __builtin_amdgcn_mfma_f32_32x32x16_bf16(qs, c0f, o[0], 0, 0, 0);
              o[1] = __builtin_amdgcn_mfma_f32_32x32x16_bf16(qs, c1f, o[1], 0, 0, 0); }
          asm volatile("s_waitcnt lgkmcnt(0)" ::: "memory");
          float rd[16];
#pragma unroll
          for (int r = 0; r < 16; ++r) rd[r] = sm[768 + wid * 32 + crow(r, hi)];
          if (dir == 0) {
#pragma unroll
              for (int r = 0; r < 16; ++r) { const int row = rb * 32 + crow(r, hi);
                  hs[row * MC_HS_LD + (2 * cb) * 32 + r32] = o[0][r] * rd[r]; hs[row * MC_HS_LD + (2 * cb + 1) * 32 + r32] = o[1][r] * rd[r]; } }
          __syncthreads();
          if (dir == 1) {
#pragma unroll
              for (int r = 0; r < 16; ++r) { const int row = rb * 32 + crow(r, hi);
                  hs[row * MC_HS_LD + (2 * cb) * 32 + r32] += o[0][r] * rd[r]; hs[row * MC_HS_LD + (2 * cb + 1) * 32 + r32] += o[1][r] * rd[r]; } }
          __syncthreads(); }
        { const int row = tid >> 3, c0 = (tid & 7) * 16; const size_t t = t0 + row;
          float v[16]; float ss = 0.f;
#pragma unroll
          for (int i = 0; i < 16; ++i) { v[i] = hs[row * MC_HS_LD + c0 + i]; ss += v[i] * v[i]; }
          ss += __shfl_xor(ss, 1); ss += __shfl_xor(ss, 2); ss += __shfl_xor(ss, 4);
          const float rn = rsqrtf(ss * (1.f / 128.f) + EPS);
          const bf16_t* og = a.PROJ + t * PW + O_CO + h * 128 + c0; const float* gn = a.hog + 1536 + h * 128 + c0;
          const u32x4 g0 = *(const u32x4*)og, g1 = *(const u32x4*)(og + 8);
          const float gg[16] = {bflo(g0.x), bfhi(g0.x), bflo(g0.y), bfhi(g0.y), bflo(g0.z), bfhi(g0.z), bflo(g0.w), bfhi(g0.w), bflo(g1.x), bfhi(g1.x), bflo(g1.y), bfhi(g1.y), bflo(g1.z), bfhi(g1.z), bflo(g1.w), bfhi(g1.w)};
          float ov[16];
#pragma unroll
          for (int i = 0; i < 16; ++i) ov[i] = v[i] * rn * gn[i] * sigmoid_f(gg[i]);
          u32x4 w0, w1; w0.x = cvt_pk_bf16(ov[0], ov[1]); w0.y = cvt_pk_bf16(ov[2], ov[3]); w0.z = cvt_pk_bf16(ov[4], ov[5]); w0.w = cvt_pk_bf16(ov[6], ov[7]);
          w1.x = cvt_pk_bf16(ov[8], ov[9]); w1.y = cvt_pk_bf16(ov[10], ov[11]); w1.z = cvt_pk_bf16(ov[12], ov[13]); w1.w = cvt_pk_bf16(ov[14], ov[15]);
          bf16_t* dst = a.YM + t * 2048 + 1536 + h * 128 + c0; *(u32x4*)dst = w0; *(u32x4*)(dst + 8) = w1; }
        __syncthreads();
    }
}
}
namespace fx {
struct EpiQB {
    static constexpr bool PERM = false;
    bf16_t* O; const float* cosB; const float* sinB;
    __device__ __forceinline__ void operator()(const f32x4 (&acc)[2][2][4][2], const Unit& u, int wr, int wc, int fr, int fq) const {
        const int row0 = u.pm * BM + wr * 64 + fr;
#pragma unroll
        for (int bj = 0; bj < 2; ++bj) { const int G = 8 * u.pn + 4 * bj + wc, gm = G % 6; const int col0 = G * 32 + 4 * fq;
#pragma unroll
            for (int ai = 0; ai < 2; ++ai)
#pragma unroll
                for (int m = 0; m < 4; ++m) { const int row = row0 + ai * HALF + m * 16; f32x4 x1 = acc[ai][bj][m][0], x2 = acc[ai][bj][m][1];
                    if (gm >= 4) { const int s = row & (S - 1), pos = gm == 4 ? (s >> 6) : (s & 63);
                        const f32x4 cs = *(const f32x4*)(cosB + pos * 16 + 4 * fq), sn = *(const f32x4*)(sinB + pos * 16 + 4 * fq);
                        const f32x4 o1 = x1 * cs - x2 * sn, o2 = x2 * cs + x1 * sn; x1 = o1; x2 = o2; }
                    bf16_t* rp = O + (size_t)row * 1280 + col0;
                    u32x2 w0, w1; w0.x = cvt_pk_bf16(x1[0], x1[1]); w0.y = cvt_pk_bf16(x1[2], x1[3]); w1.x = cvt_pk_bf16(x2[0], x2[1]); w1.y = cvt_pk_bf16(x2[2], x2[3]);
                    *(u32x2*)rp = w0; *(u32x2*)(rp + 16) = w1; } }
    }
};
constexpr size_t al256(size_t x) { return (x + 255) & ~(size_t)255; }
constexpr size_t WS_BAR = 0;
constexpr size_t WS_MOD = 16384;
constexpr size_t WS_COEF = WS_MOD + al256(2ull * 4 * 12288 * 4);
constexpr size_t WS_TAB = WS_COEF + al256(2ull * 4 * 6 * 2048 * 4);
constexpr size_t WS_CNT = WS_TAB + al256(6144 * 4);
constexpr size_t WS_WGBASE = WS_CNT + 512;
constexpr size_t WS_SELE = WS_WGBASE + 256 * 64 * 4;
constexpr size_t WS_SELG = WS_SELE + (size_t)T * 6 * 4;
constexpr size_t WS_SLOT = WS_SELG + (size_t)T * 6 * 4;
constexpr size_t WS_ROWTOK = WS_SLOT + (size_t)T * 6 * 4;
constexpr size_t WS_ROWG = WS_ROWTOK + (size_t)PTOT * 4;
constexpr size_t WS_GATES = WS_ROWG + (size_t)PTOT * 4;
constexpr size_t WS_GSC = WS_GATES + (size_t)T * 16 * 4;
constexpr size_t WS_MPREV = WS_GSC + 2048 * 2 * 4;
constexpr size_t WS_NLOC = WS_MPREV + 2048 * 4;
constexpr size_t WS_NPREV = WS_NLOC + 2048ull * 128 * 4;
constexpr size_t WS_W = al256(WS_NPREV + 2048ull * 128 * 4);
constexpr size_t W_IN = 0, W_UQ = W_IN + 4096ull * 2048 * 2, W_UKV = W_UQ + 1280ull * 384 * 2, W_OUT = W_UKV + 1536ull * 256 * 2, W_GU = W_OUT + 2048ull * 2048 * 2, W_DN = W_GU + 65ull * 1024 * 2048 * 2, W_LAYER = W_DN + 65ull * 2048 * 512 * 2;
constexpr size_t WS_XRES = WS_W + 2 * W_LAYER;
constexpr size_t WS_HA = WS_XRES + (size_t)T * 2048 * 4;
constexpr size_t WS_R1 = WS_HA + (size_t)T * 2048 * 2;
constexpr size_t WS_R2 = WS_R1 + (size_t)T * 4096 * 2;
constexpr size_t R2_QA = 0, R2_KA = R2_QA + (size_t)T * 768 * 2, R2_CQN = R2_KA + (size_t)T * 256 * 2, R2_CKVN = R2_CQN + (size_t)T * 384 * 2, R2_KR = R2_CKVN + (size_t)T * 256 * 2,
                 R2_QB = R2_KR + (size_t)T * 64 * 2, R2_KVB = R2_QB + (size_t)T * 1280 * 2, R2_QC = R2_KVB + (size_t)T * 1536 * 2, R2_KC = R2_QC + (size_t)T * 512 * 2,
                 R2_KCT = R2_KC + (size_t)T * 512 * 2, R2_CPREV = R2_KCT + 2048ull * 16384 * 2, R2_END = R2_CPREV + 2048ull * 16384 * 2;
constexpr size_t WS_END = WS_R2 + (size_t)PTOT * 2048 * 2;
static_assert(R2_END <= (size_t)PTOT * 2048 * 2, "R2 overflow");
static_assert(WS_END <= 2147483648ull, "workspace too large");
}

namespace fx {
__global__ __launch_bounds__(256) void k_f2b(const float* src, int lds_, bf16_t* dst, int ldd, int rows, int cols) {
    const size_t n = (size_t)rows * cols;
    for (size_t i = (size_t)blockIdx.x * 256 + threadIdx.x; i < n; i += (size_t)gridDim.x * 256) { const size_t r = i / cols, c = i % cols; dst[r * ldd + c] = f2bf(src[r * lds_ + c]); }
}
struct CvtW { const float* w_in; const float* w_uq; const float* w_ukv; const float* w_out; const float* eg; const float* eu; const float* ed; const float* sg; const float* su; const float* sd; bf16_t* W; };
__device__ __forceinline__ void cvt_layer(const CvtW& a, FX_LAS unsigned* my, int gwave, int nwaves, int& rot) {
    const int BIG = 1 << 30; bf16_t* W = a.W;
    bf16_t* WIN = W + W_IN / 2; bf16_t* WUQ = W + W_UQ / 2; bf16_t* WUKV = W + W_UKV / 2; bf16_t* WOUT = W + W_OUT / 2; bf16_t* WGU = W + W_GU / 2; bf16_t* WDN = W + W_DN / 2;
    { CvtSeg s; s.src = a.w_in; s.dst = WIN; s.sstride = 0; s.dstride = 0; s.ld = 4048; s.nsrc = 4048; s.K = 2048; s.ntn = 64; s.nbatch = 1; s.G = BIG; s.GS = 0; s.off = 0; cvt_seg(s, my, gwave, nwaves, rot); }
    { CvtSeg s; s.src = a.w_uq; s.dst = WUQ; s.sstride = 0; s.dstride = 0; s.ld = 1152; s.nsrc = 1152; s.K = 384; s.ntn = 20; s.nbatch = 1; s.G = BIG; s.GS = 0; s.off = 0; cvt_seg(s, my, gwave, nwaves, rot); }
    { CvtSeg s; s.src = a.w_ukv; s.dst = WUKV; s.sstride = 0; s.dstride = 0; s.ld = 1536; s.nsrc = 1536; s.K = 256; s.ntn = 24; s.nbatch = 1; s.G = BIG; s.GS = 0; s.off = 0; cvt_seg(s, my, gwave, nwaves, rot); }
    { CvtSeg s; s.src = a.w_out; s.dst = WOUT; s.sstride = 0; s.dstride = 0; s.ld = 2048; s.nsrc = 2048; s.K = 2048; s.ntn = 32; s.nbatch = 1; s.G = BIG; s.GS = 0; s.off = 0; cvt_seg(s, my, gwave, nwaves, rot); }
    { CvtSeg s; s.src = a.eg; s.dst = WGU; s.sstride = 2048ll * 512; s.dstride = 1024ll * 2048; s.ld = 512; s.nsrc = 512; s.K = 2048; s.ntn = 8; s.nbatch = 64; s.G = 128; s.GS = 256; s.off = 0; cvt_seg(s, my, gwave, nwaves, rot); }
    { CvtSeg s; s.src = a.eu; s.dst = WGU; s.sstride = 2048ll * 512; s.dstride = 1024ll * 2048; s.ld = 512; s.nsrc = 512; s.K = 2048; s.ntn = 8; s.nbatch = 64; s.G = 128; s.GS = 256; s.off = 128; cvt_seg(s, my, gwave, nwaves, rot); }
    { CvtSeg s; s.src = a.ed; s.dst = WDN; s.sstride = 512ll * 2048; s.dstride = 2048ll * 512; s.ld = 2048; s.nsrc = 2048; s.K = 512; s.ntn = 32; s.nbatch = 64; s.G = BIG; s.GS = 0; s.off = 0; cvt_seg(s, my, gwave, nwaves, rot); }
    { CvtSeg s; s.src = a.sg; s.dst = WGU + 64ull * 1024 * 2048; s.sstride = 0; s.dstride = 0; s.ld = 512; s.nsrc = 512; s.K = 2048; s.ntn = 8; s.nbatch = 1; s.G = 128; s.GS = 256; s.off = 0; cvt_seg(s, my, gwave, nwaves, rot); }
    { CvtSeg s; s.src = a.su; s.dst = WGU + 64ull * 1024 * 2048; s.sstride = 0; s.dstride = 0; s.ld = 512; s.nsrc = 512; s.K = 2048; s.ntn = 8; s.nbatch = 1; s.G = 128; s.GS = 256; s.off = 128; cvt_seg(s, my, gwave, nwaves, rot); }
    { CvtSeg s; s.src = a.sd; s.dst = WDN + 64ull * 2048 * 512; s.sstride = 0; s.dstride = 0; s.ld = 2048; s.nsrc = 2048; s.K = 512; s.ntn = 32; s.nbatch = 1; s.G = BIG; s.GS = 0; s.off = 0; cvt_seg(s, my, gwave, nwaves, rot); }
}
__global__ __launch_bounds__(512, 2) void k_cvt(CvtW a) {
    extern __shared__ __attribute__((aligned(16))) unsigned char shm[];
    const int wave = threadIdx.x >> 6; FX_LAS unsigned* my = (FX_LAS unsigned*)(shm) + wave * (64 * 33);
    int rot = 0; cvt_layer(a, my, blockIdx.x * 8 + wave, gridDim.x * 8, rot);
}
template <class Epi> __global__ __launch_bounds__(512, 2) void k_gemm_dense(const bf16_t* A, int lda, const bf16_t* Bt, int M, int N, int K, Epi E) {
    extern __shared__ __attribute__((aligned(16))) unsigned char shm[];
    DenseSched S; S.init(M, N, (int)gridDim.x, (int)blockIdx.x, lda * 2, Bt, K);
    gemm_phase<Epi, DenseSched>((FX_LAS unsigned char*)shm, (const char*)A, K, S, E);
}
__global__ __launch_bounds__(256) void k_coef(const float* mod, const float* a, const float* b, const float* c, const float* d, float* coef) { coef_phase(mod, a, b, c, d, coef, blockIdx.x * 256 + threadIdx.x, gridDim.x * 256); }
__global__ __launch_bounds__(512, 2) void k_p3(P3Args a) { extern __shared__ __attribute__((aligned(16))) unsigned char shm[]; p3_phase((FX_LAS unsigned char*)shm, a, blockIdx.x, gridDim.x); }
__global__ __launch_bounds__(512, 2) void k_mscan(const bf16_t* KCT, const float* NLOC, const float* GSC, bf16_t* CPREV, float* NPREV, float* MPREV) { scan_phase(KCT, NLOC, GSC, CPREV, NPREV, MPREV, blockIdx.x * 512 + threadIdx.x, gridDim.x * 512); }
__global__ __launch_bounds__(512, 2) void k_mc(McArgs a) { extern __shared__ __attribute__((aligned(16))) unsigned char shm[]; mlstm_c_phase((FX_LAS unsigned char*)shm, a, blockIdx.x, gridDim.x); }
__global__ __launch_bounds__(512, 2) void k_attn_fast(const bf16_t* QA, const bf16_t* KA, const bf16_t* PROJ, const bf16_t* QB, const bf16_t* KVB, const bf16_t* KR, bf16_t* YM, const float* hog) {
    extern __shared__ __attribute__((aligned(16))) unsigned char shm[];
    for (int u = blockIdx.x; u < 768; u += gridDim.x) {
        if (u < 384) attn_gqa_unit(u, QA, KA, PROJ, YM, hog, (char*)shm);
        else attn_mla_unit(u - 384, QB, KVB, KR, YM, hog, (char*)shm);
    }
}
__global__ __launch_bounds__(512, 2) void k_p7(const float* xin, const bf16_t* Y, const float* coef_l, const float* rw, const float* rb, float* XRES, bf16_t* HA, int* SELE, float* SELG, int* CNT, int* WGBASE) {
    extern __shared__ __attribute__((aligned(16))) unsigned char shm[];
    p7_phase((FX_LAS unsigned char*)shm, xin, Y, coef_l, rw, rb, XRES, HA, SELE, SELG, CNT, WGBASE, blockIdx.x, gridDim.x); }
__global__ __launch_bounds__(512, 2) void k_p8(const int* SELE, const float* SELG, const int* CNT, const int* WGBASE, int* ROWTOK, float* ROWG, int* SLOT) {
    extern __shared__ __attribute__((aligned(16))) unsigned char shm[];
    p8_phase((FX_LAS unsigned char*)shm, SELE, SELG, CNT, WGBASE, ROWTOK, ROWG, SLOT, blockIdx.x, gridDim.x); }
__global__ __launch_bounds__(512, 2) void k_p9(const bf16_t* HA, const bf16_t* WGU, const int* CNT, const int* ROWTOK, bf16_t* HID) {
    extern __shared__ __attribute__((aligned(16))) unsigned char shm[];
    p9_phase((FX_LAS unsigned char*)shm, HA, WGU, CNT, ROWTOK, HID, blockIdx.x, gridDim.x); }
__global__ __launch_bounds__(512, 2) void k_p10(const bf16_t* HID, const bf16_t* WDN, const int* CNT, const float* ROWG, bf16_t* YR) {
    extern __shared__ __attribute__((aligned(16))) unsigned char shm[];
    p10_phase((FX_LAS unsigned char*)shm, HID, WDN, CNT, ROWG, YR, blockIdx.x, gridDim.x); }
__global__ __launch_bounds__(512, 2) void k_p11(const float* x1, const bf16_t* YR, const int* SLOT, const float* coef_l, const float* coef_next, float* xout, bf16_t* HA) {
    p11_phase(x1, YR, SLOT, coef_l, coef_next, xout, HA, blockIdx.x, gridDim.x); }
}

namespace nv {
static void forward(void* const* d_in, float* out, char* ws, hipStream_t st) {
    using namespace fx;
    const float* x_in = (const float*)d_in[0]; const float* c = (const float*)d_in[1];
    const float* ada_w = (const float*)d_in[2]; const float* ada_b = (const float*)d_in[3]; const float* pre_mix_gain = (const float*)d_in[4];
    const float* w_in = (const float*)d_in[5]; const float* a_q_gain = (const float*)d_in[6]; const float* a_k_gain = (const float*)d_in[7];
    const float* b_cq_gain = (const float*)d_in[8]; const float* b_ckv_gain = (const float*)d_in[9]; const float* w_uq = (const float*)d_in[10]; const float* w_ukv = (const float*)d_in[11];
    const float* c_conv_w = (const float*)d_in[12]; const float* c_conv_b = (const float*)d_in[13]; const float* c_gate_b = (const float*)d_in[14];
    const float* head_out_gain = (const float*)d_in[15]; const float* w_out = (const float*)d_in[16]; const float* post_mix_gain = (const float*)d_in[17];
    const float* pre_ffn_gain = (const float*)d_in[18]; const float* router_w = (const float*)d_in[19]; const float* router_bias = (const float*)d_in[20];
    const float* exp_w_gate = (const float*)d_in[21]; const float* exp_w_up = (const float*)d_in[22]; const float* exp_w_down = (const float*)d_in[23];
    const float* sh_w_gate = (const float*)d_in[24]; const float* sh_w_up = (const float*)d_in[25]; const float* sh_w_down = (const float*)d_in[26]; const float* post_ffn_gain = (const float*)d_in[27];
    float* mod = (float*)(ws + WS_MOD); float* COEF = (float*)(ws + WS_COEF);
    float* cosA = (float*)(ws + WS_TAB); float* sinA = cosA + 2048; float* cosB = sinA + 2048; float* sinB = cosB + 1024;
    int* CNT = (int*)(ws + WS_CNT); int* WGBASE = (int*)(ws + WS_WGBASE); int* SELE = (int*)(ws + WS_SELE); float* SELG = (float*)(ws + WS_SELG); int* SLOT = (int*)(ws + WS_SLOT);
    int* ROWTOK = (int*)(ws + WS_ROWTOK); float* ROWG = (float*)(ws + WS_ROWG); float* GATES = (float*)(ws + WS_GATES); float* GSC = (float*)(ws + WS_GSC); float* MPREV = (float*)(ws + WS_MPREV);
    float* NLOC = (float*)(ws + WS_NLOC); float* NPREV = (float*)(ws + WS_NPREV);
    float* XRES = (float*)(ws + WS_XRES); bf16_t* HA = (bf16_t*)(ws + WS_HA); bf16_t* PROJ = (bf16_t*)(ws + WS_R1); bf16_t* Yb = PROJ; bf16_t* HID = PROJ;
    char* R2 = ws + WS_R2; bf16_t* YR = (bf16_t*)R2;
    bf16_t* QA = (bf16_t*)(R2 + R2_QA); bf16_t* KA = (bf16_t*)(R2 + R2_KA); bf16_t* CQN = (bf16_t*)(R2 + R2_CQN); bf16_t* CKVN = (bf16_t*)(R2 + R2_CKVN); bf16_t* KR = (bf16_t*)(R2 + R2_KR);
    bf16_t* QB = (bf16_t*)(R2 + R2_QB); bf16_t* KVB = (bf16_t*)(R2 + R2_KVB); bf16_t* QC = (bf16_t*)(R2 + R2_QC); bf16_t* KC = (bf16_t*)(R2 + R2_KC); bf16_t* KCT = (bf16_t*)(R2 + R2_KCT); bf16_t* CPREV = (bf16_t*)(R2 + R2_CPREV);
    float* H = (float*)(R2);
    static bool attr = false;
    if (!attr) {
        (void)hipFuncSetAttribute((const void*)k_gemm_dense<EpiBf16>, hipFuncAttributeMaxDynamicSharedMemorySize, STAGE_BYTES);
        (void)hipFuncSetAttribute((const void*)k_gemm_dense<EpiQB>, hipFuncAttributeMaxDynamicSharedMemorySize, STAGE_BYTES);
        (void)hipFuncSetAttribute((const void*)k_cvt, hipFuncAttributeMaxDynamicSharedMemorySize, 8 * 64 * 33 * 4);
        (void)hipFuncSetAttribute((const void*)k_attn_fast, hipFuncAttributeMaxDynamicSharedMemorySize, AttnC<192>::SHM);
        (void)hipFuncSetAttribute((const void*)k_p3, hipFuncAttributeMaxDynamicSharedMemorySize, P3_LDS);
        (void)hipFuncSetAttribute((const void*)k_mc, hipFuncAttributeMaxDynamicSharedMemorySize, MC_LDS);
        (void)hipFuncSetAttribute((const void*)k_p7, hipFuncAttributeMaxDynamicSharedMemorySize, P7_LDS);
        (void)hipFuncSetAttribute((const void*)k_p9, hipFuncAttributeMaxDynamicSharedMemorySize, STAGE_BYTES + 1024);
        (void)hipFuncSetAttribute((const void*)k_p10, hipFuncAttributeMaxDynamicSharedMemorySize, STAGE_BYTES + 1024); attr = true; }
    hipLaunchKernelGGL(k_mod, dim3(48, 2), dim3(256), 0, st, c, ada_w, ada_b, mod);
    hipLaunchKernelGGL(k_rope_tab, dim3(8), dim3(256), 0, st, cosA, sinA, cosB, sinB);
    hipLaunchKernelGGL(k_coef, dim3(64), dim3(256), 0, st, (const float*)mod, pre_mix_gain, post_mix_gain, pre_ffn_gain, post_ffn_gain, COEF);
    (void)hipMemsetAsync(CNT, 0, 512, st);
    for (int l = 0; l < 2; ++l) { CvtW a{}; a.w_in = w_in + (size_t)l * D * 4048; a.w_uq = w_uq + (size_t)l * 384 * 1152; a.w_ukv = w_ukv + (size_t)l * 256 * 1536; a.w_out = w_out + (size_t)l * D * D;
        a.eg = exp_w_gate + (size_t)l * NE * D * FF; a.eu = exp_w_up + (size_t)l * NE * D * FF; a.ed = exp_w_down + (size_t)l * NE * FF * D;
        a.sg = sh_w_gate + (size_t)l * D * FF; a.su = sh_w_up + (size_t)l * D * FF; a.sd = sh_w_down + (size_t)l * FF * D; a.W = (bf16_t*)(ws + WS_W + (size_t)l * W_LAYER);
        hipLaunchKernelGGL(k_cvt, dim3(256), dim3(512), 8 * 64 * 33 * 4, st, a); }
    const float* xcur = x_in;
    for (int l = 0; l < 2; ++l) {
        const bf16_t* W = (const bf16_t*)(ws + WS_W + (size_t)l * W_LAYER);
        const float* md = mod + (size_t)l * 4 * 12288; const float* sh1 = md + 0 * 2048; const float* sc1 = md + 1 * 2048;
        const float* coef_l = COEF + (size_t)l * 4 * 6 * 2048;
        if (l == 0) { hipLaunchKernelGGL(k_prenorm, dim3(T), dim3(256), 0, st, xcur, pre_mix_gain + l * D, sc1, sh1, H);
                      hipLaunchKernelGGL(k_f2b, dim3(4096), dim3(256), 0, st, (const float*)H, 2048, HA, 2048, T, 2048); }
        { EpiBf16 E{}; E.O = PROJ; E.gates = GATES; E.ldc = 4096; E.pad = 0;
          hipLaunchKernelGGL(k_gemm_dense<EpiBf16>, dim3(256), dim3(512), STAGE_BYTES, st, (const bf16_t*)HA, 2048, W + W_IN / 2, T, 4096, 2048, E); }
        { P3Args a{}; a.PROJ = PROJ; a.GATES = GATES; a.gate_b = c_gate_b + l * 16; a.conv_w = c_conv_w + (size_t)l * 5 * 1024; a.conv_b = c_conv_b + l * 1024;
          a.aq_gain = a_q_gain + l * 128; a.ak_gain = a_k_gain + l * 128; a.cq_gain = b_cq_gain + l * 384; a.ckv_gain = b_ckv_gain + l * 256;
          a.cosA = cosA; a.sinA = sinA; a.cosB = cosB; a.sinB = sinB; a.QA = QA; a.KA = KA; a.CQN = CQN; a.CKVN = CKVN; a.KR = KR; a.QC = QC; a.KC = KC; a.KCT = KCT; a.NLOC = NLOC; a.GSC = GSC;
          hipLaunchKernelGGL(k_p3, dim3(256), dim3(512), P3_LDS, st, a); }
        { EpiQB E{}; E.O = QB; E.cosB = cosB; E.sinB = sinB;
          hipLaunchKernelGGL(k_gemm_dense<EpiQB>, dim3(256), dim3(512), STAGE_BYTES, st, (const bf16_t*)CQN, 384, W + W_UQ / 2, T, 1280, 384, E); }
        { EpiBf16 E{}; E.O = KVB; E.gates = nullptr; E.ldc = 1536; E.pad = 0;
          hipLaunchKernelGGL(k_gemm_dense<EpiBf16>, dim3(256), dim3(512), STAGE_BYTES, st, (const bf16_t*)CKVN, 256, W + W_UKV / 2, T, 1536, 256, E); }
        hipLaunchKernelGGL(k_mscan, dim3(256), dim3(512), 0, st, (const bf16_t*)KCT, (const float*)NLOC, (const float*)GSC, CPREV, NPREV, MPREV);
        hipLaunchKernelGGL(k_attn_fast, dim3(256), dim3(512), AttnC<192>::SHM, st, (const bf16_t*)QA, (const bf16_t*)KA, (const bf16_t*)PROJ, (const bf16_t*)QB, (const bf16_t*)KVB, (const bf16_t*)KR, HA, head_out_gain + l * D);
        { McArgs a{}; a.PROJ = PROJ; a.GATES = GATES; a.gate_b = c_gate_b + l * 16; a.QC = QC; a.KC = KC; a.CPREV = CPREV; a.NPREV = NPREV; a.MPREV = MPREV; a.hog = head_out_gain + l * D; a.YM = HA;
          hipLaunchKernelGGL(k_mc, dim3(256), dim3(512), MC_LDS, st, a); }
        { EpiBf16 E{}; E.O = Yb; E.gates = nullptr; E.ldc = 2048; E.pad = 0;
          hipLaunchKernelGGL(k_gemm_dense<EpiBf16>, dim3(256), dim3(512), STAGE_BYTES, st, (const bf16_t*)HA, 2048, W + W_OUT / 2, T, 2048, 2048, E); }
        hipLaunchKernelGGL(k_p7, dim3(256), dim3(512), P7_LDS, st, xcur, (const bf16_t*)Yb, coef_l, router_w + (size_t)l * D * 64, router_bias + l * 64, XRES, HA, SELE, SELG, CNT + l * 64, WGBASE);
        xcur = XRES;
        hipLaunchKernelGGL(k_p8, dim3(256), dim3(512), 1024, st, (const int*)SELE, (const float*)SELG, (const int*)(CNT + l * 64), (const int*)WGBASE, ROWTOK, ROWG, SLOT);
        hipLaunchKernelGGL(k_p9, dim3(256), dim3(512), STAGE_BYTES + 1024, st, (const bf16_t*)HA, W + W_GU / 2, (const int*)(CNT + l * 64), (const int*)ROWTOK, HID);
        hipLaunchKernelGGL(k_p10, dim3(256), dim3(512), STAGE_BYTES + 1024, st, (const bf16_t*)HID, W + W_DN / 2, (const int*)(CNT + l * 64), (const float*)ROWG, YR);
        float* xo = (l == 1) ? out : XRES;
        hipLaunchKernelGGL(k_p11, dim3(256), dim3(512), 0, st, xcur, (const bf16_t*)YR, (const int*)SLOT, coef_l, (const float*)(l == 0 ? COEF + 4 * 6 * 2048 : nullptr), xo, HA);
        xcur = xo;
    }
}
}

extern "C" void kernel_launch(void* const* d_in, const int* in_sizes, int n_in, void* d_out, int out_size, void* d_ws, size_t ws_size, hipStream_t stream) {
    nv::forward(d_in, (float*)d_out, (char*)d_ws, stream);
}
```

```cpp
#define FX_WIN8 1
#define FX_WOUT8 1
#define FX_HARVEST 2
#include <hip/hip_runtime.h>
#include <stdint.h>
#include <math.h>
namespace fx {
#define FX_LAS __attribute__((address_space(3)))
typedef unsigned short bf16_t;
typedef short bf16x8 __attribute__((ext_vector_type(8)));
typedef short s16x4 __attribute__((ext_vector_type(4)));
typedef float f32x4 __attribute__((ext_vector_type(4)));
typedef float f32x16 __attribute__((ext_vector_type(16)));
typedef unsigned u32x4 __attribute__((ext_vector_type(4)));
typedef unsigned u32x2 __attribute__((ext_vector_type(2)));
typedef float f32x2 __attribute__((ext_vector_type(2)));

constexpr int D = 2048, NB = 4, S = 4096, T = NB * S, DEPTH = 2;
constexpr int NE = 64, FF = 512;
constexpr float EPS = 1e-6f;
constexpr int PW = 4096;
constexpr int O_AQ = 0, O_AK = 768, O_AV = 1024, O_BCQ = 1280, O_BCKV = 1664, O_BKR = 1920, O_CQ = 1984, O_CK = 2496, O_CV = 3008, O_CO = 3520, O_CG = 4032;

typedef __bf16 bf16x2_t __attribute__((ext_vector_type(2)));
__device__ __forceinline__ unsigned cvt_pk_bf16(float lo, float hi) { const bf16x2_t r = __builtin_convertvector((f32x2){lo, hi}, bf16x2_t); return __builtin_bit_cast(unsigned, r); }
__device__ __forceinline__ float bf2f(bf16_t b) { return __uint_as_float(((unsigned)b) << 16); }
__device__ __forceinline__ float bflo(unsigned w) { return __uint_as_float(w << 16); }
__device__ __forceinline__ float bfhi(unsigned w) { return __uint_as_float(w & 0xffff0000u); }
__device__ __forceinline__ bf16_t f2bf(float f) { return (bf16_t)(cvt_pk_bf16(f, 0.f) & 0xffffu); }
__device__ __forceinline__ float sigmoid_f(float x) { return 1.f / (1.f + __expf(-x)); }
__device__ __forceinline__ float silu_f(float x) { return x / (1.f + __expf(-x)); }
__device__ __forceinline__ int fx_lane() { unsigned z = 0u; asm volatile("" : "+v"(z)); return (int)__builtin_amdgcn_mbcnt_hi(~0u, __builtin_amdgcn_mbcnt_lo(~0u, z)); }
__device__ __forceinline__ float wave_sum(float v) { for (int o = 32; o >= 1; o >>= 1) v += __shfl_xor(v, o); return v; }
__device__ __forceinline__ float wave_max(float v) { for (int o = 32; o >= 1; o >>= 1) v = fmaxf(v, __shfl_xor(v, o)); return v; }

typedef int i32x8 __attribute__((ext_vector_type(8)));
typedef int i32x4 __attribute__((ext_vector_type(4)));
constexpr float W8_SCALE = 32.f, W8_INV = 1.f / 32.f;
__device__ __forceinline__ unsigned cvt_pk4_fp8(float a, float b, float c, float d) { int w = 0; w = __builtin_amdgcn_cvt_pk_fp8_f32(a, b, w, false); w = __builtin_amdgcn_cvt_pk_fp8_f32(c, d, w, true); return (unsigned)w; }
struct CvtSeg { const float* src; bf16_t* dst; long long sstride, dstride; int ld, nsrc, K, ntn, nbatch, G, GS, off; };
__device__ __forceinline__ void cvt_tile(const CvtSeg sg, FX_LAS unsigned* my, int tile) {
    const int lane = fx_lane();
    const int ktn = sg.K / 64, per = ktn * sg.ntn;
    {
        const int b = tile / per, r = tile - b * per, nt = r / ktn, kt = r - nt * ktn;
        const int r4 = lane >> 4, c4 = lane & 15;
        const float* src = sg.src + (size_t)b * sg.sstride + (size_t)(kt * 64) * sg.ld + nt * 64 + 4 * c4;
        const bool ok = nt * 64 + 4 * c4 < sg.nsrc;
        f32x4 va[8], vb[8];
#pragma unroll
        for (int i = 0; i < 8; ++i) { const int kp = 4 * i + r4; const f32x4 z = {0.f, 0.f, 0.f, 0.f};
            va[i] = ok ? *(const f32x4*)(src + (size_t)(2 * kp) * sg.ld) : z; vb[i] = ok ? *(const f32x4*)(src + (size_t)(2 * kp + 1) * sg.ld) : z; }
#pragma unroll
        for (int i = 0; i < 8; ++i) { const int kp = 4 * i + r4;
#pragma unroll
            for (int j = 0; j < 4; ++j) my[(4 * c4 + j) * 33 + kp] = cvt_pk_bf16(va[i][j], vb[i][j]); }
        asm volatile("s_waitcnt lgkmcnt(0)" ::: "memory");
        bf16_t* dst = sg.dst + (size_t)b * sg.dstride;
#pragma unroll
        for (int i = 0; i < 8; ++i) {
            const int nl = (lane >> 3) + 8 * i, c = lane & 7, n = nt * 64 + nl;
            u32x4 w; w.x = my[nl * 33 + 4 * c]; w.y = my[nl * 33 + 4 * c + 1]; w.z = my[nl * 33 + 4 * c + 2]; w.w = my[nl * 33 + 4 * c + 3];
            const int row = (n / sg.G) * sg.GS + (n % sg.G) + sg.off;
            *(u32x4*)(dst + (size_t)row * sg.K + kt * 64 + 8 * c) = w;
        }
        asm volatile("s_waitcnt lgkmcnt(0)" ::: "memory");
    }
}
__device__ __forceinline__ void cvt_seg(const CvtSeg sg, FX_LAS unsigned* my, int gwave, int nwaves, int& rot) {
    const int total = (sg.K / 64) * sg.ntn * sg.nbatch;
    int first = (gwave - rot) % nwaves; if (first < 0) first += nwaves;
    for (int tile = first; tile < total; tile += nwaves) cvt_tile(sg, my, tile);
    rot = (rot + total) % nwaves;
}
__device__ __forceinline__ void cvt_tile8(const CvtSeg sg, FX_LAS unsigned* my, int tile, float scale) {
    const int lane = fx_lane();
    const int ktn = sg.K / 64, per = ktn * sg.ntn;
    {
        const int b = tile / per, r = tile - b * per, nt = r / ktn, kt = r - nt * ktn;
        const int r4 = lane >> 4, c4 = lane & 15;
        const float* src = sg.src + (size_t)b * sg.sstride + (size_t)(kt * 64) * sg.ld + nt * 64 + 4 * c4;
        const bool ok = nt * 64 + 4 * c4 < sg.nsrc;
        f32x4 v[4][4];
#pragma unroll
        for (int i = 0; i < 4; ++i)
#pragma unroll
            for (int q = 0; q < 4; ++q) { const int kq = 4 * i + r4; const f32x4 z = {0.f, 0.f, 0.f, 0.f}; v[i][q] = ok ? *(const f32x4*)(src + (size_t)(4 * kq + q) * sg.ld) : z; }
#pragma unroll
        for (int i = 0; i < 4; ++i) { const int kq = 4 * i + r4;
#pragma unroll
            for (int j = 0; j < 4; ++j) my[(4 * c4 + j) * 17 + kq] = cvt_pk4_fp8(v[i][0][j] * scale, v[i][1][j] * scale, v[i][2][j] * scale, v[i][3][j] * scale); }
        asm volatile("s_waitcnt lgkmcnt(0)" ::: "memory");
        unsigned char* dst = (unsigned char*)sg.dst + (size_t)b * sg.dstride;
#pragma unroll
        for (int i = 0; i < 4; ++i) {
            const int nl = (lane >> 2) + 16 * i, c = lane & 3, n = nt * 64 + nl;
            u32x4 w; w.x = my[nl * 17 + 4 * c]; w.y = my[nl * 17 + 4 * c + 1]; w.z = my[nl * 17 + 4 * c + 2]; w.w = my[nl * 17 + 4 * c + 3];
            const int row = (n / sg.G) * sg.GS + (n % sg.G) + sg.off;
            *(u32x4*)(dst + (size_t)row * sg.K + kt * 64 + 16 * c) = w;
        }
        asm volatile("s_waitcnt lgkmcnt(0)" ::: "memory");
    }
}
__device__ __forceinline__ void cvt_seg8(const CvtSeg sg, FX_LAS unsigned* my, int gwave, int nwaves, int& rot, float scale) {
    const int total = (sg.K / 64) * sg.ntn * sg.nbatch;
    int first = (gwave - rot) % nwaves; if (first < 0) first += nwaves;
    for (int tile = first; tile < total; tile += nwaves) cvt_tile8(sg, my, tile, scale);
    rot = (rot + total) % nwaves;
}

constexpr int BM = 256, BK = 64, HALF = 128, HTB = HALF * BK * 2, STAGE_BYTES = 8 * HTB, NXCD = 8, WGM = 8;
__host__ __device__ __forceinline__ int lds_byte(int r, int c) { const int st = (r >> 4) * 2 + (c >> 5), rr = r & 15, cc = c & 31, ob = rr * 64 + cc * 2; return st * 1024 + (ob ^ (((ob >> 9) & 1) << 5)); }
__host__ __device__ __forceinline__ void stage_rc(int b, int& R, int& C) { const int st = b / 1024, sb = b % 1024, swz = sb ^ (((sb >> 9) & 1) << 5); R = (st >> 1) * 16 + swz / 64; C = (st & 1) * 32 + (swz % 64) / 2; }
__host__ __device__ __forceinline__ int perm32(int rho) { const int n = rho >> 4, i = rho & 15; return 8 * (i >> 2) + 4 * n + (i & 3); }
struct Unit { int pm, pn, e; };
struct DenseSched {
    static constexpr bool GATHER = false;
    int nM, nN, nwg, G, c; int lda_b; const char* Bt; int K; int esz;
    __device__ void init(int M, int N, int G_, int c_, int lda_bytes, const void* Bt_, int K_, int esz_ = 2) { nM = M / BM; nN = N / BM; nwg = nM * nN; G = G_; c = c_; lda_b = lda_bytes; Bt = (const char*)Bt_; K = K_; esz = esz_; }
    __device__ __forceinline__ bool next(int i, Unit& u) const {
        const long L = (long)i * G + c; if (L >= nwg) return false;
        int wgid = (int)L; { const int q = nwg / NXCD, r = nwg % NXCD, xcd = wgid % NXCD, off = wgid / NXCD; wgid = (xcd < r ? xcd * (q + 1) : r * (q + 1) + (xcd - r) * q) + off; }
        const int nig = WGM * nN, gid = wgid / nig, fm = gid * WGM, gsz = (nM - fm) < WGM ? (nM - fm) : WGM;
        u.pm = fm + ((wgid % nig) % gsz); u.pn = (wgid % nig) / gsz; u.e = 0; return true;
    }
    __device__ __forceinline__ unsigned a_row_off(const Unit& u, int R) const { return (unsigned)(u.pm * BM + R) * (unsigned)lda_b; }
    __device__ __forceinline__ size_t a_unit_base(const Unit& u) const { return (size_t)u.pm * BM * (size_t)lda_b; }
    __device__ __forceinline__ unsigned a_lane_off(int R) const { return (unsigned)R * (unsigned)lda_b; }
    __device__ __forceinline__ const char* b_ptr(const Unit& u) const { return Bt + (size_t)u.pn * BM * K * esz; }
};

template <class Epi, class Sched, bool FP8 = false>
__device__ __forceinline__ void gemm_phase(FX_LAS unsigned char* lds, const char* Abase, const int Kc, const Sched& S, const Epi& E, int tidp) {
    int K_ = Kc; asm volatile("" : "+s"(K_)); const int K = K_;
    int tid_ = tidp; asm volatile("" : "+v"(tid_));
    const int tid = tid_, wid = __builtin_amdgcn_readfirstlane(tid >> 6), lane = tid & 63, wr = wid >> 2, wc = wid & 3, fr = lane & 15, fq = lane >> 4;
    constexpr int ES = FP8 ? 1 : 2;
    const int nt = K * ES / 128;
    int Rr[2], Cc[2]; unsigned voffB[2];
#pragma unroll
    for (int i = 0; i < 2; ++i) { int R, C; stage_rc(tid * 16 + i * 8192, R, C); Rr[i] = R; Cc[i] = C; const int Rb = Epi::PERM ? ((R & ~31) + perm32(R & 31)) : R; voffB[i] = (unsigned)(Rb * K * ES + C * 2); }
    const size_t hstepB = (size_t)HALF * K * ES;
    const unsigned ldsw = (unsigned)wid * 1024u;
    const int aoff = lds_byte(wr * 64 + fr, fq * 8), boff = lds_byte(wc * 32 + fr, fq * 8);
#define FX_SA(b, h) (((b) * 2 + (h)) * HTB)
#define FX_SB(b, h) ((4 + (b) * 2 + (h)) * HTB)
#define FX_STAGE_A(bufoff, o0, o1, kb) do { const char* ap_ = Abase + (kb); \
        __builtin_amdgcn_global_load_lds((const unsigned*)(ap_ + (o0)), (FX_LAS unsigned*)(lds + (bufoff) + ldsw), 16, 0, 0); \
        __builtin_amdgcn_global_load_lds((const unsigned*)(ap_ + (o1)), (FX_LAS unsigned*)(lds + (bufoff) + ldsw + 8192), 16, 0, 0); } while (0)
#define FX_STAGE_B(bufoff, gbase) do { _Pragma("unroll") for (int _i = 0; _i < 2; ++_i) \
        __builtin_amdgcn_global_load_lds((const unsigned*)((const char*)(gbase) + voffB[_i]), (FX_LAS unsigned*)(lds + (bufoff) + ldsw + _i * 8192), 16, 0, 0); } while (0)
#define FX_LDA(dst, b, h) do { _Pragma("unroll") for (int m = 0; m < 4; ++m) _Pragma("unroll") for (int k = 0; k < 2; ++k) dst[m][k] = *(const FX_LAS bf16x8*)(lds + FX_SA(b, h) + aoff + m * 2048 + k * 1024); } while (0)
#define FX_LDB(dst, b, h) do { _Pragma("unroll") for (int n = 0; n < 2; ++n) _Pragma("unroll") for (int k = 0; k < 2; ++k) dst[n][k] = *(const FX_LAS bf16x8*)(lds + FX_SB(b, h) + boff + n * 2048 + k * 1024); } while (0)
#define FX_MMA(ai, bj, At, Bt) do { __builtin_amdgcn_s_setprio(1); _Pragma("unroll") for (int m = 0; m < 4; ++m) _Pragma("unroll") for (int n = 0; n < 2; ++n) { \
        if constexpr (FP8) { const i32x4 a0_ = __builtin_bit_cast(i32x4, At[m][0]), a1_ = __builtin_bit_cast(i32x4, At[m][1]), b0_ = __builtin_bit_cast(i32x4, Bt[n][0]), b1_ = __builtin_bit_cast(i32x4, Bt[n][1]); \
            const i32x8 af_ = __builtin_shufflevector(a0_, a1_, 0, 1, 2, 3, 4, 5, 6, 7), bf_ = __builtin_shufflevector(b0_, b1_, 0, 1, 2, 3, 4, 5, 6, 7); \
            asm volatile("v_mfma_scale_f32_16x16x128_f8f6f4 %0, %1, %2, %0, %3, %3 op_sel_hi:[0,0,0]" : "+v"(acc[ai][bj][m][n]) : "v"(bf_), "v"(af_), "v"(sc1_)); FX_MFMA_DUP(acc[ai][bj][m][n]) } \
        else { _Pragma("unroll") for (int k = 0; k < 2; ++k) acc[ai][bj][m][n] = __builtin_amdgcn_mfma_f32_16x16x32_bf16(Bt[n][k], At[m][k], acc[ai][bj][m][n], 0, 0, 0); } } \
        __builtin_amdgcn_s_setprio(0); } while (0)
#define FX_WAIT_V(n) asm volatile("s_waitcnt vmcnt(" #n ")" ::: "memory")
#define FX_WAIT_L(n) asm volatile("s_waitcnt lgkmcnt(" #n ")" ::: "memory")
#define FX_BAR __builtin_amdgcn_s_barrier()
#define FX_SCHED __builtin_amdgcn_sched_barrier(0)
#ifdef FX_PROBE_MFMA
#define FX_MFMA_DUP(ACC) asm volatile("v_mfma_scale_f32_16x16x128_f8f6f4 %0, %1, %2, %0, %3, %3 op_sel_hi:[0,0,0]" : "+v"(ACC) : "v"(bf_), "v"(af_), "v"(sc0_));
#else
#define FX_MFMA_DUP(ACC)
#endif
    const int sc0_ = 0; (void)sc0_;
    const int sc1_ = 0x7f7f7f7f;
    (void)sc1_;
    Unit cur, nxt; int ui = 0;
    if (!S.next(0, cur)) return;
    f32x4 acc[2][2][4][2];
#pragma unroll
    for (int a = 0; a < 2; ++a)
#pragma unroll
        for (int b = 0; b < 2; ++b)
#pragma unroll
            for (int m = 0; m < 4; ++m)
#pragma unroll
                for (int n = 0; n < 2; ++n) acc[a][b][m][n] = (f32x4){0.f, 0.f, 0.f, 0.f};
    bf16x8 At[4][2], B0[2][2], B1[2][2];
    unsigned c00, c01, c10, c11, n00 = 0, n01 = 0, n10 = 0, n11 = 0;
    size_t ubc = 0, ubn = 0;
    if constexpr (Sched::GATHER) { c00 = S.a_row_off(cur, Rr[0]) + Cc[0] * 2; c01 = S.a_row_off(cur, Rr[1]) + Cc[1] * 2; c10 = S.a_row_off(cur, HALF + Rr[0]) + Cc[0] * 2; c11 = S.a_row_off(cur, HALF + Rr[1]) + Cc[1] * 2; }
    else { c00 = S.a_lane_off(Rr[0]) + Cc[0] * 2; c01 = S.a_lane_off(Rr[1]) + Cc[1] * 2; c10 = c00 + S.a_lane_off(HALF); c11 = c01 + S.a_lane_off(HALF); ubc = S.a_unit_base(cur); n00 = c00; n01 = c01; n10 = c10; n11 = c11; }
    const char* cB = S.b_ptr(cur);
    const unsigned kstep = BK * 2;
    FX_STAGE_B(FX_SB(0, 0), cB); FX_STAGE_A(FX_SA(0, 0), c00, c01, ubc); FX_STAGE_B(FX_SB(0, 1), cB + hstepB); FX_STAGE_A(FX_SA(0, 1), c10, c11, ubc);
    if (wr == 1) FX_BAR;
    FX_WAIT_V(4); FX_BAR;
    FX_STAGE_B(FX_SB(1, 0), cB + kstep); FX_STAGE_A(FX_SA(1, 0), c00, c01, ubc + kstep); FX_STAGE_B(FX_SB(1, 1), cB + hstepB + kstep);
    FX_WAIT_V(6); FX_BAR;
    for (;;) {
        const bool has_next = S.next(ui + 1, nxt);
        if (!has_next) nxt = cur;
        if constexpr (!Sched::GATHER) ubn = S.a_unit_base(nxt);
        const char* nB = S.b_ptr(nxt);
        for (int t = 0; t < nt; t += 2) {
            const bool last = (t == nt - 2);
            asm volatile("" : "+v"(c00), "+v"(c01), "+v"(c10), "+v"(c11), "+v"(voffB[0]), "+v"(voffB[1]));
            if constexpr (Sched::GATHER) { if (last) {
                int t2_ = tid; asm volatile("" : "+v"(t2_)); int R0_, C0_, R1_, C1_; stage_rc(t2_ * 16, R0_, C0_); stage_rc(t2_ * 16 + 8192, R1_, C1_);
                n00 = S.a_row_off(nxt, R0_) + C0_ * 2; n01 = S.a_row_off(nxt, R1_) + C1_ * 2; n10 = S.a_row_off(nxt, HALF + R0_) + C0_ * 2; n11 = S.a_row_off(nxt, HALF + R1_) + C1_ * 2; } }
            const size_t k1 = ubc + (size_t)(t + 1) * kstep;
            const size_t k2 = last ? ubn : ubc + (size_t)(t + 2) * kstep, k3 = k2 + kstep;
            unsigned a00, a01, a10, a11;
            if constexpr (Sched::GATHER) { a00 = last ? n00 : c00; a01 = last ? n01 : c01; a10 = last ? n10 : c10; a11 = last ? n11 : c11; } else { a00 = c00; a01 = c01; a10 = c10; a11 = c11; }
            const char* b2 = last ? nB : cB + (size_t)(t + 2) * kstep; const char* b3 = b2 + kstep;
            FX_LDB(B0, 0, 0); FX_SCHED; FX_LDA(At, 0, 0); FX_STAGE_A(FX_SA(1, 1), c10, c11, k1);
            FX_WAIT_L(8); FX_BAR; FX_WAIT_L(0); FX_MMA(0, 0, At, B0); FX_BAR; FX_SCHED;
            FX_LDB(B1, 0, 1); FX_STAGE_B(FX_SB(0, 0), b2);
            FX_BAR; FX_WAIT_L(0); FX_MMA(0, 1, At, B1); FX_BAR;
            FX_LDA(At, 0, 1); FX_STAGE_A(FX_SA(0, 0), a00, a01, k2);
            FX_BAR; FX_WAIT_L(0); FX_MMA(1, 0, At, B0); FX_BAR; FX_SCHED;
            FX_STAGE_B(FX_SB(0, 1), b2 + hstepB);
            FX_WAIT_V(6); FX_BAR; FX_MMA(1, 1, At, B1); FX_BAR;
            FX_LDB(B0, 1, 0); FX_SCHED; FX_LDA(At, 1, 0); FX_STAGE_A(FX_SA(0, 1), a10, a11, k2);
            FX_WAIT_L(8); FX_BAR; FX_WAIT_L(0); FX_MMA(0, 0, At, B0); FX_BAR; FX_SCHED;
            FX_LDB(B1, 1, 1); FX_STAGE_B(FX_SB(1, 0), b3);
            FX_BAR; FX_WAIT_L(0); FX_MMA(0, 1, At, B1); FX_BAR;
            FX_LDA(At, 1, 1); FX_STAGE_A(FX_SA(1, 0), a00, a01, k3);
            FX_BAR; FX_WAIT_L(0); FX_MMA(1, 0, At, B0); FX_BAR; FX_SCHED;
            FX_STAGE_B(FX_SB(1, 1), b3 + hstepB);
            FX_WAIT_V(6); FX_BAR; FX_MMA(1, 1, At, B1); FX_BAR;
        }
        if constexpr (FP8) asm volatile("s_nop 15\n\ts_nop 15\n\ts_nop 15\n\ts_nop 15" ::: "memory");
        { int fr_e = fr, fq_e = fq; asm volatile("" : "+v"(fr_e), "+v"(fq_e)); E(acc, cur, wr, wc, fr_e, fq_e); }
        if (!has_next) break;
#pragma unroll
        for (int a = 0; a < 2; ++a)
#pragma unroll
            for (int b = 0; b < 2; ++b)
#pragma unroll
                for (int m = 0; m < 4; ++m)
#pragma unroll
                    for (int n = 0; n < 2; ++n) acc[a][b][m][n] = (f32x4){0.f, 0.f, 0.f, 0.f};
        cur = nxt; cB = nB; if constexpr (Sched::GATHER) { c00 = n00; c01 = n01; c10 = n10; c11 = n11; } else ubc = ubn; ++ui;
    }
    FX_WAIT_V(0);
    if (wr == 0) FX_BAR;
    FX_BAR;
}

struct EpiBf16 {
    static constexpr bool PERM = true;
    bf16_t* O; float* gates; int ldc; float scale;
    __device__ __forceinline__ void operator()(const f32x4 (&acc)[2][2][4][2], const Unit& u, int wr, int wc, int fr, int fq) const {
        const int row0 = u.pm * BM + wr * 64 + fr, col0 = u.pn * BM + wc * 32 + 8 * fq;
#pragma unroll
        for (int ai = 0; ai < 2; ++ai)
#pragma unroll
            for (int m = 0; m < 4; ++m) { const int row = row0 + ai * HALF + m * 16; bf16_t* rowp = O + (size_t)row * ldc + col0;
#pragma unroll
                for (int bj = 0; bj < 2; ++bj) { const f32x4 v0 = acc[ai][bj][m][0] * scale, v1 = acc[ai][bj][m][1] * scale;
                    u32x4 w; w.x = cvt_pk_bf16(v0[0], v0[1]); w.y = cvt_pk_bf16(v0[2], v0[3]); w.z = cvt_pk_bf16(v1[0], v1[1]); w.w = cvt_pk_bf16(v1[2], v1[3]);
                    *(u32x4*)(rowp + bj * HALF) = w; }
                if (gates && u.pn == 15 && wc == 2 && fq < 2) { float* g = gates + (size_t)row * 16 + 8 * fq; *(f32x4*)g = acc[ai][1][m][0] * scale; *(f32x4*)(g + 4) = acc[ai][1][m][1] * scale; } }
    }
};
}
namespace fx {
constexpr int RT = 16;
constexpr int H2S_LD = 2052;
constexpr int P7_LDS = RT * H2S_LD * 4 + 512;
constexpr int PTOT = 131072;
constexpr int NTILE_MAX = PTOT / 256;

__device__ __forceinline__ void coef_phase(const float* mod, const float* pre_mix_gain, const float* post_mix_gain, const float* pre_ffn_gain, const float* post_ffn_gain, float* coef, int gtid, int nthr) {
    for (int i = gtid; i < 2 * 4 * 2048; i += nthr) { const int d = i & 2047, b = (i >> 11) & 3, l = i >> 13;
        const float* m = mod + ((size_t)l * 4 + b) * 12288; float* c = coef + ((size_t)l * 4 + b) * 6 * 2048;
        c[0 * 2048 + d] = m[2 * 2048 + d] * post_mix_gain[l * 2048 + d];
        c[1 * 2048 + d] = pre_ffn_gain[l * 2048 + d] * (1.f + m[4 * 2048 + d]);
        c[2 * 2048 + d] = m[3 * 2048 + d];
        c[3 * 2048 + d] = m[5 * 2048 + d] * post_ffn_gain[l * 2048 + d];
        c[4 * 2048 + d] = pre_mix_gain[l * 2048 + d] * (1.f + m[1 * 2048 + d]);
        c[5 * 2048 + d] = m[0 * 2048 + d]; }
}

template <bool XBF>
__device__ __forceinline__ void p7_phase(FX_LAS unsigned char* lds, const void* xin_, const bf16_t* Y, const float* coef_l  , const float* router_w, const float* router_bias,
                                         bf16_t* XRES, unsigned char* HA8, int* SELE, float* SELG, int* CNT, int* WGBASE, int wg, int nwg, int tidp) {
    int tid_ = tidp; asm volatile("" : "+v"(tid_));
    const int tid = tid_, wid = tid >> 6, lane = tid & 63;
    FX_LAS float* h2s = (FX_LAS float*)lds;
    FX_LAS int* hist = (FX_LAS int*)(lds + RT * H2S_LD * 4);
    if (tid < 64) hist[tid] = 0;
    __syncthreads();
    for (int unit = wg; unit < T / RT; unit += nwg) {
#pragma unroll 1
        for (int tt = 0; tt < 2; ++tt) {
            const int tok = 2 * wid + tt, t = unit * RT + tok, b = t / S;
            const float* cf = coef_l + (size_t)b * 6 * 2048;
            float xv[32]; float yv[32]; float ssy = 0.f;
#pragma unroll
            for (int i = 0; i < 4; ++i) { const int c = i * 512 + lane * 8;
                const u32x4 yw = *(const u32x4*)(Y + (size_t)t * 2048 + c);
                yv[i * 8 + 0] = bflo(yw.x); yv[i * 8 + 1] = bfhi(yw.x); yv[i * 8 + 2] = bflo(yw.y); yv[i * 8 + 3] = bfhi(yw.y); yv[i * 8 + 4] = bflo(yw.z); yv[i * 8 + 5] = bfhi(yw.z); yv[i * 8 + 6] = bflo(yw.w); yv[i * 8 + 7] = bfhi(yw.w);
                if constexpr (XBF) { const u32x4 xw = *(const u32x4*)((const bf16_t*)xin_ + (size_t)t * 2048 + c);
                    xv[i * 8 + 0] = bflo(xw.x); xv[i * 8 + 1] = bfhi(xw.x); xv[i * 8 + 2] = bflo(xw.y); xv[i * 8 + 3] = bfhi(xw.y); xv[i * 8 + 4] = bflo(xw.z); xv[i * 8 + 5] = bfhi(xw.z); xv[i * 8 + 6] = bflo(xw.w); xv[i * 8 + 7] = bfhi(xw.w); }
                else { const float* xin = (const float*)xin_; const f32x4 x0 = *(const f32x4*)(xin + (size_t)t * 2048 + c), x1 = *(const f32x4*)(xin + (size_t)t * 2048 + c + 4);
                    xv[i * 8 + 0] = x0[0]; xv[i * 8 + 1] = x0[1]; xv[i * 8 + 2] = x0[2]; xv[i * 8 + 3] = x0[3]; xv[i * 8 + 4] = x1[0]; xv[i * 8 + 5] = x1[1]; xv[i * 8 + 6] = x1[2]; xv[i * 8 + 7] = x1[3]; }
#pragma unroll
                for (int j = 0; j < 8; ++j) ssy += yv[i * 8 + j] * yv[i * 8 + j]; }
            ssy = wave_sum(ssy);
            const float ry = rsqrtf(ssy * (1.f / 2048.f) + EPS); float ssx = 0.f;
#pragma unroll
            for (int i = 0; i < 4; ++i) { const int c = i * 512 + lane * 8;
                const f32x4 a0 = *(const f32x4*)(cf + c), a1 = *(const f32x4*)(cf + c + 4);
#pragma unroll
                for (int j = 0; j < 4; ++j) { xv[i * 8 + j] += a0[j] * (yv[i * 8 + j] * ry); xv[i * 8 + 4 + j] += a1[j] * (yv[i * 8 + 4 + j] * ry); }
#pragma unroll
                for (int j = 0; j < 8; ++j) ssx += xv[i * 8 + j] * xv[i * 8 + j];
                { u32x4 xo; xo.x = cvt_pk_bf16(xv[i * 8 + 0], xv[i * 8 + 1]); xo.y = cvt_pk_bf16(xv[i * 8 + 2], xv[i * 8 + 3]); xo.z = cvt_pk_bf16(xv[i * 8 + 4], xv[i * 8 + 5]); xo.w = cvt_pk_bf16(xv[i * 8 + 6], xv[i * 8 + 7]);
                  *(u32x4*)(XRES + (size_t)t * 2048 + c) = xo; } }
            ssx = wave_sum(ssx);
            const float rx = rsqrtf(ssx * (1.f / 2048.f) + EPS);
#pragma unroll
            for (int i = 0; i < 4; ++i) { const int c = i * 512 + lane * 8;
                const f32x4 b0 = *(const f32x4*)(cf + 2048 + c), b1 = *(const f32x4*)(cf + 2048 + c + 4), c0 = *(const f32x4*)(cf + 4096 + c), c1 = *(const f32x4*)(cf + 4096 + c + 4);
                float hv[8];
#pragma unroll
                for (int j = 0; j < 4; ++j) { hv[j] = xv[i * 8 + j] * rx * b0[j] + c0[j]; hv[4 + j] = xv[i * 8 + 4 + j] * rx * b1[j] + c1[j]; }
                u32x2 w; w.x = cvt_pk4_fp8(hv[0], hv[1], hv[2], hv[3]); w.y = cvt_pk4_fp8(hv[4], hv[5], hv[6], hv[7]);
                *(u32x2*)(HA8 + (size_t)t * 2048 + c) = w;
                *(FX_LAS f32x4*)(h2s + tok * H2S_LD + c) = (f32x4){hv[0], hv[1], hv[2], hv[3]};
                *(FX_LAS f32x4*)(h2s + tok * H2S_LD + c + 4) = (f32x4){hv[4], hv[5], hv[6], hv[7]}; }
        }
        __syncthreads();
        f32x4 acc[4];
#pragma unroll
        for (int j = 0; j < 4; ++j) acc[j] = (f32x4){0.f, 0.f, 0.f, 0.f};
        { const int i16 = lane & 15, g = lane >> 4;
#pragma unroll 4
          for (int ks = 0; ks < 64; ++ks) { const int k = 256 * wid + 4 * ks + g;
            const float a = h2s[i16 * H2S_LD + k];
            const f32x4 bw = *(const f32x4*)(router_w + (size_t)k * 64 + 4 * i16);
            acc[0] = __builtin_amdgcn_mfma_f32_16x16x4f32(a, bw[0], acc[0], 0, 0, 0);
            acc[1] = __builtin_amdgcn_mfma_f32_16x16x4f32(a, bw[1], acc[1], 0, 0, 0);
            acc[2] = __builtin_amdgcn_mfma_f32_16x16x4f32(a, bw[2], acc[2], 0, 0, 0);
            acc[3] = __builtin_amdgcn_mfma_f32_16x16x4f32(a, bw[3], acc[3], 0, 0, 0); } }
        __syncthreads();
        { FX_LAS float* part = h2s; const int i16 = lane & 15, g = lane >> 4;
#pragma unroll
          for (int j = 0; j < 4; ++j)
#pragma unroll
            for (int r = 0; r < 4; ++r) part[(wid * 16 + 4 * g + r) * 64 + 4 * i16 + j] = acc[j][r]; }
        __syncthreads();
#pragma unroll 1
        for (int tt = 0; tt < 2; ++tt) {
            const int tok = 2 * wid + tt, t = unit * RT + tok;
            float lg = 0.f;
#pragma unroll
            for (int w = 0; w < 8; ++w) lg += h2s[(w * 16 + tok) * 64 + lane];
            const float score = 1.f / (1.f + expf(-lg));
            float v = score + router_bias[lane];
            int my_e = 0; float my_s = 0.f, sum = 0.f;
#pragma unroll
            for (int k = 0; k < 6; ++k) {
                const float m = wave_max(v);
                const unsigned long long bal = __ballot(v == m);
                const int win = __ffsll((long long)bal) - 1;
                const float sw = __shfl(score, win);
                sum += sw; if (lane == k) { my_e = win; my_s = sw; }
                if (lane == win) v = -3.0e38f;
            }
            if (lane < 6) { SELE[(size_t)t * 6 + lane] = my_e; SELG[(size_t)t * 6 + lane] = my_s / sum * 2.5f; __hip_atomic_fetch_add(hist + my_e, 1, __ATOMIC_RELAXED, __HIP_MEMORY_SCOPE_WORKGROUP); }
        }
        __syncthreads();
    }
    if (tid < 64) { const int hv = hist[tid]; const int base = atomicAdd(CNT + tid, hv); WGBASE[wg * 64 + tid] = base; }
}

__device__ __forceinline__ void p8_phase(FX_LAS unsigned char* lds, const int* SELE, const float* SELG, const int* CNT, const int* WGBASE, int* ROWTOK, float* ROWG, int* SLOT, int wg, int nwg, int tidp) {
    int tid_ = tidp; asm volatile("" : "+v"(tid_));
    const int tid = tid_;
    FX_LAS int* pstart = (FX_LAS int*)lds; FX_LAS int* off = pstart + 80;
    if (tid < 64) { const int pc = (CNT[tid] + 255) & ~255; int incl = pc;
#pragma unroll
        for (int o = 1; o < 64; o <<= 1) { const int t2 = __shfl_up(incl, o); if (tid >= o) incl += t2; }
        pstart[tid] = 16384 + incl - pc; if (tid == 63) pstart[64] = 16384 + incl; }
    __syncthreads();
    if (tid < 64) off[tid] = pstart[tid] + WGBASE[wg * 64 + tid];
    __syncthreads();
    for (int unit = wg; unit < T / RT; unit += nwg) {
        if (tid < RT * 6) { const int t = unit * RT + tid / 6, k = tid % 6; const int e = SELE[(size_t)t * 6 + k];
            const int pos = __hip_atomic_fetch_add(off + e, 1, __ATOMIC_RELAXED, __HIP_MEMORY_SCOPE_WORKGROUP);
            ROWTOK[pos] = t; ROWG[pos] = SELG[(size_t)t * 6 + k]; SLOT[(size_t)t * 6 + k] = pos; }
    }
    for (int e = wg; e < 64; e += nwg) { const int a = pstart[e] + CNT[e], b = pstart[e + 1]; for (int r = a + tid; r < b; r += 512) { ROWTOK[r] = 0; ROWG[r] = 0.f; } }
    for (int r = wg * 512 + tid; r < 16384; r += nwg * 512) { ROWTOK[r] = r; ROWG[r] = 1.f; }
}

struct MoeSched {
    static constexpr bool GATHER = true;
    FX_LAS const unsigned char* tile_e; int ntiles, npn, nunits, G, c;
    const int* rowtok; int lda_b; const char* Bt; size_t estride_b, pnstride_b;
    __device__ __forceinline__ bool next(int i, Unit& u) const {
        const long L = (long)i * G + c; if (L >= nunits) return false;
        int id = (int)L; { const int q = nunits / NXCD, r = nunits % NXCD, xcd = id % NXCD, off = id / NXCD; id = (xcd < r ? xcd * (q + 1) : r * (q + 1) + (xcd - r) * q) + off; }
        u.pm = id / npn; u.pn = id - u.pm * npn; u.e = tile_e[u.pm]; return true;
    }
    __device__ __forceinline__ unsigned a_row_off(const Unit& u, int R) const { const int row = u.pm * BM + R; return (unsigned)(rowtok ? rowtok[row] : row) * (unsigned)lda_b; }
    __device__ __forceinline__ const char* b_ptr(const Unit& u) const { return Bt + (size_t)u.e * estride_b + (size_t)u.pn * pnstride_b; }
};
__device__ __forceinline__ int moe_sched_build(FX_LAS unsigned char* tab, const int* CNT, int tidp) {
    FX_LAS int* nt = (FX_LAS int*)(tab + 512);
    int tid_ = tidp; asm volatile("" : "+v"(tid_));
    if (tid_ < 64) { const int n = (CNT[tid_] + 255) >> 8; int incl = n;
#pragma unroll
        for (int o = 1; o < 64; o <<= 1) { const int t2 = __shfl_up(incl, o); if (tid_ >= o) incl += t2; }
        const int st0 = 64 + incl - n; for (int j = 0; j < n; ++j) tab[st0 + j] = (unsigned char)tid_;
        tab[tid_] = 64; if (tid_ == 63) nt[0] = 64 + incl; }
    __syncthreads();
    return nt[0];
}
struct EpiGateUp {
    static constexpr bool PERM = true;
    unsigned char* HID;
    __device__ __forceinline__ void operator()(const f32x4 (&acc)[2][2][4][2], const Unit& u, int wr, int wc, int fr, int fq) const {
        const int row0 = u.pm * BM + wr * 64 + fr, col0 = u.pn * 128 + wc * 32 + 8 * fq;
#pragma unroll
        for (int ai = 0; ai < 2; ++ai)
#pragma unroll
            for (int m = 0; m < 4; ++m) { const int row = row0 + ai * HALF + m * 16;
                float o[8];
#pragma unroll
                for (int n = 0; n < 2; ++n)
#pragma unroll
                    for (int j = 0; j < 4; ++j) { const float g = acc[ai][0][m][n][j] * W8_INV, up = acc[ai][1][m][n][j] * W8_INV; o[n * 4 + j] = g / (1.f + __expf(-g)) * up; }
                u32x2 w; w.x = cvt_pk4_fp8(o[0], o[1], o[2], o[3]); w.y = cvt_pk4_fp8(o[4], o[5], o[6], o[7]);
                *(u32x2*)(HID + (size_t)row * 512 + col0) = w; }
    }
};
struct EpiDown {
    static constexpr bool PERM = true;
    unsigned char* YR; const float* ROWG;
    __device__ __forceinline__ void operator()(const f32x4 (&acc)[2][2][4][2], const Unit& u, int wr, int wc, int fr, int fq) const {
        const int row0 = u.pm * BM + wr * 64 + fr, col0 = u.pn * BM + wc * 32 + 8 * fq;
#pragma unroll
        for (int ai = 0; ai < 2; ++ai)
#pragma unroll
            for (int m = 0; m < 4; ++m) { const int row = row0 + ai * HALF + m * 16; const float g = ROWG[row] * W8_INV; unsigned char* rowp = YR + (size_t)row * 2048 + col0;
#pragma unroll
                for (int bj = 0; bj < 2; ++bj) { const f32x4 v0 = acc[ai][bj][m][0] * g, v1 = acc[ai][bj][m][1] * g;
                    u32x2 w; w.x = cvt_pk4_fp8(v0[0], v0[1], v0[2], v0[3]); w.y = cvt_pk4_fp8(v1[0], v1[1], v1[2], v1[3]);
                    *(u32x2*)(rowp + bj * HALF) = w; } }
    }
};
__device__ __forceinline__ void p9_phase(FX_LAS unsigned char* lds, const unsigned char* HA, const unsigned char* WGU, const int* CNT, const int* ROWTOK, unsigned char* HID, int wg, int nwg, int tidp) {
    FX_LAS unsigned char* tab = lds + STAGE_BYTES;
    const int ntiles = moe_sched_build(tab, CNT, tidp);
    MoeSched Sc; Sc.tile_e = tab; Sc.ntiles = ntiles; Sc.npn = 4; Sc.nunits = ntiles * 4; Sc.G = nwg; Sc.c = wg; Sc.rowtok = ROWTOK; Sc.lda_b = 2048; Sc.Bt = (const char*)WGU; Sc.estride_b = (size_t)1024 * 2048; Sc.pnstride_b = (size_t)256 * 2048;
    EpiGateUp E; E.HID = HID;
    gemm_phase<EpiGateUp, MoeSched, true>(lds, (const char*)HA, 2048, Sc, E, tidp);
}
__device__ __forceinline__ void p10_phase(FX_LAS unsigned char* lds, const unsigned char* HID, const unsigned char* WDN, const int* CNT, const float* ROWG, unsigned char* YR, int wg, int nwg, int tidp) {
    FX_LAS unsigned char* tab = lds + STAGE_BYTES;
    const int ntiles = moe_sched_build(tab, CNT, tidp);
    MoeSched Sc; Sc.tile_e = tab; Sc.ntiles = ntiles; Sc.npn = 8; Sc.nunits = ntiles * 8; Sc.G = nwg; Sc.c = wg; Sc.rowtok = nullptr; Sc.lda_b = 512; Sc.Bt = (const char*)WDN; Sc.estride_b = (size_t)2048 * 512; Sc.pnstride_b = (size_t)256 * 512;
    EpiDown E; E.YR = YR; E.ROWG = ROWG;
    gemm_phase<EpiDown, MoeSched, true>(lds, (const char*)HID, 512, Sc, E, tidp);
}
template <bool OUTF32>
__device__ __forceinline__ void p11_phase(const bf16_t* x1, const unsigned char* YR, const int* SLOT, const float* coef_l, const float* coef_next  , void* xout_, bf16_t* HA, int wg, int nwg, int tidp) {
    int tid_ = tidp; asm volatile("" : "+v"(tid_));
    const int wid = tid_ >> 6, lane = tid_ & 63;
    for (int t = wg * 8 + wid; t < T; t += nwg * 8) {
        const int b = t / S; const float* cf = coef_l + (size_t)b * 6 * 2048;
        int rows[7]; rows[0] = t;
#pragma unroll
        for (int k = 0; k < 6; ++k) rows[k + 1] = SLOT[(size_t)t * 6 + k];
        float yv[32];
#pragma unroll
        for (int j = 0; j < 32; ++j) yv[j] = 0.f;
#pragma unroll
        for (int k = 0; k < 7; ++k) {
            if (k == 4) asm volatile("" ::: "memory");
#pragma unroll
            for (int i = 0; i < 4; ++i) { const u32x2 w = *(const u32x2*)(YR + (size_t)rows[k] * 2048 + i * 512 + lane * 8);
                const f32x2 a0 = __builtin_amdgcn_cvt_pk_f32_fp8((int)w.x, false), a1 = __builtin_amdgcn_cvt_pk_f32_fp8((int)w.x, true), a2 = __builtin_amdgcn_cvt_pk_f32_fp8((int)w.y, false), a3 = __builtin_amdgcn_cvt_pk_f32_fp8((int)w.y, true);
                yv[i * 8 + 0] += a0[0]; yv[i * 8 + 1] += a0[1]; yv[i * 8 + 2] += a1[0]; yv[i * 8 + 3] += a1[1]; yv[i * 8 + 4] += a2[0]; yv[i * 8 + 5] += a2[1]; yv[i * 8 + 6] += a3[0]; yv[i * 8 + 7] += a3[1]; } }
        float ss = 0.f;
#pragma unroll
        for (int j = 0; j < 32; ++j) ss += yv[j] * yv[j];
        ss = wave_sum(ss); const float ry = rsqrtf(ss * (1.f / 2048.f) + EPS); float ssx = 0.f;
#pragma unroll
        for (int i = 0; i < 4; ++i) { const int c = i * 512 + lane * 8;
            const f32x4 d0 = *(const f32x4*)(cf + 3 * 2048 + c), d1 = *(const f32x4*)(cf + 3 * 2048 + c + 4);
            const u32x4 xw = *(const u32x4*)(x1 + (size_t)t * 2048 + c); const f32x4 x0 = {bflo(xw.x), bfhi(xw.x), bflo(xw.y), bfhi(xw.y)}, x1v = {bflo(xw.z), bfhi(xw.z), bflo(xw.w), bfhi(xw.w)};
#pragma unroll
            for (int j = 0; j < 4; ++j) { yv[i * 8 + j] = x0[j] + d0[j] * (yv[i * 8 + j] * ry); yv[i * 8 + 4 + j] = x1v[j] + d1[j] * (yv[i * 8 + 4 + j] * ry); }
#pragma unroll
            for (int j = 0; j < 8; ++j) ssx += yv[i * 8 + j] * yv[i * 8 + j];
            if constexpr (OUTF32) { float* xout = (float*)xout_; *(f32x4*)(xout + (size_t)t * 2048 + c) = (f32x4){yv[i * 8 + 0], yv[i * 8 + 1], yv[i * 8 + 2], yv[i * 8 + 3]};
                *(f32x4*)(xout + (size_t)t * 2048 + c + 4) = (f32x4){yv[i * 8 + 4], yv[i * 8 + 5], yv[i * 8 + 6], yv[i * 8 + 7]}; }
            else { u32x4 xo; xo.x = cvt_pk_bf16(yv[i * 8 + 0], yv[i * 8 + 1]); xo.y = cvt_pk_bf16(yv[i * 8 + 2], yv[i * 8 + 3]); xo.z = cvt_pk_bf16(yv[i * 8 + 4], yv[i * 8 + 5]); xo.w = cvt_pk_bf16(yv[i * 8 + 6], yv[i * 8 + 7]);
                *(u32x4*)((bf16_t*)xout_ + (size_t)t * 2048 + c) = xo; } }
        if (coef_next) { const float* cn = coef_next + (size_t)b * 6 * 2048; ssx = wave_sum(ssx); const float rx = rsqrtf(ssx * (1.f / 2048.f) + EPS);
#pragma unroll
            for (int i = 0; i < 4; ++i) { const int c = i * 512 + lane * 8;
                const f32x4 e0 = *(const f32x4*)(cn + 4 * 2048 + c), e1 = *(const f32x4*)(cn + 4 * 2048 + c + 4), f0 = *(const f32x4*)(cn + 5 * 2048 + c), f1 = *(const f32x4*)(cn + 5 * 2048 + c + 4);
                float hv[8];
#pragma unroll
                for (int j = 0; j < 4; ++j) { hv[j] = yv[i * 8 + j] * rx * e0[j] + f0[j]; hv[4 + j] = yv[i * 8 + 4 + j] * rx * e1[j] + f1[j]; }
#ifdef FX_WIN8
                u32x2 w; w.x = cvt_pk4_fp8(hv[0], hv[1], hv[2], hv[3]); w.y = cvt_pk4_fp8(hv[4], hv[5], hv[6], hv[7]);
                *(u32x2*)((unsigned char*)HA + (size_t)t * 2048 + c) = w; } }
#else
                u32x4 w; w.x = cvt_pk_bf16(hv[0], hv[1]); w.y = cvt_pk_bf16(hv[2], hv[3]); w.z = cvt_pk_bf16(hv[4], hv[5]); w.w = cvt_pk_bf16(hv[6], hv[7]);
                *(u32x4*)(HA + (size_t)t * 2048 + c) = w; } }
#endif
    }
}
}
namespace fx {
#ifndef FX_SD_A
#define FX_SD_A 2
#endif
#ifndef FX_SD_B
#define FX_SD_B 1
#endif
#ifndef FX_NQR_B
#define FX_NQR_B 8
#endif
#define FX_SBAR() __builtin_amdgcn_sched_barrier(0)
__device__ __forceinline__ int crow(int r, int hi) { return (r & 3) + 8 * (r >> 2) + 4 * hi; }
__device__ __forceinline__ int v_st(int k, int c) { const int kk = (k & ~0xC) | ((k & 4) << 1) | ((k & 8) >> 1); return ((kk >> 3) * 4 + (c >> 5)) * 512 + ((kk & 7) * 32 + (c & 31)) * 2; }
__device__ __forceinline__ int v_rd_base(int lane) { return ((lane & 3) << 3) | (((lane >> 2) & 3) << 6) | (((lane >> 4) & 1) << 5) | (((lane >> 5) & 1) << 8); }
constexpr int v_rd_off(int d0, int ks, int half) { return d0 * 512 + ks * 4096 + half * 2048; }
template <int OFF> __device__ __forceinline__ s16x4 tr_read(int vb) { s16x4 r; asm volatile("ds_read_b64_tr_b16 %0, %1 offset:%2" : "=&v"(r) : "v"(vb), "i"(OFF) : "memory"); return r; }
#define FX_PK(L, H) (bf16x8){L[0], L[1], L[2], L[3], H[0], H[1], H[2], H[3]}
template <int D0> __device__ __forceinline__ void pv_one(f32x16& od, int vb, bf16x8 pa0, bf16x8 pa1, bf16x8 pa2, bf16x8 pa3) {
    const s16x4 l0 = tr_read<v_rd_off(D0, 0, 0)>(vb), h0 = tr_read<v_rd_off(D0, 0, 1)>(vb), l1 = tr_read<v_rd_off(D0, 1, 0)>(vb), h1 = tr_read<v_rd_off(D0, 1, 1)>(vb);
    const s16x4 l2 = tr_read<v_rd_off(D0, 2, 0)>(vb), h2 = tr_read<v_rd_off(D0, 2, 1)>(vb), l3 = tr_read<v_rd_off(D0, 3, 0)>(vb), h3 = tr_read<v_rd_off(D0, 3, 1)>(vb);
    asm volatile("s_waitcnt lgkmcnt(0)" ::: "memory"); FX_SBAR();
    od = __builtin_amdgcn_mfma_f32_32x32x16_bf16(pa0, FX_PK(l0, h0), od, 0, 0, 0);
    od = __builtin_amdgcn_mfma_f32_32x32x16_bf16(pa1, FX_PK(l1, h1), od, 0, 0, 0);
    od = __builtin_amdgcn_mfma_f32_32x32x16_bf16(pa2, FX_PK(l2, h2), od, 0, 0, 0);
    od = __builtin_amdgcn_mfma_f32_32x32x16_bf16(pa3, FX_PK(l3, h3), od, 0, 0, 0);
}
__device__ __forceinline__ void pv_d0(f32x16* o, int vb, bf16x8 pa0, bf16x8 pa1, bf16x8 pa2, bf16x8 pa3) {
    pv_one<0>(o[0], vb, pa0, pa1, pa2, pa3); pv_one<1>(o[1], vb, pa0, pa1, pa2, pa3); pv_one<2>(o[2], vb, pa0, pa1, pa2, pa3); pv_one<3>(o[3], vb, pa0, pa1, pa2, pa3);
}
#define FX_PK4(P, BASE, OUT) do { unsigned a0 = cvt_pk_bf16(P[BASE + 0], P[BASE + 1]), a1 = cvt_pk_bf16(P[BASE + 2], P[BASE + 3]);   \
    unsigned b0 = cvt_pk_bf16(P[BASE + 4], P[BASE + 5]), b1 = cvt_pk_bf16(P[BASE + 6], P[BASE + 7]);                              \
    auto r0 = __builtin_amdgcn_permlane32_swap(a0, b0, false, false); auto r1 = __builtin_amdgcn_permlane32_swap(a1, b1, false, false); \
    u32x4 w = {r0[0], r1[0], r0[1], r1[1]}; OUT = *reinterpret_cast<bf16x8*>(&w); } while (0)

template <int DQK> struct AttnC {
    static constexpr int NQ = DQK / 16, KROW = DQK * 2, SHM_V = 64 * 128 * 2, SHM_K = 64 * DQK * 2, NQR = (DQK == 128 ? 8 : FX_NQR_B)  , QX = (NQ - NQR) * 8 * 64 * 16, SHM = 2 * SHM_V + 2 * SHM_K + 8 * 64 * 4 + QX;
    static constexpr float SCALE = DQK == 128 ? 0.088388347648318440f : 0.072168783648703220f;
    static constexpr float THR = 8.f;
};
#define FX_KSWZ(row, colB) ((row) * C::KROW + ((colB) ^ (((row) & 7) << 4)))

template <int DQK> __device__ __forceinline__ void partialSM(f32x16& p0, f32x16& p1, float& m_reg, float& mn, float& alpha) {
    using C = AttnC<DQK>;
    constexpr float Cc = C::SCALE * 1.4426950408889634f;
    float pmax = p0[0];
#pragma unroll
    for (int r = 1; r < 16; ++r) pmax = fmaxf(pmax, p0[r]);
#pragma unroll
    for (int r = 0; r < 16; ++r) pmax = fmaxf(pmax, p1[r]);
    { auto rr = __builtin_amdgcn_permlane32_swap(__float_as_uint(pmax), __float_as_uint(pmax), false, false); pmax = fmaxf(__uint_as_float(rr[0]), __uint_as_float(rr[1])); }
    if (__builtin_expect(__all(pmax - m_reg <= C::THR / C::SCALE), 1)) { mn = m_reg; alpha = 1.f; }
    else { mn = fmaxf(m_reg, pmax); alpha = __builtin_amdgcn_exp2f((m_reg - mn) * Cc); m_reg = mn; }
    const float mnC = -mn * Cc;
#pragma unroll
    for (int r = 0; r < 16; ++r) p0[r] = fmaf(p0[r], Cc, mnC);
#pragma unroll
    for (int r = 0; r < 16; ++r) p1[r] = fmaf(p1[r], Cc, mnC);
#pragma unroll
    for (int r = 0; r < 16; ++r) p0[r] = __builtin_amdgcn_exp2f(p0[r]);
}
__device__ __forceinline__ void finishSM(f32x16& p0, f32x16& p1, float alpha, float& l_reg, bf16x8& pa0, bf16x8& pa1, bf16x8& pa2, bf16x8& pa3) {
#pragma unroll
    for (int r = 0; r < 16; ++r) p1[r] = __builtin_amdgcn_exp2f(p1[r]);
    float ps = 0;
#pragma unroll
    for (int r = 0; r < 16; ++r) ps += p0[r];
#pragma unroll
    for (int r = 0; r < 16; ++r) ps += p1[r];
    { auto rr = __builtin_amdgcn_permlane32_swap(__float_as_uint(ps), __float_as_uint(ps), false, false); ps = __uint_as_float(rr[0]) + __uint_as_float(rr[1]); }
    l_reg = l_reg * alpha + ps;
    FX_PK4(p0, 0, pa0); FX_PK4(p0, 8, pa1); FX_PK4(p1, 0, pa2); FX_PK4(p1, 8, pa3);
}
template <int DQK> __device__ __forceinline__ void qkt(f32x16& p0, f32x16& p1, const char* Ks, const bf16x8* qr, const char* qx  , int r32, int hi) {
    using C = AttnC<DQK>;
    p0 = f32x16{}; p1 = f32x16{};
#pragma unroll
    for (int d0 = 0; d0 < C::NQ; ++d0) { const int cb = (d0 * 16 + hi * 8) * 2;
        const bf16x8 qf = d0 < C::NQR ? qr[d0 < C::NQR ? d0 : 0] : *reinterpret_cast<const bf16x8*>(qx + (d0 - C::NQR) * 1024);
        const bf16x8 b0 = *reinterpret_cast<const bf16x8*>(Ks + FX_KSWZ(r32, cb));
        const bf16x8 b1 = *reinterpret_cast<const bf16x8*>(Ks + FX_KSWZ(32 + r32, cb));
        p0 = __builtin_amdgcn_mfma_f32_32x32x16_bf16(b0, qf, p0, 0, 0, 0);
        p1 = __builtin_amdgcn_mfma_f32_32x32x16_bf16(b1, qf, p1, 0, 0, 0); }
}

template <int DQK, int SD, int LDQ, int LDK1, int LDK2, int LDV>
__device__ __forceinline__ void attn_unit(const bf16_t* __restrict__ Qb, const bf16_t* __restrict__ K1, const bf16_t* __restrict__ K2, const bf16_t* __restrict__ Vh,
                                          bf16_t* __restrict__ Ob, const float* __restrict__ gain, int seq, char* lds, int tidp) {
    using C = AttnC<DQK>;
    int tid_ = tidp; asm volatile("" : "+v"(tid_));
    const int tid = tid_, wid = tid >> 6, lane = tid & 63, r32 = lane & 31, hi = lane >> 5;
    char* V_lds = lds; char* K_lds = lds + 2 * C::SHM_V;
    float* ws = (float*)(lds + 2 * C::SHM_V + 2 * C::SHM_K) + wid * 64; float* li_l = ws; float* al_l = ws + 32;
    float m_reg = -1e30f, l_reg = 0; f32x16 o[4] = {}; bf16x8 qr[C::NQR];
    char* qx = lds + 2 * C::SHM_V + 2 * C::SHM_K + 8 * 64 * 4 + wid * ((C::NQ - C::NQR) * 1024) + lane * 16;
    const bf16_t* Qw = Qb + (long)(wid * 32 + r32) * LDQ + hi * 8;
#pragma unroll
    for (int d0 = 0; d0 < C::NQR; ++d0) qr[d0] = *reinterpret_cast<const bf16x8*>(Qw + d0 * 16);
#pragma unroll
    for (int d0 = C::NQR; d0 < C::NQ; ++d0) *reinterpret_cast<bf16x8*>(qx + (d0 - C::NQR) * 1024) = *reinterpret_cast<const bf16x8*>(Qw + d0 * 16);
    const int sr = tid >> 4, sc = (tid & 15) * 8, vst0 = v_st(sr, sc), vst1 = v_st(32 + sr, sc);
    const int vb0 = (int)(uintptr_t)V_lds + v_rd_base(lane);
    const int xr = tid >> 3, xc = (tid & 7) * 8;
    struct { bf16x8 vs0, vs1, ks0, ks1, kx; } sr_[SD];
#define FX_SLOAD(i, k0) do { sr_[i].vs0 = *reinterpret_cast<const bf16x8*>(&Vh[(long)((k0) + sr) * LDV + sc]); sr_[i].vs1 = *reinterpret_cast<const bf16x8*>(&Vh[(long)((k0) + 32 + sr) * LDV + sc]); \
    sr_[i].ks0 = *reinterpret_cast<const bf16x8*>(&K1[(long)((k0) + sr) * LDK1 + sc]); sr_[i].ks1 = *reinterpret_cast<const bf16x8*>(&K1[(long)((k0) + 32 + sr) * LDK1 + sc]); \
    if (DQK == 192) sr_[i].kx = *reinterpret_cast<const bf16x8*>(&K2[(long)((k0) + xr) * LDK2 + xc]); } while (0)
#define FX_SWRITE(b, i) do { *(bf16x8*)(V_lds + (b) * C::SHM_V + vst0) = sr_[i].vs0; *(bf16x8*)(V_lds + (b) * C::SHM_V + vst1) = sr_[i].vs1; const int kc = sc * 2; \
    *(bf16x8*)(K_lds + (b) * C::SHM_K + FX_KSWZ(sr, kc)) = sr_[i].ks0; *(bf16x8*)(K_lds + (b) * C::SHM_K + FX_KSWZ(32 + sr, kc)) = sr_[i].ks1; \
    if (DQK == 192) *(bf16x8*)(K_lds + (b) * C::SHM_K + FX_KSWZ(xr, 256 + xc * 2)) = sr_[i].kx; } while (0)
#define FX_SWAIT() do { if (SD == 1) asm volatile("s_waitcnt vmcnt(0)" ::: "memory"); else if (DQK == 192) asm volatile("s_waitcnt vmcnt(5)" ::: "memory"); else asm volatile("s_waitcnt vmcnt(4)" ::: "memory"); } while (0)
#define FX_RESC(a) do { if (__any((a) < 1.f)) { if (hi == 0) al_l[r32] = (a); asm volatile("s_waitcnt lgkmcnt(0)" ::: "memory"); \
    _Pragma("unroll") for (int d = 0; d < 4; ++d) _Pragma("unroll") for (int r = 0; r < 16; ++r) o[d][r] *= al_l[crow(r, hi)]; } } while (0)
    f32x16 pA0, pA1, pB0, pB1; float mnA, mnB, alA, alB; bf16x8 pa0, pa1, pa2, pa3; const int NT = seq / 64;
    constexpr int SE = 0, SO = SD - 1;
    FX_SLOAD(SE, 0); asm volatile("s_waitcnt vmcnt(0)" ::: "memory"); FX_SWRITE(0, SE); __syncthreads();
    qkt<DQK>(pA0, pA1, K_lds, qr, qx, r32, hi); partialSM<DQK>(pA0, pA1, m_reg, mnA, alA);
    FX_SLOAD(SO, 64); if (SD == 2) { if (2 < NT) FX_SLOAD(SE, 128); }
    FX_SWAIT(); FX_SWRITE(1, SO); __syncthreads();
    for (int j = 1; j + 1 < NT; j += 2) {
        FX_SBAR(); qkt<DQK>(pB0, pB1, K_lds + C::SHM_K, qr, qx, r32, hi);
        finishSM(pA0, pA1, alA, l_reg, pa0, pa1, pa2, pa3); FX_SBAR();
        FX_SLOAD(SO, (j + SD) * 64); FX_SBAR();
        pv_d0(o, vb0, pa0, pa1, pa2, pa3); partialSM<DQK>(pB0, pB1, m_reg, mnB, alB);
        __syncthreads(); FX_SWAIT(); FX_SWRITE(0, SE);
        FX_RESC(alB); __syncthreads();
        FX_SBAR(); qkt<DQK>(pA0, pA1, K_lds, qr, qx, r32, hi);
        finishSM(pB0, pB1, alB, l_reg, pa0, pa1, pa2, pa3); FX_SBAR();
        if (SD == 1 || j + 3 < NT) FX_SLOAD(SE, (j + 1 + SD) * 64); FX_SBAR();
        pv_d0(o, vb0 + C::SHM_V, pa0, pa1, pa2, pa3); partialSM<DQK>(pA0, pA1, m_reg, mnA, alA);
        __syncthreads(); FX_SWAIT(); FX_SWRITE(1, SO);
        FX_RESC(alA); __syncthreads();
    }
    FX_SBAR(); qkt<DQK>(pB0, pB1, K_lds + C::SHM_K, qr, qx, r32, hi);
    finishSM(pA0, pA1, alA, l_reg, pa0, pa1, pa2, pa3); FX_SBAR();
    pv_d0(o, vb0, pa0, pa1, pa2, pa3); partialSM<DQK>(pB0, pB1, m_reg, mnB, alB);
    __syncthreads(); FX_RESC(alB);
    finishSM(pB0, pB1, alB, l_reg, pa0, pa1, pa2, pa3); FX_SBAR();
    pv_d0(o, vb0 + C::SHM_V, pa0, pa1, pa2, pa3);
    if (hi == 0) li_l[r32] = l_reg; asm volatile("s_waitcnt lgkmcnt(0)" ::: "memory");
    int r32e = r32; asm volatile("" : "+v"(r32e));
    float g4[4];
#pragma unroll
    for (int d0 = 0; d0 < 4; ++d0) g4[d0] = gain[d0 * 32 + r32e];
    bf16_t* Ow = Ob + (long)(wid * 32) * 2048;
#pragma unroll
    for (int r = 0; r < 16; ++r) { const float rl = __builtin_amdgcn_rcpf(li_l[crow(r, hi)]);
        float ss = 0.f;
#pragma unroll
        for (int d0 = 0; d0 < 4; ++d0) { o[d0][r] *= rl; ss += o[d0][r] * o[d0][r]; }
        ss += __shfl_xor(ss, 1); ss += __shfl_xor(ss, 2); ss += __shfl_xor(ss, 4); ss += __shfl_xor(ss, 8); ss += __shfl_xor(ss, 16);
        const float rn = rsqrtf(ss * (1.f / 128.f) + EPS); const int orow = crow(r, hi);
#pragma unroll
#ifdef FX_WOUT8
        for (int d0 = 0; d0 < 4; ++d0) ((unsigned char*)Ob)[(long)(wid * 32 + orow) * 2048 + d0 * 32 + r32e] = (unsigned char)(__builtin_amdgcn_cvt_pk_fp8_f32(o[d0][r] * rn * g4[d0], 0.f, 0, false) & 0xff); }
#else
        for (int d0 = 0; d0 < 4; ++d0) Ow[(long)orow * 2048 + d0 * 32 + r32e] = f2bf(o[d0][r] * rn * g4[d0]); }
#endif
    __syncthreads();
#undef FX_SLOAD
#undef FX_SWRITE
#undef FX_SWAIT
#undef FX_RESC
}

__device__ __forceinline__ void attn_gqa_unit(int u, const bf16_t* QA, const bf16_t* KA, const bf16_t* PROJ, bf16_t* YM, const float* hog, char* lds, int tidp) {
    const int qb = u & 15, hh = (u >> 4) % 6, b = u / 96, kvh = hh / 3;
    const size_t t0 = (size_t)b * S;
    attn_unit<128, FX_SD_A, 768, 256, 0, PW>(QA + (t0 + qb * 256) * 768 + hh * 128, KA + t0 * 256 + kvh * 128, nullptr, PROJ + t0 * PW + O_AV + kvh * 128,
#ifdef FX_WOUT8
                                    (bf16_t*)((unsigned char*)YM + (t0 + qb * 256) * 2048 + hh * 128), hog + hh * 128, S, lds, tidp);
#else
                                    YM + (t0 + qb * 256) * 2048 + hh * 128, hog + hh * 128, S, lds, tidp);
#endif
}
__device__ __forceinline__ void attn_mla_unit(int u, const bf16_t* QB, const bf16_t* KVB, const bf16_t* KR, bf16_t* YM, const float* hog, char* lds, int tidp) {
    const int qb = u & 15, hh = (u >> 4) % 6, b = u / 96;
    const size_t t0 = (size_t)b * S;
    attn_unit<192, FX_SD_B, 1280, 1536, 64, 1536>(QB + (t0 + qb * 256) * 1280 + hh * 192, KVB + t0 * 1536 + hh * 256, KR + t0 * 64, KVB + t0 * 1536 + hh * 256 + 128,
#ifdef FX_WOUT8
                                         (bf16_t*)((unsigned char*)YM + (t0 + qb * 256) * 2048 + 768 + hh * 128), hog + 768 + hh * 128, S, lds, tidp);
#else
                                         YM + (t0 + qb * 256) * 2048 + 768 + hh * 128, hog + 768 + hh * 128, S, lds, tidp);
#endif
}
}
namespace fx {
constexpr int P3_LDS = 4096 + 2048 + 65536 + 32768;
constexpr float KSCALE = 0.08838834764831845f;
__device__ __forceinline__ float logsigmoid_f(float f) { return fminf(f, 0.f) - log1pf(__expf(-fabsf(f))); }
__device__ __forceinline__ float wave_scan_incl(float v, int lane) {
#pragma unroll
    for (int o = 1; o < 64; o <<= 1) { const float t = __shfl_up(v, o); if (lane >= o) v += t; }
    return v;
}
__device__ __forceinline__ float wave_scanmax_incl(float v, int lane) {
#pragma unroll
    for (int o = 1; o < 64; o <<= 1) { const float t = __shfl_up(v, o); if (lane >= o) v = fmaxf(v, t); }
    return v;
}
__device__ __forceinline__ float wave_rscanmax_incl(float v, int lane) {
#pragma unroll
    for (int o = 1; o < 64; o <<= 1) { const float t = __shfl_down(v, o); if (lane + o < 64) v = fmaxf(v, t); }
    return v;
}

struct P3Args {
    const bf16_t* PROJ; const float* GATES; const float* gate_b; const float* conv_w; const float* conv_b;
    const float* aq_gain; const float* ak_gain; const float* cq_gain; const float* ckv_gain;
    const float* cosA; const float* sinA; const float* cosB; const float* sinB;
    bf16_t* QA; bf16_t* KA; bf16_t* CQN; bf16_t* CKVN; bf16_t* KR; bf16_t* QC; bf16_t* KC; bf16_t* KCT; float* NLOC; float* GSC;
};
__device__ __forceinline__ void p3_phase(FX_LAS unsigned char* lds_, const P3Args& a, int wg, int nwg, int tidp) {
    char* lds = (char*)lds_;
    float* gat = (float*)lds; float* wts = (float*)(lds + 4096); char* ktile = lds + 6144; char* wv = lds + 6144 + 65536;
    for (int unit = wg; unit < T / 64; unit += nwg) {
        int tid_ = tidp; asm volatile("" : "+v"(tid_));
        const int tid = tid_, wid = tid >> 6, lane = tid & 63;
        const int b = unit >> 6, co = unit & 63; const size_t t0 = (size_t)unit * 64;
        for (int i = tid; i < 1024; i += 512) gat[i] = a.GATES[t0 * 16 + i] + a.gate_b[i & 15];
        __syncthreads();
        { const int dir = wid >> 2, h = wid & 3;
          const float logi = gat[lane * 16 + (dir * 2) * 4 + h], logf = logsigmoid_f(gat[lane * 16 + (dir * 2 + 1) * 4 + h]);
          const float pre = wave_scan_incl(logf, lane), g = __shfl(pre, 63);
          const float bb = dir ? (g - pre + logf) : pre;
          const float av = g - bb + logi, mloc = wave_max(av);
          wts[wid * 64 + lane] = __expf(av - mloc);
          if (lane == 0) { const int chain = (b * 4 + h) * 2 + dir, ci = dir ? 63 - co : co; a.GSC[(chain * 64 + ci) * 2] = g; a.GSC[(chain * 64 + ci) * 2 + 1] = mloc; } }
        __syncthreads();
        { const int c0 = 2 * tid; const bool isk = c0 >= 512; const int hk = (c0 - 512) >> 7, dk = (c0 - 512) & 127;
          float w0[5], w1[5];
#pragma unroll
          for (int j = 0; j < 5; ++j) { w0[j] = a.conv_w[j * 1024 + c0]; w1[j] = a.conv_w[j * 1024 + c0 + 1]; }
          const float cb0 = a.conv_b[c0], cb1 = a.conv_b[c0 + 1];
          float x0[5], x1[5];
          const bf16_t* src = a.PROJ + t0 * PW + O_CQ + c0;
#pragma unroll
          for (int j = 0; j < 4; ++j) { const int sa = co * 64 + j - 2; unsigned w = 0u; if (sa >= 0 && sa < S) w = *(const unsigned*)(src + (long)(j - 2) * PW); x0[j + 1] = bflo(w); x1[j + 1] = bfhi(w); }
          float nf0 = 0.f, nf1 = 0.f, nb0 = 0.f, nb1 = 0.f;
#pragma unroll 1
          for (int s0 = 0; s0 < 64; s0 += 16) {
              unsigned wl[16];
#pragma unroll
              for (int q = 0; q < 16; ++q) { const int sa = co * 64 + s0 + q + 2; wl[q] = 0u; if (sa < S) wl[q] = *(const unsigned*)(src + (long)(s0 + q + 2) * PW); }
#pragma unroll
              for (int q = 0; q < 16; ++q) { const int s = s0 + q;
#pragma unroll
                  for (int j = 0; j < 4; ++j) { x0[j] = x0[j + 1]; x1[j] = x1[j + 1]; }
                  x0[4] = bflo(wl[q]); x1[4] = bfhi(wl[q]);
                  float y0 = cb0, y1 = cb1;
#pragma unroll
                  for (int j = 0; j < 5; ++j) { y0 += w0[j] * x0[j]; y1 += w1[j] * x1[j]; }
                  y0 = silu_f(y0); y1 = silu_f(y1);
                  if (!isk) { *(unsigned*)(a.QC + (t0 + s) * 512 + c0) = cvt_pk_bf16(y0, y1); }
                  else { y0 *= KSCALE; y1 *= KSCALE; const unsigned pk = cvt_pk_bf16(y0, y1);
                      *(unsigned*)(a.KC + (t0 + s) * 512 + (c0 - 512)) = pk;
                      *(unsigned*)(ktile + hk * 16384 + v_st(s, dk & ~7) + (dk & 7) * 2) = pk;
                      const float k0 = bflo(pk), k1 = bfhi(pk); const float wf = wts[hk * 64 + s], wb = wts[(4 + hk) * 64 + s];
                      nf0 += wf * k0; nf1 += wf * k1; nb0 += wb * k0; nb1 += wb * k1; } }
          }
          if (isk) { const int chf = (b * 4 + hk) * 2, chb = chf + 1;
              *(f32x2*)(a.NLOC + ((size_t)chf * 64 + co) * 128 + dk) = (f32x2){nf0, nf1};
              *(f32x2*)(a.NLOC + ((size_t)chb * 64 + (63 - co)) * 128 + dk) = (f32x2){nb0, nb1}; } }
        __syncthreads();
#pragma unroll 1
        for (int h = 0; h < 4; ++h) {
            { const int sr = tid >> 4, sc = (tid & 15) * 8;
#pragma unroll
              for (int rr = 0; rr < 2; ++rr) { const int s = sr + 32 * rr;
                const u32x4 vw = *(const u32x4*)(a.PROJ + (t0 + s) * PW + O_CV + h * 128 + sc);
                const float wf = wts[h * 64 + s], wb = wts[(4 + h) * 64 + s];
                float v[8] = {bflo(vw.x), bfhi(vw.x), bflo(vw.y), bfhi(vw.y), bflo(vw.z), bfhi(vw.z), bflo(vw.w), bfhi(vw.w)};
                u32x4 of, ob;
                of.x = cvt_pk_bf16(v[0] * wf, v[1] * wf); of.y = cvt_pk_bf16(v[2] * wf, v[3] * wf); of.z = cvt_pk_bf16(v[4] * wf, v[5] * wf); of.w = cvt_pk_bf16(v[6] * wf, v[7] * wf);
                ob.x = cvt_pk_bf16(v[0] * wb, v[1] * wb); ob.y = cvt_pk_bf16(v[2] * wb, v[3] * wb); ob.z = cvt_pk_bf16(v[4] * wb, v[5] * wb); ob.w = cvt_pk_bf16(v[6] * wb, v[7] * wb);
                *(u32x4*)(wv + v_st(s, sc)) = of; *(u32x4*)(wv + 16384 + v_st(s, sc)) = ob; } }
            __syncthreads();
            { const int dir = wid >> 2, mb = wid & 3, r32 = lane & 31, hi = lane >> 5;
              const int va = (int)(uintptr_t)(wv + dir * 16384) + v_rd_base(lane) + mb * 512;
              const int kb = (int)(uintptr_t)(ktile + h * 16384) + v_rd_base(lane);
              f32x16 acc[4] = {};
#define FX_KC_STEP(KS) do { \
              const s16x4 al = tr_read<v_rd_off(0, KS, 0)>(va), ah = tr_read<v_rd_off(0, KS, 1)>(va); \
              const s16x4 b0l = tr_read<v_rd_off(0, KS, 0)>(kb), b0h = tr_read<v_rd_off(0, KS, 1)>(kb), b1l = tr_read<v_rd_off(1, KS, 0)>(kb), b1h = tr_read<v_rd_off(1, KS, 1)>(kb); \
              const s16x4 b2l = tr_read<v_rd_off(2, KS, 0)>(kb), b2h = tr_read<v_rd_off(2, KS, 1)>(kb), b3l = tr_read<v_rd_off(3, KS, 0)>(kb), b3h = tr_read<v_rd_off(3, KS, 1)>(kb); \
              asm volatile("s_waitcnt lgkmcnt(0)" ::: "memory"); FX_SBAR(); \
              const bf16x8 af = FX_PK(al, ah); \
              acc[0] = __builtin_amdgcn_mfma_f32_32x32x16_bf16(af, FX_PK(b0l, b0h), acc[0], 0, 0, 0); acc[1] = __builtin_amdgcn_mfma_f32_32x32x16_bf16(af, FX_PK(b1l, b1h), acc[1], 0, 0, 0); \
              acc[2] = __builtin_amdgcn_mfma_f32_32x32x16_bf16(af, FX_PK(b2l, b2h), acc[2], 0, 0, 0); acc[3] = __builtin_amdgcn_mfma_f32_32x32x16_bf16(af, FX_PK(b3l, b3h), acc[3], 0, 0, 0); } while (0)
              FX_KC_STEP(0); FX_KC_STEP(1); FX_KC_STEP(2); FX_KC_STEP(3);
#undef FX_KC_STEP
              const int chain = (b * 4 + h) * 2 + dir, ci = dir ? 63 - co : co;
              bf16_t* dst = a.KCT + ((size_t)chain * 64 + ci) * 16384 + (size_t)(mb * 32) * 128 + r32;
#pragma unroll
              for (int r = 0; r < 16; ++r) { const int v = crow(r, hi);
#pragma unroll
                  for (int nb = 0; nb < 4; ++nb) dst[v * 128 + nb * 32] = f2bf(acc[nb][r]); } }
            __syncthreads();
        }
        { const int f = lane & 31, hf = lane >> 5;
#pragma unroll 8
          for (int it = wid; it < 512; it += 8) { const int s = it >> 3, hd = it & 7; const size_t t = t0 + s;
            const bf16_t* src = a.PROJ + t * PW + hd * 128 + hf * 64;
            float x1 = bf2f(src[f]), x2 = bf2f(src[32 + f]);
            const float ss = wave_sum(x1 * x1 + x2 * x2), r = rsqrtf(ss * (1.f / 128.f) + EPS);
            const float* g = hd < 6 ? a.aq_gain : a.ak_gain;
            x1 *= r * g[hf * 64 + f]; x2 *= r * g[hf * 64 + 32 + f];
            const int pos = hf ? s : co; const float cs = a.cosA[pos * 32 + f], sn = a.sinA[pos * 32 + f];
            bf16_t* dst = hd < 6 ? a.QA + t * 768 + hd * 128 + hf * 64 : a.KA + t * 256 + (hd - 6) * 128 + hf * 64;
            dst[f] = f2bf(x1 * cs - x2 * sn); dst[32 + f] = f2bf(x2 * cs + x1 * sn); } }
#pragma unroll 4
        for (int s = wid; s < 64; s += 8) { const size_t t = t0 + s; const bf16_t* p = a.PROJ + t * PW;
            float q[6]; float ss = 0.f;
#pragma unroll
            for (int i = 0; i < 3; ++i) { const unsigned w = *(const unsigned*)(p + O_BCQ + i * 128 + lane * 2); q[2 * i] = bflo(w); q[2 * i + 1] = bfhi(w); ss += q[2 * i] * q[2 * i] + q[2 * i + 1] * q[2 * i + 1]; }
            ss = wave_sum(ss); float r = rsqrtf(ss * (1.f / 384.f) + EPS);
#pragma unroll
            for (int i = 0; i < 3; ++i) { const int c = i * 128 + lane * 2; *(unsigned*)(a.CQN + t * 384 + c) = cvt_pk_bf16(q[2 * i] * r * a.cq_gain[c], q[2 * i + 1] * r * a.cq_gain[c + 1]); }
            float kv[4]; ss = 0.f;
#pragma unroll
            for (int i = 0; i < 2; ++i) { const unsigned w = *(const unsigned*)(p + O_BCKV + i * 128 + lane * 2); kv[2 * i] = bflo(w); kv[2 * i + 1] = bfhi(w); ss += kv[2 * i] * kv[2 * i] + kv[2 * i + 1] * kv[2 * i + 1]; }
            ss = wave_sum(ss); r = rsqrtf(ss * (1.f / 256.f) + EPS);
#pragma unroll
            for (int i = 0; i < 2; ++i) { const int c = i * 128 + lane * 2; *(unsigned*)(a.CKVN + t * 256 + c) = cvt_pk_bf16(kv[2 * i] * r * a.ckv_gain[c], kv[2 * i + 1] * r * a.ckv_gain[c + 1]); }
            if (lane < 32) { const int f = lane & 15, hf = lane >> 4; const int pos = hf ? s : co; const float cs = a.cosB[pos * 16 + f], sn = a.sinB[pos * 16 + f];
                const float x1 = bf2f(p[O_BKR + hf * 32 + f]), x2 = bf2f(p[O_BKR + hf * 32 + 16 + f]);
                a.KR[t * 64 + hf * 32 + f] = f2bf(x1 * cs - x2 * sn); a.KR[t * 64 + hf * 32 + 16 + f] = f2bf(x2 * cs + x1 * sn); } }
        __syncthreads();
    }
}

__device__ __forceinline__ void scan_phase(const bf16_t* KCT, const float* NLOC, const float* GSC, bf16_t* CPREV, float* NPREV, float* MPREV, int gtid, int nthr) {
    for (int item = gtid; item < 32 * 4096; item += nthr) {
        const int chain = item >> 12, e4 = item & 4095;
        const u32x2* src = (const u32x2*)(KCT + (size_t)chain * 64 * 16384) + e4; u32x2* dst = (u32x2*)(CPREV + (size_t)chain * 64 * 16384) + e4;
        const float* gs = GSC + (size_t)chain * 128;
        const bool don = e4 < 128;
        float c0 = 0.f, c1 = 0.f, c2 = 0.f, c3 = 0.f, nn = 0.f, m = 0.f;
#pragma unroll 1
        for (int cb = 0; cb < 64; cb += 8) {
            u32x2 kc[8]; float nl[8];
#pragma unroll
            for (int j = 0; j < 8; ++j) { kc[j] = src[(size_t)(cb + j) * 4096]; nl[j] = don ? NLOC[((size_t)chain * 64 + cb + j) * 128 + e4] : 0.f; }
#pragma unroll
            for (int j = 0; j < 8; ++j) { const int ci = cb + j; const float g = gs[ci * 2], ml = gs[ci * 2 + 1];
                u32x2 o; o.x = cvt_pk_bf16(c0, c1); o.y = cvt_pk_bf16(c2, c3); dst[(size_t)ci * 4096] = o;
                if (don) NPREV[((size_t)chain * 64 + ci) * 128 + e4] = nn;
                if (e4 == 0) MPREV[chain * 64 + ci] = m;
                const float mn = fmaxf(g + m, ml), dec = __expf(g + m - mn), sl = __expf(ml - mn); m = mn;
                c0 = dec * c0 + sl * bflo(kc[j].x); c1 = dec * c1 + sl * bfhi(kc[j].x); c2 = dec * c2 + sl * bflo(kc[j].y); c3 = dec * c3 + sl * bfhi(kc[j].y);
                nn = dec * nn + sl * nl[j]; }
        }
    }
}

constexpr int MC_K = 0, MC_V = 16384, MC_CT = 32768, MC_HS = 98304, MC_HS_LD = 132, MC_SM = MC_HS + 64 * MC_HS_LD * 4, MC_LDS = MC_SM + 4096;
struct McArgs { const bf16_t* PROJ; const float* GATES; const float* gate_b; const bf16_t* QC; const bf16_t* KC; const bf16_t* CPREV; const float* NPREV; const float* MPREV; const float* hog; bf16_t* YM; };
__device__ __forceinline__ void mlstm_c_phase(FX_LAS unsigned char* lds_, const McArgs& a, int wg, int nwg, int tidp) {
    char* lds = (char*)lds_;
    using C = AttnC<128>;
    float* hs = (float*)(lds + MC_HS);
    float* sm = (float*)(lds + MC_SM);
    for (int unit = wg; unit < NB * 4 * 64; unit += nwg) {
        int tid_ = tidp; asm volatile("" : "+v"(tid_));
        const int tid = tid_, wid = tid >> 6, lane = tid & 63, r32 = lane & 31, hi = lane >> 5;
        const int co = unit & 63, h = (unit >> 6) & 3, b = unit >> 8; const size_t t0 = (size_t)b * S + co * 64;
        if (wid < 2) { const int dir = wid; const int chain = (b * 4 + h) * 2 + dir, ci = dir ? 63 - co : co;
            const float logi = a.GATES[(t0 + lane) * 16 + (dir * 2) * 4 + h] + a.gate_b[(dir * 2) * 4 + h];
            const float logf = logsigmoid_f(a.GATES[(t0 + lane) * 16 + (dir * 2 + 1) * 4 + h] + a.gate_b[(dir * 2 + 1) * 4 + h]);
            const float pre = wave_scan_incl(logf, lane), g = __shfl(pre, 63);
            const float bb = dir ? (g - pre + logf) : pre;
            const float u = logi - bb;
            const float M = dir ? wave_rscanmax_incl(u, lane) : wave_scanmax_incl(u, lane);
            const float mp = a.MPREV[chain * 64 + ci], mmj = fmaxf(mp, M);
            sm[dir * 64 + lane] = u; sm[128 + dir * 64 + lane] = mmj; sm[256 + dir * 64 + lane] = __expf(mp - mmj); sm[384 + dir * 64 + lane] = __expf(-(bb + mmj));
            sm[512 + dir * 128 + lane] = a.NPREV[((size_t)chain * 64 + ci) * 128 + lane]; sm[512 + dir * 128 + 64 + lane] = a.NPREV[((size_t)chain * 64 + ci) * 128 + 64 + lane]; }
        { const int sr = tid >> 4, sc = (tid & 15) * 8;
#pragma unroll
          for (int rr = 0; rr < 2; ++rr) { const int s = sr + 32 * rr;
            *(bf16x8*)(lds + MC_K + FX_KSWZ(s, sc * 2)) = *(const bf16x8*)(a.KC + (t0 + s) * 512 + h * 128 + sc);
            *(bf16x8*)(lds + MC_V + v_st(s, sc)) = *(const bf16x8*)(a.PROJ + (t0 + s) * PW + O_CV + h * 128 + sc); }
#pragma unroll
          for (int dir = 0; dir < 2; ++dir) { const int chain = (b * 4 + h) * 2 + dir, ci = dir ? 63 - co : co; const bf16_t* ct = a.CPREV + ((size_t)chain * 64 + ci) * 16384;
#pragma unroll
            for (int rr = 0; rr < 4; ++rr) { const int v = sr + 32 * rr; *(bf16x8*)(lds + MC_CT + dir * 32768 + FX_KSWZ(v, sc * 2)) = *(const bf16x8*)(ct + v * 128 + sc); } } }
        __syncthreads();
        { const int dir = wid >> 2, rb = (wid >> 1) & 1, cb = wid & 1, j = rb * 32 + r32;
          bf16x8 qr[8];
          const bf16_t* Qw = a.QC + (t0 + j) * 512 + h * 128 + hi * 8;
#pragma unroll
          for (int d0 = 0; d0 < 8; ++d0) qr[d0] = *reinterpret_cast<const bf16x8*>(Qw + d0 * 16);
          f32x16 p0, p1;
          qkt<128>(p0, p1, lds + MC_K, qr, nullptr, r32, hi);
          const float mmj = sm[128 + dir * 64 + j], inter = sm[256 + dir * 64 + j], emn = sm[384 + dir * 64 + j];
          float dsum = 0.f;
#pragma unroll
          for (int r = 0; r < 16; ++r) { const int s0 = crow(r, hi), s1 = 32 + s0;
              const bool v0 = dir ? (s0 >= j) : (s0 <= j), v1 = dir ? (s1 >= j) : (s1 <= j);
              const float w0 = v0 ? __expf(sm[dir * 64 + s0] - mmj) : 0.f, w1 = v1 ? __expf(sm[dir * 64 + s1] - mmj) : 0.f;
              p0[r] *= w0; p1[r] *= w1; dsum += p0[r] + p1[r]; }
          float qn = 0.f;
#pragma unroll
          for (int d0 = 0; d0 < 8; ++d0) { const float* np = sm + 512 + dir * 128 + d0 * 16 + hi * 8; const u32x4 w = *reinterpret_cast<const u32x4*>(&qr[d0]);
              qn += bflo(w.x) * np[0] + bfhi(w.x) * np[1] + bflo(w.y) * np[2] + bfhi(w.y) * np[3] + bflo(w.z) * np[4] + bfhi(w.z) * np[5] + bflo(w.w) * np[6] + bfhi(w.w) * np[7]; }
          { auto rr = __builtin_amdgcn_permlane32_swap(__float_as_uint(dsum), __float_as_uint(dsum), false, false); dsum = __uint_as_float(rr[0]) + __uint_as_float(rr[1]); }
          { auto rr = __builtin_amdgcn_permlane32_swap(__float_as_uint(qn), __float_as_uint(qn), false, false); qn = __uint_as_float(rr[0]) + __uint_as_float(rr[1]); }
          const float den = dsum + inter * qn;
          if (hi == 0) sm[768 + wid * 32 + r32] = 1.f / fmaxf(fabsf(den), emn);
          bf16x8 pa0, pa1, pa2, pa3;
          FX_PK4(p0, 0, pa0); FX_PK4(p0, 8, pa1); FX_PK4(p1, 0, pa2); FX_PK4(p1, 8, pa3);
          f32x16 o[2] = {};
          const int vb = (int)(uintptr_t)(lds + MC_V) + v_rd_base(lane) + cb * 1024;
          pv_one<0>(o[0], vb, pa0, pa1, pa2, pa3); pv_one<1>(o[1], vb, pa0, pa1, pa2, pa3);
          const char* ctb = lds + MC_CT + dir * 32768;
#pragma unroll
          for (int ks = 0; ks < 8; ++ks) { const u32x4 w = *reinterpret_cast<const u32x4*>(&qr[ks]); u32x4 sq;
              sq.x = cvt_pk_bf16(bflo(w.x) * inter, bfhi(w.x) * inter); sq.y = cvt_pk_bf16(bflo(w.y) * inter, bfhi(w.y) * inter); sq.z = cvt_pk_bf16(bflo(w.z) * inter, bfhi(w.z) * inter); sq.w = cvt_pk_bf16(bflo(w.w) * inter, bfhi(w.w) * inter);
              const bf16x8 qs = *reinterpret_cast<const bf16x8*>(&sq); const int colB = (ks * 16 + hi * 8) * 2;
              const bf16x8 c0f = *reinterpret_cast<const bf16x8*>(ctb + FX_KSWZ((2 * cb) * 32 + r32, colB));
              const bf16x8 c1f = *reinterpret_cast<const bf16x8*>(ctb + FX_KSWZ((2 * cb + 1) * 32 + r32, colB));
              o[0] = __builtin_amdgcn_mfma_f32_32x32x16_bf16(qs, c0f, o[0], 0, 0, 0);
              o[1] = __builtin_amdgcn_mfma_f32_32x32x16_bf16(qs, c1f, o[1], 0, 0, 0); }
          asm volatile("s_waitcnt lgkmcnt(0)" ::: "memory");
          float rd[16];
#pragma unroll
          for (int r = 0; r < 16; ++r) rd[r] = sm[768 + wid * 32 + crow(r, hi)];
          if (dir == 0) {
#pragma unroll
              for (int r = 0; r < 16; ++r) { const int row = rb * 32 + crow(r, hi);
                  hs[row * MC_HS_LD + (2 * cb) * 32 + r32] = o[0][r] * rd[r]; hs[row * MC_HS_LD + (2 * cb + 1) * 32 + r32] = o[1][r] * rd[r]; } }
          __syncthreads();
          if (dir == 1) {
#pragma unroll
              for (int r = 0; r < 16; ++r) { const int row = rb * 32 + crow(r, hi);
                  hs[row * MC_HS_LD + (2 * cb) * 32 + r32] += o[0][r] * rd[r]; hs[row * MC_HS_LD + (2 * cb + 1) * 32 + r32] += o[1][r] * rd[r]; } }
          __syncthreads(); }
        { const int row = tid >> 3, c0 = (tid & 7) * 16; const size_t t = t0 + row;
          float v[16]; float ss = 0.f;
#pragma unroll
          for (int i = 0; i < 16; ++i) { v[i] = hs[row * MC_HS_LD + c0 + i]; ss += v[i] * v[i]; }
          ss += __shfl_xor(ss, 1); ss += __shfl_xor(ss, 2); ss += __shfl_xor(ss, 4);
          const float rn = rsqrtf(ss * (1.f / 128.f) + EPS);
          const bf16_t* og = a.PROJ + t * PW + O_CO + h * 128 + c0; const float* gn = a.hog + 1536 + h * 128 + c0;
          const u32x4 g0 = *(const u32x4*)og, g1 = *(const u32x4*)(og + 8);
          const float gg[16] = {bflo(g0.x), bfhi(g0.x), bflo(g0.y), bfhi(g0.y), bflo(g0.z), bfhi(g0.z), bflo(g0.w), bfhi(g0.w), bflo(g1.x), bfhi(g1.x), bflo(g1.y), bfhi(g1.y), bflo(g1.z), bfhi(g1.z), bflo(g1.w), bfhi(g1.w)};
          float ov[16];
#pragma unroll
          for (int i = 0; i < 16; ++i) ov[i] = v[i] * rn * gn[i] * sigmoid_f(gg[i]);
          u32x4 w0, w1; w0.x = cvt_pk_bf16(ov[0], ov[1]); w0.y = cvt_pk_bf16(ov[2], ov[3]); w0.z = cvt_pk_bf16(ov[4], ov[5]); w0.w = cvt_pk_bf16(ov[6], ov[7]);
          w1.x = cvt_pk_bf16(ov[8], ov[9]); w1.y = cvt_pk_bf16(ov[10], ov[11]); w1.z = cvt_pk_bf16(ov[12], ov[13]); w1.w = cvt_pk_bf16(ov[14], ov[15]);
#ifdef FX_WOUT8
          { u32x4 w8; w8.x = cvt_pk4_fp8(ov[0], ov[1], ov[2], ov[3]); w8.y = cvt_pk4_fp8(ov[4], ov[5], ov[6], ov[7]); w8.z = cvt_pk4_fp8(ov[8], ov[9], ov[10], ov[11]); w8.w = cvt_pk4_fp8(ov[12], ov[13], ov[14], ov[15]);
            *(u32x4*)((unsigned char*)a.YM + t * 2048 + 1536 + h * 128 + c0) = w8; (void)w0; (void)w1; } }
#else
          bf16_t* dst = a.YM + t * 2048 + 1536 + h * 128 + c0; *(u32x4*)dst = w0; *(u32x4*)(dst + 8) = w1; }
#endif
        __syncthreads();
    }
}
}
namespace fx {
struct EpiQB {
    static constexpr bool PERM = false;
    bf16_t* O; const float* cosB; const float* sinB;
    __device__ __forceinline__ void operator()(const f32x4 (&acc)[2][2][4][2], const Unit& u, int wr, int wc, int fr, int fq) const {
        const int row0 = u.pm * BM + wr * 64 + fr;
#pragma unroll
        for (int bj = 0; bj < 2; ++bj) { const int G = 8 * u.pn + 4 * bj + wc, gm = G % 6; const int col0 = G * 32 + 4 * fq;
#pragma unroll
            for (int ai = 0; ai < 2; ++ai)
#pragma unroll
                for (int m = 0; m < 4; ++m) { const int row = row0 + ai * HALF + m * 16; f32x4 x1 = acc[ai][bj][m][0], x2 = acc[ai][bj][m][1];
                    if (gm >= 4) { const int s = row & (S - 1), pos = gm == 4 ? (s >> 6) : (s & 63);
                        const f32x4 cs = *(const f32x4*)(cosB + pos * 16 + 4 * fq), sn = *(const f32x4*)(sinB + pos * 16 + 4 * fq);
                        const f32x4 o1 = x1 * cs - x2 * sn, o2 = x2 * cs + x1 * sn; x1 = o1; x2 = o2; }
                    bf16_t* rp = O + (size_t)row * 1280 + col0;
                    u32x2 w0, w1; w0.x = cvt_pk_bf16(x1[0], x1[1]); w0.y = cvt_pk_bf16(x1[2], x1[3]); w1.x = cvt_pk_bf16(x2[0], x2[1]); w1.y = cvt_pk_bf16(x2[2], x2[3]);
                    *(u32x2*)rp = w0; *(u32x2*)(rp + 16) = w1; } }
    }
};
constexpr size_t al256(size_t x) { return (x + 255) & ~(size_t)255; }
constexpr size_t WS_BAR = 0;
constexpr size_t WS_MOD = 16384;
constexpr size_t WS_COEF = WS_MOD + al256(2ull * 4 * 12288 * 4);
constexpr size_t WS_TAB = WS_COEF + al256(2ull * 4 * 6 * 2048 * 4);
constexpr size_t WS_CNT = WS_TAB + al256(6144 * 4);
constexpr size_t WS_WGBASE = WS_CNT + 512;
constexpr size_t WS_SELE = WS_WGBASE + 256 * 64 * 4;
constexpr size_t WS_SELG = WS_SELE + (size_t)T * 6 * 4;
constexpr size_t WS_SLOT = WS_SELG + (size_t)T * 6 * 4;
constexpr size_t WS_ROWTOK = WS_SLOT + (size_t)T * 6 * 4;
constexpr size_t WS_ROWG = WS_ROWTOK + (size_t)PTOT * 4;
constexpr size_t WS_GATES = WS_ROWG + (size_t)PTOT * 4;
constexpr size_t WS_GSC = WS_GATES + (size_t)T * 16 * 4;
constexpr size_t WS_MPREV = WS_GSC + 2048 * 2 * 4;
constexpr size_t WS_NLOC = WS_MPREV + 2048 * 4;
constexpr size_t WS_NPREV = WS_NLOC + 2048ull * 128 * 4;
constexpr size_t WS_W = al256(WS_NPREV + 2048ull * 128 * 4);
constexpr size_t W_IN = 0, W_UQ = W_IN + 4096ull * 2048 * 2, W_UKV = W_UQ + 1280ull * 384 * 2, W_OUT = W_UKV + 1536ull * 256 * 2, W_GU = W_OUT + 2048ull * 2048 * 2, W_DN = W_GU + 65ull * 1024 * 2048 * 2, W_LAYER = W_DN + 65ull * 2048 * 512 * 2;
constexpr size_t WS_XRES = WS_W + 2 * W_LAYER;
constexpr size_t WS_HA = WS_XRES + (size_t)T * 2048 * 4;
constexpr size_t WS_R1 = WS_HA + (size_t)T * 2048 * 2;
constexpr size_t WS_R2 = WS_R1 + (size_t)T * 4096 * 2;
constexpr size_t R2_QA = 0, R2_KA = R2_QA + (size_t)T * 768 * 2, R2_CQN = R2_KA + (size_t)T * 256 * 2, R2_CKVN = R2_CQN + (size_t)T * 384 * 2, R2_KR = R2_CKVN + (size_t)T * 256 * 2,
                 R2_QB = R2_KR + (size_t)T * 64 * 2, R2_KVB = R2_QB + (size_t)T * 1280 * 2, R2_QC = R2_KVB + (size_t)T * 1536 * 2, R2_KC = R2_QC + (size_t)T * 512 * 2,
                 R2_KCT = R2_KC + (size_t)T * 512 * 2, R2_CPREV = R2_KCT + 2048ull * 16384 * 2, R2_END = R2_CPREV + 2048ull * 16384 * 2;
constexpr size_t WS_END = WS_R2 + (size_t)PTOT * 2048 * 2;
static_assert(R2_END <= (size_t)PTOT * 2048 * 2, "R2 overflow");
static_assert(WS_END <= 2147483648ull, "workspace too large");
}
namespace fx {
struct CvtW { const float* w_in; const float* w_uq; const float* w_ukv; const float* w_out; const float* eg; const float* eu; const float* ed; const float* sg; const float* su; const float* sd; bf16_t* W; };
__device__ __forceinline__ void cvt_layer(const CvtW& a, FX_LAS unsigned* my, int gwave, int nwaves, int& rot) {
    const int BIG = 1 << 30; bf16_t* W = a.W;
    bf16_t* WIN = W + W_IN / 2; bf16_t* WUQ = W + W_UQ / 2; bf16_t* WUKV = W + W_UKV / 2; bf16_t* WOUT = W + W_OUT / 2; bf16_t* WGU = W + W_GU / 2; bf16_t* WDN = W + W_DN / 2;
#ifdef FX_WIN8
    { CvtSeg s; s.src = a.w_in; s.dst = WIN; s.sstride = 0; s.dstride = 0; s.ld = 4048; s.nsrc = 4048; s.K = 2048; s.ntn = 64; s.nbatch = 1; s.G = BIG; s.GS = 0; s.off = 0; cvt_seg8(s, my, gwave, nwaves, rot, W8_SCALE); }
#else
    { CvtSeg s; s.src = a.w_in; s.dst = WIN; s.sstride = 0; s.dstride = 0; s.ld = 4048; s.nsrc = 4048; s.K = 2048; s.ntn = 64; s.nbatch = 1; s.G = BIG; s.GS = 0; s.off = 0; cvt_seg(s, my, gwave, nwaves, rot); }
#endif
    { CvtSeg s; s.src = a.w_uq; s.dst = WUQ; s.sstride = 0; s.dstride = 0; s.ld = 1152; s.nsrc = 1152; s.K = 384; s.ntn = 20; s.nbatch = 1; s.G = BIG; s.GS = 0; s.off = 0; cvt_seg(s, my, gwave, nwaves, rot); }
    { CvtSeg s; s.src = a.w_ukv; s.dst = WUKV; s.sstride = 0; s.dstride = 0; s.ld = 1536; s.nsrc = 1536; s.K = 256; s.ntn = 24; s.nbatch = 1; s.G = BIG; s.GS = 0; s.off = 0; cvt_seg(s, my, gwave, nwaves, rot); }
#ifdef FX_WOUT8
    { CvtSeg s; s.src = a.w_out; s.dst = WOUT; s.sstride = 0; s.dstride = 0; s.ld = 2048; s.nsrc = 2048; s.K = 2048; s.ntn = 32; s.nbatch = 1; s.G = BIG; s.GS = 0; s.off = 0; cvt_seg8(s, my, gwave, nwaves, rot, W8_SCALE); }
#else
    { CvtSeg s; s.src = a.w_out; s.dst = WOUT; s.sstride = 0; s.dstride = 0; s.ld = 2048; s.nsrc = 2048; s.K = 2048; s.ntn = 32; s.nbatch = 1; s.G = BIG; s.GS = 0; s.off = 0; cvt_seg(s, my, gwave, nwaves, rot); }
#endif
    { CvtSeg s; s.src = a.eg; s.dst = WGU; s.sstride = 2048ll * 512; s.dstride = 1024ll * 2048; s.ld = 512; s.nsrc = 512; s.K = 2048; s.ntn = 8; s.nbatch = 64; s.G = 128; s.GS = 256; s.off = 0; cvt_seg8(s, my, gwave, nwaves, rot, W8_SCALE); }
    { CvtSeg s; s.src = a.eu; s.dst = WGU; s.sstride = 2048ll * 512; s.dstride = 1024ll * 2048; s.ld = 512; s.nsrc = 512; s.K = 2048; s.ntn = 8; s.nbatch = 64; s.G = 128; s.GS = 256; s.off = 128; cvt_seg8(s, my, gwave, nwaves, rot, W8_SCALE); }
    { CvtSeg s; s.src = a.ed; s.dst = WDN; s.sstride = 512ll * 2048; s.dstride = 2048ll * 512; s.ld = 2048; s.nsrc = 2048; s.K = 512; s.ntn = 32; s.nbatch = 64; s.G = BIG; s.GS = 0; s.off = 0; cvt_seg8(s, my, gwave, nwaves, rot, W8_SCALE); }
    { CvtSeg s; s.src = a.sg; s.dst = (bf16_t*)((unsigned char*)WGU + 64ull * 1024 * 2048); s.sstride = 0; s.dstride = 0; s.ld = 512; s.nsrc = 512; s.K = 2048; s.ntn = 8; s.nbatch = 1; s.G = 128; s.GS = 256; s.off = 0; cvt_seg8(s, my, gwave, nwaves, rot, W8_SCALE); }
    { CvtSeg s; s.src = a.su; s.dst = (bf16_t*)((unsigned char*)WGU + 64ull * 1024 * 2048); s.sstride = 0; s.dstride = 0; s.ld = 512; s.nsrc = 512; s.K = 2048; s.ntn = 8; s.nbatch = 1; s.G = 128; s.GS = 256; s.off = 128; cvt_seg8(s, my, gwave, nwaves, rot, W8_SCALE); }
    { CvtSeg s; s.src = a.sd; s.dst = (bf16_t*)((unsigned char*)WDN + 64ull * 2048 * 512); s.sstride = 0; s.dstride = 0; s.ld = 2048; s.nsrc = 2048; s.K = 512; s.ntn = 32; s.nbatch = 1; s.G = BIG; s.GS = 0; s.off = 0; cvt_seg8(s, my, gwave, nwaves, rot, W8_SCALE); }
}
constexpr int CVT_TILES_PER_LAYER = 2048 + 120 + 96 + 1024 + 3 * 16384 + 3 * 256;
__device__ __forceinline__ void cvt_layer_one(const CvtW& a, FX_LAS unsigned* my, int g) {
    int base = 0;
    const int BIG = 1 << 30; bf16_t* W = a.W;
    bf16_t* WIN = W + W_IN / 2; bf16_t* WUQ = W + W_UQ / 2; bf16_t* WUKV = W + W_UKV / 2; bf16_t* WOUT = W + W_OUT / 2; bf16_t* WGU = W + W_GU / 2; bf16_t* WDN = W + W_DN / 2;
#ifdef FX_WIN8
    { CvtSeg s; s.src = a.w_in; s.dst = WIN; s.sstride = 0; s.dstride = 0; s.ld = 4048; s.nsrc = 4048; s.K = 2048; s.ntn = 64; s.nbatch = 1; s.G = BIG; s.GS = 0; s.off = 0; { const int cnt_ = (s.K / 64) * s.ntn * s.nbatch; if (g >= base && g < base + cnt_) cvt_tile8(s, my, g - base, W8_SCALE); base += cnt_; } }
#else
    { CvtSeg s; s.src = a.w_in; s.dst = WIN; s.sstride = 0; s.dstride = 0; s.ld = 4048; s.nsrc = 4048; s.K = 2048; s.ntn = 64; s.nbatch = 1; s.G = BIG; s.GS = 0; s.off = 0; { const int cnt_ = (s.K / 64) * s.ntn * s.nbatch; if (g >= base && g < base + cnt_) cvt_tile(s, my, g - base); base += cnt_; } }
#endif
    { CvtSeg s; s.src = a.w_uq; s.dst = WUQ; s.sstride = 0; s.dstride = 0; s.ld = 1152; s.nsrc = 1152; s.K = 384; s.ntn = 20; s.nbatch = 1; s.G = BIG; s.GS = 0; s.off = 0; { const int cnt_ = (s.K / 64) * s.ntn * s.nbatch; if (g >= base && g < base + cnt_) cvt_tile(s, my, g - base); base += cnt_; } }
    { CvtSeg s; s.src = a.w_ukv; s.dst = WUKV; s.sstride = 0; s.dstride = 0; s.ld = 1536; s.nsrc = 1536; s.K = 256; s.ntn = 24; s.nbatch = 1; s.G = BIG; s.GS = 0; s.off = 0; { const int cnt_ = (s.K / 64) * s.ntn * s.nbatch; if (g >= base && g < base + cnt_) cvt_tile(s, my, g - base); base += cnt_; } }
#ifdef FX_WOUT8
    { CvtSeg s; s.src = a.w_out; s.dst = WOUT; s.sstride = 0; s.dstride = 0; s.ld = 2048; s.nsrc = 2048; s.K = 2048; s.ntn = 32; s.nbatch = 1; s.G = BIG; s.GS = 0; s.off = 0; { const int cnt_ = (s.K / 64) * s.ntn * s.nbatch; if (g >= base && g < base + cnt_) cvt_tile8(s, my, g - base, W8_SCALE); base += cnt_; } }
#else
    { CvtSeg s; s.src = a.w_out; s.dst = WOUT; s.sstride = 0; s.dstride = 0; s.ld = 2048; s.nsrc = 2048; s.K = 2048; s.ntn = 32; s.nbatch = 1; s.G = BIG; s.GS = 0; s.off = 0; { const int cnt_ = (s.K / 64) * s.ntn * s.nbatch; if (g >= base && g < base + cnt_) cvt_tile(s, my, g - base); base += cnt_; } }
#endif
    { CvtSeg s; s.src = a.eg; s.dst = WGU; s.sstride = 2048ll * 512; s.dstride = 1024ll * 2048; s.ld = 512; s.nsrc = 512; s.K = 2048; s.ntn = 8; s.nbatch = 64; s.G = 128; s.GS = 256; s.off = 0; { const int cnt_ = (s.K / 64) * s.ntn * s.nbatch; if (g >= base && g < base + cnt_) cvt_tile8(s, my, g - base, W8_SCALE); base += cnt_; } }
    { CvtSeg s; s.src = a.eu; s.dst = WGU; s.sstride = 2048ll * 512; s.dstride = 1024ll * 2048; s.ld = 512; s.nsrc = 512; s.K = 2048; s.ntn = 8; s.nbatch = 64; s.G = 128; s.GS = 256; s.off = 128; { const int cnt_ = (s.K / 64) * s.ntn * s.nbatch; if (g >= base && g < base + cnt_) cvt_tile8(s, my, g - base, W8_SCALE); base += cnt_; } }
    { CvtSeg s; s.src = a.ed; s.dst = WDN; s.sstride = 512ll * 2048; s.dstride = 2048ll * 512; s.ld = 2048; s.nsrc = 2048; s.K = 512; s.ntn = 32; s.nbatch = 64; s.G = BIG; s.GS = 0; s.off = 0; { const int cnt_ = (s.K / 64) * s.ntn * s.nbatch; if (g >= base && g < base + cnt_) cvt_tile8(s, my, g - base, W8_SCALE); base += cnt_; } }
    { CvtSeg s; s.src = a.sg; s.dst = (bf16_t*)((unsigned char*)WGU + 64ull * 1024 * 2048); s.sstride = 0; s.dstride = 0; s.ld = 512; s.nsrc = 512; s.K = 2048; s.ntn = 8; s.nbatch = 1; s.G = 128; s.GS = 256; s.off = 0; { const int cnt_ = (s.K / 64) * s.ntn * s.nbatch; if (g >= base && g < base + cnt_) cvt_tile8(s, my, g - base, W8_SCALE); base += cnt_; } }
    { CvtSeg s; s.src = a.su; s.dst = (bf16_t*)((unsigned char*)WGU + 64ull * 1024 * 2048); s.sstride = 0; s.dstride = 0; s.ld = 512; s.nsrc = 512; s.K = 2048; s.ntn = 8; s.nbatch = 1; s.G = 128; s.GS = 256; s.off = 128; { const int cnt_ = (s.K / 64) * s.ntn * s.nbatch; if (g >= base && g < base + cnt_) cvt_tile8(s, my, g - base, W8_SCALE); base += cnt_; } }
    { CvtSeg s; s.src = a.sd; s.dst = (bf16_t*)((unsigned char*)WDN + 64ull * 2048 * 512); s.sstride = 0; s.dstride = 0; s.ld = 2048; s.nsrc = 2048; s.K = 512; s.ntn = 32; s.nbatch = 1; s.G = BIG; s.GS = 0; s.off = 0; { const int cnt_ = (s.K / 64) * s.ntn * s.nbatch; if (g >= base && g < base + cnt_) cvt_tile8(s, my, g - base, W8_SCALE); base += cnt_; } }
}
}
namespace fx {
#define XB_TMO      128
#define XB_XCNT(j)  (256  + 64 * (j))
#define XB_XSUB(j)  (1280 + 64 * (j))
#define XB_XGEN(j)  (2304 + 64 * (j))
#define XB_TOP      3328
#define XB_TOPGEN   3392
#define XCD_BAR_WORDS 3456
#define XB_SPIN_CAP (1u << 22)
__device__ __forceinline__ unsigned xb_ld(unsigned* p)              { return __hip_atomic_load(p, __ATOMIC_RELAXED, __HIP_MEMORY_SCOPE_AGENT); }
__device__ __forceinline__ unsigned xb_add(unsigned* p, unsigned v) { return __hip_atomic_fetch_add(p, v, __ATOMIC_RELAXED, __HIP_MEMORY_SCOPE_AGENT); }
__device__ __forceinline__ unsigned xb_xcc_id() { return (unsigned)__builtin_amdgcn_s_getreg((3 << 11) | 20) & 0xFu; }
#define XB_SPIN(cond, bar) do { unsigned _sp = 0; while (cond) { __builtin_amdgcn_s_sleep(1); \
    if ((++_sp & 255u) == 0u) { if (xb_ld(&(bar)[XB_TMO])) break; if (_sp > XB_SPIN_CAP) { atomicAdd(&(bar)[XB_TMO], 1u); break; } } } } while (0)
struct XcdBarrier { unsigned* bar; unsigned x; volatile FX_LAS unsigned* st; };
__device__ __forceinline__ XcdBarrier xcd_barrier_post(unsigned* bar, volatile FX_LAS unsigned* st, int tidp) {
    XcdBarrier b; b.bar = bar; b.x = xb_xcc_id(); b.st = st;
    if (tidp == 0) (void)xb_add(&bar[XB_XCNT(b.x)], 1u);
    return b;
}
__device__ __forceinline__ void xcd_barrier_complete(unsigned* bar, unsigned x, unsigned& nloc, unsigned& nx) {
    const unsigned G = gridDim.x * gridDim.y * gridDim.z;
    unsigned sum, cnt, mine, sp = 0u;
    for (;;) {
        sum = 0u; cnt = 0u; mine = 0u;
#pragma unroll
        for (unsigned j = 0; j < 16; ++j) { const unsigned c = xb_ld(&bar[XB_XCNT(j)]); sum += c; cnt += (c > 0u) ? 1u : 0u; mine = (j == x) ? c : mine; }
        if (sum == G) break;
        __builtin_amdgcn_s_sleep(1);
        if ((++sp & 255u) == 0u) { if (xb_ld(&bar[XB_TMO])) break; if (sp > XB_SPIN_CAP) { atomicAdd(&bar[XB_TMO], 1u); break; } }
    }
    nloc = mine > 0u ? mine : 1u; nx = cnt > 0u ? cnt : 1u;
}
__device__ __forceinline__ void xcd_barrier(const XcdBarrier& b, int tidp) {
    asm volatile("s_waitcnt vmcnt(0)" ::: "memory");
    __syncthreads();
    if (tidp == 0) {
        unsigned* bar = b.bar;
        __builtin_amdgcn_s_waitcnt(0);
        unsigned nloc = b.st[0], nx = b.st[1];
        if (nloc == 0u) { xcd_barrier_complete(bar, b.x, nloc, nx); b.st[0] = nloc; b.st[1] = nx; }
        const unsigned old = xb_add(&bar[XB_XSUB(b.x)], 1u);
        const unsigned gen = old / nloc;
        if (old + 1u == (gen + 1u) * nloc) {
            __builtin_amdgcn_fence(__ATOMIC_RELEASE, "agent");
            asm volatile("s_waitcnt vmcnt(0)" ::: "memory");
            const unsigned og = xb_add(&bar[XB_TOP], 1u);
            const unsigned tg = og / nx;
            if (og + 1u == (tg + 1u) * nx) xb_add(&bar[XB_TOPGEN], 1u);
            else XB_SPIN(xb_ld(&bar[XB_TOPGEN]) == tg, bar);
            __builtin_amdgcn_fence(__ATOMIC_ACQUIRE, "agent");
            xb_add(&bar[XB_XGEN(b.x)], 1u);
            asm volatile("s_waitcnt vmcnt(0)" ::: "memory");
        } else {
            XB_SPIN(xb_ld(&bar[XB_XGEN(b.x)]) == gen, bar);
            __builtin_amdgcn_fence(__ATOMIC_ACQUIRE, "agent");
            asm volatile("s_waitcnt vmcnt(0)" ::: "memory");
        }
    }
    __syncthreads();
}

__device__ __forceinline__ void modp_phase(FX_LAS unsigned char* lds_, const float* c, const float* ada_w, float* MODP, int wg, int nwg, int tidp) {
    float* cact = (float*)(char*)lds_;
    for (int i = tidp; i < 8192; i += 512) { const float v = c[i]; cact[i] = v / (1.f + expf(-v)); }
    __syncthreads();
    int tid_ = tidp; asm volatile("" : "+v"(tid_));
    const int wid = tid_ >> 6, lane = tid_ & 63;
    for (int u = wg * 8 + wid; u < 2 * 48 * 32; u += nwg * 8) {
        const int kc = u & 31, nc = (u >> 5) % 48, l = u / (48 * 32);
        const float* w = ada_w + (size_t)l * 2048 * 12288 + (size_t)(kc * 64) * 12288 + nc * 256 + lane * 4;
        f32x4 a0 = {0.f, 0.f, 0.f, 0.f}, a1 = a0, a2 = a0, a3 = a0;
#pragma unroll 8
        for (int k = 0; k < 64; ++k) { const f32x4 wv = *(const f32x4*)(w + (size_t)k * 12288); const int kk = kc * 64 + k;
            a0 += wv * cact[kk]; a1 += wv * cact[2048 + kk]; a2 += wv * cact[4096 + kk]; a3 += wv * cact[6144 + kk]; }
        float* dst = MODP + (((size_t)l * 32 + kc) * 4) * 12288 + nc * 256 + lane * 4;
        *(f32x4*)dst = a0; *(f32x4*)(dst + 12288) = a1; *(f32x4*)(dst + 2 * 12288) = a2; *(f32x4*)(dst + 3 * 12288) = a3;
    }
    __syncthreads();
}
__device__ __forceinline__ void tab_phase(float* tab, int gtid) {
    if (gtid < 2048) { const int p = gtid >> 5, f = gtid & 31; const float inv = powf(10000.f, -(float)(2 * f) / 64.f); const float a = (float)p * inv; tab[gtid] = cosf(a); tab[2048 + gtid] = sinf(a); }
    else if (gtid < 3072) { const int i = gtid - 2048, p = i >> 4, f = i & 15; const float inv = powf(10000.f, -(float)(2 * f) / 32.f); const float a = (float)p * inv; tab[4096 + i] = cosf(a); tab[5120 + i] = sinf(a); }
}
__device__ __forceinline__ void coef2_phase(const float* MODP, const float* ada_b, const float* pre_mix_gain, const float* post_mix_gain, const float* pre_ffn_gain, const float* post_ffn_gain, float* coef, int gtid, int nthr) {
    for (int i = gtid; i < 2 * 4 * 2048; i += nthr) { const int d = i & 2047, b = (i >> 11) & 3, l = i >> 13;
        float m[6];
#pragma unroll
        for (int j = 0; j < 6; ++j) { float s = ada_b[l * 12288 + j * 2048 + d];
            for (int kc = 0; kc < 32; ++kc) s += MODP[(((size_t)l * 32 + kc) * 4 + b) * 12288 + j * 2048 + d];
            m[j] = s; }
        float* c = coef + ((size_t)l * 4 + b) * 6 * 2048;
        c[0 * 2048 + d] = m[2] * post_mix_gain[l * 2048 + d];
        c[1 * 2048 + d] = pre_ffn_gain[l * 2048 + d] * (1.f + m[4]);
        c[2 * 2048 + d] = m[3];
        c[3 * 2048 + d] = m[5] * post_ffn_gain[l * 2048 + d];
        c[4 * 2048 + d] = pre_mix_gain[l * 2048 + d] * (1.f + m[1]);
        c[5 * 2048 + d] = m[0]; }
}
__device__ __forceinline__ void prenorm_phase(const float* x, const float* coef_l, bf16_t* HA, int wg, int nwg, int tidp) {
    int tid_ = tidp; asm volatile("" : "+v"(tid_));
    const int wid = tid_ >> 6, lane = tid_ & 63;
    for (int t = wg * 8 + wid; t < T; t += nwg * 8) {
        const float* cn = coef_l + (size_t)(t / S) * 6 * 2048;
        float xv[32]; float ss = 0.f;
#pragma unroll
        for (int i = 0; i < 4; ++i) { const int c = i * 512 + lane * 8; const f32x4 x0 = *(const f32x4*)(x + (size_t)t * 2048 + c), x1 = *(const f32x4*)(x + (size_t)t * 2048 + c + 4);
#pragma unroll
            for (int j = 0; j < 4; ++j) { xv[i * 8 + j] = x0[j]; xv[i * 8 + 4 + j] = x1[j]; ss += x0[j] * x0[j] + x1[j] * x1[j]; } }
        ss = wave_sum(ss); const float rx = rsqrtf(ss * (1.f / 2048.f) + EPS);
#pragma unroll
        for (int i = 0; i < 4; ++i) { const int c = i * 512 + lane * 8;
            const f32x4 e0 = *(const f32x4*)(cn + 4 * 2048 + c), e1 = *(const f32x4*)(cn + 4 * 2048 + c + 4), f0 = *(const f32x4*)(cn + 5 * 2048 + c), f1 = *(const f32x4*)(cn + 5 * 2048 + c + 4);
            float hv[8];
#pragma unroll
            for (int j = 0; j < 4; ++j) { hv[j] = xv[i * 8 + j] * rx * e0[j] + f0[j]; hv[4 + j] = xv[i * 8 + 4 + j] * rx * e1[j] + f1[j]; }
#ifdef FX_WIN8
            u32x2 w; w.x = cvt_pk4_fp8(hv[0], hv[1], hv[2], hv[3]); w.y = cvt_pk4_fp8(hv[4], hv[5], hv[6], hv[7]);
            *(u32x2*)((unsigned char*)HA + (size_t)t * 2048 + c) = w; }
#else
            u32x4 w; w.x = cvt_pk_bf16(hv[0], hv[1]); w.y = cvt_pk_bf16(hv[2], hv[3]); w.z = cvt_pk_bf16(hv[4], hv[5]); w.w = cvt_pk_bf16(hv[6], hv[7]);
            *(u32x4*)(HA + (size_t)t * 2048 + c) = w; }
#endif
    }
}

constexpr int LDS_ST = 139264, LDS_TOTAL = LDS_ST + 64;
constexpr size_t WS_MODP = WS_R2;
struct MP {
    const float* x; const float* c; const float* ada_w; const float* ada_b; const float* pre_mix_gain; const float* w_in; const float* a_q_gain; const float* a_k_gain;
    const float* b_cq_gain; const float* b_ckv_gain; const float* w_uq; const float* w_ukv; const float* c_conv_w; const float* c_conv_b; const float* c_gate_b;
    const float* head_out_gain; const float* w_out; const float* post_mix_gain; const float* pre_ffn_gain; const float* router_w; const float* router_bias;
    const float* exp_w_gate; const float* exp_w_up; const float* exp_w_down; const float* sh_w_gate; const float* sh_w_up; const float* sh_w_down; const float* post_ffn_gain;
    char* ws; float* out;
};
#ifndef FX_NPHASE
#define FX_NPHASE 1000
#endif
#define PH_BEGIN const MP* pk = (const MP*)__builtin_amdgcn_kernarg_segment_ptr(); asm volatile("" : "+s"(pk)); char* ws = pk->ws; (void)ws; int gt_ = wid_s * 64 + fx_lane(); asm volatile("" : "+v"(gt_)); int wg_ = blockIdx.x, nwg_ = gridDim.x; asm volatile("" : "+s"(wg_), "+s"(nwg_)); const int wg = wg_, nwg = nwg_; (void)wg; (void)nwg; (void)gt_;
#define PH_BAR do { PH_BEGIN XcdBarrier b_; b_.bar = (unsigned*)(ws + WS_BAR); b_.x = xb_xcc_id(); b_.st = (volatile FX_LAS unsigned*)(lds + LDS_ST); xcd_barrier(b_, gt_); } while (0)
#define WSP(T_, off) ((T_*)(ws + (off)))
constexpr int QW_CNT = 3584;
constexpr unsigned HV_SLACK = 24;
__device__ __forceinline__ void harvest(FX_LAS unsigned char* lds, const MP* pk, char* ws, int tid, const unsigned nbar, const bool drain) {
    volatile FX_LAS unsigned* bw = (volatile FX_LAS unsigned*)(lds + LDS_ST);
    unsigned* bar = (unsigned*)(ws + WS_BAR);
    const int wave = tid >> 6; FX_LAS unsigned* my = (FX_LAS unsigned*)(lds) + wave * (64 * 33);
    CvtW a; a.w_in = pk->w_in + (size_t)D * 4048; a.w_uq = pk->w_uq + (size_t)384 * 1152; a.w_ukv = pk->w_ukv + (size_t)256 * 1536; a.w_out = pk->w_out + (size_t)D * D;
    a.eg = pk->exp_w_gate + (size_t)NE * D * FF; a.eu = pk->exp_w_up + (size_t)NE * D * FF; a.ed = pk->exp_w_down + (size_t)NE * FF * D;
    a.sg = pk->sh_w_gate + (size_t)D * FF; a.su = pk->sh_w_up + (size_t)D * FF; a.sd = pk->sh_w_down + (size_t)FF * D; a.W = (bf16_t*)(ws + WS_W + W_LAYER);
    __syncthreads();
    if (drain) {
        if (tid == 0) bw[3] = xb_ld(&bar[QW_CNT]);
        __syncthreads();
        const unsigned h = bw[3];
#pragma unroll 1
        for (unsigned g = h + (unsigned)(blockIdx.x * 8 + wave); g < (unsigned)CVT_TILES_PER_LAYER; g += gridDim.x * 8u) cvt_layer_one(a, my, (int)g);
        __syncthreads();
        return;
    }
#pragma unroll 1
    for (;;) {
        if (tid == 0) { unsigned nxt = 0xffffffffu; bool go = true;
            if (!drain) { unsigned sum = 0u;
#pragma unroll
                for (unsigned j = 0; j < 16; ++j) sum += xb_ld(&bar[XB_XSUB(j)]);
                const unsigned G = gridDim.x; go = (sum - nbar * G) + HV_SLACK < G; }
            if (go && xb_ld(&bar[QW_CNT]) < (unsigned)CVT_TILES_PER_LAYER) { const unsigned b0 = xb_add(&bar[QW_CNT], 8u); if (b0 < (unsigned)CVT_TILES_PER_LAYER) nxt = b0; }
            bw[3] = nxt; }
        __syncthreads();
        const unsigned base = bw[3];
        if (base == 0xffffffffu) break;
        const int g = (int)base + wave;
        if (g < CVT_TILES_PER_LAYER) cvt_layer_one(a, my, g);
        __syncthreads();
    }
    __syncthreads();
}
#ifndef FX_HARVEST
#define FX_HARVEST 1
#endif
#define PH_HARVEST(n, dr) do { if (FX_HARVEST && l == 0 && ((dr) || FX_HARVEST == 1)) { PH_BEGIN harvest(lds, pk, ws, gt_, (n), (dr)); } } while (0)
#ifndef FX_DUP
#define FX_DUP -1
#endif
#define FX_REP(n) _Pragma("unroll 1") for (int rep_ = 0; rep_ < ((FX_DUP == (n) && l == 0) ? 2 : 1); ++rep_)
template <int l> __device__ __forceinline__ void layer_body(FX_LAS unsigned char* lds, unsigned char* shm, const int wid_s) {
        FX_REP(2) { PH_BEGIN const bf16_t* W = WSP(const bf16_t, WS_W + (size_t)l * W_LAYER);
#ifdef FX_WIN8
          DenseSched Sc; Sc.init(T, 4096, nwg, wg, 2048, W + W_IN / 2, 2048, 1); EpiBf16 E; E.O = WSP(bf16_t, WS_R1); E.gates = WSP(float, WS_GATES); E.ldc = 4096; E.scale = W8_INV;
          gemm_phase<EpiBf16, DenseSched, true>(lds, (const char*)WSP(bf16_t, WS_HA), 2048, Sc, E, gt_); }
#else
          DenseSched Sc; Sc.init(T, 4096, nwg, wg, 2048 * 2, W + W_IN / 2, 2048); EpiBf16 E; E.O = WSP(bf16_t, WS_R1); E.gates = WSP(float, WS_GATES); E.ldc = 4096; E.scale = 1.f;
          gemm_phase<EpiBf16, DenseSched>(lds, (const char*)WSP(bf16_t, WS_HA), 2048, Sc, E, gt_); }
#endif
        PH_HARVEST(3u, false);
        PH_BAR;
        FX_REP(3) { PH_BEGIN char* R2 = ws + WS_R2; float* tab = WSP(float, WS_TAB);
          P3Args a; a.PROJ = WSP(bf16_t, WS_R1); a.GATES = WSP(float, WS_GATES); a.gate_b = pk->c_gate_b + l * 16; a.conv_w = pk->c_conv_w + (size_t)l * 5 * 1024; a.conv_b = pk->c_conv_b + l * 1024;
          a.aq_gain = pk->a_q_gain + l * 128; a.ak_gain = pk->a_k_gain + l * 128; a.cq_gain = pk->b_cq_gain + l * 384; a.ckv_gain = pk->b_ckv_gain + l * 256;
          a.cosA = tab; a.sinA = tab + 2048; a.cosB = tab + 4096; a.sinB = tab + 5120;
          a.QA = (bf16_t*)(R2 + R2_QA); a.KA = (bf16_t*)(R2 + R2_KA); a.CQN = (bf16_t*)(R2 + R2_CQN); a.CKVN = (bf16_t*)(R2 + R2_CKVN); a.KR = (bf16_t*)(R2 + R2_KR); a.QC = (bf16_t*)(R2 + R2_QC); a.KC = (bf16_t*)(R2 + R2_KC);
          a.KCT = (bf16_t*)(R2 + R2_KCT); a.NLOC = WSP(float, WS_NLOC); a.GSC = WSP(float, WS_GSC);
          p3_phase(lds, a, wg, nwg, gt_); }
        PH_BAR;
        FX_REP(4) {
        { PH_BEGIN const bf16_t* W = WSP(const bf16_t, WS_W + (size_t)l * W_LAYER); char* R2 = ws + WS_R2; float* tab = WSP(float, WS_TAB);
          DenseSched Sc; Sc.init(T, 1280, nwg, wg, 384 * 2, W + W_UQ / 2, 384); EpiQB E; E.O = (bf16_t*)(R2 + R2_QB); E.cosB = tab + 4096; E.sinB = tab + 5120;
          gemm_phase<EpiQB, DenseSched>(lds, (const char*)(R2 + R2_CQN), 384, Sc, E, gt_); }
        { PH_BEGIN const bf16_t* W = WSP(const bf16_t, WS_W + (size_t)l * W_LAYER); char* R2 = ws + WS_R2;
          DenseSched Sc; Sc.init(T, 1536, nwg, wg, 256 * 2, W + W_UKV / 2, 256); EpiBf16 E; E.O = (bf16_t*)(R2 + R2_KVB); E.gates = nullptr; E.ldc = 1536; E.scale = 1.f;
          gemm_phase<EpiBf16, DenseSched>(lds, (const char*)(R2 + R2_CKVN), 256, Sc, E, gt_); }
        { PH_BEGIN char* R2 = ws + WS_R2;
          scan_phase((const bf16_t*)(R2 + R2_KCT), WSP(float, WS_NLOC), WSP(float, WS_GSC), (bf16_t*)(R2 + R2_CPREV), WSP(float, WS_NPREV), WSP(float, WS_MPREV), wg * 512 + gt_, nwg * 512); }
        }
        PH_HARVEST(5u, false);
        PH_BAR;
        FX_REP(5) {
#pragma unroll 1
          for (int ui = 0; ui < 2; ++ui) { PH_BEGIN char* R2 = ws + WS_R2; int u;
              if (nwg == 256) { const int x = wg & 7, j = wg >> 3; if (ui == 1 && j >= 16) break; u = x * 48 + j + ui * 32; } else { u = wg + ui * nwg; if (u >= 384) break; }
              attn_gqa_unit(u, (const bf16_t*)(R2 + R2_QA), (const bf16_t*)(R2 + R2_KA), WSP(const bf16_t, WS_R1), WSP(bf16_t, WS_HA), pk->head_out_gain + l * D, (char*)shm, gt_); }
#pragma unroll 1
          for (int ui = 0; ui < 2; ++ui) { PH_BEGIN char* R2 = ws + WS_R2; int u;
              if (nwg == 256) { const int x = wg & 7, j = wg >> 3; if (j < 16) { if (ui == 1) break; u = x * 48 + j; } else u = x * 48 + 16 + (j - 16) * 2 + ui; } else { u = wg + ui * nwg; if (u >= 384) break; }
              attn_mla_unit(u, (const bf16_t*)(R2 + R2_QB), (const bf16_t*)(R2 + R2_KVB), (const bf16_t*)(R2 + R2_KR), WSP(bf16_t, WS_HA), pk->head_out_gain + l * D, (char*)shm, gt_); }
          { PH_BEGIN char* R2 = ws + WS_R2;
            McArgs a; a.PROJ = WSP(bf16_t, WS_R1); a.GATES = WSP(float, WS_GATES); a.gate_b = pk->c_gate_b + l * 16; a.QC = (bf16_t*)(R2 + R2_QC); a.KC = (bf16_t*)(R2 + R2_KC); a.CPREV = (bf16_t*)(R2 + R2_CPREV);
            a.NPREV = WSP(float, WS_NPREV); a.MPREV = WSP(float, WS_MPREV); a.hog = pk->head_out_gain + l * D; a.YM = WSP(bf16_t, WS_HA);
            mlstm_c_phase(lds, a, wg, nwg, gt_); } }
        PH_HARVEST(6u, false);
        PH_BAR;
        FX_REP(6) { PH_BEGIN const bf16_t* W = WSP(const bf16_t, WS_W + (size_t)l * W_LAYER);
#ifdef FX_WOUT8
          DenseSched Sc; Sc.init(T, 2048, nwg, wg, 2048, W + W_OUT / 2, 2048, 1); EpiBf16 E; E.O = WSP(bf16_t, WS_R1); E.gates = nullptr; E.ldc = 2048; E.scale = W8_INV;
          gemm_phase<EpiBf16, DenseSched, true>(lds, (const char*)WSP(bf16_t, WS_HA), 2048, Sc, E, gt_); }
#else
          DenseSched Sc; Sc.init(T, 2048, nwg, wg, 2048 * 2, W + W_OUT / 2, 2048); EpiBf16 E; E.O = WSP(bf16_t, WS_R1); E.gates = nullptr; E.ldc = 2048; E.scale = 1.f;
          gemm_phase<EpiBf16, DenseSched>(lds, (const char*)WSP(bf16_t, WS_HA), 2048, Sc, E, gt_); }
#endif
        PH_HARVEST(7u, false);
        PH_BAR;
        { PH_BEGIN p7_phase<(l != 0)>(lds, l == 0 ? (const void*)pk->x : (const void*)WSP(const bf16_t, WS_XRES), WSP(const bf16_t, WS_R1), WSP(float, WS_COEF) + (size_t)l * 4 * 6 * 2048, pk->router_w + (size_t)l * D * 64, pk->router_bias + l * 64,
                            WSP(bf16_t, WS_XRES), WSP(unsigned char, WS_HA), WSP(int, WS_SELE), WSP(float, WS_SELG), WSP(int, WS_CNT) + l * 64, WSP(int, WS_WGBASE), wg, nwg, gt_); }
        PH_BAR;
        { PH_BEGIN p8_phase(lds, WSP(int, WS_SELE), WSP(float, WS_SELG), WSP(int, WS_CNT) + l * 64, WSP(int, WS_WGBASE), WSP(int, WS_ROWTOK), WSP(float, WS_ROWG), WSP(int, WS_SLOT), wg, nwg, gt_); }
        PH_BAR;
        FX_REP(9) { PH_BEGIN const bf16_t* W = WSP(const bf16_t, WS_W + (size_t)l * W_LAYER);
          p9_phase(lds, WSP(unsigned char, WS_HA), (const unsigned char*)(W + W_GU / 2), WSP(int, WS_CNT) + l * 64, WSP(int, WS_ROWTOK), WSP(unsigned char, WS_R1), wg, nwg, gt_); }
        PH_HARVEST(10u, false);
        PH_BAR;
        FX_REP(10) { PH_BEGIN const bf16_t* W = WSP(const bf16_t, WS_W + (size_t)l * W_LAYER);
          p10_phase(lds, WSP(unsigned char, WS_R1), (const unsigned char*)(W + W_DN / 2), WSP(int, WS_CNT) + l * 64, WSP(float, WS_ROWG), WSP(unsigned char, WS_R2), wg, nwg, gt_); }
        PH_HARVEST(11u, false);
        PH_BAR;
        { PH_BEGIN p11_phase<(l == 1)>(WSP(bf16_t, WS_XRES), WSP(unsigned char, WS_R2), WSP(int, WS_SLOT), WSP(float, WS_COEF) + (size_t)l * 4 * 6 * 2048, l == 0 ? WSP(float, WS_COEF) + 4 * 6 * 2048 : nullptr,
                             l == 1 ? (void*)pk->out : (void*)WSP(bf16_t, WS_XRES), WSP(bf16_t, WS_HA), wg, nwg, gt_); }
        PH_HARVEST(12u, true);
        if (l == 0) PH_BAR;
}
__global__ __launch_bounds__(512, 2) void mega(MP p_unused) {
    extern __shared__ __attribute__((aligned(16))) unsigned char shm[];
    FX_LAS unsigned char* lds = (FX_LAS unsigned char*)shm;
    const int wid_s = __builtin_amdgcn_readfirstlane((int)threadIdx.x >> 6);
    { volatile FX_LAS unsigned* st = (volatile FX_LAS unsigned*)(lds + LDS_ST);
      PH_BEGIN if (gt_ == 0) { st[0] = 0u; st[1] = 0u; st[2] = 0u; st[3] = 0u; }
      __syncthreads();
      (void)xcd_barrier_post((unsigned*)(ws + WS_BAR), st, gt_); }
    { PH_BEGIN const int wave = gt_ >> 6; FX_LAS unsigned* my = (FX_LAS unsigned*)(lds) + wave * (64 * 33); int rot = 0;
#pragma unroll 1
      for (int l = 0; l < ((FX_DUP == 0) ? 4 : (FX_HARVEST ? 1 : 2)); ++l) { const int lw = l & 1; CvtW a; a.w_in = pk->w_in + (size_t)lw * D * 4048; a.w_uq = pk->w_uq + (size_t)lw * 384 * 1152; a.w_ukv = pk->w_ukv + (size_t)lw * 256 * 1536; a.w_out = pk->w_out + (size_t)lw * D * D;
          a.eg = pk->exp_w_gate + (size_t)lw * NE * D * FF; a.eu = pk->exp_w_up + (size_t)lw * NE * D * FF; a.ed = pk->exp_w_down + (size_t)lw * NE * FF * D;
          a.sg = pk->sh_w_gate + (size_t)lw * D * FF; a.su = pk->sh_w_up + (size_t)lw * D * FF; a.sd = pk->sh_w_down + (size_t)lw * FF * D; a.W = (bf16_t*)(ws + WS_W + (size_t)lw * W_LAYER);
          cvt_layer(a, my, wg * 8 + wave, nwg * 8, rot); }
      __syncthreads(); }
    { PH_BEGIN modp_phase(lds, pk->c, pk->ada_w, WSP(float, WS_MODP), wg, nwg, gt_); tab_phase(WSP(float, WS_TAB), wg * 512 + gt_); }
#if FX_DUP == 20
    { PH_BEGIN modp_phase(lds, pk->c, pk->ada_w, WSP(float, WS_MODP), wg, nwg, gt_); tab_phase(WSP(float, WS_TAB), wg * 512 + gt_); }
#endif
    PH_BAR;
    { PH_BEGIN coef2_phase(WSP(float, WS_MODP), pk->ada_b, pk->pre_mix_gain, pk->post_mix_gain, pk->pre_ffn_gain, pk->post_ffn_gain, WSP(float, WS_COEF), wg * 512 + gt_, nwg * 512); }
#if FX_DUP == 21
    { PH_BEGIN coef2_phase(WSP(float, WS_MODP), pk->ada_b, pk->pre_mix_gain, pk->post_mix_gain, pk->pre_ffn_gain, pk->post_ffn_gain, WSP(float, WS_COEF), wg * 512 + gt_, nwg * 512); }
#endif
    PH_BAR;
    { PH_BEGIN prenorm_phase(pk->x, WSP(float, WS_COEF), WSP(bf16_t, WS_HA), wg, nwg, gt_); }
#if FX_DUP == 22
    { PH_BEGIN prenorm_phase(pk->x, WSP(float, WS_COEF), WSP(bf16_t, WS_HA), wg, nwg, gt_); }
#endif
    PH_BAR;
#if FX_DUP == 99
    PH_BAR; PH_BAR; PH_BAR; PH_BAR; PH_BAR; PH_BAR; PH_BAR; PH_BAR; PH_BAR; PH_BAR;
#endif
    layer_body<0>(lds, shm, wid_s);
    layer_body<1>(lds, shm, wid_s);
}
}

extern "C" void kernel_launch(void* const* d_in, const int* in_sizes, int n_in, void* d_out, int out_size, void* d_ws, size_t ws_size, hipStream_t stream) {
    using namespace fx;
    static int grid = 0;
    if (!grid) {
        int dev = 0, cus = 0, per_cu = 0;
        (void)hipGetDevice(&dev);
        (void)hipDeviceGetAttribute(&cus, hipDeviceAttributeMultiprocessorCount, dev);
        (void)hipFuncSetAttribute((const void*)mega, hipFuncAttributeMaxDynamicSharedMemorySize, LDS_TOTAL);
        (void)hipOccupancyMaxActiveBlocksPerMultiprocessor(&per_cu, (const void*)mega, 512, LDS_TOTAL);
        if (cus > 256) cus = 256;
        grid = per_cu >= 1 ? cus : 0;
    }
    if (!grid) return;
    (void)hipMemsetAsync((char*)d_ws + WS_BAR, 0, 16384, stream);
    (void)hipMemsetAsync((char*)d_ws + WS_CNT, 0, 512, stream);
    MP p{};
    const float** q = (const float**)&p;
    for (int i = 0; i < 28; ++i) q[i] = (const float*)d_in[i];
    p.ws = (char*)d_ws; p.out = (float*)d_out;
    hipLaunchKernelGGL(mega, dim3(grid), dim3(512), LDS_TOTAL, stream, p);
}
```

```cpp
#define FX_WIN8 1
#define FX_WOUT8 1
#define FX_HARVEST 0
#include <hip/hip_runtime.h>
#include <stdint.h>
#include <math.h>
#ifndef FX_NOEPI
#define FX_NOEPI 0
#endif
namespace fx {
#define FX_LAS __attribute__((address_space(3)))
typedef unsigned short bf16_t;
typedef short bf16x8 __attribute__((ext_vector_type(8)));
typedef short s16x4 __attribute__((ext_vector_type(4)));
typedef float f32x4 __attribute__((ext_vector_type(4)));
typedef float f32x16 __attribute__((ext_vector_type(16)));
typedef unsigned u32x4 __attribute__((ext_vector_type(4)));
typedef unsigned u32x2 __attribute__((ext_vector_type(2)));
typedef float f32x2 __attribute__((ext_vector_type(2)));

constexpr int D = 2048, NB = 4, S = 4096, T = NB * S, DEPTH = 2;
constexpr int NE = 64, FF = 512;
constexpr float EPS = 1e-6f;
constexpr int PW = 4096;
constexpr int O_AQ = 0, O_AK = 768, O_AV = 1024, O_BCQ = 1280, O_BCKV = 1664, O_BKR = 1920, O_CQ = 1984, O_CK = 2496, O_CV = 3008, O_CO = 3520, O_CG = 4032;

typedef __bf16 bf16x2_t __attribute__((ext_vector_type(2)));
__device__ __forceinline__ unsigned cvt_pk_bf16(float lo, float hi) { const bf16x2_t r = __builtin_convertvector((f32x2){lo, hi}, bf16x2_t); return __builtin_bit_cast(unsigned, r); }
__device__ __forceinline__ float bf2f(bf16_t b) { return __uint_as_float(((unsigned)b) << 16); }
__device__ __forceinline__ float bflo(unsigned w) { return __uint_as_float(w << 16); }
__device__ __forceinline__ float bfhi(unsigned w) { return __uint_as_float(w & 0xffff0000u); }
__device__ __forceinline__ bf16_t f2bf(float f) { return (bf16_t)(cvt_pk_bf16(f, 0.f) & 0xffffu); }
__device__ __forceinline__ float sigmoid_f(float x) { return __builtin_amdgcn_rcpf(1.f + __expf(-x)); }
__device__ __forceinline__ float silu_f(float x) { return x * __builtin_amdgcn_rcpf(1.f + __expf(-x)); }
__device__ __forceinline__ int fx_lane() { unsigned z = 0u; asm volatile("" : "+v"(z)); return (int)__builtin_amdgcn_mbcnt_hi(~0u, __builtin_amdgcn_mbcnt_lo(~0u, z)); }
__device__ __forceinline__ float wave_sum(float v) { for (int o = 32; o >= 1; o >>= 1) v += __shfl_xor(v, o); return v; }
__device__ __forceinline__ float wave_max(float v) { for (int o = 32; o >= 1; o >>= 1) v = fmaxf(v, __shfl_xor(v, o)); return v; }

#ifndef FX_WGM
#define FX_WGM 8
#endif
#ifndef FX_PRIO8
#define FX_PRIO8 1
#endif
#ifndef FX_F8_32
#define FX_F8_32 0
#endif
typedef int i32x8 __attribute__((ext_vector_type(8)));
typedef int i32x4 __attribute__((ext_vector_type(4)));
constexpr float W8_SCALE = 32.f, W8_INV = 1.f / 32.f;
__device__ __forceinline__ unsigned cvt_pk4_fp8(float a, float b, float c, float d) { int w = 0; w = __builtin_amdgcn_cvt_pk_fp8_f32(a, b, w, false); w = __builtin_amdgcn_cvt_pk_fp8_f32(c, d, w, true); return (unsigned)w; }
struct CvtSeg { const float* src; bf16_t* dst; long long sstride, dstride; int ld, nsrc, K, ntn, nbatch, G, GS, off; };
__device__ __forceinline__ void cvt_tile(const CvtSeg sg, FX_LAS unsigned* my, int tile) {
    const int lane = fx_lane();
    const int ktn = sg.K / 64, per = ktn * sg.ntn;
    {
        const int b = tile / per, r = tile - b * per, nt = r / ktn, kt = r - nt * ktn;
        const int r4 = lane >> 4, c4 = lane & 15;
        const float* src = sg.src + (size_t)b * sg.sstride + (size_t)(kt * 64) * sg.ld + nt * 64 + 4 * c4;
        const bool ok = nt * 64 + 4 * c4 < sg.nsrc;
        f32x4 va[8], vb[8];
#pragma unroll
        for (int i = 0; i < 8; ++i) { const int kp = 4 * i + r4; const f32x4 z = {0.f, 0.f, 0.f, 0.f};
            va[i] = ok ? *(const f32x4*)(src + (size_t)(2 * kp) * sg.ld) : z; vb[i] = ok ? *(const f32x4*)(src + (size_t)(2 * kp + 1) * sg.ld) : z; }
#pragma unroll
        for (int i = 0; i < 8; ++i) { const int kp = 4 * i + r4;
#pragma unroll
            for (int j = 0; j < 4; ++j) my[(4 * c4 + j) * 33 + kp] = cvt_pk_bf16(va[i][j], vb[i][j]); }
        asm volatile("s_waitcnt lgkmcnt(0)" ::: "memory");
        bf16_t* dst = sg.dst + (size_t)b * sg.dstride;
#pragma unroll
        for (int i = 0; i < 8; ++i) {
            const int nl = (lane >> 3) + 8 * i, c = lane & 7, n = nt * 64 + nl;
            u32x4 w; w.x = my[nl * 33 + 4 * c]; w.y = my[nl * 33 + 4 * c + 1]; w.z = my[nl * 33 + 4 * c + 2]; w.w = my[nl * 33 + 4 * c + 3];
            const int row = (n / sg.G) * sg.GS + (n % sg.G) + sg.off;
            *(u32x4*)(dst + (size_t)row * sg.K + kt * 64 + 8 * c) = w;
        }
        asm volatile("s_waitcnt lgkmcnt(0)" ::: "memory");
    }
}
__device__ __forceinline__ void cvt_seg(const CvtSeg sg, FX_LAS unsigned* my, int gwave, int nwaves, int& rot) {
    const int total = (sg.K / 64) * sg.ntn * sg.nbatch;
    int first = (gwave - rot) % nwaves; if (first < 0) first += nwaves;
    for (int tile = first; tile < total; tile += nwaves) cvt_tile(sg, my, tile);
    rot = (rot + total) % nwaves;
}
__device__ __forceinline__ void cvt_tile8(const CvtSeg sg, FX_LAS unsigned* my, int tile, float scale) {
    const int lane = fx_lane();
    const int ktn = sg.K / 64, per = ktn * sg.ntn;
    {
        const int b = tile / per, r = tile - b * per, nt = r / ktn, kt = r - nt * ktn;
        const int r4 = lane >> 4, c4 = lane & 15;
        const float* src = sg.src + (size_t)b * sg.sstride + (size_t)(kt * 64) * sg.ld + nt * 64 + 4 * c4;
        const bool ok = nt * 64 + 4 * c4 < sg.nsrc;
        f32x4 v[4][4];
#pragma unroll
        for (int i = 0; i < 4; ++i)
#pragma unroll
            for (int q = 0; q < 4; ++q) { const int kq = 4 * i + r4; const f32x4 z = {0.f, 0.f, 0.f, 0.f}; v[i][q] = ok ? *(const f32x4*)(src + (size_t)(4 * kq + q) * sg.ld) : z; }
#pragma unroll
        for (int i = 0; i < 4; ++i) { const int kq = 4 * i + r4;
#pragma unroll
            for (int j = 0; j < 4; ++j) my[(4 * c4 + j) * 17 + kq] = cvt_pk4_fp8(v[i][0][j] * scale, v[i][1][j] * scale, v[i][2][j] * scale, v[i][3][j] * scale); }
        asm volatile("s_waitcnt lgkmcnt(0)" ::: "memory");
        unsigned char* dst = (unsigned char*)sg.dst + (size_t)b * sg.dstride;
#pragma unroll
        for (int i = 0; i < 4; ++i) {
            const int nl = (lane >> 2) + 16 * i, c = lane & 3, n = nt * 64 + nl;
            u32x4 w; w.x = my[nl * 17 + 4 * c]; w.y = my[nl * 17 + 4 * c + 1]; w.z = my[nl * 17 + 4 * c + 2]; w.w = my[nl * 17 + 4 * c + 3];
            const int row = (n / sg.G) * sg.GS + (n % sg.G) + sg.off;
            *(u32x4*)(dst + (size_t)row * sg.K + kt * 64 + 16 * c) = w;
        }
        asm volatile("s_waitcnt lgkmcnt(0)" ::: "memory");
    }
}
__device__ __forceinline__ void cvt_seg8(const CvtSeg sg, FX_LAS unsigned* my, int gwave, int nwaves, int& rot, float scale) {
    const int total = (sg.K / 64) * sg.ntn * sg.nbatch;
    int first = (gwave - rot) % nwaves; if (first < 0) first += nwaves;
    for (int tile = first; tile < total; tile += nwaves) cvt_tile8(sg, my, tile, scale);
    rot = (rot + total) % nwaves;
}

constexpr int BM = 256, BK = 64, HALF = 128, HTB = HALF * BK * 2, STAGE_BYTES = 8 * HTB, NXCD = 8, WGM = FX_WGM;
__host__ __device__ __forceinline__ int lds_byte(int r, int c) { const int st = (r >> 4) * 2 + (c >> 5), rr = r & 15, cc = c & 31, ob = rr * 64 + cc * 2; return st * 1024 + (ob ^ (((ob >> 9) & 1) << 5)); }
__host__ __device__ __forceinline__ void stage_rc(int b, int& R, int& C) { const int st = b / 1024, sb = b % 1024, swz = sb ^ (((sb >> 9) & 1) << 5); R = (st >> 1) * 16 + swz / 64; C = (st & 1) * 32 + (swz % 64) / 2; }
__host__ __device__ __forceinline__ int perm32(int rho) { const int n = rho >> 4, i = rho & 15; return 8 * (i >> 2) + 4 * n + (i & 3); }
struct Unit { int pm, pn, e; };
struct DenseSched {
    static constexpr bool GATHER = false;
    int nM, nN, nwg, G, c; int lda_b; const char* Bt; int K; int esz;
    __device__ void init(int M, int N, int G_, int c_, int lda_bytes, const void* Bt_, int K_, int esz_ = 2) { nM = M / BM; nN = N / BM; nwg = nM * nN; G = G_; c = c_; lda_b = lda_bytes; Bt = (const char*)Bt_; K = K_; esz = esz_; }
    __device__ __forceinline__ bool next(int i, Unit& u) const {
        const long L = (long)i * G + c; if (L >= nwg) return false;
        int wgid = (int)L; { const int q = nwg / NXCD, r = nwg % NXCD, xcd = wgid % NXCD, off = wgid / NXCD; wgid = (xcd < r ? xcd * (q + 1) : r * (q + 1) + (xcd - r) * q) + off; }
        const int nig = WGM * nN, gid = wgid / nig, fm = gid * WGM, gsz = (nM - fm) < WGM ? (nM - fm) : WGM;
        u.pm = fm + ((wgid % nig) % gsz); u.pn = (wgid % nig) / gsz; u.e = 0; return true;
    }
    __device__ __forceinline__ unsigned a_row_off(const Unit& u, int R) const { return (unsigned)(u.pm * BM + R) * (unsigned)lda_b; }
    __device__ __forceinline__ size_t a_unit_base(const Unit& u) const { return (size_t)u.pm * BM * (size_t)lda_b; }
    __device__ __forceinline__ unsigned a_lane_off(int R) const { return (unsigned)R * (unsigned)lda_b; }
    __device__ __forceinline__ const char* b_ptr(const Unit& u) const { return Bt + (size_t)u.pn * BM * K * esz; }
};

template <class Epi, class Sched, bool FP8 = false>
__device__ __forceinline__ void gemm_phase(FX_LAS unsigned char* lds, const char* Abase, const int Kc, const Sched& S, const Epi& E, int tidp, const int noepi = 0) {
    int K_ = Kc; asm volatile("" : "+s"(K_)); const int K = K_;
    int tid_ = tidp; asm volatile("" : "+v"(tid_));
    const int tid = tid_, wid = __builtin_amdgcn_readfirstlane(tid >> 6), lane = tid & 63, wr = wid >> 2, wc = wid & 3, fr = lane & 15, fq = lane >> 4;
    constexpr int ES = FP8 ? 1 : 2;
    const int nt = K * ES / 128;
    int Rr[2], Cc[2]; unsigned voffB[2];
#pragma unroll
    for (int i = 0; i < 2; ++i) { int R, C; stage_rc(tid * 16 + i * 8192, R, C); Rr[i] = R; Cc[i] = C; const int Rb = (Epi::PERM && !(FP8 && FX_F8_32)) ? ((R & ~31) + perm32(R & 31)) : R; voffB[i] = (unsigned)(Rb * K * ES + C * 2); }
    const size_t hstepB = (size_t)HALF * K * ES;
    const unsigned ldsw = (unsigned)wid * 1024u;
    constexpr bool F32M = FP8 && FX_F8_32;
    const int aoff = F32M ? lds_byte(wr * 64 + (lane & 31), 16 * (lane >> 5)) : lds_byte(wr * 64 + fr, fq * 8), boff = F32M ? lds_byte(wc * 32 + (lane & 31), 16 * (lane >> 5)) : lds_byte(wc * 32 + fr, fq * 8);
#define FX_SA(b, h) (((b) * 2 + (h)) * HTB)
#define FX_SB(b, h) ((4 + (b) * 2 + (h)) * HTB)
#define FX_STAGE_A(bufoff, o0, o1, kb) do { const char* ap_ = Abase + (kb); \
        __builtin_amdgcn_global_load_lds((const unsigned*)(ap_ + (o0)), (FX_LAS unsigned*)(lds + (bufoff) + ldsw), 16, 0, 0); \
        __builtin_amdgcn_global_load_lds((const unsigned*)(ap_ + (o1)), (FX_LAS unsigned*)(lds + (bufoff) + ldsw + 8192), 16, 0, 0); } while (0)
#define FX_STAGE_B(bufoff, gbase) do { _Pragma("unroll") for (int _i = 0; _i < 2; ++_i) \
        __builtin_amdgcn_global_load_lds((const unsigned*)((const char*)(gbase) + voffB[_i]), (FX_LAS unsigned*)(lds + (bufoff) + ldsw + _i * 8192), 16, 0, 0); } while (0)
#define FX_LDA(dst, b, h) do { if constexpr (F32M) { _Pragma("unroll") for (int q = 0; q < 4; ++q) { dst[q][0] = *(const FX_LAS bf16x8*)(lds + FX_SA(b, h) + aoff + (q >> 1) * 4096 + (q & 1) * 1024); dst[q][1] = *(const FX_LAS bf16x8*)(lds + FX_SA(b, h) + aoff + (q >> 1) * 4096 + (q & 1) * 1024 + 16); } } \
        else { _Pragma("unroll") for (int m = 0; m < 4; ++m) _Pragma("unroll") for (int k = 0; k < 2; ++k) dst[m][k] = *(const FX_LAS bf16x8*)(lds + FX_SA(b, h) + aoff + m * 2048 + k * 1024); } } while (0)
#define FX_LDB(dst, b, h) do { if constexpr (F32M) { _Pragma("unroll") for (int q = 0; q < 2; ++q) { dst[q][0] = *(const FX_LAS bf16x8*)(lds + FX_SB(b, h) + boff + q * 1024); dst[q][1] = *(const FX_LAS bf16x8*)(lds + FX_SB(b, h) + boff + q * 1024 + 16); } } \
        else { _Pragma("unroll") for (int n = 0; n < 2; ++n) _Pragma("unroll") for (int k = 0; k < 2; ++k) dst[n][k] = *(const FX_LAS bf16x8*)(lds + FX_SB(b, h) + boff + n * 2048 + k * 1024); } } while (0)
#define FX_MMA(ai, bj, At, Bt) do { if (!FP8 || FX_PRIO8) __builtin_amdgcn_s_setprio(1); \
        if constexpr (F32M) { _Pragma("unroll") for (int mb = 0; mb < 2; ++mb) _Pragma("unroll") for (int s = 0; s < 2; ++s) { \
            const i32x4 a0_ = __builtin_bit_cast(i32x4, At[mb * 2 + s][0]), a1_ = __builtin_bit_cast(i32x4, At[mb * 2 + s][1]), b0_ = __builtin_bit_cast(i32x4, Bt[s][0]), b1_ = __builtin_bit_cast(i32x4, Bt[s][1]); \
            const i32x8 af_ = __builtin_shufflevector(a0_, a1_, 0, 1, 2, 3, 4, 5, 6, 7), bf_ = __builtin_shufflevector(b0_, b1_, 0, 1, 2, 3, 4, 5, 6, 7); \
            asm volatile("v_mfma_scale_f32_32x32x64_f8f6f4 %0, %1, %2, %0, %3, %3 op_sel_hi:[0,0,0]" : "+v"(acc3[ai][bj][mb]) : "v"(bf_), "v"(af_), "v"(sc1_)); } } else \
        _Pragma("unroll") for (int m = 0; m < 4; ++m) _Pragma("unroll") for (int n = 0; n < 2; ++n) { \
        if constexpr (FP8) { const i32x4 a0_ = __builtin_bit_cast(i32x4, At[m][0]), a1_ = __builtin_bit_cast(i32x4, At[m][1]), b0_ = __builtin_bit_cast(i32x4, Bt[n][0]), b1_ = __builtin_bit_cast(i32x4, Bt[n][1]); \
            const i32x8 af_ = __builtin_shufflevector(a0_, a1_, 0, 1, 2, 3, 4, 5, 6, 7), bf_ = __builtin_shufflevector(b0_, b1_, 0, 1, 2, 3, 4, 5, 6, 7); \
            asm volatile("v_mfma_scale_f32_16x16x128_f8f6f4 %0, %1, %2, %0, %3, %3 op_sel_hi:[0,0,0]" : "+v"(acc[ai][bj][m][n]) : "v"(bf_), "v"(af_), "v"(sc1_)); FX_MFMA_DUP(acc[ai][bj][m][n]) } \
        else { _Pragma("unroll") for (int k = 0; k < 2; ++k) acc[ai][bj][m][n] = __builtin_amdgcn_mfma_f32_16x16x32_bf16(Bt[n][k], At[m][k], acc[ai][bj][m][n], 0, 0, 0); } } \
        if (!FP8 || FX_PRIO8) __builtin_amdgcn_s_setprio(0); } while (0)
#define FX_WAIT_V(n) asm volatile("s_waitcnt vmcnt(" #n ")" ::: "memory")
#define FX_WAIT_L(n) asm volatile("s_waitcnt lgkmcnt(" #n ")" ::: "memory")
#define FX_BAR __builtin_amdgcn_s_barrier()
#define FX_SCHED __builtin_amdgcn_sched_barrier(0)
#ifdef FX_PROBE_MFMA
#define FX_MFMA_DUP(ACC) asm volatile("v_mfma_scale_f32_16x16x128_f8f6f4 %0, %1, %2, %0, %3, %3 op_sel_hi:[0,0,0]" : "+v"(ACC) : "v"(bf_), "v"(af_), "v"(sc0_));
#else
#define FX_MFMA_DUP(ACC)
#endif
    const int sc0_ = 0; (void)sc0_;
    const int sc1_ = 0x7f7f7f7f;
    (void)sc1_;
    Unit cur, nxt; int ui = 0;
    if (!S.next(0, cur)) return;
    f32x4 acc[2][2][4][2];
#pragma unroll
    for (int a = 0; a < 2; ++a)
#pragma unroll
        for (int b = 0; b < 2; ++b)
#pragma unroll
            for (int m = 0; m < 4; ++m)
#pragma unroll
                for (int n = 0; n < 2; ++n) acc[a][b][m][n] = (f32x4){0.f, 0.f, 0.f, 0.f};
    f32x16 acc3[2][2][2];
#pragma unroll
    for (int q = 0; q < 8; ++q) acc3[q >> 2][(q >> 1) & 1][q & 1] = f32x16{};
    bf16x8 At[4][2], B0[2][2], B1[2][2];
    unsigned c00, c01, c10, c11, n00 = 0, n01 = 0, n10 = 0, n11 = 0;
    size_t ubc = 0, ubn = 0;
    if constexpr (Sched::GATHER) { c00 = S.a_row_off(cur, Rr[0]) + Cc[0] * 2; c01 = S.a_row_off(cur, Rr[1]) + Cc[1] * 2; c10 = S.a_row_off(cur, HALF + Rr[0]) + Cc[0] * 2; c11 = S.a_row_off(cur, HALF + Rr[1]) + Cc[1] * 2; }
    else { c00 = S.a_lane_off(Rr[0]) + Cc[0] * 2; c01 = S.a_lane_off(Rr[1]) + Cc[1] * 2; c10 = c00 + S.a_lane_off(HALF); c11 = c01 + S.a_lane_off(HALF); ubc = S.a_unit_base(cur); n00 = c00; n01 = c01; n10 = c10; n11 = c11; }
    const char* cB = S.b_ptr(cur);
    const unsigned kstep = BK * 2;
    FX_STAGE_B(FX_SB(0, 0), cB); FX_STAGE_A(FX_SA(0, 0), c00, c01, ubc); FX_STAGE_B(FX_SB(0, 1), cB + hstepB); FX_STAGE_A(FX_SA(0, 1), c10, c11, ubc);
    if (wr == 1) FX_BAR;
    FX_WAIT_V(4); FX_BAR;
    FX_STAGE_B(FX_SB(1, 0), cB + kstep); FX_STAGE_A(FX_SA(1, 0), c00, c01, ubc + kstep); FX_STAGE_B(FX_SB(1, 1), cB + hstepB + kstep);
    FX_WAIT_V(6); FX_BAR;
    for (;;) {
        const bool has_next = S.next(ui + 1, nxt);
        if (!has_next) nxt = cur;
        if constexpr (!Sched::GATHER) ubn = S.a_unit_base(nxt);
        const char* nB = S.b_ptr(nxt);
        for (int t = 0; t < nt; t += 2) {
            const bool last = (t == nt - 2);
            asm volatile("" : "+v"(c00), "+v"(c01), "+v"(c10), "+v"(c11), "+v"(voffB[0]), "+v"(voffB[1]));
            if constexpr (Sched::GATHER) { if (last) {
                int t2_ = tid; asm volatile("" : "+v"(t2_)); int R0_, C0_, R1_, C1_; stage_rc(t2_ * 16, R0_, C0_); stage_rc(t2_ * 16 + 8192, R1_, C1_);
                n00 = S.a_row_off(nxt, R0_) + C0_ * 2; n01 = S.a_row_off(nxt, R1_) + C1_ * 2; n10 = S.a_row_off(nxt, HALF + R0_) + C0_ * 2; n11 = S.a_row_off(nxt, HALF + R1_) + C1_ * 2; } }
            const size_t k1 = ubc + (size_t)(t + 1) * kstep;
            const size_t k2 = last ? ubn : ubc + (size_t)(t + 2) * kstep, k3 = k2 + kstep;
            unsigned a00, a01, a10, a11;
            if constexpr (Sched::GATHER) { a00 = last ? n00 : c00; a01 = last ? n01 : c01; a10 = last ? n10 : c10; a11 = last ? n11 : c11; } else { a00 = c00; a01 = c01; a10 = c10; a11 = c11; }
            const char* b2 = last ? nB : cB + (size_t)(t + 2) * kstep; const char* b3 = b2 + kstep;
            FX_LDB(B0, 0, 0); FX_SCHED; FX_LDA(At, 0, 0); FX_STAGE_A(FX_SA(1, 1), c10, c11, k1);
            FX_WAIT_L(8); FX_BAR; FX_WAIT_L(0); FX_MMA(0, 0, At, B0); FX_BAR; FX_SCHED;
            FX_LDB(B1, 0, 1); FX_STAGE_B(FX_SB(0, 0), b2);
            FX_BAR; FX_WAIT_L(0); FX_MMA(0, 1, At, B1); FX_BAR;
            FX_LDA(At, 0, 1); FX_STAGE_A(FX_SA(0, 0), a00, a01, k2);
            FX_BAR; FX_WAIT_L(0); FX_MMA(1, 0, At, B0); FX_BAR; FX_SCHED;
            FX_STAGE_B(FX_SB(0, 1), b2 + hstepB);
            FX_WAIT_V(6); FX_BAR; FX_MMA(1, 1, At, B1); FX_BAR;
            FX_LDB(B0, 1, 0); FX_SCHED; FX_LDA(At, 1, 0); FX_STAGE_A(FX_SA(0, 1), a10, a11, k2);
            FX_WAIT_L(8); FX_BAR; FX_WAIT_L(0); FX_MMA(0, 0, At, B0); FX_BAR; FX_SCHED;
            FX_LDB(B1, 1, 1); FX_STAGE_B(FX_SB(1, 0), b3);
            FX_BAR; FX_WAIT_L(0); FX_MMA(0, 1, At, B1); FX_BAR;
            FX_LDA(At, 1, 1); FX_STAGE_A(FX_SA(1, 0), a00, a01, k3);
            FX_BAR; FX_WAIT_L(0); FX_MMA(1, 0, At, B0); FX_BAR; FX_SCHED;
            FX_STAGE_B(FX_SB(1, 1), b3 + hstepB);
            FX_WAIT_V(6); FX_BAR; FX_MMA(1, 1, At, B1); FX_BAR;
        }
        if constexpr (FP8) asm volatile("s_nop 15\n\ts_nop 15\n\ts_nop 15\n\ts_nop 15" ::: "memory");
        if constexpr (F32M) { int ln_e = lane; asm volatile("" : "+v"(ln_e)); E.e32(acc3, cur, wr, wc, ln_e); }
        else if (noepi) { f32x4 s_ = (f32x4){0.f, 0.f, 0.f, 0.f};
#pragma unroll
            for (int q_ = 0; q_ < 32; ++q_) s_ += acc[q_ >> 4][(q_ >> 3) & 1][(q_ >> 1) & 3][q_ & 1];
            if (s_[0] + s_[1] + s_[2] + s_[3] == 1.2345e-30f) *(float*)const_cast<char*>(Abase) = s_[0]; }
        else { int fr_e = fr, fq_e = fq; asm volatile("" : "+v"(fr_e), "+v"(fq_e)); E(acc, cur, wr, wc, fr_e, fq_e); }
        if (!has_next) break;
        if constexpr (F32M) { _Pragma("unroll") for (int q = 0; q < 8; ++q) acc3[q >> 2][(q >> 1) & 1][q & 1] = f32x16{}; }
#pragma unroll
        for (int a = 0; a < 2; ++a)
#pragma unroll
            for (int b = 0; b < 2; ++b)
#pragma unroll
                for (int m = 0; m < 4; ++m)
#pragma unroll
                    for (int n = 0; n < 2; ++n) acc[a][b][m][n] = (f32x4){0.f, 0.f, 0.f, 0.f};
        cur = nxt; cB = nB; if constexpr (Sched::GATHER) { c00 = n00; c01 = n01; c10 = n10; c11 = n11; } else ubc = ubn; ++ui;
    }
    FX_WAIT_V(0);
    if (wr == 0) FX_BAR;
    FX_BAR;
}

struct EpiBf16 {
    static constexpr bool PERM = true;
    bf16_t* O; float* gates; int ldc; float scale;
    __device__ __forceinline__ void operator()(const f32x4 (&acc)[2][2][4][2], const Unit& u, int wr, int wc, int fr, int fq) const {
        const int row0 = u.pm * BM + wr * 64 + fr, col0 = u.pn * BM + wc * 32 + 8 * fq;
#pragma unroll
        for (int ai = 0; ai < 2; ++ai)
#pragma unroll
            for (int m = 0; m < 4; ++m) { const int row = row0 + ai * HALF + m * 16; bf16_t* rowp = O + (size_t)row * ldc + col0;
#pragma unroll
                for (int bj = 0; bj < 2; ++bj) { const f32x4 v0 = acc[ai][bj][m][0] * scale, v1 = acc[ai][bj][m][1] * scale;
                    u32x4 w; w.x = cvt_pk_bf16(v0[0], v0[1]); w.y = cvt_pk_bf16(v0[2], v0[3]); w.z = cvt_pk_bf16(v1[0], v1[1]); w.w = cvt_pk_bf16(v1[2], v1[3]);
                    *(u32x4*)(rowp + bj * HALF) = w; }
                if (gates && u.pn == 15 && wc == 2 && fq < 2) { float* g = gates + (size_t)row * 16 + 8 * fq; *(f32x4*)g = acc[ai][1][m][0] * scale; *(f32x4*)(g + 4) = acc[ai][1][m][1] * scale; } }
    }
    __device__ __forceinline__ void e32(const f32x16 (&acc3)[2][2][2], const Unit& u, int wr, int wc, int lane) const {
        const int j = lane & 31, hi = lane >> 5;
#pragma unroll
        for (int ai = 0; ai < 2; ++ai)
#pragma unroll
            for (int mb = 0; mb < 2; ++mb) { const int row = u.pm * BM + ai * HALF + wr * 64 + mb * 32 + j;
#pragma unroll
                for (int bj = 0; bj < 2; ++bj) { bf16_t* rowp = O + (size_t)row * ldc + u.pn * BM + bj * HALF + wc * 32 + 4 * hi;
#pragma unroll
                    for (int g = 0; g < 4; ++g) { u32x2 w; w.x = cvt_pk_bf16(acc3[ai][bj][mb][4 * g] * scale, acc3[ai][bj][mb][4 * g + 1] * scale); w.y = cvt_pk_bf16(acc3[ai][bj][mb][4 * g + 2] * scale, acc3[ai][bj][mb][4 * g + 3] * scale);
                        *(u32x2*)(rowp + 8 * g) = w; } }
                if (gates && u.pn == 15 && wc == 2) { float* gp = gates + (size_t)row * 16 + 4 * hi;
#pragma unroll
                    for (int g = 0; g < 2; ++g) *(f32x4*)(gp + 8 * g) = (f32x4){acc3[ai][1][mb][4 * g] * scale, acc3[ai][1][mb][4 * g + 1] * scale, acc3[ai][1][mb][4 * g + 2] * scale, acc3[ai][1][mb][4 * g + 3] * scale}; } }
    }
};
}
namespace fx {
constexpr int RT = 16;
constexpr int H2S_LD = 2052;
constexpr int P7_LDS = RT * H2S_LD * 4 + 512;
constexpr int PTOT = 131072;
constexpr int NTILE_MAX = PTOT / 256;

__device__ __forceinline__ void coef_phase(const float* mod, const float* pre_mix_gain, const float* post_mix_gain, const float* pre_ffn_gain, const float* post_ffn_gain, float* coef, int gtid, int nthr) {
    for (int i = gtid; i < 2 * 4 * 2048; i += nthr) { const int d = i & 2047, b = (i >> 11) & 3, l = i >> 13;
        const float* m = mod + ((size_t)l * 4 + b) * 12288; float* c = coef + ((size_t)l * 4 + b) * 6 * 2048;
        c[0 * 2048 + d] = m[2 * 2048 + d] * post_mix_gain[l * 2048 + d];
        c[1 * 2048 + d] = pre_ffn_gain[l * 2048 + d] * (1.f + m[4 * 2048 + d]);
        c[2 * 2048 + d] = m[3 * 2048 + d];
        c[3 * 2048 + d] = m[5 * 2048 + d] * post_ffn_gain[l * 2048 + d];
        c[4 * 2048 + d] = pre_mix_gain[l * 2048 + d] * (1.f + m[1 * 2048 + d]);
        c[5 * 2048 + d] = m[0 * 2048 + d]; }
}

template <bool XBF>
__device__ __forceinline__ void p7_phase(FX_LAS unsigned char* lds, const void* xin_, const bf16_t* Y, const float* coef_l  , const float* router_w, const float* router_bias,
                                         bf16_t* XRES, unsigned char* HA8, int* SELE, float* SELG, int* CNT, int* WGBASE, int wg, int nwg, int tidp) {
    int tid_ = tidp; asm volatile("" : "+v"(tid_));
    const int tid = tid_, wid = tid >> 6, lane = tid & 63;
    FX_LAS float* h2s = (FX_LAS float*)lds;
    FX_LAS int* hist = (FX_LAS int*)(lds + RT * H2S_LD * 4);
    if (tid < 64) hist[tid] = 0;
    __syncthreads();
    for (int unit = wg; unit < T / RT; unit += nwg) {
#pragma unroll 1
        for (int tt = 0; tt < 2; ++tt) {
            const int tok = 2 * wid + tt, t = unit * RT + tok, b = t / S;
            const float* cf = coef_l + (size_t)b * 6 * 2048;
            float xv[32]; float yv[32]; float ssy = 0.f;
#pragma unroll
            for (int i = 0; i < 4; ++i) { const int c = i * 512 + lane * 8;
                const u32x4 yw = *(const u32x4*)(Y + (size_t)t * 2048 + c);
                yv[i * 8 + 0] = bflo(yw.x); yv[i * 8 + 1] = bfhi(yw.x); yv[i * 8 + 2] = bflo(yw.y); yv[i * 8 + 3] = bfhi(yw.y); yv[i * 8 + 4] = bflo(yw.z); yv[i * 8 + 5] = bfhi(yw.z); yv[i * 8 + 6] = bflo(yw.w); yv[i * 8 + 7] = bfhi(yw.w);
                if constexpr (XBF) { const u32x4 xw = *(const u32x4*)((const bf16_t*)xin_ + (size_t)t * 2048 + c);
                    xv[i * 8 + 0] = bflo(xw.x); xv[i * 8 + 1] = bfhi(xw.x); xv[i * 8 + 2] = bflo(xw.y); xv[i * 8 + 3] = bfhi(xw.y); xv[i * 8 + 4] = bflo(xw.z); xv[i * 8 + 5] = bfhi(xw.z); xv[i * 8 + 6] = bflo(xw.w); xv[i * 8 + 7] = bfhi(xw.w); }
                else { const float* xin = (const float*)xin_; const f32x4 x0 = *(const f32x4*)(xin + (size_t)t * 2048 + c), x1 = *(const f32x4*)(xin + (size_t)t * 2048 + c + 4);
                    xv[i * 8 + 0] = x0[0]; xv[i * 8 + 1] = x0[1]; xv[i * 8 + 2] = x0[2]; xv[i * 8 + 3] = x0[3]; xv[i * 8 + 4] = x1[0]; xv[i * 8 + 5] = x1[1]; xv[i * 8 + 6] = x1[2]; xv[i * 8 + 7] = x1[3]; }
#pragma unroll
                for (int j = 0; j < 8; ++j) ssy += yv[i * 8 + j] * yv[i * 8 + j]; }
            ssy = wave_sum(ssy);
            const float ry = rsqrtf(ssy * (1.f / 2048.f) + EPS); float ssx = 0.f;
#pragma unroll
            for (int i = 0; i < 4; ++i) { const int c = i * 512 + lane * 8;
                const f32x4 a0 = *(const f32x4*)(cf + c), a1 = *(const f32x4*)(cf + c + 4);
#pragma unroll
                for (int j = 0; j < 4; ++j) { xv[i * 8 + j] += a0[j] * (yv[i * 8 + j] * ry); xv[i * 8 + 4 + j] += a1[j] * (yv[i * 8 + 4 + j] * ry); }
#pragma unroll
                for (int j = 0; j < 8; ++j) ssx += xv[i * 8 + j] * xv[i * 8 + j];
                { u32x4 xo; xo.x = cvt_pk_bf16(xv[i * 8 + 0], xv[i * 8 + 1]); xo.y = cvt_pk_bf16(xv[i * 8 + 2], xv[i * 8 + 3]); xo.z = cvt_pk_bf16(xv[i * 8 + 4], xv[i * 8 + 5]); xo.w = cvt_pk_bf16(xv[i * 8 + 6], xv[i * 8 + 7]);
                  *(u32x4*)(XRES + (size_t)t * 2048 + c) = xo; } }
            ssx = wave_sum(ssx);
            const float rx = rsqrtf(ssx * (1.f / 2048.f) + EPS);
#pragma unroll
            for (int i = 0; i < 4; ++i) { const int c = i * 512 + lane * 8;
                const f32x4 b0 = *(const f32x4*)(cf + 2048 + c), b1 = *(const f32x4*)(cf + 2048 + c + 4), c0 = *(const f32x4*)(cf + 4096 + c), c1 = *(const f32x4*)(cf + 4096 + c + 4);
                float hv[8];
#pragma unroll
                for (int j = 0; j < 4; ++j) { hv[j] = xv[i * 8 + j] * rx * b0[j] + c0[j]; hv[4 + j] = xv[i * 8 + 4 + j] * rx * b1[j] + c1[j]; }
                u32x2 w; w.x = cvt_pk4_fp8(hv[0], hv[1], hv[2], hv[3]); w.y = cvt_pk4_fp8(hv[4], hv[5], hv[6], hv[7]);
                *(u32x2*)(HA8 + (size_t)t * 2048 + c) = w;
                *(FX_LAS f32x4*)(h2s + tok * H2S_LD + c) = (f32x4){hv[0], hv[1], hv[2], hv[3]};
                *(FX_LAS f32x4*)(h2s + tok * H2S_LD + c + 4) = (f32x4){hv[4], hv[5], hv[6], hv[7]}; }
        }
        __syncthreads();
        f32x4 acc[4];
#pragma unroll
        for (int j = 0; j < 4; ++j) acc[j] = (f32x4){0.f, 0.f, 0.f, 0.f};
        { const int i16 = lane & 15, g = lane >> 4;
#pragma unroll 4
          for (int ks = 0; ks < 64; ++ks) { const int k = 256 * wid + 4 * ks + g;
            const float a = h2s[i16 * H2S_LD + k];
            const f32x4 bw = *(const f32x4*)(router_w + (size_t)k * 64 + 4 * i16);
            acc[0] = __builtin_amdgcn_mfma_f32_16x16x4f32(a, bw[0], acc[0], 0, 0, 0);
            acc[1] = __builtin_amdgcn_mfma_f32_16x16x4f32(a, bw[1], acc[1], 0, 0, 0);
            acc[2] = __builtin_amdgcn_mfma_f32_16x16x4f32(a, bw[2], acc[2], 0, 0, 0);
            acc[3] = __builtin_amdgcn_mfma_f32_16x16x4f32(a, bw[3], acc[3], 0, 0, 0); } }
        __syncthreads();
        { FX_LAS float* part = h2s; const int i16 = lane & 15, g = lane >> 4;
#pragma unroll
          for (int j = 0; j < 4; ++j)
#pragma unroll
            for (int r = 0; r < 4; ++r) part[(wid * 16 + 4 * g + r) * 64 + 4 * i16 + j] = acc[j][r]; }
        __syncthreads();
#pragma unroll 1
        for (int tt = 0; tt < 2; ++tt) {
            const int tok = 2 * wid + tt, t = unit * RT + tok;
            float lg = 0.f;
#pragma unroll
            for (int w = 0; w < 8; ++w) lg += h2s[(w * 16 + tok) * 64 + lane];
            const float score = 1.f / (1.f + expf(-lg));
            float v = score + router_bias[lane];
            int my_e = 0; float my_s = 0.f, sum = 0.f;
#pragma unroll
            for (int k = 0; k < 6; ++k) {
                const float m = wave_max(v);
                const unsigned long long bal = __ballot(v == m);
                const int win = __ffsll((long long)bal) - 1;
                const float sw = __shfl(score, win);
                sum += sw; if (lane == k) { my_e = win; my_s = sw; }
                if (lane == win) v = -3.0e38f;
            }
            if (lane < 6) { SELE[(size_t)t * 6 + lane] = my_e; SELG[(size_t)t * 6 + lane] = my_s / sum * 2.5f; __hip_atomic_fetch_add(hist + my_e, 1, __ATOMIC_RELAXED, __HIP_MEMORY_SCOPE_WORKGROUP); }
        }
        __syncthreads();
    }
    if (tid < 64) { const int hv = hist[tid]; const int base = atomicAdd(CNT + tid, hv); WGBASE[wg * 64 + tid] = base; }
}

__device__ __forceinline__ void p8_phase(FX_LAS unsigned char* lds, const int* SELE, const float* SELG, const int* CNT, const int* WGBASE, int* ROWTOK, float* ROWG, int* SLOT, int wg, int nwg, int tidp) {
    int tid_ = tidp; asm volatile("" : "+v"(tid_));
    const int tid = tid_;
    FX_LAS int* pstart = (FX_LAS int*)lds; FX_LAS int* off = pstart + 80;
    if (tid < 64) { const int pc = (CNT[tid] + 255) & ~255; int incl = pc;
#pragma unroll
        for (int o = 1; o < 64; o <<= 1) { const int t2 = __shfl_up(incl, o); if (tid >= o) incl += t2; }
        pstart[tid] = 16384 + incl - pc; if (tid == 63) pstart[64] = 16384 + incl; }
    __syncthreads();
    if (tid < 64) off[tid] = pstart[tid] + WGBASE[wg * 64 + tid];
    __syncthreads();
    for (int unit = wg; unit < T / RT; unit += nwg) {
        if (tid < RT * 6) { const int t = unit * RT + tid / 6, k = tid % 6; const int e = SELE[(size_t)t * 6 + k];
            const int pos = __hip_atomic_fetch_add(off + e, 1, __ATOMIC_RELAXED, __HIP_MEMORY_SCOPE_WORKGROUP);
            ROWTOK[pos] = t; ROWG[pos] = SELG[(size_t)t * 6 + k]; SLOT[(size_t)t * 6 + k] = pos; }
    }
    for (int e = wg; e < 64; e += nwg) { const int a = pstart[e] + CNT[e], b = pstart[e + 1]; for (int r = a + tid; r < b; r += 512) { ROWTOK[r] = 0; ROWG[r] = 0.f; } }
    for (int r = wg * 512 + tid; r < 16384; r += nwg * 512) { ROWTOK[r] = r; ROWG[r] = 1.f; }
}

struct MoeSched {
    static constexpr bool GATHER = true;
    FX_LAS const unsigned char* tile_e; int ntiles, npn, nunits, G, c;
    const int* rowtok; int lda_b; const char* Bt; size_t estride_b, pnstride_b;
    __device__ __forceinline__ bool next(int i, Unit& u) const {
        const long L = (long)i * G + c; if (L >= nunits) return false;
        int id = (int)L; { const int q = nunits / NXCD, r = nunits % NXCD, xcd = id % NXCD, off = id / NXCD; id = (xcd < r ? xcd * (q + 1) : r * (q + 1) + (xcd - r) * q) + off; }
        u.pm = id / npn; u.pn = id - u.pm * npn; u.e = tile_e[u.pm]; return true;
    }
    __device__ __forceinline__ unsigned a_row_off(const Unit& u, int R) const { const int row = u.pm * BM + R; return (unsigned)(rowtok ? rowtok[row] : row) * (unsigned)lda_b; }
    __device__ __forceinline__ const char* b_ptr(const Unit& u) const { return Bt + (size_t)u.e * estride_b + (size_t)u.pn * pnstride_b; }
};
__device__ __forceinline__ int moe_sched_build(FX_LAS unsigned char* tab, const int* CNT, int tidp) {
    FX_LAS int* nt = (FX_LAS int*)(tab + 512);
    int tid_ = tidp; asm volatile("" : "+v"(tid_));
    if (tid_ < 64) { const int n = (CNT[tid_] + 255) >> 8; int incl = n;
#pragma unroll
        for (int o = 1; o < 64; o <<= 1) { const int t2 = __shfl_up(incl, o); if (tid_ >= o) incl += t2; }
        const int st0 = 64 + incl - n; for (int j = 0; j < n; ++j) tab[st0 + j] = (unsigned char)tid_;
        tab[tid_] = 64; if (tid_ == 63) nt[0] = 64 + incl; }
    __syncthreads();
    return nt[0];
}
struct EpiGateUp {
    static constexpr bool PERM = true;
    unsigned char* HID;
    __device__ __forceinline__ void operator()(const f32x4 (&acc)[2][2][4][2], const Unit& u, int wr, int wc, int fr, int fq) const {
        const int row0 = u.pm * BM + wr * 64 + fr, col0 = u.pn * 128 + wc * 32 + 8 * fq;
#pragma unroll
        for (int ai = 0; ai < 2; ++ai)
#pragma unroll
            for (int m = 0; m < 4; ++m) { const int row = row0 + ai * HALF + m * 16;
                float o[8];
#pragma unroll
                for (int n = 0; n < 2; ++n)
#pragma unroll
                    for (int j = 0; j < 4; ++j) { const float g = acc[ai][0][m][n][j] * W8_INV, up = acc[ai][1][m][n][j] * W8_INV; o[n * 4 + j] = g * __builtin_amdgcn_rcpf(1.f + __expf(-g)) * up; }
                u32x2 w; w.x = cvt_pk4_fp8(o[0], o[1], o[2], o[3]); w.y = cvt_pk4_fp8(o[4], o[5], o[6], o[7]);
                *(u32x2*)(HID + (size_t)row * 512 + col0) = w; }
    }
    __device__ __forceinline__ void e32(const f32x16 (&acc3)[2][2][2], const Unit& u, int wr, int wc, int lane) const {
        const int j = lane & 31, hi = lane >> 5;
#pragma unroll
        for (int ai = 0; ai < 2; ++ai)
#pragma unroll
            for (int mb = 0; mb < 2; ++mb) { const int row = u.pm * BM + ai * HALF + wr * 64 + mb * 32 + j; unsigned char* rowp = HID + (size_t)row * 512 + u.pn * 128 + wc * 32 + 4 * hi;
#pragma unroll
                for (int g = 0; g < 4; ++g) { float o[4];
#pragma unroll
                    for (int q = 0; q < 4; ++q) { const float gt = acc3[ai][0][mb][4 * g + q] * W8_INV, up = acc3[ai][1][mb][4 * g + q] * W8_INV; o[q] = gt * __builtin_amdgcn_rcpf(1.f + __expf(-gt)) * up; }
                    *(unsigned*)(rowp + 8 * g) = cvt_pk4_fp8(o[0], o[1], o[2], o[3]); } }
    }
};
struct EpiDown {
    static constexpr bool PERM = true;
    unsigned char* YR; const float* ROWG; int nostore;
    __device__ __forceinline__ void operator()(const f32x4 (&acc)[2][2][4][2], const Unit& u, int wr, int wc, int fr, int fq) const {
        const int row0 = u.pm * BM + wr * 64 + fr, col0 = u.pn * BM + wc * 32 + 8 * fq;
        float gs[2][4];
#pragma unroll
        for (int ai = 0; ai < 2; ++ai)
#pragma unroll
            for (int m = 0; m < 4; ++m) gs[ai][m] = ROWG[row0 + ai * HALF + m * 16];
#pragma unroll
        for (int ai = 0; ai < 2; ++ai)
#pragma unroll
            for (int m = 0; m < 4; ++m) { const int row = row0 + ai * HALF + m * 16; const float g = gs[ai][m] * W8_INV; unsigned char* rowp = YR + (size_t)row * 2048 + col0;
#pragma unroll
                for (int bj = 0; bj < 2; ++bj) { const f32x4 v0 = acc[ai][bj][m][0] * g, v1 = acc[ai][bj][m][1] * g;
                    u32x2 w; w.x = cvt_pk4_fp8(v0[0], v0[1], v0[2], v0[3]); w.y = cvt_pk4_fp8(v1[0], v1[1], v1[2], v1[3]);
                    if (!FX_NOEPI || !nostore || (w.x == 0x12345678u && w.y == 0x9abcdef0u))
                    *(u32x2*)(rowp + bj * HALF) = w; } }
    }
    __device__ __forceinline__ void e32(const f32x16 (&acc3)[2][2][2], const Unit& u, int wr, int wc, int lane) const {
        const int j = lane & 31, hi = lane >> 5;
#pragma unroll
        for (int ai = 0; ai < 2; ++ai)
#pragma unroll
            for (int mb = 0; mb < 2; ++mb) { const int row = u.pm * BM + ai * HALF + wr * 64 + mb * 32 + j; const float gsc = ROWG[row] * W8_INV;
#pragma unroll
                for (int bj = 0; bj < 2; ++bj) { unsigned char* rowp = YR + (size_t)row * 2048 + u.pn * BM + bj * HALF + wc * 32 + 4 * hi;
#pragma unroll
                    for (int g = 0; g < 4; ++g) *(unsigned*)(rowp + 8 * g) = cvt_pk4_fp8(acc3[ai][bj][mb][4 * g] * gsc, acc3[ai][bj][mb][4 * g + 1] * gsc, acc3[ai][bj][mb][4 * g + 2] * gsc, acc3[ai][bj][mb][4 * g + 3] * gsc); } }
    }
};
__device__ __forceinline__ void p9_phase(FX_LAS unsigned char* lds, const unsigned char* HA, const unsigned char* WGU, const int* CNT, const int* ROWTOK, unsigned char* HID, int wg, int nwg, int tidp, const int noepi = 0) {
    FX_LAS unsigned char* tab = lds + STAGE_BYTES;
    const int ntiles = moe_sched_build(tab, CNT, tidp);
    MoeSched Sc; Sc.tile_e = tab; Sc.ntiles = ntiles; Sc.npn = 4; Sc.nunits = ntiles * 4; Sc.G = nwg; Sc.c = wg; Sc.rowtok = ROWTOK; Sc.lda_b = 2048; Sc.Bt = (const char*)WGU; Sc.estride_b = (size_t)1024 * 2048; Sc.pnstride_b = (size_t)256 * 2048;
    EpiGateUp E; E.HID = HID;
    gemm_phase<EpiGateUp, MoeSched, true>(lds, (const char*)HA, 2048, Sc, E, tidp, noepi);
}
__device__ __forceinline__ void p10_phase(FX_LAS unsigned char* lds, const unsigned char* HID, const unsigned char* WDN, const int* CNT, const float* ROWG, unsigned char* YR, int wg, int nwg, int tidp, const int noepi = 0) {
    FX_LAS unsigned char* tab = lds + STAGE_BYTES;
    const int ntiles = moe_sched_build(tab, CNT, tidp);
    MoeSched Sc; Sc.tile_e = tab; Sc.ntiles = ntiles; Sc.npn = 8; Sc.nunits = ntiles * 8; Sc.G = nwg; Sc.c = wg; Sc.rowtok = nullptr; Sc.lda_b = 512; Sc.Bt = (const char*)WDN; Sc.estride_b = (size_t)2048 * 512; Sc.pnstride_b = (size_t)256 * 512;
    EpiDown E; E.YR = YR; E.ROWG = ROWG; E.nostore = (noepi == 2);
    gemm_phase<EpiDown, MoeSched, true>(lds, (const char*)HID, 512, Sc, E, tidp, noepi == 1);
}
template <bool OUTF32>
__device__ __forceinline__ void p11_phase(const bf16_t* x1, const unsigned char* YR, const int* SLOT, const float* coef_l, const float* coef_next  , void* xout_, bf16_t* HA, int wg, int nwg, int tidp) {
    int tid_ = tidp; asm volatile("" : "+v"(tid_));
    const int wid = tid_ >> 6, lane = tid_ & 63;
    for (int t = wg * 8 + wid; t < T; t += nwg * 8) {
        const int b = t / S; const float* cf = coef_l + (size_t)b * 6 * 2048;
        int rows[7]; rows[0] = t;
#pragma unroll
        for (int k = 0; k < 6; ++k) rows[k + 1] = SLOT[(size_t)t * 6 + k];
        float yv[32];
#pragma unroll
        for (int j = 0; j < 32; ++j) yv[j] = 0.f;
#pragma unroll
        for (int k = 0; k < 7; ++k) {
            if (k == 4) asm volatile("" ::: "memory");
#pragma unroll
            for (int i = 0; i < 4; ++i) { const u32x2 w = *(const u32x2*)(YR + (size_t)rows[k] * 2048 + i * 512 + lane * 8);
                const f32x2 a0 = __builtin_amdgcn_cvt_pk_f32_fp8((int)w.x, false), a1 = __builtin_amdgcn_cvt_pk_f32_fp8((int)w.x, true), a2 = __builtin_amdgcn_cvt_pk_f32_fp8((int)w.y, false), a3 = __builtin_amdgcn_cvt_pk_f32_fp8((int)w.y, true);
                yv[i * 8 + 0] += a0[0]; yv[i * 8 + 1] += a0[1]; yv[i * 8 + 2] += a1[0]; yv[i * 8 + 3] += a1[1]; yv[i * 8 + 4] += a2[0]; yv[i * 8 + 5] += a2[1]; yv[i * 8 + 6] += a3[0]; yv[i * 8 + 7] += a3[1]; } }
        float ss = 0.f;
#pragma unroll
        for (int j = 0; j < 32; ++j) ss += yv[j] * yv[j];
        ss = wave_sum(ss); const float ry = rsqrtf(ss * (1.f / 2048.f) + EPS); float ssx = 0.f;
#pragma unroll
        for (int i = 0; i < 4; ++i) { const int c = i * 512 + lane * 8;
            const f32x4 d0 = *(const f32x4*)(cf + 3 * 2048 + c), d1 = *(const f32x4*)(cf + 3 * 2048 + c + 4);
            const u32x4 xw = *(const u32x4*)(x1 + (size_t)t * 2048 + c); const f32x4 x0 = {bflo(xw.x), bfhi(xw.x), bflo(xw.y), bfhi(xw.y)}, x1v = {bflo(xw.z), bfhi(xw.z), bflo(xw.w), bfhi(xw.w)};
#pragma unroll
            for (int j = 0; j < 4; ++j) { yv[i * 8 + j] = x0[j] + d0[j] * (yv[i * 8 + j] * ry); yv[i * 8 + 4 + j] = x1v[j] + d1[j] * (yv[i * 8 + 4 + j] * ry); }
#pragma unroll
            for (int j = 0; j < 8; ++j) ssx += yv[i * 8 + j] * yv[i * 8 + j];
            if constexpr (OUTF32) { float* xout = (float*)xout_; *(f32x4*)(xout + (size_t)t * 2048 + c) = (f32x4){yv[i * 8 + 0], yv[i * 8 + 1], yv[i * 8 + 2], yv[i * 8 + 3]};
                *(f32x4*)(xout + (size_t)t * 2048 + c + 4) = (f32x4){yv[i * 8 + 4], yv[i * 8 + 5], yv[i * 8 + 6], yv[i * 8 + 7]}; }
            else { u32x4 xo; xo.x = cvt_pk_bf16(yv[i * 8 + 0], yv[i * 8 + 1]); xo.y = cvt_pk_bf16(yv[i * 8 + 2], yv[i * 8 + 3]); xo.z = cvt_pk_bf16(yv[i * 8 + 4], yv[i * 8 + 5]); xo.w = cvt_pk_bf16(yv[i * 8 + 6], yv[i * 8 + 7]);
                *(u32x4*)((bf16_t*)xout_ + (size_t)t * 2048 + c) = xo; } }
        if (coef_next) { const float* cn = coef_next + (size_t)b * 6 * 2048; ssx = wave_sum(ssx); const float rx = rsqrtf(ssx * (1.f / 2048.f) + EPS);
#pragma unroll
            for (int i = 0; i < 4; ++i) { const int c = i * 512 + lane * 8;
                const f32x4 e0 = *(const f32x4*)(cn + 4 * 2048 + c), e1 = *(const f32x4*)(cn + 4 * 2048 + c + 4), f0 = *(const f32x4*)(cn + 5 * 2048 + c), f1 = *(const f32x4*)(cn + 5 * 2048 + c + 4);
                float hv[8];
#pragma unroll
                for (int j = 0; j < 4; ++j) { hv[j] = yv[i * 8 + j] * rx * e0[j] + f0[j]; hv[4 + j] = yv[i * 8 + 4 + j] * rx * e1[j] + f1[j]; }
#ifdef FX_WIN8
                u32x2 w; w.x = cvt_pk4_fp8(hv[0], hv[1], hv[2], hv[3]); w.y = cvt_pk4_fp8(hv[4], hv[5], hv[6], hv[7]);
                *(u32x2*)((unsigned char*)HA + (size_t)t * 2048 + c) = w; } }
#else
                u32x4 w; w.x = cvt_pk_bf16(hv[0], hv[1]); w.y = cvt_pk_bf16(hv[2], hv[3]); w.z = cvt_pk_bf16(hv[4], hv[5]); w.w = cvt_pk_bf16(hv[6], hv[7]);
                *(u32x4*)(HA + (size_t)t * 2048 + c) = w; } }
#endif
    }
}
}
namespace fx {
#ifndef FX_SD_A
#define FX_SD_A 2
#endif
#ifndef FX_SD_B
#define FX_SD_B 1
#endif
#ifndef FX_NQR_B
#define FX_NQR_B 8
#endif
#define FX_SBAR() __builtin_amdgcn_sched_barrier(0)
__device__ __forceinline__ int crow(int r, int hi) { return (r & 3) + 8 * (r >> 2) + 4 * hi; }
__device__ __forceinline__ int v_st(int k, int c) { const int kk = (k & ~0xC) | ((k & 4) << 1) | ((k & 8) >> 1); return ((kk >> 3) * 4 + (c >> 5)) * 512 + ((kk & 7) * 32 + (c & 31)) * 2; }
__device__ __forceinline__ int v_rd_base(int lane) { return ((lane & 3) << 3) | (((lane >> 2) & 3) << 6) | (((lane >> 4) & 1) << 5) | (((lane >> 5) & 1) << 8); }
constexpr int v_rd_off(int d0, int ks, int half) { return d0 * 512 + ks * 4096 + half * 2048; }
template <int OFF> __device__ __forceinline__ s16x4 tr_read(int vb) { s16x4 r; asm volatile("ds_read_b64_tr_b16 %0, %1 offset:%2" : "=&v"(r) : "v"(vb), "i"(OFF) : "memory"); return r; }
#define FX_PK(L, H) (bf16x8){L[0], L[1], L[2], L[3], H[0], H[1], H[2], H[3]}
template <int D0> __device__ __forceinline__ void pv_one(f32x16& od, int vb, bf16x8 pa0, bf16x8 pa1, bf16x8 pa2, bf16x8 pa3) {
    const s16x4 l0 = tr_read<v_rd_off(D0, 0, 0)>(vb), h0 = tr_read<v_rd_off(D0, 0, 1)>(vb), l1 = tr_read<v_rd_off(D0, 1, 0)>(vb), h1 = tr_read<v_rd_off(D0, 1, 1)>(vb);
    const s16x4 l2 = tr_read<v_rd_off(D0, 2, 0)>(vb), h2 = tr_read<v_rd_off(D0, 2, 1)>(vb), l3 = tr_read<v_rd_off(D0, 3, 0)>(vb), h3 = tr_read<v_rd_off(D0, 3, 1)>(vb);
    asm volatile("s_waitcnt lgkmcnt(0)" ::: "memory"); FX_SBAR();
    od = __builtin_amdgcn_mfma_f32_32x32x16_bf16(pa0, FX_PK(l0, h0), od, 0, 0, 0);
    od = __builtin_amdgcn_mfma_f32_32x32x16_bf16(pa1, FX_PK(l1, h1), od, 0, 0, 0);
    od = __builtin_amdgcn_mfma_f32_32x32x16_bf16(pa2, FX_PK(l2, h2), od, 0, 0, 0);
    od = __builtin_amdgcn_mfma_f32_32x32x16_bf16(pa3, FX_PK(l3, h3), od, 0, 0, 0);
}
__device__ __forceinline__ void pv_d0(f32x16* o, int vb, bf16x8 pa0, bf16x8 pa1, bf16x8 pa2, bf16x8 pa3) {
    pv_one<0>(o[0], vb, pa0, pa1, pa2, pa3); pv_one<1>(o[1], vb, pa0, pa1, pa2, pa3); pv_one<2>(o[2], vb, pa0, pa1, pa2, pa3); pv_one<3>(o[3], vb, pa0, pa1, pa2, pa3);
}
#define FX_PK4(P, BASE, OUT) do { unsigned a0 = cvt_pk_bf16(P[BASE + 0], P[BASE + 1]), a1 = cvt_pk_bf16(P[BASE + 2], P[BASE + 3]);   \
    unsigned b0 = cvt_pk_bf16(P[BASE + 4], P[BASE + 5]), b1 = cvt_pk_bf16(P[BASE + 6], P[BASE + 7]);                              \
    auto r0 = __builtin_amdgcn_permlane32_swap(a0, b0, false, false); auto r1 = __builtin_amdgcn_permlane32_swap(a1, b1, false, false); \
    u32x4 w = {r0[0], r1[0], r0[1], r1[1]}; OUT = *reinterpret_cast<bf16x8*>(&w); } while (0)

template <int DQK> struct AttnC {
    static constexpr int NQ = DQK / 16, KROW = DQK * 2, SHM_V = 64 * 128 * 2, SHM_K = 64 * DQK * 2, NQR = (DQK == 128 ? 8 : FX_NQR_B)  , QX = (NQ - NQR) * 8 * 64 * 16, SHM = 2 * SHM_V + 2 * SHM_K + 8 * 64 * 4 + QX;
    static constexpr float SCALE = DQK == 128 ? 0.088388347648318440f : 0.072168783648703220f;
    static constexpr float THR = 8.f;
};
#define FX_KSWZ(row, colB) ((row) * C::KROW + ((colB) ^ (((row) & 7) << 4)))

template <int DQK> __device__ __forceinline__ void partialSM(f32x16& p0, f32x16& p1, float& m_reg, float& mn, float& alpha) {
    using C = AttnC<DQK>;
    constexpr float Cc = C::SCALE * 1.4426950408889634f;
    float pmax = p0[0];
#pragma unroll
    for (int r = 1; r < 16; ++r) pmax = fmaxf(pmax, p0[r]);
#pragma unroll
    for (int r = 0; r < 16; ++r) pmax = fmaxf(pmax, p1[r]);
    { auto rr = __builtin_amdgcn_permlane32_swap(__float_as_uint(pmax), __float_as_uint(pmax), false, false); pmax = fmaxf(__uint_as_float(rr[0]), __uint_as_float(rr[1])); }
    if (__builtin_expect(__all(pmax - m_reg <= C::THR / C::SCALE), 1)) { mn = m_reg; alpha = 1.f; }
    else { mn = fmaxf(m_reg, pmax); alpha = __builtin_amdgcn_exp2f((m_reg - mn) * Cc); m_reg = mn; }
    const float mnC = -mn * Cc;
#pragma unroll
    for (int r = 0; r < 16; ++r) p0[r] = fmaf(p0[r], Cc, mnC);
#pragma unroll
    for (int r = 0; r < 16; ++r) p1[r] = fmaf(p1[r], Cc, mnC);
#pragma unroll
    for (int r = 0; r < 16; ++r) p0[r] = __builtin_amdgcn_exp2f(p0[r]);
}
__device__ __forceinline__ void finishSM(f32x16& p0, f32x16& p1, float alpha, float& l_reg, bf16x8& pa0, bf16x8& pa1, bf16x8& pa2, bf16x8& pa3) {
#pragma unroll
    for (int r = 0; r < 16; ++r) p1[r] = __builtin_amdgcn_exp2f(p1[r]);
    float ps = 0;
#pragma unroll
    for (int r = 0; r < 16; ++r) ps += p0[r];
#pragma unroll
    for (int r = 0; r < 16; ++r) ps += p1[r];
    { auto rr = __builtin_amdgcn_permlane32_swap(__float_as_uint(ps), __float_as_uint(ps), false, false); ps = __uint_as_float(rr[0]) + __uint_as_float(rr[1]); }
    l_reg = l_reg * alpha + ps;
    FX_PK4(p0, 0, pa0); FX_PK4(p0, 8, pa1); FX_PK4(p1, 0, pa2); FX_PK4(p1, 8, pa3);
}
template <int DQK> __device__ __forceinline__ void qkt(f32x16& p0, f32x16& p1, const char* Ks, const bf16x8* qr, const char* qx  , int r32, int hi) {
    using C = AttnC<DQK>;
    p0 = f32x16{}; p1 = f32x16{};
#pragma unroll
    for (int d0 = 0; d0 < C::NQ; ++d0) { const int cb = (d0 * 16 + hi * 8) * 2;
        const bf16x8 qf = d0 < C::NQR ? qr[d0 < C::NQR ? d0 : 0] : *reinterpret_cast<const bf16x8*>(qx + (d0 - C::NQR) * 1024);
        const bf16x8 b0 = *reinterpret_cast<const bf16x8*>(Ks + FX_KSWZ(r32, cb));
        const bf16x8 b1 = *reinterpret_cast<const bf16x8*>(Ks + FX_KSWZ(32 + r32, cb));
        p0 = __builtin_amdgcn_mfma_f32_32x32x16_bf16(b0, qf, p0, 0, 0, 0);
        p1 = __builtin_amdgcn_mfma_f32_32x32x16_bf16(b1, qf, p1, 0, 0, 0); }
}

template <int DQK, int SD, int LDQ, int LDK1, int LDK2, int LDV>
__device__ __forceinline__ void attn_unit(const bf16_t* __restrict__ Qb, const bf16_t* __restrict__ K1, const bf16_t* __restrict__ K2, const bf16_t* __restrict__ Vh,
                                          bf16_t* __restrict__ Ob, const float* __restrict__ gain, int seq, char* lds, int tidp) {
    using C = AttnC<DQK>;
    int tid_ = tidp; asm volatile("" : "+v"(tid_));
    const int tid = tid_, wid = tid >> 6, lane = tid & 63, r32 = lane & 31, hi = lane >> 5;
    char* V_lds = lds; char* K_lds = lds + 2 * C::SHM_V;
    float* ws = (float*)(lds + 2 * C::SHM_V + 2 * C::SHM_K) + wid * 64; float* li_l = ws; float* al_l = ws + 32;
    float m_reg = -1e30f, l_reg = 0; f32x16 o[4] = {}; bf16x8 qr[C::NQR];
    char* qx = lds + 2 * C::SHM_V + 2 * C::SHM_K + 8 * 64 * 4 + wid * ((C::NQ - C::NQR) * 1024) + lane * 16;
    const bf16_t* Qw = Qb + (long)(wid * 32 + r32) * LDQ + hi * 8;
#pragma unroll
    for (int d0 = 0; d0 < C::NQR; ++d0) qr[d0] = *reinterpret_cast<const bf16x8*>(Qw + d0 * 16);
#pragma unroll
    for (int d0 = C::NQR; d0 < C::NQ; ++d0) *reinterpret_cast<bf16x8*>(qx + (d0 - C::NQR) * 1024) = *reinterpret_cast<const bf16x8*>(Qw + d0 * 16);
    const int sr = tid >> 4, sc = (tid & 15) * 8, vst0 = v_st(sr, sc), vst1 = v_st(32 + sr, sc);
    const int vb0 = (int)(uintptr_t)V_lds + v_rd_base(lane);
    const int xr = tid >> 3, xc = (tid & 7) * 8;
    struct { bf16x8 vs0, vs1, ks0, ks1, kx; } sr_[SD];
#define FX_SLOAD(i, k0) do { sr_[i].vs0 = *reinterpret_cast<const bf16x8*>(&Vh[(long)((k0) + sr) * LDV + sc]); sr_[i].vs1 = *reinterpret_cast<const bf16x8*>(&Vh[(long)((k0) + 32 + sr) * LDV + sc]); \
    sr_[i].ks0 = *reinterpret_cast<const bf16x8*>(&K1[(long)((k0) + sr) * LDK1 + sc]); sr_[i].ks1 = *reinterpret_cast<const bf16x8*>(&K1[(long)((k0) + 32 + sr) * LDK1 + sc]); \
    if (DQK == 192) sr_[i].kx = *reinterpret_cast<const bf16x8*>(&K2[(long)((k0) + xr) * LDK2 + xc]); } while (0)
#define FX_SWRITE(b, i) do { *(bf16x8*)(V_lds + (b) * C::SHM_V + vst0) = sr_[i].vs0; *(bf16x8*)(V_lds + (b) * C::SHM_V + vst1) = sr_[i].vs1; const int kc = sc * 2; \
    *(bf16x8*)(K_lds + (b) * C::SHM_K + FX_KSWZ(sr, kc)) = sr_[i].ks0; *(bf16x8*)(K_lds + (b) * C::SHM_K + FX_KSWZ(32 + sr, kc)) = sr_[i].ks1; \
    if (DQK == 192) *(bf16x8*)(K_lds + (b) * C::SHM_K + FX_KSWZ(xr, 256 + xc * 2)) = sr_[i].kx; } while (0)
#define FX_SWAIT() do { if (SD == 1) asm volatile("s_waitcnt vmcnt(0)" ::: "memory"); else if (DQK == 192) asm volatile("s_waitcnt vmcnt(5)" ::: "memory"); else asm volatile("s_waitcnt vmcnt(4)" ::: "memory"); } while (0)
#define FX_RESC(a) do { if (__any((a) < 1.f)) { if (hi == 0) al_l[r32] = (a); asm volatile("s_waitcnt lgkmcnt(0)" ::: "memory"); \
    _Pragma("unroll") for (int d = 0; d < 4; ++d) _Pragma("unroll") for (int r = 0; r < 16; ++r) o[d][r] *= al_l[crow(r, hi)]; } } while (0)
    f32x16 pA0, pA1, pB0, pB1; float mnA, mnB, alA, alB; bf16x8 pa0, pa1, pa2, pa3; const int NT = seq / 64;
    constexpr int SE = 0, SO = SD - 1;
    FX_SLOAD(SE, 0); asm volatile("s_waitcnt vmcnt(0)" ::: "memory"); FX_SWRITE(0, SE); __syncthreads();
    qkt<DQK>(pA0, pA1, K_lds, qr, qx, r32, hi); partialSM<DQK>(pA0, pA1, m_reg, mnA, alA);
    FX_SLOAD(SO, 64); if (SD == 2) { if (2 < NT) FX_SLOAD(SE, 128); }
    FX_SWAIT(); FX_SWRITE(1, SO); __syncthreads();
    for (int j = 1; j + 1 < NT; j += 2) {
        FX_SBAR(); qkt<DQK>(pB0, pB1, K_lds + C::SHM_K, qr, qx, r32, hi);
        finishSM(pA0, pA1, alA, l_reg, pa0, pa1, pa2, pa3); FX_SBAR();
        FX_SLOAD(SO, (j + SD) * 64); FX_SBAR();
        pv_d0(o, vb0, pa0, pa1, pa2, pa3); partialSM<DQK>(pB0, pB1, m_reg, mnB, alB);
        __syncthreads(); FX_SWAIT(); FX_SWRITE(0, SE);
        FX_RESC(alB); __syncthreads();
        FX_SBAR(); qkt<DQK>(pA0, pA1, K_lds, qr, qx, r32, hi);
        finishSM(pB0, pB1, alB, l_reg, pa0, pa1, pa2, pa3); FX_SBAR();
        if (SD == 1 || j + 3 < NT) FX_SLOAD(SE, (j + 1 + SD) * 64); FX_SBAR();
        pv_d0(o, vb0 + C::SHM_V, pa0, pa1, pa2, pa3); partialSM<DQK>(pA0, pA1, m_reg, mnA, alA);
        __syncthreads(); FX_SWAIT(); FX_SWRITE(1, SO);
        FX_RESC(alA); __syncthreads();
    }
    FX_SBAR(); qkt<DQK>(pB0, pB1, K_lds + C::SHM_K, qr, qx, r32, hi);
    finishSM(pA0, pA1, alA, l_reg, pa0, pa1, pa2, pa3); FX_SBAR();
    pv_d0(o, vb0, pa0, pa1, pa2, pa3); partialSM<DQK>(pB0, pB1, m_reg, mnB, alB);
    __syncthreads(); FX_RESC(alB);
    finishSM(pB0, pB1, alB, l_reg, pa0, pa1, pa2, pa3); FX_SBAR();
    pv_d0(o, vb0 + C::SHM_V, pa0, pa1, pa2, pa3);
    if (hi == 0) li_l[r32] = l_reg; asm volatile("s_waitcnt lgkmcnt(0)" ::: "memory");
    int r32e = r32; asm volatile("" : "+v"(r32e));
    float g4[4];
#pragma unroll
    for (int d0 = 0; d0 < 4; ++d0) g4[d0] = gain[d0 * 32 + r32e];
    bf16_t* Ow = Ob + (long)(wid * 32) * 2048;
#pragma unroll
    for (int r = 0; r < 16; ++r) { const float rl = __builtin_amdgcn_rcpf(li_l[crow(r, hi)]);
        float ss = 0.f;
#pragma unroll
        for (int d0 = 0; d0 < 4; ++d0) { o[d0][r] *= rl; ss += o[d0][r] * o[d0][r]; }
        ss += __shfl_xor(ss, 1); ss += __shfl_xor(ss, 2); ss += __shfl_xor(ss, 4); ss += __shfl_xor(ss, 8); ss += __shfl_xor(ss, 16);
        const float rn = rsqrtf(ss * (1.f / 128.f) + EPS); const int orow = crow(r, hi);
#pragma unroll
#ifdef FX_WOUT8
        for (int d0 = 0; d0 < 4; ++d0) ((unsigned char*)Ob)[(long)(wid * 32 + orow) * 2048 + d0 * 32 + r32e] = (unsigned char)(__builtin_amdgcn_cvt_pk_fp8_f32(o[d0][r] * rn * g4[d0], 0.f, 0, false) & 0xff); }
#else
        for (int d0 = 0; d0 < 4; ++d0) Ow[(long)orow * 2048 + d0 * 32 + r32e] = f2bf(o[d0][r] * rn * g4[d0]); }
#endif
    __syncthreads();
#undef FX_SLOAD
#undef FX_SWRITE
#undef FX_SWAIT
#undef FX_RESC
}

__device__ __forceinline__ void attn_gqa_unit(int u, const bf16_t* QA, const bf16_t* KA, const bf16_t* PROJ, bf16_t* YM, const float* hog, char* lds, int tidp) {
    const int qb = u & 15, hh = (u >> 4) % 6, b = u / 96, kvh = hh / 3;
    const size_t t0 = (size_t)b * S;
    attn_unit<128, FX_SD_A, 768, 256, 0, PW>(QA + (t0 + qb * 256) * 768 + hh * 128, KA + t0 * 256 + kvh * 128, nullptr, PROJ + t0 * PW + O_AV + kvh * 128,
#ifdef FX_WOUT8
                                    (bf16_t*)((unsigned char*)YM + (t0 + qb * 256) * 2048 + hh * 128), hog + hh * 128, S, lds, tidp);
#else
                                    YM + (t0 + qb * 256) * 2048 + hh * 128, hog + hh * 128, S, lds, tidp);
#endif
}
__device__ __forceinline__ void attn_mla_unit(int u, const bf16_t* QB, const bf16_t* KVB, const bf16_t* KR, bf16_t* YM, const float* hog, char* lds, int tidp) {
    const int qb = u & 15, hh = (u >> 4) % 6, b = u / 96;
    const size_t t0 = (size_t)b * S;
    attn_unit<192, FX_SD_B, 1280, 1536, 64, 1536>(QB + (t0 + qb * 256) * 1280 + hh * 192, KVB + t0 * 1536 + hh * 256, KR + t0 * 64, KVB + t0 * 1536 + hh * 256 + 128,
#ifdef FX_WOUT8
                                         (bf16_t*)((unsigned char*)YM + (t0 + qb * 256) * 2048 + 768 + hh * 128), hog + 768 + hh * 128, S, lds, tidp);
#else
                                         YM + (t0 + qb * 256) * 2048 + 768 + hh * 128, hog + 768 + hh * 128, S, lds, tidp);
#endif
}
}
namespace fx {
constexpr int P3_LDS = 4096 + 2048 + 65536 + 32768;
constexpr float KSCALE = 0.08838834764831845f;
__device__ __forceinline__ float logsigmoid_f(float f) { return fminf(f, 0.f) - log1pf(__expf(-fabsf(f))); }
__device__ __forceinline__ float wave_scan_incl(float v, int lane) {
#pragma unroll
    for (int o = 1; o < 64; o <<= 1) { const float t = __shfl_up(v, o); if (lane >= o) v += t; }
    return v;
}
__device__ __forceinline__ float wave_scanmax_incl(float v, int lane) {
#pragma unroll
    for (int o = 1; o < 64; o <<= 1) { const float t = __shfl_up(v, o); if (lane >= o) v = fmaxf(v, t); }
    return v;
}
__device__ __forceinline__ float wave_rscanmax_incl(float v, int lane) {
#pragma unroll
    for (int o = 1; o < 64; o <<= 1) { const float t = __shfl_down(v, o); if (lane + o < 64) v = fmaxf(v, t); }
    return v;
}

struct P3Args {
    const bf16_t* PROJ; const float* GATES; const float* gate_b; const float* conv_w; const float* conv_b;
    const float* aq_gain; const float* ak_gain; const float* cq_gain; const float* ckv_gain;
    const float* cosA; const float* sinA; const float* cosB; const float* sinB;
    bf16_t* QA; bf16_t* KA; bf16_t* CQN; bf16_t* CKVN; bf16_t* KR; bf16_t* QC; bf16_t* KC; bf16_t* KCT; float* NLOC; float* GSC;
};
__device__ __forceinline__ void p3_phase(FX_LAS unsigned char* lds_, const P3Args& a, int wg, int nwg, int tidp) {
    char* lds = (char*)lds_;
    float* gat = (float*)lds; float* wts = (float*)(lds + 4096); char* ktile = lds + 6144; char* wv = lds + 6144 + 65536;
    for (int unit = wg; unit < T / 64; unit += nwg) {
        int tid_ = tidp; asm volatile("" : "+v"(tid_));
        const int tid = tid_, wid = tid >> 6, lane = tid & 63;
        const int b = unit >> 6, co = unit & 63; const size_t t0 = (size_t)unit * 64;
        for (int i = tid; i < 1024; i += 512) gat[i] = a.GATES[t0 * 16 + i] + a.gate_b[i & 15];
        __syncthreads();
        { const int dir = wid >> 2, h = wid & 3;
          const float logi = gat[lane * 16 + (dir * 2) * 4 + h], logf = logsigmoid_f(gat[lane * 16 + (dir * 2 + 1) * 4 + h]);
          const float pre = wave_scan_incl(logf, lane), g = __shfl(pre, 63);
          const float bb = dir ? (g - pre + logf) : pre;
          const float av = g - bb + logi, mloc = wave_max(av);
          wts[wid * 64 + lane] = __expf(av - mloc);
          if (lane == 0) { const int chain = (b * 4 + h) * 2 + dir, ci = dir ? 63 - co : co; a.GSC[(chain * 64 + ci) * 2] = g; a.GSC[(chain * 64 + ci) * 2 + 1] = mloc; } }
        __syncthreads();
        { const int c0 = 2 * tid; const bool isk = c0 >= 512; const int hk = (c0 - 512) >> 7, dk = (c0 - 512) & 127;
          float w0[5], w1[5];
#pragma unroll
          for (int j = 0; j < 5; ++j) { w0[j] = a.conv_w[j * 1024 + c0]; w1[j] = a.conv_w[j * 1024 + c0 + 1]; }
          const float cb0 = a.conv_b[c0], cb1 = a.conv_b[c0 + 1];
          float x0[5], x1[5];
          const bf16_t* src = a.PROJ + t0 * PW + O_CQ + c0;
#pragma unroll
          for (int j = 0; j < 4; ++j) { const int sa = co * 64 + j - 2; unsigned w = 0u; if (sa >= 0 && sa < S) w = *(const unsigned*)(src + (long)(j - 2) * PW); x0[j + 1] = bflo(w); x1[j + 1] = bfhi(w); }
          float nf0 = 0.f, nf1 = 0.f, nb0 = 0.f, nb1 = 0.f;
#pragma unroll 1
          for (int s0 = 0; s0 < 64; s0 += 16) {
              unsigned wl[16];
#pragma unroll
              for (int q = 0; q < 16; ++q) { const int sa = co * 64 + s0 + q + 2; wl[q] = 0u; if (sa < S) wl[q] = *(const unsigned*)(src + (long)(s0 + q + 2) * PW); }
#pragma unroll
              for (int q = 0; q < 16; ++q) { const int s = s0 + q;
#pragma unroll
                  for (int j = 0; j < 4; ++j) { x0[j] = x0[j + 1]; x1[j] = x1[j + 1]; }
                  x0[4] = bflo(wl[q]); x1[4] = bfhi(wl[q]);
                  float y0 = cb0, y1 = cb1;
#pragma unroll
                  for (int j = 0; j < 5; ++j) { y0 += w0[j] * x0[j]; y1 += w1[j] * x1[j]; }
                  y0 = silu_f(y0); y1 = silu_f(y1);
                  if (!isk) { *(unsigned*)(a.QC + (t0 + s) * 512 + c0) = cvt_pk_bf16(y0, y1); }
                  else { y0 *= KSCALE; y1 *= KSCALE; const unsigned pk = cvt_pk_bf16(y0, y1);
                      *(unsigned*)(a.KC + (t0 + s) * 512 + (c0 - 512)) = pk;
                      *(unsigned*)(ktile + hk * 16384 + v_st(s, dk & ~7) + (dk & 7) * 2) = pk;
                      const float k0 = bflo(pk), k1 = bfhi(pk); const float wf = wts[hk * 64 + s], wb = wts[(4 + hk) * 64 + s];
                      nf0 += wf * k0; nf1 += wf * k1; nb0 += wb * k0; nb1 += wb * k1; } }
          }
          if (isk) { const int chf = (b * 4 + hk) * 2, chb = chf + 1;
              *(f32x2*)(a.NLOC + ((size_t)chf * 64 + co) * 128 + dk) = (f32x2){nf0, nf1};
              *(f32x2*)(a.NLOC + ((size_t)chb * 64 + (63 - co)) * 128 + dk) = (f32x2){nb0, nb1}; } }
        __syncthreads();
#pragma unroll 1
        for (int h = 0; h < 4; ++h) {
            { const int sr = tid >> 4, sc = (tid & 15) * 8;
#pragma unroll
              for (int rr = 0; rr < 2; ++rr) { const int s = sr + 32 * rr;
                const u32x4 vw = *(const u32x4*)(a.PROJ + (t0 + s) * PW + O_CV + h * 128 + sc);
                const float wf = wts[h * 64 + s], wb = wts[(4 + h) * 64 + s];
                float v[8] = {bflo(vw.x), bfhi(vw.x), bflo(vw.y), bfhi(vw.y), bflo(vw.z), bfhi(vw.z), bflo(vw.w), bfhi(vw.w)};
                u32x4 of, ob;
                of.x = cvt_pk_bf16(v[0] * wf, v[1] * wf); of.y = cvt_pk_bf16(v[2] * wf, v[3] * wf); of.z = cvt_pk_bf16(v[4] * wf, v[5] * wf); of.w = cvt_pk_bf16(v[6] * wf, v[7] * wf);
                ob.x = cvt_pk_bf16(v[0] * wb, v[1] * wb); ob.y = cvt_pk_bf16(v[2] * wb, v[3] * wb); ob.z = cvt_pk_bf16(v[4] * wb, v[5] * wb); ob.w = cvt_pk_bf16(v[6] * wb, v[7] * wb);
                *(u32x4*)(wv + v_st(s, sc)) = of; *(u32x4*)(wv + 16384 + v_st(s, sc)) = ob; } }
            __syncthreads();
            { const int dir = wid >> 2, mb = wid & 3, r32 = lane & 31, hi = lane >> 5;
              const int va = (int)(uintptr_t)(wv + dir * 16384) + v_rd_base(lane) + mb * 512;
              const int kb = (int)(uintptr_t)(ktile + h * 16384) + v_rd_base(lane);
              f32x16 acc[4] = {};
#define FX_KC_STEP(KS) do { \
              const s16x4 al = tr_read<v_rd_off(0, KS, 0)>(va), ah = tr_read<v_rd_off(0, KS, 1)>(va); \
              const s16x4 b0l = tr_read<v_rd_off(0, KS, 0)>(kb), b0h = tr_read<v_rd_off(0, KS, 1)>(kb), b1l = tr_read<v_rd_off(1, KS, 0)>(kb), b1h = tr_read<v_rd_off(1, KS, 1)>(kb); \
              const s16x4 b2l = tr_read<v_rd_off(2, KS, 0)>(kb), b2h = tr_read<v_rd_off(2, KS, 1)>(kb), b3l = tr_read<v_rd_off(3, KS, 0)>(kb), b3h = tr_read<v_rd_off(3, KS, 1)>(kb); \
              asm volatile("s_waitcnt lgkmcnt(0)" ::: "memory"); FX_SBAR(); \
              const bf16x8 af = FX_PK(al, ah); \
              acc[0] = __builtin_amdgcn_mfma_f32_32x32x16_bf16(af, FX_PK(b0l, b0h), acc[0], 0, 0, 0); acc[1] = __builtin_amdgcn_mfma_f32_32x32x16_bf16(af, FX_PK(b1l, b1h), acc[1], 0, 0, 0); \
              acc[2] = __builtin_amdgcn_mfma_f32_32x32x16_bf16(af, FX_PK(b2l, b2h), acc[2], 0, 0, 0); acc[3] = __builtin_amdgcn_mfma_f32_32x32x16_bf16(af, FX_PK(b3l, b3h), acc[3], 0, 0, 0); } while (0)
              FX_KC_STEP(0); FX_KC_STEP(1); FX_KC_STEP(2); FX_KC_STEP(3);
#undef FX_KC_STEP
              const int chain = (b * 4 + h) * 2 + dir, ci = dir ? 63 - co : co;
              bf16_t* dst = a.KCT + ((size_t)chain * 64 + ci) * 16384 + (size_t)(mb * 32) * 128 + r32;
#pragma unroll
              for (int r = 0; r < 16; ++r) { const int v = crow(r, hi);
#pragma unroll
                  for (int nb = 0; nb < 4; ++nb) dst[v * 128 + nb * 32] = f2bf(acc[nb][r]); } }
            __syncthreads();
        }
        { const int f = lane & 31, hf = lane >> 5;
#pragma unroll 8
          for (int it = wid; it < 512; it += 8) { const int s = it >> 3, hd = it & 7; const size_t t = t0 + s;
            const bf16_t* src = a.PROJ + t * PW + hd * 128 + hf * 64;
            float x1 = bf2f(src[f]), x2 = bf2f(src[32 + f]);
            const float ss = wave_sum(x1 * x1 + x2 * x2), r = rsqrtf(ss * (1.f / 128.f) + EPS);
            const float* g = hd < 6 ? a.aq_gain : a.ak_gain;
            x1 *= r * g[hf * 64 + f]; x2 *= r * g[hf * 64 + 32 + f];
            const int pos = hf ? s : co; const float cs = a.cosA[pos * 32 + f], sn = a.sinA[pos * 32 + f];
            bf16_t* dst = hd < 6 ? a.QA + t * 768 + hd * 128 + hf * 64 : a.KA + t * 256 + (hd - 6) * 128 + hf * 64;
            dst[f] = f2bf(x1 * cs - x2 * sn); dst[32 + f] = f2bf(x2 * cs + x1 * sn); } }
#pragma unroll 4
        for (int s = wid; s < 64; s += 8) { const size_t t = t0 + s; const bf16_t* p = a.PROJ + t * PW;
            float q[6]; float ss = 0.f;
#pragma unroll
            for (int i = 0; i < 3; ++i) { const unsigned w = *(const unsigned*)(p + O_BCQ + i * 128 + lane * 2); q[2 * i] = bflo(w); q[2 * i + 1] = bfhi(w); ss += q[2 * i] * q[2 * i] + q[2 * i + 1] * q[2 * i + 1]; }
            ss = wave_sum(ss); float r = rsqrtf(ss * (1.f / 384.f) + EPS);
#pragma unroll
            for (int i = 0; i < 3; ++i) { const int c = i * 128 + lane * 2; *(unsigned*)(a.CQN + t * 384 + c) = cvt_pk_bf16(q[2 * i] * r * a.cq_gain[c], q[2 * i + 1] * r * a.cq_gain[c + 1]); }
            float kv[4]; ss = 0.f;
#pragma unroll
            for (int i = 0; i < 2; ++i) { const unsigned w = *(const unsigned*)(p + O_BCKV + i * 128 + lane * 2); kv[2 * i] = bflo(w); kv[2 * i + 1] = bfhi(w); ss += kv[2 * i] * kv[2 * i] + kv[2 * i + 1] * kv[2 * i + 1]; }
            ss = wave_sum(ss); r = rsqrtf(ss * (1.f / 256.f) + EPS);
#pragma unroll
            for (int i = 0; i < 2; ++i) { const int c = i * 128 + lane * 2; *(unsigned*)(a.CKVN + t * 256 + c) = cvt_pk_bf16(kv[2 * i] * r * a.ckv_gain[c], kv[2 * i + 1] * r * a.ckv_gain[c + 1]); }
            if (lane < 32) { const int f = lane & 15, hf = lane >> 4; const int pos = hf ? s : co; const float cs = a.cosB[pos * 16 + f], sn = a.sinB[pos * 16 + f];
                const float x1 = bf2f(p[O_BKR + hf * 32 + f]), x2 = bf2f(p[O_BKR + hf * 32 + 16 + f]);
                a.KR[t * 64 + hf * 32 + f] = f2bf(x1 * cs - x2 * sn); a.KR[t * 64 + hf * 32 + 16 + f] = f2bf(x2 * cs + x1 * sn); } }
        __syncthreads();
    }
}

__device__ __forceinline__ void scan_phase(const bf16_t* KCT, const float* NLOC, const float* GSC, bf16_t* CPREV, float* NPREV, float* MPREV, int gtid, int nthr) {
    for (int item = gtid; item < 32 * 4096; item += nthr) {
        const int chain = item >> 12, e4 = item & 4095;
        const u32x2* src = (const u32x2*)(KCT + (size_t)chain * 64 * 16384) + e4; u32x2* dst = (u32x2*)(CPREV + (size_t)chain * 64 * 16384) + e4;
        const float* gs = GSC + (size_t)chain * 128;
        const bool don = e4 < 128;
        float c0 = 0.f, c1 = 0.f, c2 = 0.f, c3 = 0.f, nn = 0.f, m = 0.f;
#pragma unroll 1
        for (int cb = 0; cb < 64; cb += 8) {
            u32x2 kc[8]; float nl[8];
#pragma unroll
            for (int j = 0; j < 8; ++j) { kc[j] = src[(size_t)(cb + j) * 4096]; nl[j] = don ? NLOC[((size_t)chain * 64 + cb + j) * 128 + e4] : 0.f; }
#pragma unroll
            for (int j = 0; j < 8; ++j) { const int ci = cb + j; const float g = gs[ci * 2], ml = gs[ci * 2 + 1];
                u32x2 o; o.x = cvt_pk_bf16(c0, c1); o.y = cvt_pk_bf16(c2, c3); dst[(size_t)ci * 4096] = o;
                if (don) NPREV[((size_t)chain * 64 + ci) * 128 + e4] = nn;
                if (e4 == 0) MPREV[chain * 64 + ci] = m;
                const float mn = fmaxf(g + m, ml), dec = __expf(g + m - mn), sl = __expf(ml - mn); m = mn;
                c0 = dec * c0 + sl * bflo(kc[j].x); c1 = dec * c1 + sl * bfhi(kc[j].x); c2 = dec * c2 + sl * bflo(kc[j].y); c3 = dec * c3 + sl * bfhi(kc[j].y);
                nn = dec * nn + sl * nl[j]; }
        }
    }
}

constexpr int MC_K = 0, MC_V = 16384, MC_CT = 32768, MC_HS = 98304, MC_HS_LD = 132, MC_SM = MC_HS + 64 * MC_HS_LD * 4, MC_LDS = MC_SM + 4096;
struct McArgs { const bf16_t* PROJ; const float* GATES; const float* gate_b; const bf16_t* QC; const bf16_t* KC; const bf16_t* CPREV; const float* NPREV; const float* MPREV; const float* hog; bf16_t* YM; };
__device__ __forceinline__ void mlstm_c_phase(FX_LAS unsigned char* lds_, const McArgs& a, int wg, int nwg, int tidp) {
    char* lds = (char*)lds_;
    using C = AttnC<128>;
    float* hs = (float*)(lds + MC_HS);
    float* sm = (float*)(lds + MC_SM);
    for (int unit = wg; unit < NB * 4 * 64; unit += nwg) {
        int tid_ = tidp; asm volatile("" : "+v"(tid_));
        const int tid = tid_, wid = tid >> 6, lane = tid & 63, r32 = lane & 31, hi = lane >> 5;
        const int co = unit & 63, h = (unit >> 6) & 3, b = unit >> 8; const size_t t0 = (size_t)b * S + co * 64;
        if (wid < 2) { const int dir = wid; const int chain = (b * 4 + h) * 2 + dir, ci = dir ? 63 - co : co;
            const float logi = a.GATES[(t0 + lane) * 16 + (dir * 2) * 4 + h] + a.gate_b[(dir * 2) * 4 + h];
            const float logf = logsigmoid_f(a.GATES[(t0 + lane) * 16 + (dir * 2 + 1) * 4 + h] + a.gate_b[(dir * 2 + 1) * 4 + h]);
            const float pre = wave_scan_incl(logf, lane), g = __shfl(pre, 63);
            const float bb = dir ? (g - pre + logf) : pre;
            const float u = logi - bb;
            const float M = dir ? wave_rscanmax_incl(u, lane) : wave_scanmax_incl(u, lane);
            const float mp = a.MPREV[chain * 64 + ci], mmj = fmaxf(mp, M);
            sm[dir * 64 + lane] = u; sm[128 + dir * 64 + lane] = mmj; sm[256 + dir * 64 + lane] = __expf(mp - mmj); sm[384 + dir * 64 + lane] = __expf(-(bb + mmj));
            sm[512 + dir * 128 + lane] = a.NPREV[((size_t)chain * 64 + ci) * 128 + lane]; sm[512 + dir * 128 + 64 + lane] = a.NPREV[((size_t)chain * 64 + ci) * 128 + 64 + lane]; }
        { const int sr = tid >> 4, sc = (tid & 15) * 8;
#pragma unroll
          for (int rr = 0; rr < 2; ++rr) { const int s = sr + 32 * rr;
            *(bf16x8*)(lds + MC_K + FX_KSWZ(s, sc * 2)) = *(const bf16x8*)(a.KC + (t0 + s) * 512 + h * 128 + sc);
            *(bf16x8*)(lds + MC_V + v_st(s, sc)) = *(const bf16x8*)(a.PROJ + (t0 + s) * PW + O_CV + h * 128 + sc); }
#pragma unroll
          for (int dir = 0; dir < 2; ++dir) { const int chain = (b * 4 + h) * 2 + dir, ci = dir ? 63 - co : co; const bf16_t* ct = a.CPREV + ((size_t)chain * 64 + ci) * 16384;
#pragma unroll
            for (int rr = 0; rr < 4; ++rr) { const int v = sr + 32 * rr; *(bf16x8*)(lds + MC_CT + dir * 32768 + FX_KSWZ(v, sc * 2)) = *(const bf16x8*)(ct + v * 128 + sc); } } }
        __syncthreads();
        { const int dir = wid >> 2, rb = (wid >> 1) & 1, cb = wid & 1, j = rb * 32 + r32;
          bf16x8 qr[8];
          const bf16_t* Qw = a.QC + (t0 + j) * 512 + h * 128 + hi * 8;
#pragma unroll
          for (int d0 = 0; d0 < 8; ++d0) qr[d0] = *reinterpret_cast<const bf16x8*>(Qw + d0 * 16);
          f32x16 p0, p1;
          qkt<128>(p0, p1, lds + MC_K, qr, nullptr, r32, hi);
          const float mmj = sm[128 + dir * 64 + j], inter = sm[256 + dir * 64 + j], emn = sm[384 + dir * 64 + j];
          float dsum = 0.f;
#pragma unroll
          for (int r = 0; r < 16; ++r) { const int s0 = crow(r, hi), s1 = 32 + s0;
              const bool v0 = dir ? (s0 >= j) : (s0 <= j), v1 = dir ? (s1 >= j) : (s1 <= j);
              const float w0 = v0 ? __expf(sm[dir * 64 + s0] - mmj) : 0.f, w1 = v1 ? __expf(sm[dir * 64 + s1] - mmj) : 0.f;
              p0[r] *= w0; p1[r] *= w1; dsum += p0[r] + p1[r]; }
          float qn = 0.f;
#pragma unroll
          for (int d0 = 0; d0 < 8; ++d0) { const float* np = sm + 512 + dir * 128 + d0 * 16 + hi * 8; const u32x4 w = *reinterpret_cast<const u32x4*>(&qr[d0]);
              qn += bflo(w.x) * np[0] + bfhi(w.x) * np[1] + bflo(w.y) * np[2] + bfhi(w.y) * np[3] + bflo(w.z) * np[4] + bfhi(w.z) * np[5] + bflo(w.w) * np[6] + bfhi(w.w) * np[7]; }
          { auto rr = __builtin_amdgcn_permlane32_swap(__float_as_uint(dsum), __float_as_uint(dsum), false, false); dsum = __uint_as_float(rr[0]) + __uint_as_float(rr[1]); }
          { auto rr = __builtin_amdgcn_permlane32_swap(__float_as_uint(qn), __float_as_uint(qn), false, false); qn = __uint_as_float(rr[0]) + __uint_as_float(rr[1]); }
          const float den = dsum + inter * qn;
          if (hi == 0) sm[768 + wid * 32 + r32] = 1.f / fmaxf(fabsf(den), emn);
          bf16x8 pa0, pa1, pa2, pa3;
          FX_PK4(p0, 0, pa0); FX_PK4(p0, 8, pa1); FX_PK4(p1, 0, pa2); FX_PK4(p1, 8, pa3);
          f32x16 o[2] = {};
          const int vb = (int)(uintptr_t)(lds + MC_V) + v_rd_base(lane) + cb * 1024;
          pv_one<0>(o[0], vb, pa0, pa1, pa2, pa3); pv_one<1>(o[1], vb, pa0, pa1, pa2, pa3);
          const char* ctb = lds + MC_CT + dir * 32768;
#pragma unroll
          for (int ks = 0; ks < 8; ++ks) { const u32x4 w = *reinterpret_cast<const u32x4*>(&qr[ks]); u32x4 sq;
              sq.x = cvt_pk_bf16(bflo(w.x) * inter, bfhi(w.x) * inter); sq.y = cvt_pk_bf16(bflo(w.y) * inter, bfhi(w.y) * inter); sq.z = cvt_pk_bf16(bflo(w.z) * inter, bfhi(w.z) * inter); sq.w = cvt_pk_bf16(bflo(w.w) * inter, bfhi(w.w) * inter);
              const bf16x8 qs = *reinterpret_cast<const bf16x8*>(&sq); const int colB = (ks * 16 + hi * 8) * 2;
              const bf16x8 c0f = *reinterpret_cast<const bf16x8*>(ctb + FX_KSWZ((2 * cb) * 32 + r32, colB));
              const bf16x8 c1f = *reinterpret_cast<const bf16x8*>(ctb + FX_KSWZ((2 * cb + 1) * 32 + r32, colB));
              o[0] = __builtin_amdgcn_mfma_f32_32x32x16_bf16(qs, c0f, o[0], 0, 0, 0);
              o[1] = __builtin_amdgcn_mfma_f32_32x32x16_bf16(qs, c1f, o[1], 0, 0, 0); }
          asm volatile("s_waitcnt lgkmcnt(0)" ::: "memory");
          float rd[16];
#pragma unroll
          for (int r = 0; r < 16; ++r) rd[r] = sm[768 + wid * 32 + crow(r, hi)];
          if (dir == 0) {
#pragma unroll
              for (int r = 0; r < 16; ++r) { const int row = rb * 32 + crow(r, hi);
                  hs[row * MC_HS_LD + (2 * cb) * 32 + r32] = o[0][r] * rd[r]; hs[row * MC_HS_LD + (2 * cb + 1) * 32 + r32] = o[1][r] * rd[r]; } }
          __syncthreads();
          if (dir == 1) {
#pragma unroll
              for (int r = 0; r < 16; ++r) { const int row = rb * 32 + crow(r, hi);
                  hs[row * MC_HS_LD + (2 * cb) * 32 + r32] += o[0][r] * rd[r]; hs[row * MC_HS_LD + (2 * cb + 1) * 32 + r32] += o[1][r] * rd[r]; } }
          __syncthreads(); }
        { const int row = tid >> 3, c0 = (tid & 7) * 16; const size_t t = t0 + row;
          float v[16]; float ss = 0.f;
#pragma unroll
          for (int i = 0; i < 16; ++i) { v[i] = hs[row * MC_HS_LD + c0 + i]; ss += v[i] * v[i]; }
          ss += __shfl_xor(ss, 1); ss += __shfl_xor(ss, 2); ss += __shfl_xor(ss, 4);
          const float rn = rsqrtf(ss * (1.f / 128.f) + EPS);
          const bf16_t* og = a.PROJ + t * PW + O_CO + h * 128 + c0; const float* gn = a.hog + 1536 + h * 128 + c0;
          const u32x4 g0 = *(const u32x4*)og, g1 = *(const u32x4*)(og + 8);
          const float gg[16] = {bflo(g0.x), bfhi(g0.x), bflo(g0.y), bfhi(g0.y), bflo(g0.z), bfhi(g0.z), bflo(g0.w), bfhi(g0.w), bflo(g1.x), bfhi(g1.x), bflo(g1.y), bfhi(g1.y), bflo(g1.z), bfhi(g1.z), bflo(g1.w), bfhi(g1.w)};
          float ov[16];
#pragma unroll
          for (int i = 0; i < 16; ++i) ov[i] = v[i] * rn * gn[i] * sigmoid_f(gg[i]);
          u32x4 w0, w1; w0.x = cvt_pk_bf16(ov[0], ov[1]); w0.y = cvt_pk_bf16(ov[2], ov[3]); w0.z = cvt_pk_bf16(ov[4], ov[5]); w0.w = cvt_pk_bf16(ov[6], ov[7]);
          w1.x = cvt_pk_bf16(ov[8], ov[9]); w1.y = cvt_pk_bf16(ov[10], ov[11]); w1.z = cvt_pk_bf16(ov[12], ov[13]); w1.w = cvt_pk_bf16(ov[14], ov[15]);
#ifdef FX_WOUT8
          { u32x4 w8; w8.x = cvt_pk4_fp8(ov[0], ov[1], ov[2], ov[3]); w8.y = cvt_pk4_fp8(ov[4], ov[5], ov[6], ov[7]); w8.z = cvt_pk4_fp8(ov[8], ov[9], ov[10], ov[11]); w8.w = cvt_pk4_fp8(ov[12], ov[13], ov[14], ov[15]);
            *(u32x4*)((unsigned char*)a.YM + t * 2048 + 1536 + h * 128 + c0) = w8; (void)w0; (void)w1; } }
#else
          bf16_t* dst = a.YM + t * 2048 + 1536 + h * 128 + c0; *(u32x4*)dst = w0; *(u32x4*)(dst + 8) = w1; }
#endif
        __syncthreads();
    }
}
}
namespace fx {
struct EpiQB {
    static constexpr bool PERM = false;
    bf16_t* O; const float* cosB; const float* sinB;
    __device__ __forceinline__ void operator()(const f32x4 (&acc)[2][2][4][2], const Unit& u, int wr, int wc, int fr, int fq) const {
        const int row0 = u.pm * BM + wr * 64 + fr;
#pragma unroll
        for (int bj = 0; bj < 2; ++bj) { const int G = 8 * u.pn + 4 * bj + wc, gm = G % 6; const int col0 = G * 32 + 4 * fq;
#pragma unroll
            for (int ai = 0; ai < 2; ++ai)
#pragma unroll
                for (int m = 0; m < 4; ++m) { const int row = row0 + ai * HALF + m * 16; f32x4 x1 = acc[ai][bj][m][0], x2 = acc[ai][bj][m][1];
                    if (gm >= 4) { const int s = row & (S - 1), pos = gm == 4 ? (s >> 6) : (s & 63);
                        const f32x4 cs = *(const f32x4*)(cosB + pos * 16 + 4 * fq), sn = *(const f32x4*)(sinB + pos * 16 + 4 * fq);
                        const f32x4 o1 = x1 * cs - x2 * sn, o2 = x2 * cs + x1 * sn; x1 = o1; x2 = o2; }
                    bf16_t* rp = O + (size_t)row * 1280 + col0;
                    u32x2 w0, w1; w0.x = cvt_pk_bf16(x1[0], x1[1]); w0.y = cvt_pk_bf16(x1[2], x1[3]); w1.x = cvt_pk_bf16(x2[0], x2[1]); w1.y = cvt_pk_bf16(x2[2], x2[3]);
                    *(u32x2*)rp = w0; *(u32x2*)(rp + 16) = w1; } }
    }
};
constexpr size_t al256(size_t x) { return (x + 255) & ~(size_t)255; }
constexpr size_t WS_BAR = 0;
constexpr size_t WS_MOD = 16384;
constexpr size_t WS_COEF = WS_MOD + al256(2ull * 4 * 12288 * 4);
constexpr size_t WS_TAB = WS_COEF + al256(2ull * 4 * 6 * 2048 * 4);
constexpr size_t WS_CNT = WS_TAB + al256(6144 * 4);
constexpr size_t WS_WGBASE = WS_CNT + 512;
constexpr size_t WS_SELE = WS_WGBASE + 256 * 64 * 4;
constexpr size_t WS_SELG = WS_SELE + (size_t)T * 6 * 4;
constexpr size_t WS_SLOT = WS_SELG + (size_t)T * 6 * 4;
constexpr size_t WS_ROWTOK = WS_SLOT + (size_t)T * 6 * 4;
constexpr size_t WS_ROWG = WS_ROWTOK + (size_t)PTOT * 4;
constexpr size_t WS_GATES = WS_ROWG + (size_t)PTOT * 4;
constexpr size_t WS_GSC = WS_GATES + (size_t)T * 16 * 4;
constexpr size_t WS_MPREV = WS_GSC + 2048 * 2 * 4;
constexpr size_t WS_NLOC = WS_MPREV + 2048 * 4;
constexpr size_t WS_NPREV = WS_NLOC + 2048ull * 128 * 4;
constexpr size_t WS_W = al256(WS_NPREV + 2048ull * 128 * 4);
constexpr size_t W_IN = 0, W_UQ = W_IN + 4096ull * 2048 * 2, W_UKV = W_UQ + 1280ull * 384 * 2, W_OUT = W_UKV + 1536ull * 256 * 2, W_GU = W_OUT + 2048ull * 2048 * 2, W_DN = W_GU + 65ull * 1024 * 2048 * 2, W_LAYER = W_DN + 65ull * 2048 * 512 * 2;
constexpr size_t WS_XRES = WS_W + 2 * W_LAYER;
constexpr size_t WS_HA = WS_XRES + (size_t)T * 2048 * 4;
constexpr size_t WS_R1 = WS_HA + (size_t)T * 2048 * 2;
constexpr size_t WS_R2 = WS_R1 + (size_t)T * 4096 * 2;
constexpr size_t R2_QA = 0, R2_KA = R2_QA + (size_t)T * 768 * 2, R2_CQN = R2_KA + (size_t)T * 256 * 2, R2_CKVN = R2_CQN + (size_t)T * 384 * 2, R2_KR = R2_CKVN + (size_t)T * 256 * 2,
                 R2_QB = R2_KR + (size_t)T * 64 * 2, R2_KVB = R2_QB + (size_t)T * 1280 * 2, R2_QC = R2_KVB + (size_t)T * 1536 * 2, R2_KC = R2_QC + (size_t)T * 512 * 2,
                 R2_KCT = R2_KC + (size_t)T * 512 * 2, R2_CPREV = R2_KCT + 2048ull * 16384 * 2, R2_END = R2_CPREV + 2048ull * 16384 * 2;
constexpr size_t WS_END = WS_R2 + (size_t)PTOT * 2048 * 2;
static_assert(R2_END <= (size_t)PTOT * 2048 * 2, "R2 overflow");
static_assert(WS_END <= 2147483648ull, "workspace too large");
}
namespace fx {
struct CvtW { const float* w_in; const float* w_uq; const float* w_ukv; const float* w_out; const float* eg; const float* eu; const float* ed; const float* sg; const float* su; const float* sd; bf16_t* W; };
__device__ __forceinline__ void cvt_layer(const CvtW& a, FX_LAS unsigned* my, int gwave, int nwaves, int& rot) {
    const int BIG = 1 << 30; bf16_t* W = a.W;
    bf16_t* WIN = W + W_IN / 2; bf16_t* WUQ = W + W_UQ / 2; bf16_t* WUKV = W + W_UKV / 2; bf16_t* WOUT = W + W_OUT / 2; bf16_t* WGU = W + W_GU / 2; bf16_t* WDN = W + W_DN / 2;
#ifdef FX_WIN8
    { CvtSeg s; s.src = a.w_in; s.dst = WIN; s.sstride = 0; s.dstride = 0; s.ld = 4048; s.nsrc = 4048; s.K = 2048; s.ntn = 64; s.nbatch = 1; s.G = BIG; s.GS = 0; s.off = 0; cvt_seg8(s, my, gwave, nwaves, rot, W8_SCALE); }
#else
    { CvtSeg s; s.src = a.w_in; s.dst = WIN; s.sstride = 0; s.dstride = 0; s.ld = 4048; s.nsrc = 4048; s.K = 2048; s.ntn = 64; s.nbatch = 1; s.G = BIG; s.GS = 0; s.off = 0; cvt_seg(s, my, gwave, nwaves, rot); }
#endif
    { CvtSeg s; s.src = a.w_uq; s.dst = WUQ; s.sstride = 0; s.dstride = 0; s.ld = 1152; s.nsrc = 1152; s.K = 384; s.ntn = 20; s.nbatch = 1; s.G = BIG; s.GS = 0; s.off = 0; cvt_seg(s, my, gwave, nwaves, rot); }
    { CvtSeg s; s.src = a.w_ukv; s.dst = WUKV; s.sstride = 0; s.dstride = 0; s.ld = 1536; s.nsrc = 1536; s.K = 256; s.ntn = 24; s.nbatch = 1; s.G = BIG; s.GS = 0; s.off = 0; cvt_seg(s, my, gwave, nwaves, rot); }
#ifdef FX_WOUT8
    { CvtSeg s; s.src = a.w_out; s.dst = WOUT; s.sstride = 0; s.dstride = 0; s.ld = 2048; s.nsrc = 2048; s.K = 2048; s.ntn = 32; s.nbatch = 1; s.G = BIG; s.GS = 0; s.off = 0; cvt_seg8(s, my, gwave, nwaves, rot, W8_SCALE); }
#else
    { CvtSeg s; s.src = a.w_out; s.dst = WOUT; s.sstride = 0; s.dstride = 0; s.ld = 2048; s.nsrc = 2048; s.K = 2048; s.ntn = 32; s.nbatch = 1; s.G = BIG; s.GS = 0; s.off = 0; cvt_seg(s, my, gwave, nwaves, rot); }
#endif
    { CvtSeg s; s.src = a.eg; s.dst = WGU; s.sstride = 2048ll * 512; s.dstride = 1024ll * 2048; s.ld = 512; s.nsrc = 512; s.K = 2048; s.ntn = 8; s.nbatch = 64; s.G = 128; s.GS = 256; s.off = 0; cvt_seg8(s, my, gwave, nwaves, rot, W8_SCALE); }
    { CvtSeg s; s.src = a.eu; s.dst = WGU; s.sstride = 2048ll * 512; s.dstride = 1024ll * 2048; s.ld = 512; s.nsrc = 512; s.K = 2048; s.ntn = 8; s.nbatch = 64; s.G = 128; s.GS = 256; s.off = 128; cvt_seg8(s, my, gwave, nwaves, rot, W8_SCALE); }
    { CvtSeg s; s.src = a.ed; s.dst = WDN; s.sstride = 512ll * 2048; s.dstride = 2048ll * 512; s.ld = 2048; s.nsrc = 2048; s.K = 512; s.ntn = 32; s.nbatch = 64; s.G = BIG; s.GS = 0; s.off = 0; cvt_seg8(s, my, gwave, nwaves, rot, W8_SCALE); }
    { CvtSeg s; s.src = a.sg; s.dst = (bf16_t*)((unsigned char*)WGU + 64ull * 1024 * 2048); s.sstride = 0; s.dstride = 0; s.ld = 512; s.nsrc = 512; s.K = 2048; s.ntn = 8; s.nbatch = 1; s.G = 128; s.GS = 256; s.off = 0; cvt_seg8(s, my, gwave, nwaves, rot, W8_SCALE); }
    { CvtSeg s; s.src = a.su; s.dst = (bf16_t*)((unsigned char*)WGU + 64ull * 1024 * 2048); s.sstride = 0; s.dstride = 0; s.ld = 512; s.nsrc = 512; s.K = 2048; s.ntn = 8; s.nbatch = 1; s.G = 128; s.GS = 256; s.off = 128; cvt_seg8(s, my, gwave, nwaves, rot, W8_SCALE); }
    { CvtSeg s; s.src = a.sd; s.dst = (bf16_t*)((unsigned char*)WDN + 64ull * 2048 * 512); s.sstride = 0; s.dstride = 0; s.ld = 2048; s.nsrc = 2048; s.K = 512; s.ntn = 32; s.nbatch = 1; s.G = BIG; s.GS = 0; s.off = 0; cvt_seg8(s, my, gwave, nwaves, rot, W8_SCALE); }
}
constexpr int CVT_TILES_PER_LAYER = 2048 + 120 + 96 + 1024 + 3 * 16384 + 3 * 256;
__device__ __forceinline__ void cvt_layer_one(const CvtW& a, FX_LAS unsigned* my, int g) {
    int base = 0;
    const int BIG = 1 << 30; bf16_t* W = a.W;
    bf16_t* WIN = W + W_IN / 2; bf16_t* WUQ = W + W_UQ / 2; bf16_t* WUKV = W + W_UKV / 2; bf16_t* WOUT = W + W_OUT / 2; bf16_t* WGU = W + W_GU / 2; bf16_t* WDN = W + W_DN / 2;
#ifdef FX_WIN8
    { CvtSeg s; s.src = a.w_in; s.dst = WIN; s.sstride = 0; s.dstride = 0; s.ld = 4048; s.nsrc = 4048; s.K = 2048; s.ntn = 64; s.nbatch = 1; s.G = BIG; s.GS = 0; s.off = 0; { const int cnt_ = (s.K / 64) * s.ntn * s.nbatch; if (g >= base && g < base + cnt_) cvt_tile8(s, my, g - base, W8_SCALE); base += cnt_; } }
#else
    { CvtSeg s; s.src = a.w_in; s.dst = WIN; s.sstride = 0; s.dstride = 0; s.ld = 4048; s.nsrc = 4048; s.K = 2048; s.ntn = 64; s.nbatch = 1; s.G = BIG; s.GS = 0; s.off = 0; { const int cnt_ = (s.K / 64) * s.ntn * s.nbatch; if (g >= base && g < base + cnt_) cvt_tile(s, my, g - base); base += cnt_; } }
#endif
    { CvtSeg s; s.src = a.w_uq; s.dst = WUQ; s.sstride = 0; s.dstride = 0; s.ld = 1152; s.nsrc = 1152; s.K = 384; s.ntn = 20; s.nbatch = 1; s.G = BIG; s.GS = 0; s.off = 0; { const int cnt_ = (s.K / 64) * s.ntn * s.nbatch; if (g >= base && g < base + cnt_) cvt_tile(s, my, g - base); base += cnt_; } }
    { CvtSeg s; s.src = a.w_ukv; s.dst = WUKV; s.sstride = 0; s.dstride = 0; s.ld = 1536; s.nsrc = 1536; s.K = 256; s.ntn = 24; s.nbatch = 1; s.G = BIG; s.GS = 0; s.off = 0; { const int cnt_ = (s.K / 64) * s.ntn * s.nbatch; if (g >= base && g < base + cnt_) cvt_tile(s, my, g - base); base += cnt_; } }
#ifdef FX_WOUT8
    { CvtSeg s; s.src = a.w_out; s.dst = WOUT; s.sstride = 0; s.dstride = 0; s.ld = 2048; s.nsrc = 2048; s.K = 2048; s.ntn = 32; s.nbatch = 1; s.G = BIG; s.GS = 0; s.off = 0; { const int cnt_ = (s.K / 64) * s.ntn * s.nbatch; if (g >= base && g < base + cnt_) cvt_tile8(s, my, g - base, W8_SCALE); base += cnt_; } }
#else
    { CvtSeg s; s.src = a.w_out; s.dst = WOUT; s.sstride = 0; s.dstride = 0; s.ld = 2048; s.nsrc = 2048; s.K = 2048; s.ntn = 32; s.nbatch = 1; s.G = BIG; s.GS = 0; s.off = 0; { const int cnt_ = (s.K / 64) * s.ntn * s.nbatch; if (g >= base && g < base + cnt_) cvt_tile(s, my, g - base); base += cnt_; } }
#endif
    { CvtSeg s; s.src = a.eg; s.dst = WGU; s.sstride = 2048ll * 512; s.dstride = 1024ll * 2048; s.ld = 512; s.nsrc = 512; s.K = 2048; s.ntn = 8; s.nbatch = 64; s.G = 128; s.GS = 256; s.off = 0; { const int cnt_ = (s.K / 64) * s.ntn * s.nbatch; if (g >= base && g < base + cnt_) cvt_tile8(s, my, g - base, W8_SCALE); base += cnt_; } }
    { CvtSeg s; s.src = a.eu; s.dst = WGU; s.sstride = 2048ll * 512; s.dstride = 1024ll * 2048; s.ld = 512; s.nsrc = 512; s.K = 2048; s.ntn = 8; s.nbatch = 64; s.G = 128; s.GS = 256; s.off = 128; { const int cnt_ = (s.K / 64) * s.ntn * s.nbatch; if (g >= base && g < base + cnt_) cvt_tile8(s, my, g - base, W8_SCALE); base += cnt_; } }
    { CvtSeg s; s.src = a.ed; s.dst = WDN; s.sstride = 512ll * 2048; s.dstride = 2048ll * 512; s.ld = 2048; s.nsrc = 2048; s.K = 512; s.ntn = 32; s.nbatch = 64; s.G = BIG; s.GS = 0; s.off = 0; { const int cnt_ = (s.K / 64) * s.ntn * s.nbatch; if (g >= base && g < base + cnt_) cvt_tile8(s, my, g - base, W8_SCALE); base += cnt_; } }
    { CvtSeg s; s.src = a.sg; s.dst = (bf16_t*)((unsigned char*)WGU + 64ull * 1024 * 2048); s.sstride = 0; s.dstride = 0; s.ld = 512; s.nsrc = 512; s.K = 2048; s.ntn = 8; s.nbatch = 1; s.G = 128; s.GS = 256; s.off = 0; { const int cnt_ = (s.K / 64) * s.ntn * s.nbatch; if (g >= base && g < base + cnt_) cvt_tile8(s, my, g - base, W8_SCALE); base += cnt_; } }
    { CvtSeg s; s.src = a.su; s.dst = (bf16_t*)((unsigned char*)WGU + 64ull * 1024 * 2048); s.sstride = 0; s.dstride = 0; s.ld = 512; s.nsrc = 512; s.K = 2048; s.ntn = 8; s.nbatch = 1; s.G = 128; s.GS = 256; s.off = 128; { const int cnt_ = (s.K / 64) * s.ntn * s.nbatch; if (g >= base && g < base + cnt_) cvt_tile8(s, my, g - base, W8_SCALE); base += cnt_; } }
    { CvtSeg s; s.src = a.sd; s.dst = (bf16_t*)((unsigned char*)WDN + 64ull * 2048 * 512); s.sstride = 0; s.dstride = 0; s.ld = 2048; s.nsrc = 2048; s.K = 512; s.ntn = 32; s.nbatch = 1; s.G = BIG; s.GS = 0; s.off = 0; { const int cnt_ = (s.K / 64) * s.ntn * s.nbatch; if (g >= base && g < base + cnt_) cvt_tile8(s, my, g - base, W8_SCALE); base += cnt_; } }
}
}
namespace fx {
#define XB_TMO      128
#define XB_XCNT(j)  (256  + 64 * (j))
#define XB_XSUB(j)  (1280 + 64 * (j))
#define XB_XGEN(j)  (2304 + 64 * (j))
#define XB_TOP      3328
#define XB_TOPGEN   3392
#define XCD_BAR_WORDS 3456
#define XB_SPIN_CAP (1u << 22)
__device__ __forceinline__ unsigned xb_ld(unsigned* p)              { return __hip_atomic_load(p, __ATOMIC_RELAXED, __HIP_MEMORY_SCOPE_AGENT); }
__device__ __forceinline__ unsigned xb_add(unsigned* p, unsigned v) { return __hip_atomic_fetch_add(p, v, __ATOMIC_RELAXED, __HIP_MEMORY_SCOPE_AGENT); }
__device__ __forceinline__ unsigned xb_xcc_id() { return (unsigned)__builtin_amdgcn_s_getreg((3 << 11) | 20) & 0xFu; }
#define XB_SPIN(cond, bar) do { unsigned _sp = 0; while (cond) { __builtin_amdgcn_s_sleep(1); \
    if ((++_sp & 255u) == 0u) { if (xb_ld(&(bar)[XB_TMO])) break; if (_sp > XB_SPIN_CAP) { atomicAdd(&(bar)[XB_TMO], 1u); break; } } } } while (0)
struct XcdBarrier { unsigned* bar; unsigned x; volatile FX_LAS unsigned* st; };
__device__ __forceinline__ XcdBarrier xcd_barrier_post(unsigned* bar, volatile FX_LAS unsigned* st, int tidp) {
    XcdBarrier b; b.bar = bar; b.x = xb_xcc_id(); b.st = st;
    if (tidp == 0) (void)xb_add(&bar[XB_XCNT(b.x)], 1u);
    return b;
}
__device__ __forceinline__ void xcd_barrier_complete(unsigned* bar, unsigned x, unsigned& nloc, unsigned& nx) {
    const unsigned G = gridDim.x * gridDim.y * gridDim.z;
    unsigned sum, cnt, mine, sp = 0u;
    for (;;) {
        sum = 0u; cnt = 0u; mine = 0u;
#pragma unroll
        for (unsigned j = 0; j < 16; ++j) { const unsigned c = xb_ld(&bar[XB_XCNT(j)]); sum += c; cnt += (c > 0u) ? 1u : 0u; mine = (j == x) ? c : mine; }
        if (sum == G) break;
        __builtin_amdgcn_s_sleep(1);
        if ((++sp & 255u) == 0u) { if (xb_ld(&bar[XB_TMO])) break; if (sp > XB_SPIN_CAP) { atomicAdd(&bar[XB_TMO], 1u); break; } }
    }
    nloc = mine > 0u ? mine : 1u; nx = cnt > 0u ? cnt : 1u;
}
__device__ __forceinline__ void xcd_barrier(const XcdBarrier& b, int tidp) {
    asm volatile("s_waitcnt vmcnt(0)" ::: "memory");
    __syncthreads();
    if (tidp == 0) {
        unsigned* bar = b.bar;
        __builtin_amdgcn_s_waitcnt(0);
        unsigned nloc = b.st[0], nx = b.st[1];
        if (nloc == 0u) { xcd_barrier_complete(bar, b.x, nloc, nx); b.st[0] = nloc; b.st[1] = nx; }
        const unsigned old = xb_add(&bar[XB_XSUB(b.x)], 1u);
        const unsigned gen = old / nloc;
        if (old + 1u == (gen + 1u) * nloc) {
            __builtin_amdgcn_fence(__ATOMIC_RELEASE, "agent");
            asm volatile("s_waitcnt vmcnt(0)" ::: "memory");
            const unsigned og = xb_add(&bar[XB_TOP], 1u);
            const unsigned tg = og / nx;
            if (og + 1u == (tg + 1u) * nx) xb_add(&bar[XB_TOPGEN], 1u);
            else XB_SPIN(xb_ld(&bar[XB_TOPGEN]) == tg, bar);
            __builtin_amdgcn_fence(__ATOMIC_ACQUIRE, "agent");
            xb_add(&bar[XB_XGEN(b.x)], 1u);
            asm volatile("s_waitcnt vmcnt(0)" ::: "memory");
        } else {
            XB_SPIN(xb_ld(&bar[XB_XGEN(b.x)]) == gen, bar);
            __builtin_amdgcn_fence(__ATOMIC_ACQUIRE, "agent");
            asm volatile("s_waitcnt vmcnt(0)" ::: "memory");
        }
    }
    __syncthreads();
}

__device__ __forceinline__ void modp_phase(FX_LAS unsigned char* lds_, const float* c, const float* ada_w, float* MODP, int wg, int nwg, int tidp) {
    float* cact = (float*)(char*)lds_;
    for (int i = tidp; i < 8192; i += 512) { const float v = c[i]; cact[i] = v / (1.f + expf(-v)); }
    __syncthreads();
    int tid_ = tidp; asm volatile("" : "+v"(tid_));
    const int wid = tid_ >> 6, lane = tid_ & 63;
    for (int u = wg * 8 + wid; u < 2 * 48 * 32; u += nwg * 8) {
        const int kc = u & 31, nc = (u >> 5) % 48, l = u / (48 * 32);
        const float* w = ada_w + (size_t)l * 2048 * 12288 + (size_t)(kc * 64) * 12288 + nc * 256 + lane * 4;
        f32x4 a0 = {0.f, 0.f, 0.f, 0.f}, a1 = a0, a2 = a0, a3 = a0;
#pragma unroll 8
        for (int k = 0; k < 64; ++k) { const f32x4 wv = *(const f32x4*)(w + (size_t)k * 12288); const int kk = kc * 64 + k;
            a0 += wv * cact[kk]; a1 += wv * cact[2048 + kk]; a2 += wv * cact[4096 + kk]; a3 += wv * cact[6144 + kk]; }
        float* dst = MODP + (((size_t)l * 32 + kc) * 4) * 12288 + nc * 256 + lane * 4;
        *(f32x4*)dst = a0; *(f32x4*)(dst + 12288) = a1; *(f32x4*)(dst + 2 * 12288) = a2; *(f32x4*)(dst + 3 * 12288) = a3;
    }
    __syncthreads();
}
__device__ __forceinline__ void tab_phase(float* tab, int gtid) {
    if (gtid < 2048) { const int p = gtid >> 5, f = gtid & 31; const float inv = powf(10000.f, -(float)(2 * f) / 64.f); const float a = (float)p * inv; tab[gtid] = cosf(a); tab[2048 + gtid] = sinf(a); }
    else if (gtid < 3072) { const int i = gtid - 2048, p = i >> 4, f = i & 15; const float inv = powf(10000.f, -(float)(2 * f) / 32.f); const float a = (float)p * inv; tab[4096 + i] = cosf(a); tab[5120 + i] = sinf(a); }
}
__device__ __forceinline__ void coef2_phase(const float* MODP, const float* ada_b, const float* pre_mix_gain, const float* post_mix_gain, const float* pre_ffn_gain, const float* post_ffn_gain, float* coef, int gtid, int nthr) {
    for (int i = gtid; i < 2 * 4 * 2048; i += nthr) { const int d = i & 2047, b = (i >> 11) & 3, l = i >> 13;
        float m[6];
#pragma unroll
        for (int j = 0; j < 6; ++j) { float s = ada_b[l * 12288 + j * 2048 + d];
            for (int kc = 0; kc < 32; ++kc) s += MODP[(((size_t)l * 32 + kc) * 4 + b) * 12288 + j * 2048 + d];
            m[j] = s; }
        float* c = coef + ((size_t)l * 4 + b) * 6 * 2048;
        c[0 * 2048 + d] = m[2] * post_mix_gain[l * 2048 + d];
        c[1 * 2048 + d] = pre_ffn_gain[l * 2048 + d] * (1.f + m[4]);
        c[2 * 2048 + d] = m[3];
        c[3 * 2048 + d] = m[5] * post_ffn_gain[l * 2048 + d];
        c[4 * 2048 + d] = pre_mix_gain[l * 2048 + d] * (1.f + m[1]);
        c[5 * 2048 + d] = m[0]; }
}
__device__ __forceinline__ void prenorm_phase(const float* x, const float* coef_l, bf16_t* HA, int wg, int nwg, int tidp) {
    int tid_ = tidp; asm volatile("" : "+v"(tid_));
    const int wid = tid_ >> 6, lane = tid_ & 63;
    for (int t = wg * 8 + wid; t < T; t += nwg * 8) {
        const float* cn = coef_l + (size_t)(t / S) * 6 * 2048;
        float xv[32]; float ss = 0.f;
#pragma unroll
        for (int i = 0; i < 4; ++i) { const int c = i * 512 + lane * 8; const f32x4 x0 = *(const f32x4*)(x + (size_t)t * 2048 + c), x1 = *(const f32x4*)(x + (size_t)t * 2048 + c + 4);
#pragma unroll
            for (int j = 0; j < 4; ++j) { xv[i * 8 + j] = x0[j]; xv[i * 8 + 4 + j] = x1[j]; ss += x0[j] * x0[j] + x1[j] * x1[j]; } }
        ss = wave_sum(ss); const float rx = rsqrtf(ss * (1.f / 2048.f) + EPS);
#pragma unroll
        for (int i = 0; i < 4; ++i) { const int c = i * 512 + lane * 8;
            const f32x4 e0 = *(const f32x4*)(cn + 4 * 2048 + c), e1 = *(const f32x4*)(cn + 4 * 2048 + c + 4), f0 = *(const f32x4*)(cn + 5 * 2048 + c), f1 = *(const f32x4*)(cn + 5 * 2048 + c + 4);
            float hv[8];
#pragma unroll
            for (int j = 0; j < 4; ++j) { hv[j] = xv[i * 8 + j] * rx * e0[j] + f0[j]; hv[4 + j] = xv[i * 8 + 4 + j] * rx * e1[j] + f1[j]; }
#ifdef FX_WIN8
            u32x2 w; w.x = cvt_pk4_fp8(hv[0], hv[1], hv[2], hv[3]); w.y = cvt_pk4_fp8(hv[4], hv[5], hv[6], hv[7]);
            *(u32x2*)((unsigned char*)HA + (size_t)t * 2048 + c) = w; }
#else
            u32x4 w; w.x = cvt_pk_bf16(hv[0], hv[1]); w.y = cvt_pk_bf16(hv[2], hv[3]); w.z = cvt_pk_bf16(hv[4], hv[5]); w.w = cvt_pk_bf16(hv[6], hv[7]);
            *(u32x4*)(HA + (size_t)t * 2048 + c) = w; }
#endif
    }
}

constexpr int LDS_ST = 139264, LDS_TOTAL = LDS_ST + 64;
constexpr size_t WS_MODP = WS_R2;
struct MP {
    const float* x; const float* c; const float* ada_w; const float* ada_b; const float* pre_mix_gain; const float* w_in; const float* a_q_gain; const float* a_k_gain;
    const float* b_cq_gain; const float* b_ckv_gain; const float* w_uq; const float* w_ukv; const float* c_conv_w; const float* c_conv_b; const float* c_gate_b;
    const float* head_out_gain; const float* w_out; const float* post_mix_gain; const float* pre_ffn_gain; const float* router_w; const float* router_bias;
    const float* exp_w_gate; const float* exp_w_up; const float* exp_w_down; const float* sh_w_gate; const float* sh_w_up; const float* sh_w_down; const float* post_ffn_gain;
    char* ws; float* out;
};
#ifndef FX_NPHASE
#define FX_NPHASE 1000
#endif
#define PH_BEGIN const MP* pk = (const MP*)__builtin_amdgcn_kernarg_segment_ptr(); asm volatile("" : "+s"(pk)); char* ws = pk->ws; (void)ws; int gt_ = wid_s * 64 + fx_lane(); asm volatile("" : "+v"(gt_)); int wg_ = blockIdx.x, nwg_ = gridDim.x; asm volatile("" : "+s"(wg_), "+s"(nwg_)); const int wg = wg_, nwg = nwg_; (void)wg; (void)nwg; (void)gt_;
#define PH_BAR do { PH_BEGIN XcdBarrier b_; b_.bar = (unsigned*)(ws + WS_BAR); b_.x = xb_xcc_id(); b_.st = (volatile FX_LAS unsigned*)(lds + LDS_ST); xcd_barrier(b_, gt_); } while (0)
#define WSP(T_, off) ((T_*)(ws + (off)))
constexpr int QW_CNT = 3584;
constexpr unsigned HV_SLACK = 24;
__device__ __forceinline__ void harvest(FX_LAS unsigned char* lds, const MP* pk, char* ws, int tid, const unsigned nbar, const bool drain) {
    volatile FX_LAS unsigned* bw = (volatile FX_LAS unsigned*)(lds + LDS_ST);
    unsigned* bar = (unsigned*)(ws + WS_BAR);
    const int wave = tid >> 6; FX_LAS unsigned* my = (FX_LAS unsigned*)(lds) + wave * (64 * 33);
    CvtW a; a.w_in = pk->w_in + (size_t)D * 4048; a.w_uq = pk->w_uq + (size_t)384 * 1152; a.w_ukv = pk->w_ukv + (size_t)256 * 1536; a.w_out = pk->w_out + (size_t)D * D;
    a.eg = pk->exp_w_gate + (size_t)NE * D * FF; a.eu = pk->exp_w_up + (size_t)NE * D * FF; a.ed = pk->exp_w_down + (size_t)NE * FF * D;
    a.sg = pk->sh_w_gate + (size_t)D * FF; a.su = pk->sh_w_up + (size_t)D * FF; a.sd = pk->sh_w_down + (size_t)FF * D; a.W = (bf16_t*)(ws + WS_W + W_LAYER);
    __syncthreads();
    if (drain) {
        if (tid == 0) bw[3] = xb_ld(&bar[QW_CNT]);
        __syncthreads();
        const unsigned h = bw[3];
#pragma unroll 1
        for (unsigned g = h + (unsigned)(blockIdx.x * 8 + wave); g < (unsigned)CVT_TILES_PER_LAYER; g += gridDim.x * 8u) cvt_layer_one(a, my, (int)g);
        __syncthreads();
        return;
    }
#pragma unroll 1
    for (;;) {
        if (tid == 0) { unsigned nxt = 0xffffffffu; bool go = true;
            if (!drain) { unsigned sum = 0u;
#pragma unroll
                for (unsigned j = 0; j < 16; ++j) sum += xb_ld(&bar[XB_XSUB(j)]);
                const unsigned G = gridDim.x; go = (sum - nbar * G) + HV_SLACK < G; }
            if (go && xb_ld(&bar[QW_CNT]) < (unsigned)CVT_TILES_PER_LAYER) { const unsigned b0 = xb_add(&bar[QW_CNT], 8u); if (b0 < (unsigned)CVT_TILES_PER_LAYER) nxt = b0; }
            bw[3] = nxt; }
        __syncthreads();
        const unsigned base = bw[3];
        if (base == 0xffffffffu) break;
        const int g = (int)base + wave;
        if (g < CVT_TILES_PER_LAYER) cvt_layer_one(a, my, g);
        __syncthreads();
    }
    __syncthreads();
}
#ifndef FX_HARVEST
#define FX_HARVEST 1
#endif
#define PH_HARVEST(n, dr) do { if (FX_HARVEST && l == 0 && ((dr) || FX_HARVEST == 1)) { PH_BEGIN harvest(lds, pk, ws, gt_, (n), (dr)); } } while (0)
#ifndef FX_DUP
#define FX_DUP -1
#endif
#define FX_NE ((FX_NOEPI && rep_ == 1) ? FX_NOEPI : 0)
#define FX_REP(n) _Pragma("unroll 1") for (int rep_ = 0; rep_ < ((FX_DUP == (n) && l == 0) ? 2 : 1); ++rep_)
template <int l> __device__ __forceinline__ void layer_body(FX_LAS unsigned char* lds, unsigned char* shm, const int wid_s) {
        FX_REP(2) { PH_BEGIN const bf16_t* W = WSP(const bf16_t, WS_W + (size_t)l * W_LAYER);
#ifdef FX_WIN8
          DenseSched Sc; Sc.init(T, 4096, nwg, wg, 2048, W + W_IN / 2, 2048, 1); EpiBf16 E; E.O = WSP(bf16_t, WS_R1); E.gates = WSP(float, WS_GATES); E.ldc = 4096; E.scale = W8_INV;
          gemm_phase<EpiBf16, DenseSched, true>(lds, (const char*)WSP(bf16_t, WS_HA), 2048, Sc, E, gt_, FX_NE); }
#else
          DenseSched Sc; Sc.init(T, 4096, nwg, wg, 2048 * 2, W + W_IN / 2, 2048); EpiBf16 E; E.O = WSP(bf16_t, WS_R1); E.gates = WSP(float, WS_GATES); E.ldc = 4096; E.scale = 1.f;
          gemm_phase<EpiBf16, DenseSched>(lds, (const char*)WSP(bf16_t, WS_HA), 2048, Sc, E, gt_); }
#endif
        PH_HARVEST(3u, false);
        PH_BAR;
        FX_REP(3) { PH_BEGIN char* R2 = ws + WS_R2; float* tab = WSP(float, WS_TAB);
          P3Args a; a.PROJ = WSP(bf16_t, WS_R1); a.GATES = WSP(float, WS_GATES); a.gate_b = pk->c_gate_b + l * 16; a.conv_w = pk->c_conv_w + (size_t)l * 5 * 1024; a.conv_b = pk->c_conv_b + l * 1024;
          a.aq_gain = pk->a_q_gain + l * 128; a.ak_gain = pk->a_k_gain + l * 128; a.cq_gain = pk->b_cq_gain + l * 384; a.ckv_gain = pk->b_ckv_gain + l * 256;
          a.cosA = tab; a.sinA = tab + 2048; a.cosB = tab + 4096; a.sinB = tab + 5120;
          a.QA = (bf16_t*)(R2 + R2_QA); a.KA = (bf16_t*)(R2 + R2_KA); a.CQN = (bf16_t*)(R2 + R2_CQN); a.CKVN = (bf16_t*)(R2 + R2_CKVN); a.KR = (bf16_t*)(R2 + R2_KR); a.QC = (bf16_t*)(R2 + R2_QC); a.KC = (bf16_t*)(R2 + R2_KC);
          a.KCT = (bf16_t*)(R2 + R2_KCT); a.NLOC = WSP(float, WS_NLOC); a.GSC = WSP(float, WS_GSC);
          p3_phase(lds, a, wg, nwg, gt_); }
        PH_BAR;
        FX_REP(4) {
        { PH_BEGIN const bf16_t* W = WSP(const bf16_t, WS_W + (size_t)l * W_LAYER); char* R2 = ws + WS_R2; float* tab = WSP(float, WS_TAB);
          DenseSched Sc; Sc.init(T, 1280, nwg, wg, 384 * 2, W + W_UQ / 2, 384); EpiQB E; E.O = (bf16_t*)(R2 + R2_QB); E.cosB = tab + 4096; E.sinB = tab + 5120;
          gemm_phase<EpiQB, DenseSched>(lds, (const char*)(R2 + R2_CQN), 384, Sc, E, gt_); }
        { PH_BEGIN const bf16_t* W = WSP(const bf16_t, WS_W + (size_t)l * W_LAYER); char* R2 = ws + WS_R2;
          DenseSched Sc; Sc.init(T, 1536, nwg, wg, 256 * 2, W + W_UKV / 2, 256); EpiBf16 E; E.O = (bf16_t*)(R2 + R2_KVB); E.gates = nullptr; E.ldc = 1536; E.scale = 1.f;
          gemm_phase<EpiBf16, DenseSched>(lds, (const char*)(R2 + R2_CKVN), 256, Sc, E, gt_); }
        { PH_BEGIN char* R2 = ws + WS_R2;
          scan_phase((const bf16_t*)(R2 + R2_KCT), WSP(float, WS_NLOC), WSP(float, WS_GSC), (bf16_t*)(R2 + R2_CPREV), WSP(float, WS_NPREV), WSP(float, WS_MPREV), wg * 512 + gt_, nwg * 512); }
        }
        PH_HARVEST(5u, false);
        PH_BAR;
        FX_REP(5) {
#pragma unroll 1
          for (int ui = 0; ui < 2; ++ui) { PH_BEGIN char* R2 = ws + WS_R2; int u;
              if (nwg == 256) { const int x = wg & 7, j = wg >> 3; if (ui == 1 && j >= 16) break; u = x * 48 + j + ui * 32; } else { u = wg + ui * nwg; if (u >= 384) break; }
              attn_gqa_unit(u, (const bf16_t*)(R2 + R2_QA), (const bf16_t*)(R2 + R2_KA), WSP(const bf16_t, WS_R1), WSP(bf16_t, WS_HA), pk->head_out_gain + l * D, (char*)shm, gt_); }
#pragma unroll 1
          for (int ui = 0; ui < 2; ++ui) { PH_BEGIN char* R2 = ws + WS_R2; int u;
              if (nwg == 256) { const int x = wg & 7, j = wg >> 3; if (j < 16) { if (ui == 1) break; u = x * 48 + j; } else u = x * 48 + 16 + (j - 16) * 2 + ui; } else { u = wg + ui * nwg; if (u >= 384) break; }
              attn_mla_unit(u, (const bf16_t*)(R2 + R2_QB), (const bf16_t*)(R2 + R2_KVB), (const bf16_t*)(R2 + R2_KR), WSP(bf16_t, WS_HA), pk->head_out_gain + l * D, (char*)shm, gt_); }
          { PH_BEGIN char* R2 = ws + WS_R2;
            McArgs a; a.PROJ = WSP(bf16_t, WS_R1); a.GATES = WSP(float, WS_GATES); a.gate_b = pk->c_gate_b + l * 16; a.QC = (bf16_t*)(R2 + R2_QC); a.KC = (bf16_t*)(R2 + R2_KC); a.CPREV = (bf16_t*)(R2 + R2_CPREV);
            a.NPREV = WSP(float, WS_NPREV); a.MPREV = WSP(float, WS_MPREV); a.hog = pk->head_out_gain + l * D; a.YM = WSP(bf16_t, WS_HA);
            mlstm_c_phase(lds, a, wg, nwg, gt_); } }
        PH_HARVEST(6u, false);
        PH_BAR;
        FX_REP(6) { PH_BEGIN const bf16_t* W = WSP(const bf16_t, WS_W + (size_t)l * W_LAYER);
#ifdef FX_WOUT8
          DenseSched Sc; Sc.init(T, 2048, nwg, wg, 2048, W + W_OUT / 2, 2048, 1); EpiBf16 E; E.O = WSP(bf16_t, WS_R1); E.gates = nullptr; E.ldc = 2048; E.scale = W8_INV;
          gemm_phase<EpiBf16, DenseSched, true>(lds, (const char*)WSP(bf16_t, WS_HA), 2048, Sc, E, gt_, FX_NE); }
#else
          DenseSched Sc; Sc.init(T, 2048, nwg, wg, 2048 * 2, W + W_OUT / 2, 2048); EpiBf16 E; E.O = WSP(bf16_t, WS_R1); E.gates = nullptr; E.ldc = 2048; E.scale = 1.f;
          gemm_phase<EpiBf16, DenseSched>(lds, (const char*)WSP(bf16_t, WS_HA), 2048, Sc, E, gt_); }
#endif
        PH_HARVEST(7u, false);
        PH_BAR;
        { PH_BEGIN p7_phase<(l != 0)>(lds, l == 0 ? (const void*)pk->x : (const void*)WSP(const bf16_t, WS_XRES), WSP(const bf16_t, WS_R1), WSP(float, WS_COEF) + (size_t)l * 4 * 6 * 2048, pk->router_w + (size_t)l * D * 64, pk->router_bias + l * 64,
                            WSP(bf16_t, WS_XRES), WSP(unsigned char, WS_HA), WSP(int, WS_SELE), WSP(float, WS_SELG), WSP(int, WS_CNT) + l * 64, WSP(int, WS_WGBASE), wg, nwg, gt_); }
        PH_BAR;
        { PH_BEGIN p8_phase(lds, WSP(int, WS_SELE), WSP(float, WS_SELG), WSP(int, WS_CNT) + l * 64, WSP(int, WS_WGBASE), WSP(int, WS_ROWTOK), WSP(float, WS_ROWG), WSP(int, WS_SLOT), wg, nwg, gt_); }
        PH_BAR;
        FX_REP(9) { PH_BEGIN const bf16_t* W = WSP(const bf16_t, WS_W + (size_t)l * W_LAYER);
          p9_phase(lds, WSP(unsigned char, WS_HA), (const unsigned char*)(W + W_GU / 2), WSP(int, WS_CNT) + l * 64, WSP(int, WS_ROWTOK), WSP(unsigned char, WS_R1), wg, nwg, gt_, FX_NE); }
        PH_HARVEST(10u, false);
        PH_BAR;
        FX_REP(10) { PH_BEGIN const bf16_t* W = WSP(const bf16_t, WS_W + (size_t)l * W_LAYER);
          p10_phase(lds, WSP(unsigned char, WS_R1), (const unsigned char*)(W + W_DN / 2), WSP(int, WS_CNT) + l * 64, WSP(float, WS_ROWG), WSP(unsigned char, WS_R2), wg, nwg, gt_, FX_NE); }
        PH_HARVEST(11u, false);
        PH_BAR;
        { PH_BEGIN p11_phase<(l == 1)>(WSP(bf16_t, WS_XRES), WSP(unsigned char, WS_R2), WSP(int, WS_SLOT), WSP(float, WS_COEF) + (size_t)l * 4 * 6 * 2048, l == 0 ? WSP(float, WS_COEF) + 4 * 6 * 2048 : nullptr,
                             l == 1 ? (void*)pk->out : (void*)WSP(bf16_t, WS_XRES), WSP(bf16_t, WS_HA), wg, nwg, gt_); }
        PH_HARVEST(12u, true);
        if (l == 0) PH_BAR;
}
__global__ __launch_bounds__(512, 2) void mega(MP p_unused) {
    extern __shared__ __attribute__((aligned(16))) unsigned char shm[];
    FX_LAS unsigned char* lds = (FX_LAS unsigned char*)shm;
    const int wid_s = __builtin_amdgcn_readfirstlane((int)threadIdx.x >> 6);
    { volatile FX_LAS unsigned* st = (volatile FX_LAS unsigned*)(lds + LDS_ST);
      PH_BEGIN if (gt_ == 0) { st[0] = 0u; st[1] = 0u; st[2] = 0u; st[3] = 0u; }
      __syncthreads();
      (void)xcd_barrier_post((unsigned*)(ws + WS_BAR), st, gt_); }
    { PH_BEGIN const int wave = gt_ >> 6; FX_LAS unsigned* my = (FX_LAS unsigned*)(lds) + wave * (64 * 33); int rot = 0;
#pragma unroll 1
      for (int l = 0; l < ((FX_DUP == 0) ? 4 : (FX_HARVEST ? 1 : 2)); ++l) { const int lw = l & 1; CvtW a; a.w_in = pk->w_in + (size_t)lw * D * 4048; a.w_uq = pk->w_uq + (size_t)lw * 384 * 1152; a.w_ukv = pk->w_ukv + (size_t)lw * 256 * 1536; a.w_out = pk->w_out + (size_t)lw * D * D;
          a.eg = pk->exp_w_gate + (size_t)lw * NE * D * FF; a.eu = pk->exp_w_up + (size_t)lw * NE * D * FF; a.ed = pk->exp_w_down + (size_t)lw * NE * FF * D;
          a.sg = pk->sh_w_gate + (size_t)lw * D * FF; a.su = pk->sh_w_up + (size_t)lw * D * FF; a.sd = pk->sh_w_down + (size_t)lw * FF * D; a.W = (bf16_t*)(ws + WS_W + (size_t)lw * W_LAYER);
          cvt_layer(a, my, wg * 8 + wave, nwg * 8, rot); }
      __syncthreads(); }
    { PH_BEGIN modp_phase(lds, pk->c, pk->ada_w, WSP(float, WS_MODP), wg, nwg, gt_); tab_phase(WSP(float, WS_TAB), wg * 512 + gt_); }
#if FX_DUP == 20
    { PH_BEGIN modp_phase(lds, pk->c, pk->ada_w, WSP(float, WS_MODP), wg, nwg, gt_); tab_phase(WSP(float, WS_TAB), wg * 512 + gt_); }
#endif
    PH_BAR;
    { PH_BEGIN coef2_phase(WSP(float, WS_MODP), pk->ada_b, pk->pre_mix_gain, pk->post_mix_gain, pk->pre_ffn_gain, pk->post_ffn_gain, WSP(float, WS_COEF), wg * 512 + gt_, nwg * 512); }
#if FX_DUP == 21
    { PH_BEGIN coef2_phase(WSP(float, WS_MODP), pk->ada_b, pk->pre_mix_gain, pk->post_mix_gain, pk->pre_ffn_gain, pk->post_ffn_gain, WSP(float, WS_COEF), wg * 512 + gt_, nwg * 512); }
#endif
    PH_BAR;
    { PH_BEGIN prenorm_phase(pk->x, WSP(float, WS_COEF), WSP(bf16_t, WS_HA), wg, nwg, gt_); }
#if FX_DUP == 22
    { PH_BEGIN prenorm_phase(pk->x, WSP(float, WS_COEF), WSP(bf16_t, WS_HA), wg, nwg, gt_); }
#endif
    PH_BAR;
#if FX_DUP == 99
    PH_BAR; PH_BAR; PH_BAR; PH_BAR; PH_BAR; PH_BAR; PH_BAR; PH_BAR; PH_BAR; PH_BAR;
#endif
    layer_body<0>(lds, shm, wid_s);
    layer_body<1>(lds, shm, wid_s);
}
}

extern "C" void kernel_launch(void* const* d_in, const int* in_sizes, int n_in, void* d_out, int out_size, void* d_ws, size_t ws_size, hipStream_t stream) {
    using namespace fx;
    static int grid = 0;
    if (!grid) {
        int dev = 0, cus = 0, per_cu = 0;
        (void)hipGetDevice(&dev);
        (void)hipDeviceGetAttribute(&cus, hipDeviceAttributeMultiprocessorCount, dev);
        (void)hipFuncSetAttribute((const void*)mega, hipFuncAttributeMaxDynamicSharedMemorySize, LDS_TOTAL);
        (void)hipOccupancyMaxActiveBlocksPerMultiprocessor(&per_cu, (const void*)mega, 512, LDS_TOTAL);
        if (cus > 256) cus = 256;
        grid = per_cu >= 1 ? cus : 0;
    }
    if (!grid) return;
    (void)hipMemsetAsync((char*)d_ws + WS_BAR, 0, 16384, stream);
    (void)hipMemsetAsync((char*)d_ws + WS_CNT, 0, 512, stream);
    MP p{};
    const float** q = (const float**)&p;
    for (int i = 0; i < 28; ++i) q[i] = (const float*)d_in[i];
    p.ws = (char*)d_ws; p.out = (float*)d_out;
    hipLaunchKernelGGL(mega, dim3(grid), dim3(512), LDS_TOTAL, stream, p);
}
```

```cpp
#define FX_WIN8 1
#define FX_WOUT8 1
#define FX_HARVEST 0
#include <hip/hip_runtime.h>
#include <stdint.h>
#include <math.h>
#ifndef FX_NOEPI
#define FX_NOEPI 0
#endif
namespace fx {
#define FX_LAS __attribute__((address_space(3)))
typedef unsigned short bf16_t;
typedef short bf16x8 __attribute__((ext_vector_type(8)));
typedef short s16x4 __attribute__((ext_vector_type(4)));
typedef float f32x4 __attribute__((ext_vector_type(4)));
typedef float f32x16 __attribute__((ext_vector_type(16)));
typedef unsigned u32x4 __attribute__((ext_vector_type(4)));
typedef unsigned u32x2 __attribute__((ext_vector_type(2)));
typedef float f32x2 __attribute__((ext_vector_type(2)));

constexpr int D = 2048, NB = 4, S = 4096, T = NB * S, DEPTH = 2;
constexpr int NE = 64, FF = 512;
constexpr float EPS = 1e-6f;
constexpr int PW = 4096;
constexpr int O_AQ = 0, O_AK = 768, O_AV = 1024, O_BCQ = 1280, O_BCKV = 1664, O_BKR = 1920, O_CQ = 1984, O_CK = 2496, O_CV = 3008, O_CO = 3520, O_CG = 4032;

typedef __bf16 bf16x2_t __attribute__((ext_vector_type(2)));
__device__ __forceinline__ unsigned cvt_pk_bf16(float lo, float hi) { const bf16x2_t r = __builtin_convertvector((f32x2){lo, hi}, bf16x2_t); return __builtin_bit_cast(unsigned, r); }
__device__ __forceinline__ float bf2f(bf16_t b) { return __uint_as_float(((unsigned)b) << 16); }
__device__ __forceinline__ float bflo(unsigned w) { return __uint_as_float(w << 16); }
__device__ __forceinline__ float bfhi(unsigned w) { return __uint_as_float(w & 0xffff0000u); }
__device__ __forceinline__ bf16_t f2bf(float f) { return (bf16_t)(cvt_pk_bf16(f, 0.f) & 0xffffu); }
__device__ __forceinline__ float sigmoid_f(float x) { return __builtin_amdgcn_rcpf(1.f + __expf(-x)); }
__device__ __forceinline__ float silu_f(float x) { return x * __builtin_amdgcn_rcpf(1.f + __expf(-x)); }
__device__ __forceinline__ int fx_lane() { unsigned z = 0u; asm volatile("" : "+v"(z)); return (int)__builtin_amdgcn_mbcnt_hi(~0u, __builtin_amdgcn_mbcnt_lo(~0u, z)); }
__device__ __forceinline__ float wave_sum(float v) { for (int o = 32; o >= 1; o >>= 1) v += __shfl_xor(v, o); return v; }
__device__ __forceinline__ float wave_max(float v) { for (int o = 32; o >= 1; o >>= 1) v = fmaxf(v, __shfl_xor(v, o)); return v; }

#ifndef FX_WGM
#define FX_WGM 8
#endif
#ifndef FX_PRIO8
#define FX_PRIO8 1
#endif
#ifndef FX_F8_32
#define FX_F8_32 0
#endif
typedef int i32x8 __attribute__((ext_vector_type(8)));
typedef int i32x4 __attribute__((ext_vector_type(4)));
constexpr float W8_SCALE = 32.f, W8_INV = 1.f / 32.f;
__device__ __forceinline__ unsigned cvt_pk4_fp8(float a, float b, float c, float d) { int w = 0; w = __builtin_amdgcn_cvt_pk_fp8_f32(a, b, w, false); w = __builtin_amdgcn_cvt_pk_fp8_f32(c, d, w, true); return (unsigned)w; }
struct CvtSeg { const float* src; bf16_t* dst; long long sstride, dstride; int ld, nsrc, K, ntn, nbatch, G, GS, off; };
__device__ __forceinline__ void cvt_tile(const CvtSeg sg, FX_LAS unsigned* my, int tile) {
    const int lane = fx_lane();
    const int ktn = sg.K / 64, per = ktn * sg.ntn;
    {
        const int b = tile / per, r = tile - b * per, nt = r / ktn, kt = r - nt * ktn;
        const int r4 = lane >> 4, c4 = lane & 15;
        const float* src = sg.src + (size_t)b * sg.sstride + (size_t)(kt * 64) * sg.ld + nt * 64 + 4 * c4;
        const bool ok = nt * 64 + 4 * c4 < sg.nsrc;
        f32x4 va[8], vb[8];
#pragma unroll
        for (int i = 0; i < 8; ++i) { const int kp = 4 * i + r4; const f32x4 z = {0.f, 0.f, 0.f, 0.f};
            va[i] = ok ? *(const f32x4*)(src + (size_t)(2 * kp) * sg.ld) : z; vb[i] = ok ? *(const f32x4*)(src + (size_t)(2 * kp + 1) * sg.ld) : z; }
#pragma unroll
        for (int i = 0; i < 8; ++i) { const int kp = 4 * i + r4;
#pragma unroll
            for (int j = 0; j < 4; ++j) my[(4 * c4 + j) * 33 + kp] = cvt_pk_bf16(va[i][j], vb[i][j]); }
        asm volatile("s_waitcnt lgkmcnt(0)" ::: "memory");
        bf16_t* dst = sg.dst + (size_t)b * sg.dstride;
#pragma unroll
        for (int i = 0; i < 8; ++i) {
            const int nl = (lane >> 3) + 8 * i, c = lane & 7, n = nt * 64 + nl;
            u32x4 w; w.x = my[nl * 33 + 4 * c]; w.y = my[nl * 33 + 4 * c + 1]; w.z = my[nl * 33 + 4 * c + 2]; w.w = my[nl * 33 + 4 * c + 3];
            const int row = (n / sg.G) * sg.GS + (n % sg.G) + sg.off;
            *(u32x4*)(dst + (size_t)row * sg.K + kt * 64 + 8 * c) = w;
        }
        asm volatile("s_waitcnt lgkmcnt(0)" ::: "memory");
    }
}
__device__ __forceinline__ void cvt_seg(const CvtSeg sg, FX_LAS unsigned* my, int gwave, int nwaves, int& rot) {
    const int total = (sg.K / 64) * sg.ntn * sg.nbatch;
    int first = (gwave - rot) % nwaves; if (first < 0) first += nwaves;
    for (int tile = first; tile < total; tile += nwaves) cvt_tile(sg, my, tile);
    rot = (rot + total) % nwaves;
}
__device__ __forceinline__ void cvt_tile8(const CvtSeg sg, FX_LAS unsigned* my, int tile, float scale) {
    const int lane = fx_lane();
    const int ktn = sg.K / 64, per = ktn * sg.ntn;
    {
        const int b = tile / per, r = tile - b * per, nt = r / ktn, kt = r - nt * ktn;
        const int r4 = lane >> 4, c4 = lane & 15;
        const float* src = sg.src + (size_t)b * sg.sstride + (size_t)(kt * 64) * sg.ld + nt * 64 + 4 * c4;
        const bool ok = nt * 64 + 4 * c4 < sg.nsrc;
        f32x4 v[4][4];
#pragma unroll
        for (int i = 0; i < 4; ++i)
#pragma unroll
            for (int q = 0; q < 4; ++q) { const int kq = 4 * i + r4; const f32x4 z = {0.f, 0.f, 0.f, 0.f}; v[i][q] = ok ? *(const f32x4*)(src + (size_t)(4 * kq + q) * sg.ld) : z; }
#pragma unroll
        for (int i = 0; i < 4; ++i) { const int kq = 4 * i + r4;
#pragma unroll
            for (int j = 0; j < 4; ++j) my[(4 * c4 + j) * 17 + kq] = cvt_pk4_fp8(v[i][0][j] * scale, v[i][1][j] * scale, v[i][2][j] * scale, v[i][3][j] * scale); }
        asm volatile("s_waitcnt lgkmcnt(0)" ::: "memory");
        unsigned char* dst = (unsigned char*)sg.dst + (size_t)b * sg.dstride;
#pragma unroll
        for (int i = 0; i < 4; ++i) {
            const int nl = (lane >> 2) + 16 * i, c = lane & 3, n = nt * 64 + nl;
            u32x4 w; w.x = my[nl * 17 + 4 * c]; w.y = my[nl * 17 + 4 * c + 1]; w.z = my[nl * 17 + 4 * c + 2]; w.w = my[nl * 17 + 4 * c + 3];
            const int row = (n / sg.G) * sg.GS + (n % sg.G) + sg.off;
            *(u32x4*)(dst + (size_t)row * sg.K + kt * 64 + 16 * c) = w;
        }
        asm volatile("s_waitcnt lgkmcnt(0)" ::: "memory");
    }
}
__device__ __forceinline__ void cvt_seg8(const CvtSeg sg, FX_LAS unsigned* my, int gwave, int nwaves, int& rot, float scale) {
    const int total = (sg.K / 64) * sg.ntn * sg.nbatch;
    int first = (gwave - rot) % nwaves; if (first < 0) first += nwaves;
    for (int tile = first; tile < total; tile += nwaves) cvt_tile8(sg, my, tile, scale);
    rot = (rot + total) % nwaves;
}

constexpr int BM = 256, BK = 64, HALF = 128, HTB = HALF * BK * 2, STAGE_BYTES = 8 * HTB, NXCD = 8, WGM = FX_WGM;
__host__ __device__ __forceinline__ int lds_byte(int r, int c) { const int st = (r >> 4) * 2 + (c >> 5), rr = r & 15, cc = c & 31, ob = rr * 64 + cc * 2; return st * 1024 + (ob ^ (((ob >> 9) & 1) << 5)); }
__host__ __device__ __forceinline__ void stage_rc(int b, int& R, int& C) { const int st = b / 1024, sb = b % 1024, swz = sb ^ (((sb >> 9) & 1) << 5); R = (st >> 1) * 16 + swz / 64; C = (st & 1) * 32 + (swz % 64) / 2; }
__host__ __device__ __forceinline__ int perm32(int rho) { const int n = rho >> 4, i = rho & 15; return 8 * (i >> 2) + 4 * n + (i & 3); }
struct Unit { int pm, pn, e; };
struct DenseSched {
    static constexpr bool GATHER = false;
    int nM, nN, nwg, G, c; int lda_b; const char* Bt; int K; int esz;
    __device__ void init(int M, int N, int G_, int c_, int lda_bytes, const void* Bt_, int K_, int esz_ = 2) { nM = M / BM; nN = N / BM; nwg = nM * nN; G = G_; c = c_; lda_b = lda_bytes; Bt = (const char*)Bt_; K = K_; esz = esz_; }
    __device__ __forceinline__ bool next(int i, Unit& u) const {
        const long L = (long)i * G + c; if (L >= nwg) return false;
        int wgid = (int)L; { const int q = nwg / NXCD, r = nwg % NXCD, xcd = wgid % NXCD, off = wgid / NXCD; wgid = (xcd < r ? xcd * (q + 1) : r * (q + 1) + (xcd - r) * q) + off; }
        const int nig = WGM * nN, gid = wgid / nig, fm = gid * WGM, gsz = (nM - fm) < WGM ? (nM - fm) : WGM;
        u.pm = fm + ((wgid % nig) % gsz); u.pn = (wgid % nig) / gsz; u.e = 0; return true;
    }
    __device__ __forceinline__ unsigned a_row_off(const Unit& u, int R) const { return (unsigned)(u.pm * BM + R) * (unsigned)lda_b; }
    __device__ __forceinline__ size_t a_unit_base(const Unit& u) const { return (size_t)u.pm * BM * (size_t)lda_b; }
    __device__ __forceinline__ unsigned a_lane_off(int R) const { return (unsigned)R * (unsigned)lda_b; }
    __device__ __forceinline__ const char* b_ptr(const Unit& u) const { return Bt + (size_t)u.pn * BM * K * esz; }
};

template <class Epi, class Sched, bool FP8 = false>
__device__ __forceinline__ void gemm_phase(FX_LAS unsigned char* lds, const char* Abase, const int Kc, const Sched& S, const Epi& E, int tidp, const int noepi = 0) {
    int K_ = Kc; asm volatile("" : "+s"(K_)); const int K = K_;
    int tid_ = tidp; asm volatile("" : "+v"(tid_));
    const int tid = tid_, wid = __builtin_amdgcn_readfirstlane(tid >> 6), lane = tid & 63, wr = wid >> 2, wc = wid & 3, fr = lane & 15, fq = lane >> 4;
    constexpr int ES = FP8 ? 1 : 2;
    const int nt = K * ES / 128;
    int Rr[2], Cc[2]; unsigned voffB[2];
#pragma unroll
    for (int i = 0; i < 2; ++i) { int R, C; stage_rc(tid * 16 + i * 8192, R, C); Rr[i] = R; Cc[i] = C; const int Rb = (Epi::PERM && !(FP8 && FX_F8_32)) ? ((R & ~31) + perm32(R & 31)) : R; voffB[i] = (unsigned)(Rb * K * ES + C * 2); }
    const size_t hstepB = (size_t)HALF * K * ES;
    const unsigned ldsw = (unsigned)wid * 1024u;
    constexpr bool F32M = FP8 && FX_F8_32;
    const int aoff = F32M ? lds_byte(wr * 64 + (lane & 31), 16 * (lane >> 5)) : lds_byte(wr * 64 + fr, fq * 8), boff = F32M ? lds_byte(wc * 32 + (lane & 31), 16 * (lane >> 5)) : lds_byte(wc * 32 + fr, fq * 8);
#define FX_SA(b, h) (((b) * 2 + (h)) * HTB)
#define FX_SB(b, h) ((4 + (b) * 2 + (h)) * HTB)
#define FX_STAGE_A(bufoff, o0, o1, kb) do { const char* ap_ = Abase + (kb); \
        __builtin_amdgcn_global_load_lds((const unsigned*)(ap_ + (o0)), (FX_LAS unsigned*)(lds + (bufoff) + ldsw), 16, 0, 0); \
        __builtin_amdgcn_global_load_lds((const unsigned*)(ap_ + (o1)), (FX_LAS unsigned*)(lds + (bufoff) + ldsw + 8192), 16, 0, 0); } while (0)
#define FX_STAGE_B(bufoff, gbase) do { _Pragma("unroll") for (int _i = 0; _i < 2; ++_i) \
        __builtin_amdgcn_global_load_lds((const unsigned*)((const char*)(gbase) + voffB[_i]), (FX_LAS unsigned*)(lds + (bufoff) + ldsw + _i * 8192), 16, 0, 0); } while (0)
#define FX_LDA(dst, b, h) do { if constexpr (F32M) { _Pragma("unroll") for (int q = 0; q < 4; ++q) { dst[q][0] = *(const FX_LAS bf16x8*)(lds + FX_SA(b, h) + aoff + (q >> 1) * 4096 + (q & 1) * 1024); dst[q][1] = *(const FX_LAS bf16x8*)(lds + FX_SA(b, h) + aoff + (q >> 1) * 4096 + (q & 1) * 1024 + 16); } } \
        else { _Pragma("unroll") for (int m = 0; m < 4; ++m) _Pragma("unroll") for (int k = 0; k < 2; ++k) dst[m][k] = *(const FX_LAS bf16x8*)(lds + FX_SA(b, h) + aoff + m * 2048 + k * 1024); } } while (0)
#define FX_LDB(dst, b, h) do { if constexpr (F32M) { _Pragma("unroll") for (int q = 0; q < 2; ++q) { dst[q][0] = *(const FX_LAS bf16x8*)(lds + FX_SB(b, h) + boff + q * 1024); dst[q][1] = *(const FX_LAS bf16x8*)(lds + FX_SB(b, h) + boff + q * 1024 + 16); } } \
        else { _Pragma("unroll") for (int n = 0; n < 2; ++n) _Pragma("unroll") for (int k = 0; k < 2; ++k) dst[n][k] = *(const FX_LAS bf16x8*)(lds + FX_SB(b, h) + boff + n * 2048 + k * 1024); } } while (0)
#define FX_MMA(ai, bj, At, Bt) do { if (!FP8 || FX_PRIO8) __builtin_amdgcn_s_setprio(1); \
        if constexpr (F32M) { _Pragma("unroll") for (int mb = 0; mb < 2; ++mb) _Pragma("unroll") for (int s = 0; s < 2; ++s) { \
            const i32x4 a0_ = __builtin_bit_cast(i32x4, At[mb * 2 + s][0]), a1_ = __builtin_bit_cast(i32x4, At[mb * 2 + s][1]), b0_ = __builtin_bit_cast(i32x4, Bt[s][0]), b1_ = __builtin_bit_cast(i32x4, Bt[s][1]); \
            const i32x8 af_ = __builtin_shufflevector(a0_, a1_, 0, 1, 2, 3, 4, 5, 6, 7), bf_ = __builtin_shufflevector(b0_, b1_, 0, 1, 2, 3, 4, 5, 6, 7); \
            asm volatile("v_mfma_scale_f32_32x32x64_f8f6f4 %0, %1, %2, %0, %3, %3 op_sel_hi:[0,0,0]" : "+v"(acc3[ai][bj][mb]) : "v"(bf_), "v"(af_), "v"(sc1_)); } } else \
        _Pragma("unroll") for (int m = 0; m < 4; ++m) _Pragma("unroll") for (int n = 0; n < 2; ++n) { \
        if constexpr (FP8) { const i32x4 a0_ = __builtin_bit_cast(i32x4, At[m][0]), a1_ = __builtin_bit_cast(i32x4, At[m][1]), b0_ = __builtin_bit_cast(i32x4, Bt[n][0]), b1_ = __builtin_bit_cast(i32x4, Bt[n][1]); \
            const i32x8 af_ = __builtin_shufflevector(a0_, a1_, 0, 1, 2, 3, 4, 5, 6, 7), bf_ = __builtin_shufflevector(b0_, b1_, 0, 1, 2, 3, 4, 5, 6, 7); \
            asm volatile("v_mfma_scale_f32_16x16x128_f8f6f4 %0, %1, %2, %0, %3, %3 op_sel_hi:[0,0,0]" : "+v"(acc[ai][bj][m][n]) : "v"(bf_), "v"(af_), "v"(sc1_)); FX_MFMA_DUP(acc[ai][bj][m][n]) } \
        else { _Pragma("unroll") for (int k = 0; k < 2; ++k) acc[ai][bj][m][n] = __builtin_amdgcn_mfma_f32_16x16x32_bf16(Bt[n][k], At[m][k], acc[ai][bj][m][n], 0, 0, 0); } } \
        if (!FP8 || FX_PRIO8) __builtin_amdgcn_s_setprio(0); } while (0)
#define FX_WAIT_V(n) asm volatile("s_waitcnt vmcnt(" #n ")" ::: "memory")
#define FX_WAIT_L(n) asm volatile("s_waitcnt lgkmcnt(" #n ")" ::: "memory")
#define FX_BAR __builtin_amdgcn_s_barrier()
#define FX_SCHED __builtin_amdgcn_sched_barrier(0)
#ifdef FX_PROBE_MFMA
#define FX_MFMA_DUP(ACC) asm volatile("v_mfma_scale_f32_16x16x128_f8f6f4 %0, %1, %2, %0, %3, %3 op_sel_hi:[0,0,0]" : "+v"(ACC) : "v"(bf_), "v"(af_), "v"(sc0_));
#else
#define FX_MFMA_DUP(ACC)
#endif
    const int sc0_ = 0; (void)sc0_;
    const int sc1_ = 0x7f7f7f7f;
    (void)sc1_;
    Unit cur, nxt; int ui = 0;
    if (!S.next(0, cur)) return;
    f32x4 acc[2][2][4][2];
#pragma unroll
    for (int a = 0; a < 2; ++a)
#pragma unroll
        for (int b = 0; b < 2; ++b)
#pragma unroll
            for (int m = 0; m < 4; ++m)
#pragma unroll
                for (int n = 0; n < 2; ++n) acc[a][b][m][n] = (f32x4){0.f, 0.f, 0.f, 0.f};
    f32x16 acc3[2][2][2];
#pragma unroll
    for (int q = 0; q < 8; ++q) acc3[q >> 2][(q >> 1) & 1][q & 1] = f32x16{};
    bf16x8 At[4][2], B0[2][2], B1[2][2];
    unsigned c00, c01, c10, c11, n00 = 0, n01 = 0, n10 = 0, n11 = 0;
    size_t ubc = 0, ubn = 0;
    if constexpr (Sched::GATHER) { c00 = S.a_row_off(cur, Rr[0]) + Cc[0] * 2; c01 = S.a_row_off(cur, Rr[1]) + Cc[1] * 2; c10 = S.a_row_off(cur, HALF + Rr[0]) + Cc[0] * 2; c11 = S.a_row_off(cur, HALF + Rr[1]) + Cc[1] * 2; }
    else { c00 = S.a_lane_off(Rr[0]) + Cc[0] * 2; c01 = S.a_lane_off(Rr[1]) + Cc[1] * 2; c10 = c00 + S.a_lane_off(HALF); c11 = c01 + S.a_lane_off(HALF); ubc = S.a_unit_base(cur); n00 = c00; n01 = c01; n10 = c10; n11 = c11; }
    const char* cB = S.b_ptr(cur);
    const unsigned kstep = BK * 2;
    FX_STAGE_B(FX_SB(0, 0), cB); FX_STAGE_A(FX_SA(0, 0), c00, c01, ubc); FX_STAGE_B(FX_SB(0, 1), cB + hstepB); FX_STAGE_A(FX_SA(0, 1), c10, c11, ubc);
    if (wr == 1) FX_BAR;
    FX_WAIT_V(4); FX_BAR;
    FX_STAGE_B(FX_SB(1, 0), cB + kstep); FX_STAGE_A(FX_SA(1, 0), c00, c01, ubc + kstep); FX_STAGE_B(FX_SB(1, 1), cB + hstepB + kstep);
    FX_WAIT_V(6); FX_BAR;
    for (;;) {
        const bool has_next = S.next(ui + 1, nxt);
        if (!has_next) nxt = cur;
        if constexpr (!Sched::GATHER) ubn = S.a_unit_base(nxt);
        const char* nB = S.b_ptr(nxt);
        for (int t = 0; t < nt; t += 2) {
            const bool last = (t == nt - 2);
            asm volatile("" : "+v"(c00), "+v"(c01), "+v"(c10), "+v"(c11), "+v"(voffB[0]), "+v"(voffB[1]));
            if constexpr (Sched::GATHER) { if (last) {
                int t2_ = tid; asm volatile("" : "+v"(t2_)); int R0_, C0_, R1_, C1_; stage_rc(t2_ * 16, R0_, C0_); stage_rc(t2_ * 16 + 8192, R1_, C1_);
                n00 = S.a_row_off(nxt, R0_) + C0_ * 2; n01 = S.a_row_off(nxt, R1_) + C1_ * 2; n10 = S.a_row_off(nxt, HALF + R0_) + C0_ * 2; n11 = S.a_row_off(nxt, HALF + R1_) + C1_ * 2; } }
            const size_t k1 = ubc + (size_t)(t + 1) * kstep;
            const size_t k2 = last ? ubn : ubc + (size_t)(t + 2) * kstep, k3 = k2 + kstep;
            unsigned a00, a01, a10, a11;
            if constexpr (Sched::GATHER) { a00 = last ? n00 : c00; a01 = last ? n01 : c01; a10 = last ? n10 : c10; a11 = last ? n11 : c11; } else { a00 = c00; a01 = c01; a10 = c10; a11 = c11; }
            const char* b2 = last ? nB : cB + (size_t)(t + 2) * kstep; const char* b3 = b2 + kstep;
            FX_LDB(B0, 0, 0); FX_SCHED; FX_LDA(At, 0, 0); FX_STAGE_A(FX_SA(1, 1), c10, c11, k1);
            FX_WAIT_L(8); FX_BAR; FX_WAIT_L(0); FX_MMA(0, 0, At, B0); FX_BAR; FX_SCHED;
            FX_LDB(B1, 0, 1); FX_STAGE_B(FX_SB(0, 0), b2);
            FX_BAR; FX_WAIT_L(0); FX_MMA(0, 1, At, B1); FX_BAR;
            FX_LDA(At, 0, 1); FX_STAGE_A(FX_SA(0, 0), a00, a01, k2);
            FX_BAR; FX_WAIT_L(0); FX_MMA(1, 0, At, B0); FX_BAR; FX_SCHED;
            FX_STAGE_B(FX_SB(0, 1), b2 + hstepB);
            FX_WAIT_V(6); FX_BAR; FX_MMA(1, 1, At, B1); FX_BAR;
            FX_LDB(B0, 1, 0); FX_SCHED; FX_LDA(At, 1, 0); FX_STAGE_A(FX_SA(0, 1), a10, a11, k2);
            FX_WAIT_L(8); FX_BAR; FX_WAIT_L(0); FX_MMA(0, 0, At, B0); FX_BAR; FX_SCHED;
            FX_LDB(B1, 1, 1); FX_STAGE_B(FX_SB(1, 0), b3);
            FX_BAR; FX_WAIT_L(0); FX_MMA(0, 1, At, B1); FX_BAR;
            FX_LDA(At, 1, 1); FX_STAGE_A(FX_SA(1, 0), a00, a01, k3);
            FX_BAR; FX_WAIT_L(0); FX_MMA(1, 0, At, B0); FX_BAR; FX_SCHED;
            FX_STAGE_B(FX_SB(1, 1), b3 + hstepB);
            FX_WAIT_V(6); FX_BAR; FX_MMA(1, 1, At, B1); FX_BAR;
        }
        if constexpr (FP8) asm volatile("s_nop 15\n\ts_nop 15\n\ts_nop 15\n\ts_nop 15" ::: "memory");
        if constexpr (F32M) { int ln_e = lane; asm volatile("" : "+v"(ln_e)); E.e32(acc3, cur, wr, wc, ln_e); }
        else if (noepi) { f32x4 s_ = (f32x4){0.f, 0.f, 0.f, 0.f};
#pragma unroll
            for (int q_ = 0; q_ < 32; ++q_) s_ += acc[q_ >> 4][(q_ >> 3) & 1][(q_ >> 1) & 3][q_ & 1];
            if (s_[0] + s_[1] + s_[2] + s_[3] == 1.2345e-30f) *(float*)const_cast<char*>(Abase) = s_[0]; }
        else { int fr_e = fr, fq_e = fq; asm volatile("" : "+v"(fr_e), "+v"(fq_e)); E(acc, cur, wr, wc, fr_e, fq_e); }
        if (!has_next) break;
        if constexpr (F32M) { _Pragma("unroll") for (int q = 0; q < 8; ++q) acc3[q >> 2][(q >> 1) & 1][q & 1] = f32x16{}; }
#pragma unroll
        for (int a = 0; a < 2; ++a)
#pragma unroll
            for (int b = 0; b < 2; ++b)
#pragma unroll
                for (int m = 0; m < 4; ++m)
#pragma unroll
                    for (int n = 0; n < 2; ++n) acc[a][b][m][n] = (f32x4){0.f, 0.f, 0.f, 0.f};
        cur = nxt; cB = nB; if constexpr (Sched::GATHER) { c00 = n00; c01 = n01; c10 = n10; c11 = n11; } else ubc = ubn; ++ui;
    }
    FX_WAIT_V(0);
    if (wr == 0) FX_BAR;
    FX_BAR;
}

struct EpiBf16 {
    static constexpr bool PERM = true;
    bf16_t* O; float* gates; int ldc; float scale;
    __device__ __forceinline__ void operator()(const f32x4 (&acc)[2][2][4][2], const Unit& u, int wr, int wc, int fr, int fq) const {
        const int row0 = u.pm * BM + wr * 64 + fr, col0 = u.pn * BM + wc * 32 + 8 * fq;
#pragma unroll
        for (int ai = 0; ai < 2; ++ai)
#pragma unroll
            for (int m = 0; m < 4; ++m) { const int row = row0 + ai * HALF + m * 16; bf16_t* rowp = O + (size_t)row * ldc + col0;
#pragma unroll
                for (int bj = 0; bj < 2; ++bj) { const f32x4 v0 = acc[ai][bj][m][0] * scale, v1 = acc[ai][bj][m][1] * scale;
                    u32x4 w; w.x = cvt_pk_bf16(v0[0], v0[1]); w.y = cvt_pk_bf16(v0[2], v0[3]); w.z = cvt_pk_bf16(v1[0], v1[1]); w.w = cvt_pk_bf16(v1[2], v1[3]);
                    *(u32x4*)(rowp + bj * HALF) = w; }
                if (gates && u.pn == 15 && wc == 2 && fq < 2) { float* g = gates + (size_t)row * 16 + 8 * fq; *(f32x4*)g = acc[ai][1][m][0] * scale; *(f32x4*)(g + 4) = acc[ai][1][m][1] * scale; } }
    }
    __device__ __forceinline__ void e32(const f32x16 (&acc3)[2][2][2], const Unit& u, int wr, int wc, int lane) const {
        const int j = lane & 31, hi = lane >> 5;
#pragma unroll
        for (int ai = 0; ai < 2; ++ai)
#pragma unroll
            for (int mb = 0; mb < 2; ++mb) { const int row = u.pm * BM + ai * HALF + wr * 64 + mb * 32 + j;
#pragma unroll
                for (int bj = 0; bj < 2; ++bj) { bf16_t* rowp = O + (size_t)row * ldc + u.pn * BM + bj * HALF + wc * 32 + 4 * hi;
#pragma unroll
                    for (int g = 0; g < 4; ++g) { u32x2 w; w.x = cvt_pk_bf16(acc3[ai][bj][mb][4 * g] * scale, acc3[ai][bj][mb][4 * g + 1] * scale); w.y = cvt_pk_bf16(acc3[ai][bj][mb][4 * g + 2] * scale, acc3[ai][bj][mb][4 * g + 3] * scale);
                        *(u32x2*)(rowp + 8 * g) = w; } }
                if (gates && u.pn == 15 && wc == 2) { float* gp = gates + (size_t)row * 16 + 4 * hi;
#pragma unroll
                    for (int g = 0; g < 2; ++g) *(f32x4*)(gp + 8 * g) = (f32x4){acc3[ai][1][mb][4 * g] * scale, acc3[ai][1][mb][4 * g + 1] * scale, acc3[ai][1][mb][4 * g + 2] * scale, acc3[ai][1][mb][4 * g + 3] * scale}; } }
    }
};
}
#ifndef FX_RUNR
#define FX_RUNR 16
#endif
namespace fx {
constexpr int RT = 16;
constexpr int H2S_LD = 2052;
constexpr int P7_LDS = RT * H2S_LD * 4 + 512;
constexpr int PTOT = 131072;
constexpr int NTILE_MAX = PTOT / 256;

__device__ __forceinline__ void coef_phase(const float* mod, const float* pre_mix_gain, const float* post_mix_gain, const float* pre_ffn_gain, const float* post_ffn_gain, float* coef, int gtid, int nthr) {
    for (int i = gtid; i < 2 * 4 * 2048; i += nthr) { const int d = i & 2047, b = (i >> 11) & 3, l = i >> 13;
        const float* m = mod + ((size_t)l * 4 + b) * 12288; float* c = coef + ((size_t)l * 4 + b) * 6 * 2048;
        c[0 * 2048 + d] = m[2 * 2048 + d] * post_mix_gain[l * 2048 + d];
        c[1 * 2048 + d] = pre_ffn_gain[l * 2048 + d] * (1.f + m[4 * 2048 + d]);
        c[2 * 2048 + d] = m[3 * 2048 + d];
        c[3 * 2048 + d] = m[5 * 2048 + d] * post_ffn_gain[l * 2048 + d];
        c[4 * 2048 + d] = pre_mix_gain[l * 2048 + d] * (1.f + m[1 * 2048 + d]);
        c[5 * 2048 + d] = m[0 * 2048 + d]; }
}

template <bool XBF>
__device__ __forceinline__ void p7_phase(FX_LAS unsigned char* lds, const void* xin_, const bf16_t* Y, const float* coef_l  , const float* router_w, const float* router_bias,
                                         bf16_t* XRES, unsigned char* HA8, int* SELE, float* SELG, int* CNT, int* WGBASE, int wg, int nwg, int tidp) {
    int tid_ = tidp; asm volatile("" : "+v"(tid_));
    const int tid = tid_, wid = tid >> 6, lane = tid & 63;
    FX_LAS float* h2s = (FX_LAS float*)lds;
    FX_LAS int* hist = (FX_LAS int*)(lds + RT * H2S_LD * 4);
    if (tid < 64) hist[tid] = 0;
    __syncthreads();
#define FX_GC(TY, p) ((const __attribute__((address_space(1))) TY*)(p))
#define FX_GM(TY, p) ((__attribute__((address_space(1))) TY*)(p))
    const int i16 = lane & 15, g4 = lane >> 4;
    for (int unit = wg; unit < T / RT; unit += nwg) {
        {
            const int tok0 = 2 * wid, t0 = unit * RT + tok0, b = t0 / S;
            const float* cf = coef_l + (size_t)b * 6 * 2048;
            u32x4 yw[2][4]; f32x4 ca[8];
            float xv[2][32];
#pragma unroll
            for (int tt = 0; tt < 2; ++tt)
#pragma unroll
                for (int i = 0; i < 4; ++i) yw[tt][i] = *FX_GC(u32x4, Y + (size_t)(t0 + tt) * 2048 + i * 512 + lane * 8);
            if constexpr (XBF) {
                u32x4 xw[2][4];
#pragma unroll
                for (int tt = 0; tt < 2; ++tt)
#pragma unroll
                    for (int i = 0; i < 4; ++i) xw[tt][i] = *FX_GC(u32x4, (const bf16_t*)xin_ + (size_t)(t0 + tt) * 2048 + i * 512 + lane * 8);
#pragma unroll
                for (int i = 0; i < 4; ++i) { ca[2 * i] = *FX_GC(f32x4, cf + i * 512 + lane * 8); ca[2 * i + 1] = *FX_GC(f32x4, cf + i * 512 + lane * 8 + 4); }
#pragma unroll
                for (int tt = 0; tt < 2; ++tt)
#pragma unroll
                    for (int i = 0; i < 4; ++i) { const u32x4 w = xw[tt][i];
                        xv[tt][i * 8 + 0] = bflo(w.x); xv[tt][i * 8 + 1] = bfhi(w.x); xv[tt][i * 8 + 2] = bflo(w.y); xv[tt][i * 8 + 3] = bfhi(w.y); xv[tt][i * 8 + 4] = bflo(w.z); xv[tt][i * 8 + 5] = bfhi(w.z); xv[tt][i * 8 + 6] = bflo(w.w); xv[tt][i * 8 + 7] = bfhi(w.w); }
            } else {
                const float* xin = (const float*)xin_;
#pragma unroll
                for (int tt = 0; tt < 2; ++tt)
#pragma unroll
                    for (int i = 0; i < 4; ++i) { const f32x4 x0 = *FX_GC(f32x4, xin + (size_t)(t0 + tt) * 2048 + i * 512 + lane * 8), x1 = *FX_GC(f32x4, xin + (size_t)(t0 + tt) * 2048 + i * 512 + lane * 8 + 4);
                        xv[tt][i * 8 + 0] = x0[0]; xv[tt][i * 8 + 1] = x0[1]; xv[tt][i * 8 + 2] = x0[2]; xv[tt][i * 8 + 3] = x0[3]; xv[tt][i * 8 + 4] = x1[0]; xv[tt][i * 8 + 5] = x1[1]; xv[tt][i * 8 + 6] = x1[2]; xv[tt][i * 8 + 7] = x1[3]; }
#pragma unroll
                for (int i = 0; i < 4; ++i) { ca[2 * i] = *FX_GC(f32x4, cf + i * 512 + lane * 8); ca[2 * i + 1] = *FX_GC(f32x4, cf + i * 512 + lane * 8 + 4); }
            }
            float ssy0 = 0.f, ssy1 = 0.f;
#pragma unroll
            for (int i = 0; i < 4; ++i) { const u32x4 w0 = yw[0][i], w1 = yw[1][i];
#pragma unroll
                for (int q = 0; q < 4; ++q) { const float l0 = bflo(w0[q]), h0 = bfhi(w0[q]), l1 = bflo(w1[q]), h1 = bfhi(w1[q]); ssy0 += l0 * l0 + h0 * h0; ssy1 += l1 * l1 + h1 * h1; } }
#pragma unroll
            for (int o = 32; o >= 1; o >>= 1) { ssy0 += __shfl_xor(ssy0, o); ssy1 += __shfl_xor(ssy1, o); }
            const float ry0 = rsqrtf(ssy0 * (1.f / 2048.f) + EPS), ry1 = rsqrtf(ssy1 * (1.f / 2048.f) + EPS);
            float ssx0 = 0.f, ssx1 = 0.f;
#pragma unroll
            for (int i = 0; i < 4; ++i) { const u32x4 w0 = yw[0][i], w1 = yw[1][i];
#pragma unroll
                for (int j = 0; j < 8; ++j) { const float a = ca[2 * i + (j >> 2)][j & 3];
                    const float y0 = (j & 1) ? bfhi(w0[j >> 1]) : bflo(w0[j >> 1]), y1 = (j & 1) ? bfhi(w1[j >> 1]) : bflo(w1[j >> 1]);
                    xv[0][i * 8 + j] += a * (y0 * ry0); xv[1][i * 8 + j] += a * (y1 * ry1);
                    ssx0 += xv[0][i * 8 + j] * xv[0][i * 8 + j]; ssx1 += xv[1][i * 8 + j] * xv[1][i * 8 + j]; } }
            f32x4 cb[8], cc[8];
#pragma unroll
            for (int i = 0; i < 4; ++i) { cb[2 * i] = *FX_GC(f32x4, cf + 2048 + i * 512 + lane * 8); cb[2 * i + 1] = *FX_GC(f32x4, cf + 2048 + i * 512 + lane * 8 + 4);
                cc[2 * i] = *FX_GC(f32x4, cf + 4096 + i * 512 + lane * 8); cc[2 * i + 1] = *FX_GC(f32x4, cf + 4096 + i * 512 + lane * 8 + 4); }
#pragma unroll
            for (int tt = 0; tt < 2; ++tt)
#pragma unroll
                for (int i = 0; i < 4; ++i) { u32x4 xo; xo.x = cvt_pk_bf16(xv[tt][i * 8 + 0], xv[tt][i * 8 + 1]); xo.y = cvt_pk_bf16(xv[tt][i * 8 + 2], xv[tt][i * 8 + 3]); xo.z = cvt_pk_bf16(xv[tt][i * 8 + 4], xv[tt][i * 8 + 5]); xo.w = cvt_pk_bf16(xv[tt][i * 8 + 6], xv[tt][i * 8 + 7]);
                    *FX_GM(u32x4, XRES + (size_t)(t0 + tt) * 2048 + i * 512 + lane * 8) = xo; }
#pragma unroll
            for (int o = 32; o >= 1; o >>= 1) { ssx0 += __shfl_xor(ssx0, o); ssx1 += __shfl_xor(ssx1, o); }
            const float rx0 = rsqrtf(ssx0 * (1.f / 2048.f) + EPS), rx1 = rsqrtf(ssx1 * (1.f / 2048.f) + EPS);
#pragma unroll
            for (int tt = 0; tt < 2; ++tt) { const float rx = tt ? rx1 : rx0;
#pragma unroll
                for (int i = 0; i < 4; ++i) { const int c = i * 512 + lane * 8;
                    float hv[8];
#pragma unroll
                    for (int j = 0; j < 8; ++j) hv[j] = xv[tt][i * 8 + j] * rx * cb[2 * i + (j >> 2)][j & 3] + cc[2 * i + (j >> 2)][j & 3];
                    u32x2 w; w.x = cvt_pk4_fp8(hv[0], hv[1], hv[2], hv[3]); w.y = cvt_pk4_fp8(hv[4], hv[5], hv[6], hv[7]);
                    *FX_GM(u32x2, HA8 + (size_t)(t0 + tt) * 2048 + c) = w;
                    *(FX_LAS f32x4*)(h2s + (tok0 + tt) * H2S_LD + c) = (f32x4){hv[0], hv[1], hv[2], hv[3]};
                    *(FX_LAS f32x4*)(h2s + (tok0 + tt) * H2S_LD + c + 4) = (f32x4){hv[4], hv[5], hv[6], hv[7]}; } }
        }
        f32x4 acc[4];
#pragma unroll
        for (int j = 0; j < 4; ++j) acc[j] = (f32x4){0.f, 0.f, 0.f, 0.f};
        {
            const char* rwb = (const char*)router_w + (size_t)__builtin_amdgcn_readfirstlane(wid) * (256 * 64 * 4);
            const unsigned loff = (unsigned)(g4 * 64 + 4 * i16) * 4u;
            f32x4 bwA[8], bwB[8];
            { unsigned o_ = loff; asm volatile("" : "+v"(o_));
#pragma unroll
              for (int q = 0; q < 8; ++q) bwA[q] = *FX_GC(f32x4, rwb + o_ + q * 1024); }
            __syncthreads();
#pragma unroll
            for (int kb = 0; kb < 8; ++kb) {
                if (kb < 7) { unsigned o_ = loff + (kb + 1) * 8192; asm volatile("" : "+v"(o_));
#pragma unroll
                    for (int q = 0; q < 8; ++q) { const f32x4 v = *FX_GC(f32x4, rwb + o_ + q * 1024); if (kb & 1) bwA[q] = v; else bwB[q] = v; } }
#pragma unroll
                for (int q = 0; q < 8; ++q) { const int k = 256 * wid + 4 * (kb * 8 + q) + g4;
                    const float a = h2s[i16 * H2S_LD + k]; const f32x4 bw = (kb & 1) ? bwB[q] : bwA[q];
                    acc[0] = __builtin_amdgcn_mfma_f32_16x16x4f32(a, bw[0], acc[0], 0, 0, 0);
                    acc[1] = __builtin_amdgcn_mfma_f32_16x16x4f32(a, bw[1], acc[1], 0, 0, 0);
                    acc[2] = __builtin_amdgcn_mfma_f32_16x16x4f32(a, bw[2], acc[2], 0, 0, 0);
                    acc[3] = __builtin_amdgcn_mfma_f32_16x16x4f32(a, bw[3], acc[3], 0, 0, 0); } }
        }
        __syncthreads();
        { FX_LAS float* part = h2s; const int i16 = lane & 15, g = lane >> 4;
#pragma unroll
          for (int j = 0; j < 4; ++j)
#pragma unroll
            for (int r = 0; r < 4; ++r) part[(wid * 16 + 4 * g + r) * 64 + 4 * i16 + j] = acc[j][r]; }
        __syncthreads();
#pragma unroll 1
        for (int tt = 0; tt < 2; ++tt) {
            const int tok = 2 * wid + tt, t = unit * RT + tok;
            float lg = 0.f;
#pragma unroll
            for (int w = 0; w < 8; ++w) lg += h2s[(w * 16 + tok) * 64 + lane];
            const float score = 1.f / (1.f + expf(-lg));
            float v = score + router_bias[lane];
            int my_e = 0; float my_s = 0.f, sum = 0.f;
#pragma unroll
            for (int k = 0; k < 6; ++k) {
                const float m = wave_max(v);
                const unsigned long long bal = __ballot(v == m);
                const int win = __ffsll((long long)bal) - 1;
                const float sw = __shfl(score, win);
                sum += sw; if (lane == k) { my_e = win; my_s = sw; }
                if (lane == win) v = -3.0e38f;
            }
            if (lane < 6) { SELE[(size_t)t * 6 + lane] = my_e; SELG[(size_t)t * 6 + lane] = my_s / sum * 2.5f; __hip_atomic_fetch_add(hist + my_e, 1, __ATOMIC_RELAXED, __HIP_MEMORY_SCOPE_WORKGROUP); }
        }
        __syncthreads();
    }
    if (tid < 64) { const int hv = hist[tid]; const int base = atomicAdd(CNT + tid, hv); WGBASE[wg * 64 + tid] = base; }
}

__device__ __forceinline__ void p8_phase(FX_LAS unsigned char* lds, const int* SELE, const float* SELG, const int* CNT, const int* WGBASE, int* ROWTOK, float* ROWG, int* SLOT, int wg, int nwg, int tidp) {
    int tid_ = tidp; asm volatile("" : "+v"(tid_));
    const int tid = tid_;
    FX_LAS int* pstart = (FX_LAS int*)lds; FX_LAS int* off = pstart + 80;
    if (tid < 64) { const int pc = (CNT[tid] + 255) & ~255; int incl = pc;
#pragma unroll
        for (int o = 1; o < 64; o <<= 1) { const int t2 = __shfl_up(incl, o); if (tid >= o) incl += t2; }
        pstart[tid] = 16384 + incl - pc; if (tid == 63) pstart[64] = 16384 + incl; }
    __syncthreads();
    if (tid < 64) off[tid] = pstart[tid] + WGBASE[wg * 64 + tid];
    __syncthreads();
    for (int unit = wg; unit < T / RT; unit += nwg) {
        if (tid < RT * 6) { const int t = unit * RT + tid / 6, k = tid % 6; const int e = SELE[(size_t)t * 6 + k];
            const int pos = __hip_atomic_fetch_add(off + e, 1, __ATOMIC_RELAXED, __HIP_MEMORY_SCOPE_WORKGROUP);
            ROWTOK[pos] = t; ROWG[pos] = SELG[(size_t)t * 6 + k]; SLOT[(size_t)t * 6 + k] = pos; }
    }
    for (int e = wg; e < 64; e += nwg) { const int a = pstart[e] + CNT[e], b = pstart[e + 1]; for (int r = a + tid; r < b; r += 512) { ROWTOK[r] = 0; ROWG[r] = 0.f; } }
    for (int r = wg * 512 + tid; r < 16384; r += nwg * 512) { ROWTOK[r] = r; ROWG[r] = 1.f; }
}

struct MoeSched {
    static constexpr bool GATHER = true;
    FX_LAS const unsigned char* tile_e; int ntiles, npn, nunits, G, c;
    const int* rowtok; int lda_b; const char* Bt; size_t estride_b, pnstride_b;
    __device__ __forceinline__ bool next(int i, Unit& u) const {
        const long L = (long)i * G + c; if (L >= nunits) return false;
        int id = (int)L; { const int q = nunits / NXCD, r = nunits % NXCD, xcd = id % NXCD, off = id / NXCD; id = (xcd < r ? xcd * (q + 1) : r * (q + 1) + (xcd - r) * q) + off; }
        u.pm = id / npn; u.pn = id - u.pm * npn; u.e = tile_e[u.pm]; return true;
    }
    __device__ __forceinline__ unsigned a_row_off(const Unit& u, int R) const { const int row = u.pm * BM + R; return (unsigned)(rowtok ? rowtok[row] : row) * (unsigned)lda_b; }
    __device__ __forceinline__ const char* b_ptr(const Unit& u) const { return Bt + (size_t)u.e * estride_b + (size_t)u.pn * pnstride_b; }
};
__device__ __forceinline__ int moe_sched_build(FX_LAS unsigned char* tab, const int* CNT, int tidp) {
    FX_LAS int* nt = (FX_LAS int*)(tab + 512);
    int tid_ = tidp; asm volatile("" : "+v"(tid_));
    if (tid_ < 64) { const int n = (CNT[tid_] + 255) >> 8; int incl = n;
#pragma unroll
        for (int o = 1; o < 64; o <<= 1) { const int t2 = __shfl_up(incl, o); if (tid_ >= o) incl += t2; }
        const int st0 = 64 + incl - n; for (int j = 0; j < n; ++j) tab[st0 + j] = (unsigned char)tid_;
        tab[tid_] = 64; if (tid_ == 63) nt[0] = 64 + incl; }
    __syncthreads();
    return nt[0];
}
struct EpiGateUp {
    static constexpr bool PERM = true;
    unsigned char* HID;
    __device__ __forceinline__ void operator()(const f32x4 (&acc)[2][2][4][2], const Unit& u, int wr, int wc, int fr, int fq) const {
        const int row0 = u.pm * BM + wr * 64 + fr, col0 = u.pn * 128 + wc * 32 + 8 * fq;
#pragma unroll
        for (int ai = 0; ai < 2; ++ai)
#pragma unroll
            for (int m = 0; m < 4; ++m) { const int row = row0 + ai * HALF + m * 16;
                float o[8];
#pragma unroll
                for (int n = 0; n < 2; ++n)
#pragma unroll
                    for (int j = 0; j < 4; ++j) { const float g = acc[ai][0][m][n][j] * W8_INV, up = acc[ai][1][m][n][j] * W8_INV; o[n * 4 + j] = g * __builtin_amdgcn_rcpf(1.f + __expf(-g)) * up; }
                u32x2 w; w.x = cvt_pk4_fp8(o[0], o[1], o[2], o[3]); w.y = cvt_pk4_fp8(o[4], o[5], o[6], o[7]);
                *(u32x2*)(HID + (size_t)row * 512 + col0) = w; }
    }
    __device__ __forceinline__ void e32(const f32x16 (&acc3)[2][2][2], const Unit& u, int wr, int wc, int lane) const {
        const int j = lane & 31, hi = lane >> 5;
#pragma unroll
        for (int ai = 0; ai < 2; ++ai)
#pragma unroll
            for (int mb = 0; mb < 2; ++mb) { const int row = u.pm * BM + ai * HALF + wr * 64 + mb * 32 + j; unsigned char* rowp = HID + (size_t)row * 512 + u.pn * 128 + wc * 32 + 4 * hi;
#pragma unroll
                for (int g = 0; g < 4; ++g) { float o[4];
#pragma unroll
                    for (int q = 0; q < 4; ++q) { const float gt = acc3[ai][0][mb][4 * g + q] * W8_INV, up = acc3[ai][1][mb][4 * g + q] * W8_INV; o[q] = gt * __builtin_amdgcn_rcpf(1.f + __expf(-gt)) * up; }
                    *(unsigned*)(rowp + 8 * g) = cvt_pk4_fp8(o[0], o[1], o[2], o[3]); } }
    }
};
struct EpiDown {
    static constexpr bool PERM = true;
    unsigned char* YR; const float* ROWG; int nostore;
    __device__ __forceinline__ void operator()(const f32x4 (&acc)[2][2][4][2], const Unit& u, int wr, int wc, int fr, int fq) const {
        const int row0 = u.pm * BM + wr * 64 + fr, col0 = u.pn * BM + wc * 32 + 8 * fq;
        float gs[2][4];
#pragma unroll
        for (int ai = 0; ai < 2; ++ai)
#pragma unroll
            for (int m = 0; m < 4; ++m) gs[ai][m] = ROWG[row0 + ai * HALF + m * 16];
#pragma unroll
        for (int ai = 0; ai < 2; ++ai)
#pragma unroll
            for (int m = 0; m < 4; ++m) { const int row = row0 + ai * HALF + m * 16; const float g = gs[ai][m] * W8_INV; unsigned char* rowp = YR + (size_t)row * 2048 + col0;
#pragma unroll
                for (int bj = 0; bj < 2; ++bj) { const f32x4 v0 = acc[ai][bj][m][0] * g, v1 = acc[ai][bj][m][1] * g;
                    u32x2 w; w.x = cvt_pk4_fp8(v0[0], v0[1], v0[2], v0[3]); w.y = cvt_pk4_fp8(v1[0], v1[1], v1[2], v1[3]);
                    if (!FX_NOEPI || !nostore || (w.x == 0x12345678u && w.y == 0x9abcdef0u))
                    *(u32x2*)(rowp + bj * HALF) = w; } }
    }
    __device__ __forceinline__ void e32(const f32x16 (&acc3)[2][2][2], const Unit& u, int wr, int wc, int lane) const {
        const int j = lane & 31, hi = lane >> 5;
#pragma unroll
        for (int ai = 0; ai < 2; ++ai)
#pragma unroll
            for (int mb = 0; mb < 2; ++mb) { const int row = u.pm * BM + ai * HALF + wr * 64 + mb * 32 + j; const float gsc = ROWG[row] * W8_INV;
#pragma unroll
                for (int bj = 0; bj < 2; ++bj) { unsigned char* rowp = YR + (size_t)row * 2048 + u.pn * BM + bj * HALF + wc * 32 + 4 * hi;
#pragma unroll
                    for (int g = 0; g < 4; ++g) *(unsigned*)(rowp + 8 * g) = cvt_pk4_fp8(acc3[ai][bj][mb][4 * g] * gsc, acc3[ai][bj][mb][4 * g + 1] * gsc, acc3[ai][bj][mb][4 * g + 2] * gsc, acc3[ai][bj][mb][4 * g + 3] * gsc); } }
    }
};
__device__ __forceinline__ void p9_phase(FX_LAS unsigned char* lds, const unsigned char* HA, const unsigned char* WGU, const int* CNT, const int* ROWTOK, unsigned char* HID, int wg, int nwg, int tidp, const int noepi = 0) {
    FX_LAS unsigned char* tab = lds + STAGE_BYTES;
    const int ntiles = moe_sched_build(tab, CNT, tidp);
    MoeSched Sc; Sc.tile_e = tab; Sc.ntiles = ntiles; Sc.npn = 4; Sc.nunits = ntiles * 4; Sc.G = nwg; Sc.c = wg; Sc.rowtok = ROWTOK; Sc.lda_b = 2048; Sc.Bt = (const char*)WGU; Sc.estride_b = (size_t)1024 * 2048; Sc.pnstride_b = (size_t)256 * 2048;
    EpiGateUp E; E.HID = HID;
    gemm_phase<EpiGateUp, MoeSched, true>(lds, (const char*)HA, 2048, Sc, E, tidp, noepi);
}
__device__ __forceinline__ void p10_phase(FX_LAS unsigned char* lds, const unsigned char* HID, const unsigned char* WDN, const int* CNT, const float* ROWG, unsigned char* YR, int wg, int nwg, int tidp, const int noepi = 0) {
    FX_LAS unsigned char* tab = lds + STAGE_BYTES;
    const int ntiles = moe_sched_build(tab, CNT, tidp);
    MoeSched Sc; Sc.tile_e = tab; Sc.ntiles = ntiles; Sc.npn = 8; Sc.nunits = ntiles * 8; Sc.G = nwg; Sc.c = wg; Sc.rowtok = nullptr; Sc.lda_b = 512; Sc.Bt = (const char*)WDN; Sc.estride_b = (size_t)2048 * 512; Sc.pnstride_b = (size_t)256 * 512;
    EpiDown E; E.YR = YR; E.ROWG = ROWG; E.nostore = (noepi == 2);
    gemm_phase<EpiDown, MoeSched, true>(lds, (const char*)HID, 512, Sc, E, tidp, noepi == 1);
}
template <bool OUTF32>
__device__ __forceinline__ void p11_phase(const bf16_t* x1, const unsigned char* YR, const int* SLOT, const float* coef_l, const float* coef_next  , void* xout_, bf16_t* HA, int wg, int nwg, int tidp) {
    int tid_ = tidp; asm volatile("" : "+v"(tid_));
    const int wid = tid_ >> 6, lane = tid_ & 63;
    for (int t = wg * 8 + wid; t < T; t += nwg * 8) {
        const int b = t / S; const float* cf = coef_l + (size_t)b * 6 * 2048;
        int rows[7]; rows[0] = t;
#pragma unroll
        for (int k = 0; k < 6; ++k) rows[k + 1] = SLOT[(size_t)t * 6 + k];
        float yv[32];
#pragma unroll
        for (int j = 0; j < 32; ++j) yv[j] = 0.f;
#pragma unroll
        for (int k = 0; k < 7; ++k) {
            if (k == 4) asm volatile("" ::: "memory");
#pragma unroll
            for (int i = 0; i < 4; ++i) { const u32x2 w = *(const u32x2*)(YR + (size_t)rows[k] * 2048 + i * 512 + lane * 8);
                const f32x2 a0 = __builtin_amdgcn_cvt_pk_f32_fp8((int)w.x, false), a1 = __builtin_amdgcn_cvt_pk_f32_fp8((int)w.x, true), a2 = __builtin_amdgcn_cvt_pk_f32_fp8((int)w.y, false), a3 = __builtin_amdgcn_cvt_pk_f32_fp8((int)w.y, true);
                yv[i * 8 + 0] += a0[0]; yv[i * 8 + 1] += a0[1]; yv[i * 8 + 2] += a1[0]; yv[i * 8 + 3] += a1[1]; yv[i * 8 + 4] += a2[0]; yv[i * 8 + 5] += a2[1]; yv[i * 8 + 6] += a3[0]; yv[i * 8 + 7] += a3[1]; } }
        float ss = 0.f;
#pragma unroll
        for (int j = 0; j < 32; ++j) ss += yv[j] * yv[j];
        ss = wave_sum(ss); const float ry = rsqrtf(ss * (1.f / 2048.f) + EPS); float ssx = 0.f;
#pragma unroll
        for (int i = 0; i < 4; ++i) { const int c = i * 512 + lane * 8;
            const f32x4 d0 = *(const f32x4*)(cf + 3 * 2048 + c), d1 = *(const f32x4*)(cf + 3 * 2048 + c + 4);
            const u32x4 xw = *(const u32x4*)(x1 + (size_t)t * 2048 + c); const f32x4 x0 = {bflo(xw.x), bfhi(xw.x), bflo(xw.y), bfhi(xw.y)}, x1v = {bflo(xw.z), bfhi(xw.z), bflo(xw.w), bfhi(xw.w)};
#pragma unroll
            for (int j = 0; j < 4; ++j) { yv[i * 8 + j] = x0[j] + d0[j] * (yv[i * 8 + j] * ry); yv[i * 8 + 4 + j] = x1v[j] + d1[j] * (yv[i * 8 + 4 + j] * ry); }
#pragma unroll
            for (int j = 0; j < 8; ++j) ssx += yv[i * 8 + j] * yv[i * 8 + j];
            if constexpr (OUTF32) { float* xout = (float*)xout_; *(f32x4*)(xout + (size_t)t * 2048 + c) = (f32x4){yv[i * 8 + 0], yv[i * 8 + 1], yv[i * 8 + 2], yv[i * 8 + 3]};
                *(f32x4*)(xout + (size_t)t * 2048 + c + 4) = (f32x4){yv[i * 8 + 4], yv[i * 8 + 5], yv[i * 8 + 6], yv[i * 8 + 7]}; }
            else { u32x4 xo; xo.x = cvt_pk_bf16(yv[i * 8 + 0], yv[i * 8 + 1]); xo.y = cvt_pk_bf16(yv[i * 8 + 2], yv[i * 8 + 3]); xo.z = cvt_pk_bf16(yv[i * 8 + 4], yv[i * 8 + 5]); xo.w = cvt_pk_bf16(yv[i * 8 + 6], yv[i * 8 + 7]);
                *(u32x4*)((bf16_t*)xout_ + (size_t)t * 2048 + c) = xo; } }
        if (coef_next) { const float* cn = coef_next + (size_t)b * 6 * 2048; ssx = wave_sum(ssx); const float rx = rsqrtf(ssx * (1.f / 2048.f) + EPS);
#pragma unroll
            for (int i = 0; i < 4; ++i) { const int c = i * 512 + lane * 8;
                const f32x4 e0 = *(const f32x4*)(cn + 4 * 2048 + c), e1 = *(const f32x4*)(cn + 4 * 2048 + c + 4), f0 = *(const f32x4*)(cn + 5 * 2048 + c), f1 = *(const f32x4*)(cn + 5 * 2048 + c + 4);
                float hv[8];
#pragma unroll
                for (int j = 0; j < 4; ++j) { hv[j] = yv[i * 8 + j] * rx * e0[j] + f0[j]; hv[4 + j] = yv[i * 8 + 4 + j] * rx * e1[j] + f1[j]; }
#ifdef FX_WIN8
                u32x2 w; w.x = cvt_pk4_fp8(hv[0], hv[1], hv[2], hv[3]); w.y = cvt_pk4_fp8(hv[4], hv[5], hv[6], hv[7]);
                *(u32x2*)((unsigned char*)HA + (size_t)t * 2048 + c) = w; } }
#else
                u32x4 w; w.x = cvt_pk_bf16(hv[0], hv[1]); w.y = cvt_pk_bf16(hv[2], hv[3]); w.z = cvt_pk_bf16(hv[4], hv[5]); w.w = cvt_pk_bf16(hv[6], hv[7]);
                *(u32x4*)(HA + (size_t)t * 2048 + c) = w; } }
#endif
    }
}
}
namespace fx {
#ifndef FX_SD_A
#define FX_SD_A 2
#endif
#ifndef FX_SD_B
#define FX_SD_B 1
#endif
#ifndef FX_NQR_B
#define FX_NQR_B 8
#endif
#define FX_SBAR() __builtin_amdgcn_sched_barrier(0)
__device__ __forceinline__ int crow(int r, int hi) { return (r & 3) + 8 * (r >> 2) + 4 * hi; }
__device__ __forceinline__ int v_st(int k, int c) { const int kk = (k & ~0xC) | ((k & 4) << 1) | ((k & 8) >> 1); return ((kk >> 3) * 4 + (c >> 5)) * 512 + ((kk & 7) * 32 + (c & 31)) * 2; }
__device__ __forceinline__ int v_rd_base(int lane) { return ((lane & 3) << 3) | (((lane >> 2) & 3) << 6) | (((lane >> 4) & 1) << 5) | (((lane >> 5) & 1) << 8); }
constexpr int v_rd_off(int d0, int ks, int half) { return d0 * 512 + ks * 4096 + half * 2048; }
template <int OFF> __device__ __forceinline__ s16x4 tr_read(int vb) { s16x4 r; asm volatile("ds_read_b64_tr_b16 %0, %1 offset:%2" : "=&v"(r) : "v"(vb), "i"(OFF) : "memory"); return r; }
#define FX_PK(L, H) (bf16x8){L[0], L[1], L[2], L[3], H[0], H[1], H[2], H[3]}
template <int D0> __device__ __forceinline__ void pv_one(f32x16& od, int vb, bf16x8 pa0, bf16x8 pa1, bf16x8 pa2, bf16x8 pa3) {
    const s16x4 l0 = tr_read<v_rd_off(D0, 0, 0)>(vb), h0 = tr_read<v_rd_off(D0, 0, 1)>(vb), l1 = tr_read<v_rd_off(D0, 1, 0)>(vb), h1 = tr_read<v_rd_off(D0, 1, 1)>(vb);
    const s16x4 l2 = tr_read<v_rd_off(D0, 2, 0)>(vb), h2 = tr_read<v_rd_off(D0, 2, 1)>(vb), l3 = tr_read<v_rd_off(D0, 3, 0)>(vb), h3 = tr_read<v_rd_off(D0, 3, 1)>(vb);
    asm volatile("s_waitcnt lgkmcnt(0)" ::: "memory"); FX_SBAR();
    od = __builtin_amdgcn_mfma_f32_32x32x16_bf16(pa0, FX_PK(l0, h0), od, 0, 0, 0);
    od = __builtin_amdgcn_mfma_f32_32x32x16_bf16(pa1, FX_PK(l1, h1), od, 0, 0, 0);
    od = __builtin_amdgcn_mfma_f32_32x32x16_bf16(pa2, FX_PK(l2, h2), od, 0, 0, 0);
    od = __builtin_amdgcn_mfma_f32_32x32x16_bf16(pa3, FX_PK(l3, h3), od, 0, 0, 0);
}
__device__ __forceinline__ void pv_d0(f32x16* o, int vb, bf16x8 pa0, bf16x8 pa1, bf16x8 pa2, bf16x8 pa3) {
    pv_one<0>(o[0], vb, pa0, pa1, pa2, pa3); pv_one<1>(o[1], vb, pa0, pa1, pa2, pa3); pv_one<2>(o[2], vb, pa0, pa1, pa2, pa3); pv_one<3>(o[3], vb, pa0, pa1, pa2, pa3);
}
#define FX_PK4(P, BASE, OUT) do { unsigned a0 = cvt_pk_bf16(P[BASE + 0], P[BASE + 1]), a1 = cvt_pk_bf16(P[BASE + 2], P[BASE + 3]);   \
    unsigned b0 = cvt_pk_bf16(P[BASE + 4], P[BASE + 5]), b1 = cvt_pk_bf16(P[BASE + 6], P[BASE + 7]);                              \
    auto r0 = __builtin_amdgcn_permlane32_swap(a0, b0, false, false); auto r1 = __builtin_amdgcn_permlane32_swap(a1, b1, false, false); \
    u32x4 w = {r0[0], r1[0], r0[1], r1[1]}; OUT = *reinterpret_cast<bf16x8*>(&w); } while (0)

template <int DQK> struct AttnC {
    static constexpr int NQ = DQK / 16, KROW = DQK * 2, SHM_V = 64 * 128 * 2, SHM_K = 64 * DQK * 2, NQR = (DQK == 128 ? 8 : FX_NQR_B)  , QX = (NQ - NQR) * 8 * 64 * 16, SHM = 2 * SHM_V + 2 * SHM_K + 8 * 64 * 4 + QX;
    static constexpr float SCALE = DQK == 128 ? 0.088388347648318440f : 0.072168783648703220f;
    static constexpr float THR = 8.f;
};
#define FX_KSWZ(row, colB) ((row) * C::KROW + ((colB) ^ (((row) & 7) << 4)))

template <int DQK> __device__ __forceinline__ void partialSM(f32x16& p0, f32x16& p1, float& m_reg, float& mn, float& alpha) {
    using C = AttnC<DQK>;
    constexpr float Cc = C::SCALE * 1.4426950408889634f;
    float pmax = p0[0];
#pragma unroll
    for (int r = 1; r < 16; ++r) pmax = fmaxf(pmax, p0[r]);
#pragma unroll
    for (int r = 0; r < 16; ++r) pmax = fmaxf(pmax, p1[r]);
    { auto rr = __builtin_amdgcn_permlane32_swap(__float_as_uint(pmax), __float_as_uint(pmax), false, false); pmax = fmaxf(__uint_as_float(rr[0]), __uint_as_float(rr[1])); }
    if (__builtin_expect(__all(pmax - m_reg <= C::THR / C::SCALE), 1)) { mn = m_reg; alpha = 1.f; }
    else { mn = fmaxf(m_reg, pmax); alpha = __builtin_amdgcn_exp2f((m_reg - mn) * Cc); m_reg = mn; }
    const float mnC = -mn * Cc;
#pragma unroll
    for (int r = 0; r < 16; ++r) p0[r] = fmaf(p0[r], Cc, mnC);
#pragma unroll
    for (int r = 0; r < 16; ++r) p1[r] = fmaf(p1[r], Cc, mnC);
#pragma unroll
    for (int r = 0; r < 16; ++r) p0[r] = __builtin_amdgcn_exp2f(p0[r]);
}
__device__ __forceinline__ void finishSM(f32x16& p0, f32x16& p1, float alpha, float& l_reg, bf16x8& pa0, bf16x8& pa1, bf16x8& pa2, bf16x8& pa3) {
#pragma unroll
    for (int r = 0; r < 16; ++r) p1[r] = __builtin_amdgcn_exp2f(p1[r]);
    float ps = 0;
#pragma unroll
    for (int r = 0; r < 16; ++r) ps += p0[r];
#pragma unroll
    for (int r = 0; r < 16; ++r) ps += p1[r];
    { auto rr = __builtin_amdgcn_permlane32_swap(__float_as_uint(ps), __float_as_uint(ps), false, false); ps = __uint_as_float(rr[0]) + __uint_as_float(rr[1]); }
    l_reg = l_reg * alpha + ps;
    FX_PK4(p0, 0, pa0); FX_PK4(p0, 8, pa1); FX_PK4(p1, 0, pa2); FX_PK4(p1, 8, pa3);
}
template <int DQK> __device__ __forceinline__ void qkt(f32x16& p0, f32x16& p1, const char* Ks, const bf16x8* qr, const char* qx  , int r32, int hi) {
    using C = AttnC<DQK>;
    p0 = f32x16{}; p1 = f32x16{};
#pragma unroll
    for (int d0 = 0; d0 < C::NQ; ++d0) { const int cb = (d0 * 16 + hi * 8) * 2;
        const bf16x8 qf = d0 < C::NQR ? qr[d0 < C::NQR ? d0 : 0] : *reinterpret_cast<const bf16x8*>(qx + (d0 - C::NQR) * 1024);
        const bf16x8 b0 = *reinterpret_cast<const bf16x8*>(Ks + FX_KSWZ(r32, cb));
        const bf16x8 b1 = *reinterpret_cast<const bf16x8*>(Ks + FX_KSWZ(32 + r32, cb));
        p0 = __builtin_amdgcn_mfma_f32_32x32x16_bf16(b0, qf, p0, 0, 0, 0);
        p1 = __builtin_amdgcn_mfma_f32_32x32x16_bf16(b1, qf, p1, 0, 0, 0); }
}

template <int DQK, int SD, int LDQ, int LDK1, int LDK2, int LDV>
__device__ __forceinline__ void attn_unit(const bf16_t* __restrict__ Qb, const bf16_t* __restrict__ K1, const bf16_t* __restrict__ K2, const bf16_t* __restrict__ Vh,
                                          bf16_t* __restrict__ Ob, const float* __restrict__ gain, int seq, char* lds, int tidp) {
    using C = AttnC<DQK>;
    int tid_ = tidp; asm volatile("" : "+v"(tid_));
    const int tid = tid_, wid = tid >> 6, lane = tid & 63, r32 = lane & 31, hi = lane >> 5;
    char* V_lds = lds; char* K_lds = lds + 2 * C::SHM_V;
    float* ws = (float*)(lds + 2 * C::SHM_V + 2 * C::SHM_K) + wid * 64; float* li_l = ws; float* al_l = ws + 32;
    float m_reg = -1e30f, l_reg = 0; f32x16 o[4] = {}; bf16x8 qr[C::NQR];
    char* qx = lds + 2 * C::SHM_V + 2 * C::SHM_K + 8 * 64 * 4 + wid * ((C::NQ - C::NQR) * 1024) + lane * 16;
    const bf16_t* Qw = Qb + (long)(wid * 32 + r32) * LDQ + hi * 8;
#pragma unroll
    for (int d0 = 0; d0 < C::NQR; ++d0) qr[d0] = *reinterpret_cast<const bf16x8*>(Qw + d0 * 16);
#pragma unroll
    for (int d0 = C::NQR; d0 < C::NQ; ++d0) *reinterpret_cast<bf16x8*>(qx + (d0 - C::NQR) * 1024) = *reinterpret_cast<const bf16x8*>(Qw + d0 * 16);
    const int sr = tid >> 4, sc = (tid & 15) * 8, vst0 = v_st(sr, sc), vst1 = v_st(32 + sr, sc);
    const int vb0 = (int)(uintptr_t)V_lds + v_rd_base(lane);
    const int xr = tid >> 3, xc = (tid & 7) * 8;
    struct { bf16x8 vs0, vs1, ks0, ks1, kx; } sr_[SD];
#define FX_SLOAD(i, k0) do { sr_[i].vs0 = *reinterpret_cast<const bf16x8*>(&Vh[(long)((k0) + sr) * LDV + sc]); sr_[i].vs1 = *reinterpret_cast<const bf16x8*>(&Vh[(long)((k0) + 32 + sr) * LDV + sc]); \
    sr_[i].ks0 = *reinterpret_cast<const bf16x8*>(&K1[(long)((k0) + sr) * LDK1 + sc]); sr_[i].ks1 = *reinterpret_cast<const bf16x8*>(&K1[(long)((k0) + 32 + sr) * LDK1 + sc]); \
    if (DQK == 192) sr_[i].kx = *reinterpret_cast<const bf16x8*>(&K2[(long)((k0) + xr) * LDK2 + xc]); } while (0)
#define FX_SWRITE(b, i) do { *(bf16x8*)(V_lds + (b) * C::SHM_V + vst0) = sr_[i].vs0; *(bf16x8*)(V_lds + (b) * C::SHM_V + vst1) = sr_[i].vs1; const int kc = sc * 2; \
    *(bf16x8*)(K_lds + (b) * C::SHM_K + FX_KSWZ(sr, kc)) = sr_[i].ks0; *(bf16x8*)(K_lds + (b) * C::SHM_K + FX_KSWZ(32 + sr, kc)) = sr_[i].ks1; \
    if (DQK == 192) *(bf16x8*)(K_lds + (b) * C::SHM_K + FX_KSWZ(xr, 256 + xc * 2)) = sr_[i].kx; } while (0)
#define FX_SWAIT() do { if (SD == 1) asm volatile("s_waitcnt vmcnt(0)" ::: "memory"); else if (DQK == 192) asm volatile("s_waitcnt vmcnt(5)" ::: "memory"); else asm volatile("s_waitcnt vmcnt(4)" ::: "memory"); } while (0)
#define FX_RESC(a) do { if (__any((a) < 1.f)) { if (hi == 0) al_l[r32] = (a); asm volatile("s_waitcnt lgkmcnt(0)" ::: "memory"); \
    _Pragma("unroll") for (int d = 0; d < 4; ++d) _Pragma("unroll") for (int r = 0; r < 16; ++r) o[d][r] *= al_l[crow(r, hi)]; } } while (0)
    f32x16 pA0, pA1, pB0, pB1; float mnA, mnB, alA, alB; bf16x8 pa0, pa1, pa2, pa3; const int NT = seq / 64;
    constexpr int SE = 0, SO = SD - 1;
    FX_SLOAD(SE, 0); asm volatile("s_waitcnt vmcnt(0)" ::: "memory"); FX_SWRITE(0, SE); __syncthreads();
    qkt<DQK>(pA0, pA1, K_lds, qr, qx, r32, hi); partialSM<DQK>(pA0, pA1, m_reg, mnA, alA);
    FX_SLOAD(SO, 64); if (SD == 2) { if (2 < NT) FX_SLOAD(SE, 128); }
    FX_SWAIT(); FX_SWRITE(1, SO); __syncthreads();
    for (int j = 1; j + 1 < NT; j += 2) {
        FX_SBAR(); qkt<DQK>(pB0, pB1, K_lds + C::SHM_K, qr, qx, r32, hi);
        finishSM(pA0, pA1, alA, l_reg, pa0, pa1, pa2, pa3); FX_SBAR();
        FX_SLOAD(SO, (j + SD) * 64); FX_SBAR();
        pv_d0(o, vb0, pa0, pa1, pa2, pa3); partialSM<DQK>(pB0, pB1, m_reg, mnB, alB);
        __syncthreads(); FX_SWAIT(); FX_SWRITE(0, SE);
        FX_RESC(alB); __syncthreads();
        FX_SBAR(); qkt<DQK>(pA0, pA1, K_lds, qr, qx, r32, hi);
        finishSM(pB0, pB1, alB, l_reg, pa0, pa1, pa2, pa3); FX_SBAR();
        if (SD == 1 || j + 3 < NT) FX_SLOAD(SE, (j + 1 + SD) * 64); FX_SBAR();
        pv_d0(o, vb0 + C::SHM_V, pa0, pa1, pa2, pa3); partialSM<DQK>(pA0, pA1, m_reg, mnA, alA);
        __syncthreads(); FX_SWAIT(); FX_SWRITE(1, SO);
        FX_RESC(alA); __syncthreads();
    }
    FX_SBAR(); qkt<DQK>(pB0, pB1, K_lds + C::SHM_K, qr, qx, r32, hi);
    finishSM(pA0, pA1, alA, l_reg, pa0, pa1, pa2, pa3); FX_SBAR();
    pv_d0(o, vb0, pa0, pa1, pa2, pa3); partialSM<DQK>(pB0, pB1, m_reg, mnB, alB);
    __syncthreads(); FX_RESC(alB);
    finishSM(pB0, pB1, alB, l_reg, pa0, pa1, pa2, pa3); FX_SBAR();
    pv_d0(o, vb0 + C::SHM_V, pa0, pa1, pa2, pa3);
    if (hi == 0) li_l[r32] = l_reg; asm volatile("s_waitcnt lgkmcnt(0)" ::: "memory");
    int r32e = r32; asm volatile("" : "+v"(r32e));
    float g4[4];
#pragma unroll
    for (int d0 = 0; d0 < 4; ++d0) g4[d0] = gain[d0 * 32 + r32e];
    bf16_t* Ow = Ob + (long)(wid * 32) * 2048;
#pragma unroll
    for (int r = 0; r < 16; ++r) { const float rl = __builtin_amdgcn_rcpf(li_l[crow(r, hi)]);
        float ss = 0.f;
#pragma unroll
        for (int d0 = 0; d0 < 4; ++d0) { o[d0][r] *= rl; ss += o[d0][r] * o[d0][r]; }
        ss += __shfl_xor(ss, 1); ss += __shfl_xor(ss, 2); ss += __shfl_xor(ss, 4); ss += __shfl_xor(ss, 8); ss += __shfl_xor(ss, 16);
        const float rn = rsqrtf(ss * (1.f / 128.f) + EPS); const int orow = crow(r, hi);
#pragma unroll
#ifdef FX_WOUT8
        for (int d0 = 0; d0 < 4; ++d0) ((unsigned char*)Ob)[(long)(wid * 32 + orow) * 2048 + d0 * 32 + r32e] = (unsigned char)(__builtin_amdgcn_cvt_pk_fp8_f32(o[d0][r] * rn * g4[d0], 0.f, 0, false) & 0xff); }
#else
        for (int d0 = 0; d0 < 4; ++d0) Ow[(long)orow * 2048 + d0 * 32 + r32e] = f2bf(o[d0][r] * rn * g4[d0]); }
#endif
    __syncthreads();
#undef FX_SLOAD
#undef FX_SWRITE
#undef FX_SWAIT
#undef FX_RESC
}

__device__ __forceinline__ void attn_gqa_unit(int u, const bf16_t* QA, const bf16_t* KA, const bf16_t* PROJ, bf16_t* YM, const float* hog, char* lds, int tidp) {
    const int qb = u & 15, hh = (u >> 4) % 6, b = u / 96, kvh = hh / 3;
    const size_t t0 = (size_t)b * S;
    attn_unit<128, FX_SD_A, 768, 256, 0, PW>(QA + (t0 + qb * 256) * 768 + hh * 128, KA + t0 * 256 + kvh * 128, nullptr, PROJ + t0 * PW + O_AV + kvh * 128,
#ifdef FX_WOUT8
                                    (bf16_t*)((unsigned char*)YM + (t0 + qb * 256) * 2048 + hh * 128), hog + hh * 128, S, lds, tidp);
#else
                                    YM + (t0 + qb * 256) * 2048 + hh * 128, hog + hh * 128, S, lds, tidp);
#endif
}
__device__ __forceinline__ void attn_mla_unit(int u, const bf16_t* QB, const bf16_t* KVB, const bf16_t* KR, bf16_t* YM, const float* hog, char* lds, int tidp) {
    const int qb = u & 15, hh = (u >> 4) % 6, b = u / 96;
    const size_t t0 = (size_t)b * S;
    attn_unit<192, FX_SD_B, 1280, 1536, 64, 1536>(QB + (t0 + qb * 256) * 1280 + hh * 192, KVB + t0 * 1536 + hh * 256, KR + t0 * 64, KVB + t0 * 1536 + hh * 256 + 128,
#ifdef FX_WOUT8
                                         (bf16_t*)((unsigned char*)YM + (t0 + qb * 256) * 2048 + 768 + hh * 128), hog + 768 + hh * 128, S, lds, tidp);
#else
                                         YM + (t0 + qb * 256) * 2048 + 768 + hh * 128, hog + 768 + hh * 128, S, lds, tidp);
#endif
}
}
namespace fx {
constexpr int P3_LDS = 4096 + 2048 + 65536 + 32768;
constexpr float KSCALE = 0.08838834764831845f;
__device__ __forceinline__ float logsigmoid_f(float f) { return fminf(f, 0.f) - log1pf(__expf(-fabsf(f))); }
__device__ __forceinline__ float wave_scan_incl(float v, int lane) {
#pragma unroll
    for (int o = 1; o < 64; o <<= 1) { const float t = __shfl_up(v, o); if (lane >= o) v += t; }
    return v;
}
__device__ __forceinline__ float wave_scanmax_incl(float v, int lane) {
#pragma unroll
    for (int o = 1; o < 64; o <<= 1) { const float t = __shfl_up(v, o); if (lane >= o) v = fmaxf(v, t); }
    return v;
}
__device__ __forceinline__ float wave_rscanmax_incl(float v, int lane) {
#pragma unroll
    for (int o = 1; o < 64; o <<= 1) { const float t = __shfl_down(v, o); if (lane + o < 64) v = fmaxf(v, t); }
    return v;
}

struct P3Args {
    const bf16_t* PROJ; const float* GATES; const float* gate_b; const float* conv_w; const float* conv_b;
    const float* aq_gain; const float* ak_gain; const float* cq_gain; const float* ckv_gain;
    const float* cosA; const float* sinA; const float* cosB; const float* sinB;
    bf16_t* QA; bf16_t* KA; bf16_t* CQN; bf16_t* CKVN; bf16_t* KR; bf16_t* QC; bf16_t* KC; bf16_t* KCT; float* NLOC; float* GSC;
};
__device__ __forceinline__ void p3_phase(FX_LAS unsigned char* lds_, const P3Args& a, int wg, int nwg, int tidp) {
    char* lds = (char*)lds_;
    float* gat = (float*)lds; float* wts = (float*)(lds + 4096); char* ktile = lds + 6144; char* wv = lds + 6144 + 65536;
    for (int unit = wg; unit < T / 64; unit += nwg) {
        int tid_ = tidp; asm volatile("" : "+v"(tid_));
        const int tid = tid_, wid = tid >> 6, lane = tid & 63;
        const int b = unit >> 6, co = unit & 63; const size_t t0 = (size_t)unit * 64;
        for (int i = tid; i < 1024; i += 512) gat[i] = a.GATES[t0 * 16 + i] + a.gate_b[i & 15];
        __syncthreads();
        { const int dir = wid >> 2, h = wid & 3;
          const float logi = gat[lane * 16 + (dir * 2) * 4 + h], logf = logsigmoid_f(gat[lane * 16 + (dir * 2 + 1) * 4 + h]);
          const float pre = wave_scan_incl(logf, lane), g = __shfl(pre, 63);
          const float bb = dir ? (g - pre + logf) : pre;
          const float av = g - bb + logi, mloc = wave_max(av);
          wts[wid * 64 + lane] = __expf(av - mloc);
          if (lane == 0) { const int chain = (b * 4 + h) * 2 + dir, ci = dir ? 63 - co : co; a.GSC[(chain * 64 + ci) * 2] = g; a.GSC[(chain * 64 + ci) * 2 + 1] = mloc; } }
        __syncthreads();
        { const int c0 = 2 * tid; const bool isk = c0 >= 512; const int hk = (c0 - 512) >> 7, dk = (c0 - 512) & 127;
          float w0[5], w1[5];
#pragma unroll
          for (int j = 0; j < 5; ++j) { w0[j] = a.conv_w[j * 1024 + c0]; w1[j] = a.conv_w[j * 1024 + c0 + 1]; }
          const float cb0 = a.conv_b[c0], cb1 = a.conv_b[c0 + 1];
          float x0[5], x1[5];
          const bf16_t* src = a.PROJ + t0 * PW + O_CQ + c0;
#pragma unroll
          for (int j = 0; j < 4; ++j) { const int sa = co * 64 + j - 2; unsigned w = 0u; if (sa >= 0 && sa < S) w = *(const unsigned*)(src + (long)(j - 2) * PW); x0[j + 1] = bflo(w); x1[j + 1] = bfhi(w); }
          float nf0 = 0.f, nf1 = 0.f, nb0 = 0.f, nb1 = 0.f;
#pragma unroll 1
          for (int s0 = 0; s0 < 64; s0 += 16) {
              unsigned wl[16];
#pragma unroll
              for (int q = 0; q < 16; ++q) { const int sa = co * 64 + s0 + q + 2; wl[q] = 0u; if (sa < S) wl[q] = *(const unsigned*)(src + (long)(s0 + q + 2) * PW); }
#pragma unroll
              for (int q = 0; q < 16; ++q) { const int s = s0 + q;
#pragma unroll
                  for (int j = 0; j < 4; ++j) { x0[j] = x0[j + 1]; x1[j] = x1[j + 1]; }
                  x0[4] = bflo(wl[q]); x1[4] = bfhi(wl[q]);
                  float y0 = cb0, y1 = cb1;
#pragma unroll
                  for (int j = 0; j < 5; ++j) { y0 += w0[j] * x0[j]; y1 += w1[j] * x1[j]; }
                  y0 = silu_f(y0); y1 = silu_f(y1);
                  if (!isk) { *(unsigned*)(a.QC + (t0 + s) * 512 + c0) = cvt_pk_bf16(y0, y1); }
                  else { y0 *= KSCALE; y1 *= KSCALE; const unsigned pk = cvt_pk_bf16(y0, y1);
                      *(unsigned*)(a.KC + (t0 + s) * 512 + (c0 - 512)) = pk;
                      *(unsigned*)(ktile + hk * 16384 + v_st(s, dk & ~7) + (dk & 7) * 2) = pk;
                      const float k0 = bflo(pk), k1 = bfhi(pk); const float wf = wts[hk * 64 + s], wb = wts[(4 + hk) * 64 + s];
                      nf0 += wf * k0; nf1 += wf * k1; nb0 += wb * k0; nb1 += wb * k1; } }
          }
          if (isk) { const int chf = (b * 4 + hk) * 2, chb = chf + 1;
              *(f32x2*)(a.NLOC + ((size_t)chf * 64 + co) * 128 + dk) = (f32x2){nf0, nf1};
              *(f32x2*)(a.NLOC + ((size_t)chb * 64 + (63 - co)) * 128 + dk) = (f32x2){nb0, nb1}; } }
        __syncthreads();
#pragma unroll 1
        for (int h = 0; h < 4; ++h) {
            { const int sr = tid >> 4, sc = (tid & 15) * 8;
#pragma unroll
              for (int rr = 0; rr < 2; ++rr) { const int s = sr + 32 * rr;
                const u32x4 vw = *(const u32x4*)(a.PROJ + (t0 + s) * PW + O_CV + h * 128 + sc);
                const float wf = wts[h * 64 + s], wb = wts[(4 + h) * 64 + s];
                float v[8] = {bflo(vw.x), bfhi(vw.x), bflo(vw.y), bfhi(vw.y), bflo(vw.z), bfhi(vw.z), bflo(vw.w), bfhi(vw.w)};
                u32x4 of, ob;
                of.x = cvt_pk_bf16(v[0] * wf, v[1] * wf); of.y = cvt_pk_bf16(v[2] * wf, v[3] * wf); of.z = cvt_pk_bf16(v[4] * wf, v[5] * wf); of.w = cvt_pk_bf16(v[6] * wf, v[7] * wf);
                ob.x = cvt_pk_bf16(v[0] * wb, v[1] * wb); ob.y = cvt_pk_bf16(v[2] * wb, v[3] * wb); ob.z = cvt_pk_bf16(v[4] * wb, v[5] * wb); ob.w = cvt_pk_bf16(v[6] * wb, v[7] * wb);
                *(u32x4*)(wv + v_st(s, sc)) = of; *(u32x4*)(wv + 16384 + v_st(s, sc)) = ob; } }
            __syncthreads();
            { const int dir = wid >> 2, mb = wid & 3, r32 = lane & 31, hi = lane >> 5;
              const int va = (int)(uintptr_t)(wv + dir * 16384) + v_rd_base(lane) + mb * 512;
              const int kb = (int)(uintptr_t)(ktile + h * 16384) + v_rd_base(lane);
              f32x16 acc[4] = {};
#define FX_KC_STEP(KS) do { \
              const s16x4 al = tr_read<v_rd_off(0, KS, 0)>(va), ah = tr_read<v_rd_off(0, KS, 1)>(va); \
              const s16x4 b0l = tr_read<v_rd_off(0, KS, 0)>(kb), b0h = tr_read<v_rd_off(0, KS, 1)>(kb), b1l = tr_read<v_rd_off(1, KS, 0)>(kb), b1h = tr_read<v_rd_off(1, KS, 1)>(kb); \
              const s16x4 b2l = tr_read<v_rd_off(2, KS, 0)>(kb), b2h = tr_read<v_rd_off(2, KS, 1)>(kb), b3l = tr_read<v_rd_off(3, KS, 0)>(kb), b3h = tr_read<v_rd_off(3, KS, 1)>(kb); \
              asm volatile("s_waitcnt lgkmcnt(0)" ::: "memory"); FX_SBAR(); \
              const bf16x8 af = FX_PK(al, ah); \
              acc[0] = __builtin_amdgcn_mfma_f32_32x32x16_bf16(af, FX_PK(b0l, b0h), acc[0], 0, 0, 0); acc[1] = __builtin_amdgcn_mfma_f32_32x32x16_bf16(af, FX_PK(b1l, b1h), acc[1], 0, 0, 0); \
              acc[2] = __builtin_amdgcn_mfma_f32_32x32x16_bf16(af, FX_PK(b2l, b2h), acc[2], 0, 0, 0); acc[3] = __builtin_amdgcn_mfma_f32_32x32x16_bf16(af, FX_PK(b3l, b3h), acc[3], 0, 0, 0); } while (0)
              FX_KC_STEP(0); FX_KC_STEP(1); FX_KC_STEP(2); FX_KC_STEP(3);
#undef FX_KC_STEP
              const int chain = (b * 4 + h) * 2 + dir, ci = dir ? 63 - co : co;
              bf16_t* dst = a.KCT + ((size_t)chain * 64 + ci) * 16384 + (size_t)(mb * 32) * 128 + r32;
#pragma unroll
              for (int r = 0; r < 16; ++r) { const int v = crow(r, hi);
#pragma unroll
                  for (int nb = 0; nb < 4; ++nb) dst[v * 128 + nb * 32] = f2bf(acc[nb][r]); } }
            __syncthreads();
        }
        { const int f = lane & 31, hf = lane >> 5;
#pragma unroll 8
          for (int it = wid; it < 512; it += 8) { const int s = it >> 3, hd = it & 7; const size_t t = t0 + s;
            const bf16_t* src = a.PROJ + t * PW + hd * 128 + hf * 64;
            float x1 = bf2f(src[f]), x2 = bf2f(src[32 + f]);
            const float ss = wave_sum(x1 * x1 + x2 * x2), r = rsqrtf(ss * (1.f / 128.f) + EPS);
            const float* g = hd < 6 ? a.aq_gain : a.ak_gain;
            x1 *= r * g[hf * 64 + f]; x2 *= r * g[hf * 64 + 32 + f];
            const int pos = hf ? s : co; const float cs = a.cosA[pos * 32 + f], sn = a.sinA[pos * 32 + f];
            bf16_t* dst = hd < 6 ? a.QA + t * 768 + hd * 128 + hf * 64 : a.KA + t * 256 + (hd - 6) * 128 + hf * 64;
            dst[f] = f2bf(x1 * cs - x2 * sn); dst[32 + f] = f2bf(x2 * cs + x1 * sn); } }
#pragma unroll 4
        for (int s = wid; s < 64; s += 8) { const size_t t = t0 + s; const bf16_t* p = a.PROJ + t * PW;
            float q[6]; float ss = 0.f;
#pragma unroll
            for (int i = 0; i < 3; ++i) { const unsigned w = *(const unsigned*)(p + O_BCQ + i * 128 + lane * 2); q[2 * i] = bflo(w); q[2 * i + 1] = bfhi(w); ss += q[2 * i] * q[2 * i] + q[2 * i + 1] * q[2 * i + 1]; }
            ss = wave_sum(ss); float r = rsqrtf(ss * (1.f / 384.f) + EPS);
#pragma unroll
            for (int i = 0; i < 3; ++i) { const int c = i * 128 + lane * 2; *(unsigned*)(a.CQN + t * 384 + c) = cvt_pk_bf16(q[2 * i] * r * a.cq_gain[c], q[2 * i + 1] * r * a.cq_gain[c + 1]); }
            float kv[4]; ss = 0.f;
#pragma unroll
            for (int i = 0; i < 2; ++i) { const unsigned w = *(const unsigned*)(p + O_BCKV + i * 128 + lane * 2); kv[2 * i] = bflo(w); kv[2 * i + 1] = bfhi(w); ss += kv[2 * i] * kv[2 * i] + kv[2 * i + 1] * kv[2 * i + 1]; }
            ss = wave_sum(ss); r = rsqrtf(ss * (1.f / 256.f) + EPS);
#pragma unroll
            for (int i = 0; i < 2; ++i) { const int c = i * 128 + lane * 2; *(unsigned*)(a.CKVN + t * 256 + c) = cvt_pk_bf16(kv[2 * i] * r * a.ckv_gain[c], kv[2 * i + 1] * r * a.ckv_gain[c + 1]); }
            if (lane < 32) { const int f = lane & 15, hf = lane >> 4; const int pos = hf ? s : co; const float cs = a.cosB[pos * 16 + f], sn = a.sinB[pos * 16 + f];
                const float x1 = bf2f(p[O_BKR + hf * 32 + f]), x2 = bf2f(p[O_BKR + hf * 32 + 16 + f]);
                a.KR[t * 64 + hf * 32 + f] = f2bf(x1 * cs - x2 * sn); a.KR[t * 64 + hf * 32 + 16 + f] = f2bf(x2 * cs + x1 * sn); } }
        __syncthreads();
    }
}

__device__ __forceinline__ void scan_phase(const bf16_t* KCT, const float* NLOC, const float* GSC, bf16_t* CPREV, float* NPREV, float* MPREV, int gtid, int nthr) {
    for (int item = gtid; item < 32 * 4096; item += nthr) {
        const int chain = item >> 12, e4 = item & 4095;
        const u32x2* src = (const u32x2*)(KCT + (size_t)chain * 64 * 16384) + e4; u32x2* dst = (u32x2*)(CPREV + (size_t)chain * 64 * 16384) + e4;
        const float* gs = GSC + (size_t)chain * 128;
        const bool don = e4 < 128;
        float c0 = 0.f, c1 = 0.f, c2 = 0.f, c3 = 0.f, nn = 0.f, m = 0.f;
#pragma unroll 1
        for (int cb = 0; cb < 64; cb += 8) {
            u32x2 kc[8]; float nl[8];
#pragma unroll
            for (int j = 0; j < 8; ++j) { kc[j] = src[(size_t)(cb + j) * 4096]; nl[j] = don ? NLOC[((size_t)chain * 64 + cb + j) * 128 + e4] : 0.f; }
#pragma unroll
            for (int j = 0; j < 8; ++j) { const int ci = cb + j; const float g = gs[ci * 2], ml = gs[ci * 2 + 1];
                u32x2 o; o.x = cvt_pk_bf16(c0, c1); o.y = cvt_pk_bf16(c2, c3); dst[(size_t)ci * 4096] = o;
                if (don) NPREV[((size_t)chain * 64 + ci) * 128 + e4] = nn;
                if (e4 == 0) MPREV[chain * 64 + ci] = m;
                const float mn = fmaxf(g + m, ml), dec = __expf(g + m - mn), sl = __expf(ml - mn); m = mn;
                c0 = dec * c0 + sl * bflo(kc[j].x); c1 = dec * c1 + sl * bfhi(kc[j].x); c2 = dec * c2 + sl * bflo(kc[j].y); c3 = dec * c3 + sl * bfhi(kc[j].y);
                nn = dec * nn + sl * nl[j]; }
        }
    }
}

constexpr int MC_K = 0, MC_V = 16384, MC_CT = 32768, MC_HS = 98304, MC_HS_LD = 132, MC_SM = MC_HS + 64 * MC_HS_LD * 4, MC_LDS = MC_SM + 4096;
struct McArgs { const bf16_t* PROJ; const float* GATES; const float* gate_b; const bf16_t* QC; const bf16_t* KC; const bf16_t* CPREV; const float* NPREV; const float* MPREV; const float* hog; bf16_t* YM; };
__device__ __forceinline__ void mlstm_c_phase(FX_LAS unsigned char* lds_, const McArgs& a, int wg, int nwg, int tidp) {
    char* lds = (char*)lds_;
    using C = AttnC<128>;
    float* hs = (float*)(lds + MC_HS);
    float* sm = (float*)(lds + MC_SM);
    for (int unit = wg; unit < NB * 4 * 64; unit += nwg) {
        int tid_ = tidp; asm volatile("" : "+v"(tid_));
        const int tid = tid_, wid = tid >> 6, lane = tid & 63, r32 = lane & 31, hi = lane >> 5;
        const int co = unit & 63, h = (unit >> 6) & 3, b = unit >> 8; const size_t t0 = (size_t)b * S + co * 64;
        if (wid < 2) { const int dir = wid; const int chain = (b * 4 + h) * 2 + dir, ci = dir ? 63 - co : co;
            const float logi = a.GATES[(t0 + lane) * 16 + (dir * 2) * 4 + h] + a.gate_b[(dir * 2) * 4 + h];
            const float logf = logsigmoid_f(a.GATES[(t0 + lane) * 16 + (dir * 2 + 1) * 4 + h] + a.gate_b[(dir * 2 + 1) * 4 + h]);
            const float pre = wave_scan_incl(logf, lane), g = __shfl(pre, 63);
            const float bb = dir ? (g - pre + logf) : pre;
            const float u = logi - bb;
            const float M = dir ? wave_rscanmax_incl(u, lane) : wave_scanmax_incl(u, lane);
            const float mp = a.MPREV[chain * 64 + ci], mmj = fmaxf(mp, M);
            sm[dir * 64 + lane] = u; sm[128 + dir * 64 + lane] = mmj; sm[256 + dir * 64 + lane] = __expf(mp - mmj); sm[384 + dir * 64 + lane] = __expf(-(bb + mmj));
            sm[512 + dir * 128 + lane] = a.NPREV[((size_t)chain * 64 + ci) * 128 + lane]; sm[512 + dir * 128 + 64 + lane] = a.NPREV[((size_t)chain * 64 + ci) * 128 + 64 + lane]; }
        { const int sr = tid >> 4, sc = (tid & 15) * 8;
#pragma unroll
          for (int rr = 0; rr < 2; ++rr) { const int s = sr + 32 * rr;
            *(bf16x8*)(lds + MC_K + FX_KSWZ(s, sc * 2)) = *(const bf16x8*)(a.KC + (t0 + s) * 512 + h * 128 + sc);
            *(bf16x8*)(lds + MC_V + v_st(s, sc)) = *(const bf16x8*)(a.PROJ + (t0 + s) * PW + O_CV + h * 128 + sc); }
#pragma unroll
          for (int dir = 0; dir < 2; ++dir) { const int chain = (b * 4 + h) * 2 + dir, ci = dir ? 63 - co : co; const bf16_t* ct = a.CPREV + ((size_t)chain * 64 + ci) * 16384;
#pragma unroll
            for (int rr = 0; rr < 4; ++rr) { const int v = sr + 32 * rr; *(bf16x8*)(lds + MC_CT + dir * 32768 + FX_KSWZ(v, sc * 2)) = *(const bf16x8*)(ct + v * 128 + sc); } } }
        __syncthreads();
        { const int dir = wid >> 2, rb = (wid >> 1) & 1, cb = wid & 1, j = rb * 32 + r32;
          bf16x8 qr[8];
          const bf16_t* Qw = a.QC + (t0 + j) * 512 + h * 128 + hi * 8;
#pragma unroll
          for (int d0 = 0; d0 < 8; ++d0) qr[d0] = *reinterpret_cast<const bf16x8*>(Qw + d0 * 16);
          f32x16 p0, p1;
          qkt<128>(p0, p1, lds + MC_K, qr, nullptr, r32, hi);
          const float mmj = sm[128 + dir * 64 + j], inter = sm[256 + dir * 64 + j], emn = sm[384 + dir * 64 + j];
          float dsum = 0.f;
#pragma unroll
          for (int r = 0; r < 16; ++r) { const int s0 = crow(r, hi), s1 = 32 + s0;
              const bool v0 = dir ? (s0 >= j) : (s0 <= j), v1 = dir ? (s1 >= j) : (s1 <= j);
              const float w0 = v0 ? __expf(sm[dir * 64 + s0] - mmj) : 0.f, w1 = v1 ? __expf(sm[dir * 64 + s1] - mmj) : 0.f;
              p0[r] *= w0; p1[r] *= w1; dsum += p0[r] + p1[r]; }
          float qn = 0.f;
#pragma unroll
          for (int d0 = 0; d0 < 8; ++d0) { const float* np = sm + 512 + dir * 128 + d0 * 16 + hi * 8; const u32x4 w = *reinterpret_cast<const u32x4*>(&qr[d0]);
              qn += bflo(w.x) * np[0] + bfhi(w.x) * np[1] + bflo(w.y) * np[2] + bfhi(w.y) * np[3] + bflo(w.z) * np[4] + bfhi(w.z) * np[5] + bflo(w.w) * np[6] + bfhi(w.w) * np[7]; }
          { auto rr = __builtin_amdgcn_permlane32_swap(__float_as_uint(dsum), __float_as_uint(dsum), false, false); dsum = __uint_as_float(rr[0]) + __uint_as_float(rr[1]); }
          { auto rr = __builtin_amdgcn_permlane32_swap(__float_as_uint(qn), __float_as_uint(qn), false, false); qn = __uint_as_float(rr[0]) + __uint_as_float(rr[1]); }
          const float den = dsum + inter * qn;
          if (hi == 0) sm[768 + wid * 32 + r32] = 1.f / fmaxf(fabsf(den), emn);
          bf16x8 pa0, pa1, pa2, pa3;
          FX_PK4(p0, 0, pa0); FX_PK4(p0, 8, pa1); FX_PK4(p1, 0, pa2); FX_PK4(p1, 8, pa3);
          f32x16 o[2] = {};
          const int vb = (int)(uintptr_t)(lds + MC_V) + v_rd_base(lane) + cb * 1024;
          pv_one<0>(o[0], vb, pa0, pa1, pa2, pa3); pv_one<1>(o[1], vb, pa0, pa1, pa2, pa3);
          const char* ctb = lds + MC_CT + dir * 32768;
#pragma unroll
          for (int ks = 0; ks < 8; ++ks) { const u32x4 w = *reinterpret_cast<const u32x4*>(&qr[ks]); u32x4 sq;
              sq.x = cvt_pk_bf16(bflo(w.x) * inter, bfhi(w.x) * inter); sq.y = cvt_pk_bf16(bflo(w.y) * inter, bfhi(w.y) * inter); sq.z = cvt_pk_bf16(bflo(w.z) * inter, bfhi(w.z) * inter); sq.w = cvt_pk_bf16(bflo(w.w) * inter, bfhi(w.w) * inter);
              const bf16x8 qs = *reinterpret_cast<const bf16x8*>(&sq); const int colB = (ks * 16 + hi * 8) * 2;
              const bf16x8 c0f = *reinterpret_cast<const bf16x8*>(ctb + FX_KSWZ((2 * cb) * 32 + r32, colB));
              const bf16x8 c1f = *reinterpret_cast<const bf16x8*>(ctb + FX_KSWZ((2 * cb + 1) * 32 + r32, colB));
              o[0] = __builtin_amdgcn_mfma_f32_32x32x16_bf16(qs, c0f, o[0], 0, 0, 0);
              o[1] = __builtin_amdgcn_mfma_f32_32x32x16_bf16(qs, c1f, o[1], 0, 0, 0); }
          asm volatile("s_waitcnt lgkmcnt(0)" ::: "memory");
          float rd[16];
#pragma unroll
          for (int r = 0; r < 16; ++r) rd[r] = sm[768 + wid * 32 + crow(r, hi)];
          if (dir == 0) {
#pragma unroll
              for (int r = 0; r < 16; ++r) { const int row = rb * 32 + crow(r, hi);
                  hs[row * MC_HS_LD + (2 * cb) * 32 + r32] = o[0][r] * rd[r]; hs[row * MC_HS_LD + (2 * cb + 1) * 32 + r32] = o[1][r] * rd[r]; } }
          __syncthreads();
          if (dir == 1) {
#pragma unroll
              for (int r = 0; r < 16; ++r) { const int row = rb * 32 + crow(r, hi);
                  hs[row * MC_HS_LD + (2 * cb) * 32 + r32] += o[0][r] * rd[r]; hs[row * MC_HS_LD + (2 * cb + 1) * 32 + r32] += o[1][r] * rd[r]; } }
          __syncthreads(); }
        { const int row = tid >> 3, c0 = (tid & 7) * 16; const size_t t = t0 + row;
          float v[16]; float ss = 0.f;
#pragma unroll
          for (int i = 0; i < 16; ++i) { v[i] = hs[row * MC_HS_LD + c0 + i]; ss += v[i] * v[i]; }
          ss += __shfl_xor(ss, 1); ss += __shfl_xor(ss, 2); ss += __shfl_xor(ss, 4);
          const float rn = rsqrtf(ss * (1.f / 128.f) + EPS);
          const bf16_t* og = a.PROJ + t * PW + O_CO + h * 128 + c0; const float* gn = a.hog + 1536 + h * 128 + c0;
          const u32x4 g0 = *(const u32x4*)og, g1 = *(const u32x4*)(og + 8);
          const float gg[16] = {bflo(g0.x), bfhi(g0.x), bflo(g0.y), bfhi(g0.y), bflo(g0.z), bfhi(g0.z), bflo(g0.w), bfhi(g0.w), bflo(g1.x), bfhi(g1.x), bflo(g1.y), bfhi(g1.y), bflo(g1.z), bfhi(g1.z), bflo(g1.w), bfhi(g1.w)};
          float ov[16];
#pragma unroll
          for (int i = 0; i < 16; ++i) ov[i] = v[i] * rn * gn[i] * sigmoid_f(gg[i]);
          u32x4 w0, w1; w0.x = cvt_pk_bf16(ov[0], ov[1]); w0.y = cvt_pk_bf16(ov[2], ov[3]); w0.z = cvt_pk_bf16(ov[4], ov[5]); w0.w = cvt_pk_bf16(ov[6], ov[7]);
          w1.x = cvt_pk_bf16(ov[8], ov[9]); w1.y = cvt_pk_bf16(ov[10], ov[11]); w1.z = cvt_pk_bf16(ov[12], ov[13]); w1.w = cvt_pk_bf16(ov[14], ov[15]);
#ifdef FX_WOUT8
          { u32x4 w8; w8.x = cvt_pk4_fp8(ov[0], ov[1], ov[2], ov[3]); w8.y = cvt_pk4_fp8(ov[4], ov[5], ov[6], ov[7]); w8.z = cvt_pk4_fp8(ov[8], ov[9], ov[10], ov[11]); w8.w = cvt_pk4_fp8(ov[12], ov[13], ov[14], ov[15]);
            *(u32x4*)((unsigned char*)a.YM + t * 2048 + 1536 + h * 128 + c0) = w8; (void)w0; (void)w1; } }
#else
          bf16_t* dst = a.YM + t * 2048 + 1536 + h * 128 + c0; *(u32x4*)dst = w0; *(u32x4*)(dst + 8) = w1; }
#endif
        __syncthreads();
    }
}
}
namespace fx {
struct EpiQB {
    static constexpr bool PERM = false;
    bf16_t* O; const float* cosB; const float* sinB;
    __device__ __forceinline__ void operator()(const f32x4 (&acc)[2][2][4][2], const Unit& u, int wr, int wc, int fr, int fq) const {
        const int row0 = u.pm * BM + wr * 64 + fr;
#pragma unroll
        for (int bj = 0; bj < 2; ++bj) { const int G = 8 * u.pn + 4 * bj + wc, gm = G % 6; const int col0 = G * 32 + 4 * fq;
#pragma unroll
            for (int ai = 0; ai < 2; ++ai)
#pragma unroll
                for (int m = 0; m < 4; ++m) { const int row = row0 + ai * HALF + m * 16; f32x4 x1 = acc[ai][bj][m][0], x2 = acc[ai][bj][m][1];
                    if (gm >= 4) { const int s = row & (S - 1), pos = gm == 4 ? (s >> 6) : (s & 63);
                        const f32x4 cs = *(const f32x4*)(cosB + pos * 16 + 4 * fq), sn = *(const f32x4*)(sinB + pos * 16 + 4 * fq);
                        const f32x4 o1 = x1 * cs - x2 * sn, o2 = x2 * cs + x1 * sn; x1 = o1; x2 = o2; }
                    bf16_t* rp = O + (size_t)row * 1280 + col0;
                    u32x2 w0, w1; w0.x = cvt_pk_bf16(x1[0], x1[1]); w0.y = cvt_pk_bf16(x1[2], x1[3]); w1.x = cvt_pk_bf16(x2[0], x2[1]); w1.y = cvt_pk_bf16(x2[2], x2[3]);
                    *(u32x2*)rp = w0; *(u32x2*)(rp + 16) = w1; } }
    }
};
constexpr size_t al256(size_t x) { return (x + 255) & ~(size_t)255; }
constexpr size_t WS_BAR = 0;
constexpr size_t WS_MOD = 16384;
constexpr size_t WS_COEF = WS_MOD + al256(2ull * 4 * 12288 * 4);
constexpr size_t WS_TAB = WS_COEF + al256(2ull * 4 * 6 * 2048 * 4);
constexpr size_t WS_CNT = WS_TAB + al256(6144 * 4);
constexpr size_t WS_WGBASE = WS_CNT + 512;
constexpr size_t WS_SELE = WS_WGBASE + 256 * 64 * 4;
constexpr size_t WS_SELG = WS_SELE + (size_t)T * 6 * 4;
constexpr size_t WS_SLOT = WS_SELG + (size_t)T * 6 * 4;
constexpr size_t WS_ROWTOK = WS_SLOT + (size_t)T * 6 * 4;
constexpr size_t WS_ROWG = WS_ROWTOK + (size_t)PTOT * 4;
constexpr size_t WS_GATES = WS_ROWG + (size_t)PTOT * 4;
constexpr size_t WS_GSC = WS_GATES + (size_t)T * 16 * 4;
constexpr size_t WS_MPREV = WS_GSC + 2048 * 2 * 4;
constexpr size_t WS_NLOC = WS_MPREV + 2048 * 4;
constexpr size_t WS_NPREV = WS_NLOC + 2048ull * 128 * 4;
constexpr size_t WS_W = al256(WS_NPREV + 2048ull * 128 * 4);
constexpr size_t W_IN = 0, W_UQ = W_IN + 4096ull * 2048 * 2, W_UKV = W_UQ + 1280ull * 384 * 2, W_OUT = W_UKV + 1536ull * 256 * 2, W_GU = W_OUT + 2048ull * 2048 * 2, W_DN = W_GU + 65ull * 1024 * 2048 * 2, W_LAYER = W_DN + 65ull * 2048 * 512 * 2;
constexpr size_t WS_XRES = WS_W + 2 * W_LAYER;
constexpr size_t WS_HA = WS_XRES + (size_t)T * 2048 * 4;
constexpr size_t WS_R1 = WS_HA + (size_t)T * 2048 * 2;
constexpr size_t WS_R2 = WS_R1 + (size_t)T * 4096 * 2;
constexpr size_t R2_QA = 0, R2_KA = R2_QA + (size_t)T * 768 * 2, R2_CQN = R2_KA + (size_t)T * 256 * 2, R2_CKVN = R2_CQN + (size_t)T * 384 * 2, R2_KR = R2_CKVN + (size_t)T * 256 * 2,
                 R2_QB = R2_KR + (size_t)T * 64 * 2, R2_KVB = R2_QB + (size_t)T * 1280 * 2, R2_QC = R2_KVB + (size_t)T * 1536 * 2, R2_KC = R2_QC + (size_t)T * 512 * 2,
                 R2_KCT = R2_KC + (size_t)T * 512 * 2, R2_CPREV = R2_KCT + 2048ull * 16384 * 2, R2_END = R2_CPREV + 2048ull * 16384 * 2;
constexpr size_t WS_END = WS_R2 + (size_t)PTOT * 2048 * 2;
static_assert(R2_END <= (size_t)PTOT * 2048 * 2, "R2 overflow");
static_assert(WS_END <= 2147483648ull, "workspace too large");
}
namespace fx {
struct CvtW { const float* w_in; const float* w_uq; const float* w_ukv; const float* w_out; const float* eg; const float* eu; const float* ed; const float* sg; const float* su; const float* sd; bf16_t* W; };
__device__ __forceinline__ void cvt_layer(const CvtW& a, FX_LAS unsigned* my, int gwave, int nwaves, int& rot) {
    const int BIG = 1 << 30; bf16_t* W = a.W;
    bf16_t* WIN = W + W_IN / 2; bf16_t* WUQ = W + W_UQ / 2; bf16_t* WUKV = W + W_UKV / 2; bf16_t* WOUT = W + W_OUT / 2; bf16_t* WGU = W + W_GU / 2; bf16_t* WDN = W + W_DN / 2;
#ifdef FX_WIN8
    { CvtSeg s; s.src = a.w_in; s.dst = WIN; s.sstride = 0; s.dstride = 0; s.ld = 4048; s.nsrc = 4048; s.K = 2048; s.ntn = 64; s.nbatch = 1; s.G = BIG; s.GS = 0; s.off = 0; cvt_seg8(s, my, gwave, nwaves, rot, W8_SCALE); }
#else
    { CvtSeg s; s.src = a.w_in; s.dst = WIN; s.sstride = 0; s.dstride = 0; s.ld = 4048; s.nsrc = 4048; s.K = 2048; s.ntn = 64; s.nbatch = 1; s.G = BIG; s.GS = 0; s.off = 0; cvt_seg(s, my, gwave, nwaves, rot); }
#endif
    { CvtSeg s; s.src = a.w_uq; s.dst = WUQ; s.sstride = 0; s.dstride = 0; s.ld = 1152; s.nsrc = 1152; s.K = 384; s.ntn = 20; s.nbatch = 1; s.G = BIG; s.GS = 0; s.off = 0; cvt_seg(s, my, gwave, nwaves, rot); }
    { CvtSeg s; s.src = a.w_ukv; s.dst = WUKV; s.sstride = 0; s.dstride = 0; s.ld = 1536; s.nsrc = 1536; s.K = 256; s.ntn = 24; s.nbatch = 1; s.G = BIG; s.GS = 0; s.off = 0; cvt_seg(s, my, gwave, nwaves, rot); }
#ifdef FX_WOUT8
    { CvtSeg s; s.src = a.w_out; s.dst = WOUT; s.sstride = 0; s.dstride = 0; s.ld = 2048; s.nsrc = 2048; s.K = 2048; s.ntn = 32; s.nbatch = 1; s.G = BIG; s.GS = 0; s.off = 0; cvt_seg8(s, my, gwave, nwaves, rot, W8_SCALE); }
#else
    { CvtSeg s; s.src = a.w_out; s.dst = WOUT; s.sstride = 0; s.dstride = 0; s.ld = 2048; s.nsrc = 2048; s.K = 2048; s.ntn = 32; s.nbatch = 1; s.G = BIG; s.GS = 0; s.off = 0; cvt_seg(s, my, gwave, nwaves, rot); }
#endif
    { CvtSeg s; s.src = a.eg; s.dst = WGU; s.sstride = 2048ll * 512; s.dstride = 1024ll * 2048; s.ld = 512; s.nsrc = 512; s.K = 2048; s.ntn = 8; s.nbatch = 64; s.G = 128; s.GS = 256; s.off = 0; cvt_seg8(s, my, gwave, nwaves, rot, W8_SCALE); }
    { CvtSeg s; s.src = a.eu; s.dst = WGU; s.sstride = 2048ll * 512; s.dstride = 1024ll * 2048; s.ld = 512; s.nsrc = 512; s.K = 2048; s.ntn = 8; s.nbatch = 64; s.G = 128; s.GS = 256; s.off = 128; cvt_seg8(s, my, gwave, nwaves, rot, W8_SCALE); }
    { CvtSeg s; s.src = a.ed; s.dst = WDN; s.sstride = 512ll * 2048; s.dstride = 2048ll * 512; s.ld = 2048; s.nsrc = 2048; s.K = 512; s.ntn = 32; s.nbatch = 64; s.G = BIG; s.GS = 0; s.off = 0; cvt_seg8(s, my, gwave, nwaves, rot, W8_SCALE); }
    { CvtSeg s; s.src = a.sg; s.dst = (bf16_t*)((unsigned char*)WGU + 64ull * 1024 * 2048); s.sstride = 0; s.dstride = 0; s.ld = 512; s.nsrc = 512; s.K = 2048; s.ntn = 8; s.nbatch = 1; s.G = 128; s.GS = 256; s.off = 0; cvt_seg8(s, my, gwave, nwaves, rot, W8_SCALE); }
    { CvtSeg s; s.src = a.su; s.dst = (bf16_t*)((unsigned char*)WGU + 64ull * 1024 * 2048); s.sstride = 0; s.dstride = 0; s.ld = 512; s.nsrc = 512; s.K = 2048; s.ntn = 8; s.nbatch = 1; s.G = 128; s.GS = 256; s.off = 128; cvt_seg8(s, my, gwave, nwaves, rot, W8_SCALE); }
    { CvtSeg s; s.src = a.sd; s.dst = (bf16_t*)((unsigned char*)WDN + 64ull * 2048 * 512); s.sstride = 0; s.dstride = 0; s.ld = 2048; s.nsrc = 2048; s.K = 512; s.ntn = 32; s.nbatch = 1; s.G = BIG; s.GS = 0; s.off = 0; cvt_seg8(s, my, gwave, nwaves, rot, W8_SCALE); }
}
constexpr int CVT_TILES_PER_LAYER = 2048 + 120 + 96 + 1024 + 3 * 16384 + 3 * 256;
__device__ __forceinline__ void cvt_layer_one(const CvtW& a, FX_LAS unsigned* my, int g) {
    int base = 0;
    const int BIG = 1 << 30; bf16_t* W = a.W;
    bf16_t* WIN = W + W_IN / 2; bf16_t* WUQ = W + W_UQ / 2; bf16_t* WUKV = W + W_UKV / 2; bf16_t* WOUT = W + W_OUT / 2; bf16_t* WGU = W + W_GU / 2; bf16_t* WDN = W + W_DN / 2;
#ifdef FX_WIN8
    { CvtSeg s; s.src = a.w_in; s.dst = WIN; s.sstride = 0; s.dstride = 0; s.ld = 4048; s.nsrc = 4048; s.K = 2048; s.ntn = 64; s.nbatch = 1; s.G = BIG; s.GS = 0; s.off = 0; { const int cnt_ = (s.K / 64) * s.ntn * s.nbatch; if (g >= base && g < base + cnt_) cvt_tile8(s, my, g - base, W8_SCALE); base += cnt_; } }
#else
    { CvtSeg s; s.src = a.w_in; s.dst = WIN; s.sstride = 0; s.dstride = 0; s.ld = 4048; s.nsrc = 4048; s.K = 2048; s.ntn = 64; s.nbatch = 1; s.G = BIG; s.GS = 0; s.off = 0; { const int cnt_ = (s.K / 64) * s.ntn * s.nbatch; if (g >= base && g < base + cnt_) cvt_tile(s, my, g - base); base += cnt_; } }
#endif
    { CvtSeg s; s.src = a.w_uq; s.dst = WUQ; s.sstride = 0; s.dstride = 0; s.ld = 1152; s.nsrc = 1152; s.K = 384; s.ntn = 20; s.nbatch = 1; s.G = BIG; s.GS = 0; s.off = 0; { const int cnt_ = (s.K / 64) * s.ntn * s.nbatch; if (g >= base && g < base + cnt_) cvt_tile(s, my, g - base); base += cnt_; } }
    { CvtSeg s; s.src = a.w_ukv; s.dst = WUKV; s.sstride = 0; s.dstride = 0; s.ld = 1536; s.nsrc = 1536; s.K = 256; s.ntn = 24; s.nbatch = 1; s.G = BIG; s.GS = 0; s.off = 0; { const int cnt_ = (s.K / 64) * s.ntn * s.nbatch; if (g >= base && g < base + cnt_) cvt_tile(s, my, g - base); base += cnt_; } }
#ifdef FX_WOUT8
    { CvtSeg s; s.src = a.w_out; s.dst = WOUT; s.sstride = 0; s.dstride = 0; s.ld = 2048; s.nsrc = 2048; s.K = 2048; s.ntn = 32; s.nbatch = 1; s.G = BIG; s.GS = 0; s.off = 0; { const int cnt_ = (s.K / 64) * s.ntn * s.nbatch; if (g >= base && g < base + cnt_) cvt_tile8(s, my, g - base, W8_SCALE); base += cnt_; } }
#else
    { CvtSeg s; s.src = a.w_out; s.dst = WOUT; s.sstride = 0; s.dstride = 0; s.ld = 2048; s.nsrc = 2048; s.K = 2048; s.ntn = 32; s.nbatch = 1; s.G = BIG; s.GS = 0; s.off = 0; { const int cnt_ = (s.K / 64) * s.ntn * s.nbatch; if (g >= base && g < base + cnt_) cvt_tile(s, my, g - base); base += cnt_; } }
#endif
    { CvtSeg s; s.src = a.eg; s.dst = WGU; s.sstride = 2048ll * 512; s.dstride = 1024ll * 2048; s.ld = 512; s.nsrc = 512; s.K = 2048; s.ntn = 8; s.nbatch = 64; s.G = 128; s.GS = 256; s.off = 0; { const int cnt_ = (s.K / 64) * s.ntn * s.nbatch; if (g >= base && g < base + cnt_) cvt_tile8(s, my, g - base, W8_SCALE); base += cnt_; } }
    { CvtSeg s; s.src = a.eu; s.dst = WGU; s.sstride = 2048ll * 512; s.dstride = 1024ll * 2048; s.ld = 512; s.nsrc = 512; s.K = 2048; s.ntn = 8; s.nbatch = 64; s.G = 128; s.GS = 256; s.off = 128; { const int cnt_ = (s.K / 64) * s.ntn * s.nbatch; if (g >= base && g < base + cnt_) cvt_tile8(s, my, g - base, W8_SCALE); base += cnt_; } }
    { CvtSeg s; s.src = a.ed; s.dst = WDN; s.sstride = 512ll * 2048; s.dstride = 2048ll * 512; s.ld = 2048; s.nsrc = 2048; s.K = 512; s.ntn = 32; s.nbatch = 64; s.G = BIG; s.GS = 0; s.off = 0; { const int cnt_ = (s.K / 64) * s.ntn * s.nbatch; if (g >= base && g < base + cnt_) cvt_tile8(s, my, g - base, W8_SCALE); base += cnt_; } }
    { CvtSeg s; s.src = a.sg; s.dst = (bf16_t*)((unsigned char*)WGU + 64ull * 1024 * 2048); s.sstride = 0; s.dstride = 0; s.ld = 512; s.nsrc = 512; s.K = 2048; s.ntn = 8; s.nbatch = 1; s.G = 128; s.GS = 256; s.off = 0; { const int cnt_ = (s.K / 64) * s.ntn * s.nbatch; if (g >= base && g < base + cnt_) cvt_tile8(s, my, g - base, W8_SCALE); base += cnt_; } }
    { CvtSeg s; s.src = a.su; s.dst = (bf16_t*)((unsigned char*)WGU + 64ull * 1024 * 2048); s.sstride = 0; s.dstride = 0; s.ld = 512; s.nsrc = 512; s.K = 2048; s.ntn = 8; s.nbatch = 1; s.G = 128; s.GS = 256; s.off = 128; { const int cnt_ = (s.K / 64) * s.ntn * s.nbatch; if (g >= base && g < base + cnt_) cvt_tile8(s, my, g - base, W8_SCALE); base += cnt_; } }
    { CvtSeg s; s.src = a.sd; s.dst = (bf16_t*)((unsigned char*)WDN + 64ull * 2048 * 512); s.sstride = 0; s.dstride = 0; s.ld = 2048; s.nsrc = 2048; s.K = 512; s.ntn = 32; s.nbatch = 1; s.G = BIG; s.GS = 0; s.off = 0; { const int cnt_ = (s.K / 64) * s.ntn * s.nbatch; if (g >= base && g < base + cnt_) cvt_tile8(s, my, g - base, W8_SCALE); base += cnt_; } }
}
}
namespace fx {
#define XB_TMO      128
#define XB_XCNT(j)  (256  + 64 * (j))
#define XB_XSUB(j)  (1280 + 64 * (j))
#define XB_XGEN(j)  (2304 + 64 * (j))
#define XB_TOP      3328
#define XB_TOPGEN   3392
#define XCD_BAR_WORDS 3456
#define XB_SPIN_CAP (1u << 22)
__device__ __forceinline__ unsigned xb_ld(unsigned* p)              { return __hip_atomic_load(p, __ATOMIC_RELAXED, __HIP_MEMORY_SCOPE_AGENT); }
__device__ __forceinline__ unsigned xb_add(unsigned* p, unsigned v) { return __hip_atomic_fetch_add(p, v, __ATOMIC_RELAXED, __HIP_MEMORY_SCOPE_AGENT); }
__device__ __forceinline__ unsigned xb_xcc_id() { return (unsigned)__builtin_amdgcn_s_getreg((3 << 11) | 20) & 0xFu; }
#define XB_SPIN(cond, bar) do { unsigned _sp = 0; while (cond) { __builtin_amdgcn_s_sleep(1); \
    if ((++_sp & 255u) == 0u) { if (xb_ld(&(bar)[XB_TMO])) break; if (_sp > XB_SPIN_CAP) { atomicAdd(&(bar)[XB_TMO], 1u); break; } } } } while (0)
struct XcdBarrier { unsigned* bar; unsigned x; volatile FX_LAS unsigned* st; };
__device__ __forceinline__ XcdBarrier xcd_barrier_post(unsigned* bar, volatile FX_LAS unsigned* st, int tidp) {
    XcdBarrier b; b.bar = bar; b.x = xb_xcc_id(); b.st = st;
    if (tidp == 0) (void)xb_add(&bar[XB_XCNT(b.x)], 1u);
    return b;
}
__device__ __forceinline__ void xcd_barrier_complete(unsigned* bar, unsigned x, unsigned& nloc, unsigned& nx) {
    const unsigned G = gridDim.x * gridDim.y * gridDim.z;
    unsigned sum, cnt, mine, sp = 0u;
    for (;;) {
        sum = 0u; cnt = 0u; mine = 0u;
#pragma unroll
        for (unsigned j = 0; j < 16; ++j) { const unsigned c = xb_ld(&bar[XB_XCNT(j)]); sum += c; cnt += (c > 0u) ? 1u : 0u; mine = (j == x) ? c : mine; }
        if (sum == G) break;
        __builtin_amdgcn_s_sleep(1);
        if ((++sp & 255u) == 0u) { if (xb_ld(&bar[XB_TMO])) break; if (sp > XB_SPIN_CAP) { atomicAdd(&bar[XB_TMO], 1u); break; } }
    }
    nloc = mine > 0u ? mine : 1u; nx = cnt > 0u ? cnt : 1u;
}
__device__ __forceinline__ void xcd_barrier(const XcdBarrier& b, int tidp) {
    asm volatile("s_waitcnt vmcnt(0)" ::: "memory");
    __syncthreads();
    if (tidp == 0) {
        unsigned* bar = b.bar;
        __builtin_amdgcn_s_waitcnt(0);
        unsigned nloc = b.st[0], nx = b.st[1];
        if (nloc == 0u) { xcd_barrier_complete(bar, b.x, nloc, nx); b.st[0] = nloc; b.st[1] = nx; }
        const unsigned old = xb_add(&bar[XB_XSUB(b.x)], 1u);
        const unsigned gen = old / nloc;
        if (old + 1u == (gen + 1u) * nloc) {
            __builtin_amdgcn_fence(__ATOMIC_RELEASE, "agent");
            asm volatile("s_waitcnt vmcnt(0)" ::: "memory");
            const unsigned og = xb_add(&bar[XB_TOP], 1u);
            const unsigned tg = og / nx;
            if (og + 1u == (tg + 1u) * nx) xb_add(&bar[XB_TOPGEN], 1u);
            else XB_SPIN(xb_ld(&bar[XB_TOPGEN]) == tg, bar);
            __builtin_amdgcn_fence(__ATOMIC_ACQUIRE, "agent");
            xb_add(&bar[XB_XGEN(b.x)], 1u);
            asm volatile("s_waitcnt vmcnt(0)" ::: "memory");
        } else {
            XB_SPIN(xb_ld(&bar[XB_XGEN(b.x)]) == gen, bar);
            __builtin_amdgcn_fence(__ATOMIC_ACQUIRE, "agent");
            asm volatile("s_waitcnt vmcnt(0)" ::: "memory");
        }
    }
    __syncthreads();
}

__device__ __forceinline__ void modp_phase(FX_LAS unsigned char* lds_, const float* c, const float* ada_w, float* MODP, int wg, int nwg, int tidp) {
    float* cact = (float*)(char*)lds_;
    for (int i = tidp; i < 8192; i += 512) { const float v = c[i]; cact[i] = v / (1.f + expf(-v)); }
    __syncthreads();
    int tid_ = tidp; asm volatile("" : "+v"(tid_));
    const int wid = tid_ >> 6, lane = tid_ & 63;
    for (int u = wg * 8 + wid; u < 2 * 48 * 32; u += nwg * 8) {
        const int kc = u & 31, nc = (u >> 5) % 48, l = u / (48 * 32);
        const float* w = ada_w + (size_t)l * 2048 * 12288 + (size_t)(kc * 64) * 12288 + nc * 256 + lane * 4;
        f32x4 a0 = {0.f, 0.f, 0.f, 0.f}, a1 = a0, a2 = a0, a3 = a0;
#pragma unroll 8
        for (int k = 0; k < 64; ++k) { const f32x4 wv = *(const f32x4*)(w + (size_t)k * 12288); const int kk = kc * 64 + k;
            a0 += wv * cact[kk]; a1 += wv * cact[2048 + kk]; a2 += wv * cact[4096 + kk]; a3 += wv * cact[6144 + kk]; }
        float* dst = MODP + (((size_t)l * 32 + kc) * 4) * 12288 + nc * 256 + lane * 4;
        *(f32x4*)dst = a0; *(f32x4*)(dst + 12288) = a1; *(f32x4*)(dst + 2 * 12288) = a2; *(f32x4*)(dst + 3 * 12288) = a3;
    }
    __syncthreads();
}
__device__ __forceinline__ void tab_phase(float* tab, int gtid) {
    if (gtid < 2048) { const int p = gtid >> 5, f = gtid & 31; const float inv = powf(10000.f, -(float)(2 * f) / 64.f); const float a = (float)p * inv; tab[gtid] = cosf(a); tab[2048 + gtid] = sinf(a); }
    else if (gtid < 3072) { const int i = gtid - 2048, p = i >> 4, f = i & 15; const float inv = powf(10000.f, -(float)(2 * f) / 32.f); const float a = (float)p * inv; tab[4096 + i] = cosf(a); tab[5120 + i] = sinf(a); }
}
__device__ __forceinline__ void coef2_phase(const float* MODP, const float* ada_b, const float* pre_mix_gain, const float* post_mix_gain, const float* pre_ffn_gain, const float* post_ffn_gain, float* coef, int gtid, int nthr) {
    for (int i = gtid; i < 2 * 4 * 2048; i += nthr) { const int d = i & 2047, b = (i >> 11) & 3, l = i >> 13;
        float m[6];
#pragma unroll
        for (int j = 0; j < 6; ++j) { float s = ada_b[l * 12288 + j * 2048 + d];
            for (int kc = 0; kc < 32; ++kc) s += MODP[(((size_t)l * 32 + kc) * 4 + b) * 12288 + j * 2048 + d];
            m[j] = s; }
        float* c = coef + ((size_t)l * 4 + b) * 6 * 2048;
        c[0 * 2048 + d] = m[2] * post_mix_gain[l * 2048 + d];
        c[1 * 2048 + d] = pre_ffn_gain[l * 2048 + d] * (1.f + m[4]);
        c[2 * 2048 + d] = m[3];
        c[3 * 2048 + d] = m[5] * post_ffn_gain[l * 2048 + d];
        c[4 * 2048 + d] = pre_mix_gain[l * 2048 + d] * (1.f + m[1]);
        c[5 * 2048 + d] = m[0]; }
}
__device__ __forceinline__ void prenorm_phase(const float* x, const float* coef_l, bf16_t* HA, int wg, int nwg, int tidp) {
    int tid_ = tidp; asm volatile("" : "+v"(tid_));
    const int wid = tid_ >> 6, lane = tid_ & 63;
    for (int t = wg * 8 + wid; t < T; t += nwg * 8) {
        const float* cn = coef_l + (size_t)(t / S) * 6 * 2048;
        float xv[32]; float ss = 0.f;
#pragma unroll
        for (int i = 0; i < 4; ++i) { const int c = i * 512 + lane * 8; const f32x4 x0 = *(const f32x4*)(x + (size_t)t * 2048 + c), x1 = *(const f32x4*)(x + (size_t)t * 2048 + c + 4);
#pragma unroll
            for (int j = 0; j < 4; ++j) { xv[i * 8 + j] = x0[j]; xv[i * 8 + 4 + j] = x1[j]; ss += x0[j] * x0[j] + x1[j] * x1[j]; } }
        ss = wave_sum(ss); const float rx = rsqrtf(ss * (1.f / 2048.f) + EPS);
#pragma unroll
        for (int i = 0; i < 4; ++i) { const int c = i * 512 + lane * 8;
            const f32x4 e0 = *(const f32x4*)(cn + 4 * 2048 + c), e1 = *(const f32x4*)(cn + 4 * 2048 + c + 4), f0 = *(const f32x4*)(cn + 5 * 2048 + c), f1 = *(const f32x4*)(cn + 5 * 2048 + c + 4);
            float hv[8];
#pragma unroll
            for (int j = 0; j < 4; ++j) { hv[j] = xv[i * 8 + j] * rx * e0[j] + f0[j]; hv[4 + j] = xv[i * 8 + 4 + j] * rx * e1[j] + f1[j]; }
#ifdef FX_WIN8
            u32x2 w; w.x = cvt_pk4_fp8(hv[0], hv[1], hv[2], hv[3]); w.y = cvt_pk4_fp8(hv[4], hv[5], hv[6], hv[7]);
            *(u32x2*)((unsigned char*)HA + (size_t)t * 2048 + c) = w; }
#else
            u32x4 w; w.x = cvt_pk_bf16(hv[0], hv[1]); w.y = cvt_pk_bf16(hv[2], hv[3]); w.z = cvt_pk_bf16(hv[4], hv[5]); w.w = cvt_pk_bf16(hv[6], hv[7]);
            *(u32x4*)(HA + (size_t)t * 2048 + c) = w; }
#endif
    }
}

constexpr int LDS_ST = 139264, LDS_TOTAL = LDS_ST + 64;
constexpr size_t WS_MODP = WS_R2;
struct MP {
    const float* x; const float* c; const float* ada_w; const float* ada_b; const float* pre_mix_gain; const float* w_in; const float* a_q_gain; const float* a_k_gain;
    const float* b_cq_gain; const float* b_ckv_gain; const float* w_uq; const float* w_ukv; const float* c_conv_w; const float* c_conv_b; const float* c_gate_b;
    const float* head_out_gain; const float* w_out; const float* post_mix_gain; const float* pre_ffn_gain; const float* router_w; const float* router_bias;
    const float* exp_w_gate; const float* exp_w_up; const float* exp_w_down; const float* sh_w_gate; const float* sh_w_up; const float* sh_w_down; const float* post_ffn_gain;
    char* ws; float* out;
};
#ifndef FX_NPHASE
#define FX_NPHASE 1000
#endif
#define PH_BEGIN const MP* pk = (const MP*)__builtin_amdgcn_kernarg_segment_ptr(); asm volatile("" : "+s"(pk)); char* ws = pk->ws; (void)ws; int gt_ = wid_s * 64 + fx_lane(); asm volatile("" : "+v"(gt_)); int wg_ = blockIdx.x, nwg_ = gridDim.x; asm volatile("" : "+s"(wg_), "+s"(nwg_)); const int wg = wg_, nwg = nwg_; (void)wg; (void)nwg; (void)gt_;
#define PH_BAR do { PH_BEGIN XcdBarrier b_; b_.bar = (unsigned*)(ws + WS_BAR); b_.x = xb_xcc_id(); b_.st = (volatile FX_LAS unsigned*)(lds + LDS_ST); xcd_barrier(b_, gt_); } while (0)
#define WSP(T_, off) ((T_*)(ws + (off)))
constexpr int QW_CNT = 3584;
constexpr unsigned HV_SLACK = 24;
__device__ __forceinline__ void harvest(FX_LAS unsigned char* lds, const MP* pk, char* ws, int tid, const unsigned nbar, const bool drain) {
    volatile FX_LAS unsigned* bw = (volatile FX_LAS unsigned*)(lds + LDS_ST);
    unsigned* bar = (unsigned*)(ws + WS_BAR);
    const int wave = tid >> 6; FX_LAS unsigned* my = (FX_LAS unsigned*)(lds) + wave * (64 * 33);
    CvtW a; a.w_in = pk->w_in + (size_t)D * 4048; a.w_uq = pk->w_uq + (size_t)384 * 1152; a.w_ukv = pk->w_ukv + (size_t)256 * 1536; a.w_out = pk->w_out + (size_t)D * D;
    a.eg = pk->exp_w_gate + (size_t)NE * D * FF; a.eu = pk->exp_w_up + (size_t)NE * D * FF; a.ed = pk->exp_w_down + (size_t)NE * FF * D;
    a.sg = pk->sh_w_gate + (size_t)D * FF; a.su = pk->sh_w_up + (size_t)D * FF; a.sd = pk->sh_w_down + (size_t)FF * D; a.W = (bf16_t*)(ws + WS_W + W_LAYER);
    __syncthreads();
    if (drain) {
        if (tid == 0) bw[3] = xb_ld(&bar[QW_CNT]);
        __syncthreads();
        const unsigned h = bw[3];
#pragma unroll 1
        for (unsigned g = h + (unsigned)(blockIdx.x * 8 + wave); g < (unsigned)CVT_TILES_PER_LAYER; g += gridDim.x * 8u) cvt_layer_one(a, my, (int)g);
        __syncthreads();
        return;
    }
#pragma unroll 1
    for (;;) {
        if (tid == 0) { unsigned nxt = 0xffffffffu; bool go = true;
            if (!drain) { unsigned sum = 0u;
#pragma unroll
                for (unsigned j = 0; j < 16; ++j) sum += xb_ld(&bar[XB_XSUB(j)]);
                const unsigned G = gridDim.x; go = (sum - nbar * G) + HV_SLACK < G; }
            if (go && xb_ld(&bar[QW_CNT]) < (unsigned)CVT_TILES_PER_LAYER) { const unsigned b0 = xb_add(&bar[QW_CNT], 8u); if (b0 < (unsigned)CVT_TILES_PER_LAYER) nxt = b0; }
            bw[3] = nxt; }
        __syncthreads();
        const unsigned base = bw[3];
        if (base == 0xffffffffu) break;
        const int g = (int)base + wave;
        if (g < CVT_TILES_PER_LAYER) cvt_layer_one(a, my, g);
        __syncthreads();
    }
    __syncthreads();
}
#ifndef FX_HARVEST
#define FX_HARVEST 1
#endif
#define PH_HARVEST(n, dr) do { if (FX_HARVEST && l == 0 && ((dr) || FX_HARVEST == 1)) { PH_BEGIN harvest(lds, pk, ws, gt_, (n), (dr)); } } while (0)
#ifndef FX_DUP
#define FX_DUP -1
#endif
#define FX_NE ((FX_NOEPI && rep_ == 1) ? FX_NOEPI : 0)
#define FX_REP(n) _Pragma("unroll 1") for (int rep_ = 0; rep_ < ((FX_DUP == (n) && l == 0) ? 2 : 1); ++rep_)
template <int l> __device__ __forceinline__ void layer_body(FX_LAS unsigned char* lds, unsigned char* shm, const int wid_s) {
        FX_REP(2) { PH_BEGIN const bf16_t* W = WSP(const bf16_t, WS_W + (size_t)l * W_LAYER);
#ifdef FX_WIN8
          DenseSched Sc; Sc.init(T, 4096, nwg, wg, 2048, W + W_IN / 2, 2048, 1); EpiBf16 E; E.O = WSP(bf16_t, WS_R1); E.gates = WSP(float, WS_GATES); E.ldc = 4096; E.scale = W8_INV;
          gemm_phase<EpiBf16, DenseSched, true>(lds, (const char*)WSP(bf16_t, WS_HA), 2048, Sc, E, gt_, FX_NE); }
#else
          DenseSched Sc; Sc.init(T, 4096, nwg, wg, 2048 * 2, W + W_IN / 2, 2048); EpiBf16 E; E.O = WSP(bf16_t, WS_R1); E.gates = WSP(float, WS_GATES); E.ldc = 4096; E.scale = 1.f;
          gemm_phase<EpiBf16, DenseSched>(lds, (const char*)WSP(bf16_t, WS_HA), 2048, Sc, E, gt_); }
#endif
        PH_HARVEST(3u, false);
        PH_BAR;
        FX_REP(3) { PH_BEGIN char* R2 = ws + WS_R2; float* tab = WSP(float, WS_TAB);
          P3Args a; a.PROJ = WSP(bf16_t, WS_R1); a.GATES = WSP(float, WS_GATES); a.gate_b = pk->c_gate_b + l * 16; a.conv_w = pk->c_conv_w + (size_t)l * 5 * 1024; a.conv_b = pk->c_conv_b + l * 1024;
          a.aq_gain = pk->a_q_gain + l * 128; a.ak_gain = pk->a_k_gain + l * 128; a.cq_gain = pk->b_cq_gain + l * 384; a.ckv_gain = pk->b_ckv_gain + l * 256;
          a.cosA = tab; a.sinA = tab + 2048; a.cosB = tab + 4096; a.sinB = tab + 5120;
          a.QA = (bf16_t*)(R2 + R2_QA); a.KA = (bf16_t*)(R2 + R2_KA); a.CQN = (bf16_t*)(R2 + R2_CQN); a.CKVN = (bf16_t*)(R2 + R2_CKVN); a.KR = (bf16_t*)(R2 + R2_KR); a.QC = (bf16_t*)(R2 + R2_QC); a.KC = (bf16_t*)(R2 + R2_KC);
          a.KCT = (bf16_t*)(R2 + R2_KCT); a.NLOC = WSP(float, WS_NLOC); a.GSC = WSP(float, WS_GSC);
          p3_phase(lds, a, wg, nwg, gt_); }
        PH_BAR;
        FX_REP(4) {
        { PH_BEGIN const bf16_t* W = WSP(const bf16_t, WS_W + (size_t)l * W_LAYER); char* R2 = ws + WS_R2; float* tab = WSP(float, WS_TAB);
          DenseSched Sc; Sc.init(T, 1280, nwg, wg, 384 * 2, W + W_UQ / 2, 384); EpiQB E; E.O = (bf16_t*)(R2 + R2_QB); E.cosB = tab + 4096; E.sinB = tab + 5120;
          gemm_phase<EpiQB, DenseSched>(lds, (const char*)(R2 + R2_CQN), 384, Sc, E, gt_); }
        { PH_BEGIN const bf16_t* W = WSP(const bf16_t, WS_W + (size_t)l * W_LAYER); char* R2 = ws + WS_R2;
          DenseSched Sc; Sc.init(T, 1536, nwg, wg, 256 * 2, W + W_UKV / 2, 256); EpiBf16 E; E.O = (bf16_t*)(R2 + R2_KVB); E.gates = nullptr; E.ldc = 1536; E.scale = 1.f;
          gemm_phase<EpiBf16, DenseSched>(lds, (const char*)(R2 + R2_CKVN), 256, Sc, E, gt_); }
        { PH_BEGIN char* R2 = ws + WS_R2;
          scan_phase((const bf16_t*)(R2 + R2_KCT), WSP(float, WS_NLOC), WSP(float, WS_GSC), (bf16_t*)(R2 + R2_CPREV), WSP(float, WS_NPREV), WSP(float, WS_MPREV), wg * 512 + gt_, nwg * 512); }
        }
        PH_HARVEST(5u, false);
        PH_BAR;
        FX_REP(5) {
#pragma unroll 1
          for (int ui = 0; ui < 2; ++ui) { PH_BEGIN char* R2 = ws + WS_R2; int u;
              if (nwg == 256) { const int x = wg & 7, j = wg >> 3; if (ui == 1 && j >= 16) break; u = x * 48 + j + ui * 32; } else { u = wg + ui * nwg; if (u >= 384) break; }
              attn_gqa_unit(u, (const bf16_t*)(R2 + R2_QA), (const bf16_t*)(R2 + R2_KA), WSP(const bf16_t, WS_R1), WSP(bf16_t, WS_HA), pk->head_out_gain + l * D, (char*)shm, gt_); }
#pragma unroll 1
          for (int ui = 0; ui < 2; ++ui) { PH_BEGIN char* R2 = ws + WS_R2; int u;
              if (nwg == 256) { const int x = wg & 7, j = wg >> 3; if (j < 16) { if (ui == 1) break; u = x * 48 + j; } else u = x * 48 + 16 + (j - 16) * 2 + ui; } else { u = wg + ui * nwg; if (u >= 384) break; }
              attn_mla_unit(u, (const bf16_t*)(R2 + R2_QB), (const bf16_t*)(R2 + R2_KVB), (const bf16_t*)(R2 + R2_KR), WSP(bf16_t, WS_HA), pk->head_out_gain + l * D, (char*)shm, gt_); }
          { PH_BEGIN char* R2 = ws + WS_R2;
            McArgs a; a.PROJ = WSP(bf16_t, WS_R1); a.GATES = WSP(float, WS_GATES); a.gate_b = pk->c_gate_b + l * 16; a.QC = (bf16_t*)(R2 + R2_QC); a.KC = (bf16_t*)(R2 + R2_KC); a.CPREV = (bf16_t*)(R2 + R2_CPREV);
            a.NPREV = WSP(float, WS_NPREV); a.MPREV = WSP(float, WS_MPREV); a.hog = pk->head_out_gain + l * D; a.YM = WSP(bf16_t, WS_HA);
            mlstm_c_phase(lds, a, wg, nwg, gt_); } }
        PH_HARVEST(6u, false);
        PH_BAR;
        FX_REP(6) { PH_BEGIN const bf16_t* W = WSP(const bf16_t, WS_W + (size_t)l * W_LAYER);
#ifdef FX_WOUT8
          DenseSched Sc; Sc.init(T, 2048, nwg, wg, 2048, W + W_OUT / 2, 2048, 1); EpiBf16 E; E.O = WSP(bf16_t, WS_R1); E.gates = nullptr; E.ldc = 2048; E.scale = W8_INV;
          gemm_phase<EpiBf16, DenseSched, true>(lds, (const char*)WSP(bf16_t, WS_HA), 2048, Sc, E, gt_, FX_NE); }
#else
          DenseSched Sc; Sc.init(T, 2048, nwg, wg, 2048 * 2, W + W_OUT / 2, 2048); EpiBf16 E; E.O = WSP(bf16_t, WS_R1); E.gates = nullptr; E.ldc = 2048; E.scale = 1.f;
          gemm_phase<EpiBf16, DenseSched>(lds, (const char*)WSP(bf16_t, WS_HA), 2048, Sc, E, gt_); }
#endif
        PH_HARVEST(7u, false);
        PH_BAR;
        { PH_BEGIN p7_phase<(l != 0)>(lds, l == 0 ? (const void*)pk->x : (const void*)WSP(const bf16_t, WS_XRES), WSP(const bf16_t, WS_R1), WSP(float, WS_COEF) + (size_t)l * 4 * 6 * 2048, pk->router_w + (size_t)l * D * 64, pk->router_bias + l * 64,
                            WSP(bf16_t, WS_XRES), WSP(unsigned char, WS_HA), WSP(int, WS_SELE), WSP(float, WS_SELG), WSP(int, WS_CNT) + l * 64, WSP(int, WS_WGBASE), wg, nwg, gt_); }
        PH_BAR;
        { PH_BEGIN p8_phase(lds, WSP(int, WS_SELE), WSP(float, WS_SELG), WSP(int, WS_CNT) + l * 64, WSP(int, WS_WGBASE), WSP(int, WS_ROWTOK), WSP(float, WS_ROWG), WSP(int, WS_SLOT), wg, nwg, gt_); }
        PH_BAR;
        FX_REP(9) { PH_BEGIN const bf16_t* W = WSP(const bf16_t, WS_W + (size_t)l * W_LAYER);
          p9_phase(lds, WSP(unsigned char, WS_HA), (const unsigned char*)(W + W_GU / 2), WSP(int, WS_CNT) + l * 64, WSP(int, WS_ROWTOK), WSP(unsigned char, WS_R1), wg, nwg, gt_, FX_NE); }
        PH_HARVEST(10u, false);
        PH_BAR;
        FX_REP(10) { PH_BEGIN const bf16_t* W = WSP(const bf16_t, WS_W + (size_t)l * W_LAYER);
          p10_phase(lds, WSP(unsigned char, WS_R1), (const unsigned char*)(W + W_DN / 2), WSP(int, WS_CNT) + l * 64, WSP(float, WS_ROWG), WSP(unsigned char, WS_R2), wg, nwg, gt_, FX_NE); }
        PH_HARVEST(11u, false);
        PH_BAR;
        { PH_BEGIN p11_phase<(l == 1)>(WSP(bf16_t, WS_XRES), WSP(unsigned char, WS_R2), WSP(int, WS_SLOT), WSP(float, WS_COEF) + (size_t)l * 4 * 6 * 2048, l == 0 ? WSP(float, WS_COEF) + 4 * 6 * 2048 : nullptr,
                             l == 1 ? (void*)pk->out : (void*)WSP(bf16_t, WS_XRES), WSP(bf16_t, WS_HA), wg, nwg, gt_); }
        PH_HARVEST(12u, true);
        if (l == 0) PH_BAR;
}
__global__ __launch_bounds__(512, 2) void mega(MP p_unused) {
    extern __shared__ __attribute__((aligned(16))) unsigned char shm[];
    FX_LAS unsigned char* lds = (FX_LAS unsigned char*)shm;
    const int wid_s = __builtin_amdgcn_readfirstlane((int)threadIdx.x >> 6);
    { volatile FX_LAS unsigned* st = (volatile FX_LAS unsigned*)(lds + LDS_ST);
      PH_BEGIN if (gt_ == 0) { st[0] = 0u; st[1] = 0u; st[2] = 0u; st[3] = 0u; }
      __syncthreads();
      (void)xcd_barrier_post((unsigned*)(ws + WS_BAR), st, gt_); }
    { PH_BEGIN const int wave = gt_ >> 6; FX_LAS unsigned* my = (FX_LAS unsigned*)(lds) + wave * (64 * 33); int rot = 0;
#pragma unroll 1
      for (int l = 0; l < ((FX_DUP == 0) ? 4 : (FX_HARVEST ? 1 : 2)); ++l) { const int lw = l & 1; CvtW a; a.w_in = pk->w_in + (size_t)lw * D * 4048; a.w_uq = pk->w_uq + (size_t)lw * 384 * 1152; a.w_ukv = pk->w_ukv + (size_t)lw * 256 * 1536; a.w_out = pk->w_out + (size_t)lw * D * D;
          a.eg = pk->exp_w_gate + (size_t)lw * NE * D * FF; a.eu = pk->exp_w_up + (size_t)lw * NE * D * FF; a.ed = pk->exp_w_down + (size_t)lw * NE * FF * D;
          a.sg = pk->sh_w_gate + (size_t)lw * D * FF; a.su = pk->sh_w_up + (size_t)lw * D * FF; a.sd = pk->sh_w_down + (size_t)lw * FF * D; a.W = (bf16_t*)(ws + WS_W + (size_t)lw * W_LAYER);
          cvt_layer(a, my, wg * 8 + wave, nwg * 8, rot); }
      __syncthreads(); }
    { PH_BEGIN modp_phase(lds, pk->c, pk->ada_w, WSP(float, WS_MODP), wg, nwg, gt_); tab_phase(WSP(float, WS_TAB), wg * 512 + gt_); }
#if FX_DUP == 20
    { PH_BEGIN modp_phase(lds, pk->c, pk->ada_w, WSP(float, WS_MODP), wg, nwg, gt_); tab_phase(WSP(float, WS_TAB), wg * 512 + gt_); }
#endif
    PH_BAR;
    { PH_BEGIN coef2_phase(WSP(float, WS_MODP), pk->ada_b, pk->pre_mix_gain, pk->post_mix_gain, pk->pre_ffn_gain, pk->post_ffn_gain, WSP(float, WS_COEF), wg * 512 + gt_, nwg * 512); }
#if FX_DUP == 21
    { PH_BEGIN coef2_phase(WSP(float, WS_MODP), pk->ada_b, pk->pre_mix_gain, pk->post_mix_gain, pk->pre_ffn_gain, pk->post_ffn_gain, WSP(float, WS_COEF), wg * 512 + gt_, nwg * 512); }
#endif
    PH_BAR;
    { PH_BEGIN prenorm_phase(pk->x, WSP(float, WS_COEF), WSP(bf16_t, WS_HA), wg, nwg, gt_); }
#if FX_DUP == 22
    { PH_BEGIN prenorm_phase(pk->x, WSP(float, WS_COEF), WSP(bf16_t, WS_HA), wg, nwg, gt_); }
#endif
    PH_BAR;
#if FX_DUP == 99
    PH_BAR; PH_BAR; PH_BAR; PH_BAR; PH_BAR; PH_BAR; PH_BAR; PH_BAR; PH_BAR; PH_BAR;
#endif
    layer_body<0>(lds, shm, wid_s);
    layer_body<1>(lds, shm, wid_s);
}
}

extern "C" void kernel_launch(void* const* d_in, const int* in_sizes, int n_in, void* d_out, int out_size, void* d_ws, size_t ws_size, hipStream_t stream) {
    using namespace fx;
    static int grid = 0;
    if (!grid) {
        int dev = 0, cus = 0, per_cu = 0;
        (void)hipGetDevice(&dev);
        (void)hipDeviceGetAttribute(&cus, hipDeviceAttributeMultiprocessorCount, dev);
        (void)hipFuncSetAttribute((const void*)mega, hipFuncAttributeMaxDynamicSharedMemorySize, LDS_TOTAL);
        (void)hipOccupancyMaxActiveBlocksPerMultiprocessor(&per_cu, (const void*)mega, 512, LDS_TOTAL);
        if (cus > 256) cus = 256;
        grid = per_cu >= 1 ? cus : 0;
    }
    if (!grid) return;
    (void)hipMemsetAsync((char*)d_ws + WS_BAR, 0, 16384, stream);
    (void)hipMemsetAsync((char*)d_ws + WS_CNT, 0, 512, stream);
    MP p{};
    const float** q = (const float**)&p;
    for (int i = 0; i < 28; ++i) q[i] = (const float*)d_in[i];
    p.ws = (char*)d_ws; p.out = (float*)d_out;
    hipLaunchKernelGGL(mega, dim3(grid), dim3(512), LDS_TOTAL, stream, p);
}
```

```cpp
#define FX_WIN8 1
#define FX_WOUT8 1
#define FX_HARVEST 0
#include <hip/hip_runtime.h>
#include <stdint.h>
#include <math.h>
#ifndef FX_NOEPI
#define FX_NOEPI 0
#endif
namespace fx {
#define FX_LAS __attribute__((address_space(3)))
typedef unsigned short bf16_t;
typedef short bf16x8 __attribute__((ext_vector_type(8)));
typedef short s16x4 __attribute__((ext_vector_type(4)));
typedef float f32x4 __attribute__((ext_vector_type(4)));
typedef float f32x16 __attribute__((ext_vector_type(16)));
typedef unsigned u32x4 __attribute__((ext_vector_type(4)));
typedef unsigned u32x2 __attribute__((ext_vector_type(2)));
typedef float f32x2 __attribute__((ext_vector_type(2)));

constexpr int D = 2048, NB = 4, S = 4096, T = NB * S, DEPTH = 2;
constexpr int NE = 64, FF = 512;
constexpr float EPS = 1e-6f;
constexpr int PW = 4096;
constexpr int O_AQ = 0, O_AK = 768, O_AV = 1024, O_BCQ = 1280, O_BCKV = 1664, O_BKR = 1920, O_CQ = 1984, O_CK = 2496, O_CV = 3008, O_CO = 3520, O_CG = 4032;

typedef __bf16 bf16x2_t __attribute__((ext_vector_type(2)));
__device__ __forceinline__ unsigned cvt_pk_bf16(float lo, float hi) { const bf16x2_t r = __builtin_convertvector((f32x2){lo, hi}, bf16x2_t); return __builtin_bit_cast(unsigned, r); }
__device__ __forceinline__ float bf2f(bf16_t b) { return __uint_as_float(((unsigned)b) << 16); }
__device__ __forceinline__ float bflo(unsigned w) { return __uint_as_float(w << 16); }
__device__ __forceinline__ float bfhi(unsigned w) { return __uint_as_float(w & 0xffff0000u); }
__device__ __forceinline__ bf16_t f2bf(float f) { return (bf16_t)(cvt_pk_bf16(f, 0.f) & 0xffffu); }
__device__ __forceinline__ float sigmoid_f(float x) { return __builtin_amdgcn_rcpf(1.f + __expf(-x)); }
__device__ __forceinline__ float silu_f(float x) { return x * __builtin_amdgcn_rcpf(1.f + __expf(-x)); }
__device__ __forceinline__ int fx_lane() { unsigned z = 0u; asm volatile("" : "+v"(z)); return (int)__builtin_amdgcn_mbcnt_hi(~0u, __builtin_amdgcn_mbcnt_lo(~0u, z)); }
__device__ __forceinline__ float wave_sum(float v) { for (int o = 32; o >= 1; o >>= 1) v += __shfl_xor(v, o); return v; }
__device__ __forceinline__ float wave_max(float v) { for (int o = 32; o >= 1; o >>= 1) v = fmaxf(v, __shfl_xor(v, o)); return v; }

#ifndef FX_WGM
#define FX_WGM 8
#endif
#ifndef FX_PRIO8
#define FX_PRIO8 1
#endif
#ifndef FX_F8_32
#define FX_F8_32 0
#endif
typedef int i32x8 __attribute__((ext_vector_type(8)));
typedef int i32x4 __attribute__((ext_vector_type(4)));
constexpr float W8_SCALE = 32.f, W8_INV = 1.f / 32.f;
__device__ __forceinline__ unsigned cvt_pk4_fp8(float a, float b, float c, float d) { int w = 0; w = __builtin_amdgcn_cvt_pk_fp8_f32(a, b, w, false); w = __builtin_amdgcn_cvt_pk_fp8_f32(c, d, w, true); return (unsigned)w; }
struct CvtSeg { const float* src; bf16_t* dst; long long sstride, dstride; int ld, nsrc, K, ntn, nbatch, G, GS, off; };
__device__ __forceinline__ void cvt_tile(const CvtSeg sg, FX_LAS unsigned* my, int tile) {
    const int lane = fx_lane();
    const int ktn = sg.K / 64, per = ktn * sg.ntn;
    {
        const int b = tile / per, r = tile - b * per, nt = r / ktn, kt = r - nt * ktn;
        const int r4 = lane >> 4, c4 = lane & 15;
        const float* src = sg.src + (size_t)b * sg.sstride + (size_t)(kt * 64) * sg.ld + nt * 64 + 4 * c4;
        const bool ok = nt * 64 + 4 * c4 < sg.nsrc;
        f32x4 va[8], vb[8];
#pragma unroll
        for (int i = 0; i < 8; ++i) { const int kp = 4 * i + r4; const f32x4 z = {0.f, 0.f, 0.f, 0.f};
            va[i] = ok ? *(const f32x4*)(src + (size_t)(2 * kp) * sg.ld) : z; vb[i] = ok ? *(const f32x4*)(src + (size_t)(2 * kp + 1) * sg.ld) : z; }
#pragma unroll
        for (int i = 0; i < 8; ++i) { const int kp = 4 * i + r4;
#pragma unroll
            for (int j = 0; j < 4; ++j) my[(4 * c4 + j) * 33 + kp] = cvt_pk_bf16(va[i][j], vb[i][j]); }
        asm volatile("s_waitcnt lgkmcnt(0)" ::: "memory");
        bf16_t* dst = sg.dst + (size_t)b * sg.dstride;
#pragma unroll
        for (int i = 0; i < 8; ++i) {
            const int nl = (lane >> 3) + 8 * i, c = lane & 7, n = nt * 64 + nl;
            u32x4 w; w.x = my[nl * 33 + 4 * c]; w.y = my[nl * 33 + 4 * c + 1]; w.z = my[nl * 33 + 4 * c + 2]; w.w = my[nl * 33 + 4 * c + 3];
            const int row = (n / sg.G) * sg.GS + (n % sg.G) + sg.off;
            *(u32x4*)(dst + (size_t)row * sg.K + kt * 64 + 8 * c) = w;
        }
        asm volatile("s_waitcnt lgkmcnt(0)" ::: "memory");
    }
}
__device__ __forceinline__ void cvt_seg(const CvtSeg sg, FX_LAS unsigned* my, int gwave, int nwaves, int& rot) {
    const int total = (sg.K / 64) * sg.ntn * sg.nbatch;
    int first = (gwave - rot) % nwaves; if (first < 0) first += nwaves;
    for (int tile = first; tile < total; tile += nwaves) cvt_tile(sg, my, tile);
    rot = (rot + total) % nwaves;
}
__device__ __forceinline__ void cvt_tile8(const CvtSeg sg, FX_LAS unsigned* my, int tile, float scale) {
    const int lane = fx_lane();
    const int ktn = sg.K / 64, per = ktn * sg.ntn;
    {
        const int b = tile / per, r = tile - b * per, nt = r / ktn, kt = r - nt * ktn;
        const int r4 = lane >> 4, c4 = lane & 15;
        const float* src = sg.src + (size_t)b * sg.sstride + (size_t)(kt * 64) * sg.ld + nt * 64 + 4 * c4;
        const bool ok = nt * 64 + 4 * c4 < sg.nsrc;
        f32x4 v[4][4];
#pragma unroll
        for (int i = 0; i < 4; ++i)
#pragma unroll
            for (int q = 0; q < 4; ++q) { const int kq = 4 * i + r4; const f32x4 z = {0.f, 0.f, 0.f, 0.f}; v[i][q] = ok ? *(const f32x4*)(src + (size_t)(4 * kq + q) * sg.ld) : z; }
#pragma unroll
        for (int i = 0; i < 4; ++i) { const int kq = 4 * i + r4;
#pragma unroll
            for (int j = 0; j < 4; ++j) my[(4 * c4 + j) * 17 + kq] = cvt_pk4_fp8(v[i][0][j] * scale, v[i][1][j] * scale, v[i][2][j] * scale, v[i][3][j] * scale); }
        asm volatile("s_waitcnt lgkmcnt(0)" ::: "memory");
        unsigned char* dst = (unsigned char*)sg.dst + (size_t)b * sg.dstride;
#pragma unroll
        for (int i = 0; i < 4; ++i) {
            const int nl = (lane >> 2) + 16 * i, c = lane & 3, n = nt * 64 + nl;
            u32x4 w; w.x = my[nl * 17 + 4 * c]; w.y = my[nl * 17 + 4 * c + 1]; w.z = my[nl * 17 + 4 * c + 2]; w.w = my[nl * 17 + 4 * c + 3];
            const int row = (n / sg.G) * sg.GS + (n % sg.G) + sg.off;
            *(u32x4*)(dst + (size_t)row * sg.K + kt * 64 + 16 * c) = w;
        }
        asm volatile("s_waitcnt lgkmcnt(0)" ::: "memory");
    }
}
__device__ __forceinline__ void cvt_seg8(const CvtSeg sg, FX_LAS unsigned* my, int gwave, int nwaves, int& rot, float scale) {
    const int total = (sg.K / 64) * sg.ntn * sg.nbatch;
    int first = (gwave - rot) % nwaves; if (first < 0) first += nwaves;
    for (int tile = first; tile < total; tile += nwaves) cvt_tile8(sg, my, tile, scale);
    rot = (rot + total) % nwaves;
}

constexpr int BM = 256, BK = 64, HALF = 128, HTB = HALF * BK * 2, STAGE_BYTES = 8 * HTB, NXCD = 8, WGM = FX_WGM;
__host__ __device__ __forceinline__ int lds_byte(int r, int c) { const int st = (r >> 4) * 2 + (c >> 5), rr = r & 15, cc = c & 31, ob = rr * 64 + cc * 2; return st * 1024 + (ob ^ (((ob >> 9) & 1) << 5)); }
__host__ __device__ __forceinline__ void stage_rc(int b, int& R, int& C) { const int st = b / 1024, sb = b % 1024, swz = sb ^ (((sb >> 9) & 1) << 5); R = (st >> 1) * 16 + swz / 64; C = (st & 1) * 32 + (swz % 64) / 2; }
__host__ __device__ __forceinline__ int perm32(int rho) { const int n = rho >> 4, i = rho & 15; return 8 * (i >> 2) + 4 * n + (i & 3); }
struct Unit { int pm, pn, e; };
struct DenseSched {
    static constexpr bool GATHER = false;
    int nM, nN, nwg, G, c; int lda_b; const char* Bt; int K; int esz;
    __device__ void init(int M, int N, int G_, int c_, int lda_bytes, const void* Bt_, int K_, int esz_ = 2) { nM = M / BM; nN = N / BM; nwg = nM * nN; G = G_; c = c_; lda_b = lda_bytes; Bt = (const char*)Bt_; K = K_; esz = esz_; }
    __device__ __forceinline__ bool next(int i, Unit& u) const {
        const long L = (long)i * G + c; if (L >= nwg) return false;
        int wgid = (int)L; { const int q = nwg / NXCD, r = nwg % NXCD, xcd = wgid % NXCD, off = wgid / NXCD; wgid = (xcd < r ? xcd * (q + 1) : r * (q + 1) + (xcd - r) * q) + off; }
        const int nig = WGM * nN, gid = wgid / nig, fm = gid * WGM, gsz = (nM - fm) < WGM ? (nM - fm) : WGM;
        u.pm = fm + ((wgid % nig) % gsz); u.pn = (wgid % nig) / gsz; u.e = 0; return true;
    }
    __device__ __forceinline__ unsigned a_row_off(const Unit& u, int R) const { return (unsigned)(u.pm * BM + R) * (unsigned)lda_b; }
    __device__ __forceinline__ size_t a_unit_base(const Unit& u) const { return (size_t)u.pm * BM * (size_t)lda_b; }
    __device__ __forceinline__ unsigned a_lane_off(int R) const { return (unsigned)R * (unsigned)lda_b; }
    __device__ __forceinline__ const char* b_ptr(const Unit& u) const { return Bt + (size_t)u.pn * BM * K * esz; }
};

template <class Epi, class Sched, bool FP8 = false>
__device__ __forceinline__ void gemm_phase(FX_LAS unsigned char* lds, const char* Abase, const int Kc, const Sched& S, const Epi& E, int tidp, const int noepi = 0) {
    int K_ = Kc; asm volatile("" : "+s"(K_)); const int K = K_;
    int tid_ = tidp; asm volatile("" : "+v"(tid_));
    const int tid = tid_, wid = __builtin_amdgcn_readfirstlane(tid >> 6), lane = tid & 63, wr = wid >> 2, wc = wid & 3, fr = lane & 15, fq = lane >> 4;
    constexpr int ES = FP8 ? 1 : 2;
    const int nt = K * ES / 128;
    int Rr[2], Cc[2]; unsigned voffB[2];
#pragma unroll
    for (int i = 0; i < 2; ++i) { int R, C; stage_rc(tid * 16 + i * 8192, R, C); Rr[i] = R; Cc[i] = C; const int Rb = (Epi::PERM && !(FP8 && FX_F8_32)) ? ((R & ~31) + perm32(R & 31)) : R; voffB[i] = (unsigned)(Rb * K * ES + C * 2); }
    const size_t hstepB = (size_t)HALF * K * ES;
    const unsigned ldsw = (unsigned)wid * 1024u;
    constexpr bool F32M = FP8 && FX_F8_32;
    const int aoff = F32M ? lds_byte(wr * 64 + (lane & 31), 16 * (lane >> 5)) : lds_byte(wr * 64 + fr, fq * 8), boff = F32M ? lds_byte(wc * 32 + (lane & 31), 16 * (lane >> 5)) : lds_byte(wc * 32 + fr, fq * 8);
#define FX_SA(b, h) (((b) * 2 + (h)) * HTB)
#define FX_SB(b, h) ((4 + (b) * 2 + (h)) * HTB)
#define FX_STAGE_A(bufoff, o0, o1, kb) do { const char* ap_ = Abase + (kb); \
        __builtin_amdgcn_global_load_lds((const unsigned*)(ap_ + (o0)), (FX_LAS unsigned*)(lds + (bufoff) + ldsw), 16, 0, 0); \
        __builtin_amdgcn_global_load_lds((const unsigned*)(ap_ + (o1)), (FX_LAS unsigned*)(lds + (bufoff) + ldsw + 8192), 16, 0, 0); } while (0)
#define FX_STAGE_B(bufoff, gbase) do { _Pragma("unroll") for (int _i = 0; _i < 2; ++_i) \
        __builtin_amdgcn_global_load_lds((const unsigned*)((const char*)(gbase) + voffB[_i]), (FX_LAS unsigned*)(lds + (bufoff) + ldsw + _i * 8192), 16, 0, 0); } while (0)
#define FX_LDA(dst, b, h) do { if constexpr (F32M) { _Pragma("unroll") for (int q = 0; q < 4; ++q) { dst[q][0] = *(const FX_LAS bf16x8*)(lds + FX_SA(b, h) + aoff + (q >> 1) * 4096 + (q & 1) * 1024); dst[q][1] = *(const FX_LAS bf16x8*)(lds + FX_SA(b, h) + aoff + (q >> 1) * 4096 + (q & 1) * 1024 + 16); } } \
        else { _Pragma("unroll") for (int m = 0; m < 4; ++m) _Pragma("unroll") for (int k = 0; k < 2; ++k) dst[m][k] = *(const FX_LAS bf16x8*)(lds + FX_SA(b, h) + aoff + m * 2048 + k * 1024); } } while (0)
#define FX_LDB(dst, b, h) do { if constexpr (F32M) { _Pragma("unroll") for (int q = 0; q < 2; ++q) { dst[q][0] = *(const FX_LAS bf16x8*)(lds + FX_SB(b, h) + boff + q * 1024); dst[q][1] = *(const FX_LAS bf16x8*)(lds + FX_SB(b, h) + boff + q * 1024 + 16); } } \
        else { _Pragma("unroll") for (int n = 0; n < 2; ++n) _Pragma("unroll") for (int k = 0; k < 2; ++k) dst[n][k] = *(const FX_LAS bf16x8*)(lds + FX_SB(b, h) + boff + n * 2048 + k * 1024); } } while (0)
#define FX_MMA(ai, bj, At, Bt) do { if (!FP8 || FX_PRIO8) __builtin_amdgcn_s_setprio(1); \
        if constexpr (F32M) { _Pragma("unroll") for (int mb = 0; mb < 2; ++mb) _Pragma("unroll") for (int s = 0; s < 2; ++s) { \
            const i32x4 a0_ = __builtin_bit_cast(i32x4, At[mb * 2 + s][0]), a1_ = __builtin_bit_cast(i32x4, At[mb * 2 + s][1]), b0_ = __builtin_bit_cast(i32x4, Bt[s][0]), b1_ = __builtin_bit_cast(i32x4, Bt[s][1]); \
            const i32x8 af_ = __builtin_shufflevector(a0_, a1_, 0, 1, 2, 3, 4, 5, 6, 7), bf_ = __builtin_shufflevector(b0_, b1_, 0, 1, 2, 3, 4, 5, 6, 7); \
            asm volatile("v_mfma_scale_f32_32x32x64_f8f6f4 %0, %1, %2, %0, %3, %3 op_sel_hi:[0,0,0]" : "+v"(acc3[ai][bj][mb]) : "v"(bf_), "v"(af_), "v"(sc1_)); } } else \
        _Pragma("unroll") for (int m = 0; m < 4; ++m) _Pragma("unroll") for (int n = 0; n < 2; ++n) { \
        if constexpr (FP8) { const i32x4 a0_ = __builtin_bit_cast(i32x4, At[m][0]), a1_ = __builtin_bit_cast(i32x4, At[m][1]), b0_ = __builtin_bit_cast(i32x4, Bt[n][0]), b1_ = __builtin_bit_cast(i32x4, Bt[n][1]); \
            const i32x8 af_ = __builtin_shufflevector(a0_, a1_, 0, 1, 2, 3, 4, 5, 6, 7), bf_ = __builtin_shufflevector(b0_, b1_, 0, 1, 2, 3, 4, 5, 6, 7); \
            asm volatile("v_mfma_scale_f32_16x16x128_f8f6f4 %0, %1, %2, %0, %3, %3 op_sel_hi:[0,0,0]" : "+v"(acc[ai][bj][m][n]) : "v"(bf_), "v"(af_), "v"(sc1_)); FX_MFMA_DUP(acc[ai][bj][m][n]) } \
        else { _Pragma("unroll") for (int k = 0; k < 2; ++k) acc[ai][bj][m][n] = __builtin_amdgcn_mfma_f32_16x16x32_bf16(Bt[n][k], At[m][k], acc[ai][bj][m][n], 0, 0, 0); } } \
        if (!FP8 || FX_PRIO8) __builtin_amdgcn_s_setprio(0); } while (0)
#define FX_WAIT_V(n) asm volatile("s_waitcnt vmcnt(" #n ")" ::: "memory")
#define FX_WAIT_L(n) asm volatile("s_waitcnt lgkmcnt(" #n ")" ::: "memory")
#define FX_BAR __builtin_amdgcn_s_barrier()
#define FX_SCHED __builtin_amdgcn_sched_barrier(0)
#ifdef FX_PROBE_MFMA
#define FX_MFMA_DUP(ACC) asm volatile("v_mfma_scale_f32_16x16x128_f8f6f4 %0, %1, %2, %0, %3, %3 op_sel_hi:[0,0,0]" : "+v"(ACC) : "v"(bf_), "v"(af_), "v"(sc0_));
#else
#define FX_MFMA_DUP(ACC)
#endif
    const int sc0_ = 0; (void)sc0_;
    const int sc1_ = 0x7f7f7f7f;
    (void)sc1_;
    Unit cur, nxt; int ui = 0;
    if (!S.next(0, cur)) return;
    f32x4 acc[2][2][4][2];
#pragma unroll
    for (int a = 0; a < 2; ++a)
#pragma unroll
        for (int b = 0; b < 2; ++b)
#pragma unroll
            for (int m = 0; m < 4; ++m)
#pragma unroll
                for (int n = 0; n < 2; ++n) acc[a][b][m][n] = (f32x4){0.f, 0.f, 0.f, 0.f};
    f32x16 acc3[2][2][2];
#pragma unroll
    for (int q = 0; q < 8; ++q) acc3[q >> 2][(q >> 1) & 1][q & 1] = f32x16{};
    bf16x8 At[4][2], B0[2][2], B1[2][2];
    unsigned c00, c01, c10, c11, n00 = 0, n01 = 0, n10 = 0, n11 = 0;
    size_t ubc = 0, ubn = 0;
    if constexpr (Sched::GATHER) { c00 = S.a_row_off(cur, Rr[0]) + Cc[0] * 2; c01 = S.a_row_off(cur, Rr[1]) + Cc[1] * 2; c10 = S.a_row_off(cur, HALF + Rr[0]) + Cc[0] * 2; c11 = S.a_row_off(cur, HALF + Rr[1]) + Cc[1] * 2; }
    else { c00 = S.a_lane_off(Rr[0]) + Cc[0] * 2; c01 = S.a_lane_off(Rr[1]) + Cc[1] * 2; c10 = c00 + S.a_lane_off(HALF); c11 = c01 + S.a_lane_off(HALF); ubc = S.a_unit_base(cur); n00 = c00; n01 = c01; n10 = c10; n11 = c11; }
    const char* cB = S.b_ptr(cur);
    const unsigned kstep = BK * 2;
    FX_STAGE_B(FX_SB(0, 0), cB); FX_STAGE_A(FX_SA(0, 0), c00, c01, ubc); FX_STAGE_B(FX_SB(0, 1), cB + hstepB); FX_STAGE_A(FX_SA(0, 1), c10, c11, ubc);
    if (wr == 1) FX_BAR;
    FX_WAIT_V(4); FX_BAR;
    FX_STAGE_B(FX_SB(1, 0), cB + kstep); FX_STAGE_A(FX_SA(1, 0), c00, c01, ubc + kstep); FX_STAGE_B(FX_SB(1, 1), cB + hstepB + kstep);
    FX_WAIT_V(6); FX_BAR;
    for (;;) {
        const bool has_next = S.next(ui + 1, nxt);
        if (!has_next) nxt = cur;
        if constexpr (!Sched::GATHER) ubn = S.a_unit_base(nxt);
        const char* nB = S.b_ptr(nxt);
        for (int t = 0; t < nt; t += 2) {
            const bool last = (t == nt - 2);
            asm volatile("" : "+v"(c00), "+v"(c01), "+v"(c10), "+v"(c11), "+v"(voffB[0]), "+v"(voffB[1]));
            if constexpr (Sched::GATHER) { if (last) {
                int t2_ = tid; asm volatile("" : "+v"(t2_)); int R0_, C0_, R1_, C1_; stage_rc(t2_ * 16, R0_, C0_); stage_rc(t2_ * 16 + 8192, R1_, C1_);
                n00 = S.a_row_off(nxt, R0_) + C0_ * 2; n01 = S.a_row_off(nxt, R1_) + C1_ * 2; n10 = S.a_row_off(nxt, HALF + R0_) + C0_ * 2; n11 = S.a_row_off(nxt, HALF + R1_) + C1_ * 2; } }
            const size_t k1 = ubc + (size_t)(t + 1) * kstep;
            const size_t k2 = last ? ubn : ubc + (size_t)(t + 2) * kstep, k3 = k2 + kstep;
            unsigned a00, a01, a10, a11;
            if constexpr (Sched::GATHER) { a00 = last ? n00 : c00; a01 = last ? n01 : c01; a10 = last ? n10 : c10; a11 = last ? n11 : c11; } else { a00 = c00; a01 = c01; a10 = c10; a11 = c11; }
            const char* b2 = last ? nB : cB + (size_t)(t + 2) * kstep; const char* b3 = b2 + kstep;
            FX_LDB(B0, 0, 0); FX_SCHED; FX_LDA(At, 0, 0); FX_STAGE_A(FX_SA(1, 1), c10, c11, k1);
            FX_WAIT_L(8); FX_BAR; FX_WAIT_L(0); FX_MMA(0, 0, At, B0); FX_BAR; FX_SCHED;
            FX_LDB(B1, 0, 1); FX_STAGE_B(FX_SB(0, 0), b2);
            FX_BAR; FX_WAIT_L(0); FX_MMA(0, 1, At, B1); FX_BAR;
            FX_LDA(At, 0, 1); FX_STAGE_A(FX_SA(0, 0), a00, a01, k2);
            FX_BAR; FX_WAIT_L(0); FX_MMA(1, 0, At, B0); FX_BAR; FX_SCHED;
            FX_STAGE_B(FX_SB(0, 1), b2 + hstepB);
            FX_WAIT_V(6); FX_BAR; FX_MMA(1, 1, At, B1); FX_BAR;
            FX_LDB(B0, 1, 0); FX_SCHED; FX_LDA(At, 1, 0); FX_STAGE_A(FX_SA(0, 1), a10, a11, k2);
            FX_WAIT_L(8); FX_BAR; FX_WAIT_L(0); FX_MMA(0, 0, At, B0); FX_BAR; FX_SCHED;
            FX_LDB(B1, 1, 1); FX_STAGE_B(FX_SB(1, 0), b3);
            FX_BAR; FX_WAIT_L(0); FX_MMA(0, 1, At, B1); FX_BAR;
            FX_LDA(At, 1, 1); FX_STAGE_A(FX_SA(1, 0), a00, a01, k3);
            FX_BAR; FX_WAIT_L(0); FX_MMA(1, 0, At, B0); FX_BAR; FX_SCHED;
            FX_STAGE_B(FX_SB(1, 1), b3 + hstepB);
            FX_WAIT_V(6); FX_BAR; FX_MMA(1, 1, At, B1); FX_BAR;
        }
        if constexpr (FP8) asm volatile("s_nop 15\n\ts_nop 15\n\ts_nop 15\n\ts_nop 15" ::: "memory");
        if constexpr (F32M) { int ln_e = lane; asm volatile("" : "+v"(ln_e)); E.e32(acc3, cur, wr, wc, ln_e); }
        else if (noepi) { f32x4 s_ = (f32x4){0.f, 0.f, 0.f, 0.f};
#pragma unroll
            for (int q_ = 0; q_ < 32; ++q_) s_ += acc[q_ >> 4][(q_ >> 3) & 1][(q_ >> 1) & 3][q_ & 1];
            if (s_[0] + s_[1] + s_[2] + s_[3] == 1.2345e-30f) *(float*)const_cast<char*>(Abase) = s_[0]; }
        else { int fr_e = fr, fq_e = fq; asm volatile("" : "+v"(fr_e), "+v"(fq_e)); E(acc, cur, wr, wc, fr_e, fq_e); }
        if (!has_next) break;
        if constexpr (F32M) { _Pragma("unroll") for (int q = 0; q < 8; ++q) acc3[q >> 2][(q >> 1) & 1][q & 1] = f32x16{}; }
#pragma unroll
        for (int a = 0; a < 2; ++a)
#pragma unroll
            for (int b = 0; b < 2; ++b)
#pragma unroll
                for (int m = 0; m < 4; ++m)
#pragma unroll
                    for (int n = 0; n < 2; ++n) acc[a][b][m][n] = (f32x4){0.f, 0.f, 0.f, 0.f};
        cur = nxt; cB = nB; if constexpr (Sched::GATHER) { c00 = n00; c01 = n01; c10 = n10; c11 = n11; } else ubc = ubn; ++ui;
    }
    FX_WAIT_V(0);
    if (wr == 0) FX_BAR;
    FX_BAR;
}

struct EpiBf16 {
    static constexpr bool PERM = true;
    bf16_t* O; float* gates; int ldc; float scale;
    __device__ __forceinline__ void operator()(const f32x4 (&acc)[2][2][4][2], const Unit& u, int wr, int wc, int fr, int fq) const {
        const int row0 = u.pm * BM + wr * 64 + fr, col0 = u.pn * BM + wc * 32 + 8 * fq;
#pragma unroll
        for (int ai = 0; ai < 2; ++ai)
#pragma unroll
            for (int m = 0; m < 4; ++m) { const int row = row0 + ai * HALF + m * 16; bf16_t* rowp = O + (size_t)row * ldc + col0;
#pragma unroll
                for (int bj = 0; bj < 2; ++bj) { const f32x4 v0 = acc[ai][bj][m][0] * scale, v1 = acc[ai][bj][m][1] * scale;
                    u32x4 w; w.x = cvt_pk_bf16(v0[0], v0[1]); w.y = cvt_pk_bf16(v0[2], v0[3]); w.z = cvt_pk_bf16(v1[0], v1[1]); w.w = cvt_pk_bf16(v1[2], v1[3]);
                    *(u32x4*)(rowp + bj * HALF) = w; }
                if (gates && u.pn == 15 && wc == 2 && fq < 2) { float* g = gates + (size_t)row * 16 + 8 * fq; *(f32x4*)g = acc[ai][1][m][0] * scale; *(f32x4*)(g + 4) = acc[ai][1][m][1] * scale; } }
    }
    __device__ __forceinline__ void e32(const f32x16 (&acc3)[2][2][2], const Unit& u, int wr, int wc, int lane) const {
        const int j = lane & 31, hi = lane >> 5;
#pragma unroll
        for (int ai = 0; ai < 2; ++ai)
#pragma unroll
            for (int mb = 0; mb < 2; ++mb) { const int row = u.pm * BM + ai * HALF + wr * 64 + mb * 32 + j;
#pragma unroll
                for (int bj = 0; bj < 2; ++bj) { bf16_t* rowp = O + (size_t)row * ldc + u.pn * BM + bj * HALF + wc * 32 + 4 * hi;
#pragma unroll
                    for (int g = 0; g < 4; ++g) { u32x2 w; w.x = cvt_pk_bf16(acc3[ai][bj][mb][4 * g] * scale, acc3[ai][bj][mb][4 * g + 1] * scale); w.y = cvt_pk_bf16(acc3[ai][bj][mb][4 * g + 2] * scale, acc3[ai][bj][mb][4 * g + 3] * scale);
                        *(u32x2*)(rowp + 8 * g) = w; } }
                if (gates && u.pn == 15 && wc == 2) { float* gp = gates + (size_t)row * 16 + 4 * hi;
#pragma unroll
                    for (int g = 0; g < 2; ++g) *(f32x4*)(gp + 8 * g) = (f32x4){acc3[ai][1][mb][4 * g] * scale, acc3[ai][1][mb][4 * g + 1] * scale, acc3[ai][1][mb][4 * g + 2] * scale, acc3[ai][1][mb][4 * g + 3] * scale}; } }
    }
};
}
#ifndef FX_RUNR
#define FX_RUNR 16
#endif
namespace fx {
constexpr int RT = 16;
constexpr int H2S_LD = 2052;
constexpr int P7_LDS = RT * H2S_LD * 4 + 512;
constexpr int PTOT = 131072;
constexpr int NTILE_MAX = PTOT / 256;

__device__ __forceinline__ void coef_phase(const float* mod, const float* pre_mix_gain, const float* post_mix_gain, const float* pre_ffn_gain, const float* post_ffn_gain, float* coef, int gtid, int nthr) {
    for (int i = gtid; i < 2 * 4 * 2048; i += nthr) { const int d = i & 2047, b = (i >> 11) & 3, l = i >> 13;
        const float* m = mod + ((size_t)l * 4 + b) * 12288; float* c = coef + ((size_t)l * 4 + b) * 6 * 2048;
        c[0 * 2048 + d] = m[2 * 2048 + d] * post_mix_gain[l * 2048 + d];
        c[1 * 2048 + d] = pre_ffn_gain[l * 2048 + d] * (1.f + m[4 * 2048 + d]);
        c[2 * 2048 + d] = m[3 * 2048 + d];
        c[3 * 2048 + d] = m[5 * 2048 + d] * post_ffn_gain[l * 2048 + d];
        c[4 * 2048 + d] = pre_mix_gain[l * 2048 + d] * (1.f + m[1 * 2048 + d]);
        c[5 * 2048 + d] = m[0 * 2048 + d]; }
}

template <bool XBF>
__device__ __forceinline__ void p7_phase(FX_LAS unsigned char* lds, const void* xin_, const bf16_t* Y, const float* coef_l  , const float* router_w, const float* router_bias,
                                         bf16_t* XRES, unsigned char* HA8, int* SELE, float* SELG, int* CNT, int* WGBASE, int wg, int nwg, int tidp) {
    int tid_ = tidp; asm volatile("" : "+v"(tid_));
    const int tid = tid_, wid = tid >> 6, lane = tid & 63;
    FX_LAS float* h2s = (FX_LAS float*)lds;
    FX_LAS int* hist = (FX_LAS int*)(lds + RT * H2S_LD * 4);
    if (tid < 64) hist[tid] = 0;
    __syncthreads();
#define FX_GC(TY, p) ((const __attribute__((address_space(1))) TY*)(p))
#define FX_GM(TY, p) ((__attribute__((address_space(1))) TY*)(p))
    const int i16 = lane & 15, g4 = lane >> 4;
    for (int unit = wg; unit < T / RT; unit += nwg) {
        {
            const int tok0 = 2 * wid, t0 = unit * RT + tok0, b = t0 / S;
            const float* cf = coef_l + (size_t)b * 6 * 2048;
            u32x4 yw[2][4]; f32x4 ca[8];
            float xv[2][32];
#pragma unroll
            for (int tt = 0; tt < 2; ++tt)
#pragma unroll
                for (int i = 0; i < 4; ++i) yw[tt][i] = *FX_GC(u32x4, Y + (size_t)(t0 + tt) * 2048 + i * 512 + lane * 8);
            if constexpr (XBF) {
                u32x4 xw[2][4];
#pragma unroll
                for (int tt = 0; tt < 2; ++tt)
#pragma unroll
                    for (int i = 0; i < 4; ++i) xw[tt][i] = *FX_GC(u32x4, (const bf16_t*)xin_ + (size_t)(t0 + tt) * 2048 + i * 512 + lane * 8);
#pragma unroll
                for (int i = 0; i < 4; ++i) { ca[2 * i] = *FX_GC(f32x4, cf + i * 512 + lane * 8); ca[2 * i + 1] = *FX_GC(f32x4, cf + i * 512 + lane * 8 + 4); }
#pragma unroll
                for (int tt = 0; tt < 2; ++tt)
#pragma unroll
                    for (int i = 0; i < 4; ++i) { const u32x4 w = xw[tt][i];
                        xv[tt][i * 8 + 0] = bflo(w.x); xv[tt][i * 8 + 1] = bfhi(w.x); xv[tt][i * 8 + 2] = bflo(w.y); xv[tt][i * 8 + 3] = bfhi(w.y); xv[tt][i * 8 + 4] = bflo(w.z); xv[tt][i * 8 + 5] = bfhi(w.z); xv[tt][i * 8 + 6] = bflo(w.w); xv[tt][i * 8 + 7] = bfhi(w.w); }
            } else {
                const float* xin = (const float*)xin_;
#pragma unroll
                for (int tt = 0; tt < 2; ++tt)
#pragma unroll
                    for (int i = 0; i < 4; ++i) { const f32x4 x0 = *FX_GC(f32x4, xin + (size_t)(t0 + tt) * 2048 + i * 512 + lane * 8), x1 = *FX_GC(f32x4, xin + (size_t)(t0 + tt) * 2048 + i * 512 + lane * 8 + 4);
                        xv[tt][i * 8 + 0] = x0[0]; xv[tt][i * 8 + 1] = x0[1]; xv[tt][i * 8 + 2] = x0[2]; xv[tt][i * 8 + 3] = x0[3]; xv[tt][i * 8 + 4] = x1[0]; xv[tt][i * 8 + 5] = x1[1]; xv[tt][i * 8 + 6] = x1[2]; xv[tt][i * 8 + 7] = x1[3]; }
#pragma unroll
                for (int i = 0; i < 4; ++i) { ca[2 * i] = *FX_GC(f32x4, cf + i * 512 + lane * 8); ca[2 * i + 1] = *FX_GC(f32x4, cf + i * 512 + lane * 8 + 4); }
            }
            float ssy0 = 0.f, ssy1 = 0.f;
#pragma unroll
            for (int i = 0; i < 4; ++i) { const u32x4 w0 = yw[0][i], w1 = yw[1][i];
#pragma unroll
                for (int q = 0; q < 4; ++q) { const float l0 = bflo(w0[q]), h0 = bfhi(w0[q]), l1 = bflo(w1[q]), h1 = bfhi(w1[q]); ssy0 += l0 * l0 + h0 * h0; ssy1 += l1 * l1 + h1 * h1; } }
#pragma unroll
            for (int o = 32; o >= 1; o >>= 1) { ssy0 += __shfl_xor(ssy0, o); ssy1 += __shfl_xor(ssy1, o); }
            const float ry0 = rsqrtf(ssy0 * (1.f / 2048.f) + EPS), ry1 = rsqrtf(ssy1 * (1.f / 2048.f) + EPS);
            float ssx0 = 0.f, ssx1 = 0.f;
#pragma unroll
            for (int i = 0; i < 4; ++i) { const u32x4 w0 = yw[0][i], w1 = yw[1][i];
#pragma unroll
                for (int j = 0; j < 8; ++j) { const float a = ca[2 * i + (j >> 2)][j & 3];
                    const float y0 = (j & 1) ? bfhi(w0[j >> 1]) : bflo(w0[j >> 1]), y1 = (j & 1) ? bfhi(w1[j >> 1]) : bflo(w1[j >> 1]);
                    xv[0][i * 8 + j] += a * (y0 * ry0); xv[1][i * 8 + j] += a * (y1 * ry1);
                    ssx0 += xv[0][i * 8 + j] * xv[0][i * 8 + j]; ssx1 += xv[1][i * 8 + j] * xv[1][i * 8 + j]; } }
            f32x4 cb[8], cc[8];
#pragma unroll
            for (int i = 0; i < 4; ++i) { cb[2 * i] = *FX_GC(f32x4, cf + 2048 + i * 512 + lane * 8); cb[2 * i + 1] = *FX_GC(f32x4, cf + 2048 + i * 512 + lane * 8 + 4);
                cc[2 * i] = *FX_GC(f32x4, cf + 4096 + i * 512 + lane * 8); cc[2 * i + 1] = *FX_GC(f32x4, cf + 4096 + i * 512 + lane * 8 + 4); }
#pragma unroll
            for (int tt = 0; tt < 2; ++tt)
#pragma unroll
                for (int i = 0; i < 4; ++i) { u32x4 xo; xo.x = cvt_pk_bf16(xv[tt][i * 8 + 0], xv[tt][i * 8 + 1]); xo.y = cvt_pk_bf16(xv[tt][i * 8 + 2], xv[tt][i * 8 + 3]); xo.z = cvt_pk_bf16(xv[tt][i * 8 + 4], xv[tt][i * 8 + 5]); xo.w = cvt_pk_bf16(xv[tt][i * 8 + 6], xv[tt][i * 8 + 7]);
                    *FX_GM(u32x4, XRES + (size_t)(t0 + tt) * 2048 + i * 512 + lane * 8) = xo; }
#pragma unroll
            for (int o = 32; o >= 1; o >>= 1) { ssx0 += __shfl_xor(ssx0, o); ssx1 += __shfl_xor(ssx1, o); }
            const float rx0 = rsqrtf(ssx0 * (1.f / 2048.f) + EPS), rx1 = rsqrtf(ssx1 * (1.f / 2048.f) + EPS);
#pragma unroll
            for (int tt = 0; tt < 2; ++tt) { const float rx = tt ? rx1 : rx0;
#pragma unroll
                for (int i = 0; i < 4; ++i) { const int c = i * 512 + lane * 8;
                    float hv[8];
#pragma unroll
                    for (int j = 0; j < 8; ++j) hv[j] = xv[tt][i * 8 + j] * rx * cb[2 * i + (j >> 2)][j & 3] + cc[2 * i + (j >> 2)][j & 3];
                    u32x2 w; w.x = cvt_pk4_fp8(hv[0], hv[1], hv[2], hv[3]); w.y = cvt_pk4_fp8(hv[4], hv[5], hv[6], hv[7]);
                    *FX_GM(u32x2, HA8 + (size_t)(t0 + tt) * 2048 + c) = w;
                    *(FX_LAS f32x4*)(h2s + (tok0 + tt) * H2S_LD + c) = (f32x4){hv[0], hv[1], hv[2], hv[3]};
                    *(FX_LAS f32x4*)(h2s + (tok0 + tt) * H2S_LD + c + 4) = (f32x4){hv[4], hv[5], hv[6], hv[7]}; } }
        }
        f32x4 acc[4];
#pragma unroll
        for (int j = 0; j < 4; ++j) acc[j] = (f32x4){0.f, 0.f, 0.f, 0.f};
        {
            const char* rwb = (const char*)router_w + (size_t)__builtin_amdgcn_readfirstlane(wid) * (256 * 64 * 4);
            const unsigned loff = (unsigned)(g4 * 64 + 4 * i16) * 4u;
            f32x4 bwA[8], bwB[8];
            { unsigned o_ = loff; asm volatile("" : "+v"(o_));
#pragma unroll
              for (int q = 0; q < 8; ++q) bwA[q] = *FX_GC(f32x4, rwb + o_ + q * 1024); }
            __syncthreads();
#pragma unroll
            for (int kb = 0; kb < 8; ++kb) {
                if (kb < 7) { unsigned o_ = loff + (kb + 1) * 8192; asm volatile("" : "+v"(o_));
#pragma unroll
                    for (int q = 0; q < 8; ++q) { const f32x4 v = *FX_GC(f32x4, rwb + o_ + q * 1024); if (kb & 1) bwA[q] = v; else bwB[q] = v; } }
#pragma unroll
                for (int q = 0; q < 8; ++q) { const int k = 256 * wid + 4 * (kb * 8 + q) + g4;
                    const float a = h2s[i16 * H2S_LD + k]; const f32x4 bw = (kb & 1) ? bwB[q] : bwA[q];
                    acc[0] = __builtin_amdgcn_mfma_f32_16x16x4f32(a, bw[0], acc[0], 0, 0, 0);
                    acc[1] = __builtin_amdgcn_mfma_f32_16x16x4f32(a, bw[1], acc[1], 0, 0, 0);
                    acc[2] = __builtin_amdgcn_mfma_f32_16x16x4f32(a, bw[2], acc[2], 0, 0, 0);
                    acc[3] = __builtin_amdgcn_mfma_f32_16x16x4f32(a, bw[3], acc[3], 0, 0, 0); } }
        }
        __syncthreads();
        { FX_LAS float* part = h2s; const int i16 = lane & 15, g = lane >> 4;
#pragma unroll
          for (int j = 0; j < 4; ++j)
#pragma unroll
            for (int r = 0; r < 4; ++r) part[(wid * 16 + 4 * g + r) * 64 + 4 * i16 + j] = acc[j][r]; }
        __syncthreads();
#pragma unroll 1
        for (int tt = 0; tt < 2; ++tt) {
            const int tok = 2 * wid + tt, t = unit * RT + tok;
            float lg = 0.f;
#pragma unroll
            for (int w = 0; w < 8; ++w) lg += h2s[(w * 16 + tok) * 64 + lane];
            const float score = 1.f / (1.f + expf(-lg));
            float v = score + router_bias[lane];
            int my_e = 0; float my_s = 0.f, sum = 0.f;
#pragma unroll
            for (int k = 0; k < 6; ++k) {
                const float m = wave_max(v);
                const unsigned long long bal = __ballot(v == m);
                const int win = __ffsll((long long)bal) - 1;
                const float sw = __shfl(score, win);
                sum += sw; if (lane == k) { my_e = win; my_s = sw; }
                if (lane == win) v = -3.0e38f;
            }
            if (lane < 6) { SELE[(size_t)t * 6 + lane] = my_e; SELG[(size_t)t * 6 + lane] = my_s / sum * 2.5f; __hip_atomic_fetch_add(hist + my_e, 1, __ATOMIC_RELAXED, __HIP_MEMORY_SCOPE_WORKGROUP); }
        }
        __syncthreads();
    }
    if (tid < 64) { const int hv = hist[tid]; const int base = atomicAdd(CNT + tid, hv); WGBASE[wg * 64 + tid] = base; }
}

__device__ __forceinline__ void p8_phase(FX_LAS unsigned char* lds, const int* SELE, const float* SELG, const int* CNT, const int* WGBASE, int* ROWTOK, float* ROWG, int* SLOT, int wg, int nwg, int tidp) {
    int tid_ = tidp; asm volatile("" : "+v"(tid_));
    const int tid = tid_;
    FX_LAS int* pstart = (FX_LAS int*)lds; FX_LAS int* off = pstart + 80;
    if (tid < 64) { const int pc = (CNT[tid] + 255) & ~255; int incl = pc;
#pragma unroll
        for (int o = 1; o < 64; o <<= 1) { const int t2 = __shfl_up(incl, o); if (tid >= o) incl += t2; }
        pstart[tid] = 16384 + incl - pc; if (tid == 63) pstart[64] = 16384 + incl; }
    __syncthreads();
    if (tid < 64) off[tid] = pstart[tid] + WGBASE[wg * 64 + tid];
    __syncthreads();
    for (int unit = wg; unit < T / RT; unit += nwg) {
        if (tid < RT * 6) { const int t = unit * RT + tid / 6, k = tid % 6; const int e = SELE[(size_t)t * 6 + k];
            const int pos = __hip_atomic_fetch_add(off + e, 1, __ATOMIC_RELAXED, __HIP_MEMORY_SCOPE_WORKGROUP);
            ROWTOK[pos] = t; ROWG[pos] = SELG[(size_t)t * 6 + k]; SLOT[(size_t)t * 6 + k] = pos; }
    }
    for (int e = wg; e < 64; e += nwg) { const int a = pstart[e] + CNT[e], b = pstart[e + 1]; for (int r = a + tid; r < b; r += 512) { ROWTOK[r] = 0; ROWG[r] = 0.f; } }
    for (int r = wg * 512 + tid; r < 16384; r += nwg * 512) { ROWTOK[r] = r; ROWG[r] = 1.f; }
}

struct MoeSched {
    static constexpr bool GATHER = true;
    FX_LAS const unsigned char* tile_e; int ntiles, npn, nunits, G, c;
    const int* rowtok; int lda_b; const char* Bt; size_t estride_b, pnstride_b;
    __device__ __forceinline__ bool next(int i, Unit& u) const {
        const long L = (long)i * G + c; if (L >= nunits) return false;
        int id = (int)L; { const int q = nunits / NXCD, r = nunits % NXCD, xcd = id % NXCD, off = id / NXCD; id = (xcd < r ? xcd * (q + 1) : r * (q + 1) + (xcd - r) * q) + off; }
        u.pm = id / npn; u.pn = id - u.pm * npn; u.e = tile_e[u.pm]; return true;
    }
    __device__ __forceinline__ unsigned a_row_off(const Unit& u, int R) const { const int row = u.pm * BM + R; return (unsigned)(rowtok ? rowtok[row] : row) * (unsigned)lda_b; }
    __device__ __forceinline__ const char* b_ptr(const Unit& u) const { return Bt + (size_t)u.e * estride_b + (size_t)u.pn * pnstride_b; }
};
__device__ __forceinline__ int moe_sched_build(FX_LAS unsigned char* tab, const int* CNT, int tidp) {
    FX_LAS int* nt = (FX_LAS int*)(tab + 512);
    int tid_ = tidp; asm volatile("" : "+v"(tid_));
    if (tid_ < 64) { const int n = (CNT[tid_] + 255) >> 8; int incl = n;
#pragma unroll
        for (int o = 1; o < 64; o <<= 1) { const int t2 = __shfl_up(incl, o); if (tid_ >= o) incl += t2; }
        const int st0 = 64 + incl - n; for (int j = 0; j < n; ++j) tab[st0 + j] = (unsigned char)tid_;
        tab[tid_] = 64; if (tid_ == 63) nt[0] = 64 + incl; }
    __syncthreads();
    return nt[0];
}
struct EpiGateUp {
    static constexpr bool PERM = true;
    unsigned char* HID;
    __device__ __forceinline__ void operator()(const f32x4 (&acc)[2][2][4][2], const Unit& u, int wr, int wc, int fr, int fq) const {
        const int row0 = u.pm * BM + wr * 64 + fr, col0 = u.pn * 128 + wc * 32 + 8 * fq;
#pragma unroll
        for (int ai = 0; ai < 2; ++ai)
#pragma unroll
            for (int m = 0; m < 4; ++m) { const int row = row0 + ai * HALF + m * 16;
                float o[8];
#pragma unroll
                for (int n = 0; n < 2; ++n)
#pragma unroll
                    for (int j = 0; j < 4; ++j) { const float g = acc[ai][0][m][n][j] * W8_INV, up = acc[ai][1][m][n][j] * W8_INV; o[n * 4 + j] = g * __builtin_amdgcn_rcpf(1.f + __expf(-g)) * up; }
                u32x2 w; w.x = cvt_pk4_fp8(o[0], o[1], o[2], o[3]); w.y = cvt_pk4_fp8(o[4], o[5], o[6], o[7]);
                *(u32x2*)(HID + (size_t)row * 512 + col0) = w; }
    }
    __device__ __forceinline__ void e32(const f32x16 (&acc3)[2][2][2], const Unit& u, int wr, int wc, int lane) const {
        const int j = lane & 31, hi = lane >> 5;
#pragma unroll
        for (int ai = 0; ai < 2; ++ai)
#pragma unroll
            for (int mb = 0; mb < 2; ++mb) { const int row = u.pm * BM + ai * HALF + wr * 64 + mb * 32 + j; unsigned char* rowp = HID + (size_t)row * 512 + u.pn * 128 + wc * 32 + 4 * hi;
#pragma unroll
                for (int g = 0; g < 4; ++g) { float o[4];
#pragma unroll
                    for (int q = 0; q < 4; ++q) { const float gt = acc3[ai][0][mb][4 * g + q] * W8_INV, up = acc3[ai][1][mb][4 * g + q] * W8_INV; o[q] = gt * __builtin_amdgcn_rcpf(1.f + __expf(-gt)) * up; }
                    *(unsigned*)(rowp + 8 * g) = cvt_pk4_fp8(o[0], o[1], o[2], o[3]); } }
    }
};
struct EpiDown {
    static constexpr bool PERM = true;
    unsigned char* YR; const float* ROWG; int nostore;
    __device__ __forceinline__ void operator()(const f32x4 (&acc)[2][2][4][2], const Unit& u, int wr, int wc, int fr, int fq) const {
        const int row0 = u.pm * BM + wr * 64 + fr, col0 = u.pn * BM + wc * 32 + 8 * fq;
        float gs[2][4];
#pragma unroll
        for (int ai = 0; ai < 2; ++ai)
#pragma unroll
            for (int m = 0; m < 4; ++m) gs[ai][m] = ROWG[row0 + ai * HALF + m * 16];
#pragma unroll
        for (int ai = 0; ai < 2; ++ai)
#pragma unroll
            for (int m = 0; m < 4; ++m) { const int row = row0 + ai * HALF + m * 16; const float g = gs[ai][m] * W8_INV; unsigned char* rowp = YR + (size_t)row * 2048 + col0;
#pragma unroll
                for (int bj = 0; bj < 2; ++bj) { const f32x4 v0 = acc[ai][bj][m][0] * g, v1 = acc[ai][bj][m][1] * g;
                    u32x2 w; w.x = cvt_pk4_fp8(v0[0], v0[1], v0[2], v0[3]); w.y = cvt_pk4_fp8(v1[0], v1[1], v1[2], v1[3]);
                    if (!FX_NOEPI || !nostore || (w.x == 0x12345678u && w.y == 0x9abcdef0u))
                    *(u32x2*)(rowp + bj * HALF) = w; } }
    }
    __device__ __forceinline__ void e32(const f32x16 (&acc3)[2][2][2], const Unit& u, int wr, int wc, int lane) const {
        const int j = lane & 31, hi = lane >> 5;
#pragma unroll
        for (int ai = 0; ai < 2; ++ai)
#pragma unroll
            for (int mb = 0; mb < 2; ++mb) { const int row = u.pm * BM + ai * HALF + wr * 64 + mb * 32 + j; const float gsc = ROWG[row] * W8_INV;
#pragma unroll
                for (int bj = 0; bj < 2; ++bj) { unsigned char* rowp = YR + (size_t)row * 2048 + u.pn * BM + bj * HALF + wc * 32 + 4 * hi;
#pragma unroll
                    for (int g = 0; g < 4; ++g) *(unsigned*)(rowp + 8 * g) = cvt_pk4_fp8(acc3[ai][bj][mb][4 * g] * gsc, acc3[ai][bj][mb][4 * g + 1] * gsc, acc3[ai][bj][mb][4 * g + 2] * gsc, acc3[ai][bj][mb][4 * g + 3] * gsc); } }
    }
};
__device__ __forceinline__ void p9_phase(FX_LAS unsigned char* lds, const unsigned char* HA, const unsigned char* WGU, const int* CNT, const int* ROWTOK, unsigned char* HID, int wg, int nwg, int tidp, const int noepi = 0) {
    FX_LAS unsigned char* tab = lds + STAGE_BYTES;
    const int ntiles = moe_sched_build(tab, CNT, tidp);
    MoeSched Sc; Sc.tile_e = tab; Sc.ntiles = ntiles; Sc.npn = 4; Sc.nunits = ntiles * 4; Sc.G = nwg; Sc.c = wg; Sc.rowtok = ROWTOK; Sc.lda_b = 2048; Sc.Bt = (const char*)WGU; Sc.estride_b = (size_t)1024 * 2048; Sc.pnstride_b = (size_t)256 * 2048;
    EpiGateUp E; E.HID = HID;
    gemm_phase<EpiGateUp, MoeSched, true>(lds, (const char*)HA, 2048, Sc, E, tidp, noepi);
}
__device__ __forceinline__ void p10_phase(FX_LAS unsigned char* lds, const unsigned char* HID, const unsigned char* WDN, const int* CNT, const float* ROWG, unsigned char* YR, int wg, int nwg, int tidp, const int noepi = 0) {
    FX_LAS unsigned char* tab = lds + STAGE_BYTES;
    const int ntiles = moe_sched_build(tab, CNT, tidp);
    MoeSched Sc; Sc.tile_e = tab; Sc.ntiles = ntiles; Sc.npn = 8; Sc.nunits = ntiles * 8; Sc.G = nwg; Sc.c = wg; Sc.rowtok = nullptr; Sc.lda_b = 512; Sc.Bt = (const char*)WDN; Sc.estride_b = (size_t)2048 * 512; Sc.pnstride_b = (size_t)256 * 512;
    EpiDown E; E.YR = YR; E.ROWG = ROWG; E.nostore = (noepi == 2);
    gemm_phase<EpiDown, MoeSched, true>(lds, (const char*)HID, 512, Sc, E, tidp, noepi == 1);
}
template <bool OUTF32>
__device__ __forceinline__ void p11_phase(const bf16_t* x1, const unsigned char* YR, const int* SLOT, const float* coef_l, const float* coef_next  , void* xout_, bf16_t* HA, int wg, int nwg, int tidp) {
    int tid_ = tidp; asm volatile("" : "+v"(tid_));
    const int wid = __builtin_amdgcn_readfirstlane(tid_ >> 6), lane = tid_ & 63;
    for (int t = wg * 8 + wid; t < T; t += nwg * 8) {
        const int b = t / S; const float* cf = coef_l + (size_t)b * 6 * 2048;
        int rows[7]; rows[0] = t;
        { int sl[6];
#pragma unroll
          for (int k = 0; k < 6; ++k) sl[k] = *FX_GC(int, SLOT + (size_t)t * 6 + k);
#pragma unroll
          for (int k = 0; k < 6; ++k) rows[k + 1] = __builtin_amdgcn_readfirstlane(sl[k]); }
        u32x2 ra[4][4];
#pragma unroll
        for (int k = 0; k < 4; ++k)
#pragma unroll
            for (int i = 0; i < 4; ++i) ra[k][i] = *FX_GC(u32x2, YR + (size_t)rows[k] * 2048 + i * 512 + lane * 8);
        u32x4 xw[4];
#pragma unroll
        for (int i = 0; i < 4; ++i) xw[i] = *FX_GC(u32x4, x1 + (size_t)t * 2048 + i * 512 + lane * 8);
        float yv[32];
#pragma unroll
        for (int j = 0; j < 32; ++j) yv[j] = 0.f;
#define FX_ACC8(W, I) do { const f32x2 a0 = __builtin_amdgcn_cvt_pk_f32_fp8((int)(W).x, false), a1 = __builtin_amdgcn_cvt_pk_f32_fp8((int)(W).x, true), a2 = __builtin_amdgcn_cvt_pk_f32_fp8((int)(W).y, false), a3 = __builtin_amdgcn_cvt_pk_f32_fp8((int)(W).y, true); \
            yv[(I) * 8 + 0] += a0[0]; yv[(I) * 8 + 1] += a0[1]; yv[(I) * 8 + 2] += a1[0]; yv[(I) * 8 + 3] += a1[1]; yv[(I) * 8 + 4] += a2[0]; yv[(I) * 8 + 5] += a2[1]; yv[(I) * 8 + 6] += a3[0]; yv[(I) * 8 + 7] += a3[1]; } while (0)
#pragma unroll
        for (int k = 0; k < 4; ++k)
#pragma unroll
            for (int i = 0; i < 4; ++i) FX_ACC8(ra[k][i], i);
        u32x2 rb[3][4];
#pragma unroll
        for (int k = 0; k < 3; ++k)
#pragma unroll
            for (int i = 0; i < 4; ++i) rb[k][i] = *FX_GC(u32x2, YR + (size_t)rows[4 + k] * 2048 + i * 512 + lane * 8);
        f32x4 cd[8];
#pragma unroll
        for (int i = 0; i < 4; ++i) { cd[2 * i] = *FX_GC(f32x4, cf + 3 * 2048 + i * 512 + lane * 8); cd[2 * i + 1] = *FX_GC(f32x4, cf + 3 * 2048 + i * 512 + lane * 8 + 4); }
#pragma unroll
        for (int k = 0; k < 3; ++k)
#pragma unroll
            for (int i = 0; i < 4; ++i) FX_ACC8(rb[k][i], i);
#undef FX_ACC8
        float ss = 0.f;
#pragma unroll
        for (int j = 0; j < 32; ++j) ss += yv[j] * yv[j];
        ss = wave_sum(ss); const float ry = rsqrtf(ss * (1.f / 2048.f) + EPS); float ssx = 0.f;
#pragma unroll
        for (int i = 0; i < 4; ++i) { const u32x4 w = xw[i];
            const float xs[8] = {bflo(w.x), bfhi(w.x), bflo(w.y), bfhi(w.y), bflo(w.z), bfhi(w.z), bflo(w.w), bfhi(w.w)};
#pragma unroll
            for (int j = 0; j < 8; ++j) { yv[i * 8 + j] = xs[j] + cd[2 * i + (j >> 2)][j & 3] * (yv[i * 8 + j] * ry); ssx += yv[i * 8 + j] * yv[i * 8 + j]; } }
        f32x4 ce[8], cg[8];
        if (coef_next) { const float* cn = coef_next + (size_t)b * 6 * 2048;
#pragma unroll
            for (int i = 0; i < 4; ++i) { ce[2 * i] = *FX_GC(f32x4, cn + 4 * 2048 + i * 512 + lane * 8); ce[2 * i + 1] = *FX_GC(f32x4, cn + 4 * 2048 + i * 512 + lane * 8 + 4);
                cg[2 * i] = *FX_GC(f32x4, cn + 5 * 2048 + i * 512 + lane * 8); cg[2 * i + 1] = *FX_GC(f32x4, cn + 5 * 2048 + i * 512 + lane * 8 + 4); } }
#pragma unroll
        for (int i = 0; i < 4; ++i) { const int c = i * 512 + lane * 8;
            if constexpr (OUTF32) { float* xout = (float*)xout_; *FX_GM(f32x4, xout + (size_t)t * 2048 + c) = (f32x4){yv[i * 8 + 0], yv[i * 8 + 1], yv[i * 8 + 2], yv[i * 8 + 3]};
                *FX_GM(f32x4, xout + (size_t)t * 2048 + c + 4) = (f32x4){yv[i * 8 + 4], yv[i * 8 + 5], yv[i * 8 + 6], yv[i * 8 + 7]}; }
            else { u32x4 xo; xo.x = cvt_pk_bf16(yv[i * 8 + 0], yv[i * 8 + 1]); xo.y = cvt_pk_bf16(yv[i * 8 + 2], yv[i * 8 + 3]); xo.z = cvt_pk_bf16(yv[i * 8 + 4], yv[i * 8 + 5]); xo.w = cvt_pk_bf16(yv[i * 8 + 6], yv[i * 8 + 7]);
                *FX_GM(u32x4, (bf16_t*)xout_ + (size_t)t * 2048 + c) = xo; } }
        if (coef_next) { ssx = wave_sum(ssx); const float rx = rsqrtf(ssx * (1.f / 2048.f) + EPS);
#pragma unroll
            for (int i = 0; i < 4; ++i) { const int c = i * 512 + lane * 8;
                float hv[8];
#pragma unroll
                for (int j = 0; j < 8; ++j) hv[j] = yv[i * 8 + j] * rx * ce[2 * i + (j >> 2)][j & 3] + cg[2 * i + (j >> 2)][j & 3];
#ifdef FX_WIN8
                u32x2 w; w.x = cvt_pk4_fp8(hv[0], hv[1], hv[2], hv[3]); w.y = cvt_pk4_fp8(hv[4], hv[5], hv[6], hv[7]);
                *FX_GM(u32x2, (unsigned char*)HA + (size_t)t * 2048 + c) = w; } }
#else
                u32x4 w; w.x = cvt_pk_bf16(hv[0], hv[1]); w.y = cvt_pk_bf16(hv[2], hv[3]); w.z = cvt_pk_bf16(hv[4], hv[5]); w.w = cvt_pk_bf16(hv[6], hv[7]);
                *FX_GM(u32x4, HA + (size_t)t * 2048 + c) = w; } }
#endif
    }
}
}
namespace fx {
#ifndef FX_SD_A
#define FX_SD_A 2
#endif
#ifndef FX_SD_B
#define FX_SD_B 1
#endif
#ifndef FX_NQR_B
#define FX_NQR_B 8
#endif
#define FX_SBAR() __builtin_amdgcn_sched_barrier(0)
__device__ __forceinline__ int crow(int r, int hi) { return (r & 3) + 8 * (r >> 2) + 4 * hi; }
__device__ __forceinline__ int v_st(int k, int c) { const int kk = (k & ~0xC) | ((k & 4) << 1) | ((k & 8) >> 1); return ((kk >> 3) * 4 + (c >> 5)) * 512 + ((kk & 7) * 32 + (c & 31)) * 2; }
__device__ __forceinline__ int v_rd_base(int lane) { return ((lane & 3) << 3) | (((lane >> 2) & 3) << 6) | (((lane >> 4) & 1) << 5) | (((lane >> 5) & 1) << 8); }
constexpr int v_rd_off(int d0, int ks, int half) { return d0 * 512 + ks * 4096 + half * 2048; }
template <int OFF> __device__ __forceinline__ s16x4 tr_read(int vb) { s16x4 r; asm volatile("ds_read_b64_tr_b16 %0, %1 offset:%2" : "=&v"(r) : "v"(vb), "i"(OFF) : "memory"); return r; }
#define FX_PK(L, H) (bf16x8){L[0], L[1], L[2], L[3], H[0], H[1], H[2], H[3]}
template <int D0> __device__ __forceinline__ void pv_one(f32x16& od, int vb, bf16x8 pa0, bf16x8 pa1, bf16x8 pa2, bf16x8 pa3) {
    const s16x4 l0 = tr_read<v_rd_off(D0, 0, 0)>(vb), h0 = tr_read<v_rd_off(D0, 0, 1)>(vb), l1 = tr_read<v_rd_off(D0, 1, 0)>(vb), h1 = tr_read<v_rd_off(D0, 1, 1)>(vb);
    const s16x4 l2 = tr_read<v_rd_off(D0, 2, 0)>(vb), h2 = tr_read<v_rd_off(D0, 2, 1)>(vb), l3 = tr_read<v_rd_off(D0, 3, 0)>(vb), h3 = tr_read<v_rd_off(D0, 3, 1)>(vb);
    asm volatile("s_waitcnt lgkmcnt(0)" ::: "memory"); FX_SBAR();
    od = __builtin_amdgcn_mfma_f32_32x32x16_bf16(pa0, FX_PK(l0, h0), od, 0, 0, 0);
    od = __builtin_amdgcn_mfma_f32_32x32x16_bf16(pa1, FX_PK(l1, h1), od, 0, 0, 0);
    od = __builtin_amdgcn_mfma_f32_32x32x16_bf16(pa2, FX_PK(l2, h2), od, 0, 0, 0);
    od = __builtin_amdgcn_mfma_f32_32x32x16_bf16(pa3, FX_PK(l3, h3), od, 0, 0, 0);
}
__device__ __forceinline__ void pv_d0(f32x16* o, int vb, bf16x8 pa0, bf16x8 pa1, bf16x8 pa2, bf16x8 pa3) {
    pv_one<0>(o[0], vb, pa0, pa1, pa2, pa3); pv_one<1>(o[1], vb, pa0, pa1, pa2, pa3); pv_one<2>(o[2], vb, pa0, pa1, pa2, pa3); pv_one<3>(o[3], vb, pa0, pa1, pa2, pa3);
}
#define FX_PK4(P, BASE, OUT) do { unsigned a0 = cvt_pk_bf16(P[BASE + 0], P[BASE + 1]), a1 = cvt_pk_bf16(P[BASE + 2], P[BASE + 3]);   \
    unsigned b0 = cvt_pk_bf16(P[BASE + 4], P[BASE + 5]), b1 = cvt_pk_bf16(P[BASE + 6], P[BASE + 7]);                              \
    auto r0 = __builtin_amdgcn_permlane32_swap(a0, b0, false, false); auto r1 = __builtin_amdgcn_permlane32_swap(a1, b1, false, false); \
    u32x4 w = {r0[0], r1[0], r0[1], r1[1]}; OUT = *reinterpret_cast<bf16x8*>(&w); } while (0)

template <int DQK> struct AttnC {
    static constexpr int NQ = DQK / 16, KROW = DQK * 2, SHM_V = 64 * 128 * 2, SHM_K = 64 * DQK * 2, NQR = (DQK == 128 ? 8 : FX_NQR_B)  , QX = (NQ - NQR) * 8 * 64 * 16, SHM = 2 * SHM_V + 2 * SHM_K + 8 * 64 * 4 + QX;
    static constexpr float SCALE = DQK == 128 ? 0.088388347648318440f : 0.072168783648703220f;
    static constexpr float THR = 8.f;
};
#define FX_KSWZ(row, colB) ((row) * C::KROW + ((colB) ^ (((row) & 7) << 4)))

template <int DQK> __device__ __forceinline__ void partialSM(f32x16& p0, f32x16& p1, float& m_reg, float& mn, float& alpha) {
    using C = AttnC<DQK>;
    constexpr float Cc = C::SCALE * 1.4426950408889634f;
    float pmax = p0[0];
#pragma unroll
    for (int r = 1; r < 16; ++r) pmax = fmaxf(pmax, p0[r]);
#pragma unroll
    for (int r = 0; r < 16; ++r) pmax = fmaxf(pmax, p1[r]);
    { auto rr = __builtin_amdgcn_permlane32_swap(__float_as_uint(pmax), __float_as_uint(pmax), false, false); pmax = fmaxf(__uint_as_float(rr[0]), __uint_as_float(rr[1])); }
    if (__builtin_expect(__all(pmax - m_reg <= C::THR / C::SCALE), 1)) { mn = m_reg; alpha = 1.f; }
    else { mn = fmaxf(m_reg, pmax); alpha = __builtin_amdgcn_exp2f((m_reg - mn) * Cc); m_reg = mn; }
    const float mnC = -mn * Cc;
#pragma unroll
    for (int r = 0; r < 16; ++r) p0[r] = fmaf(p0[r], Cc, mnC);
#pragma unroll
    for (int r = 0; r < 16; ++r) p1[r] = fmaf(p1[r], Cc, mnC);
#pragma unroll
    for (int r = 0; r < 16; ++r) p0[r] = __builtin_amdgcn_exp2f(p0[r]);
}
__device__ __forceinline__ void finishSM(f32x16& p0, f32x16& p1, float alpha, float& l_reg, bf16x8& pa0, bf16x8& pa1, bf16x8& pa2, bf16x8& pa3) {
#pragma unroll
    for (int r = 0; r < 16; ++r) p1[r] = __builtin_amdgcn_exp2f(p1[r]);
    float ps = 0;
#pragma unroll
    for (int r = 0; r < 16; ++r) ps += p0[r];
#pragma unroll
    for (int r = 0; r < 16; ++r) ps += p1[r];
    { auto rr = __builtin_amdgcn_permlane32_swap(__float_as_uint(ps), __float_as_uint(ps), false, false); ps = __uint_as_float(rr[0]) + __uint_as_float(rr[1]); }
    l_reg = l_reg * alpha + ps;
    FX_PK4(p0, 0, pa0); FX_PK4(p0, 8, pa1); FX_PK4(p1, 0, pa2); FX_PK4(p1, 8, pa3);
}
template <int DQK> __device__ __forceinline__ void qkt(f32x16& p0, f32x16& p1, const char* Ks, const bf16x8* qr, const char* qx  , int r32, int hi) {
    using C = AttnC<DQK>;
    p0 = f32x16{}; p1 = f32x16{};
#pragma unroll
    for (int d0 = 0; d0 < C::NQ; ++d0) { const int cb = (d0 * 16 + hi * 8) * 2;
        const bf16x8 qf = d0 < C::NQR ? qr[d0 < C::NQR ? d0 : 0] : *reinterpret_cast<const bf16x8*>(qx + (d0 - C::NQR) * 1024);
        const bf16x8 b0 = *reinterpret_cast<const bf16x8*>(Ks + FX_KSWZ(r32, cb));
        const bf16x8 b1 = *reinterpret_cast<const bf16x8*>(Ks + FX_KSWZ(32 + r32, cb));
        p0 = __builtin_amdgcn_mfma_f32_32x32x16_bf16(b0, qf, p0, 0, 0, 0);
        p1 = __builtin_amdgcn_mfma_f32_32x32x16_bf16(b1, qf, p1, 0, 0, 0); }
}

template <int DQK, int SD, int LDQ, int LDK1, int LDK2, int LDV>
__device__ __forceinline__ void attn_unit(const bf16_t* __restrict__ Qb, const bf16_t* __restrict__ K1, const bf16_t* __restrict__ K2, const bf16_t* __restrict__ Vh,
                                          bf16_t* __restrict__ Ob, const float* __restrict__ gain, int seq, char* lds, int tidp) {
    using C = AttnC<DQK>;
    int tid_ = tidp; asm volatile("" : "+v"(tid_));
    const int tid = tid_, wid = tid >> 6, lane = tid & 63, r32 = lane & 31, hi = lane >> 5;
    char* V_lds = lds; char* K_lds = lds + 2 * C::SHM_V;
    float* ws = (float*)(lds + 2 * C::SHM_V + 2 * C::SHM_K) + wid * 64; float* li_l = ws; float* al_l = ws + 32;
    float m_reg = -1e30f, l_reg = 0; f32x16 o[4] = {}; bf16x8 qr[C::NQR];
    char* qx = lds + 2 * C::SHM_V + 2 * C::SHM_K + 8 * 64 * 4 + wid * ((C::NQ - C::NQR) * 1024) + lane * 16;
    const bf16_t* Qw = Qb + (long)(wid * 32 + r32) * LDQ + hi * 8;
#pragma unroll
    for (int d0 = 0; d0 < C::NQR; ++d0) qr[d0] = *reinterpret_cast<const bf16x8*>(Qw + d0 * 16);
#pragma unroll
    for (int d0 = C::NQR; d0 < C::NQ; ++d0) *reinterpret_cast<bf16x8*>(qx + (d0 - C::NQR) * 1024) = *reinterpret_cast<const bf16x8*>(Qw + d0 * 16);
    const int sr = tid >> 4, sc = (tid & 15) * 8, vst0 = v_st(sr, sc), vst1 = v_st(32 + sr, sc);
    const int vb0 = (int)(uintptr_t)V_lds + v_rd_base(lane);
    const int xr = tid >> 3, xc = (tid & 7) * 8;
    struct { bf16x8 vs0, vs1, ks0, ks1, kx; } sr_[SD];
#define FX_SLOAD(i, k0) do { sr_[i].vs0 = *reinterpret_cast<const bf16x8*>(&Vh[(long)((k0) + sr) * LDV + sc]); sr_[i].vs1 = *reinterpret_cast<const bf16x8*>(&Vh[(long)((k0) + 32 + sr) * LDV + sc]); \
    sr_[i].ks0 = *reinterpret_cast<const bf16x8*>(&K1[(long)((k0) + sr) * LDK1 + sc]); sr_[i].ks1 = *reinterpret_cast<const bf16x8*>(&K1[(long)((k0) + 32 + sr) * LDK1 + sc]); \
    if (DQK == 192) sr_[i].kx = *reinterpret_cast<const bf16x8*>(&K2[(long)((k0) + xr) * LDK2 + xc]); } while (0)
#define FX_SWRITE(b, i) do { *(bf16x8*)(V_lds + (b) * C::SHM_V + vst0) = sr_[i].vs0; *(bf16x8*)(V_lds + (b) * C::SHM_V + vst1) = sr_[i].vs1; const int kc = sc * 2; \
    *(bf16x8*)(K_lds + (b) * C::SHM_K + FX_KSWZ(sr, kc)) = sr_[i].ks0; *(bf16x8*)(K_lds + (b) * C::SHM_K + FX_KSWZ(32 + sr, kc)) = sr_[i].ks1; \
    if (DQK == 192) *(bf16x8*)(K_lds + (b) * C::SHM_K + FX_KSWZ(xr, 256 + xc * 2)) = sr_[i].kx; } while (0)
#define FX_SWAIT() do { if (SD == 1) asm volatile("s_waitcnt vmcnt(0)" ::: "memory"); else if (DQK == 192) asm volatile("s_waitcnt vmcnt(5)" ::: "memory"); else asm volatile("s_waitcnt vmcnt(4)" ::: "memory"); } while (0)
#define FX_RESC(a) do { if (__any((a) < 1.f)) { if (hi == 0) al_l[r32] = (a); asm volatile("s_waitcnt lgkmcnt(0)" ::: "memory"); \
    _Pragma("unroll") for (int d = 0; d < 4; ++d) _Pragma("unroll") for (int r = 0; r < 16; ++r) o[d][r] *= al_l[crow(r, hi)]; } } while (0)
    f32x16 pA0, pA1, pB0, pB1; float mnA, mnB, alA, alB; bf16x8 pa0, pa1, pa2, pa3; const int NT = seq / 64;
    constexpr int SE = 0, SO = SD - 1;
    FX_SLOAD(SE, 0); asm volatile("s_waitcnt vmcnt(0)" ::: "memory"); FX_SWRITE(0, SE); __syncthreads();
    qkt<DQK>(pA0, pA1, K_lds, qr, qx, r32, hi); partialSM<DQK>(pA0, pA1, m_reg, mnA, alA);
    FX_SLOAD(SO, 64); if (SD == 2) { if (2 < NT) FX_SLOAD(SE, 128); }
    FX_SWAIT(); FX_SWRITE(1, SO); __syncthreads();
    for (int j = 1; j + 1 < NT; j += 2) {
        FX_SBAR(); qkt<DQK>(pB0, pB1, K_lds + C::SHM_K, qr, qx, r32, hi);
        finishSM(pA0, pA1, alA, l_reg, pa0, pa1, pa2, pa3); FX_SBAR();
        FX_SLOAD(SO, (j + SD) * 64); FX_SBAR();
        pv_d0(o, vb0, pa0, pa1, pa2, pa3); partialSM<DQK>(pB0, pB1, m_reg, mnB, alB);
        __syncthreads(); FX_SWAIT(); FX_SWRITE(0, SE);
        FX_RESC(alB); __syncthreads();
        FX_SBAR(); qkt<DQK>(pA0, pA1, K_lds, qr, qx, r32, hi);
        finishSM(pB0, pB1, alB, l_reg, pa0, pa1, pa2, pa3); FX_SBAR();
        if (SD == 1 || j + 3 < NT) FX_SLOAD(SE, (j + 1 + SD) * 64); FX_SBAR();
        pv_d0(o, vb0 + C::SHM_V, pa0, pa1, pa2, pa3); partialSM<DQK>(pA0, pA1, m_reg, mnA, alA);
        __syncthreads(); FX_SWAIT(); FX_SWRITE(1, SO);
        FX_RESC(alA); __syncthreads();
    }
    FX_SBAR(); qkt<DQK>(pB0, pB1, K_lds + C::SHM_K, qr, qx, r32, hi);
    finishSM(pA0, pA1, alA, l_reg, pa0, pa1, pa2, pa3); FX_SBAR();
    pv_d0(o, vb0, pa0, pa1, pa2, pa3); partialSM<DQK>(pB0, pB1, m_reg, mnB, alB);
    __syncthreads(); FX_RESC(alB);
    finishSM(pB0, pB1, alB, l_reg, pa0, pa1, pa2, pa3); FX_SBAR();
    pv_d0(o, vb0 + C::SHM_V, pa0, pa1, pa2, pa3);
    if (hi == 0) li_l[r32] = l_reg; asm volatile("s_waitcnt lgkmcnt(0)" ::: "memory");
    int r32e = r32; asm volatile("" : "+v"(r32e));
    float g4[4];
#pragma unroll
    for (int d0 = 0; d0 < 4; ++d0) g4[d0] = gain[d0 * 32 + r32e];
    bf16_t* Ow = Ob + (long)(wid * 32) * 2048;
#pragma unroll
    for (int r = 0; r < 16; ++r) { const float rl = __builtin_amdgcn_rcpf(li_l[crow(r, hi)]);
        float ss = 0.f;
#pragma unroll
        for (int d0 = 0; d0 < 4; ++d0) { o[d0][r] *= rl; ss += o[d0][r] * o[d0][r]; }
        ss += __shfl_xor(ss, 1); ss += __shfl_xor(ss, 2); ss += __shfl_xor(ss, 4); ss += __shfl_xor(ss, 8); ss += __shfl_xor(ss, 16);
        const float rn = rsqrtf(ss * (1.f / 128.f) + EPS); const int orow = crow(r, hi);
#pragma unroll
#ifdef FX_WOUT8
        for (int d0 = 0; d0 < 4; ++d0) ((unsigned char*)Ob)[(long)(wid * 32 + orow) * 2048 + d0 * 32 + r32e] = (unsigned char)(__builtin_amdgcn_cvt_pk_fp8_f32(o[d0][r] * rn * g4[d0], 0.f, 0, false) & 0xff); }
#else
        for (int d0 = 0; d0 < 4; ++d0) Ow[(long)orow * 2048 + d0 * 32 + r32e] = f2bf(o[d0][r] * rn * g4[d0]); }
#endif
    __syncthreads();
#undef FX_SLOAD
#undef FX_SWRITE
#undef FX_SWAIT
#undef FX_RESC
}

__device__ __forceinline__ void attn_gqa_unit(int u, const bf16_t* QA, const bf16_t* KA, const bf16_t* PROJ, bf16_t* YM, const float* hog, char* lds, int tidp) {
    const int qb = u & 15, hh = (u >> 4) % 6, b = u / 96, kvh = hh / 3;
    const size_t t0 = (size_t)b * S;
    attn_unit<128, FX_SD_A, 768, 256, 0, PW>(QA + (t0 + qb * 256) * 768 + hh * 128, KA + t0 * 256 + kvh * 128, nullptr, PROJ + t0 * PW + O_AV + kvh * 128,
#ifdef FX_WOUT8
                                    (bf16_t*)((unsigned char*)YM + (t0 + qb * 256) * 2048 + hh * 128), hog + hh * 128, S, lds, tidp);
#else
                                    YM + (t0 + qb * 256) * 2048 + hh * 128, hog + hh * 128, S, lds, tidp);
#endif
}
__device__ __forceinline__ void attn_mla_unit(int u, const bf16_t* QB, const bf16_t* KVB, const bf16_t* KR, bf16_t* YM, const float* hog, char* lds, int tidp) {
    const int qb = u & 15, hh = (u >> 4) % 6, b = u / 96;
    const size_t t0 = (size_t)b * S;
    attn_unit<192, FX_SD_B, 1280, 1536, 64, 1536>(QB + (t0 + qb * 256) * 1280 + hh * 192, KVB + t0 * 1536 + hh * 256, KR + t0 * 64, KVB + t0 * 1536 + hh * 256 + 128,
#ifdef FX_WOUT8
                                         (bf16_t*)((unsigned char*)YM + (t0 + qb * 256) * 2048 + 768 + hh * 128), hog + 768 + hh * 128, S, lds, tidp);
#else
                                         YM + (t0 + qb * 256) * 2048 + 768 + hh * 128, hog + 768 + hh * 128, S, lds, tidp);
#endif
}
}
namespace fx {
constexpr int P3_LDS = 4096 + 2048 + 65536 + 32768;
constexpr float KSCALE = 0.08838834764831845f;
__device__ __forceinline__ float logsigmoid_f(float f) { return fminf(f, 0.f) - log1pf(__expf(-fabsf(f))); }
__device__ __forceinline__ float wave_scan_incl(float v, int lane) {
#pragma unroll
    for (int o = 1; o < 64; o <<= 1) { const float t = __shfl_up(v, o); if (lane >= o) v += t; }
    return v;
}
__device__ __forceinline__ float wave_scanmax_incl(float v, int lane) {
#pragma unroll
    for (int o = 1; o < 64; o <<= 1) { const float t = __shfl_up(v, o); if (lane >= o) v = fmaxf(v, t); }
    return v;
}
__device__ __forceinline__ float wave_rscanmax_incl(float v, int lane) {
#pragma unroll
    for (int o = 1; o < 64; o <<= 1) { const float t = __shfl_down(v, o); if (lane + o < 64) v = fmaxf(v, t); }
    return v;
}

struct P3Args {
    const bf16_t* PROJ; const float* GATES; const float* gate_b; const float* conv_w; const float* conv_b;
    const float* aq_gain; const float* ak_gain; const float* cq_gain; const float* ckv_gain;
    const float* cosA; const float* sinA; const float* cosB; const float* sinB;
    bf16_t* QA; bf16_t* KA; bf16_t* CQN; bf16_t* CKVN; bf16_t* KR; bf16_t* QC; bf16_t* KC; bf16_t* KCT; float* NLOC; float* GSC;
};
__device__ __forceinline__ void p3_phase(FX_LAS unsigned char* lds_, const P3Args& a, int wg, int nwg, int tidp) {
    char* lds = (char*)lds_;
    float* gat = (float*)lds; float* wts = (float*)(lds + 4096); char* ktile = lds + 6144; char* wv = lds + 6144 + 65536;
    for (int unit = wg; unit < T / 64; unit += nwg) {
        int tid_ = tidp; asm volatile("" : "+v"(tid_));
        const int tid = tid_, wid = tid >> 6, lane = tid & 63;
        const int b = unit >> 6, co = unit & 63; const size_t t0 = (size_t)unit * 64;
        for (int i = tid; i < 1024; i += 512) gat[i] = a.GATES[t0 * 16 + i] + a.gate_b[i & 15];
        __syncthreads();
        { const int dir = wid >> 2, h = wid & 3;
          const float logi = gat[lane * 16 + (dir * 2) * 4 + h], logf = logsigmoid_f(gat[lane * 16 + (dir * 2 + 1) * 4 + h]);
          const float pre = wave_scan_incl(logf, lane), g = __shfl(pre, 63);
          const float bb = dir ? (g - pre + logf) : pre;
          const float av = g - bb + logi, mloc = wave_max(av);
          wts[wid * 64 + lane] = __expf(av - mloc);
          if (lane == 0) { const int chain = (b * 4 + h) * 2 + dir, ci = dir ? 63 - co : co; a.GSC[(chain * 64 + ci) * 2] = g; a.GSC[(chain * 64 + ci) * 2 + 1] = mloc; } }
        __syncthreads();
        { const int c0 = 2 * tid; const bool isk = c0 >= 512; const int hk = (c0 - 512) >> 7, dk = (c0 - 512) & 127;
          float w0[5], w1[5];
#pragma unroll
          for (int j = 0; j < 5; ++j) { w0[j] = a.conv_w[j * 1024 + c0]; w1[j] = a.conv_w[j * 1024 + c0 + 1]; }
          const float cb0 = a.conv_b[c0], cb1 = a.conv_b[c0 + 1];
          float x0[5], x1[5];
          const bf16_t* src = a.PROJ + t0 * PW + O_CQ + c0;
#pragma unroll
          for (int j = 0; j < 4; ++j) { const int sa = co * 64 + j - 2; unsigned w = 0u; if (sa >= 0 && sa < S) w = *(const unsigned*)(src + (long)(j - 2) * PW); x0[j + 1] = bflo(w); x1[j + 1] = bfhi(w); }
          float nf0 = 0.f, nf1 = 0.f, nb0 = 0.f, nb1 = 0.f;
#pragma unroll 1
          for (int s0 = 0; s0 < 64; s0 += 16) {
              unsigned wl[16];
#pragma unroll
              for (int q = 0; q < 16; ++q) { const int sa = co * 64 + s0 + q + 2; wl[q] = 0u; if (sa < S) wl[q] = *(const unsigned*)(src + (long)(s0 + q + 2) * PW); }
#pragma unroll
              for (int q = 0; q < 16; ++q) { const int s = s0 + q;
#pragma unroll
                  for (int j = 0; j < 4; ++j) { x0[j] = x0[j + 1]; x1[j] = x1[j + 1]; }
                  x0[4] = bflo(wl[q]); x1[4] = bfhi(wl[q]);
                  float y0 = cb0, y1 = cb1;
#pragma unroll
                  for (int j = 0; j < 5; ++j) { y0 += w0[j] * x0[j]; y1 += w1[j] * x1[j]; }
                  y0 = silu_f(y0); y1 = silu_f(y1);
                  if (!isk) { *(unsigned*)(a.QC + (t0 + s) * 512 + c0) = cvt_pk_bf16(y0, y1); }
                  else { y0 *= KSCALE; y1 *= KSCALE; const unsigned pk = cvt_pk_bf16(y0, y1);
                      *(unsigned*)(a.KC + (t0 + s) * 512 + (c0 - 512)) = pk;
                      *(unsigned*)(ktile + hk * 16384 + v_st(s, dk & ~7) + (dk & 7) * 2) = pk;
                      const float k0 = bflo(pk), k1 = bfhi(pk); const float wf = wts[hk * 64 + s], wb = wts[(4 + hk) * 64 + s];
                      nf0 += wf * k0; nf1 += wf * k1; nb0 += wb * k0; nb1 += wb * k1; } }
          }
          if (isk) { const int chf = (b * 4 + hk) * 2, chb = chf + 1;
              *(f32x2*)(a.NLOC + ((size_t)chf * 64 + co) * 128 + dk) = (f32x2){nf0, nf1};
              *(f32x2*)(a.NLOC + ((size_t)chb * 64 + (63 - co)) * 128 + dk) = (f32x2){nb0, nb1}; } }
        __syncthreads();
#pragma unroll 1
        for (int h = 0; h < 4; ++h) {
            { const int sr = tid >> 4, sc = (tid & 15) * 8;
#pragma unroll
              for (int rr = 0; rr < 2; ++rr) { const int s = sr + 32 * rr;
                const u32x4 vw = *(const u32x4*)(a.PROJ + (t0 + s) * PW + O_CV + h * 128 + sc);
                const float wf = wts[h * 64 + s], wb = wts[(4 + h) * 64 + s];
                float v[8] = {bflo(vw.x), bfhi(vw.x), bflo(vw.y), bfhi(vw.y), bflo(vw.z), bfhi(vw.z), bflo(vw.w), bfhi(vw.w)};
                u32x4 of, ob;
                of.x = cvt_pk_bf16(v[0] * wf, v[1] * wf); of.y = cvt_pk_bf16(v[2] * wf, v[3] * wf); of.z = cvt_pk_bf16(v[4] * wf, v[5] * wf); of.w = cvt_pk_bf16(v[6] * wf, v[7] * wf);
                ob.x = cvt_pk_bf16(v[0] * wb, v[1] * wb); ob.y = cvt_pk_bf16(v[2] * wb, v[3] * wb); ob.z = cvt_pk_bf16(v[4] * wb, v[5] * wb); ob.w = cvt_pk_bf16(v[6] * wb, v[7] * wb);
                *(u32x4*)(wv + v_st(s, sc)) = of; *(u32x4*)(wv + 16384 + v_st(s, sc)) = ob; } }
            __syncthreads();
            { const int dir = wid >> 2, mb = wid & 3, r32 = lane & 31, hi = lane >> 5;
              const int va = (int)(uintptr_t)(wv + dir * 16384) + v_rd_base(lane) + mb * 512;
              const int kb = (int)(uintptr_t)(ktile + h * 16384) + v_rd_base(lane);
              f32x16 acc[4] = {};
#define FX_KC_STEP(KS) do { \
              const s16x4 al = tr_read<v_rd_off(0, KS, 0)>(va), ah = tr_read<v_rd_off(0, KS, 1)>(va); \
              const s16x4 b0l = tr_read<v_rd_off(0, KS, 0)>(kb), b0h = tr_read<v_rd_off(0, KS, 1)>(kb), b1l = tr_read<v_rd_off(1, KS, 0)>(kb), b1h = tr_read<v_rd_off(1, KS, 1)>(kb); \
              const s16x4 b2l = tr_read<v_rd_off(2, KS, 0)>(kb), b2h = tr_read<v_rd_off(2, KS, 1)>(kb), b3l = tr_read<v_rd_off(3, KS, 0)>(kb), b3h = tr_read<v_rd_off(3, KS, 1)>(kb); \
              asm volatile("s_waitcnt lgkmcnt(0)" ::: "memory"); FX_SBAR(); \
              const bf16x8 af = FX_PK(al, ah); \
              acc[0] = __builtin_amdgcn_mfma_f32_32x32x16_bf16(af, FX_PK(b0l, b0h), acc[0], 0, 0, 0); acc[1] = __builtin_amdgcn_mfma_f32_32x32x16_bf16(af, FX_PK(b1l, b1h), acc[1], 0, 0, 0); \
              acc[2] = __builtin_amdgcn_mfma_f32_32x32x16_bf16(af, FX_PK(b2l, b2h), acc[2], 0, 0, 0); acc[3] = __builtin_amdgcn_mfma_f32_32x32x16_bf16(af, FX_PK(b3l, b3h), acc[3], 0, 0, 0); } while (0)
              FX_KC_STEP(0); FX_KC_STEP(1); FX_KC_STEP(2); FX_KC_STEP(3);
#undef FX_KC_STEP
              const int chain = (b * 4 + h) * 2 + dir, ci = dir ? 63 - co : co;
              bf16_t* dst = a.KCT + ((size_t)chain * 64 + ci) * 16384 + (size_t)(mb * 32) * 128 + r32;
#pragma unroll
              for (int r = 0; r < 16; ++r) { const int v = crow(r, hi);
#pragma unroll
                  for (int nb = 0; nb < 4; ++nb) dst[v * 128 + nb * 32] = f2bf(acc[nb][r]); } }
            __syncthreads();
        }
        { const int f = lane & 31, hf = lane >> 5;
#pragma unroll 8
          for (int it = wid; it < 512; it += 8) { const int s = it >> 3, hd = it & 7; const size_t t = t0 + s;
            const bf16_t* src = a.PROJ + t * PW + hd * 128 + hf * 64;
            float x1 = bf2f(src[f]), x2 = bf2f(src[32 + f]);
            const float ss = wave_sum(x1 * x1 + x2 * x2), r = rsqrtf(ss * (1.f / 128.f) + EPS);
            const float* g = hd < 6 ? a.aq_gain : a.ak_gain;
            x1 *= r * g[hf * 64 + f]; x2 *= r * g[hf * 64 + 32 + f];
            const int pos = hf ? s : co; const float cs = a.cosA[pos * 32 + f], sn = a.sinA[pos * 32 + f];
            bf16_t* dst = hd < 6 ? a.QA + t * 768 + hd * 128 + hf * 64 : a.KA + t * 256 + (hd - 6) * 128 + hf * 64;
            dst[f] = f2bf(x1 * cs - x2 * sn); dst[32 + f] = f2bf(x2 * cs + x1 * sn); } }
#pragma unroll 4
        for (int s = wid; s < 64; s += 8) { const size_t t = t0 + s; const bf16_t* p = a.PROJ + t * PW;
            float q[6]; float ss = 0.f;
#pragma unroll
            for (int i = 0; i < 3; ++i) { const unsigned w = *(const unsigned*)(p + O_BCQ + i * 128 + lane * 2); q[2 * i] = bflo(w); q[2 * i + 1] = bfhi(w); ss += q[2 * i] * q[2 * i] + q[2 * i + 1] * q[2 * i + 1]; }
            ss = wave_sum(ss); float r = rsqrtf(ss * (1.f / 384.f) + EPS);
#pragma unroll
            for (int i = 0; i < 3; ++i) { const int c = i * 128 + lane * 2; *(unsigned*)(a.CQN + t * 384 + c) = cvt_pk_bf16(q[2 * i] * r * a.cq_gain[c], q[2 * i + 1] * r * a.cq_gain[c + 1]); }
            float kv[4]; ss = 0.f;
#pragma unroll
            for (int i = 0; i < 2; ++i) { const unsigned w = *(const unsigned*)(p + O_BCKV + i * 128 + lane * 2); kv[2 * i] = bflo(w); kv[2 * i + 1] = bfhi(w); ss += kv[2 * i] * kv[2 * i] + kv[2 * i + 1] * kv[2 * i + 1]; }
            ss = wave_sum(ss); r = rsqrtf(ss * (1.f / 256.f) + EPS);
#pragma unroll
            for (int i = 0; i < 2; ++i) { const int c = i * 128 + lane * 2; *(unsigned*)(a.CKVN + t * 256 + c) = cvt_pk_bf16(kv[2 * i] * r * a.ckv_gain[c], kv[2 * i + 1] * r * a.ckv_gain[c + 1]); }
            if (lane < 32) { const int f = lane & 15, hf = lane >> 4; const int pos = hf ? s : co; const float cs = a.cosB[pos * 16 + f], sn = a.sinB[pos * 16 + f];
                const float x1 = bf2f(p[O_BKR + hf * 32 + f]), x2 = bf2f(p[O_BKR + hf * 32 + 16 + f]);
                a.KR[t * 64 + hf * 32 + f] = f2bf(x1 * cs - x2 * sn); a.KR[t * 64 + hf * 32 + 16 + f] = f2bf(x2 * cs + x1 * sn); } }
        __syncthreads();
    }
}

__device__ __forceinline__ void scan_phase(const bf16_t* KCT, const float* NLOC, const float* GSC, bf16_t* CPREV, float* NPREV, float* MPREV, int gtid, int nthr) {
    for (int item = gtid; item < 32 * 4096; item += nthr) {
        const int chain = item >> 12, e4 = item & 4095;
        const u32x2* src = (const u32x2*)(KCT + (size_t)chain * 64 * 16384) + e4; u32x2* dst = (u32x2*)(CPREV + (size_t)chain * 64 * 16384) + e4;
        const float* gs = GSC + (size_t)chain * 128;
        const bool don = e4 < 128;
        float c0 = 0.f, c1 = 0.f, c2 = 0.f, c3 = 0.f, nn = 0.f, m = 0.f;
#pragma unroll 1
        for (int cb = 0; cb < 64; cb += 8) {
            u32x2 kc[8]; float nl[8];
#pragma unroll
            for (int j = 0; j < 8; ++j) { kc[j] = src[(size_t)(cb + j) * 4096]; nl[j] = don ? NLOC[((size_t)chain * 64 + cb + j) * 128 + e4] : 0.f; }
#pragma unroll
            for (int j = 0; j < 8; ++j) { const int ci = cb + j; const float g = gs[ci * 2], ml = gs[ci * 2 + 1];
                u32x2 o; o.x = cvt_pk_bf16(c0, c1); o.y = cvt_pk_bf16(c2, c3); dst[(size_t)ci * 4096] = o;
                if (don) NPREV[((size_t)chain * 64 + ci) * 128 + e4] = nn;
                if (e4 == 0) MPREV[chain * 64 + ci] = m;
                const float mn = fmaxf(g + m, ml), dec = __expf(g + m - mn), sl = __expf(ml - mn); m = mn;
                c0 = dec * c0 + sl * bflo(kc[j].x); c1 = dec * c1 + sl * bfhi(kc[j].x); c2 = dec * c2 + sl * bflo(kc[j].y); c3 = dec * c3 + sl * bfhi(kc[j].y);
                nn = dec * nn + sl * nl[j]; }
        }
    }
}

constexpr int MC_K = 0, MC_V = 16384, MC_CT = 32768, MC_HS = 98304, MC_HS_LD = 132, MC_SM = MC_HS + 64 * MC_HS_LD * 4, MC_LDS = MC_SM + 4096;
struct McArgs { const bf16_t* PROJ; const float* GATES; const float* gate_b; const bf16_t* QC; const bf16_t* KC; const bf16_t* CPREV; const float* NPREV; const float* MPREV; const float* hog; bf16_t* YM; };
__device__ __forceinline__ void mlstm_c_phase(FX_LAS unsigned char* lds_, const McArgs& a, int wg, int nwg, int tidp) {
    char* lds = (char*)lds_;
    using C = AttnC<128>;
    float* hs = (float*)(lds + MC_HS);
    float* sm = (float*)(lds + MC_SM);
    for (int unit = wg; unit < NB * 4 * 64; unit += nwg) {
        int tid_ = tidp; asm volatile("" : "+v"(tid_));
        const int tid = tid_, wid = tid >> 6, lane = tid & 63, r32 = lane & 31, hi = lane >> 5;
        const int co = unit & 63, h = (unit >> 6) & 3, b = unit >> 8; const size_t t0 = (size_t)b * S + co * 64;
        if (wid < 2) { const int dir = wid; const int chain = (b * 4 + h) * 2 + dir, ci = dir ? 63 - co : co;
            const float logi = a.GATES[(t0 + lane) * 16 + (dir * 2) * 4 + h] + a.gate_b[(dir * 2) * 4 + h];
            const float logf = logsigmoid_f(a.GATES[(t0 + lane) * 16 + (dir * 2 + 1) * 4 + h] + a.gate_b[(dir * 2 + 1) * 4 + h]);
            const float pre = wave_scan_incl(logf, lane), g = __shfl(pre, 63);
            const float bb = dir ? (g - pre + logf) : pre;
            const float u = logi - bb;
            const float M = dir ? wave_rscanmax_incl(u, lane) : wave_scanmax_incl(u, lane);
            const float mp = a.MPREV[chain * 64 + ci], mmj = fmaxf(mp, M);
            sm[dir * 64 + lane] = u; sm[128 + dir * 64 + lane] = mmj; sm[256 + dir * 64 + lane] = __expf(mp - mmj); sm[384 + dir * 64 + lane] = __expf(-(bb + mmj));
            sm[512 + dir * 128 + lane] = a.NPREV[((size_t)chain * 64 + ci) * 128 + lane]; sm[512 + dir * 128 + 64 + lane] = a.NPREV[((size_t)chain * 64 + ci) * 128 + 64 + lane]; }
        { const int sr = tid >> 4, sc = (tid & 15) * 8;
#pragma unroll
          for (int rr = 0; rr < 2; ++rr) { const int s = sr + 32 * rr;
            *(bf16x8*)(lds + MC_K + FX_KSWZ(s, sc * 2)) = *(const bf16x8*)(a.KC + (t0 + s) * 512 + h * 128 + sc);
            *(bf16x8*)(lds + MC_V + v_st(s, sc)) = *(const bf16x8*)(a.PROJ + (t0 + s) * PW + O_CV + h * 128 + sc); }
#pragma unroll
          for (int dir = 0; dir < 2; ++dir) { const int chain = (b * 4 + h) * 2 + dir, ci = dir ? 63 - co : co; const bf16_t* ct = a.CPREV + ((size_t)chain * 64 + ci) * 16384;
#pragma unroll
            for (int rr = 0; rr < 4; ++rr) { const int v = sr + 32 * rr; *(bf16x8*)(lds + MC_CT + dir * 32768 + FX_KSWZ(v, sc * 2)) = *(const bf16x8*)(ct + v * 128 + sc); } } }
        __syncthreads();
        { const int dir = wid >> 2, rb = (wid >> 1) & 1, cb = wid & 1, j = rb * 32 + r32;
          bf16x8 qr[8];
          const bf16_t* Qw = a.QC + (t0 + j) * 512 + h * 128 + hi * 8;
#pragma unroll
          for (int d0 = 0; d0 < 8; ++d0) qr[d0] = *reinterpret_cast<const bf16x8*>(Qw + d0 * 16);
          f32x16 p0, p1;
          qkt<128>(p0, p1, lds + MC_K, qr, nullptr, r32, hi);
          const float mmj = sm[128 + dir * 64 + j], inter = sm[256 + dir * 64 + j], emn = sm[384 + dir * 64 + j];
          float dsum = 0.f;
#pragma unroll
          for (int r = 0; r < 16; ++r) { const int s0 = crow(r, hi), s1 = 32 + s0;
              const bool v0 = dir ? (s0 >= j) : (s0 <= j), v1 = dir ? (s1 >= j) : (s1 <= j);
              const float w0 = v0 ? __expf(sm[dir * 64 + s0] - mmj) : 0.f, w1 = v1 ? __expf(sm[dir * 64 + s1] - mmj) : 0.f;
              p0[r] *= w0; p1[r] *= w1; dsum += p0[r] + p1[r]; }
          float qn = 0.f;
#pragma unroll
          for (int d0 = 0; d0 < 8; ++d0) { const float* np = sm + 512 + dir * 128 + d0 * 16 + hi * 8; const u32x4 w = *reinterpret_cast<const u32x4*>(&qr[d0]);
              qn += bflo(w.x) * np[0] + bfhi(w.x) * np[1] + bflo(w.y) * np[2] + bfhi(w.y) * np[3] + bflo(w.z) * np[4] + bfhi(w.z) * np[5] + bflo(w.w) * np[6] + bfhi(w.w) * np[7]; }
          { auto rr = __builtin_amdgcn_permlane32_swap(__float_as_uint(dsum), __float_as_uint(dsum), false, false); dsum = __uint_as_float(rr[0]) + __uint_as_float(rr[1]); }
          { auto rr = __builtin_amdgcn_permlane32_swap(__float_as_uint(qn), __float_as_uint(qn), false, false); qn = __uint_as_float(rr[0]) + __uint_as_float(rr[1]); }
          const float den = dsum + inter * qn;
          if (hi == 0) sm[768 + wid * 32 + r32] = 1.f / fmaxf(fabsf(den), emn);
          bf16x8 pa0, pa1, pa2, pa3;
          FX_PK4(p0, 0, pa0); FX_PK4(p0, 8, pa1); FX_PK4(p1, 0, pa2); FX_PK4(p1, 8, pa3);
          f32x16 o[2] = {};
          const int vb = (int)(uintptr_t)(lds + MC_V) + v_rd_base(lane) + cb * 1024;
          pv_one<0>(o[0], vb, pa0, pa1, pa2, pa3); pv_one<1>(o[1], vb, pa0, pa1, pa2, pa3);
          const char* ctb = lds + MC_CT + dir * 32768;
#pragma unroll
          for (int ks = 0; ks < 8; ++ks) { const u32x4 w = *reinterpret_cast<const u32x4*>(&qr[ks]); u32x4 sq;
              sq.x = cvt_pk_bf16(bflo(w.x) * inter, bfhi(w.x) * inter); sq.y = cvt_pk_bf16(bflo(w.y) * inter, bfhi(w.y) * inter); sq.z = cvt_pk_bf16(bflo(w.z) * inter, bfhi(w.z) * inter); sq.w = cvt_pk_bf16(bflo(w.w) * inter, bfhi(w.w) * inter);
              const bf16x8 qs = *reinterpret_cast<const bf16x8*>(&sq); const int colB = (ks * 16 + hi * 8) * 2;
              const bf16x8 c0f = *reinterpret_cast<const bf16x8*>(ctb + FX_KSWZ((2 * cb) * 32 + r32, colB));
              const bf16x8 c1f = *reinterpret_cast<const bf16x8*>(ctb + FX_KSWZ((2 * cb + 1) * 32 + r32, colB));
              o[0] = __builtin_amdgcn_mfma_f32_32x32x16_bf16(qs, c0f, o[0], 0, 0, 0);
              o[1] = __builtin_amdgcn_mfma_f32_32x32x16_bf16(qs, c1f, o[1], 0, 0, 0); }
          asm volatile("s_waitcnt lgkmcnt(0)" ::: "memory");
          float rd[16];
#pragma unroll
          for (int r = 0; r < 16; ++r) rd[r] = sm[768 + wid * 32 + crow(r, hi)];
          if (dir == 0) {
#pragma unroll
              for (int r = 0; r < 16; ++r) { const int row = rb * 32 + crow(r, hi);
                  hs[row * MC_HS_LD + (2 * cb) * 32 + r32] = o[0][r] * rd[r]; hs[row * MC_HS_LD + (2 * cb + 1) * 32 + r32] = o[1][r] * rd[r]; } }
          __syncthreads();
          if (dir == 1) {
#pragma unroll
              for (int r = 0; r < 16; ++r) { const int row = rb * 32 + crow(r, hi);
                  hs[row * MC_HS_LD + (2 * cb) * 32 + r32] += o[0][r] * rd[r]; hs[row * MC_HS_LD + (2 * cb + 1) * 32 + r32] += o[1][r] * rd[r]; } }
          __syncthreads(); }
        { const int row = tid >> 3, c0 = (tid & 7) * 16; const size_t t = t0 + row;
          float v[16]; float ss = 0.f;
#pragma unroll
          for (int i = 0; i < 16; ++i) { v[i] = hs[row * MC_HS_LD + c0 + i]; ss += v[i] * v[i]; }
          ss += __shfl_xor(ss, 1); ss += __shfl_xor(ss, 2); ss += __shfl_xor(ss, 4);
          const float rn = rsqrtf(ss * (1.f / 128.f) + EPS);
          const bf16_t* og = a.PROJ + t * PW + O_CO + h * 128 + c0; const float* gn = a.hog + 1536 + h * 128 + c0;
          const u32x4 g0 = *(const u32x4*)og, g1 = *(const u32x4*)(og + 8);
          const float gg[16] = {bflo(g0.x), bfhi(g0.x), bflo(g0.y), bfhi(g0.y), bflo(g0.z), bfhi(g0.z), bflo(g0.w), bfhi(g0.w), bflo(g1.x), bfhi(g1.x), bflo(g1.y), bfhi(g1.y), bflo(g1.z), bfhi(g1.z), bflo(g1.w), bfhi(g1.w)};
          float ov[16];
#pragma unroll
          for (int i = 0; i < 16; ++i) ov[i] = v[i] * rn * gn[i] * sigmoid_f(gg[i]);
          u32x4 w0, w1; w0.x = cvt_pk_bf16(ov[0], ov[1]); w0.y = cvt_pk_bf16(ov[2], ov[3]); w0.z = cvt_pk_bf16(ov[4], ov[5]); w0.w = cvt_pk_bf16(ov[6], ov[7]);
          w1.x = cvt_pk_bf16(ov[8], ov[9]); w1.y = cvt_pk_bf16(ov[10], ov[11]); w1.z = cvt_pk_bf16(ov[12], ov[13]); w1.w = cvt_pk_bf16(ov[14], ov[15]);
#ifdef FX_WOUT8
          { u32x4 w8; w8.x = cvt_pk4_fp8(ov[0], ov[1], ov[2], ov[3]); w8.y = cvt_pk4_fp8(ov[4], ov[5], ov[6], ov[7]); w8.z = cvt_pk4_fp8(ov[8], ov[9], ov[10], ov[11]); w8.w = cvt_pk4_fp8(ov[12], ov[13], ov[14], ov[15]);
            *(u32x4*)((unsigned char*)a.YM + t * 2048 + 1536 + h * 128 + c0) = w8; (void)w0; (void)w1; } }
#else
          bf16_t* dst = a.YM + t * 2048 + 1536 + h * 128 + c0; *(u32x4*)dst = w0; *(u32x4*)(dst + 8) = w1; }
#endif
        __syncthreads();
    }
}
}
namespace fx {
struct EpiQB {
    static constexpr bool PERM = false;
    bf16_t* O; const float* cosB; const float* sinB;
    __device__ __forceinline__ void operator()(const f32x4 (&acc)[2][2][4][2], const Unit& u, int wr, int wc, int fr, int fq) const {
        const int row0 = u.pm * BM + wr * 64 + fr;
#pragma unroll
        for (int bj = 0; bj < 2; ++bj) { const int G = 8 * u.pn + 4 * bj + wc, gm = G % 6; const int col0 = G * 32 + 4 * fq;
#pragma unroll
            for (int ai = 0; ai < 2; ++ai)
#pragma unroll
                for (int m = 0; m < 4; ++m) { const int row = row0 + ai * HALF + m * 16; f32x4 x1 = acc[ai][bj][m][0], x2 = acc[ai][bj][m][1];
                    if (gm >= 4) { const int s = row & (S - 1), pos = gm == 4 ? (s >> 6) : (s & 63);
                        const f32x4 cs = *(const f32x4*)(cosB + pos * 16 + 4 * fq), sn = *(const f32x4*)(sinB + pos * 16 + 4 * fq);
                        const f32x4 o1 = x1 * cs - x2 * sn, o2 = x2 * cs + x1 * sn; x1 = o1; x2 = o2; }
                    bf16_t* rp = O + (size_t)row * 1280 + col0;
                    u32x2 w0, w1; w0.x = cvt_pk_bf16(x1[0], x1[1]); w0.y = cvt_pk_bf16(x1[2], x1[3]); w1.x = cvt_pk_bf16(x2[0], x2[1]); w1.y = cvt_pk_bf16(x2[2], x2[3]);
                    *(u32x2*)rp = w0; *(u32x2*)(rp + 16) = w1; } }
    }
};
constexpr size_t al256(size_t x) { return (x + 255) & ~(size_t)255; }
constexpr size_t WS_BAR = 0;
constexpr size_t WS_MOD = 16384;
constexpr size_t WS_COEF = WS_MOD + al256(2ull * 4 * 12288 * 4);
constexpr size_t WS_TAB = WS_COEF + al256(2ull * 4 * 6 * 2048 * 4);
constexpr size_t WS_CNT = WS_TAB + al256(6144 * 4);
constexpr size_t WS_WGBASE = WS_CNT + 512;
constexpr size_t WS_SELE = WS_WGBASE + 256 * 64 * 4;
constexpr size_t WS_SELG = WS_SELE + (size_t)T * 6 * 4;
constexpr size_t WS_SLOT = WS_SELG + (size_t)T * 6 * 4;
constexpr size_t WS_ROWTOK = WS_SLOT + (size_t)T * 6 * 4;
constexpr size_t WS_ROWG = WS_ROWTOK + (size_t)PTOT * 4;
constexpr size_t WS_GATES = WS_ROWG + (size_t)PTOT * 4;
constexpr size_t WS_GSC = WS_GATES + (size_t)T * 16 * 4;
constexpr size_t WS_MPREV = WS_GSC + 2048 * 2 * 4;
constexpr size_t WS_NLOC = WS_MPREV + 2048 * 4;
constexpr size_t WS_NPREV = WS_NLOC + 2048ull * 128 * 4;
constexpr size_t WS_W = al256(WS_NPREV + 2048ull * 128 * 4);
constexpr size_t W_IN = 0, W_UQ = W_IN + 4096ull * 2048 * 2, W_UKV = W_UQ + 1280ull * 384 * 2, W_OUT = W_UKV + 1536ull * 256 * 2, W_GU = W_OUT + 2048ull * 2048 * 2, W_DN = W_GU + 65ull * 1024 * 2048 * 2, W_LAYER = W_DN + 65ull * 2048 * 512 * 2;
constexpr size_t WS_XRES = WS_W + 2 * W_LAYER;
constexpr size_t WS_HA = WS_XRES + (size_t)T * 2048 * 4;
constexpr size_t WS_R1 = WS_HA + (size_t)T * 2048 * 2;
constexpr size_t WS_R2 = WS_R1 + (size_t)T * 4096 * 2;
constexpr size_t R2_QA = 0, R2_KA = R2_QA + (size_t)T * 768 * 2, R2_CQN = R2_KA + (size_t)T * 256 * 2, R2_CKVN = R2_CQN + (size_t)T * 384 * 2, R2_KR = R2_CKVN + (size_t)T * 256 * 2,
                 R2_QB = R2_KR + (size_t)T * 64 * 2, R2_KVB = R2_QB + (size_t)T * 1280 * 2, R2_QC = R2_KVB + (size_t)T * 1536 * 2, R2_KC = R2_QC + (size_t)T * 512 * 2,
                 R2_KCT = R2_KC + (size_t)T * 512 * 2, R2_CPREV = R2_KCT + 2048ull * 16384 * 2, R2_END = R2_CPREV + 2048ull * 16384 * 2;
constexpr size_t WS_END = WS_R2 + (size_t)PTOT * 2048 * 2;
static_assert(R2_END <= (size_t)PTOT * 2048 * 2, "R2 overflow");
static_assert(WS_END <= 2147483648ull, "workspace too large");
}
namespace fx {
struct CvtW { const float* w_in; const float* w_uq; const float* w_ukv; const float* w_out; const float* eg; const float* eu; const float* ed; const float* sg; const float* su; const float* sd; bf16_t* W; };
__device__ __forceinline__ void cvt_layer(const CvtW& a, FX_LAS unsigned* my, int gwave, int nwaves, int& rot) {
    const int BIG = 1 << 30; bf16_t* W = a.W;
    bf16_t* WIN = W + W_IN / 2; bf16_t* WUQ = W + W_UQ / 2; bf16_t* WUKV = W + W_UKV / 2; bf16_t* WOUT = W + W_OUT / 2; bf16_t* WGU = W + W_GU / 2; bf16_t* WDN = W + W_DN / 2;
#ifdef FX_WIN8
    { CvtSeg s; s.src = a.w_in; s.dst = WIN; s.sstride = 0; s.dstride = 0; s.ld = 4048; s.nsrc = 4048; s.K = 2048; s.ntn = 64; s.nbatch = 1; s.G = BIG; s.GS = 0; s.off = 0; cvt_seg8(s, my, gwave, nwaves, rot, W8_SCALE); }
#else
    { CvtSeg s; s.src = a.w_in; s.dst = WIN; s.sstride = 0; s.dstride = 0; s.ld = 4048; s.nsrc = 4048; s.K = 2048; s.ntn = 64; s.nbatch = 1; s.G = BIG; s.GS = 0; s.off = 0; cvt_seg(s, my, gwave, nwaves, rot); }
#endif
    { CvtSeg s; s.src = a.w_uq; s.dst = WUQ; s.sstride = 0; s.dstride = 0; s.ld = 1152; s.nsrc = 1152; s.K = 384; s.ntn = 20; s.nbatch = 1; s.G = BIG; s.GS = 0; s.off = 0; cvt_seg(s, my, gwave, nwaves, rot); }
    { CvtSeg s; s.src = a.w_ukv; s.dst = WUKV; s.sstride = 0; s.dstride = 0; s.ld = 1536; s.nsrc = 1536; s.K = 256; s.ntn = 24; s.nbatch = 1; s.G = BIG; s.GS = 0; s.off = 0; cvt_seg(s, my, gwave, nwaves, rot); }
#ifdef FX_WOUT8
    { CvtSeg s; s.src = a.w_out; s.dst = WOUT; s.sstride = 0; s.dstride = 0; s.ld = 2048; s.nsrc = 2048; s.K = 2048; s.ntn = 32; s.nbatch = 1; s.G = BIG; s.GS = 0; s.off = 0; cvt_seg8(s, my, gwave, nwaves, rot, W8_SCALE); }
#else
    { CvtSeg s; s.src = a.w_out; s.dst = WOUT; s.sstride = 0; s.dstride = 0; s.ld = 2048; s.nsrc = 2048; s.K = 2048; s.ntn = 32; s.nbatch = 1; s.G = BIG; s.GS = 0; s.off = 0; cvt_seg(s, my, gwave, nwaves, rot); }
#endif
    { CvtSeg s; s.src = a.eg; s.dst = WGU; s.sstride = 2048ll * 512; s.dstride = 1024ll * 2048; s.ld = 512; s.nsrc = 512; s.K = 2048; s.ntn = 8; s.nbatch = 64; s.G = 128; s.GS = 256; s.off = 0; cvt_seg8(s, my, gwave, nwaves, rot, W8_SCALE); }
    { CvtSeg s; s.src = a.eu; s.dst = WGU; s.sstride = 2048ll * 512; s.dstride = 1024ll * 2048; s.ld = 512; s.nsrc = 512; s.K = 2048; s.ntn = 8; s.nbatch = 64; s.G = 128; s.GS = 256; s.off = 128; cvt_seg8(s, my, gwave, nwaves, rot, W8_SCALE); }
    { CvtSeg s; s.src = a.ed; s.dst = WDN; s.sstride = 512ll * 2048; s.dstride = 2048ll * 512; s.ld = 2048; s.nsrc = 2048; s.K = 512; s.ntn = 32; s.nbatch = 64; s.G = BIG; s.GS = 0; s.off = 0; cvt_seg8(s, my, gwave, nwaves, rot, W8_SCALE); }
    { CvtSeg s; s.src = a.sg; s.dst = (bf16_t*)((unsigned char*)WGU + 64ull * 1024 * 2048); s.sstride = 0; s.dstride = 0; s.ld = 512; s.nsrc = 512; s.K = 2048; s.ntn = 8; s.nbatch = 1; s.G = 128; s.GS = 256; s.off = 0; cvt_seg8(s, my, gwave, nwaves, rot, W8_SCALE); }
    { CvtSeg s; s.src = a.su; s.dst = (bf16_t*)((unsigned char*)WGU + 64ull * 1024 * 2048); s.sstride = 0; s.dstride = 0; s.ld = 512; s.nsrc = 512; s.K = 2048; s.ntn = 8; s.nbatch = 1; s.G = 128; s.GS = 256; s.off = 128; cvt_seg8(s, my, gwave, nwaves, rot, W8_SCALE); }
    { CvtSeg s; s.src = a.sd; s.dst = (bf16_t*)((unsigned char*)WDN + 64ull * 2048 * 512); s.sstride = 0; s.dstride = 0; s.ld = 2048; s.nsrc = 2048; s.K = 512; s.ntn = 32; s.nbatch = 1; s.G = BIG; s.GS = 0; s.off = 0; cvt_seg8(s, my, gwave, nwaves, rot, W8_SCALE); }
}
constexpr int CVT_TILES_PER_LAYER = 2048 + 120 + 96 + 1024 + 3 * 16384 + 3 * 256;
__device__ __forceinline__ void cvt_layer_one(const CvtW& a, FX_LAS unsigned* my, int g) {
    int base = 0;
    const int BIG = 1 << 30; bf16_t* W = a.W;
    bf16_t* WIN = W + W_IN / 2; bf16_t* WUQ = W + W_UQ / 2; bf16_t* WUKV = W + W_UKV / 2; bf16_t* WOUT = W + W_OUT / 2; bf16_t* WGU = W + W_GU / 2; bf16_t* WDN = W + W_DN / 2;
#ifdef FX_WIN8
    { CvtSeg s; s.src = a.w_in; s.dst = WIN; s.sstride = 0; s.dstride = 0; s.ld = 4048; s.nsrc = 4048; s.K = 2048; s.ntn = 64; s.nbatch = 1; s.G = BIG; s.GS = 0; s.off = 0; { const int cnt_ = (s.K / 64) * s.ntn * s.nbatch; if (g >= base && g < base + cnt_) cvt_tile8(s, my, g - base, W8_SCALE); base += cnt_; } }
#else
    { CvtSeg s; s.src = a.w_in; s.dst = WIN; s.sstride = 0; s.dstride = 0; s.ld = 4048; s.nsrc = 4048; s.K = 2048; s.ntn = 64; s.nbatch = 1; s.G = BIG; s.GS = 0; s.off = 0; { const int cnt_ = (s.K / 64) * s.ntn * s.nbatch; if (g >= base && g < base + cnt_) cvt_tile(s, my, g - base); base += cnt_; } }
#endif
    { CvtSeg s; s.src = a.w_uq; s.dst = WUQ; s.sstride = 0; s.dstride = 0; s.ld = 1152; s.nsrc = 1152; s.K = 384; s.ntn = 20; s.nbatch = 1; s.G = BIG; s.GS = 0; s.off = 0; { const int cnt_ = (s.K / 64) * s.ntn * s.nbatch; if (g >= base && g < base + cnt_) cvt_tile(s, my, g - base); base += cnt_; } }
    { CvtSeg s; s.src = a.w_ukv; s.dst = WUKV; s.sstride = 0; s.dstride = 0; s.ld = 1536; s.nsrc = 1536; s.K = 256; s.ntn = 24; s.nbatch = 1; s.G = BIG; s.GS = 0; s.off = 0; { const int cnt_ = (s.K / 64) * s.ntn * s.nbatch; if (g >= base && g < base + cnt_) cvt_tile(s, my, g - base); base += cnt_; } }
#ifdef FX_WOUT8
    { CvtSeg s; s.src = a.w_out; s.dst = WOUT; s.sstride = 0; s.dstride = 0; s.ld = 2048; s.nsrc = 2048; s.K = 2048; s.ntn = 32; s.nbatch = 1; s.G = BIG; s.GS = 0; s.off = 0; { const int cnt_ = (s.K / 64) * s.ntn * s.nbatch; if (g >= base && g < base + cnt_) cvt_tile8(s, my, g - base, W8_SCALE); base += cnt_; } }
#else
    { CvtSeg s; s.src = a.w_out; s.dst = WOUT; s.sstride = 0; s.dstride = 0; s.ld = 2048; s.nsrc = 2048; s.K = 2048; s.ntn = 32; s.nbatch = 1; s.G = BIG; s.GS = 0; s.off = 0; { const int cnt_ = (s.K / 64) * s.ntn * s.nbatch; if (g >= base && g < base + cnt_) cvt_tile(s, my, g - base); base += cnt_; } }
#endif
    { CvtSeg s; s.src = a.eg; s.dst = WGU; s.sstride = 2048ll * 512; s.dstride = 1024ll * 2048; s.ld = 512; s.nsrc = 512; s.K = 2048; s.ntn = 8; s.nbatch = 64; s.G = 128; s.GS = 256; s.off = 0; { const int cnt_ = (s.K / 64) * s.ntn * s.nbatch; if (g >= base && g < base + cnt_) cvt_tile8(s, my, g - base, W8_SCALE); base += cnt_; } }
    { CvtSeg s; s.src = a.eu; s.dst = WGU; s.sstride = 2048ll * 512; s.dstride = 1024ll * 2048; s.ld = 512; s.nsrc = 512; s.K = 2048; s.ntn = 8; s.nbatch = 64; s.G = 128; s.GS = 256; s.off = 128; { const int cnt_ = (s.K / 64) * s.ntn * s.nbatch; if (g >= base && g < base + cnt_) cvt_tile8(s, my, g - base, W8_SCALE); base += cnt_; } }
    { CvtSeg s; s.src = a.ed; s.dst = WDN; s.sstride = 512ll * 2048; s.dstride = 2048ll * 512; s.ld = 2048; s.nsrc = 2048; s.K = 512; s.ntn = 32; s.nbatch = 64; s.G = BIG; s.GS = 0; s.off = 0; { const int cnt_ = (s.K / 64) * s.ntn * s.nbatch; if (g >= base && g < base + cnt_) cvt_tile8(s, my, g - base, W8_SCALE); base += cnt_; } }
    { CvtSeg s; s.src = a.sg; s.dst = (bf16_t*)((unsigned char*)WGU + 64ull * 1024 * 2048); s.sstride = 0; s.dstride = 0; s.ld = 512; s.nsrc = 512; s.K = 2048; s.ntn = 8; s.nbatch = 1; s.G = 128; s.GS = 256; s.off = 0; { const int cnt_ = (s.K / 64) * s.ntn * s.nbatch; if (g >= base && g < base + cnt_) cvt_tile8(s, my, g - base, W8_SCALE); base += cnt_; } }
    { CvtSeg s; s.src = a.su; s.dst = (bf16_t*)((unsigned char*)WGU + 64ull * 1024 * 2048); s.sstride = 0; s.dstride = 0; s.ld = 512; s.nsrc = 512; s.K = 2048; s.ntn = 8; s.nbatch = 1; s.G = 128; s.GS = 256; s.off = 128; { const int cnt_ = (s.K / 64) * s.ntn * s.nbatch; if (g >= base && g < base + cnt_) cvt_tile8(s, my, g - base, W8_SCALE); base += cnt_; } }
    { CvtSeg s; s.src = a.sd; s.dst = (bf16_t*)((unsigned char*)WDN + 64ull * 2048 * 512); s.sstride = 0; s.dstride = 0; s.ld = 2048; s.nsrc = 2048; s.K = 512; s.ntn = 32; s.nbatch = 1; s.G = BIG; s.GS = 0; s.off = 0; { const int cnt_ = (s.K / 64) * s.ntn * s.nbatch; if (g >= base && g < base + cnt_) cvt_tile8(s, my, g - base, W8_SCALE); base += cnt_; } }
}
}
namespace fx {
#define XB_TMO      128
#define XB_XCNT(j)  (256  + 64 * (j))
#define XB_XSUB(j)  (1280 + 64 * (j))
#define XB_XGEN(j)  (2304 + 64 * (j))
#define XB_TOP      3328
#define XB_TOPGEN   3392
#define XCD_BAR_WORDS 3456
#define XB_SPIN_CAP (1u << 22)
__device__ __forceinline__ unsigned xb_ld(unsigned* p)              { return __hip_atomic_load(p, __ATOMIC_RELAXED, __HIP_MEMORY_SCOPE_AGENT); }
__device__ __forceinline__ unsigned xb_add(unsigned* p, unsigned v) { return __hip_atomic_fetch_add(p, v, __ATOMIC_RELAXED, __HIP_MEMORY_SCOPE_AGENT); }
__device__ __forceinline__ unsigned xb_xcc_id() { return (unsigned)__builtin_amdgcn_s_getreg((3 << 11) | 20) & 0xFu; }
#define XB_SPIN(cond, bar) do { unsigned _sp = 0; while (cond) { __builtin_amdgcn_s_sleep(1); \
    if ((++_sp & 255u) == 0u) { if (xb_ld(&(bar)[XB_TMO])) break; if (_sp > XB_SPIN_CAP) { atomicAdd(&(bar)[XB_TMO], 1u); break; } } } } while (0)
struct XcdBarrier { unsigned* bar; unsigned x; volatile FX_LAS unsigned* st; };
__device__ __forceinline__ XcdBarrier xcd_barrier_post(unsigned* bar, volatile FX_LAS unsigned* st, int tidp) {
    XcdBarrier b; b.bar = bar; b.x = xb_xcc_id(); b.st = st;
    if (tidp == 0) (void)xb_add(&bar[XB_XCNT(b.x)], 1u);
    return b;
}
__device__ __forceinline__ void xcd_barrier_complete(unsigned* bar, unsigned x, unsigned& nloc, unsigned& nx) {
    const unsigned G = gridDim.x * gridDim.y * gridDim.z;
    unsigned sum, cnt, mine, sp = 0u;
    for (;;) {
        sum = 0u; cnt = 0u; mine = 0u;
#pragma unroll
        for (unsigned j = 0; j < 16; ++j) { const unsigned c = xb_ld(&bar[XB_XCNT(j)]); sum += c; cnt += (c > 0u) ? 1u : 0u; mine = (j == x) ? c : mine; }
        if (sum == G) break;
        __builtin_amdgcn_s_sleep(1);
        if ((++sp & 255u) == 0u) { if (xb_ld(&bar[XB_TMO])) break; if (sp > XB_SPIN_CAP) { atomicAdd(&bar[XB_TMO], 1u); break; } }
    }
    nloc = mine > 0u ? mine : 1u; nx = cnt > 0u ? cnt : 1u;
}
__device__ __forceinline__ void xcd_barrier(const XcdBarrier& b, int tidp) {
    asm volatile("s_waitcnt vmcnt(0)" ::: "memory");
    __syncthreads();
    if (tidp == 0) {
        unsigned* bar = b.bar;
        __builtin_amdgcn_s_waitcnt(0);
        unsigned nloc = b.st[0], nx = b.st[1];
        if (nloc == 0u) { xcd_barrier_complete(bar, b.x, nloc, nx); b.st[0] = nloc; b.st[1] = nx; }
        const unsigned old = xb_add(&bar[XB_XSUB(b.x)], 1u);
        const unsigned gen = old / nloc;
        if (old + 1u == (gen + 1u) * nloc) {
            __builtin_amdgcn_fence(__ATOMIC_RELEASE, "agent");
            asm volatile("s_waitcnt vmcnt(0)" ::: "memory");
            const unsigned og = xb_add(&bar[XB_TOP], 1u);
            const unsigned tg = og / nx;
            if (og + 1u == (tg + 1u) * nx) xb_add(&bar[XB_TOPGEN], 1u);
            else XB_SPIN(xb_ld(&bar[XB_TOPGEN]) == tg, bar);
            __builtin_amdgcn_fence(__ATOMIC_ACQUIRE, "agent");
            xb_add(&bar[XB_XGEN(b.x)], 1u);
            asm volatile("s_waitcnt vmcnt(0)" ::: "memory");
        } else {
            XB_SPIN(xb_ld(&bar[XB_XGEN(b.x)]) == gen, bar);
            __builtin_amdgcn_fence(__ATOMIC_ACQUIRE, "agent");
            asm volatile("s_waitcnt vmcnt(0)" ::: "memory");
        }
    }
    __syncthreads();
}

__device__ __forceinline__ void modp_phase(FX_LAS unsigned char* lds_, const float* c, const float* ada_w, float* MODP, int wg, int nwg, int tidp) {
    float* cact = (float*)(char*)lds_;
    for (int i = tidp; i < 8192; i += 512) { const float v = c[i]; cact[i] = v / (1.f + expf(-v)); }
    __syncthreads();
    int tid_ = tidp; asm volatile("" : "+v"(tid_));
    const int wid = tid_ >> 6, lane = tid_ & 63;
    for (int u = wg * 8 + wid; u < 2 * 48 * 32; u += nwg * 8) {
        const int kc = u & 31, nc = (u >> 5) % 48, l = u / (48 * 32);
        const float* w = ada_w + (size_t)l * 2048 * 12288 + (size_t)(kc * 64) * 12288 + nc * 256 + lane * 4;
        f32x4 a0 = {0.f, 0.f, 0.f, 0.f}, a1 = a0, a2 = a0, a3 = a0;
#pragma unroll 8
        for (int k = 0; k < 64; ++k) { const f32x4 wv = *(const f32x4*)(w + (size_t)k * 12288); const int kk = kc * 64 + k;
            a0 += wv * cact[kk]; a1 += wv * cact[2048 + kk]; a2 += wv * cact[4096 + kk]; a3 += wv * cact[6144 + kk]; }
        float* dst = MODP + (((size_t)l * 32 + kc) * 4) * 12288 + nc * 256 + lane * 4;
        *(f32x4*)dst = a0; *(f32x4*)(dst + 12288) = a1; *(f32x4*)(dst + 2 * 12288) = a2; *(f32x4*)(dst + 3 * 12288) = a3;
    }
    __syncthreads();
}
__device__ __forceinline__ void tab_phase(float* tab, int gtid) {
    if (gtid < 2048) { const int p = gtid >> 5, f = gtid & 31; const float inv = powf(10000.f, -(float)(2 * f) / 64.f); const float a = (float)p * inv; tab[gtid] = cosf(a); tab[2048 + gtid] = sinf(a); }
    else if (gtid < 3072) { const int i = gtid - 2048, p = i >> 4, f = i & 15; const float inv = powf(10000.f, -(float)(2 * f) / 32.f); const float a = (float)p * inv; tab[4096 + i] = cosf(a); tab[5120 + i] = sinf(a); }
}
__device__ __forceinline__ void coef2_phase(const float* MODP, const float* ada_b, const float* pre_mix_gain, const float* post_mix_gain, const float* pre_ffn_gain, const float* post_ffn_gain, float* coef, int gtid, int nthr) {
    for (int i = gtid; i < 2 * 4 * 2048; i += nthr) { const int d = i & 2047, b = (i >> 11) & 3, l = i >> 13;
        float m[6];
#pragma unroll
        for (int j = 0; j < 6; ++j) { float s = ada_b[l * 12288 + j * 2048 + d];
            for (int kc = 0; kc < 32; ++kc) s += MODP[(((size_t)l * 32 + kc) * 4 + b) * 12288 + j * 2048 + d];
            m[j] = s; }
        float* c = coef + ((size_t)l * 4 + b) * 6 * 2048;
        c[0 * 2048 + d] = m[2] * post_mix_gain[l * 2048 + d];
        c[1 * 2048 + d] = pre_ffn_gain[l * 2048 + d] * (1.f + m[4]);
        c[2 * 2048 + d] = m[3];
        c[3 * 2048 + d] = m[5] * post_ffn_gain[l * 2048 + d];
        c[4 * 2048 + d] = pre_mix_gain[l * 2048 + d] * (1.f + m[1]);
        c[5 * 2048 + d] = m[0]; }
}
__device__ __forceinline__ void prenorm_phase(const float* x, const float* coef_l, bf16_t* HA, int wg, int nwg, int tidp) {
    int tid_ = tidp; asm volatile("" : "+v"(tid_));
    const int wid = tid_ >> 6, lane = tid_ & 63;
    for (int t = wg * 8 + wid; t < T; t += nwg * 8) {
        const float* cn = coef_l + (size_t)(t / S) * 6 * 2048;
        float xv[32]; float ss = 0.f;
#pragma unroll
        for (int i = 0; i < 4; ++i) { const int c = i * 512 + lane * 8; const f32x4 x0 = *(const f32x4*)(x + (size_t)t * 2048 + c), x1 = *(const f32x4*)(x + (size_t)t * 2048 + c + 4);
#pragma unroll
            for (int j = 0; j < 4; ++j) { xv[i * 8 + j] = x0[j]; xv[i * 8 + 4 + j] = x1[j]; ss += x0[j] * x0[j] + x1[j] * x1[j]; } }
        ss = wave_sum(ss); const float rx = rsqrtf(ss * (1.f / 2048.f) + EPS);
#pragma unroll
        for (int i = 0; i < 4; ++i) { const int c = i * 512 + lane * 8;
            const f32x4 e0 = *(const f32x4*)(cn + 4 * 2048 + c), e1 = *(const f32x4*)(cn + 4 * 2048 + c + 4), f0 = *(const f32x4*)(cn + 5 * 2048 + c), f1 = *(const f32x4*)(cn + 5 * 2048 + c + 4);
            float hv[8];
#pragma unroll
            for (int j = 0; j < 4; ++j) { hv[j] = xv[i * 8 + j] * rx * e0[j] + f0[j]; hv[4 + j] = xv[i * 8 + 4 + j] * rx * e1[j] + f1[j]; }
#ifdef FX_WIN8
            u32x2 w; w.x = cvt_pk4_fp8(hv[0], hv[1], hv[2], hv[3]); w.y = cvt_pk4_fp8(hv[4], hv[5], hv[6], hv[7]);
            *(u32x2*)((unsigned char*)HA + (size_t)t * 2048 + c) = w; }
#else
            u32x4 w; w.x = cvt_pk_bf16(hv[0], hv[1]); w.y = cvt_pk_bf16(hv[2], hv[3]); w.z = cvt_pk_bf16(hv[4], hv[5]); w.w = cvt_pk_bf16(hv[6], hv[7]);
            *(u32x4*)(HA + (size_t)t * 2048 + c) = w; }
#endif
    }
}

constexpr int LDS_ST = 139264, LDS_TOTAL = LDS_ST + 64;
constexpr size_t WS_MODP = WS_R2;
struct MP {
    const float* x; const float* c; const float* ada_w; const float* ada_b; const float* pre_mix_gain; const float* w_in; const float* a_q_gain; const float* a_k_gain;
    const float* b_cq_gain; const float* b_ckv_gain; const float* w_uq; const float* w_ukv; const float* c_conv_w; const float* c_conv_b; const float* c_gate_b;
    const float* head_out_gain; const float* w_out; const float* post_mix_gain; const float* pre_ffn_gain; const float* router_w; const float* router_bias;
    const float* exp_w_gate; const float* exp_w_up; const float* exp_w_down; const float* sh_w_gate; const float* sh_w_up; const float* sh_w_down; const float* post_ffn_gain;
    char* ws; float* out;
};
#ifndef FX_NPHASE
#define FX_NPHASE 1000
#endif
#define PH_BEGIN const MP* pk = (const MP*)__builtin_amdgcn_kernarg_segment_ptr(); asm volatile("" : "+s"(pk)); char* ws = pk->ws; (void)ws; int gt_ = wid_s * 64 + fx_lane(); asm volatile("" : "+v"(gt_)); int wg_ = blockIdx.x, nwg_ = gridDim.x; asm volatile("" : "+s"(wg_), "+s"(nwg_)); const int wg = wg_, nwg = nwg_; (void)wg; (void)nwg; (void)gt_;
#define PH_BAR do { PH_BEGIN XcdBarrier b_; b_.bar = (unsigned*)(ws + WS_BAR); b_.x = xb_xcc_id(); b_.st = (volatile FX_LAS unsigned*)(lds + LDS_ST); xcd_barrier(b_, gt_); } while (0)
#define WSP(T_, off) ((T_*)(ws + (off)))
constexpr int QW_CNT = 3584;
constexpr unsigned HV_SLACK = 24;
__device__ __forceinline__ void harvest(FX_LAS unsigned char* lds, const MP* pk, char* ws, int tid, const unsigned nbar, const bool drain) {
    volatile FX_LAS unsigned* bw = (volatile FX_LAS unsigned*)(lds + LDS_ST);
    unsigned* bar = (unsigned*)(ws + WS_BAR);
    const int wave = tid >> 6; FX_LAS unsigned* my = (FX_LAS unsigned*)(lds) + wave * (64 * 33);
    CvtW a; a.w_in = pk->w_in + (size_t)D * 4048; a.w_uq = pk->w_uq + (size_t)384 * 1152; a.w_ukv = pk->w_ukv + (size_t)256 * 1536; a.w_out = pk->w_out + (size_t)D * D;
    a.eg = pk->exp_w_gate + (size_t)NE * D * FF; a.eu = pk->exp_w_up + (size_t)NE * D * FF; a.ed = pk->exp_w_down + (size_t)NE * FF * D;
    a.sg = pk->sh_w_gate + (size_t)D * FF; a.su = pk->sh_w_up + (size_t)D * FF; a.sd = pk->sh_w_down + (size_t)FF * D; a.W = (bf16_t*)(ws + WS_W + W_LAYER);
    __syncthreads();
    if (drain) {
        if (tid == 0) bw[3] = xb_ld(&bar[QW_CNT]);
        __syncthreads();
        const unsigned h = bw[3];
#pragma unroll 1
        for (unsigned g = h + (unsigned)(blockIdx.x * 8 + wave); g < (unsigned)CVT_TILES_PER_LAYER; g += gridDim.x * 8u) cvt_layer_one(a, my, (int)g);
        __syncthreads();
        return;
    }
#pragma unroll 1
    for (;;) {
        if (tid == 0) { unsigned nxt = 0xffffffffu; bool go = true;
            if (!drain) { unsigned sum = 0u;
#pragma unroll
                for (unsigned j = 0; j < 16; ++j) sum += xb_ld(&bar[XB_XSUB(j)]);
                const unsigned G = gridDim.x; go = (sum - nbar * G) + HV_SLACK < G; }
            if (go && xb_ld(&bar[QW_CNT]) < (unsigned)CVT_TILES_PER_LAYER) { const unsigned b0 = xb_add(&bar[QW_CNT], 8u); if (b0 < (unsigned)CVT_TILES_PER_LAYER) nxt = b0; }
            bw[3] = nxt; }
        __syncthreads();
        const unsigned base = bw[3];
        if (base == 0xffffffffu) break;
        const int g = (int)base + wave;
        if (g < CVT_TILES_PER_LAYER) cvt_layer_one(a, my, g);
        __syncthreads();
    }
    __syncthreads();
}
#ifndef FX_HARVEST
#define FX_HARVEST 1
#endif
#define PH_HARVEST(n, dr) do { if (FX_HARVEST && l == 0 && ((dr) || FX_HARVEST == 1)) { PH_BEGIN harvest(lds, pk, ws, gt_, (n), (dr)); } } while (0)
#ifndef FX_DUP
#define FX_DUP -1
#endif
#define FX_NE ((FX_NOEPI && rep_ == 1) ? FX_NOEPI : 0)
#define FX_REP(n) _Pragma("unroll 1") for (int rep_ = 0; rep_ < ((FX_DUP == (n) && l == 0) ? 2 : 1); ++rep_)
template <int l> __device__ __forceinline__ void layer_body(FX_LAS unsigned char* lds, unsigned char* shm, const int wid_s) {
        FX_REP(2) { PH_BEGIN const bf16_t* W = WSP(const bf16_t, WS_W + (size_t)l * W_LAYER);
#ifdef FX_WIN8
          DenseSched Sc; Sc.init(T, 4096, nwg, wg, 2048, W + W_IN / 2, 2048, 1); EpiBf16 E; E.O = WSP(bf16_t, WS_R1); E.gates = WSP(float, WS_GATES); E.ldc = 4096; E.scale = W8_INV;
          gemm_phase<EpiBf16, DenseSched, true>(lds, (const char*)WSP(bf16_t, WS_HA), 2048, Sc, E, gt_, FX_NE); }
#else
          DenseSched Sc; Sc.init(T, 4096, nwg, wg, 2048 * 2, W + W_IN / 2, 2048); EpiBf16 E; E.O = WSP(bf16_t, WS_R1); E.gates = WSP(float, WS_GATES); E.ldc = 4096; E.scale = 1.f;
          gemm_phase<EpiBf16, DenseSched>(lds, (const char*)WSP(bf16_t, WS_HA), 2048, Sc, E, gt_); }
#endif
        PH_HARVEST(3u, false);
        PH_BAR;
        FX_REP(3) { PH_BEGIN char* R2 = ws + WS_R2; float* tab = WSP(float, WS_TAB);
          P3Args a; a.PROJ = WSP(bf16_t, WS_R1); a.GATES = WSP(float, WS_GATES); a.gate_b = pk->c_gate_b + l * 16; a.conv_w = pk->c_conv_w + (size_t)l * 5 * 1024; a.conv_b = pk->c_conv_b + l * 1024;
          a.aq_gain = pk->a_q_gain + l * 128; a.ak_gain = pk->a_k_gain + l * 128; a.cq_gain = pk->b_cq_gain + l * 384; a.ckv_gain = pk->b_ckv_gain + l * 256;
          a.cosA = tab; a.sinA = tab + 2048; a.cosB = tab + 4096; a.sinB = tab + 5120;
          a.QA = (bf16_t*)(R2 + R2_QA); a.KA = (bf16_t*)(R2 + R2_KA); a.CQN = (bf16_t*)(R2 + R2_CQN); a.CKVN = (bf16_t*)(R2 + R2_CKVN); a.KR = (bf16_t*)(R2 + R2_KR); a.QC = (bf16_t*)(R2 + R2_QC); a.KC = (bf16_t*)(R2 + R2_KC);
          a.KCT = (bf16_t*)(R2 + R2_KCT); a.NLOC = WSP(float, WS_NLOC); a.GSC = WSP(float, WS_GSC);
          p3_phase(lds, a, wg, nwg, gt_); }
        PH_BAR;
        FX_REP(4) {
        { PH_BEGIN const bf16_t* W = WSP(const bf16_t, WS_W + (size_t)l * W_LAYER); char* R2 = ws + WS_R2; float* tab = WSP(float, WS_TAB);
          DenseSched Sc; Sc.init(T, 1280, nwg, wg, 384 * 2, W + W_UQ / 2, 384); EpiQB E; E.O = (bf16_t*)(R2 + R2_QB); E.cosB = tab + 4096; E.sinB = tab + 5120;
          gemm_phase<EpiQB, DenseSched>(lds, (const char*)(R2 + R2_CQN), 384, Sc, E, gt_); }
        { PH_BEGIN const bf16_t* W = WSP(const bf16_t, WS_W + (size_t)l * W_LAYER); char* R2 = ws + WS_R2;
          DenseSched Sc; Sc.init(T, 1536, nwg, wg, 256 * 2, W + W_UKV / 2, 256); EpiBf16 E; E.O = (bf16_t*)(R2 + R2_KVB); E.gates = nullptr; E.ldc = 1536; E.scale = 1.f;
          gemm_phase<EpiBf16, DenseSched>(lds, (const char*)(R2 + R2_CKVN), 256, Sc, E, gt_); }
        { PH_BEGIN char* R2 = ws + WS_R2;
          scan_phase((const bf16_t*)(R2 + R2_KCT), WSP(float, WS_NLOC), WSP(float, WS_GSC), (bf16_t*)(R2 + R2_CPREV), WSP(float, WS_NPREV), WSP(float, WS_MPREV), wg * 512 + gt_, nwg * 512); }
        }
        PH_HARVEST(5u, false);
        PH_BAR;
        FX_REP(5) {
#pragma unroll 1
          for (int ui = 0; ui < 2; ++ui) { PH_BEGIN char* R2 = ws + WS_R2; int u;
              if (nwg == 256) { const int x = wg & 7, j = wg >> 3; if (ui == 1 && j >= 16) break; u = x * 48 + j + ui * 32; } else { u = wg + ui * nwg; if (u >= 384) break; }
              attn_gqa_unit(u, (const bf16_t*)(R2 + R2_QA), (const bf16_t*)(R2 + R2_KA), WSP(const bf16_t, WS_R1), WSP(bf16_t, WS_HA), pk->head_out_gain + l * D, (char*)shm, gt_); }
#pragma unroll 1
          for (int ui = 0; ui < 2; ++ui) { PH_BEGIN char* R2 = ws + WS_R2; int u;
              if (nwg == 256) { const int x = wg & 7, j = wg >> 3; if (j < 16) { if (ui == 1) break; u = x * 48 + j; } else u = x * 48 + 16 + (j - 16) * 2 + ui; } else { u = wg + ui * nwg; if (u >= 384) break; }
              attn_mla_unit(u, (const bf16_t*)(R2 + R2_QB), (const bf16_t*)(R2 + R2_KVB), (const bf16_t*)(R2 + R2_KR), WSP(bf16_t, WS_HA), pk->head_out_gain + l * D, (char*)shm, gt_); }
          { PH_BEGIN char* R2 = ws + WS_R2;
            McArgs a; a.PROJ = WSP(bf16_t, WS_R1); a.GATES = WSP(float, WS_GATES); a.gate_b = pk->c_gate_b + l * 16; a.QC = (bf16_t*)(R2 + R2_QC); a.KC = (bf16_t*)(R2 + R2_KC); a.CPREV = (bf16_t*)(R2 + R2_CPREV);
            a.NPREV = WSP(float, WS_NPREV); a.MPREV = WSP(float, WS_MPREV); a.hog = pk->head_out_gain + l * D; a.YM = WSP(bf16_t, WS_HA);
            mlstm_c_phase(lds, a, wg, nwg, gt_); } }
        PH_HARVEST(6u, false);
        PH_BAR;
        FX_REP(6) { PH_BEGIN const bf16_t* W = WSP(const bf16_t, WS_W + (size_t)l * W_LAYER);
#ifdef FX_WOUT8
          DenseSched Sc; Sc.init(T, 2048, nwg, wg, 2048, W + W_OUT / 2, 2048, 1); EpiBf16 E; E.O = WSP(bf16_t, WS_R1); E.gates = nullptr; E.ldc = 2048; E.scale = W8_INV;
          gemm_phase<EpiBf16, DenseSched, true>(lds, (const char*)WSP(bf16_t, WS_HA), 2048, Sc, E, gt_, FX_NE); }
#else
          DenseSched Sc; Sc.init(T, 2048, nwg, wg, 2048 * 2, W + W_OUT / 2, 2048); EpiBf16 E; E.O = WSP(bf16_t, WS_R1); E.gates = nullptr; E.ldc = 2048; E.scale = 1.f;
          gemm_phase<EpiBf16, DenseSched>(lds, (const char*)WSP(bf16_t, WS_HA), 2048, Sc, E, gt_); }
#endif
        PH_HARVEST(7u, false);
        PH_BAR;
        { PH_BEGIN p7_phase<(l != 0)>(lds, l == 0 ? (const void*)pk->x : (const void*)WSP(const bf16_t, WS_XRES), WSP(const bf16_t, WS_R1), WSP(float, WS_COEF) + (size_t)l * 4 * 6 * 2048, pk->router_w + (size_t)l * D * 64, pk->router_bias + l * 64,
                            WSP(bf16_t, WS_XRES), WSP(unsigned char, WS_HA), WSP(int, WS_SELE), WSP(float, WS_SELG), WSP(int, WS_CNT) + l * 64, WSP(int, WS_WGBASE), wg, nwg, gt_); }
        PH_BAR;
        { PH_BEGIN p8_phase(lds, WSP(int, WS_SELE), WSP(float, WS_SELG), WSP(int, WS_CNT) + l * 64, WSP(int, WS_WGBASE), WSP(int, WS_ROWTOK), WSP(float, WS_ROWG), WSP(int, WS_SLOT), wg, nwg, gt_); }
        PH_BAR;
        FX_REP(9) { PH_BEGIN const bf16_t* W = WSP(const bf16_t, WS_W + (size_t)l * W_LAYER);
          p9_phase(lds, WSP(unsigned char, WS_HA), (const unsigned char*)(W + W_GU / 2), WSP(int, WS_CNT) + l * 64, WSP(int, WS_ROWTOK), WSP(unsigned char, WS_R1), wg, nwg, gt_, FX_NE); }
        PH_HARVEST(10u, false);
        PH_BAR;
        FX_REP(10) { PH_BEGIN const bf16_t* W = WSP(const bf16_t, WS_W + (size_t)l * W_LAYER);
          p10_phase(lds, WSP(unsigned char, WS_R1), (const unsigned char*)(W + W_DN / 2), WSP(int, WS_CNT) + l * 64, WSP(float, WS_ROWG), WSP(unsigned char, WS_R2), wg, nwg, gt_, FX_NE); }
        PH_HARVEST(11u, false);
        PH_BAR;
        { PH_BEGIN p11_phase<(l == 1)>(WSP(bf16_t, WS_XRES), WSP(unsigned char, WS_R2), WSP(int, WS_SLOT), WSP(float, WS_COEF) + (size_t)l * 4 * 6 * 2048, l == 0 ? WSP(float, WS_COEF) + 4 * 6 * 2048 : nullptr,
                             l == 1 ? (void*)pk->out : (void*)WSP(bf16_t, WS_XRES), WSP(bf16_t, WS_HA), wg, nwg, gt_); }
        PH_HARVEST(12u, true);
        if (l == 0) PH_BAR;
}
__global__ __launch_bounds__(512, 2) void mega(MP p_unused) {
    extern __shared__ __attribute__((aligned(16))) unsigned char shm[];
    FX_LAS unsigned char* lds = (FX_LAS unsigned char*)shm;
    const int wid_s = __builtin_amdgcn_readfirstlane((int)threadIdx.x >> 6);
    { volatile FX_LAS unsigned* st = (volatile FX_LAS unsigned*)(lds + LDS_ST);
      PH_BEGIN if (gt_ == 0) { st[0] = 0u; st[1] = 0u; st[2] = 0u; st[3] = 0u; }
      __syncthreads();
      (void)xcd_barrier_post((unsigned*)(ws + WS_BAR), st, gt_); }
    { PH_BEGIN const int wave = gt_ >> 6; FX_LAS unsigned* my = (FX_LAS unsigned*)(lds) + wave * (64 * 33); int rot = 0;
#pragma unroll 1
      for (int l = 0; l < ((FX_DUP == 0) ? 4 : (FX_HARVEST ? 1 : 2)); ++l) { const int lw = l & 1; CvtW a; a.w_in = pk->w_in + (size_t)lw * D * 4048; a.w_uq = pk->w_uq + (size_t)lw * 384 * 1152; a.w_ukv = pk->w_ukv + (size_t)lw * 256 * 1536; a.w_out = pk->w_out + (size_t)lw * D * D;
          a.eg = pk->exp_w_gate + (size_t)lw * NE * D * FF; a.eu = pk->exp_w_up + (size_t)lw * NE * D * FF; a.ed = pk->exp_w_down + (size_t)lw * NE * FF * D;
          a.sg = pk->sh_w_gate + (size_t)lw * D * FF; a.su = pk->sh_w_up + (size_t)lw * D * FF; a.sd = pk->sh_w_down + (size_t)lw * FF * D; a.W = (bf16_t*)(ws + WS_W + (size_t)lw * W_LAYER);
          cvt_layer(a, my, wg * 8 + wave, nwg * 8, rot); }
      __syncthreads(); }
    { PH_BEGIN modp_phase(lds, pk->c, pk->ada_w, WSP(float, WS_MODP), wg, nwg, gt_); tab_phase(WSP(float, WS_TAB), wg * 512 + gt_); }
#if FX_DUP == 20
    { PH_BEGIN modp_phase(lds, pk->c, pk->ada_w, WSP(float, WS_MODP), wg, nwg, gt_); tab_phase(WSP(float, WS_TAB), wg * 512 + gt_); }
#endif
    PH_BAR;
    { PH_BEGIN coef2_phase(WSP(float, WS_MODP), pk->ada_b, pk->pre_mix_gain, pk->post_mix_gain, pk->pre_ffn_gain, pk->post_ffn_gain, WSP(float, WS_COEF), wg * 512 + gt_, nwg * 512); }
#if FX_DUP == 21
    { PH_BEGIN coef2_phase(WSP(float, WS_MODP), pk->ada_b, pk->pre_mix_gain, pk->post_mix_gain, pk->pre_ffn_gain, pk->post_ffn_gain, WSP(float, WS_COEF), wg * 512 + gt_, nwg * 512); }
#endif
    PH_BAR;
    { PH_BEGIN prenorm_phase(pk->x, WSP(float, WS_COEF), WSP(bf16_t, WS_HA), wg, nwg, gt_); }
#if FX_DUP == 22
    { PH_BEGIN prenorm_phase(pk->x, WSP(float, WS_COEF), WSP(bf16_t, WS_HA), wg, nwg, gt_); }
#endif
    PH_BAR;
#if FX_DUP == 99
    PH_BAR; PH_BAR; PH_BAR; PH_BAR; PH_BAR; PH_BAR; PH_BAR; PH_BAR; PH_BAR; PH_BAR;
#endif
    layer_body<0>(lds, shm, wid_s);
    layer_body<1>(lds, shm, wid_s);
}
}

extern "C" void kernel_launch(void* const* d_in, const int* in_sizes, int n_in, void* d_out, int out_size, void* d_ws, size_t ws_size, hipStream_t stream) {
    using namespace fx;
    static int grid = 0;
    if (!grid) {
        int dev = 0, cus = 0, per_cu = 0;
        (void)hipGetDevice(&dev);
        (void)hipDeviceGetAttribute(&cus, hipDeviceAttributeMultiprocessorCount, dev);
        (void)hipFuncSetAttribute((const void*)mega, hipFuncAttributeMaxDynamicSharedMemorySize, LDS_TOTAL);
        (void)hipOccupancyMaxActiveBlocksPerMultiprocessor(&per_cu, (const void*)mega, 512, LDS_TOTAL);
        if (cus > 256) cus = 256;
        grid = per_cu >= 1 ? cus : 0;
    }
    if (!grid) return;
    (void)hipMemsetAsync((char*)d_ws + WS_BAR, 0, 16384, stream);
    (void)hipMemsetAsync((char*)d_ws + WS_CNT, 0, 512, stream);
    MP p{};
    const float** q = (const float**)&p;
    for (int i = 0; i < 28; ++i) q[i] = (const float*)d_in[i];
    p.ws = (char*)d_ws; p.out = (float*)d_out;
    hipLaunchKernelGGL(mega, dim3(grid), dim3(512), LDS_TOTAL, stream, p);
}
```

```cpp
#define FX_WIN8 1
#define FX_WOUT8 1
#define FX_HARVEST 0
#include <hip/hip_runtime.h>
#include <stdint.h>
#include <math.h>
#ifndef FX_NOEPI
#define FX_NOEPI 0
#endif
namespace fx {
#define FX_LAS __attribute__((address_space(3)))
typedef unsigned short bf16_t;
typedef short bf16x8 __attribute__((ext_vector_type(8)));
typedef short s16x4 __attribute__((ext_vector_type(4)));
typedef float f32x4 __attribute__((ext_vector_type(4)));
typedef float f32x16 __attribute__((ext_vector_type(16)));
typedef unsigned u32x4 __attribute__((ext_vector_type(4)));
typedef unsigned u32x2 __attribute__((ext_vector_type(2)));
typedef float f32x2 __attribute__((ext_vector_type(2)));

constexpr int D = 2048, NB = 4, S = 4096, T = NB * S, DEPTH = 2;
constexpr int NE = 64, FF = 512;
constexpr float EPS = 1e-6f;
constexpr int PW = 4096;
constexpr int O_AQ = 0, O_AK = 768, O_AV = 1024, O_BCQ = 1280, O_BCKV = 1664, O_BKR = 1920, O_CQ = 1984, O_CK = 2496, O_CV = 3008, O_CO = 3520, O_CG = 4032;

typedef __bf16 bf16x2_t __attribute__((ext_vector_type(2)));
__device__ __forceinline__ unsigned cvt_pk_bf16(float lo, float hi) { const bf16x2_t r = __builtin_convertvector((f32x2){lo, hi}, bf16x2_t); return __builtin_bit_cast(unsigned, r); }
__device__ __forceinline__ float bf2f(bf16_t b) { return __uint_as_float(((unsigned)b) << 16); }
__device__ __forceinline__ float bflo(unsigned w) { return __uint_as_float(w << 16); }
__device__ __forceinline__ float bfhi(unsigned w) { return __uint_as_float(w & 0xffff0000u); }
__device__ __forceinline__ bf16_t f2bf(float f) { return (bf16_t)(cvt_pk_bf16(f, 0.f) & 0xffffu); }
__device__ __forceinline__ float sigmoid_f(float x) { return __builtin_amdgcn_rcpf(1.f + __expf(-x)); }
__device__ __forceinline__ float silu_f(float x) { return x * __builtin_amdgcn_rcpf(1.f + __expf(-x)); }
__device__ __forceinline__ int fx_lane() { unsigned z = 0u; asm volatile("" : "+v"(z)); return (int)__builtin_amdgcn_mbcnt_hi(~0u, __builtin_amdgcn_mbcnt_lo(~0u, z)); }
__device__ __forceinline__ float wave_sum(float v) { for (int o = 32; o >= 1; o >>= 1) v += __shfl_xor(v, o); return v; }
__device__ __forceinline__ float wave_max(float v) { for (int o = 32; o >= 1; o >>= 1) v = fmaxf(v, __shfl_xor(v, o)); return v; }

#ifndef FX_WGM
#define FX_WGM 8
#endif
#ifndef FX_PRIO8
#define FX_PRIO8 1
#endif
#ifndef FX_F8_32
#define FX_F8_32 0
#endif
typedef int i32x8 __attribute__((ext_vector_type(8)));
typedef int i32x4 __attribute__((ext_vector_type(4)));
constexpr float W8_SCALE = 32.f, W8_INV = 1.f / 32.f;
__device__ __forceinline__ unsigned cvt_pk4_fp8(float a, float b, float c, float d) { int w = 0; w = __builtin_amdgcn_cvt_pk_fp8_f32(a, b, w, false); w = __builtin_amdgcn_cvt_pk_fp8_f32(c, d, w, true); return (unsigned)w; }
struct CvtSeg { const float* src; bf16_t* dst; long long sstride, dstride; int ld, nsrc, K, ntn, nbatch, G, GS, off; };
__device__ __forceinline__ void cvt_tile(const CvtSeg sg, FX_LAS unsigned* my, int tile) {
    const int lane = fx_lane();
    const int ktn = sg.K / 64, per = ktn * sg.ntn;
    {
        const int b = tile / per, r = tile - b * per, nt = r / ktn, kt = r - nt * ktn;
        const int r4 = lane >> 4, c4 = lane & 15;
        const float* src = sg.src + (size_t)b * sg.sstride + (size_t)(kt * 64) * sg.ld + nt * 64 + 4 * c4;
        const bool ok = nt * 64 + 4 * c4 < sg.nsrc;
        f32x4 va[8], vb[8];
#pragma unroll
        for (int i = 0; i < 8; ++i) { const int kp = 4 * i + r4; const f32x4 z = {0.f, 0.f, 0.f, 0.f};
            va[i] = ok ? *(const f32x4*)(src + (size_t)(2 * kp) * sg.ld) : z; vb[i] = ok ? *(const f32x4*)(src + (size_t)(2 * kp + 1) * sg.ld) : z; }
#pragma unroll
        for (int i = 0; i < 8; ++i) { const int kp = 4 * i + r4;
#pragma unroll
            for (int j = 0; j < 4; ++j) my[(4 * c4 + j) * 33 + kp] = cvt_pk_bf16(va[i][j], vb[i][j]); }
        asm volatile("s_waitcnt lgkmcnt(0)" ::: "memory");
        bf16_t* dst = sg.dst + (size_t)b * sg.dstride;
#pragma unroll
        for (int i = 0; i < 8; ++i) {
            const int nl = (lane >> 3) + 8 * i, c = lane & 7, n = nt * 64 + nl;
            u32x4 w; w.x = my[nl * 33 + 4 * c]; w.y = my[nl * 33 + 4 * c + 1]; w.z = my[nl * 33 + 4 * c + 2]; w.w = my[nl * 33 + 4 * c + 3];
            const int row = (n / sg.G) * sg.GS + (n % sg.G) + sg.off;
            *(u32x4*)(dst + (size_t)row * sg.K + kt * 64 + 8 * c) = w;
        }
        asm volatile("s_waitcnt lgkmcnt(0)" ::: "memory");
    }
}
__device__ __forceinline__ void cvt_seg(const CvtSeg sg, FX_LAS unsigned* my, int gwave, int nwaves, int& rot) {
    const int total = (sg.K / 64) * sg.ntn * sg.nbatch;
    int first = (gwave - rot) % nwaves; if (first < 0) first += nwaves;
    for (int tile = first; tile < total; tile += nwaves) cvt_tile(sg, my, tile);
    rot = (rot + total) % nwaves;
}
__device__ __forceinline__ void cvt_tile8(const CvtSeg sg, FX_LAS unsigned* my, int tile, float scale) {
    const int lane = fx_lane();
    const int ktn = sg.K / 64, per = ktn * sg.ntn;
    {
        const int b = tile / per, r = tile - b * per, nt = r / ktn, kt = r - nt * ktn;
        const int r4 = lane >> 4, c4 = lane & 15;
        const float* src = sg.src + (size_t)b * sg.sstride + (size_t)(kt * 64) * sg.ld + nt * 64 + 4 * c4;
        const bool ok = nt * 64 + 4 * c4 < sg.nsrc;
        f32x4 v[4][4];
#pragma unroll
        for (int i = 0; i < 4; ++i)
#pragma unroll
            for (int q = 0; q < 4; ++q) { const int kq = 4 * i + r4; const f32x4 z = {0.f, 0.f, 0.f, 0.f}; v[i][q] = ok ? *(const f32x4*)(src + (size_t)(4 * kq + q) * sg.ld) : z; }
#pragma unroll
        for (int i = 0; i < 4; ++i) { const int kq = 4 * i + r4;
#pragma unroll
            for (int j = 0; j < 4; ++j) my[(4 * c4 + j) * 17 + kq] = cvt_pk4_fp8(v[i][0][j] * scale, v[i][1][j] * scale, v[i][2][j] * scale, v[i][3][j] * scale); }
        asm volatile("s_waitcnt lgkmcnt(0)" ::: "memory");
        unsigned char* dst = (unsigned char*)sg.dst + (size_t)b * sg.dstride;
#pragma unroll
        for (int i = 0; i < 4; ++i) {
            const int nl = (lane >> 2) + 16 * i, c = lane & 3, n = nt * 64 + nl;
            u32x4 w; w.x = my[nl * 17 + 4 * c]; w.y = my[nl * 17 + 4 * c + 1]; w.z = my[nl * 17 + 4 * c + 2]; w.w = my[nl * 17 + 4 * c + 3];
            const int row = (n / sg.G) * sg.GS + (n % sg.G) + sg.off;
            *(u32x4*)(dst + (size_t)row * sg.K + kt * 64 + 16 * c) = w;
        }
        asm volatile("s_waitcnt lgkmcnt(0)" ::: "memory");
    }
}
__device__ __forceinline__ void cvt_seg8(const CvtSeg sg, FX_LAS unsigned* my, int gwave, int nwaves, int& rot, float scale) {
    const int total = (sg.K / 64) * sg.ntn * sg.nbatch;
    int first = (gwave - rot) % nwaves; if (first < 0) first += nwaves;
    for (int tile = first; tile < total; tile += nwaves) cvt_tile8(sg, my, tile, scale);
    rot = (rot + total) % nwaves;
}

constexpr int BM = 256, BK = 64, HALF = 128, HTB = HALF * BK * 2, STAGE_BYTES = 8 * HTB, NXCD = 8, WGM = FX_WGM;
__host__ __device__ __forceinline__ int lds_byte(int r, int c) { const int st = (r >> 4) * 2 + (c >> 5), rr = r & 15, cc = c & 31, ob = rr * 64 + cc * 2; return st * 1024 + (ob ^ (((ob >> 9) & 1) << 5)); }
__host__ __device__ __forceinline__ void stage_rc(int b, int& R, int& C) { const int st = b / 1024, sb = b % 1024, swz = sb ^ (((sb >> 9) & 1) << 5); R = (st >> 1) * 16 + swz / 64; C = (st & 1) * 32 + (swz % 64) / 2; }
__host__ __device__ __forceinline__ int perm32(int rho) { const int n = rho >> 4, i = rho & 15; return 8 * (i >> 2) + 4 * n + (i & 3); }
struct Unit { int pm, pn, e; };
struct DenseSched {
    static constexpr bool GATHER = false;
    int nM, nN, nwg, G, c; int lda_b; const char* Bt; int K; int esz;
    __device__ void init(int M, int N, int G_, int c_, int lda_bytes, const void* Bt_, int K_, int esz_ = 2) { nM = M / BM; nN = N / BM; nwg = nM * nN; G = G_; c = c_; lda_b = lda_bytes; Bt = (const char*)Bt_; K = K_; esz = esz_; }
    __device__ __forceinline__ bool next(int i, Unit& u) const {
        const long L = (long)i * G + c; if (L >= nwg) return false;
        int wgid = (int)L; { const int q = nwg / NXCD, r = nwg % NXCD, xcd = wgid % NXCD, off = wgid / NXCD; wgid = (xcd < r ? xcd * (q + 1) : r * (q + 1) + (xcd - r) * q) + off; }
        const int nig = WGM * nN, gid = wgid / nig, fm = gid * WGM, gsz = (nM - fm) < WGM ? (nM - fm) : WGM;
        u.pm = fm + ((wgid % nig) % gsz); u.pn = (wgid % nig) / gsz; u.e = 0; return true;
    }
    __device__ __forceinline__ unsigned a_row_off(const Unit& u, int R) const { return (unsigned)(u.pm * BM + R) * (unsigned)lda_b; }
    __device__ __forceinline__ size_t a_unit_base(const Unit& u) const { return (size_t)u.pm * BM * (size_t)lda_b; }
    __device__ __forceinline__ unsigned a_lane_off(int R) const { return (unsigned)R * (unsigned)lda_b; }
    __device__ __forceinline__ const char* b_ptr(const Unit& u) const { return Bt + (size_t)u.pn * BM * K * esz; }
};

template <class Epi, class Sched, bool FP8 = false>
__device__ __forceinline__ void gemm_phase(FX_LAS unsigned char* lds, const char* Abase, const int Kc, const Sched& S, const Epi& E, int tidp, const int noepi = 0) {
    int K_ = Kc; asm volatile("" : "+s"(K_)); const int K = K_;
    int tid_ = tidp; asm volatile("" : "+v"(tid_));
    const int tid = tid_, wid = __builtin_amdgcn_readfirstlane(tid >> 6), lane = tid & 63, wr = wid >> 2, wc = wid & 3, fr = lane & 15, fq = lane >> 4;
    constexpr int ES = FP8 ? 1 : 2;
    const int nt = K * ES / 128;
    int Rr[2], Cc[2]; unsigned voffB[2];
#pragma unroll
    for (int i = 0; i < 2; ++i) { int R, C; stage_rc(tid * 16 + i * 8192, R, C); Rr[i] = R; Cc[i] = C; const int Rb = (Epi::PERM && !(FP8 && FX_F8_32)) ? ((R & ~31) + perm32(R & 31)) : R; voffB[i] = (unsigned)(Rb * K * ES + C * 2); }
    const size_t hstepB = (size_t)HALF * K * ES;
    const unsigned ldsw = (unsigned)wid * 1024u;
    constexpr bool F32M = FP8 && FX_F8_32;
    const int aoff = F32M ? lds_byte(wr * 64 + (lane & 31), 16 * (lane >> 5)) : lds_byte(wr * 64 + fr, fq * 8), boff = F32M ? lds_byte(wc * 32 + (lane & 31), 16 * (lane >> 5)) : lds_byte(wc * 32 + fr, fq * 8);
#define FX_SA(b, h) (((b) * 2 + (h)) * HTB)
#define FX_SB(b, h) ((4 + (b) * 2 + (h)) * HTB)
#define FX_STAGE_A(bufoff, o0, o1, kb) do { const char* ap_ = Abase + (kb); \
        __builtin_amdgcn_global_load_lds((const unsigned*)(ap_ + (o0)), (FX_LAS unsigned*)(lds + (bufoff) + ldsw), 16, 0, 0); \
        __builtin_amdgcn_global_load_lds((const unsigned*)(ap_ + (o1)), (FX_LAS unsigned*)(lds + (bufoff) + ldsw + 8192), 16, 0, 0); } while (0)
#define FX_STAGE_B(bufoff, gbase) do { _Pragma("unroll") for (int _i = 0; _i < 2; ++_i) \
        __builtin_amdgcn_global_load_lds((const unsigned*)((const char*)(gbase) + voffB[_i]), (FX_LAS unsigned*)(lds + (bufoff) + ldsw + _i * 8192), 16, 0, 0); } while (0)
#define FX_LDA(dst, b, h) do { if constexpr (F32M) { _Pragma("unroll") for (int q = 0; q < 4; ++q) { dst[q][0] = *(const FX_LAS bf16x8*)(lds + FX_SA(b, h) + aoff + (q >> 1) * 4096 + (q & 1) * 1024); dst[q][1] = *(const FX_LAS bf16x8*)(lds + FX_SA(b, h) + aoff + (q >> 1) * 4096 + (q & 1) * 1024 + 16); } } \
        else { _Pragma("unroll") for (int m = 0; m < 4; ++m) _Pragma("unroll") for (int k = 0; k < 2; ++k) dst[m][k] = *(const FX_LAS bf16x8*)(lds + FX_SA(b, h) + aoff + m * 2048 + k * 1024); } } while (0)
#define FX_LDB(dst, b, h) do { if constexpr (F32M) { _Pragma("unroll") for (int q = 0; q < 2; ++q) { dst[q][0] = *(const FX_LAS bf16x8*)(lds + FX_SB(b, h) + boff + q * 1024); dst[q][1] = *(const FX_LAS bf16x8*)(lds + FX_SB(b, h) + boff + q * 1024 + 16); } } \
        else { _Pragma("unroll") for (int n = 0; n < 2; ++n) _Pragma("unroll") for (int k = 0; k < 2; ++k) dst[n][k] = *(const FX_LAS bf16x8*)(lds + FX_SB(b, h) + boff + n * 2048 + k * 1024); } } while (0)
#define FX_MMA(ai, bj, At, Bt) do { if (!FP8 || FX_PRIO8) __builtin_amdgcn_s_setprio(1); \
        if constexpr (F32M) { _Pragma("unroll") for (int mb = 0; mb < 2; ++mb) _Pragma("unroll") for (int s = 0; s < 2; ++s) { \
            const i32x4 a0_ = __builtin_bit_cast(i32x4, At[mb * 2 + s][0]), a1_ = __builtin_bit_cast(i32x4, At[mb * 2 + s][1]), b0_ = __builtin_bit_cast(i32x4, Bt[s][0]), b1_ = __builtin_bit_cast(i32x4, Bt[s][1]); \
            const i32x8 af_ = __builtin_shufflevector(a0_, a1_, 0, 1, 2, 3, 4, 5, 6, 7), bf_ = __builtin_shufflevector(b0_, b1_, 0, 1, 2, 3, 4, 5, 6, 7); \
            asm volatile("v_mfma_scale_f32_32x32x64_f8f6f4 %0, %1, %2, %0, %3, %3 op_sel_hi:[0,0,0]" : "+v"(acc3[ai][bj][mb]) : "v"(bf_), "v"(af_), "v"(sc1_)); } } else \
        _Pragma("unroll") for (int m = 0; m < 4; ++m) _Pragma("unroll") for (int n = 0; n < 2; ++n) { \
        if constexpr (FP8) { const i32x4 a0_ = __builtin_bit_cast(i32x4, At[m][0]), a1_ = __builtin_bit_cast(i32x4, At[m][1]), b0_ = __builtin_bit_cast(i32x4, Bt[n][0]), b1_ = __builtin_bit_cast(i32x4, Bt[n][1]); \
            const i32x8 af_ = __builtin_shufflevector(a0_, a1_, 0, 1, 2, 3, 4, 5, 6, 7), bf_ = __builtin_shufflevector(b0_, b1_, 0, 1, 2, 3, 4, 5, 6, 7); \
            asm volatile("v_mfma_scale_f32_16x16x128_f8f6f4 %0, %1, %2, %0, %3, %3 op_sel_hi:[0,0,0]" : "+v"(acc[ai][bj][m][n]) : "v"(bf_), "v"(af_), "v"(sc1_)); FX_MFMA_DUP(acc[ai][bj][m][n]) } \
        else { _Pragma("unroll") for (int k = 0; k < 2; ++k) acc[ai][bj][m][n] = __builtin_amdgcn_mfma_f32_16x16x32_bf16(Bt[n][k], At[m][k], acc[ai][bj][m][n], 0, 0, 0); } } \
        if (!FP8 || FX_PRIO8) __builtin_amdgcn_s_setprio(0); } while (0)
#define FX_WAIT_V(n) asm volatile("s_waitcnt vmcnt(" #n ")" ::: "memory")
#define FX_WAIT_L(n) asm volatile("s_waitcnt lgkmcnt(" #n ")" ::: "memory")
#define FX_BAR __builtin_amdgcn_s_barrier()
#define FX_SCHED __builtin_amdgcn_sched_barrier(0)
#ifdef FX_PROBE_MFMA
#define FX_MFMA_DUP(ACC) asm volatile("v_mfma_scale_f32_16x16x128_f8f6f4 %0, %1, %2, %0, %3, %3 op_sel_hi:[0,0,0]" : "+v"(ACC) : "v"(bf_), "v"(af_), "v"(sc0_));
#else
#define FX_MFMA_DUP(ACC)
#endif
    const int sc0_ = 0; (void)sc0_;
    const int sc1_ = 0x7f7f7f7f;
    (void)sc1_;
    Unit cur, nxt; int ui = 0;
    if (!S.next(0, cur)) return;
    f32x4 acc[2][2][4][2];
#pragma unroll
    for (int a = 0; a < 2; ++a)
#pragma unroll
        for (int b = 0; b < 2; ++b)
#pragma unroll
            for (int m = 0; m < 4; ++m)
#pragma unroll
                for (int n = 0; n < 2; ++n) acc[a][b][m][n] = (f32x4){0.f, 0.f, 0.f, 0.f};
    f32x16 acc3[2][2][2];
#pragma unroll
    for (int q = 0; q < 8; ++q) acc3[q >> 2][(q >> 1) & 1][q & 1] = f32x16{};
    bf16x8 At[4][2], B0[2][2], B1[2][2];
    unsigned c00, c01, c10, c11, n00 = 0, n01 = 0, n10 = 0, n11 = 0;
    size_t ubc = 0, ubn = 0;
    if constexpr (Sched::GATHER) { c00 = S.a_row_off(cur, Rr[0]) + Cc[0] * 2; c01 = S.a_row_off(cur, Rr[1]) + Cc[1] * 2; c10 = S.a_row_off(cur, HALF + Rr[0]) + Cc[0] * 2; c11 = S.a_row_off(cur, HALF + Rr[1]) + Cc[1] * 2; }
    else { c00 = S.a_lane_off(Rr[0]) + Cc[0] * 2; c01 = S.a_lane_off(Rr[1]) + Cc[1] * 2; c10 = c00 + S.a_lane_off(HALF); c11 = c01 + S.a_lane_off(HALF); ubc = S.a_unit_base(cur); n00 = c00; n01 = c01; n10 = c10; n11 = c11; }
    const char* cB = S.b_ptr(cur);
    const unsigned kstep = BK * 2;
    FX_STAGE_B(FX_SB(0, 0), cB); FX_STAGE_A(FX_SA(0, 0), c00, c01, ubc); FX_STAGE_B(FX_SB(0, 1), cB + hstepB); FX_STAGE_A(FX_SA(0, 1), c10, c11, ubc);
    if (wr == 1) FX_BAR;
    FX_WAIT_V(4); FX_BAR;
    FX_STAGE_B(FX_SB(1, 0), cB + kstep); FX_STAGE_A(FX_SA(1, 0), c00, c01, ubc + kstep); FX_STAGE_B(FX_SB(1, 1), cB + hstepB + kstep);
    FX_WAIT_V(6); FX_BAR;
    for (;;) {
        const bool has_next = S.next(ui + 1, nxt);
        if (!has_next) nxt = cur;
        if constexpr (!Sched::GATHER) ubn = S.a_unit_base(nxt);
        const char* nB = S.b_ptr(nxt);
        for (int t = 0; t < nt; t += 2) {
            const bool last = (t == nt - 2);
            asm volatile("" : "+v"(c00), "+v"(c01), "+v"(c10), "+v"(c11), "+v"(voffB[0]), "+v"(voffB[1]));
            if constexpr (Sched::GATHER) { if (last) {
                int t2_ = tid; asm volatile("" : "+v"(t2_)); int R0_, C0_, R1_, C1_; stage_rc(t2_ * 16, R0_, C0_); stage_rc(t2_ * 16 + 8192, R1_, C1_);
                n00 = S.a_row_off(nxt, R0_) + C0_ * 2; n01 = S.a_row_off(nxt, R1_) + C1_ * 2; n10 = S.a_row_off(nxt, HALF + R0_) + C0_ * 2; n11 = S.a_row_off(nxt, HALF + R1_) + C1_ * 2; } }
            const size_t k1 = ubc + (size_t)(t + 1) * kstep;
            const size_t k2 = last ? ubn : ubc + (size_t)(t + 2) * kstep, k3 = k2 + kstep;
            unsigned a00, a01, a10, a11;
            if constexpr (Sched::GATHER) { a00 = last ? n00 : c00; a01 = last ? n01 : c01; a10 = last ? n10 : c10; a11 = last ? n11 : c11; } else { a00 = c00; a01 = c01; a10 = c10; a11 = c11; }
            const char* b2 = last ? nB : cB + (size_t)(t + 2) * kstep; const char* b3 = b2 + kstep;
            FX_LDB(B0, 0, 0); FX_SCHED; FX_LDA(At, 0, 0); FX_STAGE_A(FX_SA(1, 1), c10, c11, k1);
            FX_WAIT_L(8); FX_BAR; FX_WAIT_L(0); FX_MMA(0, 0, At, B0); FX_BAR; FX_SCHED;
            FX_LDB(B1, 0, 1); FX_STAGE_B(FX_SB(0, 0), b2);
            FX_BAR; FX_WAIT_L(0); FX_MMA(0, 1, At, B1); FX_BAR;
            FX_LDA(At, 0, 1); FX_STAGE_A(FX_SA(0, 0), a00, a01, k2);
            FX_BAR; FX_WAIT_L(0); FX_MMA(1, 0, At, B0); FX_BAR; FX_SCHED;
            FX_STAGE_B(FX_SB(0, 1), b2 + hstepB);
            FX_WAIT_V(6); FX_BAR; FX_MMA(1, 1, At, B1); FX_BAR;
            FX_LDB(B0, 1, 0); FX_SCHED; FX_LDA(At, 1, 0); FX_STAGE_A(FX_SA(0, 1), a10, a11, k2);
            FX_WAIT_L(8); FX_BAR; FX_WAIT_L(0); FX_MMA(0, 0, At, B0); FX_BAR; FX_SCHED;
            FX_LDB(B1, 1, 1); FX_STAGE_B(FX_SB(1, 0), b3);
            FX_BAR; FX_WAIT_L(0); FX_MMA(0, 1, At, B1); FX_BAR;
            FX_LDA(At, 1, 1); FX_STAGE_A(FX_SA(1, 0), a00, a01, k3);
            FX_BAR; FX_WAIT_L(0); FX_MMA(1, 0, At, B0); FX_BAR; FX_SCHED;
            FX_STAGE_B(FX_SB(1, 1), b3 + hstepB);
            FX_WAIT_V(6); FX_BAR; FX_MMA(1, 1, At, B1); FX_BAR;
        }
        if constexpr (FP8) asm volatile("s_nop 15\n\ts_nop 15\n\ts_nop 15\n\ts_nop 15" ::: "memory");
        if constexpr (F32M) { int ln_e = lane; asm volatile("" : "+v"(ln_e)); E.e32(acc3, cur, wr, wc, ln_e); }
        else if (noepi) { f32x4 s_ = (f32x4){0.f, 0.f, 0.f, 0.f};
#pragma unroll
            for (int q_ = 0; q_ < 32; ++q_) s_ += acc[q_ >> 4][(q_ >> 3) & 1][(q_ >> 1) & 3][q_ & 1];
            if (s_[0] + s_[1] + s_[2] + s_[3] == 1.2345e-30f) *(float*)const_cast<char*>(Abase) = s_[0]; }
        else { int fr_e = fr, fq_e = fq; asm volatile("" : "+v"(fr_e), "+v"(fq_e)); E(acc, cur, wr, wc, fr_e, fq_e); }
        if (!has_next) break;
        if constexpr (F32M) { _Pragma("unroll") for (int q = 0; q < 8; ++q) acc3[q >> 2][(q >> 1) & 1][q & 1] = f32x16{}; }
#pragma unroll
        for (int a = 0; a < 2; ++a)
#pragma unroll
            for (int b = 0; b < 2; ++b)
#pragma unroll
                for (int m = 0; m < 4; ++m)
#pragma unroll
                    for (int n = 0; n < 2; ++n) acc[a][b][m][n] = (f32x4){0.f, 0.f, 0.f, 0.f};
        cur = nxt; cB = nB; if constexpr (Sched::GATHER) { c00 = n00; c01 = n01; c10 = n10; c11 = n11; } else ubc = ubn; ++ui;
    }
    FX_WAIT_V(0);
    if (wr == 0) FX_BAR;
    FX_BAR;
}

struct EpiBf16 {
    static constexpr bool PERM = true;
    bf16_t* O; float* gates; int ldc; float scale;
    __device__ __forceinline__ void operator()(const f32x4 (&acc)[2][2][4][2], const Unit& u, int wr, int wc, int fr, int fq) const {
        const int row0 = u.pm * BM + wr * 64 + fr, col0 = u.pn * BM + wc * 32 + 8 * fq;
#pragma unroll
        for (int ai = 0; ai < 2; ++ai)
#pragma unroll
            for (int m = 0; m < 4; ++m) { const int row = row0 + ai * HALF + m * 16; bf16_t* rowp = O + (size_t)row * ldc + col0;
#pragma unroll
                for (int bj = 0; bj < 2; ++bj) { const f32x4 v0 = acc[ai][bj][m][0] * scale, v1 = acc[ai][bj][m][1] * scale;
                    u32x4 w; w.x = cvt_pk_bf16(v0[0], v0[1]); w.y = cvt_pk_bf16(v0[2], v0[3]); w.z = cvt_pk_bf16(v1[0], v1[1]); w.w = cvt_pk_bf16(v1[2], v1[3]);
                    *(u32x4*)(rowp + bj * HALF) = w; }
                if (gates && u.pn == 15 && wc == 2 && fq < 2) { float* g = gates + (size_t)row * 16 + 8 * fq; *(f32x4*)g = acc[ai][1][m][0] * scale; *(f32x4*)(g + 4) = acc[ai][1][m][1] * scale; } }
    }
    __device__ __forceinline__ void e32(const f32x16 (&acc3)[2][2][2], const Unit& u, int wr, int wc, int lane) const {
        const int j = lane & 31, hi = lane >> 5;
#pragma unroll
        for (int ai = 0; ai < 2; ++ai)
#pragma unroll
            for (int mb = 0; mb < 2; ++mb) { const int row = u.pm * BM + ai * HALF + wr * 64 + mb * 32 + j;
#pragma unroll
                for (int bj = 0; bj < 2; ++bj) { bf16_t* rowp = O + (size_t)row * ldc + u.pn * BM + bj * HALF + wc * 32 + 4 * hi;
#pragma unroll
                    for (int g = 0; g < 4; ++g) { u32x2 w; w.x = cvt_pk_bf16(acc3[ai][bj][mb][4 * g] * scale, acc3[ai][bj][mb][4 * g + 1] * scale); w.y = cvt_pk_bf16(acc3[ai][bj][mb][4 * g + 2] * scale, acc3[ai][bj][mb][4 * g + 3] * scale);
                        *(u32x2*)(rowp + 8 * g) = w; } }
                if (gates && u.pn == 15 && wc == 2) { float* gp = gates + (size_t)row * 16 + 4 * hi;
#pragma unroll
                    for (int g = 0; g < 2; ++g) *(f32x4*)(gp + 8 * g) = (f32x4){acc3[ai][1][mb][4 * g] * scale, acc3[ai][1][mb][4 * g + 1] * scale, acc3[ai][1][mb][4 * g + 2] * scale, acc3[ai][1][mb][4 * g + 3] * scale}; } }
    }
};
}
#ifndef FX_RUNR
#define FX_RUNR 16
#endif
namespace fx {
constexpr int RT = 16;
constexpr int H2S_LD = 2052;
constexpr int P7_LDS = RT * H2S_LD * 4 + 512;
constexpr int PTOT = 131072;
constexpr int NTILE_MAX = PTOT / 256;

__device__ __forceinline__ void coef_phase(const float* mod, const float* pre_mix_gain, const float* post_mix_gain, const float* pre_ffn_gain, const float* post_ffn_gain, float* coef, int gtid, int nthr) {
    for (int i = gtid; i < 2 * 4 * 2048; i += nthr) { const int d = i & 2047, b = (i >> 11) & 3, l = i >> 13;
        const float* m = mod + ((size_t)l * 4 + b) * 12288; float* c = coef + ((size_t)l * 4 + b) * 6 * 2048;
        c[0 * 2048 + d] = m[2 * 2048 + d] * post_mix_gain[l * 2048 + d];
        c[1 * 2048 + d] = pre_ffn_gain[l * 2048 + d] * (1.f + m[4 * 2048 + d]);
        c[2 * 2048 + d] = m[3 * 2048 + d];
        c[3 * 2048 + d] = m[5 * 2048 + d] * post_ffn_gain[l * 2048 + d];
        c[4 * 2048 + d] = pre_mix_gain[l * 2048 + d] * (1.f + m[1 * 2048 + d]);
        c[5 * 2048 + d] = m[0 * 2048 + d]; }
}

template <bool XBF>
__device__ __forceinline__ void p7_phase(FX_LAS unsigned char* lds, const void* xin_, const bf16_t* Y, const float* coef_l  , const float* router_w, const float* router_bias,
                                         bf16_t* XRES, unsigned char* HA8, int* SELE, float* SELG, int* CNT, int* WGBASE, int wg, int nwg, int tidp) {
    int tid_ = tidp; asm volatile("" : "+v"(tid_));
    const int tid = tid_, wid = tid >> 6, lane = tid & 63;
    FX_LAS float* h2s = (FX_LAS float*)lds;
    FX_LAS int* hist = (FX_LAS int*)(lds + RT * H2S_LD * 4);
    if (tid < 64) hist[tid] = 0;
    __syncthreads();
#define FX_GC(TY, p) ((const __attribute__((address_space(1))) TY*)(p))
#define FX_GM(TY, p) ((__attribute__((address_space(1))) TY*)(p))
    const int i16 = lane & 15, g4 = lane >> 4;
    for (int unit = wg; unit < T / RT; unit += nwg) {
        {
            const int tok0 = 2 * wid, t0 = unit * RT + tok0, b = t0 / S;
            const float* cf = coef_l + (size_t)b * 6 * 2048;
            u32x4 yw[2][4]; f32x4 ca[8];
            float xv[2][32];
#pragma unroll
            for (int tt = 0; tt < 2; ++tt)
#pragma unroll
                for (int i = 0; i < 4; ++i) yw[tt][i] = *FX_GC(u32x4, Y + (size_t)(t0 + tt) * 2048 + i * 512 + lane * 8);
            if constexpr (XBF) {
                u32x4 xw[2][4];
#pragma unroll
                for (int tt = 0; tt < 2; ++tt)
#pragma unroll
                    for (int i = 0; i < 4; ++i) xw[tt][i] = *FX_GC(u32x4, (const bf16_t*)xin_ + (size_t)(t0 + tt) * 2048 + i * 512 + lane * 8);
#pragma unroll
                for (int i = 0; i < 4; ++i) { ca[2 * i] = *FX_GC(f32x4, cf + i * 512 + lane * 8); ca[2 * i + 1] = *FX_GC(f32x4, cf + i * 512 + lane * 8 + 4); }
#pragma unroll
                for (int tt = 0; tt < 2; ++tt)
#pragma unroll
                    for (int i = 0; i < 4; ++i) { const u32x4 w = xw[tt][i];
                        xv[tt][i * 8 + 0] = bflo(w.x); xv[tt][i * 8 + 1] = bfhi(w.x); xv[tt][i * 8 + 2] = bflo(w.y); xv[tt][i * 8 + 3] = bfhi(w.y); xv[tt][i * 8 + 4] = bflo(w.z); xv[tt][i * 8 + 5] = bfhi(w.z); xv[tt][i * 8 + 6] = bflo(w.w); xv[tt][i * 8 + 7] = bfhi(w.w); }
            } else {
                const float* xin = (const float*)xin_;
#pragma unroll
                for (int tt = 0; tt < 2; ++tt)
#pragma unroll
                    for (int i = 0; i < 4; ++i) { const f32x4 x0 = *FX_GC(f32x4, xin + (size_t)(t0 + tt) * 2048 + i * 512 + lane * 8), x1 = *FX_GC(f32x4, xin + (size_t)(t0 + tt) * 2048 + i * 512 + lane * 8 + 4);
                        xv[tt][i * 8 + 0] = x0[0]; xv[tt][i * 8 + 1] = x0[1]; xv[tt][i * 8 + 2] = x0[2]; xv[tt][i * 8 + 3] = x0[3]; xv[tt][i * 8 + 4] = x1[0]; xv[tt][i * 8 + 5] = x1[1]; xv[tt][i * 8 + 6] = x1[2]; xv[tt][i * 8 + 7] = x1[3]; }
#pragma unroll
                for (int i = 0; i < 4; ++i) { ca[2 * i] = *FX_GC(f32x4, cf + i * 512 + lane * 8); ca[2 * i + 1] = *FX_GC(f32x4, cf + i * 512 + lane * 8 + 4); }
            }
            float ssy0 = 0.f, ssy1 = 0.f;
#pragma unroll
            for (int i = 0; i < 4; ++i) { const u32x4 w0 = yw[0][i], w1 = yw[1][i];
#pragma unroll
                for (int q = 0; q < 4; ++q) { const float l0 = bflo(w0[q]), h0 = bfhi(w0[q]), l1 = bflo(w1[q]), h1 = bfhi(w1[q]); ssy0 += l0 * l0 + h0 * h0; ssy1 += l1 * l1 + h1 * h1; } }
#pragma unroll
            for (int o = 32; o >= 1; o >>= 1) { ssy0 += __shfl_xor(ssy0, o); ssy1 += __shfl_xor(ssy1, o); }
            const float ry0 = rsqrtf(ssy0 * (1.f / 2048.f) + EPS), ry1 = rsqrtf(ssy1 * (1.f / 2048.f) + EPS);
            float ssx0 = 0.f, ssx1 = 0.f;
#pragma unroll
            for (int i = 0; i < 4; ++i) { const u32x4 w0 = yw[0][i], w1 = yw[1][i];
#pragma unroll
                for (int j = 0; j < 8; ++j) { const float a = ca[2 * i + (j >> 2)][j & 3];
                    const float y0 = (j & 1) ? bfhi(w0[j >> 1]) : bflo(w0[j >> 1]), y1 = (j & 1) ? bfhi(w1[j >> 1]) : bflo(w1[j >> 1]);
                    xv[0][i * 8 + j] += a * (y0 * ry0); xv[1][i * 8 + j] += a * (y1 * ry1);
                    ssx0 += xv[0][i * 8 + j] * xv[0][i * 8 + j]; ssx1 += xv[1][i * 8 + j] * xv[1][i * 8 + j]; } }
            f32x4 cb[8], cc[8];
#pragma unroll
            for (int i = 0; i < 4; ++i) { cb[2 * i] = *FX_GC(f32x4, cf + 2048 + i * 512 + lane * 8); cb[2 * i + 1] = *FX_GC(f32x4, cf + 2048 + i * 512 + lane * 8 + 4);
                cc[2 * i] = *FX_GC(f32x4, cf + 4096 + i * 512 + lane * 8); cc[2 * i + 1] = *FX_GC(f32x4, cf + 4096 + i * 512 + lane * 8 + 4); }
#pragma unroll
            for (int tt = 0; tt < 2; ++tt)
#pragma unroll
                for (int i = 0; i < 4; ++i) { u32x4 xo; xo.x = cvt_pk_bf16(xv[tt][i * 8 + 0], xv[tt][i * 8 + 1]); xo.y = cvt_pk_bf16(xv[tt][i * 8 + 2], xv[tt][i * 8 + 3]); xo.z = cvt_pk_bf16(xv[tt][i * 8 + 4], xv[tt][i * 8 + 5]); xo.w = cvt_pk_bf16(xv[tt][i * 8 + 6], xv[tt][i * 8 + 7]);
                    *FX_GM(u32x4, XRES + (size_t)(t0 + tt) * 2048 + i * 512 + lane * 8) = xo; }
#pragma unroll
            for (int o = 32; o >= 1; o >>= 1) { ssx0 += __shfl_xor(ssx0, o); ssx1 += __shfl_xor(ssx1, o); }
            const float rx0 = rsqrtf(ssx0 * (1.f / 2048.f) + EPS), rx1 = rsqrtf(ssx1 * (1.f / 2048.f) + EPS);
#pragma unroll
            for (int tt = 0; tt < 2; ++tt) { const float rx = tt ? rx1 : rx0;
#pragma unroll
                for (int i = 0; i < 4; ++i) { const int c = i * 512 + lane * 8;
                    float hv[8];
#pragma unroll
                    for (int j = 0; j < 8; ++j) hv[j] = xv[tt][i * 8 + j] * rx * cb[2 * i + (j >> 2)][j & 3] + cc[2 * i + (j >> 2)][j & 3];
                    u32x2 w; w.x = cvt_pk4_fp8(hv[0], hv[1], hv[2], hv[3]); w.y = cvt_pk4_fp8(hv[4], hv[5], hv[6], hv[7]);
                    *FX_GM(u32x2, HA8 + (size_t)(t0 + tt) * 2048 + c) = w;
                    *(FX_LAS f32x4*)(h2s + (tok0 + tt) * H2S_LD + c) = (f32x4){hv[0], hv[1], hv[2], hv[3]};
                    *(FX_LAS f32x4*)(h2s + (tok0 + tt) * H2S_LD + c + 4) = (f32x4){hv[4], hv[5], hv[6], hv[7]}; } }
        }
        f32x4 acc[4];
#pragma unroll
        for (int j = 0; j < 4; ++j) acc[j] = (f32x4){0.f, 0.f, 0.f, 0.f};
        {
            const char* rwb = (const char*)router_w + (size_t)__builtin_amdgcn_readfirstlane(wid) * (256 * 64 * 4);
            const unsigned loff = (unsigned)(g4 * 64 + 4 * i16) * 4u;
            f32x4 bwA[8], bwB[8];
            { unsigned o_ = loff; asm volatile("" : "+v"(o_));
#pragma unroll
              for (int q = 0; q < 8; ++q) bwA[q] = *FX_GC(f32x4, rwb + o_ + q * 1024); }
            __syncthreads();
#pragma unroll
            for (int kb = 0; kb < 8; ++kb) {
                if (kb < 7) { unsigned o_ = loff + (kb + 1) * 8192; asm volatile("" : "+v"(o_));
#pragma unroll
                    for (int q = 0; q < 8; ++q) { const f32x4 v = *FX_GC(f32x4, rwb + o_ + q * 1024); if (kb & 1) bwA[q] = v; else bwB[q] = v; } }
#pragma unroll
                for (int q = 0; q < 8; ++q) { const int k = 256 * wid + 4 * (kb * 8 + q) + g4;
                    const float a = h2s[i16 * H2S_LD + k]; const f32x4 bw = (kb & 1) ? bwB[q] : bwA[q];
                    acc[0] = __builtin_amdgcn_mfma_f32_16x16x4f32(a, bw[0], acc[0], 0, 0, 0);
                    acc[1] = __builtin_amdgcn_mfma_f32_16x16x4f32(a, bw[1], acc[1], 0, 0, 0);
                    acc[2] = __builtin_amdgcn_mfma_f32_16x16x4f32(a, bw[2], acc[2], 0, 0, 0);
                    acc[3] = __builtin_amdgcn_mfma_f32_16x16x4f32(a, bw[3], acc[3], 0, 0, 0); } }
        }
        __syncthreads();
        { FX_LAS float* part = h2s; const int i16 = lane & 15, g = lane >> 4;
#pragma unroll
          for (int j = 0; j < 4; ++j)
#pragma unroll
            for (int r = 0; r < 4; ++r) part[(wid * 16 + 4 * g + r) * 64 + 4 * i16 + j] = acc[j][r]; }
        __syncthreads();
#pragma unroll 1
        for (int tt = 0; tt < 2; ++tt) {
            const int tok = 2 * wid + tt, t = unit * RT + tok;
            float lg = 0.f;
#pragma unroll
            for (int w = 0; w < 8; ++w) lg += h2s[(w * 16 + tok) * 64 + lane];
            const float score = 1.f / (1.f + expf(-lg));
            float v = score + router_bias[lane];
            int my_e = 0; float my_s = 0.f, sum = 0.f;
#pragma unroll
            for (int k = 0; k < 6; ++k) {
                const float m = wave_max(v);
                const unsigned long long bal = __ballot(v == m);
                const int win = __ffsll((long long)bal) - 1;
                const float sw = __shfl(score, win);
                sum += sw; if (lane == k) { my_e = win; my_s = sw; }
                if (lane == win) v = -3.0e38f;
            }
            if (lane < 6) { SELE[(size_t)t * 6 + lane] = my_e; SELG[(size_t)t * 6 + lane] = my_s / sum * 2.5f; __hip_atomic_fetch_add(hist + my_e, 1, __ATOMIC_RELAXED, __HIP_MEMORY_SCOPE_WORKGROUP); }
        }
        __syncthreads();
    }
    if (tid < 64) { const int hv = hist[tid]; const int base = atomicAdd(CNT + tid, hv); WGBASE[wg * 64 + tid] = base; }
}

__device__ __forceinline__ void p8_phase(FX_LAS unsigned char* lds, const int* SELE, const float* SELG, const int* CNT, const int* WGBASE, int* ROWTOK, float* ROWG, int* SLOT, int wg, int nwg, int tidp) {
    int tid_ = tidp; asm volatile("" : "+v"(tid_));
    const int tid = tid_;
    FX_LAS int* pstart = (FX_LAS int*)lds; FX_LAS int* off = pstart + 80;
    if (tid < 64) { const int pc = (CNT[tid] + 255) & ~255; int incl = pc;
#pragma unroll
        for (int o = 1; o < 64; o <<= 1) { const int t2 = __shfl_up(incl, o); if (tid >= o) incl += t2; }
        pstart[tid] = 16384 + incl - pc; if (tid == 63) pstart[64] = 16384 + incl; }
    __syncthreads();
    if (tid < 64) off[tid] = pstart[tid] + WGBASE[wg * 64 + tid];
    __syncthreads();
    for (int unit = wg; unit < T / RT; unit += nwg) {
        if (tid < RT * 6) { const int t = unit * RT + tid / 6, k = tid % 6; const int e = SELE[(size_t)t * 6 + k];
            const int pos = __hip_atomic_fetch_add(off + e, 1, __ATOMIC_RELAXED, __HIP_MEMORY_SCOPE_WORKGROUP);
            ROWTOK[pos] = t; ROWG[pos] = SELG[(size_t)t * 6 + k]; SLOT[(size_t)t * 6 + k] = pos; }
    }
    for (int e = wg; e < 64; e += nwg) { const int a = pstart[e] + CNT[e], b = pstart[e + 1]; for (int r = a + tid; r < b; r += 512) { ROWTOK[r] = 0; ROWG[r] = 0.f; } }
    for (int r = wg * 512 + tid; r < 16384; r += nwg * 512) { ROWTOK[r] = r; ROWG[r] = 1.f; }
}

struct MoeSched {
    static constexpr bool GATHER = true;
    FX_LAS const unsigned char* tile_e; int ntiles, npn, nunits, G, c;
    const int* rowtok; int lda_b; const char* Bt; size_t estride_b, pnstride_b;
    __device__ __forceinline__ bool next(int i, Unit& u) const {
        const long L = (long)i * G + c; if (L >= nunits) return false;
        int id = (int)L; { const int q = nunits / NXCD, r = nunits % NXCD, xcd = id % NXCD, off = id / NXCD; id = (xcd < r ? xcd * (q + 1) : r * (q + 1) + (xcd - r) * q) + off; }
        u.pm = id / npn; u.pn = id - u.pm * npn; u.e = tile_e[u.pm]; return true;
    }
    __device__ __forceinline__ unsigned a_row_off(const Unit& u, int R) const { const int row = u.pm * BM + R; return (unsigned)(rowtok ? rowtok[row] : row) * (unsigned)lda_b; }
    __device__ __forceinline__ const char* b_ptr(const Unit& u) const { return Bt + (size_t)u.e * estride_b + (size_t)u.pn * pnstride_b; }
};
__device__ __forceinline__ int moe_sched_build(FX_LAS unsigned char* tab, const int* CNT, int tidp) {
    FX_LAS int* nt = (FX_LAS int*)(tab + 512);
    int tid_ = tidp; asm volatile("" : "+v"(tid_));
    if (tid_ < 64) { const int n = (CNT[tid_] + 255) >> 8; int incl = n;
#pragma unroll
        for (int o = 1; o < 64; o <<= 1) { const int t2 = __shfl_up(incl, o); if (tid_ >= o) incl += t2; }
        const int st0 = 64 + incl - n; for (int j = 0; j < n; ++j) tab[st0 + j] = (unsigned char)tid_;
        tab[tid_] = 64; if (tid_ == 63) nt[0] = 64 + incl; }
    __syncthreads();
    return nt[0];
}
struct EpiGateUp {
    static constexpr bool PERM = true;
    unsigned char* HID;
    __device__ __forceinline__ void operator()(const f32x4 (&acc)[2][2][4][2], const Unit& u, int wr, int wc, int fr, int fq) const {
        const int row0 = u.pm * BM + wr * 64 + fr, col0 = u.pn * 128 + wc * 32 + 8 * fq;
#pragma unroll
        for (int ai = 0; ai < 2; ++ai)
#pragma unroll
            for (int m = 0; m < 4; ++m) { const int row = row0 + ai * HALF + m * 16;
                float o[8];
#pragma unroll
                for (int n = 0; n < 2; ++n)
#pragma unroll
                    for (int j = 0; j < 4; ++j) { const float g = acc[ai][0][m][n][j] * W8_INV, up = acc[ai][1][m][n][j] * W8_INV; o[n * 4 + j] = g * __builtin_amdgcn_rcpf(1.f + __expf(-g)) * up; }
                u32x2 w; w.x = cvt_pk4_fp8(o[0], o[1], o[2], o[3]); w.y = cvt_pk4_fp8(o[4], o[5], o[6], o[7]);
                *(u32x2*)(HID + (size_t)row * 512 + col0) = w; }
    }
    __device__ __forceinline__ void e32(const f32x16 (&acc3)[2][2][2], const Unit& u, int wr, int wc, int lane) const {
        const int j = lane & 31, hi = lane >> 5;
#pragma unroll
        for (int ai = 0; ai < 2; ++ai)
#pragma unroll
            for (int mb = 0; mb < 2; ++mb) { const int row = u.pm * BM + ai * HALF + wr * 64 + mb * 32 + j; unsigned char* rowp = HID + (size_t)row * 512 + u.pn * 128 + wc * 32 + 4 * hi;
#pragma unroll
                for (int g = 0; g < 4; ++g) { float o[4];
#pragma unroll
                    for (int q = 0; q < 4; ++q) { const float gt = acc3[ai][0][mb][4 * g + q] * W8_INV, up = acc3[ai][1][mb][4 * g + q] * W8_INV; o[q] = gt * __builtin_amdgcn_rcpf(1.f + __expf(-gt)) * up; }
                    *(unsigned*)(rowp + 8 * g) = cvt_pk4_fp8(o[0], o[1], o[2], o[3]); } }
    }
};
struct EpiDown {
    static constexpr bool PERM = true;
    unsigned char* YR; const float* ROWG; int nostore;
    __device__ __forceinline__ void operator()(const f32x4 (&acc)[2][2][4][2], const Unit& u, int wr, int wc, int fr, int fq) const {
        const int row0 = u.pm * BM + wr * 64 + fr, col0 = u.pn * BM + wc * 32 + 8 * fq;
        float gs[2][4];
#pragma unroll
        for (int ai = 0; ai < 2; ++ai)
#pragma unroll
            for (int m = 0; m < 4; ++m) gs[ai][m] = ROWG[row0 + ai * HALF + m * 16];
#pragma unroll
        for (int ai = 0; ai < 2; ++ai)
#pragma unroll
            for (int m = 0; m < 4; ++m) { const int row = row0 + ai * HALF + m * 16; const float g = gs[ai][m] * W8_INV; unsigned char* rowp = YR + (size_t)row * 2048 + col0;
#pragma unroll
                for (int bj = 0; bj < 2; ++bj) { const f32x4 v0 = acc[ai][bj][m][0] * g, v1 = acc[ai][bj][m][1] * g;
                    u32x2 w; w.x = cvt_pk4_fp8(v0[0], v0[1], v0[2], v0[3]); w.y = cvt_pk4_fp8(v1[0], v1[1], v1[2], v1[3]);
                    if (!FX_NOEPI || !nostore || (w.x == 0x12345678u && w.y == 0x9abcdef0u))
                    *(u32x2*)(rowp + bj * HALF) = w; } }
    }
    __device__ __forceinline__ void e32(const f32x16 (&acc3)[2][2][2], const Unit& u, int wr, int wc, int lane) const {
        const int j = lane & 31, hi = lane >> 5;
#pragma unroll
        for (int ai = 0; ai < 2; ++ai)
#pragma unroll
            for (int mb = 0; mb < 2; ++mb) { const int row = u.pm * BM + ai * HALF + wr * 64 + mb * 32 + j; const float gsc = ROWG[row] * W8_INV;
#pragma unroll
                for (int bj = 0; bj < 2; ++bj) { unsigned char* rowp = YR + (size_t)row * 2048 + u.pn * BM + bj * HALF + wc * 32 + 4 * hi;
#pragma unroll
                    for (int g = 0; g < 4; ++g) *(unsigned*)(rowp + 8 * g) = cvt_pk4_fp8(acc3[ai][bj][mb][4 * g] * gsc, acc3[ai][bj][mb][4 * g + 1] * gsc, acc3[ai][bj][mb][4 * g + 2] * gsc, acc3[ai][bj][mb][4 * g + 3] * gsc); } }
    }
};
__device__ __forceinline__ void p9_phase(FX_LAS unsigned char* lds, const unsigned char* HA, const unsigned char* WGU, const int* CNT, const int* ROWTOK, unsigned char* HID, int wg, int nwg, int tidp, const int noepi = 0) {
    FX_LAS unsigned char* tab = lds + STAGE_BYTES;
    const int ntiles = moe_sched_build(tab, CNT, tidp);
    MoeSched Sc; Sc.tile_e = tab; Sc.ntiles = ntiles; Sc.npn = 4; Sc.nunits = ntiles * 4; Sc.G = nwg; Sc.c = wg; Sc.rowtok = ROWTOK; Sc.lda_b = 2048; Sc.Bt = (const char*)WGU; Sc.estride_b = (size_t)1024 * 2048; Sc.pnstride_b = (size_t)256 * 2048;
    EpiGateUp E; E.HID = HID;
    gemm_phase<EpiGateUp, MoeSched, true>(lds, (const char*)HA, 2048, Sc, E, tidp, noepi);
}
__device__ __forceinline__ void p10_phase(FX_LAS unsigned char* lds, const unsigned char* HID, const unsigned char* WDN, const int* CNT, const float* ROWG, unsigned char* YR, int wg, int nwg, int tidp, const int noepi = 0) {
    FX_LAS unsigned char* tab = lds + STAGE_BYTES;
    const int ntiles = moe_sched_build(tab, CNT, tidp);
    MoeSched Sc; Sc.tile_e = tab; Sc.ntiles = ntiles; Sc.npn = 8; Sc.nunits = ntiles * 8; Sc.G = nwg; Sc.c = wg; Sc.rowtok = nullptr; Sc.lda_b = 512; Sc.Bt = (const char*)WDN; Sc.estride_b = (size_t)2048 * 512; Sc.pnstride_b = (size_t)256 * 512;
    EpiDown E; E.YR = YR; E.ROWG = ROWG; E.nostore = (noepi == 2);
    gemm_phase<EpiDown, MoeSched, true>(lds, (const char*)HID, 512, Sc, E, tidp, noepi == 1);
}
template <bool OUTF32>
__device__ __forceinline__ void p11_phase(const bf16_t* x1, const unsigned char* YR, const int* SLOT, const float* coef_l, const float* coef_next  , void* xout_, bf16_t* HA, int wg, int nwg, int tidp) {
    int tid_ = tidp; asm volatile("" : "+v"(tid_));
    const int wid = __builtin_amdgcn_readfirstlane(tid_ >> 6), lane = tid_ & 63;
    for (int t = wg * 8 + wid; t < T; t += nwg * 8) {
        const int b = t / S; const float* cf = coef_l + (size_t)b * 6 * 2048;
        int rows[7]; rows[0] = t;
        { int sl[6];
#pragma unroll
          for (int k = 0; k < 6; ++k) sl[k] = *FX_GC(int, SLOT + (size_t)t * 6 + k);
#pragma unroll
          for (int k = 0; k < 6; ++k) rows[k + 1] = __builtin_amdgcn_readfirstlane(sl[k]); }
        u32x2 ra[4][4];
#pragma unroll
        for (int k = 0; k < 4; ++k)
#pragma unroll
            for (int i = 0; i < 4; ++i) ra[k][i] = *FX_GC(u32x2, YR + (size_t)rows[k] * 2048 + i * 512 + lane * 8);
        u32x4 xw[4];
#pragma unroll
        for (int i = 0; i < 4; ++i) xw[i] = *FX_GC(u32x4, x1 + (size_t)t * 2048 + i * 512 + lane * 8);
        float yv[32];
#pragma unroll
        for (int j = 0; j < 32; ++j) yv[j] = 0.f;
#define FX_ACC8(W, I) do { const f32x2 a0 = __builtin_amdgcn_cvt_pk_f32_fp8((int)(W).x, false), a1 = __builtin_amdgcn_cvt_pk_f32_fp8((int)(W).x, true), a2 = __builtin_amdgcn_cvt_pk_f32_fp8((int)(W).y, false), a3 = __builtin_amdgcn_cvt_pk_f32_fp8((int)(W).y, true); \
            yv[(I) * 8 + 0] += a0[0]; yv[(I) * 8 + 1] += a0[1]; yv[(I) * 8 + 2] += a1[0]; yv[(I) * 8 + 3] += a1[1]; yv[(I) * 8 + 4] += a2[0]; yv[(I) * 8 + 5] += a2[1]; yv[(I) * 8 + 6] += a3[0]; yv[(I) * 8 + 7] += a3[1]; } while (0)
#pragma unroll
        for (int k = 0; k < 4; ++k)
#pragma unroll
            for (int i = 0; i < 4; ++i) FX_ACC8(ra[k][i], i);
        u32x2 rb[3][4];
#pragma unroll
        for (int k = 0; k < 3; ++k)
#pragma unroll
            for (int i = 0; i < 4; ++i) rb[k][i] = *FX_GC(u32x2, YR + (size_t)rows[4 + k] * 2048 + i * 512 + lane * 8);
        f32x4 cd[8];
#pragma unroll
        for (int i = 0; i < 4; ++i) { cd[2 * i] = *FX_GC(f32x4, cf + 3 * 2048 + i * 512 + lane * 8); cd[2 * i + 1] = *FX_GC(f32x4, cf + 3 * 2048 + i * 512 + lane * 8 + 4); }
#pragma unroll
        for (int k = 0; k < 3; ++k)
#pragma unroll
            for (int i = 0; i < 4; ++i) FX_ACC8(rb[k][i], i);
#undef FX_ACC8
        float ss = 0.f;
#pragma unroll
        for (int j = 0; j < 32; ++j) ss += yv[j] * yv[j];
        ss = wave_sum(ss); const float ry = rsqrtf(ss * (1.f / 2048.f) + EPS); float ssx = 0.f;
#pragma unroll
        for (int i = 0; i < 4; ++i) { const u32x4 w = xw[i];
            const float xs[8] = {bflo(w.x), bfhi(w.x), bflo(w.y), bfhi(w.y), bflo(w.z), bfhi(w.z), bflo(w.w), bfhi(w.w)};
#pragma unroll
            for (int j = 0; j < 8; ++j) { yv[i * 8 + j] = xs[j] + cd[2 * i + (j >> 2)][j & 3] * (yv[i * 8 + j] * ry); ssx += yv[i * 8 + j] * yv[i * 8 + j]; } }
        f32x4 ce[8], cg[8];
        if (coef_next) { const float* cn = coef_next + (size_t)b * 6 * 2048;
#pragma unroll
            for (int i = 0; i < 4; ++i) { ce[2 * i] = *FX_GC(f32x4, cn + 4 * 2048 + i * 512 + lane * 8); ce[2 * i + 1] = *FX_GC(f32x4, cn + 4 * 2048 + i * 512 + lane * 8 + 4);
                cg[2 * i] = *FX_GC(f32x4, cn + 5 * 2048 + i * 512 + lane * 8); cg[2 * i + 1] = *FX_GC(f32x4, cn + 5 * 2048 + i * 512 + lane * 8 + 4); } }
#pragma unroll
        for (int i = 0; i < 4; ++i) { const int c = i * 512 + lane * 8;
            if constexpr (OUTF32) { float* xout = (float*)xout_; *FX_GM(f32x4, xout + (size_t)t * 2048 + c) = (f32x4){yv[i * 8 + 0], yv[i * 8 + 1], yv[i * 8 + 2], yv[i * 8 + 3]};
                *FX_GM(f32x4, xout + (size_t)t * 2048 + c + 4) = (f32x4){yv[i * 8 + 4], yv[i * 8 + 5], yv[i * 8 + 6], yv[i * 8 + 7]}; }
            else { u32x4 xo; xo.x = cvt_pk_bf16(yv[i * 8 + 0], yv[i * 8 + 1]); xo.y = cvt_pk_bf16(yv[i * 8 + 2], yv[i * 8 + 3]); xo.z = cvt_pk_bf16(yv[i * 8 + 4], yv[i * 8 + 5]); xo.w = cvt_pk_bf16(yv[i * 8 + 6], yv[i * 8 + 7]);
                *FX_GM(u32x4, (bf16_t*)xout_ + (size_t)t * 2048 + c) = xo; } }
        if (coef_next) { ssx = wave_sum(ssx); const float rx = rsqrtf(ssx * (1.f / 2048.f) + EPS);
#pragma unroll
            for (int i = 0; i < 4; ++i) { const int c = i * 512 + lane * 8;
                float hv[8];
#pragma unroll
                for (int j = 0; j < 8; ++j) hv[j] = yv[i * 8 + j] * rx * ce[2 * i + (j >> 2)][j & 3] + cg[2 * i + (j >> 2)][j & 3];
#ifdef FX_WIN8
                u32x2 w; w.x = cvt_pk4_fp8(hv[0], hv[1], hv[2], hv[3]); w.y = cvt_pk4_fp8(hv[4], hv[5], hv[6], hv[7]);
                *FX_GM(u32x2, (unsigned char*)HA + (size_t)t * 2048 + c) = w; } }
#else
                u32x4 w; w.x = cvt_pk_bf16(hv[0], hv[1]); w.y = cvt_pk_bf16(hv[2], hv[3]); w.z = cvt_pk_bf16(hv[4], hv[5]); w.w = cvt_pk_bf16(hv[6], hv[7]);
                *FX_GM(u32x4, HA + (size_t)t * 2048 + c) = w; } }
#endif
    }
}
}
namespace fx {
#ifndef FX_SD_A
#define FX_SD_A 2
#endif
#ifndef FX_SD_B
#define FX_SD_B 1
#endif
#ifndef FX_NQR_B
#define FX_NQR_B 8
#endif
#define FX_SBAR() __builtin_amdgcn_sched_barrier(0)
__device__ __forceinline__ int crow(int r, int hi) { return (r & 3) + 8 * (r >> 2) + 4 * hi; }
__device__ __forceinline__ int v_st(int k, int c) { const int kk = (k & ~0xC) | ((k & 4) << 1) | ((k & 8) >> 1); return ((kk >> 3) * 4 + (c >> 5)) * 512 + ((kk & 7) * 32 + (c & 31)) * 2; }
__device__ __forceinline__ int v_rd_base(int lane) { return ((lane & 3) << 3) | (((lane >> 2) & 3) << 6) | (((lane >> 4) & 1) << 5) | (((lane >> 5) & 1) << 8); }
constexpr int v_rd_off(int d0, int ks, int half) { return d0 * 512 + ks * 4096 + half * 2048; }
template <int OFF> __device__ __forceinline__ s16x4 tr_read(int vb) { s16x4 r; asm volatile("ds_read_b64_tr_b16 %0, %1 offset:%2" : "=&v"(r) : "v"(vb), "i"(OFF) : "memory"); return r; }
#define FX_PK(L, H) (bf16x8){L[0], L[1], L[2], L[3], H[0], H[1], H[2], H[3]}
template <int D0> __device__ __forceinline__ void pv_one(f32x16& od, int vb, bf16x8 pa0, bf16x8 pa1, bf16x8 pa2, bf16x8 pa3) {
    const s16x4 l0 = tr_read<v_rd_off(D0, 0, 0)>(vb), h0 = tr_read<v_rd_off(D0, 0, 1)>(vb), l1 = tr_read<v_rd_off(D0, 1, 0)>(vb), h1 = tr_read<v_rd_off(D0, 1, 1)>(vb);
    const s16x4 l2 = tr_read<v_rd_off(D0, 2, 0)>(vb), h2 = tr_read<v_rd_off(D0, 2, 1)>(vb), l3 = tr_read<v_rd_off(D0, 3, 0)>(vb), h3 = tr_read<v_rd_off(D0, 3, 1)>(vb);
    asm volatile("s_waitcnt lgkmcnt(0)" ::: "memory"); FX_SBAR();
    od = __builtin_amdgcn_mfma_f32_32x32x16_bf16(pa0, FX_PK(l0, h0), od, 0, 0, 0);
    od = __builtin_amdgcn_mfma_f32_32x32x16_bf16(pa1, FX_PK(l1, h1), od, 0, 0, 0);
    od = __builtin_amdgcn_mfma_f32_32x32x16_bf16(pa2, FX_PK(l2, h2), od, 0, 0, 0);
    od = __builtin_amdgcn_mfma_f32_32x32x16_bf16(pa3, FX_PK(l3, h3), od, 0, 0, 0);
}
__device__ __forceinline__ void pv_d0(f32x16* o, int vb, bf16x8 pa0, bf16x8 pa1, bf16x8 pa2, bf16x8 pa3) {
    pv_one<0>(o[0], vb, pa0, pa1, pa2, pa3); pv_one<1>(o[1], vb, pa0, pa1, pa2, pa3); pv_one<2>(o[2], vb, pa0, pa1, pa2, pa3); pv_one<3>(o[3], vb, pa0, pa1, pa2, pa3);
}
#define FX_PK4(P, BASE, OUT) do { unsigned a0 = cvt_pk_bf16(P[BASE + 0], P[BASE + 1]), a1 = cvt_pk_bf16(P[BASE + 2], P[BASE + 3]);   \
    unsigned b0 = cvt_pk_bf16(P[BASE + 4], P[BASE + 5]), b1 = cvt_pk_bf16(P[BASE + 6], P[BASE + 7]);                              \
    auto r0 = __builtin_amdgcn_permlane32_swap(a0, b0, false, false); auto r1 = __builtin_amdgcn_permlane32_swap(a1, b1, false, false); \
    u32x4 w = {r0[0], r1[0], r0[1], r1[1]}; OUT = *reinterpret_cast<bf16x8*>(&w); } while (0)

template <int DQK> struct AttnC {
    static constexpr int NQ = DQK / 16, KROW = DQK * 2, SHM_V = 64 * 128 * 2, SHM_K = 64 * DQK * 2, NQR = (DQK == 128 ? 8 : FX_NQR_B)  , QX = (NQ - NQR) * 8 * 64 * 16, SHM = 2 * SHM_V + 2 * SHM_K + 8 * 64 * 4 + QX;
    static constexpr float SCALE = DQK == 128 ? 0.088388347648318440f : 0.072168783648703220f;
    static constexpr float THR = 8.f;
};
#define FX_KSWZ(row, colB) ((row) * C::KROW + ((colB) ^ (((row) & 7) << 4)))

template <int DQK> __device__ __forceinline__ void partialSM(f32x16& p0, f32x16& p1, float& m_reg, float& mn, float& alpha) {
    using C = AttnC<DQK>;
    constexpr float Cc = C::SCALE * 1.4426950408889634f;
    float pmax = p0[0];
#pragma unroll
    for (int r = 1; r < 16; ++r) pmax = fmaxf(pmax, p0[r]);
#pragma unroll
    for (int r = 0; r < 16; ++r) pmax = fmaxf(pmax, p1[r]);
    { auto rr = __builtin_amdgcn_permlane32_swap(__float_as_uint(pmax), __float_as_uint(pmax), false, false); pmax = fmaxf(__uint_as_float(rr[0]), __uint_as_float(rr[1])); }
    if (__builtin_expect(__all(pmax - m_reg <= C::THR / C::SCALE), 1)) { mn = m_reg; alpha = 1.f; }
    else { mn = fmaxf(m_reg, pmax); alpha = __builtin_amdgcn_exp2f((m_reg - mn) * Cc); m_reg = mn; }
    const float mnC = -mn * Cc;
#pragma unroll
    for (int r = 0; r < 16; ++r) p0[r] = fmaf(p0[r], Cc, mnC);
#pragma unroll
    for (int r = 0; r < 16; ++r) p1[r] = fmaf(p1[r], Cc, mnC);
#pragma unroll
    for (int r = 0; r < 16; ++r) p0[r] = __builtin_amdgcn_exp2f(p0[r]);
}
__device__ __forceinline__ void finishSM(f32x16& p0, f32x16& p1, float alpha, float& l_reg, bf16x8& pa0, bf16x8& pa1, bf16x8& pa2, bf16x8& pa3) {
#pragma unroll
    for (int r = 0; r < 16; ++r) p1[r] = __builtin_amdgcn_exp2f(p1[r]);
    float ps = 0;
#pragma unroll
    for (int r = 0; r < 16; ++r) ps += p0[r];
#pragma unroll
    for (int r = 0; r < 16; ++r) ps += p1[r];
    { auto rr = __builtin_amdgcn_permlane32_swap(__float_as_uint(ps), __float_as_uint(ps), false, false); ps = __uint_as_float(rr[0]) + __uint_as_float(rr[1]); }
    l_reg = l_reg * alpha + ps;
    FX_PK4(p0, 0, pa0); FX_PK4(p0, 8, pa1); FX_PK4(p1, 0, pa2); FX_PK4(p1, 8, pa3);
}
template <int DQK> __device__ __forceinline__ void qkt(f32x16& p0, f32x16& p1, const char* Ks, const bf16x8* qr, const char* qx  , int r32, int hi) {
    using C = AttnC<DQK>;
    p0 = f32x16{}; p1 = f32x16{};
#pragma unroll
    for (int d0 = 0; d0 < C::NQ; ++d0) { const int cb = (d0 * 16 + hi * 8) * 2;
        const bf16x8 qf = d0 < C::NQR ? qr[d0 < C::NQR ? d0 : 0] : *reinterpret_cast<const bf16x8*>(qx + (d0 - C::NQR) * 1024);
        const bf16x8 b0 = *reinterpret_cast<const bf16x8*>(Ks + FX_KSWZ(r32, cb));
        const bf16x8 b1 = *reinterpret_cast<const bf16x8*>(Ks + FX_KSWZ(32 + r32, cb));
        p0 = __builtin_amdgcn_mfma_f32_32x32x16_bf16(b0, qf, p0, 0, 0, 0);
        p1 = __builtin_amdgcn_mfma_f32_32x32x16_bf16(b1, qf, p1, 0, 0, 0); }
}

template <int DQK, int SD, int LDQ, int LDK1, int LDK2, int LDV>
__device__ __forceinline__ void attn_unit(const bf16_t* __restrict__ Qb, const bf16_t* __restrict__ K1, const bf16_t* __restrict__ K2, const bf16_t* __restrict__ Vh,
                                          bf16_t* __restrict__ Ob, const float* __restrict__ gain, int seq, char* lds, int tidp) {
    using C = AttnC<DQK>;
    int tid_ = tidp; asm volatile("" : "+v"(tid_));
    const int tid = tid_, wid = __builtin_amdgcn_readfirstlane(tid >> 6)  , lane = tid & 63, r32 = lane & 31, hi = lane >> 5;
    char* V_lds = lds; char* K_lds = lds + 2 * C::SHM_V;
    float* ws = (float*)(lds + 2 * C::SHM_V + 2 * C::SHM_K) + wid * 64; float* li_l = ws; float* al_l = ws + 32;
    float m_reg = -1e30f, l_reg = 0; f32x16 o[4] = {}; bf16x8 qr[C::NQR];
    char* qx = lds + 2 * C::SHM_V + 2 * C::SHM_K + 8 * 64 * 4 + wid * ((C::NQ - C::NQR) * 1024) + lane * 16;
    const bf16_t* Qw = Qb + (long)(wid * 32 + r32) * LDQ + hi * 8;
#pragma unroll
    for (int d0 = 0; d0 < C::NQR; ++d0) qr[d0] = *reinterpret_cast<const bf16x8*>(Qw + d0 * 16);
#pragma unroll
    for (int d0 = C::NQR; d0 < C::NQ; ++d0) *reinterpret_cast<bf16x8*>(qx + (d0 - C::NQR) * 1024) = *reinterpret_cast<const bf16x8*>(Qw + d0 * 16);
    const int sr = tid >> 4, sc = (tid & 15) * 8, vst0 = v_st(sr, sc), vst1 = v_st(32 + sr, sc);
    const int vb0 = (int)(uintptr_t)V_lds + v_rd_base(lane);
    const int xr = tid >> 3, xc = (tid & 7) * 8;
    struct { bf16x8 vs0, vs1, ks0, ks1, kx; } sr_[SD];
#define FX_SLOAD(i, k0) do { sr_[i].vs0 = *reinterpret_cast<const bf16x8*>(&Vh[(long)((k0) + sr) * LDV + sc]); sr_[i].vs1 = *reinterpret_cast<const bf16x8*>(&Vh[(long)((k0) + 32 + sr) * LDV + sc]); \
    sr_[i].ks0 = *reinterpret_cast<const bf16x8*>(&K1[(long)((k0) + sr) * LDK1 + sc]); sr_[i].ks1 = *reinterpret_cast<const bf16x8*>(&K1[(long)((k0) + 32 + sr) * LDK1 + sc]); \
    if (DQK == 192) sr_[i].kx = *reinterpret_cast<const bf16x8*>(&K2[(long)((k0) + xr) * LDK2 + xc]); } while (0)
#define FX_SWRITE(b, i) do { *(bf16x8*)(V_lds + (b) * C::SHM_V + vst0) = sr_[i].vs0; *(bf16x8*)(V_lds + (b) * C::SHM_V + vst1) = sr_[i].vs1; const int kc = sc * 2; \
    *(bf16x8*)(K_lds + (b) * C::SHM_K + FX_KSWZ(sr, kc)) = sr_[i].ks0; *(bf16x8*)(K_lds + (b) * C::SHM_K + FX_KSWZ(32 + sr, kc)) = sr_[i].ks1; \
    if (DQK == 192) *(bf16x8*)(K_lds + (b) * C::SHM_K + FX_KSWZ(xr, 256 + xc * 2)) = sr_[i].kx; } while (0)
#define FX_SWAIT() do { if (SD == 1) asm volatile("s_waitcnt vmcnt(0)" ::: "memory"); else if (DQK == 192) asm volatile("s_waitcnt vmcnt(5)" ::: "memory"); else asm volatile("s_waitcnt vmcnt(4)" ::: "memory"); } while (0)
#define FX_RESC(a) do { if (__any((a) < 1.f)) { if (hi == 0) al_l[r32] = (a); asm volatile("s_waitcnt lgkmcnt(0)" ::: "memory"); \
    _Pragma("unroll") for (int d = 0; d < 4; ++d) _Pragma("unroll") for (int r = 0; r < 16; ++r) o[d][r] *= al_l[crow(r, hi)]; } } while (0)
    f32x16 pA0, pA1, pB0, pB1; float mnA, mnB, alA, alB; bf16x8 pa0, pa1, pa2, pa3; const int NT = seq / 64;
    constexpr int SE = 0, SO = SD - 1;
    FX_SLOAD(SE, 0); asm volatile("s_waitcnt vmcnt(0)" ::: "memory"); FX_SWRITE(0, SE); __syncthreads();
    qkt<DQK>(pA0, pA1, K_lds, qr, qx, r32, hi); partialSM<DQK>(pA0, pA1, m_reg, mnA, alA);
    FX_SLOAD(SO, 64); if (SD == 2) { if (2 < NT) FX_SLOAD(SE, 128); }
    FX_SWAIT(); FX_SWRITE(1, SO); __syncthreads();
    for (int j = 1; j + 1 < NT; j += 2) {
        FX_SBAR(); qkt<DQK>(pB0, pB1, K_lds + C::SHM_K, qr, qx, r32, hi);
        finishSM(pA0, pA1, alA, l_reg, pa0, pa1, pa2, pa3); FX_SBAR();
        FX_SLOAD(SO, (j + SD) * 64); FX_SBAR();
        pv_d0(o, vb0, pa0, pa1, pa2, pa3); partialSM<DQK>(pB0, pB1, m_reg, mnB, alB);
        __syncthreads(); FX_SWAIT(); FX_SWRITE(0, SE);
        FX_RESC(alB); __syncthreads();
        FX_SBAR(); qkt<DQK>(pA0, pA1, K_lds, qr, qx, r32, hi);
        finishSM(pB0, pB1, alB, l_reg, pa0, pa1, pa2, pa3); FX_SBAR();
        if (SD == 1 || j + 3 < NT) FX_SLOAD(SE, (j + 1 + SD) * 64); FX_SBAR();
        pv_d0(o, vb0 + C::SHM_V, pa0, pa1, pa2, pa3); partialSM<DQK>(pA0, pA1, m_reg, mnA, alA);
        __syncthreads(); FX_SWAIT(); FX_SWRITE(1, SO);
        FX_RESC(alA); __syncthreads();
    }
    FX_SBAR(); qkt<DQK>(pB0, pB1, K_lds + C::SHM_K, qr, qx, r32, hi);
    finishSM(pA0, pA1, alA, l_reg, pa0, pa1, pa2, pa3); FX_SBAR();
    pv_d0(o, vb0, pa0, pa1, pa2, pa3); partialSM<DQK>(pB0, pB1, m_reg, mnB, alB);
    __syncthreads(); FX_RESC(alB);
    finishSM(pB0, pB1, alB, l_reg, pa0, pa1, pa2, pa3); FX_SBAR();
    pv_d0(o, vb0 + C::SHM_V, pa0, pa1, pa2, pa3);
    if (hi == 0) li_l[r32] = l_reg; asm volatile("s_waitcnt lgkmcnt(0)" ::: "memory");
    int r32e = r32; asm volatile("" : "+v"(r32e));
    float g4[4];
#pragma unroll
    for (int d0 = 0; d0 < 4; ++d0) g4[d0] = gain[d0 * 32 + r32e];
    bf16_t* Ow = Ob + (long)(wid * 32) * 2048;
#pragma unroll
    for (int r = 0; r < 16; ++r) { const float rl = __builtin_amdgcn_rcpf(li_l[crow(r, hi)]);
        float ss = 0.f;
#pragma unroll
        for (int d0 = 0; d0 < 4; ++d0) { o[d0][r] *= rl; ss += o[d0][r] * o[d0][r]; }
        ss += __shfl_xor(ss, 1); ss += __shfl_xor(ss, 2); ss += __shfl_xor(ss, 4); ss += __shfl_xor(ss, 8); ss += __shfl_xor(ss, 16);
        const float rn = rsqrtf(ss * (1.f / 128.f) + EPS); const int orow = crow(r, hi);
#pragma unroll
#ifdef FX_WOUT8
        for (int d0 = 0; d0 < 4; ++d0) ((unsigned char*)Ob)[(long)(wid * 32 + orow) * 2048 + d0 * 32 + r32e] = (unsigned char)(__builtin_amdgcn_cvt_pk_fp8_f32(o[d0][r] * rn * g4[d0], 0.f, 0, false) & 0xff); }
#else
        for (int d0 = 0; d0 < 4; ++d0) Ow[(long)orow * 2048 + d0 * 32 + r32e] = f2bf(o[d0][r] * rn * g4[d0]); }
#endif
    __syncthreads();
#undef FX_SLOAD
#undef FX_SWRITE
#undef FX_SWAIT
#undef FX_RESC
}

__device__ __forceinline__ void attn_gqa_unit(int u, const bf16_t* QA, const bf16_t* KA, const bf16_t* PROJ, bf16_t* YM, const float* hog, char* lds, int tidp) {
    const int qb = u & 15, hh = (u >> 4) % 6, b = u / 96, kvh = hh / 3;
    const size_t t0 = (size_t)b * S;
    attn_unit<128, FX_SD_A, 768, 256, 0, PW>(QA + (t0 + qb * 256) * 768 + hh * 128, KA + t0 * 256 + kvh * 128, nullptr, PROJ + t0 * PW + O_AV + kvh * 128,
#ifdef FX_WOUT8
                                    (bf16_t*)((unsigned char*)YM + (t0 + qb * 256) * 2048 + hh * 128), hog + hh * 128, S, lds, tidp);
#else
                                    YM + (t0 + qb * 256) * 2048 + hh * 128, hog + hh * 128, S, lds, tidp);
#endif
}
__device__ __forceinline__ void attn_mla_unit(int u, const bf16_t* QB, const bf16_t* KVB, const bf16_t* KR, bf16_t* YM, const float* hog, char* lds, int tidp) {
    const int qb = u & 15, hh = (u >> 4) % 6, b = u / 96;
    const size_t t0 = (size_t)b * S;
    attn_unit<192, FX_SD_B, 1280, 1536, 64, 1536>(QB + (t0 + qb * 256) * 1280 + hh * 192, KVB + t0 * 1536 + hh * 256, KR + t0 * 64, KVB + t0 * 1536 + hh * 256 + 128,
#ifdef FX_WOUT8
                                         (bf16_t*)((unsigned char*)YM + (t0 + qb * 256) * 2048 + 768 + hh * 128), hog + 768 + hh * 128, S, lds, tidp);
#else
                                         YM + (t0 + qb * 256) * 2048 + 768 + hh * 128, hog + 768 + hh * 128, S, lds, tidp);
#endif
}
}
namespace fx {
constexpr int P3_LDS = 4096 + 2048 + 65536 + 32768;
constexpr float KSCALE = 0.08838834764831845f;
__device__ __forceinline__ float logsigmoid_f(float f) { return fminf(f, 0.f) - log1pf(__expf(-fabsf(f))); }
__device__ __forceinline__ float wave_scan_incl(float v, int lane) {
#pragma unroll
    for (int o = 1; o < 64; o <<= 1) { const float t = __shfl_up(v, o); if (lane >= o) v += t; }
    return v;
}
__device__ __forceinline__ float wave_scanmax_incl(float v, int lane) {
#pragma unroll
    for (int o = 1; o < 64; o <<= 1) { const float t = __shfl_up(v, o); if (lane >= o) v = fmaxf(v, t); }
    return v;
}
__device__ __forceinline__ float wave_rscanmax_incl(float v, int lane) {
#pragma unroll
    for (int o = 1; o < 64; o <<= 1) { const float t = __shfl_down(v, o); if (lane + o < 64) v = fmaxf(v, t); }
    return v;
}

struct P3Args {
    const bf16_t* PROJ; const float* GATES; const float* gate_b; const float* conv_w; const float* conv_b;
    const float* aq_gain; const float* ak_gain; const float* cq_gain; const float* ckv_gain;
    const float* cosA; const float* sinA; const float* cosB; const float* sinB;
    bf16_t* QA; bf16_t* KA; bf16_t* CQN; bf16_t* CKVN; bf16_t* KR; bf16_t* QC; bf16_t* KC; bf16_t* KCT; float* NLOC; float* GSC;
};
__device__ __forceinline__ void p3_phase(FX_LAS unsigned char* lds_, const P3Args& a, int wg, int nwg, int tidp) {
    char* lds = (char*)lds_;
    float* gat = (float*)lds; float* wts = (float*)(lds + 4096); char* ktile = lds + 6144; char* wv = lds + 6144 + 65536;
    for (int unit = wg; unit < T / 64; unit += nwg) {
        int tid_ = tidp; asm volatile("" : "+v"(tid_));
        const int tid = tid_, wid = tid >> 6, lane = tid & 63;
        const int b = unit >> 6, co = unit & 63; const size_t t0 = (size_t)unit * 64;
        for (int i = tid; i < 1024; i += 512) gat[i] = a.GATES[t0 * 16 + i] + a.gate_b[i & 15];
        __syncthreads();
        { const int dir = wid >> 2, h = wid & 3;
          const float logi = gat[lane * 16 + (dir * 2) * 4 + h], logf = logsigmoid_f(gat[lane * 16 + (dir * 2 + 1) * 4 + h]);
          const float pre = wave_scan_incl(logf, lane), g = __shfl(pre, 63);
          const float bb = dir ? (g - pre + logf) : pre;
          const float av = g - bb + logi, mloc = wave_max(av);
          wts[wid * 64 + lane] = __expf(av - mloc);
          if (lane == 0) { const int chain = (b * 4 + h) * 2 + dir, ci = dir ? 63 - co : co; a.GSC[(chain * 64 + ci) * 2] = g; a.GSC[(chain * 64 + ci) * 2 + 1] = mloc; } }
        __syncthreads();
        { const int c0 = 2 * tid; const bool isk = c0 >= 512; const int hk = (c0 - 512) >> 7, dk = (c0 - 512) & 127;
          float w0[5], w1[5];
#pragma unroll
          for (int j = 0; j < 5; ++j) { w0[j] = a.conv_w[j * 1024 + c0]; w1[j] = a.conv_w[j * 1024 + c0 + 1]; }
          const float cb0 = a.conv_b[c0], cb1 = a.conv_b[c0 + 1];
          float x0[5], x1[5];
          const bf16_t* src = a.PROJ + t0 * PW + O_CQ + c0;
#pragma unroll
          for (int j = 0; j < 4; ++j) { const int sa = co * 64 + j - 2; unsigned w = 0u; if (sa >= 0 && sa < S) w = *(const unsigned*)(src + (long)(j - 2) * PW); x0[j + 1] = bflo(w); x1[j + 1] = bfhi(w); }
          float nf0 = 0.f, nf1 = 0.f, nb0 = 0.f, nb1 = 0.f;
#pragma unroll 1
          for (int s0 = 0; s0 < 64; s0 += 16) {
              unsigned wl[16];
#pragma unroll
              for (int q = 0; q < 16; ++q) { const int sa = co * 64 + s0 + q + 2; wl[q] = 0u; if (sa < S) wl[q] = *(const unsigned*)(src + (long)(s0 + q + 2) * PW); }
#pragma unroll
              for (int q = 0; q < 16; ++q) { const int s = s0 + q;
#pragma unroll
                  for (int j = 0; j < 4; ++j) { x0[j] = x0[j + 1]; x1[j] = x1[j + 1]; }
                  x0[4] = bflo(wl[q]); x1[4] = bfhi(wl[q]);
                  float y0 = cb0, y1 = cb1;
#pragma unroll
                  for (int j = 0; j < 5; ++j) { y0 += w0[j] * x0[j]; y1 += w1[j] * x1[j]; }
                  y0 = silu_f(y0); y1 = silu_f(y1);
                  if (!isk) { *(unsigned*)(a.QC + (t0 + s) * 512 + c0) = cvt_pk_bf16(y0, y1); }
                  else { y0 *= KSCALE; y1 *= KSCALE; const unsigned pk = cvt_pk_bf16(y0, y1);
                      *(unsigned*)(a.KC + (t0 + s) * 512 + (c0 - 512)) = pk;
                      *(unsigned*)(ktile + hk * 16384 + v_st(s, dk & ~7) + (dk & 7) * 2) = pk;
                      const float k0 = bflo(pk), k1 = bfhi(pk); const float wf = wts[hk * 64 + s], wb = wts[(4 + hk) * 64 + s];
                      nf0 += wf * k0; nf1 += wf * k1; nb0 += wb * k0; nb1 += wb * k1; } }
          }
          if (isk) { const int chf = (b * 4 + hk) * 2, chb = chf + 1;
              *(f32x2*)(a.NLOC + ((size_t)chf * 64 + co) * 128 + dk) = (f32x2){nf0, nf1};
              *(f32x2*)(a.NLOC + ((size_t)chb * 64 + (63 - co)) * 128 + dk) = (f32x2){nb0, nb1}; } }
        __syncthreads();
#pragma unroll 1
        for (int h = 0; h < 4; ++h) {
            { const int sr = tid >> 4, sc = (tid & 15) * 8;
#pragma unroll
              for (int rr = 0; rr < 2; ++rr) { const int s = sr + 32 * rr;
                const u32x4 vw = *(const u32x4*)(a.PROJ + (t0 + s) * PW + O_CV + h * 128 + sc);
                const float wf = wts[h * 64 + s], wb = wts[(4 + h) * 64 + s];
                float v[8] = {bflo(vw.x), bfhi(vw.x), bflo(vw.y), bfhi(vw.y), bflo(vw.z), bfhi(vw.z), bflo(vw.w), bfhi(vw.w)};
                u32x4 of, ob;
                of.x = cvt_pk_bf16(v[0] * wf, v[1] * wf); of.y = cvt_pk_bf16(v[2] * wf, v[3] * wf); of.z = cvt_pk_bf16(v[4] * wf, v[5] * wf); of.w = cvt_pk_bf16(v[6] * wf, v[7] * wf);
                ob.x = cvt_pk_bf16(v[0] * wb, v[1] * wb); ob.y = cvt_pk_bf16(v[2] * wb, v[3] * wb); ob.z = cvt_pk_bf16(v[4] * wb, v[5] * wb); ob.w = cvt_pk_bf16(v[6] * wb, v[7] * wb);
                *(u32x4*)(wv + v_st(s, sc)) = of; *(u32x4*)(wv + 16384 + v_st(s, sc)) = ob; } }
            __syncthreads();
            { const int dir = wid >> 2, mb = wid & 3, r32 = lane & 31, hi = lane >> 5;
              const int va = (int)(uintptr_t)(wv + dir * 16384) + v_rd_base(lane) + mb * 512;
              const int kb = (int)(uintptr_t)(ktile + h * 16384) + v_rd_base(lane);
              f32x16 acc[4] = {};
#define FX_KC_STEP(KS) do { \
              const s16x4 al = tr_read<v_rd_off(0, KS, 0)>(va), ah = tr_read<v_rd_off(0, KS, 1)>(va); \
              const s16x4 b0l = tr_read<v_rd_off(0, KS, 0)>(kb), b0h = tr_read<v_rd_off(0, KS, 1)>(kb), b1l = tr_read<v_rd_off(1, KS, 0)>(kb), b1h = tr_read<v_rd_off(1, KS, 1)>(kb); \
              const s16x4 b2l = tr_read<v_rd_off(2, KS, 0)>(kb), b2h = tr_read<v_rd_off(2, KS, 1)>(kb), b3l = tr_read<v_rd_off(3, KS, 0)>(kb), b3h = tr_read<v_rd_off(3, KS, 1)>(kb); \
              asm volatile("s_waitcnt lgkmcnt(0)" ::: "memory"); FX_SBAR(); \
              const bf16x8 af = FX_PK(al, ah); \
              acc[0] = __builtin_amdgcn_mfma_f32_32x32x16_bf16(af, FX_PK(b0l, b0h), acc[0], 0, 0, 0); acc[1] = __builtin_amdgcn_mfma_f32_32x32x16_bf16(af, FX_PK(b1l, b1h), acc[1], 0, 0, 0); \
              acc[2] = __builtin_amdgcn_mfma_f32_32x32x16_bf16(af, FX_PK(b2l, b2h), acc[2], 0, 0, 0); acc[3] = __builtin_amdgcn_mfma_f32_32x32x16_bf16(af, FX_PK(b3l, b3h), acc[3], 0, 0, 0); } while (0)
              FX_KC_STEP(0); FX_KC_STEP(1); FX_KC_STEP(2); FX_KC_STEP(3);
#undef FX_KC_STEP
              const int chain = (b * 4 + h) * 2 + dir, ci = dir ? 63 - co : co;
              bf16_t* dst = a.KCT + ((size_t)chain * 64 + ci) * 16384 + (size_t)(mb * 32) * 128 + r32;
#pragma unroll
              for (int r = 0; r < 16; ++r) { const int v = crow(r, hi);
#pragma unroll
                  for (int nb = 0; nb < 4; ++nb) dst[v * 128 + nb * 32] = f2bf(acc[nb][r]); } }
            __syncthreads();
        }
        { const int f = lane & 31, hf = lane >> 5;
#pragma unroll 8
          for (int it = wid; it < 512; it += 8) { const int s = it >> 3, hd = it & 7; const size_t t = t0 + s;
            const bf16_t* src = a.PROJ + t * PW + hd * 128 + hf * 64;
            float x1 = bf2f(src[f]), x2 = bf2f(src[32 + f]);
            const float ss = wave_sum(x1 * x1 + x2 * x2), r = rsqrtf(ss * (1.f / 128.f) + EPS);
            const float* g = hd < 6 ? a.aq_gain : a.ak_gain;
            x1 *= r * g[hf * 64 + f]; x2 *= r * g[hf * 64 + 32 + f];
            const int pos = hf ? s : co; const float cs = a.cosA[pos * 32 + f], sn = a.sinA[pos * 32 + f];
            bf16_t* dst = hd < 6 ? a.QA + t * 768 + hd * 128 + hf * 64 : a.KA + t * 256 + (hd - 6) * 128 + hf * 64;
            dst[f] = f2bf(x1 * cs - x2 * sn); dst[32 + f] = f2bf(x2 * cs + x1 * sn); } }
#pragma unroll 4
        for (int s = wid; s < 64; s += 8) { const size_t t = t0 + s; const bf16_t* p = a.PROJ + t * PW;
            float q[6]; float ss = 0.f;
#pragma unroll
            for (int i = 0; i < 3; ++i) { const unsigned w = *(const unsigned*)(p + O_BCQ + i * 128 + lane * 2); q[2 * i] = bflo(w); q[2 * i + 1] = bfhi(w); ss += q[2 * i] * q[2 * i] + q[2 * i + 1] * q[2 * i + 1]; }
            ss = wave_sum(ss); float r = rsqrtf(ss * (1.f / 384.f) + EPS);
#pragma unroll
            for (int i = 0; i < 3; ++i) { const int c = i * 128 + lane * 2; *(unsigned*)(a.CQN + t * 384 + c) = cvt_pk_bf16(q[2 * i] * r * a.cq_gain[c], q[2 * i + 1] * r * a.cq_gain[c + 1]); }
            float kv[4]; ss = 0.f;
#pragma unroll
            for (int i = 0; i < 2; ++i) { const unsigned w = *(const unsigned*)(p + O_BCKV + i * 128 + lane * 2); kv[2 * i] = bflo(w); kv[2 * i + 1] = bfhi(w); ss += kv[2 * i] * kv[2 * i] + kv[2 * i + 1] * kv[2 * i + 1]; }
            ss = wave_sum(ss); r = rsqrtf(ss * (1.f / 256.f) + EPS);
#pragma unroll
            for (int i = 0; i < 2; ++i) { const int c = i * 128 + lane * 2; *(unsigned*)(a.CKVN + t * 256 + c) = cvt_pk_bf16(kv[2 * i] * r * a.ckv_gain[c], kv[2 * i + 1] * r * a.ckv_gain[c + 1]); }
            if (lane < 32) { const int f = lane & 15, hf = lane >> 4; const int pos = hf ? s : co; const float cs = a.cosB[pos * 16 + f], sn = a.sinB[pos * 16 + f];
                const float x1 = bf2f(p[O_BKR + hf * 32 + f]), x2 = bf2f(p[O_BKR + hf * 32 + 16 + f]);
                a.KR[t * 64 + hf * 32 + f] = f2bf(x1 * cs - x2 * sn); a.KR[t * 64 + hf * 32 + 16 + f] = f2bf(x2 * cs + x1 * sn); } }
        __syncthreads();
    }
}

__device__ __forceinline__ void scan_phase(const bf16_t* KCT, const float* NLOC, const float* GSC, bf16_t* CPREV, float* NPREV, float* MPREV, int gtid, int nthr) {
    for (int item = gtid; item < 32 * 4096; item += nthr) {
        const int chain = item >> 12, e4 = item & 4095;
        const u32x2* src = (const u32x2*)(KCT + (size_t)chain * 64 * 16384) + e4; u32x2* dst = (u32x2*)(CPREV + (size_t)chain * 64 * 16384) + e4;
        const float* gs = GSC + (size_t)chain * 128;
        const bool don = e4 < 128;
        float c0 = 0.f, c1 = 0.f, c2 = 0.f, c3 = 0.f, nn = 0.f, m = 0.f;
#pragma unroll 1
        for (int cb = 0; cb < 64; cb += 8) {
            u32x2 kc[8]; float nl[8];
#pragma unroll
            for (int j = 0; j < 8; ++j) { kc[j] = src[(size_t)(cb + j) * 4096]; nl[j] = don ? NLOC[((size_t)chain * 64 + cb + j) * 128 + e4] : 0.f; }
#pragma unroll
            for (int j = 0; j < 8; ++j) { const int ci = cb + j; const float g = gs[ci * 2], ml = gs[ci * 2 + 1];
                u32x2 o; o.x = cvt_pk_bf16(c0, c1); o.y = cvt_pk_bf16(c2, c3); dst[(size_t)ci * 4096] = o;
                if (don) NPREV[((size_t)chain * 64 + ci) * 128 + e4] = nn;
                if (e4 == 0) MPREV[chain * 64 + ci] = m;
                const float mn = fmaxf(g + m, ml), dec = __expf(g + m - mn), sl = __expf(ml - mn); m = mn;
                c0 = dec * c0 + sl * bflo(kc[j].x); c1 = dec * c1 + sl * bfhi(kc[j].x); c2 = dec * c2 + sl * bflo(kc[j].y); c3 = dec * c3 + sl * bfhi(kc[j].y);
                nn = dec * nn + sl * nl[j]; }
        }
    }
}

constexpr int MC_K = 0, MC_V = 16384, MC_CT = 32768, MC_HS = 98304, MC_HS_LD = 132, MC_SM = MC_HS + 64 * MC_HS_LD * 4, MC_LDS = MC_SM + 4096;
struct McArgs { const bf16_t* PROJ; const float* GATES; const float* gate_b; const bf16_t* QC; const bf16_t* KC; const bf16_t* CPREV; const float* NPREV; const float* MPREV; const float* hog; bf16_t* YM; };
__device__ __forceinline__ void mlstm_c_phase(FX_LAS unsigned char* lds_, const McArgs& a, int wg, int nwg, int tidp) {
    char* lds = (char*)lds_;
    using C = AttnC<128>;
    float* hs = (float*)(lds + MC_HS);
    float* sm = (float*)(lds + MC_SM);
    for (int unit = wg; unit < NB * 4 * 64; unit += nwg) {
        int tid_ = tidp; asm volatile("" : "+v"(tid_));
        const int tid = tid_, wid = tid >> 6, lane = tid & 63, r32 = lane & 31, hi = lane >> 5;
        const int co = unit & 63, h = (unit >> 6) & 3, b = unit >> 8; const size_t t0 = (size_t)b * S + co * 64;
        if (wid < 2) { const int dir = wid; const int chain = (b * 4 + h) * 2 + dir, ci = dir ? 63 - co : co;
            const float logi = a.GATES[(t0 + lane) * 16 + (dir * 2) * 4 + h] + a.gate_b[(dir * 2) * 4 + h];
            const float logf = logsigmoid_f(a.GATES[(t0 + lane) * 16 + (dir * 2 + 1) * 4 + h] + a.gate_b[(dir * 2 + 1) * 4 + h]);
            const float pre = wave_scan_incl(logf, lane), g = __shfl(pre, 63);
            const float bb = dir ? (g - pre + logf) : pre;
            const float u = logi - bb;
            const float M = dir ? wave_rscanmax_incl(u, lane) : wave_scanmax_incl(u, lane);
            const float mp = a.MPREV[chain * 64 + ci], mmj = fmaxf(mp, M);
            sm[dir * 64 + lane] = u; sm[128 + dir * 64 + lane] = mmj; sm[256 + dir * 64 + lane] = __expf(mp - mmj); sm[384 + dir * 64 + lane] = __expf(-(bb + mmj));
            sm[512 + dir * 128 + lane] = a.NPREV[((size_t)chain * 64 + ci) * 128 + lane]; sm[512 + dir * 128 + 64 + lane] = a.NPREV[((size_t)chain * 64 + ci) * 128 + 64 + lane]; }
        { const int sr = tid >> 4, sc = (tid & 15) * 8;
#pragma unroll
          for (int rr = 0; rr < 2; ++rr) { const int s = sr + 32 * rr;
            *(bf16x8*)(lds + MC_K + FX_KSWZ(s, sc * 2)) = *(const bf16x8*)(a.KC + (t0 + s) * 512 + h * 128 + sc);
            *(bf16x8*)(lds + MC_V + v_st(s, sc)) = *(const bf16x8*)(a.PROJ + (t0 + s) * PW + O_CV + h * 128 + sc); }
#pragma unroll
          for (int dir = 0; dir < 2; ++dir) { const int chain = (b * 4 + h) * 2 + dir, ci = dir ? 63 - co : co; const bf16_t* ct = a.CPREV + ((size_t)chain * 64 + ci) * 16384;
#pragma unroll
            for (int rr = 0; rr < 4; ++rr) { const int v = sr + 32 * rr; *(bf16x8*)(lds + MC_CT + dir * 32768 + FX_KSWZ(v, sc * 2)) = *(const bf16x8*)(ct + v * 128 + sc); } } }
        __syncthreads();
        { const int dir = wid >> 2, rb = (wid >> 1) & 1, cb = wid & 1, j = rb * 32 + r32;
          bf16x8 qr[8];
          const bf16_t* Qw = a.QC + (t0 + j) * 512 + h * 128 + hi * 8;
#pragma unroll
          for (int d0 = 0; d0 < 8; ++d0) qr[d0] = *reinterpret_cast<const bf16x8*>(Qw + d0 * 16);
          f32x16 p0, p1;
          qkt<128>(p0, p1, lds + MC_K, qr, nullptr, r32, hi);
          const float mmj = sm[128 + dir * 64 + j], inter = sm[256 + dir * 64 + j], emn = sm[384 + dir * 64 + j];
          float dsum = 0.f;
#pragma unroll
          for (int r = 0; r < 16; ++r) { const int s0 = crow(r, hi), s1 = 32 + s0;
              const bool v0 = dir ? (s0 >= j) : (s0 <= j), v1 = dir ? (s1 >= j) : (s1 <= j);
              const float w0 = v0 ? __expf(sm[dir * 64 + s0] - mmj) : 0.f, w1 = v1 ? __expf(sm[dir * 64 + s1] - mmj) : 0.f;
              p0[r] *= w0; p1[r] *= w1; dsum += p0[r] + p1[r]; }
          float qn = 0.f;
#pragma unroll
          for (int d0 = 0; d0 < 8; ++d0) { const float* np = sm + 512 + dir * 128 + d0 * 16 + hi * 8; const u32x4 w = *reinterpret_cast<const u32x4*>(&qr[d0]);
              qn += bflo(w.x) * np[0] + bfhi(w.x) * np[1] + bflo(w.y) * np[2] + bfhi(w.y) * np[3] + bflo(w.z) * np[4] + bfhi(w.z) * np[5] + bflo(w.w) * np[6] + bfhi(w.w) * np[7]; }
          { auto rr = __builtin_amdgcn_permlane32_swap(__float_as_uint(dsum), __float_as_uint(dsum), false, false); dsum = __uint_as_float(rr[0]) + __uint_as_float(rr[1]); }
          { auto rr = __builtin_amdgcn_permlane32_swap(__float_as_uint(qn), __float_as_uint(qn), false, false); qn = __uint_as_float(rr[0]) + __uint_as_float(rr[1]); }
          const float den = dsum + inter * qn;
          if (hi == 0) sm[768 + wid * 32 + r32] = 1.f / fmaxf(fabsf(den), emn);
          bf16x8 pa0, pa1, pa2, pa3;
          FX_PK4(p0, 0, pa0); FX_PK4(p0, 8, pa1); FX_PK4(p1, 0, pa2); FX_PK4(p1, 8, pa3);
          f32x16 o[2] = {};
          const int vb = (int)(uintptr_t)(lds + MC_V) + v_rd_base(lane) + cb * 1024;
          pv_one<0>(o[0], vb, pa0, pa1, pa2, pa3); pv_one<1>(o[1], vb, pa0, pa1, pa2, pa3);
          const char* ctb = lds + MC_CT + dir * 32768;
#pragma unroll
          for (int ks = 0; ks < 8; ++ks) { const u32x4 w = *reinterpret_cast<const u32x4*>(&qr[ks]); u32x4 sq;
              sq.x = cvt_pk_bf16(bflo(w.x) * inter, bfhi(w.x) * inter); sq.y = cvt_pk_bf16(bflo(w.y) * inter, bfhi(w.y) * inter); sq.z = cvt_pk_bf16(bflo(w.z) * inter, bfhi(w.z) * inter); sq.w = cvt_pk_bf16(bflo(w.w) * inter, bfhi(w.w) * inter);
              const bf16x8 qs = *reinterpret_cast<const bf16x8*>(&sq); const int colB = (ks * 16 + hi * 8) * 2;
              const bf16x8 c0f = *reinterpret_cast<const bf16x8*>(ctb + FX_KSWZ((2 * cb) * 32 + r32, colB));
              const bf16x8 c1f = *reinterpret_cast<const bf16x8*>(ctb + FX_KSWZ((2 * cb + 1) * 32 + r32, colB));
              o[0] = __builtin_amdgcn_mfma_f32_32x32x16_bf16(qs, c0f, o[0], 0, 0, 0);
              o[1] = __builtin_amdgcn_mfma_f32_32x32x16_bf16(qs, c1f, o[1], 0, 0, 0); }
          asm volatile("s_waitcnt lgkmcnt(0)" ::: "memory");
          float rd[16];
#pragma unroll
          for (int r = 0; r < 16; ++r) rd[r] = sm[768 + wid * 32 + crow(r, hi)];
          if (dir == 0) {
#pragma unroll
              for (int r = 0; r < 16; ++r) { const int row = rb * 32 + crow(r, hi);
                  hs[row * MC_HS_LD + (2 * cb) * 32 + r32] = o[0][r] * rd[r]; hs[row * MC_HS_LD + (2 * cb + 1) * 32 + r32] = o[1][r] * rd[r]; } }
          __syncthreads();
          if (dir == 1) {
#pragma unroll
              for (int r = 0; r < 16; ++r) { const int row = rb * 32 + crow(r, hi);
                  hs[row * MC_HS_LD + (2 * cb) * 32 + r32] += o[0][r] * rd[r]; hs[row * MC_HS_LD + (2 * cb + 1) * 32 + r32] += o[1][r] * rd[r]; } }
          __syncthreads(); }
        { const int row = tid >> 3, c0 = (tid & 7) * 16; const size_t t = t0 + row;
          float v[16]; float ss = 0.f;
#pragma unroll
          for (int i = 0; i < 16; ++i) { v[i] = hs[row * MC_HS_LD + c0 + i]; ss += v[i] * v[i]; }
          ss += __shfl_xor(ss, 1); ss += __shfl_xor(ss, 2); ss += __shfl_xor(ss, 4);
          const float rn = rsqrtf(ss * (1.f / 128.f) + EPS);
          const bf16_t* og = a.PROJ + t * PW + O_CO + h * 128 + c0; const float* gn = a.hog + 1536 + h * 128 + c0;
          const u32x4 g0 = *(const u32x4*)og, g1 = *(const u32x4*)(og + 8);
          const float gg[16] = {bflo(g0.x), bfhi(g0.x), bflo(g0.y), bfhi(g0.y), bflo(g0.z), bfhi(g0.z), bflo(g0.w), bfhi(g0.w), bflo(g1.x), bfhi(g1.x), bflo(g1.y), bfhi(g1.y), bflo(g1.z), bfhi(g1.z), bflo(g1.w), bfhi(g1.w)};
          float ov[16];
#pragma unroll
          for (int i = 0; i < 16; ++i) ov[i] = v[i] * rn * gn[i] * sigmoid_f(gg[i]);
          u32x4 w0, w1; w0.x = cvt_pk_bf16(ov[0], ov[1]); w0.y = cvt_pk_bf16(ov[2], ov[3]); w0.z = cvt_pk_bf16(ov[4], ov[5]); w0.w = cvt_pk_bf16(ov[6], ov[7]);
          w1.x = cvt_pk_bf16(ov[8], ov[9]); w1.y = cvt_pk_bf16(ov[10], ov[11]); w1.z = cvt_pk_bf16(ov[12], ov[13]); w1.w = cvt_pk_bf16(ov[14], ov[15]);
#ifdef FX_WOUT8
          { u32x4 w8; w8.x = cvt_pk4_fp8(ov[0], ov[1], ov[2], ov[3]); w8.y = cvt_pk4_fp8(ov[4], ov[5], ov[6], ov[7]); w8.z = cvt_pk4_fp8(ov[8], ov[9], ov[10], ov[11]); w8.w = cvt_pk4_fp8(ov[12], ov[13], ov[14], ov[15]);
            *(u32x4*)((unsigned char*)a.YM + t * 2048 + 1536 + h * 128 + c0) = w8; (void)w0; (void)w1; } }
#else
          bf16_t* dst = a.YM + t * 2048 + 1536 + h * 128 + c0; *(u32x4*)dst = w0; *(u32x4*)(dst + 8) = w1; }
#endif
        __syncthreads();
    }
}
}
namespace fx {
struct EpiQB {
    static constexpr bool PERM = false;
    bf16_t* O; const float* cosB; const float* sinB;
    __device__ __forceinline__ void operator()(const f32x4 (&acc)[2][2][4][2], const Unit& u, int wr, int wc, int fr, int fq) const {
        const int row0 = u.pm * BM + wr * 64 + fr;
#pragma unroll
        for (int bj = 0; bj < 2; ++bj) { const int G = 8 * u.pn + 4 * bj + wc, gm = G % 6; const int col0 = G * 32 + 4 * fq;
#pragma unroll
            for (int ai = 0; ai < 2; ++ai)
#pragma unroll
                for (int m = 0; m < 4; ++m) { const int row = row0 + ai * HALF + m * 16; f32x4 x1 = acc[ai][bj][m][0], x2 = acc[ai][bj][m][1];
                    if (gm >= 4) { const int s = row & (S - 1), pos = gm == 4 ? (s >> 6) : (s & 63);
                        const f32x4 cs = *(const f32x4*)(cosB + pos * 16 + 4 * fq), sn = *(const f32x4*)(sinB + pos * 16 + 4 * fq);
                        const f32x4 o1 = x1 * cs - x2 * sn, o2 = x2 * cs + x1 * sn; x1 = o1; x2 = o2; }
                    bf16_t* rp = O + (size_t)row * 1280 + col0;
                    u32x2 w0, w1; w0.x = cvt_pk_bf16(x1[0], x1[1]); w0.y = cvt_pk_bf16(x1[2], x1[3]); w1.x = cvt_pk_bf16(x2[0], x2[1]); w1.y = cvt_pk_bf16(x2[2], x2[3]);
                    *(u32x2*)rp = w0; *(u32x2*)(rp + 16) = w1; } }
    }
};
constexpr size_t al256(size_t x) { return (x + 255) & ~(size_t)255; }
constexpr size_t WS_BAR = 0;
constexpr size_t WS_MOD = 16384;
constexpr size_t WS_COEF = WS_MOD + al256(2ull * 4 * 12288 * 4);
constexpr size_t WS_TAB = WS_COEF + al256(2ull * 4 * 6 * 2048 * 4);
constexpr size_t WS_CNT = WS_TAB + al256(6144 * 4);
constexpr size_t WS_WGBASE = WS_CNT + 512;
constexpr size_t WS_SELE = WS_WGBASE + 256 * 64 * 4;
constexpr size_t WS_SELG = WS_SELE + (size_t)T * 6 * 4;
constexpr size_t WS_SLOT = WS_SELG + (size_t)T * 6 * 4;
constexpr size_t WS_ROWTOK = WS_SLOT + (size_t)T * 6 * 4;
constexpr size_t WS_ROWG = WS_ROWTOK + (size_t)PTOT * 4;
constexpr size_t WS_GATES = WS_ROWG + (size_t)PTOT * 4;
constexpr size_t WS_GSC = WS_GATES + (size_t)T * 16 * 4;
constexpr size_t WS_MPREV = WS_GSC + 2048 * 2 * 4;
constexpr size_t WS_NLOC = WS_MPREV + 2048 * 4;
constexpr size_t WS_NPREV = WS_NLOC + 2048ull * 128 * 4;
constexpr size_t WS_W = al256(WS_NPREV + 2048ull * 128 * 4);
constexpr size_t W_IN = 0, W_UQ = W_IN + 4096ull * 2048 * 2, W_UKV = W_UQ + 1280ull * 384 * 2, W_OUT = W_UKV + 1536ull * 256 * 2, W_GU = W_OUT + 2048ull * 2048 * 2, W_DN = W_GU + 65ull * 1024 * 2048 * 2, W_LAYER = W_DN + 65ull * 2048 * 512 * 2;
constexpr size_t WS_XRES = WS_W + 2 * W_LAYER;
constexpr size_t WS_HA = WS_XRES + (size_t)T * 2048 * 4;
constexpr size_t WS_R1 = WS_HA + (size_t)T * 2048 * 2;
constexpr size_t WS_R2 = WS_R1 + (size_t)T * 4096 * 2;
constexpr size_t R2_QA = 0, R2_KA = R2_QA + (size_t)T * 768 * 2, R2_CQN = R2_KA + (size_t)T * 256 * 2, R2_CKVN = R2_CQN + (size_t)T * 384 * 2, R2_KR = R2_CKVN + (size_t)T * 256 * 2,
                 R2_QB = R2_KR + (size_t)T * 64 * 2, R2_KVB = R2_QB + (size_t)T * 1280 * 2, R2_QC = R2_KVB + (size_t)T * 1536 * 2, R2_KC = R2_QC + (size_t)T * 512 * 2,
                 R2_KCT = R2_KC + (size_t)T * 512 * 2, R2_CPREV = R2_KCT + 2048ull * 16384 * 2, R2_END = R2_CPREV + 2048ull * 16384 * 2;
constexpr size_t WS_END = WS_R2 + (size_t)PTOT * 2048 * 2;
static_assert(R2_END <= (size_t)PTOT * 2048 * 2, "R2 overflow");
static_assert(WS_END <= 2147483648ull, "workspace too large");
}
namespace fx {
struct CvtW { const float* w_in; const float* w_uq; const float* w_ukv; const float* w_out; const float* eg; const float* eu; const float* ed; const float* sg; const float* su; const float* sd; bf16_t* W; };
__device__ __forceinline__ void cvt_layer(const CvtW& a, FX_LAS unsigned* my, int gwave, int nwaves, int& rot) {
    const int BIG = 1 << 30; bf16_t* W = a.W;
    bf16_t* WIN = W + W_IN / 2; bf16_t* WUQ = W + W_UQ / 2; bf16_t* WUKV = W + W_UKV / 2; bf16_t* WOUT = W + W_OUT / 2; bf16_t* WGU = W + W_GU / 2; bf16_t* WDN = W + W_DN / 2;
#ifdef FX_WIN8
    { CvtSeg s; s.src = a.w_in; s.dst = WIN; s.sstride = 0; s.dstride = 0; s.ld = 4048; s.nsrc = 4048; s.K = 2048; s.ntn = 64; s.nbatch = 1; s.G = BIG; s.GS = 0; s.off = 0; cvt_seg8(s, my, gwave, nwaves, rot, W8_SCALE); }
#else
    { CvtSeg s; s.src = a.w_in; s.dst = WIN; s.sstride = 0; s.dstride = 0; s.ld = 4048; s.nsrc = 4048; s.K = 2048; s.ntn = 64; s.nbatch = 1; s.G = BIG; s.GS = 0; s.off = 0; cvt_seg(s, my, gwave, nwaves, rot); }
#endif
    { CvtSeg s; s.src = a.w_uq; s.dst = WUQ; s.sstride = 0; s.dstride = 0; s.ld = 1152; s.nsrc = 1152; s.K = 384; s.ntn = 20; s.nbatch = 1; s.G = BIG; s.GS = 0; s.off = 0; cvt_seg(s, my, gwave, nwaves, rot); }
    { CvtSeg s; s.src = a.w_ukv; s.dst = WUKV; s.sstride = 0; s.dstride = 0; s.ld = 1536; s.nsrc = 1536; s.K = 256; s.ntn = 24; s.nbatch = 1; s.G = BIG; s.GS = 0; s.off = 0; cvt_seg(s, my, gwave, nwaves, rot); }
#ifdef FX_WOUT8
    { CvtSeg s; s.src = a.w_out; s.dst = WOUT; s.sstride = 0; s.dstride = 0; s.ld = 2048; s.nsrc = 2048; s.K = 2048; s.ntn = 32; s.nbatch = 1; s.G = BIG; s.GS = 0; s.off = 0; cvt_seg8(s, my, gwave, nwaves, rot, W8_SCALE); }
#else
    { CvtSeg s; s.src = a.w_out; s.dst = WOUT; s.sstride = 0; s.dstride = 0; s.ld = 2048; s.nsrc = 2048; s.K = 2048; s.ntn = 32; s.nbatch = 1; s.G = BIG; s.GS = 0; s.off = 0; cvt_seg(s, my, gwave, nwaves, rot); }
#endif
    { CvtSeg s; s.src = a.eg; s.dst = WGU; s.sstride = 2048ll * 512; s.dstride = 1024ll * 2048; s.ld = 512; s.nsrc = 512; s.K = 2048; s.ntn = 8; s.nbatch = 64; s.G = 128; s.GS = 256; s.off = 0; cvt_seg8(s, my, gwave, nwaves, rot, W8_SCALE); }
    { CvtSeg s; s.src = a.eu; s.dst = WGU; s.sstride = 2048ll * 512; s.dstride = 1024ll * 2048; s.ld = 512; s.nsrc = 512; s.K = 2048; s.ntn = 8; s.nbatch = 64; s.G = 128; s.GS = 256; s.off = 128; cvt_seg8(s, my, gwave, nwaves, rot, W8_SCALE); }
    { CvtSeg s; s.src = a.ed; s.dst = WDN; s.sstride = 512ll * 2048; s.dstride = 2048ll * 512; s.ld = 2048; s.nsrc = 2048; s.K = 512; s.ntn = 32; s.nbatch = 64; s.G = BIG; s.GS = 0; s.off = 0; cvt_seg8(s, my, gwave, nwaves, rot, W8_SCALE); }
    { CvtSeg s; s.src = a.sg; s.dst = (bf16_t*)((unsigned char*)WGU + 64ull * 1024 * 2048); s.sstride = 0; s.dstride = 0; s.ld = 512; s.nsrc = 512; s.K = 2048; s.ntn = 8; s.nbatch = 1; s.G = 128; s.GS = 256; s.off = 0; cvt_seg8(s, my, gwave, nwaves, rot, W8_SCALE); }
    { CvtSeg s; s.src = a.su; s.dst = (bf16_t*)((unsigned char*)WGU + 64ull * 1024 * 2048); s.sstride = 0; s.dstride = 0; s.ld = 512; s.nsrc = 512; s.K = 2048; s.ntn = 8; s.nbatch = 1; s.G = 128; s.GS = 256; s.off = 128; cvt_seg8(s, my, gwave, nwaves, rot, W8_SCALE); }
    { CvtSeg s; s.src = a.sd; s.dst = (bf16_t*)((unsigned char*)WDN + 64ull * 2048 * 512); s.sstride = 0; s.dstride = 0; s.ld = 2048; s.nsrc = 2048; s.K = 512; s.ntn = 32; s.nbatch = 1; s.G = BIG; s.GS = 0; s.off = 0; cvt_seg8(s, my, gwave, nwaves, rot, W8_SCALE); }
}
constexpr int CVT_TILES_PER_LAYER = 2048 + 120 + 96 + 1024 + 3 * 16384 + 3 * 256;
__device__ __forceinline__ void cvt_layer_one(const CvtW& a, FX_LAS unsigned* my, int g) {
    int base = 0;
    const int BIG = 1 << 30; bf16_t* W = a.W;
    bf16_t* WIN = W + W_IN / 2; bf16_t* WUQ = W + W_UQ / 2; bf16_t* WUKV = W + W_UKV / 2; bf16_t* WOUT = W + W_OUT / 2; bf16_t* WGU = W + W_GU / 2; bf16_t* WDN = W + W_DN / 2;
#ifdef FX_WIN8
    { CvtSeg s; s.src = a.w_in; s.dst = WIN; s.sstride = 0; s.dstride = 0; s.ld = 4048; s.nsrc = 4048; s.K = 2048; s.ntn = 64; s.nbatch = 1; s.G = BIG; s.GS = 0; s.off = 0; { const int cnt_ = (s.K / 64) * s.ntn * s.nbatch; if (g >= base && g < base + cnt_) cvt_tile8(s, my, g - base, W8_SCALE); base += cnt_; } }
#else
    { CvtSeg s; s.src = a.w_in; s.dst = WIN; s.sstride = 0; s.dstride = 0; s.ld = 4048; s.nsrc = 4048; s.K = 2048; s.ntn = 64; s.nbatch = 1; s.G = BIG; s.GS = 0; s.off = 0; { const int cnt_ = (s.K / 64) * s.ntn * s.nbatch; if (g >= base && g < base + cnt_) cvt_tile(s, my, g - base); base += cnt_; } }
#endif
    { CvtSeg s; s.src = a.w_uq; s.dst = WUQ; s.sstride = 0; s.dstride = 0; s.ld = 1152; s.nsrc = 1152; s.K = 384; s.ntn = 20; s.nbatch = 1; s.G = BIG; s.GS = 0; s.off = 0; { const int cnt_ = (s.K / 64) * s.ntn * s.nbatch; if (g >= base && g < base + cnt_) cvt_tile(s, my, g - base); base += cnt_; } }
    { CvtSeg s; s.src = a.w_ukv; s.dst = WUKV; s.sstride = 0; s.dstride = 0; s.ld = 1536; s.nsrc = 1536; s.K = 256; s.ntn = 24; s.nbatch = 1; s.G = BIG; s.GS = 0; s.off = 0; { const int cnt_ = (s.K / 64) * s.ntn * s.nbatch; if (g >= base && g < base + cnt_) cvt_tile(s, my, g - base); base += cnt_; } }
#ifdef FX_WOUT8
    { CvtSeg s; s.src = a.w_out; s.dst = WOUT; s.sstride = 0; s.dstride = 0; s.ld = 2048; s.nsrc = 2048; s.K = 2048; s.ntn = 32; s.nbatch = 1; s.G = BIG; s.GS = 0; s.off = 0; { const int cnt_ = (s.K / 64) * s.ntn * s.nbatch; if (g >= base && g < base + cnt_) cvt_tile8(s, my, g - base, W8_SCALE); base += cnt_; } }
#else
    { CvtSeg s; s.src = a.w_out; s.dst = WOUT; s.sstride = 0; s.dstride = 0; s.ld = 2048; s.nsrc = 2048; s.K = 2048; s.ntn = 32; s.nbatch = 1; s.G = BIG; s.GS = 0; s.off = 0; { const int cnt_ = (s.K / 64) * s.ntn * s.nbatch; if (g >= base && g < base + cnt_) cvt_tile(s, my, g - base); base += cnt_; } }
#endif
    { CvtSeg s; s.src = a.eg; s.dst = WGU; s.sstride = 2048ll * 512; s.dstride = 1024ll * 2048; s.ld = 512; s.nsrc = 512; s.K = 2048; s.ntn = 8; s.nbatch = 64; s.G = 128; s.GS = 256; s.off = 0; { const int cnt_ = (s.K / 64) * s.ntn * s.nbatch; if (g >= base && g < base + cnt_) cvt_tile8(s, my, g - base, W8_SCALE); base += cnt_; } }
    { CvtSeg s; s.src = a.eu; s.dst = WGU; s.sstride = 2048ll * 512; s.dstride = 1024ll * 2048; s.ld = 512; s.nsrc = 512; s.K = 2048; s.ntn = 8; s.nbatch = 64; s.G = 128; s.GS = 256; s.off = 128; { const int cnt_ = (s.K / 64) * s.ntn * s.nbatch; if (g >= base && g < base + cnt_) cvt_tile8(s, my, g - base, W8_SCALE); base += cnt_; } }
    { CvtSeg s; s.src = a.ed; s.dst = WDN; s.sstride = 512ll * 2048; s.dstride = 2048ll * 512; s.ld = 2048; s.nsrc = 2048; s.K = 512; s.ntn = 32; s.nbatch = 64; s.G = BIG; s.GS = 0; s.off = 0; { const int cnt_ = (s.K / 64) * s.ntn * s.nbatch; if (g >= base && g < base + cnt_) cvt_tile8(s, my, g - base, W8_SCALE); base += cnt_; } }
    { CvtSeg s; s.src = a.sg; s.dst = (bf16_t*)((unsigned char*)WGU + 64ull * 1024 * 2048); s.sstride = 0; s.dstride = 0; s.ld = 512; s.nsrc = 512; s.K = 2048; s.ntn = 8; s.nbatch = 1; s.G = 128; s.GS = 256; s.off = 0; { const int cnt_ = (s.K / 64) * s.ntn * s.nbatch; if (g >= base && g < base + cnt_) cvt_tile8(s, my, g - base, W8_SCALE); base += cnt_; } }
    { CvtSeg s; s.src = a.su; s.dst = (bf16_t*)((unsigned char*)WGU + 64ull * 1024 * 2048); s.sstride = 0; s.dstride = 0; s.ld = 512; s.nsrc = 512; s.K = 2048; s.ntn = 8; s.nbatch = 1; s.G = 128; s.GS = 256; s.off = 128; { const int cnt_ = (s.K / 64) * s.ntn * s.nbatch; if (g >= base && g < base + cnt_) cvt_tile8(s, my, g - base, W8_SCALE); base += cnt_; } }
    { CvtSeg s; s.src = a.sd; s.dst = (bf16_t*)((unsigned char*)WDN + 64ull * 2048 * 512); s.sstride = 0; s.dstride = 0; s.ld = 2048; s.nsrc = 2048; s.K = 512; s.ntn = 32; s.nbatch = 1; s.G = BIG; s.GS = 0; s.off = 0; { const int cnt_ = (s.K / 64) * s.ntn * s.nbatch; if (g >= base && g < base + cnt_) cvt_tile8(s, my, g - base, W8_SCALE); base += cnt_; } }
}
}
namespace fx {
#define XB_TMO      128
#define XB_XCNT(j)  (256  + 64 * (j))
#define XB_XSUB(j)  (1280 + 64 * (j))
#define XB_XGEN(j)  (2304 + 64 * (j))
#define XB_TOP      3328
#define XB_TOPGEN   3392
#define XCD_BAR_WORDS 3456
#define XB_SPIN_CAP (1u << 22)
__device__ __forceinline__ unsigned xb_ld(unsigned* p)              { return __hip_atomic_load(p, __ATOMIC_RELAXED, __HIP_MEMORY_SCOPE_AGENT); }
__device__ __forceinline__ unsigned xb_add(unsigned* p, unsigned v) { return __hip_atomic_fetch_add(p, v, __ATOMIC_RELAXED, __HIP_MEMORY_SCOPE_AGENT); }
__device__ __forceinline__ unsigned xb_xcc_id() { return (unsigned)__builtin_amdgcn_s_getreg((3 << 11) | 20) & 0xFu; }
#define XB_SPIN(cond, bar) do { unsigned _sp = 0; while (cond) { __builtin_amdgcn_s_sleep(1); \
    if ((++_sp & 255u) == 0u) { if (xb_ld(&(bar)[XB_TMO])) break; if (_sp > XB_SPIN_CAP) { atomicAdd(&(bar)[XB_TMO], 1u); break; } } } } while (0)
struct XcdBarrier { unsigned* bar; unsigned x; volatile FX_LAS unsigned* st; };
__device__ __forceinline__ XcdBarrier xcd_barrier_post(unsigned* bar, volatile FX_LAS unsigned* st, int tidp) {
    XcdBarrier b; b.bar = bar; b.x = xb_xcc_id(); b.st = st;
    if (tidp == 0) (void)xb_add(&bar[XB_XCNT(b.x)], 1u);
    return b;
}
__device__ __forceinline__ void xcd_barrier_complete(unsigned* bar, unsigned x, unsigned& nloc, unsigned& nx) {
    const unsigned G = gridDim.x * gridDim.y * gridDim.z;
    unsigned sum, cnt, mine, sp = 0u;
    for (;;) {
        sum = 0u; cnt = 0u; mine = 0u;
#pragma unroll
        for (unsigned j = 0; j < 16; ++j) { const unsigned c = xb_ld(&bar[XB_XCNT(j)]); sum += c; cnt += (c > 0u) ? 1u : 0u; mine = (j == x) ? c : mine; }
        if (sum == G) break;
        __builtin_amdgcn_s_sleep(1);
        if ((++sp & 255u) == 0u) { if (xb_ld(&bar[XB_TMO])) break; if (sp > XB_SPIN_CAP) { atomicAdd(&bar[XB_TMO], 1u); break; } }
    }
    nloc = mine > 0u ? mine : 1u; nx = cnt > 0u ? cnt : 1u;
}
__device__ __forceinline__ void xcd_barrier(const XcdBarrier& b, int tidp) {
    asm volatile("s_waitcnt vmcnt(0)" ::: "memory");
    __syncthreads();
    if (tidp == 0) {
        unsigned* bar = b.bar;
        __builtin_amdgcn_s_waitcnt(0);
        unsigned nloc = b.st[0], nx = b.st[1];
        if (nloc == 0u) { xcd_barrier_complete(bar, b.x, nloc, nx); b.st[0] = nloc; b.st[1] = nx; }
        const unsigned old = xb_add(&bar[XB_XSUB(b.x)], 1u);
        const unsigned gen = old / nloc;
        if (old + 1u == (gen + 1u) * nloc) {
            __builtin_amdgcn_fence(__ATOMIC_RELEASE, "agent");
            asm volatile("s_waitcnt vmcnt(0)" ::: "memory");
            const unsigned og = xb_add(&bar[XB_TOP], 1u);
            const unsigned tg = og / nx;
            if (og + 1u == (tg + 1u) * nx) xb_add(&bar[XB_TOPGEN], 1u);
            else XB_SPIN(xb_ld(&bar[XB_TOPGEN]) == tg, bar);
            __builtin_amdgcn_fence(__ATOMIC_ACQUIRE, "agent");
            xb_add(&bar[XB_XGEN(b.x)], 1u);
            asm volatile("s_waitcnt vmcnt(0)" ::: "memory");
        } else {
            XB_SPIN(xb_ld(&bar[XB_XGEN(b.x)]) == gen, bar);
            __builtin_amdgcn_fence(__ATOMIC_ACQUIRE, "agent");
            asm volatile("s_waitcnt vmcnt(0)" ::: "memory");
        }
    }
    __syncthreads();
}

__device__ __forceinline__ void modp_phase(FX_LAS unsigned char* lds_, const float* c, const float* ada_w, float* MODP, int wg, int nwg, int tidp) {
    float* cact = (float*)(char*)lds_;
    for (int i = tidp; i < 8192; i += 512) { const float v = c[i]; cact[i] = v / (1.f + expf(-v)); }
    __syncthreads();
    int tid_ = tidp; asm volatile("" : "+v"(tid_));
    const int wid = tid_ >> 6, lane = tid_ & 63;
    for (int u = wg * 8 + wid; u < 2 * 48 * 32; u += nwg * 8) {
        const int kc = u & 31, nc = (u >> 5) % 48, l = u / (48 * 32);
        const float* w = ada_w + (size_t)l * 2048 * 12288 + (size_t)(kc * 64) * 12288 + nc * 256 + lane * 4;
        f32x4 a0 = {0.f, 0.f, 0.f, 0.f}, a1 = a0, a2 = a0, a3 = a0;
#pragma unroll 8
        for (int k = 0; k < 64; ++k) { const f32x4 wv = *(const f32x4*)(w + (size_t)k * 12288); const int kk = kc * 64 + k;
            a0 += wv * cact[kk]; a1 += wv * cact[2048 + kk]; a2 += wv * cact[4096 + kk]; a3 += wv * cact[6144 + kk]; }
        float* dst = MODP + (((size_t)l * 32 + kc) * 4) * 12288 + nc * 256 + lane * 4;
        *(f32x4*)dst = a0; *(f32x4*)(dst + 12288) = a1; *(f32x4*)(dst + 2 * 12288) = a2; *(f32x4*)(dst + 3 * 12288) = a3;
    }
    __syncthreads();
}
__device__ __forceinline__ void tab_phase(float* tab, int gtid) {
    if (gtid < 2048) { const int p = gtid >> 5, f = gtid & 31; const float inv = powf(10000.f, -(float)(2 * f) / 64.f); const float a = (float)p * inv; tab[gtid] = cosf(a); tab[2048 + gtid] = sinf(a); }
    else if (gtid < 3072) { const int i = gtid - 2048, p = i >> 4, f = i & 15; const float inv = powf(10000.f, -(float)(2 * f) / 32.f); const float a = (float)p * inv; tab[4096 + i] = cosf(a); tab[5120 + i] = sinf(a); }
}
__device__ __forceinline__ void coef2_phase(const float* MODP, const float* ada_b, const float* pre_mix_gain, const float* post_mix_gain, const float* pre_ffn_gain, const float* post_ffn_gain, float* coef, int gtid, int nthr) {
    for (int i = gtid; i < 2 * 4 * 2048; i += nthr) { const int d = i & 2047, b = (i >> 11) & 3, l = i >> 13;
        float m[6];
#pragma unroll
        for (int j = 0; j < 6; ++j) { float s = ada_b[l * 12288 + j * 2048 + d];
            for (int kc = 0; kc < 32; ++kc) s += MODP[(((size_t)l * 32 + kc) * 4 + b) * 12288 + j * 2048 + d];
            m[j] = s; }
        float* c = coef + ((size_t)l * 4 + b) * 6 * 2048;
        c[0 * 2048 + d] = m[2] * post_mix_gain[l * 2048 + d];
        c[1 * 2048 + d] = pre_ffn_gain[l * 2048 + d] * (1.f + m[4]);
        c[2 * 2048 + d] = m[3];
        c[3 * 2048 + d] = m[5] * post_ffn_gain[l * 2048 + d];
        c[4 * 2048 + d] = pre_mix_gain[l * 2048 + d] * (1.f + m[1]);
        c[5 * 2048 + d] = m[0]; }
}
__device__ __forceinline__ void prenorm_phase(const float* x, const float* coef_l, bf16_t* HA, int wg, int nwg, int tidp) {
    int tid_ = tidp; asm volatile("" : "+v"(tid_));
    const int wid = tid_ >> 6, lane = tid_ & 63;
    for (int t = wg * 8 + wid; t < T; t += nwg * 8) {
        const float* cn = coef_l + (size_t)(t / S) * 6 * 2048;
        float xv[32]; float ss = 0.f;
#pragma unroll
        for (int i = 0; i < 4; ++i) { const int c = i * 512 + lane * 8; const f32x4 x0 = *(const f32x4*)(x + (size_t)t * 2048 + c), x1 = *(const f32x4*)(x + (size_t)t * 2048 + c + 4);
#pragma unroll
            for (int j = 0; j < 4; ++j) { xv[i * 8 + j] = x0[j]; xv[i * 8 + 4 + j] = x1[j]; ss += x0[j] * x0[j] + x1[j] * x1[j]; } }
        ss = wave_sum(ss); const float rx = rsqrtf(ss * (1.f / 2048.f) + EPS);
#pragma unroll
        for (int i = 0; i < 4; ++i) { const int c = i * 512 + lane * 8;
            const f32x4 e0 = *(const f32x4*)(cn + 4 * 2048 + c), e1 = *(const f32x4*)(cn + 4 * 2048 + c + 4), f0 = *(const f32x4*)(cn + 5 * 2048 + c), f1 = *(const f32x4*)(cn + 5 * 2048 + c + 4);
            float hv[8];
#pragma unroll
            for (int j = 0; j < 4; ++j) { hv[j] = xv[i * 8 + j] * rx * e0[j] + f0[j]; hv[4 + j] = xv[i * 8 + 4 + j] * rx * e1[j] + f1[j]; }
#ifdef FX_WIN8
            u32x2 w; w.x = cvt_pk4_fp8(hv[0], hv[1], hv[2], hv[3]); w.y = cvt_pk4_fp8(hv[4], hv[5], hv[6], hv[7]);
            *(u32x2*)((unsigned char*)HA + (size_t)t * 2048 + c) = w; }
#else
            u32x4 w; w.x = cvt_pk_bf16(hv[0], hv[1]); w.y = cvt_pk_bf16(hv[2], hv[3]); w.z = cvt_pk_bf16(hv[4], hv[5]); w.w = cvt_pk_bf16(hv[6], hv[7]);
            *(u32x4*)(HA + (size_t)t * 2048 + c) = w; }
#endif
    }
}

constexpr int LDS_ST = 139264, LDS_TOTAL = LDS_ST + 64;
constexpr size_t WS_MODP = WS_R2;
#define FX_KAS __attribute__((address_space(4)))
template <class TY> __device__ __forceinline__ TY* fx_glob(TY* p) { __attribute__((address_space(1))) TY* g = (__attribute__((address_space(1))) TY*)p; asm volatile("" : "+s"(g)); return (TY*)g; }
struct MP {
    const float* x; const float* c; const float* ada_w; const float* ada_b; const float* pre_mix_gain; const float* w_in; const float* a_q_gain; const float* a_k_gain;
    const float* b_cq_gain; const float* b_ckv_gain; const float* w_uq; const float* w_ukv; const float* c_conv_w; const float* c_conv_b; const float* c_gate_b;
    const float* head_out_gain; const float* w_out; const float* post_mix_gain; const float* pre_ffn_gain; const float* router_w; const float* router_bias;
    const float* exp_w_gate; const float* exp_w_up; const float* exp_w_down; const float* sh_w_gate; const float* sh_w_up; const float* sh_w_down; const float* post_ffn_gain;
    char* ws; float* out;
};
#ifndef FX_NPHASE
#define FX_NPHASE 1000
#endif
#define PH_BEGIN const FX_KAS MP* pk = (const FX_KAS MP*)__builtin_amdgcn_kernarg_segment_ptr(); asm volatile("" : "+s"(pk)); char* ws = fx_glob(pk->ws); (void)ws; int gt_ = wid_s * 64 + fx_lane(); asm volatile("" : "+v"(gt_)); int wg_ = blockIdx.x, nwg_ = gridDim.x; asm volatile("" : "+s"(wg_), "+s"(nwg_)); const int wg = wg_, nwg = nwg_; (void)wg; (void)nwg; (void)gt_;
#define PH_BAR do { PH_BEGIN XcdBarrier b_; b_.bar = (unsigned*)(ws + WS_BAR); b_.x = xb_xcc_id(); b_.st = (volatile FX_LAS unsigned*)(lds + LDS_ST); xcd_barrier(b_, gt_); } while (0)
#define WSP(T_, off) ((T_*)(ws + (off)))
constexpr int QW_CNT = 3584;
constexpr unsigned HV_SLACK = 24;
__device__ __forceinline__ void harvest(FX_LAS unsigned char* lds, const FX_KAS MP* pk, char* ws, int tid, const unsigned nbar, const bool drain) {
    volatile FX_LAS unsigned* bw = (volatile FX_LAS unsigned*)(lds + LDS_ST);
    unsigned* bar = (unsigned*)(ws + WS_BAR);
    const int wave = tid >> 6; FX_LAS unsigned* my = (FX_LAS unsigned*)(lds) + wave * (64 * 33);
    CvtW a; a.w_in = fx_glob(pk->w_in) + (size_t)D * 4048; a.w_uq = fx_glob(pk->w_uq) + (size_t)384 * 1152; a.w_ukv = fx_glob(pk->w_ukv) + (size_t)256 * 1536; a.w_out = fx_glob(pk->w_out) + (size_t)D * D;
    a.eg = fx_glob(pk->exp_w_gate) + (size_t)NE * D * FF; a.eu = fx_glob(pk->exp_w_up) + (size_t)NE * D * FF; a.ed = fx_glob(pk->exp_w_down) + (size_t)NE * FF * D;
    a.sg = fx_glob(pk->sh_w_gate) + (size_t)D * FF; a.su = fx_glob(pk->sh_w_up) + (size_t)D * FF; a.sd = fx_glob(pk->sh_w_down) + (size_t)FF * D; a.W = (bf16_t*)(ws + WS_W + W_LAYER);
    __syncthreads();
    if (drain) {
        if (tid == 0) bw[3] = xb_ld(&bar[QW_CNT]);
        __syncthreads();
        const unsigned h = bw[3];
#pragma unroll 1
        for (unsigned g = h + (unsigned)(blockIdx.x * 8 + wave); g < (unsigned)CVT_TILES_PER_LAYER; g += gridDim.x * 8u) cvt_layer_one(a, my, (int)g);
        __syncthreads();
        return;
    }
#pragma unroll 1
    for (;;) {
        if (tid == 0) { unsigned nxt = 0xffffffffu; bool go = true;
            if (!drain) { unsigned sum = 0u;
#pragma unroll
                for (unsigned j = 0; j < 16; ++j) sum += xb_ld(&bar[XB_XSUB(j)]);
                const unsigned G = gridDim.x; go = (sum - nbar * G) + HV_SLACK < G; }
            if (go && xb_ld(&bar[QW_CNT]) < (unsigned)CVT_TILES_PER_LAYER) { const unsigned b0 = xb_add(&bar[QW_CNT], 8u); if (b0 < (unsigned)CVT_TILES_PER_LAYER) nxt = b0; }
            bw[3] = nxt; }
        __syncthreads();
        const unsigned base = bw[3];
        if (base == 0xffffffffu) break;
        const int g = (int)base + wave;
        if (g < CVT_TILES_PER_LAYER) cvt_layer_one(a, my, g);
        __syncthreads();
    }
    __syncthreads();
}
#ifndef FX_HARVEST
#define FX_HARVEST 1
#endif
#define PH_HARVEST(n, dr) do { if (FX_HARVEST && l == 0 && ((dr) || FX_HARVEST == 1)) { PH_BEGIN harvest(lds, pk, ws, gt_, (n), (dr)); } } while (0)
#ifndef FX_DUP
#define FX_DUP -1
#endif
#define FX_NE ((FX_NOEPI && rep_ == 1) ? FX_NOEPI : 0)
#define FX_REP(n) _Pragma("unroll 1") for (int rep_ = 0; rep_ < ((FX_DUP == (n) && l == 0) ? 2 : 1); ++rep_)
template <int l> __device__ __forceinline__ void layer_body(FX_LAS unsigned char* lds, unsigned char* shm, const int wid_s) {
        FX_REP(2) { PH_BEGIN const bf16_t* W = WSP(const bf16_t, WS_W + (size_t)l * W_LAYER);
#ifdef FX_WIN8
          DenseSched Sc; Sc.init(T, 4096, nwg, wg, 2048, W + W_IN / 2, 2048, 1); EpiBf16 E; E.O = WSP(bf16_t, WS_R1); E.gates = WSP(float, WS_GATES); E.ldc = 4096; E.scale = W8_INV;
          gemm_phase<EpiBf16, DenseSched, true>(lds, (const char*)WSP(bf16_t, WS_HA), 2048, Sc, E, gt_, FX_NE); }
#else
          DenseSched Sc; Sc.init(T, 4096, nwg, wg, 2048 * 2, W + W_IN / 2, 2048); EpiBf16 E; E.O = WSP(bf16_t, WS_R1); E.gates = WSP(float, WS_GATES); E.ldc = 4096; E.scale = 1.f;
          gemm_phase<EpiBf16, DenseSched>(lds, (const char*)WSP(bf16_t, WS_HA), 2048, Sc, E, gt_); }
#endif
        PH_HARVEST(3u, false);
        PH_BAR;
        FX_REP(3) { PH_BEGIN char* R2 = ws + WS_R2; float* tab = WSP(float, WS_TAB);
          P3Args a; a.PROJ = WSP(bf16_t, WS_R1); a.GATES = WSP(float, WS_GATES); a.gate_b = fx_glob(pk->c_gate_b) + l * 16; a.conv_w = fx_glob(pk->c_conv_w) + (size_t)l * 5 * 1024; a.conv_b = fx_glob(pk->c_conv_b) + l * 1024;
          a.aq_gain = fx_glob(pk->a_q_gain) + l * 128; a.ak_gain = fx_glob(pk->a_k_gain) + l * 128; a.cq_gain = fx_glob(pk->b_cq_gain) + l * 384; a.ckv_gain = fx_glob(pk->b_ckv_gain) + l * 256;
          a.cosA = tab; a.sinA = tab + 2048; a.cosB = tab + 4096; a.sinB = tab + 5120;
          a.QA = (bf16_t*)(R2 + R2_QA); a.KA = (bf16_t*)(R2 + R2_KA); a.CQN = (bf16_t*)(R2 + R2_CQN); a.CKVN = (bf16_t*)(R2 + R2_CKVN); a.KR = (bf16_t*)(R2 + R2_KR); a.QC = (bf16_t*)(R2 + R2_QC); a.KC = (bf16_t*)(R2 + R2_KC);
          a.KCT = (bf16_t*)(R2 + R2_KCT); a.NLOC = WSP(float, WS_NLOC); a.GSC = WSP(float, WS_GSC);
          p3_phase(lds, a, wg, nwg, gt_); }
        PH_BAR;
        FX_REP(4) {
        { PH_BEGIN const bf16_t* W = WSP(const bf16_t, WS_W + (size_t)l * W_LAYER); char* R2 = ws + WS_R2; float* tab = WSP(float, WS_TAB);
          DenseSched Sc; Sc.init(T, 1280, nwg, wg, 384 * 2, W + W_UQ / 2, 384); EpiQB E; E.O = (bf16_t*)(R2 + R2_QB); E.cosB = tab + 4096; E.sinB = tab + 5120;
          gemm_phase<EpiQB, DenseSched>(lds, (const char*)(R2 + R2_CQN), 384, Sc, E, gt_); }
        { PH_BEGIN const bf16_t* W = WSP(const bf16_t, WS_W + (size_t)l * W_LAYER); char* R2 = ws + WS_R2;
          DenseSched Sc; Sc.init(T, 1536, nwg, wg, 256 * 2, W + W_UKV / 2, 256); EpiBf16 E; E.O = (bf16_t*)(R2 + R2_KVB); E.gates = nullptr; E.ldc = 1536; E.scale = 1.f;
          gemm_phase<EpiBf16, DenseSched>(lds, (const char*)(R2 + R2_CKVN), 256, Sc, E, gt_); }
        { PH_BEGIN char* R2 = ws + WS_R2;
          scan_phase((const bf16_t*)(R2 + R2_KCT), WSP(float, WS_NLOC), WSP(float, WS_GSC), (bf16_t*)(R2 + R2_CPREV), WSP(float, WS_NPREV), WSP(float, WS_MPREV), wg * 512 + gt_, nwg * 512); }
        }
        PH_HARVEST(5u, false);
        PH_BAR;
        FX_REP(5) {
#pragma unroll 1
          for (int ui = 0; ui < 2; ++ui) { PH_BEGIN char* R2 = ws + WS_R2; int u;
              if (nwg == 256) { const int x = wg & 7, j = wg >> 3; if (ui == 1 && j >= 16) break; u = x * 48 + j + ui * 32; } else { u = wg + ui * nwg; if (u >= 384) break; }
              attn_gqa_unit(u, (const bf16_t*)(R2 + R2_QA), (const bf16_t*)(R2 + R2_KA), WSP(const bf16_t, WS_R1), WSP(bf16_t, WS_HA), fx_glob(pk->head_out_gain) + l * D, (char*)shm, gt_); }
#pragma unroll 1
          for (int ui = 0; ui < 2; ++ui) { PH_BEGIN char* R2 = ws + WS_R2; int u;
              if (nwg == 256) { const int x = wg & 7, j = wg >> 3; if (j < 16) { if (ui == 1) break; u = x * 48 + j; } else u = x * 48 + 16 + (j - 16) * 2 + ui; } else { u = wg + ui * nwg; if (u >= 384) break; }
              attn_mla_unit(u, (const bf16_t*)(R2 + R2_QB), (const bf16_t*)(R2 + R2_KVB), (const bf16_t*)(R2 + R2_KR), WSP(bf16_t, WS_HA), fx_glob(pk->head_out_gain) + l * D, (char*)shm, gt_); }
          { PH_BEGIN char* R2 = ws + WS_R2;
            McArgs a; a.PROJ = WSP(bf16_t, WS_R1); a.GATES = WSP(float, WS_GATES); a.gate_b = fx_glob(pk->c_gate_b) + l * 16; a.QC = (bf16_t*)(R2 + R2_QC); a.KC = (bf16_t*)(R2 + R2_KC); a.CPREV = (bf16_t*)(R2 + R2_CPREV);
            a.NPREV = WSP(float, WS_NPREV); a.MPREV = WSP(float, WS_MPREV); a.hog = fx_glob(pk->head_out_gain) + l * D; a.YM = WSP(bf16_t, WS_HA);
            mlstm_c_phase(lds, a, wg, nwg, gt_); } }
        PH_HARVEST(6u, false);
        PH_BAR;
        FX_REP(6) { PH_BEGIN const bf16_t* W = WSP(const bf16_t, WS_W + (size_t)l * W_LAYER);
#ifdef FX_WOUT8
          DenseSched Sc; Sc.init(T, 2048, nwg, wg, 2048, W + W_OUT / 2, 2048, 1); EpiBf16 E; E.O = WSP(bf16_t, WS_R1); E.gates = nullptr; E.ldc = 2048; E.scale = W8_INV;
          gemm_phase<EpiBf16, DenseSched, true>(lds, (const char*)WSP(bf16_t, WS_HA), 2048, Sc, E, gt_, FX_NE); }
#else
          DenseSched Sc; Sc.init(T, 2048, nwg, wg, 2048 * 2, W + W_OUT / 2, 2048); EpiBf16 E; E.O = WSP(bf16_t, WS_R1); E.gates = nullptr; E.ldc = 2048; E.scale = 1.f;
          gemm_phase<EpiBf16, DenseSched>(lds, (const char*)WSP(bf16_t, WS_HA), 2048, Sc, E, gt_); }
#endif
        PH_HARVEST(7u, false);
        PH_BAR;
        { PH_BEGIN p7_phase<(l != 0)>(lds, l == 0 ? (const void*)fx_glob(pk->x) : (const void*)WSP(const bf16_t, WS_XRES), WSP(const bf16_t, WS_R1), WSP(float, WS_COEF) + (size_t)l * 4 * 6 * 2048, fx_glob(pk->router_w) + (size_t)l * D * 64, fx_glob(pk->router_bias) + l * 64,
                            WSP(bf16_t, WS_XRES), WSP(unsigned char, WS_HA), WSP(int, WS_SELE), WSP(float, WS_SELG), WSP(int, WS_CNT) + l * 64, WSP(int, WS_WGBASE), wg, nwg, gt_); }
        PH_BAR;
        { PH_BEGIN p8_phase(lds, WSP(int, WS_SELE), WSP(float, WS_SELG), WSP(int, WS_CNT) + l * 64, WSP(int, WS_WGBASE), WSP(int, WS_ROWTOK), WSP(float, WS_ROWG), WSP(int, WS_SLOT), wg, nwg, gt_); }
        PH_BAR;
        FX_REP(9) { PH_BEGIN const bf16_t* W = WSP(const bf16_t, WS_W + (size_t)l * W_LAYER);
          p9_phase(lds, WSP(unsigned char, WS_HA), (const unsigned char*)(W + W_GU / 2), WSP(int, WS_CNT) + l * 64, WSP(int, WS_ROWTOK), WSP(unsigned char, WS_R1), wg, nwg, gt_, FX_NE); }
        PH_HARVEST(10u, false);
        PH_BAR;
        FX_REP(10) { PH_BEGIN const bf16_t* W = WSP(const bf16_t, WS_W + (size_t)l * W_LAYER);
          p10_phase(lds, WSP(unsigned char, WS_R1), (const unsigned char*)(W + W_DN / 2), WSP(int, WS_CNT) + l * 64, WSP(float, WS_ROWG), WSP(unsigned char, WS_R2), wg, nwg, gt_, FX_NE); }
        PH_HARVEST(11u, false);
        PH_BAR;
        { PH_BEGIN p11_phase<(l == 1)>(WSP(bf16_t, WS_XRES), WSP(unsigned char, WS_R2), WSP(int, WS_SLOT), WSP(float, WS_COEF) + (size_t)l * 4 * 6 * 2048, l == 0 ? WSP(float, WS_COEF) + 4 * 6 * 2048 : nullptr,
                             l == 1 ? (void*)fx_glob(pk->out) : (void*)WSP(bf16_t, WS_XRES), WSP(bf16_t, WS_HA), wg, nwg, gt_); }
        PH_HARVEST(12u, true);
        if (l == 0) PH_BAR;
}
__global__ __launch_bounds__(512, 2) void mega(MP p_unused) {
    extern __shared__ __attribute__((aligned(16))) unsigned char shm[];
    FX_LAS unsigned char* lds = (FX_LAS unsigned char*)shm;
    const int wid_s = __builtin_amdgcn_readfirstlane((int)threadIdx.x >> 6);
    { volatile FX_LAS unsigned* st = (volatile FX_LAS unsigned*)(lds + LDS_ST);
      PH_BEGIN if (gt_ == 0) { st[0] = 0u; st[1] = 0u; st[2] = 0u; st[3] = 0u; }
      __syncthreads();
      (void)xcd_barrier_post((unsigned*)(ws + WS_BAR), st, gt_); }
    { PH_BEGIN const int wave = gt_ >> 6; FX_LAS unsigned* my = (FX_LAS unsigned*)(lds) + wave * (64 * 33); int rot = 0;
#pragma unroll 1
      for (int l = 0; l < ((FX_DUP == 0) ? 4 : (FX_HARVEST ? 1 : 2)); ++l) { const int lw = l & 1; CvtW a; a.w_in = fx_glob(pk->w_in) + (size_t)lw * D * 4048; a.w_uq = fx_glob(pk->w_uq) + (size_t)lw * 384 * 1152; a.w_ukv = fx_glob(pk->w_ukv) + (size_t)lw * 256 * 1536; a.w_out = fx_glob(pk->w_out) + (size_t)lw * D * D;
          a.eg = fx_glob(pk->exp_w_gate) + (size_t)lw * NE * D * FF; a.eu = fx_glob(pk->exp_w_up) + (size_t)lw * NE * D * FF; a.ed = fx_glob(pk->exp_w_down) + (size_t)lw * NE * FF * D;
          a.sg = fx_glob(pk->sh_w_gate) + (size_t)lw * D * FF; a.su = fx_glob(pk->sh_w_up) + (size_t)lw * D * FF; a.sd = fx_glob(pk->sh_w_down) + (size_t)lw * FF * D; a.W = (bf16_t*)(ws + WS_W + (size_t)lw * W_LAYER);
          cvt_layer(a, my, wg * 8 + wave, nwg * 8, rot); }
      __syncthreads(); }
    { PH_BEGIN modp_phase(lds, fx_glob(pk->c), fx_glob(pk->ada_w), WSP(float, WS_MODP), wg, nwg, gt_); tab_phase(WSP(float, WS_TAB), wg * 512 + gt_); }
#if FX_DUP == 20
    { PH_BEGIN modp_phase(lds, fx_glob(pk->c), fx_glob(pk->ada_w), WSP(float, WS_MODP), wg, nwg, gt_); tab_phase(WSP(float, WS_TAB), wg * 512 + gt_); }
#endif
    PH_BAR;
    { PH_BEGIN coef2_phase(WSP(float, WS_MODP), fx_glob(pk->ada_b), fx_glob(pk->pre_mix_gain), fx_glob(pk->post_mix_gain), fx_glob(pk->pre_ffn_gain), fx_glob(pk->post_ffn_gain), WSP(float, WS_COEF), wg * 512 + gt_, nwg * 512); }
#if FX_DUP == 21
    { PH_BEGIN coef2_phase(WSP(float, WS_MODP), fx_glob(pk->ada_b), fx_glob(pk->pre_mix_gain), fx_glob(pk->post_mix_gain), fx_glob(pk->pre_ffn_gain), fx_glob(pk->post_ffn_gain), WSP(float, WS_COEF), wg * 512 + gt_, nwg * 512); }
#endif
    PH_BAR;
    { PH_BEGIN prenorm_phase(fx_glob(pk->x), WSP(float, WS_COEF), WSP(bf16_t, WS_HA), wg, nwg, gt_); }
#if FX_DUP == 22
    { PH_BEGIN prenorm_phase(fx_glob(pk->x), WSP(float, WS_COEF), WSP(bf16_t, WS_HA), wg, nwg, gt_); }
#endif
    PH_BAR;
#if FX_DUP == 99
    PH_BAR; PH_BAR; PH_BAR; PH_BAR; PH_BAR; PH_BAR; PH_BAR; PH_BAR; PH_BAR; PH_BAR;
#endif
    layer_body<0>(lds, shm, wid_s);
    layer_body<1>(lds, shm, wid_s);
}
}

extern "C" void kernel_launch(void* const* d_in, const int* in_sizes, int n_in, void* d_out, int out_size, void* d_ws, size_t ws_size, hipStream_t stream) {
    using namespace fx;
    static int grid = 0;
    if (!grid) {
        int dev = 0, cus = 0, per_cu = 0;
        (void)hipGetDevice(&dev);
        (void)hipDeviceGetAttribute(&cus, hipDeviceAttributeMultiprocessorCount, dev);
        (void)hipFuncSetAttribute((const void*)mega, hipFuncAttributeMaxDynamicSharedMemorySize, LDS_TOTAL);
        (void)hipOccupancyMaxActiveBlocksPerMultiprocessor(&per_cu, (const void*)mega, 512, LDS_TOTAL);
        if (cus > 256) cus = 256;
        grid = per_cu >= 1 ? cus : 0;
    }
    if (!grid) return;
    (void)hipMemsetAsync((char*)d_ws + WS_BAR, 0, 16384, stream);
    (void)hipMemsetAsync((char*)d_ws + WS_CNT, 0, 512, stream);
    MP p{};
    const float** q = (const float**)&p;
    for (int i = 0; i < 28; ++i) q[i] = (const float*)d_in[i];
    p.ws = (char*)d_ws; p.out = (float*)d_out;
    hipLaunchKernelGGL(mega, dim3(grid), dim3(512), LDS_TOTAL, stream, p);
}
```

```cpp
#define FX_WIN8 1
#define FX_WOUT8 1
#define FX_HARVEST 0
#include <hip/hip_runtime.h>
#include <stdint.h>
#include <math.h>
#ifndef FX_NOEPI
#define FX_NOEPI 0
#endif
namespace fx {
#define FX_LAS __attribute__((address_space(3)))
typedef unsigned short bf16_t;
typedef short bf16x8 __attribute__((ext_vector_type(8)));
typedef short s16x4 __attribute__((ext_vector_type(4)));
typedef float f32x4 __attribute__((ext_vector_type(4)));
typedef float f32x16 __attribute__((ext_vector_type(16)));
typedef unsigned u32x4 __attribute__((ext_vector_type(4)));
typedef unsigned u32x2 __attribute__((ext_vector_type(2)));
typedef float f32x2 __attribute__((ext_vector_type(2)));

constexpr int D = 2048, NB = 4, S = 4096, T = NB * S, DEPTH = 2;
constexpr int NE = 64, FF = 512;
constexpr float EPS = 1e-6f;
constexpr int PW = 4096;
constexpr int O_AQ = 0, O_AK = 768, O_AV = 1024, O_BCQ = 1280, O_BCKV = 1664, O_BKR = 1920, O_CQ = 1984, O_CK = 2496, O_CV = 3008, O_CO = 3520, O_CG = 4032;

typedef __bf16 bf16x2_t __attribute__((ext_vector_type(2)));
__device__ __forceinline__ unsigned cvt_pk_bf16(float lo, float hi) { const bf16x2_t r = __builtin_convertvector((f32x2){lo, hi}, bf16x2_t); return __builtin_bit_cast(unsigned, r); }
__device__ __forceinline__ float bf2f(bf16_t b) { return __uint_as_float(((unsigned)b) << 16); }
__device__ __forceinline__ float bflo(unsigned w) { return __uint_as_float(w << 16); }
__device__ __forceinline__ float bfhi(unsigned w) { return __uint_as_float(w & 0xffff0000u); }
__device__ __forceinline__ bf16_t f2bf(float f) { return (bf16_t)(cvt_pk_bf16(f, 0.f) & 0xffffu); }
__device__ __forceinline__ float sigmoid_f(float x) { return __builtin_amdgcn_rcpf(1.f + __expf(-x)); }
__device__ __forceinline__ float silu_f(float x) { return x * __builtin_amdgcn_rcpf(1.f + __expf(-x)); }
__device__ __forceinline__ int fx_lane() { unsigned z = 0u; asm volatile("" : "+v"(z)); return (int)__builtin_amdgcn_mbcnt_hi(~0u, __builtin_amdgcn_mbcnt_lo(~0u, z)); }
__device__ __forceinline__ float wave_sum(float v) { for (int o = 32; o >= 1; o >>= 1) v += __shfl_xor(v, o); return v; }
__device__ __forceinline__ float wave_max(float v) { for (int o = 32; o >= 1; o >>= 1) v = fmaxf(v, __shfl_xor(v, o)); return v; }

#ifndef FX_WGM
#define FX_WGM 8
#endif
#ifndef FX_CVTPIPE
#define FX_CVTPIPE 1
#endif
#ifndef FX_PRIO8
#define FX_PRIO8 1
#endif
#ifndef FX_F8_32
#define FX_F8_32 0
#endif
typedef int i32x8 __attribute__((ext_vector_type(8)));
typedef int i32x4 __attribute__((ext_vector_type(4)));
constexpr float W8_SCALE = 32.f, W8_INV = 1.f / 32.f;
__device__ __forceinline__ unsigned cvt_pk4_fp8(float a, float b, float c, float d) { int w = 0; w = __builtin_amdgcn_cvt_pk_fp8_f32(a, b, w, false); w = __builtin_amdgcn_cvt_pk_fp8_f32(c, d, w, true); return (unsigned)w; }
struct CvtSeg { const float* src; bf16_t* dst; long long sstride, dstride; int ld, nsrc, K, ntn, nbatch, G, GS, off; };
__device__ __forceinline__ void cvt_tile(const CvtSeg sg, FX_LAS unsigned* my, int tile) {
    const int lane = fx_lane();
    const int ktn = sg.K / 64, per = ktn * sg.ntn;
    {
        const int b = tile / per, r = tile - b * per, nt = r / ktn, kt = r - nt * ktn;
        const int r4 = lane >> 4, c4 = lane & 15;
        const float* src = sg.src + (size_t)b * sg.sstride + (size_t)(kt * 64) * sg.ld + nt * 64 + 4 * c4;
        const bool ok = nt * 64 + 4 * c4 < sg.nsrc;
        f32x4 va[8], vb[8];
#pragma unroll
        for (int i = 0; i < 8; ++i) { const int kp = 4 * i + r4; const f32x4 z = {0.f, 0.f, 0.f, 0.f};
            va[i] = ok ? *(const f32x4*)(src + (size_t)(2 * kp) * sg.ld) : z; vb[i] = ok ? *(const f32x4*)(src + (size_t)(2 * kp + 1) * sg.ld) : z; }
#pragma unroll
        for (int i = 0; i < 8; ++i) { const int kp = 4 * i + r4;
#pragma unroll
            for (int j = 0; j < 4; ++j) my[(4 * c4 + j) * 33 + kp] = cvt_pk_bf16(va[i][j], vb[i][j]); }
        asm volatile("s_waitcnt lgkmcnt(0)" ::: "memory");
        bf16_t* dst = sg.dst + (size_t)b * sg.dstride;
#pragma unroll
        for (int i = 0; i < 8; ++i) {
            const int nl = (lane >> 3) + 8 * i, c = lane & 7, n = nt * 64 + nl;
            u32x4 w; w.x = my[nl * 33 + 4 * c]; w.y = my[nl * 33 + 4 * c + 1]; w.z = my[nl * 33 + 4 * c + 2]; w.w = my[nl * 33 + 4 * c + 3];
            const int row = (n / sg.G) * sg.GS + (n % sg.G) + sg.off;
            *(u32x4*)(dst + (size_t)row * sg.K + kt * 64 + 8 * c) = w;
        }
        asm volatile("s_waitcnt lgkmcnt(0)" ::: "memory");
    }
}
__device__ __forceinline__ void cvt_seg(const CvtSeg sg, FX_LAS unsigned* my, int gwave, int nwaves, int& rot) {
    const int total = (sg.K / 64) * sg.ntn * sg.nbatch;
    int first = (gwave - rot) % nwaves; if (first < 0) first += nwaves;
    for (int tile = first; tile < total; tile += nwaves) cvt_tile(sg, my, tile);
    rot = (rot + total) % nwaves;
}
__device__ __forceinline__ void cvt_tile8(const CvtSeg sg, FX_LAS unsigned* my, int tile, float scale) {
    const int lane = fx_lane();
    const int ktn = sg.K / 64, per = ktn * sg.ntn;
    {
        const int b = tile / per, r = tile - b * per, nt = r / ktn, kt = r - nt * ktn;
        const int r4 = lane >> 4, c4 = lane & 15;
        const float* src = sg.src + (size_t)b * sg.sstride + (size_t)(kt * 64) * sg.ld + nt * 64 + 4 * c4;
        const bool ok = nt * 64 + 4 * c4 < sg.nsrc;
        f32x4 v[4][4];
#pragma unroll
        for (int i = 0; i < 4; ++i)
#pragma unroll
            for (int q = 0; q < 4; ++q) { const int kq = 4 * i + r4; const f32x4 z = {0.f, 0.f, 0.f, 0.f}; v[i][q] = ok ? *(const f32x4*)(src + (size_t)(4 * kq + q) * sg.ld) : z; }
#pragma unroll
        for (int i = 0; i < 4; ++i) { const int kq = 4 * i + r4;
#pragma unroll
            for (int j = 0; j < 4; ++j) my[(4 * c4 + j) * 17 + kq] = cvt_pk4_fp8(v[i][0][j] * scale, v[i][1][j] * scale, v[i][2][j] * scale, v[i][3][j] * scale); }
        asm volatile("s_waitcnt lgkmcnt(0)" ::: "memory");
        unsigned char* dst = (unsigned char*)sg.dst + (size_t)b * sg.dstride;
#pragma unroll
        for (int i = 0; i < 4; ++i) {
            const int nl = (lane >> 2) + 16 * i, c = lane & 3, n = nt * 64 + nl;
            u32x4 w; w.x = my[nl * 17 + 4 * c]; w.y = my[nl * 17 + 4 * c + 1]; w.z = my[nl * 17 + 4 * c + 2]; w.w = my[nl * 17 + 4 * c + 3];
            const int row = (n / sg.G) * sg.GS + (n % sg.G) + sg.off;
            *(u32x4*)(dst + (size_t)row * sg.K + kt * 64 + 16 * c) = w;
        }
        asm volatile("s_waitcnt lgkmcnt(0)" ::: "memory");
    }
}
struct Cvt8P { const float* src; unsigned char* dst; float sc; int nt, kt; };
__device__ __forceinline__ Cvt8P cvt8_params(const CvtSeg sg, int tile, float scale, int lane) {
    const int ktn = sg.K / 64, per = ktn * sg.ntn;
    const int b = tile / per, r = tile - b * per, nt = r / ktn, kt = r - nt * ktn;
    const int c4 = lane & 15;
    const bool ok = nt * 64 + 4 * c4 < sg.nsrc;
    Cvt8P p; p.src = sg.src + (size_t)b * sg.sstride + (size_t)(kt * 64) * sg.ld + (ok ? nt * 64 + 4 * c4 : 0); p.dst = (unsigned char*)sg.dst + (size_t)b * sg.dstride; p.sc = ok ? scale : 0.f; p.nt = nt; p.kt = kt;
    return p;
}
__device__ __forceinline__ void cvt8_out(const CvtSeg sg, FX_LAS unsigned* my, const Cvt8P& p, int lane) {
    asm volatile("s_waitcnt lgkmcnt(0)" ::: "memory");
#pragma unroll
    for (int i = 0; i < 4; ++i) {
        const int nl = (lane >> 2) + 16 * i, c = lane & 3, n = p.nt * 64 + nl;
        u32x4 w; w.x = my[nl * 17 + 4 * c]; w.y = my[nl * 17 + 4 * c + 1]; w.z = my[nl * 17 + 4 * c + 2]; w.w = my[nl * 17 + 4 * c + 3];
        const int row = (n / sg.G) * sg.GS + (n % sg.G) + sg.off;
        *(u32x4*)(p.dst + (size_t)row * sg.K + p.kt * 64 + 16 * c) = w;
    }
    asm volatile("s_waitcnt lgkmcnt(0)" ::: "memory");
}
__device__ __forceinline__ void cvt_seg8(const CvtSeg sg, FX_LAS unsigned* my, int gwave, int nwaves, int& rot, float scale) {
    const int total = (sg.K / 64) * sg.ntn * sg.nbatch;
    int first = (gwave - rot) % nwaves; if (first < 0) first += nwaves;
#if FX_CVTPIPE
    if (first < total) {
        const int lane = fx_lane(), r4 = lane >> 4, c4 = lane & 15;
        f32x4 v[4][4];
        Cvt8P cur = cvt8_params(sg, first, scale, lane);
#pragma unroll
        for (int i = 0; i < 4; ++i)
#pragma unroll
            for (int q = 0; q < 4; ++q) v[i][q] = *(const f32x4*)(cur.src + (size_t)(4 * (4 * i + r4) + q) * sg.ld);
        int tile = first;
#pragma unroll 1
        while (tile + nwaves < total) {
            tile += nwaves;
            const Cvt8P nx = cvt8_params(sg, tile, scale, lane);
#pragma unroll
            for (int i = 0; i < 4; ++i) { const int kq = 4 * i + r4;
#pragma unroll
                for (int j = 0; j < 4; ++j) my[(4 * c4 + j) * 17 + kq] = cvt_pk4_fp8(v[i][0][j] * cur.sc, v[i][1][j] * cur.sc, v[i][2][j] * cur.sc, v[i][3][j] * cur.sc);
#pragma unroll
                for (int q = 0; q < 4; ++q) v[i][q] = *(const f32x4*)(nx.src + (size_t)(4 * kq + q) * sg.ld); }
            cvt8_out(sg, my, cur, lane);
            cur = nx;
        }
#pragma unroll
        for (int i = 0; i < 4; ++i) { const int kq = 4 * i + r4;
#pragma unroll
            for (int j = 0; j < 4; ++j) my[(4 * c4 + j) * 17 + kq] = cvt_pk4_fp8(v[i][0][j] * cur.sc, v[i][1][j] * cur.sc, v[i][2][j] * cur.sc, v[i][3][j] * cur.sc); }
        cvt8_out(sg, my, cur, lane);
    }
#else
    for (int tile = first; tile < total; tile += nwaves) cvt_tile8(sg, my, tile, scale);
#endif
    rot = (rot + total) % nwaves;
}

constexpr int BM = 256, BK = 64, HALF = 128, HTB = HALF * BK * 2, STAGE_BYTES = 8 * HTB, NXCD = 8, WGM = FX_WGM;
__host__ __device__ __forceinline__ int lds_byte(int r, int c) { const int st = (r >> 4) * 2 + (c >> 5), rr = r & 15, cc = c & 31, ob = rr * 64 + cc * 2; return st * 1024 + (ob ^ (((ob >> 9) & 1) << 5)); }
__host__ __device__ __forceinline__ void stage_rc(int b, int& R, int& C) { const int st = b / 1024, sb = b % 1024, swz = sb ^ (((sb >> 9) & 1) << 5); R = (st >> 1) * 16 + swz / 64; C = (st & 1) * 32 + (swz % 64) / 2; }
__host__ __device__ __forceinline__ int perm32(int rho) { const int n = rho >> 4, i = rho & 15; return 8 * (i >> 2) + 4 * n + (i & 3); }
struct Unit { int pm, pn, e; };
struct DenseSched {
    static constexpr bool GATHER = false;
    int nM, nN, nwg, G, c; int lda_b; const char* Bt; int K; int esz;
    __device__ void init(int M, int N, int G_, int c_, int lda_bytes, const void* Bt_, int K_, int esz_ = 2) { nM = M / BM; nN = N / BM; nwg = nM * nN; G = G_; c = c_; lda_b = lda_bytes; Bt = (const char*)Bt_; K = K_; esz = esz_; }
    __device__ __forceinline__ bool next(int i, Unit& u) const {
        const long L = (long)i * G + c; if (L >= nwg) return false;
        int wgid = (int)L; { const int q = nwg / NXCD, r = nwg % NXCD, xcd = wgid % NXCD, off = wgid / NXCD; wgid = (xcd < r ? xcd * (q + 1) : r * (q + 1) + (xcd - r) * q) + off; }
        const int nig = WGM * nN, gid = wgid / nig, fm = gid * WGM, gsz = (nM - fm) < WGM ? (nM - fm) : WGM;
        u.pm = fm + ((wgid % nig) % gsz); u.pn = (wgid % nig) / gsz; u.e = 0; return true;
    }
    __device__ __forceinline__ unsigned a_row_off(const Unit& u, int R) const { return (unsigned)(u.pm * BM + R) * (unsigned)lda_b; }
    __device__ __forceinline__ size_t a_unit_base(const Unit& u) const { return (size_t)u.pm * BM * (size_t)lda_b; }
    __device__ __forceinline__ unsigned a_lane_off(int R) const { return (unsigned)R * (unsigned)lda_b; }
    __device__ __forceinline__ const char* b_ptr(const Unit& u) const { return Bt + (size_t)u.pn * BM * K * esz; }
};

template <class Epi, class Sched, bool FP8 = false>
__device__ __forceinline__ void gemm_phase(FX_LAS unsigned char* lds, const char* Abase, const int Kc, const Sched& S, const Epi& E, int tidp, const int noepi = 0) {
    int K_ = Kc; asm volatile("" : "+s"(K_)); const int K = K_;
    int tid_ = tidp; asm volatile("" : "+v"(tid_));
    const int tid = tid_, wid = __builtin_amdgcn_readfirstlane(tid >> 6), lane = tid & 63, wr = wid >> 2, wc = wid & 3, fr = lane & 15, fq = lane >> 4;
    constexpr int ES = FP8 ? 1 : 2;
    const int nt = K * ES / 128;
    int Rr[2], Cc[2]; unsigned voffB[2];
#pragma unroll
    for (int i = 0; i < 2; ++i) { int R, C; stage_rc(tid * 16 + i * 8192, R, C); Rr[i] = R; Cc[i] = C; const int Rb = (Epi::PERM && !(FP8 && FX_F8_32)) ? ((R & ~31) + perm32(R & 31)) : R; voffB[i] = (unsigned)(Rb * K * ES + C * 2); }
    const size_t hstepB = (size_t)HALF * K * ES;
    const unsigned ldsw = (unsigned)wid * 1024u;
    constexpr bool F32M = FP8 && FX_F8_32;
    const int aoff = F32M ? lds_byte(wr * 64 + (lane & 31), 16 * (lane >> 5)) : lds_byte(wr * 64 + fr, fq * 8), boff = F32M ? lds_byte(wc * 32 + (lane & 31), 16 * (lane >> 5)) : lds_byte(wc * 32 + fr, fq * 8);
#define FX_SA(b, h) (((b) * 2 + (h)) * HTB)
#define FX_SB(b, h) ((4 + (b) * 2 + (h)) * HTB)
#define FX_STAGE_A(bufoff, o0, o1, kb) do { const char* ap_ = Abase + (kb); \
        __builtin_amdgcn_global_load_lds((const unsigned*)(ap_ + (o0)), (FX_LAS unsigned*)(lds + (bufoff) + ldsw), 16, 0, 0); \
        __builtin_amdgcn_global_load_lds((const unsigned*)(ap_ + (o1)), (FX_LAS unsigned*)(lds + (bufoff) + ldsw + 8192), 16, 0, 0); } while (0)
#define FX_STAGE_B(bufoff, gbase) do { _Pragma("unroll") for (int _i = 0; _i < 2; ++_i) \
        __builtin_amdgcn_global_load_lds((const unsigned*)((const char*)(gbase) + voffB[_i]), (FX_LAS unsigned*)(lds + (bufoff) + ldsw + _i * 8192), 16, 0, 0); } while (0)
#define FX_LDA(dst, b, h) do { if constexpr (F32M) { _Pragma("unroll") for (int q = 0; q < 4; ++q) { dst[q][0] = *(const FX_LAS bf16x8*)(lds + FX_SA(b, h) + aoff + (q >> 1) * 4096 + (q & 1) * 1024); dst[q][1] = *(const FX_LAS bf16x8*)(lds + FX_SA(b, h) + aoff + (q >> 1) * 4096 + (q & 1) * 1024 + 16); } } \
        else { _Pragma("unroll") for (int m = 0; m < 4; ++m) _Pragma("unroll") for (int k = 0; k < 2; ++k) dst[m][k] = *(const FX_LAS bf16x8*)(lds + FX_SA(b, h) + aoff + m * 2048 + k * 1024); } } while (0)
#define FX_LDB(dst, b, h) do { if constexpr (F32M) { _Pragma("unroll") for (int q = 0; q < 2; ++q) { dst[q][0] = *(const FX_LAS bf16x8*)(lds + FX_SB(b, h) + boff + q * 1024); dst[q][1] = *(const FX_LAS bf16x8*)(lds + FX_SB(b, h) + boff + q * 1024 + 16); } } \
        else { _Pragma("unroll") for (int n = 0; n < 2; ++n) _Pragma("unroll") for (int k = 0; k < 2; ++k) dst[n][k] = *(const FX_LAS bf16x8*)(lds + FX_SB(b, h) + boff + n * 2048 + k * 1024); } } while (0)
#define FX_MMA(ai, bj, At, Bt) do { if (!FP8 || FX_PRIO8) __builtin_amdgcn_s_setprio(1); \
        if constexpr (F32M) { _Pragma("unroll") for (int mb = 0; mb < 2; ++mb) _Pragma("unroll") for (int s = 0; s < 2; ++s) { \
            const i32x4 a0_ = __builtin_bit_cast(i32x4, At[mb * 2 + s][0]), a1_ = __builtin_bit_cast(i32x4, At[mb * 2 + s][1]), b0_ = __builtin_bit_cast(i32x4, Bt[s][0]), b1_ = __builtin_bit_cast(i32x4, Bt[s][1]); \
            const i32x8 af_ = __builtin_shufflevector(a0_, a1_, 0, 1, 2, 3, 4, 5, 6, 7), bf_ = __builtin_shufflevector(b0_, b1_, 0, 1, 2, 3, 4, 5, 6, 7); \
            asm volatile("v_mfma_scale_f32_32x32x64_f8f6f4 %0, %1, %2, %0, %3, %3 op_sel_hi:[0,0,0]" : "+v"(acc3[ai][bj][mb]) : "v"(bf_), "v"(af_), "v"(sc1_)); } } else \
        _Pragma("unroll") for (int m = 0; m < 4; ++m) _Pragma("unroll") for (int n = 0; n < 2; ++n) { \
        if constexpr (FP8) { const i32x4 a0_ = __builtin_bit_cast(i32x4, At[m][0]), a1_ = __builtin_bit_cast(i32x4, At[m][1]), b0_ = __builtin_bit_cast(i32x4, Bt[n][0]), b1_ = __builtin_bit_cast(i32x4, Bt[n][1]); \
            const i32x8 af_ = __builtin_shufflevector(a0_, a1_, 0, 1, 2, 3, 4, 5, 6, 7), bf_ = __builtin_shufflevector(b0_, b1_, 0, 1, 2, 3, 4, 5, 6, 7); \
            asm volatile("v_mfma_scale_f32_16x16x128_f8f6f4 %0, %1, %2, %0, %3, %3 op_sel_hi:[0,0,0]" : "+v"(acc[ai][bj][m][n]) : "v"(bf_), "v"(af_), "v"(sc1_)); FX_MFMA_DUP(acc[ai][bj][m][n]) } \
        else { _Pragma("unroll") for (int k = 0; k < 2; ++k) acc[ai][bj][m][n] = __builtin_amdgcn_mfma_f32_16x16x32_bf16(Bt[n][k], At[m][k], acc[ai][bj][m][n], 0, 0, 0); } } \
        if (!FP8 || FX_PRIO8) __builtin_amdgcn_s_setprio(0); } while (0)
#define FX_WAIT_V(n) asm volatile("s_waitcnt vmcnt(" #n ")" ::: "memory")
#define FX_WAIT_L(n) asm volatile("s_waitcnt lgkmcnt(" #n ")" ::: "memory")
#define FX_BAR __builtin_amdgcn_s_barrier()
#define FX_SCHED __builtin_amdgcn_sched_barrier(0)
#ifdef FX_PROBE_MFMA
#define FX_MFMA_DUP(ACC) asm volatile("v_mfma_scale_f32_16x16x128_f8f6f4 %0, %1, %2, %0, %3, %3 op_sel_hi:[0,0,0]" : "+v"(ACC) : "v"(bf_), "v"(af_), "v"(sc0_));
#else
#define FX_MFMA_DUP(ACC)
#endif
    const int sc0_ = 0; (void)sc0_;
    const int sc1_ = 0x7f7f7f7f;
    (void)sc1_;
    Unit cur, nxt; int ui = 0;
    if (!S.next(0, cur)) return;
    f32x4 acc[2][2][4][2];
#pragma unroll
    for (int a = 0; a < 2; ++a)
#pragma unroll
        for (int b = 0; b < 2; ++b)
#pragma unroll
            for (int m = 0; m < 4; ++m)
#pragma unroll
                for (int n = 0; n < 2; ++n) acc[a][b][m][n] = (f32x4){0.f, 0.f, 0.f, 0.f};
    f32x16 acc3[2][2][2];
#pragma unroll
    for (int q = 0; q < 8; ++q) acc3[q >> 2][(q >> 1) & 1][q & 1] = f32x16{};
    bf16x8 At[4][2], B0[2][2], B1[2][2];
    unsigned c00, c01, c10, c11, n00 = 0, n01 = 0, n10 = 0, n11 = 0;
    size_t ubc = 0, ubn = 0;
    if constexpr (Sched::GATHER) { c00 = S.a_row_off(cur, Rr[0]) + Cc[0] * 2; c01 = S.a_row_off(cur, Rr[1]) + Cc[1] * 2; c10 = S.a_row_off(cur, HALF + Rr[0]) + Cc[0] * 2; c11 = S.a_row_off(cur, HALF + Rr[1]) + Cc[1] * 2; }
    else { c00 = S.a_lane_off(Rr[0]) + Cc[0] * 2; c01 = S.a_lane_off(Rr[1]) + Cc[1] * 2; c10 = c00 + S.a_lane_off(HALF); c11 = c01 + S.a_lane_off(HALF); ubc = S.a_unit_base(cur); n00 = c00; n01 = c01; n10 = c10; n11 = c11; }
    const char* cB = S.b_ptr(cur);
    const unsigned kstep = BK * 2;
    FX_STAGE_B(FX_SB(0, 0), cB); FX_STAGE_A(FX_SA(0, 0), c00, c01, ubc); FX_STAGE_B(FX_SB(0, 1), cB + hstepB); FX_STAGE_A(FX_SA(0, 1), c10, c11, ubc);
    if (wr == 1) FX_BAR;
    FX_WAIT_V(4); FX_BAR;
    FX_STAGE_B(FX_SB(1, 0), cB + kstep); FX_STAGE_A(FX_SA(1, 0), c00, c01, ubc + kstep); FX_STAGE_B(FX_SB(1, 1), cB + hstepB + kstep);
    FX_WAIT_V(6); FX_BAR;
    for (;;) {
        const bool has_next = S.next(ui + 1, nxt);
        if (!has_next) nxt = cur;
        if constexpr (!Sched::GATHER) ubn = S.a_unit_base(nxt);
        const char* nB = S.b_ptr(nxt);
        for (int t = 0; t < nt; t += 2) {
            const bool last = (t == nt - 2);
            asm volatile("" : "+v"(c00), "+v"(c01), "+v"(c10), "+v"(c11), "+v"(voffB[0]), "+v"(voffB[1]));
            if constexpr (Sched::GATHER) { if (last) {
                int t2_ = tid; asm volatile("" : "+v"(t2_)); int R0_, C0_, R1_, C1_; stage_rc(t2_ * 16, R0_, C0_); stage_rc(t2_ * 16 + 8192, R1_, C1_);
                n00 = S.a_row_off(nxt, R0_) + C0_ * 2; n01 = S.a_row_off(nxt, R1_) + C1_ * 2; n10 = S.a_row_off(nxt, HALF + R0_) + C0_ * 2; n11 = S.a_row_off(nxt, HALF + R1_) + C1_ * 2; } }
            const size_t k1 = ubc + (size_t)(t + 1) * kstep;
            const size_t k2 = last ? ubn : ubc + (size_t)(t + 2) * kstep, k3 = k2 + kstep;
            unsigned a00, a01, a10, a11;
            if constexpr (Sched::GATHER) { a00 = last ? n00 : c00; a01 = last ? n01 : c01; a10 = last ? n10 : c10; a11 = last ? n11 : c11; } else { a00 = c00; a01 = c01; a10 = c10; a11 = c11; }
            const char* b2 = last ? nB : cB + (size_t)(t + 2) * kstep; const char* b3 = b2 + kstep;
            FX_LDB(B0, 0, 0); FX_SCHED; FX_LDA(At, 0, 0); FX_STAGE_A(FX_SA(1, 1), c10, c11, k1);
            FX_WAIT_L(8); FX_BAR; FX_WAIT_L(0); FX_MMA(0, 0, At, B0); FX_BAR; FX_SCHED;
            FX_LDB(B1, 0, 1); FX_STAGE_B(FX_SB(0, 0), b2);
            FX_BAR; FX_WAIT_L(0); FX_MMA(0, 1, At, B1); FX_BAR;
            FX_LDA(At, 0, 1); FX_STAGE_A(FX_SA(0, 0), a00, a01, k2);
            FX_BAR; FX_WAIT_L(0); FX_MMA(1, 0, At, B0); FX_BAR; FX_SCHED;
            FX_STAGE_B(FX_SB(0, 1), b2 + hstepB);
            FX_WAIT_V(6); FX_BAR; FX_MMA(1, 1, At, B1); FX_BAR;
            FX_LDB(B0, 1, 0); FX_SCHED; FX_LDA(At, 1, 0); FX_STAGE_A(FX_SA(0, 1), a10, a11, k2);
            FX_WAIT_L(8); FX_BAR; FX_WAIT_L(0); FX_MMA(0, 0, At, B0); FX_BAR; FX_SCHED;
            FX_LDB(B1, 1, 1); FX_STAGE_B(FX_SB(1, 0), b3);
            FX_BAR; FX_WAIT_L(0); FX_MMA(0, 1, At, B1); FX_BAR;
            FX_LDA(At, 1, 1); FX_STAGE_A(FX_SA(1, 0), a00, a01, k3);
            FX_BAR; FX_WAIT_L(0); FX_MMA(1, 0, At, B0); FX_BAR; FX_SCHED;
            FX_STAGE_B(FX_SB(1, 1), b3 + hstepB);
            FX_WAIT_V(6); FX_BAR; FX_MMA(1, 1, At, B1); FX_BAR;
        }
        if constexpr (FP8) asm volatile("s_nop 15\n\ts_nop 15\n\ts_nop 15\n\ts_nop 15" ::: "memory");
        if constexpr (F32M) { int ln_e = lane; asm volatile("" : "+v"(ln_e)); E.e32(acc3, cur, wr, wc, ln_e); }
        else if (noepi) { f32x4 s_ = (f32x4){0.f, 0.f, 0.f, 0.f};
#pragma unroll
            for (int q_ = 0; q_ < 32; ++q_) s_ += acc[q_ >> 4][(q_ >> 3) & 1][(q_ >> 1) & 3][q_ & 1];
            if (s_[0] + s_[1] + s_[2] + s_[3] == 1.2345e-30f) *(float*)const_cast<char*>(Abase) = s_[0]; }
        else { int fr_e = fr, fq_e = fq; asm volatile("" : "+v"(fr_e), "+v"(fq_e)); E(acc, cur, wr, wc, fr_e, fq_e); }
        if (!has_next) break;
        if constexpr (F32M) { _Pragma("unroll") for (int q = 0; q < 8; ++q) acc3[q >> 2][(q >> 1) & 1][q & 1] = f32x16{}; }
#pragma unroll
        for (int a = 0; a < 2; ++a)
#pragma unroll
            for (int b = 0; b < 2; ++b)
#pragma unroll
                for (int m = 0; m < 4; ++m)
#pragma unroll
                    for (int n = 0; n < 2; ++n) acc[a][b][m][n] = (f32x4){0.f, 0.f, 0.f, 0.f};
        cur = nxt; cB = nB; if constexpr (Sched::GATHER) { c00 = n00; c01 = n01; c10 = n10; c11 = n11; } else ubc = ubn; ++ui;
    }
    FX_WAIT_V(0);
    if (wr == 0) FX_BAR;
    FX_BAR;
}

struct EpiBf16 {
    static constexpr bool PERM = true;
    bf16_t* O; float* gates; int ldc; float scale;
    __device__ __forceinline__ void operator()(const f32x4 (&acc)[2][2][4][2], const Unit& u, int wr, int wc, int fr, int fq) const {
        const int row0 = u.pm * BM + wr * 64 + fr, col0 = u.pn * BM + wc * 32 + 8 * fq;
#pragma unroll
        for (int ai = 0; ai < 2; ++ai)
#pragma unroll
            for (int m = 0; m < 4; ++m) { const int row = row0 + ai * HALF + m * 16; bf16_t* rowp = O + (size_t)row * ldc + col0;
#pragma unroll
                for (int bj = 0; bj < 2; ++bj) { const f32x4 v0 = acc[ai][bj][m][0] * scale, v1 = acc[ai][bj][m][1] * scale;
                    u32x4 w; w.x = cvt_pk_bf16(v0[0], v0[1]); w.y = cvt_pk_bf16(v0[2], v0[3]); w.z = cvt_pk_bf16(v1[0], v1[1]); w.w = cvt_pk_bf16(v1[2], v1[3]);
                    *(u32x4*)(rowp + bj * HALF) = w; }
                if (gates && u.pn == 15 && wc == 2 && fq < 2) { float* g = gates + (size_t)row * 16 + 8 * fq; *(f32x4*)g = acc[ai][1][m][0] * scale; *(f32x4*)(g + 4) = acc[ai][1][m][1] * scale; } }
    }
    __device__ __forceinline__ void e32(const f32x16 (&acc3)[2][2][2], const Unit& u, int wr, int wc, int lane) const {
        const int j = lane & 31, hi = lane >> 5;
#pragma unroll
        for (int ai = 0; ai < 2; ++ai)
#pragma unroll
            for (int mb = 0; mb < 2; ++mb) { const int row = u.pm * BM + ai * HALF + wr * 64 + mb * 32 + j;
#pragma unroll
                for (int bj = 0; bj < 2; ++bj) { bf16_t* rowp = O + (size_t)row * ldc + u.pn * BM + bj * HALF + wc * 32 + 4 * hi;
#pragma unroll
                    for (int g = 0; g < 4; ++g) { u32x2 w; w.x = cvt_pk_bf16(acc3[ai][bj][mb][4 * g] * scale, acc3[ai][bj][mb][4 * g + 1] * scale); w.y = cvt_pk_bf16(acc3[ai][bj][mb][4 * g + 2] * scale, acc3[ai][bj][mb][4 * g + 3] * scale);
                        *(u32x2*)(rowp + 8 * g) = w; } }
                if (gates && u.pn == 15 && wc == 2) { float* gp = gates + (size_t)row * 16 + 4 * hi;
#pragma unroll
                    for (int g = 0; g < 2; ++g) *(f32x4*)(gp + 8 * g) = (f32x4){acc3[ai][1][mb][4 * g] * scale, acc3[ai][1][mb][4 * g + 1] * scale, acc3[ai][1][mb][4 * g + 2] * scale, acc3[ai][1][mb][4 * g + 3] * scale}; } }
    }
};
}
#ifndef FX_RUNR
#define FX_RUNR 16
#endif
namespace fx {
constexpr int RT = 16;
constexpr int H2S_LD = 2052;
constexpr int P7_LDS = RT * H2S_LD * 4 + 512;
constexpr int PTOT = 131072;
constexpr int NTILE_MAX = PTOT / 256;

__device__ __forceinline__ void coef_phase(const float* mod, const float* pre_mix_gain, const float* post_mix_gain, const float* pre_ffn_gain, const float* post_ffn_gain, float* coef, int gtid, int nthr) {
    for (int i = gtid; i < 2 * 4 * 2048; i += nthr) { const int d = i & 2047, b = (i >> 11) & 3, l = i >> 13;
        const float* m = mod + ((size_t)l * 4 + b) * 12288; float* c = coef + ((size_t)l * 4 + b) * 6 * 2048;
        c[0 * 2048 + d] = m[2 * 2048 + d] * post_mix_gain[l * 2048 + d];
        c[1 * 2048 + d] = pre_ffn_gain[l * 2048 + d] * (1.f + m[4 * 2048 + d]);
        c[2 * 2048 + d] = m[3 * 2048 + d];
        c[3 * 2048 + d] = m[5 * 2048 + d] * post_ffn_gain[l * 2048 + d];
        c[4 * 2048 + d] = pre_mix_gain[l * 2048 + d] * (1.f + m[1 * 2048 + d]);
        c[5 * 2048 + d] = m[0 * 2048 + d]; }
}

template <bool XBF>
__device__ __forceinline__ void p7_phase(FX_LAS unsigned char* lds, const void* xin_, const bf16_t* Y, const float* coef_l  , const float* router_w, const float* router_bias,
                                         bf16_t* XRES, unsigned char* HA8, int* SELE, float* SELG, int* CNT, int* WGBASE, int wg, int nwg, int tidp) {
    int tid_ = tidp; asm volatile("" : "+v"(tid_));
    const int tid = tid_, wid = tid >> 6, lane = tid & 63;
    FX_LAS float* h2s = (FX_LAS float*)lds;
    FX_LAS int* hist = (FX_LAS int*)(lds + RT * H2S_LD * 4);
    if (tid < 64) hist[tid] = 0;
    __syncthreads();
#define FX_GC(TY, p) ((const __attribute__((address_space(1))) TY*)(p))
#define FX_GM(TY, p) ((__attribute__((address_space(1))) TY*)(p))
    const int i16 = lane & 15, g4 = lane >> 4;
    for (int unit = wg; unit < T / RT; unit += nwg) {
        {
            const int tok0 = 2 * wid, t0 = unit * RT + tok0, b = t0 / S;
            const float* cf = coef_l + (size_t)b * 6 * 2048;
            u32x4 yw[2][4]; f32x4 ca[8];
            float xv[2][32];
#pragma unroll
            for (int tt = 0; tt < 2; ++tt)
#pragma unroll
                for (int i = 0; i < 4; ++i) yw[tt][i] = *FX_GC(u32x4, Y + (size_t)(t0 + tt) * 2048 + i * 512 + lane * 8);
            if constexpr (XBF) {
                u32x4 xw[2][4];
#pragma unroll
                for (int tt = 0; tt < 2; ++tt)
#pragma unroll
                    for (int i = 0; i < 4; ++i) xw[tt][i] = *FX_GC(u32x4, (const bf16_t*)xin_ + (size_t)(t0 + tt) * 2048 + i * 512 + lane * 8);
#pragma unroll
                for (int i = 0; i < 4; ++i) { ca[2 * i] = *FX_GC(f32x4, cf + i * 512 + lane * 8); ca[2 * i + 1] = *FX_GC(f32x4, cf + i * 512 + lane * 8 + 4); }
#pragma unroll
                for (int tt = 0; tt < 2; ++tt)
#pragma unroll
                    for (int i = 0; i < 4; ++i) { const u32x4 w = xw[tt][i];
                        xv[tt][i * 8 + 0] = bflo(w.x); xv[tt][i * 8 + 1] = bfhi(w.x); xv[tt][i * 8 + 2] = bflo(w.y); xv[tt][i * 8 + 3] = bfhi(w.y); xv[tt][i * 8 + 4] = bflo(w.z); xv[tt][i * 8 + 5] = bfhi(w.z); xv[tt][i * 8 + 6] = bflo(w.w); xv[tt][i * 8 + 7] = bfhi(w.w); }
            } else {
                const float* xin = (const float*)xin_;
#pragma unroll
                for (int tt = 0; tt < 2; ++tt)
#pragma unroll
                    for (int i = 0; i < 4; ++i) { const f32x4 x0 = *FX_GC(f32x4, xin + (size_t)(t0 + tt) * 2048 + i * 512 + lane * 8), x1 = *FX_GC(f32x4, xin + (size_t)(t0 + tt) * 2048 + i * 512 + lane * 8 + 4);
                        xv[tt][i * 8 + 0] = x0[0]; xv[tt][i * 8 + 1] = x0[1]; xv[tt][i * 8 + 2] = x0[2]; xv[tt][i * 8 + 3] = x0[3]; xv[tt][i * 8 + 4] = x1[0]; xv[tt][i * 8 + 5] = x1[1]; xv[tt][i * 8 + 6] = x1[2]; xv[tt][i * 8 + 7] = x1[3]; }
#pragma unroll
                for (int i = 0; i < 4; ++i) { ca[2 * i] = *FX_GC(f32x4, cf + i * 512 + lane * 8); ca[2 * i + 1] = *FX_GC(f32x4, cf + i * 512 + lane * 8 + 4); }
            }
            float ssy0 = 0.f, ssy1 = 0.f;
#pragma unroll
            for (int i = 0; i < 4; ++i) { const u32x4 w0 = yw[0][i], w1 = yw[1][i];
#pragma unroll
                for (int q = 0; q < 4; ++q) { const float l0 = bflo(w0[q]), h0 = bfhi(w0[q]), l1 = bflo(w1[q]), h1 = bfhi(w1[q]); ssy0 += l0 * l0 + h0 * h0; ssy1 += l1 * l1 + h1 * h1; } }
#pragma unroll
            for (int o = 32; o >= 1; o >>= 1) { ssy0 += __shfl_xor(ssy0, o); ssy1 += __shfl_xor(ssy1, o); }
            const float ry0 = rsqrtf(ssy0 * (1.f / 2048.f) + EPS), ry1 = rsqrtf(ssy1 * (1.f / 2048.f) + EPS);
            float ssx0 = 0.f, ssx1 = 0.f;
#pragma unroll
            for (int i = 0; i < 4; ++i) { const u32x4 w0 = yw[0][i], w1 = yw[1][i];
#pragma unroll
                for (int j = 0; j < 8; ++j) { const float a = ca[2 * i + (j >> 2)][j & 3];
                    const float y0 = (j & 1) ? bfhi(w0[j >> 1]) : bflo(w0[j >> 1]), y1 = (j & 1) ? bfhi(w1[j >> 1]) : bflo(w1[j >> 1]);
                    xv[0][i * 8 + j] += a * (y0 * ry0); xv[1][i * 8 + j] += a * (y1 * ry1);
                    ssx0 += xv[0][i * 8 + j] * xv[0][i * 8 + j]; ssx1 += xv[1][i * 8 + j] * xv[1][i * 8 + j]; } }
            f32x4 cb[8], cc[8];
#pragma unroll
            for (int i = 0; i < 4; ++i) { cb[2 * i] = *FX_GC(f32x4, cf + 2048 + i * 512 + lane * 8); cb[2 * i + 1] = *FX_GC(f32x4, cf + 2048 + i * 512 + lane * 8 + 4);
                cc[2 * i] = *FX_GC(f32x4, cf + 4096 + i * 512 + lane * 8); cc[2 * i + 1] = *FX_GC(f32x4, cf + 4096 + i * 512 + lane * 8 + 4); }
#pragma unroll
            for (int tt = 0; tt < 2; ++tt)
#pragma unroll
                for (int i = 0; i < 4; ++i) { u32x4 xo; xo.x = cvt_pk_bf16(xv[tt][i * 8 + 0], xv[tt][i * 8 + 1]); xo.y = cvt_pk_bf16(xv[tt][i * 8 + 2], xv[tt][i * 8 + 3]); xo.z = cvt_pk_bf16(xv[tt][i * 8 + 4], xv[tt][i * 8 + 5]); xo.w = cvt_pk_bf16(xv[tt][i * 8 + 6], xv[tt][i * 8 + 7]);
                    *FX_GM(u32x4, XRES + (size_t)(t0 + tt) * 2048 + i * 512 + lane * 8) = xo; }
#pragma unroll
            for (int o = 32; o >= 1; o >>= 1) { ssx0 += __shfl_xor(ssx0, o); ssx1 += __shfl_xor(ssx1, o); }
            const float rx0 = rsqrtf(ssx0 * (1.f / 2048.f) + EPS), rx1 = rsqrtf(ssx1 * (1.f / 2048.f) + EPS);
#pragma unroll
            for (int tt = 0; tt < 2; ++tt) { const float rx = tt ? rx1 : rx0;
#pragma unroll
                for (int i = 0; i < 4; ++i) { const int c = i * 512 + lane * 8;
                    float hv[8];
#pragma unroll
                    for (int j = 0; j < 8; ++j) hv[j] = xv[tt][i * 8 + j] * rx * cb[2 * i + (j >> 2)][j & 3] + cc[2 * i + (j >> 2)][j & 3];
                    u32x2 w; w.x = cvt_pk4_fp8(hv[0], hv[1], hv[2], hv[3]); w.y = cvt_pk4_fp8(hv[4], hv[5], hv[6], hv[7]);
                    *FX_GM(u32x2, HA8 + (size_t)(t0 + tt) * 2048 + c) = w;
                    *(FX_LAS f32x4*)(h2s + (tok0 + tt) * H2S_LD + c) = (f32x4){hv[0], hv[1], hv[2], hv[3]};
                    *(FX_LAS f32x4*)(h2s + (tok0 + tt) * H2S_LD + c + 4) = (f32x4){hv[4], hv[5], hv[6], hv[7]}; } }
        }
        f32x4 acc[4];
#pragma unroll
        for (int j = 0; j < 4; ++j) acc[j] = (f32x4){0.f, 0.f, 0.f, 0.f};
        {
            const char* rwb = (const char*)router_w + (size_t)__builtin_amdgcn_readfirstlane(wid) * (256 * 64 * 4);
            const unsigned loff = (unsigned)(g4 * 64 + 4 * i16) * 4u;
            f32x4 bwA[8], bwB[8];
            { unsigned o_ = loff; asm volatile("" : "+v"(o_));
#pragma unroll
              for (int q = 0; q < 8; ++q) bwA[q] = *FX_GC(f32x4, rwb + o_ + q * 1024); }
            __syncthreads();
#pragma unroll
            for (int kb = 0; kb < 8; ++kb) {
                if (kb < 7) { unsigned o_ = loff + (kb + 1) * 8192; asm volatile("" : "+v"(o_));
#pragma unroll
                    for (int q = 0; q < 8; ++q) { const f32x4 v = *FX_GC(f32x4, rwb + o_ + q * 1024); if (kb & 1) bwA[q] = v; else bwB[q] = v; } }
#pragma unroll
                for (int q = 0; q < 8; ++q) { const int k = 256 * wid + 4 * (kb * 8 + q) + g4;
                    const float a = h2s[i16 * H2S_LD + k]; const f32x4 bw = (kb & 1) ? bwB[q] : bwA[q];
                    acc[0] = __builtin_amdgcn_mfma_f32_16x16x4f32(a, bw[0], acc[0], 0, 0, 0);
                    acc[1] = __builtin_amdgcn_mfma_f32_16x16x4f32(a, bw[1], acc[1], 0, 0, 0);
                    acc[2] = __builtin_amdgcn_mfma_f32_16x16x4f32(a, bw[2], acc[2], 0, 0, 0);
                    acc[3] = __builtin_amdgcn_mfma_f32_16x16x4f32(a, bw[3], acc[3], 0, 0, 0); } }
        }
        __syncthreads();
        { FX_LAS float* part = h2s; const int i16 = lane & 15, g = lane >> 4;
#pragma unroll
          for (int j = 0; j < 4; ++j)
#pragma unroll
            for (int r = 0; r < 4; ++r) part[(wid * 16 + 4 * g + r) * 64 + 4 * i16 + j] = acc[j][r]; }
        __syncthreads();
#pragma unroll 1
        for (int tt = 0; tt < 2; ++tt) {
            const int tok = 2 * wid + tt, t = unit * RT + tok;
            float lg = 0.f;
#pragma unroll
            for (int w = 0; w < 8; ++w) lg += h2s[(w * 16 + tok) * 64 + lane];
            const float score = 1.f / (1.f + expf(-lg));
            float v = score + router_bias[lane];
            int my_e = 0; float my_s = 0.f, sum = 0.f;
#pragma unroll
            for (int k = 0; k < 6; ++k) {
                const float m = wave_max(v);
                const unsigned long long bal = __ballot(v == m);
                const int win = __ffsll((long long)bal) - 1;
                const float sw = __shfl(score, win);
                sum += sw; if (lane == k) { my_e = win; my_s = sw; }
                if (lane == win) v = -3.0e38f;
            }
            if (lane < 6) { SELE[(size_t)t * 6 + lane] = my_e; SELG[(size_t)t * 6 + lane] = my_s / sum * 2.5f; __hip_atomic_fetch_add(hist + my_e, 1, __ATOMIC_RELAXED, __HIP_MEMORY_SCOPE_WORKGROUP); }
        }
        __syncthreads();
    }
    if (tid < 64) { const int hv = hist[tid]; const int base = atomicAdd(CNT + tid, hv); WGBASE[wg * 64 + tid] = base; }
}

__device__ __forceinline__ void p8_phase(FX_LAS unsigned char* lds, const int* SELE, const float* SELG, const int* CNT, const int* WGBASE, int* ROWTOK, float* ROWG, int* SLOT, int wg, int nwg, int tidp) {
    int tid_ = tidp; asm volatile("" : "+v"(tid_));
    const int tid = tid_;
    FX_LAS int* pstart = (FX_LAS int*)lds; FX_LAS int* off = pstart + 80;
    if (tid < 64) { const int pc = (CNT[tid] + 255) & ~255; int incl = pc;
#pragma unroll
        for (int o = 1; o < 64; o <<= 1) { const int t2 = __shfl_up(incl, o); if (tid >= o) incl += t2; }
        pstart[tid] = 16384 + incl - pc; if (tid == 63) pstart[64] = 16384 + incl; }
    __syncthreads();
    if (tid < 64) off[tid] = pstart[tid] + WGBASE[wg * 64 + tid];
    __syncthreads();
    for (int unit = wg; unit < T / RT; unit += nwg) {
        if (tid < RT * 6) { const int t = unit * RT + tid / 6, k = tid % 6; const int e = SELE[(size_t)t * 6 + k];
            const int pos = __hip_atomic_fetch_add(off + e, 1, __ATOMIC_RELAXED, __HIP_MEMORY_SCOPE_WORKGROUP);
            ROWTOK[pos] = t; ROWG[pos] = SELG[(size_t)t * 6 + k]; SLOT[(size_t)t * 6 + k] = pos; }
    }
    for (int e = wg; e < 64; e += nwg) { const int a = pstart[e] + CNT[e], b = pstart[e + 1]; for (int r = a + tid; r < b; r += 512) { ROWTOK[r] = 0; ROWG[r] = 0.f; } }
    for (int r = wg * 512 + tid; r < 16384; r += nwg * 512) { ROWTOK[r] = r; ROWG[r] = 1.f; }
}

struct MoeSched {
    static constexpr bool GATHER = true;
    FX_LAS const unsigned char* tile_e; int ntiles, npn, nunits, G, c;
    const int* rowtok; int lda_b; const char* Bt; size_t estride_b, pnstride_b;
    __device__ __forceinline__ bool next(int i, Unit& u) const {
        const long L = (long)i * G + c; if (L >= nunits) return false;
        int id = (int)L; { const int q = nunits / NXCD, r = nunits % NXCD, xcd = id % NXCD, off = id / NXCD; id = (xcd < r ? xcd * (q + 1) : r * (q + 1) + (xcd - r) * q) + off; }
        u.pm = id / npn; u.pn = id - u.pm * npn; u.e = tile_e[u.pm]; return true;
    }
    __device__ __forceinline__ unsigned a_row_off(const Unit& u, int R) const { const int row = u.pm * BM + R; return (unsigned)(rowtok ? rowtok[row] : row) * (unsigned)lda_b; }
    __device__ __forceinline__ const char* b_ptr(const Unit& u) const { return Bt + (size_t)u.e * estride_b + (size_t)u.pn * pnstride_b; }
};
__device__ __forceinline__ int moe_sched_build(FX_LAS unsigned char* tab, const int* CNT, int tidp) {
    FX_LAS int* nt = (FX_LAS int*)(tab + 512);
    int tid_ = tidp; asm volatile("" : "+v"(tid_));
    if (tid_ < 64) { const int n = (CNT[tid_] + 255) >> 8; int incl = n;
#pragma unroll
        for (int o = 1; o < 64; o <<= 1) { const int t2 = __shfl_up(incl, o); if (tid_ >= o) incl += t2; }
        const int st0 = 64 + incl - n; for (int j = 0; j < n; ++j) tab[st0 + j] = (unsigned char)tid_;
        tab[tid_] = 64; if (tid_ == 63) nt[0] = 64 + incl; }
    __syncthreads();
    return nt[0];
}
struct EpiGateUp {
    static constexpr bool PERM = true;
    unsigned char* HID;
    __device__ __forceinline__ void operator()(const f32x4 (&acc)[2][2][4][2], const Unit& u, int wr, int wc, int fr, int fq) const {
        const int row0 = u.pm * BM + wr * 64 + fr, col0 = u.pn * 128 + wc * 32 + 8 * fq;
#pragma unroll
        for (int ai = 0; ai < 2; ++ai)
#pragma unroll
            for (int m = 0; m < 4; ++m) { const int row = row0 + ai * HALF + m * 16;
                float o[8];
#pragma unroll
                for (int n = 0; n < 2; ++n)
#pragma unroll
                    for (int j = 0; j < 4; ++j) { const float g = acc[ai][0][m][n][j] * W8_INV, up = acc[ai][1][m][n][j] * W8_INV; o[n * 4 + j] = g * __builtin_amdgcn_rcpf(1.f + __expf(-g)) * up; }
                u32x2 w; w.x = cvt_pk4_fp8(o[0], o[1], o[2], o[3]); w.y = cvt_pk4_fp8(o[4], o[5], o[6], o[7]);
                *(u32x2*)(HID + (size_t)row * 512 + col0) = w; }
    }
    __device__ __forceinline__ void e32(const f32x16 (&acc3)[2][2][2], const Unit& u, int wr, int wc, int lane) const {
        const int j = lane & 31, hi = lane >> 5;
#pragma unroll
        for (int ai = 0; ai < 2; ++ai)
#pragma unroll
            for (int mb = 0; mb < 2; ++mb) { const int row = u.pm * BM + ai * HALF + wr * 64 + mb * 32 + j; unsigned char* rowp = HID + (size_t)row * 512 + u.pn * 128 + wc * 32 + 4 * hi;
#pragma unroll
                for (int g = 0; g < 4; ++g) { float o[4];
#pragma unroll
                    for (int q = 0; q < 4; ++q) { const float gt = acc3[ai][0][mb][4 * g + q] * W8_INV, up = acc3[ai][1][mb][4 * g + q] * W8_INV; o[q] = gt * __builtin_amdgcn_rcpf(1.f + __expf(-gt)) * up; }
                    *(unsigned*)(rowp + 8 * g) = cvt_pk4_fp8(o[0], o[1], o[2], o[3]); } }
    }
};
struct EpiDown {
    static constexpr bool PERM = true;
    unsigned char* YR; const float* ROWG; int nostore;
    __device__ __forceinline__ void operator()(const f32x4 (&acc)[2][2][4][2], const Unit& u, int wr, int wc, int fr, int fq) const {
        const int row0 = u.pm * BM + wr * 64 + fr, col0 = u.pn * BM + wc * 32 + 8 * fq;
        float gs[2][4];
#pragma unroll
        for (int ai = 0; ai < 2; ++ai)
#pragma unroll
            for (int m = 0; m < 4; ++m) gs[ai][m] = ROWG[row0 + ai * HALF + m * 16];
#pragma unroll
        for (int ai = 0; ai < 2; ++ai)
#pragma unroll
            for (int m = 0; m < 4; ++m) { const int row = row0 + ai * HALF + m * 16; const float g = gs[ai][m] * W8_INV; unsigned char* rowp = YR + (size_t)row * 2048 + col0;
#pragma unroll
                for (int bj = 0; bj < 2; ++bj) { const f32x4 v0 = acc[ai][bj][m][0] * g, v1 = acc[ai][bj][m][1] * g;
                    u32x2 w; w.x = cvt_pk4_fp8(v0[0], v0[1], v0[2], v0[3]); w.y = cvt_pk4_fp8(v1[0], v1[1], v1[2], v1[3]);
                    if (!FX_NOEPI || !nostore || (w.x == 0x12345678u && w.y == 0x9abcdef0u))
                    *(u32x2*)(rowp + bj * HALF) = w; } }
    }
    __device__ __forceinline__ void e32(const f32x16 (&acc3)[2][2][2], const Unit& u, int wr, int wc, int lane) const {
        const int j = lane & 31, hi = lane >> 5;
#pragma unroll
        for (int ai = 0; ai < 2; ++ai)
#pragma unroll
            for (int mb = 0; mb < 2; ++mb) { const int row = u.pm * BM + ai * HALF + wr * 64 + mb * 32 + j; const float gsc = ROWG[row] * W8_INV;
#pragma unroll
                for (int bj = 0; bj < 2; ++bj) { unsigned char* rowp = YR + (size_t)row * 2048 + u.pn * BM + bj * HALF + wc * 32 + 4 * hi;
#pragma unroll
                    for (int g = 0; g < 4; ++g) *(unsigned*)(rowp + 8 * g) = cvt_pk4_fp8(acc3[ai][bj][mb][4 * g] * gsc, acc3[ai][bj][mb][4 * g + 1] * gsc, acc3[ai][bj][mb][4 * g + 2] * gsc, acc3[ai][bj][mb][4 * g + 3] * gsc); } }
    }
};
__device__ __forceinline__ void p9_phase(FX_LAS unsigned char* lds, const unsigned char* HA, const unsigned char* WGU, const int* CNT, const int* ROWTOK, unsigned char* HID, int wg, int nwg, int tidp, const int noepi = 0) {
    FX_LAS unsigned char* tab = lds + STAGE_BYTES;
    const int ntiles = moe_sched_build(tab, CNT, tidp);
    MoeSched Sc; Sc.tile_e = tab; Sc.ntiles = ntiles; Sc.npn = 4; Sc.nunits = ntiles * 4; Sc.G = nwg; Sc.c = wg; Sc.rowtok = ROWTOK; Sc.lda_b = 2048; Sc.Bt = (const char*)WGU; Sc.estride_b = (size_t)1024 * 2048; Sc.pnstride_b = (size_t)256 * 2048;
    EpiGateUp E; E.HID = HID;
    gemm_phase<EpiGateUp, MoeSched, true>(lds, (const char*)HA, 2048, Sc, E, tidp, noepi);
}
__device__ __forceinline__ void p10_phase(FX_LAS unsigned char* lds, const unsigned char* HID, const unsigned char* WDN, const int* CNT, const float* ROWG, unsigned char* YR, int wg, int nwg, int tidp, const int noepi = 0) {
    FX_LAS unsigned char* tab = lds + STAGE_BYTES;
    const int ntiles = moe_sched_build(tab, CNT, tidp);
    MoeSched Sc; Sc.tile_e = tab; Sc.ntiles = ntiles; Sc.npn = 8; Sc.nunits = ntiles * 8; Sc.G = nwg; Sc.c = wg; Sc.rowtok = nullptr; Sc.lda_b = 512; Sc.Bt = (const char*)WDN; Sc.estride_b = (size_t)2048 * 512; Sc.pnstride_b = (size_t)256 * 512;
    EpiDown E; E.YR = YR; E.ROWG = ROWG; E.nostore = (noepi == 2);
    gemm_phase<EpiDown, MoeSched, true>(lds, (const char*)HID, 512, Sc, E, tidp, noepi == 1);
}
template <bool OUTF32>
__device__ __forceinline__ void p11_phase(const bf16_t* x1, const unsigned char* YR, const int* SLOT, const float* coef_l, const float* coef_next  , void* xout_, bf16_t* HA, int wg, int nwg, int tidp) {
    int tid_ = tidp; asm volatile("" : "+v"(tid_));
    const int wid = __builtin_amdgcn_readfirstlane(tid_ >> 6), lane = tid_ & 63;
    for (int t = wg * 8 + wid; t < T; t += nwg * 8) {
        const int b = t / S; const float* cf = coef_l + (size_t)b * 6 * 2048;
        int rows[7]; rows[0] = t;
        { int sl[6];
#pragma unroll
          for (int k = 0; k < 6; ++k) sl[k] = *FX_GC(int, SLOT + (size_t)t * 6 + k);
#pragma unroll
          for (int k = 0; k < 6; ++k) rows[k + 1] = __builtin_amdgcn_readfirstlane(sl[k]); }
        u32x2 ra[4][4];
#pragma unroll
        for (int k = 0; k < 4; ++k)
#pragma unroll
            for (int i = 0; i < 4; ++i) ra[k][i] = *FX_GC(u32x2, YR + (size_t)rows[k] * 2048 + i * 512 + lane * 8);
        u32x4 xw[4];
#pragma unroll
        for (int i = 0; i < 4; ++i) xw[i] = *FX_GC(u32x4, x1 + (size_t)t * 2048 + i * 512 + lane * 8);
        float yv[32];
#pragma unroll
        for (int j = 0; j < 32; ++j) yv[j] = 0.f;
#define FX_ACC8(W, I) do { const f32x2 a0 = __builtin_amdgcn_cvt_pk_f32_fp8((int)(W).x, false), a1 = __builtin_amdgcn_cvt_pk_f32_fp8((int)(W).x, true), a2 = __builtin_amdgcn_cvt_pk_f32_fp8((int)(W).y, false), a3 = __builtin_amdgcn_cvt_pk_f32_fp8((int)(W).y, true); \
            yv[(I) * 8 + 0] += a0[0]; yv[(I) * 8 + 1] += a0[1]; yv[(I) * 8 + 2] += a1[0]; yv[(I) * 8 + 3] += a1[1]; yv[(I) * 8 + 4] += a2[0]; yv[(I) * 8 + 5] += a2[1]; yv[(I) * 8 + 6] += a3[0]; yv[(I) * 8 + 7] += a3[1]; } while (0)
#pragma unroll
        for (int k = 0; k < 4; ++k)
#pragma unroll
            for (int i = 0; i < 4; ++i) FX_ACC8(ra[k][i], i);
        u32x2 rb[3][4];
#pragma unroll
        for (int k = 0; k < 3; ++k)
#pragma unroll
            for (int i = 0; i < 4; ++i) rb[k][i] = *FX_GC(u32x2, YR + (size_t)rows[4 + k] * 2048 + i * 512 + lane * 8);
        f32x4 cd[8];
#pragma unroll
        for (int i = 0; i < 4; ++i) { cd[2 * i] = *FX_GC(f32x4, cf + 3 * 2048 + i * 512 + lane * 8); cd[2 * i + 1] = *FX_GC(f32x4, cf + 3 * 2048 + i * 512 + lane * 8 + 4); }
#pragma unroll
        for (int k = 0; k < 3; ++k)
#pragma unroll
            for (int i = 0; i < 4; ++i) FX_ACC8(rb[k][i], i);
#undef FX_ACC8
        float ss = 0.f;
#pragma unroll
        for (int j = 0; j < 32; ++j) ss += yv[j] * yv[j];
        ss = wave_sum(ss); const float ry = rsqrtf(ss * (1.f / 2048.f) + EPS); float ssx = 0.f;
#pragma unroll
        for (int i = 0; i < 4; ++i) { const u32x4 w = xw[i];
            const float xs[8] = {bflo(w.x), bfhi(w.x), bflo(w.y), bfhi(w.y), bflo(w.z), bfhi(w.z), bflo(w.w), bfhi(w.w)};
#pragma unroll
            for (int j = 0; j < 8; ++j) { yv[i * 8 + j] = xs[j] + cd[2 * i + (j >> 2)][j & 3] * (yv[i * 8 + j] * ry); ssx += yv[i * 8 + j] * yv[i * 8 + j]; } }
        f32x4 ce[8], cg[8];
        if (coef_next) { const float* cn = coef_next + (size_t)b * 6 * 2048;
#pragma unroll
            for (int i = 0; i < 4; ++i) { ce[2 * i] = *FX_GC(f32x4, cn + 4 * 2048 + i * 512 + lane * 8); ce[2 * i + 1] = *FX_GC(f32x4, cn + 4 * 2048 + i * 512 + lane * 8 + 4);
                cg[2 * i] = *FX_GC(f32x4, cn + 5 * 2048 + i * 512 + lane * 8); cg[2 * i + 1] = *FX_GC(f32x4, cn + 5 * 2048 + i * 512 + lane * 8 + 4); } }
#pragma unroll
        for (int i = 0; i < 4; ++i) { const int c = i * 512 + lane * 8;
            if constexpr (OUTF32) { float* xout = (float*)xout_; *FX_GM(f32x4, xout + (size_t)t * 2048 + c) = (f32x4){yv[i * 8 + 0], yv[i * 8 + 1], yv[i * 8 + 2], yv[i * 8 + 3]};
                *FX_GM(f32x4, xout + (size_t)t * 2048 + c + 4) = (f32x4){yv[i * 8 + 4], yv[i * 8 + 5], yv[i * 8 + 6], yv[i * 8 + 7]}; }
            else { u32x4 xo; xo.x = cvt_pk_bf16(yv[i * 8 + 0], yv[i * 8 + 1]); xo.y = cvt_pk_bf16(yv[i * 8 + 2], yv[i * 8 + 3]); xo.z = cvt_pk_bf16(yv[i * 8 + 4], yv[i * 8 + 5]); xo.w = cvt_pk_bf16(yv[i * 8 + 6], yv[i * 8 + 7]);
                *FX_GM(u32x4, (bf16_t*)xout_ + (size_t)t * 2048 + c) = xo; } }
        if (coef_next) { ssx = wave_sum(ssx); const float rx = rsqrtf(ssx * (1.f / 2048.f) + EPS);
#pragma unroll
            for (int i = 0; i < 4; ++i) { const int c = i * 512 + lane * 8;
                float hv[8];
#pragma unroll
                for (int j = 0; j < 8; ++j) hv[j] = yv[i * 8 + j] * rx * ce[2 * i + (j >> 2)][j & 3] + cg[2 * i + (j >> 2)][j & 3];
#ifdef FX_WIN8
                u32x2 w; w.x = cvt_pk4_fp8(hv[0], hv[1], hv[2], hv[3]); w.y = cvt_pk4_fp8(hv[4], hv[5], hv[6], hv[7]);
                *FX_GM(u32x2, (unsigned char*)HA + (size_t)t * 2048 + c) = w; } }
#else
                u32x4 w; w.x = cvt_pk_bf16(hv[0], hv[1]); w.y = cvt_pk_bf16(hv[2], hv[3]); w.z = cvt_pk_bf16(hv[4], hv[5]); w.w = cvt_pk_bf16(hv[6], hv[7]);
                *FX_GM(u32x4, HA + (size_t)t * 2048 + c) = w; } }
#endif
    }
}
}
namespace fx {
#ifndef FX_SD_A
#define FX_SD_A 2
#endif
#ifndef FX_SD_B
#define FX_SD_B 1
#endif
#ifndef FX_NQR_B
#define FX_NQR_B 8
#endif
#define FX_SBAR() __builtin_amdgcn_sched_barrier(0)
__device__ __forceinline__ int crow(int r, int hi) { return (r & 3) + 8 * (r >> 2) + 4 * hi; }
__device__ __forceinline__ int v_st(int k, int c) { const int kk = (k & ~0xC) | ((k & 4) << 1) | ((k & 8) >> 1); return ((kk >> 3) * 4 + (c >> 5)) * 512 + ((kk & 7) * 32 + (c & 31)) * 2; }
__device__ __forceinline__ int v_rd_base(int lane) { return ((lane & 3) << 3) | (((lane >> 2) & 3) << 6) | (((lane >> 4) & 1) << 5) | (((lane >> 5) & 1) << 8); }
constexpr int v_rd_off(int d0, int ks, int half) { return d0 * 512 + ks * 4096 + half * 2048; }
template <int OFF> __device__ __forceinline__ s16x4 tr_read(int vb) { s16x4 r; asm volatile("ds_read_b64_tr_b16 %0, %1 offset:%2" : "=&v"(r) : "v"(vb), "i"(OFF) : "memory"); return r; }
#define FX_PK(L, H) (bf16x8){L[0], L[1], L[2], L[3], H[0], H[1], H[2], H[3]}
template <int D0> __device__ __forceinline__ void pv_one(f32x16& od, int vb, bf16x8 pa0, bf16x8 pa1, bf16x8 pa2, bf16x8 pa3) {
    const s16x4 l0 = tr_read<v_rd_off(D0, 0, 0)>(vb), h0 = tr_read<v_rd_off(D0, 0, 1)>(vb), l1 = tr_read<v_rd_off(D0, 1, 0)>(vb), h1 = tr_read<v_rd_off(D0, 1, 1)>(vb);
    const s16x4 l2 = tr_read<v_rd_off(D0, 2, 0)>(vb), h2 = tr_read<v_rd_off(D0, 2, 1)>(vb), l3 = tr_read<v_rd_off(D0, 3, 0)>(vb), h3 = tr_read<v_rd_off(D0, 3, 1)>(vb);
    asm volatile("s_waitcnt lgkmcnt(0)" ::: "memory"); FX_SBAR();
    od = __builtin_amdgcn_mfma_f32_32x32x16_bf16(pa0, FX_PK(l0, h0), od, 0, 0, 0);
    od = __builtin_amdgcn_mfma_f32_32x32x16_bf16(pa1, FX_PK(l1, h1), od, 0, 0, 0);
    od = __builtin_amdgcn_mfma_f32_32x32x16_bf16(pa2, FX_PK(l2, h2), od, 0, 0, 0);
    od = __builtin_amdgcn_mfma_f32_32x32x16_bf16(pa3, FX_PK(l3, h3), od, 0, 0, 0);
}
__device__ __forceinline__ void pv_d0(f32x16* o, int vb, bf16x8 pa0, bf16x8 pa1, bf16x8 pa2, bf16x8 pa3) {
    pv_one<0>(o[0], vb, pa0, pa1, pa2, pa3); pv_one<1>(o[1], vb, pa0, pa1, pa2, pa3); pv_one<2>(o[2], vb, pa0, pa1, pa2, pa3); pv_one<3>(o[3], vb, pa0, pa1, pa2, pa3);
}
#define FX_PK4(P, BASE, OUT) do { unsigned a0 = cvt_pk_bf16(P[BASE + 0], P[BASE + 1]), a1 = cvt_pk_bf16(P[BASE + 2], P[BASE + 3]);   \
    unsigned b0 = cvt_pk_bf16(P[BASE + 4], P[BASE + 5]), b1 = cvt_pk_bf16(P[BASE + 6], P[BASE + 7]);                              \
    auto r0 = __builtin_amdgcn_permlane32_swap(a0, b0, false, false); auto r1 = __builtin_amdgcn_permlane32_swap(a1, b1, false, false); \
    u32x4 w = {r0[0], r1[0], r0[1], r1[1]}; OUT = *reinterpret_cast<bf16x8*>(&w); } while (0)

template <int DQK> struct AttnC {
    static constexpr int NQ = DQK / 16, KROW = DQK * 2, SHM_V = 64 * 128 * 2, SHM_K = 64 * DQK * 2, NQR = (DQK == 128 ? 8 : FX_NQR_B)  , QX = (NQ - NQR) * 8 * 64 * 16, SHM = 2 * SHM_V + 2 * SHM_K + 8 * 64 * 4 + QX;
    static constexpr float SCALE = DQK == 128 ? 0.088388347648318440f : 0.072168783648703220f;
    static constexpr float THR = 8.f;
};
#define FX_KSWZ(row, colB) ((row) * C::KROW + ((colB) ^ (((row) & 7) << 4)))

template <int DQK> __device__ __forceinline__ void partialSM(f32x16& p0, f32x16& p1, float& m_reg, float& mn, float& alpha) {
    using C = AttnC<DQK>;
    constexpr float Cc = C::SCALE * 1.4426950408889634f;
    float pmax = p0[0];
#pragma unroll
    for (int r = 1; r < 16; ++r) pmax = fmaxf(pmax, p0[r]);
#pragma unroll
    for (int r = 0; r < 16; ++r) pmax = fmaxf(pmax, p1[r]);
    { auto rr = __builtin_amdgcn_permlane32_swap(__float_as_uint(pmax), __float_as_uint(pmax), false, false); pmax = fmaxf(__uint_as_float(rr[0]), __uint_as_float(rr[1])); }
    if (__builtin_expect(__all(pmax - m_reg <= C::THR / C::SCALE), 1)) { mn = m_reg; alpha = 1.f; }
    else { mn = fmaxf(m_reg, pmax); alpha = __builtin_amdgcn_exp2f((m_reg - mn) * Cc); m_reg = mn; }
    const float mnC = -mn * Cc;
#pragma unroll
    for (int r = 0; r < 16; ++r) p0[r] = fmaf(p0[r], Cc, mnC);
#pragma unroll
    for (int r = 0; r < 16; ++r) p1[r] = fmaf(p1[r], Cc, mnC);
#pragma unroll
    for (int r = 0; r < 16; ++r) p0[r] = __builtin_amdgcn_exp2f(p0[r]);
}
__device__ __forceinline__ void finishSM(f32x16& p0, f32x16& p1, float alpha, float& l_reg, bf16x8& pa0, bf16x8& pa1, bf16x8& pa2, bf16x8& pa3) {
#pragma unroll
    for (int r = 0; r < 16; ++r) p1[r] = __builtin_amdgcn_exp2f(p1[r]);
    float ps = 0;
#pragma unroll
    for (int r = 0; r < 16; ++r) ps += p0[r];
#pragma unroll
    for (int r = 0; r < 16; ++r) ps += p1[r];
    { auto rr = __builtin_amdgcn_permlane32_swap(__float_as_uint(ps), __float_as_uint(ps), false, false); ps = __uint_as_float(rr[0]) + __uint_as_float(rr[1]); }
    l_reg = l_reg * alpha + ps;
    FX_PK4(p0, 0, pa0); FX_PK4(p0, 8, pa1); FX_PK4(p1, 0, pa2); FX_PK4(p1, 8, pa3);
}
template <int DQK> __device__ __forceinline__ void qkt(f32x16& p0, f32x16& p1, const char* Ks, const bf16x8* qr, const char* qx  , int r32, int hi) {
    using C = AttnC<DQK>;
    p0 = f32x16{}; p1 = f32x16{};
#pragma unroll
    for (int d0 = 0; d0 < C::NQ; ++d0) { const int cb = (d0 * 16 + hi * 8) * 2;
        const bf16x8 qf = d0 < C::NQR ? qr[d0 < C::NQR ? d0 : 0] : *reinterpret_cast<const bf16x8*>(qx + (d0 - C::NQR) * 1024);
        const bf16x8 b0 = *reinterpret_cast<const bf16x8*>(Ks + FX_KSWZ(r32, cb));
        const bf16x8 b1 = *reinterpret_cast<const bf16x8*>(Ks + FX_KSWZ(32 + r32, cb));
        p0 = __builtin_amdgcn_mfma_f32_32x32x16_bf16(b0, qf, p0, 0, 0, 0);
        p1 = __builtin_amdgcn_mfma_f32_32x32x16_bf16(b1, qf, p1, 0, 0, 0); }
}

template <int DQK, int SD, int LDQ, int LDK1, int LDK2, int LDV>
__device__ __forceinline__ void attn_unit(const bf16_t* __restrict__ Qb, const bf16_t* __restrict__ K1, const bf16_t* __restrict__ K2, const bf16_t* __restrict__ Vh,
                                          bf16_t* __restrict__ Ob, const float* __restrict__ gain, int seq, char* lds, int tidp) {
    using C = AttnC<DQK>;
    int tid_ = tidp; asm volatile("" : "+v"(tid_));
    const int tid = tid_, wid = __builtin_amdgcn_readfirstlane(tid >> 6)  , lane = tid & 63, r32 = lane & 31, hi = lane >> 5;
    char* V_lds = lds; char* K_lds = lds + 2 * C::SHM_V;
    float* ws = (float*)(lds + 2 * C::SHM_V + 2 * C::SHM_K) + wid * 64; float* li_l = ws; float* al_l = ws + 32;
    float m_reg = -1e30f, l_reg = 0; f32x16 o[4] = {}; bf16x8 qr[C::NQR];
    char* qx = lds + 2 * C::SHM_V + 2 * C::SHM_K + 8 * 64 * 4 + wid * ((C::NQ - C::NQR) * 1024) + lane * 16;
    const bf16_t* Qw = Qb + (long)(wid * 32 + r32) * LDQ + hi * 8;
#pragma unroll
    for (int d0 = 0; d0 < C::NQR; ++d0) qr[d0] = *reinterpret_cast<const bf16x8*>(Qw + d0 * 16);
#pragma unroll
    for (int d0 = C::NQR; d0 < C::NQ; ++d0) *reinterpret_cast<bf16x8*>(qx + (d0 - C::NQR) * 1024) = *reinterpret_cast<const bf16x8*>(Qw + d0 * 16);
    const int sr = tid >> 4, sc = (tid & 15) * 8, vst0 = v_st(sr, sc), vst1 = v_st(32 + sr, sc);
    const int vb0 = (int)(uintptr_t)V_lds + v_rd_base(lane);
    const int xr = tid >> 3, xc = (tid & 7) * 8;
    struct { bf16x8 vs0, vs1, ks0, ks1, kx; } sr_[SD];
#define FX_SLOAD(i, k0) do { sr_[i].vs0 = *reinterpret_cast<const bf16x8*>(&Vh[(long)((k0) + sr) * LDV + sc]); sr_[i].vs1 = *reinterpret_cast<const bf16x8*>(&Vh[(long)((k0) + 32 + sr) * LDV + sc]); \
    sr_[i].ks0 = *reinterpret_cast<const bf16x8*>(&K1[(long)((k0) + sr) * LDK1 + sc]); sr_[i].ks1 = *reinterpret_cast<const bf16x8*>(&K1[(long)((k0) + 32 + sr) * LDK1 + sc]); \
    if (DQK == 192) sr_[i].kx = *reinterpret_cast<const bf16x8*>(&K2[(long)((k0) + xr) * LDK2 + xc]); } while (0)
#define FX_SWRITE(b, i) do { *(bf16x8*)(V_lds + (b) * C::SHM_V + vst0) = sr_[i].vs0; *(bf16x8*)(V_lds + (b) * C::SHM_V + vst1) = sr_[i].vs1; const int kc = sc * 2; \
    *(bf16x8*)(K_lds + (b) * C::SHM_K + FX_KSWZ(sr, kc)) = sr_[i].ks0; *(bf16x8*)(K_lds + (b) * C::SHM_K + FX_KSWZ(32 + sr, kc)) = sr_[i].ks1; \
    if (DQK == 192) *(bf16x8*)(K_lds + (b) * C::SHM_K + FX_KSWZ(xr, 256 + xc * 2)) = sr_[i].kx; } while (0)
#define FX_SWAIT() do { if (SD == 1) asm volatile("s_waitcnt vmcnt(0)" ::: "memory"); else if (DQK == 192) asm volatile("s_waitcnt vmcnt(5)" ::: "memory"); else asm volatile("s_waitcnt vmcnt(4)" ::: "memory"); } while (0)
#define FX_RESC(a) do { if (__any((a) < 1.f)) { if (hi == 0) al_l[r32] = (a); asm volatile("s_waitcnt lgkmcnt(0)" ::: "memory"); \
    _Pragma("unroll") for (int d = 0; d < 4; ++d) _Pragma("unroll") for (int r = 0; r < 16; ++r) o[d][r] *= al_l[crow(r, hi)]; } } while (0)
    f32x16 pA0, pA1, pB0, pB1; float mnA, mnB, alA, alB; bf16x8 pa0, pa1, pa2, pa3; const int NT = seq / 64;
    constexpr int SE = 0, SO = SD - 1;
    FX_SLOAD(SE, 0); asm volatile("s_waitcnt vmcnt(0)" ::: "memory"); FX_SWRITE(0, SE); __syncthreads();
    qkt<DQK>(pA0, pA1, K_lds, qr, qx, r32, hi); partialSM<DQK>(pA0, pA1, m_reg, mnA, alA);
    FX_SLOAD(SO, 64); if (SD == 2) { if (2 < NT) FX_SLOAD(SE, 128); }
    FX_SWAIT(); FX_SWRITE(1, SO); __syncthreads();
    for (int j = 1; j + 1 < NT; j += 2) {
        FX_SBAR(); qkt<DQK>(pB0, pB1, K_lds + C::SHM_K, qr, qx, r32, hi);
        finishSM(pA0, pA1, alA, l_reg, pa0, pa1, pa2, pa3); FX_SBAR();
        FX_SLOAD(SO, (j + SD) * 64); FX_SBAR();
        pv_d0(o, vb0, pa0, pa1, pa2, pa3); partialSM<DQK>(pB0, pB1, m_reg, mnB, alB);
        __syncthreads(); FX_SWAIT(); FX_SWRITE(0, SE);
        FX_RESC(alB); __syncthreads();
        FX_SBAR(); qkt<DQK>(pA0, pA1, K_lds, qr, qx, r32, hi);
        finishSM(pB0, pB1, alB, l_reg, pa0, pa1, pa2, pa3); FX_SBAR();
        if (SD == 1 || j + 3 < NT) FX_SLOAD(SE, (j + 1 + SD) * 64); FX_SBAR();
        pv_d0(o, vb0 + C::SHM_V, pa0, pa1, pa2, pa3); partialSM<DQK>(pA0, pA1, m_reg, mnA, alA);
        __syncthreads(); FX_SWAIT(); FX_SWRITE(1, SO);
        FX_RESC(alA); __syncthreads();
    }
    FX_SBAR(); qkt<DQK>(pB0, pB1, K_lds + C::SHM_K, qr, qx, r32, hi);
    finishSM(pA0, pA1, alA, l_reg, pa0, pa1, pa2, pa3); FX_SBAR();
    pv_d0(o, vb0, pa0, pa1, pa2, pa3); partialSM<DQK>(pB0, pB1, m_reg, mnB, alB);
    __syncthreads(); FX_RESC(alB);
    finishSM(pB0, pB1, alB, l_reg, pa0, pa1, pa2, pa3); FX_SBAR();
    pv_d0(o, vb0 + C::SHM_V, pa0, pa1, pa2, pa3);
    if (hi == 0) li_l[r32] = l_reg; asm volatile("s_waitcnt lgkmcnt(0)" ::: "memory");
    int r32e = r32; asm volatile("" : "+v"(r32e));
    float g4[4];
#pragma unroll
    for (int d0 = 0; d0 < 4; ++d0) g4[d0] = gain[d0 * 32 + r32e];
    bf16_t* Ow = Ob + (long)(wid * 32) * 2048;
#pragma unroll
    for (int r = 0; r < 16; ++r) { const float rl = __builtin_amdgcn_rcpf(li_l[crow(r, hi)]);
        float ss = 0.f;
#pragma unroll
        for (int d0 = 0; d0 < 4; ++d0) { o[d0][r] *= rl; ss += o[d0][r] * o[d0][r]; }
        ss += __shfl_xor(ss, 1); ss += __shfl_xor(ss, 2); ss += __shfl_xor(ss, 4); ss += __shfl_xor(ss, 8); ss += __shfl_xor(ss, 16);
        const float rn = rsqrtf(ss * (1.f / 128.f) + EPS); const int orow = crow(r, hi);
#pragma unroll
#ifdef FX_WOUT8
        for (int d0 = 0; d0 < 4; ++d0) ((unsigned char*)Ob)[(long)(wid * 32 + orow) * 2048 + d0 * 32 + r32e] = (unsigned char)(__builtin_amdgcn_cvt_pk_fp8_f32(o[d0][r] * rn * g4[d0], 0.f, 0, false) & 0xff); }
#else
        for (int d0 = 0; d0 < 4; ++d0) Ow[(long)orow * 2048 + d0 * 32 + r32e] = f2bf(o[d0][r] * rn * g4[d0]); }
#endif
    __syncthreads();
#undef FX_SLOAD
#undef FX_SWRITE
#undef FX_SWAIT
#undef FX_RESC
}

__device__ __forceinline__ void attn_gqa_unit(int u, const bf16_t* QA, const bf16_t* KA, const bf16_t* PROJ, bf16_t* YM, const float* hog, char* lds, int tidp) {
    const int qb = u & 15, hh = (u >> 4) % 6, b = u / 96, kvh = hh / 3;
    const size_t t0 = (size_t)b * S;
    attn_unit<128, FX_SD_A, 768, 256, 0, PW>(QA + (t0 + qb * 256) * 768 + hh * 128, KA + t0 * 256 + kvh * 128, nullptr, PROJ + t0 * PW + O_AV + kvh * 128,
#ifdef FX_WOUT8
                                    (bf16_t*)((unsigned char*)YM + (t0 + qb * 256) * 2048 + hh * 128), hog + hh * 128, S, lds, tidp);
#else
                                    YM + (t0 + qb * 256) * 2048 + hh * 128, hog + hh * 128, S, lds, tidp);
#endif
}
__device__ __forceinline__ void attn_mla_unit(int u, const bf16_t* QB, const bf16_t* KVB, const bf16_t* KR, bf16_t* YM, const float* hog, char* lds, int tidp) {
    const int qb = u & 15, hh = (u >> 4) % 6, b = u / 96;
    const size_t t0 = (size_t)b * S;
    attn_unit<192, FX_SD_B, 1280, 1536, 64, 1536>(QB + (t0 + qb * 256) * 1280 + hh * 192, KVB + t0 * 1536 + hh * 256, KR + t0 * 64, KVB + t0 * 1536 + hh * 256 + 128,
#ifdef FX_WOUT8
                                         (bf16_t*)((unsigned char*)YM + (t0 + qb * 256) * 2048 + 768 + hh * 128), hog + 768 + hh * 128, S, lds, tidp);
#else
                                         YM + (t0 + qb * 256) * 2048 + 768 + hh * 128, hog + 768 + hh * 128, S, lds, tidp);
#endif
}
}
namespace fx {
constexpr int P3_LDS = 4096 + 2048 + 65536 + 32768;
constexpr float KSCALE = 0.08838834764831845f;
__device__ __forceinline__ float logsigmoid_f(float f) { return fminf(f, 0.f) - log1pf(__expf(-fabsf(f))); }
__device__ __forceinline__ float wave_scan_incl(float v, int lane) {
#pragma unroll
    for (int o = 1; o < 64; o <<= 1) { const float t = __shfl_up(v, o); if (lane >= o) v += t; }
    return v;
}
__device__ __forceinline__ float wave_scanmax_incl(float v, int lane) {
#pragma unroll
    for (int o = 1; o < 64; o <<= 1) { const float t = __shfl_up(v, o); if (lane >= o) v = fmaxf(v, t); }
    return v;
}
__device__ __forceinline__ float wave_rscanmax_incl(float v, int lane) {
#pragma unroll
    for (int o = 1; o < 64; o <<= 1) { const float t = __shfl_down(v, o); if (lane + o < 64) v = fmaxf(v, t); }
    return v;
}

struct P3Args {
    const bf16_t* PROJ; const float* GATES; const float* gate_b; const float* conv_w; const float* conv_b;
    const float* aq_gain; const float* ak_gain; const float* cq_gain; const float* ckv_gain;
    const float* cosA; const float* sinA; const float* cosB; const float* sinB;
    bf16_t* QA; bf16_t* KA; bf16_t* CQN; bf16_t* CKVN; bf16_t* KR; bf16_t* QC; bf16_t* KC; bf16_t* KCT; float* NLOC; float* GSC;
};
__device__ __forceinline__ void p3_phase(FX_LAS unsigned char* lds_, const P3Args& a, int wg, int nwg, int tidp) {
    char* lds = (char*)lds_;
    float* gat = (float*)lds; float* wts = (float*)(lds + 4096); char* ktile = lds + 6144; char* wv = lds + 6144 + 65536;
    for (int unit = wg; unit < T / 64; unit += nwg) {
        int tid_ = tidp; asm volatile("" : "+v"(tid_));
        const int tid = tid_, wid = tid >> 6, lane = tid & 63;
        const int b = unit >> 6, co = unit & 63; const size_t t0 = (size_t)unit * 64;
        for (int i = tid; i < 1024; i += 512) gat[i] = a.GATES[t0 * 16 + i] + a.gate_b[i & 15];
        __syncthreads();
        { const int dir = wid >> 2, h = wid & 3;
          const float logi = gat[lane * 16 + (dir * 2) * 4 + h], logf = logsigmoid_f(gat[lane * 16 + (dir * 2 + 1) * 4 + h]);
          const float pre = wave_scan_incl(logf, lane), g = __shfl(pre, 63);
          const float bb = dir ? (g - pre + logf) : pre;
          const float av = g - bb + logi, mloc = wave_max(av);
          wts[wid * 64 + lane] = __expf(av - mloc);
          if (lane == 0) { const int chain = (b * 4 + h) * 2 + dir, ci = dir ? 63 - co : co; a.GSC[(chain * 64 + ci) * 2] = g; a.GSC[(chain * 64 + ci) * 2 + 1] = mloc; } }
        __syncthreads();
        { const int c0 = 2 * tid; const bool isk = c0 >= 512; const int hk = (c0 - 512) >> 7, dk = (c0 - 512) & 127;
          float w0[5], w1[5];
#pragma unroll
          for (int j = 0; j < 5; ++j) { w0[j] = a.conv_w[j * 1024 + c0]; w1[j] = a.conv_w[j * 1024 + c0 + 1]; }
          const float cb0 = a.conv_b[c0], cb1 = a.conv_b[c0 + 1];
          float x0[5], x1[5];
          const bf16_t* src = a.PROJ + t0 * PW + O_CQ + c0;
#pragma unroll
          for (int j = 0; j < 4; ++j) { const int sa = co * 64 + j - 2; unsigned w = 0u; if (sa >= 0 && sa < S) w = *(const unsigned*)(src + (long)(j - 2) * PW); x0[j + 1] = bflo(w); x1[j + 1] = bfhi(w); }
          float nf0 = 0.f, nf1 = 0.f, nb0 = 0.f, nb1 = 0.f;
#pragma unroll 1
          for (int s0 = 0; s0 < 64; s0 += 16) {
              unsigned wl[16];
#pragma unroll
              for (int q = 0; q < 16; ++q) { const int sa = co * 64 + s0 + q + 2; wl[q] = 0u; if (sa < S) wl[q] = *(const unsigned*)(src + (long)(s0 + q + 2) * PW); }
#pragma unroll
              for (int q = 0; q < 16; ++q) { const int s = s0 + q;
#pragma unroll
                  for (int j = 0; j < 4; ++j) { x0[j] = x0[j + 1]; x1[j] = x1[j + 1]; }
                  x0[4] = bflo(wl[q]); x1[4] = bfhi(wl[q]);
                  float y0 = cb0, y1 = cb1;
#pragma unroll
                  for (int j = 0; j < 5; ++j) { y0 += w0[j] * x0[j]; y1 += w1[j] * x1[j]; }
                  y0 = silu_f(y0); y1 = silu_f(y1);
                  if (!isk) { *(unsigned*)(a.QC + (t0 + s) * 512 + c0) = cvt_pk_bf16(y0, y1); }
                  else { y0 *= KSCALE; y1 *= KSCALE; const unsigned pk = cvt_pk_bf16(y0, y1);
                      *(unsigned*)(a.KC + (t0 + s) * 512 + (c0 - 512)) = pk;
                      *(unsigned*)(ktile + hk * 16384 + v_st(s, dk & ~7) + (dk & 7) * 2) = pk;
                      const float k0 = bflo(pk), k1 = bfhi(pk); const float wf = wts[hk * 64 + s], wb = wts[(4 + hk) * 64 + s];
                      nf0 += wf * k0; nf1 += wf * k1; nb0 += wb * k0; nb1 += wb * k1; } }
          }
          if (isk) { const int chf = (b * 4 + hk) * 2, chb = chf + 1;
              *(f32x2*)(a.NLOC + ((size_t)chf * 64 + co) * 128 + dk) = (f32x2){nf0, nf1};
              *(f32x2*)(a.NLOC + ((size_t)chb * 64 + (63 - co)) * 128 + dk) = (f32x2){nb0, nb1}; } }
        __syncthreads();
#pragma unroll 1
        for (int h = 0; h < 4; ++h) {
            { const int sr = tid >> 4, sc = (tid & 15) * 8;
#pragma unroll
              for (int rr = 0; rr < 2; ++rr) { const int s = sr + 32 * rr;
                const u32x4 vw = *(const u32x4*)(a.PROJ + (t0 + s) * PW + O_CV + h * 128 + sc);
                const float wf = wts[h * 64 + s], wb = wts[(4 + h) * 64 + s];
                float v[8] = {bflo(vw.x), bfhi(vw.x), bflo(vw.y), bfhi(vw.y), bflo(vw.z), bfhi(vw.z), bflo(vw.w), bfhi(vw.w)};
                u32x4 of, ob;
                of.x = cvt_pk_bf16(v[0] * wf, v[1] * wf); of.y = cvt_pk_bf16(v[2] * wf, v[3] * wf); of.z = cvt_pk_bf16(v[4] * wf, v[5] * wf); of.w = cvt_pk_bf16(v[6] * wf, v[7] * wf);
                ob.x = cvt_pk_bf16(v[0] * wb, v[1] * wb); ob.y = cvt_pk_bf16(v[2] * wb, v[3] * wb); ob.z = cvt_pk_bf16(v[4] * wb, v[5] * wb); ob.w = cvt_pk_bf16(v[6] * wb, v[7] * wb);
                *(u32x4*)(wv + v_st(s, sc)) = of; *(u32x4*)(wv + 16384 + v_st(s, sc)) = ob; } }
            __syncthreads();
            { const int dir = wid >> 2, mb = wid & 3, r32 = lane & 31, hi = lane >> 5;
              const int va = (int)(uintptr_t)(wv + dir * 16384) + v_rd_base(lane) + mb * 512;
              const int kb = (int)(uintptr_t)(ktile + h * 16384) + v_rd_base(lane);
              f32x16 acc[4] = {};
#define FX_KC_STEP(KS) do { \
              const s16x4 al = tr_read<v_rd_off(0, KS, 0)>(va), ah = tr_read<v_rd_off(0, KS, 1)>(va); \
              const s16x4 b0l = tr_read<v_rd_off(0, KS, 0)>(kb), b0h = tr_read<v_rd_off(0, KS, 1)>(kb), b1l = tr_read<v_rd_off(1, KS, 0)>(kb), b1h = tr_read<v_rd_off(1, KS, 1)>(kb); \
              const s16x4 b2l = tr_read<v_rd_off(2, KS, 0)>(kb), b2h = tr_read<v_rd_off(2, KS, 1)>(kb), b3l = tr_read<v_rd_off(3, KS, 0)>(kb), b3h = tr_read<v_rd_off(3, KS, 1)>(kb); \
              asm volatile("s_waitcnt lgkmcnt(0)" ::: "memory"); FX_SBAR(); \
              const bf16x8 af = FX_PK(al, ah); \
              acc[0] = __builtin_amdgcn_mfma_f32_32x32x16_bf16(af, FX_PK(b0l, b0h), acc[0], 0, 0, 0); acc[1] = __builtin_amdgcn_mfma_f32_32x32x16_bf16(af, FX_PK(b1l, b1h), acc[1], 0, 0, 0); \
              acc[2] = __builtin_amdgcn_mfma_f32_32x32x16_bf16(af, FX_PK(b2l, b2h), acc[2], 0, 0, 0); acc[3] = __builtin_amdgcn_mfma_f32_32x32x16_bf16(af, FX_PK(b3l, b3h), acc[3], 0, 0, 0); } while (0)
              FX_KC_STEP(0); FX_KC_STEP(1); FX_KC_STEP(2); FX_KC_STEP(3);
#undef FX_KC_STEP
              const int chain = (b * 4 + h) * 2 + dir, ci = dir ? 63 - co : co;
              bf16_t* dst = a.KCT + ((size_t)chain * 64 + ci) * 16384 + (size_t)(mb * 32) * 128 + r32;
#pragma unroll
              for (int r = 0; r < 16; ++r) { const int v = crow(r, hi);
#pragma unroll
                  for (int nb = 0; nb < 4; ++nb) dst[v * 128 + nb * 32] = f2bf(acc[nb][r]); } }
            __syncthreads();
        }
        { const int f = lane & 31, hf = lane >> 5;
#pragma unroll 8
          for (int it = wid; it < 512; it += 8) { const int s = it >> 3, hd = it & 7; const size_t t = t0 + s;
            const bf16_t* src = a.PROJ + t * PW + hd * 128 + hf * 64;
            float x1 = bf2f(src[f]), x2 = bf2f(src[32 + f]);
            const float ss = wave_sum(x1 * x1 + x2 * x2), r = rsqrtf(ss * (1.f / 128.f) + EPS);
            const float* g = hd < 6 ? a.aq_gain : a.ak_gain;
            x1 *= r * g[hf * 64 + f]; x2 *= r * g[hf * 64 + 32 + f];
            const int pos = hf ? s : co; const float cs = a.cosA[pos * 32 + f], sn = a.sinA[pos * 32 + f];
            bf16_t* dst = hd < 6 ? a.QA + t * 768 + hd * 128 + hf * 64 : a.KA + t * 256 + (hd - 6) * 128 + hf * 64;
            dst[f] = f2bf(x1 * cs - x2 * sn); dst[32 + f] = f2bf(x2 * cs + x1 * sn); } }
#pragma unroll 4
        for (int s = wid; s < 64; s += 8) { const size_t t = t0 + s; const bf16_t* p = a.PROJ + t * PW;
            float q[6]; float ss = 0.f;
#pragma unroll
            for (int i = 0; i < 3; ++i) { const unsigned w = *(const unsigned*)(p + O_BCQ + i * 128 + lane * 2); q[2 * i] = bflo(w); q[2 * i + 1] = bfhi(w); ss += q[2 * i] * q[2 * i] + q[2 * i + 1] * q[2 * i + 1]; }
            ss = wave_sum(ss); float r = rsqrtf(ss * (1.f / 384.f) + EPS);
#pragma unroll
            for (int i = 0; i < 3; ++i) { const int c = i * 128 + lane * 2; *(unsigned*)(a.CQN + t * 384 + c) = cvt_pk_bf16(q[2 * i] * r * a.cq_gain[c], q[2 * i + 1] * r * a.cq_gain[c + 1]); }
            float kv[4]; ss = 0.f;
#pragma unroll
            for (int i = 0; i < 2; ++i) { const unsigned w = *(const unsigned*)(p + O_BCKV + i * 128 + lane * 2); kv[2 * i] = bflo(w); kv[2 * i + 1] = bfhi(w); ss += kv[2 * i] * kv[2 * i] + kv[2 * i + 1] * kv[2 * i + 1]; }
            ss = wave_sum(ss); r = rsqrtf(ss * (1.f / 256.f) + EPS);
#pragma unroll
            for (int i = 0; i < 2; ++i) { const int c = i * 128 + lane * 2; *(unsigned*)(a.CKVN + t * 256 + c) = cvt_pk_bf16(kv[2 * i] * r * a.ckv_gain[c], kv[2 * i + 1] * r * a.ckv_gain[c + 1]); }
            if (lane < 32) { const int f = lane & 15, hf = lane >> 4; const int pos = hf ? s : co; const float cs = a.cosB[pos * 16 + f], sn = a.sinB[pos * 16 + f];
                const float x1 = bf2f(p[O_BKR + hf * 32 + f]), x2 = bf2f(p[O_BKR + hf * 32 + 16 + f]);
                a.KR[t * 64 + hf * 32 + f] = f2bf(x1 * cs - x2 * sn); a.KR[t * 64 + hf * 32 + 16 + f] = f2bf(x2 * cs + x1 * sn); } }
        __syncthreads();
    }
}

__device__ __forceinline__ void scan_phase(const bf16_t* KCT, const float* NLOC, const float* GSC, bf16_t* CPREV, float* NPREV, float* MPREV, int gtid, int nthr) {
    for (int item = gtid; item < 32 * 4096; item += nthr) {
        const int chain = item >> 12, e4 = item & 4095;
        const u32x2* src = (const u32x2*)(KCT + (size_t)chain * 64 * 16384) + e4; u32x2* dst = (u32x2*)(CPREV + (size_t)chain * 64 * 16384) + e4;
        const float* gs = GSC + (size_t)chain * 128;
        const bool don = e4 < 128;
        float c0 = 0.f, c1 = 0.f, c2 = 0.f, c3 = 0.f, nn = 0.f, m = 0.f;
#pragma unroll 1
        for (int cb = 0; cb < 64; cb += 8) {
            u32x2 kc[8]; float nl[8];
#pragma unroll
            for (int j = 0; j < 8; ++j) { kc[j] = src[(size_t)(cb + j) * 4096]; nl[j] = don ? NLOC[((size_t)chain * 64 + cb + j) * 128 + e4] : 0.f; }
#pragma unroll
            for (int j = 0; j < 8; ++j) { const int ci = cb + j; const float g = gs[ci * 2], ml = gs[ci * 2 + 1];
                u32x2 o; o.x = cvt_pk_bf16(c0, c1); o.y = cvt_pk_bf16(c2, c3); dst[(size_t)ci * 4096] = o;
                if (don) NPREV[((size_t)chain * 64 + ci) * 128 + e4] = nn;
                if (e4 == 0) MPREV[chain * 64 + ci] = m;
                const float mn = fmaxf(g + m, ml), dec = __expf(g + m - mn), sl = __expf(ml - mn); m = mn;
                c0 = dec * c0 + sl * bflo(kc[j].x); c1 = dec * c1 + sl * bfhi(kc[j].x); c2 = dec * c2 + sl * bflo(kc[j].y); c3 = dec * c3 + sl * bfhi(kc[j].y);
                nn = dec * nn + sl * nl[j]; }
        }
    }
}

constexpr int MC_K = 0, MC_V = 16384, MC_CT = 32768, MC_HS = 98304, MC_HS_LD = 132, MC_SM = MC_HS + 64 * MC_HS_LD * 4, MC_LDS = MC_SM + 4096;
struct McArgs { const bf16_t* PROJ; const float* GATES; const float* gate_b; const bf16_t* QC; const bf16_t* KC; const bf16_t* CPREV; const float* NPREV; const float* MPREV; const float* hog; bf16_t* YM; };
__device__ __forceinline__ void mlstm_c_phase(FX_LAS unsigned char* lds_, const McArgs& a, int wg, int nwg, int tidp) {
    char* lds = (char*)lds_;
    using C = AttnC<128>;
    float* hs = (float*)(lds + MC_HS);
    float* sm = (float*)(lds + MC_SM);
    for (int unit = wg; unit < NB * 4 * 64; unit += nwg) {
        int tid_ = tidp; asm volatile("" : "+v"(tid_));
        const int tid = tid_, wid = tid >> 6, lane = tid & 63, r32 = lane & 31, hi = lane >> 5;
        const int co = unit & 63, h = (unit >> 6) & 3, b = unit >> 8; const size_t t0 = (size_t)b * S + co * 64;
        if (wid < 2) { const int dir = wid; const int chain = (b * 4 + h) * 2 + dir, ci = dir ? 63 - co : co;
            const float logi = a.GATES[(t0 + lane) * 16 + (dir * 2) * 4 + h] + a.gate_b[(dir * 2) * 4 + h];
            const float logf = logsigmoid_f(a.GATES[(t0 + lane) * 16 + (dir * 2 + 1) * 4 + h] + a.gate_b[(dir * 2 + 1) * 4 + h]);
            const float pre = wave_scan_incl(logf, lane), g = __shfl(pre, 63);
            const float bb = dir ? (g - pre + logf) : pre;
            const float u = logi - bb;
            const float M = dir ? wave_rscanmax_incl(u, lane) : wave_scanmax_incl(u, lane);
            const float mp = a.MPREV[chain * 64 + ci], mmj = fmaxf(mp, M);
            sm[dir * 64 + lane] = u; sm[128 + dir * 64 + lane] = mmj; sm[256 + dir * 64 + lane] = __expf(mp - mmj); sm[384 + dir * 64 + lane] = __expf(-(bb + mmj));
            sm[512 + dir * 128 + lane] = a.NPREV[((size_t)chain * 64 + ci) * 128 + lane]; sm[512 + dir * 128 + 64 + lane] = a.NPREV[((size_t)chain * 64 + ci) * 128 + 64 + lane]; }
        { const int sr = tid >> 4, sc = (tid & 15) * 8;
#pragma unroll
          for (int rr = 0; rr < 2; ++rr) { const int s = sr + 32 * rr;
            *(bf16x8*)(lds + MC_K + FX_KSWZ(s, sc * 2)) = *(const bf16x8*)(a.KC + (t0 + s) * 512 + h * 128 + sc);
            *(bf16x8*)(lds + MC_V + v_st(s, sc)) = *(const bf16x8*)(a.PROJ + (t0 + s) * PW + O_CV + h * 128 + sc); }
#pragma unroll
          for (int dir = 0; dir < 2; ++dir) { const int chain = (b * 4 + h) * 2 + dir, ci = dir ? 63 - co : co; const bf16_t* ct = a.CPREV + ((size_t)chain * 64 + ci) * 16384;
#pragma unroll
            for (int rr = 0; rr < 4; ++rr) { const int v = sr + 32 * rr; *(bf16x8*)(lds + MC_CT + dir * 32768 + FX_KSWZ(v, sc * 2)) = *(const bf16x8*)(ct + v * 128 + sc); } } }
        __syncthreads();
        { const int dir = wid >> 2, rb = (wid >> 1) & 1, cb = wid & 1, j = rb * 32 + r32;
          bf16x8 qr[8];
          const bf16_t* Qw = a.QC + (t0 + j) * 512 + h * 128 + hi * 8;
#pragma unroll
          for (int d0 = 0; d0 < 8; ++d0) qr[d0] = *reinterpret_cast<const bf16x8*>(Qw + d0 * 16);
          f32x16 p0, p1;
          qkt<128>(p0, p1, lds + MC_K, qr, nullptr, r32, hi);
          const float mmj = sm[128 + dir * 64 + j], inter = sm[256 + dir * 64 + j], emn = sm[384 + dir * 64 + j];
          float dsum = 0.f;
#pragma unroll
          for (int r = 0; r < 16; ++r) { const int s0 = crow(r, hi), s1 = 32 + s0;
              const bool v0 = dir ? (s0 >= j) : (s0 <= j), v1 = dir ? (s1 >= j) : (s1 <= j);
              const float w0 = v0 ? __expf(sm[dir * 64 + s0] - mmj) : 0.f, w1 = v1 ? __expf(sm[dir * 64 + s1] - mmj) : 0.f;
              p0[r] *= w0; p1[r] *= w1; dsum += p0[r] + p1[r]; }
          float qn = 0.f;
#pragma unroll
          for (int d0 = 0; d0 < 8; ++d0) { const float* np = sm + 512 + dir * 128 + d0 * 16 + hi * 8; const u32x4 w = *reinterpret_cast<const u32x4*>(&qr[d0]);
              qn += bflo(w.x) * np[0] + bfhi(w.x) * np[1] + bflo(w.y) * np[2] + bfhi(w.y) * np[3] + bflo(w.z) * np[4] + bfhi(w.z) * np[5] + bflo(w.w) * np[6] + bfhi(w.w) * np[7]; }
          { auto rr = __builtin_amdgcn_permlane32_swap(__float_as_uint(dsum), __float_as_uint(dsum), false, false); dsum = __uint_as_float(rr[0]) + __uint_as_float(rr[1]); }
          { auto rr = __builtin_amdgcn_permlane32_swap(__float_as_uint(qn), __float_as_uint(qn), false, false); qn = __uint_as_float(rr[0]) + __uint_as_float(rr[1]); }
          const float den = dsum + inter * qn;
          if (hi == 0) sm[768 + wid * 32 + r32] = 1.f / fmaxf(fabsf(den), emn);
          bf16x8 pa0, pa1, pa2, pa3;
          FX_PK4(p0, 0, pa0); FX_PK4(p0, 8, pa1); FX_PK4(p1, 0, pa2); FX_PK4(p1, 8, pa3);
          f32x16 o[2] = {};
          const int vb = (int)(uintptr_t)(lds + MC_V) + v_rd_base(lane) + cb * 1024;
          pv_one<0>(o[0], vb, pa0, pa1, pa2, pa3); pv_one<1>(o[1], vb, pa0, pa1, pa2, pa3);
          const char* ctb = lds + MC_CT + dir * 32768;
#pragma unroll
          for (int ks = 0; ks < 8; ++ks) { const u32x4 w = *reinterpret_cast<const u32x4*>(&qr[ks]); u32x4 sq;
              sq.x = cvt_pk_bf16(bflo(w.x) * inter, bfhi(w.x) * inter); sq.y = cvt_pk_bf16(bflo(w.y) * inter, bfhi(w.y) * inter); sq.z = cvt_pk_bf16(bflo(w.z) * inter, bfhi(w.z) * inter); sq.w = cvt_pk_bf16(bflo(w.w) * inter, bfhi(w.w) * inter);
              const bf16x8 qs = *reinterpret_cast<const bf16x8*>(&sq); const int colB = (ks * 16 + hi * 8) * 2;
              const bf16x8 c0f = *reinterpret_cast<const bf16x8*>(ctb + FX_KSWZ((2 * cb) * 32 + r32, colB));
              const bf16x8 c1f = *reinterpret_cast<const bf16x8*>(ctb + FX_KSWZ((2 * cb + 1) * 32 + r32, colB));
              o[0] = __builtin_amdgcn_mfma_f32_32x32x16_bf16(qs, c0f, o[0], 0, 0, 0);
              o[1] = __builtin_amdgcn_mfma_f32_32x32x16_bf16(qs, c1f, o[1], 0, 0, 0); }
          asm volatile("s_waitcnt lgkmcnt(0)" ::: "memory");
          float rd[16];
#pragma unroll
          for (int r = 0; r < 16; ++r) rd[r] = sm[768 + wid * 32 + crow(r, hi)];
          if (dir == 0) {
#pragma unroll
              for (int r = 0; r < 16; ++r) { const int row = rb * 32 + crow(r, hi);
                  hs[row * MC_HS_LD + (2 * cb) * 32 + r32] = o[0][r] * rd[r]; hs[row * MC_HS_LD + (2 * cb + 1) * 32 + r32] = o[1][r] * rd[r]; } }
          __syncthreads();
          if (dir == 1) {
#pragma unroll
              for (int r = 0; r < 16; ++r) { const int row = rb * 32 + crow(r, hi);
                  hs[row * MC_HS_LD + (2 * cb) * 32 + r32] += o[0][r] * rd[r]; hs[row * MC_HS_LD + (2 * cb + 1) * 32 + r32] += o[1][r] * rd[r]; } }
          __syncthreads(); }
        { const int row = tid >> 3, c0 = (tid & 7) * 16; const size_t t = t0 + row;
          float v[16]; float ss = 0.f;
#pragma unroll
          for (int i = 0; i < 16; ++i) { v[i] = hs[row * MC_HS_LD + c0 + i]; ss += v[i] * v[i]; }
          ss += __shfl_xor(ss, 1); ss += __shfl_xor(ss, 2); ss += __shfl_xor(ss, 4);
          const float rn = rsqrtf(ss * (1.f / 128.f) + EPS);
          const bf16_t* og = a.PROJ + t * PW + O_CO + h * 128 + c0; const float* gn = a.hog + 1536 + h * 128 + c0;
          const u32x4 g0 = *(const u32x4*)og, g1 = *(const u32x4*)(og + 8);
          const float gg[16] = {bflo(g0.x), bfhi(g0.x), bflo(g0.y), bfhi(g0.y), bflo(g0.z), bfhi(g0.z), bflo(g0.w), bfhi(g0.w), bflo(g1.x), bfhi(g1.x), bflo(g1.y), bfhi(g1.y), bflo(g1.z), bfhi(g1.z), bflo(g1.w), bfhi(g1.w)};
          float ov[16];
#pragma unroll
          for (int i = 0; i < 16; ++i) ov[i] = v[i] * rn * gn[i] * sigmoid_f(gg[i]);
          u32x4 w0, w1; w0.x = cvt_pk_bf16(ov[0], ov[1]); w0.y = cvt_pk_bf16(ov[2], ov[3]); w0.z = cvt_pk_bf16(ov[4], ov[5]); w0.w = cvt_pk_bf16(ov[6], ov[7]);
          w1.x = cvt_pk_bf16(ov[8], ov[9]); w1.y = cvt_pk_bf16(ov[10], ov[11]); w1.z = cvt_pk_bf16(ov[12], ov[13]); w1.w = cvt_pk_bf16(ov[14], ov[15]);
#ifdef FX_WOUT8
          { u32x4 w8; w8.x = cvt_pk4_fp8(ov[0], ov[1], ov[2], ov[3]); w8.y = cvt_pk4_fp8(ov[4], ov[5], ov[6], ov[7]); w8.z = cvt_pk4_fp8(ov[8], ov[9], ov[10], ov[11]); w8.w = cvt_pk4_fp8(ov[12], ov[13], ov[14], ov[15]);
            *(u32x4*)((unsigned char*)a.YM + t * 2048 + 1536 + h * 128 + c0) = w8; (void)w0; (void)w1; } }
#else
          bf16_t* dst = a.YM + t * 2048 + 1536 + h * 128 + c0; *(u32x4*)dst = w0; *(u32x4*)(dst + 8) = w1; }
#endif
        __syncthreads();
    }
}
}
namespace fx {
struct EpiQB {
    static constexpr bool PERM = false;
    bf16_t* O; const float* cosB; const float* sinB;
    __device__ __forceinline__ void operator()(const f32x4 (&acc)[2][2][4][2], const Unit& u, int wr, int wc, int fr, int fq) const {
        const int row0 = u.pm * BM + wr * 64 + fr;
#pragma unroll
        for (int bj = 0; bj < 2; ++bj) { const int G = 8 * u.pn + 4 * bj + wc, gm = G % 6; const int col0 = G * 32 + 4 * fq;
#pragma unroll
            for (int ai = 0; ai < 2; ++ai)
#pragma unroll
                for (int m = 0; m < 4; ++m) { const int row = row0 + ai * HALF + m * 16; f32x4 x1 = acc[ai][bj][m][0], x2 = acc[ai][bj][m][1];
                    if (gm >= 4) { const int s = row & (S - 1), pos = gm == 4 ? (s >> 6) : (s & 63);
                        const f32x4 cs = *(const f32x4*)(cosB + pos * 16 + 4 * fq), sn = *(const f32x4*)(sinB + pos * 16 + 4 * fq);
                        const f32x4 o1 = x1 * cs - x2 * sn, o2 = x2 * cs + x1 * sn; x1 = o1; x2 = o2; }
                    bf16_t* rp = O + (size_t)row * 1280 + col0;
                    u32x2 w0, w1; w0.x = cvt_pk_bf16(x1[0], x1[1]); w0.y = cvt_pk_bf16(x1[2], x1[3]); w1.x = cvt_pk_bf16(x2[0], x2[1]); w1.y = cvt_pk_bf16(x2[2], x2[3]);
                    *(u32x2*)rp = w0; *(u32x2*)(rp + 16) = w1; } }
    }
};
constexpr size_t al256(size_t x) { return (x + 255) & ~(size_t)255; }
constexpr size_t WS_BAR = 0;
constexpr size_t WS_MOD = 16384;
constexpr size_t WS_COEF = WS_MOD + al256(2ull * 4 * 12288 * 4);
constexpr size_t WS_TAB = WS_COEF + al256(2ull * 4 * 6 * 2048 * 4);
constexpr size_t WS_CNT = WS_TAB + al256(6144 * 4);
constexpr size_t WS_WGBASE = WS_CNT + 512;
constexpr size_t WS_SELE = WS_WGBASE + 256 * 64 * 4;
constexpr size_t WS_SELG = WS_SELE + (size_t)T * 6 * 4;
constexpr size_t WS_SLOT = WS_SELG + (size_t)T * 6 * 4;
constexpr size_t WS_ROWTOK = WS_SLOT + (size_t)T * 6 * 4;
constexpr size_t WS_ROWG = WS_ROWTOK + (size_t)PTOT * 4;
constexpr size_t WS_GATES = WS_ROWG + (size_t)PTOT * 4;
constexpr size_t WS_GSC = WS_GATES + (size_t)T * 16 * 4;
constexpr size_t WS_MPREV = WS_GSC + 2048 * 2 * 4;
constexpr size_t WS_NLOC = WS_MPREV + 2048 * 4;
constexpr size_t WS_NPREV = WS_NLOC + 2048ull * 128 * 4;
constexpr size_t WS_W = al256(WS_NPREV + 2048ull * 128 * 4);
constexpr size_t W_IN = 0, W_UQ = W_IN + 4096ull * 2048 * 2, W_UKV = W_UQ + 1280ull * 384 * 2, W_OUT = W_UKV + 1536ull * 256 * 2, W_GU = W_OUT + 2048ull * 2048 * 2, W_DN = W_GU + 65ull * 1024 * 2048 * 2, W_LAYER = W_DN + 65ull * 2048 * 512 * 2;
constexpr size_t WS_XRES = WS_W + 2 * W_LAYER;
constexpr size_t WS_HA = WS_XRES + (size_t)T * 2048 * 4;
constexpr size_t WS_R1 = WS_HA + (size_t)T * 2048 * 2;
constexpr size_t WS_R2 = WS_R1 + (size_t)T * 4096 * 2;
constexpr size_t R2_QA = 0, R2_KA = R2_QA + (size_t)T * 768 * 2, R2_CQN = R2_KA + (size_t)T * 256 * 2, R2_CKVN = R2_CQN + (size_t)T * 384 * 2, R2_KR = R2_CKVN + (size_t)T * 256 * 2,
                 R2_QB = R2_KR + (size_t)T * 64 * 2, R2_KVB = R2_QB + (size_t)T * 1280 * 2, R2_QC = R2_KVB + (size_t)T * 1536 * 2, R2_KC = R2_QC + (size_t)T * 512 * 2,
                 R2_KCT = R2_KC + (size_t)T * 512 * 2, R2_CPREV = R2_KCT + 2048ull * 16384 * 2, R2_END = R2_CPREV + 2048ull * 16384 * 2;
constexpr size_t WS_END = WS_R2 + (size_t)PTOT * 2048 * 2;
static_assert(R2_END <= (size_t)PTOT * 2048 * 2, "R2 overflow");
static_assert(WS_END <= 2147483648ull, "workspace too large");
}
namespace fx {
struct CvtW { const float* w_in; const float* w_uq; const float* w_ukv; const float* w_out; const float* eg; const float* eu; const float* ed; const float* sg; const float* su; const float* sd; bf16_t* W; };
__device__ __forceinline__ void cvt_layer(const CvtW& a, FX_LAS unsigned* my, int gwave, int nwaves, int& rot) {
    const int BIG = 1 << 30; bf16_t* W = a.W;
    bf16_t* WIN = W + W_IN / 2; bf16_t* WUQ = W + W_UQ / 2; bf16_t* WUKV = W + W_UKV / 2; bf16_t* WOUT = W + W_OUT / 2; bf16_t* WGU = W + W_GU / 2; bf16_t* WDN = W + W_DN / 2;
#ifdef FX_WIN8
    { CvtSeg s; s.src = a.w_in; s.dst = WIN; s.sstride = 0; s.dstride = 0; s.ld = 4048; s.nsrc = 4048; s.K = 2048; s.ntn = 64; s.nbatch = 1; s.G = BIG; s.GS = 0; s.off = 0; cvt_seg8(s, my, gwave, nwaves, rot, W8_SCALE); }
#else
    { CvtSeg s; s.src = a.w_in; s.dst = WIN; s.sstride = 0; s.dstride = 0; s.ld = 4048; s.nsrc = 4048; s.K = 2048; s.ntn = 64; s.nbatch = 1; s.G = BIG; s.GS = 0; s.off = 0; cvt_seg(s, my, gwave, nwaves, rot); }
#endif
    { CvtSeg s; s.src = a.w_uq; s.dst = WUQ; s.sstride = 0; s.dstride = 0; s.ld = 1152; s.nsrc = 1152; s.K = 384; s.ntn = 20; s.nbatch = 1; s.G = BIG; s.GS = 0; s.off = 0; cvt_seg(s, my, gwave, nwaves, rot); }
    { CvtSeg s; s.src = a.w_ukv; s.dst = WUKV; s.sstride = 0; s.dstride = 0; s.ld = 1536; s.nsrc = 1536; s.K = 256; s.ntn = 24; s.nbatch = 1; s.G = BIG; s.GS = 0; s.off = 0; cvt_seg(s, my, gwave, nwaves, rot); }
#ifdef FX_WOUT8
    { CvtSeg s; s.src = a.w_out; s.dst = WOUT; s.sstride = 0; s.dstride = 0; s.ld = 2048; s.nsrc = 2048; s.K = 2048; s.ntn = 32; s.nbatch = 1; s.G = BIG; s.GS = 0; s.off = 0; cvt_seg8(s, my, gwave, nwaves, rot, W8_SCALE); }
#else
    { CvtSeg s; s.src = a.w_out; s.dst = WOUT; s.sstride = 0; s.dstride = 0; s.ld = 2048; s.nsrc = 2048; s.K = 2048; s.ntn = 32; s.nbatch = 1; s.G = BIG; s.GS = 0; s.off = 0; cvt_seg(s, my, gwave, nwaves, rot); }
#endif
    { CvtSeg s; s.src = a.eg; s.dst = WGU; s.sstride = 2048ll * 512; s.dstride = 1024ll * 2048; s.ld = 512; s.nsrc = 512; s.K = 2048; s.ntn = 8; s.nbatch = 64; s.G = 128; s.GS = 256; s.off = 0; cvt_seg8(s, my, gwave, nwaves, rot, W8_SCALE); }
    { CvtSeg s; s.src = a.eu; s.dst = WGU; s.sstride = 2048ll * 512; s.dstride = 1024ll * 2048; s.ld = 512; s.nsrc = 512; s.K = 2048; s.ntn = 8; s.nbatch = 64; s.G = 128; s.GS = 256; s.off = 128; cvt_seg8(s, my, gwave, nwaves, rot, W8_SCALE); }
    { CvtSeg s; s.src = a.ed; s.dst = WDN; s.sstride = 512ll * 2048; s.dstride = 2048ll * 512; s.ld = 2048; s.nsrc = 2048; s.K = 512; s.ntn = 32; s.nbatch = 64; s.G = BIG; s.GS = 0; s.off = 0; cvt_seg8(s, my, gwave, nwaves, rot, W8_SCALE); }
    { CvtSeg s; s.src = a.sg; s.dst = (bf16_t*)((unsigned char*)WGU + 64ull * 1024 * 2048); s.sstride = 0; s.dstride = 0; s.ld = 512; s.nsrc = 512; s.K = 2048; s.ntn = 8; s.nbatch = 1; s.G = 128; s.GS = 256; s.off = 0; cvt_seg8(s, my, gwave, nwaves, rot, W8_SCALE); }
    { CvtSeg s; s.src = a.su; s.dst = (bf16_t*)((unsigned char*)WGU + 64ull * 1024 * 2048); s.sstride = 0; s.dstride = 0; s.ld = 512; s.nsrc = 512; s.K = 2048; s.ntn = 8; s.nbatch = 1; s.G = 128; s.GS = 256; s.off = 128; cvt_seg8(s, my, gwave, nwaves, rot, W8_SCALE); }
    { CvtSeg s; s.src = a.sd; s.dst = (bf16_t*)((unsigned char*)WDN + 64ull * 2048 * 512); s.sstride = 0; s.dstride = 0; s.ld = 2048; s.nsrc = 2048; s.K = 512; s.ntn = 32; s.nbatch = 1; s.G = BIG; s.GS = 0; s.off = 0; cvt_seg8(s, my, gwave, nwaves, rot, W8_SCALE); }
}
constexpr int CVT_TILES_PER_LAYER = 2048 + 120 + 96 + 1024 + 3 * 16384 + 3 * 256;
__device__ __forceinline__ void cvt_layer_one(const CvtW& a, FX_LAS unsigned* my, int g) {
    int base = 0;
    const int BIG = 1 << 30; bf16_t* W = a.W;
    bf16_t* WIN = W + W_IN / 2; bf16_t* WUQ = W + W_UQ / 2; bf16_t* WUKV = W + W_UKV / 2; bf16_t* WOUT = W + W_OUT / 2; bf16_t* WGU = W + W_GU / 2; bf16_t* WDN = W + W_DN / 2;
#ifdef FX_WIN8
    { CvtSeg s; s.src = a.w_in; s.dst = WIN; s.sstride = 0; s.dstride = 0; s.ld = 4048; s.nsrc = 4048; s.K = 2048; s.ntn = 64; s.nbatch = 1; s.G = BIG; s.GS = 0; s.off = 0; { const int cnt_ = (s.K / 64) * s.ntn * s.nbatch; if (g >= base && g < base + cnt_) cvt_tile8(s, my, g - base, W8_SCALE); base += cnt_; } }
#else
    { CvtSeg s; s.src = a.w_in; s.dst = WIN; s.sstride = 0; s.dstride = 0; s.ld = 4048; s.nsrc = 4048; s.K = 2048; s.ntn = 64; s.nbatch = 1; s.G = BIG; s.GS = 0; s.off = 0; { const int cnt_ = (s.K / 64) * s.ntn * s.nbatch; if (g >= base && g < base + cnt_) cvt_tile(s, my, g - base); base += cnt_; } }
#endif
    { CvtSeg s; s.src = a.w_uq; s.dst = WUQ; s.sstride = 0; s.dstride = 0; s.ld = 1152; s.nsrc = 1152; s.K = 384; s.ntn = 20; s.nbatch = 1; s.G = BIG; s.GS = 0; s.off = 0; { const int cnt_ = (s.K / 64) * s.ntn * s.nbatch; if (g >= base && g < base + cnt_) cvt_tile(s, my, g - base); base += cnt_; } }
    { CvtSeg s; s.src = a.w_ukv; s.dst = WUKV; s.sstride = 0; s.dstride = 0; s.ld = 1536; s.nsrc = 1536; s.K = 256; s.ntn = 24; s.nbatch = 1; s.G = BIG; s.GS = 0; s.off = 0; { const int cnt_ = (s.K / 64) * s.ntn * s.nbatch; if (g >= base && g < base + cnt_) cvt_tile(s, my, g - base); base += cnt_; } }
#ifdef FX_WOUT8
    { CvtSeg s; s.src = a.w_out; s.dst = WOUT; s.sstride = 0; s.dstride = 0; s.ld = 2048; s.nsrc = 2048; s.K = 2048; s.ntn = 32; s.nbatch = 1; s.G = BIG; s.GS = 0; s.off = 0; { const int cnt_ = (s.K / 64) * s.ntn * s.nbatch; if (g >= base && g < base + cnt_) cvt_tile8(s, my, g - base, W8_SCALE); base += cnt_; } }
#else
    { CvtSeg s; s.src = a.w_out; s.dst = WOUT; s.sstride = 0; s.dstride = 0; s.ld = 2048; s.nsrc = 2048; s.K = 2048; s.ntn = 32; s.nbatch = 1; s.G = BIG; s.GS = 0; s.off = 0; { const int cnt_ = (s.K / 64) * s.ntn * s.nbatch; if (g >= base && g < base + cnt_) cvt_tile(s, my, g - base); base += cnt_; } }
#endif
    { CvtSeg s; s.src = a.eg; s.dst = WGU; s.sstride = 2048ll * 512; s.dstride = 1024ll * 2048; s.ld = 512; s.nsrc = 512; s.K = 2048; s.ntn = 8; s.nbatch = 64; s.G = 128; s.GS = 256; s.off = 0; { const int cnt_ = (s.K / 64) * s.ntn * s.nbatch; if (g >= base && g < base + cnt_) cvt_tile8(s, my, g - base, W8_SCALE); base += cnt_; } }
    { CvtSeg s; s.src = a.eu; s.dst = WGU; s.sstride = 2048ll * 512; s.dstride = 1024ll * 2048; s.ld = 512; s.nsrc = 512; s.K = 2048; s.ntn = 8; s.nbatch = 64; s.G = 128; s.GS = 256; s.off = 128; { const int cnt_ = (s.K / 64) * s.ntn * s.nbatch; if (g >= base && g < base + cnt_) cvt_tile8(s, my, g - base, W8_SCALE); base += cnt_; } }
    { CvtSeg s; s.src = a.ed; s.dst = WDN; s.sstride = 512ll * 2048; s.dstride = 2048ll * 512; s.ld = 2048; s.nsrc = 2048; s.K = 512; s.ntn = 32; s.nbatch = 64; s.G = BIG; s.GS = 0; s.off = 0; { const int cnt_ = (s.K / 64) * s.ntn * s.nbatch; if (g >= base && g < base + cnt_) cvt_tile8(s, my, g - base, W8_SCALE); base += cnt_; } }
    { CvtSeg s; s.src = a.sg; s.dst = (bf16_t*)((unsigned char*)WGU + 64ull * 1024 * 2048); s.sstride = 0; s.dstride = 0; s.ld = 512; s.nsrc = 512; s.K = 2048; s.ntn = 8; s.nbatch = 1; s.G = 128; s.GS = 256; s.off = 0; { const int cnt_ = (s.K / 64) * s.ntn * s.nbatch; if (g >= base && g < base + cnt_) cvt_tile8(s, my, g - base, W8_SCALE); base += cnt_; } }
    { CvtSeg s; s.src = a.su; s.dst = (bf16_t*)((unsigned char*)WGU + 64ull * 1024 * 2048); s.sstride = 0; s.dstride = 0; s.ld = 512; s.nsrc = 512; s.K = 2048; s.ntn = 8; s.nbatch = 1; s.G = 128; s.GS = 256; s.off = 128; { const int cnt_ = (s.K / 64) * s.ntn * s.nbatch; if (g >= base && g < base + cnt_) cvt_tile8(s, my, g - base, W8_SCALE); base += cnt_; } }
    { CvtSeg s; s.src = a.sd; s.dst = (bf16_t*)((unsigned char*)WDN + 64ull * 2048 * 512); s.sstride = 0; s.dstride = 0; s.ld = 2048; s.nsrc = 2048; s.K = 512; s.ntn = 32; s.nbatch = 1; s.G = BIG; s.GS = 0; s.off = 0; { const int cnt_ = (s.K / 64) * s.ntn * s.nbatch; if (g >= base && g < base + cnt_) cvt_tile8(s, my, g - base, W8_SCALE); base += cnt_; } }
}
}
namespace fx {
#define XB_TMO      128
#define XB_XCNT(j)  (256  + 64 * (j))
#define XB_XSUB(j)  (1280 + 64 * (j))
#define XB_XGEN(j)  (2304 + 64 * (j))
#define XB_TOP      3328
#define XB_TOPGEN   3392
#define XCD_BAR_WORDS 3456
#define XB_SPIN_CAP (1u << 22)
__device__ __forceinline__ unsigned xb_ld(unsigned* p)              { return __hip_atomic_load(p, __ATOMIC_RELAXED, __HIP_MEMORY_SCOPE_AGENT); }
__device__ __forceinline__ unsigned xb_add(unsigned* p, unsigned v) { return __hip_atomic_fetch_add(p, v, __ATOMIC_RELAXED, __HIP_MEMORY_SCOPE_AGENT); }
__device__ __forceinline__ unsigned xb_xcc_id() { return (unsigned)__builtin_amdgcn_s_getreg((3 << 11) | 20) & 0xFu; }
#define XB_SPIN(cond, bar) do { unsigned _sp = 0; while (cond) { __builtin_amdgcn_s_sleep(1); \
    if ((++_sp & 255u) == 0u) { if (xb_ld(&(bar)[XB_TMO])) break; if (_sp > XB_SPIN_CAP) { atomicAdd(&(bar)[XB_TMO], 1u); break; } } } } while (0)
struct XcdBarrier { unsigned* bar; unsigned x; volatile FX_LAS unsigned* st; };
__device__ __forceinline__ XcdBarrier xcd_barrier_post(unsigned* bar, volatile FX_LAS unsigned* st, int tidp) {
    XcdBarrier b; b.bar = bar; b.x = xb_xcc_id(); b.st = st;
    if (tidp == 0) (void)xb_add(&bar[XB_XCNT(b.x)], 1u);
    return b;
}
__device__ __forceinline__ void xcd_barrier_complete(unsigned* bar, unsigned x, unsigned& nloc, unsigned& nx) {
    const unsigned G = gridDim.x * gridDim.y * gridDim.z;
    unsigned sum, cnt, mine, sp = 0u;
    for (;;) {
        sum = 0u; cnt = 0u; mine = 0u;
#pragma unroll
        for (unsigned j = 0; j < 16; ++j) { const unsigned c = xb_ld(&bar[XB_XCNT(j)]); sum += c; cnt += (c > 0u) ? 1u : 0u; mine = (j == x) ? c : mine; }
        if (sum == G) break;
        __builtin_amdgcn_s_sleep(1);
        if ((++sp & 255u) == 0u) { if (xb_ld(&bar[XB_TMO])) break; if (sp > XB_SPIN_CAP) { atomicAdd(&bar[XB_TMO], 1u); break; } }
    }
    nloc = mine > 0u ? mine : 1u; nx = cnt > 0u ? cnt : 1u;
}
__device__ __forceinline__ void xcd_barrier(const XcdBarrier& b, int tidp) {
    asm volatile("s_waitcnt vmcnt(0)" ::: "memory");
    __syncthreads();
    if (tidp == 0) {
        unsigned* bar = b.bar;
        __builtin_amdgcn_s_waitcnt(0);
        unsigned nloc = b.st[0], nx = b.st[1];
        if (nloc == 0u) { xcd_barrier_complete(bar, b.x, nloc, nx); b.st[0] = nloc; b.st[1] = nx; }
        const unsigned old = xb_add(&bar[XB_XSUB(b.x)], 1u);
        const unsigned gen = old / nloc;
        if (old + 1u == (gen + 1u) * nloc) {
            __builtin_amdgcn_fence(__ATOMIC_RELEASE, "agent");
            asm volatile("s_waitcnt vmcnt(0)" ::: "memory");
            const unsigned og = xb_add(&bar[XB_TOP], 1u);
            const unsigned tg = og / nx;
            if (og + 1u == (tg + 1u) * nx) xb_add(&bar[XB_TOPGEN], 1u);
            else XB_SPIN(xb_ld(&bar[XB_TOPGEN]) == tg, bar);
            __builtin_amdgcn_fence(__ATOMIC_ACQUIRE, "agent");
            xb_add(&bar[XB_XGEN(b.x)], 1u);
            asm volatile("s_waitcnt vmcnt(0)" ::: "memory");
        } else {
            XB_SPIN(xb_ld(&bar[XB_XGEN(b.x)]) == gen, bar);
            __builtin_amdgcn_fence(__ATOMIC_ACQUIRE, "agent");
            asm volatile("s_waitcnt vmcnt(0)" ::: "memory");
        }
    }
    __syncthreads();
}

__device__ __forceinline__ void modp_phase(FX_LAS unsigned char* lds_, const float* c, const float* ada_w, float* MODP, int wg, int nwg, int tidp) {
    float* cact = (float*)(char*)lds_;
    for (int i = tidp; i < 8192; i += 512) { const float v = c[i]; cact[i] = v / (1.f + expf(-v)); }
    __syncthreads();
    int tid_ = tidp; asm volatile("" : "+v"(tid_));
    const int wid = tid_ >> 6, lane = tid_ & 63;
    for (int u = wg * 8 + wid; u < 2 * 48 * 32; u += nwg * 8) {
        const int kc = u & 31, nc = (u >> 5) % 48, l = u / (48 * 32);
        const float* w = ada_w + (size_t)l * 2048 * 12288 + (size_t)(kc * 64) * 12288 + nc * 256 + lane * 4;
        f32x4 a0 = {0.f, 0.f, 0.f, 0.f}, a1 = a0, a2 = a0, a3 = a0;
#pragma unroll 8
        for (int k = 0; k < 64; ++k) { const f32x4 wv = *(const f32x4*)(w + (size_t)k * 12288); const int kk = kc * 64 + k;
            a0 += wv * cact[kk]; a1 += wv * cact[2048 + kk]; a2 += wv * cact[4096 + kk]; a3 += wv * cact[6144 + kk]; }
        float* dst = MODP + (((size_t)l * 32 + kc) * 4) * 12288 + nc * 256 + lane * 4;
        *(f32x4*)dst = a0; *(f32x4*)(dst + 12288) = a1; *(f32x4*)(dst + 2 * 12288) = a2; *(f32x4*)(dst + 3 * 12288) = a3;
    }
    __syncthreads();
}
__device__ __forceinline__ void tab_phase(float* tab, int gtid) {
    if (gtid < 2048) { const int p = gtid >> 5, f = gtid & 31; const float inv = powf(10000.f, -(float)(2 * f) / 64.f); const float a = (float)p * inv; tab[gtid] = cosf(a); tab[2048 + gtid] = sinf(a); }
    else if (gtid < 3072) { const int i = gtid - 2048, p = i >> 4, f = i & 15; const float inv = powf(10000.f, -(float)(2 * f) / 32.f); const float a = (float)p * inv; tab[4096 + i] = cosf(a); tab[5120 + i] = sinf(a); }
}
__device__ __forceinline__ void coef2_phase(const float* MODP, const float* ada_b, const float* pre_mix_gain, const float* post_mix_gain, const float* pre_ffn_gain, const float* post_ffn_gain, float* coef, int gtid, int nthr) {
    for (int i = gtid; i < 2 * 4 * 2048; i += nthr) { const int d = i & 2047, b = (i >> 11) & 3, l = i >> 13;
        float m[6];
#pragma unroll
        for (int j = 0; j < 6; ++j) { float s = ada_b[l * 12288 + j * 2048 + d];
            for (int kc = 0; kc < 32; ++kc) s += MODP[(((size_t)l * 32 + kc) * 4 + b) * 12288 + j * 2048 + d];
            m[j] = s; }
        float* c = coef + ((size_t)l * 4 + b) * 6 * 2048;
        c[0 * 2048 + d] = m[2] * post_mix_gain[l * 2048 + d];
        c[1 * 2048 + d] = pre_ffn_gain[l * 2048 + d] * (1.f + m[4]);
        c[2 * 2048 + d] = m[3];
        c[3 * 2048 + d] = m[5] * post_ffn_gain[l * 2048 + d];
        c[4 * 2048 + d] = pre_mix_gain[l * 2048 + d] * (1.f + m[1]);
        c[5 * 2048 + d] = m[0]; }
}
__device__ __forceinline__ void prenorm_phase(const float* x, const float* coef_l, bf16_t* HA, int wg, int nwg, int tidp) {
    int tid_ = tidp; asm volatile("" : "+v"(tid_));
    const int wid = tid_ >> 6, lane = tid_ & 63;
    for (int t = wg * 8 + wid; t < T; t += nwg * 8) {
        const float* cn = coef_l + (size_t)(t / S) * 6 * 2048;
        float xv[32]; float ss = 0.f;
#pragma unroll
        for (int i = 0; i < 4; ++i) { const int c = i * 512 + lane * 8; const f32x4 x0 = *(const f32x4*)(x + (size_t)t * 2048 + c), x1 = *(const f32x4*)(x + (size_t)t * 2048 + c + 4);
#pragma unroll
            for (int j = 0; j < 4; ++j) { xv[i * 8 + j] = x0[j]; xv[i * 8 + 4 + j] = x1[j]; ss += x0[j] * x0[j] + x1[j] * x1[j]; } }
        ss = wave_sum(ss); const float rx = rsqrtf(ss * (1.f / 2048.f) + EPS);
#pragma unroll
        for (int i = 0; i < 4; ++i) { const int c = i * 512 + lane * 8;
            const f32x4 e0 = *(const f32x4*)(cn + 4 * 2048 + c), e1 = *(const f32x4*)(cn + 4 * 2048 + c + 4), f0 = *(const f32x4*)(cn + 5 * 2048 + c), f1 = *(const f32x4*)(cn + 5 * 2048 + c + 4);
            float hv[8];
#pragma unroll
            for (int j = 0; j < 4; ++j) { hv[j] = xv[i * 8 + j] * rx * e0[j] + f0[j]; hv[4 + j] = xv[i * 8 + 4 + j] * rx * e1[j] + f1[j]; }
#ifdef FX_WIN8
            u32x2 w; w.x = cvt_pk4_fp8(hv[0], hv[1], hv[2], hv[3]); w.y = cvt_pk4_fp8(hv[4], hv[5], hv[6], hv[7]);
            *(u32x2*)((unsigned char*)HA + (size_t)t * 2048 + c) = w; }
#else
            u32x4 w; w.x = cvt_pk_bf16(hv[0], hv[1]); w.y = cvt_pk_bf16(hv[2], hv[3]); w.z = cvt_pk_bf16(hv[4], hv[5]); w.w = cvt_pk_bf16(hv[6], hv[7]);
            *(u32x4*)(HA + (size_t)t * 2048 + c) = w; }
#endif
    }
}

constexpr int LDS_ST = 139264, LDS_TOTAL = LDS_ST + 64;
constexpr size_t WS_MODP = WS_R2;
#define FX_KAS __attribute__((address_space(4)))
template <class TY> __device__ __forceinline__ TY* fx_glob(TY* p) { __attribute__((address_space(1))) TY* g = (__attribute__((address_space(1))) TY*)p; asm volatile("" : "+s"(g)); return (TY*)g; }
struct MP {
    const float* x; const float* c; const float* ada_w; const float* ada_b; const float* pre_mix_gain; const float* w_in; const float* a_q_gain; const float* a_k_gain;
    const float* b_cq_gain; const float* b_ckv_gain; const float* w_uq; const float* w_ukv; const float* c_conv_w; const float* c_conv_b; const float* c_gate_b;
    const float* head_out_gain; const float* w_out; const float* post_mix_gain; const float* pre_ffn_gain; const float* router_w; const float* router_bias;
    const float* exp_w_gate; const float* exp_w_up; const float* exp_w_down; const float* sh_w_gate; const float* sh_w_up; const float* sh_w_down; const float* post_ffn_gain;
    char* ws; float* out;
};
#ifndef FX_NPHASE
#define FX_NPHASE 1000
#endif
#define PH_BEGIN const FX_KAS MP* pk = (const FX_KAS MP*)__builtin_amdgcn_kernarg_segment_ptr(); asm volatile("" : "+s"(pk)); char* ws = fx_glob(pk->ws); (void)ws; int gt_ = wid_s * 64 + fx_lane(); asm volatile("" : "+v"(gt_)); int wg_ = blockIdx.x, nwg_ = gridDim.x; asm volatile("" : "+s"(wg_), "+s"(nwg_)); const int wg = wg_, nwg = nwg_; (void)wg; (void)nwg; (void)gt_;
#define PH_BAR do { PH_BEGIN XcdBarrier b_; b_.bar = (unsigned*)(ws + WS_BAR); b_.x = xb_xcc_id(); b_.st = (volatile FX_LAS unsigned*)(lds + LDS_ST); xcd_barrier(b_, gt_); } while (0)
#define WSP(T_, off) ((T_*)(ws + (off)))
constexpr int QW_CNT = 3584;
constexpr unsigned HV_SLACK = 24;
__device__ __forceinline__ void harvest(FX_LAS unsigned char* lds, const FX_KAS MP* pk, char* ws, int tid, const unsigned nbar, const bool drain) {
    volatile FX_LAS unsigned* bw = (volatile FX_LAS unsigned*)(lds + LDS_ST);
    unsigned* bar = (unsigned*)(ws + WS_BAR);
    const int wave = tid >> 6; FX_LAS unsigned* my = (FX_LAS unsigned*)(lds) + wave * (64 * 33);
    CvtW a; a.w_in = fx_glob(pk->w_in) + (size_t)D * 4048; a.w_uq = fx_glob(pk->w_uq) + (size_t)384 * 1152; a.w_ukv = fx_glob(pk->w_ukv) + (size_t)256 * 1536; a.w_out = fx_glob(pk->w_out) + (size_t)D * D;
    a.eg = fx_glob(pk->exp_w_gate) + (size_t)NE * D * FF; a.eu = fx_glob(pk->exp_w_up) + (size_t)NE * D * FF; a.ed = fx_glob(pk->exp_w_down) + (size_t)NE * FF * D;
    a.sg = fx_glob(pk->sh_w_gate) + (size_t)D * FF; a.su = fx_glob(pk->sh_w_up) + (size_t)D * FF; a.sd = fx_glob(pk->sh_w_down) + (size_t)FF * D; a.W = (bf16_t*)(ws + WS_W + W_LAYER);
    __syncthreads();
    if (drain) {
        if (tid == 0) bw[3] = xb_ld(&bar[QW_CNT]);
        __syncthreads();
        const unsigned h = bw[3];
#pragma unroll 1
        for (unsigned g = h + (unsigned)(blockIdx.x * 8 + wave); g < (unsigned)CVT_TILES_PER_LAYER; g += gridDim.x * 8u) cvt_layer_one(a, my, (int)g);
        __syncthreads();
        return;
    }
#pragma unroll 1
    for (;;) {
        if (tid == 0) { unsigned nxt = 0xffffffffu; bool go = true;
            if (!drain) { unsigned sum = 0u;
#pragma unroll
                for (unsigned j = 0; j < 16; ++j) sum += xb_ld(&bar[XB_XSUB(j)]);
                const unsigned G = gridDim.x; go = (sum - nbar * G) + HV_SLACK < G; }
            if (go && xb_ld(&bar[QW_CNT]) < (unsigned)CVT_TILES_PER_LAYER) { const unsigned b0 = xb_add(&bar[QW_CNT], 8u); if (b0 < (unsigned)CVT_TILES_PER_LAYER) nxt = b0; }
            bw[3] = nxt; }
        __syncthreads();
        const unsigned base = bw[3];
        if (base == 0xffffffffu) break;
        const int g = (int)base + wave;
        if (g < CVT_TILES_PER_LAYER) cvt_layer_one(a, my, g);
        __syncthreads();
    }
    __syncthreads();
}
#ifndef FX_HARVEST
#define FX_HARVEST 1
#endif
#define PH_HARVEST(n, dr) do { if (FX_HARVEST && l == 0 && ((dr) || FX_HARVEST == 1)) { PH_BEGIN harvest(lds, pk, ws, gt_, (n), (dr)); } } while (0)
#ifndef FX_DUP
#define FX_DUP -1
#endif
#define FX_NE ((FX_NOEPI && rep_ == 1) ? FX_NOEPI : 0)
#define FX_REP(n) _Pragma("unroll 1") for (int rep_ = 0; rep_ < ((FX_DUP == (n) && l == 0) ? 2 : 1); ++rep_)
template <int l> __device__ __forceinline__ void layer_body(FX_LAS unsigned char* lds, unsigned char* shm, const int wid_s) {
        FX_REP(2) { PH_BEGIN const bf16_t* W = WSP(const bf16_t, WS_W + (size_t)l * W_LAYER);
#ifdef FX_WIN8
          DenseSched Sc; Sc.init(T, 4096, nwg, wg, 2048, W + W_IN / 2, 2048, 1); EpiBf16 E; E.O = WSP(bf16_t, WS_R1); E.gates = WSP(float, WS_GATES); E.ldc = 4096; E.scale = W8_INV;
          gemm_phase<EpiBf16, DenseSched, true>(lds, (const char*)WSP(bf16_t, WS_HA), 2048, Sc, E, gt_, FX_NE); }
#else
          DenseSched Sc; Sc.init(T, 4096, nwg, wg, 2048 * 2, W + W_IN / 2, 2048); EpiBf16 E; E.O = WSP(bf16_t, WS_R1); E.gates = WSP(float, WS_GATES); E.ldc = 4096; E.scale = 1.f;
          gemm_phase<EpiBf16, DenseSched>(lds, (const char*)WSP(bf16_t, WS_HA), 2048, Sc, E, gt_); }
#endif
        PH_HARVEST(3u, false);
        PH_BAR;
        FX_REP(3) { PH_BEGIN char* R2 = ws + WS_R2; float* tab = WSP(float, WS_TAB);
          P3Args a; a.PROJ = WSP(bf16_t, WS_R1); a.GATES = WSP(float, WS_GATES); a.gate_b = fx_glob(pk->c_gate_b) + l * 16; a.conv_w = fx_glob(pk->c_conv_w) + (size_t)l * 5 * 1024; a.conv_b = fx_glob(pk->c_conv_b) + l * 1024;
          a.aq_gain = fx_glob(pk->a_q_gain) + l * 128; a.ak_gain = fx_glob(pk->a_k_gain) + l * 128; a.cq_gain = fx_glob(pk->b_cq_gain) + l * 384; a.ckv_gain = fx_glob(pk->b_ckv_gain) + l * 256;
          a.cosA = tab; a.sinA = tab + 2048; a.cosB = tab + 4096; a.sinB = tab + 5120;
          a.QA = (bf16_t*)(R2 + R2_QA); a.KA = (bf16_t*)(R2 + R2_KA); a.CQN = (bf16_t*)(R2 + R2_CQN); a.CKVN = (bf16_t*)(R2 + R2_CKVN); a.KR = (bf16_t*)(R2 + R2_KR); a.QC = (bf16_t*)(R2 + R2_QC); a.KC = (bf16_t*)(R2 + R2_KC);
          a.KCT = (bf16_t*)(R2 + R2_KCT); a.NLOC = WSP(float, WS_NLOC); a.GSC = WSP(float, WS_GSC);
          p3_phase(lds, a, wg, nwg, gt_); }
        PH_BAR;
        FX_REP(4) {
        { PH_BEGIN const bf16_t* W = WSP(const bf16_t, WS_W + (size_t)l * W_LAYER); char* R2 = ws + WS_R2; float* tab = WSP(float, WS_TAB);
          DenseSched Sc; Sc.init(T, 1280, nwg, wg, 384 * 2, W + W_UQ / 2, 384); EpiQB E; E.O = (bf16_t*)(R2 + R2_QB); E.cosB = tab + 4096; E.sinB = tab + 5120;
          gemm_phase<EpiQB, DenseSched>(lds, (const char*)(R2 + R2_CQN), 384, Sc, E, gt_); }
        { PH_BEGIN const bf16_t* W = WSP(const bf16_t, WS_W + (size_t)l * W_LAYER); char* R2 = ws + WS_R2;
          DenseSched Sc; Sc.init(T, 1536, nwg, wg, 256 * 2, W + W_UKV / 2, 256); EpiBf16 E; E.O = (bf16_t*)(R2 + R2_KVB); E.gates = nullptr; E.ldc = 1536; E.scale = 1.f;
          gemm_phase<EpiBf16, DenseSched>(lds, (const char*)(R2 + R2_CKVN), 256, Sc, E, gt_); }
        { PH_BEGIN char* R2 = ws + WS_R2;
          scan_phase((const bf16_t*)(R2 + R2_KCT), WSP(float, WS_NLOC), WSP(float, WS_GSC), (bf16_t*)(R2 + R2_CPREV), WSP(float, WS_NPREV), WSP(float, WS_MPREV), wg * 512 + gt_, nwg * 512); }
        }
        PH_HARVEST(5u, false);
        PH_BAR;
        FX_REP(5) {
#pragma unroll 1
          for (int ui = 0; ui < 2; ++ui) { PH_BEGIN char* R2 = ws + WS_R2; int u;
              if (nwg == 256) { const int x = wg & 7, j = wg >> 3; if (ui == 1 && j >= 16) break; u = x * 48 + j + ui * 32; } else { u = wg + ui * nwg; if (u >= 384) break; }
              attn_gqa_unit(u, (const bf16_t*)(R2 + R2_QA), (const bf16_t*)(R2 + R2_KA), WSP(const bf16_t, WS_R1), WSP(bf16_t, WS_HA), fx_glob(pk->head_out_gain) + l * D, (char*)shm, gt_); }
#pragma unroll 1
          for (int ui = 0; ui < 2; ++ui) { PH_BEGIN char* R2 = ws + WS_R2; int u;
              if (nwg == 256) { const int x = wg & 7, j = wg >> 3; if (j < 16) { if (ui == 1) break; u = x * 48 + j; } else u = x * 48 + 16 + (j - 16) * 2 + ui; } else { u = wg + ui * nwg; if (u >= 384) break; }
              attn_mla_unit(u, (const bf16_t*)(R2 + R2_QB), (const bf16_t*)(R2 + R2_KVB), (const bf16_t*)(R2 + R2_KR), WSP(bf16_t, WS_HA), fx_glob(pk->head_out_gain) + l * D, (char*)shm, gt_); }
          { PH_BEGIN char* R2 = ws + WS_R2;
            McArgs a; a.PROJ = WSP(bf16_t, WS_R1); a.GATES = WSP(float, WS_GATES); a.gate_b = fx_glob(pk->c_gate_b) + l * 16; a.QC = (bf16_t*)(R2 + R2_QC); a.KC = (bf16_t*)(R2 + R2_KC); a.CPREV = (bf16_t*)(R2 + R2_CPREV);
            a.NPREV = WSP(float, WS_NPREV); a.MPREV = WSP(float, WS_MPREV); a.hog = fx_glob(pk->head_out_gain) + l * D; a.YM = WSP(bf16_t, WS_HA);
            mlstm_c_phase(lds, a, wg, nwg, gt_); } }
        PH_HARVEST(6u, false);
        PH_BAR;
        FX_REP(6) { PH_BEGIN const bf16_t* W = WSP(const bf16_t, WS_W + (size_t)l * W_LAYER);
#ifdef FX_WOUT8
          DenseSched Sc; Sc.init(T, 2048, nwg, wg, 2048, W + W_OUT / 2, 2048, 1); EpiBf16 E; E.O = WSP(bf16_t, WS_R1); E.gates = nullptr; E.ldc = 2048; E.scale = W8_INV;
          gemm_phase<EpiBf16, DenseSched, true>(lds, (const char*)WSP(bf16_t, WS_HA), 2048, Sc, E, gt_, FX_NE); }
#else
          DenseSched Sc; Sc.init(T, 2048, nwg, wg, 2048 * 2, W + W_OUT / 2, 2048); EpiBf16 E; E.O = WSP(bf16_t, WS_R1); E.gates = nullptr; E.ldc = 2048; E.scale = 1.f;
          gemm_phase<EpiBf16, DenseSched>(lds, (const char*)WSP(bf16_t, WS_HA), 2048, Sc, E, gt_); }
#endif
        PH_HARVEST(7u, false);
        PH_BAR;
        { PH_BEGIN p7_phase<(l != 0)>(lds, l == 0 ? (const void*)fx_glob(pk->x) : (const void*)WSP(const bf16_t, WS_XRES), WSP(const bf16_t, WS_R1), WSP(float, WS_COEF) + (size_t)l * 4 * 6 * 2048, fx_glob(pk->router_w) + (size_t)l * D * 64, fx_glob(pk->router_bias) + l * 64,
                            WSP(bf16_t, WS_XRES), WSP(unsigned char, WS_HA), WSP(int, WS_SELE), WSP(float, WS_SELG), WSP(int, WS_CNT) + l * 64, WSP(int, WS_WGBASE), wg, nwg, gt_); }
        PH_BAR;
        { PH_BEGIN p8_phase(lds, WSP(int, WS_SELE), WSP(float, WS_SELG), WSP(int, WS_CNT) + l * 64, WSP(int, WS_WGBASE), WSP(int, WS_ROWTOK), WSP(float, WS_ROWG), WSP(int, WS_SLOT), wg, nwg, gt_); }
        PH_BAR;
        FX_REP(9) { PH_BEGIN const bf16_t* W = WSP(const bf16_t, WS_W + (size_t)l * W_LAYER);
          p9_phase(lds, WSP(unsigned char, WS_HA), (const unsigned char*)(W + W_GU / 2), WSP(int, WS_CNT) + l * 64, WSP(int, WS_ROWTOK), WSP(unsigned char, WS_R1), wg, nwg, gt_, FX_NE); }
        PH_HARVEST(10u, false);
        PH_BAR;
        FX_REP(10) { PH_BEGIN const bf16_t* W = WSP(const bf16_t, WS_W + (size_t)l * W_LAYER);
          p10_phase(lds, WSP(unsigned char, WS_R1), (const unsigned char*)(W + W_DN / 2), WSP(int, WS_CNT) + l * 64, WSP(float, WS_ROWG), WSP(unsigned char, WS_R2), wg, nwg, gt_, FX_NE); }
        PH_HARVEST(11u, false);
        PH_BAR;
        { PH_BEGIN p11_phase<(l == 1)>(WSP(bf16_t, WS_XRES), WSP(unsigned char, WS_R2), WSP(int, WS_SLOT), WSP(float, WS_COEF) + (size_t)l * 4 * 6 * 2048, l == 0 ? WSP(float, WS_COEF) + 4 * 6 * 2048 : nullptr,
                             l == 1 ? (void*)fx_glob(pk->out) : (void*)WSP(bf16_t, WS_XRES), WSP(bf16_t, WS_HA), wg, nwg, gt_); }
        PH_HARVEST(12u, true);
        if (l == 0) PH_BAR;
}
__global__ __launch_bounds__(512, 2) void mega(MP p_unused) {
    extern __shared__ __attribute__((aligned(16))) unsigned char shm[];
    FX_LAS unsigned char* lds = (FX_LAS unsigned char*)shm;
    const int wid_s = __builtin_amdgcn_readfirstlane((int)threadIdx.x >> 6);
    { volatile FX_LAS unsigned* st = (volatile FX_LAS unsigned*)(lds + LDS_ST);
      PH_BEGIN if (gt_ == 0) { st[0] = 0u; st[1] = 0u; st[2] = 0u; st[3] = 0u; }
      __syncthreads();
      (void)xcd_barrier_post((unsigned*)(ws + WS_BAR), st, gt_); }
    { PH_BEGIN const int wave = wid_s;     FX_LAS unsigned* my = (FX_LAS unsigned*)(lds) + wave * (64 * 33); int rot = 0;
#pragma unroll 1
      for (int l = 0; l < ((FX_DUP == 0) ? 4 : (FX_HARVEST ? 1 : 2)); ++l) { const int lw = l & 1; CvtW a; a.w_in = fx_glob(pk->w_in) + (size_t)lw * D * 4048; a.w_uq = fx_glob(pk->w_uq) + (size_t)lw * 384 * 1152; a.w_ukv = fx_glob(pk->w_ukv) + (size_t)lw * 256 * 1536; a.w_out = fx_glob(pk->w_out) + (size_t)lw * D * D;
          a.eg = fx_glob(pk->exp_w_gate) + (size_t)lw * NE * D * FF; a.eu = fx_glob(pk->exp_w_up) + (size_t)lw * NE * D * FF; a.ed = fx_glob(pk->exp_w_down) + (size_t)lw * NE * FF * D;
          a.sg = fx_glob(pk->sh_w_gate) + (size_t)lw * D * FF; a.su = fx_glob(pk->sh_w_up) + (size_t)lw * D * FF; a.sd = fx_glob(pk->sh_w_down) + (size_t)lw * FF * D; a.W = (bf16_t*)(ws + WS_W + (size_t)lw * W_LAYER);
          cvt_layer(a, my, wg * 8 + wave, nwg * 8, rot); }
      __syncthreads(); }
    { PH_BEGIN modp_phase(lds, fx_glob(pk->c), fx_glob(pk->ada_w), WSP(float, WS_MODP), wg, nwg, gt_); tab_phase(WSP(float, WS_TAB), wg * 512 + gt_); }
#if FX_DUP == 20
    { PH_BEGIN modp_phase(lds, fx_glob(pk->c), fx_glob(pk->ada_w), WSP(float, WS_MODP), wg, nwg, gt_); tab_phase(WSP(float, WS_TAB), wg * 512 + gt_); }
#endif
    PH_BAR;
    { PH_BEGIN coef2_phase(WSP(float, WS_MODP), fx_glob(pk->ada_b), fx_glob(pk->pre_mix_gain), fx_glob(pk->post_mix_gain), fx_glob(pk->pre_ffn_gain), fx_glob(pk->post_ffn_gain), WSP(float, WS_COEF), wg * 512 + gt_, nwg * 512); }
#if FX_DUP == 21
    { PH_BEGIN coef2_phase(WSP(float, WS_MODP), fx_glob(pk->ada_b), fx_glob(pk->pre_mix_gain), fx_glob(pk->post_mix_gain), fx_glob(pk->pre_ffn_gain), fx_glob(pk->post_ffn_gain), WSP(float, WS_COEF), wg * 512 + gt_, nwg * 512); }
#endif
    PH_BAR;
    { PH_BEGIN prenorm_phase(fx_glob(pk->x), WSP(float, WS_COEF), WSP(bf16_t, WS_HA), wg, nwg, gt_); }
#if FX_DUP == 22
    { PH_BEGIN prenorm_phase(fx_glob(pk->x), WSP(float, WS_COEF), WSP(bf16_t, WS_HA), wg, nwg, gt_); }
#endif
    PH_BAR;
#if FX_DUP == 99
    PH_BAR; PH_BAR; PH_BAR; PH_BAR; PH_BAR; PH_BAR; PH_BAR; PH_BAR; PH_BAR; PH_BAR;
#endif
    layer_body<0>(lds, shm, wid_s);
    layer_body<1>(lds, shm, wid_s);
}
}

extern "C" void kernel_launch(void* const* d_in, const int* in_sizes, int n_in, void* d_out, int out_size, void* d_ws, size_t ws_size, hipStream_t stream) {
    using namespace fx;
    static int grid = 0;
    if (!grid) {
        int dev = 0, cus = 0, per_cu = 0;
        (void)hipGetDevice(&dev);
        (void)hipDeviceGetAttribute(&cus, hipDeviceAttributeMultiprocessorCount, dev);
        (void)hipFuncSetAttribute((const void*)mega, hipFuncAttributeMaxDynamicSharedMemorySize, LDS_TOTAL);
        (void)hipOccupancyMaxActiveBlocksPerMultiprocessor(&per_cu, (const void*)mega, 512, LDS_TOTAL);
        if (cus > 256) cus = 256;
        grid = per_cu >= 1 ? cus : 0;
    }
    if (!grid) return;
    (void)hipMemsetAsync((char*)d_ws + WS_BAR, 0, 16384, stream);
    (void)hipMemsetAsync((char*)d_ws + WS_CNT, 0, 512, stream);
    MP p{};
    const float** q = (const float**)&p;
    for (int i = 0; i < 28; ++i) q[i] = (const float*)d_in[i];
    p.ws = (char*)d_ws; p.out = (float*)d_out;
    hipLaunchKernelGGL(mega, dim3(grid), dim3(512), LDS_TOTAL, stream, p);
}
```

```cpp
#define FX_WIN8 1
#define FX_WOUT8 1
#define FX_HARVEST 0
#include <hip/hip_runtime.h>
#include <stdint.h>
#include <math.h>
#ifndef FX_NOEPI
#define FX_NOEPI 0
#endif
namespace fx {
#define FX_LAS __attribute__((address_space(3)))
typedef unsigned short bf16_t;
typedef short bf16x8 __attribute__((ext_vector_type(8)));
typedef short s16x4 __attribute__((ext_vector_type(4)));
typedef float f32x4 __attribute__((ext_vector_type(4)));
typedef float f32x16 __attribute__((ext_vector_type(16)));
typedef unsigned u32x4 __attribute__((ext_vector_type(4)));
typedef unsigned u32x2 __attribute__((ext_vector_type(2)));
typedef float f32x2 __attribute__((ext_vector_type(2)));

constexpr int D = 2048, NB = 4, S = 4096, T = NB * S, DEPTH = 2;
constexpr int NE = 64, FF = 512;
constexpr float EPS = 1e-6f;
constexpr int PW = 4096;
constexpr int O_AQ = 0, O_AK = 768, O_AV = 1024, O_BCQ = 1280, O_BCKV = 1664, O_BKR = 1920, O_CQ = 1984, O_CK = 2496, O_CV = 3008, O_CO = 3520, O_CG = 4032;

typedef __bf16 bf16x2_t __attribute__((ext_vector_type(2)));
__device__ __forceinline__ unsigned cvt_pk_bf16(float lo, float hi) { const bf16x2_t r = __builtin_convertvector((f32x2){lo, hi}, bf16x2_t); return __builtin_bit_cast(unsigned, r); }
__device__ __forceinline__ float bf2f(bf16_t b) { return __uint_as_float(((unsigned)b) << 16); }
__device__ __forceinline__ float bflo(unsigned w) { return __uint_as_float(w << 16); }
__device__ __forceinline__ float bfhi(unsigned w) { return __uint_as_float(w & 0xffff0000u); }
__device__ __forceinline__ bf16_t f2bf(float f) { return (bf16_t)(cvt_pk_bf16(f, 0.f) & 0xffffu); }
__device__ __forceinline__ float sigmoid_f(float x) { return __builtin_amdgcn_rcpf(1.f + __expf(-x)); }
__device__ __forceinline__ float silu_f(float x) { return x * __builtin_amdgcn_rcpf(1.f + __expf(-x)); }
__device__ __forceinline__ int fx_lane() { unsigned z = 0u; asm volatile("" : "+v"(z)); return (int)__builtin_amdgcn_mbcnt_hi(~0u, __builtin_amdgcn_mbcnt_lo(~0u, z)); }
__device__ __forceinline__ float wave_sum(float v) { for (int o = 32; o >= 1; o >>= 1) v += __shfl_xor(v, o); return v; }
__device__ __forceinline__ float wave_max(float v) { for (int o = 32; o >= 1; o >>= 1) v = fmaxf(v, __shfl_xor(v, o)); return v; }

#ifndef FX_WGM
#define FX_WGM 8
#endif
#ifndef FX_CVT2D
#define FX_CVT2D 0
#endif
#ifndef FX_CVTPIPE
#define FX_CVTPIPE 1
#endif
#ifndef FX_PRIO8
#define FX_PRIO8 1
#endif
#ifndef FX_F8_32
#define FX_F8_32 0
#endif
typedef int i32x8 __attribute__((ext_vector_type(8)));
typedef int i32x4 __attribute__((ext_vector_type(4)));
constexpr float W8_SCALE = 32.f, W8_INV = 1.f / 32.f;
__device__ __forceinline__ unsigned cvt_pk4_fp8(float a, float b, float c, float d) { int w = 0; w = __builtin_amdgcn_cvt_pk_fp8_f32(a, b, w, false); w = __builtin_amdgcn_cvt_pk_fp8_f32(c, d, w, true); return (unsigned)w; }
struct CvtSeg { const float* src; bf16_t* dst; long long sstride, dstride; int ld, nsrc, K, ntn, nbatch, G, GS, off; };
__device__ __forceinline__ void cvt_tile(const CvtSeg sg, FX_LAS unsigned* my, int tile) {
    const int lane = fx_lane();
    const int ktn = sg.K / 64, per = ktn * sg.ntn;
    {
        const int b = tile / per, r = tile - b * per, nt = r / ktn, kt = r - nt * ktn;
        const int r4 = lane >> 4, c4 = lane & 15;
        const float* src = sg.src + (size_t)b * sg.sstride + (size_t)(kt * 64) * sg.ld + nt * 64 + 4 * c4;
        const bool ok = nt * 64 + 4 * c4 < sg.nsrc;
        f32x4 va[8], vb[8];
#pragma unroll
        for (int i = 0; i < 8; ++i) { const int kp = 4 * i + r4; const f32x4 z = {0.f, 0.f, 0.f, 0.f};
            va[i] = ok ? *(const f32x4*)(src + (size_t)(2 * kp) * sg.ld) : z; vb[i] = ok ? *(const f32x4*)(src + (size_t)(2 * kp + 1) * sg.ld) : z; }
#pragma unroll
        for (int i = 0; i < 8; ++i) { const int kp = 4 * i + r4;
#pragma unroll
            for (int j = 0; j < 4; ++j) my[(4 * c4 + j) * 33 + kp] = cvt_pk_bf16(va[i][j], vb[i][j]); }
        asm volatile("s_waitcnt lgkmcnt(0)" ::: "memory");
        bf16_t* dst = sg.dst + (size_t)b * sg.dstride;
#pragma unroll
        for (int i = 0; i < 8; ++i) {
            const int nl = (lane >> 3) + 8 * i, c = lane & 7, n = nt * 64 + nl;
            u32x4 w; w.x = my[nl * 33 + 4 * c]; w.y = my[nl * 33 + 4 * c + 1]; w.z = my[nl * 33 + 4 * c + 2]; w.w = my[nl * 33 + 4 * c + 3];
            const int row = (n / sg.G) * sg.GS + (n % sg.G) + sg.off;
            *(u32x4*)(dst + (size_t)row * sg.K + kt * 64 + 8 * c) = w;
        }
        asm volatile("s_waitcnt lgkmcnt(0)" ::: "memory");
    }
}
__device__ __forceinline__ void cvt_seg(const CvtSeg sg, FX_LAS unsigned* my, int gwave, int nwaves, int& rot) {
    const int total = (sg.K / 64) * sg.ntn * sg.nbatch;
    int first = (gwave - rot) % nwaves; if (first < 0) first += nwaves;
    for (int tile = first; tile < total; tile += nwaves) cvt_tile(sg, my, tile);
    rot = (rot + total) % nwaves;
}
__device__ __forceinline__ void cvt_tile8(const CvtSeg sg, FX_LAS unsigned* my, int tile, float scale) {
    const int lane = fx_lane();
    const int ktn = sg.K / 64, per = ktn * sg.ntn;
    {
        const int b = tile / per, r = tile - b * per, nt = r / ktn, kt = r - nt * ktn;
        const int r4 = lane >> 4, c4 = lane & 15;
        const float* src = sg.src + (size_t)b * sg.sstride + (size_t)(kt * 64) * sg.ld + nt * 64 + 4 * c4;
        const bool ok = nt * 64 + 4 * c4 < sg.nsrc;
        f32x4 v[4][4];
#pragma unroll
        for (int i = 0; i < 4; ++i)
#pragma unroll
            for (int q = 0; q < 4; ++q) { const int kq = 4 * i + r4; const f32x4 z = {0.f, 0.f, 0.f, 0.f}; v[i][q] = ok ? *(const f32x4*)(src + (size_t)(4 * kq + q) * sg.ld) : z; }
#pragma unroll
        for (int i = 0; i < 4; ++i) { const int kq = 4 * i + r4;
#pragma unroll
            for (int j = 0; j < 4; ++j) my[(4 * c4 + j) * 17 + kq] = cvt_pk4_fp8(v[i][0][j] * scale, v[i][1][j] * scale, v[i][2][j] * scale, v[i][3][j] * scale); }
        asm volatile("s_waitcnt lgkmcnt(0)" ::: "memory");
        unsigned char* dst = (unsigned char*)sg.dst + (size_t)b * sg.dstride;
#pragma unroll
        for (int i = 0; i < 4; ++i) {
            const int nl = (lane >> 2) + 16 * i, c = lane & 3, n = nt * 64 + nl;
            u32x4 w; w.x = my[nl * 17 + 4 * c]; w.y = my[nl * 17 + 4 * c + 1]; w.z = my[nl * 17 + 4 * c + 2]; w.w = my[nl * 17 + 4 * c + 3];
            const int row = (n / sg.G) * sg.GS + (n % sg.G) + sg.off;
            *(u32x4*)(dst + (size_t)row * sg.K + kt * 64 + 16 * c) = w;
        }
        asm volatile("s_waitcnt lgkmcnt(0)" ::: "memory");
    }
}
struct Cvt8P { const float* src; unsigned char* dst; float sc; int nt, kt; };
__device__ __forceinline__ Cvt8P cvt8_params(const CvtSeg sg, int tile, float scale, int lane) {
    const int ktn = sg.K / 64, per = ktn * sg.ntn;
#if FX_CVT2D
    const int b = tile / per, r = tile - b * per, w8 = r & 7, g8 = r >> 3, ktp = ktn >> 1, ntq = g8 / ktp, nt = 4 * ntq + (w8 & 3), kt = 2 * (g8 - ntq * ktp) + (w8 >> 2);
#else
    const int b = tile / per, r = tile - b * per, nt = r / ktn, kt = r - nt * ktn;
#endif
    const int c4 = lane & 15;
    const bool ok = nt * 64 + 4 * c4 < sg.nsrc;
    Cvt8P p; p.src = sg.src + (size_t)b * sg.sstride + (size_t)(kt * 64) * sg.ld + (ok ? nt * 64 + 4 * c4 : 0); p.dst = (unsigned char*)sg.dst + (size_t)b * sg.dstride; p.sc = ok ? scale : 0.f; p.nt = nt; p.kt = kt;
    return p;
}
__device__ __forceinline__ void cvt8_out(const CvtSeg sg, FX_LAS unsigned* my, const Cvt8P& p, int lane) {
    asm volatile("s_waitcnt lgkmcnt(0)" ::: "memory");
#pragma unroll
    for (int i = 0; i < 4; ++i) {
        const int nl = (lane >> 2) + 16 * i, c = lane & 3, n = p.nt * 64 + nl;
        u32x4 w; w.x = my[nl * 17 + 4 * c]; w.y = my[nl * 17 + 4 * c + 1]; w.z = my[nl * 17 + 4 * c + 2]; w.w = my[nl * 17 + 4 * c + 3];
        const int row = (n / sg.G) * sg.GS + (n % sg.G) + sg.off;
        *(u32x4*)(p.dst + (size_t)row * sg.K + p.kt * 64 + 16 * c) = w;
    }
    asm volatile("s_waitcnt lgkmcnt(0)" ::: "memory");
}
__device__ __forceinline__ void cvt_seg8(const CvtSeg sg, FX_LAS unsigned* my, int gwave, int nwaves, int& rot, float scale) {
    const int total = (sg.K / 64) * sg.ntn * sg.nbatch;
    int first = (gwave - rot) % nwaves; if (first < 0) first += nwaves;
#if FX_CVTPIPE
    if (first < total) {
        const int lane = fx_lane(), r4 = lane >> 4, c4 = lane & 15;
        f32x4 v[4][4];
        Cvt8P cur = cvt8_params(sg, first, scale, lane);
#pragma unroll
        for (int i = 0; i < 4; ++i)
#pragma unroll
            for (int q = 0; q < 4; ++q) v[i][q] = *(const f32x4*)(cur.src + (size_t)(4 * (4 * i + r4) + q) * sg.ld);
        int tile = first;
#pragma unroll 1
        while (tile + nwaves < total) {
            tile += nwaves;
            const Cvt8P nx = cvt8_params(sg, tile, scale, lane);
#pragma unroll
            for (int i = 0; i < 4; ++i) { const int kq = 4 * i + r4;
#pragma unroll
                for (int j = 0; j < 4; ++j) my[(4 * c4 + j) * 17 + kq] = cvt_pk4_fp8(v[i][0][j] * cur.sc, v[i][1][j] * cur.sc, v[i][2][j] * cur.sc, v[i][3][j] * cur.sc);
#pragma unroll
                for (int q = 0; q < 4; ++q) v[i][q] = *(const f32x4*)(nx.src + (size_t)(4 * kq + q) * sg.ld); }
            cvt8_out(sg, my, cur, lane);
            cur = nx;
        }
#pragma unroll
        for (int i = 0; i < 4; ++i) { const int kq = 4 * i + r4;
#pragma unroll
            for (int j = 0; j < 4; ++j) my[(4 * c4 + j) * 17 + kq] = cvt_pk4_fp8(v[i][0][j] * cur.sc, v[i][1][j] * cur.sc, v[i][2][j] * cur.sc, v[i][3][j] * cur.sc); }
        cvt8_out(sg, my, cur, lane);
    }
#else
    for (int tile = first; tile < total; tile += nwaves) cvt_tile8(sg, my, tile, scale);
#endif
    rot = (rot + total) % nwaves;
}

constexpr int BM = 256, BK = 64, HALF = 128, HTB = HALF * BK * 2, STAGE_BYTES = 8 * HTB, NXCD = 8, WGM = FX_WGM;
__host__ __device__ __forceinline__ int lds_byte(int r, int c) { const int st = (r >> 4) * 2 + (c >> 5), rr = r & 15, cc = c & 31, ob = rr * 64 + cc * 2; return st * 1024 + (ob ^ (((ob >> 9) & 1) << 5)); }
__host__ __device__ __forceinline__ void stage_rc(int b, int& R, int& C) { const int st = b / 1024, sb = b % 1024, swz = sb ^ (((sb >> 9) & 1) << 5); R = (st >> 1) * 16 + swz / 64; C = (st & 1) * 32 + (swz % 64) / 2; }
__host__ __device__ __forceinline__ int perm32(int rho) { const int n = rho >> 4, i = rho & 15; return 8 * (i >> 2) + 4 * n + (i & 3); }
struct Unit { int pm, pn, e; };
struct DenseSched {
    static constexpr bool GATHER = false;
    int nM, nN, nwg, G, c; int lda_b; const char* Bt; int K; int esz;
    __device__ void init(int M, int N, int G_, int c_, int lda_bytes, const void* Bt_, int K_, int esz_ = 2) { nM = M / BM; nN = N / BM; nwg = nM * nN; G = G_; c = c_; lda_b = lda_bytes; Bt = (const char*)Bt_; K = K_; esz = esz_; }
    __device__ __forceinline__ bool next(int i, Unit& u) const {
        const long L = (long)i * G + c; if (L >= nwg) return false;
        int wgid = (int)L; { const int q = nwg / NXCD, r = nwg % NXCD, xcd = wgid % NXCD, off = wgid / NXCD; wgid = (xcd < r ? xcd * (q + 1) : r * (q + 1) + (xcd - r) * q) + off; }
        const int nig = WGM * nN, gid = wgid / nig, fm = gid * WGM, gsz = (nM - fm) < WGM ? (nM - fm) : WGM;
        u.pm = fm + ((wgid % nig) % gsz); u.pn = (wgid % nig) / gsz; u.e = 0; return true;
    }
    __device__ __forceinline__ unsigned a_row_off(const Unit& u, int R) const { return (unsigned)(u.pm * BM + R) * (unsigned)lda_b; }
    __device__ __forceinline__ size_t a_unit_base(const Unit& u) const { return (size_t)u.pm * BM * (size_t)lda_b; }
    __device__ __forceinline__ unsigned a_lane_off(int R) const { return (unsigned)R * (unsigned)lda_b; }
    __device__ __forceinline__ const char* b_ptr(const Unit& u) const { return Bt + (size_t)u.pn * BM * K * esz; }
};

template <class Epi, class Sched, bool FP8 = false>
__device__ __forceinline__ void gemm_phase(FX_LAS unsigned char* lds, const char* Abase, const int Kc, const Sched& S, const Epi& E, int tidp, const int noepi = 0) {
    int K_ = Kc; asm volatile("" : "+s"(K_)); const int K = K_;
    int tid_ = tidp; asm volatile("" : "+v"(tid_));
    const int tid = tid_, wid = __builtin_amdgcn_readfirstlane(tid >> 6), lane = tid & 63, wr = wid >> 2, wc = wid & 3, fr = lane & 15, fq = lane >> 4;
    constexpr int ES = FP8 ? 1 : 2;
    const int nt = K * ES / 128;
    int Rr[2], Cc[2]; unsigned voffB[2];
#pragma unroll
    for (int i = 0; i < 2; ++i) { int R, C; stage_rc(tid * 16 + i * 8192, R, C); Rr[i] = R; Cc[i] = C; const int Rb = (Epi::PERM && !(FP8 && FX_F8_32)) ? ((R & ~31) + perm32(R & 31)) : R; voffB[i] = (unsigned)(Rb * K * ES + C * 2); }
    const size_t hstepB = (size_t)HALF * K * ES;
    const unsigned ldsw = (unsigned)wid * 1024u;
    constexpr bool F32M = FP8 && FX_F8_32;
    const int aoff = F32M ? lds_byte(wr * 64 + (lane & 31), 16 * (lane >> 5)) : lds_byte(wr * 64 + fr, fq * 8), boff = F32M ? lds_byte(wc * 32 + (lane & 31), 16 * (lane >> 5)) : lds_byte(wc * 32 + fr, fq * 8);
#define FX_SA(b, h) (((b) * 2 + (h)) * HTB)
#define FX_SB(b, h) ((4 + (b) * 2 + (h)) * HTB)
#define FX_STAGE_A(bufoff, o0, o1, kb) do { const char* ap_ = Abase + (kb); \
        __builtin_amdgcn_global_load_lds((const unsigned*)(ap_ + (o0)), (FX_LAS unsigned*)(lds + (bufoff) + ldsw), 16, 0, 0); \
        __builtin_amdgcn_global_load_lds((const unsigned*)(ap_ + (o1)), (FX_LAS unsigned*)(lds + (bufoff) + ldsw + 8192), 16, 0, 0); } while (0)
#define FX_STAGE_B(bufoff, gbase) do { _Pragma("unroll") for (int _i = 0; _i < 2; ++_i) \
        __builtin_amdgcn_global_load_lds((const unsigned*)((const char*)(gbase) + voffB[_i]), (FX_LAS unsigned*)(lds + (bufoff) + ldsw + _i * 8192), 16, 0, 0); } while (0)
#define FX_LDA(dst, b, h) do { if constexpr (F32M) { _Pragma("unroll") for (int q = 0; q < 4; ++q) { dst[q][0] = *(const FX_LAS bf16x8*)(lds + FX_SA(b, h) + aoff + (q >> 1) * 4096 + (q & 1) * 1024); dst[q][1] = *(const FX_LAS bf16x8*)(lds + FX_SA(b, h) + aoff + (q >> 1) * 4096 + (q & 1) * 1024 + 16); } } \
        else { _Pragma("unroll") for (int m = 0; m < 4; ++m) _Pragma("unroll") for (int k = 0; k < 2; ++k) dst[m][k] = *(const FX_LAS bf16x8*)(lds + FX_SA(b, h) + aoff + m * 2048 + k * 1024); } } while (0)
#define FX_LDB(dst, b, h) do { if constexpr (F32M) { _Pragma("unroll") for (int q = 0; q < 2; ++q) { dst[q][0] = *(const FX_LAS bf16x8*)(lds + FX_SB(b, h) + boff + q * 1024); dst[q][1] = *(const FX_LAS bf16x8*)(lds + FX_SB(b, h) + boff + q * 1024 + 16); } } \
        else { _Pragma("unroll") for (int n = 0; n < 2; ++n) _Pragma("unroll") for (int k = 0; k < 2; ++k) dst[n][k] = *(const FX_LAS bf16x8*)(lds + FX_SB(b, h) + boff + n * 2048 + k * 1024); } } while (0)
#define FX_MMA(ai, bj, At, Bt) do { if (!FP8 || FX_PRIO8) __builtin_amdgcn_s_setprio(1); \
        if constexpr (F32M) { _Pragma("unroll") for (int mb = 0; mb < 2; ++mb) _Pragma("unroll") for (int s = 0; s < 2; ++s) { \
            const i32x4 a0_ = __builtin_bit_cast(i32x4, At[mb * 2 + s][0]), a1_ = __builtin_bit_cast(i32x4, At[mb * 2 + s][1]), b0_ = __builtin_bit_cast(i32x4, Bt[s][0]), b1_ = __builtin_bit_cast(i32x4, Bt[s][1]); \
            const i32x8 af_ = __builtin_shufflevector(a0_, a1_, 0, 1, 2, 3, 4, 5, 6, 7), bf_ = __builtin_shufflevector(b0_, b1_, 0, 1, 2, 3, 4, 5, 6, 7); \
            asm volatile("v_mfma_scale_f32_32x32x64_f8f6f4 %0, %1, %2, %0, %3, %3 op_sel_hi:[0,0,0]" : "+v"(acc3[ai][bj][mb]) : "v"(bf_), "v"(af_), "v"(sc1_)); } } else \
        _Pragma("unroll") for (int m = 0; m < 4; ++m) _Pragma("unroll") for (int n = 0; n < 2; ++n) { \
        if constexpr (FP8) { const i32x4 a0_ = __builtin_bit_cast(i32x4, At[m][0]), a1_ = __builtin_bit_cast(i32x4, At[m][1]), b0_ = __builtin_bit_cast(i32x4, Bt[n][0]), b1_ = __builtin_bit_cast(i32x4, Bt[n][1]); \
            const i32x8 af_ = __builtin_shufflevector(a0_, a1_, 0, 1, 2, 3, 4, 5, 6, 7), bf_ = __builtin_shufflevector(b0_, b1_, 0, 1, 2, 3, 4, 5, 6, 7); \
            asm volatile("v_mfma_scale_f32_16x16x128_f8f6f4 %0, %1, %2, %0, %3, %3 op_sel_hi:[0,0,0]" : "+v"(acc[ai][bj][m][n]) : "v"(bf_), "v"(af_), "v"(sc1_)); FX_MFMA_DUP(acc[ai][bj][m][n]) } \
        else { _Pragma("unroll") for (int k = 0; k < 2; ++k) acc[ai][bj][m][n] = __builtin_amdgcn_mfma_f32_16x16x32_bf16(Bt[n][k], At[m][k], acc[ai][bj][m][n], 0, 0, 0); } } \
        if (!FP8 || FX_PRIO8) __builtin_amdgcn_s_setprio(0); } while (0)
#define FX_WAIT_V(n) asm volatile("s_waitcnt vmcnt(" #n ")" ::: "memory")
#define FX_WAIT_L(n) asm volatile("s_waitcnt lgkmcnt(" #n ")" ::: "memory")
#define FX_BAR __builtin_amdgcn_s_barrier()
#define FX_SCHED __builtin_amdgcn_sched_barrier(0)
#ifdef FX_PROBE_MFMA
#define FX_MFMA_DUP(ACC) asm volatile("v_mfma_scale_f32_16x16x128_f8f6f4 %0, %1, %2, %0, %3, %3 op_sel_hi:[0,0,0]" : "+v"(ACC) : "v"(bf_), "v"(af_), "v"(sc0_));
#else
#define FX_MFMA_DUP(ACC)
#endif
    const int sc0_ = 0; (void)sc0_;
    const int sc1_ = 0x7f7f7f7f;
    (void)sc1_;
    Unit cur, nxt; int ui = 0;
    if (!S.next(0, cur)) return;
    f32x4 acc[2][2][4][2];
#pragma unroll
    for (int a = 0; a < 2; ++a)
#pragma unroll
        for (int b = 0; b < 2; ++b)
#pragma unroll
            for (int m = 0; m < 4; ++m)
#pragma unroll
                for (int n = 0; n < 2; ++n) acc[a][b][m][n] = (f32x4){0.f, 0.f, 0.f, 0.f};
    f32x16 acc3[2][2][2];
#pragma unroll
    for (int q = 0; q < 8; ++q) acc3[q >> 2][(q >> 1) & 1][q & 1] = f32x16{};
    bf16x8 At[4][2], B0[2][2], B1[2][2];
    unsigned c00, c01, c10, c11, n00 = 0, n01 = 0, n10 = 0, n11 = 0;
    size_t ubc = 0, ubn = 0;
    if constexpr (Sched::GATHER) { c00 = S.a_row_off(cur, Rr[0]) + Cc[0] * 2; c01 = S.a_row_off(cur, Rr[1]) + Cc[1] * 2; c10 = S.a_row_off(cur, HALF + Rr[0]) + Cc[0] * 2; c11 = S.a_row_off(cur, HALF + Rr[1]) + Cc[1] * 2; }
    else { c00 = S.a_lane_off(Rr[0]) + Cc[0] * 2; c01 = S.a_lane_off(Rr[1]) + Cc[1] * 2; c10 = c00 + S.a_lane_off(HALF); c11 = c01 + S.a_lane_off(HALF); ubc = S.a_unit_base(cur); n00 = c00; n01 = c01; n10 = c10; n11 = c11; }
    const char* cB = S.b_ptr(cur);
    const unsigned kstep = BK * 2;
    FX_STAGE_B(FX_SB(0, 0), cB); FX_STAGE_A(FX_SA(0, 0), c00, c01, ubc); FX_STAGE_B(FX_SB(0, 1), cB + hstepB); FX_STAGE_A(FX_SA(0, 1), c10, c11, ubc);
    if (wr == 1) FX_BAR;
    FX_WAIT_V(4); FX_BAR;
    FX_STAGE_B(FX_SB(1, 0), cB + kstep); FX_STAGE_A(FX_SA(1, 0), c00, c01, ubc + kstep); FX_STAGE_B(FX_SB(1, 1), cB + hstepB + kstep);
    FX_WAIT_V(6); FX_BAR;
    for (;;) {
        const bool has_next = S.next(ui + 1, nxt);
        if (!has_next) nxt = cur;
        if constexpr (!Sched::GATHER) ubn = S.a_unit_base(nxt);
        const char* nB = S.b_ptr(nxt);
        for (int t = 0; t < nt; t += 2) {
            const bool last = (t == nt - 2);
            asm volatile("" : "+v"(c00), "+v"(c01), "+v"(c10), "+v"(c11), "+v"(voffB[0]), "+v"(voffB[1]));
            if constexpr (Sched::GATHER) { if (last) {
                int t2_ = tid; asm volatile("" : "+v"(t2_)); int R0_, C0_, R1_, C1_; stage_rc(t2_ * 16, R0_, C0_); stage_rc(t2_ * 16 + 8192, R1_, C1_);
                n00 = S.a_row_off(nxt, R0_) + C0_ * 2; n01 = S.a_row_off(nxt, R1_) + C1_ * 2; n10 = S.a_row_off(nxt, HALF + R0_) + C0_ * 2; n11 = S.a_row_off(nxt, HALF + R1_) + C1_ * 2; } }
            const size_t k1 = ubc + (size_t)(t + 1) * kstep;
            const size_t k2 = last ? ubn : ubc + (size_t)(t + 2) * kstep, k3 = k2 + kstep;
            unsigned a00, a01, a10, a11;
            if constexpr (Sched::GATHER) { a00 = last ? n00 : c00; a01 = last ? n01 : c01; a10 = last ? n10 : c10; a11 = last ? n11 : c11; } else { a00 = c00; a01 = c01; a10 = c10; a11 = c11; }
            const char* b2 = last ? nB : cB + (size_t)(t + 2) * kstep; const char* b3 = b2 + kstep;
            FX_LDB(B0, 0, 0); FX_SCHED; FX_LDA(At, 0, 0); FX_STAGE_A(FX_SA(1, 1), c10, c11, k1);
            FX_WAIT_L(8); FX_BAR; FX_WAIT_L(0); FX_MMA(0, 0, At, B0); FX_BAR; FX_SCHED;
            FX_LDB(B1, 0, 1); FX_STAGE_B(FX_SB(0, 0), b2);
            FX_BAR; FX_WAIT_L(0); FX_MMA(0, 1, At, B1); FX_BAR;
            FX_LDA(At, 0, 1); FX_STAGE_A(FX_SA(0, 0), a00, a01, k2);
            FX_BAR; FX_WAIT_L(0); FX_MMA(1, 0, At, B0); FX_BAR; FX_SCHED;
            FX_STAGE_B(FX_SB(0, 1), b2 + hstepB);
            FX_WAIT_V(6); FX_BAR; FX_MMA(1, 1, At, B1); FX_BAR;
            FX_LDB(B0, 1, 0); FX_SCHED; FX_LDA(At, 1, 0); FX_STAGE_A(FX_SA(0, 1), a10, a11, k2);
            FX_WAIT_L(8); FX_BAR; FX_WAIT_L(0); FX_MMA(0, 0, At, B0); FX_BAR; FX_SCHED;
            FX_LDB(B1, 1, 1); FX_STAGE_B(FX_SB(1, 0), b3);
            FX_BAR; FX_WAIT_L(0); FX_MMA(0, 1, At, B1); FX_BAR;
            FX_LDA(At, 1, 1); FX_STAGE_A(FX_SA(1, 0), a00, a01, k3);
            FX_BAR; FX_WAIT_L(0); FX_MMA(1, 0, At, B0); FX_BAR; FX_SCHED;
            FX_STAGE_B(FX_SB(1, 1), b3 + hstepB);
            FX_WAIT_V(6); FX_BAR; FX_MMA(1, 1, At, B1); FX_BAR;
        }
        if constexpr (FP8) asm volatile("s_nop 15\n\ts_nop 15\n\ts_nop 15\n\ts_nop 15" ::: "memory");
        if constexpr (F32M) { int ln_e = lane; asm volatile("" : "+v"(ln_e)); E.e32(acc3, cur, wr, wc, ln_e); }
        else if (noepi) { f32x4 s_ = (f32x4){0.f, 0.f, 0.f, 0.f};
#pragma unroll
            for (int q_ = 0; q_ < 32; ++q_) s_ += acc[q_ >> 4][(q_ >> 3) & 1][(q_ >> 1) & 3][q_ & 1];
            if (s_[0] + s_[1] + s_[2] + s_[3] == 1.2345e-30f) *(float*)const_cast<char*>(Abase) = s_[0]; }
        else { int fr_e = fr, fq_e = fq; asm volatile("" : "+v"(fr_e), "+v"(fq_e)); E(acc, cur, wr, wc, fr_e, fq_e); }
        if (!has_next) break;
        if constexpr (F32M) { _Pragma("unroll") for (int q = 0; q < 8; ++q) acc3[q >> 2][(q >> 1) & 1][q & 1] = f32x16{}; }
#pragma unroll
        for (int a = 0; a < 2; ++a)
#pragma unroll
            for (int b = 0; b < 2; ++b)
#pragma unroll
                for (int m = 0; m < 4; ++m)
#pragma unroll
                    for (int n = 0; n < 2; ++n) acc[a][b][m][n] = (f32x4){0.f, 0.f, 0.f, 0.f};
        cur = nxt; cB = nB; if constexpr (Sched::GATHER) { c00 = n00; c01 = n01; c10 = n10; c11 = n11; } else ubc = ubn; ++ui;
    }
    FX_WAIT_V(0);
    if (wr == 0) FX_BAR;
    FX_BAR;
}

struct EpiBf16 {
    static constexpr bool PERM = true;
    bf16_t* O; float* gates; int ldc; float scale;
    __device__ __forceinline__ void operator()(const f32x4 (&acc)[2][2][4][2], const Unit& u, int wr, int wc, int fr, int fq) const {
        const int row0 = u.pm * BM + wr * 64 + fr, col0 = u.pn * BM + wc * 32 + 8 * fq;
#pragma unroll
        for (int ai = 0; ai < 2; ++ai)
#pragma unroll
            for (int m = 0; m < 4; ++m) { const int row = row0 + ai * HALF + m * 16; bf16_t* rowp = O + (size_t)row * ldc + col0;
#pragma unroll
                for (int bj = 0; bj < 2; ++bj) { const f32x4 v0 = acc[ai][bj][m][0] * scale, v1 = acc[ai][bj][m][1] * scale;
                    u32x4 w; w.x = cvt_pk_bf16(v0[0], v0[1]); w.y = cvt_pk_bf16(v0[2], v0[3]); w.z = cvt_pk_bf16(v1[0], v1[1]); w.w = cvt_pk_bf16(v1[2], v1[3]);
                    *(u32x4*)(rowp + bj * HALF) = w; }
                if (gates && u.pn == 15 && wc == 2 && fq < 2) { float* g = gates + (size_t)row * 16 + 8 * fq; *(f32x4*)g = acc[ai][1][m][0] * scale; *(f32x4*)(g + 4) = acc[ai][1][m][1] * scale; } }
    }
    __device__ __forceinline__ void e32(const f32x16 (&acc3)[2][2][2], const Unit& u, int wr, int wc, int lane) const {
        const int j = lane & 31, hi = lane >> 5;
#pragma unroll
        for (int ai = 0; ai < 2; ++ai)
#pragma unroll
            for (int mb = 0; mb < 2; ++mb) { const int row = u.pm * BM + ai * HALF + wr * 64 + mb * 32 + j;
#pragma unroll
                for (int bj = 0; bj < 2; ++bj) { bf16_t* rowp = O + (size_t)row * ldc + u.pn * BM + bj * HALF + wc * 32 + 4 * hi;
#pragma unroll
                    for (int g = 0; g < 4; ++g) { u32x2 w; w.x = cvt_pk_bf16(acc3[ai][bj][mb][4 * g] * scale, acc3[ai][bj][mb][4 * g + 1] * scale); w.y = cvt_pk_bf16(acc3[ai][bj][mb][4 * g + 2] * scale, acc3[ai][bj][mb][4 * g + 3] * scale);
                        *(u32x2*)(rowp + 8 * g) = w; } }
                if (gates && u.pn == 15 && wc == 2) { float* gp = gates + (size_t)row * 16 + 4 * hi;
#pragma unroll
                    for (int g = 0; g < 2; ++g) *(f32x4*)(gp + 8 * g) = (f32x4){acc3[ai][1][mb][4 * g] * scale, acc3[ai][1][mb][4 * g + 1] * scale, acc3[ai][1][mb][4 * g + 2] * scale, acc3[ai][1][mb][4 * g + 3] * scale}; } }
    }
};
}
#ifndef FX_RUNR
#define FX_RUNR 16
#endif
namespace fx {
constexpr int RT = 16;
constexpr int H2S_LD = 2052;
constexpr int P7_LDS = RT * H2S_LD * 4 + 512;
constexpr int PTOT = 131072;
constexpr int NTILE_MAX = PTOT / 256;

__device__ __forceinline__ void coef_phase(const float* mod, const float* pre_mix_gain, const float* post_mix_gain, const float* pre_ffn_gain, const float* post_ffn_gain, float* coef, int gtid, int nthr) {
    for (int i = gtid; i < 2 * 4 * 2048; i += nthr) { const int d = i & 2047, b = (i >> 11) & 3, l = i >> 13;
        const float* m = mod + ((size_t)l * 4 + b) * 12288; float* c = coef + ((size_t)l * 4 + b) * 6 * 2048;
        c[0 * 2048 + d] = m[2 * 2048 + d] * post_mix_gain[l * 2048 + d];
        c[1 * 2048 + d] = pre_ffn_gain[l * 2048 + d] * (1.f + m[4 * 2048 + d]);
        c[2 * 2048 + d] = m[3 * 2048 + d];
        c[3 * 2048 + d] = m[5 * 2048 + d] * post_ffn_gain[l * 2048 + d];
        c[4 * 2048 + d] = pre_mix_gain[l * 2048 + d] * (1.f + m[1 * 2048 + d]);
        c[5 * 2048 + d] = m[0 * 2048 + d]; }
}

template <bool XBF>
__device__ __forceinline__ void p7_phase(FX_LAS unsigned char* lds, const void* xin_, const bf16_t* Y, const float* coef_l  , const float* router_w, const float* router_bias,
                                         bf16_t* XRES, unsigned char* HA8, int* SELE, float* SELG, int* CNT, int* WGBASE, int wg, int nwg, int tidp) {
    int tid_ = tidp; asm volatile("" : "+v"(tid_));
    const int tid = tid_, wid = tid >> 6, lane = tid & 63;
    FX_LAS float* h2s = (FX_LAS float*)lds;
    FX_LAS int* hist = (FX_LAS int*)(lds + RT * H2S_LD * 4);
    if (tid < 64) hist[tid] = 0;
    __syncthreads();
#define FX_GC(TY, p) ((const __attribute__((address_space(1))) TY*)(p))
#define FX_GM(TY, p) ((__attribute__((address_space(1))) TY*)(p))
    const int i16 = lane & 15, g4 = lane >> 4;
    for (int unit = wg; unit < T / RT; unit += nwg) {
        {
            const int tok0 = 2 * wid, t0 = unit * RT + tok0, b = t0 / S;
            const float* cf = coef_l + (size_t)b * 6 * 2048;
            u32x4 yw[2][4]; f32x4 ca[8];
            float xv[2][32];
#pragma unroll
            for (int tt = 0; tt < 2; ++tt)
#pragma unroll
                for (int i = 0; i < 4; ++i) yw[tt][i] = *FX_GC(u32x4, Y + (size_t)(t0 + tt) * 2048 + i * 512 + lane * 8);
            if constexpr (XBF) {
                u32x4 xw[2][4];
#pragma unroll
                for (int tt = 0; tt < 2; ++tt)
#pragma unroll
                    for (int i = 0; i < 4; ++i) xw[tt][i] = *FX_GC(u32x4, (const bf16_t*)xin_ + (size_t)(t0 + tt) * 2048 + i * 512 + lane * 8);
#pragma unroll
                for (int i = 0; i < 4; ++i) { ca[2 * i] = *FX_GC(f32x4, cf + i * 512 + lane * 8); ca[2 * i + 1] = *FX_GC(f32x4, cf + i * 512 + lane * 8 + 4); }
#pragma unroll
                for (int tt = 0; tt < 2; ++tt)
#pragma unroll
                    for (int i = 0; i < 4; ++i) { const u32x4 w = xw[tt][i];
                        xv[tt][i * 8 + 0] = bflo(w.x); xv[tt][i * 8 + 1] = bfhi(w.x); xv[tt][i * 8 + 2] = bflo(w.y); xv[tt][i * 8 + 3] = bfhi(w.y); xv[tt][i * 8 + 4] = bflo(w.z); xv[tt][i * 8 + 5] = bfhi(w.z); xv[tt][i * 8 + 6] = bflo(w.w); xv[tt][i * 8 + 7] = bfhi(w.w); }
            } else {
                const float* xin = (const float*)xin_;
#pragma unroll
                for (int tt = 0; tt < 2; ++tt)
#pragma unroll
                    for (int i = 0; i < 4; ++i) { const f32x4 x0 = *FX_GC(f32x4, xin + (size_t)(t0 + tt) * 2048 + i * 512 + lane * 8), x1 = *FX_GC(f32x4, xin + (size_t)(t0 + tt) * 2048 + i * 512 + lane * 8 + 4);
                        xv[tt][i * 8 + 0] = x0[0]; xv[tt][i * 8 + 1] = x0[1]; xv[tt][i * 8 + 2] = x0[2]; xv[tt][i * 8 + 3] = x0[3]; xv[tt][i * 8 + 4] = x1[0]; xv[tt][i * 8 + 5] = x1[1]; xv[tt][i * 8 + 6] = x1[2]; xv[tt][i * 8 + 7] = x1[3]; }
#pragma unroll
                for (int i = 0; i < 4; ++i) { ca[2 * i] = *FX_GC(f32x4, cf + i * 512 + lane * 8); ca[2 * i + 1] = *FX_GC(f32x4, cf + i * 512 + lane * 8 + 4); }
            }
            float ssy0 = 0.f, ssy1 = 0.f;
#pragma unroll
            for (int i = 0; i < 4; ++i) { const u32x4 w0 = yw[0][i], w1 = yw[1][i];
#pragma unroll
                for (int q = 0; q < 4; ++q) { const float l0 = bflo(w0[q]), h0 = bfhi(w0[q]), l1 = bflo(w1[q]), h1 = bfhi(w1[q]); ssy0 += l0 * l0 + h0 * h0; ssy1 += l1 * l1 + h1 * h1; } }
#pragma unroll
            for (int o = 32; o >= 1; o >>= 1) { ssy0 += __shfl_xor(ssy0, o); ssy1 += __shfl_xor(ssy1, o); }
            const float ry0 = rsqrtf(ssy0 * (1.f / 2048.f) + EPS), ry1 = rsqrtf(ssy1 * (1.f / 2048.f) + EPS);
            float ssx0 = 0.f, ssx1 = 0.f;
#pragma unroll
            for (int i = 0; i < 4; ++i) { const u32x4 w0 = yw[0][i], w1 = yw[1][i];
#pragma unroll
                for (int j = 0; j < 8; ++j) { const float a = ca[2 * i + (j >> 2)][j & 3];
                    const float y0 = (j & 1) ? bfhi(w0[j >> 1]) : bflo(w0[j >> 1]), y1 = (j & 1) ? bfhi(w1[j >> 1]) : bflo(w1[j >> 1]);
                    xv[0][i * 8 + j] += a * (y0 * ry0); xv[1][i * 8 + j] += a * (y1 * ry1);
                    ssx0 += xv[0][i * 8 + j] * xv[0][i * 8 + j]; ssx1 += xv[1][i * 8 + j] * xv[1][i * 8 + j]; } }
            f32x4 cb[8], cc[8];
#pragma unroll
            for (int i = 0; i < 4; ++i) { cb[2 * i] = *FX_GC(f32x4, cf + 2048 + i * 512 + lane * 8); cb[2 * i + 1] = *FX_GC(f32x4, cf + 2048 + i * 512 + lane * 8 + 4);
                cc[2 * i] = *FX_GC(f32x4, cf + 4096 + i * 512 + lane * 8); cc[2 * i + 1] = *FX_GC(f32x4, cf + 4096 + i * 512 + lane * 8 + 4); }
#pragma unroll
            for (int tt = 0; tt < 2; ++tt)
#pragma unroll
                for (int i = 0; i < 4; ++i) { u32x4 xo; xo.x = cvt_pk_bf16(xv[tt][i * 8 + 0], xv[tt][i * 8 + 1]); xo.y = cvt_pk_bf16(xv[tt][i * 8 + 2], xv[tt][i * 8 + 3]); xo.z = cvt_pk_bf16(xv[tt][i * 8 + 4], xv[tt][i * 8 + 5]); xo.w = cvt_pk_bf16(xv[tt][i * 8 + 6], xv[tt][i * 8 + 7]);
                    *FX_GM(u32x4, XRES + (size_t)(t0 + tt) * 2048 + i * 512 + lane * 8) = xo; }
#pragma unroll
            for (int o = 32; o >= 1; o >>= 1) { ssx0 += __shfl_xor(ssx0, o); ssx1 += __shfl_xor(ssx1, o); }
            const float rx0 = rsqrtf(ssx0 * (1.f / 2048.f) + EPS), rx1 = rsqrtf(ssx1 * (1.f / 2048.f) + EPS);
#pragma unroll
            for (int tt = 0; tt < 2; ++tt) { const float rx = tt ? rx1 : rx0;
#pragma unroll
                for (int i = 0; i < 4; ++i) { const int c = i * 512 + lane * 8;
                    float hv[8];
#pragma unroll
                    for (int j = 0; j < 8; ++j) hv[j] = xv[tt][i * 8 + j] * rx * cb[2 * i + (j >> 2)][j & 3] + cc[2 * i + (j >> 2)][j & 3];
                    u32x2 w; w.x = cvt_pk4_fp8(hv[0], hv[1], hv[2], hv[3]); w.y = cvt_pk4_fp8(hv[4], hv[5], hv[6], hv[7]);
                    *FX_GM(u32x2, HA8 + (size_t)(t0 + tt) * 2048 + c) = w;
                    *(FX_LAS f32x4*)(h2s + (tok0 + tt) * H2S_LD + c) = (f32x4){hv[0], hv[1], hv[2], hv[3]};
                    *(FX_LAS f32x4*)(h2s + (tok0 + tt) * H2S_LD + c + 4) = (f32x4){hv[4], hv[5], hv[6], hv[7]}; } }
        }
        f32x4 acc[4];
#pragma unroll
        for (int j = 0; j < 4; ++j) acc[j] = (f32x4){0.f, 0.f, 0.f, 0.f};
        {
            const char* rwb = (const char*)router_w + (size_t)__builtin_amdgcn_readfirstlane(wid) * (256 * 64 * 4);
            const unsigned loff = (unsigned)(g4 * 64 + 4 * i16) * 4u;
            f32x4 bwA[8], bwB[8];
            { unsigned o_ = loff; asm volatile("" : "+v"(o_));
#pragma unroll
              for (int q = 0; q < 8; ++q) bwA[q] = *FX_GC(f32x4, rwb + o_ + q * 1024); }
            __syncthreads();
#pragma unroll
            for (int kb = 0; kb < 8; ++kb) {
                if (kb < 7) { unsigned o_ = loff + (kb + 1) * 8192; asm volatile("" : "+v"(o_));
#pragma unroll
                    for (int q = 0; q < 8; ++q) { const f32x4 v = *FX_GC(f32x4, rwb + o_ + q * 1024); if (kb & 1) bwA[q] = v; else bwB[q] = v; } }
#pragma unroll
                for (int q = 0; q < 8; ++q) { const int k = 256 * wid + 4 * (kb * 8 + q) + g4;
                    const float a = h2s[i16 * H2S_LD + k]; const f32x4 bw = (kb & 1) ? bwB[q] : bwA[q];
                    acc[0] = __builtin_amdgcn_mfma_f32_16x16x4f32(a, bw[0], acc[0], 0, 0, 0);
                    acc[1] = __builtin_amdgcn_mfma_f32_16x16x4f32(a, bw[1], acc[1], 0, 0, 0);
                    acc[2] = __builtin_amdgcn_mfma_f32_16x16x4f32(a, bw[2], acc[2], 0, 0, 0);
                    acc[3] = __builtin_amdgcn_mfma_f32_16x16x4f32(a, bw[3], acc[3], 0, 0, 0); } }
        }
        __syncthreads();
        { FX_LAS float* part = h2s; const int i16 = lane & 15, g = lane >> 4;
#pragma unroll
          for (int j = 0; j < 4; ++j)
#pragma unroll
            for (int r = 0; r < 4; ++r) part[(wid * 16 + 4 * g + r) * 64 + 4 * i16 + j] = acc[j][r]; }
        __syncthreads();
#pragma unroll 1
        for (int tt = 0; tt < 2; ++tt) {
            const int tok = 2 * wid + tt, t = unit * RT + tok;
            float lg = 0.f;
#pragma unroll
            for (int w = 0; w < 8; ++w) lg += h2s[(w * 16 + tok) * 64 + lane];
            const float score = 1.f / (1.f + expf(-lg));
            float v = score + router_bias[lane];
            int my_e = 0; float my_s = 0.f, sum = 0.f;
#pragma unroll
            for (int k = 0; k < 6; ++k) {
                const float m = wave_max(v);
                const unsigned long long bal = __ballot(v == m);
                const int win = __ffsll((long long)bal) - 1;
                const float sw = __shfl(score, win);
                sum += sw; if (lane == k) { my_e = win; my_s = sw; }
                if (lane == win) v = -3.0e38f;
            }
            if (lane < 6) { SELE[(size_t)t * 6 + lane] = my_e; SELG[(size_t)t * 6 + lane] = my_s / sum * 2.5f; __hip_atomic_fetch_add(hist + my_e, 1, __ATOMIC_RELAXED, __HIP_MEMORY_SCOPE_WORKGROUP); }
        }
        __syncthreads();
    }
    if (tid < 64) { const int hv = hist[tid]; const int base = atomicAdd(CNT + tid, hv); WGBASE[wg * 64 + tid] = base; }
}

__device__ __forceinline__ void p8_phase(FX_LAS unsigned char* lds, const int* SELE, const float* SELG, const int* CNT, const int* WGBASE, int* ROWTOK, float* ROWG, int* SLOT, int wg, int nwg, int tidp) {
    int tid_ = tidp; asm volatile("" : "+v"(tid_));
    const int tid = tid_;
    FX_LAS int* pstart = (FX_LAS int*)lds; FX_LAS int* off = pstart + 80;
    if (tid < 64) { const int pc = (CNT[tid] + 255) & ~255; int incl = pc;
#pragma unroll
        for (int o = 1; o < 64; o <<= 1) { const int t2 = __shfl_up(incl, o); if (tid >= o) incl += t2; }
        pstart[tid] = 16384 + incl - pc; if (tid == 63) pstart[64] = 16384 + incl; }
    __syncthreads();
    if (tid < 64) off[tid] = pstart[tid] + WGBASE[wg * 64 + tid];
    __syncthreads();
    for (int unit = wg; unit < T / RT; unit += nwg) {
        if (tid < RT * 6) { const int t = unit * RT + tid / 6, k = tid % 6; const int e = SELE[(size_t)t * 6 + k];
            const int pos = __hip_atomic_fetch_add(off + e, 1, __ATOMIC_RELAXED, __HIP_MEMORY_SCOPE_WORKGROUP);
            ROWTOK[pos] = t; ROWG[pos] = SELG[(size_t)t * 6 + k]; SLOT[(size_t)t * 6 + k] = pos; }
    }
    for (int e = wg; e < 64; e += nwg) { const int a = pstart[e] + CNT[e], b = pstart[e + 1]; for (int r = a + tid; r < b; r += 512) { ROWTOK[r] = 0; ROWG[r] = 0.f; } }
    for (int r = wg * 512 + tid; r < 16384; r += nwg * 512) { ROWTOK[r] = r; ROWG[r] = 1.f; }
}

struct MoeSched {
    static constexpr bool GATHER = true;
    FX_LAS const unsigned char* tile_e; int ntiles, npn, nunits, G, c;
    const int* rowtok; int lda_b; const char* Bt; size_t estride_b, pnstride_b;
    __device__ __forceinline__ bool next(int i, Unit& u) const {
        const long L = (long)i * G + c; if (L >= nunits) return false;
        int id = (int)L; { const int q = nunits / NXCD, r = nunits % NXCD, xcd = id % NXCD, off = id / NXCD; id = (xcd < r ? xcd * (q + 1) : r * (q + 1) + (xcd - r) * q) + off; }
        u.pm = id / npn; u.pn = id - u.pm * npn; u.e = tile_e[u.pm]; return true;
    }
    __device__ __forceinline__ unsigned a_row_off(const Unit& u, int R) const { const int row = u.pm * BM + R; return (unsigned)(rowtok ? rowtok[row] : row) * (unsigned)lda_b; }
    __device__ __forceinline__ const char* b_ptr(const Unit& u) const { return Bt + (size_t)u.e * estride_b + (size_t)u.pn * pnstride_b; }
};
__device__ __forceinline__ int moe_sched_build(FX_LAS unsigned char* tab, const int* CNT, int tidp) {
    FX_LAS int* nt = (FX_LAS int*)(tab + 512);
    int tid_ = tidp; asm volatile("" : "+v"(tid_));
    if (tid_ < 64) { const int n = (CNT[tid_] + 255) >> 8; int incl = n;
#pragma unroll
        for (int o = 1; o < 64; o <<= 1) { const int t2 = __shfl_up(incl, o); if (tid_ >= o) incl += t2; }
        const int st0 = 64 + incl - n; for (int j = 0; j < n; ++j) tab[st0 + j] = (unsigned char)tid_;
        tab[tid_] = 64; if (tid_ == 63) nt[0] = 64 + incl; }
    __syncthreads();
    return nt[0];
}
struct EpiGateUp {
    static constexpr bool PERM = true;
    unsigned char* HID;
    __device__ __forceinline__ void operator()(const f32x4 (&acc)[2][2][4][2], const Unit& u, int wr, int wc, int fr, int fq) const {
        const int row0 = u.pm * BM + wr * 64 + fr, col0 = u.pn * 128 + wc * 32 + 8 * fq;
#pragma unroll
        for (int ai = 0; ai < 2; ++ai)
#pragma unroll
            for (int m = 0; m < 4; ++m) { const int row = row0 + ai * HALF + m * 16;
                float o[8];
#pragma unroll
                for (int n = 0; n < 2; ++n)
#pragma unroll
                    for (int j = 0; j < 4; ++j) { const float g = acc[ai][0][m][n][j] * W8_INV, up = acc[ai][1][m][n][j] * W8_INV; o[n * 4 + j] = g * __builtin_amdgcn_rcpf(1.f + __expf(-g)) * up; }
                u32x2 w; w.x = cvt_pk4_fp8(o[0], o[1], o[2], o[3]); w.y = cvt_pk4_fp8(o[4], o[5], o[6], o[7]);
                *(u32x2*)(HID + (size_t)row * 512 + col0) = w; }
    }
    __device__ __forceinline__ void e32(const f32x16 (&acc3)[2][2][2], const Unit& u, int wr, int wc, int lane) const {
        const int j = lane & 31, hi = lane >> 5;
#pragma unroll
        for (int ai = 0; ai < 2; ++ai)
#pragma unroll
            for (int mb = 0; mb < 2; ++mb) { const int row = u.pm * BM + ai * HALF + wr * 64 + mb * 32 + j; unsigned char* rowp = HID + (size_t)row * 512 + u.pn * 128 + wc * 32 + 4 * hi;
#pragma unroll
                for (int g = 0; g < 4; ++g) { float o[4];
#pragma unroll
                    for (int q = 0; q < 4; ++q) { const float gt = acc3[ai][0][mb][4 * g + q] * W8_INV, up = acc3[ai][1][mb][4 * g + q] * W8_INV; o[q] = gt * __builtin_amdgcn_rcpf(1.f + __expf(-gt)) * up; }
                    *(unsigned*)(rowp + 8 * g) = cvt_pk4_fp8(o[0], o[1], o[2], o[3]); } }
    }
};
struct EpiDown {
    static constexpr bool PERM = true;
    unsigned char* YR; const float* ROWG; int nostore;
    __device__ __forceinline__ void operator()(const f32x4 (&acc)[2][2][4][2], const Unit& u, int wr, int wc, int fr, int fq) const {
        const int row0 = u.pm * BM + wr * 64 + fr, col0 = u.pn * BM + wc * 32 + 8 * fq;
        float gs[2][4];
#pragma unroll
        for (int ai = 0; ai < 2; ++ai)
#pragma unroll
            for (int m = 0; m < 4; ++m) gs[ai][m] = ROWG[row0 + ai * HALF + m * 16];
#pragma unroll
        for (int ai = 0; ai < 2; ++ai)
#pragma unroll
            for (int m = 0; m < 4; ++m) { const int row = row0 + ai * HALF + m * 16; const float g = gs[ai][m] * W8_INV; unsigned char* rowp = YR + (size_t)row * 2048 + col0;
#pragma unroll
                for (int bj = 0; bj < 2; ++bj) { const f32x4 v0 = acc[ai][bj][m][0] * g, v1 = acc[ai][bj][m][1] * g;
                    u32x2 w; w.x = cvt_pk4_fp8(v0[0], v0[1], v0[2], v0[3]); w.y = cvt_pk4_fp8(v1[0], v1[1], v1[2], v1[3]);
                    if (!FX_NOEPI || !nostore || (w.x == 0x12345678u && w.y == 0x9abcdef0u))
                    *(u32x2*)(rowp + bj * HALF) = w; } }
    }
    __device__ __forceinline__ void e32(const f32x16 (&acc3)[2][2][2], const Unit& u, int wr, int wc, int lane) const {
        const int j = lane & 31, hi = lane >> 5;
#pragma unroll
        for (int ai = 0; ai < 2; ++ai)
#pragma unroll
            for (int mb = 0; mb < 2; ++mb) { const int row = u.pm * BM + ai * HALF + wr * 64 + mb * 32 + j; const float gsc = ROWG[row] * W8_INV;
#pragma unroll
                for (int bj = 0; bj < 2; ++bj) { unsigned char* rowp = YR + (size_t)row * 2048 + u.pn * BM + bj * HALF + wc * 32 + 4 * hi;
#pragma unroll
                    for (int g = 0; g < 4; ++g) *(unsigned*)(rowp + 8 * g) = cvt_pk4_fp8(acc3[ai][bj][mb][4 * g] * gsc, acc3[ai][bj][mb][4 * g + 1] * gsc, acc3[ai][bj][mb][4 * g + 2] * gsc, acc3[ai][bj][mb][4 * g + 3] * gsc); } }
    }
};
__device__ __forceinline__ void p9_phase(FX_LAS unsigned char* lds, const unsigned char* HA, const unsigned char* WGU, const int* CNT, const int* ROWTOK, unsigned char* HID, int wg, int nwg, int tidp, const int noepi = 0) {
    FX_LAS unsigned char* tab = lds + STAGE_BYTES;
    const int ntiles = moe_sched_build(tab, CNT, tidp);
    MoeSched Sc; Sc.tile_e = tab; Sc.ntiles = ntiles; Sc.npn = 4; Sc.nunits = ntiles * 4; Sc.G = nwg; Sc.c = wg; Sc.rowtok = ROWTOK; Sc.lda_b = 2048; Sc.Bt = (const char*)WGU; Sc.estride_b = (size_t)1024 * 2048; Sc.pnstride_b = (size_t)256 * 2048;
    EpiGateUp E; E.HID = HID;
    gemm_phase<EpiGateUp, MoeSched, true>(lds, (const char*)HA, 2048, Sc, E, tidp, noepi);
}
__device__ __forceinline__ void p10_phase(FX_LAS unsigned char* lds, const unsigned char* HID, const unsigned char* WDN, const int* CNT, const float* ROWG, unsigned char* YR, int wg, int nwg, int tidp, const int noepi = 0) {
    FX_LAS unsigned char* tab = lds + STAGE_BYTES;
    const int ntiles = moe_sched_build(tab, CNT, tidp);
    MoeSched Sc; Sc.tile_e = tab; Sc.ntiles = ntiles; Sc.npn = 8; Sc.nunits = ntiles * 8; Sc.G = nwg; Sc.c = wg; Sc.rowtok = nullptr; Sc.lda_b = 512; Sc.Bt = (const char*)WDN; Sc.estride_b = (size_t)2048 * 512; Sc.pnstride_b = (size_t)256 * 512;
    EpiDown E; E.YR = YR; E.ROWG = ROWG; E.nostore = (noepi == 2);
    gemm_phase<EpiDown, MoeSched, true>(lds, (const char*)HID, 512, Sc, E, tidp, noepi == 1);
}
template <bool OUTF32>
__device__ __forceinline__ void p11_phase(const bf16_t* x1, const unsigned char* YR, const int* SLOT, const float* coef_l, const float* coef_next  , void* xout_, bf16_t* HA, int wg, int nwg, int tidp) {
    int tid_ = tidp; asm volatile("" : "+v"(tid_));
    const int wid = __builtin_amdgcn_readfirstlane(tid_ >> 6), lane = tid_ & 63;
    for (int t = wg * 8 + wid; t < T; t += nwg * 8) {
        const int b = t / S; const float* cf = coef_l + (size_t)b * 6 * 2048;
        int rows[7]; rows[0] = t;
        { int sl[6];
#pragma unroll
          for (int k = 0; k < 6; ++k) sl[k] = *FX_GC(int, SLOT + (size_t)t * 6 + k);
#pragma unroll
          for (int k = 0; k < 6; ++k) rows[k + 1] = __builtin_amdgcn_readfirstlane(sl[k]); }
        u32x2 ra[4][4];
#pragma unroll
        for (int k = 0; k < 4; ++k)
#pragma unroll
            for (int i = 0; i < 4; ++i) ra[k][i] = *FX_GC(u32x2, YR + (size_t)rows[k] * 2048 + i * 512 + lane * 8);
        u32x4 xw[4];
#pragma unroll
        for (int i = 0; i < 4; ++i) xw[i] = *FX_GC(u32x4, x1 + (size_t)t * 2048 + i * 512 + lane * 8);
        float yv[32];
#pragma unroll
        for (int j = 0; j < 32; ++j) yv[j] = 0.f;
#define FX_ACC8(W, I) do { const f32x2 a0 = __builtin_amdgcn_cvt_pk_f32_fp8((int)(W).x, false), a1 = __builtin_amdgcn_cvt_pk_f32_fp8((int)(W).x, true), a2 = __builtin_amdgcn_cvt_pk_f32_fp8((int)(W).y, false), a3 = __builtin_amdgcn_cvt_pk_f32_fp8((int)(W).y, true); \
            yv[(I) * 8 + 0] += a0[0]; yv[(I) * 8 + 1] += a0[1]; yv[(I) * 8 + 2] += a1[0]; yv[(I) * 8 + 3] += a1[1]; yv[(I) * 8 + 4] += a2[0]; yv[(I) * 8 + 5] += a2[1]; yv[(I) * 8 + 6] += a3[0]; yv[(I) * 8 + 7] += a3[1]; } while (0)
#pragma unroll
        for (int k = 0; k < 4; ++k)
#pragma unroll
            for (int i = 0; i < 4; ++i) FX_ACC8(ra[k][i], i);
        u32x2 rb[3][4];
#pragma unroll
        for (int k = 0; k < 3; ++k)
#pragma unroll
            for (int i = 0; i < 4; ++i) rb[k][i] = *FX_GC(u32x2, YR + (size_t)rows[4 + k] * 2048 + i * 512 + lane * 8);
        f32x4 cd[8];
#pragma unroll
        for (int i = 0; i < 4; ++i) { cd[2 * i] = *FX_GC(f32x4, cf + 3 * 2048 + i * 512 + lane * 8); cd[2 * i + 1] = *FX_GC(f32x4, cf + 3 * 2048 + i * 512 + lane * 8 + 4); }
#pragma unroll
        for (int k = 0; k < 3; ++k)
#pragma unroll
            for (int i = 0; i < 4; ++i) FX_ACC8(rb[k][i], i);
#undef FX_ACC8
        float ss = 0.f;
#pragma unroll
        for (int j = 0; j < 32; ++j) ss += yv[j] * yv[j];
        ss = wave_sum(ss); const float ry = rsqrtf(ss * (1.f / 2048.f) + EPS); float ssx = 0.f;
#pragma unroll
        for (int i = 0; i < 4; ++i) { const u32x4 w = xw[i];
            const float xs[8] = {bflo(w.x), bfhi(w.x), bflo(w.y), bfhi(w.y), bflo(w.z), bfhi(w.z), bflo(w.w), bfhi(w.w)};
#pragma unroll
            for (int j = 0; j < 8; ++j) { yv[i * 8 + j] = xs[j] + cd[2 * i + (j >> 2)][j & 3] * (yv[i * 8 + j] * ry); ssx += yv[i * 8 + j] * yv[i * 8 + j]; } }
        f32x4 ce[8], cg[8];
        if (coef_next) { const float* cn = coef_next + (size_t)b * 6 * 2048;
#pragma unroll
            for (int i = 0; i < 4; ++i) { ce[2 * i] = *FX_GC(f32x4, cn + 4 * 2048 + i * 512 + lane * 8); ce[2 * i + 1] = *FX_GC(f32x4, cn + 4 * 2048 + i * 512 + lane * 8 + 4);
                cg[2 * i] = *FX_GC(f32x4, cn + 5 * 2048 + i * 512 + lane * 8); cg[2 * i + 1] = *FX_GC(f32x4, cn + 5 * 2048 + i * 512 + lane * 8 + 4); } }
#pragma unroll
        for (int i = 0; i < 4; ++i) { const int c = i * 512 + lane * 8;
            if constexpr (OUTF32) { float* xout = (float*)xout_; *FX_GM(f32x4, xout + (size_t)t * 2048 + c) = (f32x4){yv[i * 8 + 0], yv[i * 8 + 1], yv[i * 8 + 2], yv[i * 8 + 3]};
                *FX_GM(f32x4, xout + (size_t)t * 2048 + c + 4) = (f32x4){yv[i * 8 + 4], yv[i * 8 + 5], yv[i * 8 + 6], yv[i * 8 + 7]}; }
            else { u32x4 xo; xo.x = cvt_pk_bf16(yv[i * 8 + 0], yv[i * 8 + 1]); xo.y = cvt_pk_bf16(yv[i * 8 + 2], yv[i * 8 + 3]); xo.z = cvt_pk_bf16(yv[i * 8 + 4], yv[i * 8 + 5]); xo.w = cvt_pk_bf16(yv[i * 8 + 6], yv[i * 8 + 7]);
                *FX_GM(u32x4, (bf16_t*)xout_ + (size_t)t * 2048 + c) = xo; } }
        if (coef_next) { ssx = wave_sum(ssx); const float rx = rsqrtf(ssx * (1.f / 2048.f) + EPS);
#pragma unroll
            for (int i = 0; i < 4; ++i) { const int c = i * 512 + lane * 8;
                float hv[8];
#pragma unroll
                for (int j = 0; j < 8; ++j) hv[j] = yv[i * 8 + j] * rx * ce[2 * i + (j >> 2)][j & 3] + cg[2 * i + (j >> 2)][j & 3];
#ifdef FX_WIN8
                u32x2 w; w.x = cvt_pk4_fp8(hv[0], hv[1], hv[2], hv[3]); w.y = cvt_pk4_fp8(hv[4], hv[5], hv[6], hv[7]);
                *FX_GM(u32x2, (unsigned char*)HA + (size_t)t * 2048 + c) = w; } }
#else
                u32x4 w; w.x = cvt_pk_bf16(hv[0], hv[1]); w.y = cvt_pk_bf16(hv[2], hv[3]); w.z = cvt_pk_bf16(hv[4], hv[5]); w.w = cvt_pk_bf16(hv[6], hv[7]);
                *FX_GM(u32x4, HA + (size_t)t * 2048 + c) = w; } }
#endif
    }
}
}
namespace fx {
#ifndef FX_SD_A
#define FX_SD_A 2
#endif
#ifndef FX_SD_B
#define FX_SD_B 1
#endif
#ifndef FX_NQR_B
#define FX_NQR_B 8
#endif
#define FX_SBAR() __builtin_amdgcn_sched_barrier(0)
__device__ __forceinline__ int crow(int r, int hi) { return (r & 3) + 8 * (r >> 2) + 4 * hi; }
__device__ __forceinline__ int v_st(int k, int c) { const int kk = (k & ~0xC) | ((k & 4) << 1) | ((k & 8) >> 1); return ((kk >> 3) * 4 + (c >> 5)) * 512 + ((kk & 7) * 32 + (c & 31)) * 2; }
__device__ __forceinline__ int v_rd_base(int lane) { return ((lane & 3) << 3) | (((lane >> 2) & 3) << 6) | (((lane >> 4) & 1) << 5) | (((lane >> 5) & 1) << 8); }
constexpr int v_rd_off(int d0, int ks, int half) { return d0 * 512 + ks * 4096 + half * 2048; }
template <int OFF> __device__ __forceinline__ s16x4 tr_read(int vb) { s16x4 r; asm volatile("ds_read_b64_tr_b16 %0, %1 offset:%2" : "=&v"(r) : "v"(vb), "i"(OFF) : "memory"); return r; }
#define FX_PK(L, H) (bf16x8){L[0], L[1], L[2], L[3], H[0], H[1], H[2], H[3]}
template <int D0> __device__ __forceinline__ void pv_one(f32x16& od, int vb, bf16x8 pa0, bf16x8 pa1, bf16x8 pa2, bf16x8 pa3) {
    const s16x4 l0 = tr_read<v_rd_off(D0, 0, 0)>(vb), h0 = tr_read<v_rd_off(D0, 0, 1)>(vb), l1 = tr_read<v_rd_off(D0, 1, 0)>(vb), h1 = tr_read<v_rd_off(D0, 1, 1)>(vb);
    const s16x4 l2 = tr_read<v_rd_off(D0, 2, 0)>(vb), h2 = tr_read<v_rd_off(D0, 2, 1)>(vb), l3 = tr_read<v_rd_off(D0, 3, 0)>(vb), h3 = tr_read<v_rd_off(D0, 3, 1)>(vb);
    asm volatile("s_waitcnt lgkmcnt(0)" ::: "memory"); FX_SBAR();
    od = __builtin_amdgcn_mfma_f32_32x32x16_bf16(pa0, FX_PK(l0, h0), od, 0, 0, 0);
    od = __builtin_amdgcn_mfma_f32_32x32x16_bf16(pa1, FX_PK(l1, h1), od, 0, 0, 0);
    od = __builtin_amdgcn_mfma_f32_32x32x16_bf16(pa2, FX_PK(l2, h2), od, 0, 0, 0);
    od = __builtin_amdgcn_mfma_f32_32x32x16_bf16(pa3, FX_PK(l3, h3), od, 0, 0, 0);
}
__device__ __forceinline__ void pv_d0(f32x16* o, int vb, bf16x8 pa0, bf16x8 pa1, bf16x8 pa2, bf16x8 pa3) {
    pv_one<0>(o[0], vb, pa0, pa1, pa2, pa3); pv_one<1>(o[1], vb, pa0, pa1, pa2, pa3); pv_one<2>(o[2], vb, pa0, pa1, pa2, pa3); pv_one<3>(o[3], vb, pa0, pa1, pa2, pa3);
}
#define FX_PK4(P, BASE, OUT) do { unsigned a0 = cvt_pk_bf16(P[BASE + 0], P[BASE + 1]), a1 = cvt_pk_bf16(P[BASE + 2], P[BASE + 3]);   \
    unsigned b0 = cvt_pk_bf16(P[BASE + 4], P[BASE + 5]), b1 = cvt_pk_bf16(P[BASE + 6], P[BASE + 7]);                              \
    auto r0 = __builtin_amdgcn_permlane32_swap(a0, b0, false, false); auto r1 = __builtin_amdgcn_permlane32_swap(a1, b1, false, false); \
    u32x4 w = {r0[0], r1[0], r0[1], r1[1]}; OUT = *reinterpret_cast<bf16x8*>(&w); } while (0)

template <int DQK> struct AttnC {
    static constexpr int NQ = DQK / 16, KROW = DQK * 2, SHM_V = 64 * 128 * 2, SHM_K = 64 * DQK * 2, NQR = (DQK == 128 ? 8 : FX_NQR_B)  , QX = (NQ - NQR) * 8 * 64 * 16, SHM = 2 * SHM_V + 2 * SHM_K + 8 * 64 * 4 + QX;
    static constexpr float SCALE = DQK == 128 ? 0.088388347648318440f : 0.072168783648703220f;
    static constexpr float THR = 8.f;
};
#define FX_KSWZ(row, colB) ((row) * C::KROW + ((colB) ^ (((row) & 7) << 4)))

template <int DQK> __device__ __forceinline__ void partialSM(f32x16& p0, f32x16& p1, float& m_reg, float& mn, float& alpha) {
    using C = AttnC<DQK>;
    constexpr float Cc = C::SCALE * 1.4426950408889634f;
    float pmax = p0[0];
#pragma unroll
    for (int r = 1; r < 16; ++r) pmax = fmaxf(pmax, p0[r]);
#pragma unroll
    for (int r = 0; r < 16; ++r) pmax = fmaxf(pmax, p1[r]);
    { auto rr = __builtin_amdgcn_permlane32_swap(__float_as_uint(pmax), __float_as_uint(pmax), false, false); pmax = fmaxf(__uint_as_float(rr[0]), __uint_as_float(rr[1])); }
    if (__builtin_expect(__all(pmax - m_reg <= C::THR / C::SCALE), 1)) { mn = m_reg; alpha = 1.f; }
    else { mn = fmaxf(m_reg, pmax); alpha = __builtin_amdgcn_exp2f((m_reg - mn) * Cc); m_reg = mn; }
    const float mnC = -mn * Cc;
#pragma unroll
    for (int r = 0; r < 16; ++r) p0[r] = fmaf(p0[r], Cc, mnC);
#pragma unroll
    for (int r = 0; r < 16; ++r) p1[r] = fmaf(p1[r], Cc, mnC);
#pragma unroll
    for (int r = 0; r < 16; ++r) p0[r] = __builtin_amdgcn_exp2f(p0[r]);
}
__device__ __forceinline__ void finishSM(f32x16& p0, f32x16& p1, float alpha, float& l_reg, bf16x8& pa0, bf16x8& pa1, bf16x8& pa2, bf16x8& pa3) {
#pragma unroll
    for (int r = 0; r < 16; ++r) p1[r] = __builtin_amdgcn_exp2f(p1[r]);
    float ps = 0;
#pragma unroll
    for (int r = 0; r < 16; ++r) ps += p0[r];
#pragma unroll
    for (int r = 0; r < 16; ++r) ps += p1[r];
    { auto rr = __builtin_amdgcn_permlane32_swap(__float_as_uint(ps), __float_as_uint(ps), false, false); ps = __uint_as_float(rr[0]) + __uint_as_float(rr[1]); }
    l_reg = l_reg * alpha + ps;
    FX_PK4(p0, 0, pa0); FX_PK4(p0, 8, pa1); FX_PK4(p1, 0, pa2); FX_PK4(p1, 8, pa3);
}
template <int DQK> __device__ __forceinline__ void qkt(f32x16& p0, f32x16& p1, const char* Ks, const bf16x8* qr, const char* qx  , int r32, int hi) {
    using C = AttnC<DQK>;
    p0 = f32x16{}; p1 = f32x16{};
#pragma unroll
    for (int d0 = 0; d0 < C::NQ; ++d0) { const int cb = (d0 * 16 + hi * 8) * 2;
        const bf16x8 qf = d0 < C::NQR ? qr[d0 < C::NQR ? d0 : 0] : *reinterpret_cast<const bf16x8*>(qx + (d0 - C::NQR) * 1024);
        const bf16x8 b0 = *reinterpret_cast<const bf16x8*>(Ks + FX_KSWZ(r32, cb));
        const bf16x8 b1 = *reinterpret_cast<const bf16x8*>(Ks + FX_KSWZ(32 + r32, cb));
        p0 = __builtin_amdgcn_mfma_f32_32x32x16_bf16(b0, qf, p0, 0, 0, 0);
        p1 = __builtin_amdgcn_mfma_f32_32x32x16_bf16(b1, qf, p1, 0, 0, 0); }
}

template <int DQK, int SD, int LDQ, int LDK1, int LDK2, int LDV>
__device__ __forceinline__ void attn_unit(const bf16_t* __restrict__ Qb, const bf16_t* __restrict__ K1, const bf16_t* __restrict__ K2, const bf16_t* __restrict__ Vh,
                                          bf16_t* __restrict__ Ob, const float* __restrict__ gain, int seq, char* lds, int tidp) {
    using C = AttnC<DQK>;
    int tid_ = tidp; asm volatile("" : "+v"(tid_));
    const int tid = tid_, wid = __builtin_amdgcn_readfirstlane(tid >> 6)  , lane = tid & 63, r32 = lane & 31, hi = lane >> 5;
    char* V_lds = lds; char* K_lds = lds + 2 * C::SHM_V;
    float* ws = (float*)(lds + 2 * C::SHM_V + 2 * C::SHM_K) + wid * 64; float* li_l = ws; float* al_l = ws + 32;
    float m_reg = -1e30f, l_reg = 0; f32x16 o[4] = {}; bf16x8 qr[C::NQR];
    char* qx = lds + 2 * C::SHM_V + 2 * C::SHM_K + 8 * 64 * 4 + wid * ((C::NQ - C::NQR) * 1024) + lane * 16;
    const bf16_t* Qw = Qb + (long)(wid * 32 + r32) * LDQ + hi * 8;
#pragma unroll
    for (int d0 = 0; d0 < C::NQR; ++d0) qr[d0] = *reinterpret_cast<const bf16x8*>(Qw + d0 * 16);
#pragma unroll
    for (int d0 = C::NQR; d0 < C::NQ; ++d0) *reinterpret_cast<bf16x8*>(qx + (d0 - C::NQR) * 1024) = *reinterpret_cast<const bf16x8*>(Qw + d0 * 16);
    const int sr = tid >> 4, sc = (tid & 15) * 8, vst0 = v_st(sr, sc), vst1 = v_st(32 + sr, sc);
    const int vb0 = (int)(uintptr_t)V_lds + v_rd_base(lane);
    const int xr = tid >> 3, xc = (tid & 7) * 8;
    struct { bf16x8 vs0, vs1, ks0, ks1, kx; } sr_[SD];
#define FX_SLOAD(i, k0) do { sr_[i].vs0 = *reinterpret_cast<const bf16x8*>(&Vh[(long)((k0) + sr) * LDV + sc]); sr_[i].vs1 = *reinterpret_cast<const bf16x8*>(&Vh[(long)((k0) + 32 + sr) * LDV + sc]); \
    sr_[i].ks0 = *reinterpret_cast<const bf16x8*>(&K1[(long)((k0) + sr) * LDK1 + sc]); sr_[i].ks1 = *reinterpret_cast<const bf16x8*>(&K1[(long)((k0) + 32 + sr) * LDK1 + sc]); \
    if (DQK == 192) sr_[i].kx = *reinterpret_cast<const bf16x8*>(&K2[(long)((k0) + xr) * LDK2 + xc]); } while (0)
#define FX_SWRITE(b, i) do { *(bf16x8*)(V_lds + (b) * C::SHM_V + vst0) = sr_[i].vs0; *(bf16x8*)(V_lds + (b) * C::SHM_V + vst1) = sr_[i].vs1; const int kc = sc * 2; \
    *(bf16x8*)(K_lds + (b) * C::SHM_K + FX_KSWZ(sr, kc)) = sr_[i].ks0; *(bf16x8*)(K_lds + (b) * C::SHM_K + FX_KSWZ(32 + sr, kc)) = sr_[i].ks1; \
    if (DQK == 192) *(bf16x8*)(K_lds + (b) * C::SHM_K + FX_KSWZ(xr, 256 + xc * 2)) = sr_[i].kx; } while (0)
#define FX_SWAIT() do { if (SD == 1) asm volatile("s_waitcnt vmcnt(0)" ::: "memory"); else if (DQK == 192) asm volatile("s_waitcnt vmcnt(5)" ::: "memory"); else asm volatile("s_waitcnt vmcnt(4)" ::: "memory"); } while (0)
#define FX_RESC(a) do { if (__any((a) < 1.f)) { if (hi == 0) al_l[r32] = (a); asm volatile("s_waitcnt lgkmcnt(0)" ::: "memory"); \
    _Pragma("unroll") for (int d = 0; d < 4; ++d) _Pragma("unroll") for (int r = 0; r < 16; ++r) o[d][r] *= al_l[crow(r, hi)]; } } while (0)
    f32x16 pA0, pA1, pB0, pB1; float mnA, mnB, alA, alB; bf16x8 pa0, pa1, pa2, pa3; const int NT = seq / 64;
    constexpr int SE = 0, SO = SD - 1;
    FX_SLOAD(SE, 0); asm volatile("s_waitcnt vmcnt(0)" ::: "memory"); FX_SWRITE(0, SE); __syncthreads();
    qkt<DQK>(pA0, pA1, K_lds, qr, qx, r32, hi); partialSM<DQK>(pA0, pA1, m_reg, mnA, alA);
    FX_SLOAD(SO, 64); if (SD == 2) { if (2 < NT) FX_SLOAD(SE, 128); }
    FX_SWAIT(); FX_SWRITE(1, SO); __syncthreads();
    for (int j = 1; j + 1 < NT; j += 2) {
        FX_SBAR(); qkt<DQK>(pB0, pB1, K_lds + C::SHM_K, qr, qx, r32, hi);
        finishSM(pA0, pA1, alA, l_reg, pa0, pa1, pa2, pa3); FX_SBAR();
        FX_SLOAD(SO, (j + SD) * 64); FX_SBAR();
        pv_d0(o, vb0, pa0, pa1, pa2, pa3); partialSM<DQK>(pB0, pB1, m_reg, mnB, alB);
        __syncthreads(); FX_SWAIT(); FX_SWRITE(0, SE);
        FX_RESC(alB); __syncthreads();
        FX_SBAR(); qkt<DQK>(pA0, pA1, K_lds, qr, qx, r32, hi);
        finishSM(pB0, pB1, alB, l_reg, pa0, pa1, pa2, pa3); FX_SBAR();
        if (SD == 1 || j + 3 < NT) FX_SLOAD(SE, (j + 1 + SD) * 64); FX_SBAR();
        pv_d0(o, vb0 + C::SHM_V, pa0, pa1, pa2, pa3); partialSM<DQK>(pA0, pA1, m_reg, mnA, alA);
        __syncthreads(); FX_SWAIT(); FX_SWRITE(1, SO);
        FX_RESC(alA); __syncthreads();
    }
    FX_SBAR(); qkt<DQK>(pB0, pB1, K_lds + C::SHM_K, qr, qx, r32, hi);
    finishSM(pA0, pA1, alA, l_reg, pa0, pa1, pa2, pa3); FX_SBAR();
    pv_d0(o, vb0, pa0, pa1, pa2, pa3); partialSM<DQK>(pB0, pB1, m_reg, mnB, alB);
    __syncthreads(); FX_RESC(alB);
    finishSM(pB0, pB1, alB, l_reg, pa0, pa1, pa2, pa3); FX_SBAR();
    pv_d0(o, vb0 + C::SHM_V, pa0, pa1, pa2, pa3);
    if (hi == 0) li_l[r32] = l_reg; asm volatile("s_waitcnt lgkmcnt(0)" ::: "memory");
    int r32e = r32; asm volatile("" : "+v"(r32e));
    float g4[4];
#pragma unroll
    for (int d0 = 0; d0 < 4; ++d0) g4[d0] = gain[d0 * 32 + r32e];
    bf16_t* Ow = Ob + (long)(wid * 32) * 2048;
#pragma unroll
    for (int r = 0; r < 16; ++r) { const float rl = __builtin_amdgcn_rcpf(li_l[crow(r, hi)]);
        float ss = 0.f;
#pragma unroll
        for (int d0 = 0; d0 < 4; ++d0) { o[d0][r] *= rl; ss += o[d0][r] * o[d0][r]; }
        ss += __shfl_xor(ss, 1); ss += __shfl_xor(ss, 2); ss += __shfl_xor(ss, 4); ss += __shfl_xor(ss, 8); ss += __shfl_xor(ss, 16);
        const float rn = rsqrtf(ss * (1.f / 128.f) + EPS); const int orow = crow(r, hi);
#pragma unroll
#ifdef FX_WOUT8
        for (int d0 = 0; d0 < 4; ++d0) ((unsigned char*)Ob)[(long)(wid * 32 + orow) * 2048 + d0 * 32 + r32e] = (unsigned char)(__builtin_amdgcn_cvt_pk_fp8_f32(o[d0][r] * rn * g4[d0], 0.f, 0, false) & 0xff); }
#else
        for (int d0 = 0; d0 < 4; ++d0) Ow[(long)orow * 2048 + d0 * 32 + r32e] = f2bf(o[d0][r] * rn * g4[d0]); }
#endif
    __syncthreads();
#undef FX_SLOAD
#undef FX_SWRITE
#undef FX_SWAIT
#undef FX_RESC
}

__device__ __forceinline__ void attn_gqa_unit(int u, const bf16_t* QA, const bf16_t* KA, const bf16_t* PROJ, bf16_t* YM, const float* hog, char* lds, int tidp) {
    const int qb = u & 15, hh = (u >> 4) % 6, b = u / 96, kvh = hh / 3;
    const size_t t0 = (size_t)b * S;
    attn_unit<128, FX_SD_A, 768, 256, 0, PW>(QA + (t0 + qb * 256) * 768 + hh * 128, KA + t0 * 256 + kvh * 128, nullptr, PROJ + t0 * PW + O_AV + kvh * 128,
#ifdef FX_WOUT8
                                    (bf16_t*)((unsigned char*)YM + (t0 + qb * 256) * 2048 + hh * 128), hog + hh * 128, S, lds, tidp);
#else
                                    YM + (t0 + qb * 256) * 2048 + hh * 128, hog + hh * 128, S, lds, tidp);
#endif
}
__device__ __forceinline__ void attn_mla_unit(int u, const bf16_t* QB, const bf16_t* KVB, const bf16_t* KR, bf16_t* YM, const float* hog, char* lds, int tidp) {
    const int qb = u & 15, hh = (u >> 4) % 6, b = u / 96;
    const size_t t0 = (size_t)b * S;
    attn_unit<192, FX_SD_B, 1280, 1536, 64, 1536>(QB + (t0 + qb * 256) * 1280 + hh * 192, KVB + t0 * 1536 + hh * 256, KR + t0 * 64, KVB + t0 * 1536 + hh * 256 + 128,
#ifdef FX_WOUT8
                                         (bf16_t*)((unsigned char*)YM + (t0 + qb * 256) * 2048 + 768 + hh * 128), hog + 768 + hh * 128, S, lds, tidp);
#else
                                         YM + (t0 + qb * 256) * 2048 + 768 + hh * 128, hog + 768 + hh * 128, S, lds, tidp);
#endif
}
}
namespace fx {
constexpr int P3_LDS = 4096 + 2048 + 65536 + 32768;
constexpr float KSCALE = 0.08838834764831845f;
__device__ __forceinline__ float logsigmoid_f(float f) { return fminf(f, 0.f) - log1pf(__expf(-fabsf(f))); }
__device__ __forceinline__ float wave_scan_incl(float v, int lane) {
#pragma unroll
    for (int o = 1; o < 64; o <<= 1) { const float t = __shfl_up(v, o); if (lane >= o) v += t; }
    return v;
}
__device__ __forceinline__ float wave_scanmax_incl(float v, int lane) {
#pragma unroll
    for (int o = 1; o < 64; o <<= 1) { const float t = __shfl_up(v, o); if (lane >= o) v = fmaxf(v, t); }
    return v;
}
__device__ __forceinline__ float wave_rscanmax_incl(float v, int lane) {
#pragma unroll
    for (int o = 1; o < 64; o <<= 1) { const float t = __shfl_down(v, o); if (lane + o < 64) v = fmaxf(v, t); }
    return v;
}

struct P3Args {
    const bf16_t* PROJ; const float* GATES; const float* gate_b; const float* conv_w; const float* conv_b;
    const float* aq_gain; const float* ak_gain; const float* cq_gain; const float* ckv_gain;
    const float* cosA; const float* sinA; const float* cosB; const float* sinB;
    bf16_t* QA; bf16_t* KA; bf16_t* CQN; bf16_t* CKVN; bf16_t* KR; bf16_t* QC; bf16_t* KC; bf16_t* KCT; float* NLOC; float* GSC;
};
__device__ __forceinline__ void p3_phase(FX_LAS unsigned char* lds_, const P3Args& a, int wg, int nwg, int tidp) {
    char* lds = (char*)lds_;
    float* gat = (float*)lds; float* wts = (float*)(lds + 4096); char* ktile = lds + 6144; char* wv = lds + 6144 + 65536;
    for (int unit = wg; unit < T / 64; unit += nwg) {
        int tid_ = tidp; asm volatile("" : "+v"(tid_));
        const int tid = tid_, wid = tid >> 6, lane = tid & 63;
        const int b = unit >> 6, co = unit & 63; const size_t t0 = (size_t)unit * 64;
        for (int i = tid; i < 1024; i += 512) gat[i] = a.GATES[t0 * 16 + i] + a.gate_b[i & 15];
        __syncthreads();
        { const int dir = wid >> 2, h = wid & 3;
          const float logi = gat[lane * 16 + (dir * 2) * 4 + h], logf = logsigmoid_f(gat[lane * 16 + (dir * 2 + 1) * 4 + h]);
          const float pre = wave_scan_incl(logf, lane), g = __shfl(pre, 63);
          const float bb = dir ? (g - pre + logf) : pre;
          const float av = g - bb + logi, mloc = wave_max(av);
          wts[wid * 64 + lane] = __expf(av - mloc);
          if (lane == 0) { const int chain = (b * 4 + h) * 2 + dir, ci = dir ? 63 - co : co; a.GSC[(chain * 64 + ci) * 2] = g; a.GSC[(chain * 64 + ci) * 2 + 1] = mloc; } }
        __syncthreads();
        { const int c0 = 2 * tid; const bool isk = c0 >= 512; const int hk = (c0 - 512) >> 7, dk = (c0 - 512) & 127;
          float w0[5], w1[5];
#pragma unroll
          for (int j = 0; j < 5; ++j) { w0[j] = a.conv_w[j * 1024 + c0]; w1[j] = a.conv_w[j * 1024 + c0 + 1]; }
          const float cb0 = a.conv_b[c0], cb1 = a.conv_b[c0 + 1];
          float x0[5], x1[5];
          const bf16_t* src = a.PROJ + t0 * PW + O_CQ + c0;
#pragma unroll
          for (int j = 0; j < 4; ++j) { const int sa = co * 64 + j - 2; unsigned w = 0u; if (sa >= 0 && sa < S) w = *(const unsigned*)(src + (long)(j - 2) * PW); x0[j + 1] = bflo(w); x1[j + 1] = bfhi(w); }
          float nf0 = 0.f, nf1 = 0.f, nb0 = 0.f, nb1 = 0.f;
#pragma unroll 1
          for (int s0 = 0; s0 < 64; s0 += 16) {
              unsigned wl[16];
#pragma unroll
              for (int q = 0; q < 16; ++q) { const int sa = co * 64 + s0 + q + 2; wl[q] = 0u; if (sa < S) wl[q] = *(const unsigned*)(src + (long)(s0 + q + 2) * PW); }
#pragma unroll
              for (int q = 0; q < 16; ++q) { const int s = s0 + q;
#pragma unroll
                  for (int j = 0; j < 4; ++j) { x0[j] = x0[j + 1]; x1[j] = x1[j + 1]; }
                  x0[4] = bflo(wl[q]); x1[4] = bfhi(wl[q]);
                  float y0 = cb0, y1 = cb1;
#pragma unroll
                  for (int j = 0; j < 5; ++j) { y0 += w0[j] * x0[j]; y1 += w1[j] * x1[j]; }
                  y0 = silu_f(y0); y1 = silu_f(y1);
                  if (!isk) { *(unsigned*)(a.QC + (t0 + s) * 512 + c0) = cvt_pk_bf16(y0, y1); }
                  else { y0 *= KSCALE; y1 *= KSCALE; const unsigned pk = cvt_pk_bf16(y0, y1);
                      *(unsigned*)(a.KC + (t0 + s) * 512 + (c0 - 512)) = pk;
                      *(unsigned*)(ktile + hk * 16384 + v_st(s, dk & ~7) + (dk & 7) * 2) = pk;
                      const float k0 = bflo(pk), k1 = bfhi(pk); const float wf = wts[hk * 64 + s], wb = wts[(4 + hk) * 64 + s];
                      nf0 += wf * k0; nf1 += wf * k1; nb0 += wb * k0; nb1 += wb * k1; } }
          }
          if (isk) { const int chf = (b * 4 + hk) * 2, chb = chf + 1;
              *(f32x2*)(a.NLOC + ((size_t)chf * 64 + co) * 128 + dk) = (f32x2){nf0, nf1};
              *(f32x2*)(a.NLOC + ((size_t)chb * 64 + (63 - co)) * 128 + dk) = (f32x2){nb0, nb1}; } }
        __syncthreads();
#pragma unroll 1
        for (int h = 0; h < 4; ++h) {
            { const int sr = tid >> 4, sc = (tid & 15) * 8;
#pragma unroll
              for (int rr = 0; rr < 2; ++rr) { const int s = sr + 32 * rr;
                const u32x4 vw = *(const u32x4*)(a.PROJ + (t0 + s) * PW + O_CV + h * 128 + sc);
                const float wf = wts[h * 64 + s], wb = wts[(4 + h) * 64 + s];
                float v[8] = {bflo(vw.x), bfhi(vw.x), bflo(vw.y), bfhi(vw.y), bflo(vw.z), bfhi(vw.z), bflo(vw.w), bfhi(vw.w)};
                u32x4 of, ob;
                of.x = cvt_pk_bf16(v[0] * wf, v[1] * wf); of.y = cvt_pk_bf16(v[2] * wf, v[3] * wf); of.z = cvt_pk_bf16(v[4] * wf, v[5] * wf); of.w = cvt_pk_bf16(v[6] * wf, v[7] * wf);
                ob.x = cvt_pk_bf16(v[0] * wb, v[1] * wb); ob.y = cvt_pk_bf16(v[2] * wb, v[3] * wb); ob.z = cvt_pk_bf16(v[4] * wb, v[5] * wb); ob.w = cvt_pk_bf16(v[6] * wb, v[7] * wb);
                *(u32x4*)(wv + v_st(s, sc)) = of; *(u32x4*)(wv + 16384 + v_st(s, sc)) = ob; } }
            __syncthreads();
            { const int dir = wid >> 2, mb = wid & 3, r32 = lane & 31, hi = lane >> 5;
              const int va = (int)(uintptr_t)(wv + dir * 16384) + v_rd_base(lane) + mb * 512;
              const int kb = (int)(uintptr_t)(ktile + h * 16384) + v_rd_base(lane);
              f32x16 acc[4] = {};
#define FX_KC_STEP(KS) do { \
              const s16x4 al = tr_read<v_rd_off(0, KS, 0)>(va), ah = tr_read<v_rd_off(0, KS, 1)>(va); \
              const s16x4 b0l = tr_read<v_rd_off(0, KS, 0)>(kb), b0h = tr_read<v_rd_off(0, KS, 1)>(kb), b1l = tr_read<v_rd_off(1, KS, 0)>(kb), b1h = tr_read<v_rd_off(1, KS, 1)>(kb); \
              const s16x4 b2l = tr_read<v_rd_off(2, KS, 0)>(kb), b2h = tr_read<v_rd_off(2, KS, 1)>(kb), b3l = tr_read<v_rd_off(3, KS, 0)>(kb), b3h = tr_read<v_rd_off(3, KS, 1)>(kb); \
              asm volatile("s_waitcnt lgkmcnt(0)" ::: "memory"); FX_SBAR(); \
              const bf16x8 af = FX_PK(al, ah); \
              acc[0] = __builtin_amdgcn_mfma_f32_32x32x16_bf16(af, FX_PK(b0l, b0h), acc[0], 0, 0, 0); acc[1] = __builtin_amdgcn_mfma_f32_32x32x16_bf16(af, FX_PK(b1l, b1h), acc[1], 0, 0, 0); \
              acc[2] = __builtin_amdgcn_mfma_f32_32x32x16_bf16(af, FX_PK(b2l, b2h), acc[2], 0, 0, 0); acc[3] = __builtin_amdgcn_mfma_f32_32x32x16_bf16(af, FX_PK(b3l, b3h), acc[3], 0, 0, 0); } while (0)
              FX_KC_STEP(0); FX_KC_STEP(1); FX_KC_STEP(2); FX_KC_STEP(3);
#undef FX_KC_STEP
              const int chain = (b * 4 + h) * 2 + dir, ci = dir ? 63 - co : co;
              bf16_t* dst = a.KCT + ((size_t)chain * 64 + ci) * 16384 + (size_t)(mb * 32) * 128 + r32;
#pragma unroll
              for (int r = 0; r < 16; ++r) { const int v = crow(r, hi);
#pragma unroll
                  for (int nb = 0; nb < 4; ++nb) dst[v * 128 + nb * 32] = f2bf(acc[nb][r]); } }
            __syncthreads();
        }
        { const int hd = __builtin_amdgcn_readfirstlane(wid), l16 = lane & 15, tq = lane >> 4, e0 = 8 * l16, hf = e0 >> 6, f0 = e0 & 31; const bool second = (e0 & 32) != 0;
          const float* g = hd < 6 ? a.aq_gain : a.ak_gain;
          const f32x4 g0 = *(const f32x4*)(g + e0), g1 = *(const f32x4*)(g + e0 + 4);
#pragma unroll 4
          for (int p = 0; p < 16; ++p) { const int s = 4 * p + tq; const size_t t = t0 + s;
            const u32x4 xw = *(const u32x4*)(a.PROJ + t * PW + hd * 128 + e0);
            const int pos = hf ? s : co;
            const f32x4 c0 = *(const f32x4*)(a.cosA + pos * 32 + f0), c1 = *(const f32x4*)(a.cosA + pos * 32 + f0 + 4), s0 = *(const f32x4*)(a.sinA + pos * 32 + f0), s1 = *(const f32x4*)(a.sinA + pos * 32 + f0 + 4);
            float x[8] = {bflo(xw.x), bfhi(xw.x), bflo(xw.y), bfhi(xw.y), bflo(xw.z), bfhi(xw.z), bflo(xw.w), bfhi(xw.w)};
            float ss = 0.f;
#pragma unroll
            for (int j = 0; j < 8; ++j) ss += x[j] * x[j];
            ss += __shfl_xor(ss, 1); ss += __shfl_xor(ss, 2); ss += __shfl_xor(ss, 4); ss += __shfl_xor(ss, 8);
            const float r = rsqrtf(ss * (1.f / 128.f) + EPS);
            float o[8];
#pragma unroll
            for (int j = 0; j < 8; ++j) { x[j] *= r * (j < 4 ? g0[j & 3] : g1[j & 3]); }
#pragma unroll
            for (int j = 0; j < 8; ++j) { const float y = __shfl_xor(x[j], 4), cs = j < 4 ? c0[j & 3] : c1[j & 3], sn = j < 4 ? s0[j & 3] : s1[j & 3]; o[j] = second ? (x[j] * cs + y * sn) : (x[j] * cs - y * sn); }
            u32x4 w; w.x = cvt_pk_bf16(o[0], o[1]); w.y = cvt_pk_bf16(o[2], o[3]); w.z = cvt_pk_bf16(o[4], o[5]); w.w = cvt_pk_bf16(o[6], o[7]);
            bf16_t* dst = hd < 6 ? a.QA + t * 768 + hd * 128 + e0 : a.KA + t * 256 + (hd - 6) * 128 + e0;
            *(u32x4*)dst = w; } }
#pragma unroll 4
        for (int s = wid; s < 64; s += 8) { const size_t t = t0 + s; const bf16_t* p = a.PROJ + t * PW;
            float q[6]; float ss = 0.f;
#pragma unroll
            for (int i = 0; i < 3; ++i) { const unsigned w = *(const unsigned*)(p + O_BCQ + i * 128 + lane * 2); q[2 * i] = bflo(w); q[2 * i + 1] = bfhi(w); ss += q[2 * i] * q[2 * i] + q[2 * i + 1] * q[2 * i + 1]; }
            ss = wave_sum(ss); float r = rsqrtf(ss * (1.f / 384.f) + EPS);
#pragma unroll
            for (int i = 0; i < 3; ++i) { const int c = i * 128 + lane * 2; *(unsigned*)(a.CQN + t * 384 + c) = cvt_pk_bf16(q[2 * i] * r * a.cq_gain[c], q[2 * i + 1] * r * a.cq_gain[c + 1]); }
            float kv[4]; ss = 0.f;
#pragma unroll
            for (int i = 0; i < 2; ++i) { const unsigned w = *(const unsigned*)(p + O_BCKV + i * 128 + lane * 2); kv[2 * i] = bflo(w); kv[2 * i + 1] = bfhi(w); ss += kv[2 * i] * kv[2 * i] + kv[2 * i + 1] * kv[2 * i + 1]; }
            ss = wave_sum(ss); r = rsqrtf(ss * (1.f / 256.f) + EPS);
#pragma unroll
            for (int i = 0; i < 2; ++i) { const int c = i * 128 + lane * 2; *(unsigned*)(a.CKVN + t * 256 + c) = cvt_pk_bf16(kv[2 * i] * r * a.ckv_gain[c], kv[2 * i + 1] * r * a.ckv_gain[c + 1]); }
            if (lane < 32) { const int f = lane & 15, hf = lane >> 4; const int pos = hf ? s : co; const float cs = a.cosB[pos * 16 + f], sn = a.sinB[pos * 16 + f];
                const float x1 = bf2f(p[O_BKR + hf * 32 + f]), x2 = bf2f(p[O_BKR + hf * 32 + 16 + f]);
                a.KR[t * 64 + hf * 32 + f] = f2bf(x1 * cs - x2 * sn); a.KR[t * 64 + hf * 32 + 16 + f] = f2bf(x2 * cs + x1 * sn); } }
        __syncthreads();
    }
}

__device__ __forceinline__ void scan_phase(const bf16_t* KCT, const float* NLOC, const float* GSC, bf16_t* CPREV, float* NPREV, float* MPREV, int gtid, int nthr) {
    for (int item = gtid; item < 32 * 4096; item += nthr) {
        const int chain = item >> 12, e4 = item & 4095;
        const u32x2* src = (const u32x2*)(KCT + (size_t)chain * 64 * 16384) + e4; u32x2* dst = (u32x2*)(CPREV + (size_t)chain * 64 * 16384) + e4;
        const float* gs = GSC + (size_t)chain * 128;
        const bool don = e4 < 128;
        float c0 = 0.f, c1 = 0.f, c2 = 0.f, c3 = 0.f, nn = 0.f, m = 0.f;
#pragma unroll 1
        for (int cb = 0; cb < 64; cb += 8) {
            u32x2 kc[8]; float nl[8];
#pragma unroll
            for (int j = 0; j < 8; ++j) { kc[j] = src[(size_t)(cb + j) * 4096]; nl[j] = don ? NLOC[((size_t)chain * 64 + cb + j) * 128 + e4] : 0.f; }
#pragma unroll
            for (int j = 0; j < 8; ++j) { const int ci = cb + j; const float g = gs[ci * 2], ml = gs[ci * 2 + 1];
                u32x2 o; o.x = cvt_pk_bf16(c0, c1); o.y = cvt_pk_bf16(c2, c3); dst[(size_t)ci * 4096] = o;
                if (don) NPREV[((size_t)chain * 64 + ci) * 128 + e4] = nn;
                if (e4 == 0) MPREV[chain * 64 + ci] = m;
                const float mn = fmaxf(g + m, ml), dec = __expf(g + m - mn), sl = __expf(ml - mn); m = mn;
                c0 = dec * c0 + sl * bflo(kc[j].x); c1 = dec * c1 + sl * bfhi(kc[j].x); c2 = dec * c2 + sl * bflo(kc[j].y); c3 = dec * c3 + sl * bfhi(kc[j].y);
                nn = dec * nn + sl * nl[j]; }
        }
    }
}

constexpr int MC_K = 0, MC_V = 16384, MC_CT = 32768, MC_HS = 98304, MC_HS_LD = 132, MC_SM = MC_HS + 64 * MC_HS_LD * 4, MC_LDS = MC_SM + 4096;
struct McArgs { const bf16_t* PROJ; const float* GATES; const float* gate_b; const bf16_t* QC; const bf16_t* KC; const bf16_t* CPREV; const float* NPREV; const float* MPREV; const float* hog; bf16_t* YM; };
__device__ __forceinline__ void mlstm_c_phase(FX_LAS unsigned char* lds_, const McArgs& a, int wg, int nwg, int tidp) {
    char* lds = (char*)lds_;
    using C = AttnC<128>;
    float* hs = (float*)(lds + MC_HS);
    float* sm = (float*)(lds + MC_SM);
    for (int unit = wg; unit < NB * 4 * 64; unit += nwg) {
        int tid_ = tidp; asm volatile("" : "+v"(tid_));
        const int tid = tid_, wid = tid >> 6, lane = tid & 63, r32 = lane & 31, hi = lane >> 5;
        const int co = unit & 63, h = (unit >> 6) & 3, b = unit >> 8; const size_t t0 = (size_t)b * S + co * 64;
        if (wid < 2) { const int dir = wid; const int chain = (b * 4 + h) * 2 + dir, ci = dir ? 63 - co : co;
            const float logi = a.GATES[(t0 + lane) * 16 + (dir * 2) * 4 + h] + a.gate_b[(dir * 2) * 4 + h];
            const float logf = logsigmoid_f(a.GATES[(t0 + lane) * 16 + (dir * 2 + 1) * 4 + h] + a.gate_b[(dir * 2 + 1) * 4 + h]);
            const float pre = wave_scan_incl(logf, lane), g = __shfl(pre, 63);
            const float bb = dir ? (g - pre + logf) : pre;
            const float u = logi - bb;
            const float M = dir ? wave_rscanmax_incl(u, lane) : wave_scanmax_incl(u, lane);
            const float mp = a.MPREV[chain * 64 + ci], mmj = fmaxf(mp, M);
            sm[dir * 64 + lane] = u; sm[128 + dir * 64 + lane] = mmj; sm[256 + dir * 64 + lane] = __expf(mp - mmj); sm[384 + dir * 64 + lane] = __expf(-(bb + mmj));
            sm[512 + dir * 128 + lane] = a.NPREV[((size_t)chain * 64 + ci) * 128 + lane]; sm[512 + dir * 128 + 64 + lane] = a.NPREV[((size_t)chain * 64 + ci) * 128 + 64 + lane]; }
        { const int sr = tid >> 4, sc = (tid & 15) * 8;
#pragma unroll
          for (int rr = 0; rr < 2; ++rr) { const int s = sr + 32 * rr;
            *(bf16x8*)(lds + MC_K + FX_KSWZ(s, sc * 2)) = *(const bf16x8*)(a.KC + (t0 + s) * 512 + h * 128 + sc);
            *(bf16x8*)(lds + MC_V + v_st(s, sc)) = *(const bf16x8*)(a.PROJ + (t0 + s) * PW + O_CV + h * 128 + sc); }
#pragma unroll
          for (int dir = 0; dir < 2; ++dir) { const int chain = (b * 4 + h) * 2 + dir, ci = dir ? 63 - co : co; const bf16_t* ct = a.CPREV + ((size_t)chain * 64 + ci) * 16384;
#pragma unroll
            for (int rr = 0; rr < 4; ++rr) { const int v = sr + 32 * rr; *(bf16x8*)(lds + MC_CT + dir * 32768 + FX_KSWZ(v, sc * 2)) = *(const bf16x8*)(ct + v * 128 + sc); } } }
        __syncthreads();
        { const int dir = wid >> 2, rb = (wid >> 1) & 1, cb = wid & 1, j = rb * 32 + r32;
          bf16x8 qr[8];
          const bf16_t* Qw = a.QC + (t0 + j) * 512 + h * 128 + hi * 8;
#pragma unroll
          for (int d0 = 0; d0 < 8; ++d0) qr[d0] = *reinterpret_cast<const bf16x8*>(Qw + d0 * 16);
          f32x16 p0, p1;
          qkt<128>(p0, p1, lds + MC_K, qr, nullptr, r32, hi);
          const float mmj = sm[128 + dir * 64 + j], inter = sm[256 + dir * 64 + j], emn = sm[384 + dir * 64 + j];
          float dsum = 0.f;
#pragma unroll
          for (int r = 0; r < 16; ++r) { const int s0 = crow(r, hi), s1 = 32 + s0;
              const bool v0 = dir ? (s0 >= j) : (s0 <= j), v1 = dir ? (s1 >= j) : (s1 <= j);
              const float w0 = v0 ? __expf(sm[dir * 64 + s0] - mmj) : 0.f, w1 = v1 ? __expf(sm[dir * 64 + s1] - mmj) : 0.f;
              p0[r] *= w0; p1[r] *= w1; dsum += p0[r] + p1[r]; }
          float qn = 0.f;
#pragma unroll
          for (int d0 = 0; d0 < 8; ++d0) { const float* np = sm + 512 + dir * 128 + d0 * 16 + hi * 8; const u32x4 w = *reinterpret_cast<const u32x4*>(&qr[d0]);
              qn += bflo(w.x) * np[0] + bfhi(w.x) * np[1] + bflo(w.y) * np[2] + bfhi(w.y) * np[3] + bflo(w.z) * np[4] + bfhi(w.z) * np[5] + bflo(w.w) * np[6] + bfhi(w.w) * np[7]; }
          { auto rr = __builtin_amdgcn_permlane32_swap(__float_as_uint(dsum), __float_as_uint(dsum), false, false); dsum = __uint_as_float(rr[0]) + __uint_as_float(rr[1]); }
          { auto rr = __builtin_amdgcn_permlane32_swap(__float_as_uint(qn), __float_as_uint(qn), false, false); qn = __uint_as_float(rr[0]) + __uint_as_float(rr[1]); }
          const float den = dsum + inter * qn;
          if (hi == 0) sm[768 + wid * 32 + r32] = 1.f / fmaxf(fabsf(den), emn);
          bf16x8 pa0, pa1, pa2, pa3;
          FX_PK4(p0, 0, pa0); FX_PK4(p0, 8, pa1); FX_PK4(p1, 0, pa2); FX_PK4(p1, 8, pa3);
          f32x16 o[2] = {};
          const int vb = (int)(uintptr_t)(lds + MC_V) + v_rd_base(lane) + cb * 1024;
          pv_one<0>(o[0], vb, pa0, pa1, pa2, pa3); pv_one<1>(o[1], vb, pa0, pa1, pa2, pa3);
          const char* ctb = lds + MC_CT + dir * 32768;
#pragma unroll
          for (int ks = 0; ks < 8; ++ks) { const u32x4 w = *reinterpret_cast<const u32x4*>(&qr[ks]); u32x4 sq;
              sq.x = cvt_pk_bf16(bflo(w.x) * inter, bfhi(w.x) * inter); sq.y = cvt_pk_bf16(bflo(w.y) * inter, bfhi(w.y) * inter); sq.z = cvt_pk_bf16(bflo(w.z) * inter, bfhi(w.z) * inter); sq.w = cvt_pk_bf16(bflo(w.w) * inter, bfhi(w.w) * inter);
              const bf16x8 qs = *reinterpret_cast<const bf16x8*>(&sq); const int colB = (ks * 16 + hi * 8) * 2;
              const bf16x8 c0f = *reinterpret_cast<const bf16x8*>(ctb + FX_KSWZ((2 * cb) * 32 + r32, colB));
              const bf16x8 c1f = *reinterpret_cast<const bf16x8*>(ctb + FX_KSWZ((2 * cb + 1) * 32 + r32, colB));
              o[0] = __builtin_amdgcn_mfma_f32_32x32x16_bf16(qs, c0f, o[0], 0, 0, 0);
              o[1] = __builtin_amdgcn_mfma_f32_32x32x16_bf16(qs, c1f, o[1], 0, 0, 0); }
          asm volatile("s_waitcnt lgkmcnt(0)" ::: "memory");
          float rd[16];
#pragma unroll
          for (int r = 0; r < 16; ++r) rd[r] = sm[768 + wid * 32 + crow(r, hi)];
          if (dir == 0) {
#pragma unroll
              for (int r = 0; r < 16; ++r) { const int row = rb * 32 + crow(r, hi);
                  hs[row * MC_HS_LD + (2 * cb) * 32 + r32] = o[0][r] * rd[r]; hs[row * MC_HS_LD + (2 * cb + 1) * 32 + r32] = o[1][r] * rd[r]; } }
          __syncthreads();
          if (dir == 1) {
#pragma unroll
              for (int r = 0; r < 16; ++r) { const int row = rb * 32 + crow(r, hi);
                  hs[row * MC_HS_LD + (2 * cb) * 32 + r32] += o[0][r] * rd[r]; hs[row * MC_HS_LD + (2 * cb + 1) * 32 + r32] += o[1][r] * rd[r]; } }
          __syncthreads(); }
        { const int row = tid >> 3, c0 = (tid & 7) * 16; const size_t t = t0 + row;
          float v[16]; float ss = 0.f;
#pragma unroll
          for (int i = 0; i < 16; ++i) { v[i] = hs[row * MC_HS_LD + c0 + i]; ss += v[i] * v[i]; }
          ss += __shfl_xor(ss, 1); ss += __shfl_xor(ss, 2); ss += __shfl_xor(ss, 4);
          const float rn = rsqrtf(ss * (1.f / 128.f) + EPS);
          const bf16_t* og = a.PROJ + t * PW + O_CO + h * 128 + c0; const float* gn = a.hog + 1536 + h * 128 + c0;
          const u32x4 g0 = *(const u32x4*)og, g1 = *(const u32x4*)(og + 8);
          const float gg[16] = {bflo(g0.x), bfhi(g0.x), bflo(g0.y), bfhi(g0.y), bflo(g0.z), bfhi(g0.z), bflo(g0.w), bfhi(g0.w), bflo(g1.x), bfhi(g1.x), bflo(g1.y), bfhi(g1.y), bflo(g1.z), bfhi(g1.z), bflo(g1.w), bfhi(g1.w)};
          float ov[16];
#pragma unroll
          for (int i = 0; i < 16; ++i) ov[i] = v[i] * rn * gn[i] * sigmoid_f(gg[i]);
          u32x4 w0, w1; w0.x = cvt_pk_bf16(ov[0], ov[1]); w0.y = cvt_pk_bf16(ov[2], ov[3]); w0.z = cvt_pk_bf16(ov[4], ov[5]); w0.w = cvt_pk_bf16(ov[6], ov[7]);
          w1.x = cvt_pk_bf16(ov[8], ov[9]); w1.y = cvt_pk_bf16(ov[10], ov[11]); w1.z = cvt_pk_bf16(ov[12], ov[13]); w1.w = cvt_pk_bf16(ov[14], ov[15]);
#ifdef FX_WOUT8
          { u32x4 w8; w8.x = cvt_pk4_fp8(ov[0], ov[1], ov[2], ov[3]); w8.y = cvt_pk4_fp8(ov[4], ov[5], ov[6], ov[7]); w8.z = cvt_pk4_fp8(ov[8], ov[9], ov[10], ov[11]); w8.w = cvt_pk4_fp8(ov[12], ov[13], ov[14], ov[15]);
            *(u32x4*)((unsigned char*)a.YM + t * 2048 + 1536 + h * 128 + c0) = w8; (void)w0; (void)w1; } }
#else
          bf16_t* dst = a.YM + t * 2048 + 1536 + h * 128 + c0; *(u32x4*)dst = w0; *(u32x4*)(dst + 8) = w1; }
#endif
        __syncthreads();
    }
}
}
namespace fx {
struct EpiQB {
    static constexpr bool PERM = false;
    bf16_t* O; const float* cosB; const float* sinB;
    __device__ __forceinline__ void operator()(const f32x4 (&acc)[2][2][4][2], const Unit& u, int wr, int wc, int fr, int fq) const {
        const int row0 = u.pm * BM + wr * 64 + fr;
#pragma unroll
        for (int bj = 0; bj < 2; ++bj) { const int G = 8 * u.pn + 4 * bj + wc, gm = G % 6; const int col0 = G * 32 + 4 * fq;
#pragma unroll
            for (int ai = 0; ai < 2; ++ai)
#pragma unroll
                for (int m = 0; m < 4; ++m) { const int row = row0 + ai * HALF + m * 16; f32x4 x1 = acc[ai][bj][m][0], x2 = acc[ai][bj][m][1];
                    if (gm >= 4) { const int s = row & (S - 1), pos = gm == 4 ? (s >> 6) : (s & 63);
                        const f32x4 cs = *(const f32x4*)(cosB + pos * 16 + 4 * fq), sn = *(const f32x4*)(sinB + pos * 16 + 4 * fq);
                        const f32x4 o1 = x1 * cs - x2 * sn, o2 = x2 * cs + x1 * sn; x1 = o1; x2 = o2; }
                    bf16_t* rp = O + (size_t)row * 1280 + col0;
                    u32x2 w0, w1; w0.x = cvt_pk_bf16(x1[0], x1[1]); w0.y = cvt_pk_bf16(x1[2], x1[3]); w1.x = cvt_pk_bf16(x2[0], x2[1]); w1.y = cvt_pk_bf16(x2[2], x2[3]);
                    *(u32x2*)rp = w0; *(u32x2*)(rp + 16) = w1; } }
    }
};
constexpr size_t al256(size_t x) { return (x + 255) & ~(size_t)255; }
constexpr size_t WS_BAR = 0;
constexpr size_t WS_MOD = 16384;
constexpr size_t WS_COEF = WS_MOD + al256(2ull * 4 * 12288 * 4);
constexpr size_t WS_TAB = WS_COEF + al256(2ull * 4 * 6 * 2048 * 4);
constexpr size_t WS_CNT = WS_TAB + al256(6144 * 4);
constexpr size_t WS_WGBASE = WS_CNT + 512;
constexpr size_t WS_SELE = WS_WGBASE + 256 * 64 * 4;
constexpr size_t WS_SELG = WS_SELE + (size_t)T * 6 * 4;
constexpr size_t WS_SLOT = WS_SELG + (size_t)T * 6 * 4;
constexpr size_t WS_ROWTOK = WS_SLOT + (size_t)T * 6 * 4;
constexpr size_t WS_ROWG = WS_ROWTOK + (size_t)PTOT * 4;
constexpr size_t WS_GATES = WS_ROWG + (size_t)PTOT * 4;
constexpr size_t WS_GSC = WS_GATES + (size_t)T * 16 * 4;
constexpr size_t WS_MPREV = WS_GSC + 2048 * 2 * 4;
constexpr size_t WS_NLOC = WS_MPREV + 2048 * 4;
constexpr size_t WS_NPREV = WS_NLOC + 2048ull * 128 * 4;
constexpr size_t WS_W = al256(WS_NPREV + 2048ull * 128 * 4);
constexpr size_t W_IN = 0, W_UQ = W_IN + 4096ull * 2048 * 2, W_UKV = W_UQ + 1280ull * 384 * 2, W_OUT = W_UKV + 1536ull * 256 * 2, W_GU = W_OUT + 2048ull * 2048 * 2, W_DN = W_GU + 65ull * 1024 * 2048 * 2, W_LAYER = W_DN + 65ull * 2048 * 512 * 2;
constexpr size_t WS_XRES = WS_W + 2 * W_LAYER;
constexpr size_t WS_HA = WS_XRES + (size_t)T * 2048 * 4;
constexpr size_t WS_R1 = WS_HA + (size_t)T * 2048 * 2;
constexpr size_t WS_R2 = WS_R1 + (size_t)T * 4096 * 2;
constexpr size_t R2_QA = 0, R2_KA = R2_QA + (size_t)T * 768 * 2, R2_CQN = R2_KA + (size_t)T * 256 * 2, R2_CKVN = R2_CQN + (size_t)T * 384 * 2, R2_KR = R2_CKVN + (size_t)T * 256 * 2,
                 R2_QB = R2_KR + (size_t)T * 64 * 2, R2_KVB = R2_QB + (size_t)T * 1280 * 2, R2_QC = R2_KVB + (size_t)T * 1536 * 2, R2_KC = R2_QC + (size_t)T * 512 * 2,
                 R2_KCT = R2_KC + (size_t)T * 512 * 2, R2_CPREV = R2_KCT + 2048ull * 16384 * 2, R2_END = R2_CPREV + 2048ull * 16384 * 2;
constexpr size_t WS_END = WS_R2 + (size_t)PTOT * 2048 * 2;
static_assert(R2_END <= (size_t)PTOT * 2048 * 2, "R2 overflow");
static_assert(WS_END <= 2147483648ull, "workspace too large");
}
namespace fx {
struct CvtW { const float* w_in; const float* w_uq; const float* w_ukv; const float* w_out; const float* eg; const float* eu; const float* ed; const float* sg; const float* su; const float* sd; bf16_t* W; };
__device__ __forceinline__ void cvt_layer(const CvtW& a, FX_LAS unsigned* my, int gwave, int nwaves, int& rot) {
    const int BIG = 1 << 30; bf16_t* W = a.W;
    bf16_t* WIN = W + W_IN / 2; bf16_t* WUQ = W + W_UQ / 2; bf16_t* WUKV = W + W_UKV / 2; bf16_t* WOUT = W + W_OUT / 2; bf16_t* WGU = W + W_GU / 2; bf16_t* WDN = W + W_DN / 2;
#ifdef FX_WIN8
    { CvtSeg s; s.src = a.w_in; s.dst = WIN; s.sstride = 0; s.dstride = 0; s.ld = 4048; s.nsrc = 4048; s.K = 2048; s.ntn = 64; s.nbatch = 1; s.G = BIG; s.GS = 0; s.off = 0; cvt_seg8(s, my, gwave, nwaves, rot, W8_SCALE); }
#else
    { CvtSeg s; s.src = a.w_in; s.dst = WIN; s.sstride = 0; s.dstride = 0; s.ld = 4048; s.nsrc = 4048; s.K = 2048; s.ntn = 64; s.nbatch = 1; s.G = BIG; s.GS = 0; s.off = 0; cvt_seg(s, my, gwave, nwaves, rot); }
#endif
    { CvtSeg s; s.src = a.w_uq; s.dst = WUQ; s.sstride = 0; s.dstride = 0; s.ld = 1152; s.nsrc = 1152; s.K = 384; s.ntn = 20; s.nbatch = 1; s.G = BIG; s.GS = 0; s.off = 0; cvt_seg(s, my, gwave, nwaves, rot); }
    { CvtSeg s; s.src = a.w_ukv; s.dst = WUKV; s.sstride = 0; s.dstride = 0; s.ld = 1536; s.nsrc = 1536; s.K = 256; s.ntn = 24; s.nbatch = 1; s.G = BIG; s.GS = 0; s.off = 0; cvt_seg(s, my, gwave, nwaves, rot); }
#ifdef FX_WOUT8
    { CvtSeg s; s.src = a.w_out; s.dst = WOUT; s.sstride = 0; s.dstride = 0; s.ld = 2048; s.nsrc = 2048; s.K = 2048; s.ntn = 32; s.nbatch = 1; s.G = BIG; s.GS = 0; s.off = 0; cvt_seg8(s, my, gwave, nwaves, rot, W8_SCALE); }
#else
    { CvtSeg s; s.src = a.w_out; s.dst = WOUT; s.sstride = 0; s.dstride = 0; s.ld = 2048; s.nsrc = 2048; s.K = 2048; s.ntn = 32; s.nbatch = 1; s.G = BIG; s.GS = 0; s.off = 0; cvt_seg(s, my, gwave, nwaves, rot); }
#endif
    { CvtSeg s; s.src = a.eg; s.dst = WGU; s.sstride = 2048ll * 512; s.dstride = 1024ll * 2048; s.ld = 512; s.nsrc = 512; s.K = 2048; s.ntn = 8; s.nbatch = 64; s.G = 128; s.GS = 256; s.off = 0; cvt_seg8(s, my, gwave, nwaves, rot, W8_SCALE); }
    { CvtSeg s; s.src = a.eu; s.dst = WGU; s.sstride = 2048ll * 512; s.dstride = 1024ll * 2048; s.ld = 512; s.nsrc = 512; s.K = 2048; s.ntn = 8; s.nbatch = 64; s.G = 128; s.GS = 256; s.off = 128; cvt_seg8(s, my, gwave, nwaves, rot, W8_SCALE); }
    { CvtSeg s; s.src = a.ed; s.dst = WDN; s.sstride = 512ll * 2048; s.dstride = 2048ll * 512; s.ld = 2048; s.nsrc = 2048; s.K = 512; s.ntn = 32; s.nbatch = 64; s.G = BIG; s.GS = 0; s.off = 0; cvt_seg8(s, my, gwave, nwaves, rot, W8_SCALE); }
    { CvtSeg s; s.src = a.sg; s.dst = (bf16_t*)((unsigned char*)WGU + 64ull * 1024 * 2048); s.sstride = 0; s.dstride = 0; s.ld = 512; s.nsrc = 512; s.K = 2048; s.ntn = 8; s.nbatch = 1; s.G = 128; s.GS = 256; s.off = 0; cvt_seg8(s, my, gwave, nwaves, rot, W8_SCALE); }
    { CvtSeg s; s.src = a.su; s.dst = (bf16_t*)((unsigned char*)WGU + 64ull * 1024 * 2048); s.sstride = 0; s.dstride = 0; s.ld = 512; s.nsrc = 512; s.K = 2048; s.ntn = 8; s.nbatch = 1; s.G = 128; s.GS = 256; s.off = 128; cvt_seg8(s, my, gwave, nwaves, rot, W8_SCALE); }
    { CvtSeg s; s.src = a.sd; s.dst = (bf16_t*)((unsigned char*)WDN + 64ull * 2048 * 512); s.sstride = 0; s.dstride = 0; s.ld = 2048; s.nsrc = 2048; s.K = 512; s.ntn = 32; s.nbatch = 1; s.G = BIG; s.GS = 0; s.off = 0; cvt_seg8(s, my, gwave, nwaves, rot, W8_SCALE); }
}
constexpr int CVT_TILES_PER_LAYER = 2048 + 120 + 96 + 1024 + 3 * 16384 + 3 * 256;
__device__ __forceinline__ void cvt_layer_one(const CvtW& a, FX_LAS unsigned* my, int g) {
    int base = 0;
    const int BIG = 1 << 30; bf16_t* W = a.W;
    bf16_t* WIN = W + W_IN / 2; bf16_t* WUQ = W + W_UQ / 2; bf16_t* WUKV = W + W_UKV / 2; bf16_t* WOUT = W + W_OUT / 2; bf16_t* WGU = W + W_GU / 2; bf16_t* WDN = W + W_DN / 2;
#ifdef FX_WIN8
    { CvtSeg s; s.src = a.w_in; s.dst = WIN; s.sstride = 0; s.dstride = 0; s.ld = 4048; s.nsrc = 4048; s.K = 2048; s.ntn = 64; s.nbatch = 1; s.G = BIG; s.GS = 0; s.off = 0; { const int cnt_ = (s.K / 64) * s.ntn * s.nbatch; if (g >= base && g < base + cnt_) cvt_tile8(s, my, g - base, W8_SCALE); base += cnt_; } }
#else
    { CvtSeg s; s.src = a.w_in; s.dst = WIN; s.sstride = 0; s.dstride = 0; s.ld = 4048; s.nsrc = 4048; s.K = 2048; s.ntn = 64; s.nbatch = 1; s.G = BIG; s.GS = 0; s.off = 0; { const int cnt_ = (s.K / 64) * s.ntn * s.nbatch; if (g >= base && g < base + cnt_) cvt_tile(s, my, g - base); base += cnt_; } }
#endif
    { CvtSeg s; s.src = a.w_uq; s.dst = WUQ; s.sstride = 0; s.dstride = 0; s.ld = 1152; s.nsrc = 1152; s.K = 384; s.ntn = 20; s.nbatch = 1; s.G = BIG; s.GS = 0; s.off = 0; { const int cnt_ = (s.K / 64) * s.ntn * s.nbatch; if (g >= base && g < base + cnt_) cvt_tile(s, my, g - base); base += cnt_; } }
    { CvtSeg s; s.src = a.w_ukv; s.dst = WUKV; s.sstride = 0; s.dstride = 0; s.ld = 1536; s.nsrc = 1536; s.K = 256; s.ntn = 24; s.nbatch = 1; s.G = BIG; s.GS = 0; s.off = 0; { const int cnt_ = (s.K / 64) * s.ntn * s.nbatch; if (g >= base && g < base + cnt_) cvt_tile(s, my, g - base); base += cnt_; } }
#ifdef FX_WOUT8
    { CvtSeg s; s.src = a.w_out; s.dst = WOUT; s.sstride = 0; s.dstride = 0; s.ld = 2048; s.nsrc = 2048; s.K = 2048; s.ntn = 32; s.nbatch = 1; s.G = BIG; s.GS = 0; s.off = 0; { const int cnt_ = (s.K / 64) * s.ntn * s.nbatch; if (g >= base && g < base + cnt_) cvt_tile8(s, my, g - base, W8_SCALE); base += cnt_; } }
#else
    { CvtSeg s; s.src = a.w_out; s.dst = WOUT; s.sstride = 0; s.dstride = 0; s.ld = 2048; s.nsrc = 2048; s.K = 2048; s.ntn = 32; s.nbatch = 1; s.G = BIG; s.GS = 0; s.off = 0; { const int cnt_ = (s.K / 64) * s.ntn * s.nbatch; if (g >= base && g < base + cnt_) cvt_tile(s, my, g - base); base += cnt_; } }
#endif
    { CvtSeg s; s.src = a.eg; s.dst = WGU; s.sstride = 2048ll * 512; s.dstride = 1024ll * 2048; s.ld = 512; s.nsrc = 512; s.K = 2048; s.ntn = 8; s.nbatch = 64; s.G = 128; s.GS = 256; s.off = 0; { const int cnt_ = (s.K / 64) * s.ntn * s.nbatch; if (g >= base && g < base + cnt_) cvt_tile8(s, my, g - base, W8_SCALE); base += cnt_; } }
    { CvtSeg s; s.src = a.eu; s.dst = WGU; s.sstride = 2048ll * 512; s.dstride = 1024ll * 2048; s.ld = 512; s.nsrc = 512; s.K = 2048; s.ntn = 8; s.nbatch = 64; s.G = 128; s.GS = 256; s.off = 128; { const int cnt_ = (s.K / 64) * s.ntn * s.nbatch; if (g >= base && g < base + cnt_) cvt_tile8(s, my, g - base, W8_SCALE); base += cnt_; } }
    { CvtSeg s; s.src = a.ed; s.dst = WDN; s.sstride = 512ll * 2048; s.dstride = 2048ll * 512; s.ld = 2048; s.nsrc = 2048; s.K = 512; s.ntn = 32; s.nbatch = 64; s.G = BIG; s.GS = 0; s.off = 0; { const int cnt_ = (s.K / 64) * s.ntn * s.nbatch; if (g >= base && g < base + cnt_) cvt_tile8(s, my, g - base, W8_SCALE); base += cnt_; } }
    { CvtSeg s; s.src = a.sg; s.dst = (bf16_t*)((unsigned char*)WGU + 64ull * 1024 * 2048); s.sstride = 0; s.dstride = 0; s.ld = 512; s.nsrc = 512; s.K = 2048; s.ntn = 8; s.nbatch = 1; s.G = 128; s.GS = 256; s.off = 0; { const int cnt_ = (s.K / 64) * s.ntn * s.nbatch; if (g >= base && g < base + cnt_) cvt_tile8(s, my, g - base, W8_SCALE); base += cnt_; } }
    { CvtSeg s; s.src = a.su; s.dst = (bf16_t*)((unsigned char*)WGU + 64ull * 1024 * 2048); s.sstride = 0; s.dstride = 0; s.ld = 512; s.nsrc = 512; s.K = 2048; s.ntn = 8; s.nbatch = 1; s.G = 128; s.GS = 256; s.off = 128; { const int cnt_ = (s.K / 64) * s.ntn * s.nbatch; if (g >= base && g < base + cnt_) cvt_tile8(s, my, g - base, W8_SCALE); base += cnt_; } }
    { CvtSeg s; s.src = a.sd; s.dst = (bf16_t*)((unsigned char*)WDN + 64ull * 2048 * 512); s.sstride = 0; s.dstride = 0; s.ld = 2048; s.nsrc = 2048; s.K = 512; s.ntn = 32; s.nbatch = 1; s.G = BIG; s.GS = 0; s.off = 0; { const int cnt_ = (s.K / 64) * s.ntn * s.nbatch; if (g >= base && g < base + cnt_) cvt_tile8(s, my, g - base, W8_SCALE); base += cnt_; } }
}
}
namespace fx {
#define XB_TMO      128
#define XB_XCNT(j)  (256  + 64 * (j))
#define XB_XSUB(j)  (1280 + 64 * (j))
#define XB_XGEN(j)  (2304 + 64 * (j))
#define XB_TOP      3328
#define XB_TOPGEN   3392
#define XCD_BAR_WORDS 3456
#define XB_SPIN_CAP (1u << 22)
__device__ __forceinline__ unsigned xb_ld(unsigned* p)              { return __hip_atomic_load(p, __ATOMIC_RELAXED, __HIP_MEMORY_SCOPE_AGENT); }
__device__ __forceinline__ unsigned xb_add(unsigned* p, unsigned v) { return __hip_atomic_fetch_add(p, v, __ATOMIC_RELAXED, __HIP_MEMORY_SCOPE_AGENT); }
__device__ __forceinline__ unsigned xb_xcc_id() { return (unsigned)__builtin_amdgcn_s_getreg((3 << 11) | 20) & 0xFu; }
#define XB_SPIN(cond, bar) do { unsigned _sp = 0; while (cond) { __builtin_amdgcn_s_sleep(1); \
    if ((++_sp & 255u) == 0u) { if (xb_ld(&(bar)[XB_TMO])) break; if (_sp > XB_SPIN_CAP) { atomicAdd(&(bar)[XB_TMO], 1u); break; } } } } while (0)
struct XcdBarrier { unsigned* bar; unsigned x; volatile FX_LAS unsigned* st; };
__device__ __forceinline__ XcdBarrier xcd_barrier_post(unsigned* bar, volatile FX_LAS unsigned* st, int tidp) {
    XcdBarrier b; b.bar = bar; b.x = xb_xcc_id(); b.st = st;
    if (tidp == 0) (void)xb_add(&bar[XB_XCNT(b.x)], 1u);
    return b;
}
__device__ __forceinline__ void xcd_barrier_complete(unsigned* bar, unsigned x, unsigned& nloc, unsigned& nx) {
    const unsigned G = gridDim.x * gridDim.y * gridDim.z;
    unsigned sum, cnt, mine, sp = 0u;
    for (;;) {
        sum = 0u; cnt = 0u; mine = 0u;
#pragma unroll
        for (unsigned j = 0; j < 16; ++j) { const unsigned c = xb_ld(&bar[XB_XCNT(j)]); sum += c; cnt += (c > 0u) ? 1u : 0u; mine = (j == x) ? c : mine; }
        if (sum == G) break;
        __builtin_amdgcn_s_sleep(1);
        if ((++sp & 255u) == 0u) { if (xb_ld(&bar[XB_TMO])) break; if (sp > XB_SPIN_CAP) { atomicAdd(&bar[XB_TMO], 1u); break; } }
    }
    nloc = mine > 0u ? mine : 1u; nx = cnt > 0u ? cnt : 1u;
}
__device__ __forceinline__ void xcd_barrier(const XcdBarrier& b, int tidp) {
    asm volatile("s_waitcnt vmcnt(0)" ::: "memory");
    __syncthreads();
    if (tidp == 0) {
        unsigned* bar = b.bar;
        __builtin_amdgcn_s_waitcnt(0);
        unsigned nloc = b.st[0], nx = b.st[1];
        if (nloc == 0u) { xcd_barrier_complete(bar, b.x, nloc, nx); b.st[0] = nloc; b.st[1] = nx; }
        const unsigned old = xb_add(&bar[XB_XSUB(b.x)], 1u);
        const unsigned gen = old / nloc;
        if (old + 1u == (gen + 1u) * nloc) {
            __builtin_amdgcn_fence(__ATOMIC_RELEASE, "agent");
            asm volatile("s_waitcnt vmcnt(0)" ::: "memory");
            const unsigned og = xb_add(&bar[XB_TOP], 1u);
            const unsigned tg = og / nx;
            if (og + 1u == (tg + 1u) * nx) xb_add(&bar[XB_TOPGEN], 1u);
            else XB_SPIN(xb_ld(&bar[XB_TOPGEN]) == tg, bar);
            __builtin_amdgcn_fence(__ATOMIC_ACQUIRE, "agent");
            xb_add(&bar[XB_XGEN(b.x)], 1u);
            asm volatile("s_waitcnt vmcnt(0)" ::: "memory");
        } else {
            XB_SPIN(xb_ld(&bar[XB_XGEN(b.x)]) == gen, bar);
            __builtin_amdgcn_fence(__ATOMIC_ACQUIRE, "agent");
            asm volatile("s_waitcnt vmcnt(0)" ::: "memory");
        }
    }
    __syncthreads();
}

__device__ __forceinline__ void modp_phase(FX_LAS unsigned char* lds_, const float* c, const float* ada_w, float* MODP, int wg, int nwg, int tidp) {
    float* cact = (float*)(char*)lds_;
    for (int i = tidp; i < 8192; i += 512) { const float v = c[i]; cact[i] = v / (1.f + expf(-v)); }
    __syncthreads();
    int tid_ = tidp; asm volatile("" : "+v"(tid_));
    const int wid = tid_ >> 6, lane = tid_ & 63;
    for (int u = wg * 8 + wid; u < 2 * 48 * 32; u += nwg * 8) {
        const int kc = u & 31, nc = (u >> 5) % 48, l = u / (48 * 32);
        const float* w = ada_w + (size_t)l * 2048 * 12288 + (size_t)(kc * 64) * 12288 + nc * 256 + lane * 4;
        f32x4 a0 = {0.f, 0.f, 0.f, 0.f}, a1 = a0, a2 = a0, a3 = a0;
#pragma unroll 8
        for (int k = 0; k < 64; ++k) { const f32x4 wv = *(const f32x4*)(w + (size_t)k * 12288); const int kk = kc * 64 + k;
            a0 += wv * cact[kk]; a1 += wv * cact[2048 + kk]; a2 += wv * cact[4096 + kk]; a3 += wv * cact[6144 + kk]; }
        float* dst = MODP + (((size_t)l * 32 + kc) * 4) * 12288 + nc * 256 + lane * 4;
        *(f32x4*)dst = a0; *(f32x4*)(dst + 12288) = a1; *(f32x4*)(dst + 2 * 12288) = a2; *(f32x4*)(dst + 3 * 12288) = a3;
    }
    __syncthreads();
}
__device__ __forceinline__ void tab_phase(float* tab, int gtid) {
    if (gtid < 2048) { const int p = gtid >> 5, f = gtid & 31; const float inv = powf(10000.f, -(float)(2 * f) / 64.f); const float a = (float)p * inv; tab[gtid] = cosf(a); tab[2048 + gtid] = sinf(a); }
    else if (gtid < 3072) { const int i = gtid - 2048, p = i >> 4, f = i & 15; const float inv = powf(10000.f, -(float)(2 * f) / 32.f); const float a = (float)p * inv; tab[4096 + i] = cosf(a); tab[5120 + i] = sinf(a); }
}
__device__ __forceinline__ void coef2_phase(const float* MODP, const float* ada_b, const float* pre_mix_gain, const float* post_mix_gain, const float* pre_ffn_gain, const float* post_ffn_gain, float* coef, int gtid, int nthr) {
    for (int i = gtid; i < 2 * 4 * 2048; i += nthr) { const int d = i & 2047, b = (i >> 11) & 3, l = i >> 13;
        float m[6];
#pragma unroll
        for (int j = 0; j < 6; ++j) { float s = ada_b[l * 12288 + j * 2048 + d];
            for (int kc = 0; kc < 32; ++kc) s += MODP[(((size_t)l * 32 + kc) * 4 + b) * 12288 + j * 2048 + d];
            m[j] = s; }
        float* c = coef + ((size_t)l * 4 + b) * 6 * 2048;
        c[0 * 2048 + d] = m[2] * post_mix_gain[l * 2048 + d];
        c[1 * 2048 + d] = pre_ffn_gain[l * 2048 + d] * (1.f + m[4]);
        c[2 * 2048 + d] = m[3];
        c[3 * 2048 + d] = m[5] * post_ffn_gain[l * 2048 + d];
        c[4 * 2048 + d] = pre_mix_gain[l * 2048 + d] * (1.f + m[1]);
        c[5 * 2048 + d] = m[0]; }
}
__device__ __forceinline__ void coef3_phase(FX_LAS unsigned char* lds_, const float* MODP, const float* ada_b, const float* pre_mix_gain, const float* post_mix_gain, const float* pre_ffn_gain, const float* post_ffn_gain, float* coef, int wg, int nwg, int tidp) {
    FX_LAS float* ms = (FX_LAS float*)lds_;
    int tid_ = tidp; asm volatile("" : "+v"(tid_));
    const int wid = __builtin_amdgcn_readfirstlane(tid_ >> 6), lane = tid_ & 63;
    for (int base = wg * 64; base < 2 * 4 * 2048; base += nwg * 64) {
        const int i = base + lane, d = i & 2047, b = (i >> 11) & 3, l = i >> 13;
        if (wid < 6) { const int j = wid; float pv[32];
#pragma unroll
            for (int kc = 0; kc < 32; ++kc) pv[kc] = MODP[(((size_t)l * 32 + kc) * 4 + b) * 12288 + j * 2048 + d];
            float s = ada_b[l * 12288 + j * 2048 + d];
#pragma unroll
            for (int kc = 0; kc < 32; ++kc) s += pv[kc];
            ms[j * 64 + lane] = s; }
        __syncthreads();
        if (wid == 0) { float m[6];
#pragma unroll
            for (int j = 0; j < 6; ++j) m[j] = ms[j * 64 + lane];
            float* c = coef + ((size_t)l * 4 + b) * 6 * 2048;
            c[0 * 2048 + d] = m[2] * post_mix_gain[l * 2048 + d];
            c[1 * 2048 + d] = pre_ffn_gain[l * 2048 + d] * (1.f + m[4]);
            c[2 * 2048 + d] = m[3];
            c[3 * 2048 + d] = m[5] * post_ffn_gain[l * 2048 + d];
            c[4 * 2048 + d] = pre_mix_gain[l * 2048 + d] * (1.f + m[1]);
            c[5 * 2048 + d] = m[0]; }
        __syncthreads();
    }
}
__device__ __forceinline__ void prenorm_phase(const float* x, const float* coef_l, bf16_t* HA, int wg, int nwg, int tidp) {
    int tid_ = tidp; asm volatile("" : "+v"(tid_));
    const int wid = tid_ >> 6, lane = tid_ & 63;
    for (int t = wg * 8 + wid; t < T; t += nwg * 8) {
        const float* cn = coef_l + (size_t)(t / S) * 6 * 2048;
        float xv[32]; float ss = 0.f;
#pragma unroll
        for (int i = 0; i < 4; ++i) { const int c = i * 512 + lane * 8; const f32x4 x0 = *(const f32x4*)(x + (size_t)t * 2048 + c), x1 = *(const f32x4*)(x + (size_t)t * 2048 + c + 4);
#pragma unroll
            for (int j = 0; j < 4; ++j) { xv[i * 8 + j] = x0[j]; xv[i * 8 + 4 + j] = x1[j]; ss += x0[j] * x0[j] + x1[j] * x1[j]; } }
        ss = wave_sum(ss); const float rx = rsqrtf(ss * (1.f / 2048.f) + EPS);
#pragma unroll
        for (int i = 0; i < 4; ++i) { const int c = i * 512 + lane * 8;
            const f32x4 e0 = *(const f32x4*)(cn + 4 * 2048 + c), e1 = *(const f32x4*)(cn + 4 * 2048 + c + 4), f0 = *(const f32x4*)(cn + 5 * 2048 + c), f1 = *(const f32x4*)(cn + 5 * 2048 + c + 4);
            float hv[8];
#pragma unroll
            for (int j = 0; j < 4; ++j) { hv[j] = xv[i * 8 + j] * rx * e0[j] + f0[j]; hv[4 + j] = xv[i * 8 + 4 + j] * rx * e1[j] + f1[j]; }
#ifdef FX_WIN8
            u32x2 w; w.x = cvt_pk4_fp8(hv[0], hv[1], hv[2], hv[3]); w.y = cvt_pk4_fp8(hv[4], hv[5], hv[6], hv[7]);
            *(u32x2*)((unsigned char*)HA + (size_t)t * 2048 + c) = w; }
#else
            u32x4 w; w.x = cvt_pk_bf16(hv[0], hv[1]); w.y = cvt_pk_bf16(hv[2], hv[3]); w.z = cvt_pk_bf16(hv[4], hv[5]); w.w = cvt_pk_bf16(hv[6], hv[7]);
            *(u32x4*)(HA + (size_t)t * 2048 + c) = w; }
#endif
    }
}

constexpr int LDS_ST = 139264, LDS_TOTAL = LDS_ST + 64;
constexpr size_t WS_MODP = WS_R2;
#define FX_KAS __attribute__((address_space(4)))
template <class TY> __device__ __forceinline__ TY* fx_glob(TY* p) { __attribute__((address_space(1))) TY* g = (__attribute__((address_space(1))) TY*)p; asm volatile("" : "+s"(g)); return (TY*)g; }
struct MP {
    const float* x; const float* c; const float* ada_w; const float* ada_b; const float* pre_mix_gain; const float* w_in; const float* a_q_gain; const float* a_k_gain;
    const float* b_cq_gain; const float* b_ckv_gain; const float* w_uq; const float* w_ukv; const float* c_conv_w; const float* c_conv_b; const float* c_gate_b;
    const float* head_out_gain; const float* w_out; const float* post_mix_gain; const float* pre_ffn_gain; const float* router_w; const float* router_bias;
    const float* exp_w_gate; const float* exp_w_up; const float* exp_w_down; const float* sh_w_gate; const float* sh_w_up; const float* sh_w_down; const float* post_ffn_gain;
    char* ws; float* out;
};
#ifndef FX_NPHASE
#define FX_NPHASE 1000
#endif
#define PH_BEGIN const FX_KAS MP* pk = (const FX_KAS MP*)__builtin_amdgcn_kernarg_segment_ptr(); asm volatile("" : "+s"(pk)); char* ws = fx_glob(pk->ws); (void)ws; int gt_ = wid_s * 64 + fx_lane(); asm volatile("" : "+v"(gt_)); int wg_ = blockIdx.x, nwg_ = gridDim.x; asm volatile("" : "+s"(wg_), "+s"(nwg_)); const int wg = wg_, nwg = nwg_; (void)wg; (void)nwg; (void)gt_;
#define PH_BAR do { PH_BEGIN XcdBarrier b_; b_.bar = (unsigned*)(ws + WS_BAR); b_.x = xb_xcc_id(); b_.st = (volatile FX_LAS unsigned*)(lds + LDS_ST); xcd_barrier(b_, gt_); } while (0)
#define WSP(T_, off) ((T_*)(ws + (off)))
constexpr int QW_CNT = 3584;
constexpr unsigned HV_SLACK = 24;
__device__ __forceinline__ void harvest(FX_LAS unsigned char* lds, const FX_KAS MP* pk, char* ws, int tid, const unsigned nbar, const bool drain) {
    volatile FX_LAS unsigned* bw = (volatile FX_LAS unsigned*)(lds + LDS_ST);
    unsigned* bar = (unsigned*)(ws + WS_BAR);
    const int wave = tid >> 6; FX_LAS unsigned* my = (FX_LAS unsigned*)(lds) + wave * (64 * 33);
    CvtW a; a.w_in = fx_glob(pk->w_in) + (size_t)D * 4048; a.w_uq = fx_glob(pk->w_uq) + (size_t)384 * 1152; a.w_ukv = fx_glob(pk->w_ukv) + (size_t)256 * 1536; a.w_out = fx_glob(pk->w_out) + (size_t)D * D;
    a.eg = fx_glob(pk->exp_w_gate) + (size_t)NE * D * FF; a.eu = fx_glob(pk->exp_w_up) + (size_t)NE * D * FF; a.ed = fx_glob(pk->exp_w_down) + (size_t)NE * FF * D;
    a.sg = fx_glob(pk->sh_w_gate) + (size_t)D * FF; a.su = fx_glob(pk->sh_w_up) + (size_t)D * FF; a.sd = fx_glob(pk->sh_w_down) + (size_t)FF * D; a.W = (bf16_t*)(ws + WS_W + W_LAYER);
    __syncthreads();
    if (drain) {
        if (tid == 0) bw[3] = xb_ld(&bar[QW_CNT]);
        __syncthreads();
        const unsigned h = bw[3];
#pragma unroll 1
        for (unsigned g = h + (unsigned)(blockIdx.x * 8 + wave); g < (unsigned)CVT_TILES_PER_LAYER; g += gridDim.x * 8u) cvt_layer_one(a, my, (int)g);
        __syncthreads();
        return;
    }
#pragma unroll 1
    for (;;) {
        if (tid == 0) { unsigned nxt = 0xffffffffu; bool go = true;
            if (!drain) { unsigned sum = 0u;
#pragma unroll
                for (unsigned j = 0; j < 16; ++j) sum += xb_ld(&bar[XB_XSUB(j)]);
                const unsigned G = gridDim.x; go = (sum - nbar * G) + HV_SLACK < G; }
            if (go && xb_ld(&bar[QW_CNT]) < (unsigned)CVT_TILES_PER_LAYER) { const unsigned b0 = xb_add(&bar[QW_CNT], 8u); if (b0 < (unsigned)CVT_TILES_PER_LAYER) nxt = b0; }
            bw[3] = nxt; }
        __syncthreads();
        const unsigned base = bw[3];
        if (base == 0xffffffffu) break;
        const int g = (int)base + wave;
        if (g < CVT_TILES_PER_LAYER) cvt_layer_one(a, my, g);
        __syncthreads();
    }
    __syncthreads();
}
#ifndef FX_HARVEST
#define FX_HARVEST 1
#endif
#define PH_HARVEST(n, dr) do { if (FX_HARVEST && l == 0 && ((dr) || FX_HARVEST == 1)) { PH_BEGIN harvest(lds, pk, ws, gt_, (n), (dr)); } } while (0)
#ifndef FX_DUP
#define FX_DUP -1
#endif
#define FX_NE ((FX_NOEPI && rep_ == 1) ? FX_NOEPI : 0)
#define FX_REP(n) _Pragma("unroll 1") for (int rep_ = 0; rep_ < ((FX_DUP == (n) && l == 0) ? 2 : 1); ++rep_)
template <int l> __device__ __forceinline__ void layer_body(FX_LAS unsigned char* lds, unsigned char* shm, const int wid_s) {
        FX_REP(2) { PH_BEGIN const bf16_t* W = WSP(const bf16_t, WS_W + (size_t)l * W_LAYER);
#ifdef FX_WIN8
          DenseSched Sc; Sc.init(T, 4096, nwg, wg, 2048, W + W_IN / 2, 2048, 1); EpiBf16 E; E.O = WSP(bf16_t, WS_R1); E.gates = WSP(float, WS_GATES); E.ldc = 4096; E.scale = W8_INV;
          gemm_phase<EpiBf16, DenseSched, true>(lds, (const char*)WSP(bf16_t, WS_HA), 2048, Sc, E, gt_, FX_NE); }
#else
          DenseSched Sc; Sc.init(T, 4096, nwg, wg, 2048 * 2, W + W_IN / 2, 2048); EpiBf16 E; E.O = WSP(bf16_t, WS_R1); E.gates = WSP(float, WS_GATES); E.ldc = 4096; E.scale = 1.f;
          gemm_phase<EpiBf16, DenseSched>(lds, (const char*)WSP(bf16_t, WS_HA), 2048, Sc, E, gt_); }
#endif
        PH_HARVEST(3u, false);
        PH_BAR;
        FX_REP(3) { PH_BEGIN char* R2 = ws + WS_R2; float* tab = WSP(float, WS_TAB);
          P3Args a; a.PROJ = WSP(bf16_t, WS_R1); a.GATES = WSP(float, WS_GATES); a.gate_b = fx_glob(pk->c_gate_b) + l * 16; a.conv_w = fx_glob(pk->c_conv_w) + (size_t)l * 5 * 1024; a.conv_b = fx_glob(pk->c_conv_b) + l * 1024;
          a.aq_gain = fx_glob(pk->a_q_gain) + l * 128; a.ak_gain = fx_glob(pk->a_k_gain) + l * 128; a.cq_gain = fx_glob(pk->b_cq_gain) + l * 384; a.ckv_gain = fx_glob(pk->b_ckv_gain) + l * 256;
          a.cosA = tab; a.sinA = tab + 2048; a.cosB = tab + 4096; a.sinB = tab + 5120;
          a.QA = (bf16_t*)(R2 + R2_QA); a.KA = (bf16_t*)(R2 + R2_KA); a.CQN = (bf16_t*)(R2 + R2_CQN); a.CKVN = (bf16_t*)(R2 + R2_CKVN); a.KR = (bf16_t*)(R2 + R2_KR); a.QC = (bf16_t*)(R2 + R2_QC); a.KC = (bf16_t*)(R2 + R2_KC);
          a.KCT = (bf16_t*)(R2 + R2_KCT); a.NLOC = WSP(float, WS_NLOC); a.GSC = WSP(float, WS_GSC);
          p3_phase(lds, a, wg, nwg, gt_); }
        PH_BAR;
        FX_REP(4) {
        { PH_BEGIN const bf16_t* W = WSP(const bf16_t, WS_W + (size_t)l * W_LAYER); char* R2 = ws + WS_R2; float* tab = WSP(float, WS_TAB);
          DenseSched Sc; Sc.init(T, 1280, nwg, wg, 384 * 2, W + W_UQ / 2, 384); EpiQB E; E.O = (bf16_t*)(R2 + R2_QB); E.cosB = tab + 4096; E.sinB = tab + 5120;
          gemm_phase<EpiQB, DenseSched>(lds, (const char*)(R2 + R2_CQN), 384, Sc, E, gt_); }
        { PH_BEGIN const bf16_t* W = WSP(const bf16_t, WS_W + (size_t)l * W_LAYER); char* R2 = ws + WS_R2;
          DenseSched Sc; Sc.init(T, 1536, nwg, (wg + nwg / 2) % nwg  , 256 * 2, W + W_UKV / 2, 256); EpiBf16 E; E.O = (bf16_t*)(R2 + R2_KVB); E.gates = nullptr; E.ldc = 1536; E.scale = 1.f;
          gemm_phase<EpiBf16, DenseSched>(lds, (const char*)(R2 + R2_CKVN), 256, Sc, E, gt_); }
        { PH_BEGIN char* R2 = ws + WS_R2;
          scan_phase((const bf16_t*)(R2 + R2_KCT), WSP(float, WS_NLOC), WSP(float, WS_GSC), (bf16_t*)(R2 + R2_CPREV), WSP(float, WS_NPREV), WSP(float, WS_MPREV), wg * 512 + gt_, nwg * 512); }
        }
        PH_HARVEST(5u, false);
        PH_BAR;
        FX_REP(5) {
#pragma unroll 1
          for (int ui = 0; ui < 2; ++ui) { PH_BEGIN char* R2 = ws + WS_R2; int u;
              if (nwg == 256) { const int x = wg & 7, j = wg >> 3; if (ui == 1 && j >= 16) break; u = x * 48 + j + ui * 32; } else { u = wg + ui * nwg; if (u >= 384) break; }
              attn_gqa_unit(u, (const bf16_t*)(R2 + R2_QA), (const bf16_t*)(R2 + R2_KA), WSP(const bf16_t, WS_R1), WSP(bf16_t, WS_HA), fx_glob(pk->head_out_gain) + l * D, (char*)shm, gt_); }
#pragma unroll 1
          for (int ui = 0; ui < 2; ++ui) { PH_BEGIN char* R2 = ws + WS_R2; int u;
              if (nwg == 256) { const int x = wg & 7, j = wg >> 3; if (j < 16) { if (ui == 1) break; u = x * 48 + j; } else u = x * 48 + 16 + (j - 16) * 2 + ui; } else { u = wg + ui * nwg; if (u >= 384) break; }
              attn_mla_unit(u, (const bf16_t*)(R2 + R2_QB), (const bf16_t*)(R2 + R2_KVB), (const bf16_t*)(R2 + R2_KR), WSP(bf16_t, WS_HA), fx_glob(pk->head_out_gain) + l * D, (char*)shm, gt_); }
          { PH_BEGIN char* R2 = ws + WS_R2;
            McArgs a; a.PROJ = WSP(bf16_t, WS_R1); a.GATES = WSP(float, WS_GATES); a.gate_b = fx_glob(pk->c_gate_b) + l * 16; a.QC = (bf16_t*)(R2 + R2_QC); a.KC = (bf16_t*)(R2 + R2_KC); a.CPREV = (bf16_t*)(R2 + R2_CPREV);
            a.NPREV = WSP(float, WS_NPREV); a.MPREV = WSP(float, WS_MPREV); a.hog = fx_glob(pk->head_out_gain) + l * D; a.YM = WSP(bf16_t, WS_HA);
            mlstm_c_phase(lds, a, wg, nwg, gt_); } }
        PH_HARVEST(6u, false);
        PH_BAR;
        FX_REP(6) { PH_BEGIN const bf16_t* W = WSP(const bf16_t, WS_W + (size_t)l * W_LAYER);
#ifdef FX_WOUT8
          DenseSched Sc; Sc.init(T, 2048, nwg, wg, 2048, W + W_OUT / 2, 2048, 1); EpiBf16 E; E.O = WSP(bf16_t, WS_R1); E.gates = nullptr; E.ldc = 2048; E.scale = W8_INV;
          gemm_phase<EpiBf16, DenseSched, true>(lds, (const char*)WSP(bf16_t, WS_HA), 2048, Sc, E, gt_, FX_NE); }
#else
          DenseSched Sc; Sc.init(T, 2048, nwg, wg, 2048 * 2, W + W_OUT / 2, 2048); EpiBf16 E; E.O = WSP(bf16_t, WS_R1); E.gates = nullptr; E.ldc = 2048; E.scale = 1.f;
          gemm_phase<EpiBf16, DenseSched>(lds, (const char*)WSP(bf16_t, WS_HA), 2048, Sc, E, gt_); }
#endif
        PH_HARVEST(7u, false);
        PH_BAR;
        { PH_BEGIN p7_phase<(l != 0)>(lds, l == 0 ? (const void*)fx_glob(pk->x) : (const void*)WSP(const bf16_t, WS_XRES), WSP(const bf16_t, WS_R1), WSP(float, WS_COEF) + (size_t)l * 4 * 6 * 2048, fx_glob(pk->router_w) + (size_t)l * D * 64, fx_glob(pk->router_bias) + l * 64,
                            WSP(bf16_t, WS_XRES), WSP(unsigned char, WS_HA), WSP(int, WS_SELE), WSP(float, WS_SELG), WSP(int, WS_CNT) + l * 64, WSP(int, WS_WGBASE), wg, nwg, gt_); }
        PH_BAR;
        { PH_BEGIN p8_phase(lds, WSP(int, WS_SELE), WSP(float, WS_SELG), WSP(int, WS_CNT) + l * 64, WSP(int, WS_WGBASE), WSP(int, WS_ROWTOK), WSP(float, WS_ROWG), WSP(int, WS_SLOT), wg, nwg, gt_); }
        PH_BAR;
        FX_REP(9) { PH_BEGIN const bf16_t* W = WSP(const bf16_t, WS_W + (size_t)l * W_LAYER);
          p9_phase(lds, WSP(unsigned char, WS_HA), (const unsigned char*)(W + W_GU / 2), WSP(int, WS_CNT) + l * 64, WSP(int, WS_ROWTOK), WSP(unsigned char, WS_R1), wg, nwg, gt_, FX_NE); }
        PH_HARVEST(10u, false);
        PH_BAR;
        FX_REP(10) { PH_BEGIN const bf16_t* W = WSP(const bf16_t, WS_W + (size_t)l * W_LAYER);
          p10_phase(lds, WSP(unsigned char, WS_R1), (const unsigned char*)(W + W_DN / 2), WSP(int, WS_CNT) + l * 64, WSP(float, WS_ROWG), WSP(unsigned char, WS_R2), wg, nwg, gt_, FX_NE); }
        PH_HARVEST(11u, false);
        PH_BAR;
        { PH_BEGIN p11_phase<(l == 1)>(WSP(bf16_t, WS_XRES), WSP(unsigned char, WS_R2), WSP(int, WS_SLOT), WSP(float, WS_COEF) + (size_t)l * 4 * 6 * 2048, l == 0 ? WSP(float, WS_COEF) + 4 * 6 * 2048 : nullptr,
                             l == 1 ? (void*)fx_glob(pk->out) : (void*)WSP(bf16_t, WS_XRES), WSP(bf16_t, WS_HA), wg, nwg, gt_); }
        PH_HARVEST(12u, true);
        if (l == 0) PH_BAR;
}
__global__ __launch_bounds__(512, 2) void mega(MP p_unused) {
    extern __shared__ __attribute__((aligned(16))) unsigned char shm[];
    FX_LAS unsigned char* lds = (FX_LAS unsigned char*)shm;
    const int wid_s = __builtin_amdgcn_readfirstlane((int)threadIdx.x >> 6);
    { volatile FX_LAS unsigned* st = (volatile FX_LAS unsigned*)(lds + LDS_ST);
      PH_BEGIN if (gt_ == 0) { st[0] = 0u; st[1] = 0u; st[2] = 0u; st[3] = 0u; }
      __syncthreads();
      (void)xcd_barrier_post((unsigned*)(ws + WS_BAR), st, gt_); }
    { PH_BEGIN const int wave = wid_s;     FX_LAS unsigned* my = (FX_LAS unsigned*)(lds) + wave * (64 * 33); int rot = 0;
#pragma unroll 1
      for (int l = 0; l < ((FX_DUP == 0) ? 4 : (FX_HARVEST ? 1 : 2)); ++l) { const int lw = l & 1; CvtW a; a.w_in = fx_glob(pk->w_in) + (size_t)lw * D * 4048; a.w_uq = fx_glob(pk->w_uq) + (size_t)lw * 384 * 1152; a.w_ukv = fx_glob(pk->w_ukv) + (size_t)lw * 256 * 1536; a.w_out = fx_glob(pk->w_out) + (size_t)lw * D * D;
          a.eg = fx_glob(pk->exp_w_gate) + (size_t)lw * NE * D * FF; a.eu = fx_glob(pk->exp_w_up) + (size_t)lw * NE * D * FF; a.ed = fx_glob(pk->exp_w_down) + (size_t)lw * NE * FF * D;
          a.sg = fx_glob(pk->sh_w_gate) + (size_t)lw * D * FF; a.su = fx_glob(pk->sh_w_up) + (size_t)lw * D * FF; a.sd = fx_glob(pk->sh_w_down) + (size_t)lw * FF * D; a.W = (bf16_t*)(ws + WS_W + (size_t)lw * W_LAYER);
          cvt_layer(a, my, wg * 8 + wave, nwg * 8, rot); }
      __syncthreads(); }
    { PH_BEGIN modp_phase(lds, fx_glob(pk->c), fx_glob(pk->ada_w), WSP(float, WS_MODP), wg, nwg, gt_); tab_phase(WSP(float, WS_TAB), wg * 512 + gt_); }
#if FX_DUP == 20
    { PH_BEGIN modp_phase(lds, fx_glob(pk->c), fx_glob(pk->ada_w), WSP(float, WS_MODP), wg, nwg, gt_); tab_phase(WSP(float, WS_TAB), wg * 512 + gt_); }
#endif
    PH_BAR;
    { PH_BEGIN coef3_phase(lds, WSP(float, WS_MODP), fx_glob(pk->ada_b), fx_glob(pk->pre_mix_gain), fx_glob(pk->post_mix_gain), fx_glob(pk->pre_ffn_gain), fx_glob(pk->post_ffn_gain), WSP(float, WS_COEF), wg, nwg, gt_); }
    PH_BAR;
    { PH_BEGIN prenorm_phase(fx_glob(pk->x), WSP(float, WS_COEF), WSP(bf16_t, WS_HA), wg, nwg, gt_); }
#if FX_DUP == 22
    { PH_BEGIN prenorm_phase(fx_glob(pk->x), WSP(float, WS_COEF), WSP(bf16_t, WS_HA), wg, nwg, gt_); }
#endif
    PH_BAR;
#if FX_DUP == 99
    PH_BAR; PH_BAR; PH_BAR; PH_BAR; PH_BAR; PH_BAR; PH_BAR; PH_BAR; PH_BAR; PH_BAR;
#endif
    layer_body<0>(lds, shm, wid_s);
    layer_body<1>(lds, shm, wid_s);
}
}

extern "C" void kernel_launch(void* const* d_in, const int* in_sizes, int n_in, void* d_out, int out_size, void* d_ws, size_t ws_size, hipStream_t stream) {
    using namespace fx;
    static int grid = 0;
    if (!grid) {
        int dev = 0, cus = 0, per_cu = 0;
        (void)hipGetDevice(&dev);
        (void)hipDeviceGetAttribute(&cus, hipDeviceAttributeMultiprocessorCount, dev);
        (void)hipFuncSetAttribute((const void*)mega, hipFuncAttributeMaxDynamicSharedMemorySize, LDS_TOTAL);
        (void)hipOccupancyMaxActiveBlocksPerMultiprocessor(&per_cu, (const void*)mega, 512, LDS_TOTAL);
        if (cus > 256) cus = 256;
        grid = per_cu >= 1 ? cus : 0;
    }
    if (!grid) return;
    (void)hipMemsetAsync((char*)d_ws + WS_BAR, 0, 16384, stream);
    (void)hipMemsetAsync((char*)d_ws + WS_CNT, 0, 512, stream);
    MP p{};
    const float** q = (const float**)&p;
    for (int i = 0; i < 28; ++i) q[i] = (const float*)d_in[i];
    p.ws = (char*)d_ws; p.out = (float*)d_out;
    hipLaunchKernelGGL(mega, dim3(grid), dim3(512), LDS_TOTAL, stream, p);
}
```

```cpp
#define FX_WIN8 1
#define FX_WOUT8 1
#define FX_HARVEST 0
#include <hip/hip_runtime.h>
#include <stdint.h>
#include <math.h>
#ifndef FX_NOEPI
#define FX_NOEPI 0
#endif
namespace fx {
#define FX_LAS __attribute__((address_space(3)))
typedef unsigned short bf16_t;
typedef short bf16x8 __attribute__((ext_vector_type(8)));
typedef short s16x4 __attribute__((ext_vector_type(4)));
typedef float f32x4 __attribute__((ext_vector_type(4)));
typedef float f32x16 __attribute__((ext_vector_type(16)));
typedef unsigned u32x4 __attribute__((ext_vector_type(4)));
typedef unsigned u32x2 __attribute__((ext_vector_type(2)));
typedef float f32x2 __attribute__((ext_vector_type(2)));

constexpr int D = 2048, NB = 4, S = 4096, T = NB * S, DEPTH = 2;
constexpr int NE = 64, FF = 512;
constexpr float EPS = 1e-6f;
constexpr int PW = 4096;
constexpr int O_AQ = 0, O_AK = 768, O_AV = 1024, O_BCQ = 1280, O_BCKV = 1664, O_BKR = 1920, O_CQ = 1984, O_CK = 2496, O_CV = 3008, O_CO = 3520, O_CG = 4032;

typedef __bf16 bf16x2_t __attribute__((ext_vector_type(2)));
__device__ __forceinline__ unsigned cvt_pk_bf16(float lo, float hi) { const bf16x2_t r = __builtin_convertvector((f32x2){lo, hi}, bf16x2_t); return __builtin_bit_cast(unsigned, r); }
__device__ __forceinline__ float bf2f(bf16_t b) { return __uint_as_float(((unsigned)b) << 16); }
__device__ __forceinline__ float bflo(unsigned w) { return __uint_as_float(w << 16); }
__device__ __forceinline__ float bfhi(unsigned w) { return __uint_as_float(w & 0xffff0000u); }
__device__ __forceinline__ bf16_t f2bf(float f) { return (bf16_t)(cvt_pk_bf16(f, 0.f) & 0xffffu); }
__device__ __forceinline__ float sigmoid_f(float x) { return __builtin_amdgcn_rcpf(1.f + __expf(-x)); }
__device__ __forceinline__ float silu_f(float x) { return x * __builtin_amdgcn_rcpf(1.f + __expf(-x)); }
__device__ __forceinline__ int fx_lane() { unsigned z = 0u; asm volatile("" : "+v"(z)); return (int)__builtin_amdgcn_mbcnt_hi(~0u, __builtin_amdgcn_mbcnt_lo(~0u, z)); }
__device__ __forceinline__ float wave_sum(float v) { for (int o = 32; o >= 1; o >>= 1) v += __shfl_xor(v, o); return v; }
__device__ __forceinline__ float wave_max(float v) { for (int o = 32; o >= 1; o >>= 1) v = fmaxf(v, __shfl_xor(v, o)); return v; }

#ifndef FX_WGM
#define FX_WGM 8
#endif
#ifndef FX_CVT2D
#define FX_CVT2D 0
#endif
#ifndef FX_CVTPIPE
#define FX_CVTPIPE 1
#endif
#ifndef FX_PRIO8
#define FX_PRIO8 1
#endif
#ifndef FX_F8_32
#define FX_F8_32 0
#endif
typedef int i32x8 __attribute__((ext_vector_type(8)));
typedef int i32x4 __attribute__((ext_vector_type(4)));
constexpr float W8_SCALE = 32.f, W8_INV = 1.f / 32.f;
__device__ __forceinline__ unsigned cvt_pk4_fp8(float a, float b, float c, float d) { int w = 0; w = __builtin_amdgcn_cvt_pk_fp8_f32(a, b, w, false); w = __builtin_amdgcn_cvt_pk_fp8_f32(c, d, w, true); return (unsigned)w; }
struct CvtSeg { const float* src; bf16_t* dst; long long sstride, dstride; int ld, nsrc, K, ntn, nbatch, G, GS, off; };
__device__ __forceinline__ void cvt_tile(const CvtSeg sg, FX_LAS unsigned* my, int tile) {
    const int lane = fx_lane();
    const int ktn = sg.K / 64, per = ktn * sg.ntn;
    {
        const int b = tile / per, r = tile - b * per, nt = r / ktn, kt = r - nt * ktn;
        const int r4 = lane >> 4, c4 = lane & 15;
        const float* src = sg.src + (size_t)b * sg.sstride + (size_t)(kt * 64) * sg.ld + nt * 64 + 4 * c4;
        const bool ok = nt * 64 + 4 * c4 < sg.nsrc;
        f32x4 va[8], vb[8];
#pragma unroll
        for (int i = 0; i < 8; ++i) { const int kp = 4 * i + r4; const f32x4 z = {0.f, 0.f, 0.f, 0.f};
            va[i] = ok ? *(const f32x4*)(src + (size_t)(2 * kp) * sg.ld) : z; vb[i] = ok ? *(const f32x4*)(src + (size_t)(2 * kp + 1) * sg.ld) : z; }
#pragma unroll
        for (int i = 0; i < 8; ++i) { const int kp = 4 * i + r4;
#pragma unroll
            for (int j = 0; j < 4; ++j) my[(4 * c4 + j) * 33 + kp] = cvt_pk_bf16(va[i][j], vb[i][j]); }
        asm volatile("s_waitcnt lgkmcnt(0)" ::: "memory");
        bf16_t* dst = sg.dst + (size_t)b * sg.dstride;
#pragma unroll
        for (int i = 0; i < 8; ++i) {
            const int nl = (lane >> 3) + 8 * i, c = lane & 7, n = nt * 64 + nl;
            u32x4 w; w.x = my[nl * 33 + 4 * c]; w.y = my[nl * 33 + 4 * c + 1]; w.z = my[nl * 33 + 4 * c + 2]; w.w = my[nl * 33 + 4 * c + 3];
            const int row = (n / sg.G) * sg.GS + (n % sg.G) + sg.off;
            *(u32x4*)(dst + (size_t)row * sg.K + kt * 64 + 8 * c) = w;
        }
        asm volatile("s_waitcnt lgkmcnt(0)" ::: "memory");
    }
}
__device__ __forceinline__ void cvt_seg(const CvtSeg sg, FX_LAS unsigned* my, int gwave, int nwaves, int& rot) {
    const int total = (sg.K / 64) * sg.ntn * sg.nbatch;
    int first = (gwave - rot) % nwaves; if (first < 0) first += nwaves;
    for (int tile = first; tile < total; tile += nwaves) cvt_tile(sg, my, tile);
    rot = (rot + total) % nwaves;
}
__device__ __forceinline__ void cvt_tile8(const CvtSeg sg, FX_LAS unsigned* my, int tile, float scale) {
    const int lane = fx_lane();
    const int ktn = sg.K / 64, per = ktn * sg.ntn;
    {
        const int b = tile / per, r = tile - b * per, nt = r / ktn, kt = r - nt * ktn;
        const int r4 = lane >> 4, c4 = lane & 15;
        const float* src = sg.src + (size_t)b * sg.sstride + (size_t)(kt * 64) * sg.ld + nt * 64 + 4 * c4;
        const bool ok = nt * 64 + 4 * c4 < sg.nsrc;
        f32x4 v[4][4];
#pragma unroll
        for (int i = 0; i < 4; ++i)
#pragma unroll
            for (int q = 0; q < 4; ++q) { const int kq = 4 * i + r4; const f32x4 z = {0.f, 0.f, 0.f, 0.f}; v[i][q] = ok ? *(const f32x4*)(src + (size_t)(4 * kq + q) * sg.ld) : z; }
#pragma unroll
        for (int i = 0; i < 4; ++i) { const int kq = 4 * i + r4;
#pragma unroll
            for (int j = 0; j < 4; ++j) my[(4 * c4 + j) * 17 + kq] = cvt_pk4_fp8(v[i][0][j] * scale, v[i][1][j] * scale, v[i][2][j] * scale, v[i][3][j] * scale); }
        asm volatile("s_waitcnt lgkmcnt(0)" ::: "memory");
        unsigned char* dst = (unsigned char*)sg.dst + (size_t)b * sg.dstride;
#pragma unroll
        for (int i = 0; i < 4; ++i) {
            const int nl = (lane >> 2) + 16 * i, c = lane & 3, n = nt * 64 + nl;
            u32x4 w; w.x = my[nl * 17 + 4 * c]; w.y = my[nl * 17 + 4 * c + 1]; w.z = my[nl * 17 + 4 * c + 2]; w.w = my[nl * 17 + 4 * c + 3];
            const int row = (n / sg.G) * sg.GS + (n % sg.G) + sg.off;
            *(u32x4*)(dst + (size_t)row * sg.K + kt * 64 + 16 * c) = w;
        }
        asm volatile("s_waitcnt lgkmcnt(0)" ::: "memory");
    }
}
struct Cvt8P { const float* src; unsigned char* dst; float sc; int nt, kt; };
__device__ __forceinline__ Cvt8P cvt8_params(const CvtSeg sg, int tile, float scale, int lane) {
    const int ktn = sg.K / 64, per = ktn * sg.ntn;
#if FX_CVT2D
    const int b = tile / per, r = tile - b * per, w8 = r & 7, g8 = r >> 3, ktp = ktn >> 1, ntq = g8 / ktp, nt = 4 * ntq + (w8 & 3), kt = 2 * (g8 - ntq * ktp) + (w8 >> 2);
#else
    const int b = tile / per, r = tile - b * per, nt = r / ktn, kt = r - nt * ktn;
#endif
    const int c4 = lane & 15;
    const bool ok = nt * 64 + 4 * c4 < sg.nsrc;
    Cvt8P p; p.src = sg.src + (size_t)b * sg.sstride + (size_t)(kt * 64) * sg.ld + (ok ? nt * 64 + 4 * c4 : 0); p.dst = (unsigned char*)sg.dst + (size_t)b * sg.dstride; p.sc = ok ? scale : 0.f; p.nt = nt; p.kt = kt;
    return p;
}
__device__ __forceinline__ void cvt8_out(const CvtSeg sg, FX_LAS unsigned* my, const Cvt8P& p, int lane) {
    asm volatile("s_waitcnt lgkmcnt(0)" ::: "memory");
#pragma unroll
    for (int i = 0; i < 4; ++i) {
        const int nl = (lane >> 2) + 16 * i, c = lane & 3, n = p.nt * 64 + nl;
        u32x4 w; w.x = my[nl * 17 + 4 * c]; w.y = my[nl * 17 + 4 * c + 1]; w.z = my[nl * 17 + 4 * c + 2]; w.w = my[nl * 17 + 4 * c + 3];
        const int row = (n / sg.G) * sg.GS + (n % sg.G) + sg.off;
        *(u32x4*)(p.dst + (size_t)row * sg.K + p.kt * 64 + 16 * c) = w;
    }
    asm volatile("s_waitcnt lgkmcnt(0)" ::: "memory");
}
__device__ __forceinline__ void cvt_seg8(const CvtSeg sg, FX_LAS unsigned* my, int gwave, int nwaves, int& rot, float scale) {
    const int total = (sg.K / 64) * sg.ntn * sg.nbatch;
    int first = (gwave - rot) % nwaves; if (first < 0) first += nwaves;
#if FX_CVTPIPE
    if (first < total) {
        const int lane = fx_lane(), r4 = lane >> 4, c4 = lane & 15;
        f32x4 v[4][4];
        Cvt8P cur = cvt8_params(sg, first, scale, lane);
#pragma unroll
        for (int i = 0; i < 4; ++i)
#pragma unroll
            for (int q = 0; q < 4; ++q) v[i][q] = *(const f32x4*)(cur.src + (size_t)(4 * (4 * i + r4) + q) * sg.ld);
        int tile = first;
#pragma unroll 1
        while (tile + nwaves < total) {
            tile += nwaves;
            const Cvt8P nx = cvt8_params(sg, tile, scale, lane);
#pragma unroll
            for (int i = 0; i < 4; ++i) { const int kq = 4 * i + r4;
#pragma unroll
                for (int j = 0; j < 4; ++j) my[(4 * c4 + j) * 17 + kq] = cvt_pk4_fp8(v[i][0][j] * cur.sc, v[i][1][j] * cur.sc, v[i][2][j] * cur.sc, v[i][3][j] * cur.sc);
#pragma unroll
                for (int q = 0; q < 4; ++q) v[i][q] = *(const f32x4*)(nx.src + (size_t)(4 * kq + q) * sg.ld); }
            cvt8_out(sg, my, cur, lane);
            cur = nx;
        }
#pragma unroll
        for (int i = 0; i < 4; ++i) { const int kq = 4 * i + r4;
#pragma unroll
            for (int j = 0; j < 4; ++j) my[(4 * c4 + j) * 17 + kq] = cvt_pk4_fp8(v[i][0][j] * cur.sc, v[i][1][j] * cur.sc, v[i][2][j] * cur.sc, v[i][3][j] * cur.sc); }
        cvt8_out(sg, my, cur, lane);
    }
#else
    for (int tile = first; tile < total; tile += nwaves) cvt_tile8(sg, my, tile, scale);
#endif
    rot = (rot + total) % nwaves;
}

constexpr int BM = 256, BK = 64, HALF = 128, HTB = HALF * BK * 2, STAGE_BYTES = 8 * HTB, NXCD = 8, WGM = FX_WGM;
__host__ __device__ __forceinline__ int lds_byte(int r, int c) { const int st = (r >> 4) * 2 + (c >> 5), rr = r & 15, cc = c & 31, ob = rr * 64 + cc * 2; return st * 1024 + (ob ^ (((ob >> 9) & 1) << 5)); }
__host__ __device__ __forceinline__ void stage_rc(int b, int& R, int& C) { const int st = b / 1024, sb = b % 1024, swz = sb ^ (((sb >> 9) & 1) << 5); R = (st >> 1) * 16 + swz / 64; C = (st & 1) * 32 + (swz % 64) / 2; }
__host__ __device__ __forceinline__ int perm32(int rho) { const int n = rho >> 4, i = rho & 15; return 8 * (i >> 2) + 4 * n + (i & 3); }
struct Unit { int pm, pn, e; };
struct DenseSched {
    static constexpr bool GATHER = false;
    int nM, nN, nwg, G, c; int lda_b; const char* Bt; int K; int esz;
    __device__ void init(int M, int N, int G_, int c_, int lda_bytes, const void* Bt_, int K_, int esz_ = 2) { nM = M / BM; nN = N / BM; nwg = nM * nN; G = G_; c = c_; lda_b = lda_bytes; Bt = (const char*)Bt_; K = K_; esz = esz_; }
    __device__ __forceinline__ bool next(int i, Unit& u) const {
        const long L = (long)i * G + c; if (L >= nwg) return false;
        int wgid = (int)L; { const int q = nwg / NXCD, r = nwg % NXCD, xcd = wgid % NXCD, off = wgid / NXCD; wgid = (xcd < r ? xcd * (q + 1) : r * (q + 1) + (xcd - r) * q) + off; }
        const int nig = WGM * nN, gid = wgid / nig, fm = gid * WGM, gsz = (nM - fm) < WGM ? (nM - fm) : WGM;
        u.pm = fm + ((wgid % nig) % gsz); u.pn = (wgid % nig) / gsz; u.e = 0; return true;
    }
    __device__ __forceinline__ unsigned a_row_off(const Unit& u, int R) const { return (unsigned)(u.pm * BM + R) * (unsigned)lda_b; }
    __device__ __forceinline__ size_t a_unit_base(const Unit& u) const { return (size_t)u.pm * BM * (size_t)lda_b; }
    __device__ __forceinline__ unsigned a_lane_off(int R) const { return (unsigned)R * (unsigned)lda_b; }
    __device__ __forceinline__ const char* b_ptr(const Unit& u) const { return Bt + (size_t)u.pn * BM * K * esz; }
};

template <class Epi, class Sched, bool FP8 = false>
__device__ __forceinline__ void gemm_phase(FX_LAS unsigned char* lds, const char* Abase, const int Kc, const Sched& S, const Epi& E, int tidp, const int noepi = 0) {
    int K_ = Kc; asm volatile("" : "+s"(K_)); const int K = K_;
    int tid_ = tidp; asm volatile("" : "+v"(tid_));
    const int tid = tid_, wid = __builtin_amdgcn_readfirstlane(tid >> 6), lane = tid & 63, wr = wid >> 2, wc = wid & 3, fr = lane & 15, fq = lane >> 4;
    constexpr int ES = FP8 ? 1 : 2;
    const int nt = K * ES / 128;
    int Rr[2], Cc[2]; unsigned voffB[2];
#pragma unroll
    for (int i = 0; i < 2; ++i) { int R, C; stage_rc(tid * 16 + i * 8192, R, C); Rr[i] = R; Cc[i] = C; const int Rb = (Epi::PERM && !(FP8 && FX_F8_32)) ? ((R & ~31) + perm32(R & 31)) : R; voffB[i] = (unsigned)(Rb * K * ES + C * 2); }
    const size_t hstepB = (size_t)HALF * K * ES;
    const unsigned ldsw = (unsigned)wid * 1024u;
    constexpr bool F32M = FP8 && FX_F8_32;
    const int aoff = F32M ? lds_byte(wr * 64 + (lane & 31), 16 * (lane >> 5)) : lds_byte(wr * 64 + fr, fq * 8), boff = F32M ? lds_byte(wc * 32 + (lane & 31), 16 * (lane >> 5)) : lds_byte(wc * 32 + fr, fq * 8);
#define FX_SA(b, h) (((b) * 2 + (h)) * HTB)
#define FX_SB(b, h) ((4 + (b) * 2 + (h)) * HTB)
#define FX_STAGE_A(bufoff, o0, o1, kb) do { const char* ap_ = Abase + (kb); \
        __builtin_amdgcn_global_load_lds((const unsigned*)(ap_ + (o0)), (FX_LAS unsigned*)(lds + (bufoff) + ldsw), 16, 0, 0); \
        __builtin_amdgcn_global_load_lds((const unsigned*)(ap_ + (o1)), (FX_LAS unsigned*)(lds + (bufoff) + ldsw + 8192), 16, 0, 0); } while (0)
#define FX_STAGE_B(bufoff, gbase) do { _Pragma("unroll") for (int _i = 0; _i < 2; ++_i) \
        __builtin_amdgcn_global_load_lds((const unsigned*)((const char*)(gbase) + voffB[_i]), (FX_LAS unsigned*)(lds + (bufoff) + ldsw + _i * 8192), 16, 0, 0); } while (0)
#define FX_LDA(dst, b, h) do { if constexpr (F32M) { _Pragma("unroll") for (int q = 0; q < 4; ++q) { dst[q][0] = *(const FX_LAS bf16x8*)(lds + FX_SA(b, h) + aoff + (q >> 1) * 4096 + (q & 1) * 1024); dst[q][1] = *(const FX_LAS bf16x8*)(lds + FX_SA(b, h) + aoff + (q >> 1) * 4096 + (q & 1) * 1024 + 16); } } \
        else { _Pragma("unroll") for (int m = 0; m < 4; ++m) _Pragma("unroll") for (int k = 0; k < 2; ++k) dst[m][k] = *(const FX_LAS bf16x8*)(lds + FX_SA(b, h) + aoff + m * 2048 + k * 1024); } } while (0)
#define FX_LDB(dst, b, h) do { if constexpr (F32M) { _Pragma("unroll") for (int q = 0; q < 2; ++q) { dst[q][0] = *(const FX_LAS bf16x8*)(lds + FX_SB(b, h) + boff + q * 1024); dst[q][1] = *(const FX_LAS bf16x8*)(lds + FX_SB(b, h) + boff + q * 1024 + 16); } } \
        else { _Pragma("unroll") for (int n = 0; n < 2; ++n) _Pragma("unroll") for (int k = 0; k < 2; ++k) dst[n][k] = *(const FX_LAS bf16x8*)(lds + FX_SB(b, h) + boff + n * 2048 + k * 1024); } } while (0)
#define FX_MMA(ai, bj, At, Bt) do { if (!FP8 || FX_PRIO8) __builtin_amdgcn_s_setprio(1); \
        if constexpr (F32M) { _Pragma("unroll") for (int mb = 0; mb < 2; ++mb) _Pragma("unroll") for (int s = 0; s < 2; ++s) { \
            const i32x4 a0_ = __builtin_bit_cast(i32x4, At[mb * 2 + s][0]), a1_ = __builtin_bit_cast(i32x4, At[mb * 2 + s][1]), b0_ = __builtin_bit_cast(i32x4, Bt[s][0]), b1_ = __builtin_bit_cast(i32x4, Bt[s][1]); \
            const i32x8 af_ = __builtin_shufflevector(a0_, a1_, 0, 1, 2, 3, 4, 5, 6, 7), bf_ = __builtin_shufflevector(b0_, b1_, 0, 1, 2, 3, 4, 5, 6, 7); \
            asm volatile("v_mfma_scale_f32_32x32x64_f8f6f4 %0, %1, %2, %0, %3, %3 op_sel_hi:[0,0,0]" : "+v"(acc3[ai][bj][mb]) : "v"(bf_), "v"(af_), "v"(sc1_)); } } else \
        _Pragma("unroll") for (int m = 0; m < 4; ++m) _Pragma("unroll") for (int n = 0; n < 2; ++n) { \
        if constexpr (FP8) { const i32x4 a0_ = __builtin_bit_cast(i32x4, At[m][0]), a1_ = __builtin_bit_cast(i32x4, At[m][1]), b0_ = __builtin_bit_cast(i32x4, Bt[n][0]), b1_ = __builtin_bit_cast(i32x4, Bt[n][1]); \
            const i32x8 af_ = __builtin_shufflevector(a0_, a1_, 0, 1, 2, 3, 4, 5, 6, 7), bf_ = __builtin_shufflevector(b0_, b1_, 0, 1, 2, 3, 4, 5, 6, 7); \
            asm volatile("v_mfma_scale_f32_16x16x128_f8f6f4 %0, %1, %2, %0, %3, %3 op_sel_hi:[0,0,0]" : "+v"(acc[ai][bj][m][n]) : "v"(bf_), "v"(af_), "v"(sc1_)); FX_MFMA_DUP(acc[ai][bj][m][n]) } \
        else { _Pragma("unroll") for (int k = 0; k < 2; ++k) acc[ai][bj][m][n] = __builtin_amdgcn_mfma_f32_16x16x32_bf16(Bt[n][k], At[m][k], acc[ai][bj][m][n], 0, 0, 0); } } \
        if (!FP8 || FX_PRIO8) __builtin_amdgcn_s_setprio(0); } while (0)
#define FX_WAIT_V(n) asm volatile("s_waitcnt vmcnt(" #n ")" ::: "memory")
#define FX_WAIT_L(n) asm volatile("s_waitcnt lgkmcnt(" #n ")" ::: "memory")
#define FX_BAR __builtin_amdgcn_s_barrier()
#define FX_SCHED __builtin_amdgcn_sched_barrier(0)
#ifdef FX_PROBE_MFMA
#define FX_MFMA_DUP(ACC) asm volatile("v_mfma_scale_f32_16x16x128_f8f6f4 %0, %1, %2, %0, %3, %3 op_sel_hi:[0,0,0]" : "+v"(ACC) : "v"(bf_), "v"(af_), "v"(sc0_));
#else
#define FX_MFMA_DUP(ACC)
#endif
    const int sc0_ = 0; (void)sc0_;
    const int sc1_ = 0x7f7f7f7f;
    (void)sc1_;
    Unit cur, nxt; int ui = 0;
    if (!S.next(0, cur)) return;
    f32x4 acc[2][2][4][2];
#pragma unroll
    for (int a = 0; a < 2; ++a)
#pragma unroll
        for (int b = 0; b < 2; ++b)
#pragma unroll
            for (int m = 0; m < 4; ++m)
#pragma unroll
                for (int n = 0; n < 2; ++n) acc[a][b][m][n] = (f32x4){0.f, 0.f, 0.f, 0.f};
    f32x16 acc3[2][2][2];
#pragma unroll
    for (int q = 0; q < 8; ++q) acc3[q >> 2][(q >> 1) & 1][q & 1] = f32x16{};
    bf16x8 At[4][2], B0[2][2], B1[2][2];
    unsigned c00, c01, c10, c11, n00 = 0, n01 = 0, n10 = 0, n11 = 0;
    size_t ubc = 0, ubn = 0;
    if constexpr (Sched::GATHER) { c00 = S.a_row_off(cur, Rr[0]) + Cc[0] * 2; c01 = S.a_row_off(cur, Rr[1]) + Cc[1] * 2; c10 = S.a_row_off(cur, HALF + Rr[0]) + Cc[0] * 2; c11 = S.a_row_off(cur, HALF + Rr[1]) + Cc[1] * 2; }
    else { c00 = S.a_lane_off(Rr[0]) + Cc[0] * 2; c01 = S.a_lane_off(Rr[1]) + Cc[1] * 2; c10 = c00 + S.a_lane_off(HALF); c11 = c01 + S.a_lane_off(HALF); ubc = S.a_unit_base(cur); n00 = c00; n01 = c01; n10 = c10; n11 = c11; }
    const char* cB = S.b_ptr(cur);
    const unsigned kstep = BK * 2;
    FX_STAGE_B(FX_SB(0, 0), cB); FX_STAGE_A(FX_SA(0, 0), c00, c01, ubc); FX_STAGE_B(FX_SB(0, 1), cB + hstepB); FX_STAGE_A(FX_SA(0, 1), c10, c11, ubc);
    if (wr == 1) FX_BAR;
    FX_WAIT_V(4); FX_BAR;
    FX_STAGE_B(FX_SB(1, 0), cB + kstep); FX_STAGE_A(FX_SA(1, 0), c00, c01, ubc + kstep); FX_STAGE_B(FX_SB(1, 1), cB + hstepB + kstep);
    FX_WAIT_V(6); FX_BAR;
    for (;;) {
        const bool has_next = S.next(ui + 1, nxt);
        if (!has_next) nxt = cur;
        if constexpr (!Sched::GATHER) ubn = S.a_unit_base(nxt);
        const char* nB = S.b_ptr(nxt);
        for (int t = 0; t < nt; t += 2) {
            const bool last = (t == nt - 2);
            asm volatile("" : "+v"(c00), "+v"(c01), "+v"(c10), "+v"(c11), "+v"(voffB[0]), "+v"(voffB[1]));
            if constexpr (Sched::GATHER) { if (last) {
                int t2_ = tid; asm volatile("" : "+v"(t2_)); int R0_, C0_, R1_, C1_; stage_rc(t2_ * 16, R0_, C0_); stage_rc(t2_ * 16 + 8192, R1_, C1_);
                n00 = S.a_row_off(nxt, R0_) + C0_ * 2; n01 = S.a_row_off(nxt, R1_) + C1_ * 2; n10 = S.a_row_off(nxt, HALF + R0_) + C0_ * 2; n11 = S.a_row_off(nxt, HALF + R1_) + C1_ * 2; } }
            const size_t k1 = ubc + (size_t)(t + 1) * kstep;
            const size_t k2 = last ? ubn : ubc + (size_t)(t + 2) * kstep, k3 = k2 + kstep;
            unsigned a00, a01, a10, a11;
            if constexpr (Sched::GATHER) { a00 = last ? n00 : c00; a01 = last ? n01 : c01; a10 = last ? n10 : c10; a11 = last ? n11 : c11; } else { a00 = c00; a01 = c01; a10 = c10; a11 = c11; }
            const char* b2 = last ? nB : cB + (size_t)(t + 2) * kstep; const char* b3 = b2 + kstep;
            FX_LDB(B0, 0, 0); FX_SCHED; FX_LDA(At, 0, 0); FX_STAGE_A(FX_SA(1, 1), c10, c11, k1);
            FX_WAIT_L(8); FX_BAR; FX_WAIT_L(0); FX_MMA(0, 0, At, B0); FX_BAR; FX_SCHED;
            FX_LDB(B1, 0, 1); FX_STAGE_B(FX_SB(0, 0), b2);
            FX_BAR; FX_WAIT_L(0); FX_MMA(0, 1, At, B1); FX_BAR;
            FX_LDA(At, 0, 1); FX_STAGE_A(FX_SA(0, 0), a00, a01, k2);
            FX_BAR; FX_WAIT_L(0); FX_MMA(1, 0, At, B0); FX_BAR; FX_SCHED;
            FX_STAGE_B(FX_SB(0, 1), b2 + hstepB);
            FX_WAIT_V(6); FX_BAR; FX_MMA(1, 1, At, B1); FX_BAR;
            FX_LDB(B0, 1, 0); FX_SCHED; FX_LDA(At, 1, 0); FX_STAGE_A(FX_SA(0, 1), a10, a11, k2);
            FX_WAIT_L(8); FX_BAR; FX_WAIT_L(0); FX_MMA(0, 0, At, B0); FX_BAR; FX_SCHED;
            FX_LDB(B1, 1, 1); FX_STAGE_B(FX_SB(1, 0), b3);
            FX_BAR; FX_WAIT_L(0); FX_MMA(0, 1, At, B1); FX_BAR;
            FX_LDA(At, 1, 1); FX_STAGE_A(FX_SA(1, 0), a00, a01, k3);
            FX_BAR; FX_WAIT_L(0); FX_MMA(1, 0, At, B0); FX_BAR; FX_SCHED;
            FX_STAGE_B(FX_SB(1, 1), b3 + hstepB);
            FX_WAIT_V(6); FX_BAR; FX_MMA(1, 1, At, B1); FX_BAR;
        }
        if constexpr (FP8) asm volatile("s_nop 15\n\ts_nop 15\n\ts_nop 15\n\ts_nop 15" ::: "memory");
        if constexpr (F32M) { int ln_e = lane; asm volatile("" : "+v"(ln_e)); E.e32(acc3, cur, wr, wc, ln_e); }
        else if (noepi) { f32x4 s_ = (f32x4){0.f, 0.f, 0.f, 0.f};
#pragma unroll
            for (int q_ = 0; q_ < 32; ++q_) s_ += acc[q_ >> 4][(q_ >> 3) & 1][(q_ >> 1) & 3][q_ & 1];
            if (s_[0] + s_[1] + s_[2] + s_[3] == 1.2345e-30f) *(float*)const_cast<char*>(Abase) = s_[0]; }
        else { int fr_e = fr, fq_e = fq; asm volatile("" : "+v"(fr_e), "+v"(fq_e)); E(acc, cur, wr, wc, fr_e, fq_e); }
        if (!has_next) break;
        if constexpr (F32M) { _Pragma("unroll") for (int q = 0; q < 8; ++q) acc3[q >> 2][(q >> 1) & 1][q & 1] = f32x16{}; }
#pragma unroll
        for (int a = 0; a < 2; ++a)
#pragma unroll
            for (int b = 0; b < 2; ++b)
#pragma unroll
                for (int m = 0; m < 4; ++m)
#pragma unroll
                    for (int n = 0; n < 2; ++n) acc[a][b][m][n] = (f32x4){0.f, 0.f, 0.f, 0.f};
        cur = nxt; cB = nB; if constexpr (Sched::GATHER) { c00 = n00; c01 = n01; c10 = n10; c11 = n11; } else ubc = ubn; ++ui;
    }
    FX_WAIT_V(0);
    if (wr == 0) FX_BAR;
    FX_BAR;
}

#ifndef FX_EPILDS
#define FX_EPILDS 1
#endif
#ifndef FX_NTST
#define FX_NTST 0
#endif
#if FX_NTST
#define FX_EPI_ST(TY, p, v) __builtin_nontemporal_store((v), (TY*)(p))
#else
#define FX_EPI_ST(TY, p, v) (*(TY*)(p) = (v))
#endif
constexpr int EPI_LDS_OFF = STAGE_BYTES + 8192 + 64, EPI_LDS_BYTES = 8 * 2304;
struct EpiBf16 {
    static constexpr bool PERM = true;
    bf16_t* O; float* gates; int ldc; float scale; FX_LAS unsigned char* es;
    __device__ __forceinline__ void operator()(const f32x4 (&acc)[2][2][4][2], const Unit& u, int wr, int wc, int fr, int fq) const {
        const int row0 = u.pm * BM + wr * 64 + fr, col0 = u.pn * BM + wc * 32 + 8 * fq;
#if FX_EPILDS
        if (FX_EPILDS == 1 || (FX_EPILDS == 2 && gates == nullptr && ldc == 2048) || (FX_EPILDS == 3 && gates != nullptr) || (FX_EPILDS == 4 && ldc == 1536)) {
        FX_LAS unsigned char* my = es + (wr * 4 + wc) * 2304;
        const int lane = fq * 16 + fr, rrow = lane >> 2, rch = lane & 3;
#pragma unroll
        for (int ai = 0; ai < 2; ++ai)
#pragma unroll
            for (int m = 0; m < 4; ++m) { FX_LAS unsigned char* buf = my;
#pragma unroll
                for (int bj = 0; bj < 2; ++bj) { const f32x4 v0 = acc[ai][bj][m][0] * scale, v1 = acc[ai][bj][m][1] * scale;
                    u32x4 w; w.x = cvt_pk_bf16(v0[0], v0[1]); w.y = cvt_pk_bf16(v0[2], v0[3]); w.z = cvt_pk_bf16(v1[0], v1[1]); w.w = cvt_pk_bf16(v1[2], v1[3]);
                    *(FX_LAS u32x4*)(buf + fr * 144 + bj * 64 + fq * 16) = w; }
                const int row = u.pm * BM + wr * 64 + ai * HALF + m * 16 + rrow; bf16_t* rowp = O + (size_t)row * ldc + u.pn * BM + wc * 32 + rch * 8;
#pragma unroll
                for (int q = 0; q < 2; ++q) { const u32x4 w = *(const FX_LAS u32x4*)(buf + rrow * 144 + q * 64 + rch * 16); *(u32x4*)(rowp + q * HALF) = w; }
                if (gates && u.pn == 15 && wc == 2 && fq < 2) { float* g = gates + (size_t)(row0 + ai * HALF + m * 16) * 16 + 8 * fq; *(f32x4*)g = acc[ai][1][m][0] * scale; *(f32x4*)(g + 4) = acc[ai][1][m][1] * scale; } }
        (void)col0; return; }
#endif
        {
#pragma unroll
        for (int ai = 0; ai < 2; ++ai)
#pragma unroll
            for (int m = 0; m < 4; ++m) { const int row = row0 + ai * HALF + m * 16; bf16_t* rowp = O + (size_t)row * ldc + col0;
#pragma unroll
                for (int bj = 0; bj < 2; ++bj) { const f32x4 v0 = acc[ai][bj][m][0] * scale, v1 = acc[ai][bj][m][1] * scale;
                    u32x4 w; w.x = cvt_pk_bf16(v0[0], v0[1]); w.y = cvt_pk_bf16(v0[2], v0[3]); w.z = cvt_pk_bf16(v1[0], v1[1]); w.w = cvt_pk_bf16(v1[2], v1[3]);
                    FX_EPI_ST(u32x4, rowp + bj * HALF, w); }
                if (gates && u.pn == 15 && wc == 2 && fq < 2) { float* g = gates + (size_t)row * 16 + 8 * fq; *(f32x4*)g = acc[ai][1][m][0] * scale; *(f32x4*)(g + 4) = acc[ai][1][m][1] * scale; } }
        }
    }
    __device__ __forceinline__ void e32(const f32x16 (&acc3)[2][2][2], const Unit& u, int wr, int wc, int lane) const {
        const int j = lane & 31, hi = lane >> 5;
#pragma unroll
        for (int ai = 0; ai < 2; ++ai)
#pragma unroll
            for (int mb = 0; mb < 2; ++mb) { const int row = u.pm * BM + ai * HALF + wr * 64 + mb * 32 + j;
#pragma unroll
                for (int bj = 0; bj < 2; ++bj) { bf16_t* rowp = O + (size_t)row * ldc + u.pn * BM + bj * HALF + wc * 32 + 4 * hi;
#pragma unroll
                    for (int g = 0; g < 4; ++g) { u32x2 w; w.x = cvt_pk_bf16(acc3[ai][bj][mb][4 * g] * scale, acc3[ai][bj][mb][4 * g + 1] * scale); w.y = cvt_pk_bf16(acc3[ai][bj][mb][4 * g + 2] * scale, acc3[ai][bj][mb][4 * g + 3] * scale);
                        *(u32x2*)(rowp + 8 * g) = w; } }
                if (gates && u.pn == 15 && wc == 2) { float* gp = gates + (size_t)row * 16 + 4 * hi;
#pragma unroll
                    for (int g = 0; g < 2; ++g) *(f32x4*)(gp + 8 * g) = (f32x4){acc3[ai][1][mb][4 * g] * scale, acc3[ai][1][mb][4 * g + 1] * scale, acc3[ai][1][mb][4 * g + 2] * scale, acc3[ai][1][mb][4 * g + 3] * scale}; } }
    }
};
}
#ifndef FX_RUNR
#define FX_RUNR 16
#endif
namespace fx {
constexpr int RT = 16;
constexpr int H2S_LD = 2052;
constexpr int P7_LDS = RT * H2S_LD * 4 + 512;
constexpr int PTOT = 131072;
constexpr int NTILE_MAX = PTOT / 256;

__device__ __forceinline__ void coef_phase(const float* mod, const float* pre_mix_gain, const float* post_mix_gain, const float* pre_ffn_gain, const float* post_ffn_gain, float* coef, int gtid, int nthr) {
    for (int i = gtid; i < 2 * 4 * 2048; i += nthr) { const int d = i & 2047, b = (i >> 11) & 3, l = i >> 13;
        const float* m = mod + ((size_t)l * 4 + b) * 12288; float* c = coef + ((size_t)l * 4 + b) * 6 * 2048;
        c[0 * 2048 + d] = m[2 * 2048 + d] * post_mix_gain[l * 2048 + d];
        c[1 * 2048 + d] = pre_ffn_gain[l * 2048 + d] * (1.f + m[4 * 2048 + d]);
        c[2 * 2048 + d] = m[3 * 2048 + d];
        c[3 * 2048 + d] = m[5 * 2048 + d] * post_ffn_gain[l * 2048 + d];
        c[4 * 2048 + d] = pre_mix_gain[l * 2048 + d] * (1.f + m[1 * 2048 + d]);
        c[5 * 2048 + d] = m[0 * 2048 + d]; }
}

template <bool XBF>
__device__ __forceinline__ void p7_phase(FX_LAS unsigned char* lds, const void* xin_, const bf16_t* Y, const float* coef_l  , const float* router_w, const float* router_bias,
                                         bf16_t* XRES, unsigned char* HA8, int* SELE, float* SELG, int* CNT, int* WGBASE, int wg, int nwg, int tidp) {
    int tid_ = tidp; asm volatile("" : "+v"(tid_));
    const int tid = tid_, wid = tid >> 6, lane = tid & 63;
    FX_LAS float* h2s = (FX_LAS float*)lds;
    FX_LAS int* hist = (FX_LAS int*)(lds + RT * H2S_LD * 4);
    if (tid < 64) hist[tid] = 0;
    __syncthreads();
#define FX_GC(TY, p) ((const __attribute__((address_space(1))) TY*)(p))
#define FX_GM(TY, p) ((__attribute__((address_space(1))) TY*)(p))
    const int i16 = lane & 15, g4 = lane >> 4;
    for (int unit = wg; unit < T / RT; unit += nwg) {
        {
            const int tok0 = 2 * wid, t0 = unit * RT + tok0, b = t0 / S;
            const float* cf = coef_l + (size_t)b * 6 * 2048;
            u32x4 yw[2][4]; f32x4 ca[8];
            float xv[2][32];
#pragma unroll
            for (int tt = 0; tt < 2; ++tt)
#pragma unroll
                for (int i = 0; i < 4; ++i) yw[tt][i] = *FX_GC(u32x4, Y + (size_t)(t0 + tt) * 2048 + i * 512 + lane * 8);
            if constexpr (XBF) {
                u32x4 xw[2][4];
#pragma unroll
                for (int tt = 0; tt < 2; ++tt)
#pragma unroll
                    for (int i = 0; i < 4; ++i) xw[tt][i] = *FX_GC(u32x4, (const bf16_t*)xin_ + (size_t)(t0 + tt) * 2048 + i * 512 + lane * 8);
#pragma unroll
                for (int i = 0; i < 4; ++i) { ca[2 * i] = *FX_GC(f32x4, cf + i * 512 + lane * 8); ca[2 * i + 1] = *FX_GC(f32x4, cf + i * 512 + lane * 8 + 4); }
#pragma unroll
                for (int tt = 0; tt < 2; ++tt)
#pragma unroll
                    for (int i = 0; i < 4; ++i) { const u32x4 w = xw[tt][i];
                        xv[tt][i * 8 + 0] = bflo(w.x); xv[tt][i * 8 + 1] = bfhi(w.x); xv[tt][i * 8 + 2] = bflo(w.y); xv[tt][i * 8 + 3] = bfhi(w.y); xv[tt][i * 8 + 4] = bflo(w.z); xv[tt][i * 8 + 5] = bfhi(w.z); xv[tt][i * 8 + 6] = bflo(w.w); xv[tt][i * 8 + 7] = bfhi(w.w); }
            } else {
                const float* xin = (const float*)xin_;
#pragma unroll
                for (int tt = 0; tt < 2; ++tt)
#pragma unroll
                    for (int i = 0; i < 4; ++i) { const f32x4 x0 = *FX_GC(f32x4, xin + (size_t)(t0 + tt) * 2048 + i * 512 + lane * 8), x1 = *FX_GC(f32x4, xin + (size_t)(t0 + tt) * 2048 + i * 512 + lane * 8 + 4);
                        xv[tt][i * 8 + 0] = x0[0]; xv[tt][i * 8 + 1] = x0[1]; xv[tt][i * 8 + 2] = x0[2]; xv[tt][i * 8 + 3] = x0[3]; xv[tt][i * 8 + 4] = x1[0]; xv[tt][i * 8 + 5] = x1[1]; xv[tt][i * 8 + 6] = x1[2]; xv[tt][i * 8 + 7] = x1[3]; }
#pragma unroll
                for (int i = 0; i < 4; ++i) { ca[2 * i] = *FX_GC(f32x4, cf + i * 512 + lane * 8); ca[2 * i + 1] = *FX_GC(f32x4, cf + i * 512 + lane * 8 + 4); }
            }
            float ssy0 = 0.f, ssy1 = 0.f;
#pragma unroll
            for (int i = 0; i < 4; ++i) { const u32x4 w0 = yw[0][i], w1 = yw[1][i];
#pragma unroll
                for (int q = 0; q < 4; ++q) { const float l0 = bflo(w0[q]), h0 = bfhi(w0[q]), l1 = bflo(w1[q]), h1 = bfhi(w1[q]); ssy0 += l0 * l0 + h0 * h0; ssy1 += l1 * l1 + h1 * h1; } }
#pragma unroll
            for (int o = 32; o >= 1; o >>= 1) { ssy0 += __shfl_xor(ssy0, o); ssy1 += __shfl_xor(ssy1, o); }
            const float ry0 = rsqrtf(ssy0 * (1.f / 2048.f) + EPS), ry1 = rsqrtf(ssy1 * (1.f / 2048.f) + EPS);
            float ssx0 = 0.f, ssx1 = 0.f;
#pragma unroll
            for (int i = 0; i < 4; ++i) { const u32x4 w0 = yw[0][i], w1 = yw[1][i];
#pragma unroll
                for (int j = 0; j < 8; ++j) { const float a = ca[2 * i + (j >> 2)][j & 3];
                    const float y0 = (j & 1) ? bfhi(w0[j >> 1]) : bflo(w0[j >> 1]), y1 = (j & 1) ? bfhi(w1[j >> 1]) : bflo(w1[j >> 1]);
                    xv[0][i * 8 + j] += a * (y0 * ry0); xv[1][i * 8 + j] += a * (y1 * ry1);
                    ssx0 += xv[0][i * 8 + j] * xv[0][i * 8 + j]; ssx1 += xv[1][i * 8 + j] * xv[1][i * 8 + j]; } }
            f32x4 cb[8], cc[8];
#pragma unroll
            for (int i = 0; i < 4; ++i) { cb[2 * i] = *FX_GC(f32x4, cf + 2048 + i * 512 + lane * 8); cb[2 * i + 1] = *FX_GC(f32x4, cf + 2048 + i * 512 + lane * 8 + 4);
                cc[2 * i] = *FX_GC(f32x4, cf + 4096 + i * 512 + lane * 8); cc[2 * i + 1] = *FX_GC(f32x4, cf + 4096 + i * 512 + lane * 8 + 4); }
#pragma unroll
            for (int tt = 0; tt < 2; ++tt)
#pragma unroll
                for (int i = 0; i < 4; ++i) { u32x4 xo; xo.x = cvt_pk_bf16(xv[tt][i * 8 + 0], xv[tt][i * 8 + 1]); xo.y = cvt_pk_bf16(xv[tt][i * 8 + 2], xv[tt][i * 8 + 3]); xo.z = cvt_pk_bf16(xv[tt][i * 8 + 4], xv[tt][i * 8 + 5]); xo.w = cvt_pk_bf16(xv[tt][i * 8 + 6], xv[tt][i * 8 + 7]);
                    *FX_GM(u32x4, XRES + (size_t)(t0 + tt) * 2048 + i * 512 + lane * 8) = xo; }
#pragma unroll
            for (int o = 32; o >= 1; o >>= 1) { ssx0 += __shfl_xor(ssx0, o); ssx1 += __shfl_xor(ssx1, o); }
            const float rx0 = rsqrtf(ssx0 * (1.f / 2048.f) + EPS), rx1 = rsqrtf(ssx1 * (1.f / 2048.f) + EPS);
#pragma unroll
            for (int tt = 0; tt < 2; ++tt) { const float rx = tt ? rx1 : rx0;
#pragma unroll
                for (int i = 0; i < 4; ++i) { const int c = i * 512 + lane * 8;
                    float hv[8];
#pragma unroll
                    for (int j = 0; j < 8; ++j) hv[j] = xv[tt][i * 8 + j] * rx * cb[2 * i + (j >> 2)][j & 3] + cc[2 * i + (j >> 2)][j & 3];
                    u32x2 w; w.x = cvt_pk4_fp8(hv[0], hv[1], hv[2], hv[3]); w.y = cvt_pk4_fp8(hv[4], hv[5], hv[6], hv[7]);
                    *FX_GM(u32x2, HA8 + (size_t)(t0 + tt) * 2048 + c) = w;
                    *(FX_LAS f32x4*)(h2s + (tok0 + tt) * H2S_LD + c) = (f32x4){hv[0], hv[1], hv[2], hv[3]};
                    *(FX_LAS f32x4*)(h2s + (tok0 + tt) * H2S_LD + c + 4) = (f32x4){hv[4], hv[5], hv[6], hv[7]}; } }
        }
        f32x4 acc[4];
#pragma unroll
        for (int j = 0; j < 4; ++j) acc[j] = (f32x4){0.f, 0.f, 0.f, 0.f};
        {
            const char* rwb = (const char*)router_w + (size_t)__builtin_amdgcn_readfirstlane(wid) * (256 * 64 * 4);
            const unsigned loff = (unsigned)(g4 * 64 + 4 * i16) * 4u;
            f32x4 bwA[8], bwB[8];
            { unsigned o_ = loff; asm volatile("" : "+v"(o_));
#pragma unroll
              for (int q = 0; q < 8; ++q) bwA[q] = *FX_GC(f32x4, rwb + o_ + q * 1024); }
            __syncthreads();
#pragma unroll
            for (int kb = 0; kb < 8; ++kb) {
                if (kb < 7) { unsigned o_ = loff + (kb + 1) * 8192; asm volatile("" : "+v"(o_));
#pragma unroll
                    for (int q = 0; q < 8; ++q) { const f32x4 v = *FX_GC(f32x4, rwb + o_ + q * 1024); if (kb & 1) bwA[q] = v; else bwB[q] = v; } }
#pragma unroll
                for (int q = 0; q < 8; ++q) { const int k = 256 * wid + 4 * (kb * 8 + q) + g4;
                    const float a = h2s[i16 * H2S_LD + k]; const f32x4 bw = (kb & 1) ? bwB[q] : bwA[q];
                    acc[0] = __builtin_amdgcn_mfma_f32_16x16x4f32(a, bw[0], acc[0], 0, 0, 0);
                    acc[1] = __builtin_amdgcn_mfma_f32_16x16x4f32(a, bw[1], acc[1], 0, 0, 0);
                    acc[2] = __builtin_amdgcn_mfma_f32_16x16x4f32(a, bw[2], acc[2], 0, 0, 0);
                    acc[3] = __builtin_amdgcn_mfma_f32_16x16x4f32(a, bw[3], acc[3], 0, 0, 0); } }
        }
        __syncthreads();
        { FX_LAS float* part = h2s; const int i16 = lane & 15, g = lane >> 4;
#pragma unroll
          for (int j = 0; j < 4; ++j)
#pragma unroll
            for (int r = 0; r < 4; ++r) part[(wid * 16 + 4 * g + r) * 64 + 4 * i16 + j] = acc[j][r]; }
        __syncthreads();
#pragma unroll 1
        for (int tt = 0; tt < 2; ++tt) {
            const int tok = 2 * wid + tt, t = unit * RT + tok;
            float lg = 0.f;
#pragma unroll
            for (int w = 0; w < 8; ++w) lg += h2s[(w * 16 + tok) * 64 + lane];
            const float score = 1.f / (1.f + expf(-lg));
            float v = score + router_bias[lane];
            int my_e = 0; float my_s = 0.f, sum = 0.f;
#pragma unroll
            for (int k = 0; k < 6; ++k) {
                const float m = wave_max(v);
                const unsigned long long bal = __ballot(v == m);
                const int win = __ffsll((long long)bal) - 1;
                const float sw = __shfl(score, win);
                sum += sw; if (lane == k) { my_e = win; my_s = sw; }
                if (lane == win) v = -3.0e38f;
            }
            if (lane < 6) { SELE[(size_t)t * 6 + lane] = my_e; SELG[(size_t)t * 6 + lane] = my_s / sum * 2.5f; __hip_atomic_fetch_add(hist + my_e, 1, __ATOMIC_RELAXED, __HIP_MEMORY_SCOPE_WORKGROUP); }
        }
        __syncthreads();
    }
    if (tid < 64) { const int hv = hist[tid]; const int base = atomicAdd(CNT + tid, hv); WGBASE[wg * 64 + tid] = base; }
}

__device__ __forceinline__ void p8_phase(FX_LAS unsigned char* lds, const int* SELE, const float* SELG, const int* CNT, const int* WGBASE, int* ROWTOK, float* ROWG, int* SLOT, int wg, int nwg, int tidp) {
    int tid_ = tidp; asm volatile("" : "+v"(tid_));
    const int tid = tid_;
    FX_LAS int* pstart = (FX_LAS int*)lds; FX_LAS int* off = pstart + 80;
    if (tid < 64) { const int pc = (CNT[tid] + 255) & ~255; int incl = pc;
#pragma unroll
        for (int o = 1; o < 64; o <<= 1) { const int t2 = __shfl_up(incl, o); if (tid >= o) incl += t2; }
        pstart[tid] = 16384 + incl - pc; if (tid == 63) pstart[64] = 16384 + incl; }
    __syncthreads();
    if (tid < 64) off[tid] = pstart[tid] + WGBASE[wg * 64 + tid];
    __syncthreads();
    for (int unit = wg; unit < T / RT; unit += nwg) {
        if (tid < RT * 6) { const int t = unit * RT + tid / 6, k = tid % 6; const int e = SELE[(size_t)t * 6 + k];
            const int pos = __hip_atomic_fetch_add(off + e, 1, __ATOMIC_RELAXED, __HIP_MEMORY_SCOPE_WORKGROUP);
            ROWTOK[pos] = t; ROWG[pos] = SELG[(size_t)t * 6 + k]; SLOT[(size_t)t * 6 + k] = pos; }
    }
    for (int e = wg; e < 64; e += nwg) { const int a = pstart[e] + CNT[e], b = pstart[e + 1]; for (int r = a + tid; r < b; r += 512) { ROWTOK[r] = 0; ROWG[r] = 0.f; } }
    for (int r = wg * 512 + tid; r < 16384; r += nwg * 512) { ROWTOK[r] = r; ROWG[r] = 1.f; }
}

struct MoeSched {
    static constexpr bool GATHER = true;
    FX_LAS const unsigned char* tile_e; int ntiles, npn, nunits, G, c;
    const int* rowtok; int lda_b; const char* Bt; size_t estride_b, pnstride_b;
    __device__ __forceinline__ bool next(int i, Unit& u) const {
        const long L = (long)i * G + c; if (L >= nunits) return false;
        int id = (int)L; { const int q = nunits / NXCD, r = nunits % NXCD, xcd = id % NXCD, off = id / NXCD; id = (xcd < r ? xcd * (q + 1) : r * (q + 1) + (xcd - r) * q) + off; }
        u.pm = id / npn; u.pn = id - u.pm * npn; u.e = tile_e[u.pm]; return true;
    }
    __device__ __forceinline__ unsigned a_row_off(const Unit& u, int R) const { const int row = u.pm * BM + R; return (unsigned)(rowtok ? rowtok[row] : row) * (unsigned)lda_b; }
    __device__ __forceinline__ const char* b_ptr(const Unit& u) const { return Bt + (size_t)u.e * estride_b + (size_t)u.pn * pnstride_b; }
};
__device__ __forceinline__ int moe_sched_build(FX_LAS unsigned char* tab, const int* CNT, int tidp) {
    FX_LAS int* nt = (FX_LAS int*)(tab + 512);
    int tid_ = tidp; asm volatile("" : "+v"(tid_));
    if (tid_ < 64) { const int n = (CNT[tid_] + 255) >> 8; int incl = n;
#pragma unroll
        for (int o = 1; o < 64; o <<= 1) { const int t2 = __shfl_up(incl, o); if (tid_ >= o) incl += t2; }
        const int st0 = 64 + incl - n; for (int j = 0; j < n; ++j) tab[st0 + j] = (unsigned char)tid_;
        tab[tid_] = 64; if (tid_ == 63) nt[0] = 64 + incl; }
    __syncthreads();
    return nt[0];
}
struct EpiGateUp {
    static constexpr bool PERM = true;
    unsigned char* HID;
    __device__ __forceinline__ void operator()(const f32x4 (&acc)[2][2][4][2], const Unit& u, int wr, int wc, int fr, int fq) const {
        const int row0 = u.pm * BM + wr * 64 + fr, col0 = u.pn * 128 + wc * 32 + 8 * fq;
#pragma unroll
        for (int ai = 0; ai < 2; ++ai)
#pragma unroll
            for (int m = 0; m < 4; ++m) { const int row = row0 + ai * HALF + m * 16;
                float o[8];
#pragma unroll
                for (int n = 0; n < 2; ++n)
#pragma unroll
                    for (int j = 0; j < 4; ++j) { const float g = acc[ai][0][m][n][j] * W8_INV, up = acc[ai][1][m][n][j] * W8_INV; o[n * 4 + j] = g * __builtin_amdgcn_rcpf(1.f + __expf(-g)) * up; }
                u32x2 w; w.x = cvt_pk4_fp8(o[0], o[1], o[2], o[3]); w.y = cvt_pk4_fp8(o[4], o[5], o[6], o[7]);
                FX_EPI_ST(u32x2, HID + (size_t)row * 512 + col0, w); }
    }
    __device__ __forceinline__ void e32(const f32x16 (&acc3)[2][2][2], const Unit& u, int wr, int wc, int lane) const {
        const int j = lane & 31, hi = lane >> 5;
#pragma unroll
        for (int ai = 0; ai < 2; ++ai)
#pragma unroll
            for (int mb = 0; mb < 2; ++mb) { const int row = u.pm * BM + ai * HALF + wr * 64 + mb * 32 + j; unsigned char* rowp = HID + (size_t)row * 512 + u.pn * 128 + wc * 32 + 4 * hi;
#pragma unroll
                for (int g = 0; g < 4; ++g) { float o[4];
#pragma unroll
                    for (int q = 0; q < 4; ++q) { const float gt = acc3[ai][0][mb][4 * g + q] * W8_INV, up = acc3[ai][1][mb][4 * g + q] * W8_INV; o[q] = gt * __builtin_amdgcn_rcpf(1.f + __expf(-gt)) * up; }
                    *(unsigned*)(rowp + 8 * g) = cvt_pk4_fp8(o[0], o[1], o[2], o[3]); } }
    }
};
struct EpiDown {
    static constexpr bool PERM = true;
    unsigned char* YR; const float* ROWG; int nostore;
    __device__ __forceinline__ void operator()(const f32x4 (&acc)[2][2][4][2], const Unit& u, int wr, int wc, int fr, int fq) const {
        const int row0 = u.pm * BM + wr * 64 + fr, col0 = u.pn * BM + wc * 32 + 8 * fq;
        float gs[2][4];
#pragma unroll
        for (int ai = 0; ai < 2; ++ai)
#pragma unroll
            for (int m = 0; m < 4; ++m) gs[ai][m] = ROWG[row0 + ai * HALF + m * 16];
#pragma unroll
        for (int ai = 0; ai < 2; ++ai)
#pragma unroll
            for (int m = 0; m < 4; ++m) { const int row = row0 + ai * HALF + m * 16; const float g = gs[ai][m] * W8_INV; unsigned char* rowp = YR + (size_t)row * 2048 + col0;
#pragma unroll
                for (int bj = 0; bj < 2; ++bj) { const f32x4 v0 = acc[ai][bj][m][0] * g, v1 = acc[ai][bj][m][1] * g;
                    u32x2 w; w.x = cvt_pk4_fp8(v0[0], v0[1], v0[2], v0[3]); w.y = cvt_pk4_fp8(v1[0], v1[1], v1[2], v1[3]);
                    if (!FX_NOEPI || !nostore || (w.x == 0x12345678u && w.y == 0x9abcdef0u))
                    FX_EPI_ST(u32x2, rowp + bj * HALF, w); } }
    }
    __device__ __forceinline__ void e32(const f32x16 (&acc3)[2][2][2], const Unit& u, int wr, int wc, int lane) const {
        const int j = lane & 31, hi = lane >> 5;
#pragma unroll
        for (int ai = 0; ai < 2; ++ai)
#pragma unroll
            for (int mb = 0; mb < 2; ++mb) { const int row = u.pm * BM + ai * HALF + wr * 64 + mb * 32 + j; const float gsc = ROWG[row] * W8_INV;
#pragma unroll
                for (int bj = 0; bj < 2; ++bj) { unsigned char* rowp = YR + (size_t)row * 2048 + u.pn * BM + bj * HALF + wc * 32 + 4 * hi;
#pragma unroll
                    for (int g = 0; g < 4; ++g) *(unsigned*)(rowp + 8 * g) = cvt_pk4_fp8(acc3[ai][bj][mb][4 * g] * gsc, acc3[ai][bj][mb][4 * g + 1] * gsc, acc3[ai][bj][mb][4 * g + 2] * gsc, acc3[ai][bj][mb][4 * g + 3] * gsc); } }
    }
};
__device__ __forceinline__ void p9_phase(FX_LAS unsigned char* lds, const unsigned char* HA, const unsigned char* WGU, const int* CNT, const int* ROWTOK, unsigned char* HID, int wg, int nwg, int tidp, const int noepi = 0) {
    FX_LAS unsigned char* tab = lds + STAGE_BYTES;
    const int ntiles = moe_sched_build(tab, CNT, tidp);
    MoeSched Sc; Sc.tile_e = tab; Sc.ntiles = ntiles; Sc.npn = 4; Sc.nunits = ntiles * 4; Sc.G = nwg; Sc.c = wg; Sc.rowtok = ROWTOK; Sc.lda_b = 2048; Sc.Bt = (const char*)WGU; Sc.estride_b = (size_t)1024 * 2048; Sc.pnstride_b = (size_t)256 * 2048;
    EpiGateUp E; E.HID = HID;
    gemm_phase<EpiGateUp, MoeSched, true>(lds, (const char*)HA, 2048, Sc, E, tidp, noepi);
}
__device__ __forceinline__ void p10_phase(FX_LAS unsigned char* lds, const unsigned char* HID, const unsigned char* WDN, const int* CNT, const float* ROWG, unsigned char* YR, int wg, int nwg, int tidp, const int noepi = 0) {
    FX_LAS unsigned char* tab = lds + STAGE_BYTES;
    const int ntiles = moe_sched_build(tab, CNT, tidp);
    MoeSched Sc; Sc.tile_e = tab; Sc.ntiles = ntiles; Sc.npn = 8; Sc.nunits = ntiles * 8; Sc.G = nwg; Sc.c = wg; Sc.rowtok = nullptr; Sc.lda_b = 512; Sc.Bt = (const char*)WDN; Sc.estride_b = (size_t)2048 * 512; Sc.pnstride_b = (size_t)256 * 512;
    EpiDown E; E.YR = YR; E.ROWG = ROWG; E.nostore = (noepi == 2);
    gemm_phase<EpiDown, MoeSched, true>(lds, (const char*)HID, 512, Sc, E, tidp, noepi == 1);
}
template <bool OUTF32>
__device__ __forceinline__ void p11_phase(const bf16_t* x1, const unsigned char* YR, const int* SLOT, const float* coef_l, const float* coef_next  , void* xout_, bf16_t* HA, int wg, int nwg, int tidp) {
    int tid_ = tidp; asm volatile("" : "+v"(tid_));
    const int wid = __builtin_amdgcn_readfirstlane(tid_ >> 6), lane = tid_ & 63;
    for (int t = wg * 8 + wid; t < T; t += nwg * 8) {
        const int b = t / S; const float* cf = coef_l + (size_t)b * 6 * 2048;
        int rows[7]; rows[0] = t;
        { int sl[6];
#pragma unroll
          for (int k = 0; k < 6; ++k) sl[k] = *FX_GC(int, SLOT + (size_t)t * 6 + k);
#pragma unroll
          for (int k = 0; k < 6; ++k) rows[k + 1] = __builtin_amdgcn_readfirstlane(sl[k]); }
        u32x2 ra[4][4];
#pragma unroll
        for (int k = 0; k < 4; ++k)
#pragma unroll
            for (int i = 0; i < 4; ++i) ra[k][i] = *FX_GC(u32x2, YR + (size_t)rows[k] * 2048 + i * 512 + lane * 8);
        u32x4 xw[4];
#pragma unroll
        for (int i = 0; i < 4; ++i) xw[i] = *FX_GC(u32x4, x1 + (size_t)t * 2048 + i * 512 + lane * 8);
        float yv[32];
#pragma unroll
        for (int j = 0; j < 32; ++j) yv[j] = 0.f;
#define FX_ACC8(W, I) do { const f32x2 a0 = __builtin_amdgcn_cvt_pk_f32_fp8((int)(W).x, false), a1 = __builtin_amdgcn_cvt_pk_f32_fp8((int)(W).x, true), a2 = __builtin_amdgcn_cvt_pk_f32_fp8((int)(W).y, false), a3 = __builtin_amdgcn_cvt_pk_f32_fp8((int)(W).y, true); \
            yv[(I) * 8 + 0] += a0[0]; yv[(I) * 8 + 1] += a0[1]; yv[(I) * 8 + 2] += a1[0]; yv[(I) * 8 + 3] += a1[1]; yv[(I) * 8 + 4] += a2[0]; yv[(I) * 8 + 5] += a2[1]; yv[(I) * 8 + 6] += a3[0]; yv[(I) * 8 + 7] += a3[1]; } while (0)
#pragma unroll
        for (int k = 0; k < 4; ++k)
#pragma unroll
            for (int i = 0; i < 4; ++i) FX_ACC8(ra[k][i], i);
        u32x2 rb[3][4];
#pragma unroll
        for (int k = 0; k < 3; ++k)
#pragma unroll
            for (int i = 0; i < 4; ++i) rb[k][i] = *FX_GC(u32x2, YR + (size_t)rows[4 + k] * 2048 + i * 512 + lane * 8);
        f32x4 cd[8];
#pragma unroll
        for (int i = 0; i < 4; ++i) { cd[2 * i] = *FX_GC(f32x4, cf + 3 * 2048 + i * 512 + lane * 8); cd[2 * i + 1] = *FX_GC(f32x4, cf + 3 * 2048 + i * 512 + lane * 8 + 4); }
#pragma unroll
        for (int k = 0; k < 3; ++k)
#pragma unroll
            for (int i = 0; i < 4; ++i) FX_ACC8(rb[k][i], i);
#undef FX_ACC8
        float ss = 0.f;
#pragma unroll
        for (int j = 0; j < 32; ++j) ss += yv[j] * yv[j];
        ss = wave_sum(ss); const float ry = rsqrtf(ss * (1.f / 2048.f) + EPS); float ssx = 0.f;
#pragma unroll
        for (int i = 0; i < 4; ++i) { const u32x4 w = xw[i];
            const float xs[8] = {bflo(w.x), bfhi(w.x), bflo(w.y), bfhi(w.y), bflo(w.z), bfhi(w.z), bflo(w.w), bfhi(w.w)};
#pragma unroll
            for (int j = 0; j < 8; ++j) { yv[i * 8 + j] = xs[j] + cd[2 * i + (j >> 2)][j & 3] * (yv[i * 8 + j] * ry); ssx += yv[i * 8 + j] * yv[i * 8 + j]; } }
        f32x4 ce[8], cg[8];
        if (coef_next) { const float* cn = coef_next + (size_t)b * 6 * 2048;
#pragma unroll
            for (int i = 0; i < 4; ++i) { ce[2 * i] = *FX_GC(f32x4, cn + 4 * 2048 + i * 512 + lane * 8); ce[2 * i + 1] = *FX_GC(f32x4, cn + 4 * 2048 + i * 512 + lane * 8 + 4);
                cg[2 * i] = *FX_GC(f32x4, cn + 5 * 2048 + i * 512 + lane * 8); cg[2 * i + 1] = *FX_GC(f32x4, cn + 5 * 2048 + i * 512 + lane * 8 + 4); } }
#pragma unroll
        for (int i = 0; i < 4; ++i) { const int c = i * 512 + lane * 8;
            if constexpr (OUTF32) { float* xout = (float*)xout_; *FX_GM(f32x4, xout + (size_t)t * 2048 + c) = (f32x4){yv[i * 8 + 0], yv[i * 8 + 1], yv[i * 8 + 2], yv[i * 8 + 3]};
                *FX_GM(f32x4, xout + (size_t)t * 2048 + c + 4) = (f32x4){yv[i * 8 + 4], yv[i * 8 + 5], yv[i * 8 + 6], yv[i * 8 + 7]}; }
            else { u32x4 xo; xo.x = cvt_pk_bf16(yv[i * 8 + 0], yv[i * 8 + 1]); xo.y = cvt_pk_bf16(yv[i * 8 + 2], yv[i * 8 + 3]); xo.z = cvt_pk_bf16(yv[i * 8 + 4], yv[i * 8 + 5]); xo.w = cvt_pk_bf16(yv[i * 8 + 6], yv[i * 8 + 7]);
                *FX_GM(u32x4, (bf16_t*)xout_ + (size_t)t * 2048 + c) = xo; } }
        if (coef_next) { ssx = wave_sum(ssx); const float rx = rsqrtf(ssx * (1.f / 2048.f) + EPS);
#pragma unroll
            for (int i = 0; i < 4; ++i) { const int c = i * 512 + lane * 8;
                float hv[8];
#pragma unroll
                for (int j = 0; j < 8; ++j) hv[j] = yv[i * 8 + j] * rx * ce[2 * i + (j >> 2)][j & 3] + cg[2 * i + (j >> 2)][j & 3];
#ifdef FX_WIN8
                u32x2 w; w.x = cvt_pk4_fp8(hv[0], hv[1], hv[2], hv[3]); w.y = cvt_pk4_fp8(hv[4], hv[5], hv[6], hv[7]);
                *FX_GM(u32x2, (unsigned char*)HA + (size_t)t * 2048 + c) = w; } }
#else
                u32x4 w; w.x = cvt_pk_bf16(hv[0], hv[1]); w.y = cvt_pk_bf16(hv[2], hv[3]); w.z = cvt_pk_bf16(hv[4], hv[5]); w.w = cvt_pk_bf16(hv[6], hv[7]);
                *FX_GM(u32x4, HA + (size_t)t * 2048 + c) = w; } }
#endif
    }
}
}
namespace fx {
#ifndef FX_SD_A
#define FX_SD_A 2
#endif
#ifndef FX_SD_B
#define FX_SD_B 1
#endif
#ifndef FX_NQR_B
#define FX_NQR_B 8
#endif
#define FX_SBAR() __builtin_amdgcn_sched_barrier(0)
__device__ __forceinline__ int crow(int r, int hi) { return (r & 3) + 8 * (r >> 2) + 4 * hi; }
__device__ __forceinline__ int v_st(int k, int c) { const int kk = (k & ~0xC) | ((k & 4) << 1) | ((k & 8) >> 1); return ((kk >> 3) * 4 + (c >> 5)) * 512 + ((kk & 7) * 32 + (c & 31)) * 2; }
__device__ __forceinline__ int v_rd_base(int lane) { return ((lane & 3) << 3) | (((lane >> 2) & 3) << 6) | (((lane >> 4) & 1) << 5) | (((lane >> 5) & 1) << 8); }
constexpr int v_rd_off(int d0, int ks, int half) { return d0 * 512 + ks * 4096 + half * 2048; }
template <int OFF> __device__ __forceinline__ s16x4 tr_read(int vb) { s16x4 r; asm volatile("ds_read_b64_tr_b16 %0, %1 offset:%2" : "=&v"(r) : "v"(vb), "i"(OFF) : "memory"); return r; }
#define FX_PK(L, H) (bf16x8){L[0], L[1], L[2], L[3], H[0], H[1], H[2], H[3]}
template <int D0> __device__ __forceinline__ void pv_one(f32x16& od, int vb, bf16x8 pa0, bf16x8 pa1, bf16x8 pa2, bf16x8 pa3) {
    const s16x4 l0 = tr_read<v_rd_off(D0, 0, 0)>(vb), h0 = tr_read<v_rd_off(D0, 0, 1)>(vb), l1 = tr_read<v_rd_off(D0, 1, 0)>(vb), h1 = tr_read<v_rd_off(D0, 1, 1)>(vb);
    const s16x4 l2 = tr_read<v_rd_off(D0, 2, 0)>(vb), h2 = tr_read<v_rd_off(D0, 2, 1)>(vb), l3 = tr_read<v_rd_off(D0, 3, 0)>(vb), h3 = tr_read<v_rd_off(D0, 3, 1)>(vb);
    asm volatile("s_waitcnt lgkmcnt(0)" ::: "memory"); FX_SBAR();
    od = __builtin_amdgcn_mfma_f32_32x32x16_bf16(pa0, FX_PK(l0, h0), od, 0, 0, 0);
    od = __builtin_amdgcn_mfma_f32_32x32x16_bf16(pa1, FX_PK(l1, h1), od, 0, 0, 0);
    od = __builtin_amdgcn_mfma_f32_32x32x16_bf16(pa2, FX_PK(l2, h2), od, 0, 0, 0);
    od = __builtin_amdgcn_mfma_f32_32x32x16_bf16(pa3, FX_PK(l3, h3), od, 0, 0, 0);
}
__device__ __forceinline__ void pv_d0(f32x16* o, int vb, bf16x8 pa0, bf16x8 pa1, bf16x8 pa2, bf16x8 pa3) {
    pv_one<0>(o[0], vb, pa0, pa1, pa2, pa3); pv_one<1>(o[1], vb, pa0, pa1, pa2, pa3); pv_one<2>(o[2], vb, pa0, pa1, pa2, pa3); pv_one<3>(o[3], vb, pa0, pa1, pa2, pa3);
}
#define FX_PK4(P, BASE, OUT) do { unsigned a0 = cvt_pk_bf16(P[BASE + 0], P[BASE + 1]), a1 = cvt_pk_bf16(P[BASE + 2], P[BASE + 3]);   \
    unsigned b0 = cvt_pk_bf16(P[BASE + 4], P[BASE + 5]), b1 = cvt_pk_bf16(P[BASE + 6], P[BASE + 7]);                              \
    auto r0 = __builtin_amdgcn_permlane32_swap(a0, b0, false, false); auto r1 = __builtin_amdgcn_permlane32_swap(a1, b1, false, false); \
    u32x4 w = {r0[0], r1[0], r0[1], r1[1]}; OUT = *reinterpret_cast<bf16x8*>(&w); } while (0)

template <int DQK> struct AttnC {
    static constexpr int NQ = DQK / 16, KROW = DQK * 2, SHM_V = 64 * 128 * 2, SHM_K = 64 * DQK * 2, NQR = (DQK == 128 ? 8 : FX_NQR_B)  , QX = (NQ - NQR) * 8 * 64 * 16, SHM = 2 * SHM_V + 2 * SHM_K + 8 * 64 * 4 + QX;
    static constexpr float SCALE = DQK == 128 ? 0.088388347648318440f : 0.072168783648703220f;
    static constexpr float THR = 8.f;
};
#define FX_KSWZ(row, colB) ((row) * C::KROW + ((colB) ^ (((row) & 7) << 4)))

template <int DQK> __device__ __forceinline__ void partialSM(f32x16& p0, f32x16& p1, float& m_reg, float& mn, float& alpha) {
    using C = AttnC<DQK>;
    constexpr float Cc = C::SCALE * 1.4426950408889634f;
    float pmax = p0[0];
#pragma unroll
    for (int r = 1; r < 16; ++r) pmax = fmaxf(pmax, p0[r]);
#pragma unroll
    for (int r = 0; r < 16; ++r) pmax = fmaxf(pmax, p1[r]);
    { auto rr = __builtin_amdgcn_permlane32_swap(__float_as_uint(pmax), __float_as_uint(pmax), false, false); pmax = fmaxf(__uint_as_float(rr[0]), __uint_as_float(rr[1])); }
    if (__builtin_expect(__all(pmax - m_reg <= C::THR / C::SCALE), 1)) { mn = m_reg; alpha = 1.f; }
    else { mn = fmaxf(m_reg, pmax); alpha = __builtin_amdgcn_exp2f((m_reg - mn) * Cc); m_reg = mn; }
    const float mnC = -mn * Cc;
#pragma unroll
    for (int r = 0; r < 16; ++r) p0[r] = fmaf(p0[r], Cc, mnC);
#pragma unroll
    for (int r = 0; r < 16; ++r) p1[r] = fmaf(p1[r], Cc, mnC);
#pragma unroll
    for (int r = 0; r < 16; ++r) p0[r] = __builtin_amdgcn_exp2f(p0[r]);
}
__device__ __forceinline__ void finishSM(f32x16& p0, f32x16& p1, float alpha, float& l_reg, bf16x8& pa0, bf16x8& pa1, bf16x8& pa2, bf16x8& pa3) {
#pragma unroll
    for (int r = 0; r < 16; ++r) p1[r] = __builtin_amdgcn_exp2f(p1[r]);
    float ps = 0;
#pragma unroll
    for (int r = 0; r < 16; ++r) ps += p0[r];
#pragma unroll
    for (int r = 0; r < 16; ++r) ps += p1[r];
    { auto rr = __builtin_amdgcn_permlane32_swap(__float_as_uint(ps), __float_as_uint(ps), false, false); ps = __uint_as_float(rr[0]) + __uint_as_float(rr[1]); }
    l_reg = l_reg * alpha + ps;
    FX_PK4(p0, 0, pa0); FX_PK4(p0, 8, pa1); FX_PK4(p1, 0, pa2); FX_PK4(p1, 8, pa3);
}
template <int DQK> __device__ __forceinline__ void qkt(f32x16& p0, f32x16& p1, const char* Ks, const bf16x8* qr, const char* qx  , int r32, int hi) {
    using C = AttnC<DQK>;
    p0 = f32x16{}; p1 = f32x16{};
#pragma unroll
    for (int d0 = 0; d0 < C::NQ; ++d0) { const int cb = (d0 * 16 + hi * 8) * 2;
        const bf16x8 qf = d0 < C::NQR ? qr[d0 < C::NQR ? d0 : 0] : *reinterpret_cast<const bf16x8*>(qx + (d0 - C::NQR) * 1024);
        const bf16x8 b0 = *reinterpret_cast<const bf16x8*>(Ks + FX_KSWZ(r32, cb));
        const bf16x8 b1 = *reinterpret_cast<const bf16x8*>(Ks + FX_KSWZ(32 + r32, cb));
        p0 = __builtin_amdgcn_mfma_f32_32x32x16_bf16(b0, qf, p0, 0, 0, 0);
        p1 = __builtin_amdgcn_mfma_f32_32x32x16_bf16(b1, qf, p1, 0, 0, 0); }
}

template <int DQK, int SD, int LDQ, int LDK1, int LDK2, int LDV>
__device__ __forceinline__ void attn_unit(const bf16_t* __restrict__ Qb, const bf16_t* __restrict__ K1, const bf16_t* __restrict__ K2, const bf16_t* __restrict__ Vh,
                                          bf16_t* __restrict__ Ob, const float* __restrict__ gain, int seq, char* lds, int tidp) {
    using C = AttnC<DQK>;
    int tid_ = tidp; asm volatile("" : "+v"(tid_));
    const int tid = tid_, wid = __builtin_amdgcn_readfirstlane(tid >> 6)  , lane = tid & 63, r32 = lane & 31, hi = lane >> 5;
    char* V_lds = lds; char* K_lds = lds + 2 * C::SHM_V;
    float* ws = (float*)(lds + 2 * C::SHM_V + 2 * C::SHM_K) + wid * 64; float* li_l = ws; float* al_l = ws + 32;
    float m_reg = -1e30f, l_reg = 0; f32x16 o[4] = {}; bf16x8 qr[C::NQR];
    char* qx = lds + 2 * C::SHM_V + 2 * C::SHM_K + 8 * 64 * 4 + wid * ((C::NQ - C::NQR) * 1024) + lane * 16;
    const bf16_t* Qw = Qb + (long)(wid * 32 + r32) * LDQ + hi * 8;
#pragma unroll
    for (int d0 = 0; d0 < C::NQR; ++d0) qr[d0] = *reinterpret_cast<const bf16x8*>(Qw + d0 * 16);
#pragma unroll
    for (int d0 = C::NQR; d0 < C::NQ; ++d0) *reinterpret_cast<bf16x8*>(qx + (d0 - C::NQR) * 1024) = *reinterpret_cast<const bf16x8*>(Qw + d0 * 16);
    const int sr = tid >> 4, sc = (tid & 15) * 8, vst0 = v_st(sr, sc), vst1 = v_st(32 + sr, sc);
    const int vb0 = (int)(uintptr_t)V_lds + v_rd_base(lane);
    const int xr = tid >> 3, xc = (tid & 7) * 8;
    struct { bf16x8 vs0, vs1, ks0, ks1, kx; } sr_[SD];
#define FX_SLOAD(i, k0) do { sr_[i].vs0 = *reinterpret_cast<const bf16x8*>(&Vh[(long)((k0) + sr) * LDV + sc]); sr_[i].vs1 = *reinterpret_cast<const bf16x8*>(&Vh[(long)((k0) + 32 + sr) * LDV + sc]); \
    sr_[i].ks0 = *reinterpret_cast<const bf16x8*>(&K1[(long)((k0) + sr) * LDK1 + sc]); sr_[i].ks1 = *reinterpret_cast<const bf16x8*>(&K1[(long)((k0) + 32 + sr) * LDK1 + sc]); \
    if (DQK == 192) sr_[i].kx = *reinterpret_cast<const bf16x8*>(&K2[(long)((k0) + xr) * LDK2 + xc]); } while (0)
#define FX_SWRITE(b, i) do { *(bf16x8*)(V_lds + (b) * C::SHM_V + vst0) = sr_[i].vs0; *(bf16x8*)(V_lds + (b) * C::SHM_V + vst1) = sr_[i].vs1; const int kc = sc * 2; \
    *(bf16x8*)(K_lds + (b) * C::SHM_K + FX_KSWZ(sr, kc)) = sr_[i].ks0; *(bf16x8*)(K_lds + (b) * C::SHM_K + FX_KSWZ(32 + sr, kc)) = sr_[i].ks1; \
    if (DQK == 192) *(bf16x8*)(K_lds + (b) * C::SHM_K + FX_KSWZ(xr, 256 + xc * 2)) = sr_[i].kx; } while (0)
#define FX_SWAIT() do { if (SD == 1) asm volatile("s_waitcnt vmcnt(0)" ::: "memory"); else if (DQK == 192) asm volatile("s_waitcnt vmcnt(5)" ::: "memory"); else asm volatile("s_waitcnt vmcnt(4)" ::: "memory"); } while (0)
#define FX_RESC(a) do { if (__any((a) < 1.f)) { if (hi == 0) al_l[r32] = (a); asm volatile("s_waitcnt lgkmcnt(0)" ::: "memory"); \
    _Pragma("unroll") for (int d = 0; d < 4; ++d) _Pragma("unroll") for (int r = 0; r < 16; ++r) o[d][r] *= al_l[crow(r, hi)]; } } while (0)
    f32x16 pA0, pA1, pB0, pB1; float mnA, mnB, alA, alB; bf16x8 pa0, pa1, pa2, pa3; const int NT = seq / 64;
    constexpr int SE = 0, SO = SD - 1;
    FX_SLOAD(SE, 0); asm volatile("s_waitcnt vmcnt(0)" ::: "memory"); FX_SWRITE(0, SE); __syncthreads();
    qkt<DQK>(pA0, pA1, K_lds, qr, qx, r32, hi); partialSM<DQK>(pA0, pA1, m_reg, mnA, alA);
    FX_SLOAD(SO, 64); if (SD == 2) { if (2 < NT) FX_SLOAD(SE, 128); }
    FX_SWAIT(); FX_SWRITE(1, SO); __syncthreads();
    for (int j = 1; j + 1 < NT; j += 2) {
        FX_SBAR(); qkt<DQK>(pB0, pB1, K_lds + C::SHM_K, qr, qx, r32, hi);
        finishSM(pA0, pA1, alA, l_reg, pa0, pa1, pa2, pa3); FX_SBAR();
        FX_SLOAD(SO, (j + SD) * 64); FX_SBAR();
        pv_d0(o, vb0, pa0, pa1, pa2, pa3); partialSM<DQK>(pB0, pB1, m_reg, mnB, alB);
        __syncthreads(); FX_SWAIT(); FX_SWRITE(0, SE);
        FX_RESC(alB); __syncthreads();
        FX_SBAR(); qkt<DQK>(pA0, pA1, K_lds, qr, qx, r32, hi);
        finishSM(pB0, pB1, alB, l_reg, pa0, pa1, pa2, pa3); FX_SBAR();
        if (SD == 1 || j + 3 < NT) FX_SLOAD(SE, (j + 1 + SD) * 64); FX_SBAR();
        pv_d0(o, vb0 + C::SHM_V, pa0, pa1, pa2, pa3); partialSM<DQK>(pA0, pA1, m_reg, mnA, alA);
        __syncthreads(); FX_SWAIT(); FX_SWRITE(1, SO);
        FX_RESC(alA); __syncthreads();
    }
    FX_SBAR(); qkt<DQK>(pB0, pB1, K_lds + C::SHM_K, qr, qx, r32, hi);
    finishSM(pA0, pA1, alA, l_reg, pa0, pa1, pa2, pa3); FX_SBAR();
    pv_d0(o, vb0, pa0, pa1, pa2, pa3); partialSM<DQK>(pB0, pB1, m_reg, mnB, alB);
    __syncthreads(); FX_RESC(alB);
    finishSM(pB0, pB1, alB, l_reg, pa0, pa1, pa2, pa3); FX_SBAR();
    pv_d0(o, vb0 + C::SHM_V, pa0, pa1, pa2, pa3);
    if (hi == 0) li_l[r32] = l_reg; asm volatile("s_waitcnt lgkmcnt(0)" ::: "memory");
    int r32e = r32; asm volatile("" : "+v"(r32e));
    float g4[4];
#pragma unroll
    for (int d0 = 0; d0 < 4; ++d0) g4[d0] = gain[d0 * 32 + r32e];
    bf16_t* Ow = Ob + (long)(wid * 32) * 2048;
#pragma unroll
    for (int r = 0; r < 16; ++r) { const float rl = __builtin_amdgcn_rcpf(li_l[crow(r, hi)]);
        float ss = 0.f;
#pragma unroll
        for (int d0 = 0; d0 < 4; ++d0) { o[d0][r] *= rl; ss += o[d0][r] * o[d0][r]; }
        ss += __shfl_xor(ss, 1); ss += __shfl_xor(ss, 2); ss += __shfl_xor(ss, 4); ss += __shfl_xor(ss, 8); ss += __shfl_xor(ss, 16);
        const float rn = rsqrtf(ss * (1.f / 128.f) + EPS); const int orow = crow(r, hi);
#pragma unroll
#ifdef FX_WOUT8
        for (int d0 = 0; d0 < 4; ++d0) ((unsigned char*)Ob)[(long)(wid * 32 + orow) * 2048 + d0 * 32 + r32e] = (unsigned char)(__builtin_amdgcn_cvt_pk_fp8_f32(o[d0][r] * rn * g4[d0], 0.f, 0, false) & 0xff); }
#else
        for (int d0 = 0; d0 < 4; ++d0) Ow[(long)orow * 2048 + d0 * 32 + r32e] = f2bf(o[d0][r] * rn * g4[d0]); }
#endif
    __syncthreads();
#undef FX_SLOAD
#undef FX_SWRITE
#undef FX_SWAIT
#undef FX_RESC
}

__device__ __forceinline__ void attn_gqa_unit(int u, const bf16_t* QA, const bf16_t* KA, const bf16_t* PROJ, bf16_t* YM, const float* hog, char* lds, int tidp) {
    const int qb = u & 15, hh = (u >> 4) % 6, b = u / 96, kvh = hh / 3;
    const size_t t0 = (size_t)b * S;
    attn_unit<128, FX_SD_A, 768, 256, 0, PW>(QA + (t0 + qb * 256) * 768 + hh * 128, KA + t0 * 256 + kvh * 128, nullptr, PROJ + t0 * PW + O_AV + kvh * 128,
#ifdef FX_WOUT8
                                    (bf16_t*)((unsigned char*)YM + (t0 + qb * 256) * 2048 + hh * 128), hog + hh * 128, S, lds, tidp);
#else
                                    YM + (t0 + qb * 256) * 2048 + hh * 128, hog + hh * 128, S, lds, tidp);
#endif
}
__device__ __forceinline__ void attn_mla_unit(int u, const bf16_t* QB, const bf16_t* KVB, const bf16_t* KR, bf16_t* YM, const float* hog, char* lds, int tidp) {
    const int qb = u & 15, hh = (u >> 4) % 6, b = u / 96;
    const size_t t0 = (size_t)b * S;
    attn_unit<192, FX_SD_B, 1280, 1536, 64, 1536>(QB + (t0 + qb * 256) * 1280 + hh * 192, KVB + t0 * 1536 + hh * 256, KR + t0 * 64, KVB + t0 * 1536 + hh * 256 + 128,
#ifdef FX_WOUT8
                                         (bf16_t*)((unsigned char*)YM + (t0 + qb * 256) * 2048 + 768 + hh * 128), hog + 768 + hh * 128, S, lds, tidp);
#else
                                         YM + (t0 + qb * 256) * 2048 + 768 + hh * 128, hog + 768 + hh * 128, S, lds, tidp);
#endif
}
}
namespace fx {
constexpr int P3_LDS = 4096 + 2048 + 65536 + 32768;
constexpr float KSCALE = 0.08838834764831845f;
__device__ __forceinline__ float logsigmoid_f(float f) { return fminf(f, 0.f) - log1pf(__expf(-fabsf(f))); }
__device__ __forceinline__ float wave_scan_incl(float v, int lane) {
#pragma unroll
    for (int o = 1; o < 64; o <<= 1) { const float t = __shfl_up(v, o); if (lane >= o) v += t; }
    return v;
}
__device__ __forceinline__ float wave_scanmax_incl(float v, int lane) {
#pragma unroll
    for (int o = 1; o < 64; o <<= 1) { const float t = __shfl_up(v, o); if (lane >= o) v = fmaxf(v, t); }
    return v;
}
__device__ __forceinline__ float wave_rscanmax_incl(float v, int lane) {
#pragma unroll
    for (int o = 1; o < 64; o <<= 1) { const float t = __shfl_down(v, o); if (lane + o < 64) v = fmaxf(v, t); }
    return v;
}

struct P3Args {
    const bf16_t* PROJ; const float* GATES; const float* gate_b; const float* conv_w; const float* conv_b;
    const float* aq_gain; const float* ak_gain; const float* cq_gain; const float* ckv_gain;
    const float* cosA; const float* sinA; const float* cosB; const float* sinB;
    bf16_t* QA; bf16_t* KA; bf16_t* CQN; bf16_t* CKVN; bf16_t* KR; bf16_t* QC; bf16_t* KC; bf16_t* KCT; float* NLOC; float* GSC;
};
__device__ __forceinline__ void p3_phase(FX_LAS unsigned char* lds_, const P3Args& a, int wg, int nwg, int tidp) {
    char* lds = (char*)lds_;
    float* gat = (float*)lds; float* wts = (float*)(lds + 4096); char* ktile = lds + 6144; char* wv = lds + 6144 + 65536;
    for (int unit = wg; unit < T / 64; unit += nwg) {
        int tid_ = tidp; asm volatile("" : "+v"(tid_));
        const int tid = tid_, wid = tid >> 6, lane = tid & 63;
        const int b = unit >> 6, co = unit & 63; const size_t t0 = (size_t)unit * 64;
        for (int i = tid; i < 1024; i += 512) gat[i] = a.GATES[t0 * 16 + i] + a.gate_b[i & 15];
        __syncthreads();
        { const int dir = wid >> 2, h = wid & 3;
          const float logi = gat[lane * 16 + (dir * 2) * 4 + h], logf = logsigmoid_f(gat[lane * 16 + (dir * 2 + 1) * 4 + h]);
          const float pre = wave_scan_incl(logf, lane), g = __shfl(pre, 63);
          const float bb = dir ? (g - pre + logf) : pre;
          const float av = g - bb + logi, mloc = wave_max(av);
          wts[wid * 64 + lane] = __expf(av - mloc);
          if (lane == 0) { const int chain = (b * 4 + h) * 2 + dir, ci = dir ? 63 - co : co; a.GSC[(chain * 64 + ci) * 2] = g; a.GSC[(chain * 64 + ci) * 2 + 1] = mloc; } }
        __syncthreads();
        { const int c0 = 2 * tid; const bool isk = c0 >= 512; const int hk = (c0 - 512) >> 7, dk = (c0 - 512) & 127;
          float w0[5], w1[5];
#pragma unroll
          for (int j = 0; j < 5; ++j) { w0[j] = a.conv_w[j * 1024 + c0]; w1[j] = a.conv_w[j * 1024 + c0 + 1]; }
          const float cb0 = a.conv_b[c0], cb1 = a.conv_b[c0 + 1];
          float x0[5], x1[5];
          const bf16_t* src = a.PROJ + t0 * PW + O_CQ + c0;
#pragma unroll
          for (int j = 0; j < 4; ++j) { const int sa = co * 64 + j - 2; unsigned w = 0u; if (sa >= 0 && sa < S) w = *(const unsigned*)(src + (long)(j - 2) * PW); x0[j + 1] = bflo(w); x1[j + 1] = bfhi(w); }
          float nf0 = 0.f, nf1 = 0.f, nb0 = 0.f, nb1 = 0.f;
#pragma unroll 1
          for (int s0 = 0; s0 < 64; s0 += 16) {
              unsigned wl[16];
#pragma unroll
              for (int q = 0; q < 16; ++q) { const int sa = co * 64 + s0 + q + 2; wl[q] = 0u; if (sa < S) wl[q] = *(const unsigned*)(src + (long)(s0 + q + 2) * PW); }
#pragma unroll
              for (int q = 0; q < 16; ++q) { const int s = s0 + q;
#pragma unroll
                  for (int j = 0; j < 4; ++j) { x0[j] = x0[j + 1]; x1[j] = x1[j + 1]; }
                  x0[4] = bflo(wl[q]); x1[4] = bfhi(wl[q]);
                  float y0 = cb0, y1 = cb1;
#pragma unroll
                  for (int j = 0; j < 5; ++j) { y0 += w0[j] * x0[j]; y1 += w1[j] * x1[j]; }
                  y0 = silu_f(y0); y1 = silu_f(y1);
                  if (!isk) { *(unsigned*)(a.QC + (t0 + s) * 512 + c0) = cvt_pk_bf16(y0, y1); }
                  else { y0 *= KSCALE; y1 *= KSCALE; const unsigned pk = cvt_pk_bf16(y0, y1);
                      *(unsigned*)(a.KC + (t0 + s) * 512 + (c0 - 512)) = pk;
                      *(unsigned*)(ktile + hk * 16384 + v_st(s, dk & ~7) + (dk & 7) * 2) = pk;
                      const float k0 = bflo(pk), k1 = bfhi(pk); const float wf = wts[hk * 64 + s], wb = wts[(4 + hk) * 64 + s];
                      nf0 += wf * k0; nf1 += wf * k1; nb0 += wb * k0; nb1 += wb * k1; } }
          }
          if (isk) { const int chf = (b * 4 + hk) * 2, chb = chf + 1;
              *(f32x2*)(a.NLOC + ((size_t)chf * 64 + co) * 128 + dk) = (f32x2){nf0, nf1};
              *(f32x2*)(a.NLOC + ((size_t)chb * 64 + (63 - co)) * 128 + dk) = (f32x2){nb0, nb1}; } }
        __syncthreads();
#pragma unroll 1
        for (int h = 0; h < 4; ++h) {
            { const int sr = tid >> 4, sc = (tid & 15) * 8;
#pragma unroll
              for (int rr = 0; rr < 2; ++rr) { const int s = sr + 32 * rr;
                const u32x4 vw = *(const u32x4*)(a.PROJ + (t0 + s) * PW + O_CV + h * 128 + sc);
                const float wf = wts[h * 64 + s], wb = wts[(4 + h) * 64 + s];
                float v[8] = {bflo(vw.x), bfhi(vw.x), bflo(vw.y), bfhi(vw.y), bflo(vw.z), bfhi(vw.z), bflo(vw.w), bfhi(vw.w)};
                u32x4 of, ob;
                of.x = cvt_pk_bf16(v[0] * wf, v[1] * wf); of.y = cvt_pk_bf16(v[2] * wf, v[3] * wf); of.z = cvt_pk_bf16(v[4] * wf, v[5] * wf); of.w = cvt_pk_bf16(v[6] * wf, v[7] * wf);
                ob.x = cvt_pk_bf16(v[0] * wb, v[1] * wb); ob.y = cvt_pk_bf16(v[2] * wb, v[3] * wb); ob.z = cvt_pk_bf16(v[4] * wb, v[5] * wb); ob.w = cvt_pk_bf16(v[6] * wb, v[7] * wb);
                *(u32x4*)(wv + v_st(s, sc)) = of; *(u32x4*)(wv + 16384 + v_st(s, sc)) = ob; } }
            __syncthreads();
            { const int dir = wid >> 2, mb = wid & 3, r32 = lane & 31, hi = lane >> 5;
              const int va = (int)(uintptr_t)(wv + dir * 16384) + v_rd_base(lane) + mb * 512;
              const int kb = (int)(uintptr_t)(ktile + h * 16384) + v_rd_base(lane);
              f32x16 acc[4] = {};
#define FX_KC_STEP(KS) do { \
              const s16x4 al = tr_read<v_rd_off(0, KS, 0)>(va), ah = tr_read<v_rd_off(0, KS, 1)>(va); \
              const s16x4 b0l = tr_read<v_rd_off(0, KS, 0)>(kb), b0h = tr_read<v_rd_off(0, KS, 1)>(kb), b1l = tr_read<v_rd_off(1, KS, 0)>(kb), b1h = tr_read<v_rd_off(1, KS, 1)>(kb); \
              const s16x4 b2l = tr_read<v_rd_off(2, KS, 0)>(kb), b2h = tr_read<v_rd_off(2, KS, 1)>(kb), b3l = tr_read<v_rd_off(3, KS, 0)>(kb), b3h = tr_read<v_rd_off(3, KS, 1)>(kb); \
              asm volatile("s_waitcnt lgkmcnt(0)" ::: "memory"); FX_SBAR(); \
              const bf16x8 af = FX_PK(al, ah); \
              acc[0] = __builtin_amdgcn_mfma_f32_32x32x16_bf16(af, FX_PK(b0l, b0h), acc[0], 0, 0, 0); acc[1] = __builtin_amdgcn_mfma_f32_32x32x16_bf16(af, FX_PK(b1l, b1h), acc[1], 0, 0, 0); \
              acc[2] = __builtin_amdgcn_mfma_f32_32x32x16_bf16(af, FX_PK(b2l, b2h), acc[2], 0, 0, 0); acc[3] = __builtin_amdgcn_mfma_f32_32x32x16_bf16(af, FX_PK(b3l, b3h), acc[3], 0, 0, 0); } while (0)
              FX_KC_STEP(0); FX_KC_STEP(1); FX_KC_STEP(2); FX_KC_STEP(3);
#undef FX_KC_STEP
              const int chain = (b * 4 + h) * 2 + dir, ci = dir ? 63 - co : co;
              bf16_t* dst = a.KCT + ((size_t)chain * 64 + ci) * 16384 + (size_t)(mb * 32) * 128 + r32;
#pragma unroll
              for (int r = 0; r < 16; ++r) { const int v = crow(r, hi);
#pragma unroll
                  for (int nb = 0; nb < 4; ++nb) dst[v * 128 + nb * 32] = f2bf(acc[nb][r]); } }
            __syncthreads();
        }
        { const int hd = __builtin_amdgcn_readfirstlane(wid), l16 = lane & 15, tq = lane >> 4, e0 = 8 * l16, hf = e0 >> 6, f0 = e0 & 31; const bool second = (e0 & 32) != 0;
          const float* g = hd < 6 ? a.aq_gain : a.ak_gain;
          const f32x4 g0 = *(const f32x4*)(g + e0), g1 = *(const f32x4*)(g + e0 + 4);
#pragma unroll 4
          for (int p = 0; p < 16; ++p) { const int s = 4 * p + tq; const size_t t = t0 + s;
            const u32x4 xw = *(const u32x4*)(a.PROJ + t * PW + hd * 128 + e0);
            const int pos = hf ? s : co;
            const f32x4 c0 = *(const f32x4*)(a.cosA + pos * 32 + f0), c1 = *(const f32x4*)(a.cosA + pos * 32 + f0 + 4), s0 = *(const f32x4*)(a.sinA + pos * 32 + f0), s1 = *(const f32x4*)(a.sinA + pos * 32 + f0 + 4);
            float x[8] = {bflo(xw.x), bfhi(xw.x), bflo(xw.y), bfhi(xw.y), bflo(xw.z), bfhi(xw.z), bflo(xw.w), bfhi(xw.w)};
            float ss = 0.f;
#pragma unroll
            for (int j = 0; j < 8; ++j) ss += x[j] * x[j];
            ss += __shfl_xor(ss, 1); ss += __shfl_xor(ss, 2); ss += __shfl_xor(ss, 4); ss += __shfl_xor(ss, 8);
            const float r = rsqrtf(ss * (1.f / 128.f) + EPS);
            float o[8];
#pragma unroll
            for (int j = 0; j < 8; ++j) { x[j] *= r * (j < 4 ? g0[j & 3] : g1[j & 3]); }
#pragma unroll
            for (int j = 0; j < 8; ++j) { const float y = __shfl_xor(x[j], 4), cs = j < 4 ? c0[j & 3] : c1[j & 3], sn = j < 4 ? s0[j & 3] : s1[j & 3]; o[j] = second ? (x[j] * cs + y * sn) : (x[j] * cs - y * sn); }
            u32x4 w; w.x = cvt_pk_bf16(o[0], o[1]); w.y = cvt_pk_bf16(o[2], o[3]); w.z = cvt_pk_bf16(o[4], o[5]); w.w = cvt_pk_bf16(o[6], o[7]);
            bf16_t* dst = hd < 6 ? a.QA + t * 768 + hd * 128 + e0 : a.KA + t * 256 + (hd - 6) * 128 + e0;
            *(u32x4*)dst = w; } }
#pragma unroll 4
        for (int s = wid; s < 64; s += 8) { const size_t t = t0 + s; const bf16_t* p = a.PROJ + t * PW;
            float q[6]; float ss = 0.f;
#pragma unroll
            for (int i = 0; i < 3; ++i) { const unsigned w = *(const unsigned*)(p + O_BCQ + i * 128 + lane * 2); q[2 * i] = bflo(w); q[2 * i + 1] = bfhi(w); ss += q[2 * i] * q[2 * i] + q[2 * i + 1] * q[2 * i + 1]; }
            ss = wave_sum(ss); float r = rsqrtf(ss * (1.f / 384.f) + EPS);
#pragma unroll
            for (int i = 0; i < 3; ++i) { const int c = i * 128 + lane * 2; *(unsigned*)(a.CQN + t * 384 + c) = cvt_pk_bf16(q[2 * i] * r * a.cq_gain[c], q[2 * i + 1] * r * a.cq_gain[c + 1]); }
            float kv[4]; ss = 0.f;
#pragma unroll
            for (int i = 0; i < 2; ++i) { const unsigned w = *(const unsigned*)(p + O_BCKV + i * 128 + lane * 2); kv[2 * i] = bflo(w); kv[2 * i + 1] = bfhi(w); ss += kv[2 * i] * kv[2 * i] + kv[2 * i + 1] * kv[2 * i + 1]; }
            ss = wave_sum(ss); r = rsqrtf(ss * (1.f / 256.f) + EPS);
#pragma unroll
            for (int i = 0; i < 2; ++i) { const int c = i * 128 + lane * 2; *(unsigned*)(a.CKVN + t * 256 + c) = cvt_pk_bf16(kv[2 * i] * r * a.ckv_gain[c], kv[2 * i + 1] * r * a.ckv_gain[c + 1]); }
            if (lane < 32) { const int f = lane & 15, hf = lane >> 4; const int pos = hf ? s : co; const float cs = a.cosB[pos * 16 + f], sn = a.sinB[pos * 16 + f];
                const float x1 = bf2f(p[O_BKR + hf * 32 + f]), x2 = bf2f(p[O_BKR + hf * 32 + 16 + f]);
                a.KR[t * 64 + hf * 32 + f] = f2bf(x1 * cs - x2 * sn); a.KR[t * 64 + hf * 32 + 16 + f] = f2bf(x2 * cs + x1 * sn); } }
        __syncthreads();
    }
}

__device__ __forceinline__ void scan_phase(const bf16_t* KCT, const float* NLOC, const float* GSC, bf16_t* CPREV, float* NPREV, float* MPREV, int gtid, int nthr) {
    for (int item = gtid; item < 32 * 4096; item += nthr) {
        const int chain = item >> 12, e4 = item & 4095;
        const u32x2* src = (const u32x2*)(KCT + (size_t)chain * 64 * 16384) + e4; u32x2* dst = (u32x2*)(CPREV + (size_t)chain * 64 * 16384) + e4;
        const float* gs = GSC + (size_t)chain * 128;
        const bool don = e4 < 128;
        float c0 = 0.f, c1 = 0.f, c2 = 0.f, c3 = 0.f, nn = 0.f, m = 0.f;
#pragma unroll 1
        for (int cb = 0; cb < 64; cb += 8) {
            u32x2 kc[8]; float nl[8];
#pragma unroll
            for (int j = 0; j < 8; ++j) { kc[j] = src[(size_t)(cb + j) * 4096]; nl[j] = don ? NLOC[((size_t)chain * 64 + cb + j) * 128 + e4] : 0.f; }
#pragma unroll
            for (int j = 0; j < 8; ++j) { const int ci = cb + j; const float g = gs[ci * 2], ml = gs[ci * 2 + 1];
                u32x2 o; o.x = cvt_pk_bf16(c0, c1); o.y = cvt_pk_bf16(c2, c3); dst[(size_t)ci * 4096] = o;
                if (don) NPREV[((size_t)chain * 64 + ci) * 128 + e4] = nn;
                if (e4 == 0) MPREV[chain * 64 + ci] = m;
                const float mn = fmaxf(g + m, ml), dec = __expf(g + m - mn), sl = __expf(ml - mn); m = mn;
                c0 = dec * c0 + sl * bflo(kc[j].x); c1 = dec * c1 + sl * bfhi(kc[j].x); c2 = dec * c2 + sl * bflo(kc[j].y); c3 = dec * c3 + sl * bfhi(kc[j].y);
                nn = dec * nn + sl * nl[j]; }
        }
    }
}

constexpr int MC_K = 0, MC_V = 16384, MC_CT = 32768, MC_HS = 98304, MC_HS_LD = 132, MC_SM = MC_HS + 64 * MC_HS_LD * 4, MC_LDS = MC_SM + 4096;
struct McArgs { const bf16_t* PROJ; const float* GATES; const float* gate_b; const bf16_t* QC; const bf16_t* KC; const bf16_t* CPREV; const float* NPREV; const float* MPREV; const float* hog; bf16_t* YM; };
__device__ __forceinline__ void mlstm_c_phase(FX_LAS unsigned char* lds_, const McArgs& a, int wg, int nwg, int tidp) {
    char* lds = (char*)lds_;
    using C = AttnC<128>;
    float* hs = (float*)(lds + MC_HS);
    float* sm = (float*)(lds + MC_SM);
    for (int unit = wg; unit < NB * 4 * 64; unit += nwg) {
        int tid_ = tidp; asm volatile("" : "+v"(tid_));
        const int tid = tid_, wid = tid >> 6, lane = tid & 63, r32 = lane & 31, hi = lane >> 5;
        const int co = unit & 63, h = (unit >> 6) & 3, b = unit >> 8; const size_t t0 = (size_t)b * S + co * 64;
        if (wid < 2) { const int dir = wid; const int chain = (b * 4 + h) * 2 + dir, ci = dir ? 63 - co : co;
            const float logi = a.GATES[(t0 + lane) * 16 + (dir * 2) * 4 + h] + a.gate_b[(dir * 2) * 4 + h];
            const float logf = logsigmoid_f(a.GATES[(t0 + lane) * 16 + (dir * 2 + 1) * 4 + h] + a.gate_b[(dir * 2 + 1) * 4 + h]);
            const float pre = wave_scan_incl(logf, lane), g = __shfl(pre, 63);
            const float bb = dir ? (g - pre + logf) : pre;
            const float u = logi - bb;
            const float M = dir ? wave_rscanmax_incl(u, lane) : wave_scanmax_incl(u, lane);
            const float mp = a.MPREV[chain * 64 + ci], mmj = fmaxf(mp, M);
            sm[dir * 64 + lane] = u; sm[128 + dir * 64 + lane] = mmj; sm[256 + dir * 64 + lane] = __expf(mp - mmj); sm[384 + dir * 64 + lane] = __expf(-(bb + mmj));
            sm[512 + dir * 128 + lane] = a.NPREV[((size_t)chain * 64 + ci) * 128 + lane]; sm[512 + dir * 128 + 64 + lane] = a.NPREV[((size_t)chain * 64 + ci) * 128 + 64 + lane]; }
        { const int sr = tid >> 4, sc = (tid & 15) * 8;
#pragma unroll
          for (int rr = 0; rr < 2; ++rr) { const int s = sr + 32 * rr;
            *(bf16x8*)(lds + MC_K + FX_KSWZ(s, sc * 2)) = *(const bf16x8*)(a.KC + (t0 + s) * 512 + h * 128 + sc);
            *(bf16x8*)(lds + MC_V + v_st(s, sc)) = *(const bf16x8*)(a.PROJ + (t0 + s) * PW + O_CV + h * 128 + sc); }
#pragma unroll
          for (int dir = 0; dir < 2; ++dir) { const int chain = (b * 4 + h) * 2 + dir, ci = dir ? 63 - co : co; const bf16_t* ct = a.CPREV + ((size_t)chain * 64 + ci) * 16384;
#pragma unroll
            for (int rr = 0; rr < 4; ++rr) { const int v = sr + 32 * rr; *(bf16x8*)(lds + MC_CT + dir * 32768 + FX_KSWZ(v, sc * 2)) = *(const bf16x8*)(ct + v * 128 + sc); } } }
        __syncthreads();
        { const int dir = wid >> 2, rb = (wid >> 1) & 1, cb = wid & 1, j = rb * 32 + r32;
          bf16x8 qr[8];
          const bf16_t* Qw = a.QC + (t0 + j) * 512 + h * 128 + hi * 8;
#pragma unroll
          for (int d0 = 0; d0 < 8; ++d0) qr[d0] = *reinterpret_cast<const bf16x8*>(Qw + d0 * 16);
          f32x16 p0, p1;
          qkt<128>(p0, p1, lds + MC_K, qr, nullptr, r32, hi);
          const float mmj = sm[128 + dir * 64 + j], inter = sm[256 + dir * 64 + j], emn = sm[384 + dir * 64 + j];
          float dsum = 0.f;
#pragma unroll
          for (int r = 0; r < 16; ++r) { const int s0 = crow(r, hi), s1 = 32 + s0;
              const bool v0 = dir ? (s0 >= j) : (s0 <= j), v1 = dir ? (s1 >= j) : (s1 <= j);
              const float w0 = v0 ? __expf(sm[dir * 64 + s0] - mmj) : 0.f, w1 = v1 ? __expf(sm[dir * 64 + s1] - mmj) : 0.f;
              p0[r] *= w0; p1[r] *= w1; dsum += p0[r] + p1[r]; }
          float qn = 0.f;
#pragma unroll
          for (int d0 = 0; d0 < 8; ++d0) { const float* np = sm + 512 + dir * 128 + d0 * 16 + hi * 8; const u32x4 w = *reinterpret_cast<const u32x4*>(&qr[d0]);
              qn += bflo(w.x) * np[0] + bfhi(w.x) * np[1] + bflo(w.y) * np[2] + bfhi(w.y) * np[3] + bflo(w.z) * np[4] + bfhi(w.z) * np[5] + bflo(w.w) * np[6] + bfhi(w.w) * np[7]; }
          { auto rr = __builtin_amdgcn_permlane32_swap(__float_as_uint(dsum), __float_as_uint(dsum), false, false); dsum = __uint_as_float(rr[0]) + __uint_as_float(rr[1]); }
          { auto rr = __builtin_amdgcn_permlane32_swap(__float_as_uint(qn), __float_as_uint(qn), false, false); qn = __uint_as_float(rr[0]) + __uint_as_float(rr[1]); }
          const float den = dsum + inter * qn;
          if (hi == 0) sm[768 + wid * 32 + r32] = 1.f / fmaxf(fabsf(den), emn);
          bf16x8 pa0, pa1, pa2, pa3;
          FX_PK4(p0, 0, pa0); FX_PK4(p0, 8, pa1); FX_PK4(p1, 0, pa2); FX_PK4(p1, 8, pa3);
          f32x16 o[2] = {};
          const int vb = (int)(uintptr_t)(lds + MC_V) + v_rd_base(lane) + cb * 1024;
          pv_one<0>(o[0], vb, pa0, pa1, pa2, pa3); pv_one<1>(o[1], vb, pa0, pa1, pa2, pa3);
          const char* ctb = lds + MC_CT + dir * 32768;
#pragma unroll
          for (int ks = 0; ks < 8; ++ks) { const u32x4 w = *reinterpret_cast<const u32x4*>(&qr[ks]); u32x4 sq;
              sq.x = cvt_pk_bf16(bflo(w.x) * inter, bfhi(w.x) * inter); sq.y = cvt_pk_bf16(bflo(w.y) * inter, bfhi(w.y) * inter); sq.z = cvt_pk_bf16(bflo(w.z) * inter, bfhi(w.z) * inter); sq.w = cvt_pk_bf16(bflo(w.w) * inter, bfhi(w.w) * inter);
              const bf16x8 qs = *reinterpret_cast<const bf16x8*>(&sq); const int colB = (ks * 16 + hi * 8) * 2;
              const bf16x8 c0f = *reinterpret_cast<const bf16x8*>(ctb + FX_KSWZ((2 * cb) * 32 + r32, colB));
              const bf16x8 c1f = *reinterpret_cast<const bf16x8*>(ctb + FX_KSWZ((2 * cb + 1) * 32 + r32, colB));
              o[0] = __builtin_amdgcn_mfma_f32_32x32x16_bf16(qs, c0f, o[0], 0, 0, 0);
              o[1] = __builtin_amdgcn_mfma_f32_32x32x16_bf16(qs, c1f, o[1], 0, 0, 0); }
          asm volatile("s_waitcnt lgkmcnt(0)" ::: "memory");
          float rd[16];
#pragma unroll
          for (int r = 0; r < 16; ++r) rd[r] = sm[768 + wid * 32 + crow(r, hi)];
          if (dir == 0) {
#pragma unroll
              for (int r = 0; r < 16; ++r) { const int row = rb * 32 + crow(r, hi);
                  hs[row * MC_HS_LD + (2 * cb) * 32 + r32] = o[0][r] * rd[r]; hs[row * MC_HS_LD + (2 * cb + 1) * 32 + r32] = o[1][r] * rd[r]; } }
          __syncthreads();
          if (dir == 1) {
#pragma unroll
              for (int r = 0; r < 16; ++r) { const int row = rb * 32 + crow(r, hi);
                  hs[row * MC_HS_LD + (2 * cb) * 32 + r32] += o[0][r] * rd[r]; hs[row * MC_HS_LD + (2 * cb + 1) * 32 + r32] += o[1][r] * rd[r]; } }
          __syncthreads(); }
        { const int row = tid >> 3, c0 = (tid & 7) * 16; const size_t t = t0 + row;
          float v[16]; float ss = 0.f;
#pragma unroll
          for (int i = 0; i < 16; ++i) { v[i] = hs[row * MC_HS_LD + c0 + i]; ss += v[i] * v[i]; }
          ss += __shfl_xor(ss, 1); ss += __shfl_xor(ss, 2); ss += __shfl_xor(ss, 4);
          const float rn = rsqrtf(ss * (1.f / 128.f) + EPS);
          const bf16_t* og = a.PROJ + t * PW + O_CO + h * 128 + c0; const float* gn = a.hog + 1536 + h * 128 + c0;
          const u32x4 g0 = *(const u32x4*)og, g1 = *(const u32x4*)(og + 8);
          const float gg[16] = {bflo(g0.x), bfhi(g0.x), bflo(g0.y), bfhi(g0.y), bflo(g0.z), bfhi(g0.z), bflo(g0.w), bfhi(g0.w), bflo(g1.x), bfhi(g1.x), bflo(g1.y), bfhi(g1.y), bflo(g1.z), bfhi(g1.z), bflo(g1.w), bfhi(g1.w)};
          float ov[16];
#pragma unroll
          for (int i = 0; i < 16; ++i) ov[i] = v[i] * rn * gn[i] * sigmoid_f(gg[i]);
          u32x4 w0, w1; w0.x = cvt_pk_bf16(ov[0], ov[1]); w0.y = cvt_pk_bf16(ov[2], ov[3]); w0.z = cvt_pk_bf16(ov[4], ov[5]); w0.w = cvt_pk_bf16(ov[6], ov[7]);
          w1.x = cvt_pk_bf16(ov[8], ov[9]); w1.y = cvt_pk_bf16(ov[10], ov[11]); w1.z = cvt_pk_bf16(ov[12], ov[13]); w1.w = cvt_pk_bf16(ov[14], ov[15]);
#ifdef FX_WOUT8
          { u32x4 w8; w8.x = cvt_pk4_fp8(ov[0], ov[1], ov[2], ov[3]); w8.y = cvt_pk4_fp8(ov[4], ov[5], ov[6], ov[7]); w8.z = cvt_pk4_fp8(ov[8], ov[9], ov[10], ov[11]); w8.w = cvt_pk4_fp8(ov[12], ov[13], ov[14], ov[15]);
            *(u32x4*)((unsigned char*)a.YM + t * 2048 + 1536 + h * 128 + c0) = w8; (void)w0; (void)w1; } }
#else
          bf16_t* dst = a.YM + t * 2048 + 1536 + h * 128 + c0; *(u32x4*)dst = w0; *(u32x4*)(dst + 8) = w1; }
#endif
        __syncthreads();
    }
}
}
namespace fx {
struct EpiQB {
    static constexpr bool PERM = false;
    bf16_t* O; const float* cosB; const float* sinB;
    __device__ __forceinline__ void operator()(const f32x4 (&acc)[2][2][4][2], const Unit& u, int wr, int wc, int fr, int fq) const {
        const int row0 = u.pm * BM + wr * 64 + fr;
#pragma unroll
        for (int bj = 0; bj < 2; ++bj) { const int G = 8 * u.pn + 4 * bj + wc, gm = G % 6; const int col0 = G * 32 + 4 * fq;
#pragma unroll
            for (int ai = 0; ai < 2; ++ai)
#pragma unroll
                for (int m = 0; m < 4; ++m) { const int row = row0 + ai * HALF + m * 16; f32x4 x1 = acc[ai][bj][m][0], x2 = acc[ai][bj][m][1];
                    if (gm >= 4) { const int s = row & (S - 1), pos = gm == 4 ? (s >> 6) : (s & 63);
                        const f32x4 cs = *(const f32x4*)(cosB + pos * 16 + 4 * fq), sn = *(const f32x4*)(sinB + pos * 16 + 4 * fq);
                        const f32x4 o1 = x1 * cs - x2 * sn, o2 = x2 * cs + x1 * sn; x1 = o1; x2 = o2; }
                    bf16_t* rp = O + (size_t)row * 1280 + col0;
                    u32x2 w0, w1; w0.x = cvt_pk_bf16(x1[0], x1[1]); w0.y = cvt_pk_bf16(x1[2], x1[3]); w1.x = cvt_pk_bf16(x2[0], x2[1]); w1.y = cvt_pk_bf16(x2[2], x2[3]);
                    *(u32x2*)rp = w0; *(u32x2*)(rp + 16) = w1; } }
    }
};
constexpr size_t al256(size_t x) { return (x + 255) & ~(size_t)255; }
constexpr size_t WS_BAR = 0;
constexpr size_t WS_MOD = 16384;
constexpr size_t WS_COEF = WS_MOD + al256(2ull * 4 * 12288 * 4);
constexpr size_t WS_TAB = WS_COEF + al256(2ull * 4 * 6 * 2048 * 4);
constexpr size_t WS_CNT = WS_TAB + al256(6144 * 4);
constexpr size_t WS_WGBASE = WS_CNT + 512;
constexpr size_t WS_SELE = WS_WGBASE + 256 * 64 * 4;
constexpr size_t WS_SELG = WS_SELE + (size_t)T * 6 * 4;
constexpr size_t WS_SLOT = WS_SELG + (size_t)T * 6 * 4;
constexpr size_t WS_ROWTOK = WS_SLOT + (size_t)T * 6 * 4;
constexpr size_t WS_ROWG = WS_ROWTOK + (size_t)PTOT * 4;
constexpr size_t WS_GATES = WS_ROWG + (size_t)PTOT * 4;
constexpr size_t WS_GSC = WS_GATES + (size_t)T * 16 * 4;
constexpr size_t WS_MPREV = WS_GSC + 2048 * 2 * 4;
constexpr size_t WS_NLOC = WS_MPREV + 2048 * 4;
constexpr size_t WS_NPREV = WS_NLOC + 2048ull * 128 * 4;
constexpr size_t WS_W = al256(WS_NPREV + 2048ull * 128 * 4);
constexpr size_t W_IN = 0, W_UQ = W_IN + 4096ull * 2048 * 2, W_UKV = W_UQ + 1280ull * 384 * 2, W_OUT = W_UKV + 1536ull * 256 * 2, W_GU = W_OUT + 2048ull * 2048 * 2, W_DN = W_GU + 65ull * 1024 * 2048 * 2, W_LAYER = W_DN + 65ull * 2048 * 512 * 2;
constexpr size_t WS_XRES = WS_W + 2 * W_LAYER;
constexpr size_t WS_HA = WS_XRES + (size_t)T * 2048 * 4;
constexpr size_t WS_R1 = WS_HA + (size_t)T * 2048 * 2;
constexpr size_t WS_R2 = WS_R1 + (size_t)T * 4096 * 2;
constexpr size_t R2_QA = 0, R2_KA = R2_QA + (size_t)T * 768 * 2, R2_CQN = R2_KA + (size_t)T * 256 * 2, R2_CKVN = R2_CQN + (size_t)T * 384 * 2, R2_KR = R2_CKVN + (size_t)T * 256 * 2,
                 R2_QB = R2_KR + (size_t)T * 64 * 2, R2_KVB = R2_QB + (size_t)T * 1280 * 2, R2_QC = R2_KVB + (size_t)T * 1536 * 2, R2_KC = R2_QC + (size_t)T * 512 * 2,
                 R2_KCT = R2_KC + (size_t)T * 512 * 2, R2_CPREV = R2_KCT + 2048ull * 16384 * 2, R2_END = R2_CPREV + 2048ull * 16384 * 2;
constexpr size_t WS_END = WS_R2 + (size_t)PTOT * 2048 * 2;
static_assert(R2_END <= (size_t)PTOT * 2048 * 2, "R2 overflow");
static_assert(WS_END <= 2147483648ull, "workspace too large");
}
namespace fx {
struct CvtW { const float* w_in; const float* w_uq; const float* w_ukv; const float* w_out; const float* eg; const float* eu; const float* ed; const float* sg; const float* su; const float* sd; bf16_t* W; };
__device__ __forceinline__ void cvt_layer(const CvtW& a, FX_LAS unsigned* my, int gwave, int nwaves, int& rot) {
    const int BIG = 1 << 30; bf16_t* W = a.W;
    bf16_t* WIN = W + W_IN / 2; bf16_t* WUQ = W + W_UQ / 2; bf16_t* WUKV = W + W_UKV / 2; bf16_t* WOUT = W + W_OUT / 2; bf16_t* WGU = W + W_GU / 2; bf16_t* WDN = W + W_DN / 2;
#ifdef FX_WIN8
    { CvtSeg s; s.src = a.w_in; s.dst = WIN; s.sstride = 0; s.dstride = 0; s.ld = 4048; s.nsrc = 4048; s.K = 2048; s.ntn = 64; s.nbatch = 1; s.G = BIG; s.GS = 0; s.off = 0; cvt_seg8(s, my, gwave, nwaves, rot, W8_SCALE); }
#else
    { CvtSeg s; s.src = a.w_in; s.dst = WIN; s.sstride = 0; s.dstride = 0; s.ld = 4048; s.nsrc = 4048; s.K = 2048; s.ntn = 64; s.nbatch = 1; s.G = BIG; s.GS = 0; s.off = 0; cvt_seg(s, my, gwave, nwaves, rot); }
#endif
    { CvtSeg s; s.src = a.w_uq; s.dst = WUQ; s.sstride = 0; s.dstride = 0; s.ld = 1152; s.nsrc = 1152; s.K = 384; s.ntn = 20; s.nbatch = 1; s.G = BIG; s.GS = 0; s.off = 0; cvt_seg(s, my, gwave, nwaves, rot); }
    { CvtSeg s; s.src = a.w_ukv; s.dst = WUKV; s.sstride = 0; s.dstride = 0; s.ld = 1536; s.nsrc = 1536; s.K = 256; s.ntn = 24; s.nbatch = 1; s.G = BIG; s.GS = 0; s.off = 0; cvt_seg(s, my, gwave, nwaves, rot); }
#ifdef FX_WOUT8
    { CvtSeg s; s.src = a.w_out; s.dst = WOUT; s.sstride = 0; s.dstride = 0; s.ld = 2048; s.nsrc = 2048; s.K = 2048; s.ntn = 32; s.nbatch = 1; s.G = BIG; s.GS = 0; s.off = 0; cvt_seg8(s, my, gwave, nwaves, rot, W8_SCALE); }
#else
    { CvtSeg s; s.src = a.w_out; s.dst = WOUT; s.sstride = 0; s.dstride = 0; s.ld = 2048; s.nsrc = 2048; s.K = 2048; s.ntn = 32; s.nbatch = 1; s.G = BIG; s.GS = 0; s.off = 0; cvt_seg(s, my, gwave, nwaves, rot); }
#endif
    { CvtSeg s; s.src = a.eg; s.dst = WGU; s.sstride = 2048ll * 512; s.dstride = 1024ll * 2048; s.ld = 512; s.nsrc = 512; s.K = 2048; s.ntn = 8; s.nbatch = 64; s.G = 128; s.GS = 256; s.off = 0; cvt_seg8(s, my, gwave, nwaves, rot, W8_SCALE); }
    { CvtSeg s; s.src = a.eu; s.dst = WGU; s.sstride = 2048ll * 512; s.dstride = 1024ll * 2048; s.ld = 512; s.nsrc = 512; s.K = 2048; s.ntn = 8; s.nbatch = 64; s.G = 128; s.GS = 256; s.off = 128; cvt_seg8(s, my, gwave, nwaves, rot, W8_SCALE); }
    { CvtSeg s; s.src = a.ed; s.dst = WDN; s.sstride = 512ll * 2048; s.dstride = 2048ll * 512; s.ld = 2048; s.nsrc = 2048; s.K = 512; s.ntn = 32; s.nbatch = 64; s.G = BIG; s.GS = 0; s.off = 0; cvt_seg8(s, my, gwave, nwaves, rot, W8_SCALE); }
    { CvtSeg s; s.src = a.sg; s.dst = (bf16_t*)((unsigned char*)WGU + 64ull * 1024 * 2048); s.sstride = 0; s.dstride = 0; s.ld = 512; s.nsrc = 512; s.K = 2048; s.ntn = 8; s.nbatch = 1; s.G = 128; s.GS = 256; s.off = 0; cvt_seg8(s, my, gwave, nwaves, rot, W8_SCALE); }
    { CvtSeg s; s.src = a.su; s.dst = (bf16_t*)((unsigned char*)WGU + 64ull * 1024 * 2048); s.sstride = 0; s.dstride = 0; s.ld = 512; s.nsrc = 512; s.K = 2048; s.ntn = 8; s.nbatch = 1; s.G = 128; s.GS = 256; s.off = 128; cvt_seg8(s, my, gwave, nwaves, rot, W8_SCALE); }
    { CvtSeg s; s.src = a.sd; s.dst = (bf16_t*)((unsigned char*)WDN + 64ull * 2048 * 512); s.sstride = 0; s.dstride = 0; s.ld = 2048; s.nsrc = 2048; s.K = 512; s.ntn = 32; s.nbatch = 1; s.G = BIG; s.GS = 0; s.off = 0; cvt_seg8(s, my, gwave, nwaves, rot, W8_SCALE); }
}
constexpr int CVT_TILES_PER_LAYER = 2048 + 120 + 96 + 1024 + 3 * 16384 + 3 * 256;
__device__ __forceinline__ void cvt_layer_one(const CvtW& a, FX_LAS unsigned* my, int g) {
    int base = 0;
    const int BIG = 1 << 30; bf16_t* W = a.W;
    bf16_t* WIN = W + W_IN / 2; bf16_t* WUQ = W + W_UQ / 2; bf16_t* WUKV = W + W_UKV / 2; bf16_t* WOUT = W + W_OUT / 2; bf16_t* WGU = W + W_GU / 2; bf16_t* WDN = W + W_DN / 2;
#ifdef FX_WIN8
    { CvtSeg s; s.src = a.w_in; s.dst = WIN; s.sstride = 0; s.dstride = 0; s.ld = 4048; s.nsrc = 4048; s.K = 2048; s.ntn = 64; s.nbatch = 1; s.G = BIG; s.GS = 0; s.off = 0; { const int cnt_ = (s.K / 64) * s.ntn * s.nbatch; if (g >= base && g < base + cnt_) cvt_tile8(s, my, g - base, W8_SCALE); base += cnt_; } }
#else
    { CvtSeg s; s.src = a.w_in; s.dst = WIN; s.sstride = 0; s.dstride = 0; s.ld = 4048; s.nsrc = 4048; s.K = 2048; s.ntn = 64; s.nbatch = 1; s.G = BIG; s.GS = 0; s.off = 0; { const int cnt_ = (s.K / 64) * s.ntn * s.nbatch; if (g >= base && g < base + cnt_) cvt_tile(s, my, g - base); base += cnt_; } }
#endif
    { CvtSeg s; s.src = a.w_uq; s.dst = WUQ; s.sstride = 0; s.dstride = 0; s.ld = 1152; s.nsrc = 1152; s.K = 384; s.ntn = 20; s.nbatch = 1; s.G = BIG; s.GS = 0; s.off = 0; { const int cnt_ = (s.K / 64) * s.ntn * s.nbatch; if (g >= base && g < base + cnt_) cvt_tile(s, my, g - base); base += cnt_; } }
    { CvtSeg s; s.src = a.w_ukv; s.dst = WUKV; s.sstride = 0; s.dstride = 0; s.ld = 1536; s.nsrc = 1536; s.K = 256; s.ntn = 24; s.nbatch = 1; s.G = BIG; s.GS = 0; s.off = 0; { const int cnt_ = (s.K / 64) * s.ntn * s.nbatch; if (g >= base && g < base + cnt_) cvt_tile(s, my, g - base); base += cnt_; } }
#ifdef FX_WOUT8
    { CvtSeg s; s.src = a.w_out; s.dst = WOUT; s.sstride = 0; s.dstride = 0; s.ld = 2048; s.nsrc = 2048; s.K = 2048; s.ntn = 32; s.nbatch = 1; s.G = BIG; s.GS = 0; s.off = 0; { const int cnt_ = (s.K / 64) * s.ntn * s.nbatch; if (g >= base && g < base + cnt_) cvt_tile8(s, my, g - base, W8_SCALE); base += cnt_; } }
#else
    { CvtSeg s; s.src = a.w_out; s.dst = WOUT; s.sstride = 0; s.dstride = 0; s.ld = 2048; s.nsrc = 2048; s.K = 2048; s.ntn = 32; s.nbatch = 1; s.G = BIG; s.GS = 0; s.off = 0; { const int cnt_ = (s.K / 64) * s.ntn * s.nbatch; if (g >= base && g < base + cnt_) cvt_tile(s, my, g - base); base += cnt_; } }
#endif
    { CvtSeg s; s.src = a.eg; s.dst = WGU; s.sstride = 2048ll * 512; s.dstride = 1024ll * 2048; s.ld = 512; s.nsrc = 512; s.K = 2048; s.ntn = 8; s.nbatch = 64; s.G = 128; s.GS = 256; s.off = 0; { const int cnt_ = (s.K / 64) * s.ntn * s.nbatch; if (g >= base && g < base + cnt_) cvt_tile8(s, my, g - base, W8_SCALE); base += cnt_; } }
    { CvtSeg s; s.src = a.eu; s.dst = WGU; s.sstride = 2048ll * 512; s.dstride = 1024ll * 2048; s.ld = 512; s.nsrc = 512; s.K = 2048; s.ntn = 8; s.nbatch = 64; s.G = 128; s.GS = 256; s.off = 128; { const int cnt_ = (s.K / 64) * s.ntn * s.nbatch; if (g >= base && g < base + cnt_) cvt_tile8(s, my, g - base, W8_SCALE); base += cnt_; } }
    { CvtSeg s; s.src = a.ed; s.dst = WDN; s.sstride = 512ll * 2048; s.dstride = 2048ll * 512; s.ld = 2048; s.nsrc = 2048; s.K = 512; s.ntn = 32; s.nbatch = 64; s.G = BIG; s.GS = 0; s.off = 0; { const int cnt_ = (s.K / 64) * s.ntn * s.nbatch; if (g >= base && g < base + cnt_) cvt_tile8(s, my, g - base, W8_SCALE); base += cnt_; } }
    { CvtSeg s; s.src = a.sg; s.dst = (bf16_t*)((unsigned char*)WGU + 64ull * 1024 * 2048); s.sstride = 0; s.dstride = 0; s.ld = 512; s.nsrc = 512; s.K = 2048; s.ntn = 8; s.nbatch = 1; s.G = 128; s.GS = 256; s.off = 0; { const int cnt_ = (s.K / 64) * s.ntn * s.nbatch; if (g >= base && g < base + cnt_) cvt_tile8(s, my, g - base, W8_SCALE); base += cnt_; } }
    { CvtSeg s; s.src = a.su; s.dst = (bf16_t*)((unsigned char*)WGU + 64ull * 1024 * 2048); s.sstride = 0; s.dstride = 0; s.ld = 512; s.nsrc = 512; s.K = 2048; s.ntn = 8; s.nbatch = 1; s.G = 128; s.GS = 256; s.off = 128; { const int cnt_ = (s.K / 64) * s.ntn * s.nbatch; if (g >= base && g < base + cnt_) cvt_tile8(s, my, g - base, W8_SCALE); base += cnt_; } }
    { CvtSeg s; s.src = a.sd; s.dst = (bf16_t*)((unsigned char*)WDN + 64ull * 2048 * 512); s.sstride = 0; s.dstride = 0; s.ld = 2048; s.nsrc = 2048; s.K = 512; s.ntn = 32; s.nbatch = 1; s.G = BIG; s.GS = 0; s.off = 0; { const int cnt_ = (s.K / 64) * s.ntn * s.nbatch; if (g >= base && g < base + cnt_) cvt_tile8(s, my, g - base, W8_SCALE); base += cnt_; } }
}
}
namespace fx {
#define XB_TMO      128
#define XB_XCNT(j)  (256  + 64 * (j))
#define XB_XSUB(j)  (1280 + 64 * (j))
#define XB_XGEN(j)  (2304 + 64 * (j))
#define XB_TOP      3328
#define XB_TOPGEN   3392
#define XCD_BAR_WORDS 3456
#define XB_SPIN_CAP (1u << 22)
__device__ __forceinline__ unsigned xb_ld(unsigned* p)              { return __hip_atomic_load(p, __ATOMIC_RELAXED, __HIP_MEMORY_SCOPE_AGENT); }
__device__ __forceinline__ unsigned xb_add(unsigned* p, unsigned v) { return __hip_atomic_fetch_add(p, v, __ATOMIC_RELAXED, __HIP_MEMORY_SCOPE_AGENT); }
__device__ __forceinline__ unsigned xb_xcc_id() { return (unsigned)__builtin_amdgcn_s_getreg((3 << 11) | 20) & 0xFu; }
#define XB_SPIN(cond, bar) do { unsigned _sp = 0; while (cond) { __builtin_amdgcn_s_sleep(1); \
    if ((++_sp & 255u) == 0u) { if (xb_ld(&(bar)[XB_TMO])) break; if (_sp > XB_SPIN_CAP) { atomicAdd(&(bar)[XB_TMO], 1u); break; } } } } while (0)
struct XcdBarrier { unsigned* bar; unsigned x; volatile FX_LAS unsigned* st; };
__device__ __forceinline__ XcdBarrier xcd_barrier_post(unsigned* bar, volatile FX_LAS unsigned* st, int tidp) {
    XcdBarrier b; b.bar = bar; b.x = xb_xcc_id(); b.st = st;
    if (tidp == 0) (void)xb_add(&bar[XB_XCNT(b.x)], 1u);
    return b;
}
__device__ __forceinline__ void xcd_barrier_complete(unsigned* bar, unsigned x, unsigned& nloc, unsigned& nx) {
    const unsigned G = gridDim.x * gridDim.y * gridDim.z;
    unsigned sum, cnt, mine, sp = 0u;
    for (;;) {
        sum = 0u; cnt = 0u; mine = 0u;
#pragma unroll
        for (unsigned j = 0; j < 16; ++j) { const unsigned c = xb_ld(&bar[XB_XCNT(j)]); sum += c; cnt += (c > 0u) ? 1u : 0u; mine = (j == x) ? c : mine; }
        if (sum == G) break;
        __builtin_amdgcn_s_sleep(1);
        if ((++sp & 255u) == 0u) { if (xb_ld(&bar[XB_TMO])) break; if (sp > XB_SPIN_CAP) { atomicAdd(&bar[XB_TMO], 1u); break; } }
    }
    nloc = mine > 0u ? mine : 1u; nx = cnt > 0u ? cnt : 1u;
}
__device__ __forceinline__ void xcd_barrier(const XcdBarrier& b, int tidp) {
    asm volatile("s_waitcnt vmcnt(0)" ::: "memory");
    __syncthreads();
    if (tidp == 0) {
        unsigned* bar = b.bar;
        __builtin_amdgcn_s_waitcnt(0);
        unsigned nloc = b.st[0], nx = b.st[1];
        if (nloc == 0u) { xcd_barrier_complete(bar, b.x, nloc, nx); b.st[0] = nloc; b.st[1] = nx; }
        const unsigned old = xb_add(&bar[XB_XSUB(b.x)], 1u);
        const unsigned gen = old / nloc;
        if (old + 1u == (gen + 1u) * nloc) {
            __builtin_amdgcn_fence(__ATOMIC_RELEASE, "agent");
            asm volatile("s_waitcnt vmcnt(0)" ::: "memory");
            const unsigned og = xb_add(&bar[XB_TOP], 1u);
            const unsigned tg = og / nx;
            if (og + 1u == (tg + 1u) * nx) xb_add(&bar[XB_TOPGEN], 1u);
            else XB_SPIN(xb_ld(&bar[XB_TOPGEN]) == tg, bar);
            __builtin_amdgcn_fence(__ATOMIC_ACQUIRE, "agent");
            xb_add(&bar[XB_XGEN(b.x)], 1u);
            asm volatile("s_waitcnt vmcnt(0)" ::: "memory");
        } else {
            XB_SPIN(xb_ld(&bar[XB_XGEN(b.x)]) == gen, bar);
            __builtin_amdgcn_fence(__ATOMIC_ACQUIRE, "agent");
            asm volatile("s_waitcnt vmcnt(0)" ::: "memory");
        }
    }
    __syncthreads();
}

__device__ __forceinline__ void modp_phase(FX_LAS unsigned char* lds_, const float* c, const float* ada_w, float* MODP, int wg, int nwg, int tidp) {
    float* cact = (float*)(char*)lds_;
    for (int i = tidp; i < 8192; i += 512) { const float v = c[i]; cact[i] = v / (1.f + expf(-v)); }
    __syncthreads();
    int tid_ = tidp; asm volatile("" : "+v"(tid_));
    const int wid = tid_ >> 6, lane = tid_ & 63;
    for (int u = wg * 8 + wid; u < 2 * 48 * 32; u += nwg * 8) {
        const int kc = u & 31, nc = (u >> 5) % 48, l = u / (48 * 32);
        const float* w = ada_w + (size_t)l * 2048 * 12288 + (size_t)(kc * 64) * 12288 + nc * 256 + lane * 4;
        f32x4 a0 = {0.f, 0.f, 0.f, 0.f}, a1 = a0, a2 = a0, a3 = a0;
#pragma unroll 8
        for (int k = 0; k < 64; ++k) { const f32x4 wv = *(const f32x4*)(w + (size_t)k * 12288); const int kk = kc * 64 + k;
            a0 += wv * cact[kk]; a1 += wv * cact[2048 + kk]; a2 += wv * cact[4096 + kk]; a3 += wv * cact[6144 + kk]; }
        float* dst = MODP + (((size_t)l * 32 + kc) * 4) * 12288 + nc * 256 + lane * 4;
        *(f32x4*)dst = a0; *(f32x4*)(dst + 12288) = a1; *(f32x4*)(dst + 2 * 12288) = a2; *(f32x4*)(dst + 3 * 12288) = a3;
    }
    __syncthreads();
}
__device__ __forceinline__ void tab_phase(float* tab, int gtid) {
    if (gtid < 2048) { const int p = gtid >> 5, f = gtid & 31; const float inv = powf(10000.f, -(float)(2 * f) / 64.f); const float a = (float)p * inv; tab[gtid] = cosf(a); tab[2048 + gtid] = sinf(a); }
    else if (gtid < 3072) { const int i = gtid - 2048, p = i >> 4, f = i & 15; const float inv = powf(10000.f, -(float)(2 * f) / 32.f); const float a = (float)p * inv; tab[4096 + i] = cosf(a); tab[5120 + i] = sinf(a); }
}
__device__ __forceinline__ void coef2_phase(const float* MODP, const float* ada_b, const float* pre_mix_gain, const float* post_mix_gain, const float* pre_ffn_gain, const float* post_ffn_gain, float* coef, int gtid, int nthr) {
    for (int i = gtid; i < 2 * 4 * 2048; i += nthr) { const int d = i & 2047, b = (i >> 11) & 3, l = i >> 13;
        float m[6];
#pragma unroll
        for (int j = 0; j < 6; ++j) { float s = ada_b[l * 12288 + j * 2048 + d];
            for (int kc = 0; kc < 32; ++kc) s += MODP[(((size_t)l * 32 + kc) * 4 + b) * 12288 + j * 2048 + d];
            m[j] = s; }
        float* c = coef + ((size_t)l * 4 + b) * 6 * 2048;
        c[0 * 2048 + d] = m[2] * post_mix_gain[l * 2048 + d];
        c[1 * 2048 + d] = pre_ffn_gain[l * 2048 + d] * (1.f + m[4]);
        c[2 * 2048 + d] = m[3];
        c[3 * 2048 + d] = m[5] * post_ffn_gain[l * 2048 + d];
        c[4 * 2048 + d] = pre_mix_gain[l * 2048 + d] * (1.f + m[1]);
        c[5 * 2048 + d] = m[0]; }
}
__device__ __forceinline__ void coef3_phase(FX_LAS unsigned char* lds_, const float* MODP, const float* ada_b, const float* pre_mix_gain, const float* post_mix_gain, const float* pre_ffn_gain, const float* post_ffn_gain, float* coef, int wg, int nwg, int tidp) {
    FX_LAS float* ms = (FX_LAS float*)lds_;
    int tid_ = tidp; asm volatile("" : "+v"(tid_));
    const int wid = __builtin_amdgcn_readfirstlane(tid_ >> 6), lane = tid_ & 63;
    for (int base = wg * 64; base < 2 * 4 * 2048; base += nwg * 64) {
        const int i = base + lane, d = i & 2047, b = (i >> 11) & 3, l = i >> 13;
        if (wid < 6) { const int j = wid; float pv[32];
#pragma unroll
            for (int kc = 0; kc < 32; ++kc) pv[kc] = MODP[(((size_t)l * 32 + kc) * 4 + b) * 12288 + j * 2048 + d];
            float s = ada_b[l * 12288 + j * 2048 + d];
#pragma unroll
            for (int kc = 0; kc < 32; ++kc) s += pv[kc];
            ms[j * 64 + lane] = s; }
        __syncthreads();
        if (wid == 0) { float m[6];
#pragma unroll
            for (int j = 0; j < 6; ++j) m[j] = ms[j * 64 + lane];
            float* c = coef + ((size_t)l * 4 + b) * 6 * 2048;
            c[0 * 2048 + d] = m[2] * post_mix_gain[l * 2048 + d];
            c[1 * 2048 + d] = pre_ffn_gain[l * 2048 + d] * (1.f + m[4]);
            c[2 * 2048 + d] = m[3];
            c[3 * 2048 + d] = m[5] * post_ffn_gain[l * 2048 + d];
            c[4 * 2048 + d] = pre_mix_gain[l * 2048 + d] * (1.f + m[1]);
            c[5 * 2048 + d] = m[0]; }
        __syncthreads();
    }
}
__device__ __forceinline__ void prenorm_phase(const float* x, const float* coef_l, bf16_t* HA, int wg, int nwg, int tidp) {
    int tid_ = tidp; asm volatile("" : "+v"(tid_));
    const int wid = tid_ >> 6, lane = tid_ & 63;
    for (int t = wg * 8 + wid; t < T; t += nwg * 8) {
        const float* cn = coef_l + (size_t)(t / S) * 6 * 2048;
        float xv[32]; float ss = 0.f;
#pragma unroll
        for (int i = 0; i < 4; ++i) { const int c = i * 512 + lane * 8; const f32x4 x0 = *(const f32x4*)(x + (size_t)t * 2048 + c), x1 = *(const f32x4*)(x + (size_t)t * 2048 + c + 4);
#pragma unroll
            for (int j = 0; j < 4; ++j) { xv[i * 8 + j] = x0[j]; xv[i * 8 + 4 + j] = x1[j]; ss += x0[j] * x0[j] + x1[j] * x1[j]; } }
        ss = wave_sum(ss); const float rx = rsqrtf(ss * (1.f / 2048.f) + EPS);
#pragma unroll
        for (int i = 0; i < 4; ++i) { const int c = i * 512 + lane * 8;
            const f32x4 e0 = *(const f32x4*)(cn + 4 * 2048 + c), e1 = *(const f32x4*)(cn + 4 * 2048 + c + 4), f0 = *(const f32x4*)(cn + 5 * 2048 + c), f1 = *(const f32x4*)(cn + 5 * 2048 + c + 4);
            float hv[8];
#pragma unroll
            for (int j = 0; j < 4; ++j) { hv[j] = xv[i * 8 + j] * rx * e0[j] + f0[j]; hv[4 + j] = xv[i * 8 + 4 + j] * rx * e1[j] + f1[j]; }
#ifdef FX_WIN8
            u32x2 w; w.x = cvt_pk4_fp8(hv[0], hv[1], hv[2], hv[3]); w.y = cvt_pk4_fp8(hv[4], hv[5], hv[6], hv[7]);
            *(u32x2*)((unsigned char*)HA + (size_t)t * 2048 + c) = w; }
#else
            u32x4 w; w.x = cvt_pk_bf16(hv[0], hv[1]); w.y = cvt_pk_bf16(hv[2], hv[3]); w.z = cvt_pk_bf16(hv[4], hv[5]); w.w = cvt_pk_bf16(hv[6], hv[7]);
            *(u32x4*)(HA + (size_t)t * 2048 + c) = w; }
#endif
    }
}

constexpr int LDS_ST = 139264, LDS_TOTAL = LDS_ST + 64 + EPI_LDS_BYTES;
static_assert(EPI_LDS_OFF == LDS_ST + 64 && LDS_TOTAL <= 160 * 1024, "LDS layout");
constexpr size_t WS_MODP = WS_R2;
#define FX_KAS __attribute__((address_space(4)))
template <class TY> __device__ __forceinline__ TY* fx_glob(TY* p) { __attribute__((address_space(1))) TY* g = (__attribute__((address_space(1))) TY*)p; asm volatile("" : "+s"(g)); return (TY*)g; }
struct MP {
    const float* x; const float* c; const float* ada_w; const float* ada_b; const float* pre_mix_gain; const float* w_in; const float* a_q_gain; const float* a_k_gain;
    const float* b_cq_gain; const float* b_ckv_gain; const float* w_uq; const float* w_ukv; const float* c_conv_w; const float* c_conv_b; const float* c_gate_b;
    const float* head_out_gain; const float* w_out; const float* post_mix_gain; const float* pre_ffn_gain; const float* router_w; const float* router_bias;
    const float* exp_w_gate; const float* exp_w_up; const float* exp_w_down; const float* sh_w_gate; const float* sh_w_up; const float* sh_w_down; const float* post_ffn_gain;
    char* ws; float* out;
};
#ifndef FX_NPHASE
#define FX_NPHASE 1000
#endif
#define PH_BEGIN const FX_KAS MP* pk = (const FX_KAS MP*)__builtin_amdgcn_kernarg_segment_ptr(); asm volatile("" : "+s"(pk)); char* ws = fx_glob(pk->ws); (void)ws; int gt_ = wid_s * 64 + fx_lane(); asm volatile("" : "+v"(gt_)); int wg_ = blockIdx.x, nwg_ = gridDim.x; asm volatile("" : "+s"(wg_), "+s"(nwg_)); const int wg = wg_, nwg = nwg_; (void)wg; (void)nwg; (void)gt_;
#define PH_BAR do { PH_BEGIN XcdBarrier b_; b_.bar = (unsigned*)(ws + WS_BAR); b_.x = xb_xcc_id(); b_.st = (volatile FX_LAS unsigned*)(lds + LDS_ST); xcd_barrier(b_, gt_); } while (0)
#define WSP(T_, off) ((T_*)(ws + (off)))
constexpr int QW_CNT = 3584;
constexpr unsigned HV_SLACK = 24;
__device__ __forceinline__ void harvest(FX_LAS unsigned char* lds, const FX_KAS MP* pk, char* ws, int tid, const unsigned nbar, const bool drain) {
    volatile FX_LAS unsigned* bw = (volatile FX_LAS unsigned*)(lds + LDS_ST);
    unsigned* bar = (unsigned*)(ws + WS_BAR);
    const int wave = tid >> 6; FX_LAS unsigned* my = (FX_LAS unsigned*)(lds) + wave * (64 * 33);
    CvtW a; a.w_in = fx_glob(pk->w_in) + (size_t)D * 4048; a.w_uq = fx_glob(pk->w_uq) + (size_t)384 * 1152; a.w_ukv = fx_glob(pk->w_ukv) + (size_t)256 * 1536; a.w_out = fx_glob(pk->w_out) + (size_t)D * D;
    a.eg = fx_glob(pk->exp_w_gate) + (size_t)NE * D * FF; a.eu = fx_glob(pk->exp_w_up) + (size_t)NE * D * FF; a.ed = fx_glob(pk->exp_w_down) + (size_t)NE * FF * D;
    a.sg = fx_glob(pk->sh_w_gate) + (size_t)D * FF; a.su = fx_glob(pk->sh_w_up) + (size_t)D * FF; a.sd = fx_glob(pk->sh_w_down) + (size_t)FF * D; a.W = (bf16_t*)(ws + WS_W + W_LAYER);
    __syncthreads();
    if (drain) {
        if (tid == 0) bw[3] = xb_ld(&bar[QW_CNT]);
        __syncthreads();
        const unsigned h = bw[3];
#pragma unroll 1
        for (unsigned g = h + (unsigned)(blockIdx.x * 8 + wave); g < (unsigned)CVT_TILES_PER_LAYER; g += gridDim.x * 8u) cvt_layer_one(a, my, (int)g);
        __syncthreads();
        return;
    }
#pragma unroll 1
    for (;;) {
        if (tid == 0) { unsigned nxt = 0xffffffffu; bool go = true;
            if (!drain) { unsigned sum = 0u;
#pragma unroll
                for (unsigned j = 0; j < 16; ++j) sum += xb_ld(&bar[XB_XSUB(j)]);
                const unsigned G = gridDim.x; go = (sum - nbar * G) + HV_SLACK < G; }
            if (go && xb_ld(&bar[QW_CNT]) < (unsigned)CVT_TILES_PER_LAYER) { const unsigned b0 = xb_add(&bar[QW_CNT], 8u); if (b0 < (unsigned)CVT_TILES_PER_LAYER) nxt = b0; }
            bw[3] = nxt; }
        __syncthreads();
        const unsigned base = bw[3];
        if (base == 0xffffffffu) break;
        const int g = (int)base + wave;
        if (g < CVT_TILES_PER_LAYER) cvt_layer_one(a, my, g);
        __syncthreads();
    }
    __syncthreads();
}
#ifndef FX_HARVEST
#define FX_HARVEST 1
#endif
#define PH_HARVEST(n, dr) do { if (FX_HARVEST && l == 0 && ((dr) || FX_HARVEST == 1)) { PH_BEGIN harvest(lds, pk, ws, gt_, (n), (dr)); } } while (0)
#ifndef FX_DUP
#define FX_DUP -1
#endif
#define FX_NE ((FX_NOEPI && rep_ == 1) ? FX_NOEPI : 0)
#define FX_REP(n) _Pragma("unroll 1") for (int rep_ = 0; rep_ < ((FX_DUP == (n) && l == 0) ? 2 : 1); ++rep_)
template <int l> __device__ __forceinline__ void layer_body(FX_LAS unsigned char* lds, unsigned char* shm, const int wid_s) {
        FX_REP(2) { PH_BEGIN const bf16_t* W = WSP(const bf16_t, WS_W + (size_t)l * W_LAYER);
#ifdef FX_WIN8
          DenseSched Sc; Sc.init(T, 4096, nwg, wg, 2048, W + W_IN / 2, 2048, 1); EpiBf16 E; E.es = lds + EPI_LDS_OFF; E.O = WSP(bf16_t, WS_R1); E.gates = WSP(float, WS_GATES); E.ldc = 4096; E.scale = W8_INV;
          gemm_phase<EpiBf16, DenseSched, true>(lds, (const char*)WSP(bf16_t, WS_HA), 2048, Sc, E, gt_, FX_NE); }
#else
          DenseSched Sc; Sc.init(T, 4096, nwg, wg, 2048 * 2, W + W_IN / 2, 2048); EpiBf16 E; E.es = lds + EPI_LDS_OFF; E.O = WSP(bf16_t, WS_R1); E.gates = WSP(float, WS_GATES); E.ldc = 4096; E.scale = 1.f;
          gemm_phase<EpiBf16, DenseSched>(lds, (const char*)WSP(bf16_t, WS_HA), 2048, Sc, E, gt_); }
#endif
        PH_HARVEST(3u, false);
        PH_BAR;
        FX_REP(3) { PH_BEGIN char* R2 = ws + WS_R2; float* tab = WSP(float, WS_TAB);
          P3Args a; a.PROJ = WSP(bf16_t, WS_R1); a.GATES = WSP(float, WS_GATES); a.gate_b = fx_glob(pk->c_gate_b) + l * 16; a.conv_w = fx_glob(pk->c_conv_w) + (size_t)l * 5 * 1024; a.conv_b = fx_glob(pk->c_conv_b) + l * 1024;
          a.aq_gain = fx_glob(pk->a_q_gain) + l * 128; a.ak_gain = fx_glob(pk->a_k_gain) + l * 128; a.cq_gain = fx_glob(pk->b_cq_gain) + l * 384; a.ckv_gain = fx_glob(pk->b_ckv_gain) + l * 256;
          a.cosA = tab; a.sinA = tab + 2048; a.cosB = tab + 4096; a.sinB = tab + 5120;
          a.QA = (bf16_t*)(R2 + R2_QA); a.KA = (bf16_t*)(R2 + R2_KA); a.CQN = (bf16_t*)(R2 + R2_CQN); a.CKVN = (bf16_t*)(R2 + R2_CKVN); a.KR = (bf16_t*)(R2 + R2_KR); a.QC = (bf16_t*)(R2 + R2_QC); a.KC = (bf16_t*)(R2 + R2_KC);
          a.KCT = (bf16_t*)(R2 + R2_KCT); a.NLOC = WSP(float, WS_NLOC); a.GSC = WSP(float, WS_GSC);
          p3_phase(lds, a, wg, nwg, gt_); }
        PH_BAR;
        FX_REP(4) {
        { PH_BEGIN const bf16_t* W = WSP(const bf16_t, WS_W + (size_t)l * W_LAYER); char* R2 = ws + WS_R2; float* tab = WSP(float, WS_TAB);
          DenseSched Sc; Sc.init(T, 1280, nwg, wg, 384 * 2, W + W_UQ / 2, 384); EpiQB E; E.O = (bf16_t*)(R2 + R2_QB); E.cosB = tab + 4096; E.sinB = tab + 5120;
          gemm_phase<EpiQB, DenseSched>(lds, (const char*)(R2 + R2_CQN), 384, Sc, E, gt_); }
        { PH_BEGIN const bf16_t* W = WSP(const bf16_t, WS_W + (size_t)l * W_LAYER); char* R2 = ws + WS_R2;
          DenseSched Sc; Sc.init(T, 1536, nwg, (wg + nwg / 2) % nwg  , 256 * 2, W + W_UKV / 2, 256); EpiBf16 E; E.es = lds + EPI_LDS_OFF; E.O = (bf16_t*)(R2 + R2_KVB); E.gates = nullptr; E.ldc = 1536; E.scale = 1.f;
          gemm_phase<EpiBf16, DenseSched>(lds, (const char*)(R2 + R2_CKVN), 256, Sc, E, gt_); }
        { PH_BEGIN char* R2 = ws + WS_R2;
          scan_phase((const bf16_t*)(R2 + R2_KCT), WSP(float, WS_NLOC), WSP(float, WS_GSC), (bf16_t*)(R2 + R2_CPREV), WSP(float, WS_NPREV), WSP(float, WS_MPREV), wg * 512 + gt_, nwg * 512); }
        }
        PH_HARVEST(5u, false);
        PH_BAR;
        FX_REP(5) {
#pragma unroll 1
          for (int ui = 0; ui < 2; ++ui) { PH_BEGIN char* R2 = ws + WS_R2; int u;
              if (nwg == 256) { const int x = wg & 7, j = wg >> 3; if (ui == 1 && j >= 16) break; u = x * 48 + j + ui * 32; } else { u = wg + ui * nwg; if (u >= 384) break; }
              attn_gqa_unit(u, (const bf16_t*)(R2 + R2_QA), (const bf16_t*)(R2 + R2_KA), WSP(const bf16_t, WS_R1), WSP(bf16_t, WS_HA), fx_glob(pk->head_out_gain) + l * D, (char*)shm, gt_); }
#pragma unroll 1
          for (int ui = 0; ui < 2; ++ui) { PH_BEGIN char* R2 = ws + WS_R2; int u;
              if (nwg == 256) { const int x = wg & 7, j = wg >> 3; if (j < 16) { if (ui == 1) break; u = x * 48 + j; } else u = x * 48 + 16 + (j - 16) * 2 + ui; } else { u = wg + ui * nwg; if (u >= 384) break; }
              attn_mla_unit(u, (const bf16_t*)(R2 + R2_QB), (const bf16_t*)(R2 + R2_KVB), (const bf16_t*)(R2 + R2_KR), WSP(bf16_t, WS_HA), fx_glob(pk->head_out_gain) + l * D, (char*)shm, gt_); }
          { PH_BEGIN char* R2 = ws + WS_R2;
            McArgs a; a.PROJ = WSP(bf16_t, WS_R1); a.GATES = WSP(float, WS_GATES); a.gate_b = fx_glob(pk->c_gate_b) + l * 16; a.QC = (bf16_t*)(R2 + R2_QC); a.KC = (bf16_t*)(R2 + R2_KC); a.CPREV = (bf16_t*)(R2 + R2_CPREV);
            a.NPREV = WSP(float, WS_NPREV); a.MPREV = WSP(float, WS_MPREV); a.hog = fx_glob(pk->head_out_gain) + l * D; a.YM = WSP(bf16_t, WS_HA);
            mlstm_c_phase(lds, a, wg, nwg, gt_); } }
        PH_HARVEST(6u, false);
        PH_BAR;
        FX_REP(6) { PH_BEGIN const bf16_t* W = WSP(const bf16_t, WS_W + (size_t)l * W_LAYER);
#ifdef FX_WOUT8
          DenseSched Sc; Sc.init(T, 2048, nwg, wg, 2048, W + W_OUT / 2, 2048, 1); EpiBf16 E; E.es = lds + EPI_LDS_OFF; E.O = WSP(bf16_t, WS_R1); E.gates = nullptr; E.ldc = 2048; E.scale = W8_INV;
          gemm_phase<EpiBf16, DenseSched, true>(lds, (const char*)WSP(bf16_t, WS_HA), 2048, Sc, E, gt_, FX_NE); }
#else
          DenseSched Sc; Sc.init(T, 2048, nwg, wg, 2048 * 2, W + W_OUT / 2, 2048); EpiBf16 E; E.es = lds + EPI_LDS_OFF; E.O = WSP(bf16_t, WS_R1); E.gates = nullptr; E.ldc = 2048; E.scale = 1.f;
          gemm_phase<EpiBf16, DenseSched>(lds, (const char*)WSP(bf16_t, WS_HA), 2048, Sc, E, gt_); }
#endif
        PH_HARVEST(7u, false);
        PH_BAR;
        { PH_BEGIN p7_phase<(l != 0)>(lds, l == 0 ? (const void*)fx_glob(pk->x) : (const void*)WSP(const bf16_t, WS_XRES), WSP(const bf16_t, WS_R1), WSP(float, WS_COEF) + (size_t)l * 4 * 6 * 2048, fx_glob(pk->router_w) + (size_t)l * D * 64, fx_glob(pk->router_bias) + l * 64,
                            WSP(bf16_t, WS_XRES), WSP(unsigned char, WS_HA), WSP(int, WS_SELE), WSP(float, WS_SELG), WSP(int, WS_CNT) + l * 64, WSP(int, WS_WGBASE), wg, nwg, gt_); }
        PH_BAR;
        { PH_BEGIN p8_phase(lds, WSP(int, WS_SELE), WSP(float, WS_SELG), WSP(int, WS_CNT) + l * 64, WSP(int, WS_WGBASE), WSP(int, WS_ROWTOK), WSP(float, WS_ROWG), WSP(int, WS_SLOT), wg, nwg, gt_); }
        PH_BAR;
        FX_REP(9) { PH_BEGIN const bf16_t* W = WSP(const bf16_t, WS_W + (size_t)l * W_LAYER);
          p9_phase(lds, WSP(unsigned char, WS_HA), (const unsigned char*)(W + W_GU / 2), WSP(int, WS_CNT) + l * 64, WSP(int, WS_ROWTOK), WSP(unsigned char, WS_R1), wg, nwg, gt_, FX_NE); }
        PH_HARVEST(10u, false);
        PH_BAR;
        FX_REP(10) { PH_BEGIN const bf16_t* W = WSP(const bf16_t, WS_W + (size_t)l * W_LAYER);
          p10_phase(lds, WSP(unsigned char, WS_R1), (const unsigned char*)(W + W_DN / 2), WSP(int, WS_CNT) + l * 64, WSP(float, WS_ROWG), WSP(unsigned char, WS_R2), wg, nwg, gt_, FX_NE); }
        PH_HARVEST(11u, false);
        PH_BAR;
        { PH_BEGIN p11_phase<(l == 1)>(WSP(bf16_t, WS_XRES), WSP(unsigned char, WS_R2), WSP(int, WS_SLOT), WSP(float, WS_COEF) + (size_t)l * 4 * 6 * 2048, l == 0 ? WSP(float, WS_COEF) + 4 * 6 * 2048 : nullptr,
                             l == 1 ? (void*)fx_glob(pk->out) : (void*)WSP(bf16_t, WS_XRES), WSP(bf16_t, WS_HA), wg, nwg, gt_); }
        PH_HARVEST(12u, true);
        if (l == 0) PH_BAR;
}
__global__ __launch_bounds__(512, 2) void mega(MP p_unused) {
    extern __shared__ __attribute__((aligned(16))) unsigned char shm[];
    FX_LAS unsigned char* lds = (FX_LAS unsigned char*)shm;
    const int wid_s = __builtin_amdgcn_readfirstlane((int)threadIdx.x >> 6);
    { volatile FX_LAS unsigned* st = (volatile FX_LAS unsigned*)(lds + LDS_ST);
      PH_BEGIN if (gt_ == 0) { st[0] = 0u; st[1] = 0u; st[2] = 0u; st[3] = 0u; }
      __syncthreads();
      (void)xcd_barrier_post((unsigned*)(ws + WS_BAR), st, gt_); }
    { PH_BEGIN const int wave = wid_s;     FX_LAS unsigned* my = (FX_LAS unsigned*)(lds) + wave * (64 * 33); int rot = 0;
#pragma unroll 1
      for (int l = 0; l < ((FX_DUP == 0) ? 4 : (FX_HARVEST ? 1 : 2)); ++l) { const int lw = l & 1; CvtW a; a.w_in = fx_glob(pk->w_in) + (size_t)lw * D * 4048; a.w_uq = fx_glob(pk->w_uq) + (size_t)lw * 384 * 1152; a.w_ukv = fx_glob(pk->w_ukv) + (size_t)lw * 256 * 1536; a.w_out = fx_glob(pk->w_out) + (size_t)lw * D * D;
          a.eg = fx_glob(pk->exp_w_gate) + (size_t)lw * NE * D * FF; a.eu = fx_glob(pk->exp_w_up) + (size_t)lw * NE * D * FF; a.ed = fx_glob(pk->exp_w_down) + (size_t)lw * NE * FF * D;
          a.sg = fx_glob(pk->sh_w_gate) + (size_t)lw * D * FF; a.su = fx_glob(pk->sh_w_up) + (size_t)lw * D * FF; a.sd = fx_glob(pk->sh_w_down) + (size_t)lw * FF * D; a.W = (bf16_t*)(ws + WS_W + (size_t)lw * W_LAYER);
          cvt_layer(a, my, wg * 8 + wave, nwg * 8, rot); }
      __syncthreads(); }
    { PH_BEGIN modp_phase(lds, fx_glob(pk->c), fx_glob(pk->ada_w), WSP(float, WS_MODP), wg, nwg, gt_); tab_phase(WSP(float, WS_TAB), wg * 512 + gt_); }
#if FX_DUP == 20
    { PH_BEGIN modp_phase(lds, fx_glob(pk->c), fx_glob(pk->ada_w), WSP(float, WS_MODP), wg, nwg, gt_); tab_phase(WSP(float, WS_TAB), wg * 512 + gt_); }
#endif
    PH_BAR;
    { PH_BEGIN coef3_phase(lds, WSP(float, WS_MODP), fx_glob(pk->ada_b), fx_glob(pk->pre_mix_gain), fx_glob(pk->post_mix_gain), fx_glob(pk->pre_ffn_gain), fx_glob(pk->post_ffn_gain), WSP(float, WS_COEF), wg, nwg, gt_); }
    PH_BAR;
    { PH_BEGIN prenorm_phase(fx_glob(pk->x), WSP(float, WS_COEF), WSP(bf16_t, WS_HA), wg, nwg, gt_); }
#if FX_DUP == 22
    { PH_BEGIN prenorm_phase(fx_glob(pk->x), WSP(float, WS_COEF), WSP(bf16_t, WS_HA), wg, nwg, gt_); }
#endif
    PH_BAR;
#if FX_DUP == 99
    PH_BAR; PH_BAR; PH_BAR; PH_BAR; PH_BAR; PH_BAR; PH_BAR; PH_BAR; PH_BAR; PH_BAR;
#endif
    layer_body<0>(lds, shm, wid_s);
    layer_body<1>(lds, shm, wid_s);
}
}

extern "C" void kernel_launch(void* const* d_in, const int* in_sizes, int n_in, void* d_out, int out_size, void* d_ws, size_t ws_size, hipStream_t stream) {
    using namespace fx;
    static int grid = 0;
    if (!grid) {
        int dev = 0, cus = 0, per_cu = 0;
        (void)hipGetDevice(&dev);
        (void)hipDeviceGetAttribute(&cus, hipDeviceAttributeMultiprocessorCount, dev);
        (void)hipFuncSetAttribute((const void*)mega, hipFuncAttributeMaxDynamicSharedMemorySize, LDS_TOTAL);
        (void)hipOccupancyMaxActiveBlocksPerMultiprocessor(&per_cu, (const void*)mega, 512, LDS_TOTAL);
        if (cus > 256) cus = 256;
        grid = per_cu >= 1 ? cus : 0;
    }
    if (!grid) return;
    (void)hipMemsetAsync((char*)d_ws + WS_BAR, 0, 16384, stream);
    (void)hipMemsetAsync((char*)d_ws + WS_CNT, 0, 512, stream);
    MP p{};
    const float** q = (const float**)&p;
    for (int i = 0; i < 28; ++i) q[i] = (const float*)d_in[i];
    p.ws = (char*)d_ws; p.out = (float*)d_out;
    hipLaunchKernelGGL(mega, dim3(grid), dim3(512), LDS_TOTAL, stream, p);
}
```

```cpp
#define FX_WIN8 1
#define FX_WOUT8 1
#define FX_HARVEST 0
#include <hip/hip_runtime.h>
#include <stdint.h>
#include <math.h>
#ifndef FX_NOEPI
#define FX_NOEPI 0
#endif
namespace fx {
#define FX_LAS __attribute__((address_space(3)))
typedef unsigned short bf16_t;
typedef short bf16x8 __attribute__((ext_vector_type(8)));
typedef short s16x4 __attribute__((ext_vector_type(4)));
typedef float f32x4 __attribute__((ext_vector_type(4)));
typedef float f32x16 __attribute__((ext_vector_type(16)));
typedef unsigned u32x4 __attribute__((ext_vector_type(4)));
typedef unsigned u32x2 __attribute__((ext_vector_type(2)));
typedef float f32x2 __attribute__((ext_vector_type(2)));

constexpr int D = 2048, NB = 4, S = 4096, T = NB * S, DEPTH = 2;
constexpr int NE = 64, FF = 512;
constexpr float EPS = 1e-6f;
constexpr int PW = 4096;
constexpr int O_AQ = 0, O_AK = 768, O_AV = 1024, O_BCQ = 1280, O_BCKV = 1664, O_BKR = 1920, O_CQ = 1984, O_CK = 2496, O_CV = 3008, O_CO = 3520, O_CG = 4032;

typedef __bf16 bf16x2_t __attribute__((ext_vector_type(2)));
__device__ __forceinline__ unsigned cvt_pk_bf16(float lo, float hi) { const bf16x2_t r = __builtin_convertvector((f32x2){lo, hi}, bf16x2_t); return __builtin_bit_cast(unsigned, r); }
__device__ __forceinline__ float bf2f(bf16_t b) { return __uint_as_float(((unsigned)b) << 16); }
__device__ __forceinline__ float bflo(unsigned w) { return __uint_as_float(w << 16); }
__device__ __forceinline__ float bfhi(unsigned w) { return __uint_as_float(w & 0xffff0000u); }
__device__ __forceinline__ bf16_t f2bf(float f) { return (bf16_t)(cvt_pk_bf16(f, 0.f) & 0xffffu); }
__device__ __forceinline__ float sigmoid_f(float x) { return __builtin_amdgcn_rcpf(1.f + __expf(-x)); }
__device__ __forceinline__ float silu_f(float x) { return x * __builtin_amdgcn_rcpf(1.f + __expf(-x)); }
__device__ __forceinline__ int fx_lane() { unsigned z = 0u; asm volatile("" : "+v"(z)); return (int)__builtin_amdgcn_mbcnt_hi(~0u, __builtin_amdgcn_mbcnt_lo(~0u, z)); }
__device__ __forceinline__ float wave_sum(float v) { for (int o = 32; o >= 1; o >>= 1) v += __shfl_xor(v, o); return v; }
__device__ __forceinline__ float wave_max(float v) { for (int o = 32; o >= 1; o >>= 1) v = fmaxf(v, __shfl_xor(v, o)); return v; }

#ifndef FX_WGM
#define FX_WGM 8
#endif
#ifndef FX_CVT2D
#define FX_CVT2D 0
#endif
#ifndef FX_CVTPIPE
#define FX_CVTPIPE 1
#endif
#ifndef FX_PRIO8
#define FX_PRIO8 1
#endif
#ifndef FX_F8_32
#define FX_F8_32 0
#endif
typedef int i32x8 __attribute__((ext_vector_type(8)));
typedef int i32x4 __attribute__((ext_vector_type(4)));
constexpr float W8_SCALE = 32.f, W8_INV = 1.f / 32.f;
__device__ __forceinline__ unsigned cvt_pk4_fp8(float a, float b, float c, float d) { int w = 0; w = __builtin_amdgcn_cvt_pk_fp8_f32(a, b, w, false); w = __builtin_amdgcn_cvt_pk_fp8_f32(c, d, w, true); return (unsigned)w; }
struct CvtSeg { const float* src; bf16_t* dst; long long sstride, dstride; int ld, nsrc, K, ntn, nbatch, G, GS, off; };
__device__ __forceinline__ void cvt_tile(const CvtSeg sg, FX_LAS unsigned* my, int tile) {
    const int lane = fx_lane();
    const int ktn = sg.K / 64, per = ktn * sg.ntn;
    {
        const int b = tile / per, r = tile - b * per, nt = r / ktn, kt = r - nt * ktn;
        const int r4 = lane >> 4, c4 = lane & 15;
        const float* src = sg.src + (size_t)b * sg.sstride + (size_t)(kt * 64) * sg.ld + nt * 64 + 4 * c4;
        const bool ok = nt * 64 + 4 * c4 < sg.nsrc;
        f32x4 va[8], vb[8];
#pragma unroll
        for (int i = 0; i < 8; ++i) { const int kp = 4 * i + r4; const f32x4 z = {0.f, 0.f, 0.f, 0.f};
            va[i] = ok ? *(const f32x4*)(src + (size_t)(2 * kp) * sg.ld) : z; vb[i] = ok ? *(const f32x4*)(src + (size_t)(2 * kp + 1) * sg.ld) : z; }
#pragma unroll
        for (int i = 0; i < 8; ++i) { const int kp = 4 * i + r4;
#pragma unroll
            for (int j = 0; j < 4; ++j) my[(4 * c4 + j) * 33 + kp] = cvt_pk_bf16(va[i][j], vb[i][j]); }
        asm volatile("s_waitcnt lgkmcnt(0)" ::: "memory");
        bf16_t* dst = sg.dst + (size_t)b * sg.dstride;
#pragma unroll
        for (int i = 0; i < 8; ++i) {
            const int nl = (lane >> 3) + 8 * i, c = lane & 7, n = nt * 64 + nl;
            u32x4 w; w.x = my[nl * 33 + 4 * c]; w.y = my[nl * 33 + 4 * c + 1]; w.z = my[nl * 33 + 4 * c + 2]; w.w = my[nl * 33 + 4 * c + 3];
            const int row = (n / sg.G) * sg.GS + (n % sg.G) + sg.off;
            *(u32x4*)(dst + (size_t)row * sg.K + kt * 64 + 8 * c) = w;
        }
        asm volatile("s_waitcnt lgkmcnt(0)" ::: "memory");
    }
}
__device__ __forceinline__ void cvt_seg(const CvtSeg sg, FX_LAS unsigned* my, int gwave, int nwaves, int& rot) {
    const int total = (sg.K / 64) * sg.ntn * sg.nbatch;
    int first = (gwave - rot) % nwaves; if (first < 0) first += nwaves;
    for (int tile = first; tile < total; tile += nwaves) cvt_tile(sg, my, tile);
    rot = (rot + total) % nwaves;
}
__device__ __forceinline__ void cvt_tile8(const CvtSeg sg, FX_LAS unsigned* my, int tile, float scale) {
    const int lane = fx_lane();
    const int ktn = sg.K / 64, per = ktn * sg.ntn;
    {
        const int b = tile / per, r = tile - b * per, nt = r / ktn, kt = r - nt * ktn;
        const int r4 = lane >> 4, c4 = lane & 15;
        const float* src = sg.src + (size_t)b * sg.sstride + (size_t)(kt * 64) * sg.ld + nt * 64 + 4 * c4;
        const bool ok = nt * 64 + 4 * c4 < sg.nsrc;
        f32x4 v[4][4];
#pragma unroll
        for (int i = 0; i < 4; ++i)
#pragma unroll
            for (int q = 0; q < 4; ++q) { const int kq = 4 * i + r4; const f32x4 z = {0.f, 0.f, 0.f, 0.f}; v[i][q] = ok ? *(const f32x4*)(src + (size_t)(4 * kq + q) * sg.ld) : z; }
#pragma unroll
        for (int i = 0; i < 4; ++i) { const int kq = 4 * i + r4;
#pragma unroll
            for (int j = 0; j < 4; ++j) my[(4 * c4 + j) * 17 + kq] = cvt_pk4_fp8(v[i][0][j] * scale, v[i][1][j] * scale, v[i][2][j] * scale, v[i][3][j] * scale); }
        asm volatile("s_waitcnt lgkmcnt(0)" ::: "memory");
        unsigned char* dst = (unsigned char*)sg.dst + (size_t)b * sg.dstride;
#pragma unroll
        for (int i = 0; i < 4; ++i) {
            const int nl = (lane >> 2) + 16 * i, c = lane & 3, n = nt * 64 + nl;
            u32x4 w; w.x = my[nl * 17 + 4 * c]; w.y = my[nl * 17 + 4 * c + 1]; w.z = my[nl * 17 + 4 * c + 2]; w.w = my[nl * 17 + 4 * c + 3];
            const int row = (n / sg.G) * sg.GS + (n % sg.G) + sg.off;
            *(u32x4*)(dst + (size_t)row * sg.K + kt * 64 + 16 * c) = w;
        }
        asm volatile("s_waitcnt lgkmcnt(0)" ::: "memory");
    }
}
struct Cvt8P { const float* src; unsigned char* dst; float sc; int nt, kt; };
__device__ __forceinline__ Cvt8P cvt8_params(const CvtSeg sg, int tile, float scale, int lane) {
    const int ktn = sg.K / 64, per = ktn * sg.ntn;
#if FX_CVT2D
    const int b = tile / per, r = tile - b * per, w8 = r & 7, g8 = r >> 3, ktp = ktn >> 1, ntq = g8 / ktp, nt = 4 * ntq + (w8 & 3), kt = 2 * (g8 - ntq * ktp) + (w8 >> 2);
#else
    const int b = tile / per, r = tile - b * per, nt = r / ktn, kt = r - nt * ktn;
#endif
    const int c4 = lane & 15;
    const bool ok = nt * 64 + 4 * c4 < sg.nsrc;
    Cvt8P p; p.src = sg.src + (size_t)b * sg.sstride + (size_t)(kt * 64) * sg.ld + (ok ? nt * 64 + 4 * c4 : 0); p.dst = (unsigned char*)sg.dst + (size_t)b * sg.dstride; p.sc = ok ? scale : 0.f; p.nt = nt; p.kt = kt;
    return p;
}
__device__ __forceinline__ void cvt8_out(const CvtSeg sg, FX_LAS unsigned* my, const Cvt8P& p, int lane) {
    asm volatile("s_waitcnt lgkmcnt(0)" ::: "memory");
#pragma unroll
    for (int i = 0; i < 4; ++i) {
        const int nl = (lane >> 2) + 16 * i, c = lane & 3, n = p.nt * 64 + nl;
        u32x4 w; w.x = my[nl * 17 + 4 * c]; w.y = my[nl * 17 + 4 * c + 1]; w.z = my[nl * 17 + 4 * c + 2]; w.w = my[nl * 17 + 4 * c + 3];
        const int row = (n / sg.G) * sg.GS + (n % sg.G) + sg.off;
        *(u32x4*)(p.dst + (size_t)row * sg.K + p.kt * 64 + 16 * c) = w;
    }
    asm volatile("s_waitcnt lgkmcnt(0)" ::: "memory");
}
__device__ __forceinline__ void cvt_seg8(const CvtSeg sg, FX_LAS unsigned* my, int gwave, int nwaves, int& rot, float scale) {
    const int total = (sg.K / 64) * sg.ntn * sg.nbatch;
    int first = (gwave - rot) % nwaves; if (first < 0) first += nwaves;
#if FX_CVTPIPE
    if (first < total) {
        const int lane = fx_lane(), r4 = lane >> 4, c4 = lane & 15;
        f32x4 v[4][4];
        Cvt8P cur = cvt8_params(sg, first, scale, lane);
#pragma unroll
        for (int i = 0; i < 4; ++i)
#pragma unroll
            for (int q = 0; q < 4; ++q) v[i][q] = *(const f32x4*)(cur.src + (size_t)(4 * (4 * i + r4) + q) * sg.ld);
        int tile = first;
#pragma unroll 1
        while (tile + nwaves < total) {
            tile += nwaves;
            const Cvt8P nx = cvt8_params(sg, tile, scale, lane);
#pragma unroll
            for (int i = 0; i < 4; ++i) { const int kq = 4 * i + r4;
#pragma unroll
                for (int j = 0; j < 4; ++j) my[(4 * c4 + j) * 17 + kq] = cvt_pk4_fp8(v[i][0][j] * cur.sc, v[i][1][j] * cur.sc, v[i][2][j] * cur.sc, v[i][3][j] * cur.sc);
#pragma unroll
                for (int q = 0; q < 4; ++q) v[i][q] = *(const f32x4*)(nx.src + (size_t)(4 * kq + q) * sg.ld); }
            cvt8_out(sg, my, cur, lane);
            cur = nx;
        }
#pragma unroll
        for (int i = 0; i < 4; ++i) { const int kq = 4 * i + r4;
#pragma unroll
            for (int j = 0; j < 4; ++j) my[(4 * c4 + j) * 17 + kq] = cvt_pk4_fp8(v[i][0][j] * cur.sc, v[i][1][j] * cur.sc, v[i][2][j] * cur.sc, v[i][3][j] * cur.sc); }
        cvt8_out(sg, my, cur, lane);
    }
#else
    for (int tile = first; tile < total; tile += nwaves) cvt_tile8(sg, my, tile, scale);
#endif
    rot = (rot + total) % nwaves;
}

constexpr int BM = 256, BK = 64, HALF = 128, HTB = HALF * BK * 2, STAGE_BYTES = 8 * HTB, NXCD = 8, WGM = FX_WGM;
__host__ __device__ __forceinline__ int lds_byte(int r, int c) { const int st = (r >> 4) * 2 + (c >> 5), rr = r & 15, cc = c & 31, ob = rr * 64 + cc * 2; return st * 1024 + (ob ^ (((ob >> 9) & 1) << 5)); }
__host__ __device__ __forceinline__ void stage_rc(int b, int& R, int& C) { const int st = b / 1024, sb = b % 1024, swz = sb ^ (((sb >> 9) & 1) << 5); R = (st >> 1) * 16 + swz / 64; C = (st & 1) * 32 + (swz % 64) / 2; }
__host__ __device__ __forceinline__ int perm32(int rho) { const int n = rho >> 4, i = rho & 15; return 8 * (i >> 2) + 4 * n + (i & 3); }
struct Unit { int pm, pn, e; };
struct DenseSched {
    static constexpr bool GATHER = false;
    int nM, nN, nwg, G, c; int lda_b; const char* Bt; int K; int esz;
    __device__ void init(int M, int N, int G_, int c_, int lda_bytes, const void* Bt_, int K_, int esz_ = 2) { nM = M / BM; nN = N / BM; nwg = nM * nN; G = G_; c = c_; lda_b = lda_bytes; Bt = (const char*)Bt_; K = K_; esz = esz_; }
    __device__ __forceinline__ bool next(int i, Unit& u) const {
        const long L = (long)i * G + c; if (L >= nwg) return false;
        int wgid = (int)L; { const int q = nwg / NXCD, r = nwg % NXCD, xcd = wgid % NXCD, off = wgid / NXCD; wgid = (xcd < r ? xcd * (q + 1) : r * (q + 1) + (xcd - r) * q) + off; }
        const int nig = WGM * nN, gid = wgid / nig, fm = gid * WGM, gsz = (nM - fm) < WGM ? (nM - fm) : WGM;
        u.pm = fm + ((wgid % nig) % gsz); u.pn = (wgid % nig) / gsz; u.e = 0; return true;
    }
    __device__ __forceinline__ unsigned a_row_off(const Unit& u, int R) const { return (unsigned)(u.pm * BM + R) * (unsigned)lda_b; }
    __device__ __forceinline__ size_t a_unit_base(const Unit& u) const { return (size_t)u.pm * BM * (size_t)lda_b; }
    __device__ __forceinline__ unsigned a_lane_off(int R) const { return (unsigned)R * (unsigned)lda_b; }
    __device__ __forceinline__ const char* b_ptr(const Unit& u) const { return Bt + (size_t)u.pn * BM * K * esz; }
};

template <class Epi, class Sched, bool FP8 = false>
__device__ __forceinline__ void gemm_phase(FX_LAS unsigned char* lds, const char* Abase, const int Kc, const Sched& S, const Epi& E, int tidp, const int noepi = 0) {
    int K_ = Kc; asm volatile("" : "+s"(K_)); const int K = K_;
    int tid_ = tidp; asm volatile("" : "+v"(tid_));
    const int tid = tid_, wid = __builtin_amdgcn_readfirstlane(tid >> 6), lane = tid & 63, wr = wid >> 2, wc = wid & 3, fr = lane & 15, fq = lane >> 4;
    constexpr int ES = FP8 ? 1 : 2;
    const int nt = K * ES / 128;
    int Rr[2], Cc[2]; unsigned voffB[2];
#pragma unroll
    for (int i = 0; i < 2; ++i) { int R, C; stage_rc(tid * 16 + i * 8192, R, C); Rr[i] = R; Cc[i] = C; const int Rb = (Epi::PERM && !(FP8 && FX_F8_32)) ? ((R & ~31) + perm32(R & 31)) : R; voffB[i] = (unsigned)(Rb * K * ES + C * 2); }
    const size_t hstepB = (size_t)HALF * K * ES;
    const unsigned ldsw = (unsigned)wid * 1024u;
    constexpr bool F32M = FP8 && FX_F8_32;
    const int aoff = F32M ? lds_byte(wr * 64 + (lane & 31), 16 * (lane >> 5)) : lds_byte(wr * 64 + fr, fq * 8), boff = F32M ? lds_byte(wc * 32 + (lane & 31), 16 * (lane >> 5)) : lds_byte(wc * 32 + fr, fq * 8);
#define FX_SA(b, h) (((b) * 2 + (h)) * HTB)
#define FX_SB(b, h) ((4 + (b) * 2 + (h)) * HTB)
#define FX_STAGE_A(bufoff, o0, o1, kb) do { const char* ap_ = Abase + (kb); \
        __builtin_amdgcn_global_load_lds((const unsigned*)(ap_ + (o0)), (FX_LAS unsigned*)(lds + (bufoff) + ldsw), 16, 0, 0); \
        __builtin_amdgcn_global_load_lds((const unsigned*)(ap_ + (o1)), (FX_LAS unsigned*)(lds + (bufoff) + ldsw + 8192), 16, 0, 0); } while (0)
#define FX_STAGE_B(bufoff, gbase) do { _Pragma("unroll") for (int _i = 0; _i < 2; ++_i) \
        __builtin_amdgcn_global_load_lds((const unsigned*)((const char*)(gbase) + voffB[_i]), (FX_LAS unsigned*)(lds + (bufoff) + ldsw + _i * 8192), 16, 0, 0); } while (0)
#define FX_LDA(dst, b, h) do { if constexpr (F32M) { _Pragma("unroll") for (int q = 0; q < 4; ++q) { dst[q][0] = *(const FX_LAS bf16x8*)(lds + FX_SA(b, h) + aoff + (q >> 1) * 4096 + (q & 1) * 1024); dst[q][1] = *(const FX_LAS bf16x8*)(lds + FX_SA(b, h) + aoff + (q >> 1) * 4096 + (q & 1) * 1024 + 16); } } \
        else { _Pragma("unroll") for (int m = 0; m < 4; ++m) _Pragma("unroll") for (int k = 0; k < 2; ++k) dst[m][k] = *(const FX_LAS bf16x8*)(lds + FX_SA(b, h) + aoff + m * 2048 + k * 1024); } } while (0)
#define FX_LDB(dst, b, h) do { if constexpr (F32M) { _Pragma("unroll") for (int q = 0; q < 2; ++q) { dst[q][0] = *(const FX_LAS bf16x8*)(lds + FX_SB(b, h) + boff + q * 1024); dst[q][1] = *(const FX_LAS bf16x8*)(lds + FX_SB(b, h) + boff + q * 1024 + 16); } } \
        else { _Pragma("unroll") for (int n = 0; n < 2; ++n) _Pragma("unroll") for (int k = 0; k < 2; ++k) dst[n][k] = *(const FX_LAS bf16x8*)(lds + FX_SB(b, h) + boff + n * 2048 + k * 1024); } } while (0)
#define FX_MMA(ai, bj, At, Bt) do { if (!FP8 || FX_PRIO8) __builtin_amdgcn_s_setprio(1); \
        if constexpr (F32M) { _Pragma("unroll") for (int mb = 0; mb < 2; ++mb) _Pragma("unroll") for (int s = 0; s < 2; ++s) { \
            const i32x4 a0_ = __builtin_bit_cast(i32x4, At[mb * 2 + s][0]), a1_ = __builtin_bit_cast(i32x4, At[mb * 2 + s][1]), b0_ = __builtin_bit_cast(i32x4, Bt[s][0]), b1_ = __builtin_bit_cast(i32x4, Bt[s][1]); \
            const i32x8 af_ = __builtin_shufflevector(a0_, a1_, 0, 1, 2, 3, 4, 5, 6, 7), bf_ = __builtin_shufflevector(b0_, b1_, 0, 1, 2, 3, 4, 5, 6, 7); \
            asm volatile("v_mfma_scale_f32_32x32x64_f8f6f4 %0, %1, %2, %0, %3, %3 op_sel_hi:[0,0,0]" : "+v"(acc3[ai][bj][mb]) : "v"(bf_), "v"(af_), "v"(sc1_)); } } else \
        _Pragma("unroll") for (int m = 0; m < 4; ++m) _Pragma("unroll") for (int n = 0; n < 2; ++n) { \
        if constexpr (FP8) { const i32x4 a0_ = __builtin_bit_cast(i32x4, At[m][0]), a1_ = __builtin_bit_cast(i32x4, At[m][1]), b0_ = __builtin_bit_cast(i32x4, Bt[n][0]), b1_ = __builtin_bit_cast(i32x4, Bt[n][1]); \
            const i32x8 af_ = __builtin_shufflevector(a0_, a1_, 0, 1, 2, 3, 4, 5, 6, 7), bf_ = __builtin_shufflevector(b0_, b1_, 0, 1, 2, 3, 4, 5, 6, 7); \
            asm volatile("v_mfma_scale_f32_16x16x128_f8f6f4 %0, %1, %2, %0, %3, %3 op_sel_hi:[0,0,0]" : "+v"(acc[ai][bj][m][n]) : "v"(bf_), "v"(af_), "v"(sc1_)); FX_MFMA_DUP(acc[ai][bj][m][n]) } \
        else { _Pragma("unroll") for (int k = 0; k < 2; ++k) acc[ai][bj][m][n] = __builtin_amdgcn_mfma_f32_16x16x32_bf16(Bt[n][k], At[m][k], acc[ai][bj][m][n], 0, 0, 0); } } \
        if (!FP8 || FX_PRIO8) __builtin_amdgcn_s_setprio(0); } while (0)
#define FX_WAIT_V(n) asm volatile("s_waitcnt vmcnt(" #n ")" ::: "memory")
#define FX_WAIT_L(n) asm volatile("s_waitcnt lgkmcnt(" #n ")" ::: "memory")
#define FX_BAR __builtin_amdgcn_s_barrier()
#define FX_SCHED __builtin_amdgcn_sched_barrier(0)
#ifdef FX_PROBE_MFMA
#define FX_MFMA_DUP(ACC) asm volatile("v_mfma_scale_f32_16x16x128_f8f6f4 %0, %1, %2, %0, %3, %3 op_sel_hi:[0,0,0]" : "+v"(ACC) : "v"(bf_), "v"(af_), "v"(sc0_));
#else
#define FX_MFMA_DUP(ACC)
#endif
    const int sc0_ = 0; (void)sc0_;
    const int sc1_ = 0x7f7f7f7f;
    (void)sc1_;
    Unit cur, nxt; int ui = 0;
    if (!S.next(0, cur)) return;
    f32x4 acc[2][2][4][2];
#pragma unroll
    for (int a = 0; a < 2; ++a)
#pragma unroll
        for (int b = 0; b < 2; ++b)
#pragma unroll
            for (int m = 0; m < 4; ++m)
#pragma unroll
                for (int n = 0; n < 2; ++n) acc[a][b][m][n] = (f32x4){0.f, 0.f, 0.f, 0.f};
    f32x16 acc3[2][2][2];
#pragma unroll
    for (int q = 0; q < 8; ++q) acc3[q >> 2][(q >> 1) & 1][q & 1] = f32x16{};
    bf16x8 At[4][2], B0[2][2], B1[2][2];
    unsigned c00, c01, c10, c11, n00 = 0, n01 = 0, n10 = 0, n11 = 0;
    size_t ubc = 0, ubn = 0;
    if constexpr (Sched::GATHER) { c00 = S.a_row_off(cur, Rr[0]) + Cc[0] * 2; c01 = S.a_row_off(cur, Rr[1]) + Cc[1] * 2; c10 = S.a_row_off(cur, HALF + Rr[0]) + Cc[0] * 2; c11 = S.a_row_off(cur, HALF + Rr[1]) + Cc[1] * 2; }
    else { c00 = S.a_lane_off(Rr[0]) + Cc[0] * 2; c01 = S.a_lane_off(Rr[1]) + Cc[1] * 2; c10 = c00 + S.a_lane_off(HALF); c11 = c01 + S.a_lane_off(HALF); ubc = S.a_unit_base(cur); n00 = c00; n01 = c01; n10 = c10; n11 = c11; }
    const char* cB = S.b_ptr(cur);
    const unsigned kstep = BK * 2;
    FX_STAGE_B(FX_SB(0, 0), cB); FX_STAGE_A(FX_SA(0, 0), c00, c01, ubc); FX_STAGE_B(FX_SB(0, 1), cB + hstepB); FX_STAGE_A(FX_SA(0, 1), c10, c11, ubc);
    if (wr == 1) FX_BAR;
    FX_WAIT_V(4); FX_BAR;
    FX_STAGE_B(FX_SB(1, 0), cB + kstep); FX_STAGE_A(FX_SA(1, 0), c00, c01, ubc + kstep); FX_STAGE_B(FX_SB(1, 1), cB + hstepB + kstep);
    FX_WAIT_V(6); FX_BAR;
    for (;;) {
        const bool has_next = S.next(ui + 1, nxt);
        if (!has_next) nxt = cur;
        if constexpr (!Sched::GATHER) ubn = S.a_unit_base(nxt);
        const char* nB = S.b_ptr(nxt);
        for (int t = 0; t < nt; t += 2) {
            const bool last = (t == nt - 2);
            asm volatile("" : "+v"(c00), "+v"(c01), "+v"(c10), "+v"(c11), "+v"(voffB[0]), "+v"(voffB[1]));
            if constexpr (Sched::GATHER) { if (last) {
                int t2_ = tid; asm volatile("" : "+v"(t2_)); int R0_, C0_, R1_, C1_; stage_rc(t2_ * 16, R0_, C0_); stage_rc(t2_ * 16 + 8192, R1_, C1_);
                n00 = S.a_row_off(nxt, R0_) + C0_ * 2; n01 = S.a_row_off(nxt, R1_) + C1_ * 2; n10 = S.a_row_off(nxt, HALF + R0_) + C0_ * 2; n11 = S.a_row_off(nxt, HALF + R1_) + C1_ * 2; } }
            const size_t k1 = ubc + (size_t)(t + 1) * kstep;
            const size_t k2 = last ? ubn : ubc + (size_t)(t + 2) * kstep, k3 = k2 + kstep;
            unsigned a00, a01, a10, a11;
            if constexpr (Sched::GATHER) { a00 = last ? n00 : c00; a01 = last ? n01 : c01; a10 = last ? n10 : c10; a11 = last ? n11 : c11; } else { a00 = c00; a01 = c01; a10 = c10; a11 = c11; }
            const char* b2 = last ? nB : cB + (size_t)(t + 2) * kstep; const char* b3 = b2 + kstep;
            FX_LDB(B0, 0, 0); FX_SCHED; FX_LDA(At, 0, 0); FX_STAGE_A(FX_SA(1, 1), c10, c11, k1);
            FX_WAIT_L(8); FX_BAR; FX_WAIT_L(0); FX_MMA(0, 0, At, B0); FX_BAR; FX_SCHED;
            FX_LDB(B1, 0, 1); FX_STAGE_B(FX_SB(0, 0), b2);
            FX_BAR; FX_WAIT_L(0); FX_MMA(0, 1, At, B1); FX_BAR;
            FX_LDA(At, 0, 1); FX_STAGE_A(FX_SA(0, 0), a00, a01, k2);
            FX_BAR; FX_WAIT_L(0); FX_MMA(1, 0, At, B0); FX_BAR; FX_SCHED;
            FX_STAGE_B(FX_SB(0, 1), b2 + hstepB);
            FX_WAIT_V(6); FX_BAR; FX_MMA(1, 1, At, B1); FX_BAR;
            FX_LDB(B0, 1, 0); FX_SCHED; FX_LDA(At, 1, 0); FX_STAGE_A(FX_SA(0, 1), a10, a11, k2);
            FX_WAIT_L(8); FX_BAR; FX_WAIT_L(0); FX_MMA(0, 0, At, B0); FX_BAR; FX_SCHED;
            FX_LDB(B1, 1, 1); FX_STAGE_B(FX_SB(1, 0), b3);
            FX_BAR; FX_WAIT_L(0); FX_MMA(0, 1, At, B1); FX_BAR;
            FX_LDA(At, 1, 1); FX_STAGE_A(FX_SA(1, 0), a00, a01, k3);
            FX_BAR; FX_WAIT_L(0); FX_MMA(1, 0, At, B0); FX_BAR; FX_SCHED;
            FX_STAGE_B(FX_SB(1, 1), b3 + hstepB);
            FX_WAIT_V(6); FX_BAR; FX_MMA(1, 1, At, B1); FX_BAR;
        }
        if constexpr (FP8) asm volatile("s_nop 15\n\ts_nop 15\n\ts_nop 15\n\ts_nop 15" ::: "memory");
        if constexpr (F32M) { int ln_e = lane; asm volatile("" : "+v"(ln_e)); E.e32(acc3, cur, wr, wc, ln_e); }
        else if (noepi) { f32x4 s_ = (f32x4){0.f, 0.f, 0.f, 0.f};
#pragma unroll
            for (int q_ = 0; q_ < 32; ++q_) s_ += acc[q_ >> 4][(q_ >> 3) & 1][(q_ >> 1) & 3][q_ & 1];
            if (s_[0] + s_[1] + s_[2] + s_[3] == 1.2345e-30f) *(float*)const_cast<char*>(Abase) = s_[0]; }
        else { int fr_e = fr, fq_e = fq; asm volatile("" : "+v"(fr_e), "+v"(fq_e)); E(acc, cur, wr, wc, fr_e, fq_e); }
        if (!has_next) break;
        if constexpr (F32M) { _Pragma("unroll") for (int q = 0; q < 8; ++q) acc3[q >> 2][(q >> 1) & 1][q & 1] = f32x16{}; }
#pragma unroll
        for (int a = 0; a < 2; ++a)
#pragma unroll
            for (int b = 0; b < 2; ++b)
#pragma unroll
                for (int m = 0; m < 4; ++m)
#pragma unroll
                    for (int n = 0; n < 2; ++n) acc[a][b][m][n] = (f32x4){0.f, 0.f, 0.f, 0.f};
        cur = nxt; cB = nB; if constexpr (Sched::GATHER) { c00 = n00; c01 = n01; c10 = n10; c11 = n11; } else ubc = ubn; ++ui;
    }
    FX_WAIT_V(0);
    if (wr == 0) FX_BAR;
    FX_BAR;
}

#ifndef FX_EPILDS
#define FX_EPILDS 1
#endif
#ifndef FX_NTST
#define FX_NTST 0
#endif
#if FX_NTST
#define FX_EPI_ST(TY, p, v) __builtin_nontemporal_store((v), (TY*)(p))
#else
#define FX_EPI_ST(TY, p, v) (*(TY*)(p) = (v))
#endif
constexpr int EPI_LDS_OFF = STAGE_BYTES + 8192 + 64, EPI_LDS_BYTES = 8 * 2304;
struct EpiBf16 {
    static constexpr bool PERM = true;
    bf16_t* O; float* gates; int ldc; float scale; FX_LAS unsigned char* es;
    __device__ __forceinline__ void operator()(const f32x4 (&acc)[2][2][4][2], const Unit& u, int wr, int wc, int fr, int fq) const {
        const int row0 = u.pm * BM + wr * 64 + fr, col0 = u.pn * BM + wc * 32 + 8 * fq;
#if FX_EPILDS
        if (FX_EPILDS == 1 || (FX_EPILDS == 2 && gates == nullptr && ldc == 2048) || (FX_EPILDS == 3 && gates != nullptr) || (FX_EPILDS == 4 && ldc == 1536)) {
        FX_LAS unsigned char* my = es + (wr * 4 + wc) * 2304;
        const int lane = fq * 16 + fr, rrow = lane >> 2, rch = lane & 3;
#pragma unroll
        for (int ai = 0; ai < 2; ++ai)
#pragma unroll
            for (int m = 0; m < 4; ++m) { FX_LAS unsigned char* buf = my;
#pragma unroll
                for (int bj = 0; bj < 2; ++bj) { const f32x4 v0 = acc[ai][bj][m][0] * scale, v1 = acc[ai][bj][m][1] * scale;
                    u32x4 w; w.x = cvt_pk_bf16(v0[0], v0[1]); w.y = cvt_pk_bf16(v0[2], v0[3]); w.z = cvt_pk_bf16(v1[0], v1[1]); w.w = cvt_pk_bf16(v1[2], v1[3]);
                    *(FX_LAS u32x4*)(buf + fr * 144 + bj * 64 + fq * 16) = w; }
                const int row = u.pm * BM + wr * 64 + ai * HALF + m * 16 + rrow; bf16_t* rowp = O + (size_t)row * ldc + u.pn * BM + wc * 32 + rch * 8;
#pragma unroll
                for (int q = 0; q < 2; ++q) { const u32x4 w = *(const FX_LAS u32x4*)(buf + rrow * 144 + q * 64 + rch * 16); *(u32x4*)(rowp + q * HALF) = w; }
                if (gates && u.pn == 15 && wc == 2 && fq < 2) { float* g = gates + (size_t)(row0 + ai * HALF + m * 16) * 16 + 8 * fq; *(f32x4*)g = acc[ai][1][m][0] * scale; *(f32x4*)(g + 4) = acc[ai][1][m][1] * scale; } }
        (void)col0; return; }
#endif
        {
#pragma unroll
        for (int ai = 0; ai < 2; ++ai)
#pragma unroll
            for (int m = 0; m < 4; ++m) { const int row = row0 + ai * HALF + m * 16; bf16_t* rowp = O + (size_t)row * ldc + col0;
#pragma unroll
                for (int bj = 0; bj < 2; ++bj) { const f32x4 v0 = acc[ai][bj][m][0] * scale, v1 = acc[ai][bj][m][1] * scale;
                    u32x4 w; w.x = cvt_pk_bf16(v0[0], v0[1]); w.y = cvt_pk_bf16(v0[2], v0[3]); w.z = cvt_pk_bf16(v1[0], v1[1]); w.w = cvt_pk_bf16(v1[2], v1[3]);
                    FX_EPI_ST(u32x4, rowp + bj * HALF, w); }
                if (gates && u.pn == 15 && wc == 2 && fq < 2) { float* g = gates + (size_t)row * 16 + 8 * fq; *(f32x4*)g = acc[ai][1][m][0] * scale; *(f32x4*)(g + 4) = acc[ai][1][m][1] * scale; } }
        }
    }
    __device__ __forceinline__ void e32(const f32x16 (&acc3)[2][2][2], const Unit& u, int wr, int wc, int lane) const {
        const int j = lane & 31, hi = lane >> 5;
#pragma unroll
        for (int ai = 0; ai < 2; ++ai)
#pragma unroll
            for (int mb = 0; mb < 2; ++mb) { const int row = u.pm * BM + ai * HALF + wr * 64 + mb * 32 + j;
#pragma unroll
                for (int bj = 0; bj < 2; ++bj) { bf16_t* rowp = O + (size_t)row * ldc + u.pn * BM + bj * HALF + wc * 32 + 4 * hi;
#pragma unroll
                    for (int g = 0; g < 4; ++g) { u32x2 w; w.x = cvt_pk_bf16(acc3[ai][bj][mb][4 * g] * scale, acc3[ai][bj][mb][4 * g + 1] * scale); w.y = cvt_pk_bf16(acc3[ai][bj][mb][4 * g + 2] * scale, acc3[ai][bj][mb][4 * g + 3] * scale);
                        *(u32x2*)(rowp + 8 * g) = w; } }
                if (gates && u.pn == 15 && wc == 2) { float* gp = gates + (size_t)row * 16 + 4 * hi;
#pragma unroll
                    for (int g = 0; g < 2; ++g) *(f32x4*)(gp + 8 * g) = (f32x4){acc3[ai][1][mb][4 * g] * scale, acc3[ai][1][mb][4 * g + 1] * scale, acc3[ai][1][mb][4 * g + 2] * scale, acc3[ai][1][mb][4 * g + 3] * scale}; } }
    }
};
}
#ifndef FX_RUNR
#define FX_RUNR 16
#endif
namespace fx {
constexpr int RT = 16;
constexpr int H2S_LD = 2052;
constexpr int P7_LDS = RT * H2S_LD * 4 + 512;
constexpr int PTOT = 131072;
constexpr int NTILE_MAX = PTOT / 256;

__device__ __forceinline__ void coef_phase(const float* mod, const float* pre_mix_gain, const float* post_mix_gain, const float* pre_ffn_gain, const float* post_ffn_gain, float* coef, int gtid, int nthr) {
    for (int i = gtid; i < 2 * 4 * 2048; i += nthr) { const int d = i & 2047, b = (i >> 11) & 3, l = i >> 13;
        const float* m = mod + ((size_t)l * 4 + b) * 12288; float* c = coef + ((size_t)l * 4 + b) * 6 * 2048;
        c[0 * 2048 + d] = m[2 * 2048 + d] * post_mix_gain[l * 2048 + d];
        c[1 * 2048 + d] = pre_ffn_gain[l * 2048 + d] * (1.f + m[4 * 2048 + d]);
        c[2 * 2048 + d] = m[3 * 2048 + d];
        c[3 * 2048 + d] = m[5 * 2048 + d] * post_ffn_gain[l * 2048 + d];
        c[4 * 2048 + d] = pre_mix_gain[l * 2048 + d] * (1.f + m[1 * 2048 + d]);
        c[5 * 2048 + d] = m[0 * 2048 + d]; }
}

template <bool XBF>
__device__ __forceinline__ void p7_phase(FX_LAS unsigned char* lds, const void* xin_, const bf16_t* Y, const float* coef_l  , const float* router_w, const float* router_bias,
                                         bf16_t* XRES, unsigned char* HA8, int* SELE, float* SELG, int* CNT, int* WGBASE, int wg, int nwg, int tidp) {
    int tid_ = tidp; asm volatile("" : "+v"(tid_));
    const int tid = tid_, wid = tid >> 6, lane = tid & 63;
    FX_LAS float* h2s = (FX_LAS float*)lds;
    FX_LAS int* hist = (FX_LAS int*)(lds + RT * H2S_LD * 4);
    if (tid < 64) hist[tid] = 0;
    __syncthreads();
#define FX_GC(TY, p) ((const __attribute__((address_space(1))) TY*)(p))
#define FX_GM(TY, p) ((__attribute__((address_space(1))) TY*)(p))
    const int i16 = lane & 15, g4 = lane >> 4;
    for (int unit = wg; unit < T / RT; unit += nwg) {
        {
            const int tok0 = 2 * wid, t0 = unit * RT + tok0, b = t0 / S;
            const float* cf = coef_l + (size_t)b * 6 * 2048;
            u32x4 yw[2][4]; f32x4 ca[8];
            float xv[2][32];
#pragma unroll
            for (int tt = 0; tt < 2; ++tt)
#pragma unroll
                for (int i = 0; i < 4; ++i) yw[tt][i] = *FX_GC(u32x4, Y + (size_t)(t0 + tt) * 2048 + i * 512 + lane * 8);
            if constexpr (XBF) {
                u32x4 xw[2][4];
#pragma unroll
                for (int tt = 0; tt < 2; ++tt)
#pragma unroll
                    for (int i = 0; i < 4; ++i) xw[tt][i] = *FX_GC(u32x4, (const bf16_t*)xin_ + (size_t)(t0 + tt) * 2048 + i * 512 + lane * 8);
#pragma unroll
                for (int i = 0; i < 4; ++i) { ca[2 * i] = *FX_GC(f32x4, cf + i * 512 + lane * 8); ca[2 * i + 1] = *FX_GC(f32x4, cf + i * 512 + lane * 8 + 4); }
#pragma unroll
                for (int tt = 0; tt < 2; ++tt)
#pragma unroll
                    for (int i = 0; i < 4; ++i) { const u32x4 w = xw[tt][i];
                        xv[tt][i * 8 + 0] = bflo(w.x); xv[tt][i * 8 + 1] = bfhi(w.x); xv[tt][i * 8 + 2] = bflo(w.y); xv[tt][i * 8 + 3] = bfhi(w.y); xv[tt][i * 8 + 4] = bflo(w.z); xv[tt][i * 8 + 5] = bfhi(w.z); xv[tt][i * 8 + 6] = bflo(w.w); xv[tt][i * 8 + 7] = bfhi(w.w); }
            } else {
                const float* xin = (const float*)xin_;
#pragma unroll
                for (int tt = 0; tt < 2; ++tt)
#pragma unroll
                    for (int i = 0; i < 4; ++i) { const f32x4 x0 = *FX_GC(f32x4, xin + (size_t)(t0 + tt) * 2048 + i * 512 + lane * 8), x1 = *FX_GC(f32x4, xin + (size_t)(t0 + tt) * 2048 + i * 512 + lane * 8 + 4);
                        xv[tt][i * 8 + 0] = x0[0]; xv[tt][i * 8 + 1] = x0[1]; xv[tt][i * 8 + 2] = x0[2]; xv[tt][i * 8 + 3] = x0[3]; xv[tt][i * 8 + 4] = x1[0]; xv[tt][i * 8 + 5] = x1[1]; xv[tt][i * 8 + 6] = x1[2]; xv[tt][i * 8 + 7] = x1[3]; }
#pragma unroll
                for (int i = 0; i < 4; ++i) { ca[2 * i] = *FX_GC(f32x4, cf + i * 512 + lane * 8); ca[2 * i + 1] = *FX_GC(f32x4, cf + i * 512 + lane * 8 + 4); }
            }
            float ssy0 = 0.f, ssy1 = 0.f;
#pragma unroll
            for (int i = 0; i < 4; ++i) { const u32x4 w0 = yw[0][i], w1 = yw[1][i];
#pragma unroll
                for (int q = 0; q < 4; ++q) { const float l0 = bflo(w0[q]), h0 = bfhi(w0[q]), l1 = bflo(w1[q]), h1 = bfhi(w1[q]); ssy0 += l0 * l0 + h0 * h0; ssy1 += l1 * l1 + h1 * h1; } }
#pragma unroll
            for (int o = 32; o >= 1; o >>= 1) { ssy0 += __shfl_xor(ssy0, o); ssy1 += __shfl_xor(ssy1, o); }
            const float ry0 = rsqrtf(ssy0 * (1.f / 2048.f) + EPS), ry1 = rsqrtf(ssy1 * (1.f / 2048.f) + EPS);
            float ssx0 = 0.f, ssx1 = 0.f;
#pragma unroll
            for (int i = 0; i < 4; ++i) { const u32x4 w0 = yw[0][i], w1 = yw[1][i];
#pragma unroll
                for (int j = 0; j < 8; ++j) { const float a = ca[2 * i + (j >> 2)][j & 3];
                    const float y0 = (j & 1) ? bfhi(w0[j >> 1]) : bflo(w0[j >> 1]), y1 = (j & 1) ? bfhi(w1[j >> 1]) : bflo(w1[j >> 1]);
                    xv[0][i * 8 + j] += a * (y0 * ry0); xv[1][i * 8 + j] += a * (y1 * ry1);
                    ssx0 += xv[0][i * 8 + j] * xv[0][i * 8 + j]; ssx1 += xv[1][i * 8 + j] * xv[1][i * 8 + j]; } }
            f32x4 cb[8], cc[8];
#pragma unroll
            for (int i = 0; i < 4; ++i) { cb[2 * i] = *FX_GC(f32x4, cf + 2048 + i * 512 + lane * 8); cb[2 * i + 1] = *FX_GC(f32x4, cf + 2048 + i * 512 + lane * 8 + 4);
                cc[2 * i] = *FX_GC(f32x4, cf + 4096 + i * 512 + lane * 8); cc[2 * i + 1] = *FX_GC(f32x4, cf + 4096 + i * 512 + lane * 8 + 4); }
#pragma unroll
            for (int tt = 0; tt < 2; ++tt)
#pragma unroll
                for (int i = 0; i < 4; ++i) { u32x4 xo; xo.x = cvt_pk_bf16(xv[tt][i * 8 + 0], xv[tt][i * 8 + 1]); xo.y = cvt_pk_bf16(xv[tt][i * 8 + 2], xv[tt][i * 8 + 3]); xo.z = cvt_pk_bf16(xv[tt][i * 8 + 4], xv[tt][i * 8 + 5]); xo.w = cvt_pk_bf16(xv[tt][i * 8 + 6], xv[tt][i * 8 + 7]);
                    *FX_GM(u32x4, XRES + (size_t)(t0 + tt) * 2048 + i * 512 + lane * 8) = xo; }
#pragma unroll
            for (int o = 32; o >= 1; o >>= 1) { ssx0 += __shfl_xor(ssx0, o); ssx1 += __shfl_xor(ssx1, o); }
            const float rx0 = rsqrtf(ssx0 * (1.f / 2048.f) + EPS), rx1 = rsqrtf(ssx1 * (1.f / 2048.f) + EPS);
#pragma unroll
            for (int tt = 0; tt < 2; ++tt) { const float rx = tt ? rx1 : rx0;
#pragma unroll
                for (int i = 0; i < 4; ++i) { const int c = i * 512 + lane * 8;
                    float hv[8];
#pragma unroll
                    for (int j = 0; j < 8; ++j) hv[j] = xv[tt][i * 8 + j] * rx * cb[2 * i + (j >> 2)][j & 3] + cc[2 * i + (j >> 2)][j & 3];
                    u32x2 w; w.x = cvt_pk4_fp8(hv[0], hv[1], hv[2], hv[3]); w.y = cvt_pk4_fp8(hv[4], hv[5], hv[6], hv[7]);
                    *FX_GM(u32x2, HA8 + (size_t)(t0 + tt) * 2048 + c) = w;
                    *(FX_LAS f32x4*)(h2s + (tok0 + tt) * H2S_LD + c) = (f32x4){hv[0], hv[1], hv[2], hv[3]};
                    *(FX_LAS f32x4*)(h2s + (tok0 + tt) * H2S_LD + c + 4) = (f32x4){hv[4], hv[5], hv[6], hv[7]}; } }
        }
        f32x4 acc[4];
#pragma unroll
        for (int j = 0; j < 4; ++j) acc[j] = (f32x4){0.f, 0.f, 0.f, 0.f};
        {
            const char* rwb = (const char*)router_w + (size_t)__builtin_amdgcn_readfirstlane(wid) * (256 * 64 * 4);
            const unsigned loff = (unsigned)(g4 * 64 + 4 * i16) * 4u;
            f32x4 bwA[8], bwB[8];
            { unsigned o_ = loff; asm volatile("" : "+v"(o_));
#pragma unroll
              for (int q = 0; q < 8; ++q) bwA[q] = *FX_GC(f32x4, rwb + o_ + q * 1024); }
            __syncthreads();
#pragma unroll
            for (int kb = 0; kb < 8; ++kb) {
                if (kb < 7) { unsigned o_ = loff + (kb + 1) * 8192; asm volatile("" : "+v"(o_));
#pragma unroll
                    for (int q = 0; q < 8; ++q) { const f32x4 v = *FX_GC(f32x4, rwb + o_ + q * 1024); if (kb & 1) bwA[q] = v; else bwB[q] = v; } }
#pragma unroll
                for (int q = 0; q < 8; ++q) { const int k = 256 * wid + 4 * (kb * 8 + q) + g4;
                    const float a = h2s[i16 * H2S_LD + k]; const f32x4 bw = (kb & 1) ? bwB[q] : bwA[q];
                    acc[0] = __builtin_amdgcn_mfma_f32_16x16x4f32(a, bw[0], acc[0], 0, 0, 0);
                    acc[1] = __builtin_amdgcn_mfma_f32_16x16x4f32(a, bw[1], acc[1], 0, 0, 0);
                    acc[2] = __builtin_amdgcn_mfma_f32_16x16x4f32(a, bw[2], acc[2], 0, 0, 0);
                    acc[3] = __builtin_amdgcn_mfma_f32_16x16x4f32(a, bw[3], acc[3], 0, 0, 0); } }
        }
        __syncthreads();
        { FX_LAS float* part = h2s; const int i16 = lane & 15, g = lane >> 4;
#pragma unroll
          for (int j = 0; j < 4; ++j)
#pragma unroll
            for (int r = 0; r < 4; ++r) part[(wid * 16 + 4 * g + r) * 64 + 4 * i16 + j] = acc[j][r]; }
        __syncthreads();
#pragma unroll 1
        for (int tt = 0; tt < 2; ++tt) {
            const int tok = 2 * wid + tt, t = unit * RT + tok;
            float lg = 0.f;
#pragma unroll
            for (int w = 0; w < 8; ++w) lg += h2s[(w * 16 + tok) * 64 + lane];
            const float score = 1.f / (1.f + expf(-lg));
            float v = score + router_bias[lane];
            int my_e = 0; float my_s = 0.f, sum = 0.f;
#pragma unroll
            for (int k = 0; k < 6; ++k) {
                const float m = wave_max(v);
                const unsigned long long bal = __ballot(v == m);
                const int win = __ffsll((long long)bal) - 1;
                const float sw = __shfl(score, win);
                sum += sw; if (lane == k) { my_e = win; my_s = sw; }
                if (lane == win) v = -3.0e38f;
            }
            if (lane < 6) { SELE[(size_t)t * 6 + lane] = my_e; SELG[(size_t)t * 6 + lane] = my_s / sum * 2.5f; __hip_atomic_fetch_add(hist + my_e, 1, __ATOMIC_RELAXED, __HIP_MEMORY_SCOPE_WORKGROUP); }
        }
        __syncthreads();
    }
    if (tid < 64) { const int hv = hist[tid]; const int base = atomicAdd(CNT + tid, hv); WGBASE[wg * 64 + tid] = base; }
}

__device__ __forceinline__ void p8_phase(FX_LAS unsigned char* lds, const int* SELE, const float* SELG, const int* CNT, const int* WGBASE, int* ROWTOK, float* ROWG, int* SLOT, int wg, int nwg, int tidp) {
    int tid_ = tidp; asm volatile("" : "+v"(tid_));
    const int tid = tid_;
    FX_LAS int* pstart = (FX_LAS int*)lds; FX_LAS int* off = pstart + 80;
    if (tid < 64) { const int pc = (CNT[tid] + 255) & ~255; int incl = pc;
#pragma unroll
        for (int o = 1; o < 64; o <<= 1) { const int t2 = __shfl_up(incl, o); if (tid >= o) incl += t2; }
        pstart[tid] = 16384 + incl - pc; if (tid == 63) pstart[64] = 16384 + incl; }
    __syncthreads();
    if (tid < 64) off[tid] = pstart[tid] + WGBASE[wg * 64 + tid];
    __syncthreads();
    for (int unit = wg; unit < T / RT; unit += nwg) {
        if (tid < RT * 6) { const int t = unit * RT + tid / 6, k = tid % 6; const int e = SELE[(size_t)t * 6 + k];
            const int pos = __hip_atomic_fetch_add(off + e, 1, __ATOMIC_RELAXED, __HIP_MEMORY_SCOPE_WORKGROUP);
            ROWTOK[pos] = t; ROWG[pos] = SELG[(size_t)t * 6 + k]; SLOT[(size_t)t * 6 + k] = pos; }
    }
    for (int e = wg; e < 64; e += nwg) { const int a = pstart[e] + CNT[e], b = pstart[e + 1]; for (int r = a + tid; r < b; r += 512) { ROWTOK[r] = 0; ROWG[r] = 0.f; } }
    for (int r = wg * 512 + tid; r < 16384; r += nwg * 512) { ROWTOK[r] = r; ROWG[r] = 1.f; }
}

struct MoeSched {
    static constexpr bool GATHER = true;
    FX_LAS const unsigned char* tile_e; int ntiles, npn, nunits, G, c;
    const int* rowtok; int lda_b; const char* Bt; size_t estride_b, pnstride_b;
    __device__ __forceinline__ bool next(int i, Unit& u) const {
        const long L = (long)i * G + c; if (L >= nunits) return false;
        int id = (int)L; { const int q = nunits / NXCD, r = nunits % NXCD, xcd = id % NXCD, off = id / NXCD; id = (xcd < r ? xcd * (q + 1) : r * (q + 1) + (xcd - r) * q) + off; }
        u.pm = id / npn; u.pn = id - u.pm * npn; u.e = tile_e[u.pm]; return true;
    }
    __device__ __forceinline__ unsigned a_row_off(const Unit& u, int R) const { const int row = u.pm * BM + R; return (unsigned)(rowtok ? rowtok[row] : row) * (unsigned)lda_b; }
    __device__ __forceinline__ const char* b_ptr(const Unit& u) const { return Bt + (size_t)u.e * estride_b + (size_t)u.pn * pnstride_b; }
};
__device__ __forceinline__ int moe_sched_build(FX_LAS unsigned char* tab, const int* CNT, int tidp) {
    FX_LAS int* nt = (FX_LAS int*)(tab + 512);
    int tid_ = tidp; asm volatile("" : "+v"(tid_));
    if (tid_ < 64) { const int n = (CNT[tid_] + 255) >> 8; int incl = n;
#pragma unroll
        for (int o = 1; o < 64; o <<= 1) { const int t2 = __shfl_up(incl, o); if (tid_ >= o) incl += t2; }
        const int st0 = 64 + incl - n; for (int j = 0; j < n; ++j) tab[st0 + j] = (unsigned char)tid_;
        tab[tid_] = 64; if (tid_ == 63) nt[0] = 64 + incl; }
    __syncthreads();
    return nt[0];
}
struct EpiGateUp {
    static constexpr bool PERM = true;
    unsigned char* HID; FX_LAS unsigned char* es;
    __device__ __forceinline__ void operator()(const f32x4 (&acc)[2][2][4][2], const Unit& u, int wr, int wc, int fr, int fq) const {
        FX_LAS unsigned char* buf = es + (wr * 4 + wc) * 2304;
        const int lane = fq * 16 + fr, rr = lane >> 1, rch = lane & 1;
#pragma unroll
        for (int ai = 0; ai < 2; ++ai)
#pragma unroll
            for (int p = 0; p < 2; ++p) {
#pragma unroll
                for (int mm = 0; mm < 2; ++mm) { const int m = 2 * p + mm;
                    float o[8];
#pragma unroll
                    for (int n = 0; n < 2; ++n)
#pragma unroll
                        for (int j = 0; j < 4; ++j) { const float g = acc[ai][0][m][n][j] * W8_INV, up = acc[ai][1][m][n][j] * W8_INV; o[n * 4 + j] = g * __builtin_amdgcn_rcpf(1.f + __expf(-g)) * up; }
                    u32x2 w; w.x = cvt_pk4_fp8(o[0], o[1], o[2], o[3]); w.y = cvt_pk4_fp8(o[4], o[5], o[6], o[7]);
                    *(FX_LAS u32x2*)(buf + (mm * 16 + fr) * 48 + fq * 8) = w; }
                const u32x4 v = *(const FX_LAS u32x4*)(buf + rr * 48 + rch * 16);
                const int row = u.pm * BM + wr * 64 + ai * HALF + (2 * p + (rr >> 4)) * 16 + (rr & 15);
                *(u32x4*)(HID + (size_t)row * 512 + u.pn * 128 + wc * 32 + rch * 16) = v; }
    }
    __device__ __forceinline__ void e32(const f32x16 (&acc3)[2][2][2], const Unit& u, int wr, int wc, int lane) const {
        const int j = lane & 31, hi = lane >> 5;
#pragma unroll
        for (int ai = 0; ai < 2; ++ai)
#pragma unroll
            for (int mb = 0; mb < 2; ++mb) { const int row = u.pm * BM + ai * HALF + wr * 64 + mb * 32 + j; unsigned char* rowp = HID + (size_t)row * 512 + u.pn * 128 + wc * 32 + 4 * hi;
#pragma unroll
                for (int g = 0; g < 4; ++g) { float o[4];
#pragma unroll
                    for (int q = 0; q < 4; ++q) { const float gt = acc3[ai][0][mb][4 * g + q] * W8_INV, up = acc3[ai][1][mb][4 * g + q] * W8_INV; o[q] = gt * __builtin_amdgcn_rcpf(1.f + __expf(-gt)) * up; }
                    *(unsigned*)(rowp + 8 * g) = cvt_pk4_fp8(o[0], o[1], o[2], o[3]); } }
    }
};
struct EpiDown {
    static constexpr bool PERM = true;
    unsigned char* YR; const float* ROWG; int nostore; FX_LAS unsigned char* es;
    __device__ __forceinline__ void operator()(const f32x4 (&acc)[2][2][4][2], const Unit& u, int wr, int wc, int fr, int fq) const {
        const int row0 = u.pm * BM + wr * 64 + fr;
        float gs[2][4];
#pragma unroll
        for (int ai = 0; ai < 2; ++ai)
#pragma unroll
            for (int m = 0; m < 4; ++m) gs[ai][m] = ROWG[row0 + ai * HALF + m * 16];
        FX_LAS unsigned char* buf = es + (wr * 4 + wc) * 2304;
        const int lane = fq * 16 + fr, rrow = lane >> 2, rch = lane & 3;
#pragma unroll
        for (int ai = 0; ai < 2; ++ai)
#pragma unroll
            for (int m = 0; m < 4; ++m) { const float g = gs[ai][m] * W8_INV;
#pragma unroll
                for (int bj = 0; bj < 2; ++bj) { const f32x4 v0 = acc[ai][bj][m][0] * g, v1 = acc[ai][bj][m][1] * g;
                    u32x2 w; w.x = cvt_pk4_fp8(v0[0], v0[1], v0[2], v0[3]); w.y = cvt_pk4_fp8(v1[0], v1[1], v1[2], v1[3]);
                    *(FX_LAS u32x2*)(buf + fr * 80 + bj * 32 + fq * 8) = w; }
                const u32x4 v = *(const FX_LAS u32x4*)(buf + rrow * 80 + rch * 16);
                const int row = u.pm * BM + wr * 64 + ai * HALF + m * 16 + rrow;
                *(u32x4*)(YR + (size_t)row * 2048 + u.pn * BM + (rch >> 1) * HALF + wc * 32 + (rch & 1) * 16) = v; }
    }
    __device__ __forceinline__ void e32(const f32x16 (&acc3)[2][2][2], const Unit& u, int wr, int wc, int lane) const {
        const int j = lane & 31, hi = lane >> 5;
#pragma unroll
        for (int ai = 0; ai < 2; ++ai)
#pragma unroll
            for (int mb = 0; mb < 2; ++mb) { const int row = u.pm * BM + ai * HALF + wr * 64 + mb * 32 + j; const float gsc = ROWG[row] * W8_INV;
#pragma unroll
                for (int bj = 0; bj < 2; ++bj) { unsigned char* rowp = YR + (size_t)row * 2048 + u.pn * BM + bj * HALF + wc * 32 + 4 * hi;
#pragma unroll
                    for (int g = 0; g < 4; ++g) *(unsigned*)(rowp + 8 * g) = cvt_pk4_fp8(acc3[ai][bj][mb][4 * g] * gsc, acc3[ai][bj][mb][4 * g + 1] * gsc, acc3[ai][bj][mb][4 * g + 2] * gsc, acc3[ai][bj][mb][4 * g + 3] * gsc); } }
    }
};
__device__ __forceinline__ void p9_phase(FX_LAS unsigned char* lds, const unsigned char* HA, const unsigned char* WGU, const int* CNT, const int* ROWTOK, unsigned char* HID, int wg, int nwg, int tidp, const int noepi = 0) {
    FX_LAS unsigned char* tab = lds + STAGE_BYTES;
    const int ntiles = moe_sched_build(tab, CNT, tidp);
    MoeSched Sc; Sc.tile_e = tab; Sc.ntiles = ntiles; Sc.npn = 4; Sc.nunits = ntiles * 4; Sc.G = nwg; Sc.c = wg; Sc.rowtok = ROWTOK; Sc.lda_b = 2048; Sc.Bt = (const char*)WGU; Sc.estride_b = (size_t)1024 * 2048; Sc.pnstride_b = (size_t)256 * 2048;
    EpiGateUp E; E.HID = HID; E.es = lds + EPI_LDS_OFF;
    gemm_phase<EpiGateUp, MoeSched, true>(lds, (const char*)HA, 2048, Sc, E, tidp, noepi);
}
__device__ __forceinline__ void p10_phase(FX_LAS unsigned char* lds, const unsigned char* HID, const unsigned char* WDN, const int* CNT, const float* ROWG, unsigned char* YR, int wg, int nwg, int tidp, const int noepi = 0) {
    FX_LAS unsigned char* tab = lds + STAGE_BYTES;
    const int ntiles = moe_sched_build(tab, CNT, tidp);
    MoeSched Sc; Sc.tile_e = tab; Sc.ntiles = ntiles; Sc.npn = 8; Sc.nunits = ntiles * 8; Sc.G = nwg; Sc.c = wg; Sc.rowtok = nullptr; Sc.lda_b = 512; Sc.Bt = (const char*)WDN; Sc.estride_b = (size_t)2048 * 512; Sc.pnstride_b = (size_t)256 * 512;
    EpiDown E; E.YR = YR; E.ROWG = ROWG; E.nostore = 0; E.es = lds + EPI_LDS_OFF;
    gemm_phase<EpiDown, MoeSched, true>(lds, (const char*)HID, 512, Sc, E, tidp, noepi == 1);
}
template <bool OUTF32>
__device__ __forceinline__ void p11_phase(const bf16_t* x1, const unsigned char* YR, const int* SLOT, const float* coef_l, const float* coef_next  , void* xout_, bf16_t* HA, int wg, int nwg, int tidp) {
    int tid_ = tidp; asm volatile("" : "+v"(tid_));
    const int wid = __builtin_amdgcn_readfirstlane(tid_ >> 6), lane = tid_ & 63;
    for (int t = wg * 8 + wid; t < T; t += nwg * 8) {
        const int b = t / S; const float* cf = coef_l + (size_t)b * 6 * 2048;
        int rows[7]; rows[0] = t;
        { int sl[6];
#pragma unroll
          for (int k = 0; k < 6; ++k) sl[k] = *FX_GC(int, SLOT + (size_t)t * 6 + k);
#pragma unroll
          for (int k = 0; k < 6; ++k) rows[k + 1] = __builtin_amdgcn_readfirstlane(sl[k]); }
        u32x2 ra[4][4];
#pragma unroll
        for (int k = 0; k < 4; ++k)
#pragma unroll
            for (int i = 0; i < 4; ++i) ra[k][i] = *FX_GC(u32x2, YR + (size_t)rows[k] * 2048 + i * 512 + lane * 8);
        u32x4 xw[4];
#pragma unroll
        for (int i = 0; i < 4; ++i) xw[i] = *FX_GC(u32x4, x1 + (size_t)t * 2048 + i * 512 + lane * 8);
        float yv[32];
#pragma unroll
        for (int j = 0; j < 32; ++j) yv[j] = 0.f;
#define FX_ACC8(W, I) do { const f32x2 a0 = __builtin_amdgcn_cvt_pk_f32_fp8((int)(W).x, false), a1 = __builtin_amdgcn_cvt_pk_f32_fp8((int)(W).x, true), a2 = __builtin_amdgcn_cvt_pk_f32_fp8((int)(W).y, false), a3 = __builtin_amdgcn_cvt_pk_f32_fp8((int)(W).y, true); \
            yv[(I) * 8 + 0] += a0[0]; yv[(I) * 8 + 1] += a0[1]; yv[(I) * 8 + 2] += a1[0]; yv[(I) * 8 + 3] += a1[1]; yv[(I) * 8 + 4] += a2[0]; yv[(I) * 8 + 5] += a2[1]; yv[(I) * 8 + 6] += a3[0]; yv[(I) * 8 + 7] += a3[1]; } while (0)
#pragma unroll
        for (int k = 0; k < 4; ++k)
#pragma unroll
            for (int i = 0; i < 4; ++i) FX_ACC8(ra[k][i], i);
        u32x2 rb[3][4];
#pragma unroll
        for (int k = 0; k < 3; ++k)
#pragma unroll
            for (int i = 0; i < 4; ++i) rb[k][i] = *FX_GC(u32x2, YR + (size_t)rows[4 + k] * 2048 + i * 512 + lane * 8);
        f32x4 cd[8];
#pragma unroll
        for (int i = 0; i < 4; ++i) { cd[2 * i] = *FX_GC(f32x4, cf + 3 * 2048 + i * 512 + lane * 8); cd[2 * i + 1] = *FX_GC(f32x4, cf + 3 * 2048 + i * 512 + lane * 8 + 4); }
#pragma unroll
        for (int k = 0; k < 3; ++k)
#pragma unroll
            for (int i = 0; i < 4; ++i) FX_ACC8(rb[k][i], i);
#undef FX_ACC8
        float ss = 0.f;
#pragma unroll
        for (int j = 0; j < 32; ++j) ss += yv[j] * yv[j];
        ss = wave_sum(ss); const float ry = rsqrtf(ss * (1.f / 2048.f) + EPS); float ssx = 0.f;
#pragma unroll
        for (int i = 0; i < 4; ++i) { const u32x4 w = xw[i];
            const float xs[8] = {bflo(w.x), bfhi(w.x), bflo(w.y), bfhi(w.y), bflo(w.z), bfhi(w.z), bflo(w.w), bfhi(w.w)};
#pragma unroll
            for (int j = 0; j < 8; ++j) { yv[i * 8 + j] = xs[j] + cd[2 * i + (j >> 2)][j & 3] * (yv[i * 8 + j] * ry); ssx += yv[i * 8 + j] * yv[i * 8 + j]; } }
        f32x4 ce[8], cg[8];
        if (coef_next) { const float* cn = coef_next + (size_t)b * 6 * 2048;
#pragma unroll
            for (int i = 0; i < 4; ++i) { ce[2 * i] = *FX_GC(f32x4, cn + 4 * 2048 + i * 512 + lane * 8); ce[2 * i + 1] = *FX_GC(f32x4, cn + 4 * 2048 + i * 512 + lane * 8 + 4);
                cg[2 * i] = *FX_GC(f32x4, cn + 5 * 2048 + i * 512 + lane * 8); cg[2 * i + 1] = *FX_GC(f32x4, cn + 5 * 2048 + i * 512 + lane * 8 + 4); } }
#pragma unroll
        for (int i = 0; i < 4; ++i) { const int c = i * 512 + lane * 8;
            if constexpr (OUTF32) { float* xout = (float*)xout_; *FX_GM(f32x4, xout + (size_t)t * 2048 + c) = (f32x4){yv[i * 8 + 0], yv[i * 8 + 1], yv[i * 8 + 2], yv[i * 8 + 3]};
                *FX_GM(f32x4, xout + (size_t)t * 2048 + c + 4) = (f32x4){yv[i * 8 + 4], yv[i * 8 + 5], yv[i * 8 + 6], yv[i * 8 + 7]}; }
            else { u32x4 xo; xo.x = cvt_pk_bf16(yv[i * 8 + 0], yv[i * 8 + 1]); xo.y = cvt_pk_bf16(yv[i * 8 + 2], yv[i * 8 + 3]); xo.z = cvt_pk_bf16(yv[i * 8 + 4], yv[i * 8 + 5]); xo.w = cvt_pk_bf16(yv[i * 8 + 6], yv[i * 8 + 7]);
                *FX_GM(u32x4, (bf16_t*)xout_ + (size_t)t * 2048 + c) = xo; } }
        if (coef_next) { ssx = wave_sum(ssx); const float rx = rsqrtf(ssx * (1.f / 2048.f) + EPS);
#pragma unroll
            for (int i = 0; i < 4; ++i) { const int c = i * 512 + lane * 8;
                float hv[8];
#pragma unroll
                for (int j = 0; j < 8; ++j) hv[j] = yv[i * 8 + j] * rx * ce[2 * i + (j >> 2)][j & 3] + cg[2 * i + (j >> 2)][j & 3];
#ifdef FX_WIN8
                u32x2 w; w.x = cvt_pk4_fp8(hv[0], hv[1], hv[2], hv[3]); w.y = cvt_pk4_fp8(hv[4], hv[5], hv[6], hv[7]);
                *FX_GM(u32x2, (unsigned char*)HA + (size_t)t * 2048 + c) = w; } }
#else
                u32x4 w; w.x = cvt_pk_bf16(hv[0], hv[1]); w.y = cvt_pk_bf16(hv[2], hv[3]); w.z = cvt_pk_bf16(hv[4], hv[5]); w.w = cvt_pk_bf16(hv[6], hv[7]);
                *FX_GM(u32x4, HA + (size_t)t * 2048 + c) = w; } }
#endif
    }
}
}
namespace fx {
#ifndef FX_SD_A
#define FX_SD_A 2
#endif
#ifndef FX_SD_B
#define FX_SD_B 1
#endif
#ifndef FX_NQR_B
#define FX_NQR_B 8
#endif
#define FX_SBAR() __builtin_amdgcn_sched_barrier(0)
__device__ __forceinline__ int crow(int r, int hi) { return (r & 3) + 8 * (r >> 2) + 4 * hi; }
__device__ __forceinline__ int v_st(int k, int c) { const int kk = (k & ~0xC) | ((k & 4) << 1) | ((k & 8) >> 1); return ((kk >> 3) * 4 + (c >> 5)) * 512 + ((kk & 7) * 32 + (c & 31)) * 2; }
__device__ __forceinline__ int v_rd_base(int lane) { return ((lane & 3) << 3) | (((lane >> 2) & 3) << 6) | (((lane >> 4) & 1) << 5) | (((lane >> 5) & 1) << 8); }
constexpr int v_rd_off(int d0, int ks, int half) { return d0 * 512 + ks * 4096 + half * 2048; }
template <int OFF> __device__ __forceinline__ s16x4 tr_read(int vb) { s16x4 r; asm volatile("ds_read_b64_tr_b16 %0, %1 offset:%2" : "=&v"(r) : "v"(vb), "i"(OFF) : "memory"); return r; }
#define FX_PK(L, H) (bf16x8){L[0], L[1], L[2], L[3], H[0], H[1], H[2], H[3]}
template <int D0> __device__ __forceinline__ void pv_one(f32x16& od, int vb, bf16x8 pa0, bf16x8 pa1, bf16x8 pa2, bf16x8 pa3) {
    const s16x4 l0 = tr_read<v_rd_off(D0, 0, 0)>(vb), h0 = tr_read<v_rd_off(D0, 0, 1)>(vb), l1 = tr_read<v_rd_off(D0, 1, 0)>(vb), h1 = tr_read<v_rd_off(D0, 1, 1)>(vb);
    const s16x4 l2 = tr_read<v_rd_off(D0, 2, 0)>(vb), h2 = tr_read<v_rd_off(D0, 2, 1)>(vb), l3 = tr_read<v_rd_off(D0, 3, 0)>(vb), h3 = tr_read<v_rd_off(D0, 3, 1)>(vb);
    asm volatile("s_waitcnt lgkmcnt(0)" ::: "memory"); FX_SBAR();
    od = __builtin_amdgcn_mfma_f32_32x32x16_bf16(pa0, FX_PK(l0, h0), od, 0, 0, 0);
    od = __builtin_amdgcn_mfma_f32_32x32x16_bf16(pa1, FX_PK(l1, h1), od, 0, 0, 0);
    od = __builtin_amdgcn_mfma_f32_32x32x16_bf16(pa2, FX_PK(l2, h2), od, 0, 0, 0);
    od = __builtin_amdgcn_mfma_f32_32x32x16_bf16(pa3, FX_PK(l3, h3), od, 0, 0, 0);
}
__device__ __forceinline__ void pv_d0(f32x16* o, int vb, bf16x8 pa0, bf16x8 pa1, bf16x8 pa2, bf16x8 pa3) {
    pv_one<0>(o[0], vb, pa0, pa1, pa2, pa3); pv_one<1>(o[1], vb, pa0, pa1, pa2, pa3); pv_one<2>(o[2], vb, pa0, pa1, pa2, pa3); pv_one<3>(o[3], vb, pa0, pa1, pa2, pa3);
}
#define FX_PK4(P, BASE, OUT) do { unsigned a0 = cvt_pk_bf16(P[BASE + 0], P[BASE + 1]), a1 = cvt_pk_bf16(P[BASE + 2], P[BASE + 3]);   \
    unsigned b0 = cvt_pk_bf16(P[BASE + 4], P[BASE + 5]), b1 = cvt_pk_bf16(P[BASE + 6], P[BASE + 7]);                              \
    auto r0 = __builtin_amdgcn_permlane32_swap(a0, b0, false, false); auto r1 = __builtin_amdgcn_permlane32_swap(a1, b1, false, false); \
    u32x4 w = {r0[0], r1[0], r0[1], r1[1]}; OUT = *reinterpret_cast<bf16x8*>(&w); } while (0)

template <int DQK> struct AttnC {
    static constexpr int NQ = DQK / 16, KROW = DQK * 2, SHM_V = 64 * 128 * 2, SHM_K = 64 * DQK * 2, NQR = (DQK == 128 ? 8 : FX_NQR_B)  , QX = (NQ - NQR) * 8 * 64 * 16, SHM = 2 * SHM_V + 2 * SHM_K + 8 * 64 * 4 + QX;
    static constexpr float SCALE = DQK == 128 ? 0.088388347648318440f : 0.072168783648703220f;
    static constexpr float THR = 8.f;
};
#define FX_KSWZ(row, colB) ((row) * C::KROW + ((colB) ^ (((row) & 7) << 4)))

template <int DQK> __device__ __forceinline__ void partialSM(f32x16& p0, f32x16& p1, float& m_reg, float& mn, float& alpha) {
    using C = AttnC<DQK>;
    constexpr float Cc = C::SCALE * 1.4426950408889634f;
    float pmax = p0[0];
#pragma unroll
    for (int r = 1; r < 16; ++r) pmax = fmaxf(pmax, p0[r]);
#pragma unroll
    for (int r = 0; r < 16; ++r) pmax = fmaxf(pmax, p1[r]);
    { auto rr = __builtin_amdgcn_permlane32_swap(__float_as_uint(pmax), __float_as_uint(pmax), false, false); pmax = fmaxf(__uint_as_float(rr[0]), __uint_as_float(rr[1])); }
    if (__builtin_expect(__all(pmax - m_reg <= C::THR / C::SCALE), 1)) { mn = m_reg; alpha = 1.f; }
    else { mn = fmaxf(m_reg, pmax); alpha = __builtin_amdgcn_exp2f((m_reg - mn) * Cc); m_reg = mn; }
    const float mnC = -mn * Cc;
#pragma unroll
    for (int r = 0; r < 16; ++r) p0[r] = fmaf(p0[r], Cc, mnC);
#pragma unroll
    for (int r = 0; r < 16; ++r) p1[r] = fmaf(p1[r], Cc, mnC);
#pragma unroll
    for (int r = 0; r < 16; ++r) p0[r] = __builtin_amdgcn_exp2f(p0[r]);
}
__device__ __forceinline__ void finishSM(f32x16& p0, f32x16& p1, float alpha, float& l_reg, bf16x8& pa0, bf16x8& pa1, bf16x8& pa2, bf16x8& pa3) {
#pragma unroll
    for (int r = 0; r < 16; ++r) p1[r] = __builtin_amdgcn_exp2f(p1[r]);
    float ps = 0;
#pragma unroll
    for (int r = 0; r < 16; ++r) ps += p0[r];
#pragma unroll
    for (int r = 0; r < 16; ++r) ps += p1[r];
    { auto rr = __builtin_amdgcn_permlane32_swap(__float_as_uint(ps), __float_as_uint(ps), false, false); ps = __uint_as_float(rr[0]) + __uint_as_float(rr[1]); }
    l_reg = l_reg * alpha + ps;
    FX_PK4(p0, 0, pa0); FX_PK4(p0, 8, pa1); FX_PK4(p1, 0, pa2); FX_PK4(p1, 8, pa3);
}
template <int DQK> __device__ __forceinline__ void qkt(f32x16& p0, f32x16& p1, const char* Ks, const bf16x8* qr, const char* qx  , int r32, int hi) {
    using C = AttnC<DQK>;
    p0 = f32x16{}; p1 = f32x16{};
#pragma unroll
    for (int d0 = 0; d0 < C::NQ; ++d0) { const int cb = (d0 * 16 + hi * 8) * 2;
        const bf16x8 qf = d0 < C::NQR ? qr[d0 < C::NQR ? d0 : 0] : *reinterpret_cast<const bf16x8*>(qx + (d0 - C::NQR) * 1024);
        const bf16x8 b0 = *reinterpret_cast<const bf16x8*>(Ks + FX_KSWZ(r32, cb));
        const bf16x8 b1 = *reinterpret_cast<const bf16x8*>(Ks + FX_KSWZ(32 + r32, cb));
        p0 = __builtin_amdgcn_mfma_f32_32x32x16_bf16(b0, qf, p0, 0, 0, 0);
        p1 = __builtin_amdgcn_mfma_f32_32x32x16_bf16(b1, qf, p1, 0, 0, 0); }
}

template <int DQK, int SD, int LDQ, int LDK1, int LDK2, int LDV>
__device__ __forceinline__ void attn_unit(const bf16_t* __restrict__ Qb, const bf16_t* __restrict__ K1, const bf16_t* __restrict__ K2, const bf16_t* __restrict__ Vh,
                                          bf16_t* __restrict__ Ob, const float* __restrict__ gain, int seq, char* lds, int tidp) {
    using C = AttnC<DQK>;
    int tid_ = tidp; asm volatile("" : "+v"(tid_));
    const int tid = tid_, wid = __builtin_amdgcn_readfirstlane(tid >> 6)  , lane = tid & 63, r32 = lane & 31, hi = lane >> 5;
    char* V_lds = lds; char* K_lds = lds + 2 * C::SHM_V;
    float* ws = (float*)(lds + 2 * C::SHM_V + 2 * C::SHM_K) + wid * 64; float* li_l = ws; float* al_l = ws + 32;
    float m_reg = -1e30f, l_reg = 0; f32x16 o[4] = {}; bf16x8 qr[C::NQR];
    char* qx = lds + 2 * C::SHM_V + 2 * C::SHM_K + 8 * 64 * 4 + wid * ((C::NQ - C::NQR) * 1024) + lane * 16;
    const bf16_t* Qw = Qb + (long)(wid * 32 + r32) * LDQ + hi * 8;
#pragma unroll
    for (int d0 = 0; d0 < C::NQR; ++d0) qr[d0] = *reinterpret_cast<const bf16x8*>(Qw + d0 * 16);
#pragma unroll
    for (int d0 = C::NQR; d0 < C::NQ; ++d0) *reinterpret_cast<bf16x8*>(qx + (d0 - C::NQR) * 1024) = *reinterpret_cast<const bf16x8*>(Qw + d0 * 16);
    const int sr = tid >> 4, sc = (tid & 15) * 8, vst0 = v_st(sr, sc), vst1 = v_st(32 + sr, sc);
    const int vb0 = (int)(uintptr_t)V_lds + v_rd_base(lane);
    const int xr = tid >> 3, xc = (tid & 7) * 8;
    struct { bf16x8 vs0, vs1, ks0, ks1, kx; } sr_[SD];
#define FX_SLOAD(i, k0) do { sr_[i].vs0 = *reinterpret_cast<const bf16x8*>(&Vh[(long)((k0) + sr) * LDV + sc]); sr_[i].vs1 = *reinterpret_cast<const bf16x8*>(&Vh[(long)((k0) + 32 + sr) * LDV + sc]); \
    sr_[i].ks0 = *reinterpret_cast<const bf16x8*>(&K1[(long)((k0) + sr) * LDK1 + sc]); sr_[i].ks1 = *reinterpret_cast<const bf16x8*>(&K1[(long)((k0) + 32 + sr) * LDK1 + sc]); \
    if (DQK == 192) sr_[i].kx = *reinterpret_cast<const bf16x8*>(&K2[(long)((k0) + xr) * LDK2 + xc]); } while (0)
#define FX_SWRITE(b, i) do { *(bf16x8*)(V_lds + (b) * C::SHM_V + vst0) = sr_[i].vs0; *(bf16x8*)(V_lds + (b) * C::SHM_V + vst1) = sr_[i].vs1; const int kc = sc * 2; \
    *(bf16x8*)(K_lds + (b) * C::SHM_K + FX_KSWZ(sr, kc)) = sr_[i].ks0; *(bf16x8*)(K_lds + (b) * C::SHM_K + FX_KSWZ(32 + sr, kc)) = sr_[i].ks1; \
    if (DQK == 192) *(bf16x8*)(K_lds + (b) * C::SHM_K + FX_KSWZ(xr, 256 + xc * 2)) = sr_[i].kx; } while (0)
#define FX_SWAIT() do { if (SD == 1) asm volatile("s_waitcnt vmcnt(0)" ::: "memory"); else if (DQK == 192) asm volatile("s_waitcnt vmcnt(5)" ::: "memory"); else asm volatile("s_waitcnt vmcnt(4)" ::: "memory"); } while (0)
#define FX_RESC(a) do { if (__any((a) < 1.f)) { if (hi == 0) al_l[r32] = (a); asm volatile("s_waitcnt lgkmcnt(0)" ::: "memory"); \
    _Pragma("unroll") for (int d = 0; d < 4; ++d) _Pragma("unroll") for (int r = 0; r < 16; ++r) o[d][r] *= al_l[crow(r, hi)]; } } while (0)
    f32x16 pA0, pA1, pB0, pB1; float mnA, mnB, alA, alB; bf16x8 pa0, pa1, pa2, pa3; const int NT = seq / 64;
    constexpr int SE = 0, SO = SD - 1;
    FX_SLOAD(SE, 0); asm volatile("s_waitcnt vmcnt(0)" ::: "memory"); FX_SWRITE(0, SE); __syncthreads();
    qkt<DQK>(pA0, pA1, K_lds, qr, qx, r32, hi); partialSM<DQK>(pA0, pA1, m_reg, mnA, alA);
    FX_SLOAD(SO, 64); if (SD == 2) { if (2 < NT) FX_SLOAD(SE, 128); }
    FX_SWAIT(); FX_SWRITE(1, SO); __syncthreads();
    for (int j = 1; j + 1 < NT; j += 2) {
        FX_SBAR(); qkt<DQK>(pB0, pB1, K_lds + C::SHM_K, qr, qx, r32, hi);
        finishSM(pA0, pA1, alA, l_reg, pa0, pa1, pa2, pa3); FX_SBAR();
        FX_SLOAD(SO, (j + SD) * 64); FX_SBAR();
        pv_d0(o, vb0, pa0, pa1, pa2, pa3); partialSM<DQK>(pB0, pB1, m_reg, mnB, alB);
        __syncthreads(); FX_SWAIT(); FX_SWRITE(0, SE);
        FX_RESC(alB); __syncthreads();
        FX_SBAR(); qkt<DQK>(pA0, pA1, K_lds, qr, qx, r32, hi);
        finishSM(pB0, pB1, alB, l_reg, pa0, pa1, pa2, pa3); FX_SBAR();
        if (SD == 1 || j + 3 < NT) FX_SLOAD(SE, (j + 1 + SD) * 64); FX_SBAR();
        pv_d0(o, vb0 + C::SHM_V, pa0, pa1, pa2, pa3); partialSM<DQK>(pA0, pA1, m_reg, mnA, alA);
        __syncthreads(); FX_SWAIT(); FX_SWRITE(1, SO);
        FX_RESC(alA); __syncthreads();
    }
    FX_SBAR(); qkt<DQK>(pB0, pB1, K_lds + C::SHM_K, qr, qx, r32, hi);
    finishSM(pA0, pA1, alA, l_reg, pa0, pa1, pa2, pa3); FX_SBAR();
    pv_d0(o, vb0, pa0, pa1, pa2, pa3); partialSM<DQK>(pB0, pB1, m_reg, mnB, alB);
    __syncthreads(); FX_RESC(alB);
    finishSM(pB0, pB1, alB, l_reg, pa0, pa1, pa2, pa3); FX_SBAR();
    pv_d0(o, vb0 + C::SHM_V, pa0, pa1, pa2, pa3);
    if (hi == 0) li_l[r32] = l_reg; asm volatile("s_waitcnt lgkmcnt(0)" ::: "memory");
    int r32e = r32; asm volatile("" : "+v"(r32e));
    float g4[4];
#pragma unroll
    for (int d0 = 0; d0 < 4; ++d0) g4[d0] = gain[d0 * 32 + r32e];
    bf16_t* Ow = Ob + (long)(wid * 32) * 2048;
#pragma unroll
    for (int r = 0; r < 16; ++r) { const float rl = __builtin_amdgcn_rcpf(li_l[crow(r, hi)]);
        float ss = 0.f;
#pragma unroll
        for (int d0 = 0; d0 < 4; ++d0) { o[d0][r] *= rl; ss += o[d0][r] * o[d0][r]; }
        ss += __shfl_xor(ss, 1); ss += __shfl_xor(ss, 2); ss += __shfl_xor(ss, 4); ss += __shfl_xor(ss, 8); ss += __shfl_xor(ss, 16);
        const float rn = rsqrtf(ss * (1.f / 128.f) + EPS); const int orow = crow(r, hi);
#pragma unroll
#ifdef FX_WOUT8
        for (int d0 = 0; d0 < 4; ++d0) ((unsigned char*)Ob)[(long)(wid * 32 + orow) * 2048 + d0 * 32 + r32e] = (unsigned char)(__builtin_amdgcn_cvt_pk_fp8_f32(o[d0][r] * rn * g4[d0], 0.f, 0, false) & 0xff); }
#else
        for (int d0 = 0; d0 < 4; ++d0) Ow[(long)orow * 2048 + d0 * 32 + r32e] = f2bf(o[d0][r] * rn * g4[d0]); }
#endif
    __syncthreads();
#undef FX_SLOAD
#undef FX_SWRITE
#undef FX_SWAIT
#undef FX_RESC
}

__device__ __forceinline__ void attn_gqa_unit(int u, const bf16_t* QA, const bf16_t* KA, const bf16_t* PROJ, bf16_t* YM, const float* hog, char* lds, int tidp) {
    const int qb = u & 15, hh = (u >> 4) % 6, b = u / 96, kvh = hh / 3;
    const size_t t0 = (size_t)b * S;
    attn_unit<128, FX_SD_A, 768, 256, 0, PW>(QA + (t0 + qb * 256) * 768 + hh * 128, KA + t0 * 256 + kvh * 128, nullptr, PROJ + t0 * PW + O_AV + kvh * 128,
#ifdef FX_WOUT8
                                    (bf16_t*)((unsigned char*)YM + (t0 + qb * 256) * 2048 + hh * 128), hog + hh * 128, S, lds, tidp);
#else
                                    YM + (t0 + qb * 256) * 2048 + hh * 128, hog + hh * 128, S, lds, tidp);
#endif
}
__device__ __forceinline__ void attn_mla_unit(int u, const bf16_t* QB, const bf16_t* KVB, const bf16_t* KR, bf16_t* YM, const float* hog, char* lds, int tidp) {
    const int qb = u & 15, hh = (u >> 4) % 6, b = u / 96;
    const size_t t0 = (size_t)b * S;
    attn_unit<192, FX_SD_B, 1280, 1536, 64, 1536>(QB + (t0 + qb * 256) * 1280 + hh * 192, KVB + t0 * 1536 + hh * 256, KR + t0 * 64, KVB + t0 * 1536 + hh * 256 + 128,
#ifdef FX_WOUT8
                                         (bf16_t*)((unsigned char*)YM + (t0 + qb * 256) * 2048 + 768 + hh * 128), hog + 768 + hh * 128, S, lds, tidp);
#else
                                         YM + (t0 + qb * 256) * 2048 + 768 + hh * 128, hog + 768 + hh * 128, S, lds, tidp);
#endif
}
}
namespace fx {
constexpr int P3_LDS = 4096 + 2048 + 65536 + 32768;
constexpr float KSCALE = 0.08838834764831845f;
__device__ __forceinline__ float logsigmoid_f(float f) { return fminf(f, 0.f) - log1pf(__expf(-fabsf(f))); }
__device__ __forceinline__ float wave_scan_incl(float v, int lane) {
#pragma unroll
    for (int o = 1; o < 64; o <<= 1) { const float t = __shfl_up(v, o); if (lane >= o) v += t; }
    return v;
}
__device__ __forceinline__ float wave_scanmax_incl(float v, int lane) {
#pragma unroll
    for (int o = 1; o < 64; o <<= 1) { const float t = __shfl_up(v, o); if (lane >= o) v = fmaxf(v, t); }
    return v;
}
__device__ __forceinline__ float wave_rscanmax_incl(float v, int lane) {
#pragma unroll
    for (int o = 1; o < 64; o <<= 1) { const float t = __shfl_down(v, o); if (lane + o < 64) v = fmaxf(v, t); }
    return v;
}

struct P3Args {
    const bf16_t* PROJ; const float* GATES; const float* gate_b; const float* conv_w; const float* conv_b;
    const float* aq_gain; const float* ak_gain; const float* cq_gain; const float* ckv_gain;
    const float* cosA; const float* sinA; const float* cosB; const float* sinB;
    bf16_t* QA; bf16_t* KA; bf16_t* CQN; bf16_t* CKVN; bf16_t* KR; bf16_t* QC; bf16_t* KC; bf16_t* KCT; float* NLOC; float* GSC;
};
__device__ __forceinline__ void p3_phase(FX_LAS unsigned char* lds_, const P3Args& a, int wg, int nwg, int tidp) {
    char* lds = (char*)lds_;
    float* gat = (float*)lds; float* wts = (float*)(lds + 4096); char* ktile = lds + 6144; char* wv = lds + 6144 + 65536;
    for (int unit = wg; unit < T / 64; unit += nwg) {
        int tid_ = tidp; asm volatile("" : "+v"(tid_));
        const int tid = tid_, wid = tid >> 6, lane = tid & 63;
        const int b = unit >> 6, co = unit & 63; const size_t t0 = (size_t)unit * 64;
        for (int i = tid; i < 1024; i += 512) gat[i] = a.GATES[t0 * 16 + i] + a.gate_b[i & 15];
        __syncthreads();
        { const int dir = wid >> 2, h = wid & 3;
          const float logi = gat[lane * 16 + (dir * 2) * 4 + h], logf = logsigmoid_f(gat[lane * 16 + (dir * 2 + 1) * 4 + h]);
          const float pre = wave_scan_incl(logf, lane), g = __shfl(pre, 63);
          const float bb = dir ? (g - pre + logf) : pre;
          const float av = g - bb + logi, mloc = wave_max(av);
          wts[wid * 64 + lane] = __expf(av - mloc);
          if (lane == 0) { const int chain = (b * 4 + h) * 2 + dir, ci = dir ? 63 - co : co; a.GSC[(chain * 64 + ci) * 2] = g; a.GSC[(chain * 64 + ci) * 2 + 1] = mloc; } }
        __syncthreads();
        { const int c0 = 2 * tid; const bool isk = c0 >= 512; const int hk = (c0 - 512) >> 7, dk = (c0 - 512) & 127;
          float w0[5], w1[5];
#pragma unroll
          for (int j = 0; j < 5; ++j) { w0[j] = a.conv_w[j * 1024 + c0]; w1[j] = a.conv_w[j * 1024 + c0 + 1]; }
          const float cb0 = a.conv_b[c0], cb1 = a.conv_b[c0 + 1];
          float x0[5], x1[5];
          const bf16_t* src = a.PROJ + t0 * PW + O_CQ + c0;
#pragma unroll
          for (int j = 0; j < 4; ++j) { const int sa = co * 64 + j - 2; unsigned w = 0u; if (sa >= 0 && sa < S) w = *(const unsigned*)(src + (long)(j - 2) * PW); x0[j + 1] = bflo(w); x1[j + 1] = bfhi(w); }
          float nf0 = 0.f, nf1 = 0.f, nb0 = 0.f, nb1 = 0.f;
#pragma unroll 1
          for (int s0 = 0; s0 < 64; s0 += 16) {
              unsigned wl[16];
#pragma unroll
              for (int q = 0; q < 16; ++q) { const int sa = co * 64 + s0 + q + 2; wl[q] = 0u; if (sa < S) wl[q] = *(const unsigned*)(src + (long)(s0 + q + 2) * PW); }
#pragma unroll
              for (int q = 0; q < 16; ++q) { const int s = s0 + q;
#pragma unroll
                  for (int j = 0; j < 4; ++j) { x0[j] = x0[j + 1]; x1[j] = x1[j + 1]; }
                  x0[4] = bflo(wl[q]); x1[4] = bfhi(wl[q]);
                  float y0 = cb0, y1 = cb1;
#pragma unroll
                  for (int j = 0; j < 5; ++j) { y0 += w0[j] * x0[j]; y1 += w1[j] * x1[j]; }
                  y0 = silu_f(y0); y1 = silu_f(y1);
                  if (!isk) { *(unsigned*)(a.QC + (t0 + s) * 512 + c0) = cvt_pk_bf16(y0, y1); }
                  else { y0 *= KSCALE; y1 *= KSCALE; const unsigned pk = cvt_pk_bf16(y0, y1);
                      *(unsigned*)(a.KC + (t0 + s) * 512 + (c0 - 512)) = pk;
                      *(unsigned*)(ktile + hk * 16384 + v_st(s, dk & ~7) + (dk & 7) * 2) = pk;
                      const float k0 = bflo(pk), k1 = bfhi(pk); const float wf = wts[hk * 64 + s], wb = wts[(4 + hk) * 64 + s];
                      nf0 += wf * k0; nf1 += wf * k1; nb0 += wb * k0; nb1 += wb * k1; } }
          }
          if (isk) { const int chf = (b * 4 + hk) * 2, chb = chf + 1;
              *(f32x2*)(a.NLOC + ((size_t)chf * 64 + co) * 128 + dk) = (f32x2){nf0, nf1};
              *(f32x2*)(a.NLOC + ((size_t)chb * 64 + (63 - co)) * 128 + dk) = (f32x2){nb0, nb1}; } }
        __syncthreads();
#pragma unroll 1
        for (int h = 0; h < 4; ++h) {
            { const int sr = tid >> 4, sc = (tid & 15) * 8;
#pragma unroll
              for (int rr = 0; rr < 2; ++rr) { const int s = sr + 32 * rr;
                const u32x4 vw = *(const u32x4*)(a.PROJ + (t0 + s) * PW + O_CV + h * 128 + sc);
                const float wf = wts[h * 64 + s], wb = wts[(4 + h) * 64 + s];
                float v[8] = {bflo(vw.x), bfhi(vw.x), bflo(vw.y), bfhi(vw.y), bflo(vw.z), bfhi(vw.z), bflo(vw.w), bfhi(vw.w)};
                u32x4 of, ob;
                of.x = cvt_pk_bf16(v[0] * wf, v[1] * wf); of.y = cvt_pk_bf16(v[2] * wf, v[3] * wf); of.z = cvt_pk_bf16(v[4] * wf, v[5] * wf); of.w = cvt_pk_bf16(v[6] * wf, v[7] * wf);
                ob.x = cvt_pk_bf16(v[0] * wb, v[1] * wb); ob.y = cvt_pk_bf16(v[2] * wb, v[3] * wb); ob.z = cvt_pk_bf16(v[4] * wb, v[5] * wb); ob.w = cvt_pk_bf16(v[6] * wb, v[7] * wb);
                *(u32x4*)(wv + v_st(s, sc)) = of; *(u32x4*)(wv + 16384 + v_st(s, sc)) = ob; } }
            __syncthreads();
            { const int dir = wid >> 2, mb = wid & 3, r32 = lane & 31, hi = lane >> 5;
              const int va = (int)(uintptr_t)(wv + dir * 16384) + v_rd_base(lane) + mb * 512;
              const int kb = (int)(uintptr_t)(ktile + h * 16384) + v_rd_base(lane);
              f32x16 acc[4] = {};
#define FX_KC_STEP(KS) do { \
              const s16x4 al = tr_read<v_rd_off(0, KS, 0)>(va), ah = tr_read<v_rd_off(0, KS, 1)>(va); \
              const s16x4 b0l = tr_read<v_rd_off(0, KS, 0)>(kb), b0h = tr_read<v_rd_off(0, KS, 1)>(kb), b1l = tr_read<v_rd_off(1, KS, 0)>(kb), b1h = tr_read<v_rd_off(1, KS, 1)>(kb); \
              const s16x4 b2l = tr_read<v_rd_off(2, KS, 0)>(kb), b2h = tr_read<v_rd_off(2, KS, 1)>(kb), b3l = tr_read<v_rd_off(3, KS, 0)>(kb), b3h = tr_read<v_rd_off(3, KS, 1)>(kb); \
              asm volatile("s_waitcnt lgkmcnt(0)" ::: "memory"); FX_SBAR(); \
              const bf16x8 af = FX_PK(al, ah); \
              acc[0] = __builtin_amdgcn_mfma_f32_32x32x16_bf16(af, FX_PK(b0l, b0h), acc[0], 0, 0, 0); acc[1] = __builtin_amdgcn_mfma_f32_32x32x16_bf16(af, FX_PK(b1l, b1h), acc[1], 0, 0, 0); \
              acc[2] = __builtin_amdgcn_mfma_f32_32x32x16_bf16(af, FX_PK(b2l, b2h), acc[2], 0, 0, 0); acc[3] = __builtin_amdgcn_mfma_f32_32x32x16_bf16(af, FX_PK(b3l, b3h), acc[3], 0, 0, 0); } while (0)
              FX_KC_STEP(0); FX_KC_STEP(1); FX_KC_STEP(2); FX_KC_STEP(3);
#undef FX_KC_STEP
              const int chain = (b * 4 + h) * 2 + dir, ci = dir ? 63 - co : co;
              bf16_t* dst = a.KCT + ((size_t)chain * 64 + ci) * 16384 + (size_t)(mb * 32) * 128 + r32;
#pragma unroll
              for (int r = 0; r < 16; ++r) { const int v = crow(r, hi);
#pragma unroll
                  for (int nb = 0; nb < 4; ++nb) dst[v * 128 + nb * 32] = f2bf(acc[nb][r]); } }
            __syncthreads();
        }
        { const int hd = __builtin_amdgcn_readfirstlane(wid), l16 = lane & 15, tq = lane >> 4, e0 = 8 * l16, hf = e0 >> 6, f0 = e0 & 31; const bool second = (e0 & 32) != 0;
          const float* g = hd < 6 ? a.aq_gain : a.ak_gain;
          const f32x4 g0 = *(const f32x4*)(g + e0), g1 = *(const f32x4*)(g + e0 + 4);
#pragma unroll 4
          for (int p = 0; p < 16; ++p) { const int s = 4 * p + tq; const size_t t = t0 + s;
            const u32x4 xw = *(const u32x4*)(a.PROJ + t * PW + hd * 128 + e0);
            const int pos = hf ? s : co;
            const f32x4 c0 = *(const f32x4*)(a.cosA + pos * 32 + f0), c1 = *(const f32x4*)(a.cosA + pos * 32 + f0 + 4), s0 = *(const f32x4*)(a.sinA + pos * 32 + f0), s1 = *(const f32x4*)(a.sinA + pos * 32 + f0 + 4);
            float x[8] = {bflo(xw.x), bfhi(xw.x), bflo(xw.y), bfhi(xw.y), bflo(xw.z), bfhi(xw.z), bflo(xw.w), bfhi(xw.w)};
            float ss = 0.f;
#pragma unroll
            for (int j = 0; j < 8; ++j) ss += x[j] * x[j];
            ss += __shfl_xor(ss, 1); ss += __shfl_xor(ss, 2); ss += __shfl_xor(ss, 4); ss += __shfl_xor(ss, 8);
            const float r = rsqrtf(ss * (1.f / 128.f) + EPS);
            float o[8];
#pragma unroll
            for (int j = 0; j < 8; ++j) { x[j] *= r * (j < 4 ? g0[j & 3] : g1[j & 3]); }
#pragma unroll
            for (int j = 0; j < 8; ++j) { const float y = __shfl_xor(x[j], 4), cs = j < 4 ? c0[j & 3] : c1[j & 3], sn = j < 4 ? s0[j & 3] : s1[j & 3]; o[j] = second ? (x[j] * cs + y * sn) : (x[j] * cs - y * sn); }
            u32x4 w; w.x = cvt_pk_bf16(o[0], o[1]); w.y = cvt_pk_bf16(o[2], o[3]); w.z = cvt_pk_bf16(o[4], o[5]); w.w = cvt_pk_bf16(o[6], o[7]);
            bf16_t* dst = hd < 6 ? a.QA + t * 768 + hd * 128 + e0 : a.KA + t * 256 + (hd - 6) * 128 + e0;
            *(u32x4*)dst = w; } }
#pragma unroll 4
        for (int s = wid; s < 64; s += 8) { const size_t t = t0 + s; const bf16_t* p = a.PROJ + t * PW;
            float q[6]; float ss = 0.f;
#pragma unroll
            for (int i = 0; i < 3; ++i) { const unsigned w = *(const unsigned*)(p + O_BCQ + i * 128 + lane * 2); q[2 * i] = bflo(w); q[2 * i + 1] = bfhi(w); ss += q[2 * i] * q[2 * i] + q[2 * i + 1] * q[2 * i + 1]; }
            ss = wave_sum(ss); float r = rsqrtf(ss * (1.f / 384.f) + EPS);
#pragma unroll
            for (int i = 0; i < 3; ++i) { const int c = i * 128 + lane * 2; *(unsigned*)(a.CQN + t * 384 + c) = cvt_pk_bf16(q[2 * i] * r * a.cq_gain[c], q[2 * i + 1] * r * a.cq_gain[c + 1]); }
            float kv[4]; ss = 0.f;
#pragma unroll
            for (int i = 0; i < 2; ++i) { const unsigned w = *(const unsigned*)(p + O_BCKV + i * 128 + lane * 2); kv[2 * i] = bflo(w); kv[2 * i + 1] = bfhi(w); ss += kv[2 * i] * kv[2 * i] + kv[2 * i + 1] * kv[2 * i + 1]; }
            ss = wave_sum(ss); r = rsqrtf(ss * (1.f / 256.f) + EPS);
#pragma unroll
            for (int i = 0; i < 2; ++i) { const int c = i * 128 + lane * 2; *(unsigned*)(a.CKVN + t * 256 + c) = cvt_pk_bf16(kv[2 * i] * r * a.ckv_gain[c], kv[2 * i + 1] * r * a.ckv_gain[c + 1]); }
            if (lane < 32) { const int f = lane & 15, hf = lane >> 4; const int pos = hf ? s : co; const float cs = a.cosB[pos * 16 + f], sn = a.sinB[pos * 16 + f];
                const float x1 = bf2f(p[O_BKR + hf * 32 + f]), x2 = bf2f(p[O_BKR + hf * 32 + 16 + f]);
                a.KR[t * 64 + hf * 32 + f] = f2bf(x1 * cs - x2 * sn); a.KR[t * 64 + hf * 32 + 16 + f] = f2bf(x2 * cs + x1 * sn); } }
        __syncthreads();
    }
}

#ifndef FX_SCANB
#define FX_SCANB 32
#endif
__device__ __forceinline__ void scan_phase(const bf16_t* KCT, const float* NLOC, const float* GSC, bf16_t* CPREV, float* NPREV, float* MPREV, int gtid, int nthr) {
    for (int item = gtid; item < 32 * 4096; item += nthr) {
        const int chain = item >> 12, e4 = item & 4095;
        const u32x2* src = (const u32x2*)(KCT + (size_t)chain * 64 * 16384) + e4; u32x2* dst = (u32x2*)(CPREV + (size_t)chain * 64 * 16384) + e4;
        const float* gs = GSC + (size_t)chain * 128;
        const bool don = e4 < 128;
        float c0 = 0.f, c1 = 0.f, c2 = 0.f, c3 = 0.f, nn = 0.f, m = 0.f;
#pragma unroll 1
        for (int cb = 0; cb < 64; cb += FX_SCANB) {
            u32x2 kc[FX_SCANB]; float nl[FX_SCANB]; f32x2 gm[FX_SCANB];
#pragma unroll
            for (int j = 0; j < FX_SCANB; ++j) { kc[j] = src[(size_t)(cb + j) * 4096]; nl[j] = don ? NLOC[((size_t)chain * 64 + cb + j) * 128 + e4] : 0.f; gm[j] = *(const f32x2*)(gs + (cb + j) * 2); }
#pragma unroll
            for (int j = 0; j < FX_SCANB; ++j) { const int ci = cb + j; const float g = gm[j][0], ml = gm[j][1];
                u32x2 o; o.x = cvt_pk_bf16(c0, c1); o.y = cvt_pk_bf16(c2, c3); dst[(size_t)ci * 4096] = o;
                if (don) NPREV[((size_t)chain * 64 + ci) * 128 + e4] = nn;
                if (e4 == 0) MPREV[chain * 64 + ci] = m;
                const float mn = fmaxf(g + m, ml), dec = __expf(g + m - mn), sl = __expf(ml - mn); m = mn;
                c0 = dec * c0 + sl * bflo(kc[j].x); c1 = dec * c1 + sl * bfhi(kc[j].x); c2 = dec * c2 + sl * bflo(kc[j].y); c3 = dec * c3 + sl * bfhi(kc[j].y);
                nn = dec * nn + sl * nl[j]; }
        }
    }
}

constexpr int MC_K = 0, MC_V = 16384, MC_CT = 32768, MC_HS = 98304, MC_HS_LD = 132, MC_SM = MC_HS + 64 * MC_HS_LD * 4, MC_LDS = MC_SM + 4096;
struct McArgs { const bf16_t* PROJ; const float* GATES; const float* gate_b; const bf16_t* QC; const bf16_t* KC; const bf16_t* CPREV; const float* NPREV; const float* MPREV; const float* hog; bf16_t* YM; };
__device__ __forceinline__ void mlstm_c_phase(FX_LAS unsigned char* lds_, const McArgs& a, int wg, int nwg, int tidp) {
    char* lds = (char*)lds_;
    using C = AttnC<128>;
    float* hs = (float*)(lds + MC_HS);
    float* sm = (float*)(lds + MC_SM);
    for (int unit = wg; unit < NB * 4 * 64; unit += nwg) {
        int tid_ = tidp; asm volatile("" : "+v"(tid_));
        const int tid = tid_, wid = tid >> 6, lane = tid & 63, r32 = lane & 31, hi = lane >> 5;
        const int co = unit & 63, h = (unit >> 6) & 3, b = unit >> 8; const size_t t0 = (size_t)b * S + co * 64;
        if (wid < 2) { const int dir = wid; const int chain = (b * 4 + h) * 2 + dir, ci = dir ? 63 - co : co;
            const float logi = a.GATES[(t0 + lane) * 16 + (dir * 2) * 4 + h] + a.gate_b[(dir * 2) * 4 + h];
            const float logf = logsigmoid_f(a.GATES[(t0 + lane) * 16 + (dir * 2 + 1) * 4 + h] + a.gate_b[(dir * 2 + 1) * 4 + h]);
            const float pre = wave_scan_incl(logf, lane), g = __shfl(pre, 63);
            const float bb = dir ? (g - pre + logf) : pre;
            const float u = logi - bb;
            const float M = dir ? wave_rscanmax_incl(u, lane) : wave_scanmax_incl(u, lane);
            const float mp = a.MPREV[chain * 64 + ci], mmj = fmaxf(mp, M);
            sm[dir * 64 + lane] = u; sm[128 + dir * 64 + lane] = mmj; sm[256 + dir * 64 + lane] = __expf(mp - mmj); sm[384 + dir * 64 + lane] = __expf(-(bb + mmj));
            sm[512 + dir * 128 + lane] = a.NPREV[((size_t)chain * 64 + ci) * 128 + lane]; sm[512 + dir * 128 + 64 + lane] = a.NPREV[((size_t)chain * 64 + ci) * 128 + 64 + lane]; }
        { const int sr = tid >> 4, sc = (tid & 15) * 8;
#pragma unroll
          for (int rr = 0; rr < 2; ++rr) { const int s = sr + 32 * rr;
            *(bf16x8*)(lds + MC_K + FX_KSWZ(s, sc * 2)) = *(const bf16x8*)(a.KC + (t0 + s) * 512 + h * 128 + sc);
            *(bf16x8*)(lds + MC_V + v_st(s, sc)) = *(const bf16x8*)(a.PROJ + (t0 + s) * PW + O_CV + h * 128 + sc); }
#pragma unroll
          for (int dir = 0; dir < 2; ++dir) { const int chain = (b * 4 + h) * 2 + dir, ci = dir ? 63 - co : co; const bf16_t* ct = a.CPREV + ((size_t)chain * 64 + ci) * 16384;
#pragma unroll
            for (int rr = 0; rr < 4; ++rr) { const int v = sr + 32 * rr; *(bf16x8*)(lds + MC_CT + dir * 32768 + FX_KSWZ(v, sc * 2)) = *(const bf16x8*)(ct + v * 128 + sc); } } }
        __syncthreads();
        { const int dir = wid >> 2, rb = (wid >> 1) & 1, cb = wid & 1, j = rb * 32 + r32;
          bf16x8 qr[8];
          const bf16_t* Qw = a.QC + (t0 + j) * 512 + h * 128 + hi * 8;
#pragma unroll
          for (int d0 = 0; d0 < 8; ++d0) qr[d0] = *reinterpret_cast<const bf16x8*>(Qw + d0 * 16);
          f32x16 p0, p1;
          qkt<128>(p0, p1, lds + MC_K, qr, nullptr, r32, hi);
          const float mmj = sm[128 + dir * 64 + j], inter = sm[256 + dir * 64 + j], emn = sm[384 + dir * 64 + j];
          float dsum = 0.f;
#pragma unroll
          for (int r = 0; r < 16; ++r) { const int s0 = crow(r, hi), s1 = 32 + s0;
              const bool v0 = dir ? (s0 >= j) : (s0 <= j), v1 = dir ? (s1 >= j) : (s1 <= j);
              const float w0 = v0 ? __expf(sm[dir * 64 + s0] - mmj) : 0.f, w1 = v1 ? __expf(sm[dir * 64 + s1] - mmj) : 0.f;
              p0[r] *= w0; p1[r] *= w1; dsum += p0[r] + p1[r]; }
          float qn = 0.f;
#pragma unroll
          for (int d0 = 0; d0 < 8; ++d0) { const float* np = sm + 512 + dir * 128 + d0 * 16 + hi * 8; const u32x4 w = *reinterpret_cast<const u32x4*>(&qr[d0]);
              qn += bflo(w.x) * np[0] + bfhi(w.x) * np[1] + bflo(w.y) * np[2] + bfhi(w.y) * np[3] + bflo(w.z) * np[4] + bfhi(w.z) * np[5] + bflo(w.w) * np[6] + bfhi(w.w) * np[7]; }
          { auto rr = __builtin_amdgcn_permlane32_swap(__float_as_uint(dsum), __float_as_uint(dsum), false, false); dsum = __uint_as_float(rr[0]) + __uint_as_float(rr[1]); }
          { auto rr = __builtin_amdgcn_permlane32_swap(__float_as_uint(qn), __float_as_uint(qn), false, false); qn = __uint_as_float(rr[0]) + __uint_as_float(rr[1]); }
          const float den = dsum + inter * qn;
          if (hi == 0) sm[768 + wid * 32 + r32] = 1.f / fmaxf(fabsf(den), emn);
          bf16x8 pa0, pa1, pa2, pa3;
          FX_PK4(p0, 0, pa0); FX_PK4(p0, 8, pa1); FX_PK4(p1, 0, pa2); FX_PK4(p1, 8, pa3);
          f32x16 o[2] = {};
          const int vb = (int)(uintptr_t)(lds + MC_V) + v_rd_base(lane) + cb * 1024;
          pv_one<0>(o[0], vb, pa0, pa1, pa2, pa3); pv_one<1>(o[1], vb, pa0, pa1, pa2, pa3);
          const char* ctb = lds + MC_CT + dir * 32768;
#pragma unroll
          for (int ks = 0; ks < 8; ++ks) { const u32x4 w = *reinterpret_cast<const u32x4*>(&qr[ks]); u32x4 sq;
              sq.x = cvt_pk_bf16(bflo(w.x) * inter, bfhi(w.x) * inter); sq.y = cvt_pk_bf16(bflo(w.y) * inter, bfhi(w.y) * inter); sq.z = cvt_pk_bf16(bflo(w.z) * inter, bfhi(w.z) * inter); sq.w = cvt_pk_bf16(bflo(w.w) * inter, bfhi(w.w) * inter);
              const bf16x8 qs = *reinterpret_cast<const bf16x8*>(&sq); const int colB = (ks * 16 + hi * 8) * 2;
              const bf16x8 c0f = *reinterpret_cast<const bf16x8*>(ctb + FX_KSWZ((2 * cb) * 32 + r32, colB));
              const bf16x8 c1f = *reinterpret_cast<const bf16x8*>(ctb + FX_KSWZ((2 * cb + 1) * 32 + r32, colB));
              o[0] = __builtin_amdgcn_mfma_f32_32x32x16_bf16(qs, c0f, o[0], 0, 0, 0);
              o[1] = __builtin_amdgcn_mfma_f32_32x32x16_bf16(qs, c1f, o[1], 0, 0, 0); }
          asm volatile("s_waitcnt lgkmcnt(0)" ::: "memory");
          float rd[16];
#pragma unroll
          for (int r = 0; r < 16; ++r) rd[r] = sm[768 + wid * 32 + crow(r, hi)];
          if (dir == 0) {
#pragma unroll
              for (int r = 0; r < 16; ++r) { const int row = rb * 32 + crow(r, hi);
                  hs[row * MC_HS_LD + (2 * cb) * 32 + r32] = o[0][r] * rd[r]; hs[row * MC_HS_LD + (2 * cb + 1) * 32 + r32] = o[1][r] * rd[r]; } }
          __syncthreads();
          if (dir == 1) {
#pragma unroll
              for (int r = 0; r < 16; ++r) { const int row = rb * 32 + crow(r, hi);
                  hs[row * MC_HS_LD + (2 * cb) * 32 + r32] += o[0][r] * rd[r]; hs[row * MC_HS_LD + (2 * cb + 1) * 32 + r32] += o[1][r] * rd[r]; } }
          __syncthreads(); }
        { const int row = tid >> 3, c0 = (tid & 7) * 16; const size_t t = t0 + row;
          float v[16]; float ss = 0.f;
#pragma unroll
          for (int i = 0; i < 16; ++i) { v[i] = hs[row * MC_HS_LD + c0 + i]; ss += v[i] * v[i]; }
          ss += __shfl_xor(ss, 1); ss += __shfl_xor(ss, 2); ss += __shfl_xor(ss, 4);
          const float rn = rsqrtf(ss * (1.f / 128.f) + EPS);
          const bf16_t* og = a.PROJ + t * PW + O_CO + h * 128 + c0; const float* gn = a.hog + 1536 + h * 128 + c0;
          const u32x4 g0 = *(const u32x4*)og, g1 = *(const u32x4*)(og + 8);
          const float gg[16] = {bflo(g0.x), bfhi(g0.x), bflo(g0.y), bfhi(g0.y), bflo(g0.z), bfhi(g0.z), bflo(g0.w), bfhi(g0.w), bflo(g1.x), bfhi(g1.x), bflo(g1.y), bfhi(g1.y), bflo(g1.z), bfhi(g1.z), bflo(g1.w), bfhi(g1.w)};
          float ov[16];
#pragma unroll
          for (int i = 0; i < 16; ++i) ov[i] = v[i] * rn * gn[i] * sigmoid_f(gg[i]);
          u32x4 w0, w1; w0.x = cvt_pk_bf16(ov[0], ov[1]); w0.y = cvt_pk_bf16(ov[2], ov[3]); w0.z = cvt_pk_bf16(ov[4], ov[5]); w0.w = cvt_pk_bf16(ov[6], ov[7]);
          w1.x = cvt_pk_bf16(ov[8], ov[9]); w1.y = cvt_pk_bf16(ov[10], ov[11]); w1.z = cvt_pk_bf16(ov[12], ov[13]); w1.w = cvt_pk_bf16(ov[14], ov[15]);
#ifdef FX_WOUT8
          { u32x4 w8; w8.x = cvt_pk4_fp8(ov[0], ov[1], ov[2], ov[3]); w8.y = cvt_pk4_fp8(ov[4], ov[5], ov[6], ov[7]); w8.z = cvt_pk4_fp8(ov[8], ov[9], ov[10], ov[11]); w8.w = cvt_pk4_fp8(ov[12], ov[13], ov[14], ov[15]);
            *(u32x4*)((unsigned char*)a.YM + t * 2048 + 1536 + h * 128 + c0) = w8; (void)w0; (void)w1; } }
#else
          bf16_t* dst = a.YM + t * 2048 + 1536 + h * 128 + c0; *(u32x4*)dst = w0; *(u32x4*)(dst + 8) = w1; }
#endif
        __syncthreads();
    }
}
}
namespace fx {
struct EpiQB {
    static constexpr bool PERM = false;
    bf16_t* O; const float* cosB; const float* sinB;
    __device__ __forceinline__ void operator()(const f32x4 (&acc)[2][2][4][2], const Unit& u, int wr, int wc, int fr, int fq) const {
        const int row0 = u.pm * BM + wr * 64 + fr;
#pragma unroll
        for (int bj = 0; bj < 2; ++bj) { const int G = 8 * u.pn + 4 * bj + wc, gm = G % 6; const int col0 = G * 32 + 4 * fq;
#pragma unroll
            for (int ai = 0; ai < 2; ++ai)
#pragma unroll
                for (int m = 0; m < 4; ++m) { const int row = row0 + ai * HALF + m * 16; f32x4 x1 = acc[ai][bj][m][0], x2 = acc[ai][bj][m][1];
                    if (gm >= 4) { const int s = row & (S - 1), pos = gm == 4 ? (s >> 6) : (s & 63);
                        const f32x4 cs = *(const f32x4*)(cosB + pos * 16 + 4 * fq), sn = *(const f32x4*)(sinB + pos * 16 + 4 * fq);
                        const f32x4 o1 = x1 * cs - x2 * sn, o2 = x2 * cs + x1 * sn; x1 = o1; x2 = o2; }
                    bf16_t* rp = O + (size_t)row * 1280 + col0;
                    u32x2 w0, w1; w0.x = cvt_pk_bf16(x1[0], x1[1]); w0.y = cvt_pk_bf16(x1[2], x1[3]); w1.x = cvt_pk_bf16(x2[0], x2[1]); w1.y = cvt_pk_bf16(x2[2], x2[3]);
                    *(u32x2*)rp = w0; *(u32x2*)(rp + 16) = w1; } }
    }
};
constexpr size_t al256(size_t x) { return (x + 255) & ~(size_t)255; }
constexpr size_t WS_BAR = 0;
constexpr size_t WS_MOD = 16384;
constexpr size_t WS_COEF = WS_MOD + al256(2ull * 4 * 12288 * 4);
constexpr size_t WS_TAB = WS_COEF + al256(2ull * 4 * 6 * 2048 * 4);
constexpr size_t WS_CNT = WS_TAB + al256(6144 * 4);
constexpr size_t WS_WGBASE = WS_CNT + 512;
constexpr size_t WS_SELE = WS_WGBASE + 256 * 64 * 4;
constexpr size_t WS_SELG = WS_SELE + (size_t)T * 6 * 4;
constexpr size_t WS_SLOT = WS_SELG + (size_t)T * 6 * 4;
constexpr size_t WS_ROWTOK = WS_SLOT + (size_t)T * 6 * 4;
constexpr size_t WS_ROWG = WS_ROWTOK + (size_t)PTOT * 4;
constexpr size_t WS_GATES = WS_ROWG + (size_t)PTOT * 4;
constexpr size_t WS_GSC = WS_GATES + (size_t)T * 16 * 4;
constexpr size_t WS_MPREV = WS_GSC + 2048 * 2 * 4;
constexpr size_t WS_NLOC = WS_MPREV + 2048 * 4;
constexpr size_t WS_NPREV = WS_NLOC + 2048ull * 128 * 4;
constexpr size_t WS_W = al256(WS_NPREV + 2048ull * 128 * 4);
constexpr size_t W_IN = 0, W_UQ = W_IN + 4096ull * 2048 * 2, W_UKV = W_UQ + 1280ull * 384 * 2, W_OUT = W_UKV + 1536ull * 256 * 2, W_GU = W_OUT + 2048ull * 2048 * 2, W_DN = W_GU + 65ull * 1024 * 2048 * 2, W_LAYER = W_DN + 65ull * 2048 * 512 * 2;
constexpr size_t WS_XRES = WS_W + 2 * W_LAYER;
constexpr size_t WS_HA = WS_XRES + (size_t)T * 2048 * 4;
constexpr size_t WS_R1 = WS_HA + (size_t)T * 2048 * 2;
constexpr size_t WS_R2 = WS_R1 + (size_t)T * 4096 * 2;
constexpr size_t R2_QA = 0, R2_KA = R2_QA + (size_t)T * 768 * 2, R2_CQN = R2_KA + (size_t)T * 256 * 2, R2_CKVN = R2_CQN + (size_t)T * 384 * 2, R2_KR = R2_CKVN + (size_t)T * 256 * 2,
                 R2_QB = R2_KR + (size_t)T * 64 * 2, R2_KVB = R2_QB + (size_t)T * 1280 * 2, R2_QC = R2_KVB + (size_t)T * 1536 * 2, R2_KC = R2_QC + (size_t)T * 512 * 2,
                 R2_KCT = R2_KC + (size_t)T * 512 * 2, R2_CPREV = R2_KCT + 2048ull * 16384 * 2, R2_END = R2_CPREV + 2048ull * 16384 * 2;
constexpr size_t WS_END = WS_R2 + (size_t)PTOT * 2048 * 2;
static_assert(R2_END <= (size_t)PTOT * 2048 * 2, "R2 overflow");
static_assert(WS_END <= 2147483648ull, "workspace too large");
}
namespace fx {
struct CvtW { const float* w_in; const float* w_uq; const float* w_ukv; const float* w_out; const float* eg; const float* eu; const float* ed; const float* sg; const float* su; const float* sd; bf16_t* W; };
__device__ __forceinline__ void cvt_layer(const CvtW& a, FX_LAS unsigned* my, int gwave, int nwaves, int& rot) {
    const int BIG = 1 << 30; bf16_t* W = a.W;
    bf16_t* WIN = W + W_IN / 2; bf16_t* WUQ = W + W_UQ / 2; bf16_t* WUKV = W + W_UKV / 2; bf16_t* WOUT = W + W_OUT / 2; bf16_t* WGU = W + W_GU / 2; bf16_t* WDN = W + W_DN / 2;
#ifdef FX_WIN8
    { CvtSeg s; s.src = a.w_in; s.dst = WIN; s.sstride = 0; s.dstride = 0; s.ld = 4048; s.nsrc = 4048; s.K = 2048; s.ntn = 64; s.nbatch = 1; s.G = BIG; s.GS = 0; s.off = 0; cvt_seg8(s, my, gwave, nwaves, rot, W8_SCALE); }
#else
    { CvtSeg s; s.src = a.w_in; s.dst = WIN; s.sstride = 0; s.dstride = 0; s.ld = 4048; s.nsrc = 4048; s.K = 2048; s.ntn = 64; s.nbatch = 1; s.G = BIG; s.GS = 0; s.off = 0; cvt_seg(s, my, gwave, nwaves, rot); }
#endif
    { CvtSeg s; s.src = a.w_uq; s.dst = WUQ; s.sstride = 0; s.dstride = 0; s.ld = 1152; s.nsrc = 1152; s.K = 384; s.ntn = 20; s.nbatch = 1; s.G = BIG; s.GS = 0; s.off = 0; cvt_seg(s, my, gwave, nwaves, rot); }
    { CvtSeg s; s.src = a.w_ukv; s.dst = WUKV; s.sstride = 0; s.dstride = 0; s.ld = 1536; s.nsrc = 1536; s.K = 256; s.ntn = 24; s.nbatch = 1; s.G = BIG; s.GS = 0; s.off = 0; cvt_seg(s, my, gwave, nwaves, rot); }
#ifdef FX_WOUT8
    { CvtSeg s; s.src = a.w_out; s.dst = WOUT; s.sstride = 0; s.dstride = 0; s.ld = 2048; s.nsrc = 2048; s.K = 2048; s.ntn = 32; s.nbatch = 1; s.G = BIG; s.GS = 0; s.off = 0; cvt_seg8(s, my, gwave, nwaves, rot, W8_SCALE); }
#else
    { CvtSeg s; s.src = a.w_out; s.dst = WOUT; s.sstride = 0; s.dstride = 0; s.ld = 2048; s.nsrc = 2048; s.K = 2048; s.ntn = 32; s.nbatch = 1; s.G = BIG; s.GS = 0; s.off = 0; cvt_seg(s, my, gwave, nwaves, rot); }
#endif
    { CvtSeg s; s.src = a.eg; s.dst = WGU; s.sstride = 2048ll * 512; s.dstride = 1024ll * 2048; s.ld = 512; s.nsrc = 512; s.K = 2048; s.ntn = 8; s.nbatch = 64; s.G = 128; s.GS = 256; s.off = 0; cvt_seg8(s, my, gwave, nwaves, rot, W8_SCALE); }
    { CvtSeg s; s.src = a.eu; s.dst = WGU; s.sstride = 2048ll * 512; s.dstride = 1024ll * 2048; s.ld = 512; s.nsrc = 512; s.K = 2048; s.ntn = 8; s.nbatch = 64; s.G = 128; s.GS = 256; s.off = 128; cvt_seg8(s, my, gwave, nwaves, rot, W8_SCALE); }
    { CvtSeg s; s.src = a.ed; s.dst = WDN; s.sstride = 512ll * 2048; s.dstride = 2048ll * 512; s.ld = 2048; s.nsrc = 2048; s.K = 512; s.ntn = 32; s.nbatch = 64; s.G = BIG; s.GS = 0; s.off = 0; cvt_seg8(s, my, gwave, nwaves, rot, W8_SCALE); }
    { CvtSeg s; s.src = a.sg; s.dst = (bf16_t*)((unsigned char*)WGU + 64ull * 1024 * 2048); s.sstride = 0; s.dstride = 0; s.ld = 512; s.nsrc = 512; s.K = 2048; s.ntn = 8; s.nbatch = 1; s.G = 128; s.GS = 256; s.off = 0; cvt_seg8(s, my, gwave, nwaves, rot, W8_SCALE); }
    { CvtSeg s; s.src = a.su; s.dst = (bf16_t*)((unsigned char*)WGU + 64ull * 1024 * 2048); s.sstride = 0; s.dstride = 0; s.ld = 512; s.nsrc = 512; s.K = 2048; s.ntn = 8; s.nbatch = 1; s.G = 128; s.GS = 256; s.off = 128; cvt_seg8(s, my, gwave, nwaves, rot, W8_SCALE); }
    { CvtSeg s; s.src = a.sd; s.dst = (bf16_t*)((unsigned char*)WDN + 64ull * 2048 * 512); s.sstride = 0; s.dstride = 0; s.ld = 2048; s.nsrc = 2048; s.K = 512; s.ntn = 32; s.nbatch = 1; s.G = BIG; s.GS = 0; s.off = 0; cvt_seg8(s, my, gwave, nwaves, rot, W8_SCALE); }
}
constexpr int CVT_TILES_PER_LAYER = 2048 + 120 + 96 + 1024 + 3 * 16384 + 3 * 256;
__device__ __forceinline__ void cvt_layer_one(const CvtW& a, FX_LAS unsigned* my, int g) {
    int base = 0;
    const int BIG = 1 << 30; bf16_t* W = a.W;
    bf16_t* WIN = W + W_IN / 2; bf16_t* WUQ = W + W_UQ / 2; bf16_t* WUKV = W + W_UKV / 2; bf16_t* WOUT = W + W_OUT / 2; bf16_t* WGU = W + W_GU / 2; bf16_t* WDN = W + W_DN / 2;
#ifdef FX_WIN8
    { CvtSeg s; s.src = a.w_in; s.dst = WIN; s.sstride = 0; s.dstride = 0; s.ld = 4048; s.nsrc = 4048; s.K = 2048; s.ntn = 64; s.nbatch = 1; s.G = BIG; s.GS = 0; s.off = 0; { const int cnt_ = (s.K / 64) * s.ntn * s.nbatch; if (g >= base && g < base + cnt_) cvt_tile8(s, my, g - base, W8_SCALE); base += cnt_; } }
#else
    { CvtSeg s; s.src = a.w_in; s.dst = WIN; s.sstride = 0; s.dstride = 0; s.ld = 4048; s.nsrc = 4048; s.K = 2048; s.ntn = 64; s.nbatch = 1; s.G = BIG; s.GS = 0; s.off = 0; { const int cnt_ = (s.K / 64) * s.ntn * s.nbatch; if (g >= base && g < base + cnt_) cvt_tile(s, my, g - base); base += cnt_; } }
#endif
    { CvtSeg s; s.src = a.w_uq; s.dst = WUQ; s.sstride = 0; s.dstride = 0; s.ld = 1152; s.nsrc = 1152; s.K = 384; s.ntn = 20; s.nbatch = 1; s.G = BIG; s.GS = 0; s.off = 0; { const int cnt_ = (s.K / 64) * s.ntn * s.nbatch; if (g >= base && g < base + cnt_) cvt_tile(s, my, g - base); base += cnt_; } }
    { CvtSeg s; s.src = a.w_ukv; s.dst = WUKV; s.sstride = 0; s.dstride = 0; s.ld = 1536; s.nsrc = 1536; s.K = 256; s.ntn = 24; s.nbatch = 1; s.G = BIG; s.GS = 0; s.off = 0; { const int cnt_ = (s.K / 64) * s.ntn * s.nbatch; if (g >= base && g < base + cnt_) cvt_tile(s, my, g - base); base += cnt_; } }
#ifdef FX_WOUT8
    { CvtSeg s; s.src = a.w_out; s.dst = WOUT; s.sstride = 0; s.dstride = 0; s.ld = 2048; s.nsrc = 2048; s.K = 2048; s.ntn = 32; s.nbatch = 1; s.G = BIG; s.GS = 0; s.off = 0; { const int cnt_ = (s.K / 64) * s.ntn * s.nbatch; if (g >= base && g < base + cnt_) cvt_tile8(s, my, g - base, W8_SCALE); base += cnt_; } }
#else
    { CvtSeg s; s.src = a.w_out; s.dst = WOUT; s.sstride = 0; s.dstride = 0; s.ld = 2048; s.nsrc = 2048; s.K = 2048; s.ntn = 32; s.nbatch = 1; s.G = BIG; s.GS = 0; s.off = 0; { const int cnt_ = (s.K / 64) * s.ntn * s.nbatch; if (g >= base && g < base + cnt_) cvt_tile(s, my, g - base); base += cnt_; } }
#endif
    { CvtSeg s; s.src = a.eg; s.dst = WGU; s.sstride = 2048ll * 512; s.dstride = 1024ll * 2048; s.ld = 512; s.nsrc = 512; s.K = 2048; s.ntn = 8; s.nbatch = 64; s.G = 128; s.GS = 256; s.off = 0; { const int cnt_ = (s.K / 64) * s.ntn * s.nbatch; if (g >= base && g < base + cnt_) cvt_tile8(s, my, g - base, W8_SCALE); base += cnt_; } }
    { CvtSeg s; s.src = a.eu; s.dst = WGU; s.sstride = 2048ll * 512; s.dstride = 1024ll * 2048; s.ld = 512; s.nsrc = 512; s.K = 2048; s.ntn = 8; s.nbatch = 64; s.G = 128; s.GS = 256; s.off = 128; { const int cnt_ = (s.K / 64) * s.ntn * s.nbatch; if (g >= base && g < base + cnt_) cvt_tile8(s, my, g - base, W8_SCALE); base += cnt_; } }
    { CvtSeg s; s.src = a.ed; s.dst = WDN; s.sstride = 512ll * 2048; s.dstride = 2048ll * 512; s.ld = 2048; s.nsrc = 2048; s.K = 512; s.ntn = 32; s.nbatch = 64; s.G = BIG; s.GS = 0; s.off = 0; { const int cnt_ = (s.K / 64) * s.ntn * s.nbatch; if (g >= base && g < base + cnt_) cvt_tile8(s, my, g - base, W8_SCALE); base += cnt_; } }
    { CvtSeg s; s.src = a.sg; s.dst = (bf16_t*)((unsigned char*)WGU + 64ull * 1024 * 2048); s.sstride = 0; s.dstride = 0; s.ld = 512; s.nsrc = 512; s.K = 2048; s.ntn = 8; s.nbatch = 1; s.G = 128; s.GS = 256; s.off = 0; { const int cnt_ = (s.K / 64) * s.ntn * s.nbatch; if (g >= base && g < base + cnt_) cvt_tile8(s, my, g - base, W8_SCALE); base += cnt_; } }
    { CvtSeg s; s.src = a.su; s.dst = (bf16_t*)((unsigned char*)WGU + 64ull * 1024 * 2048); s.sstride = 0; s.dstride = 0; s.ld = 512; s.nsrc = 512; s.K = 2048; s.ntn = 8; s.nbatch = 1; s.G = 128; s.GS = 256; s.off = 128; { const int cnt_ = (s.K / 64) * s.ntn * s.nbatch; if (g >= base && g < base + cnt_) cvt_tile8(s, my, g - base, W8_SCALE); base += cnt_; } }
    { CvtSeg s; s.src = a.sd; s.dst = (bf16_t*)((unsigned char*)WDN + 64ull * 2048 * 512); s.sstride = 0; s.dstride = 0; s.ld = 2048; s.nsrc = 2048; s.K = 512; s.ntn = 32; s.nbatch = 1; s.G = BIG; s.GS = 0; s.off = 0; { const int cnt_ = (s.K / 64) * s.ntn * s.nbatch; if (g >= base && g < base + cnt_) cvt_tile8(s, my, g - base, W8_SCALE); base += cnt_; } }
}
}
namespace fx {
#define XB_TMO      128
#define XB_XCNT(j)  (256  + 64 * (j))
#define XB_XSUB(j)  (1280 + 64 * (j))
#define XB_XGEN(j)  (2304 + 64 * (j))
#define XB_TOP      3328
#define XB_TOPGEN   3392
#define XCD_BAR_WORDS 3456
#define XB_SPIN_CAP (1u << 22)
__device__ __forceinline__ unsigned xb_ld(unsigned* p)              { return __hip_atomic_load(p, __ATOMIC_RELAXED, __HIP_MEMORY_SCOPE_AGENT); }
__device__ __forceinline__ unsigned xb_add(unsigned* p, unsigned v) { return __hip_atomic_fetch_add(p, v, __ATOMIC_RELAXED, __HIP_MEMORY_SCOPE_AGENT); }
__device__ __forceinline__ unsigned xb_xcc_id() { return (unsigned)__builtin_amdgcn_s_getreg((3 << 11) | 20) & 0xFu; }
#define XB_SPIN(cond, bar) do { unsigned _sp = 0; while (cond) { __builtin_amdgcn_s_sleep(1); \
    if ((++_sp & 255u) == 0u) { if (xb_ld(&(bar)[XB_TMO])) break; if (_sp > XB_SPIN_CAP) { atomicAdd(&(bar)[XB_TMO], 1u); break; } } } } while (0)
struct XcdBarrier { unsigned* bar; unsigned x; volatile FX_LAS unsigned* st; };
__device__ __forceinline__ XcdBarrier xcd_barrier_post(unsigned* bar, volatile FX_LAS unsigned* st, int tidp) {
    XcdBarrier b; b.bar = bar; b.x = xb_xcc_id(); b.st = st;
    if (tidp == 0) (void)xb_add(&bar[XB_XCNT(b.x)], 1u);
    return b;
}
__device__ __forceinline__ void xcd_barrier_complete(unsigned* bar, unsigned x, unsigned& nloc, unsigned& nx) {
    const unsigned G = gridDim.x * gridDim.y * gridDim.z;
    unsigned sum, cnt, mine, sp = 0u;
    for (;;) {
        sum = 0u; cnt = 0u; mine = 0u;
#pragma unroll
        for (unsigned j = 0; j < 16; ++j) { const unsigned c = xb_ld(&bar[XB_XCNT(j)]); sum += c; cnt += (c > 0u) ? 1u : 0u; mine = (j == x) ? c : mine; }
        if (sum == G) break;
        __builtin_amdgcn_s_sleep(1);
        if ((++sp & 255u) == 0u) { if (xb_ld(&bar[XB_TMO])) break; if (sp > XB_SPIN_CAP) { atomicAdd(&bar[XB_TMO], 1u); break; } }
    }
    nloc = mine > 0u ? mine : 1u; nx = cnt > 0u ? cnt : 1u;
}
__device__ __forceinline__ void xcd_barrier(const XcdBarrier& b, int tidp) {
    asm volatile("s_waitcnt vmcnt(0)" ::: "memory");
    __syncthreads();
    if (tidp == 0) {
        unsigned* bar = b.bar;
        __builtin_amdgcn_s_waitcnt(0);
        unsigned nloc = b.st[0], nx = b.st[1];
        if (nloc == 0u) { xcd_barrier_complete(bar, b.x, nloc, nx); b.st[0] = nloc; b.st[1] = nx; }
        const unsigned old = xb_add(&bar[XB_XSUB(b.x)], 1u);
        const unsigned gen = old / nloc;
        if (old + 1u == (gen + 1u) * nloc) {
            __builtin_amdgcn_fence(__ATOMIC_RELEASE, "agent");
            asm volatile("s_waitcnt vmcnt(0)" ::: "memory");
            const unsigned og = xb_add(&bar[XB_TOP], 1u);
            const unsigned tg = og / nx;
            if (og + 1u == (tg + 1u) * nx) xb_add(&bar[XB_TOPGEN], 1u);
            else XB_SPIN(xb_ld(&bar[XB_TOPGEN]) == tg, bar);
            __builtin_amdgcn_fence(__ATOMIC_ACQUIRE, "agent");
            xb_add(&bar[XB_XGEN(b.x)], 1u);
            asm volatile("s_waitcnt vmcnt(0)" ::: "memory");
        } else {
            XB_SPIN(xb_ld(&bar[XB_XGEN(b.x)]) == gen, bar);
            __builtin_amdgcn_fence(__ATOMIC_ACQUIRE, "agent");
            asm volatile("s_waitcnt vmcnt(0)" ::: "memory");
        }
    }
    __syncthreads();
}

__device__ __forceinline__ void modp_phase(FX_LAS unsigned char* lds_, const float* c, const float* ada_w, float* MODP, int wg, int nwg, int tidp) {
    float* cact = (float*)(char*)lds_;
    for (int i = tidp; i < 8192; i += 512) { const float v = c[i]; cact[i] = v / (1.f + expf(-v)); }
    __syncthreads();
    int tid_ = tidp; asm volatile("" : "+v"(tid_));
    const int wid = tid_ >> 6, lane = tid_ & 63;
    for (int u = wg * 8 + wid; u < 2 * 48 * 32; u += nwg * 8) {
        const int kc = u & 31, nc = (u >> 5) % 48, l = u / (48 * 32);
        const float* w = ada_w + (size_t)l * 2048 * 12288 + (size_t)(kc * 64) * 12288 + nc * 256 + lane * 4;
        f32x4 a0 = {0.f, 0.f, 0.f, 0.f}, a1 = a0, a2 = a0, a3 = a0;
#pragma unroll 8
        for (int k = 0; k < 64; ++k) { const f32x4 wv = *(const f32x4*)(w + (size_t)k * 12288); const int kk = kc * 64 + k;
            a0 += wv * cact[kk]; a1 += wv * cact[2048 + kk]; a2 += wv * cact[4096 + kk]; a3 += wv * cact[6144 + kk]; }
        float* dst = MODP + (((size_t)l * 32 + kc) * 4) * 12288 + nc * 256 + lane * 4;
        *(f32x4*)dst = a0; *(f32x4*)(dst + 12288) = a1; *(f32x4*)(dst + 2 * 12288) = a2; *(f32x4*)(dst + 3 * 12288) = a3;
    }
    __syncthreads();
}
__device__ __forceinline__ void tab_phase(float* tab, int gtid) {
    if (gtid < 2048) { const int p = gtid >> 5, f = gtid & 31; const float inv = powf(10000.f, -(float)(2 * f) / 64.f); const float a = (float)p * inv; tab[gtid] = cosf(a); tab[2048 + gtid] = sinf(a); }
    else if (gtid < 3072) { const int i = gtid - 2048, p = i >> 4, f = i & 15; const float inv = powf(10000.f, -(float)(2 * f) / 32.f); const float a = (float)p * inv; tab[4096 + i] = cosf(a); tab[5120 + i] = sinf(a); }
}
__device__ __forceinline__ void coef2_phase(const float* MODP, const float* ada_b, const float* pre_mix_gain, const float* post_mix_gain, const float* pre_ffn_gain, const float* post_ffn_gain, float* coef, int gtid, int nthr) {
    for (int i = gtid; i < 2 * 4 * 2048; i += nthr) { const int d = i & 2047, b = (i >> 11) & 3, l = i >> 13;
        float m[6];
#pragma unroll
        for (int j = 0; j < 6; ++j) { float s = ada_b[l * 12288 + j * 2048 + d];
            for (int kc = 0; kc < 32; ++kc) s += MODP[(((size_t)l * 32 + kc) * 4 + b) * 12288 + j * 2048 + d];
            m[j] = s; }
        float* c = coef + ((size_t)l * 4 + b) * 6 * 2048;
        c[0 * 2048 + d] = m[2] * post_mix_gain[l * 2048 + d];
        c[1 * 2048 + d] = pre_ffn_gain[l * 2048 + d] * (1.f + m[4]);
        c[2 * 2048 + d] = m[3];
        c[3 * 2048 + d] = m[5] * post_ffn_gain[l * 2048 + d];
        c[4 * 2048 + d] = pre_mix_gain[l * 2048 + d] * (1.f + m[1]);
        c[5 * 2048 + d] = m[0]; }
}
__device__ __forceinline__ void coef3_phase(FX_LAS unsigned char* lds_, const float* MODP, const float* ada_b, const float* pre_mix_gain, const float* post_mix_gain, const float* pre_ffn_gain, const float* post_ffn_gain, float* coef, int wg, int nwg, int tidp) {
    FX_LAS float* ms = (FX_LAS float*)lds_;
    int tid_ = tidp; asm volatile("" : "+v"(tid_));
    const int wid = __builtin_amdgcn_readfirstlane(tid_ >> 6), lane = tid_ & 63;
    for (int base = wg * 64; base < 2 * 4 * 2048; base += nwg * 64) {
        const int i = base + lane, d = i & 2047, b = (i >> 11) & 3, l = i >> 13;
        if (wid < 6) { const int j = wid; float pv[32];
#pragma unroll
            for (int kc = 0; kc < 32; ++kc) pv[kc] = MODP[(((size_t)l * 32 + kc) * 4 + b) * 12288 + j * 2048 + d];
            float s = ada_b[l * 12288 + j * 2048 + d];
#pragma unroll
            for (int kc = 0; kc < 32; ++kc) s += pv[kc];
            ms[j * 64 + lane] = s; }
        __syncthreads();
        if (wid == 0) { float m[6];
#pragma unroll
            for (int j = 0; j < 6; ++j) m[j] = ms[j * 64 + lane];
            float* c = coef + ((size_t)l * 4 + b) * 6 * 2048;
            c[0 * 2048 + d] = m[2] * post_mix_gain[l * 2048 + d];
            c[1 * 2048 + d] = pre_ffn_gain[l * 2048 + d] * (1.f + m[4]);
            c[2 * 2048 + d] = m[3];
            c[3 * 2048 + d] = m[5] * post_ffn_gain[l * 2048 + d];
            c[4 * 2048 + d] = pre_mix_gain[l * 2048 + d] * (1.f + m[1]);
            c[5 * 2048 + d] = m[0]; }
        __syncthreads();
    }
}
__device__ __forceinline__ void prenorm_phase(const float* x, const float* coef_l, bf16_t* HA, int wg, int nwg, int tidp) {
    int tid_ = tidp; asm volatile("" : "+v"(tid_));
    const int wid = tid_ >> 6, lane = tid_ & 63;
    for (int t = wg * 8 + wid; t < T; t += nwg * 8) {
        const float* cn = coef_l + (size_t)(t / S) * 6 * 2048;
        float xv[32]; float ss = 0.f;
#pragma unroll
        for (int i = 0; i < 4; ++i) { const int c = i * 512 + lane * 8; const f32x4 x0 = *(const f32x4*)(x + (size_t)t * 2048 + c), x1 = *(const f32x4*)(x + (size_t)t * 2048 + c + 4);
#pragma unroll
            for (int j = 0; j < 4; ++j) { xv[i * 8 + j] = x0[j]; xv[i * 8 + 4 + j] = x1[j]; ss += x0[j] * x0[j] + x1[j] * x1[j]; } }
        ss = wave_sum(ss); const float rx = rsqrtf(ss * (1.f / 2048.f) + EPS);
#pragma unroll
        for (int i = 0; i < 4; ++i) { const int c = i * 512 + lane * 8;
            const f32x4 e0 = *(const f32x4*)(cn + 4 * 2048 + c), e1 = *(const f32x4*)(cn + 4 * 2048 + c + 4), f0 = *(const f32x4*)(cn + 5 * 2048 + c), f1 = *(const f32x4*)(cn + 5 * 2048 + c + 4);
            float hv[8];
#pragma unroll
            for (int j = 0; j < 4; ++j) { hv[j] = xv[i * 8 + j] * rx * e0[j] + f0[j]; hv[4 + j] = xv[i * 8 + 4 + j] * rx * e1[j] + f1[j]; }
#ifdef FX_WIN8
            u32x2 w; w.x = cvt_pk4_fp8(hv[0], hv[1], hv[2], hv[3]); w.y = cvt_pk4_fp8(hv[4], hv[5], hv[6], hv[7]);
            *(u32x2*)((unsigned char*)HA + (size_t)t * 2048 + c) = w; }
#else
            u32x4 w; w.x = cvt_pk_bf16(hv[0], hv[1]); w.y = cvt_pk_bf16(hv[2], hv[3]); w.z = cvt_pk_bf16(hv[4], hv[5]); w.w = cvt_pk_bf16(hv[6], hv[7]);
            *(u32x4*)(HA + (size_t)t * 2048 + c) = w; }
#endif
    }
}

constexpr int LDS_ST = 139264, LDS_TOTAL = LDS_ST + 64 + EPI_LDS_BYTES;
static_assert(EPI_LDS_OFF == LDS_ST + 64 && LDS_TOTAL <= 160 * 1024, "LDS layout");
constexpr size_t WS_MODP = WS_R2;
#define FX_KAS __attribute__((address_space(4)))
template <class TY> __device__ __forceinline__ TY* fx_glob(TY* p) { __attribute__((address_space(1))) TY* g = (__attribute__((address_space(1))) TY*)p; asm volatile("" : "+s"(g)); return (TY*)g; }
struct MP {
    const float* x; const float* c; const float* ada_w; const float* ada_b; const float* pre_mix_gain; const float* w_in; const float* a_q_gain; const float* a_k_gain;
    const float* b_cq_gain; const float* b_ckv_gain; const float* w_uq; const float* w_ukv; const float* c_conv_w; const float* c_conv_b; const float* c_gate_b;
    const float* head_out_gain; const float* w_out; const float* post_mix_gain; const float* pre_ffn_gain; const float* router_w; const float* router_bias;
    const float* exp_w_gate; const float* exp_w_up; const float* exp_w_down; const float* sh_w_gate; const float* sh_w_up; const float* sh_w_down; const float* post_ffn_gain;
    char* ws; float* out;
};
#ifndef FX_NPHASE
#define FX_NPHASE 1000
#endif
#define PH_BEGIN const FX_KAS MP* pk = (const FX_KAS MP*)__builtin_amdgcn_kernarg_segment_ptr(); asm volatile("" : "+s"(pk)); char* ws = fx_glob(pk->ws); (void)ws; int gt_ = wid_s * 64 + fx_lane(); asm volatile("" : "+v"(gt_)); int wg_ = blockIdx.x, nwg_ = gridDim.x; asm volatile("" : "+s"(wg_), "+s"(nwg_)); const int wg = wg_, nwg = nwg_; (void)wg; (void)nwg; (void)gt_;
#define PH_BAR do { PH_BEGIN XcdBarrier b_; b_.bar = (unsigned*)(ws + WS_BAR); b_.x = xb_xcc_id(); b_.st = (volatile FX_LAS unsigned*)(lds + LDS_ST); xcd_barrier(b_, gt_); } while (0)
#define WSP(T_, off) ((T_*)(ws + (off)))
constexpr int QW_CNT = 3584;
constexpr unsigned HV_SLACK = 24;
__device__ __forceinline__ void harvest(FX_LAS unsigned char* lds, const FX_KAS MP* pk, char* ws, int tid, const unsigned nbar, const bool drain) {
    volatile FX_LAS unsigned* bw = (volatile FX_LAS unsigned*)(lds + LDS_ST);
    unsigned* bar = (unsigned*)(ws + WS_BAR);
    const int wave = tid >> 6; FX_LAS unsigned* my = (FX_LAS unsigned*)(lds) + wave * (64 * 33);
    CvtW a; a.w_in = fx_glob(pk->w_in) + (size_t)D * 4048; a.w_uq = fx_glob(pk->w_uq) + (size_t)384 * 1152; a.w_ukv = fx_glob(pk->w_ukv) + (size_t)256 * 1536; a.w_out = fx_glob(pk->w_out) + (size_t)D * D;
    a.eg = fx_glob(pk->exp_w_gate) + (size_t)NE * D * FF; a.eu = fx_glob(pk->exp_w_up) + (size_t)NE * D * FF; a.ed = fx_glob(pk->exp_w_down) + (size_t)NE * FF * D;
    a.sg = fx_glob(pk->sh_w_gate) + (size_t)D * FF; a.su = fx_glob(pk->sh_w_up) + (size_t)D * FF; a.sd = fx_glob(pk->sh_w_down) + (size_t)FF * D; a.W = (bf16_t*)(ws + WS_W + W_LAYER);
    __syncthreads();
    if (drain) {
        if (tid == 0) bw[3] = xb_ld(&bar[QW_CNT]);
        __syncthreads();
        const unsigned h = bw[3];
#pragma unroll 1
        for (unsigned g = h + (unsigned)(blockIdx.x * 8 + wave); g < (unsigned)CVT_TILES_PER_LAYER; g += gridDim.x * 8u) cvt_layer_one(a, my, (int)g);
        __syncthreads();
        return;
    }
#pragma unroll 1
    for (;;) {
        if (tid == 0) { unsigned nxt = 0xffffffffu; bool go = true;
            if (!drain) { unsigned sum = 0u;
#pragma unroll
                for (unsigned j = 0; j < 16; ++j) sum += xb_ld(&bar[XB_XSUB(j)]);
                const unsigned G = gridDim.x; go = (sum - nbar * G) + HV_SLACK < G; }
            if (go && xb_ld(&bar[QW_CNT]) < (unsigned)CVT_TILES_PER_LAYER) { const unsigned b0 = xb_add(&bar[QW_CNT], 8u); if (b0 < (unsigned)CVT_TILES_PER_LAYER) nxt = b0; }
            bw[3] = nxt; }
        __syncthreads();
        const unsigned base = bw[3];
        if (base == 0xffffffffu) break;
        const int g = (int)base + wave;
        if (g < CVT_TILES_PER_LAYER) cvt_layer_one(a, my, g);
        __syncthreads();
    }
    __syncthreads();
}
#ifndef FX_HARVEST
#define FX_HARVEST 1
#endif
#define PH_HARVEST(n, dr) do { if (FX_HARVEST && l == 0 && ((dr) || FX_HARVEST == 1)) { PH_BEGIN harvest(lds, pk, ws, gt_, (n), (dr)); } } while (0)
#ifndef FX_DUP
#define FX_DUP -1
#endif
#define FX_NE ((FX_NOEPI && rep_ == 1) ? FX_NOEPI : 0)
#define FX_REP(n) _Pragma("unroll 1") for (int rep_ = 0; rep_ < ((FX_DUP == (n) && l == 0) ? 2 : 1); ++rep_)
template <int l> __device__ __forceinline__ void layer_body(FX_LAS unsigned char* lds, unsigned char* shm, const int wid_s) {
        FX_REP(2) { PH_BEGIN const bf16_t* W = WSP(const bf16_t, WS_W + (size_t)l * W_LAYER);
#ifdef FX_WIN8
          DenseSched Sc; Sc.init(T, 4096, nwg, wg, 2048, W + W_IN / 2, 2048, 1); EpiBf16 E; E.es = lds + EPI_LDS_OFF; E.O = WSP(bf16_t, WS_R1); E.gates = WSP(float, WS_GATES); E.ldc = 4096; E.scale = W8_INV;
          gemm_phase<EpiBf16, DenseSched, true>(lds, (const char*)WSP(bf16_t, WS_HA), 2048, Sc, E, gt_, FX_NE); }
#else
          DenseSched Sc; Sc.init(T, 4096, nwg, wg, 2048 * 2, W + W_IN / 2, 2048); EpiBf16 E; E.es = lds + EPI_LDS_OFF; E.O = WSP(bf16_t, WS_R1); E.gates = WSP(float, WS_GATES); E.ldc = 4096; E.scale = 1.f;
          gemm_phase<EpiBf16, DenseSched>(lds, (const char*)WSP(bf16_t, WS_HA), 2048, Sc, E, gt_); }
#endif
        PH_HARVEST(3u, false);
        PH_BAR;
        FX_REP(3) { PH_BEGIN char* R2 = ws + WS_R2; float* tab = WSP(float, WS_TAB);
          P3Args a; a.PROJ = WSP(bf16_t, WS_R1); a.GATES = WSP(float, WS_GATES); a.gate_b = fx_glob(pk->c_gate_b) + l * 16; a.conv_w = fx_glob(pk->c_conv_w) + (size_t)l * 5 * 1024; a.conv_b = fx_glob(pk->c_conv_b) + l * 1024;
          a.aq_gain = fx_glob(pk->a_q_gain) + l * 128; a.ak_gain = fx_glob(pk->a_k_gain) + l * 128; a.cq_gain = fx_glob(pk->b_cq_gain) + l * 384; a.ckv_gain = fx_glob(pk->b_ckv_gain) + l * 256;
          a.cosA = tab; a.sinA = tab + 2048; a.cosB = tab + 4096; a.sinB = tab + 5120;
          a.QA = (bf16_t*)(R2 + R2_QA); a.KA = (bf16_t*)(R2 + R2_KA); a.CQN = (bf16_t*)(R2 + R2_CQN); a.CKVN = (bf16_t*)(R2 + R2_CKVN); a.KR = (bf16_t*)(R2 + R2_KR); a.QC = (bf16_t*)(R2 + R2_QC); a.KC = (bf16_t*)(R2 + R2_KC);
          a.KCT = (bf16_t*)(R2 + R2_KCT); a.NLOC = WSP(float, WS_NLOC); a.GSC = WSP(float, WS_GSC);
          p3_phase(lds, a, wg, nwg, gt_); }
        PH_BAR;
        FX_REP(4) {
        { PH_BEGIN const bf16_t* W = WSP(const bf16_t, WS_W + (size_t)l * W_LAYER); char* R2 = ws + WS_R2; float* tab = WSP(float, WS_TAB);
          DenseSched Sc; Sc.init(T, 1280, nwg, wg, 384 * 2, W + W_UQ / 2, 384); EpiQB E; E.O = (bf16_t*)(R2 + R2_QB); E.cosB = tab + 4096; E.sinB = tab + 5120;
          gemm_phase<EpiQB, DenseSched>(lds, (const char*)(R2 + R2_CQN), 384, Sc, E, gt_); }
        { PH_BEGIN const bf16_t* W = WSP(const bf16_t, WS_W + (size_t)l * W_LAYER); char* R2 = ws + WS_R2;
          DenseSched Sc; Sc.init(T, 1536, nwg, (wg + nwg / 2) % nwg  , 256 * 2, W + W_UKV / 2, 256); EpiBf16 E; E.es = lds + EPI_LDS_OFF; E.O = (bf16_t*)(R2 + R2_KVB); E.gates = nullptr; E.ldc = 1536; E.scale = 1.f;
          gemm_phase<EpiBf16, DenseSched>(lds, (const char*)(R2 + R2_CKVN), 256, Sc, E, gt_); }
        { PH_BEGIN char* R2 = ws + WS_R2;
          scan_phase((const bf16_t*)(R2 + R2_KCT), WSP(float, WS_NLOC), WSP(float, WS_GSC), (bf16_t*)(R2 + R2_CPREV), WSP(float, WS_NPREV), WSP(float, WS_MPREV), wg * 512 + gt_, nwg * 512); }
        }
        PH_HARVEST(5u, false);
        PH_BAR;
        FX_REP(5) {
#pragma unroll 1
          for (int ui = 0; ui < 2; ++ui) { PH_BEGIN char* R2 = ws + WS_R2; int u;
              if (nwg == 256) { const int x = wg & 7, j = wg >> 3; if (ui == 1 && j >= 16) break; u = x * 48 + j + ui * 32; } else { u = wg + ui * nwg; if (u >= 384) break; }
              attn_gqa_unit(u, (const bf16_t*)(R2 + R2_QA), (const bf16_t*)(R2 + R2_KA), WSP(const bf16_t, WS_R1), WSP(bf16_t, WS_HA), fx_glob(pk->head_out_gain) + l * D, (char*)shm, gt_); }
#pragma unroll 1
          for (int ui = 0; ui < 2; ++ui) { PH_BEGIN char* R2 = ws + WS_R2; int u;
              if (nwg == 256) { const int x = wg & 7, j = wg >> 3; if (j < 16) { if (ui == 1) break; u = x * 48 + j; } else u = x * 48 + 16 + (j - 16) * 2 + ui; } else { u = wg + ui * nwg; if (u >= 384) break; }
              attn_mla_unit(u, (const bf16_t*)(R2 + R2_QB), (const bf16_t*)(R2 + R2_KVB), (const bf16_t*)(R2 + R2_KR), WSP(bf16_t, WS_HA), fx_glob(pk->head_out_gain) + l * D, (char*)shm, gt_); }
          { PH_BEGIN char* R2 = ws + WS_R2;
            McArgs a; a.PROJ = WSP(bf16_t, WS_R1); a.GATES = WSP(float, WS_GATES); a.gate_b = fx_glob(pk->c_gate_b) + l * 16; a.QC = (bf16_t*)(R2 + R2_QC); a.KC = (bf16_t*)(R2 + R2_KC); a.CPREV = (bf16_t*)(R2 + R2_CPREV);
            a.NPREV = WSP(float, WS_NPREV); a.MPREV = WSP(float, WS_MPREV); a.hog = fx_glob(pk->head_out_gain) + l * D; a.YM = WSP(bf16_t, WS_HA);
            mlstm_c_phase(lds, a, wg, nwg, gt_); } }
        PH_HARVEST(6u, false);
        PH_BAR;
        FX_REP(6) { PH_BEGIN const bf16_t* W = WSP(const bf16_t, WS_W + (size_t)l * W_LAYER);
#ifdef FX_WOUT8
          DenseSched Sc; Sc.init(T, 2048, nwg, wg, 2048, W + W_OUT / 2, 2048, 1); EpiBf16 E; E.es = lds + EPI_LDS_OFF; E.O = WSP(bf16_t, WS_R1); E.gates = nullptr; E.ldc = 2048; E.scale = W8_INV;
          gemm_phase<EpiBf16, DenseSched, true>(lds, (const char*)WSP(bf16_t, WS_HA), 2048, Sc, E, gt_, FX_NE); }
#else
          DenseSched Sc; Sc.init(T, 2048, nwg, wg, 2048 * 2, W + W_OUT / 2, 2048); EpiBf16 E; E.es = lds + EPI_LDS_OFF; E.O = WSP(bf16_t, WS_R1); E.gates = nullptr; E.ldc = 2048; E.scale = 1.f;
          gemm_phase<EpiBf16, DenseSched>(lds, (const char*)WSP(bf16_t, WS_HA), 2048, Sc, E, gt_); }
#endif
        PH_HARVEST(7u, false);
        PH_BAR;
        { PH_BEGIN p7_phase<(l != 0)>(lds, l == 0 ? (const void*)fx_glob(pk->x) : (const void*)WSP(const bf16_t, WS_XRES), WSP(const bf16_t, WS_R1), WSP(float, WS_COEF) + (size_t)l * 4 * 6 * 2048, fx_glob(pk->router_w) + (size_t)l * D * 64, fx_glob(pk->router_bias) + l * 64,
                            WSP(bf16_t, WS_XRES), WSP(unsigned char, WS_HA), WSP(int, WS_SELE), WSP(float, WS_SELG), WSP(int, WS_CNT) + l * 64, WSP(int, WS_WGBASE), wg, nwg, gt_); }
        PH_BAR;
        { PH_BEGIN p8_phase(lds, WSP(int, WS_SELE), WSP(float, WS_SELG), WSP(int, WS_CNT) + l * 64, WSP(int, WS_WGBASE), WSP(int, WS_ROWTOK), WSP(float, WS_ROWG), WSP(int, WS_SLOT), wg, nwg, gt_); }
        PH_BAR;
        FX_REP(9) { PH_BEGIN const bf16_t* W = WSP(const bf16_t, WS_W + (size_t)l * W_LAYER);
          p9_phase(lds, WSP(unsigned char, WS_HA), (const unsigned char*)(W + W_GU / 2), WSP(int, WS_CNT) + l * 64, WSP(int, WS_ROWTOK), WSP(unsigned char, WS_R1), wg, nwg, gt_, FX_NE); }
        PH_HARVEST(10u, false);
        PH_BAR;
        FX_REP(10) { PH_BEGIN const bf16_t* W = WSP(const bf16_t, WS_W + (size_t)l * W_LAYER);
          p10_phase(lds, WSP(unsigned char, WS_R1), (const unsigned char*)(W + W_DN / 2), WSP(int, WS_CNT) + l * 64, WSP(float, WS_ROWG), WSP(unsigned char, WS_R2), wg, nwg, gt_, FX_NE); }
        PH_HARVEST(11u, false);
        PH_BAR;
        { PH_BEGIN p11_phase<(l == 1)>(WSP(bf16_t, WS_XRES), WSP(unsigned char, WS_R2), WSP(int, WS_SLOT), WSP(float, WS_COEF) + (size_t)l * 4 * 6 * 2048, l == 0 ? WSP(float, WS_COEF) + 4 * 6 * 2048 : nullptr,
                             l == 1 ? (void*)fx_glob(pk->out) : (void*)WSP(bf16_t, WS_XRES), WSP(bf16_t, WS_HA), wg, nwg, gt_); }
        PH_HARVEST(12u, true);
        if (l == 0) PH_BAR;
}
__global__ __launch_bounds__(512, 2) void mega(MP p_unused) {
    extern __shared__ __attribute__((aligned(16))) unsigned char shm[];
    FX_LAS unsigned char* lds = (FX_LAS unsigned char*)shm;
    const int wid_s = __builtin_amdgcn_readfirstlane((int)threadIdx.x >> 6);
    { volatile FX_LAS unsigned* st = (volatile FX_LAS unsigned*)(lds + LDS_ST);
      PH_BEGIN if (gt_ == 0) { st[0] = 0u; st[1] = 0u; st[2] = 0u; st[3] = 0u; }
      __syncthreads();
      (void)xcd_barrier_post((unsigned*)(ws + WS_BAR), st, gt_); }
    { PH_BEGIN const int wave = wid_s;     FX_LAS unsigned* my = (FX_LAS unsigned*)(lds) + wave * (64 * 33); int rot = 0;
#pragma unroll 1
      for (int l = 0; l < ((FX_DUP == 0) ? 4 : (FX_HARVEST ? 1 : 2)); ++l) { const int lw = l & 1; CvtW a; a.w_in = fx_glob(pk->w_in) + (size_t)lw * D * 4048; a.w_uq = fx_glob(pk->w_uq) + (size_t)lw * 384 * 1152; a.w_ukv = fx_glob(pk->w_ukv) + (size_t)lw * 256 * 1536; a.w_out = fx_glob(pk->w_out) + (size_t)lw * D * D;
          a.eg = fx_glob(pk->exp_w_gate) + (size_t)lw * NE * D * FF; a.eu = fx_glob(pk->exp_w_up) + (size_t)lw * NE * D * FF; a.ed = fx_glob(pk->exp_w_down) + (size_t)lw * NE * FF * D;
          a.sg = fx_glob(pk->sh_w_gate) + (size_t)lw * D * FF; a.su = fx_glob(pk->sh_w_up) + (size_t)lw * D * FF; a.sd = fx_glob(pk->sh_w_down) + (size_t)lw * FF * D; a.W = (bf16_t*)(ws + WS_W + (size_t)lw * W_LAYER);
          cvt_layer(a, my, wg * 8 + wave, nwg * 8, rot); }
      __syncthreads(); }
    { PH_BEGIN modp_phase(lds, fx_glob(pk->c), fx_glob(pk->ada_w), WSP(float, WS_MODP), wg, nwg, gt_); tab_phase(WSP(float, WS_TAB), wg * 512 + gt_); }
#if FX_DUP == 20
    { PH_BEGIN modp_phase(lds, fx_glob(pk->c), fx_glob(pk->ada_w), WSP(float, WS_MODP), wg, nwg, gt_); tab_phase(WSP(float, WS_TAB), wg * 512 + gt_); }
#endif
    PH_BAR;
    { PH_BEGIN coef3_phase(lds, WSP(float, WS_MODP), fx_glob(pk->ada_b), fx_glob(pk->pre_mix_gain), fx_glob(pk->post_mix_gain), fx_glob(pk->pre_ffn_gain), fx_glob(pk->post_ffn_gain), WSP(float, WS_COEF), wg, nwg, gt_); }
    PH_BAR;
    { PH_BEGIN prenorm_phase(fx_glob(pk->x), WSP(float, WS_COEF), WSP(bf16_t, WS_HA), wg, nwg, gt_); }
#if FX_DUP == 22
    { PH_BEGIN prenorm_phase(fx_glob(pk->x), WSP(float, WS_COEF), WSP(bf16_t, WS_HA), wg, nwg, gt_); }
#endif
    PH_BAR;
#if FX_DUP == 99
    PH_BAR; PH_BAR; PH_BAR; PH_BAR; PH_BAR; PH_BAR; PH_BAR; PH_BAR; PH_BAR; PH_BAR;
#endif
    layer_body<0>(lds, shm, wid_s);
    layer_body<1>(lds, shm, wid_s);
}
}

extern "C" void kernel_launch(void* const* d_in, const int* in_sizes, int n_in, void* d_out, int out_size, void* d_ws, size_t ws_size, hipStream_t stream) {
    using namespace fx;
    static int grid = 0;
    if (!grid) {
        int dev = 0, cus = 0, per_cu = 0;
        (void)hipGetDevice(&dev);
        (void)hipDeviceGetAttribute(&cus, hipDeviceAttributeMultiprocessorCount, dev);
        (void)hipFuncSetAttribute((const void*)mega, hipFuncAttributeMaxDynamicSharedMemorySize, LDS_TOTAL);
        (void)hipOccupancyMaxActiveBlocksPerMultiprocessor(&per_cu, (const void*)mega, 512, LDS_TOTAL);
        if (cus > 256) cus = 256;
        grid = per_cu >= 1 ? cus : 0;
    }
    if (!grid) return;
    (void)hipMemsetAsync((char*)d_ws + WS_BAR, 0, 16384, stream);
    (void)hipMemsetAsync((char*)d_ws + WS_CNT, 0, 512, stream);
    MP p{};
    const float** q = (const float**)&p;
    for (int i = 0; i < 28; ++i) q[i] = (const float*)d_in[i];
    p.ws = (char*)d_ws; p.out = (float*)d_out;
    hipLaunchKernelGGL(mega, dim3(grid), dim3(512), LDS_TOTAL, stream, p);
}
```

```cpp
#define FX_WIN8 1
#define FX_WOUT8 1
#define FX_HARVEST 0
#include <hip/hip_runtime.h>
#include <stdint.h>
#include <math.h>
#ifndef FX_ROWDMA
#define FX_ROWDMA 1
#endif
#ifndef FX_SEAM
#define FX_SEAM 1
#endif
#ifndef FX_WARM
#define FX_WARM 0
#endif
#ifndef FX_NOEPI
#define FX_NOEPI 0
#endif
namespace fx {
#define FX_LAS __attribute__((address_space(3)))
typedef unsigned short bf16_t;
typedef short bf16x8 __attribute__((ext_vector_type(8)));
typedef short s16x4 __attribute__((ext_vector_type(4)));
typedef float f32x4 __attribute__((ext_vector_type(4)));
typedef float f32x16 __attribute__((ext_vector_type(16)));
typedef unsigned u32x4 __attribute__((ext_vector_type(4)));
typedef unsigned u32x2 __attribute__((ext_vector_type(2)));
typedef float f32x2 __attribute__((ext_vector_type(2)));

constexpr int D = 2048, NB = 4, S = 4096, T = NB * S, DEPTH = 2;
constexpr int NE = 64, FF = 512;
constexpr float EPS = 1e-6f;
constexpr int PW = 4096;
constexpr int O_AQ = 0, O_AK = 768, O_AV = 1024, O_BCQ = 1280, O_BCKV = 1664, O_BKR = 1920, O_CQ = 1984, O_CK = 2496, O_CV = 3008, O_CO = 3520, O_CG = 4032;

typedef __bf16 bf16x2_t __attribute__((ext_vector_type(2)));
__device__ __forceinline__ unsigned cvt_pk_bf16(float lo, float hi) { const bf16x2_t r = __builtin_convertvector((f32x2){lo, hi}, bf16x2_t); return __builtin_bit_cast(unsigned, r); }
__device__ __forceinline__ float bf2f(bf16_t b) { return __uint_as_float(((unsigned)b) << 16); }
__device__ __forceinline__ float bflo(unsigned w) { return __uint_as_float(w << 16); }
__device__ __forceinline__ float bfhi(unsigned w) { return __uint_as_float(w & 0xffff0000u); }
__device__ __forceinline__ bf16_t f2bf(float f) { return (bf16_t)(cvt_pk_bf16(f, 0.f) & 0xffffu); }
__device__ __forceinline__ float sigmoid_f(float x) { return __builtin_amdgcn_rcpf(1.f + __expf(-x)); }
__device__ __forceinline__ float silu_f(float x) { return x * __builtin_amdgcn_rcpf(1.f + __expf(-x)); }
__device__ __forceinline__ int fx_lane() { unsigned z = 0u; asm volatile("" : "+v"(z)); return (int)__builtin_amdgcn_mbcnt_hi(~0u, __builtin_amdgcn_mbcnt_lo(~0u, z)); }
#ifndef FX_DPPRED
#define FX_DPPRED 1
#endif
#if FX_DPPRED
#define FX_DPP(IDENT, V, CTRL, RMASK) __builtin_bit_cast(float, __builtin_amdgcn_update_dpp(__builtin_bit_cast(int, (float)(IDENT)), __builtin_bit_cast(int, (V)), (CTRL), (RMASK), 0xF, false))
__device__ __forceinline__ float wave_sum(float v) {
    v += FX_DPP(0.f, v, 0xB1, 0xF); v += FX_DPP(0.f, v, 0x4E, 0xF); v += FX_DPP(0.f, v, 0x141, 0xF); v += FX_DPP(0.f, v, 0x140, 0xF);
    v += FX_DPP(0.f, v, 0x142, 0xA); v += FX_DPP(0.f, v, 0x143, 0xC);
    return __builtin_bit_cast(float, __builtin_amdgcn_readlane(__builtin_bit_cast(int, v), 63));
}
__device__ __forceinline__ float wave_max(float v) {
    const float NI = -3.4028234664e38f;
    v = fmaxf(v, FX_DPP(NI, v, 0xB1, 0xF)); v = fmaxf(v, FX_DPP(NI, v, 0x4E, 0xF)); v = fmaxf(v, FX_DPP(NI, v, 0x141, 0xF)); v = fmaxf(v, FX_DPP(NI, v, 0x140, 0xF));
    v = fmaxf(v, FX_DPP(NI, v, 0x142, 0xA)); v = fmaxf(v, FX_DPP(NI, v, 0x143, 0xC));
    return __builtin_bit_cast(float, __builtin_amdgcn_readlane(__builtin_bit_cast(int, v), 63));
}
#else
__device__ __forceinline__ float wave_sum(float v) { for (int o = 32; o >= 1; o >>= 1) v += __shfl_xor(v, o); return v; }
__device__ __forceinline__ float wave_max(float v) { for (int o = 32; o >= 1; o >>= 1) v = fmaxf(v, __shfl_xor(v, o)); return v; }
#endif

#ifndef FX_WGM
#define FX_WGM 8
#endif
#ifndef FX_CVT2D
#define FX_CVT2D 0
#endif
#ifndef FX_CVTPIPE
#define FX_CVTPIPE 1
#endif
#ifndef FX_PRIO8
#define FX_PRIO8 1
#endif
#ifndef FX_F8_32
#define FX_F8_32 0
#endif
typedef int i32x8 __attribute__((ext_vector_type(8)));
typedef int i32x4 __attribute__((ext_vector_type(4)));
constexpr float W8_SCALE = 32.f, W8_INV = 1.f / 32.f;
__device__ __forceinline__ unsigned cvt_pk4_fp8(float a, float b, float c, float d) { int w = 0; w = __builtin_amdgcn_cvt_pk_fp8_f32(a, b, w, false); w = __builtin_amdgcn_cvt_pk_fp8_f32(c, d, w, true); return (unsigned)w; }
struct CvtSeg { const float* src; bf16_t* dst; long long sstride, dstride; int ld, nsrc, K, ntn, nbatch, G, GS, off; int kperm = 0; };
__device__ __forceinline__ void cvt_tile(const CvtSeg sg, FX_LAS unsigned* my, int tile) {
    const int lane = fx_lane();
    const int ktn = sg.K / 64, per = ktn * sg.ntn;
    {
        const int b = tile / per, r = tile - b * per, nt = r / ktn, kt = r - nt * ktn;
        const int r4 = lane >> 4, c4 = lane & 15;
        const float* src = sg.src + (size_t)b * sg.sstride + (size_t)(kt * 64) * sg.ld + nt * 64 + 4 * c4;
        const bool ok = nt * 64 + 4 * c4 < sg.nsrc;
        f32x4 va[8], vb[8];
#pragma unroll
        for (int i = 0; i < 8; ++i) { const int kp = 4 * i + r4; const f32x4 z = {0.f, 0.f, 0.f, 0.f};
            va[i] = ok ? *(const f32x4*)(src + (size_t)(2 * kp) * sg.ld) : z; vb[i] = ok ? *(const f32x4*)(src + (size_t)(2 * kp + 1) * sg.ld) : z; }
#pragma unroll
        for (int i = 0; i < 8; ++i) { const int kp = 4 * i + r4;
#pragma unroll
            for (int j = 0; j < 4; ++j) my[(4 * c4 + j) * 33 + kp] = cvt_pk_bf16(va[i][j], vb[i][j]); }
        asm volatile("s_waitcnt lgkmcnt(0)" ::: "memory");
        bf16_t* dst = sg.dst + (size_t)b * sg.dstride;
#pragma unroll
        for (int i = 0; i < 8; ++i) {
            const int nl = (lane >> 3) + 8 * i, c = lane & 7, n = nt * 64 + nl;
            u32x4 w; w.x = my[nl * 33 + 4 * c]; w.y = my[nl * 33 + 4 * c + 1]; w.z = my[nl * 33 + 4 * c + 2]; w.w = my[nl * 33 + 4 * c + 3];
            const int row = (n / sg.G) * sg.GS + (n % sg.G) + sg.off;
            *(u32x4*)(dst + (size_t)row * sg.K + kt * 64 + 8 * c) = w;
        }
        asm volatile("s_waitcnt lgkmcnt(0)" ::: "memory");
    }
}
__device__ __forceinline__ void cvt_seg(const CvtSeg sg, FX_LAS unsigned* my, int gwave, int nwaves, int& rot) {
    const int total = (sg.K / 64) * sg.ntn * sg.nbatch;
    int first = (gwave - rot) % nwaves; if (first < 0) first += nwaves;
    for (int tile = first; tile < total; tile += nwaves) cvt_tile(sg, my, tile);
    rot = (rot + total) % nwaves;
}
__device__ __forceinline__ void cvt_tile8(const CvtSeg sg, FX_LAS unsigned* my, int tile, float scale) {
    const int lane = fx_lane();
    const int ktn = sg.K / 64, per = ktn * sg.ntn;
    {
        const int b = tile / per, r = tile - b * per, nt = r / ktn, kt = r - nt * ktn;
        const int r4 = lane >> 4, c4 = lane & 15;
        const float* src = sg.src + (size_t)b * sg.sstride + (size_t)(kt * 64) * sg.ld + nt * 64 + 4 * c4;
        const bool ok = nt * 64 + 4 * c4 < sg.nsrc;
        f32x4 v[4][4];
#pragma unroll
        for (int i = 0; i < 4; ++i)
#pragma unroll
            for (int q = 0; q < 4; ++q) { const int kq = 4 * i + r4; const f32x4 z = {0.f, 0.f, 0.f, 0.f}; v[i][q] = ok ? *(const f32x4*)(src + (size_t)(4 * kq + q) * sg.ld) : z; }
#pragma unroll
        for (int i = 0; i < 4; ++i) { const int kq = 4 * i + r4;
#pragma unroll
            for (int j = 0; j < 4; ++j) my[(4 * c4 + j) * 17 + kq] = cvt_pk4_fp8(v[i][0][j] * scale, v[i][1][j] * scale, v[i][2][j] * scale, v[i][3][j] * scale); }
        asm volatile("s_waitcnt lgkmcnt(0)" ::: "memory");
        unsigned char* dst = (unsigned char*)sg.dst + (size_t)b * sg.dstride;
#pragma unroll
        for (int i = 0; i < 4; ++i) {
            const int nl = (lane >> 2) + 16 * i, c = lane & 3, n = nt * 64 + nl;
            u32x4 w; w.x = my[nl * 17 + 4 * c]; w.y = my[nl * 17 + 4 * c + 1]; w.z = my[nl * 17 + 4 * c + 2]; w.w = my[nl * 17 + 4 * c + 3];
            const int row = (n / sg.G) * sg.GS + (n % sg.G) + sg.off;
            *(u32x4*)(dst + (size_t)row * sg.K + kt * 64 + 16 * c) = w;
        }
        asm volatile("s_waitcnt lgkmcnt(0)" ::: "memory");
    }
}
struct Cvt8P { const float* src; unsigned char* dst; float sc; int nt, kt, perm; };
#define FX_C8ROW(P, kq, q) ((P).perm ? 32 * (q) + (kq) : 4 * (kq) + (q))
__device__ __forceinline__ Cvt8P cvt8_params(const CvtSeg sg, int tile, float scale, int lane) {
    const int ktn = sg.K / 64, per = ktn * sg.ntn;
#if FX_CVT2D
    const int b = tile / per, r = tile - b * per, w8 = r & 7, g8 = r >> 3, ktp = ktn >> 1, ntq = g8 / ktp, nt = 4 * ntq + (w8 & 3), kt = 2 * (g8 - ntq * ktp) + (w8 >> 2);
#else
    const int b = tile / per, r = tile - b * per, nt = r / ktn, kt = r - nt * ktn;
#endif
    const int c4 = lane & 15;
    const bool ok = nt * 64 + 4 * c4 < sg.nsrc;
    Cvt8P p; p.perm = (kt * 64 < sg.kperm) ? 1 : 0; p.src = sg.src + (size_t)b * sg.sstride + (size_t)(p.perm ? (kt >> 1) * 128 + 16 * (kt & 1) : kt * 64) * sg.ld + (ok ? nt * 64 + 4 * c4 : 0); p.dst = (unsigned char*)sg.dst + (size_t)b * sg.dstride; p.sc = ok ? scale : 0.f; p.nt = nt; p.kt = kt;
    return p;
}
__device__ __forceinline__ void cvt8_out(const CvtSeg sg, FX_LAS unsigned* my, const Cvt8P& p, int lane) {
    asm volatile("s_waitcnt lgkmcnt(0)" ::: "memory");
#pragma unroll
    for (int i = 0; i < 4; ++i) {
        const int nl = (lane >> 2) + 16 * i, c = lane & 3, n = p.nt * 64 + nl;
        u32x4 w; w.x = my[nl * 17 + 4 * c]; w.y = my[nl * 17 + 4 * c + 1]; w.z = my[nl * 17 + 4 * c + 2]; w.w = my[nl * 17 + 4 * c + 3];
        const int row = (n / sg.G) * sg.GS + (n % sg.G) + sg.off;
        *(u32x4*)(p.dst + (size_t)row * sg.K + p.kt * 64 + 16 * c) = w;
    }
    asm volatile("s_waitcnt lgkmcnt(0)" ::: "memory");
}
__device__ __forceinline__ void cvt_seg8(const CvtSeg sg, FX_LAS unsigned* my, int gwave, int nwaves, int& rot, float scale) {
    const int total = (sg.K / 64) * sg.ntn * sg.nbatch;
    int first = (gwave - rot) % nwaves; if (first < 0) first += nwaves;
#if FX_CVTPIPE
    if (first < total) {
        const int lane = fx_lane(), r4 = lane >> 4, c4 = lane & 15;
        f32x4 v[4][4];
        Cvt8P cur = cvt8_params(sg, first, scale, lane);
#pragma unroll
        for (int i = 0; i < 4; ++i)
#pragma unroll
            for (int q = 0; q < 4; ++q) v[i][q] = *(const f32x4*)(cur.src + (size_t)FX_C8ROW(cur, 4 * i + r4, q) * sg.ld);
        int tile = first;
#pragma unroll 1
        while (tile + nwaves < total) {
            tile += nwaves;
            const Cvt8P nx = cvt8_params(sg, tile, scale, lane);
#pragma unroll
            for (int i = 0; i < 4; ++i) { const int kq = 4 * i + r4;
#pragma unroll
                for (int j = 0; j < 4; ++j) my[(4 * c4 + j) * 17 + kq] = cvt_pk4_fp8(v[i][0][j] * cur.sc, v[i][1][j] * cur.sc, v[i][2][j] * cur.sc, v[i][3][j] * cur.sc);
#pragma unroll
                for (int q = 0; q < 4; ++q) v[i][q] = *(const f32x4*)(nx.src + (size_t)FX_C8ROW(nx, kq, q) * sg.ld); }
            cvt8_out(sg, my, cur, lane);
            cur = nx;
        }
#pragma unroll
        for (int i = 0; i < 4; ++i) { const int kq = 4 * i + r4;
#pragma unroll
            for (int j = 0; j < 4; ++j) my[(4 * c4 + j) * 17 + kq] = cvt_pk4_fp8(v[i][0][j] * cur.sc, v[i][1][j] * cur.sc, v[i][2][j] * cur.sc, v[i][3][j] * cur.sc); }
        cvt8_out(sg, my, cur, lane);
    }
#else
    for (int tile = first; tile < total; tile += nwaves) cvt_tile8(sg, my, tile, scale);
#endif
    rot = (rot + total) % nwaves;
}

constexpr int BM = 256, BK = 64, HALF = 128, HTB = HALF * BK * 2, STAGE_BYTES = 8 * HTB, NXCD = 8, WGM = FX_WGM;
__host__ __device__ __forceinline__ int lds_byte(int r, int c) { const int st = (r >> 4) * 2 + (c >> 5), rr = r & 15, cc = c & 31, ob = rr * 64 + cc * 2; return st * 1024 + (ob ^ (((ob >> 9) & 1) << 5)); }
__host__ __device__ __forceinline__ void stage_rc(int b, int& R, int& C) { const int st = b / 1024, sb = b % 1024, swz = sb ^ (((sb >> 9) & 1) << 5); R = (st >> 1) * 16 + swz / 64; C = (st & 1) * 32 + (swz % 64) / 2; }
__host__ __device__ __forceinline__ int perm32(int rho) { const int n = rho >> 4, i = rho & 15; return 8 * (i >> 2) + 4 * n + (i & 3); }
struct Unit { int pm, pn, e; };
struct DenseSched {
    static constexpr bool GATHER = false, WARM2 = false;
    int nM, nN, nwg, G, c; int lda_b; const char* Bt; int K; int esz;
    __device__ void init(int M, int N, int G_, int c_, int lda_bytes, const void* Bt_, int K_, int esz_ = 2) { nM = M / BM; nN = N / BM; nwg = nM * nN; G = G_; c = c_; lda_b = lda_bytes; Bt = (const char*)Bt_; K = K_; esz = esz_; }
    __device__ __forceinline__ bool next(int i, Unit& u) const {
        const long L = (long)i * G + c; if (L >= nwg) return false;
        int wgid = (int)L; { const int q = nwg / NXCD, r = nwg % NXCD, xcd = wgid % NXCD, off = wgid / NXCD; wgid = (xcd < r ? xcd * (q + 1) : r * (q + 1) + (xcd - r) * q) + off; }
        const int nig = WGM * nN, gid = wgid / nig, fm = gid * WGM, gsz = (nM - fm) < WGM ? (nM - fm) : WGM;
        u.pm = fm + ((wgid % nig) % gsz); u.pn = (wgid % nig) / gsz; u.e = 0; return true;
    }
    __device__ __forceinline__ unsigned a_row_off(const Unit& u, int R) const { return (unsigned)(u.pm * BM + R) * (unsigned)lda_b; }
    __device__ __forceinline__ size_t a_unit_base(const Unit& u) const { return (size_t)u.pm * BM * (size_t)lda_b; }
    __device__ __forceinline__ unsigned a_lane_off(int R) const { return (unsigned)R * (unsigned)lda_b; }
    __device__ __forceinline__ const char* b_ptr(const Unit& u) const { return Bt + (size_t)u.pn * BM * K * esz; }
};

template <class Epi, class Sched, bool FP8 = false>
__device__ __forceinline__ void gemm_phase(FX_LAS unsigned char* lds, const char* Abase, const int Kc, const Sched& S, const Epi& E, int tidp, const int noepi = 0) {
    int K_ = Kc; asm volatile("" : "+s"(K_)); const int K = K_;
    int tid_ = tidp; asm volatile("" : "+v"(tid_));
    const int tid = tid_, wid = __builtin_amdgcn_readfirstlane(tid >> 6), lane = tid & 63, wr = wid >> 2, wc = wid & 3, fr = lane & 15, fq = lane >> 4;
    constexpr int ES = FP8 ? 1 : 2;
    const int nt = K * ES / 128;
    int Rr[2], Cc[2]; unsigned voffB[2];
#pragma unroll
    for (int i = 0; i < 2; ++i) { int R, C; stage_rc(tid * 16 + i * 8192, R, C); Rr[i] = R; Cc[i] = C; const int Rb = (Epi::PERM && !(FP8 && FX_F8_32)) ? ((R & ~31) + perm32(R & 31)) : R; voffB[i] = (unsigned)(Rb * (noepi == 3 ? 128 : K * ES) + C * 2); }
    const size_t hstepB = (size_t)HALF * (noepi == 3 ? 128 : K * ES);
    const unsigned ldsw = (unsigned)wid * 1024u;
    constexpr bool F32M = FP8 && FX_F8_32;
    const int aoff = F32M ? lds_byte(wr * 64 + (lane & 31), 16 * (lane >> 5)) : lds_byte(wr * 64 + fr, fq * 8), boff = F32M ? lds_byte(wc * 32 + (lane & 31), 16 * (lane >> 5)) : lds_byte(wc * 32 + fr, fq * 8);
#define FX_SA(b, h) (((b) * 2 + (h)) * HTB)
#define FX_SB(b, h) ((4 + (b) * 2 + (h)) * HTB)
#define FX_STAGE_A(bufoff, o0, o1, kb) do { const char* ap_ = Abase + (kb); \
        __builtin_amdgcn_global_load_lds((const unsigned*)(ap_ + (o0)), (FX_LAS unsigned*)(lds + (bufoff) + ldsw), 16, 0, 0); \
        __builtin_amdgcn_global_load_lds((const unsigned*)(ap_ + (o1)), (FX_LAS unsigned*)(lds + (bufoff) + ldsw + 8192), 16, 0, 0); } while (0)
#define FX_STAGE_B(bufoff, gbase) do { _Pragma("unroll") for (int _i = 0; _i < 2; ++_i) \
        __builtin_amdgcn_global_load_lds((const unsigned*)((const char*)(gbase) + voffB[_i]), (FX_LAS unsigned*)(lds + (bufoff) + ldsw + _i * 8192), 16, 0, 0); } while (0)
#define FX_LDA(dst, b, h) do { if constexpr (F32M) { _Pragma("unroll") for (int q = 0; q < 4; ++q) { dst[q][0] = *(const FX_LAS bf16x8*)(lds + FX_SA(b, h) + aoff + (q >> 1) * 4096 + (q & 1) * 1024); dst[q][1] = *(const FX_LAS bf16x8*)(lds + FX_SA(b, h) + aoff + (q >> 1) * 4096 + (q & 1) * 1024 + 16); } } \
        else { _Pragma("unroll") for (int m = 0; m < 4; ++m) _Pragma("unroll") for (int k = 0; k < 2; ++k) dst[m][k] = *(const FX_LAS bf16x8*)(lds + FX_SA(b, h) + aoff + m * 2048 + k * 1024); } } while (0)
#define FX_LDB(dst, b, h) do { if constexpr (F32M) { _Pragma("unroll") for (int q = 0; q < 2; ++q) { dst[q][0] = *(const FX_LAS bf16x8*)(lds + FX_SB(b, h) + boff + q * 1024); dst[q][1] = *(const FX_LAS bf16x8*)(lds + FX_SB(b, h) + boff + q * 1024 + 16); } } \
        else { _Pragma("unroll") for (int n = 0; n < 2; ++n) _Pragma("unroll") for (int k = 0; k < 2; ++k) dst[n][k] = *(const FX_LAS bf16x8*)(lds + FX_SB(b, h) + boff + n * 2048 + k * 1024); } } while (0)
#define FX_MMA(ai, bj, At, Bt) do { if (!FP8 || FX_PRIO8) __builtin_amdgcn_s_setprio(1); \
        if constexpr (F32M) { _Pragma("unroll") for (int mb = 0; mb < 2; ++mb) _Pragma("unroll") for (int s = 0; s < 2; ++s) { \
            const i32x4 a0_ = __builtin_bit_cast(i32x4, At[mb * 2 + s][0]), a1_ = __builtin_bit_cast(i32x4, At[mb * 2 + s][1]), b0_ = __builtin_bit_cast(i32x4, Bt[s][0]), b1_ = __builtin_bit_cast(i32x4, Bt[s][1]); \
            const i32x8 af_ = __builtin_shufflevector(a0_, a1_, 0, 1, 2, 3, 4, 5, 6, 7), bf_ = __builtin_shufflevector(b0_, b1_, 0, 1, 2, 3, 4, 5, 6, 7); \
            asm volatile("v_mfma_scale_f32_32x32x64_f8f6f4 %0, %1, %2, %0, %3, %3 op_sel_hi:[0,0,0]" : "+v"(acc3[ai][bj][mb]) : "v"(bf_), "v"(af_), "v"(sc1_)); } } else \
        _Pragma("unroll") for (int m = 0; m < 4; ++m) _Pragma("unroll") for (int n = 0; n < 2; ++n) { \
        if constexpr (FP8) { const i32x4 a0_ = __builtin_bit_cast(i32x4, At[m][0]), a1_ = __builtin_bit_cast(i32x4, At[m][1]), b0_ = __builtin_bit_cast(i32x4, Bt[n][0]), b1_ = __builtin_bit_cast(i32x4, Bt[n][1]); \
            const i32x8 af_ = __builtin_shufflevector(a0_, a1_, 0, 1, 2, 3, 4, 5, 6, 7), bf_ = __builtin_shufflevector(b0_, b1_, 0, 1, 2, 3, 4, 5, 6, 7); \
            asm volatile("v_mfma_scale_f32_16x16x128_f8f6f4 %0, %1, %2, %0, %3, %3 op_sel_hi:[0,0,0]" : "+v"(acc[ai][bj][m][n]) : "v"(bf_), "v"(af_), "v"(sc1_)); FX_MFMA_DUP(acc[ai][bj][m][n]) } \
        else { _Pragma("unroll") for (int k = 0; k < 2; ++k) acc[ai][bj][m][n] = __builtin_amdgcn_mfma_f32_16x16x32_bf16(Bt[n][k], At[m][k], acc[ai][bj][m][n], 0, 0, 0); } } \
        if (!FP8 || FX_PRIO8) __builtin_amdgcn_s_setprio(0); } while (0)
#define FX_WAIT_V(n) asm volatile("s_waitcnt vmcnt(" #n ")" ::: "memory")
#define FX_WAIT_L(n) asm volatile("s_waitcnt lgkmcnt(" #n ")" ::: "memory")
#define FX_BAR __builtin_amdgcn_s_barrier()
#define FX_SCHED __builtin_amdgcn_sched_barrier(0)
#ifdef FX_PROBE_MFMA
#define FX_MFMA_DUP(ACC) asm volatile("v_mfma_scale_f32_16x16x128_f8f6f4 %0, %1, %2, %0, %3, %3 op_sel_hi:[0,0,0]" : "+v"(ACC) : "v"(bf_), "v"(af_), "v"(sc0_));
#else
#define FX_MFMA_DUP(ACC)
#endif
    const int sc0_ = 0; (void)sc0_;
    const int sc1_ = 0x7f7f7f7f;
    (void)sc1_;
    Unit cur, nxt; int ui = 0; bool seamed = false;
    if (!S.next(0, cur)) return;
    f32x4 acc[2][2][4][2];
#pragma unroll
    for (int a = 0; a < 2; ++a)
#pragma unroll
        for (int b = 0; b < 2; ++b)
#pragma unroll
            for (int m = 0; m < 4; ++m)
#pragma unroll
                for (int n = 0; n < 2; ++n) acc[a][b][m][n] = (f32x4){0.f, 0.f, 0.f, 0.f};
    f32x16 acc3[2][2][2];
#pragma unroll
    for (int q = 0; q < 8; ++q) acc3[q >> 2][(q >> 1) & 1][q & 1] = f32x16{};
    bf16x8 At[4][2], B0[2][2], B1[2][2];
    unsigned c00, c01, c10, c11, n00 = 0, n01 = 0, n10 = 0, n11 = 0;
    size_t ubc = 0, ubn = 0;
    if constexpr (Sched::GATHER) { c00 = S.a_row_off(cur, Rr[0]) + Cc[0] * 2; c01 = S.a_row_off(cur, Rr[1]) + Cc[1] * 2; c10 = S.a_row_off(cur, HALF + Rr[0]) + Cc[0] * 2; c11 = S.a_row_off(cur, HALF + Rr[1]) + Cc[1] * 2; }
    else { c00 = S.a_lane_off(Rr[0]) + Cc[0] * 2; c01 = S.a_lane_off(Rr[1]) + Cc[1] * 2; c10 = c00 + S.a_lane_off(HALF); c11 = c01 + S.a_lane_off(HALF); ubc = S.a_unit_base(cur); n00 = c00; n01 = c01; n10 = c10; n11 = c11; }
    const char* cB = S.b_ptr(cur);
    const unsigned kstep = noepi == 3 ? 32768u : BK * 2;
    FX_STAGE_B(FX_SB(0, 0), cB); FX_STAGE_A(FX_SA(0, 0), c00, c01, ubc); FX_STAGE_B(FX_SB(0, 1), cB + hstepB); FX_STAGE_A(FX_SA(0, 1), c10, c11, ubc);
    if (wr == 1) FX_BAR;
    FX_WAIT_V(4); FX_BAR;
    FX_STAGE_B(FX_SB(1, 0), cB + kstep); FX_STAGE_A(FX_SA(1, 0), c00, c01, ubc + kstep); FX_STAGE_B(FX_SB(1, 1), cB + hstepB + kstep);
    FX_WAIT_V(6); FX_BAR;
    for (;;) {
        const bool has_next = S.next(ui + 1, nxt);
        if (!has_next) nxt = cur;
        if constexpr (!Sched::GATHER) ubn = S.a_unit_base(nxt);
        const char* nB = S.b_ptr(nxt);
        for (int t = 0; t < nt; t += 2) {
            const bool last = (t == nt - 2);
            asm volatile("" : "+v"(c00), "+v"(c01), "+v"(c10), "+v"(c11), "+v"(voffB[0]), "+v"(voffB[1]));
            if constexpr (Sched::GATHER) {
#if FX_ROWDMA
                FX_LAS unsigned* rscr = (FX_LAS unsigned*)(lds + STAGE_BYTES + 2048);
                if (t == nt - 4 && has_next && wid < 4) __builtin_amdgcn_global_load_lds((const unsigned*)S.rowtok + (size_t)nxt.pm * BM + wid * 64 + lane, rscr + wid * 64, 4, 0, 0);
                if (last) { int t2_ = tid; asm volatile("" : "+v"(t2_)); int R0_, C0_, R1_, C1_; stage_rc(t2_ * 16, R0_, C0_); stage_rc(t2_ * 16 + 8192, R1_, C1_);
                    if (has_next) { n00 = rscr[R0_] * (unsigned)S.lda_b + C0_ * 2; n01 = rscr[R1_] * (unsigned)S.lda_b + C1_ * 2; n10 = rscr[HALF + R0_] * (unsigned)S.lda_b + C0_ * 2; n11 = rscr[HALF + R1_] * (unsigned)S.lda_b + C1_ * 2; }
                    else { n00 = c00; n01 = c01; n10 = c10; n11 = c11; } }
#else
                if (last) {
                int t2_ = tid; asm volatile("" : "+v"(t2_)); int R0_, C0_, R1_, C1_; stage_rc(t2_ * 16, R0_, C0_); stage_rc(t2_ * 16 + 8192, R1_, C1_);
                n00 = S.a_row_off(nxt, R0_) + C0_ * 2; n01 = S.a_row_off(nxt, R1_) + C1_ * 2; n10 = S.a_row_off(nxt, HALF + R0_) + C0_ * 2; n11 = S.a_row_off(nxt, HALF + R1_) + C1_ * 2; }
#endif
            }
            const size_t k1 = ubc + (size_t)(t + 1) * kstep;
            const size_t k2 = last ? ubn : ubc + (size_t)(t + 2) * kstep, k3 = k2 + kstep;
            unsigned a00, a01, a10, a11;
            if constexpr (Sched::GATHER) { a00 = last ? n00 : c00; a01 = last ? n01 : c01; a10 = last ? n10 : c10; a11 = last ? n11 : c11; } else { a00 = c00; a01 = c01; a10 = c10; a11 = c11; }
            const char* b2 = last ? nB : cB + (size_t)(t + 2) * kstep; const char* b3 = b2 + kstep;
            FX_LDB(B0, 0, 0); FX_SCHED; FX_LDA(At, 0, 0); if (!(FX_SEAM && seamed && t == 0)) FX_STAGE_A(FX_SA(1, 1), c10, c11, k1);
            FX_WAIT_L(8); FX_BAR; FX_WAIT_L(0); FX_MMA(0, 0, At, B0); FX_BAR; FX_SCHED;
            FX_LDB(B1, 0, 1); FX_STAGE_B(FX_SB(0, 0), b2);
            FX_BAR; FX_WAIT_L(0); FX_MMA(0, 1, At, B1); FX_BAR;
            FX_LDA(At, 0, 1); FX_STAGE_A(FX_SA(0, 0), a00, a01, k2);
            FX_BAR; FX_WAIT_L(0); FX_MMA(1, 0, At, B0); FX_BAR; FX_SCHED;
            FX_STAGE_B(FX_SB(0, 1), b2 + hstepB);
            if (FX_SEAM && seamed && t == 0) asm volatile("s_waitcnt vmcnt(%0)" :: "n"(6 + Epi::NST) : "memory");
            else FX_WAIT_V(6);
            FX_BAR; FX_MMA(1, 1, At, B1); FX_BAR;
            FX_LDB(B0, 1, 0); FX_SCHED; FX_LDA(At, 1, 0); FX_STAGE_A(FX_SA(0, 1), a10, a11, k2);
            FX_WAIT_L(8); FX_BAR; FX_WAIT_L(0); FX_MMA(0, 0, At, B0); FX_BAR; FX_SCHED;
            FX_LDB(B1, 1, 1); FX_STAGE_B(FX_SB(1, 0), b3);
            FX_BAR; FX_WAIT_L(0); FX_MMA(0, 1, At, B1); FX_BAR;
            FX_LDA(At, 1, 1); FX_STAGE_A(FX_SA(1, 0), a00, a01, k3);
            FX_BAR; FX_WAIT_L(0); FX_MMA(1, 0, At, B0); FX_BAR; FX_SCHED;
            FX_STAGE_B(FX_SB(1, 1), b3 + hstepB);
            FX_WAIT_V(6); FX_BAR; FX_MMA(1, 1, At, B1); FX_BAR;
        }
#if FX_SEAM
        const bool seam_now = has_next && !noepi;
        if (seam_now) { if constexpr (Sched::GATHER) FX_STAGE_A(FX_SA(1, 1), n10, n11, (size_t)kstep); else FX_STAGE_A(FX_SA(1, 1), c10, c11, ubn + (size_t)kstep); }
#endif
#if FX_WARM
        if constexpr (Sched::WARM2 && FP8) {
            Unit w2; if (S.next(ui + 2, w2)) {
                int tw_ = tid; asm volatile("" : "+v"(tw_)); const int wrow = tw_ >> 1, wl = (tw_ & 1) * 256;
                FX_LAS unsigned* scr = (FX_LAS unsigned*)(lds + STAGE_BYTES + 2048) + wid * 64;
                const char* pa = Abase + S.a_unit_base(w2) + S.a_lane_off(wrow) + wl; const char* pb = S.b_ptr(w2) + (size_t)wrow * K * ES + wl;
                __builtin_amdgcn_global_load_lds((const unsigned*)pa, scr, 4, 0, 0); __builtin_amdgcn_global_load_lds((const unsigned*)(pa + 128), scr, 4, 0, 0);
                __builtin_amdgcn_global_load_lds((const unsigned*)pb, scr, 4, 0, 0); __builtin_amdgcn_global_load_lds((const unsigned*)(pb + 128), scr, 4, 0, 0); } }
#endif
        if constexpr (FP8) asm volatile("s_nop 15\n\ts_nop 15\n\ts_nop 15\n\ts_nop 15" ::: "memory");
        if constexpr (F32M) { int ln_e = lane; asm volatile("" : "+v"(ln_e)); E.e32(acc3, cur, wr, wc, ln_e); }
        else if (noepi) { f32x4 s_ = (f32x4){0.f, 0.f, 0.f, 0.f};
#pragma unroll
            for (int q_ = 0; q_ < 32; ++q_) s_ += acc[q_ >> 4][(q_ >> 3) & 1][(q_ >> 1) & 3][q_ & 1];
            if (s_[0] + s_[1] + s_[2] + s_[3] == 1.2345e-30f) *(float*)const_cast<char*>(Abase) = s_[0]; }
        else { int fr_e = fr, fq_e = fq; asm volatile("" : "+v"(fr_e), "+v"(fq_e)); E(acc, cur, wr, wc, fr_e, fq_e); }
        if (!has_next) break;
        if constexpr (F32M) { _Pragma("unroll") for (int q = 0; q < 8; ++q) acc3[q >> 2][(q >> 1) & 1][q & 1] = f32x16{}; }
#pragma unroll
        for (int a = 0; a < 2; ++a)
#pragma unroll
            for (int b = 0; b < 2; ++b)
#pragma unroll
                for (int m = 0; m < 4; ++m)
#pragma unroll
                    for (int n = 0; n < 2; ++n) acc[a][b][m][n] = (f32x4){0.f, 0.f, 0.f, 0.f};
        cur = nxt; cB = nB; if constexpr (Sched::GATHER) { c00 = n00; c01 = n01; c10 = n10; c11 = n11; } else ubc = ubn; ++ui;
#if FX_SEAM
        seamed = seam_now;
#endif
    }
    FX_WAIT_V(0);
    if (wr == 0) FX_BAR;
    FX_BAR;
}

#ifndef FX_WARM
#define FX_WARM 0
#endif
#ifndef FX_EPILDS
#define FX_EPILDS 1
#endif
#ifndef FX_NTST
#define FX_NTST 0
#endif
#if FX_NTST
#define FX_EPI_ST(TY, p, v) __builtin_nontemporal_store((v), (TY*)(p))
#else
#define FX_EPI_ST(TY, p, v) (*(TY*)(p) = (v))
#endif
constexpr int EPI_LDS_OFF = STAGE_BYTES + 8192 + 64, EPI_LDS_BYTES = 8 * 2304;
struct EpiBf16 {
    static constexpr bool PERM = true; static constexpr int NST = FX_EPILDS == 1 ? 16 : 0;
    bf16_t* O; float* gates; int ldc; float scale; FX_LAS unsigned char* es;
    __device__ __forceinline__ void operator()(const f32x4 (&acc)[2][2][4][2], const Unit& u, int wr, int wc, int fr, int fq) const {
        const int row0 = u.pm * BM + wr * 64 + fr, col0 = u.pn * BM + wc * 32 + 8 * fq;
#if FX_EPILDS
        if (FX_EPILDS == 1 || (FX_EPILDS == 2 && gates == nullptr && ldc == 2048) || (FX_EPILDS == 3 && gates != nullptr) || (FX_EPILDS == 4 && ldc == 1536)) {
        FX_LAS unsigned char* my = es + (wr * 4 + wc) * 2304;
        const int lane = fq * 16 + fr, rrow = lane >> 2, rch = lane & 3;
#pragma unroll
        for (int ai = 0; ai < 2; ++ai)
#pragma unroll
            for (int m = 0; m < 4; ++m) { FX_LAS unsigned char* buf = my;
#pragma unroll
                for (int bj = 0; bj < 2; ++bj) { const f32x4 v0 = acc[ai][bj][m][0] * scale, v1 = acc[ai][bj][m][1] * scale;
                    u32x4 w; w.x = cvt_pk_bf16(v0[0], v0[1]); w.y = cvt_pk_bf16(v0[2], v0[3]); w.z = cvt_pk_bf16(v1[0], v1[1]); w.w = cvt_pk_bf16(v1[2], v1[3]);
                    *(FX_LAS u32x4*)(buf + fr * 144 + bj * 64 + fq * 16) = w; }
                const int row = u.pm * BM + wr * 64 + ai * HALF + m * 16 + rrow; bf16_t* rowp = O + (size_t)row * ldc + u.pn * BM + wc * 32 + rch * 8;
#pragma unroll
                for (int q = 0; q < 2; ++q) { const u32x4 w = *(const FX_LAS u32x4*)(buf + rrow * 144 + q * 64 + rch * 16); *(u32x4*)(rowp + q * HALF) = w; }
                if (gates && u.pn == 15 && wc == 2 && fq < 2) { float* g = gates + (size_t)(row0 + ai * HALF + m * 16) * 16 + 8 * fq; *(f32x4*)g = acc[ai][1][m][0] * scale; *(f32x4*)(g + 4) = acc[ai][1][m][1] * scale; } }
        (void)col0; return; }
#endif
        {
#pragma unroll
        for (int ai = 0; ai < 2; ++ai)
#pragma unroll
            for (int m = 0; m < 4; ++m) { const int row = row0 + ai * HALF + m * 16; bf16_t* rowp = O + (size_t)row * ldc + col0;
#pragma unroll
                for (int bj = 0; bj < 2; ++bj) { const f32x4 v0 = acc[ai][bj][m][0] * scale, v1 = acc[ai][bj][m][1] * scale;
                    u32x4 w; w.x = cvt_pk_bf16(v0[0], v0[1]); w.y = cvt_pk_bf16(v0[2], v0[3]); w.z = cvt_pk_bf16(v1[0], v1[1]); w.w = cvt_pk_bf16(v1[2], v1[3]);
                    FX_EPI_ST(u32x4, rowp + bj * HALF, w); }
                if (gates && u.pn == 15 && wc == 2 && fq < 2) { float* g = gates + (size_t)row * 16 + 8 * fq; *(f32x4*)g = acc[ai][1][m][0] * scale; *(f32x4*)(g + 4) = acc[ai][1][m][1] * scale; } }
        }
    }
    __device__ __forceinline__ void e32(const f32x16 (&acc3)[2][2][2], const Unit& u, int wr, int wc, int lane) const {
        const int j = lane & 31, hi = lane >> 5;
#pragma unroll
        for (int ai = 0; ai < 2; ++ai)
#pragma unroll
            for (int mb = 0; mb < 2; ++mb) { const int row = u.pm * BM + ai * HALF + wr * 64 + mb * 32 + j;
#pragma unroll
                for (int bj = 0; bj < 2; ++bj) { bf16_t* rowp = O + (size_t)row * ldc + u.pn * BM + bj * HALF + wc * 32 + 4 * hi;
#pragma unroll
                    for (int g = 0; g < 4; ++g) { u32x2 w; w.x = cvt_pk_bf16(acc3[ai][bj][mb][4 * g] * scale, acc3[ai][bj][mb][4 * g + 1] * scale); w.y = cvt_pk_bf16(acc3[ai][bj][mb][4 * g + 2] * scale, acc3[ai][bj][mb][4 * g + 3] * scale);
                        *(u32x2*)(rowp + 8 * g) = w; } }
                if (gates && u.pn == 15 && wc == 2) { float* gp = gates + (size_t)row * 16 + 4 * hi;
#pragma unroll
                    for (int g = 0; g < 2; ++g) *(f32x4*)(gp + 8 * g) = (f32x4){acc3[ai][1][mb][4 * g] * scale, acc3[ai][1][mb][4 * g + 1] * scale, acc3[ai][1][mb][4 * g + 2] * scale, acc3[ai][1][mb][4 * g + 3] * scale}; } }
    }
};
}
#ifndef FX_HOTA
#define FX_HOTA 0
#endif
#ifndef FX_RUNR
#define FX_RUNR 16
#endif
namespace fx {
constexpr int RT = 16;
constexpr int H2S_LD = 2052;
constexpr int P7_LDS = RT * H2S_LD * 4 + 512;
constexpr int PTOT = 131072;
constexpr int NTILE_MAX = PTOT / 256;

__device__ __forceinline__ void coef_phase(const float* mod, const float* pre_mix_gain, const float* post_mix_gain, const float* pre_ffn_gain, const float* post_ffn_gain, float* coef, int gtid, int nthr) {
    for (int i = gtid; i < 2 * 4 * 2048; i += nthr) { const int d = i & 2047, b = (i >> 11) & 3, l = i >> 13;
        const float* m = mod + ((size_t)l * 4 + b) * 12288; float* c = coef + ((size_t)l * 4 + b) * 6 * 2048;
        c[0 * 2048 + d] = m[2 * 2048 + d] * post_mix_gain[l * 2048 + d];
        c[1 * 2048 + d] = pre_ffn_gain[l * 2048 + d] * (1.f + m[4 * 2048 + d]);
        c[2 * 2048 + d] = m[3 * 2048 + d];
        c[3 * 2048 + d] = m[5 * 2048 + d] * post_ffn_gain[l * 2048 + d];
        c[4 * 2048 + d] = pre_mix_gain[l * 2048 + d] * (1.f + m[1 * 2048 + d]);
        c[5 * 2048 + d] = m[0 * 2048 + d]; }
}

template <bool XBF>
__device__ __forceinline__ void p7_phase(FX_LAS unsigned char* lds, const void* xin_, const bf16_t* Y, const float* coef_l  , const float* router_w, const float* router_bias,
                                         bf16_t* XRES, unsigned char* HA8, int* SELE, float* SELG, int* CNT, int* WGBASE, int wg, int nwg, int tidp) {
    int tid_ = tidp; asm volatile("" : "+v"(tid_));
    const int tid = tid_, wid = tid >> 6, lane = tid & 63;
    FX_LAS float* h2s = (FX_LAS float*)lds;
    FX_LAS int* hist = (FX_LAS int*)(lds + RT * H2S_LD * 4);
    if (tid < 64) hist[tid] = 0;
    __syncthreads();
#define FX_GC(TY, p) ((const __attribute__((address_space(1))) TY*)(p))
#define FX_GM(TY, p) ((__attribute__((address_space(1))) TY*)(p))
    const int i16 = lane & 15, g4 = lane >> 4;
    for (int unit = wg; unit < T / RT; unit += nwg) {
        {
            const int tok0 = 2 * wid, t0 = unit * RT + tok0, b = t0 / S;
            const float* cf = coef_l + (size_t)b * 6 * 2048;
            u32x4 yw[2][4]; f32x4 ca[8];
            float xv[2][32];
#pragma unroll
            for (int tt = 0; tt < 2; ++tt)
#pragma unroll
                for (int i = 0; i < 4; ++i) yw[tt][i] = *FX_GC(u32x4, Y + (size_t)(t0 + tt) * 2048 + i * 512 + lane * 8);
            if constexpr (XBF) {
                u32x4 xw[2][4];
#pragma unroll
                for (int tt = 0; tt < 2; ++tt)
#pragma unroll
                    for (int i = 0; i < 4; ++i) xw[tt][i] = *FX_GC(u32x4, (const bf16_t*)xin_ + (size_t)(t0 + tt) * 2048 + i * 512 + lane * 8);
#pragma unroll
                for (int i = 0; i < 4; ++i) { ca[2 * i] = *FX_GC(f32x4, cf + i * 512 + lane * 8); ca[2 * i + 1] = *FX_GC(f32x4, cf + i * 512 + lane * 8 + 4); }
#pragma unroll
                for (int tt = 0; tt < 2; ++tt)
#pragma unroll
                    for (int i = 0; i < 4; ++i) { const u32x4 w = xw[tt][i];
                        xv[tt][i * 8 + 0] = bflo(w.x); xv[tt][i * 8 + 1] = bfhi(w.x); xv[tt][i * 8 + 2] = bflo(w.y); xv[tt][i * 8 + 3] = bfhi(w.y); xv[tt][i * 8 + 4] = bflo(w.z); xv[tt][i * 8 + 5] = bfhi(w.z); xv[tt][i * 8 + 6] = bflo(w.w); xv[tt][i * 8 + 7] = bfhi(w.w); }
            } else {
                const float* xin = (const float*)xin_;
#pragma unroll
                for (int tt = 0; tt < 2; ++tt)
#pragma unroll
                    for (int i = 0; i < 4; ++i) { const f32x4 x0 = *FX_GC(f32x4, xin + (size_t)(t0 + tt) * 2048 + i * 512 + lane * 8), x1 = *FX_GC(f32x4, xin + (size_t)(t0 + tt) * 2048 + i * 512 + lane * 8 + 4);
                        xv[tt][i * 8 + 0] = x0[0]; xv[tt][i * 8 + 1] = x0[1]; xv[tt][i * 8 + 2] = x0[2]; xv[tt][i * 8 + 3] = x0[3]; xv[tt][i * 8 + 4] = x1[0]; xv[tt][i * 8 + 5] = x1[1]; xv[tt][i * 8 + 6] = x1[2]; xv[tt][i * 8 + 7] = x1[3]; }
#pragma unroll
                for (int i = 0; i < 4; ++i) { ca[2 * i] = *FX_GC(f32x4, cf + i * 512 + lane * 8); ca[2 * i + 1] = *FX_GC(f32x4, cf + i * 512 + lane * 8 + 4); }
            }
            float ssy0 = 0.f, ssy1 = 0.f;
#pragma unroll
            for (int i = 0; i < 4; ++i) { const u32x4 w0 = yw[0][i], w1 = yw[1][i];
#pragma unroll
                for (int q = 0; q < 4; ++q) { const float l0 = bflo(w0[q]), h0 = bfhi(w0[q]), l1 = bflo(w1[q]), h1 = bfhi(w1[q]); ssy0 += l0 * l0 + h0 * h0; ssy1 += l1 * l1 + h1 * h1; } }
            ssy0 = wave_sum(ssy0); ssy1 = wave_sum(ssy1);
            const float ry0 = rsqrtf(ssy0 * (1.f / 2048.f) + EPS), ry1 = rsqrtf(ssy1 * (1.f / 2048.f) + EPS);
            float ssx0 = 0.f, ssx1 = 0.f;
#pragma unroll
            for (int i = 0; i < 4; ++i) { const u32x4 w0 = yw[0][i], w1 = yw[1][i];
#pragma unroll
                for (int j = 0; j < 8; ++j) { const float a = ca[2 * i + (j >> 2)][j & 3];
                    const float y0 = (j & 1) ? bfhi(w0[j >> 1]) : bflo(w0[j >> 1]), y1 = (j & 1) ? bfhi(w1[j >> 1]) : bflo(w1[j >> 1]);
                    xv[0][i * 8 + j] += a * (y0 * ry0); xv[1][i * 8 + j] += a * (y1 * ry1);
                    ssx0 += xv[0][i * 8 + j] * xv[0][i * 8 + j]; ssx1 += xv[1][i * 8 + j] * xv[1][i * 8 + j]; } }
            f32x4 cb[8], cc[8];
#pragma unroll
            for (int i = 0; i < 4; ++i) { cb[2 * i] = *FX_GC(f32x4, cf + 2048 + i * 512 + lane * 8); cb[2 * i + 1] = *FX_GC(f32x4, cf + 2048 + i * 512 + lane * 8 + 4);
                cc[2 * i] = *FX_GC(f32x4, cf + 4096 + i * 512 + lane * 8); cc[2 * i + 1] = *FX_GC(f32x4, cf + 4096 + i * 512 + lane * 8 + 4); }
#pragma unroll
            for (int tt = 0; tt < 2; ++tt)
#pragma unroll
                for (int i = 0; i < 4; ++i) { u32x4 xo; xo.x = cvt_pk_bf16(xv[tt][i * 8 + 0], xv[tt][i * 8 + 1]); xo.y = cvt_pk_bf16(xv[tt][i * 8 + 2], xv[tt][i * 8 + 3]); xo.z = cvt_pk_bf16(xv[tt][i * 8 + 4], xv[tt][i * 8 + 5]); xo.w = cvt_pk_bf16(xv[tt][i * 8 + 6], xv[tt][i * 8 + 7]);
                    *FX_GM(u32x4, XRES + (size_t)(t0 + tt) * 2048 + i * 512 + lane * 8) = xo; }
            ssx0 = wave_sum(ssx0); ssx1 = wave_sum(ssx1);
            const float rx0 = rsqrtf(ssx0 * (1.f / 2048.f) + EPS), rx1 = rsqrtf(ssx1 * (1.f / 2048.f) + EPS);
#pragma unroll
            for (int tt = 0; tt < 2; ++tt) { const float rx = tt ? rx1 : rx0;
#pragma unroll
                for (int i = 0; i < 4; ++i) { const int c = i * 512 + lane * 8;
                    float hv[8];
#pragma unroll
                    for (int j = 0; j < 8; ++j) hv[j] = xv[tt][i * 8 + j] * rx * cb[2 * i + (j >> 2)][j & 3] + cc[2 * i + (j >> 2)][j & 3];
                    u32x2 w; w.x = cvt_pk4_fp8(hv[0], hv[1], hv[2], hv[3]); w.y = cvt_pk4_fp8(hv[4], hv[5], hv[6], hv[7]);
                    *FX_GM(u32x2, HA8 + (size_t)(t0 + tt) * 2048 + c) = w;
                    *(FX_LAS f32x4*)(h2s + (tok0 + tt) * H2S_LD + c) = (f32x4){hv[0], hv[1], hv[2], hv[3]};
                    *(FX_LAS f32x4*)(h2s + (tok0 + tt) * H2S_LD + c + 4) = (f32x4){hv[4], hv[5], hv[6], hv[7]}; } }
        }
        f32x4 acc[4];
#pragma unroll
        for (int j = 0; j < 4; ++j) acc[j] = (f32x4){0.f, 0.f, 0.f, 0.f};
        {
            const char* rwb = (const char*)router_w + (size_t)__builtin_amdgcn_readfirstlane(wid) * (256 * 64 * 4);
            const unsigned loff = (unsigned)(g4 * 64 + 4 * i16) * 4u;
            f32x4 bwA[8], bwB[8];
            { unsigned o_ = loff; asm volatile("" : "+v"(o_));
#pragma unroll
              for (int q = 0; q < 8; ++q) bwA[q] = *FX_GC(f32x4, rwb + o_ + q * 1024); }
            __syncthreads();
#pragma unroll
            for (int kb = 0; kb < 8; ++kb) {
                if (kb < 7) { unsigned o_ = loff + (kb + 1) * 8192; asm volatile("" : "+v"(o_));
#pragma unroll
                    for (int q = 0; q < 8; ++q) { const f32x4 v = *FX_GC(f32x4, rwb + o_ + q * 1024); if (kb & 1) bwA[q] = v; else bwB[q] = v; } }
#pragma unroll
                for (int q = 0; q < 8; ++q) { const int k = 256 * wid + 4 * (kb * 8 + q) + g4;
                    const float a = h2s[i16 * H2S_LD + k]; const f32x4 bw = (kb & 1) ? bwB[q] : bwA[q];
                    acc[0] = __builtin_amdgcn_mfma_f32_16x16x4f32(a, bw[0], acc[0], 0, 0, 0);
                    acc[1] = __builtin_amdgcn_mfma_f32_16x16x4f32(a, bw[1], acc[1], 0, 0, 0);
                    acc[2] = __builtin_amdgcn_mfma_f32_16x16x4f32(a, bw[2], acc[2], 0, 0, 0);
                    acc[3] = __builtin_amdgcn_mfma_f32_16x16x4f32(a, bw[3], acc[3], 0, 0, 0); } }
        }
        __syncthreads();
        { FX_LAS float* part = h2s; const int i16 = lane & 15, g = lane >> 4;
#pragma unroll
          for (int j = 0; j < 4; ++j)
#pragma unroll
            for (int r = 0; r < 4; ++r) part[(wid * 16 + 4 * g + r) * 64 + 4 * i16 + j] = acc[j][r]; }
        __syncthreads();
#pragma unroll 1
        for (int tt = 0; tt < 2; ++tt) {
            const int tok = 2 * wid + tt, t = unit * RT + tok;
            float lg = 0.f;
#pragma unroll
            for (int w = 0; w < 8; ++w) lg += h2s[(w * 16 + tok) * 64 + lane];
            const float score = 1.f / (1.f + expf(-lg));
            float v = score + router_bias[lane];
            int my_e = 0; float my_s = 0.f, sum = 0.f;
#pragma unroll
            for (int k = 0; k < 6; ++k) {
                const float m = wave_max(v);
                const unsigned long long bal = __ballot(v == m);
                const int win = __ffsll((long long)bal) - 1;
                const float sw = __builtin_bit_cast(float, __builtin_amdgcn_readlane(__builtin_bit_cast(int, score), win));
                sum += sw; if (lane == k) { my_e = win; my_s = sw; }
                if (lane == win) v = -3.0e38f;
            }
            if (lane < 6) { SELE[(size_t)t * 6 + lane] = my_e; SELG[(size_t)t * 6 + lane] = my_s / sum * 2.5f; __hip_atomic_fetch_add(hist + my_e, 1, __ATOMIC_RELAXED, __HIP_MEMORY_SCOPE_WORKGROUP); }
        }
        __syncthreads();
    }
    { int te = tid; asm volatile("" : "+v"(te));
      if (te < 64) { const int hv = hist[te]; const int base = atomicAdd(CNT + te, hv); WGBASE[wg * 64 + te] = base; } }
}

__device__ __forceinline__ void p8_phase(FX_LAS unsigned char* lds, const int* SELE, const float* SELG, const int* CNT, const int* WGBASE, int* ROWTOK, float* ROWG, int* SLOT, int wg, int nwg, int tidp) {
    int tid_ = tidp; asm volatile("" : "+v"(tid_));
    const int tid = tid_;
    FX_LAS int* pstart = (FX_LAS int*)lds; FX_LAS int* off = pstart + 80;
    const int u4 = tid / 96, r96 = tid - u4 * 96;
    int unit = wg + u4 * nwg; bool act = u4 < 4 && unit < T / RT;
    int t = 0, k = 0, e = 0; float g = 0.f;
    if (act) { t = unit * RT + r96 / 6; k = r96 % 6; e = SELE[(size_t)t * 6 + k]; g = SELG[(size_t)t * 6 + k]; }
    int wb = 0;
    if (tid < 64) { wb = WGBASE[wg * 64 + tid]; const int pc = (CNT[tid] + 255) & ~255; int incl = pc;
#pragma unroll
        for (int o = 1; o < 64; o <<= 1) { const int t2 = __shfl_up(incl, o); if (tid >= o) incl += t2; }
        pstart[tid] = 16384 + incl - pc; if (tid == 63) pstart[64] = 16384 + incl; off[tid] = 16384 + incl - pc + wb; }
    __syncthreads();
    for (;;) {
        if (act) { const int pos = __hip_atomic_fetch_add(off + e, 1, __ATOMIC_RELAXED, __HIP_MEMORY_SCOPE_WORKGROUP);
            ROWTOK[pos] = t; ROWG[pos] = g; SLOT[(size_t)t * 6 + k] = pos; }
        unit += 4 * nwg; if (wg + 4 * nwg >= T / RT || unit - u4 * nwg >= T / RT) break;
        act = u4 < 4 && unit < T / RT;
        if (act) { t = unit * RT + r96 / 6; k = r96 % 6; e = SELE[(size_t)t * 6 + k]; g = SELG[(size_t)t * 6 + k]; }
    }
    for (int e = wg; e < 64; e += nwg) { const int a = pstart[e] + CNT[e], b = pstart[e + 1]; for (int r = a + tid; r < b; r += 512) { ROWTOK[r] = 0; ROWG[r] = 0.f; } }
    for (int r = wg * 512 + tid; r < 16384; r += nwg * 512) { ROWTOK[r] = r; ROWG[r] = 1.f; }
}

template <bool RT_> struct MoeSchedT {
    static constexpr bool GATHER = RT_, WARM2 = !RT_;
    FX_LAS const unsigned char* tile_e; int ntiles, npn, nunits, G, c;
    const int* rowtok; int lda_b; const char* Bt; size_t estride_b, pnstride_b;
    __device__ __forceinline__ bool next(int i, Unit& u) const {
        const long L = (long)i * G + c; if (L >= nunits) return false;
        int id = (int)L; { const int q = nunits / NXCD, r = nunits % NXCD, xcd = id % NXCD, off = id / NXCD; id = (xcd < r ? xcd * (q + 1) : r * (q + 1) + (xcd - r) * q) + off; }
        u.pm = id / npn; u.pn = id - u.pm * npn; u.e = tile_e[u.pm]; return true;
    }
    __device__ __forceinline__ unsigned a_row_off(const Unit& u, int R) const { return a_row_raw(u, R) * (unsigned)lda_b; }
    __device__ __forceinline__ unsigned a_row_raw(const Unit& u, int R) const { const int row = u.pm * BM + R; if constexpr (RT_) return (unsigned)rowtok[row]; else return (unsigned)row; }
    __device__ __forceinline__ unsigned a_row_scale(unsigned raw) const { return raw * (unsigned)lda_b; }
    int hotA = 0;
    __device__ __forceinline__ size_t a_unit_base(const Unit& u) const { return (size_t)(hotA ? (u.pm & 3) : u.pm) * BM * (size_t)lda_b; }
    __device__ __forceinline__ unsigned a_lane_off(int R) const { return (unsigned)R * (unsigned)lda_b; }
    int hotB = 0;
    __device__ __forceinline__ const char* b_ptr(const Unit& u) const { return Bt + (size_t)(hotB ? (u.e & 1) : u.e) * estride_b + (size_t)u.pn * pnstride_b; }
};
__device__ __forceinline__ int moe_sched_build(FX_LAS unsigned char* tab, const int* CNT, int tidp) {
    FX_LAS int* nt = (FX_LAS int*)(tab + 512);
    int tid_ = tidp; asm volatile("" : "+v"(tid_));
    if (tid_ < 64) { const int n = (CNT[tid_] + 255) >> 8; int incl = n;
#pragma unroll
        for (int o = 1; o < 64; o <<= 1) { const int t2 = __shfl_up(incl, o); if (tid_ >= o) incl += t2; }
        const int st0 = 64 + incl - n; for (int j = 0; j < n; ++j) tab[st0 + j] = (unsigned char)tid_;
        tab[tid_] = 64; if (tid_ == 63) nt[0] = 64 + incl; }
    __syncthreads();
    return nt[0];
}
struct EpiGateUp {
    static constexpr bool PERM = true; static constexpr int NST = 4;
    unsigned char* HID; FX_LAS unsigned char* es;
    __device__ __forceinline__ void operator()(const f32x4 (&acc)[2][2][4][2], const Unit& u, int wr, int wc, int fr, int fq) const {
        FX_LAS unsigned char* buf = es + (wr * 4 + wc) * 2304;
        const int lane = fq * 16 + fr, rr = lane >> 1, rch = lane & 1;
#pragma unroll
        for (int ai = 0; ai < 2; ++ai)
#pragma unroll
            for (int p = 0; p < 2; ++p) {
#pragma unroll
                for (int mm = 0; mm < 2; ++mm) { const int m = 2 * p + mm;
                    float o[8];
#pragma unroll
                    for (int n = 0; n < 2; ++n)
#pragma unroll
                        for (int j = 0; j < 4; ++j) { const float g = acc[ai][0][m][n][j] * W8_INV, up = acc[ai][1][m][n][j] * W8_INV; o[n * 4 + j] = g * __builtin_amdgcn_rcpf(1.f + __expf(-g)) * up; }
                    u32x2 w; w.x = cvt_pk4_fp8(o[0], o[1], o[2], o[3]); w.y = cvt_pk4_fp8(o[4], o[5], o[6], o[7]);
                    *(FX_LAS u32x2*)(buf + (mm * 16 + fr) * 48 + fq * 8) = w; }
                const u32x4 v = *(const FX_LAS u32x4*)(buf + rr * 48 + rch * 16);
                const int row = u.pm * BM + wr * 64 + ai * HALF + (2 * p + (rr >> 4)) * 16 + (rr & 15);
                *(u32x4*)(HID + (size_t)row * 512 + u.pn * 128 + wc * 32 + rch * 16) = v; }
    }
    __device__ __forceinline__ void e32(const f32x16 (&acc3)[2][2][2], const Unit& u, int wr, int wc, int lane) const {
        const int j = lane & 31, hi = lane >> 5;
#pragma unroll
        for (int ai = 0; ai < 2; ++ai)
#pragma unroll
            for (int mb = 0; mb < 2; ++mb) { const int row = u.pm * BM + ai * HALF + wr * 64 + mb * 32 + j; unsigned char* rowp = HID + (size_t)row * 512 + u.pn * 128 + wc * 32 + 4 * hi;
#pragma unroll
                for (int g = 0; g < 4; ++g) { float o[4];
#pragma unroll
                    for (int q = 0; q < 4; ++q) { const float gt = acc3[ai][0][mb][4 * g + q] * W8_INV, up = acc3[ai][1][mb][4 * g + q] * W8_INV; o[q] = gt * __builtin_amdgcn_rcpf(1.f + __expf(-gt)) * up; }
                    *(unsigned*)(rowp + 8 * g) = cvt_pk4_fp8(o[0], o[1], o[2], o[3]); } }
    }
};
struct EpiDown {
    static constexpr bool PERM = true; static constexpr int NST = 8;
    unsigned char* YR; const float* ROWG; int nostore; FX_LAS unsigned char* es;
    __device__ __forceinline__ void operator()(const f32x4 (&acc)[2][2][4][2], const Unit& u, int wr, int wc, int fr, int fq) const {
        FX_LAS unsigned char* buf = es + (wr * 4 + wc) * 2304;
        const int lane = fq * 16 + fr, rrow = lane >> 2, rch = lane & 3;
#pragma unroll
        for (int ai = 0; ai < 2; ++ai)
#pragma unroll
            for (int m = 0; m < 4; ++m) { const float g = W8_INV;
#pragma unroll
                for (int bj = 0; bj < 2; ++bj) { const f32x4 v0 = acc[ai][bj][m][0] * g, v1 = acc[ai][bj][m][1] * g;
                    u32x2 w; w.x = cvt_pk4_fp8(v0[0], v0[1], v0[2], v0[3]); w.y = cvt_pk4_fp8(v1[0], v1[1], v1[2], v1[3]);
                    *(FX_LAS u32x2*)(buf + fr * 80 + bj * 32 + fq * 8) = w; }
                const u32x4 v = *(const FX_LAS u32x4*)(buf + rrow * 80 + rch * 16);
                const int row = u.pm * BM + wr * 64 + ai * HALF + m * 16 + rrow;
                *(u32x4*)(YR + (size_t)row * 2048 + u.pn * BM + (rch >> 1) * HALF + wc * 32 + (rch & 1) * 16) = v; }
    }
    __device__ __forceinline__ void e32(const f32x16 (&acc3)[2][2][2], const Unit& u, int wr, int wc, int lane) const {
        const int j = lane & 31, hi = lane >> 5;
#pragma unroll
        for (int ai = 0; ai < 2; ++ai)
#pragma unroll
            for (int mb = 0; mb < 2; ++mb) { const int row = u.pm * BM + ai * HALF + wr * 64 + mb * 32 + j; const float gsc = ROWG[row] * W8_INV;
#pragma unroll
                for (int bj = 0; bj < 2; ++bj) { unsigned char* rowp = YR + (size_t)row * 2048 + u.pn * BM + bj * HALF + wc * 32 + 4 * hi;
#pragma unroll
                    for (int g = 0; g < 4; ++g) *(unsigned*)(rowp + 8 * g) = cvt_pk4_fp8(acc3[ai][bj][mb][4 * g] * gsc, acc3[ai][bj][mb][4 * g + 1] * gsc, acc3[ai][bj][mb][4 * g + 2] * gsc, acc3[ai][bj][mb][4 * g + 3] * gsc); } }
    }
};
__device__ __forceinline__ void p9_phase(FX_LAS unsigned char* lds, const unsigned char* HA, const unsigned char* WGU, const int* CNT, const int* ROWTOK, unsigned char* HID, int wg, int nwg, int tidp, const int noepi = 0) {
    FX_LAS unsigned char* tab = lds + STAGE_BYTES;
    const int ntiles = moe_sched_build(tab, CNT, tidp);
    MoeSchedT<true> Sc; Sc.tile_e = tab; Sc.ntiles = ntiles; Sc.npn = 4; Sc.nunits = ntiles * 4; Sc.G = nwg; Sc.c = wg; Sc.rowtok = ROWTOK; Sc.lda_b = 2048; Sc.Bt = (const char*)WGU; Sc.estride_b = (size_t)1024 * 2048; Sc.pnstride_b = (size_t)256 * 2048;
    EpiGateUp E; E.HID = HID; E.es = lds + EPI_LDS_OFF;
    gemm_phase<EpiGateUp, MoeSchedT<true>, true>(lds, (const char*)HA, 2048, Sc, E, tidp, noepi);
}
__device__ __forceinline__ void p10_phase(FX_LAS unsigned char* lds, const unsigned char* HID, const unsigned char* WDN, const int* CNT, const float* ROWG, unsigned char* YR, int wg, int nwg, int tidp, const int noepi = 0) {
    FX_LAS unsigned char* tab = lds + STAGE_BYTES;
    const int ntiles = moe_sched_build(tab, CNT, tidp);
    MoeSchedT<false> Sc; Sc.tile_e = tab; Sc.ntiles = ntiles; Sc.npn = 8; Sc.nunits = ntiles * 8; Sc.G = nwg; Sc.c = wg; Sc.rowtok = nullptr; Sc.lda_b = 512; Sc.Bt = (const char*)WDN; Sc.estride_b = (size_t)2048 * 512; Sc.pnstride_b = (size_t)256 * 512;
    EpiDown E; E.YR = YR; E.ROWG = ROWG; E.nostore = 0; E.es = lds + EPI_LDS_OFF; Sc.hotA = (FX_HOTA == 1 && noepi == 1) ? 1 : 0; Sc.hotB = (FX_HOTA == 2 && noepi == 1) ? 1 : 0;
    if (FX_HOTA == 3 && noepi == 1) { Sc.lda_b = 128; gemm_phase<EpiDown, MoeSchedT<false>, true>(lds, (const char*)HID, 512, Sc, E, tidp, 3); return; }
    gemm_phase<EpiDown, MoeSchedT<false>, true>(lds, (const char*)HID, 512, Sc, E, tidp, noepi == 1);
}
template <bool OUTF32>
__device__ __forceinline__ void p11_phase(const bf16_t* x1, const unsigned char* YR, const int* SLOT, const float* SELG, const float* coef_l, const float* coef_next  , void* xout_, bf16_t* HA, int wg, int nwg, int tidp) {
    int tid_ = tidp; asm volatile("" : "+v"(tid_));
    const int wid = __builtin_amdgcn_readfirstlane(tid_ >> 6), lane = tid_ & 63;
    for (int t = wg * 8 + wid; t < T; t += nwg * 8) {
        const int b = t / S; const float* cf = coef_l + (size_t)b * 6 * 2048;
        int rows[7]; rows[0] = t;
        float gk[7]; gk[0] = 1.f;
        { int sl[6]; float sg[6];
#pragma unroll
          for (int k = 0; k < 6; ++k) { sl[k] = *FX_GC(int, SLOT + (size_t)t * 6 + k); sg[k] = *FX_GC(float, SELG + (size_t)t * 6 + k); }
#pragma unroll
          for (int k = 0; k < 6; ++k) { rows[k + 1] = __builtin_amdgcn_readfirstlane(sl[k]); gk[k + 1] = __builtin_bit_cast(float, __builtin_amdgcn_readfirstlane(__builtin_bit_cast(int, sg[k]))); } }
        u32x2 ra[4][4];
#pragma unroll
        for (int k = 0; k < 4; ++k)
#pragma unroll
            for (int i = 0; i < 4; ++i) ra[k][i] = *FX_GC(u32x2, YR + (size_t)rows[k] * 2048 + i * 512 + lane * 8);
        u32x4 xw[4];
#pragma unroll
        for (int i = 0; i < 4; ++i) xw[i] = *FX_GC(u32x4, x1 + (size_t)t * 2048 + i * 512 + lane * 8);
        float yv[32];
#pragma unroll
        for (int j = 0; j < 32; ++j) yv[j] = 0.f;
#define FX_ACC8(W, I, G) do { const f32x2 a0 = __builtin_amdgcn_cvt_pk_f32_fp8((int)(W).x, false), a1 = __builtin_amdgcn_cvt_pk_f32_fp8((int)(W).x, true), a2 = __builtin_amdgcn_cvt_pk_f32_fp8((int)(W).y, false), a3 = __builtin_amdgcn_cvt_pk_f32_fp8((int)(W).y, true); \
            yv[(I) * 8 + 0] += (G) * a0[0]; yv[(I) * 8 + 1] += (G) * a0[1]; yv[(I) * 8 + 2] += (G) * a1[0]; yv[(I) * 8 + 3] += (G) * a1[1]; yv[(I) * 8 + 4] += (G) * a2[0]; yv[(I) * 8 + 5] += (G) * a2[1]; yv[(I) * 8 + 6] += (G) * a3[0]; yv[(I) * 8 + 7] += (G) * a3[1]; } while (0)
#pragma unroll
        for (int k = 0; k < 4; ++k)
#pragma unroll
            for (int i = 0; i < 4; ++i) FX_ACC8(ra[k][i], i, gk[k]);
        u32x2 rb[3][4];
#pragma unroll
        for (int k = 0; k < 3; ++k)
#pragma unroll
            for (int i = 0; i < 4; ++i) rb[k][i] = *FX_GC(u32x2, YR + (size_t)rows[4 + k] * 2048 + i * 512 + lane * 8);
        f32x4 cd[8];
#pragma unroll
        for (int i = 0; i < 4; ++i) { cd[2 * i] = *FX_GC(f32x4, cf + 3 * 2048 + i * 512 + lane * 8); cd[2 * i + 1] = *FX_GC(f32x4, cf + 3 * 2048 + i * 512 + lane * 8 + 4); }
#pragma unroll
        for (int k = 0; k < 3; ++k)
#pragma unroll
            for (int i = 0; i < 4; ++i) FX_ACC8(rb[k][i], i, gk[4 + k]);
#undef FX_ACC8
        float ss = 0.f;
#pragma unroll
        for (int j = 0; j < 32; ++j) ss += yv[j] * yv[j];
        ss = wave_sum(ss); const float ry = rsqrtf(ss * (1.f / 2048.f) + EPS); float ssx = 0.f;
#pragma unroll
        for (int i = 0; i < 4; ++i) { const u32x4 w = xw[i];
            const float xs[8] = {bflo(w.x), bfhi(w.x), bflo(w.y), bfhi(w.y), bflo(w.z), bfhi(w.z), bflo(w.w), bfhi(w.w)};
#pragma unroll
            for (int j = 0; j < 8; ++j) { yv[i * 8 + j] = xs[j] + cd[2 * i + (j >> 2)][j & 3] * (yv[i * 8 + j] * ry); ssx += yv[i * 8 + j] * yv[i * 8 + j]; } }
        f32x4 ce[8], cg[8];
        if (coef_next) { const float* cn = coef_next + (size_t)b * 6 * 2048;
#pragma unroll
            for (int i = 0; i < 4; ++i) { ce[2 * i] = *FX_GC(f32x4, cn + 4 * 2048 + i * 512 + lane * 8); ce[2 * i + 1] = *FX_GC(f32x4, cn + 4 * 2048 + i * 512 + lane * 8 + 4);
                cg[2 * i] = *FX_GC(f32x4, cn + 5 * 2048 + i * 512 + lane * 8); cg[2 * i + 1] = *FX_GC(f32x4, cn + 5 * 2048 + i * 512 + lane * 8 + 4); } }
#pragma unroll
        for (int i = 0; i < 4; ++i) { const int c = i * 512 + lane * 8;
            if constexpr (OUTF32) { float* xout = (float*)xout_; *FX_GM(f32x4, xout + (size_t)t * 2048 + c) = (f32x4){yv[i * 8 + 0], yv[i * 8 + 1], yv[i * 8 + 2], yv[i * 8 + 3]};
                *FX_GM(f32x4, xout + (size_t)t * 2048 + c + 4) = (f32x4){yv[i * 8 + 4], yv[i * 8 + 5], yv[i * 8 + 6], yv[i * 8 + 7]}; }
            else { u32x4 xo; xo.x = cvt_pk_bf16(yv[i * 8 + 0], yv[i * 8 + 1]); xo.y = cvt_pk_bf16(yv[i * 8 + 2], yv[i * 8 + 3]); xo.z = cvt_pk_bf16(yv[i * 8 + 4], yv[i * 8 + 5]); xo.w = cvt_pk_bf16(yv[i * 8 + 6], yv[i * 8 + 7]);
                *FX_GM(u32x4, (bf16_t*)xout_ + (size_t)t * 2048 + c) = xo; } }
        if (coef_next) { ssx = wave_sum(ssx); const float rx = rsqrtf(ssx * (1.f / 2048.f) + EPS);
#pragma unroll
            for (int i = 0; i < 4; ++i) { const int c = i * 512 + lane * 8;
                float hv[8];
#pragma unroll
                for (int j = 0; j < 8; ++j) hv[j] = yv[i * 8 + j] * rx * ce[2 * i + (j >> 2)][j & 3] + cg[2 * i + (j >> 2)][j & 3];
#ifdef FX_WIN8
                u32x2 w; w.x = cvt_pk4_fp8(hv[0], hv[1], hv[2], hv[3]); w.y = cvt_pk4_fp8(hv[4], hv[5], hv[6], hv[7]);
                *FX_GM(u32x2, (unsigned char*)HA + (size_t)t * 2048 + c) = w; } }
#else
                u32x4 w; w.x = cvt_pk_bf16(hv[0], hv[1]); w.y = cvt_pk_bf16(hv[2], hv[3]); w.z = cvt_pk_bf16(hv[4], hv[5]); w.w = cvt_pk_bf16(hv[6], hv[7]);
                *FX_GM(u32x4, HA + (size_t)t * 2048 + c) = w; } }
#endif
    }
}
}
namespace fx {
#ifndef FX_YMPERM
#define FX_YMPERM 1
#endif
#ifndef FX_SD_A
#define FX_SD_A 2
#endif
#ifndef FX_SD_B
#define FX_SD_B 1
#endif
#ifndef FX_NQR_B
#define FX_NQR_B 12
#endif
#define FX_SBAR() __builtin_amdgcn_sched_barrier(0)
__device__ __forceinline__ int crow(int r, int hi) { return (r & 3) + 8 * (r >> 2) + 4 * hi; }
__device__ __forceinline__ int v_st(int k, int c) { const int kk = (k & ~0xC) | ((k & 4) << 1) | ((k & 8) >> 1); return ((kk >> 3) * 4 + (c >> 5)) * 512 + ((kk & 7) * 32 + (c & 31)) * 2; }
__device__ __forceinline__ int v_rd_base(int lane) { return ((lane & 3) << 3) | (((lane >> 2) & 3) << 6) | (((lane >> 4) & 1) << 5) | (((lane >> 5) & 1) << 8); }
constexpr int v_rd_off(int d0, int ks, int half) { return d0 * 512 + ks * 4096 + half * 2048; }
template <int OFF> __device__ __forceinline__ s16x4 tr_read(int vb) { s16x4 r; asm volatile("ds_read_b64_tr_b16 %0, %1 offset:%2" : "=&v"(r) : "v"(vb), "i"(OFF) : "memory"); return r; }
#define FX_PK(L, H) (bf16x8){L[0], L[1], L[2], L[3], H[0], H[1], H[2], H[3]}
template <int D0> __device__ __forceinline__ void pv_one(f32x16& od, int vb, bf16x8 pa0, bf16x8 pa1, bf16x8 pa2, bf16x8 pa3) {
    const s16x4 l0 = tr_read<v_rd_off(D0, 0, 0)>(vb), h0 = tr_read<v_rd_off(D0, 0, 1)>(vb), l1 = tr_read<v_rd_off(D0, 1, 0)>(vb), h1 = tr_read<v_rd_off(D0, 1, 1)>(vb);
    const s16x4 l2 = tr_read<v_rd_off(D0, 2, 0)>(vb), h2 = tr_read<v_rd_off(D0, 2, 1)>(vb), l3 = tr_read<v_rd_off(D0, 3, 0)>(vb), h3 = tr_read<v_rd_off(D0, 3, 1)>(vb);
    asm volatile("s_waitcnt lgkmcnt(0)" ::: "memory"); FX_SBAR();
    od = __builtin_amdgcn_mfma_f32_32x32x16_bf16(pa0, FX_PK(l0, h0), od, 0, 0, 0);
    od = __builtin_amdgcn_mfma_f32_32x32x16_bf16(pa1, FX_PK(l1, h1), od, 0, 0, 0);
    od = __builtin_amdgcn_mfma_f32_32x32x16_bf16(pa2, FX_PK(l2, h2), od, 0, 0, 0);
    od = __builtin_amdgcn_mfma_f32_32x32x16_bf16(pa3, FX_PK(l3, h3), od, 0, 0, 0);
}
__device__ __forceinline__ void pv_d0(f32x16* o, int vb, bf16x8 pa0, bf16x8 pa1, bf16x8 pa2, bf16x8 pa3) {
    pv_one<0>(o[0], vb, pa0, pa1, pa2, pa3); pv_one<1>(o[1], vb, pa0, pa1, pa2, pa3); pv_one<2>(o[2], vb, pa0, pa1, pa2, pa3); pv_one<3>(o[3], vb, pa0, pa1, pa2, pa3);
}
#define FX_PK4(P, BASE, OUT) do { unsigned a0 = cvt_pk_bf16(P[BASE + 0], P[BASE + 1]), a1 = cvt_pk_bf16(P[BASE + 2], P[BASE + 3]);   \
    unsigned b0 = cvt_pk_bf16(P[BASE + 4], P[BASE + 5]), b1 = cvt_pk_bf16(P[BASE + 6], P[BASE + 7]);                              \
    auto r0 = __builtin_amdgcn_permlane32_swap(a0, b0, false, false); auto r1 = __builtin_amdgcn_permlane32_swap(a1, b1, false, false); \
    u32x4 w = {r0[0], r1[0], r0[1], r1[1]}; OUT = *reinterpret_cast<bf16x8*>(&w); } while (0)

template <int DQK> struct AttnC {
    static constexpr int NQ = DQK / 16, KROW = DQK * 2, SHM_V = 64 * 128 * 2, SHM_K = 64 * DQK * 2, NQR = (DQK == 128 ? 8 : FX_NQR_B)  , QX = (NQ - NQR) * 8 * 64 * 16, SHM = 2 * SHM_V + 2 * SHM_K + 8 * 64 * 4 + QX;
    static constexpr float SCALE = DQK == 128 ? 0.088388347648318440f : 0.072168783648703220f;
    static constexpr float THR = 8.f;
};
#define FX_KSWZ(row, colB) ((row) * C::KROW + ((colB) ^ (((row) & 7) << 4)))

template <int DQK> __device__ __forceinline__ void partialSM(f32x16& p0, f32x16& p1, float& m_reg, float& mn, float& alpha) {
    using C = AttnC<DQK>;
    constexpr float Cc = C::SCALE * 1.4426950408889634f;
    float pmax = p0[0];
#pragma unroll
    for (int r = 1; r < 16; ++r) pmax = fmaxf(pmax, p0[r]);
#pragma unroll
    for (int r = 0; r < 16; ++r) pmax = fmaxf(pmax, p1[r]);
    { auto rr = __builtin_amdgcn_permlane32_swap(__float_as_uint(pmax), __float_as_uint(pmax), false, false); pmax = fmaxf(__uint_as_float(rr[0]), __uint_as_float(rr[1])); }
    if (__builtin_expect(__all(pmax - m_reg <= C::THR / C::SCALE), 1)) { mn = m_reg; alpha = 1.f; }
    else { mn = fmaxf(m_reg, pmax); alpha = __builtin_amdgcn_exp2f((m_reg - mn) * Cc); m_reg = mn; }
    const float mnC = -mn * Cc;
#pragma unroll
    for (int r = 0; r < 16; ++r) p0[r] = fmaf(p0[r], Cc, mnC);
#pragma unroll
    for (int r = 0; r < 16; ++r) p1[r] = fmaf(p1[r], Cc, mnC);
#pragma unroll
    for (int r = 0; r < 16; ++r) p0[r] = __builtin_amdgcn_exp2f(p0[r]);
}
__device__ __forceinline__ void finishSM(f32x16& p0, f32x16& p1, float alpha, float& l_reg, bf16x8& pa0, bf16x8& pa1, bf16x8& pa2, bf16x8& pa3) {
#pragma unroll
    for (int r = 0; r < 16; ++r) p1[r] = __builtin_amdgcn_exp2f(p1[r]);
    float ps = 0;
#pragma unroll
    for (int r = 0; r < 16; ++r) ps += p0[r];
#pragma unroll
    for (int r = 0; r < 16; ++r) ps += p1[r];
    { auto rr = __builtin_amdgcn_permlane32_swap(__float_as_uint(ps), __float_as_uint(ps), false, false); ps = __uint_as_float(rr[0]) + __uint_as_float(rr[1]); }
    l_reg = l_reg * alpha + ps;
    FX_PK4(p0, 0, pa0); FX_PK4(p0, 8, pa1); FX_PK4(p1, 0, pa2); FX_PK4(p1, 8, pa3);
}
template <int DQK> __device__ __forceinline__ void qkt(f32x16& p0, f32x16& p1, const char* Ks, const bf16x8* qr, const char* qx  , int r32, int hi) {
    using C = AttnC<DQK>;
    p0 = f32x16{}; p1 = f32x16{};
#pragma unroll
    for (int d0 = 0; d0 < C::NQ; ++d0) { const int cb = (d0 * 16 + hi * 8) * 2;
        const bf16x8 qf = d0 < C::NQR ? qr[d0 < C::NQR ? d0 : 0] : *reinterpret_cast<const bf16x8*>(qx + (d0 - C::NQR) * 1024);
        const bf16x8 b0 = *reinterpret_cast<const bf16x8*>(Ks + FX_KSWZ(r32, cb));
        const bf16x8 b1 = *reinterpret_cast<const bf16x8*>(Ks + FX_KSWZ(32 + r32, cb));
        p0 = __builtin_amdgcn_mfma_f32_32x32x16_bf16(b0, qf, p0, 0, 0, 0);
        p1 = __builtin_amdgcn_mfma_f32_32x32x16_bf16(b1, qf, p1, 0, 0, 0); }
}

template <int DQK, int SD, int LDQ, int LDK1, int LDK2, int LDV>
__device__ __forceinline__ void attn_unit(const bf16_t* __restrict__ Qb, const bf16_t* __restrict__ K1, const bf16_t* __restrict__ K2, const bf16_t* __restrict__ Vh,
                                          bf16_t* __restrict__ Ob, const float* __restrict__ gain, int seq, char* lds, int tidp) {
    using C = AttnC<DQK>;
    int tid_ = tidp; asm volatile("" : "+v"(tid_));
    const int tid = tid_, wid = __builtin_amdgcn_readfirstlane(tid >> 6)  , lane = tid & 63, r32 = lane & 31, hi = lane >> 5;
    char* V_lds = lds; char* K_lds = lds + 2 * C::SHM_V;
    float* ws = (float*)(lds + 2 * C::SHM_V + 2 * C::SHM_K) + wid * 64; float* li_l = ws; float* al_l = ws + 32;
    float m_reg = -1e30f, l_reg = 0; f32x16 o[4] = {}; bf16x8 qr[C::NQR];
    char* qx = lds + 2 * C::SHM_V + 2 * C::SHM_K + 8 * 64 * 4 + wid * ((C::NQ - C::NQR) * 1024) + lane * 16;
    const bf16_t* Qw = Qb + (long)(wid * 32 + r32) * LDQ + hi * 8;
#pragma unroll
    for (int d0 = 0; d0 < C::NQR; ++d0) qr[d0] = *reinterpret_cast<const bf16x8*>(Qw + d0 * 16);
#pragma unroll
    for (int d0 = C::NQR; d0 < C::NQ; ++d0) *reinterpret_cast<bf16x8*>(qx + (d0 - C::NQR) * 1024) = *reinterpret_cast<const bf16x8*>(Qw + d0 * 16);
    const int sr = tid >> 4, sc = (tid & 15) * 8, vst0 = v_st(sr, sc), vst1 = v_st(32 + sr, sc);
    const int vb0 = (int)(uintptr_t)V_lds + v_rd_base(lane);
    const int xr = tid >> 3, xc = (tid & 7) * 8;
    struct { bf16x8 vs0, vs1, ks0, ks1, kx; } sr_[SD];
#define FX_SLOAD(i, k0) do { sr_[i].vs0 = *reinterpret_cast<const bf16x8*>(&Vh[(long)((k0) + sr) * LDV + sc]); sr_[i].vs1 = *reinterpret_cast<const bf16x8*>(&Vh[(long)((k0) + 32 + sr) * LDV + sc]); \
    sr_[i].ks0 = *reinterpret_cast<const bf16x8*>(&K1[(long)((k0) + sr) * LDK1 + sc]); sr_[i].ks1 = *reinterpret_cast<const bf16x8*>(&K1[(long)((k0) + 32 + sr) * LDK1 + sc]); \
    if (DQK == 192) sr_[i].kx = *reinterpret_cast<const bf16x8*>(&K2[(long)((k0) + xr) * LDK2 + xc]); } while (0)
#define FX_SWRITE(b, i) do { *(bf16x8*)(V_lds + (b) * C::SHM_V + vst0) = sr_[i].vs0; *(bf16x8*)(V_lds + (b) * C::SHM_V + vst1) = sr_[i].vs1; const int kc = sc * 2; \
    *(bf16x8*)(K_lds + (b) * C::SHM_K + FX_KSWZ(sr, kc)) = sr_[i].ks0; *(bf16x8*)(K_lds + (b) * C::SHM_K + FX_KSWZ(32 + sr, kc)) = sr_[i].ks1; \
    if (DQK == 192) *(bf16x8*)(K_lds + (b) * C::SHM_K + FX_KSWZ(xr, 256 + xc * 2)) = sr_[i].kx; } while (0)
#define FX_SWAIT() do { if (SD == 1) asm volatile("s_waitcnt vmcnt(0)" ::: "memory"); else if (DQK == 192) asm volatile("s_waitcnt vmcnt(5)" ::: "memory"); else asm volatile("s_waitcnt vmcnt(4)" ::: "memory"); } while (0)
#define FX_RESC(a) do { if (__any((a) < 1.f)) { if (hi == 0) al_l[r32] = (a); asm volatile("s_waitcnt lgkmcnt(0)" ::: "memory"); \
    _Pragma("unroll") for (int d = 0; d < 4; ++d) _Pragma("unroll") for (int r = 0; r < 16; ++r) o[d][r] *= al_l[crow(r, hi)]; } } while (0)
    f32x16 pA0, pA1, pB0, pB1; float mnA, mnB, alA, alB; bf16x8 pa0, pa1, pa2, pa3; const int NT = seq / 64;
    constexpr int SE = 0, SO = SD - 1;
    FX_SLOAD(SE, 0); asm volatile("s_waitcnt vmcnt(0)" ::: "memory"); FX_SWRITE(0, SE); __syncthreads();
    qkt<DQK>(pA0, pA1, K_lds, qr, qx, r32, hi); partialSM<DQK>(pA0, pA1, m_reg, mnA, alA);
    FX_SLOAD(SO, 64); if (SD == 2) { if (2 < NT) FX_SLOAD(SE, 128); }
    FX_SWAIT(); FX_SWRITE(1, SO); __syncthreads();
    for (int j = 1; j + 1 < NT; j += 2) {
        FX_SBAR(); qkt<DQK>(pB0, pB1, K_lds + C::SHM_K, qr, qx, r32, hi);
        finishSM(pA0, pA1, alA, l_reg, pa0, pa1, pa2, pa3); FX_SBAR();
        FX_SLOAD(SO, (j + SD) * 64); FX_SBAR();
        pv_d0(o, vb0, pa0, pa1, pa2, pa3); partialSM<DQK>(pB0, pB1, m_reg, mnB, alB);
        __syncthreads(); FX_SWAIT(); FX_SWRITE(0, SE);
        FX_RESC(alB); __syncthreads();
        FX_SBAR(); qkt<DQK>(pA0, pA1, K_lds, qr, qx, r32, hi);
        finishSM(pB0, pB1, alB, l_reg, pa0, pa1, pa2, pa3); FX_SBAR();
        if (SD == 1 || j + 3 < NT) FX_SLOAD(SE, (j + 1 + SD) * 64); FX_SBAR();
        pv_d0(o, vb0 + C::SHM_V, pa0, pa1, pa2, pa3); partialSM<DQK>(pA0, pA1, m_reg, mnA, alA);
        __syncthreads(); FX_SWAIT(); FX_SWRITE(1, SO);
        FX_RESC(alA); __syncthreads();
    }
    FX_SBAR(); qkt<DQK>(pB0, pB1, K_lds + C::SHM_K, qr, qx, r32, hi);
    finishSM(pA0, pA1, alA, l_reg, pa0, pa1, pa2, pa3); FX_SBAR();
    pv_d0(o, vb0, pa0, pa1, pa2, pa3); partialSM<DQK>(pB0, pB1, m_reg, mnB, alB);
    __syncthreads(); FX_RESC(alB);
    finishSM(pB0, pB1, alB, l_reg, pa0, pa1, pa2, pa3); FX_SBAR();
    pv_d0(o, vb0 + C::SHM_V, pa0, pa1, pa2, pa3);
    if (hi == 0) li_l[r32] = l_reg; asm volatile("s_waitcnt lgkmcnt(0)" ::: "memory");
    int r32e = r32; asm volatile("" : "+v"(r32e));
    float g4[4];
#pragma unroll
    for (int d0 = 0; d0 < 4; ++d0) g4[d0] = gain[d0 * 32 + r32e];
    bf16_t* Ow = Ob + (long)(wid * 32) * 2048;
#pragma unroll
    for (int r = 0; r < 16; ++r) { const float rl = __builtin_amdgcn_rcpf(li_l[crow(r, hi)]);
        float ss = 0.f;
#pragma unroll
        for (int d0 = 0; d0 < 4; ++d0) { o[d0][r] *= rl; ss += o[d0][r] * o[d0][r]; }
        ss += __shfl_xor(ss, 1); ss += __shfl_xor(ss, 2); ss += __shfl_xor(ss, 4); ss += __shfl_xor(ss, 8); ss += __shfl_xor(ss, 16);
        const float rn = rsqrtf(ss * (1.f / 128.f) + EPS); const int orow = crow(r, hi);
#if defined(FX_WOUT8) && FX_YMPERM
        *(unsigned*)((unsigned char*)Ob + (long)(wid * 32 + orow) * 2048 + 4 * r32e) = cvt_pk4_fp8(o[0][r] * rn * g4[0], o[1][r] * rn * g4[1], o[2][r] * rn * g4[2], o[3][r] * rn * g4[3]); }
#elif defined(FX_WOUT8)
#pragma unroll
        for (int d0 = 0; d0 < 4; ++d0) ((unsigned char*)Ob)[(long)(wid * 32 + orow) * 2048 + d0 * 32 + r32e] = (unsigned char)(__builtin_amdgcn_cvt_pk_fp8_f32(o[d0][r] * rn * g4[d0], 0.f, 0, false) & 0xff); }
#else
#pragma unroll
        for (int d0 = 0; d0 < 4; ++d0) Ow[(long)orow * 2048 + d0 * 32 + r32e] = f2bf(o[d0][r] * rn * g4[d0]); }
#endif
    __syncthreads();
#undef FX_SLOAD
#undef FX_SWRITE
#undef FX_SWAIT
#undef FX_RESC
}

__device__ __forceinline__ void attn_gqa_unit(int u, const bf16_t* QA, const bf16_t* KA, const bf16_t* PROJ, bf16_t* YM, const float* hog, char* lds, int tidp) {
    const int qb = u & 15, hh = (u >> 4) % 6, b = u / 96, kvh = hh / 3;
    const size_t t0 = (size_t)b * S;
    attn_unit<128, FX_SD_A, 768, 256, 0, PW>(QA + (t0 + qb * 256) * 768 + hh * 128, KA + t0 * 256 + kvh * 128, nullptr, PROJ + t0 * PW + O_AV + kvh * 128,
#ifdef FX_WOUT8
                                    (bf16_t*)((unsigned char*)YM + (t0 + qb * 256) * 2048 + hh * 128), hog + hh * 128, S, lds, tidp);
#else
                                    YM + (t0 + qb * 256) * 2048 + hh * 128, hog + hh * 128, S, lds, tidp);
#endif
}
__device__ __forceinline__ void attn_mla_unit(int u, const bf16_t* QB, const bf16_t* KVB, const bf16_t* KR, bf16_t* YM, const float* hog, char* lds, int tidp) {
    const int qb = u & 15, hh = (u >> 4) % 6, b = u / 96;
    const size_t t0 = (size_t)b * S;
    attn_unit<192, FX_SD_B, 1280, 1536, 64, 1536>(QB + (t0 + qb * 256) * 1280 + hh * 192, KVB + t0 * 1536 + hh * 256, KR + t0 * 64, KVB + t0 * 1536 + hh * 256 + 128,
#ifdef FX_WOUT8
                                         (bf16_t*)((unsigned char*)YM + (t0 + qb * 256) * 2048 + 768 + hh * 128), hog + 768 + hh * 128, S, lds, tidp);
#else
                                         YM + (t0 + qb * 256) * 2048 + 768 + hh * 128, hog + 768 + hh * 128, S, lds, tidp);
#endif
}
}
namespace fx {
constexpr int P3_LDS = 4096 + 2048 + 65536 + 32768;
constexpr float KSCALE = 0.08838834764831845f;
__device__ __forceinline__ float logsigmoid_f(float f) { return fminf(f, 0.f) - log1pf(__expf(-fabsf(f))); }
__device__ __forceinline__ float wave_scan_incl(float v, int lane) {
#pragma unroll
    for (int o = 1; o < 64; o <<= 1) { const float t = __shfl_up(v, o); if (lane >= o) v += t; }
    return v;
}
__device__ __forceinline__ float wave_scanmax_incl(float v, int lane) {
#pragma unroll
    for (int o = 1; o < 64; o <<= 1) { const float t = __shfl_up(v, o); if (lane >= o) v = fmaxf(v, t); }
    return v;
}
__device__ __forceinline__ float wave_rscanmax_incl(float v, int lane) {
#pragma unroll
    for (int o = 1; o < 64; o <<= 1) { const float t = __shfl_down(v, o); if (lane + o < 64) v = fmaxf(v, t); }
    return v;
}

struct P3Args {
    const bf16_t* PROJ; const float* GATES; const float* gate_b; const float* conv_w; const float* conv_b;
    const float* aq_gain; const float* ak_gain; const float* cq_gain; const float* ckv_gain;
    const float* cosA; const float* sinA; const float* cosB; const float* sinB;
    bf16_t* QA; bf16_t* KA; bf16_t* CQN; bf16_t* CKVN; bf16_t* KR; bf16_t* QC; bf16_t* KC; bf16_t* KCT; float* NLOC; float* GSC;
};
__device__ __forceinline__ void p3_phase(FX_LAS unsigned char* lds_, const P3Args& a, int wg, int nwg, int tidp) {
    char* lds = (char*)lds_;
    float* gat = (float*)lds; float* wts = (float*)(lds + 4096); char* ktile = lds + 6144; char* wv = lds + 6144 + 65536;
    for (int unit = wg; unit < T / 64; unit += nwg) {
        int tid_ = tidp; asm volatile("" : "+v"(tid_));
        const int tid = tid_, wid = tid >> 6, lane = tid & 63;
        const int b = unit >> 6, co = unit & 63; const size_t t0 = (size_t)unit * 64;
        for (int i = tid; i < 1024; i += 512) gat[i] = a.GATES[t0 * 16 + i] + a.gate_b[i & 15];
        __syncthreads();
        { const int dir = wid >> 2, h = wid & 3;
          const float logi = gat[lane * 16 + (dir * 2) * 4 + h], logf = logsigmoid_f(gat[lane * 16 + (dir * 2 + 1) * 4 + h]);
          const float pre = wave_scan_incl(logf, lane), g = __shfl(pre, 63);
          const float bb = dir ? (g - pre + logf) : pre;
          const float av = g - bb + logi, mloc = wave_max(av);
          wts[wid * 64 + lane] = __expf(av - mloc);
          if (lane == 0) { const int chain = (b * 4 + h) * 2 + dir, ci = dir ? 63 - co : co; a.GSC[(chain * 64 + ci) * 2] = g; a.GSC[(chain * 64 + ci) * 2 + 1] = mloc; } }
        __syncthreads();
        { const int c0 = 2 * tid; const bool isk = c0 >= 512; const int hk = (c0 - 512) >> 7, dk = (c0 - 512) & 127;
          float w0[5], w1[5];
#pragma unroll
          for (int j = 0; j < 5; ++j) { w0[j] = a.conv_w[j * 1024 + c0]; w1[j] = a.conv_w[j * 1024 + c0 + 1]; }
          const float cb0 = a.conv_b[c0], cb1 = a.conv_b[c0 + 1];
          float x0[5], x1[5];
          const bf16_t* src = a.PROJ + t0 * PW + O_CQ + c0;
#pragma unroll
          for (int j = 0; j < 4; ++j) { const int sa = co * 64 + j - 2; unsigned w = 0u; if (sa >= 0 && sa < S) w = *(const unsigned*)(src + (long)(j - 2) * PW); x0[j + 1] = bflo(w); x1[j + 1] = bfhi(w); }
          float nf0 = 0.f, nf1 = 0.f, nb0 = 0.f, nb1 = 0.f;
#pragma unroll 1
          for (int s0 = 0; s0 < 64; s0 += 16) {
              unsigned wl[16];
#pragma unroll
              for (int q = 0; q < 16; ++q) { const int sa = co * 64 + s0 + q + 2; wl[q] = 0u; if (sa < S) wl[q] = *(const unsigned*)(src + (long)(s0 + q + 2) * PW); }
#pragma unroll
              for (int q = 0; q < 16; ++q) { const int s = s0 + q;
#pragma unroll
                  for (int j = 0; j < 4; ++j) { x0[j] = x0[j + 1]; x1[j] = x1[j + 1]; }
                  x0[4] = bflo(wl[q]); x1[4] = bfhi(wl[q]);
                  float y0 = cb0, y1 = cb1;
#pragma unroll
                  for (int j = 0; j < 5; ++j) { y0 += w0[j] * x0[j]; y1 += w1[j] * x1[j]; }
                  y0 = silu_f(y0); y1 = silu_f(y1);
                  if (!isk) { *(unsigned*)(a.QC + (t0 + s) * 512 + c0) = cvt_pk_bf16(y0, y1); }
                  else { y0 *= KSCALE; y1 *= KSCALE; const unsigned pk = cvt_pk_bf16(y0, y1);
                      *(unsigned*)(a.KC + (t0 + s) * 512 + (c0 - 512)) = pk;
                      *(unsigned*)(ktile + hk * 16384 + v_st(s, dk & ~7) + (dk & 7) * 2) = pk;
                      const float k0 = bflo(pk), k1 = bfhi(pk); const float wf = wts[hk * 64 + s], wb = wts[(4 + hk) * 64 + s];
                      nf0 += wf * k0; nf1 += wf * k1; nb0 += wb * k0; nb1 += wb * k1; } }
          }
          if (isk) { const int chf = (b * 4 + hk) * 2, chb = chf + 1;
              *(f32x2*)(a.NLOC + ((size_t)chf * 64 + co) * 128 + dk) = (f32x2){nf0, nf1};
              *(f32x2*)(a.NLOC + ((size_t)chb * 64 + (63 - co)) * 128 + dk) = (f32x2){nb0, nb1}; } }
        __syncthreads();
#pragma unroll 1
        for (int h = 0; h < 4; ++h) {
            { const int sr = tid >> 4, sc = (tid & 15) * 8;
#pragma unroll
              for (int rr = 0; rr < 2; ++rr) { const int s = sr + 32 * rr;
                const u32x4 vw = *(const u32x4*)(a.PROJ + (t0 + s) * PW + O_CV + h * 128 + sc);
                const float wf = wts[h * 64 + s], wb = wts[(4 + h) * 64 + s];
                float v[8] = {bflo(vw.x), bfhi(vw.x), bflo(vw.y), bfhi(vw.y), bflo(vw.z), bfhi(vw.z), bflo(vw.w), bfhi(vw.w)};
                u32x4 of, ob;
                of.x = cvt_pk_bf16(v[0] * wf, v[1] * wf); of.y = cvt_pk_bf16(v[2] * wf, v[3] * wf); of.z = cvt_pk_bf16(v[4] * wf, v[5] * wf); of.w = cvt_pk_bf16(v[6] * wf, v[7] * wf);
                ob.x = cvt_pk_bf16(v[0] * wb, v[1] * wb); ob.y = cvt_pk_bf16(v[2] * wb, v[3] * wb); ob.z = cvt_pk_bf16(v[4] * wb, v[5] * wb); ob.w = cvt_pk_bf16(v[6] * wb, v[7] * wb);
                *(u32x4*)(wv + v_st(s, sc)) = of; *(u32x4*)(wv + 16384 + v_st(s, sc)) = ob; } }
            __syncthreads();
            { const int dir = wid >> 2, mb = wid & 3, r32 = lane & 31, hi = lane >> 5;
              const int va = (int)(uintptr_t)(wv + dir * 16384) + v_rd_base(lane) + mb * 512;
              const int kb = (int)(uintptr_t)(ktile + h * 16384) + v_rd_base(lane);
              f32x16 acc[4] = {};
#define FX_KC_STEP(KS) do { \
              const s16x4 al = tr_read<v_rd_off(0, KS, 0)>(va), ah = tr_read<v_rd_off(0, KS, 1)>(va); \
              const s16x4 b0l = tr_read<v_rd_off(0, KS, 0)>(kb), b0h = tr_read<v_rd_off(0, KS, 1)>(kb), b1l = tr_read<v_rd_off(1, KS, 0)>(kb), b1h = tr_read<v_rd_off(1, KS, 1)>(kb); \
              const s16x4 b2l = tr_read<v_rd_off(2, KS, 0)>(kb), b2h = tr_read<v_rd_off(2, KS, 1)>(kb), b3l = tr_read<v_rd_off(3, KS, 0)>(kb), b3h = tr_read<v_rd_off(3, KS, 1)>(kb); \
              asm volatile("s_waitcnt lgkmcnt(0)" ::: "memory"); FX_SBAR(); \
              const bf16x8 af = FX_PK(al, ah); \
              acc[0] = __builtin_amdgcn_mfma_f32_32x32x16_bf16(af, FX_PK(b0l, b0h), acc[0], 0, 0, 0); acc[1] = __builtin_amdgcn_mfma_f32_32x32x16_bf16(af, FX_PK(b1l, b1h), acc[1], 0, 0, 0); \
              acc[2] = __builtin_amdgcn_mfma_f32_32x32x16_bf16(af, FX_PK(b2l, b2h), acc[2], 0, 0, 0); acc[3] = __builtin_amdgcn_mfma_f32_32x32x16_bf16(af, FX_PK(b3l, b3h), acc[3], 0, 0, 0); } while (0)
              FX_KC_STEP(0); FX_KC_STEP(1); FX_KC_STEP(2); FX_KC_STEP(3);
#undef FX_KC_STEP
              const int chain = (b * 4 + h) * 2 + dir, ci = dir ? 63 - co : co;
              const int par = r32 & 1;
              bf16_t* dst = a.KCT + ((size_t)chain * 64 + ci) * 16384 + (size_t)(mb * 32) * 128 + (r32 - par) + par * 64;
#pragma unroll
              for (int r = 0; r < 16; ++r) { const int v = crow(r, hi);
                  const unsigned w01 = cvt_pk_bf16(acc[0][r], acc[1][r]), w23 = cvt_pk_bf16(acc[2][r], acc[3][r]);
                  const unsigned n01 = (unsigned)__builtin_amdgcn_update_dpp(0, (int)w01, 0xB1, 0xF, 0xF, false), n23 = (unsigned)__builtin_amdgcn_update_dpp(0, (int)w23, 0xB1, 0xF, 0xF, false);
                  const unsigned A = par ? n23 : w01, B = par ? w23 : n01;
                  *(unsigned*)(dst + v * 128) = (A & 0xffffu) | (B << 16); *(unsigned*)(dst + v * 128 + 32) = (A >> 16) | (B & 0xffff0000u); } }
            __syncthreads();
        }
        { const int hd = __builtin_amdgcn_readfirstlane(wid), l16 = lane & 15, tq = lane >> 4, e0 = 8 * l16, hf = e0 >> 6, f0 = e0 & 31; const bool second = (e0 & 32) != 0;
          const float* g = hd < 6 ? a.aq_gain : a.ak_gain;
          const f32x4 g0 = *(const f32x4*)(g + e0), g1 = *(const f32x4*)(g + e0 + 4);
#pragma unroll 4
          for (int p = 0; p < 16; ++p) { const int s = 4 * p + tq; const size_t t = t0 + s;
            const u32x4 xw = *(const u32x4*)(a.PROJ + t * PW + hd * 128 + e0);
            const int pos = hf ? s : co;
            const f32x4 c0 = *(const f32x4*)(a.cosA + pos * 32 + f0), c1 = *(const f32x4*)(a.cosA + pos * 32 + f0 + 4), s0 = *(const f32x4*)(a.sinA + pos * 32 + f0), s1 = *(const f32x4*)(a.sinA + pos * 32 + f0 + 4);
            float x[8] = {bflo(xw.x), bfhi(xw.x), bflo(xw.y), bfhi(xw.y), bflo(xw.z), bfhi(xw.z), bflo(xw.w), bfhi(xw.w)};
            float ss = 0.f;
#pragma unroll
            for (int j = 0; j < 8; ++j) ss += x[j] * x[j];
            ss += __shfl_xor(ss, 1); ss += __shfl_xor(ss, 2); ss += __shfl_xor(ss, 4); ss += __shfl_xor(ss, 8);
            const float r = rsqrtf(ss * (1.f / 128.f) + EPS);
            float o[8];
#pragma unroll
            for (int j = 0; j < 8; ++j) { x[j] *= r * (j < 4 ? g0[j & 3] : g1[j & 3]); }
#pragma unroll
            for (int j = 0; j < 8; ++j) { const float y = __shfl_xor(x[j], 4), cs = j < 4 ? c0[j & 3] : c1[j & 3], sn = j < 4 ? s0[j & 3] : s1[j & 3]; o[j] = second ? (x[j] * cs + y * sn) : (x[j] * cs - y * sn); }
            u32x4 w; w.x = cvt_pk_bf16(o[0], o[1]); w.y = cvt_pk_bf16(o[2], o[3]); w.z = cvt_pk_bf16(o[4], o[5]); w.w = cvt_pk_bf16(o[6], o[7]);
            bf16_t* dst = hd < 6 ? a.QA + t * 768 + hd * 128 + e0 : a.KA + t * 256 + (hd - 6) * 128 + e0;
            *(u32x4*)dst = w; } }
#pragma unroll 4
        for (int s = wid; s < 64; s += 8) { const size_t t = t0 + s; const bf16_t* p = a.PROJ + t * PW;
            float q[6]; float ss = 0.f;
#pragma unroll
            for (int i = 0; i < 3; ++i) { const unsigned w = *(const unsigned*)(p + O_BCQ + i * 128 + lane * 2); q[2 * i] = bflo(w); q[2 * i + 1] = bfhi(w); ss += q[2 * i] * q[2 * i] + q[2 * i + 1] * q[2 * i + 1]; }
            ss = wave_sum(ss); float r = rsqrtf(ss * (1.f / 384.f) + EPS);
#pragma unroll
            for (int i = 0; i < 3; ++i) { const int c = i * 128 + lane * 2; *(unsigned*)(a.CQN + t * 384 + c) = cvt_pk_bf16(q[2 * i] * r * a.cq_gain[c], q[2 * i + 1] * r * a.cq_gain[c + 1]); }
            float kv[4]; ss = 0.f;
#pragma unroll
            for (int i = 0; i < 2; ++i) { const unsigned w = *(const unsigned*)(p + O_BCKV + i * 128 + lane * 2); kv[2 * i] = bflo(w); kv[2 * i + 1] = bfhi(w); ss += kv[2 * i] * kv[2 * i] + kv[2 * i + 1] * kv[2 * i + 1]; }
            ss = wave_sum(ss); r = rsqrtf(ss * (1.f / 256.f) + EPS);
#pragma unroll
            for (int i = 0; i < 2; ++i) { const int c = i * 128 + lane * 2; *(unsigned*)(a.CKVN + t * 256 + c) = cvt_pk_bf16(kv[2 * i] * r * a.ckv_gain[c], kv[2 * i + 1] * r * a.ckv_gain[c + 1]); }
            if (lane < 32) { const int f = lane & 15, hf = lane >> 4; const int pos = hf ? s : co; const float cs = a.cosB[pos * 16 + f], sn = a.sinB[pos * 16 + f];
                const float x1 = bf2f(p[O_BKR + hf * 32 + f]), x2 = bf2f(p[O_BKR + hf * 32 + 16 + f]);
                a.KR[t * 64 + hf * 32 + f] = f2bf(x1 * cs - x2 * sn); a.KR[t * 64 + hf * 32 + 16 + f] = f2bf(x2 * cs + x1 * sn); } }
        __syncthreads();
    }
}

#ifndef FX_MCDEAL
#define FX_MCDEAL 1
#endif
#ifndef FX_SCANB
#define FX_SCANB 32
#endif
__device__ __forceinline__ void scan_phase(const bf16_t* KCT, const float* NLOC, const float* GSC, bf16_t* CPREV, float* NPREV, float* MPREV, int gtid, int nthr) {
    for (int item = gtid; item < 32 * 4096; item += nthr) {
        const int chain = item >> 12, e4 = item & 4095;
        const u32x2* src = (const u32x2*)(KCT + (size_t)chain * 64 * 16384) + e4; u32x2* dst = (u32x2*)(CPREV + (size_t)chain * 64 * 16384) + e4;
        const float* gs = GSC + (size_t)chain * 128;
        const bool don = e4 < 128;
        float c0 = 0.f, c1 = 0.f, c2 = 0.f, c3 = 0.f, nn = 0.f, m = 0.f;
#pragma unroll 1
        for (int cb = 0; cb < 64; cb += FX_SCANB) {
            u32x2 kc[FX_SCANB]; float nl[FX_SCANB]; f32x2 gm[FX_SCANB];
#pragma unroll
            for (int j = 0; j < FX_SCANB; ++j) { kc[j] = src[(size_t)(cb + j) * 4096]; nl[j] = don ? NLOC[((size_t)chain * 64 + cb + j) * 128 + e4] : 0.f; gm[j] = *(const f32x2*)(gs + (cb + j) * 2); }
#pragma unroll
            for (int j = 0; j < FX_SCANB; ++j) { const int ci = cb + j; const float g = gm[j][0], ml = gm[j][1];
                u32x2 o; o.x = cvt_pk_bf16(c0, c1); o.y = cvt_pk_bf16(c2, c3); dst[(size_t)ci * 4096] = o;
                if (don) NPREV[((size_t)chain * 64 + ci) * 128 + e4] = nn;
                if (e4 == 0) MPREV[chain * 64 + ci] = m;
                const float mn = fmaxf(g + m, ml), dec = __expf(g + m - mn), sl = __expf(ml - mn); m = mn;
                c0 = dec * c0 + sl * bflo(kc[j].x); c1 = dec * c1 + sl * bfhi(kc[j].x); c2 = dec * c2 + sl * bflo(kc[j].y); c3 = dec * c3 + sl * bfhi(kc[j].y);
                nn = dec * nn + sl * nl[j]; }
        }
    }
}

constexpr int MC_K = 0, MC_V = 16384, MC_CT = 32768, MC_HS = 98304, MC_HS_LD = 132, MC_SM = MC_HS + 64 * MC_HS_LD * 4, MC_LDS = MC_SM + 4096;
struct McArgs { const bf16_t* PROJ; const float* GATES; const float* gate_b; const bf16_t* QC; const bf16_t* KC; const bf16_t* CPREV; const float* NPREV; const float* MPREV; const float* hog; bf16_t* YM; };
__device__ __forceinline__ void mlstm_c_phase(FX_LAS unsigned char* lds_, const McArgs& a, int wg, int nwg, int tidp) {
    char* lds = (char*)lds_;
    using C = AttnC<128>;
    float* hs = (float*)(lds + MC_HS);
    float* sm = (float*)(lds + MC_SM);
    const bool deal53 = FX_MCDEAL && nwg == 256; const int jg = wg >> 3, xg = wg & 7;
    const int u_first = deal53 ? (jg < 16 ? (xg * 16 + jg) * 5 : 640 + (xg * 16 + jg - 16) * 3) : wg, u_cnt = deal53 ? (jg < 16 ? 5 : 3) : (NB * 4 * 64 - wg + nwg - 1) / nwg, u_step = deal53 ? 1 : nwg;
    for (int ui_ = 0, unit = u_first; ui_ < u_cnt; ++ui_, unit += u_step) {
        int tid_ = tidp; asm volatile("" : "+v"(tid_));
        const int tid = tid_, wid = tid >> 6, lane = tid & 63, r32 = lane & 31, hi = lane >> 5;
        const int co = unit & 63, h = (unit >> 6) & 3, b = unit >> 8; const size_t t0 = (size_t)b * S + co * 64;
        const int sr = tid >> 4, sc = (tid & 15) * 8;
        bf16x8 gk[2], gv[2], gc[2][4];
#pragma unroll
        for (int rr = 0; rr < 2; ++rr) { const int s = sr + 32 * rr; gk[rr] = *(const bf16x8*)(a.KC + (t0 + s) * 512 + h * 128 + sc); gv[rr] = *(const bf16x8*)(a.PROJ + (t0 + s) * PW + O_CV + h * 128 + sc); }
#pragma unroll
        for (int dir = 0; dir < 2; ++dir) { const int chain = (b * 4 + h) * 2 + dir, ci = dir ? 63 - co : co; const bf16_t* ct = a.CPREV + ((size_t)chain * 64 + ci) * 16384;
#pragma unroll
            for (int rr = 0; rr < 4; ++rr) gc[dir][rr] = *(const bf16x8*)(ct + (sr + 32 * rr) * 128 + sc); }
        if (wid < 2) { const int dir = wid; const int chain = (b * 4 + h) * 2 + dir, ci = dir ? 63 - co : co;
            const float logi = a.GATES[(t0 + lane) * 16 + (dir * 2) * 4 + h] + a.gate_b[(dir * 2) * 4 + h];
            const float logf = logsigmoid_f(a.GATES[(t0 + lane) * 16 + (dir * 2 + 1) * 4 + h] + a.gate_b[(dir * 2 + 1) * 4 + h]);
            const float pre = wave_scan_incl(logf, lane), g = __shfl(pre, 63);
            const float bb = dir ? (g - pre + logf) : pre;
            const float u = logi - bb;
            const float M = dir ? wave_rscanmax_incl(u, lane) : wave_scanmax_incl(u, lane);
            const float mp = a.MPREV[chain * 64 + ci], mmj = fmaxf(mp, M);
            sm[dir * 64 + lane] = u; sm[128 + dir * 64 + lane] = mmj; sm[256 + dir * 64 + lane] = __expf(mp - mmj); sm[384 + dir * 64 + lane] = __expf(-(bb + mmj));
            sm[512 + dir * 128 + lane] = a.NPREV[((size_t)chain * 64 + ci) * 128 + lane]; sm[512 + dir * 128 + 64 + lane] = a.NPREV[((size_t)chain * 64 + ci) * 128 + 64 + lane]; }
        {
#pragma unroll
          for (int rr = 0; rr < 2; ++rr) { const int s = sr + 32 * rr;
            *(bf16x8*)(lds + MC_K + FX_KSWZ(s, sc * 2)) = gk[rr];
            *(bf16x8*)(lds + MC_V + v_st(s, sc)) = gv[rr]; }
#pragma unroll
          for (int dir = 0; dir < 2; ++dir) {
#pragma unroll
            for (int rr = 0; rr < 4; ++rr) { const int v = sr + 32 * rr; *(bf16x8*)(lds + MC_CT + dir * 32768 + FX_KSWZ(v, sc * 2)) = gc[dir][rr]; } } }
        __syncthreads();
        { const int dir = wid >> 2, rb = (wid >> 1) & 1, cb = wid & 1, j = rb * 32 + r32;
          bf16x8 qr[8];
          const bf16_t* Qw = a.QC + (t0 + j) * 512 + h * 128 + hi * 8;
#pragma unroll
          for (int d0 = 0; d0 < 8; ++d0) qr[d0] = *reinterpret_cast<const bf16x8*>(Qw + d0 * 16);
          f32x16 p0, p1;
          qkt<128>(p0, p1, lds + MC_K, qr, nullptr, r32, hi);
          const float mmj = sm[128 + dir * 64 + j], inter = sm[256 + dir * 64 + j], emn = sm[384 + dir * 64 + j];
          float dsum = 0.f;
#pragma unroll
          for (int r = 0; r < 16; ++r) { const int s0 = crow(r, hi), s1 = 32 + s0;
              const bool v0 = dir ? (s0 >= j) : (s0 <= j), v1 = dir ? (s1 >= j) : (s1 <= j);
              const float w0 = v0 ? __expf(sm[dir * 64 + s0] - mmj) : 0.f, w1 = v1 ? __expf(sm[dir * 64 + s1] - mmj) : 0.f;
              p0[r] *= w0; p1[r] *= w1; dsum += p0[r] + p1[r]; }
          float qn = 0.f;
#pragma unroll
          for (int d0 = 0; d0 < 8; ++d0) { const float* np = sm + 512 + dir * 128 + d0 * 16 + hi * 8; const u32x4 w = *reinterpret_cast<const u32x4*>(&qr[d0]);
              qn += bflo(w.x) * np[0] + bfhi(w.x) * np[1] + bflo(w.y) * np[2] + bfhi(w.y) * np[3] + bflo(w.z) * np[4] + bfhi(w.z) * np[5] + bflo(w.w) * np[6] + bfhi(w.w) * np[7]; }
          { auto rr = __builtin_amdgcn_permlane32_swap(__float_as_uint(dsum), __float_as_uint(dsum), false, false); dsum = __uint_as_float(rr[0]) + __uint_as_float(rr[1]); }
          { auto rr = __builtin_amdgcn_permlane32_swap(__float_as_uint(qn), __float_as_uint(qn), false, false); qn = __uint_as_float(rr[0]) + __uint_as_float(rr[1]); }
          const float den = dsum + inter * qn;
          if (hi == 0) sm[768 + wid * 32 + r32] = 1.f / fmaxf(fabsf(den), emn);
          bf16x8 pa0, pa1, pa2, pa3;
          FX_PK4(p0, 0, pa0); FX_PK4(p0, 8, pa1); FX_PK4(p1, 0, pa2); FX_PK4(p1, 8, pa3);
          f32x16 o[2] = {};
          const int vb = (int)(uintptr_t)(lds + MC_V) + v_rd_base(lane) + cb * 1024;
          pv_one<0>(o[0], vb, pa0, pa1, pa2, pa3); pv_one<1>(o[1], vb, pa0, pa1, pa2, pa3);
          const char* ctb = lds + MC_CT + dir * 32768;
#pragma unroll
          for (int ks = 0; ks < 8; ++ks) { const u32x4 w = *reinterpret_cast<const u32x4*>(&qr[ks]); u32x4 sq;
              sq.x = cvt_pk_bf16(bflo(w.x) * inter, bfhi(w.x) * inter); sq.y = cvt_pk_bf16(bflo(w.y) * inter, bfhi(w.y) * inter); sq.z = cvt_pk_bf16(bflo(w.z) * inter, bfhi(w.z) * inter); sq.w = cvt_pk_bf16(bflo(w.w) * inter, bfhi(w.w) * inter);
              const bf16x8 qs = *reinterpret_cast<const bf16x8*>(&sq); const int colB = (ks * 16 + hi * 8) * 2;
              const bf16x8 c0f = *reinterpret_cast<const bf16x8*>(ctb + FX_KSWZ((2 * cb) * 32 + r32, colB));
              const bf16x8 c1f = *reinterpret_cast<const bf16x8*>(ctb + FX_KSWZ((2 * cb + 1) * 32 + r32, colB));
              o[0] = __builtin_amdgcn_mfma_f32_32x32x16_bf16(qs, c0f, o[0], 0, 0, 0);
              o[1] = __builtin_amdgcn_mfma_f32_32x32x16_bf16(qs, c1f, o[1], 0, 0, 0); }
          asm volatile("s_waitcnt lgkmcnt(0)" ::: "memory");
          float rd[16];
#pragma unroll
          for (int r = 0; r < 16; ++r) rd[r] = sm[768 + wid * 32 + crow(r, hi)];
          if (dir == 0) {
#pragma unroll
              for (int r = 0; r < 16; ++r) { const int row = rb * 32 + crow(r, hi);
                  hs[row * MC_HS_LD + (2 * cb) * 32 + r32] = o[0][r] * rd[r]; hs[row * MC_HS_LD + (2 * cb + 1) * 32 + r32] = o[1][r] * rd[r]; } }
          __syncthreads();
          if (dir == 1) {
#pragma unroll
              for (int r = 0; r < 16; ++r) { const int row = rb * 32 + crow(r, hi);
                  hs[row * MC_HS_LD + (2 * cb) * 32 + r32] += o[0][r] * rd[r]; hs[row * MC_HS_LD + (2 * cb + 1) * 32 + r32] += o[1][r] * rd[r]; } }
          __syncthreads(); }
        { const int row = tid >> 3, c0 = (tid & 7) * 16; const size_t t = t0 + row;
          float v[16]; float ss = 0.f;
#pragma unroll
          for (int i = 0; i < 16; ++i) { v[i] = hs[row * MC_HS_LD + c0 + i]; ss += v[i] * v[i]; }
          ss += __shfl_xor(ss, 1); ss += __shfl_xor(ss, 2); ss += __shfl_xor(ss, 4);
          const float rn = rsqrtf(ss * (1.f / 128.f) + EPS);
          const bf16_t* og = a.PROJ + t * PW + O_CO + h * 128 + c0; const float* gn = a.hog + 1536 + h * 128 + c0;
          const u32x4 g0 = *(const u32x4*)og, g1 = *(const u32x4*)(og + 8);
          const float gg[16] = {bflo(g0.x), bfhi(g0.x), bflo(g0.y), bfhi(g0.y), bflo(g0.z), bfhi(g0.z), bflo(g0.w), bfhi(g0.w), bflo(g1.x), bfhi(g1.x), bflo(g1.y), bfhi(g1.y), bflo(g1.z), bfhi(g1.z), bflo(g1.w), bfhi(g1.w)};
          float ov[16];
#pragma unroll
          for (int i = 0; i < 16; ++i) ov[i] = v[i] * rn * gn[i] * sigmoid_f(gg[i]);
          u32x4 w0, w1; w0.x = cvt_pk_bf16(ov[0], ov[1]); w0.y = cvt_pk_bf16(ov[2], ov[3]); w0.z = cvt_pk_bf16(ov[4], ov[5]); w0.w = cvt_pk_bf16(ov[6], ov[7]);
          w1.x = cvt_pk_bf16(ov[8], ov[9]); w1.y = cvt_pk_bf16(ov[10], ov[11]); w1.z = cvt_pk_bf16(ov[12], ov[13]); w1.w = cvt_pk_bf16(ov[14], ov[15]);
#ifdef FX_WOUT8
          { u32x4 w8; w8.x = cvt_pk4_fp8(ov[0], ov[1], ov[2], ov[3]); w8.y = cvt_pk4_fp8(ov[4], ov[5], ov[6], ov[7]); w8.z = cvt_pk4_fp8(ov[8], ov[9], ov[10], ov[11]); w8.w = cvt_pk4_fp8(ov[12], ov[13], ov[14], ov[15]);
            *(u32x4*)((unsigned char*)a.YM + t * 2048 + 1536 + h * 128 + c0) = w8; (void)w0; (void)w1; } }
#else
          bf16_t* dst = a.YM + t * 2048 + 1536 + h * 128 + c0; *(u32x4*)dst = w0; *(u32x4*)(dst + 8) = w1; }
#endif
        __syncthreads();
    }
}
}
namespace fx {
struct EpiQB {
    static constexpr bool PERM = false; static constexpr int NST = 32;
    bf16_t* O; const float* cosB; const float* sinB;
    __device__ __forceinline__ void operator()(const f32x4 (&acc)[2][2][4][2], const Unit& u, int wr, int wc, int fr, int fq) const {
        const int row0 = u.pm * BM + wr * 64 + fr;
#pragma unroll
        for (int bj = 0; bj < 2; ++bj) { const int G = 8 * u.pn + 4 * bj + wc, gm = G % 6; const int col0 = G * 32 + 4 * fq;
            f32x4 cs[2][4], sn[2][4];
            if (gm >= 4) {
#pragma unroll
                for (int ai = 0; ai < 2; ++ai)
#pragma unroll
                    for (int m = 0; m < 4; ++m) { const int row = row0 + ai * HALF + m * 16, s = row & (S - 1), pos = gm == 4 ? (s >> 6) : (s & 63);
                        cs[ai][m] = *(const f32x4*)(cosB + pos * 16 + 4 * fq); sn[ai][m] = *(const f32x4*)(sinB + pos * 16 + 4 * fq); } }
#pragma unroll
            for (int ai = 0; ai < 2; ++ai)
#pragma unroll
                for (int m = 0; m < 4; ++m) { const int row = row0 + ai * HALF + m * 16; f32x4 x1 = acc[ai][bj][m][0], x2 = acc[ai][bj][m][1];
                    if (gm >= 4) { const f32x4 o1 = x1 * cs[ai][m] - x2 * sn[ai][m], o2 = x2 * cs[ai][m] + x1 * sn[ai][m]; x1 = o1; x2 = o2; }
                    bf16_t* rp = O + (size_t)row * 1280 + col0;
                    u32x2 w0, w1; w0.x = cvt_pk_bf16(x1[0], x1[1]); w0.y = cvt_pk_bf16(x1[2], x1[3]); w1.x = cvt_pk_bf16(x2[0], x2[1]); w1.y = cvt_pk_bf16(x2[2], x2[3]);
                    *(u32x2*)rp = w0; *(u32x2*)(rp + 16) = w1; } }
    }
};
constexpr size_t al256(size_t x) { return (x + 255) & ~(size_t)255; }
constexpr size_t WS_BAR = 0;
constexpr size_t WS_MOD = 16384;
constexpr size_t WS_COEF = WS_MOD + al256(2ull * 4 * 12288 * 4);
constexpr size_t WS_TAB = WS_COEF + al256(2ull * 4 * 6 * 2048 * 4);
constexpr size_t WS_CNT = WS_BAR + 3712 * 4;
constexpr size_t WS_WGBASE = WS_TAB + al256(6144 * 4) + 512;
constexpr size_t WS_SELE = WS_WGBASE + 256 * 64 * 4;
constexpr size_t WS_SELG = WS_SELE + (size_t)T * 6 * 4;
constexpr size_t WS_SLOT = WS_SELG + (size_t)T * 6 * 4;
constexpr size_t WS_ROWTOK = WS_SLOT + (size_t)T * 6 * 4;
constexpr size_t WS_ROWG = WS_ROWTOK + (size_t)PTOT * 4;
constexpr size_t WS_GATES = WS_ROWG + (size_t)PTOT * 4;
constexpr size_t WS_GSC = WS_GATES + (size_t)T * 16 * 4;
constexpr size_t WS_MPREV = WS_GSC + 2048 * 2 * 4;
constexpr size_t WS_NLOC = WS_MPREV + 2048 * 4;
constexpr size_t WS_NPREV = WS_NLOC + 2048ull * 128 * 4;
constexpr size_t WS_W = al256(WS_NPREV + 2048ull * 128 * 4);
constexpr size_t W_IN = 0, W_UQ = W_IN + 4096ull * 2048 * 2, W_UKV = W_UQ + 1280ull * 384 * 2, W_OUT = W_UKV + 1536ull * 256 * 2, W_GU = W_OUT + 2048ull * 2048 * 2, W_DN = W_GU + 65ull * 1024 * 2048 * 2, W_LAYER = W_DN + 65ull * 2048 * 512 * 2;
constexpr size_t WS_XRES = WS_W + 2 * W_LAYER;
constexpr size_t WS_HA = WS_XRES + (size_t)T * 2048 * 4;
constexpr size_t WS_R1 = WS_HA + (size_t)T * 2048 * 2;
constexpr size_t WS_R2 = WS_R1 + (size_t)T * 4096 * 2;
constexpr size_t R2_QA = 0, R2_KA = R2_QA + (size_t)T * 768 * 2, R2_CQN = R2_KA + (size_t)T * 256 * 2, R2_CKVN = R2_CQN + (size_t)T * 384 * 2, R2_KR = R2_CKVN + (size_t)T * 256 * 2,
                 R2_QB = R2_KR + (size_t)T * 64 * 2, R2_KVB = R2_QB + (size_t)T * 1280 * 2, R2_QC = R2_KVB + (size_t)T * 1536 * 2, R2_KC = R2_QC + (size_t)T * 512 * 2,
                 R2_KCT = R2_KC + (size_t)T * 512 * 2, R2_CPREV = R2_KCT + 2048ull * 16384 * 2, R2_END = R2_CPREV + 2048ull * 16384 * 2;
constexpr size_t WS_END = WS_R2 + (size_t)PTOT * 2048 * 2;
static_assert(R2_END <= (size_t)PTOT * 2048 * 2, "R2 overflow");
static_assert(WS_END <= 2147483648ull, "workspace too large");
}
namespace fx {
struct CvtW { const float* w_in; const float* w_uq; const float* w_ukv; const float* w_out; const float* eg; const float* eu; const float* ed; const float* sg; const float* su; const float* sd; bf16_t* W; };
__device__ __forceinline__ void cvt_layer(const CvtW& a, FX_LAS unsigned* my, int gwave, int nwaves, int& rot) {
    const int BIG = 1 << 30; bf16_t* W = a.W;
    bf16_t* WIN = W + W_IN / 2; bf16_t* WUQ = W + W_UQ / 2; bf16_t* WUKV = W + W_UKV / 2; bf16_t* WOUT = W + W_OUT / 2; bf16_t* WGU = W + W_GU / 2; bf16_t* WDN = W + W_DN / 2;
#ifdef FX_WIN8
    { CvtSeg s; s.src = a.w_in; s.dst = WIN; s.sstride = 0; s.dstride = 0; s.ld = 4048; s.nsrc = 4048; s.K = 2048; s.ntn = 64; s.nbatch = 1; s.G = BIG; s.GS = 0; s.off = 0; cvt_seg8(s, my, gwave, nwaves, rot, W8_SCALE); }
#else
    { CvtSeg s; s.src = a.w_in; s.dst = WIN; s.sstride = 0; s.dstride = 0; s.ld = 4048; s.nsrc = 4048; s.K = 2048; s.ntn = 64; s.nbatch = 1; s.G = BIG; s.GS = 0; s.off = 0; cvt_seg(s, my, gwave, nwaves, rot); }
#endif
    { CvtSeg s; s.src = a.w_uq; s.dst = WUQ; s.sstride = 0; s.dstride = 0; s.ld = 1152; s.nsrc = 1152; s.K = 384; s.ntn = 20; s.nbatch = 1; s.G = BIG; s.GS = 0; s.off = 0; cvt_seg(s, my, gwave, nwaves, rot); }
    { CvtSeg s; s.src = a.w_ukv; s.dst = WUKV; s.sstride = 0; s.dstride = 0; s.ld = 1536; s.nsrc = 1536; s.K = 256; s.ntn = 24; s.nbatch = 1; s.G = BIG; s.GS = 0; s.off = 0; cvt_seg(s, my, gwave, nwaves, rot); }
#ifdef FX_WOUT8
    { CvtSeg s; s.src = a.w_out; s.dst = WOUT; s.sstride = 0; s.dstride = 0; s.ld = 2048; s.nsrc = 2048; s.K = 2048; s.ntn = 32; s.nbatch = 1; s.G = BIG; s.GS = 0; s.off = 0; s.kperm = FX_YMPERM ? 1536 : 0; cvt_seg8(s, my, gwave, nwaves, rot, W8_SCALE); }
#else
    { CvtSeg s; s.src = a.w_out; s.dst = WOUT; s.sstride = 0; s.dstride = 0; s.ld = 2048; s.nsrc = 2048; s.K = 2048; s.ntn = 32; s.nbatch = 1; s.G = BIG; s.GS = 0; s.off = 0; cvt_seg(s, my, gwave, nwaves, rot); }
#endif
    { CvtSeg s; s.src = a.eg; s.dst = WGU; s.sstride = 2048ll * 512; s.dstride = 1024ll * 2048; s.ld = 512; s.nsrc = 512; s.K = 2048; s.ntn = 8; s.nbatch = 64; s.G = 128; s.GS = 256; s.off = 0; cvt_seg8(s, my, gwave, nwaves, rot, W8_SCALE); }
    { CvtSeg s; s.src = a.eu; s.dst = WGU; s.sstride = 2048ll * 512; s.dstride = 1024ll * 2048; s.ld = 512; s.nsrc = 512; s.K = 2048; s.ntn = 8; s.nbatch = 64; s.G = 128; s.GS = 256; s.off = 128; cvt_seg8(s, my, gwave, nwaves, rot, W8_SCALE); }
    { CvtSeg s; s.src = a.ed; s.dst = WDN; s.sstride = 512ll * 2048; s.dstride = 2048ll * 512; s.ld = 2048; s.nsrc = 2048; s.K = 512; s.ntn = 32; s.nbatch = 64; s.G = BIG; s.GS = 0; s.off = 0; cvt_seg8(s, my, gwave, nwaves, rot, W8_SCALE); }
    { CvtSeg s; s.src = a.sg; s.dst = (bf16_t*)((unsigned char*)WGU + 64ull * 1024 * 2048); s.sstride = 0; s.dstride = 0; s.ld = 512; s.nsrc = 512; s.K = 2048; s.ntn = 8; s.nbatch = 1; s.G = 128; s.GS = 256; s.off = 0; cvt_seg8(s, my, gwave, nwaves, rot, W8_SCALE); }
    { CvtSeg s; s.src = a.su; s.dst = (bf16_t*)((unsigned char*)WGU + 64ull * 1024 * 2048); s.sstride = 0; s.dstride = 0; s.ld = 512; s.nsrc = 512; s.K = 2048; s.ntn = 8; s.nbatch = 1; s.G = 128; s.GS = 256; s.off = 128; cvt_seg8(s, my, gwave, nwaves, rot, W8_SCALE); }
    { CvtSeg s; s.src = a.sd; s.dst = (bf16_t*)((unsigned char*)WDN + 64ull * 2048 * 512); s.sstride = 0; s.dstride = 0; s.ld = 2048; s.nsrc = 2048; s.K = 512; s.ntn = 32; s.nbatch = 1; s.G = BIG; s.GS = 0; s.off = 0; cvt_seg8(s, my, gwave, nwaves, rot, W8_SCALE); }
}
constexpr int CVT_TILES_PER_LAYER = 2048 + 120 + 96 + 1024 + 3 * 16384 + 3 * 256;
__device__ __forceinline__ void cvt_layer_one(const CvtW& a, FX_LAS unsigned* my, int g) {
    int base = 0;
    const int BIG = 1 << 30; bf16_t* W = a.W;
    bf16_t* WIN = W + W_IN / 2; bf16_t* WUQ = W + W_UQ / 2; bf16_t* WUKV = W + W_UKV / 2; bf16_t* WOUT = W + W_OUT / 2; bf16_t* WGU = W + W_GU / 2; bf16_t* WDN = W + W_DN / 2;
#ifdef FX_WIN8
    { CvtSeg s; s.src = a.w_in; s.dst = WIN; s.sstride = 0; s.dstride = 0; s.ld = 4048; s.nsrc = 4048; s.K = 2048; s.ntn = 64; s.nbatch = 1; s.G = BIG; s.GS = 0; s.off = 0; { const int cnt_ = (s.K / 64) * s.ntn * s.nbatch; if (g >= base && g < base + cnt_) cvt_tile8(s, my, g - base, W8_SCALE); base += cnt_; } }
#else
    { CvtSeg s; s.src = a.w_in; s.dst = WIN; s.sstride = 0; s.dstride = 0; s.ld = 4048; s.nsrc = 4048; s.K = 2048; s.ntn = 64; s.nbatch = 1; s.G = BIG; s.GS = 0; s.off = 0; { const int cnt_ = (s.K / 64) * s.ntn * s.nbatch; if (g >= base && g < base + cnt_) cvt_tile(s, my, g - base); base += cnt_; } }
#endif
    { CvtSeg s; s.src = a.w_uq; s.dst = WUQ; s.sstride = 0; s.dstride = 0; s.ld = 1152; s.nsrc = 1152; s.K = 384; s.ntn = 20; s.nbatch = 1; s.G = BIG; s.GS = 0; s.off = 0; { const int cnt_ = (s.K / 64) * s.ntn * s.nbatch; if (g >= base && g < base + cnt_) cvt_tile(s, my, g - base); base += cnt_; } }
    { CvtSeg s; s.src = a.w_ukv; s.dst = WUKV; s.sstride = 0; s.dstride = 0; s.ld = 1536; s.nsrc = 1536; s.K = 256; s.ntn = 24; s.nbatch = 1; s.G = BIG; s.GS = 0; s.off = 0; { const int cnt_ = (s.K / 64) * s.ntn * s.nbatch; if (g >= base && g < base + cnt_) cvt_tile(s, my, g - base); base += cnt_; } }
#ifdef FX_WOUT8
    { CvtSeg s; s.src = a.w_out; s.dst = WOUT; s.sstride = 0; s.dstride = 0; s.ld = 2048; s.nsrc = 2048; s.K = 2048; s.ntn = 32; s.nbatch = 1; s.G = BIG; s.GS = 0; s.off = 0; { const int cnt_ = (s.K / 64) * s.ntn * s.nbatch; if (g >= base && g < base + cnt_) cvt_tile8(s, my, g - base, W8_SCALE); base += cnt_; } }
#else
    { CvtSeg s; s.src = a.w_out; s.dst = WOUT; s.sstride = 0; s.dstride = 0; s.ld = 2048; s.nsrc = 2048; s.K = 2048; s.ntn = 32; s.nbatch = 1; s.G = BIG; s.GS = 0; s.off = 0; { const int cnt_ = (s.K / 64) * s.ntn * s.nbatch; if (g >= base && g < base + cnt_) cvt_tile(s, my, g - base); base += cnt_; } }
#endif
    { CvtSeg s; s.src = a.eg; s.dst = WGU; s.sstride = 2048ll * 512; s.dstride = 1024ll * 2048; s.ld = 512; s.nsrc = 512; s.K = 2048; s.ntn = 8; s.nbatch = 64; s.G = 128; s.GS = 256; s.off = 0; { const int cnt_ = (s.K / 64) * s.ntn * s.nbatch; if (g >= base && g < base + cnt_) cvt_tile8(s, my, g - base, W8_SCALE); base += cnt_; } }
    { CvtSeg s; s.src = a.eu; s.dst = WGU; s.sstride = 2048ll * 512; s.dstride = 1024ll * 2048; s.ld = 512; s.nsrc = 512; s.K = 2048; s.ntn = 8; s.nbatch = 64; s.G = 128; s.GS = 256; s.off = 128; { const int cnt_ = (s.K / 64) * s.ntn * s.nbatch; if (g >= base && g < base + cnt_) cvt_tile8(s, my, g - base, W8_SCALE); base += cnt_; } }
    { CvtSeg s; s.src = a.ed; s.dst = WDN; s.sstride = 512ll * 2048; s.dstride = 2048ll * 512; s.ld = 2048; s.nsrc = 2048; s.K = 512; s.ntn = 32; s.nbatch = 64; s.G = BIG; s.GS = 0; s.off = 0; { const int cnt_ = (s.K / 64) * s.ntn * s.nbatch; if (g >= base && g < base + cnt_) cvt_tile8(s, my, g - base, W8_SCALE); base += cnt_; } }
    { CvtSeg s; s.src = a.sg; s.dst = (bf16_t*)((unsigned char*)WGU + 64ull * 1024 * 2048); s.sstride = 0; s.dstride = 0; s.ld = 512; s.nsrc = 512; s.K = 2048; s.ntn = 8; s.nbatch = 1; s.G = 128; s.GS = 256; s.off = 0; { const int cnt_ = (s.K / 64) * s.ntn * s.nbatch; if (g >= base && g < base + cnt_) cvt_tile8(s, my, g - base, W8_SCALE); base += cnt_; } }
    { CvtSeg s; s.src = a.su; s.dst = (bf16_t*)((unsigned char*)WGU + 64ull * 1024 * 2048); s.sstride = 0; s.dstride = 0; s.ld = 512; s.nsrc = 512; s.K = 2048; s.ntn = 8; s.nbatch = 1; s.G = 128; s.GS = 256; s.off = 128; { const int cnt_ = (s.K / 64) * s.ntn * s.nbatch; if (g >= base && g < base + cnt_) cvt_tile8(s, my, g - base, W8_SCALE); base += cnt_; } }
    { CvtSeg s; s.src = a.sd; s.dst = (bf16_t*)((unsigned char*)WDN + 64ull * 2048 * 512); s.sstride = 0; s.dstride = 0; s.ld = 2048; s.nsrc = 2048; s.K = 512; s.ntn = 32; s.nbatch = 1; s.G = BIG; s.GS = 0; s.off = 0; { const int cnt_ = (s.K / 64) * s.ntn * s.nbatch; if (g >= base && g < base + cnt_) cvt_tile8(s, my, g - base, W8_SCALE); base += cnt_; } }
}
}
namespace fx {
#define XB_TMO      128
#define XB_XCNT(j)  (256  + 64 * (j))
#define XB_XSUB(j)  (1280 + 64 * (j))
#define XB_XGEN(j)  (2304 + 64 * (j))
#define XB_TOP      3328
#define XB_TOPGEN   3392
#define XCD_BAR_WORDS 3456
#define XB_SPIN_CAP (1u << 22)
__device__ __forceinline__ unsigned xb_ld(unsigned* p)              { return __hip_atomic_load(p, __ATOMIC_RELAXED, __HIP_MEMORY_SCOPE_AGENT); }
__device__ __forceinline__ unsigned xb_add(unsigned* p, unsigned v) { return __hip_atomic_fetch_add(p, v, __ATOMIC_RELAXED, __HIP_MEMORY_SCOPE_AGENT); }
__device__ __forceinline__ unsigned xb_xcc_id() { return (unsigned)__builtin_amdgcn_s_getreg((3 << 11) | 20) & 0xFu; }
#define XB_SPIN(cond, bar) do { unsigned _sp = 0; while (cond) { __builtin_amdgcn_s_sleep(1); \
    if ((++_sp & 255u) == 0u) { if (xb_ld(&(bar)[XB_TMO])) break; if (_sp > XB_SPIN_CAP) { atomicAdd(&(bar)[XB_TMO], 1u); break; } } } } while (0)
struct XcdBarrier { unsigned* bar; unsigned x; volatile FX_LAS unsigned* st; };
__device__ __forceinline__ XcdBarrier xcd_barrier_post(unsigned* bar, volatile FX_LAS unsigned* st, int tidp) {
    XcdBarrier b; b.bar = bar; b.x = xb_xcc_id(); b.st = st;
    if (tidp == 0) (void)xb_add(&bar[XB_XCNT(b.x)], 1u);
    return b;
}
__device__ __forceinline__ void xcd_barrier_complete(unsigned* bar, unsigned x, unsigned& nloc, unsigned& nx) {
    const unsigned G = gridDim.x * gridDim.y * gridDim.z;
    unsigned sum, cnt, mine, sp = 0u;
    for (;;) {
        sum = 0u; cnt = 0u; mine = 0u;
#pragma unroll
        for (unsigned j = 0; j < 16; ++j) { const unsigned c = xb_ld(&bar[XB_XCNT(j)]); sum += c; cnt += (c > 0u) ? 1u : 0u; mine = (j == x) ? c : mine; }
        if (sum == G) break;
        __builtin_amdgcn_s_sleep(1);
        if ((++sp & 255u) == 0u) { if (xb_ld(&bar[XB_TMO])) break; if (sp > XB_SPIN_CAP) { atomicAdd(&bar[XB_TMO], 1u); break; } }
    }
    nloc = mine > 0u ? mine : 1u; nx = cnt > 0u ? cnt : 1u;
}
__device__ __forceinline__ void xcd_barrier(const XcdBarrier& b, int tidp) {
    asm volatile("s_waitcnt vmcnt(0)" ::: "memory");
    __syncthreads();
    if (tidp == 0) {
        unsigned* bar = b.bar;
        __builtin_amdgcn_s_waitcnt(0);
        unsigned nloc = b.st[0], nx = b.st[1];
        if (nloc == 0u) { xcd_barrier_complete(bar, b.x, nloc, nx); b.st[0] = nloc; b.st[1] = nx; }
        const unsigned old = xb_add(&bar[XB_XSUB(b.x)], 1u);
        const unsigned gen = old / nloc;
        if (old + 1u == (gen + 1u) * nloc) {
            __builtin_amdgcn_fence(__ATOMIC_RELEASE, "agent");
            asm volatile("s_waitcnt vmcnt(0)" ::: "memory");
            const unsigned og = xb_add(&bar[XB_TOP], 1u);
            const unsigned tg = og / nx;
            if (og + 1u == (tg + 1u) * nx) xb_add(&bar[XB_TOPGEN], 1u);
            else XB_SPIN(xb_ld(&bar[XB_TOPGEN]) == tg, bar);
            __builtin_amdgcn_fence(__ATOMIC_ACQUIRE, "agent");
            xb_add(&bar[XB_XGEN(b.x)], 1u);
            asm volatile("s_waitcnt vmcnt(0)" ::: "memory");
        } else {
            XB_SPIN(xb_ld(&bar[XB_XGEN(b.x)]) == gen, bar);
            __builtin_amdgcn_fence(__ATOMIC_ACQUIRE, "agent");
            asm volatile("s_waitcnt vmcnt(0)" ::: "memory");
        }
    }
    __syncthreads();
}

__device__ __forceinline__ void modp_phase(FX_LAS unsigned char* lds_, const float* c, const float* ada_w, float* MODP, int wg, int nwg, int tidp) {
    float* cact = (float*)(char*)lds_;
    for (int i = tidp; i < 8192; i += 512) { const float v = c[i]; cact[i] = v / (1.f + expf(-v)); }
    __syncthreads();
    int tid_ = tidp; asm volatile("" : "+v"(tid_));
    const int wid = tid_ >> 6, lane = tid_ & 63;
    for (int u = wg * 8 + wid; u < 2 * 48 * 32; u += nwg * 8) {
        const int kc = u & 31, nc = (u >> 5) % 48, l = u / (48 * 32);
        const float* w = ada_w + (size_t)l * 2048 * 12288 + (size_t)(kc * 64) * 12288 + nc * 256 + lane * 4;
        f32x4 a0 = {0.f, 0.f, 0.f, 0.f}, a1 = a0, a2 = a0, a3 = a0;
#pragma unroll 16
        for (int k = 0; k < 64; ++k) { const f32x4 wv = *(const f32x4*)(w + (size_t)k * 12288); const int kk = kc * 64 + k;
            a0 += wv * cact[kk]; a1 += wv * cact[2048 + kk]; a2 += wv * cact[4096 + kk]; a3 += wv * cact[6144 + kk]; }
        float* dst = MODP + (((size_t)l * 32 + kc) * 4) * 12288 + nc * 256 + lane * 4;
        *(f32x4*)dst = a0; *(f32x4*)(dst + 12288) = a1; *(f32x4*)(dst + 2 * 12288) = a2; *(f32x4*)(dst + 3 * 12288) = a3;
    }
    __syncthreads();
}
__device__ __forceinline__ void tab_phase(float* tab, int gtid) {
    if (gtid < 2048) { const int p = gtid >> 5, f = gtid & 31; const float inv = powf(10000.f, -(float)(2 * f) / 64.f); const float a = (float)p * inv; tab[gtid] = cosf(a); tab[2048 + gtid] = sinf(a); }
    else if (gtid < 3072) { const int i = gtid - 2048, p = i >> 4, f = i & 15; const float inv = powf(10000.f, -(float)(2 * f) / 32.f); const float a = (float)p * inv; tab[4096 + i] = cosf(a); tab[5120 + i] = sinf(a); }
}
__device__ __forceinline__ void coef2_phase(const float* MODP, const float* ada_b, const float* pre_mix_gain, const float* post_mix_gain, const float* pre_ffn_gain, const float* post_ffn_gain, float* coef, int gtid, int nthr) {
    for (int i = gtid; i < 2 * 4 * 2048; i += nthr) { const int d = i & 2047, b = (i >> 11) & 3, l = i >> 13;
        float m[6];
#pragma unroll
        for (int j = 0; j < 6; ++j) { float s = ada_b[l * 12288 + j * 2048 + d];
            for (int kc = 0; kc < 32; ++kc) s += MODP[(((size_t)l * 32 + kc) * 4 + b) * 12288 + j * 2048 + d];
            m[j] = s; }
        float* c = coef + ((size_t)l * 4 + b) * 6 * 2048;
        c[0 * 2048 + d] = m[2] * post_mix_gain[l * 2048 + d];
        c[1 * 2048 + d] = pre_ffn_gain[l * 2048 + d] * (1.f + m[4]);
        c[2 * 2048 + d] = m[3];
        c[3 * 2048 + d] = m[5] * post_ffn_gain[l * 2048 + d];
        c[4 * 2048 + d] = pre_mix_gain[l * 2048 + d] * (1.f + m[1]);
        c[5 * 2048 + d] = m[0]; }
}
__device__ __forceinline__ void coef3_phase(FX_LAS unsigned char* lds_, const float* MODP, const float* ada_b, const float* pre_mix_gain, const float* post_mix_gain, const float* pre_ffn_gain, const float* post_ffn_gain, float* coef, int wg, int nwg, int tidp) {
    FX_LAS float* ms = (FX_LAS float*)lds_;
    int tid_ = tidp; asm volatile("" : "+v"(tid_));
    const int wid = __builtin_amdgcn_readfirstlane(tid_ >> 6), lane = tid_ & 63;
    for (int base = wg * 64; base < 2 * 4 * 2048; base += nwg * 64) {
        const int i = base + lane, d = i & 2047, b = (i >> 11) & 3, l = i >> 13;
        if (wid < 6) { const int j = wid; float pv[32];
#pragma unroll
            for (int kc = 0; kc < 32; ++kc) pv[kc] = MODP[(((size_t)l * 32 + kc) * 4 + b) * 12288 + j * 2048 + d];
            float s = ada_b[l * 12288 + j * 2048 + d];
#pragma unroll
            for (int kc = 0; kc < 32; ++kc) s += pv[kc];
            ms[j * 64 + lane] = s; }
        __syncthreads();
        if (wid == 0) { float m[6];
#pragma unroll
            for (int j = 0; j < 6; ++j) m[j] = ms[j * 64 + lane];
            float* c = coef + ((size_t)l * 4 + b) * 6 * 2048;
            c[0 * 2048 + d] = m[2] * post_mix_gain[l * 2048 + d];
            c[1 * 2048 + d] = pre_ffn_gain[l * 2048 + d] * (1.f + m[4]);
            c[2 * 2048 + d] = m[3];
            c[3 * 2048 + d] = m[5] * post_ffn_gain[l * 2048 + d];
            c[4 * 2048 + d] = pre_mix_gain[l * 2048 + d] * (1.f + m[1]);
            c[5 * 2048 + d] = m[0]; }
        __syncthreads();
    }
}
__device__ __forceinline__ void prenorm_phase(const float* x, const float* coef_l, bf16_t* HA, int wg, int nwg, int tidp) {
    int tid_ = tidp; asm volatile("" : "+v"(tid_));
    const int wid = tid_ >> 6, lane = tid_ & 63;
    for (int t = wg * 8 + wid; t < T; t += nwg * 8) {
        const float* cn = coef_l + (size_t)(t / S) * 6 * 2048;
        float xv[32]; float ss = 0.f;
#pragma unroll
        for (int i = 0; i < 4; ++i) { const int c = i * 512 + lane * 8; const f32x4 x0 = *(const f32x4*)(x + (size_t)t * 2048 + c), x1 = *(const f32x4*)(x + (size_t)t * 2048 + c + 4);
#pragma unroll
            for (int j = 0; j < 4; ++j) { xv[i * 8 + j] = x0[j]; xv[i * 8 + 4 + j] = x1[j]; ss += x0[j] * x0[j] + x1[j] * x1[j]; } }
        ss = wave_sum(ss); const float rx = rsqrtf(ss * (1.f / 2048.f) + EPS);
#pragma unroll
        for (int i = 0; i < 4; ++i) { const int c = i * 512 + lane * 8;
            const f32x4 e0 = *(const f32x4*)(cn + 4 * 2048 + c), e1 = *(const f32x4*)(cn + 4 * 2048 + c + 4), f0 = *(const f32x4*)(cn + 5 * 2048 + c), f1 = *(const f32x4*)(cn + 5 * 2048 + c + 4);
            float hv[8];
#pragma unroll
            for (int j = 0; j < 4; ++j) { hv[j] = xv[i * 8 + j] * rx * e0[j] + f0[j]; hv[4 + j] = xv[i * 8 + 4 + j] * rx * e1[j] + f1[j]; }
#ifdef FX_WIN8
            u32x2 w; w.x = cvt_pk4_fp8(hv[0], hv[1], hv[2], hv[3]); w.y = cvt_pk4_fp8(hv[4], hv[5], hv[6], hv[7]);
            *(u32x2*)((unsigned char*)HA + (size_t)t * 2048 + c) = w; }
#else
            u32x4 w; w.x = cvt_pk_bf16(hv[0], hv[1]); w.y = cvt_pk_bf16(hv[2], hv[3]); w.z = cvt_pk_bf16(hv[4], hv[5]); w.w = cvt_pk_bf16(hv[6], hv[7]);
            *(u32x4*)(HA + (size_t)t * 2048 + c) = w; }
#endif
    }
}

constexpr int LDS_ST = 139264, LDS_TOTAL = LDS_ST + 64 + EPI_LDS_BYTES;
static_assert(EPI_LDS_OFF == LDS_ST + 64 && LDS_TOTAL <= 160 * 1024, "LDS layout");
constexpr size_t WS_MODP = WS_R2;
#define FX_KAS __attribute__((address_space(4)))
template <class TY> __device__ __forceinline__ TY* fx_glob(TY* p) { __attribute__((address_space(1))) TY* g = (__attribute__((address_space(1))) TY*)p; asm volatile("" : "+s"(g)); return (TY*)g; }
struct MP {
    const float* x; const float* c; const float* ada_w; const float* ada_b; const float* pre_mix_gain; const float* w_in; const float* a_q_gain; const float* a_k_gain;
    const float* b_cq_gain; const float* b_ckv_gain; const float* w_uq; const float* w_ukv; const float* c_conv_w; const float* c_conv_b; const float* c_gate_b;
    const float* head_out_gain; const float* w_out; const float* post_mix_gain; const float* pre_ffn_gain; const float* router_w; const float* router_bias;
    const float* exp_w_gate; const float* exp_w_up; const float* exp_w_down; const float* sh_w_gate; const float* sh_w_up; const float* sh_w_down; const float* post_ffn_gain;
    char* ws; float* out;
};
#ifndef FX_NPHASE
#define FX_NPHASE 1000
#endif
#define PH_BEGIN const FX_KAS MP* pk = (const FX_KAS MP*)__builtin_amdgcn_kernarg_segment_ptr(); asm volatile("" : "+s"(pk)); char* ws = fx_glob(pk->ws); (void)ws; int gt_ = wid_s * 64 + fx_lane(); asm volatile("" : "+v"(gt_)); int wg_ = blockIdx.x, nwg_ = gridDim.x; asm volatile("" : "+s"(wg_), "+s"(nwg_)); const int wg = wg_, nwg = nwg_; (void)wg; (void)nwg; (void)gt_;
#define PH_BAR do { PH_BEGIN XcdBarrier b_; b_.bar = (unsigned*)(ws + WS_BAR); b_.x = xb_xcc_id(); b_.st = (volatile FX_LAS unsigned*)(lds + LDS_ST); xcd_barrier(b_, gt_); } while (0)
#define WSP(T_, off) ((T_*)(ws + (off)))
constexpr int QW_CNT = 3584;
constexpr unsigned HV_SLACK = 24;
__device__ __forceinline__ void harvest(FX_LAS unsigned char* lds, const FX_KAS MP* pk, char* ws, int tid, const unsigned nbar, const bool drain) {
    volatile FX_LAS unsigned* bw = (volatile FX_LAS unsigned*)(lds + LDS_ST);
    unsigned* bar = (unsigned*)(ws + WS_BAR);
    const int wave = tid >> 6; FX_LAS unsigned* my = (FX_LAS unsigned*)(lds) + wave * (64 * 33);
    CvtW a; a.w_in = fx_glob(pk->w_in) + (size_t)D * 4048; a.w_uq = fx_glob(pk->w_uq) + (size_t)384 * 1152; a.w_ukv = fx_glob(pk->w_ukv) + (size_t)256 * 1536; a.w_out = fx_glob(pk->w_out) + (size_t)D * D;
    a.eg = fx_glob(pk->exp_w_gate) + (size_t)NE * D * FF; a.eu = fx_glob(pk->exp_w_up) + (size_t)NE * D * FF; a.ed = fx_glob(pk->exp_w_down) + (size_t)NE * FF * D;
    a.sg = fx_glob(pk->sh_w_gate) + (size_t)D * FF; a.su = fx_glob(pk->sh_w_up) + (size_t)D * FF; a.sd = fx_glob(pk->sh_w_down) + (size_t)FF * D; a.W = (bf16_t*)(ws + WS_W + W_LAYER);
    __syncthreads();
    if (drain) {
        if (tid == 0) bw[3] = xb_ld(&bar[QW_CNT]);
        __syncthreads();
        const unsigned h = bw[3];
#pragma unroll 1
        for (unsigned g = h + (unsigned)(blockIdx.x * 8 + wave); g < (unsigned)CVT_TILES_PER_LAYER; g += gridDim.x * 8u) cvt_layer_one(a, my, (int)g);
        __syncthreads();
        return;
    }
#pragma unroll 1
    for (;;) {
        if (tid == 0) { unsigned nxt = 0xffffffffu; bool go = true;
            if (!drain) { unsigned sum = 0u;
#pragma unroll
                for (unsigned j = 0; j < 16; ++j) sum += xb_ld(&bar[XB_XSUB(j)]);
                const unsigned G = gridDim.x; go = (sum - nbar * G) + HV_SLACK < G; }
            if (go && xb_ld(&bar[QW_CNT]) < (unsigned)CVT_TILES_PER_LAYER) { const unsigned b0 = xb_add(&bar[QW_CNT], 8u); if (b0 < (unsigned)CVT_TILES_PER_LAYER) nxt = b0; }
            bw[3] = nxt; }
        __syncthreads();
        const unsigned base = bw[3];
        if (base == 0xffffffffu) break;
        const int g = (int)base + wave;
        if (g < CVT_TILES_PER_LAYER) cvt_layer_one(a, my, g);
        __syncthreads();
    }
    __syncthreads();
}
#ifndef FX_HARVEST
#define FX_HARVEST 1
#endif
#if FX_HARVEST && FX_YMPERM
#error "the work-queue conversion path does not implement the permuted w_out k order"
#endif
#define PH_HARVEST(n, dr) do { if (FX_HARVEST && l == 0 && ((dr) || FX_HARVEST == 1)) { PH_BEGIN harvest(lds, pk, ws, gt_, (n), (dr)); } } while (0)
#ifndef FX_DUP
#define FX_DUP -1
#endif
#define FX_NE ((FX_NOEPI && rep_ == 1) ? FX_NOEPI : 0)
#define FX_REP(n) _Pragma("unroll 1") for (int rep_ = 0; rep_ < ((FX_DUP == (n) && l == 0) ? 2 : 1); ++rep_)
template <int l> __device__ __forceinline__ void layer_body(FX_LAS unsigned char* lds, unsigned char* shm, const int wid_s) {
        FX_REP(2) { PH_BEGIN const bf16_t* W = WSP(const bf16_t, WS_W + (size_t)l * W_LAYER);
#ifdef FX_WIN8
          DenseSched Sc; Sc.init(T, 4096, nwg, wg, 2048, W + W_IN / 2, 2048, 1); EpiBf16 E; E.es = lds + EPI_LDS_OFF; E.O = WSP(bf16_t, WS_R1); E.gates = WSP(float, WS_GATES); E.ldc = 4096; E.scale = W8_INV;
          gemm_phase<EpiBf16, DenseSched, true>(lds, (const char*)WSP(bf16_t, WS_HA), 2048, Sc, E, gt_, FX_NE); }
#else
          DenseSched Sc; Sc.init(T, 4096, nwg, wg, 2048 * 2, W + W_IN / 2, 2048); EpiBf16 E; E.es = lds + EPI_LDS_OFF; E.O = WSP(bf16_t, WS_R1); E.gates = WSP(float, WS_GATES); E.ldc = 4096; E.scale = 1.f;
          gemm_phase<EpiBf16, DenseSched>(lds, (const char*)WSP(bf16_t, WS_HA), 2048, Sc, E, gt_); }
#endif
        PH_HARVEST(3u, false);
        PH_BAR;
        FX_REP(3) { PH_BEGIN char* R2 = ws + WS_R2; float* tab = WSP(float, WS_TAB);
          P3Args a; a.PROJ = WSP(bf16_t, WS_R1); a.GATES = WSP(float, WS_GATES); a.gate_b = fx_glob(pk->c_gate_b) + l * 16; a.conv_w = fx_glob(pk->c_conv_w) + (size_t)l * 5 * 1024; a.conv_b = fx_glob(pk->c_conv_b) + l * 1024;
          a.aq_gain = fx_glob(pk->a_q_gain) + l * 128; a.ak_gain = fx_glob(pk->a_k_gain) + l * 128; a.cq_gain = fx_glob(pk->b_cq_gain) + l * 384; a.ckv_gain = fx_glob(pk->b_ckv_gain) + l * 256;
          a.cosA = tab; a.sinA = tab + 2048; a.cosB = tab + 4096; a.sinB = tab + 5120;
          a.QA = (bf16_t*)(R2 + R2_QA); a.KA = (bf16_t*)(R2 + R2_KA); a.CQN = (bf16_t*)(R2 + R2_CQN); a.CKVN = (bf16_t*)(R2 + R2_CKVN); a.KR = (bf16_t*)(R2 + R2_KR); a.QC = (bf16_t*)(R2 + R2_QC); a.KC = (bf16_t*)(R2 + R2_KC);
          a.KCT = (bf16_t*)(R2 + R2_KCT); a.NLOC = WSP(float, WS_NLOC); a.GSC = WSP(float, WS_GSC);
          p3_phase(lds, a, wg, nwg, gt_); }
        PH_BAR;
        FX_REP(4) {
        { PH_BEGIN const bf16_t* W = WSP(const bf16_t, WS_W + (size_t)l * W_LAYER); char* R2 = ws + WS_R2; float* tab = WSP(float, WS_TAB);
          DenseSched Sc; Sc.init(T, 1280, nwg, wg, 384 * 2, W + W_UQ / 2, 384); EpiQB E; E.O = (bf16_t*)(R2 + R2_QB); E.cosB = tab + 4096; E.sinB = tab + 5120;
          gemm_phase<EpiQB, DenseSched>(lds, (const char*)(R2 + R2_CQN), 384, Sc, E, gt_); }
        { PH_BEGIN const bf16_t* W = WSP(const bf16_t, WS_W + (size_t)l * W_LAYER); char* R2 = ws + WS_R2;
          DenseSched Sc; Sc.init(T, 1536, nwg, (wg + nwg / 2) % nwg  , 256 * 2, W + W_UKV / 2, 256); EpiBf16 E; E.es = lds + EPI_LDS_OFF; E.O = (bf16_t*)(R2 + R2_KVB); E.gates = nullptr; E.ldc = 1536; E.scale = 1.f;
          gemm_phase<EpiBf16, DenseSched>(lds, (const char*)(R2 + R2_CKVN), 256, Sc, E, gt_); }
        { PH_BEGIN char* R2 = ws + WS_R2;
          scan_phase((const bf16_t*)(R2 + R2_KCT), WSP(float, WS_NLOC), WSP(float, WS_GSC), (bf16_t*)(R2 + R2_CPREV), WSP(float, WS_NPREV), WSP(float, WS_MPREV), wg * 512 + gt_, nwg * 512); }
        }
        PH_HARVEST(5u, false);
        PH_BAR;
        FX_REP(5) {
#pragma unroll 1
          for (int ui = 0; ui < 2; ++ui) { PH_BEGIN char* R2 = ws + WS_R2; int u;
              if (nwg == 256) { const int x = wg & 7, j = wg >> 3; if (ui == 1 && j >= 16) break; u = x * 48 + j + ui * 32; } else { u = wg + ui * nwg; if (u >= 384) break; }
              attn_gqa_unit(u, (const bf16_t*)(R2 + R2_QA), (const bf16_t*)(R2 + R2_KA), WSP(const bf16_t, WS_R1), WSP(bf16_t, WS_HA), fx_glob(pk->head_out_gain) + l * D, (char*)shm, gt_); }
#pragma unroll 1
          for (int ui = 0; ui < 2; ++ui) { PH_BEGIN char* R2 = ws + WS_R2; int u;
              if (nwg == 256) { const int x = wg & 7, j = wg >> 3; if (j < 16) { if (ui == 1) break; u = x * 48 + j; } else u = x * 48 + 16 + (j - 16) * 2 + ui; } else { u = wg + ui * nwg; if (u >= 384) break; }
              attn_mla_unit(u, (const bf16_t*)(R2 + R2_QB), (const bf16_t*)(R2 + R2_KVB), (const bf16_t*)(R2 + R2_KR), WSP(bf16_t, WS_HA), fx_glob(pk->head_out_gain) + l * D, (char*)shm, gt_); }
          { PH_BEGIN char* R2 = ws + WS_R2;
            McArgs a; a.PROJ = WSP(bf16_t, WS_R1); a.GATES = WSP(float, WS_GATES); a.gate_b = fx_glob(pk->c_gate_b) + l * 16; a.QC = (bf16_t*)(R2 + R2_QC); a.KC = (bf16_t*)(R2 + R2_KC); a.CPREV = (bf16_t*)(R2 + R2_CPREV);
            a.NPREV = WSP(float, WS_NPREV); a.MPREV = WSP(float, WS_MPREV); a.hog = fx_glob(pk->head_out_gain) + l * D; a.YM = WSP(bf16_t, WS_HA);
            mlstm_c_phase(lds, a, wg, nwg, gt_); } }
        PH_HARVEST(6u, false);
        PH_BAR;
        FX_REP(6) { PH_BEGIN const bf16_t* W = WSP(const bf16_t, WS_W + (size_t)l * W_LAYER);
#ifdef FX_WOUT8
          DenseSched Sc; Sc.init(T, 2048, nwg, wg, 2048, W + W_OUT / 2, 2048, 1); EpiBf16 E; E.es = lds + EPI_LDS_OFF; E.O = WSP(bf16_t, WS_R1); E.gates = nullptr; E.ldc = 2048; E.scale = W8_INV;
          gemm_phase<EpiBf16, DenseSched, true>(lds, (const char*)WSP(bf16_t, WS_HA), 2048, Sc, E, gt_, FX_NE); }
#else
          DenseSched Sc; Sc.init(T, 2048, nwg, wg, 2048 * 2, W + W_OUT / 2, 2048); EpiBf16 E; E.es = lds + EPI_LDS_OFF; E.O = WSP(bf16_t, WS_R1); E.gates = nullptr; E.ldc = 2048; E.scale = 1.f;
          gemm_phase<EpiBf16, DenseSched>(lds, (const char*)WSP(bf16_t, WS_HA), 2048, Sc, E, gt_); }
#endif
        PH_HARVEST(7u, false);
        PH_BAR;
        { PH_BEGIN p7_phase<(l != 0)>(lds, l == 0 ? (const void*)fx_glob(pk->x) : (const void*)WSP(const bf16_t, WS_XRES), WSP(const bf16_t, WS_R1), WSP(float, WS_COEF) + (size_t)l * 4 * 6 * 2048, fx_glob(pk->router_w) + (size_t)l * D * 64, fx_glob(pk->router_bias) + l * 64,
                            WSP(bf16_t, WS_XRES), WSP(unsigned char, WS_HA), WSP(int, WS_SELE), WSP(float, WS_SELG), WSP(int, WS_CNT) + l * 64, WSP(int, WS_WGBASE), wg, nwg, gt_); }
        PH_BAR;
        { PH_BEGIN p8_phase(lds, WSP(int, WS_SELE), WSP(float, WS_SELG), WSP(int, WS_CNT) + l * 64, WSP(int, WS_WGBASE), WSP(int, WS_ROWTOK), WSP(float, WS_ROWG), WSP(int, WS_SLOT), wg, nwg, gt_); }
        PH_BAR;
        FX_REP(9) { PH_BEGIN const bf16_t* W = WSP(const bf16_t, WS_W + (size_t)l * W_LAYER);
          p9_phase(lds, WSP(unsigned char, WS_HA), (const unsigned char*)(W + W_GU / 2), WSP(int, WS_CNT) + l * 64, WSP(int, WS_ROWTOK), WSP(unsigned char, WS_R1), wg, nwg, gt_, FX_NE); }
        PH_HARVEST(10u, false);
        PH_BAR;
        FX_REP(10) { PH_BEGIN const bf16_t* W = WSP(const bf16_t, WS_W + (size_t)l * W_LAYER);
          p10_phase(lds, WSP(unsigned char, WS_R1), (const unsigned char*)(W + W_DN / 2), WSP(int, WS_CNT) + l * 64, WSP(float, WS_ROWG), WSP(unsigned char, WS_R2), wg, nwg, gt_, FX_NE); }
        PH_HARVEST(11u, false);
        PH_BAR;
        { PH_BEGIN p11_phase<(l == 1)>(WSP(bf16_t, WS_XRES), WSP(unsigned char, WS_R2), WSP(int, WS_SLOT), WSP(float, WS_SELG), WSP(float, WS_COEF) + (size_t)l * 4 * 6 * 2048, l == 0 ? WSP(float, WS_COEF) + 4 * 6 * 2048 : nullptr,
                             l == 1 ? (void*)fx_glob(pk->out) : (void*)WSP(bf16_t, WS_XRES), WSP(bf16_t, WS_HA), wg, nwg, gt_); }
        PH_HARVEST(12u, true);
        if (l == 0) PH_BAR;
}
__global__ __launch_bounds__(512, 2) void mega(MP p_unused) {
    extern __shared__ __attribute__((aligned(16))) unsigned char shm[];
    FX_LAS unsigned char* lds = (FX_LAS unsigned char*)shm;
    const int wid_s = __builtin_amdgcn_readfirstlane((int)threadIdx.x >> 6);
    { volatile FX_LAS unsigned* st = (volatile FX_LAS unsigned*)(lds + LDS_ST);
      PH_BEGIN if (gt_ == 0) { st[0] = 0u; st[1] = 0u; st[2] = 0u; st[3] = 0u; }
      __syncthreads();
      (void)xcd_barrier_post((unsigned*)(ws + WS_BAR), st, gt_); }
    { PH_BEGIN const int wave = wid_s;     FX_LAS unsigned* my = (FX_LAS unsigned*)(lds) + wave * (64 * 33); int rot = 0;
#pragma unroll 1
      for (int l = 0; l < ((FX_DUP == 0) ? 4 : (FX_HARVEST ? 1 : 2)); ++l) { const int lw = l & 1; CvtW a; a.w_in = fx_glob(pk->w_in) + (size_t)lw * D * 4048; a.w_uq = fx_glob(pk->w_uq) + (size_t)lw * 384 * 1152; a.w_ukv = fx_glob(pk->w_ukv) + (size_t)lw * 256 * 1536; a.w_out = fx_glob(pk->w_out) + (size_t)lw * D * D;
          a.eg = fx_glob(pk->exp_w_gate) + (size_t)lw * NE * D * FF; a.eu = fx_glob(pk->exp_w_up) + (size_t)lw * NE * D * FF; a.ed = fx_glob(pk->exp_w_down) + (size_t)lw * NE * FF * D;
          a.sg = fx_glob(pk->sh_w_gate) + (size_t)lw * D * FF; a.su = fx_glob(pk->sh_w_up) + (size_t)lw * D * FF; a.sd = fx_glob(pk->sh_w_down) + (size_t)lw * FF * D; a.W = (bf16_t*)(ws + WS_W + (size_t)lw * W_LAYER);
          cvt_layer(a, my, wg * 8 + wave, nwg * 8, rot); }
      __syncthreads(); }
    { PH_BEGIN modp_phase(lds, fx_glob(pk->c), fx_glob(pk->ada_w), WSP(float, WS_MODP), wg, nwg, gt_); tab_phase(WSP(float, WS_TAB), wg * 512 + gt_); }
#if FX_DUP == 20
    { PH_BEGIN modp_phase(lds, fx_glob(pk->c), fx_glob(pk->ada_w), WSP(float, WS_MODP), wg, nwg, gt_); tab_phase(WSP(float, WS_TAB), wg * 512 + gt_); }
#endif
    PH_BAR;
    { PH_BEGIN coef3_phase(lds, WSP(float, WS_MODP), fx_glob(pk->ada_b), fx_glob(pk->pre_mix_gain), fx_glob(pk->post_mix_gain), fx_glob(pk->pre_ffn_gain), fx_glob(pk->post_ffn_gain), WSP(float, WS_COEF), wg, nwg, gt_); }
    PH_BAR;
    { PH_BEGIN prenorm_phase(fx_glob(pk->x), WSP(float, WS_COEF), WSP(bf16_t, WS_HA), wg, nwg, gt_); }
#if FX_DUP == 22
    { PH_BEGIN prenorm_phase(fx_glob(pk->x), WSP(float, WS_COEF), WSP(bf16_t, WS_HA), wg, nwg, gt_); }
#endif
    PH_BAR;
#if FX_DUP == 99
    PH_BAR; PH_BAR; PH_BAR; PH_BAR; PH_BAR; PH_BAR; PH_BAR; PH_BAR; PH_BAR; PH_BAR;
#endif
    layer_body<0>(lds, shm, wid_s);
    layer_body<1>(lds, shm, wid_s);
}
}

extern "C" void kernel_launch(void* const* d_in, const int* in_sizes, int n_in, void* d_out, int out_size, void* d_ws, size_t ws_size, hipStream_t stream) {
    using namespace fx;
    static int grid = 0;
    if (!grid) {
        int dev = 0, cus = 0, per_cu = 0;
        (void)hipGetDevice(&dev);
        (void)hipDeviceGetAttribute(&cus, hipDeviceAttributeMultiprocessorCount, dev);
        (void)hipFuncSetAttribute((const void*)mega, hipFuncAttributeMaxDynamicSharedMemorySize, LDS_TOTAL);
        (void)hipOccupancyMaxActiveBlocksPerMultiprocessor(&per_cu, (const void*)mega, 512, LDS_TOTAL);
        if (cus > 256) cus = 256;
        grid = per_cu >= 1 ? cus : 0;
    }
    if (!grid) return;
    (void)hipMemsetAsync((char*)d_ws + WS_BAR, 0, 16384, stream);
    static_assert(WS_CNT + 512 <= WS_BAR + 16384 && WS_CNT >= WS_BAR + (size_t)XCD_BAR_WORDS * 4 && WS_CNT >= WS_BAR + (size_t)(QW_CNT + 1) * 4, "counter block placement");
    MP p{};
    const float** q = (const float**)&p;
    for (int i = 0; i < 28; ++i) q[i] = (const float*)d_in[i];
    p.ws = (char*)d_ws; p.out = (float*)d_out;
    hipLaunchKernelGGL(mega, dim3(grid), dim3(512), LDS_TOTAL, stream, p);
}
```

```cpp
#define FX_WIN8 1
#define FX_WOUT8 1
#define FX_HARVEST 0
#include <hip/hip_runtime.h>
#include <stdint.h>
#include <math.h>
#ifndef FX_SEAM
#define FX_SEAM 1
#endif
#ifndef FX_WARM
#define FX_WARM 0
#endif
#ifndef FX_NOEPI
#define FX_NOEPI 0
#endif
namespace fx {
#define FX_LAS __attribute__((address_space(3)))
typedef unsigned short bf16_t;
typedef short bf16x8 __attribute__((ext_vector_type(8)));
typedef short s16x4 __attribute__((ext_vector_type(4)));
typedef float f32x4 __attribute__((ext_vector_type(4)));
typedef float f32x16 __attribute__((ext_vector_type(16)));
typedef unsigned u32x4 __attribute__((ext_vector_type(4)));
typedef unsigned u32x2 __attribute__((ext_vector_type(2)));
typedef float f32x2 __attribute__((ext_vector_type(2)));

constexpr int D = 2048, NB = 4, S = 4096, T = NB * S, DEPTH = 2;
constexpr int NE = 64, FF = 512;
constexpr float EPS = 1e-6f;
constexpr int PW = 4096;
constexpr int O_AQ = 0, O_AK = 768, O_AV = 1024, O_BCQ = 1280, O_BCKV = 1664, O_BKR = 1920, O_CQ = 1984, O_CK = 2496, O_CV = 3008, O_CO = 3520, O_CG = 4032;

typedef __bf16 bf16x2_t __attribute__((ext_vector_type(2)));
__device__ __forceinline__ unsigned cvt_pk_bf16(float lo, float hi) { const bf16x2_t r = __builtin_convertvector((f32x2){lo, hi}, bf16x2_t); return __builtin_bit_cast(unsigned, r); }
__device__ __forceinline__ float bf2f(bf16_t b) { return __uint_as_float(((unsigned)b) << 16); }
__device__ __forceinline__ float bflo(unsigned w) { return __uint_as_float(w << 16); }
__device__ __forceinline__ float bfhi(unsigned w) { return __uint_as_float(w & 0xffff0000u); }
__device__ __forceinline__ bf16_t f2bf(float f) { return (bf16_t)(cvt_pk_bf16(f, 0.f) & 0xffffu); }
__device__ __forceinline__ float sigmoid_f(float x) { return __builtin_amdgcn_rcpf(1.f + __expf(-x)); }
__device__ __forceinline__ float silu_f(float x) { return x * __builtin_amdgcn_rcpf(1.f + __expf(-x)); }
__device__ __forceinline__ int fx_lane() { unsigned z = 0u; asm volatile("" : "+v"(z)); return (int)__builtin_amdgcn_mbcnt_hi(~0u, __builtin_amdgcn_mbcnt_lo(~0u, z)); }
#ifndef FX_DPPRED
#define FX_DPPRED 1
#endif
#if FX_DPPRED
#define FX_DPP(IDENT, V, CTRL, RMASK) __builtin_bit_cast(float, __builtin_amdgcn_update_dpp(__builtin_bit_cast(int, (float)(IDENT)), __builtin_bit_cast(int, (V)), (CTRL), (RMASK), 0xF, false))
__device__ __forceinline__ float wave_sum(float v) {
    v += FX_DPP(0.f, v, 0xB1, 0xF); v += FX_DPP(0.f, v, 0x4E, 0xF); v += FX_DPP(0.f, v, 0x141, 0xF); v += FX_DPP(0.f, v, 0x140, 0xF);
    v += FX_DPP(0.f, v, 0x142, 0xA); v += FX_DPP(0.f, v, 0x143, 0xC);
    return __builtin_bit_cast(float, __builtin_amdgcn_readlane(__builtin_bit_cast(int, v), 63));
}
__device__ __forceinline__ float wave_max(float v) {
    const float NI = -3.4028234664e38f;
    v = fmaxf(v, FX_DPP(NI, v, 0xB1, 0xF)); v = fmaxf(v, FX_DPP(NI, v, 0x4E, 0xF)); v = fmaxf(v, FX_DPP(NI, v, 0x141, 0xF)); v = fmaxf(v, FX_DPP(NI, v, 0x140, 0xF));
    v = fmaxf(v, FX_DPP(NI, v, 0x142, 0xA)); v = fmaxf(v, FX_DPP(NI, v, 0x143, 0xC));
    return __builtin_bit_cast(float, __builtin_amdgcn_readlane(__builtin_bit_cast(int, v), 63));
}
#else
__device__ __forceinline__ float wave_sum(float v) { for (int o = 32; o >= 1; o >>= 1) v += __shfl_xor(v, o); return v; }
__device__ __forceinline__ float wave_max(float v) { for (int o = 32; o >= 1; o >>= 1) v = fmaxf(v, __shfl_xor(v, o)); return v; }
#endif

#ifndef FX_WGM
#define FX_WGM 8
#endif
#ifndef FX_CVT2D
#define FX_CVT2D 0
#endif
#ifndef FX_CVTPIPE
#define FX_CVTPIPE 1
#endif
#ifndef FX_PRIO8
#define FX_PRIO8 1
#endif
#ifndef FX_F8_32
#define FX_F8_32 0
#endif
typedef int i32x8 __attribute__((ext_vector_type(8)));
typedef int i32x4 __attribute__((ext_vector_type(4)));
constexpr float W8_SCALE = 32.f, W8_INV = 1.f / 32.f;
__device__ __forceinline__ unsigned cvt_pk4_fp8(float a, float b, float c, float d) { int w = 0; w = __builtin_amdgcn_cvt_pk_fp8_f32(a, b, w, false); w = __builtin_amdgcn_cvt_pk_fp8_f32(c, d, w, true); return (unsigned)w; }
struct CvtSeg { const float* src; bf16_t* dst; long long sstride, dstride; int ld, nsrc, K, ntn, nbatch, G, GS, off; int kperm = 0; };
__device__ __forceinline__ void cvt_tile(const CvtSeg sg, FX_LAS unsigned* my, int tile) {
    const int lane = fx_lane();
    const int ktn = sg.K / 64, per = ktn * sg.ntn;
    {
        const int b = tile / per, r = tile - b * per, nt = r / ktn, kt = r - nt * ktn;
        const int r4 = lane >> 4, c4 = lane & 15;
        const float* src = sg.src + (size_t)b * sg.sstride + (size_t)(kt * 64) * sg.ld + nt * 64 + 4 * c4;
        const bool ok = nt * 64 + 4 * c4 < sg.nsrc;
        f32x4 va[8], vb[8];
#pragma unroll
        for (int i = 0; i < 8; ++i) { const int kp = 4 * i + r4; const f32x4 z = {0.f, 0.f, 0.f, 0.f};
            va[i] = ok ? *(const f32x4*)(src + (size_t)(2 * kp) * sg.ld) : z; vb[i] = ok ? *(const f32x4*)(src + (size_t)(2 * kp + 1) * sg.ld) : z; }
#pragma unroll
        for (int i = 0; i < 8; ++i) { const int kp = 4 * i + r4;
#pragma unroll
            for (int j = 0; j < 4; ++j) my[(4 * c4 + j) * 33 + kp] = cvt_pk_bf16(va[i][j], vb[i][j]); }
        asm volatile("s_waitcnt lgkmcnt(0)" ::: "memory");
        bf16_t* dst = sg.dst + (size_t)b * sg.dstride;
#pragma unroll
        for (int i = 0; i < 8; ++i) {
            const int nl = (lane >> 3) + 8 * i, c = lane & 7, n = nt * 64 + nl;
            u32x4 w; w.x = my[nl * 33 + 4 * c]; w.y = my[nl * 33 + 4 * c + 1]; w.z = my[nl * 33 + 4 * c + 2]; w.w = my[nl * 33 + 4 * c + 3];
            const int row = (n / sg.G) * sg.GS + (n % sg.G) + sg.off;
            *(u32x4*)(dst + (size_t)row * sg.K + kt * 64 + 8 * c) = w;
        }
        asm volatile("s_waitcnt lgkmcnt(0)" ::: "memory");
    }
}
__device__ __forceinline__ void cvt_seg(const CvtSeg sg, FX_LAS unsigned* my, int gwave, int nwaves, int& rot) {
    const int total = (sg.K / 64) * sg.ntn * sg.nbatch;
    int first = (gwave - rot) % nwaves; if (first < 0) first += nwaves;
    for (int tile = first; tile < total; tile += nwaves) cvt_tile(sg, my, tile);
    rot = (rot + total) % nwaves;
}
__device__ __forceinline__ void cvt_tile8(const CvtSeg sg, FX_LAS unsigned* my, int tile, float scale) {
    const int lane = fx_lane();
    const int ktn = sg.K / 64, per = ktn * sg.ntn;
    {
        const int b = tile / per, r = tile - b * per, nt = r / ktn, kt = r - nt * ktn;
        const int r4 = lane >> 4, c4 = lane & 15;
        const float* src = sg.src + (size_t)b * sg.sstride + (size_t)(kt * 64) * sg.ld + nt * 64 + 4 * c4;
        const bool ok = nt * 64 + 4 * c4 < sg.nsrc;
        f32x4 v[4][4];
#pragma unroll
        for (int i = 0; i < 4; ++i)
#pragma unroll
            for (int q = 0; q < 4; ++q) { const int kq = 4 * i + r4; const f32x4 z = {0.f, 0.f, 0.f, 0.f}; v[i][q] = ok ? *(const f32x4*)(src + (size_t)(4 * kq + q) * sg.ld) : z; }
#pragma unroll
        for (int i = 0; i < 4; ++i) { const int kq = 4 * i + r4;
#pragma unroll
            for (int j = 0; j < 4; ++j) my[(4 * c4 + j) * 17 + kq] = cvt_pk4_fp8(v[i][0][j] * scale, v[i][1][j] * scale, v[i][2][j] * scale, v[i][3][j] * scale); }
        asm volatile("s_waitcnt lgkmcnt(0)" ::: "memory");
        unsigned char* dst = (unsigned char*)sg.dst + (size_t)b * sg.dstride;
#pragma unroll
        for (int i = 0; i < 4; ++i) {
            const int nl = (lane >> 2) + 16 * i, c = lane & 3, n = nt * 64 + nl;
            u32x4 w; w.x = my[nl * 17 + 4 * c]; w.y = my[nl * 17 + 4 * c + 1]; w.z = my[nl * 17 + 4 * c + 2]; w.w = my[nl * 17 + 4 * c + 3];
            const int row = (n / sg.G) * sg.GS + (n % sg.G) + sg.off;
            *(u32x4*)(dst + (size_t)row * sg.K + kt * 64 + 16 * c) = w;
        }
        asm volatile("s_waitcnt lgkmcnt(0)" ::: "memory");
    }
}
struct Cvt8P { const float* src; unsigned char* dst; float sc; int nt, kt, perm; };
#define FX_C8ROW(P, kq, q) ((P).perm ? 32 * (q) + (kq) : 4 * (kq) + (q))
__device__ __forceinline__ Cvt8P cvt8_params(const CvtSeg sg, int tile, float scale, int lane) {
    const int ktn = sg.K / 64, per = ktn * sg.ntn;
#if FX_CVT2D
    const int b = tile / per, r = tile - b * per, w8 = r & 7, g8 = r >> 3, ktp = ktn >> 1, ntq = g8 / ktp, nt = 4 * ntq + (w8 & 3), kt = 2 * (g8 - ntq * ktp) + (w8 >> 2);
#else
    const int b = tile / per, r = tile - b * per, nt = r / ktn, kt = r - nt * ktn;
#endif
    const int c4 = lane & 15;
    const bool ok = nt * 64 + 4 * c4 < sg.nsrc;
    Cvt8P p; p.perm = (kt * 64 < sg.kperm) ? 1 : 0; p.src = sg.src + (size_t)b * sg.sstride + (size_t)(p.perm ? (kt >> 1) * 128 + 16 * (kt & 1) : kt * 64) * sg.ld + (ok ? nt * 64 + 4 * c4 : 0); p.dst = (unsigned char*)sg.dst + (size_t)b * sg.dstride; p.sc = ok ? scale : 0.f; p.nt = nt; p.kt = kt;
    return p;
}
__device__ __forceinline__ void cvt8_out(const CvtSeg sg, FX_LAS unsigned* my, const Cvt8P& p, int lane) {
    asm volatile("s_waitcnt lgkmcnt(0)" ::: "memory");
#pragma unroll
    for (int i = 0; i < 4; ++i) {
        const int nl = (lane >> 2) + 16 * i, c = lane & 3, n = p.nt * 64 + nl;
        u32x4 w; w.x = my[nl * 17 + 4 * c]; w.y = my[nl * 17 + 4 * c + 1]; w.z = my[nl * 17 + 4 * c + 2]; w.w = my[nl * 17 + 4 * c + 3];
        const int row = (n / sg.G) * sg.GS + (n % sg.G) + sg.off;
        *(u32x4*)(p.dst + (size_t)row * sg.K + p.kt * 64 + 16 * c) = w;
    }
    asm volatile("s_waitcnt lgkmcnt(0)" ::: "memory");
}
__device__ __forceinline__ void cvt_seg8(const CvtSeg sg, FX_LAS unsigned* my, int gwave, int nwaves, int& rot, float scale) {
    const int total = (sg.K / 64) * sg.ntn * sg.nbatch;
    int first = (gwave - rot) % nwaves; if (first < 0) first += nwaves;
#if FX_CVTPIPE
    if (first < total) {
        const int lane = fx_lane(), r4 = lane >> 4, c4 = lane & 15;
        f32x4 v[4][4];
        Cvt8P cur = cvt8_params(sg, first, scale, lane);
#pragma unroll
        for (int i = 0; i < 4; ++i)
#pragma unroll
            for (int q = 0; q < 4; ++q) v[i][q] = *(const f32x4*)(cur.src + (size_t)FX_C8ROW(cur, 4 * i + r4, q) * sg.ld);
        int tile = first;
#pragma unroll 1
        while (tile + nwaves < total) {
            tile += nwaves;
            const Cvt8P nx = cvt8_params(sg, tile, scale, lane);
#pragma unroll
            for (int i = 0; i < 4; ++i) { const int kq = 4 * i + r4;
#pragma unroll
                for (int j = 0; j < 4; ++j) my[(4 * c4 + j) * 17 + kq] = cvt_pk4_fp8(v[i][0][j] * cur.sc, v[i][1][j] * cur.sc, v[i][2][j] * cur.sc, v[i][3][j] * cur.sc);
#pragma unroll
                for (int q = 0; q < 4; ++q) v[i][q] = *(const f32x4*)(nx.src + (size_t)FX_C8ROW(nx, kq, q) * sg.ld); }
            cvt8_out(sg, my, cur, lane);
            cur = nx;
        }
#pragma unroll
        for (int i = 0; i < 4; ++i) { const int kq = 4 * i + r4;
#pragma unroll
            for (int j = 0; j < 4; ++j) my[(4 * c4 + j) * 17 + kq] = cvt_pk4_fp8(v[i][0][j] * cur.sc, v[i][1][j] * cur.sc, v[i][2][j] * cur.sc, v[i][3][j] * cur.sc); }
        cvt8_out(sg, my, cur, lane);
    }
#else
    for (int tile = first; tile < total; tile += nwaves) cvt_tile8(sg, my, tile, scale);
#endif
    rot = (rot + total) % nwaves;
}

constexpr int BM = 256, BK = 64, HALF = 128, HTB = HALF * BK * 2, STAGE_BYTES = 8 * HTB, NXCD = 8, WGM = FX_WGM;
__host__ __device__ __forceinline__ int lds_byte(int r, int c) { const int st = (r >> 4) * 2 + (c >> 5), rr = r & 15, cc = c & 31, ob = rr * 64 + cc * 2; return st * 1024 + (ob ^ (((ob >> 9) & 1) << 5)); }
__host__ __device__ __forceinline__ void stage_rc(int b, int& R, int& C) { const int st = b / 1024, sb = b % 1024, swz = sb ^ (((sb >> 9) & 1) << 5); R = (st >> 1) * 16 + swz / 64; C = (st & 1) * 32 + (swz % 64) / 2; }
__host__ __device__ __forceinline__ int perm32(int rho) { const int n = rho >> 4, i = rho & 15; return 8 * (i >> 2) + 4 * n + (i & 3); }
struct Unit { int pm, pn, e; };
struct DenseSched {
    static constexpr bool GATHER = false, WARM2 = false;
    int nM, nN, nwg, G, c; int lda_b; const char* Bt; int K; int esz;
    __device__ void init(int M, int N, int G_, int c_, int lda_bytes, const void* Bt_, int K_, int esz_ = 2) { nM = M / BM; nN = N / BM; nwg = nM * nN; G = G_; c = c_; lda_b = lda_bytes; Bt = (const char*)Bt_; K = K_; esz = esz_; }
    __device__ __forceinline__ bool next(int i, Unit& u) const {
        const long L = (long)i * G + c; if (L >= nwg) return false;
        int wgid = (int)L; { const int q = nwg / NXCD, r = nwg % NXCD, xcd = wgid % NXCD, off = wgid / NXCD; wgid = (xcd < r ? xcd * (q + 1) : r * (q + 1) + (xcd - r) * q) + off; }
        const int nig = WGM * nN, gid = wgid / nig, fm = gid * WGM, gsz = (nM - fm) < WGM ? (nM - fm) : WGM;
        u.pm = fm + ((wgid % nig) % gsz); u.pn = (wgid % nig) / gsz; u.e = 0; return true;
    }
    __device__ __forceinline__ unsigned a_row_off(const Unit& u, int R) const { return (unsigned)(u.pm * BM + R) * (unsigned)lda_b; }
    __device__ __forceinline__ size_t a_unit_base(const Unit& u) const { return (size_t)u.pm * BM * (size_t)lda_b; }
    __device__ __forceinline__ unsigned a_lane_off(int R) const { return (unsigned)R * (unsigned)lda_b; }
    __device__ __forceinline__ const char* b_ptr(const Unit& u) const { return Bt + (size_t)u.pn * BM * K * esz; }
};

template <class Epi, class Sched, bool FP8 = false>
__device__ __forceinline__ void gemm_phase(FX_LAS unsigned char* lds, const char* Abase, const int Kc, const Sched& S, const Epi& E, int tidp, const int noepi = 0) {
    int K_ = Kc; asm volatile("" : "+s"(K_)); const int K = K_;
    int tid_ = tidp; asm volatile("" : "+v"(tid_));
    const int tid = tid_, wid = __builtin_amdgcn_readfirstlane(tid >> 6), lane = tid & 63, wr = wid >> 2, wc = wid & 3, fr = lane & 15, fq = lane >> 4;
    constexpr int ES = FP8 ? 1 : 2;
    const int nt = K * ES / 128;
    int Rr[2], Cc[2]; unsigned voffB[2];
#pragma unroll
    for (int i = 0; i < 2; ++i) { int R, C; stage_rc(tid * 16 + i * 8192, R, C); Rr[i] = R; Cc[i] = C; const int Rb = (Epi::PERM && !(FP8 && FX_F8_32)) ? ((R & ~31) + perm32(R & 31)) : R; voffB[i] = (unsigned)(Rb * (noepi == 3 ? 128 : K * ES) + C * 2); }
    const size_t hstepB = (size_t)HALF * (noepi == 3 ? 128 : K * ES);
    const unsigned ldsw = (unsigned)wid * 1024u;
    constexpr bool F32M = FP8 && FX_F8_32;
    const int aoff = F32M ? lds_byte(wr * 64 + (lane & 31), 16 * (lane >> 5)) : lds_byte(wr * 64 + fr, fq * 8), boff = F32M ? lds_byte(wc * 32 + (lane & 31), 16 * (lane >> 5)) : lds_byte(wc * 32 + fr, fq * 8);
#define FX_SA(b, h) (((b) * 2 + (h)) * HTB)
#define FX_SB(b, h) ((4 + (b) * 2 + (h)) * HTB)
#define FX_STAGE_A(bufoff, o0, o1, kb) do { const char* ap_ = Abase + (kb); \
        __builtin_amdgcn_global_load_lds((const unsigned*)(ap_ + (o0)), (FX_LAS unsigned*)(lds + (bufoff) + ldsw), 16, 0, 0); \
        __builtin_amdgcn_global_load_lds((const unsigned*)(ap_ + (o1)), (FX_LAS unsigned*)(lds + (bufoff) + ldsw + 8192), 16, 0, 0); } while (0)
#define FX_STAGE_B(bufoff, gbase) do { _Pragma("unroll") for (int _i = 0; _i < 2; ++_i) \
        __builtin_amdgcn_global_load_lds((const unsigned*)((const char*)(gbase) + voffB[_i]), (FX_LAS unsigned*)(lds + (bufoff) + ldsw + _i * 8192), 16, 0, 0); } while (0)
#define FX_LDA(dst, b, h) do { if constexpr (F32M) { _Pragma("unroll") for (int q = 0; q < 4; ++q) { dst[q][0] = *(const FX_LAS bf16x8*)(lds + FX_SA(b, h) + aoff + (q >> 1) * 4096 + (q & 1) * 1024); dst[q][1] = *(const FX_LAS bf16x8*)(lds + FX_SA(b, h) + aoff + (q >> 1) * 4096 + (q & 1) * 1024 + 16); } } \
        else { _Pragma("unroll") for (int m = 0; m < 4; ++m) _Pragma("unroll") for (int k = 0; k < 2; ++k) dst[m][k] = *(const FX_LAS bf16x8*)(lds + FX_SA(b, h) + aoff + m * 2048 + k * 1024); } } while (0)
#define FX_LDB(dst, b, h) do { if constexpr (F32M) { _Pragma("unroll") for (int q = 0; q < 2; ++q) { dst[q][0] = *(const FX_LAS bf16x8*)(lds + FX_SB(b, h) + boff + q * 1024); dst[q][1] = *(const FX_LAS bf16x8*)(lds + FX_SB(b, h) + boff + q * 1024 + 16); } } \
        else { _Pragma("unroll") for (int n = 0; n < 2; ++n) _Pragma("unroll") for (int k = 0; k < 2; ++k) dst[n][k] = *(const FX_LAS bf16x8*)(lds + FX_SB(b, h) + boff + n * 2048 + k * 1024); } } while (0)
#define FX_MMA(ai, bj, At, Bt) do { if (!FP8 || FX_PRIO8) __builtin_amdgcn_s_setprio(1); \
        if constexpr (F32M) { _Pragma("unroll") for (int mb = 0; mb < 2; ++mb) _Pragma("unroll") for (int s = 0; s < 2; ++s) { \
            const i32x4 a0_ = __builtin_bit_cast(i32x4, At[mb * 2 + s][0]), a1_ = __builtin_bit_cast(i32x4, At[mb * 2 + s][1]), b0_ = __builtin_bit_cast(i32x4, Bt[s][0]), b1_ = __builtin_bit_cast(i32x4, Bt[s][1]); \
            const i32x8 af_ = __builtin_shufflevector(a0_, a1_, 0, 1, 2, 3, 4, 5, 6, 7), bf_ = __builtin_shufflevector(b0_, b1_, 0, 1, 2, 3, 4, 5, 6, 7); \
            asm volatile("v_mfma_scale_f32_32x32x64_f8f6f4 %0, %1, %2, %0, %3, %3 op_sel_hi:[0,0,0]" : "+v"(acc3[ai][bj][mb]) : "v"(bf_), "v"(af_), "v"(sc1_)); } } else \
        _Pragma("unroll") for (int m = 0; m < 4; ++m) _Pragma("unroll") for (int n = 0; n < 2; ++n) { \
        if constexpr (FP8) { const i32x4 a0_ = __builtin_bit_cast(i32x4, At[m][0]), a1_ = __builtin_bit_cast(i32x4, At[m][1]), b0_ = __builtin_bit_cast(i32x4, Bt[n][0]), b1_ = __builtin_bit_cast(i32x4, Bt[n][1]); \
            const i32x8 af_ = __builtin_shufflevector(a0_, a1_, 0, 1, 2, 3, 4, 5, 6, 7), bf_ = __builtin_shufflevector(b0_, b1_, 0, 1, 2, 3, 4, 5, 6, 7); \
            asm volatile("v_mfma_scale_f32_16x16x128_f8f6f4 %0, %1, %2, %0, %3, %3 op_sel_hi:[0,0,0]" : "+v"(acc[ai][bj][m][n]) : "v"(bf_), "v"(af_), "v"(sc1_)); FX_MFMA_DUP(acc[ai][bj][m][n]) } \
        else { _Pragma("unroll") for (int k = 0; k < 2; ++k) acc[ai][bj][m][n] = __builtin_amdgcn_mfma_f32_16x16x32_bf16(Bt[n][k], At[m][k], acc[ai][bj][m][n], 0, 0, 0); } } \
        if (!FP8 || FX_PRIO8) __builtin_amdgcn_s_setprio(0); } while (0)
#define FX_WAIT_V(n) asm volatile("s_waitcnt vmcnt(" #n ")" ::: "memory")
#define FX_WAIT_L(n) asm volatile("s_waitcnt lgkmcnt(" #n ")" ::: "memory")
#define FX_BAR __builtin_amdgcn_s_barrier()
#define FX_SCHED __builtin_amdgcn_sched_barrier(0)
#ifdef FX_PROBE_MFMA
#define FX_MFMA_DUP(ACC) asm volatile("v_mfma_scale_f32_16x16x128_f8f6f4 %0, %1, %2, %0, %3, %3 op_sel_hi:[0,0,0]" : "+v"(ACC) : "v"(bf_), "v"(af_), "v"(sc0_));
#else
#define FX_MFMA_DUP(ACC)
#endif
    const int sc0_ = 0; (void)sc0_;
    const int sc1_ = 0x7f7f7f7f;
    (void)sc1_;
    Unit cur, nxt; int ui = 0; bool seamed = false;
    if (!S.next(0, cur)) return;
    f32x4 acc[2][2][4][2];
#pragma unroll
    for (int a = 0; a < 2; ++a)
#pragma unroll
        for (int b = 0; b < 2; ++b)
#pragma unroll
            for (int m = 0; m < 4; ++m)
#pragma unroll
                for (int n = 0; n < 2; ++n) acc[a][b][m][n] = (f32x4){0.f, 0.f, 0.f, 0.f};
    f32x16 acc3[2][2][2];
#pragma unroll
    for (int q = 0; q < 8; ++q) acc3[q >> 2][(q >> 1) & 1][q & 1] = f32x16{};
    bf16x8 At[4][2], B0[2][2], B1[2][2];
    unsigned c00, c01, c10, c11, n00 = 0, n01 = 0, n10 = 0, n11 = 0;
    size_t ubc = 0, ubn = 0;
    if constexpr (Sched::GATHER) { c00 = S.a_row_off(cur, Rr[0]) + Cc[0] * 2; c01 = S.a_row_off(cur, Rr[1]) + Cc[1] * 2; c10 = S.a_row_off(cur, HALF + Rr[0]) + Cc[0] * 2; c11 = S.a_row_off(cur, HALF + Rr[1]) + Cc[1] * 2; }
    else { c00 = S.a_lane_off(Rr[0]) + Cc[0] * 2; c01 = S.a_lane_off(Rr[1]) + Cc[1] * 2; c10 = c00 + S.a_lane_off(HALF); c11 = c01 + S.a_lane_off(HALF); ubc = S.a_unit_base(cur); n00 = c00; n01 = c01; n10 = c10; n11 = c11; }
    const char* cB = S.b_ptr(cur);
    const unsigned kstep = noepi == 3 ? 32768u : BK * 2;
    FX_STAGE_B(FX_SB(0, 0), cB); FX_STAGE_A(FX_SA(0, 0), c00, c01, ubc); FX_STAGE_B(FX_SB(0, 1), cB + hstepB); FX_STAGE_A(FX_SA(0, 1), c10, c11, ubc);
    if (wr == 1) FX_BAR;
    FX_WAIT_V(4); FX_BAR;
    FX_STAGE_B(FX_SB(1, 0), cB + kstep); FX_STAGE_A(FX_SA(1, 0), c00, c01, ubc + kstep); FX_STAGE_B(FX_SB(1, 1), cB + hstepB + kstep);
    FX_WAIT_V(6); FX_BAR;
    for (;;) {
        const bool has_next = S.next(ui + 1, nxt);
        if (!has_next) nxt = cur;
        if constexpr (!Sched::GATHER) ubn = S.a_unit_base(nxt);
        const char* nB = S.b_ptr(nxt);
        for (int t = 0; t < nt; t += 2) {
            const bool last = (t == nt - 2);
            asm volatile("" : "+v"(c00), "+v"(c01), "+v"(c10), "+v"(c11), "+v"(voffB[0]), "+v"(voffB[1]));
            if constexpr (Sched::GATHER) { if (last) {
                int t2_ = tid; asm volatile("" : "+v"(t2_)); int R0_, C0_, R1_, C1_; stage_rc(t2_ * 16, R0_, C0_); stage_rc(t2_ * 16 + 8192, R1_, C1_);
                n00 = S.a_row_off(nxt, R0_) + C0_ * 2; n01 = S.a_row_off(nxt, R1_) + C1_ * 2; n10 = S.a_row_off(nxt, HALF + R0_) + C0_ * 2; n11 = S.a_row_off(nxt, HALF + R1_) + C1_ * 2; } }
            const size_t k1 = ubc + (size_t)(t + 1) * kstep;
            const size_t k2 = last ? ubn : ubc + (size_t)(t + 2) * kstep, k3 = k2 + kstep;
            unsigned a00, a01, a10, a11;
            if constexpr (Sched::GATHER) { a00 = last ? n00 : c00; a01 = last ? n01 : c01; a10 = last ? n10 : c10; a11 = last ? n11 : c11; } else { a00 = c00; a01 = c01; a10 = c10; a11 = c11; }
            const char* b2 = last ? nB : cB + (size_t)(t + 2) * kstep; const char* b3 = b2 + kstep;
            FX_LDB(B0, 0, 0); FX_SCHED; FX_LDA(At, 0, 0); if (!(FX_SEAM && seamed && t == 0)) FX_STAGE_A(FX_SA(1, 1), c10, c11, k1);
            FX_WAIT_L(8); FX_BAR; FX_WAIT_L(0); FX_MMA(0, 0, At, B0); FX_BAR; FX_SCHED;
            FX_LDB(B1, 0, 1); FX_STAGE_B(FX_SB(0, 0), b2);
            FX_BAR; FX_WAIT_L(0); FX_MMA(0, 1, At, B1); FX_BAR;
            FX_LDA(At, 0, 1); FX_STAGE_A(FX_SA(0, 0), a00, a01, k2);
            FX_BAR; FX_WAIT_L(0); FX_MMA(1, 0, At, B0); FX_BAR; FX_SCHED;
            FX_STAGE_B(FX_SB(0, 1), b2 + hstepB);
            if (FX_SEAM && seamed && t == 0) asm volatile("s_waitcnt vmcnt(%0)" :: "n"(6 + Epi::NST) : "memory");
            else FX_WAIT_V(6);
            FX_BAR; FX_MMA(1, 1, At, B1); FX_BAR;
            FX_LDB(B0, 1, 0); FX_SCHED; FX_LDA(At, 1, 0); FX_STAGE_A(FX_SA(0, 1), a10, a11, k2);
            FX_WAIT_L(8); FX_BAR; FX_WAIT_L(0); FX_MMA(0, 0, At, B0); FX_BAR; FX_SCHED;
            FX_LDB(B1, 1, 1); FX_STAGE_B(FX_SB(1, 0), b3);
            FX_BAR; FX_WAIT_L(0); FX_MMA(0, 1, At, B1); FX_BAR;
            FX_LDA(At, 1, 1); FX_STAGE_A(FX_SA(1, 0), a00, a01, k3);
            FX_BAR; FX_WAIT_L(0); FX_MMA(1, 0, At, B0); FX_BAR; FX_SCHED;
            FX_STAGE_B(FX_SB(1, 1), b3 + hstepB);
            FX_WAIT_V(6); FX_BAR; FX_MMA(1, 1, At, B1); FX_BAR;
        }
#if FX_SEAM
        const bool seam_now = has_next && !noepi;
        if (seam_now) { if constexpr (Sched::GATHER) FX_STAGE_A(FX_SA(1, 1), n10, n11, (size_t)kstep); else FX_STAGE_A(FX_SA(1, 1), c10, c11, ubn + (size_t)kstep); }
#endif
#if FX_WARM
        if constexpr (Sched::WARM2 && FP8) {
            Unit w2; if (S.next(ui + 2, w2)) {
                int tw_ = tid; asm volatile("" : "+v"(tw_)); const int wrow = tw_ >> 1, wl = (tw_ & 1) * 256;
                FX_LAS unsigned* scr = (FX_LAS unsigned*)(lds + STAGE_BYTES + 2048) + wid * 64;
                const char* pa = Abase + S.a_unit_base(w2) + S.a_lane_off(wrow) + wl; const char* pb = S.b_ptr(w2) + (size_t)wrow * K * ES + wl;
                __builtin_amdgcn_global_load_lds((const unsigned*)pa, scr, 4, 0, 0); __builtin_amdgcn_global_load_lds((const unsigned*)(pa + 128), scr, 4, 0, 0);
                __builtin_amdgcn_global_load_lds((const unsigned*)pb, scr, 4, 0, 0); __builtin_amdgcn_global_load_lds((const unsigned*)(pb + 128), scr, 4, 0, 0); } }
#endif
        if constexpr (FP8) asm volatile("s_nop 15\n\ts_nop 15\n\ts_nop 15\n\ts_nop 15" ::: "memory");
        if constexpr (F32M) { int ln_e = lane; asm volatile("" : "+v"(ln_e)); E.e32(acc3, cur, wr, wc, ln_e); }
        else if (noepi) { f32x4 s_ = (f32x4){0.f, 0.f, 0.f, 0.f};
#pragma unroll
            for (int q_ = 0; q_ < 32; ++q_) s_ += acc[q_ >> 4][(q_ >> 3) & 1][(q_ >> 1) & 3][q_ & 1];
            if (s_[0] + s_[1] + s_[2] + s_[3] == 1.2345e-30f) *(float*)const_cast<char*>(Abase) = s_[0]; }
        else { int fr_e = fr, fq_e = fq; asm volatile("" : "+v"(fr_e), "+v"(fq_e)); E(acc, cur, wr, wc, fr_e, fq_e); }
        if (!has_next) break;
        if constexpr (F32M) { _Pragma("unroll") for (int q = 0; q < 8; ++q) acc3[q >> 2][(q >> 1) & 1][q & 1] = f32x16{}; }
#pragma unroll
        for (int a = 0; a < 2; ++a)
#pragma unroll
            for (int b = 0; b < 2; ++b)
#pragma unroll
                for (int m = 0; m < 4; ++m)
#pragma unroll
                    for (int n = 0; n < 2; ++n) acc[a][b][m][n] = (f32x4){0.f, 0.f, 0.f, 0.f};
        cur = nxt; cB = nB; if constexpr (Sched::GATHER) { c00 = n00; c01 = n01; c10 = n10; c11 = n11; } else ubc = ubn; ++ui;
#if FX_SEAM
        seamed = seam_now;
#endif
    }
    FX_WAIT_V(0);
    if (wr == 0) FX_BAR;
    FX_BAR;
}

#ifndef FX_WARM
#define FX_WARM 0
#endif
#ifndef FX_EPILDS
#define FX_EPILDS 1
#endif
#ifndef FX_NTST
#define FX_NTST 0
#endif
#if FX_NTST
#define FX_EPI_ST(TY, p, v) __builtin_nontemporal_store((v), (TY*)(p))
#else
#define FX_EPI_ST(TY, p, v) (*(TY*)(p) = (v))
#endif
constexpr int EPI_LDS_OFF = STAGE_BYTES + 8192 + 64, EPI_LDS_BYTES = 8 * 2304;
struct EpiBf16 {
    static constexpr bool PERM = true; static constexpr int NST = FX_EPILDS == 1 ? 16 : 0;
    bf16_t* O; float* gates; int ldc; float scale; FX_LAS unsigned char* es;
    __device__ __forceinline__ void operator()(const f32x4 (&acc)[2][2][4][2], const Unit& u, int wr, int wc, int fr, int fq) const {
        const int row0 = u.pm * BM + wr * 64 + fr, col0 = u.pn * BM + wc * 32 + 8 * fq;
#if FX_EPILDS
        if (FX_EPILDS == 1 || (FX_EPILDS == 2 && gates == nullptr && ldc == 2048) || (FX_EPILDS == 3 && gates != nullptr) || (FX_EPILDS == 4 && ldc == 1536)) {
        FX_LAS unsigned char* my = es + (wr * 4 + wc) * 2304;
        const int lane = fq * 16 + fr, rrow = lane >> 2, rch = lane & 3;
#pragma unroll
        for (int ai = 0; ai < 2; ++ai)
#pragma unroll
            for (int m = 0; m < 4; ++m) { FX_LAS unsigned char* buf = my;
#pragma unroll
                for (int bj = 0; bj < 2; ++bj) { const f32x4 v0 = acc[ai][bj][m][0] * scale, v1 = acc[ai][bj][m][1] * scale;
                    u32x4 w; w.x = cvt_pk_bf16(v0[0], v0[1]); w.y = cvt_pk_bf16(v0[2], v0[3]); w.z = cvt_pk_bf16(v1[0], v1[1]); w.w = cvt_pk_bf16(v1[2], v1[3]);
                    *(FX_LAS u32x4*)(buf + fr * 144 + bj * 64 + fq * 16) = w; }
                const int row = u.pm * BM + wr * 64 + ai * HALF + m * 16 + rrow; bf16_t* rowp = O + (size_t)row * ldc + u.pn * BM + wc * 32 + rch * 8;
#pragma unroll
                for (int q = 0; q < 2; ++q) { const u32x4 w = *(const FX_LAS u32x4*)(buf + rrow * 144 + q * 64 + rch * 16); *(u32x4*)(rowp + q * HALF) = w; }
                if (gates && u.pn == 15 && wc == 2 && fq < 2) { float* g = gates + (size_t)(row0 + ai * HALF + m * 16) * 16 + 8 * fq; *(f32x4*)g = acc[ai][1][m][0] * scale; *(f32x4*)(g + 4) = acc[ai][1][m][1] * scale; } }
        (void)col0; return; }
#endif
        {
#pragma unroll
        for (int ai = 0; ai < 2; ++ai)
#pragma unroll
            for (int m = 0; m < 4; ++m) { const int row = row0 + ai * HALF + m * 16; bf16_t* rowp = O + (size_t)row * ldc + col0;
#pragma unroll
                for (int bj = 0; bj < 2; ++bj) { const f32x4 v0 = acc[ai][bj][m][0] * scale, v1 = acc[ai][bj][m][1] * scale;
                    u32x4 w; w.x = cvt_pk_bf16(v0[0], v0[1]); w.y = cvt_pk_bf16(v0[2], v0[3]); w.z = cvt_pk_bf16(v1[0], v1[1]); w.w = cvt_pk_bf16(v1[2], v1[3]);
                    FX_EPI_ST(u32x4, rowp + bj * HALF, w); }
                if (gates && u.pn == 15 && wc == 2 && fq < 2) { float* g = gates + (size_t)row * 16 + 8 * fq; *(f32x4*)g = acc[ai][1][m][0] * scale; *(f32x4*)(g + 4) = acc[ai][1][m][1] * scale; } }
        }
    }
    __device__ __forceinline__ void e32(const f32x16 (&acc3)[2][2][2], const Unit& u, int wr, int wc, int lane) const {
        const int j = lane & 31, hi = lane >> 5;
#pragma unroll
        for (int ai = 0; ai < 2; ++ai)
#pragma unroll
            for (int mb = 0; mb < 2; ++mb) { const int row = u.pm * BM + ai * HALF + wr * 64 + mb * 32 + j;
#pragma unroll
                for (int bj = 0; bj < 2; ++bj) { bf16_t* rowp = O + (size_t)row * ldc + u.pn * BM + bj * HALF + wc * 32 + 4 * hi;
#pragma unroll
                    for (int g = 0; g < 4; ++g) { u32x2 w; w.x = cvt_pk_bf16(acc3[ai][bj][mb][4 * g] * scale, acc3[ai][bj][mb][4 * g + 1] * scale); w.y = cvt_pk_bf16(acc3[ai][bj][mb][4 * g + 2] * scale, acc3[ai][bj][mb][4 * g + 3] * scale);
                        *(u32x2*)(rowp + 8 * g) = w; } }
                if (gates && u.pn == 15 && wc == 2) { float* gp = gates + (size_t)row * 16 + 4 * hi;
#pragma unroll
                    for (int g = 0; g < 2; ++g) *(f32x4*)(gp + 8 * g) = (f32x4){acc3[ai][1][mb][4 * g] * scale, acc3[ai][1][mb][4 * g + 1] * scale, acc3[ai][1][mb][4 * g + 2] * scale, acc3[ai][1][mb][4 * g + 3] * scale}; } }
    }
};
}
#ifndef FX_HOTA
#define FX_HOTA 0
#endif
#ifndef FX_RUNR
#define FX_RUNR 16
#endif
namespace fx {
constexpr int RT = 16;
constexpr int H2S_LD = 2052;
constexpr int P7_LDS = RT * H2S_LD * 4 + 512;
constexpr int PTOT = 131072;
constexpr int NTILE_MAX = PTOT / 256;

__device__ __forceinline__ void coef_phase(const float* mod, const float* pre_mix_gain, const float* post_mix_gain, const float* pre_ffn_gain, const float* post_ffn_gain, float* coef, int gtid, int nthr) {
    for (int i = gtid; i < 2 * 4 * 2048; i += nthr) { const int d = i & 2047, b = (i >> 11) & 3, l = i >> 13;
        const float* m = mod + ((size_t)l * 4 + b) * 12288; float* c = coef + ((size_t)l * 4 + b) * 6 * 2048;
        c[0 * 2048 + d] = m[2 * 2048 + d] * post_mix_gain[l * 2048 + d];
        c[1 * 2048 + d] = pre_ffn_gain[l * 2048 + d] * (1.f + m[4 * 2048 + d]);
        c[2 * 2048 + d] = m[3 * 2048 + d];
        c[3 * 2048 + d] = m[5 * 2048 + d] * post_ffn_gain[l * 2048 + d];
        c[4 * 2048 + d] = pre_mix_gain[l * 2048 + d] * (1.f + m[1 * 2048 + d]);
        c[5 * 2048 + d] = m[0 * 2048 + d]; }
}

template <bool XBF>
__device__ __forceinline__ void p7_phase(FX_LAS unsigned char* lds, const void* xin_, const bf16_t* Y, const float* coef_l  , const float* router_w, const float* router_bias,
                                         bf16_t* XRES, unsigned char* HA8, int* SELE, float* SELG, int* CNT, int* WGBASE, int wg, int nwg, int tidp) {
    int tid_ = tidp; asm volatile("" : "+v"(tid_));
    const int tid = tid_, wid = tid >> 6, lane = tid & 63;
    FX_LAS float* h2s = (FX_LAS float*)lds;
    FX_LAS int* hist = (FX_LAS int*)(lds + RT * H2S_LD * 4);
    if (tid < 64) hist[tid] = 0;
    __syncthreads();
#define FX_GC(TY, p) ((const __attribute__((address_space(1))) TY*)(p))
#define FX_GM(TY, p) ((__attribute__((address_space(1))) TY*)(p))
    const int i16 = lane & 15, g4 = lane >> 4;
    for (int unit = wg; unit < T / RT; unit += nwg) {
        {
            const int tok0 = 2 * wid, t0 = unit * RT + tok0, b = t0 / S;
            const float* cf = coef_l + (size_t)b * 6 * 2048;
            u32x4 yw[2][4]; f32x4 ca[8];
            float xv[2][32];
#pragma unroll
            for (int tt = 0; tt < 2; ++tt)
#pragma unroll
                for (int i = 0; i < 4; ++i) yw[tt][i] = *FX_GC(u32x4, Y + (size_t)(t0 + tt) * 2048 + i * 512 + lane * 8);
            if constexpr (XBF) {
                u32x4 xw[2][4];
#pragma unroll
                for (int tt = 0; tt < 2; ++tt)
#pragma unroll
                    for (int i = 0; i < 4; ++i) xw[tt][i] = *FX_GC(u32x4, (const bf16_t*)xin_ + (size_t)(t0 + tt) * 2048 + i * 512 + lane * 8);
#pragma unroll
                for (int i = 0; i < 4; ++i) { ca[2 * i] = *FX_GC(f32x4, cf + i * 512 + lane * 8); ca[2 * i + 1] = *FX_GC(f32x4, cf + i * 512 + lane * 8 + 4); }
#pragma unroll
                for (int tt = 0; tt < 2; ++tt)
#pragma unroll
                    for (int i = 0; i < 4; ++i) { const u32x4 w = xw[tt][i];
                        xv[tt][i * 8 + 0] = bflo(w.x); xv[tt][i * 8 + 1] = bfhi(w.x); xv[tt][i * 8 + 2] = bflo(w.y); xv[tt][i * 8 + 3] = bfhi(w.y); xv[tt][i * 8 + 4] = bflo(w.z); xv[tt][i * 8 + 5] = bfhi(w.z); xv[tt][i * 8 + 6] = bflo(w.w); xv[tt][i * 8 + 7] = bfhi(w.w); }
            } else {
                const float* xin = (const float*)xin_;
#pragma unroll
                for (int tt = 0; tt < 2; ++tt)
#pragma unroll
                    for (int i = 0; i < 4; ++i) { const f32x4 x0 = *FX_GC(f32x4, xin + (size_t)(t0 + tt) * 2048 + i * 512 + lane * 8), x1 = *FX_GC(f32x4, xin + (size_t)(t0 + tt) * 2048 + i * 512 + lane * 8 + 4);
                        xv[tt][i * 8 + 0] = x0[0]; xv[tt][i * 8 + 1] = x0[1]; xv[tt][i * 8 + 2] = x0[2]; xv[tt][i * 8 + 3] = x0[3]; xv[tt][i * 8 + 4] = x1[0]; xv[tt][i * 8 + 5] = x1[1]; xv[tt][i * 8 + 6] = x1[2]; xv[tt][i * 8 + 7] = x1[3]; }
#pragma unroll
                for (int i = 0; i < 4; ++i) { ca[2 * i] = *FX_GC(f32x4, cf + i * 512 + lane * 8); ca[2 * i + 1] = *FX_GC(f32x4, cf + i * 512 + lane * 8 + 4); }
            }
            float ssy0 = 0.f, ssy1 = 0.f;
#pragma unroll
            for (int i = 0; i < 4; ++i) { const u32x4 w0 = yw[0][i], w1 = yw[1][i];
#pragma unroll
                for (int q = 0; q < 4; ++q) { const float l0 = bflo(w0[q]), h0 = bfhi(w0[q]), l1 = bflo(w1[q]), h1 = bfhi(w1[q]); ssy0 += l0 * l0 + h0 * h0; ssy1 += l1 * l1 + h1 * h1; } }
            ssy0 = wave_sum(ssy0); ssy1 = wave_sum(ssy1);
            const float ry0 = rsqrtf(ssy0 * (1.f / 2048.f) + EPS), ry1 = rsqrtf(ssy1 * (1.f / 2048.f) + EPS);
            float ssx0 = 0.f, ssx1 = 0.f;
#pragma unroll
            for (int i = 0; i < 4; ++i) { const u32x4 w0 = yw[0][i], w1 = yw[1][i];
#pragma unroll
                for (int j = 0; j < 8; ++j) { const float a = ca[2 * i + (j >> 2)][j & 3];
                    const float y0 = (j & 1) ? bfhi(w0[j >> 1]) : bflo(w0[j >> 1]), y1 = (j & 1) ? bfhi(w1[j >> 1]) : bflo(w1[j >> 1]);
                    xv[0][i * 8 + j] += a * (y0 * ry0); xv[1][i * 8 + j] += a * (y1 * ry1);
                    ssx0 += xv[0][i * 8 + j] * xv[0][i * 8 + j]; ssx1 += xv[1][i * 8 + j] * xv[1][i * 8 + j]; } }
            f32x4 cb[8], cc[8];
#pragma unroll
            for (int i = 0; i < 4; ++i) { cb[2 * i] = *FX_GC(f32x4, cf + 2048 + i * 512 + lane * 8); cb[2 * i + 1] = *FX_GC(f32x4, cf + 2048 + i * 512 + lane * 8 + 4);
                cc[2 * i] = *FX_GC(f32x4, cf + 4096 + i * 512 + lane * 8); cc[2 * i + 1] = *FX_GC(f32x4, cf + 4096 + i * 512 + lane * 8 + 4); }
#pragma unroll
            for (int tt = 0; tt < 2; ++tt)
#pragma unroll
                for (int i = 0; i < 4; ++i) { u32x4 xo; xo.x = cvt_pk_bf16(xv[tt][i * 8 + 0], xv[tt][i * 8 + 1]); xo.y = cvt_pk_bf16(xv[tt][i * 8 + 2], xv[tt][i * 8 + 3]); xo.z = cvt_pk_bf16(xv[tt][i * 8 + 4], xv[tt][i * 8 + 5]); xo.w = cvt_pk_bf16(xv[tt][i * 8 + 6], xv[tt][i * 8 + 7]);
                    *FX_GM(u32x4, XRES + (size_t)(t0 + tt) * 2048 + i * 512 + lane * 8) = xo; }
            ssx0 = wave_sum(ssx0); ssx1 = wave_sum(ssx1);
            const float rx0 = rsqrtf(ssx0 * (1.f / 2048.f) + EPS), rx1 = rsqrtf(ssx1 * (1.f / 2048.f) + EPS);
#pragma unroll
            for (int tt = 0; tt < 2; ++tt) { const float rx = tt ? rx1 : rx0;
#pragma unroll
                for (int i = 0; i < 4; ++i) { const int c = i * 512 + lane * 8;
                    float hv[8];
#pragma unroll
                    for (int j = 0; j < 8; ++j) hv[j] = xv[tt][i * 8 + j] * rx * cb[2 * i + (j >> 2)][j & 3] + cc[2 * i + (j >> 2)][j & 3];
                    u32x2 w; w.x = cvt_pk4_fp8(hv[0], hv[1], hv[2], hv[3]); w.y = cvt_pk4_fp8(hv[4], hv[5], hv[6], hv[7]);
                    *FX_GM(u32x2, HA8 + (size_t)(t0 + tt) * 2048 + c) = w;
                    *(FX_LAS f32x4*)(h2s + (tok0 + tt) * H2S_LD + c) = (f32x4){hv[0], hv[1], hv[2], hv[3]};
                    *(FX_LAS f32x4*)(h2s + (tok0 + tt) * H2S_LD + c + 4) = (f32x4){hv[4], hv[5], hv[6], hv[7]}; } }
        }
        f32x4 acc[4];
#pragma unroll
        for (int j = 0; j < 4; ++j) acc[j] = (f32x4){0.f, 0.f, 0.f, 0.f};
        {
            const char* rwb = (const char*)router_w + (size_t)__builtin_amdgcn_readfirstlane(wid) * (256 * 64 * 4);
            const unsigned loff = (unsigned)(g4 * 64 + 4 * i16) * 4u;
            f32x4 bwA[8], bwB[8];
            { unsigned o_ = loff; asm volatile("" : "+v"(o_));
#pragma unroll
              for (int q = 0; q < 8; ++q) bwA[q] = *FX_GC(f32x4, rwb + o_ + q * 1024); }
            __syncthreads();
#pragma unroll
            for (int kb = 0; kb < 8; ++kb) {
                if (kb < 7) { unsigned o_ = loff + (kb + 1) * 8192; asm volatile("" : "+v"(o_));
#pragma unroll
                    for (int q = 0; q < 8; ++q) { const f32x4 v = *FX_GC(f32x4, rwb + o_ + q * 1024); if (kb & 1) bwA[q] = v; else bwB[q] = v; } }
#pragma unroll
                for (int q = 0; q < 8; ++q) { const int k = 256 * wid + 4 * (kb * 8 + q) + g4;
                    const float a = h2s[i16 * H2S_LD + k]; const f32x4 bw = (kb & 1) ? bwB[q] : bwA[q];
                    acc[0] = __builtin_amdgcn_mfma_f32_16x16x4f32(a, bw[0], acc[0], 0, 0, 0);
                    acc[1] = __builtin_amdgcn_mfma_f32_16x16x4f32(a, bw[1], acc[1], 0, 0, 0);
                    acc[2] = __builtin_amdgcn_mfma_f32_16x16x4f32(a, bw[2], acc[2], 0, 0, 0);
                    acc[3] = __builtin_amdgcn_mfma_f32_16x16x4f32(a, bw[3], acc[3], 0, 0, 0); } }
        }
        __syncthreads();
        { FX_LAS float* part = h2s; const int i16 = lane & 15, g = lane >> 4;
#pragma unroll
          for (int j = 0; j < 4; ++j)
#pragma unroll
            for (int r = 0; r < 4; ++r) part[(wid * 16 + 4 * g + r) * 64 + 4 * i16 + j] = acc[j][r]; }
        __syncthreads();
#pragma unroll 1
        for (int tt = 0; tt < 2; ++tt) {
            const int tok = 2 * wid + tt, t = unit * RT + tok;
            float lg = 0.f;
#pragma unroll
            for (int w = 0; w < 8; ++w) lg += h2s[(w * 16 + tok) * 64 + lane];
            const float score = 1.f / (1.f + expf(-lg));
            float v = score + router_bias[lane];
            int my_e = 0; float my_s = 0.f, sum = 0.f;
#pragma unroll
            for (int k = 0; k < 6; ++k) {
                const float m = wave_max(v);
                const unsigned long long bal = __ballot(v == m);
                const int win = __ffsll((long long)bal) - 1;
                const float sw = __builtin_bit_cast(float, __builtin_amdgcn_readlane(__builtin_bit_cast(int, score), win));
                sum += sw; if (lane == k) { my_e = win; my_s = sw; }
                if (lane == win) v = -3.0e38f;
            }
            if (lane < 6) { SELE[(size_t)t * 6 + lane] = my_e; SELG[(size_t)t * 6 + lane] = my_s / sum * 2.5f; __hip_atomic_fetch_add(hist + my_e, 1, __ATOMIC_RELAXED, __HIP_MEMORY_SCOPE_WORKGROUP); }
        }
        __syncthreads();
    }
    { int te = tid; asm volatile("" : "+v"(te));
      if (te < 64) { const int hv = hist[te]; const int base = atomicAdd(CNT + te, hv); WGBASE[wg * 64 + te] = base; } }
}

__device__ __forceinline__ void p8_phase(FX_LAS unsigned char* lds, const int* SELE, const float* SELG, const int* CNT, const int* WGBASE, int* ROWTOK, float* ROWG, int* SLOT, int wg, int nwg, int tidp) {
    int tid_ = tidp; asm volatile("" : "+v"(tid_));
    const int tid = tid_;
    FX_LAS int* pstart = (FX_LAS int*)lds; FX_LAS int* off = pstart + 80;
    const int u4 = tid / 96, r96 = tid - u4 * 96;
    int unit = wg + u4 * nwg; bool act = u4 < 4 && unit < T / RT;
    int t = 0, k = 0, e = 0; float g = 0.f;
    if (act) { t = unit * RT + r96 / 6; k = r96 % 6; e = SELE[(size_t)t * 6 + k]; g = SELG[(size_t)t * 6 + k]; }
    int wb = 0;
    if (tid < 64) { wb = WGBASE[wg * 64 + tid]; const int pc = (CNT[tid] + 255) & ~255; int incl = pc;
#pragma unroll
        for (int o = 1; o < 64; o <<= 1) { const int t2 = __shfl_up(incl, o); if (tid >= o) incl += t2; }
        pstart[tid] = 16384 + incl - pc; if (tid == 63) pstart[64] = 16384 + incl; off[tid] = 16384 + incl - pc + wb; }
    __syncthreads();
    for (;;) {
        if (act) { const int pos = __hip_atomic_fetch_add(off + e, 1, __ATOMIC_RELAXED, __HIP_MEMORY_SCOPE_WORKGROUP);
            ROWTOK[pos] = t; SLOT[(size_t)t * 6 + k] = pos; (void)g; }
        unit += 4 * nwg; if (wg + 4 * nwg >= T / RT || unit - u4 * nwg >= T / RT) break;
        act = u4 < 4 && unit < T / RT;
        if (act) { t = unit * RT + r96 / 6; k = r96 % 6; e = SELE[(size_t)t * 6 + k]; g = SELG[(size_t)t * 6 + k]; }
    }
    for (int e = wg; e < 64; e += nwg) { const int a = pstart[e] + CNT[e], b = pstart[e + 1]; for (int r = a + tid; r < b; r += 512) ROWTOK[r] = 0; }
    for (int r = wg * 512 + tid; r < 16384; r += nwg * 512) ROWTOK[r] = r;
}

template <bool RT_> struct MoeSchedT {
    static constexpr bool GATHER = RT_, WARM2 = !RT_;
    FX_LAS const unsigned char* tile_e; int ntiles, npn, nunits, G, c;
    const int* rowtok; int lda_b; const char* Bt; size_t estride_b, pnstride_b;
    __device__ __forceinline__ bool next(int i, Unit& u) const {
        const long L = (long)i * G + c; if (L >= nunits) return false;
        int id = (int)L; { const int q = nunits / NXCD, r = nunits % NXCD, xcd = id % NXCD, off = id / NXCD; id = (xcd < r ? xcd * (q + 1) : r * (q + 1) + (xcd - r) * q) + off; }
        u.pm = id / npn; u.pn = id - u.pm * npn; u.e = tile_e[u.pm]; return true;
    }
    __device__ __forceinline__ unsigned a_row_off(const Unit& u, int R) const { return a_row_raw(u, R) * (unsigned)lda_b; }
    __device__ __forceinline__ unsigned a_row_raw(const Unit& u, int R) const { const int row = u.pm * BM + R; if constexpr (RT_) return (unsigned)rowtok[row]; else return (unsigned)row; }
    __device__ __forceinline__ unsigned a_row_scale(unsigned raw) const { return raw * (unsigned)lda_b; }
    int hotA = 0;
    __device__ __forceinline__ size_t a_unit_base(const Unit& u) const { return (size_t)(hotA ? (u.pm & 3) : u.pm) * BM * (size_t)lda_b; }
    __device__ __forceinline__ unsigned a_lane_off(int R) const { return (unsigned)R * (unsigned)lda_b; }
    int hotB = 0;
    __device__ __forceinline__ const char* b_ptr(const Unit& u) const { return Bt + (size_t)(hotB ? (u.e & 1) : u.e) * estride_b + (size_t)u.pn * pnstride_b; }
};
__device__ __forceinline__ int moe_sched_build(FX_LAS unsigned char* tab, const int* CNT, int tidp) {
    FX_LAS int* nt = (FX_LAS int*)(tab + 512);
    int tid_ = tidp; asm volatile("" : "+v"(tid_));
    if (tid_ < 64) { const int n = (CNT[tid_] + 255) >> 8; int incl = n;
#pragma unroll
        for (int o = 1; o < 64; o <<= 1) { const int t2 = __shfl_up(incl, o); if (tid_ >= o) incl += t2; }
        const int st0 = 64 + incl - n; for (int j = 0; j < n; ++j) tab[st0 + j] = (unsigned char)tid_;
        tab[tid_] = 64; if (tid_ == 63) nt[0] = 64 + incl; }
    __syncthreads();
    return nt[0];
}
struct EpiGateUp {
    static constexpr bool PERM = true; static constexpr int NST = 4;
    unsigned char* HID; FX_LAS unsigned char* es;
    __device__ __forceinline__ void operator()(const f32x4 (&acc)[2][2][4][2], const Unit& u, int wr, int wc, int fr, int fq) const {
        FX_LAS unsigned char* buf = es + (wr * 4 + wc) * 2304;
        const int lane = fq * 16 + fr, rr = lane >> 1, rch = lane & 1;
#pragma unroll
        for (int ai = 0; ai < 2; ++ai)
#pragma unroll
            for (int p = 0; p < 2; ++p) {
#pragma unroll
                for (int mm = 0; mm < 2; ++mm) { const int m = 2 * p + mm;
                    float o[8];
#pragma unroll
                    for (int n = 0; n < 2; ++n)
#pragma unroll
                        for (int j = 0; j < 4; ++j) { const float g = acc[ai][0][m][n][j] * W8_INV, up = acc[ai][1][m][n][j] * W8_INV; o[n * 4 + j] = g * __builtin_amdgcn_rcpf(1.f + __expf(-g)) * up; }
                    u32x2 w; w.x = cvt_pk4_fp8(o[0], o[1], o[2], o[3]); w.y = cvt_pk4_fp8(o[4], o[5], o[6], o[7]);
                    *(FX_LAS u32x2*)(buf + (mm * 16 + fr) * 48 + fq * 8) = w; }
                const u32x4 v = *(const FX_LAS u32x4*)(buf + rr * 48 + rch * 16);
                const int row = u.pm * BM + wr * 64 + ai * HALF + (2 * p + (rr >> 4)) * 16 + (rr & 15);
                *(u32x4*)(HID + (size_t)row * 512 + u.pn * 128 + wc * 32 + rch * 16) = v; }
    }
    __device__ __forceinline__ void e32(const f32x16 (&acc3)[2][2][2], const Unit& u, int wr, int wc, int lane) const {
        const int j = lane & 31, hi = lane >> 5;
#pragma unroll
        for (int ai = 0; ai < 2; ++ai)
#pragma unroll
            for (int mb = 0; mb < 2; ++mb) { const int row = u.pm * BM + ai * HALF + wr * 64 + mb * 32 + j; unsigned char* rowp = HID + (size_t)row * 512 + u.pn * 128 + wc * 32 + 4 * hi;
#pragma unroll
                for (int g = 0; g < 4; ++g) { float o[4];
#pragma unroll
                    for (int q = 0; q < 4; ++q) { const float gt = acc3[ai][0][mb][4 * g + q] * W8_INV, up = acc3[ai][1][mb][4 * g + q] * W8_INV; o[q] = gt * __builtin_amdgcn_rcpf(1.f + __expf(-gt)) * up; }
                    *(unsigned*)(rowp + 8 * g) = cvt_pk4_fp8(o[0], o[1], o[2], o[3]); } }
    }
};
struct EpiDown {
    static constexpr bool PERM = true; static constexpr int NST = 8;
    unsigned char* YR; const float* ROWG; int nostore; FX_LAS unsigned char* es;
    __device__ __forceinline__ void operator()(const f32x4 (&acc)[2][2][4][2], const Unit& u, int wr, int wc, int fr, int fq) const {
        FX_LAS unsigned char* buf = es + (wr * 4 + wc) * 2304;
        const int lane = fq * 16 + fr, rrow = lane >> 2, rch = lane & 3;
#pragma unroll
        for (int ai = 0; ai < 2; ++ai)
#pragma unroll
            for (int m = 0; m < 4; ++m) { const float g = W8_INV;
#pragma unroll
                for (int bj = 0; bj < 2; ++bj) { const f32x4 v0 = acc[ai][bj][m][0] * g, v1 = acc[ai][bj][m][1] * g;
                    u32x2 w; w.x = cvt_pk4_fp8(v0[0], v0[1], v0[2], v0[3]); w.y = cvt_pk4_fp8(v1[0], v1[1], v1[2], v1[3]);
                    *(FX_LAS u32x2*)(buf + fr * 80 + bj * 32 + fq * 8) = w; }
                const u32x4 v = *(const FX_LAS u32x4*)(buf + rrow * 80 + rch * 16);
                const int row = u.pm * BM + wr * 64 + ai * HALF + m * 16 + rrow;
                *(u32x4*)(YR + (size_t)row * 2048 + u.pn * BM + (rch >> 1) * HALF + wc * 32 + (rch & 1) * 16) = v; }
    }
    __device__ __forceinline__ void e32(const f32x16 (&acc3)[2][2][2], const Unit& u, int wr, int wc, int lane) const {
        const int j = lane & 31, hi = lane >> 5;
#pragma unroll
        for (int ai = 0; ai < 2; ++ai)
#pragma unroll
            for (int mb = 0; mb < 2; ++mb) { const int row = u.pm * BM + ai * HALF + wr * 64 + mb * 32 + j; const float gsc = ROWG[row] * W8_INV;
#pragma unroll
                for (int bj = 0; bj < 2; ++bj) { unsigned char* rowp = YR + (size_t)row * 2048 + u.pn * BM + bj * HALF + wc * 32 + 4 * hi;
#pragma unroll
                    for (int g = 0; g < 4; ++g) *(unsigned*)(rowp + 8 * g) = cvt_pk4_fp8(acc3[ai][bj][mb][4 * g] * gsc, acc3[ai][bj][mb][4 * g + 1] * gsc, acc3[ai][bj][mb][4 * g + 2] * gsc, acc3[ai][bj][mb][4 * g + 3] * gsc); } }
    }
};
__device__ __forceinline__ void p9_phase(FX_LAS unsigned char* lds, const unsigned char* HA, const unsigned char* WGU, const int* CNT, const int* ROWTOK, unsigned char* HID, int wg, int nwg, int tidp, const int noepi = 0) {
    FX_LAS unsigned char* tab = lds + STAGE_BYTES;
    const int ntiles = moe_sched_build(tab, CNT, tidp);
    MoeSchedT<true> Sc; Sc.tile_e = tab; Sc.ntiles = ntiles; Sc.npn = 4; Sc.nunits = ntiles * 4; Sc.G = nwg; Sc.c = wg; Sc.rowtok = ROWTOK; Sc.lda_b = 2048; Sc.Bt = (const char*)WGU; Sc.estride_b = (size_t)1024 * 2048; Sc.pnstride_b = (size_t)256 * 2048;
    EpiGateUp E; E.HID = HID; E.es = lds + EPI_LDS_OFF;
    gemm_phase<EpiGateUp, MoeSchedT<true>, true>(lds, (const char*)HA, 2048, Sc, E, tidp, noepi);
}
__device__ __forceinline__ void p10_phase(FX_LAS unsigned char* lds, const unsigned char* HID, const unsigned char* WDN, const int* CNT, const float* ROWG, unsigned char* YR, int wg, int nwg, int tidp, const int noepi = 0) {
    FX_LAS unsigned char* tab = lds + STAGE_BYTES;
    const int ntiles = moe_sched_build(tab, CNT, tidp);
    MoeSchedT<false> Sc; Sc.tile_e = tab; Sc.ntiles = ntiles; Sc.npn = 8; Sc.nunits = ntiles * 8; Sc.G = nwg; Sc.c = wg; Sc.rowtok = nullptr; Sc.lda_b = 512; Sc.Bt = (const char*)WDN; Sc.estride_b = (size_t)2048 * 512; Sc.pnstride_b = (size_t)256 * 512;
    EpiDown E; E.YR = YR; E.ROWG = ROWG; E.nostore = 0; E.es = lds + EPI_LDS_OFF; Sc.hotA = (FX_HOTA == 1 && noepi == 1) ? 1 : 0; Sc.hotB = (FX_HOTA == 2 && noepi == 1) ? 1 : 0;
    if (FX_HOTA == 3 && noepi == 1) { Sc.lda_b = 128; gemm_phase<EpiDown, MoeSchedT<false>, true>(lds, (const char*)HID, 512, Sc, E, tidp, 3); return; }
    gemm_phase<EpiDown, MoeSchedT<false>, true>(lds, (const char*)HID, 512, Sc, E, tidp, noepi == 1);
}
template <bool OUTF32>
__device__ __forceinline__ void p11_phase(const bf16_t* x1, const unsigned char* YR, const int* SLOT, const float* SELG, const float* coef_l, const float* coef_next  , void* xout_, bf16_t* HA, int wg, int nwg, int tidp) {
    int tid_ = tidp; asm volatile("" : "+v"(tid_));
    const int wid = __builtin_amdgcn_readfirstlane(tid_ >> 6), lane = tid_ & 63;
    for (int t = wg * 8 + wid; t < T; t += nwg * 8) {
        const int b = t / S; const float* cf = coef_l + (size_t)b * 6 * 2048;
        int rows[7]; rows[0] = t;
        float gk[7]; gk[0] = 1.f;
        { int sl[6]; float sg[6];
#pragma unroll
          for (int k = 0; k < 6; ++k) { sl[k] = *FX_GC(int, SLOT + (size_t)t * 6 + k); sg[k] = *FX_GC(float, SELG + (size_t)t * 6 + k); }
#pragma unroll
          for (int k = 0; k < 6; ++k) { rows[k + 1] = __builtin_amdgcn_readfirstlane(sl[k]); gk[k + 1] = __builtin_bit_cast(float, __builtin_amdgcn_readfirstlane(__builtin_bit_cast(int, sg[k]))); } }
        u32x2 ra[4][4];
#pragma unroll
        for (int k = 0; k < 4; ++k)
#pragma unroll
            for (int i = 0; i < 4; ++i) ra[k][i] = *FX_GC(u32x2, YR + (size_t)rows[k] * 2048 + i * 512 + lane * 8);
        u32x4 xw[4];
#pragma unroll
        for (int i = 0; i < 4; ++i) xw[i] = *FX_GC(u32x4, x1 + (size_t)t * 2048 + i * 512 + lane * 8);
        float yv[32];
#pragma unroll
        for (int j = 0; j < 32; ++j) yv[j] = 0.f;
#define FX_ACC8(W, I, G) do { const f32x2 a0 = __builtin_amdgcn_cvt_pk_f32_fp8((int)(W).x, false), a1 = __builtin_amdgcn_cvt_pk_f32_fp8((int)(W).x, true), a2 = __builtin_amdgcn_cvt_pk_f32_fp8((int)(W).y, false), a3 = __builtin_amdgcn_cvt_pk_f32_fp8((int)(W).y, true); \
            yv[(I) * 8 + 0] += (G) * a0[0]; yv[(I) * 8 + 1] += (G) * a0[1]; yv[(I) * 8 + 2] += (G) * a1[0]; yv[(I) * 8 + 3] += (G) * a1[1]; yv[(I) * 8 + 4] += (G) * a2[0]; yv[(I) * 8 + 5] += (G) * a2[1]; yv[(I) * 8 + 6] += (G) * a3[0]; yv[(I) * 8 + 7] += (G) * a3[1]; } while (0)
#pragma unroll
        for (int k = 0; k < 4; ++k)
#pragma unroll
            for (int i = 0; i < 4; ++i) FX_ACC8(ra[k][i], i, gk[k]);
        u32x2 rb[3][4];
#pragma unroll
        for (int k = 0; k < 3; ++k)
#pragma unroll
            for (int i = 0; i < 4; ++i) rb[k][i] = *FX_GC(u32x2, YR + (size_t)rows[4 + k] * 2048 + i * 512 + lane * 8);
        f32x4 cd[8];
#pragma unroll
        for (int i = 0; i < 4; ++i) { cd[2 * i] = *FX_GC(f32x4, cf + 3 * 2048 + i * 512 + lane * 8); cd[2 * i + 1] = *FX_GC(f32x4, cf + 3 * 2048 + i * 512 + lane * 8 + 4); }
#pragma unroll
        for (int k = 0; k < 3; ++k)
#pragma unroll
            for (int i = 0; i < 4; ++i) FX_ACC8(rb[k][i], i, gk[4 + k]);
#undef FX_ACC8
        float ss = 0.f;
#pragma unroll
        for (int j = 0; j < 32; ++j) ss += yv[j] * yv[j];
        ss = wave_sum(ss); const float ry = rsqrtf(ss * (1.f / 2048.f) + EPS); float ssx = 0.f;
#pragma unroll
        for (int i = 0; i < 4; ++i) { const u32x4 w = xw[i];
            const float xs[8] = {bflo(w.x), bfhi(w.x), bflo(w.y), bfhi(w.y), bflo(w.z), bfhi(w.z), bflo(w.w), bfhi(w.w)};
#pragma unroll
            for (int j = 0; j < 8; ++j) { yv[i * 8 + j] = xs[j] + cd[2 * i + (j >> 2)][j & 3] * (yv[i * 8 + j] * ry); ssx += yv[i * 8 + j] * yv[i * 8 + j]; } }
        f32x4 ce[8], cg[8];
        if (coef_next) { const float* cn = coef_next + (size_t)b * 6 * 2048;
#pragma unroll
            for (int i = 0; i < 4; ++i) { ce[2 * i] = *FX_GC(f32x4, cn + 4 * 2048 + i * 512 + lane * 8); ce[2 * i + 1] = *FX_GC(f32x4, cn + 4 * 2048 + i * 512 + lane * 8 + 4);
                cg[2 * i] = *FX_GC(f32x4, cn + 5 * 2048 + i * 512 + lane * 8); cg[2 * i + 1] = *FX_GC(f32x4, cn + 5 * 2048 + i * 512 + lane * 8 + 4); } }
#pragma unroll
        for (int i = 0; i < 4; ++i) { const int c = i * 512 + lane * 8;
            if constexpr (OUTF32) { float* xout = (float*)xout_; *FX_GM(f32x4, xout + (size_t)t * 2048 + c) = (f32x4){yv[i * 8 + 0], yv[i * 8 + 1], yv[i * 8 + 2], yv[i * 8 + 3]};
                *FX_GM(f32x4, xout + (size_t)t * 2048 + c + 4) = (f32x4){yv[i * 8 + 4], yv[i * 8 + 5], yv[i * 8 + 6], yv[i * 8 + 7]}; }
            else { u32x4 xo; xo.x = cvt_pk_bf16(yv[i * 8 + 0], yv[i * 8 + 1]); xo.y = cvt_pk_bf16(yv[i * 8 + 2], yv[i * 8 + 3]); xo.z = cvt_pk_bf16(yv[i * 8 + 4], yv[i * 8 + 5]); xo.w = cvt_pk_bf16(yv[i * 8 + 6], yv[i * 8 + 7]);
                *FX_GM(u32x4, (bf16_t*)xout_ + (size_t)t * 2048 + c) = xo; } }
        if (coef_next) { ssx = wave_sum(ssx); const float rx = rsqrtf(ssx * (1.f / 2048.f) + EPS);
#pragma unroll
            for (int i = 0; i < 4; ++i) { const int c = i * 512 + lane * 8;
                float hv[8];
#pragma unroll
                for (int j = 0; j < 8; ++j) hv[j] = yv[i * 8 + j] * rx * ce[2 * i + (j >> 2)][j & 3] + cg[2 * i + (j >> 2)][j & 3];
#ifdef FX_WIN8
                u32x2 w; w.x = cvt_pk4_fp8(hv[0], hv[1], hv[2], hv[3]); w.y = cvt_pk4_fp8(hv[4], hv[5], hv[6], hv[7]);
                *FX_GM(u32x2, (unsigned char*)HA + (size_t)t * 2048 + c) = w; } }
#else
                u32x4 w; w.x = cvt_pk_bf16(hv[0], hv[1]); w.y = cvt_pk_bf16(hv[2], hv[3]); w.z = cvt_pk_bf16(hv[4], hv[5]); w.w = cvt_pk_bf16(hv[6], hv[7]);
                *FX_GM(u32x4, HA + (size_t)t * 2048 + c) = w; } }
#endif
    }
}
}
namespace fx {
#ifndef FX_YMPERM
#define FX_YMPERM 1
#endif
#ifndef FX_SD_A
#define FX_SD_A 2
#endif
#ifndef FX_SD_B
#define FX_SD_B 1
#endif
#ifndef FX_NQR_B
#define FX_NQR_B 12
#endif
#define FX_SBAR() __builtin_amdgcn_sched_barrier(0)
__device__ __forceinline__ int crow(int r, int hi) { return (r & 3) + 8 * (r >> 2) + 4 * hi; }
__device__ __forceinline__ int v_st(int k, int c) { const int kk = (k & ~0xC) | ((k & 4) << 1) | ((k & 8) >> 1); return ((kk >> 3) * 4 + (c >> 5)) * 512 + ((kk & 7) * 32 + (c & 31)) * 2; }
__device__ __forceinline__ int v_rd_base(int lane) { return ((lane & 3) << 3) | (((lane >> 2) & 3) << 6) | (((lane >> 4) & 1) << 5) | (((lane >> 5) & 1) << 8); }
constexpr int v_rd_off(int d0, int ks, int half) { return d0 * 512 + ks * 4096 + half * 2048; }
template <int OFF> __device__ __forceinline__ s16x4 tr_read(int vb) { s16x4 r; asm volatile("ds_read_b64_tr_b16 %0, %1 offset:%2" : "=&v"(r) : "v"(vb), "i"(OFF) : "memory"); return r; }
#define FX_PK(L, H) (bf16x8){L[0], L[1], L[2], L[3], H[0], H[1], H[2], H[3]}
template <int D0> __device__ __forceinline__ void pv_one(f32x16& od, int vb, bf16x8 pa0, bf16x8 pa1, bf16x8 pa2, bf16x8 pa3) {
    const s16x4 l0 = tr_read<v_rd_off(D0, 0, 0)>(vb), h0 = tr_read<v_rd_off(D0, 0, 1)>(vb), l1 = tr_read<v_rd_off(D0, 1, 0)>(vb), h1 = tr_read<v_rd_off(D0, 1, 1)>(vb);
    const s16x4 l2 = tr_read<v_rd_off(D0, 2, 0)>(vb), h2 = tr_read<v_rd_off(D0, 2, 1)>(vb), l3 = tr_read<v_rd_off(D0, 3, 0)>(vb), h3 = tr_read<v_rd_off(D0, 3, 1)>(vb);
    asm volatile("s_waitcnt lgkmcnt(0)" ::: "memory"); FX_SBAR();
    od = __builtin_amdgcn_mfma_f32_32x32x16_bf16(pa0, FX_PK(l0, h0), od, 0, 0, 0);
    od = __builtin_amdgcn_mfma_f32_32x32x16_bf16(pa1, FX_PK(l1, h1), od, 0, 0, 0);
    od = __builtin_amdgcn_mfma_f32_32x32x16_bf16(pa2, FX_PK(l2, h2), od, 0, 0, 0);
    od = __builtin_amdgcn_mfma_f32_32x32x16_bf16(pa3, FX_PK(l3, h3), od, 0, 0, 0);
}
__device__ __forceinline__ void pv_d0(f32x16* o, int vb, bf16x8 pa0, bf16x8 pa1, bf16x8 pa2, bf16x8 pa3) {
    pv_one<0>(o[0], vb, pa0, pa1, pa2, pa3); pv_one<1>(o[1], vb, pa0, pa1, pa2, pa3); pv_one<2>(o[2], vb, pa0, pa1, pa2, pa3); pv_one<3>(o[3], vb, pa0, pa1, pa2, pa3);
}
#define FX_PK4(P, BASE, OUT) do { unsigned a0 = cvt_pk_bf16(P[BASE + 0], P[BASE + 1]), a1 = cvt_pk_bf16(P[BASE + 2], P[BASE + 3]);   \
    unsigned b0 = cvt_pk_bf16(P[BASE + 4], P[BASE + 5]), b1 = cvt_pk_bf16(P[BASE + 6], P[BASE + 7]);                              \
    auto r0 = __builtin_amdgcn_permlane32_swap(a0, b0, false, false); auto r1 = __builtin_amdgcn_permlane32_swap(a1, b1, false, false); \
    u32x4 w = {r0[0], r1[0], r0[1], r1[1]}; OUT = *reinterpret_cast<bf16x8*>(&w); } while (0)

template <int DQK> struct AttnC {
    static constexpr int NQ = DQK / 16, KROW = DQK * 2, SHM_V = 64 * 128 * 2, SHM_K = 64 * DQK * 2, NQR = (DQK == 128 ? 8 : FX_NQR_B)  , QX = (NQ - NQR) * 8 * 64 * 16, SHM = 2 * SHM_V + 2 * SHM_K + 8 * 64 * 4 + QX;
    static constexpr float SCALE = DQK == 128 ? 0.088388347648318440f : 0.072168783648703220f;
    static constexpr float THR = 8.f;
};
#define FX_KSWZ(row, colB) ((row) * C::KROW + ((colB) ^ (((row) & 7) << 4)))

template <int DQK> __device__ __forceinline__ void partialSM(f32x16& p0, f32x16& p1, float& m_reg, float& mn, float& alpha) {
    using C = AttnC<DQK>;
    constexpr float Cc = C::SCALE * 1.4426950408889634f;
    float pmax = p0[0];
#pragma unroll
    for (int r = 1; r < 16; ++r) pmax = fmaxf(pmax, p0[r]);
#pragma unroll
    for (int r = 0; r < 16; ++r) pmax = fmaxf(pmax, p1[r]);
    { auto rr = __builtin_amdgcn_permlane32_swap(__float_as_uint(pmax), __float_as_uint(pmax), false, false); pmax = fmaxf(__uint_as_float(rr[0]), __uint_as_float(rr[1])); }
    if (__builtin_expect(__all(pmax - m_reg <= C::THR / C::SCALE), 1)) { mn = m_reg; alpha = 1.f; }
    else { mn = fmaxf(m_reg, pmax); alpha = __builtin_amdgcn_exp2f((m_reg - mn) * Cc); m_reg = mn; }
    const float mnC = -mn * Cc;
#pragma unroll
    for (int r = 0; r < 16; ++r) p0[r] = fmaf(p0[r], Cc, mnC);
#pragma unroll
    for (int r = 0; r < 16; ++r) p1[r] = fmaf(p1[r], Cc, mnC);
#pragma unroll
    for (int r = 0; r < 16; ++r) p0[r] = __builtin_amdgcn_exp2f(p0[r]);
}
__device__ __forceinline__ void finishSM(f32x16& p0, f32x16& p1, float alpha, float& l_reg, bf16x8& pa0, bf16x8& pa1, bf16x8& pa2, bf16x8& pa3) {
#pragma unroll
    for (int r = 0; r < 16; ++r) p1[r] = __builtin_amdgcn_exp2f(p1[r]);
    float ps = 0;
#pragma unroll
    for (int r = 0; r < 16; ++r) ps += p0[r];
#pragma unroll
    for (int r = 0; r < 16; ++r) ps += p1[r];
    { auto rr = __builtin_amdgcn_permlane32_swap(__float_as_uint(ps), __float_as_uint(ps), false, false); ps = __uint_as_float(rr[0]) + __uint_as_float(rr[1]); }
    l_reg = l_reg * alpha + ps;
    FX_PK4(p0, 0, pa0); FX_PK4(p0, 8, pa1); FX_PK4(p1, 0, pa2); FX_PK4(p1, 8, pa3);
}
template <int DQK> __device__ __forceinline__ void qkt(f32x16& p0, f32x16& p1, const char* Ks, const bf16x8* qr, const char* qx  , int r32, int hi) {
    using C = AttnC<DQK>;
    p0 = f32x16{}; p1 = f32x16{};
#pragma unroll
    for (int d0 = 0; d0 < C::NQ; ++d0) { const int cb = (d0 * 16 + hi * 8) * 2;
        const bf16x8 qf = d0 < C::NQR ? qr[d0 < C::NQR ? d0 : 0] : *reinterpret_cast<const bf16x8*>(qx + (d0 - C::NQR) * 1024);
        const bf16x8 b0 = *reinterpret_cast<const bf16x8*>(Ks + FX_KSWZ(r32, cb));
        const bf16x8 b1 = *reinterpret_cast<const bf16x8*>(Ks + FX_KSWZ(32 + r32, cb));
        p0 = __builtin_amdgcn_mfma_f32_32x32x16_bf16(b0, qf, p0, 0, 0, 0);
        p1 = __builtin_amdgcn_mfma_f32_32x32x16_bf16(b1, qf, p1, 0, 0, 0); }
}

template <int DQK, int SD, int LDQ, int LDK1, int LDK2, int LDV>
__device__ __forceinline__ void attn_unit(const bf16_t* __restrict__ Qb, const bf16_t* __restrict__ K1, const bf16_t* __restrict__ K2, const bf16_t* __restrict__ Vh,
                                          bf16_t* __restrict__ Ob, const float* __restrict__ gain, int seq, char* lds, int tidp) {
    using C = AttnC<DQK>;
    int tid_ = tidp; asm volatile("" : "+v"(tid_));
    const int tid = tid_, wid = __builtin_amdgcn_readfirstlane(tid >> 6)  , lane = tid & 63, r32 = lane & 31, hi = lane >> 5;
    char* V_lds = lds; char* K_lds = lds + 2 * C::SHM_V;
    float* ws = (float*)(lds + 2 * C::SHM_V + 2 * C::SHM_K) + wid * 64; float* li_l = ws; float* al_l = ws + 32;
    float m_reg = -1e30f, l_reg = 0; f32x16 o[4] = {}; bf16x8 qr[C::NQR];
    char* qx = lds + 2 * C::SHM_V + 2 * C::SHM_K + 8 * 64 * 4 + wid * ((C::NQ - C::NQR) * 1024) + lane * 16;
    const bf16_t* Qw = Qb + (long)(wid * 32 + r32) * LDQ + hi * 8;
#pragma unroll
    for (int d0 = 0; d0 < C::NQR; ++d0) qr[d0] = *reinterpret_cast<const bf16x8*>(Qw + d0 * 16);
#pragma unroll
    for (int d0 = C::NQR; d0 < C::NQ; ++d0) *reinterpret_cast<bf16x8*>(qx + (d0 - C::NQR) * 1024) = *reinterpret_cast<const bf16x8*>(Qw + d0 * 16);
    const int sr = tid >> 4, sc = (tid & 15) * 8, vst0 = v_st(sr, sc), vst1 = v_st(32 + sr, sc);
    const int vb0 = (int)(uintptr_t)V_lds + v_rd_base(lane);
    const int xr = tid >> 3, xc = (tid & 7) * 8;
    struct { bf16x8 vs0, vs1, ks0, ks1, kx; } sr_[SD];
#define FX_SLOAD(i, k0) do { sr_[i].vs0 = *reinterpret_cast<const bf16x8*>(&Vh[(long)((k0) + sr) * LDV + sc]); sr_[i].vs1 = *reinterpret_cast<const bf16x8*>(&Vh[(long)((k0) + 32 + sr) * LDV + sc]); \
    sr_[i].ks0 = *reinterpret_cast<const bf16x8*>(&K1[(long)((k0) + sr) * LDK1 + sc]); sr_[i].ks1 = *reinterpret_cast<const bf16x8*>(&K1[(long)((k0) + 32 + sr) * LDK1 + sc]); \
    if (DQK == 192) sr_[i].kx = *reinterpret_cast<const bf16x8*>(&K2[(long)((k0) + xr) * LDK2 + xc]); } while (0)
#define FX_SWRITE(b, i) do { *(bf16x8*)(V_lds + (b) * C::SHM_V + vst0) = sr_[i].vs0; *(bf16x8*)(V_lds + (b) * C::SHM_V + vst1) = sr_[i].vs1; const int kc = sc * 2; \
    *(bf16x8*)(K_lds + (b) * C::SHM_K + FX_KSWZ(sr, kc)) = sr_[i].ks0; *(bf16x8*)(K_lds + (b) * C::SHM_K + FX_KSWZ(32 + sr, kc)) = sr_[i].ks1; \
    if (DQK == 192) *(bf16x8*)(K_lds + (b) * C::SHM_K + FX_KSWZ(xr, 256 + xc * 2)) = sr_[i].kx; } while (0)
#define FX_SWAIT() do { if (SD == 1) asm volatile("s_waitcnt vmcnt(0)" ::: "memory"); else if (DQK == 192) asm volatile("s_waitcnt vmcnt(5)" ::: "memory"); else asm volatile("s_waitcnt vmcnt(4)" ::: "memory"); } while (0)
#define FX_RESC(a) do { if (__any((a) < 1.f)) { if (hi == 0) al_l[r32] = (a); asm volatile("s_waitcnt lgkmcnt(0)" ::: "memory"); \
    _Pragma("unroll") for (int d = 0; d < 4; ++d) _Pragma("unroll") for (int r = 0; r < 16; ++r) o[d][r] *= al_l[crow(r, hi)]; } } while (0)
    f32x16 pA0, pA1, pB0, pB1; float mnA, mnB, alA, alB; bf16x8 pa0, pa1, pa2, pa3; const int NT = seq / 64;
    constexpr int SE = 0, SO = SD - 1;
    FX_SLOAD(SE, 0); asm volatile("s_waitcnt vmcnt(0)" ::: "memory"); FX_SWRITE(0, SE); __syncthreads();
    qkt<DQK>(pA0, pA1, K_lds, qr, qx, r32, hi); partialSM<DQK>(pA0, pA1, m_reg, mnA, alA);
    FX_SLOAD(SO, 64); if (SD == 2) { if (2 < NT) FX_SLOAD(SE, 128); }
    FX_SWAIT(); FX_SWRITE(1, SO); __syncthreads();
    for (int j = 1; j + 1 < NT; j += 2) {
        FX_SBAR(); qkt<DQK>(pB0, pB1, K_lds + C::SHM_K, qr, qx, r32, hi);
        finishSM(pA0, pA1, alA, l_reg, pa0, pa1, pa2, pa3); FX_SBAR();
        FX_SLOAD(SO, (j + SD) * 64); FX_SBAR();
        pv_d0(o, vb0, pa0, pa1, pa2, pa3); partialSM<DQK>(pB0, pB1, m_reg, mnB, alB);
        __syncthreads(); FX_SWAIT(); FX_SWRITE(0, SE);
        FX_RESC(alB); __syncthreads();
        FX_SBAR(); qkt<DQK>(pA0, pA1, K_lds, qr, qx, r32, hi);
        finishSM(pB0, pB1, alB, l_reg, pa0, pa1, pa2, pa3); FX_SBAR();
        if (SD == 1 || j + 3 < NT) FX_SLOAD(SE, (j + 1 + SD) * 64); FX_SBAR();
        pv_d0(o, vb0 + C::SHM_V, pa0, pa1, pa2, pa3); partialSM<DQK>(pA0, pA1, m_reg, mnA, alA);
        __syncthreads(); FX_SWAIT(); FX_SWRITE(1, SO);
        FX_RESC(alA); __syncthreads();
    }
    FX_SBAR(); qkt<DQK>(pB0, pB1, K_lds + C::SHM_K, qr, qx, r32, hi);
    finishSM(pA0, pA1, alA, l_reg, pa0, pa1, pa2, pa3); FX_SBAR();
    pv_d0(o, vb0, pa0, pa1, pa2, pa3); partialSM<DQK>(pB0, pB1, m_reg, mnB, alB);
    __syncthreads(); FX_RESC(alB);
    finishSM(pB0, pB1, alB, l_reg, pa0, pa1, pa2, pa3); FX_SBAR();
    pv_d0(o, vb0 + C::SHM_V, pa0, pa1, pa2, pa3);
    if (hi == 0) li_l[r32] = l_reg; asm volatile("s_waitcnt lgkmcnt(0)" ::: "memory");
    int r32e = r32; asm volatile("" : "+v"(r32e));
    float g4[4];
#pragma unroll
    for (int d0 = 0; d0 < 4; ++d0) g4[d0] = gain[d0 * 32 + r32e];
    bf16_t* Ow = Ob + (long)(wid * 32) * 2048;
#pragma unroll
    for (int r = 0; r < 16; ++r) { const float rl = __builtin_amdgcn_rcpf(li_l[crow(r, hi)]);
        float ss = 0.f;
#pragma unroll
        for (int d0 = 0; d0 < 4; ++d0) { o[d0][r] *= rl; ss += o[d0][r] * o[d0][r]; }
        ss += __shfl_xor(ss, 1); ss += __shfl_xor(ss, 2); ss += __shfl_xor(ss, 4); ss += __shfl_xor(ss, 8); ss += __shfl_xor(ss, 16);
        const float rn = rsqrtf(ss * (1.f / 128.f) + EPS); const int orow = crow(r, hi);
#if defined(FX_WOUT8) && FX_YMPERM
        *(unsigned*)((unsigned char*)Ob + (long)(wid * 32 + orow) * 2048 + 4 * r32e) = cvt_pk4_fp8(o[0][r] * rn * g4[0], o[1][r] * rn * g4[1], o[2][r] * rn * g4[2], o[3][r] * rn * g4[3]); }
#elif defined(FX_WOUT8)
#pragma unroll
        for (int d0 = 0; d0 < 4; ++d0) ((unsigned char*)Ob)[(long)(wid * 32 + orow) * 2048 + d0 * 32 + r32e] = (unsigned char)(__builtin_amdgcn_cvt_pk_fp8_f32(o[d0][r] * rn * g4[d0], 0.f, 0, false) & 0xff); }
#else
#pragma unroll
        for (int d0 = 0; d0 < 4; ++d0) Ow[(long)orow * 2048 + d0 * 32 + r32e] = f2bf(o[d0][r] * rn * g4[d0]); }
#endif
    __syncthreads();
#undef FX_SLOAD
#undef FX_SWRITE
#undef FX_SWAIT
#undef FX_RESC
}

__device__ __forceinline__ void attn_gqa_unit(int u, const bf16_t* QA, const bf16_t* KA, const bf16_t* PROJ, bf16_t* YM, const float* hog, char* lds, int tidp) {
    const int qb = u & 15, hh = (u >> 4) % 6, b = u / 96, kvh = hh / 3;
    const size_t t0 = (size_t)b * S;
    attn_unit<128, FX_SD_A, 768, 256, 0, PW>(QA + (t0 + qb * 256) * 768 + hh * 128, KA + t0 * 256 + kvh * 128, nullptr, PROJ + t0 * PW + O_AV + kvh * 128,
#ifdef FX_WOUT8
                                    (bf16_t*)((unsigned char*)YM + (t0 + qb * 256) * 2048 + hh * 128), hog + hh * 128, S, lds, tidp);
#else
                                    YM + (t0 + qb * 256) * 2048 + hh * 128, hog + hh * 128, S, lds, tidp);
#endif
}
__device__ __forceinline__ void attn_mla_unit(int u, const bf16_t* QB, const bf16_t* KVB, const bf16_t* KR, bf16_t* YM, const float* hog, char* lds, int tidp) {
    const int qb = u & 15, hh = (u >> 4) % 6, b = u / 96;
    const size_t t0 = (size_t)b * S;
    attn_unit<192, FX_SD_B, 1280, 1536, 64, 1536>(QB + (t0 + qb * 256) * 1280 + hh * 192, KVB + t0 * 1536 + hh * 256, KR + t0 * 64, KVB + t0 * 1536 + hh * 256 + 128,
#ifdef FX_WOUT8
                                         (bf16_t*)((unsigned char*)YM + (t0 + qb * 256) * 2048 + 768 + hh * 128), hog + 768 + hh * 128, S, lds, tidp);
#else
                                         YM + (t0 + qb * 256) * 2048 + 768 + hh * 128, hog + 768 + hh * 128, S, lds, tidp);
#endif
}
}
namespace fx {
constexpr int P3_LDS = 4096 + 2048 + 65536 + 32768;
constexpr float KSCALE = 0.08838834764831845f;
__device__ __forceinline__ float logsigmoid_f(float f) { return fminf(f, 0.f) - log1pf(__expf(-fabsf(f))); }
__device__ __forceinline__ float wave_scan_incl(float v, int lane) {
#pragma unroll
    for (int o = 1; o < 64; o <<= 1) { const float t = __shfl_up(v, o); if (lane >= o) v += t; }
    return v;
}
__device__ __forceinline__ float wave_scanmax_incl(float v, int lane) {
#pragma unroll
    for (int o = 1; o < 64; o <<= 1) { const float t = __shfl_up(v, o); if (lane >= o) v = fmaxf(v, t); }
    return v;
}
__device__ __forceinline__ float wave_rscanmax_incl(float v, int lane) {
#pragma unroll
    for (int o = 1; o < 64; o <<= 1) { const float t = __shfl_down(v, o); if (lane + o < 64) v = fmaxf(v, t); }
    return v;
}

struct P3Args {
    const bf16_t* PROJ; const float* GATES; const float* gate_b; const float* conv_w; const float* conv_b;
    const float* aq_gain; const float* ak_gain; const float* cq_gain; const float* ckv_gain;
    const float* cosA; const float* sinA; const float* cosB; const float* sinB;
    bf16_t* QA; bf16_t* KA; bf16_t* CQN; bf16_t* CKVN; bf16_t* KR; bf16_t* QC; bf16_t* KC; bf16_t* KCT; float* NLOC; float* GSC;
};
__device__ __forceinline__ void p3_phase(FX_LAS unsigned char* lds_, const P3Args& a, int wg, int nwg, int tidp) {
    char* lds = (char*)lds_;
    float* gat = (float*)lds; float* wts = (float*)(lds + 4096); char* ktile = lds + 6144; char* wv = lds + 6144 + 65536;
    for (int unit = wg; unit < T / 64; unit += nwg) {
        int tid_ = tidp; asm volatile("" : "+v"(tid_));
        const int tid = tid_, wid = tid >> 6, lane = tid & 63;
        const int b = unit >> 6, co = unit & 63; const size_t t0 = (size_t)unit * 64;
        for (int i = tid; i < 1024; i += 512) gat[i] = a.GATES[t0 * 16 + i] + a.gate_b[i & 15];
        __syncthreads();
        { const int dir = wid >> 2, h = wid & 3;
          const float logi = gat[lane * 16 + (dir * 2) * 4 + h], logf = logsigmoid_f(gat[lane * 16 + (dir * 2 + 1) * 4 + h]);
          const float pre = wave_scan_incl(logf, lane), g = __shfl(pre, 63);
          const float bb = dir ? (g - pre + logf) : pre;
          const float av = g - bb + logi, mloc = wave_max(av);
          wts[wid * 64 + lane] = __expf(av - mloc);
          if (lane == 0) { const int chain = (b * 4 + h) * 2 + dir, ci = dir ? 63 - co : co; a.GSC[(chain * 64 + ci) * 2] = g; a.GSC[(chain * 64 + ci) * 2 + 1] = mloc; } }
        __syncthreads();
        { const int c0 = 2 * tid; const bool isk = c0 >= 512; const int hk = (c0 - 512) >> 7, dk = (c0 - 512) & 127;
          float w0[5], w1[5];
#pragma unroll
          for (int j = 0; j < 5; ++j) { w0[j] = a.conv_w[j * 1024 + c0]; w1[j] = a.conv_w[j * 1024 + c0 + 1]; }
          const float cb0 = a.conv_b[c0], cb1 = a.conv_b[c0 + 1];
          float x0[5], x1[5];
          const bf16_t* src = a.PROJ + t0 * PW + O_CQ + c0;
#pragma unroll
          for (int j = 0; j < 4; ++j) { const int sa = co * 64 + j - 2; unsigned w = 0u; if (sa >= 0 && sa < S) w = *(const unsigned*)(src + (long)(j - 2) * PW); x0[j + 1] = bflo(w); x1[j + 1] = bfhi(w); }
          float nf0 = 0.f, nf1 = 0.f, nb0 = 0.f, nb1 = 0.f;
#pragma unroll 1
          for (int s0 = 0; s0 < 64; s0 += 16) {
              unsigned wl[16];
#pragma unroll
              for (int q = 0; q < 16; ++q) { const int sa = co * 64 + s0 + q + 2; wl[q] = 0u; if (sa < S) wl[q] = *(const unsigned*)(src + (long)(s0 + q + 2) * PW); }
#pragma unroll
              for (int q = 0; q < 16; ++q) { const int s = s0 + q;
#pragma unroll
                  for (int j = 0; j < 4; ++j) { x0[j] = x0[j + 1]; x1[j] = x1[j + 1]; }
                  x0[4] = bflo(wl[q]); x1[4] = bfhi(wl[q]);
                  float y0 = cb0, y1 = cb1;
#pragma unroll
                  for (int j = 0; j < 5; ++j) { y0 += w0[j] * x0[j]; y1 += w1[j] * x1[j]; }
                  y0 = silu_f(y0); y1 = silu_f(y1);
                  if (!isk) { *(unsigned*)(a.QC + (t0 + s) * 512 + c0) = cvt_pk_bf16(y0, y1); }
                  else { y0 *= KSCALE; y1 *= KSCALE; const unsigned pk = cvt_pk_bf16(y0, y1);
                      *(unsigned*)(a.KC + (t0 + s) * 512 + (c0 - 512)) = pk;
                      *(unsigned*)(ktile + hk * 16384 + v_st(s, dk & ~7) + (dk & 7) * 2) = pk;
                      const float k0 = bflo(pk), k1 = bfhi(pk); const float wf = wts[hk * 64 + s], wb = wts[(4 + hk) * 64 + s];
                      nf0 += wf * k0; nf1 += wf * k1; nb0 += wb * k0; nb1 += wb * k1; } }
          }
          if (isk) { const int chf = (b * 4 + hk) * 2, chb = chf + 1;
              *(f32x2*)(a.NLOC + ((size_t)chf * 64 + co) * 128 + dk) = (f32x2){nf0, nf1};
              *(f32x2*)(a.NLOC + ((size_t)chb * 64 + (63 - co)) * 128 + dk) = (f32x2){nb0, nb1}; } }
        __syncthreads();
#pragma unroll 1
        for (int h = 0; h < 4; ++h) {
            { const int sr = tid >> 4, sc = (tid & 15) * 8;
#pragma unroll
              for (int rr = 0; rr < 2; ++rr) { const int s = sr + 32 * rr;
                const u32x4 vw = *(const u32x4*)(a.PROJ + (t0 + s) * PW + O_CV + h * 128 + sc);
                const float wf = wts[h * 64 + s], wb = wts[(4 + h) * 64 + s];
                float v[8] = {bflo(vw.x), bfhi(vw.x), bflo(vw.y), bfhi(vw.y), bflo(vw.z), bfhi(vw.z), bflo(vw.w), bfhi(vw.w)};
                u32x4 of, ob;
                of.x = cvt_pk_bf16(v[0] * wf, v[1] * wf); of.y = cvt_pk_bf16(v[2] * wf, v[3] * wf); of.z = cvt_pk_bf16(v[4] * wf, v[5] * wf); of.w = cvt_pk_bf16(v[6] * wf, v[7] * wf);
                ob.x = cvt_pk_bf16(v[0] * wb, v[1] * wb); ob.y = cvt_pk_bf16(v[2] * wb, v[3] * wb); ob.z = cvt_pk_bf16(v[4] * wb, v[5] * wb); ob.w = cvt_pk_bf16(v[6] * wb, v[7] * wb);
                *(u32x4*)(wv + v_st(s, sc)) = of; *(u32x4*)(wv + 16384 + v_st(s, sc)) = ob; } }
            __syncthreads();
            { const int dir = wid >> 2, mb = wid & 3, r32 = lane & 31, hi = lane >> 5;
              const int va = (int)(uintptr_t)(wv + dir * 16384) + v_rd_base(lane) + mb * 512;
              const int kb = (int)(uintptr_t)(ktile + h * 16384) + v_rd_base(lane);
              f32x16 acc[4] = {};
#define FX_KC_STEP(KS) do { \
              const s16x4 al = tr_read<v_rd_off(0, KS, 0)>(va), ah = tr_read<v_rd_off(0, KS, 1)>(va); \
              const s16x4 b0l = tr_read<v_rd_off(0, KS, 0)>(kb), b0h = tr_read<v_rd_off(0, KS, 1)>(kb), b1l = tr_read<v_rd_off(1, KS, 0)>(kb), b1h = tr_read<v_rd_off(1, KS, 1)>(kb); \
              const s16x4 b2l = tr_read<v_rd_off(2, KS, 0)>(kb), b2h = tr_read<v_rd_off(2, KS, 1)>(kb), b3l = tr_read<v_rd_off(3, KS, 0)>(kb), b3h = tr_read<v_rd_off(3, KS, 1)>(kb); \
              asm volatile("s_waitcnt lgkmcnt(0)" ::: "memory"); FX_SBAR(); \
              const bf16x8 af = FX_PK(al, ah); \
              acc[0] = __builtin_amdgcn_mfma_f32_32x32x16_bf16(af, FX_PK(b0l, b0h), acc[0], 0, 0, 0); acc[1] = __builtin_amdgcn_mfma_f32_32x32x16_bf16(af, FX_PK(b1l, b1h), acc[1], 0, 0, 0); \
              acc[2] = __builtin_amdgcn_mfma_f32_32x32x16_bf16(af, FX_PK(b2l, b2h), acc[2], 0, 0, 0); acc[3] = __builtin_amdgcn_mfma_f32_32x32x16_bf16(af, FX_PK(b3l, b3h), acc[3], 0, 0, 0); } while (0)
              FX_KC_STEP(0); FX_KC_STEP(1); FX_KC_STEP(2); FX_KC_STEP(3);
#undef FX_KC_STEP
              const int chain = (b * 4 + h) * 2 + dir, ci = dir ? 63 - co : co;
              const int par = r32 & 1;
              bf16_t* dst = a.KCT + ((size_t)chain * 64 + ci) * 16384 + (size_t)(mb * 32) * 128 + (r32 - par) + par * 64;
#pragma unroll
              for (int r = 0; r < 16; ++r) { const int v = crow(r, hi);
                  const unsigned w01 = cvt_pk_bf16(acc[0][r], acc[1][r]), w23 = cvt_pk_bf16(acc[2][r], acc[3][r]);
                  const unsigned n01 = (unsigned)__builtin_amdgcn_update_dpp(0, (int)w01, 0xB1, 0xF, 0xF, false), n23 = (unsigned)__builtin_amdgcn_update_dpp(0, (int)w23, 0xB1, 0xF, 0xF, false);
                  const unsigned A = par ? n23 : w01, B = par ? w23 : n01;
                  *(unsigned*)(dst + v * 128) = (A & 0xffffu) | (B << 16); *(unsigned*)(dst + v * 128 + 32) = (A >> 16) | (B & 0xffff0000u); } }
            __syncthreads();
        }
        { const int hd = __builtin_amdgcn_readfirstlane(wid), l16 = lane & 15, tq = lane >> 4, e0 = 8 * l16, hf = e0 >> 6, f0 = e0 & 31; const bool second = (e0 & 32) != 0;
          const float* g = hd < 6 ? a.aq_gain : a.ak_gain;
          const f32x4 g0 = *(const f32x4*)(g + e0), g1 = *(const f32x4*)(g + e0 + 4);
#pragma unroll 4
          for (int p = 0; p < 16; ++p) { const int s = 4 * p + tq; const size_t t = t0 + s;
            const u32x4 xw = *(const u32x4*)(a.PROJ + t * PW + hd * 128 + e0);
            const int pos = hf ? s : co;
            const f32x4 c0 = *(const f32x4*)(a.cosA + pos * 32 + f0), c1 = *(const f32x4*)(a.cosA + pos * 32 + f0 + 4), s0 = *(const f32x4*)(a.sinA + pos * 32 + f0), s1 = *(const f32x4*)(a.sinA + pos * 32 + f0 + 4);
            float x[8] = {bflo(xw.x), bfhi(xw.x), bflo(xw.y), bfhi(xw.y), bflo(xw.z), bfhi(xw.z), bflo(xw.w), bfhi(xw.w)};
            float ss = 0.f;
#pragma unroll
            for (int j = 0; j < 8; ++j) ss += x[j] * x[j];
            ss += __shfl_xor(ss, 1); ss += __shfl_xor(ss, 2); ss += __shfl_xor(ss, 4); ss += __shfl_xor(ss, 8);
            const float r = rsqrtf(ss * (1.f / 128.f) + EPS);
            float o[8];
#pragma unroll
            for (int j = 0; j < 8; ++j) { x[j] *= r * (j < 4 ? g0[j & 3] : g1[j & 3]); }
#pragma unroll
            for (int j = 0; j < 8; ++j) { const float y = __shfl_xor(x[j], 4), cs = j < 4 ? c0[j & 3] : c1[j & 3], sn = j < 4 ? s0[j & 3] : s1[j & 3]; o[j] = second ? (x[j] * cs + y * sn) : (x[j] * cs - y * sn); }
            u32x4 w; w.x = cvt_pk_bf16(o[0], o[1]); w.y = cvt_pk_bf16(o[2], o[3]); w.z = cvt_pk_bf16(o[4], o[5]); w.w = cvt_pk_bf16(o[6], o[7]);
            bf16_t* dst = hd < 6 ? a.QA + t * 768 + hd * 128 + e0 : a.KA + t * 256 + (hd - 6) * 128 + e0;
            *(u32x4*)dst = w; } }
#pragma unroll 4
        for (int s = wid; s < 64; s += 8) { const size_t t = t0 + s; const bf16_t* p = a.PROJ + t * PW;
            float q[6]; float ss = 0.f;
#pragma unroll
            for (int i = 0; i < 3; ++i) { const unsigned w = *(const unsigned*)(p + O_BCQ + i * 128 + lane * 2); q[2 * i] = bflo(w); q[2 * i + 1] = bfhi(w); ss += q[2 * i] * q[2 * i] + q[2 * i + 1] * q[2 * i + 1]; }
            ss = wave_sum(ss); float r = rsqrtf(ss * (1.f / 384.f) + EPS);
#pragma unroll
            for (int i = 0; i < 3; ++i) { const int c = i * 128 + lane * 2; *(unsigned*)(a.CQN + t * 384 + c) = cvt_pk_bf16(q[2 * i] * r * a.cq_gain[c], q[2 * i + 1] * r * a.cq_gain[c + 1]); }
            float kv[4]; ss = 0.f;
#pragma unroll
            for (int i = 0; i < 2; ++i) { const unsigned w = *(const unsigned*)(p + O_BCKV + i * 128 + lane * 2); kv[2 * i] = bflo(w); kv[2 * i + 1] = bfhi(w); ss += kv[2 * i] * kv[2 * i] + kv[2 * i + 1] * kv[2 * i + 1]; }
            ss = wave_sum(ss); r = rsqrtf(ss * (1.f / 256.f) + EPS);
#pragma unroll
            for (int i = 0; i < 2; ++i) { const int c = i * 128 + lane * 2; *(unsigned*)(a.CKVN + t * 256 + c) = cvt_pk_bf16(kv[2 * i] * r * a.ckv_gain[c], kv[2 * i + 1] * r * a.ckv_gain[c + 1]); }
            if (lane < 32) { const int f = lane & 15, hf = lane >> 4; const int pos = hf ? s : co; const float cs = a.cosB[pos * 16 + f], sn = a.sinB[pos * 16 + f];
                const float x1 = bf2f(p[O_BKR + hf * 32 + f]), x2 = bf2f(p[O_BKR + hf * 32 + 16 + f]);
                a.KR[t * 64 + hf * 32 + f] = f2bf(x1 * cs - x2 * sn); a.KR[t * 64 + hf * 32 + 16 + f] = f2bf(x2 * cs + x1 * sn); } }
        __syncthreads();
    }
}

#ifndef FX_MCDEAL
#define FX_MCDEAL 1
#endif
#ifndef FX_SCANB
#define FX_SCANB 32
#endif
__device__ __forceinline__ void scan_phase(const bf16_t* KCT, const float* NLOC, const float* GSC, bf16_t* CPREV, float* NPREV, float* MPREV, int gtid, int nthr) {
    for (int item = gtid; item < 32 * 4096; item += nthr) {
        const int chain = item >> 12, e4 = item & 4095;
        const u32x2* src = (const u32x2*)(KCT + (size_t)chain * 64 * 16384) + e4; u32x2* dst = (u32x2*)(CPREV + (size_t)chain * 64 * 16384) + e4;
        const float* gs = GSC + (size_t)chain * 128;
        const bool don = e4 < 128;
        float c0 = 0.f, c1 = 0.f, c2 = 0.f, c3 = 0.f, nn = 0.f, m = 0.f;
#pragma unroll 1
        for (int cb = 0; cb < 64; cb += FX_SCANB) {
            u32x2 kc[FX_SCANB]; float nl[FX_SCANB]; f32x2 gm[FX_SCANB];
#pragma unroll
            for (int j = 0; j < FX_SCANB; ++j) { kc[j] = src[(size_t)(cb + j) * 4096]; nl[j] = don ? NLOC[((size_t)chain * 64 + cb + j) * 128 + e4] : 0.f; gm[j] = *(const f32x2*)(gs + (cb + j) * 2); }
#pragma unroll
            for (int j = 0; j < FX_SCANB; ++j) { const int ci = cb + j; const float g = gm[j][0], ml = gm[j][1];
                u32x2 o; o.x = cvt_pk_bf16(c0, c1); o.y = cvt_pk_bf16(c2, c3); dst[(size_t)ci * 4096] = o;
                if (don) NPREV[((size_t)chain * 64 + ci) * 128 + e4] = nn;
                if (e4 == 0) MPREV[chain * 64 + ci] = m;
                const float mn = fmaxf(g + m, ml), dec = __expf(g + m - mn), sl = __expf(ml - mn); m = mn;
                c0 = dec * c0 + sl * bflo(kc[j].x); c1 = dec * c1 + sl * bfhi(kc[j].x); c2 = dec * c2 + sl * bflo(kc[j].y); c3 = dec * c3 + sl * bfhi(kc[j].y);
                nn = dec * nn + sl * nl[j]; }
        }
    }
}

constexpr int MC_K = 0, MC_V = 16384, MC_CT = 32768, MC_HS = 98304, MC_HS_LD = 132, MC_SM = MC_HS + 64 * MC_HS_LD * 4, MC_LDS = MC_SM + 4096;
struct McArgs { const bf16_t* PROJ; const float* GATES; const float* gate_b; const bf16_t* QC; const bf16_t* KC; const bf16_t* CPREV; const float* NPREV; const float* MPREV; const float* hog; bf16_t* YM; };
__device__ __forceinline__ void mlstm_c_phase(FX_LAS unsigned char* lds_, const McArgs& a, int wg, int nwg, int tidp) {
    char* lds = (char*)lds_;
    using C = AttnC<128>;
    float* hs = (float*)(lds + MC_HS);
    float* sm = (float*)(lds + MC_SM);
    const bool deal53 = FX_MCDEAL && nwg == 256; const int jg = wg >> 3, xg = wg & 7;
    const int u_first = deal53 ? (jg < 16 ? (xg * 16 + jg) * 5 : 640 + (xg * 16 + jg - 16) * 3) : wg, u_cnt = deal53 ? (jg < 16 ? 5 : 3) : (NB * 4 * 64 - wg + nwg - 1) / nwg, u_step = deal53 ? 1 : nwg;
    for (int ui_ = 0, unit = u_first; ui_ < u_cnt; ++ui_, unit += u_step) {
        int tid_ = tidp; asm volatile("" : "+v"(tid_));
        const int tid = tid_, wid = tid >> 6, lane = tid & 63, r32 = lane & 31, hi = lane >> 5;
        const int co = unit & 63, h = (unit >> 6) & 3, b = unit >> 8; const size_t t0 = (size_t)b * S + co * 64;
        const int sr = tid >> 4, sc = (tid & 15) * 8;
        bf16x8 gk[2], gv[2], gc[2][4];
#pragma unroll
        for (int rr = 0; rr < 2; ++rr) { const int s = sr + 32 * rr; gk[rr] = *(const bf16x8*)(a.KC + (t0 + s) * 512 + h * 128 + sc); gv[rr] = *(const bf16x8*)(a.PROJ + (t0 + s) * PW + O_CV + h * 128 + sc); }
#pragma unroll
        for (int dir = 0; dir < 2; ++dir) { const int chain = (b * 4 + h) * 2 + dir, ci = dir ? 63 - co : co; const bf16_t* ct = a.CPREV + ((size_t)chain * 64 + ci) * 16384;
#pragma unroll
            for (int rr = 0; rr < 4; ++rr) gc[dir][rr] = *(const bf16x8*)(ct + (sr + 32 * rr) * 128 + sc); }
        if (wid < 2) { const int dir = wid; const int chain = (b * 4 + h) * 2 + dir, ci = dir ? 63 - co : co;
            const float logi = a.GATES[(t0 + lane) * 16 + (dir * 2) * 4 + h] + a.gate_b[(dir * 2) * 4 + h];
            const float logf = logsigmoid_f(a.GATES[(t0 + lane) * 16 + (dir * 2 + 1) * 4 + h] + a.gate_b[(dir * 2 + 1) * 4 + h]);
            const float pre = wave_scan_incl(logf, lane), g = __shfl(pre, 63);
            const float bb = dir ? (g - pre + logf) : pre;
            const float u = logi - bb;
            const float M = dir ? wave_rscanmax_incl(u, lane) : wave_scanmax_incl(u, lane);
            const float mp = a.MPREV[chain * 64 + ci], mmj = fmaxf(mp, M);
            sm[dir * 64 + lane] = u; sm[128 + dir * 64 + lane] = mmj; sm[256 + dir * 64 + lane] = __expf(mp - mmj); sm[384 + dir * 64 + lane] = __expf(-(bb + mmj));
            sm[512 + dir * 128 + lane] = a.NPREV[((size_t)chain * 64 + ci) * 128 + lane]; sm[512 + dir * 128 + 64 + lane] = a.NPREV[((size_t)chain * 64 + ci) * 128 + 64 + lane]; }
        {
#pragma unroll
          for (int rr = 0; rr < 2; ++rr) { const int s = sr + 32 * rr;
            *(bf16x8*)(lds + MC_K + FX_KSWZ(s, sc * 2)) = gk[rr];
            *(bf16x8*)(lds + MC_V + v_st(s, sc)) = gv[rr]; }
#pragma unroll
          for (int dir = 0; dir < 2; ++dir) {
#pragma unroll
            for (int rr = 0; rr < 4; ++rr) { const int v = sr + 32 * rr; *(bf16x8*)(lds + MC_CT + dir * 32768 + FX_KSWZ(v, sc * 2)) = gc[dir][rr]; } } }
        __syncthreads();
        { const int dir = wid >> 2, rb = (wid >> 1) & 1, cb = wid & 1, j = rb * 32 + r32;
          bf16x8 qr[8];
          const bf16_t* Qw = a.QC + (t0 + j) * 512 + h * 128 + hi * 8;
#pragma unroll
          for (int d0 = 0; d0 < 8; ++d0) qr[d0] = *reinterpret_cast<const bf16x8*>(Qw + d0 * 16);
          f32x16 p0, p1;
          qkt<128>(p0, p1, lds + MC_K, qr, nullptr, r32, hi);
          const float mmj = sm[128 + dir * 64 + j], inter = sm[256 + dir * 64 + j], emn = sm[384 + dir * 64 + j];
          float dsum = 0.f;
#pragma unroll
          for (int r = 0; r < 16; ++r) { const int s0 = crow(r, hi), s1 = 32 + s0;
              const bool v0 = dir ? (s0 >= j) : (s0 <= j), v1 = dir ? (s1 >= j) : (s1 <= j);
              const float w0 = v0 ? __expf(sm[dir * 64 + s0] - mmj) : 0.f, w1 = v1 ? __expf(sm[dir * 64 + s1] - mmj) : 0.f;
              p0[r] *= w0; p1[r] *= w1; dsum += p0[r] + p1[r]; }
          float qn = 0.f;
#pragma unroll
          for (int d0 = 0; d0 < 8; ++d0) { const float* np = sm + 512 + dir * 128 + d0 * 16 + hi * 8; const u32x4 w = *reinterpret_cast<const u32x4*>(&qr[d0]);
              qn += bflo(w.x) * np[0] + bfhi(w.x) * np[1] + bflo(w.y) * np[2] + bfhi(w.y) * np[3] + bflo(w.z) * np[4] + bfhi(w.z) * np[5] + bflo(w.w) * np[6] + bfhi(w.w) * np[7]; }
          { auto rr = __builtin_amdgcn_permlane32_swap(__float_as_uint(dsum), __float_as_uint(dsum), false, false); dsum = __uint_as_float(rr[0]) + __uint_as_float(rr[1]); }
          { auto rr = __builtin_amdgcn_permlane32_swap(__float_as_uint(qn), __float_as_uint(qn), false, false); qn = __uint_as_float(rr[0]) + __uint_as_float(rr[1]); }
          const float den = dsum + inter * qn;
          if (hi == 0) sm[768 + wid * 32 + r32] = 1.f / fmaxf(fabsf(den), emn);
          bf16x8 pa0, pa1, pa2, pa3;
          FX_PK4(p0, 0, pa0); FX_PK4(p0, 8, pa1); FX_PK4(p1, 0, pa2); FX_PK4(p1, 8, pa3);
          f32x16 o[2] = {};
          const int vb = (int)(uintptr_t)(lds + MC_V) + v_rd_base(lane) + cb * 1024;
          pv_one<0>(o[0], vb, pa0, pa1, pa2, pa3); pv_one<1>(o[1], vb, pa0, pa1, pa2, pa3);
          const char* ctb = lds + MC_CT + dir * 32768;
#pragma unroll
          for (int ks = 0; ks < 8; ++ks) { const u32x4 w = *reinterpret_cast<const u32x4*>(&qr[ks]); u32x4 sq;
              sq.x = cvt_pk_bf16(bflo(w.x) * inter, bfhi(w.x) * inter); sq.y = cvt_pk_bf16(bflo(w.y) * inter, bfhi(w.y) * inter); sq.z = cvt_pk_bf16(bflo(w.z) * inter, bfhi(w.z) * inter); sq.w = cvt_pk_bf16(bflo(w.w) * inter, bfhi(w.w) * inter);
              const bf16x8 qs = *reinterpret_cast<const bf16x8*>(&sq); const int colB = (ks * 16 + hi * 8) * 2;
              const bf16x8 c0f = *reinterpret_cast<const bf16x8*>(ctb + FX_KSWZ((2 * cb) * 32 + r32, colB));
              const bf16x8 c1f = *reinterpret_cast<const bf16x8*>(ctb + FX_KSWZ((2 * cb + 1) * 32 + r32, colB));
              o[0] = __builtin_amdgcn_mfma_f32_32x32x16_bf16(qs, c0f, o[0], 0, 0, 0);
              o[1] = __builtin_amdgcn_mfma_f32_32x32x16_bf16(qs, c1f, o[1], 0, 0, 0); }
          asm volatile("s_waitcnt lgkmcnt(0)" ::: "memory");
          float rd[16];
#pragma unroll
          for (int r = 0; r < 16; ++r) rd[r] = sm[768 + wid * 32 + crow(r, hi)];
          if (dir == 0) {
#pragma unroll
              for (int r = 0; r < 16; ++r) { const int row = rb * 32 + crow(r, hi);
                  hs[row * MC_HS_LD + (2 * cb) * 32 + r32] = o[0][r] * rd[r]; hs[row * MC_HS_LD + (2 * cb + 1) * 32 + r32] = o[1][r] * rd[r]; } }
          __syncthreads();
          if (dir == 1) {
#pragma unroll
              for (int r = 0; r < 16; ++r) { const int row = rb * 32 + crow(r, hi);
                  hs[row * MC_HS_LD + (2 * cb) * 32 + r32] += o[0][r] * rd[r]; hs[row * MC_HS_LD + (2 * cb + 1) * 32 + r32] += o[1][r] * rd[r]; } }
          __syncthreads(); }
        { const int row = tid >> 3, c0 = (tid & 7) * 16; const size_t t = t0 + row;
          float v[16]; float ss = 0.f;
#pragma unroll
          for (int i = 0; i < 16; ++i) { v[i] = hs[row * MC_HS_LD + c0 + i]; ss += v[i] * v[i]; }
          ss += __shfl_xor(ss, 1); ss += __shfl_xor(ss, 2); ss += __shfl_xor(ss, 4);
          const float rn = rsqrtf(ss * (1.f / 128.f) + EPS);
          const bf16_t* og = a.PROJ + t * PW + O_CO + h * 128 + c0; const float* gn = a.hog + 1536 + h * 128 + c0;
          const u32x4 g0 = *(const u32x4*)og, g1 = *(const u32x4*)(og + 8);
          const float gg[16] = {bflo(g0.x), bfhi(g0.x), bflo(g0.y), bfhi(g0.y), bflo(g0.z), bfhi(g0.z), bflo(g0.w), bfhi(g0.w), bflo(g1.x), bfhi(g1.x), bflo(g1.y), bfhi(g1.y), bflo(g1.z), bfhi(g1.z), bflo(g1.w), bfhi(g1.w)};
          float ov[16];
#pragma unroll
          for (int i = 0; i < 16; ++i) ov[i] = v[i] * rn * gn[i] * sigmoid_f(gg[i]);
          u32x4 w0, w1; w0.x = cvt_pk_bf16(ov[0], ov[1]); w0.y = cvt_pk_bf16(ov[2], ov[3]); w0.z = cvt_pk_bf16(ov[4], ov[5]); w0.w = cvt_pk_bf16(ov[6], ov[7]);
          w1.x = cvt_pk_bf16(ov[8], ov[9]); w1.y = cvt_pk_bf16(ov[10], ov[11]); w1.z = cvt_pk_bf16(ov[12], ov[13]); w1.w = cvt_pk_bf16(ov[14], ov[15]);
#ifdef FX_WOUT8
          { u32x4 w8; w8.x = cvt_pk4_fp8(ov[0], ov[1], ov[2], ov[3]); w8.y = cvt_pk4_fp8(ov[4], ov[5], ov[6], ov[7]); w8.z = cvt_pk4_fp8(ov[8], ov[9], ov[10], ov[11]); w8.w = cvt_pk4_fp8(ov[12], ov[13], ov[14], ov[15]);
            *(u32x4*)((unsigned char*)a.YM + t * 2048 + 1536 + h * 128 + c0) = w8; (void)w0; (void)w1; } }
#else
          bf16_t* dst = a.YM + t * 2048 + 1536 + h * 128 + c0; *(u32x4*)dst = w0; *(u32x4*)(dst + 8) = w1; }
#endif
        __syncthreads();
    }
}
}
namespace fx {
struct EpiQB {
    static constexpr bool PERM = false; static constexpr int NST = 32;
    bf16_t* O; const float* cosB; const float* sinB;
    __device__ __forceinline__ void operator()(const f32x4 (&acc)[2][2][4][2], const Unit& u, int wr, int wc, int fr, int fq) const {
        const int row0 = u.pm * BM + wr * 64 + fr;
#pragma unroll
        for (int bj = 0; bj < 2; ++bj) { const int G = 8 * u.pn + 4 * bj + wc, gm = G % 6; const int col0 = G * 32 + 4 * fq;
            f32x4 cs[2][4], sn[2][4];
            if (gm >= 4) {
#pragma unroll
                for (int ai = 0; ai < 2; ++ai)
#pragma unroll
                    for (int m = 0; m < 4; ++m) { const int row = row0 + ai * HALF + m * 16, s = row & (S - 1), pos = gm == 4 ? (s >> 6) : (s & 63);
                        cs[ai][m] = *(const f32x4*)(cosB + pos * 16 + 4 * fq); sn[ai][m] = *(const f32x4*)(sinB + pos * 16 + 4 * fq); } }
#pragma unroll
            for (int ai = 0; ai < 2; ++ai)
#pragma unroll
                for (int m = 0; m < 4; ++m) { const int row = row0 + ai * HALF + m * 16; f32x4 x1 = acc[ai][bj][m][0], x2 = acc[ai][bj][m][1];
                    if (gm >= 4) { const f32x4 o1 = x1 * cs[ai][m] - x2 * sn[ai][m], o2 = x2 * cs[ai][m] + x1 * sn[ai][m]; x1 = o1; x2 = o2; }
                    bf16_t* rp = O + (size_t)row * 1280 + col0;
                    u32x2 w0, w1; w0.x = cvt_pk_bf16(x1[0], x1[1]); w0.y = cvt_pk_bf16(x1[2], x1[3]); w1.x = cvt_pk_bf16(x2[0], x2[1]); w1.y = cvt_pk_bf16(x2[2], x2[3]);
                    *(u32x2*)rp = w0; *(u32x2*)(rp + 16) = w1; } }
    }
};
constexpr size_t al256(size_t x) { return (x + 255) & ~(size_t)255; }
constexpr size_t WS_BAR = 0;
constexpr size_t WS_MOD = 16384;
constexpr size_t WS_COEF = WS_MOD + al256(2ull * 4 * 12288 * 4);
constexpr size_t WS_TAB = WS_COEF + al256(2ull * 4 * 6 * 2048 * 4);
constexpr size_t WS_CNT = WS_BAR + 3712 * 4;
constexpr size_t WS_WGBASE = WS_TAB + al256(6144 * 4) + 512;
constexpr size_t WS_SELE = WS_WGBASE + 256 * 64 * 4;
constexpr size_t WS_SELG = WS_SELE + (size_t)T * 6 * 4;
constexpr size_t WS_SLOT = WS_SELG + (size_t)T * 6 * 4;
constexpr size_t WS_ROWTOK = WS_SLOT + (size_t)T * 6 * 4;
constexpr size_t WS_ROWG = WS_ROWTOK + (size_t)PTOT * 4;
constexpr size_t WS_GATES = WS_ROWG + (size_t)PTOT * 4;
constexpr size_t WS_GSC = WS_GATES + (size_t)T * 16 * 4;
constexpr size_t WS_MPREV = WS_GSC + 2048 * 2 * 4;
constexpr size_t WS_NLOC = WS_MPREV + 2048 * 4;
constexpr size_t WS_NPREV = WS_NLOC + 2048ull * 128 * 4;
constexpr size_t WS_W = al256(WS_NPREV + 2048ull * 128 * 4);
constexpr size_t W_IN = 0, W_UQ = W_IN + 4096ull * 2048 * 2, W_UKV = W_UQ + 1280ull * 384 * 2, W_OUT = W_UKV + 1536ull * 256 * 2, W_GU = W_OUT + 2048ull * 2048 * 2, W_DN = W_GU + 65ull * 1024 * 2048 * 2, W_LAYER = W_DN + 65ull * 2048 * 512 * 2;
constexpr size_t WS_XRES = WS_W + 2 * W_LAYER;
constexpr size_t WS_HA = WS_XRES + (size_t)T * 2048 * 4;
constexpr size_t WS_R1 = WS_HA + (size_t)T * 2048 * 2;
constexpr size_t WS_R2 = WS_R1 + (size_t)T * 4096 * 2;
constexpr size_t R2_QA = 0, R2_KA = R2_QA + (size_t)T * 768 * 2, R2_CQN = R2_KA + (size_t)T * 256 * 2, R2_CKVN = R2_CQN + (size_t)T * 384 * 2, R2_KR = R2_CKVN + (size_t)T * 256 * 2,
                 R2_QB = R2_KR + (size_t)T * 64 * 2, R2_KVB = R2_QB + (size_t)T * 1280 * 2, R2_QC = R2_KVB + (size_t)T * 1536 * 2, R2_KC = R2_QC + (size_t)T * 512 * 2,
                 R2_KCT = R2_KC + (size_t)T * 512 * 2, R2_CPREV = R2_KCT + 2048ull * 16384 * 2, R2_END = R2_CPREV + 2048ull * 16384 * 2;
constexpr size_t WS_END = WS_R2 + (size_t)PTOT * 2048 * 2;
static_assert(R2_END <= (size_t)PTOT * 2048 * 2, "R2 overflow");
static_assert(WS_END <= 2147483648ull, "workspace too large");
}
namespace fx {
struct CvtW { const float* w_in; const float* w_uq; const float* w_ukv; const float* w_out; const float* eg; const float* eu; const float* ed; const float* sg; const float* su; const float* sd; bf16_t* W; };
__device__ __forceinline__ void cvt_layer(const CvtW& a, FX_LAS unsigned* my, int gwave, int nwaves, int& rot) {
    const int BIG = 1 << 30; bf16_t* W = a.W;
    bf16_t* WIN = W + W_IN / 2; bf16_t* WUQ = W + W_UQ / 2; bf16_t* WUKV = W + W_UKV / 2; bf16_t* WOUT = W + W_OUT / 2; bf16_t* WGU = W + W_GU / 2; bf16_t* WDN = W + W_DN / 2;
#ifdef FX_WIN8
    { CvtSeg s; s.src = a.w_in; s.dst = WIN; s.sstride = 0; s.dstride = 0; s.ld = 4048; s.nsrc = 4048; s.K = 2048; s.ntn = 64; s.nbatch = 1; s.G = BIG; s.GS = 0; s.off = 0; cvt_seg8(s, my, gwave, nwaves, rot, W8_SCALE); }
#else
    { CvtSeg s; s.src = a.w_in; s.dst = WIN; s.sstride = 0; s.dstride = 0; s.ld = 4048; s.nsrc = 4048; s.K = 2048; s.ntn = 64; s.nbatch = 1; s.G = BIG; s.GS = 0; s.off = 0; cvt_seg(s, my, gwave, nwaves, rot); }
#endif
    { CvtSeg s; s.src = a.w_uq; s.dst = WUQ; s.sstride = 0; s.dstride = 0; s.ld = 1152; s.nsrc = 1152; s.K = 384; s.ntn = 20; s.nbatch = 1; s.G = BIG; s.GS = 0; s.off = 0; cvt_seg(s, my, gwave, nwaves, rot); }
    { CvtSeg s; s.src = a.w_ukv; s.dst = WUKV; s.sstride = 0; s.dstride = 0; s.ld = 1536; s.nsrc = 1536; s.K = 256; s.ntn = 24; s.nbatch = 1; s.G = BIG; s.GS = 0; s.off = 0; cvt_seg(s, my, gwave, nwaves, rot); }
#ifdef FX_WOUT8
    { CvtSeg s; s.src = a.w_out; s.dst = WOUT; s.sstride = 0; s.dstride = 0; s.ld = 2048; s.nsrc = 2048; s.K = 2048; s.ntn = 32; s.nbatch = 1; s.G = BIG; s.GS = 0; s.off = 0; s.kperm = FX_YMPERM ? 1536 : 0; cvt_seg8(s, my, gwave, nwaves, rot, W8_SCALE); }
#else
    { CvtSeg s; s.src = a.w_out; s.dst = WOUT; s.sstride = 0; s.dstride = 0; s.ld = 2048; s.nsrc = 2048; s.K = 2048; s.ntn = 32; s.nbatch = 1; s.G = BIG; s.GS = 0; s.off = 0; cvt_seg(s, my, gwave, nwaves, rot); }
#endif
    { CvtSeg s; s.src = a.eg; s.dst = WGU; s.sstride = 2048ll * 512; s.dstride = 1024ll * 2048; s.ld = 512; s.nsrc = 512; s.K = 2048; s.ntn = 8; s.nbatch = 64; s.G = 128; s.GS = 256; s.off = 0; cvt_seg8(s, my, gwave, nwaves, rot, W8_SCALE); }
    { CvtSeg s; s.src = a.eu; s.dst = WGU; s.sstride = 2048ll * 512; s.dstride = 1024ll * 2048; s.ld = 512; s.nsrc = 512; s.K = 2048; s.ntn = 8; s.nbatch = 64; s.G = 128; s.GS = 256; s.off = 128; cvt_seg8(s, my, gwave, nwaves, rot, W8_SCALE); }
    { CvtSeg s; s.src = a.ed; s.dst = WDN; s.sstride = 512ll * 2048; s.dstride = 2048ll * 512; s.ld = 2048; s.nsrc = 2048; s.K = 512; s.ntn = 32; s.nbatch = 64; s.G = BIG; s.GS = 0; s.off = 0; cvt_seg8(s, my, gwave, nwaves, rot, W8_SCALE); }
    { CvtSeg s; s.src = a.sg; s.dst = (bf16_t*)((unsigned char*)WGU + 64ull * 1024 * 2048); s.sstride = 0; s.dstride = 0; s.ld = 512; s.nsrc = 512; s.K = 2048; s.ntn = 8; s.nbatch = 1; s.G = 128; s.GS = 256; s.off = 0; cvt_seg8(s, my, gwave, nwaves, rot, W8_SCALE); }
    { CvtSeg s; s.src = a.su; s.dst = (bf16_t*)((unsigned char*)WGU + 64ull * 1024 * 2048); s.sstride = 0; s.dstride = 0; s.ld = 512; s.nsrc = 512; s.K = 2048; s.ntn = 8; s.nbatch = 1; s.G = 128; s.GS = 256; s.off = 128; cvt_seg8(s, my, gwave, nwaves, rot, W8_SCALE); }
    { CvtSeg s; s.src = a.sd; s.dst = (bf16_t*)((unsigned char*)WDN + 64ull * 2048 * 512); s.sstride = 0; s.dstride = 0; s.ld = 2048; s.nsrc = 2048; s.K = 512; s.ntn = 32; s.nbatch = 1; s.G = BIG; s.GS = 0; s.off = 0; cvt_seg8(s, my, gwave, nwaves, rot, W8_SCALE); }
}
constexpr int CVT_TILES_PER_LAYER = 2048 + 120 + 96 + 1024 + 3 * 16384 + 3 * 256;
__device__ __forceinline__ void cvt_layer_one(const CvtW& a, FX_LAS unsigned* my, int g) {
    int base = 0;
    const int BIG = 1 << 30; bf16_t* W = a.W;
    bf16_t* WIN = W + W_IN / 2; bf16_t* WUQ = W + W_UQ / 2; bf16_t* WUKV = W + W_UKV / 2; bf16_t* WOUT = W + W_OUT / 2; bf16_t* WGU = W + W_GU / 2; bf16_t* WDN = W + W_DN / 2;
#ifdef FX_WIN8
    { CvtSeg s; s.src = a.w_in; s.dst = WIN; s.sstride = 0; s.dstride = 0; s.ld = 4048; s.nsrc = 4048; s.K = 2048; s.ntn = 64; s.nbatch = 1; s.G = BIG; s.GS = 0; s.off = 0; { const int cnt_ = (s.K / 64) * s.ntn * s.nbatch; if (g >= base && g < base + cnt_) cvt_tile8(s, my, g - base, W8_SCALE); base += cnt_; } }
#else
    { CvtSeg s; s.src = a.w_in; s.dst = WIN; s.sstride = 0; s.dstride = 0; s.ld = 4048; s.nsrc = 4048; s.K = 2048; s.ntn = 64; s.nbatch = 1; s.G = BIG; s.GS = 0; s.off = 0; { const int cnt_ = (s.K / 64) * s.ntn * s.nbatch; if (g >= base && g < base + cnt_) cvt_tile(s, my, g - base); base += cnt_; } }
#endif
    { CvtSeg s; s.src = a.w_uq; s.dst = WUQ; s.sstride = 0; s.dstride = 0; s.ld = 1152; s.nsrc = 1152; s.K = 384; s.ntn = 20; s.nbatch = 1; s.G = BIG; s.GS = 0; s.off = 0; { const int cnt_ = (s.K / 64) * s.ntn * s.nbatch; if (g >= base && g < base + cnt_) cvt_tile(s, my, g - base); base += cnt_; } }
    { CvtSeg s; s.src = a.w_ukv; s.dst = WUKV; s.sstride = 0; s.dstride = 0; s.ld = 1536; s.nsrc = 1536; s.K = 256; s.ntn = 24; s.nbatch = 1; s.G = BIG; s.GS = 0; s.off = 0; { const int cnt_ = (s.K / 64) * s.ntn * s.nbatch; if (g >= base && g < base + cnt_) cvt_tile(s, my, g - base); base += cnt_; } }
#ifdef FX_WOUT8
    { CvtSeg s; s.src = a.w_out; s.dst = WOUT; s.sstride = 0; s.dstride = 0; s.ld = 2048; s.nsrc = 2048; s.K = 2048; s.ntn = 32; s.nbatch = 1; s.G = BIG; s.GS = 0; s.off = 0; { const int cnt_ = (s.K / 64) * s.ntn * s.nbatch; if (g >= base && g < base + cnt_) cvt_tile8(s, my, g - base, W8_SCALE); base += cnt_; } }
#else
    { CvtSeg s; s.src = a.w_out; s.dst = WOUT; s.sstride = 0; s.dstride = 0; s.ld = 2048; s.nsrc = 2048; s.K = 2048; s.ntn = 32; s.nbatch = 1; s.G = BIG; s.GS = 0; s.off = 0; { const int cnt_ = (s.K / 64) * s.ntn * s.nbatch; if (g >= base && g < base + cnt_) cvt_tile(s, my, g - base); base += cnt_; } }
#endif
    { CvtSeg s; s.src = a.eg; s.dst = WGU; s.sstride = 2048ll * 512; s.dstride = 1024ll * 2048; s.ld = 512; s.nsrc = 512; s.K = 2048; s.ntn = 8; s.nbatch = 64; s.G = 128; s.GS = 256; s.off = 0; { const int cnt_ = (s.K / 64) * s.ntn * s.nbatch; if (g >= base && g < base + cnt_) cvt_tile8(s, my, g - base, W8_SCALE); base += cnt_; } }
    { CvtSeg s; s.src = a.eu; s.dst = WGU; s.sstride = 2048ll * 512; s.dstride = 1024ll * 2048; s.ld = 512; s.nsrc = 512; s.K = 2048; s.ntn = 8; s.nbatch = 64; s.G = 128; s.GS = 256; s.off = 128; { const int cnt_ = (s.K / 64) * s.ntn * s.nbatch; if (g >= base && g < base + cnt_) cvt_tile8(s, my, g - base, W8_SCALE); base += cnt_; } }
    { CvtSeg s; s.src = a.ed; s.dst = WDN; s.sstride = 512ll * 2048; s.dstride = 2048ll * 512; s.ld = 2048; s.nsrc = 2048; s.K = 512; s.ntn = 32; s.nbatch = 64; s.G = BIG; s.GS = 0; s.off = 0; { const int cnt_ = (s.K / 64) * s.ntn * s.nbatch; if (g >= base && g < base + cnt_) cvt_tile8(s, my, g - base, W8_SCALE); base += cnt_; } }
    { CvtSeg s; s.src = a.sg; s.dst = (bf16_t*)((unsigned char*)WGU + 64ull * 1024 * 2048); s.sstride = 0; s.dstride = 0; s.ld = 512; s.nsrc = 512; s.K = 2048; s.ntn = 8; s.nbatch = 1; s.G = 128; s.GS = 256; s.off = 0; { const int cnt_ = (s.K / 64) * s.ntn * s.nbatch; if (g >= base && g < base + cnt_) cvt_tile8(s, my, g - base, W8_SCALE); base += cnt_; } }
    { CvtSeg s; s.src = a.su; s.dst = (bf16_t*)((unsigned char*)WGU + 64ull * 1024 * 2048); s.sstride = 0; s.dstride = 0; s.ld = 512; s.nsrc = 512; s.K = 2048; s.ntn = 8; s.nbatch = 1; s.G = 128; s.GS = 256; s.off = 128; { const int cnt_ = (s.K / 64) * s.ntn * s.nbatch; if (g >= base && g < base + cnt_) cvt_tile8(s, my, g - base, W8_SCALE); base += cnt_; } }
    { CvtSeg s; s.src = a.sd; s.dst = (bf16_t*)((unsigned char*)WDN + 64ull * 2048 * 512); s.sstride = 0; s.dstride = 0; s.ld = 2048; s.nsrc = 2048; s.K = 512; s.ntn = 32; s.nbatch = 1; s.G = BIG; s.GS = 0; s.off = 0; { const int cnt_ = (s.K / 64) * s.ntn * s.nbatch; if (g >= base && g < base + cnt_) cvt_tile8(s, my, g - base, W8_SCALE); base += cnt_; } }
}
}
namespace fx {
#define XB_TMO      128
#define XB_XCNT(j)  (256  + 64 * (j))
#define XB_XSUB(j)  (1280 + 64 * (j))
#define XB_XGEN(j)  (2304 + 64 * (j))
#define XB_TOP      3328
#define XB_TOPGEN   3392
#define XCD_BAR_WORDS 3456
#define XB_SPIN_CAP (1u << 22)
__device__ __forceinline__ unsigned xb_ld(unsigned* p)              { return __hip_atomic_load(p, __ATOMIC_RELAXED, __HIP_MEMORY_SCOPE_AGENT); }
__device__ __forceinline__ unsigned xb_add(unsigned* p, unsigned v) { return __hip_atomic_fetch_add(p, v, __ATOMIC_RELAXED, __HIP_MEMORY_SCOPE_AGENT); }
__device__ __forceinline__ unsigned xb_xcc_id() { return (unsigned)__builtin_amdgcn_s_getreg((3 << 11) | 20) & 0xFu; }
#define XB_SPIN(cond, bar) do { unsigned _sp = 0; while (cond) { __builtin_amdgcn_s_sleep(1); \
    if ((++_sp & 255u) == 0u) { if (xb_ld(&(bar)[XB_TMO])) break; if (_sp > XB_SPIN_CAP) { atomicAdd(&(bar)[XB_TMO], 1u); break; } } } } while (0)
struct XcdBarrier { unsigned* bar; unsigned x; volatile FX_LAS unsigned* st; };
__device__ __forceinline__ XcdBarrier xcd_barrier_post(unsigned* bar, volatile FX_LAS unsigned* st, int tidp) {
    XcdBarrier b; b.bar = bar; b.x = xb_xcc_id(); b.st = st;
    if (tidp == 0) (void)xb_add(&bar[XB_XCNT(b.x)], 1u);
    return b;
}
__device__ __forceinline__ void xcd_barrier_complete(unsigned* bar, unsigned x, unsigned& nloc, unsigned& nx) {
    const unsigned G = gridDim.x * gridDim.y * gridDim.z;
    unsigned sum, cnt, mine, sp = 0u;
    for (;;) {
        sum = 0u; cnt = 0u; mine = 0u;
#pragma unroll
        for (unsigned j = 0; j < 16; ++j) { const unsigned c = xb_ld(&bar[XB_XCNT(j)]); sum += c; cnt += (c > 0u) ? 1u : 0u; mine = (j == x) ? c : mine; }
        if (sum == G) break;
        __builtin_amdgcn_s_sleep(1);
        if ((++sp & 255u) == 0u) { if (xb_ld(&bar[XB_TMO])) break; if (sp > XB_SPIN_CAP) { atomicAdd(&bar[XB_TMO], 1u); break; } }
    }
    nloc = mine > 0u ? mine : 1u; nx = cnt > 0u ? cnt : 1u;
}
__device__ __forceinline__ void xcd_barrier(const XcdBarrier& b, int tidp) {
    asm volatile("s_waitcnt vmcnt(0)" ::: "memory");
    __syncthreads();
    if (tidp == 0) {
        unsigned* bar = b.bar;
        __builtin_amdgcn_s_waitcnt(0);
        unsigned nloc = b.st[0], nx = b.st[1];
        if (nloc == 0u) { xcd_barrier_complete(bar, b.x, nloc, nx); b.st[0] = nloc; b.st[1] = nx; }
        const unsigned old = xb_add(&bar[XB_XSUB(b.x)], 1u);
        const unsigned gen = old / nloc;
        if (old + 1u == (gen + 1u) * nloc) {
            __builtin_amdgcn_fence(__ATOMIC_RELEASE, "agent");
            asm volatile("s_waitcnt vmcnt(0)" ::: "memory");
            const unsigned og = xb_add(&bar[XB_TOP], 1u);
            const unsigned tg = og / nx;
            if (og + 1u == (tg + 1u) * nx) xb_add(&bar[XB_TOPGEN], 1u);
            else XB_SPIN(xb_ld(&bar[XB_TOPGEN]) == tg, bar);
            __builtin_amdgcn_fence(__ATOMIC_ACQUIRE, "agent");
            xb_add(&bar[XB_XGEN(b.x)], 1u);
            asm volatile("s_waitcnt vmcnt(0)" ::: "memory");
        } else {
            XB_SPIN(xb_ld(&bar[XB_XGEN(b.x)]) == gen, bar);
            __builtin_amdgcn_fence(__ATOMIC_ACQUIRE, "agent");
            asm volatile("s_waitcnt vmcnt(0)" ::: "memory");
        }
    }
    __syncthreads();
}

__device__ __forceinline__ void modp_phase(FX_LAS unsigned char* lds_, const float* c, const float* ada_w, float* MODP, int wg, int nwg, int tidp) {
    float* cact = (float*)(char*)lds_;
    for (int i = tidp; i < 8192; i += 512) { const float v = c[i]; cact[i] = v / (1.f + expf(-v)); }
    __syncthreads();
    int tid_ = tidp; asm volatile("" : "+v"(tid_));
    const int wid = tid_ >> 6, lane = tid_ & 63;
    for (int u = wg * 8 + wid; u < 2 * 48 * 32; u += nwg * 8) {
        const int kc = u & 31, nc = (u >> 5) % 48, l = u / (48 * 32);
        const float* w = ada_w + (size_t)l * 2048 * 12288 + (size_t)(kc * 64) * 12288 + nc * 256 + lane * 4;
        f32x4 a0 = {0.f, 0.f, 0.f, 0.f}, a1 = a0, a2 = a0, a3 = a0;
#pragma unroll 16
        for (int k = 0; k < 64; ++k) { const f32x4 wv = *(const f32x4*)(w + (size_t)k * 12288); const int kk = kc * 64 + k;
            a0 += wv * cact[kk]; a1 += wv * cact[2048 + kk]; a2 += wv * cact[4096 + kk]; a3 += wv * cact[6144 + kk]; }
        float* dst = MODP + (((size_t)l * 32 + kc) * 4) * 12288 + nc * 256 + lane * 4;
        *(f32x4*)dst = a0; *(f32x4*)(dst + 12288) = a1; *(f32x4*)(dst + 2 * 12288) = a2; *(f32x4*)(dst + 3 * 12288) = a3;
    }
    __syncthreads();
}
__device__ __forceinline__ void tab_phase(float* tab, int gtid) {
    if (gtid < 2048) { const int p = gtid >> 5, f = gtid & 31; const float inv = powf(10000.f, -(float)(2 * f) / 64.f); const float a = (float)p * inv; tab[gtid] = cosf(a); tab[2048 + gtid] = sinf(a); }
    else if (gtid < 3072) { const int i = gtid - 2048, p = i >> 4, f = i & 15; const float inv = powf(10000.f, -(float)(2 * f) / 32.f); const float a = (float)p * inv; tab[4096 + i] = cosf(a); tab[5120 + i] = sinf(a); }
}
__device__ __forceinline__ void coef2_phase(const float* MODP, const float* ada_b, const float* pre_mix_gain, const float* post_mix_gain, const float* pre_ffn_gain, const float* post_ffn_gain, float* coef, int gtid, int nthr) {
    for (int i = gtid; i < 2 * 4 * 2048; i += nthr) { const int d = i & 2047, b = (i >> 11) & 3, l = i >> 13;
        float m[6];
#pragma unroll
        for (int j = 0; j < 6; ++j) { float s = ada_b[l * 12288 + j * 2048 + d];
            for (int kc = 0; kc < 32; ++kc) s += MODP[(((size_t)l * 32 + kc) * 4 + b) * 12288 + j * 2048 + d];
            m[j] = s; }
        float* c = coef + ((size_t)l * 4 + b) * 6 * 2048;
        c[0 * 2048 + d] = m[2] * post_mix_gain[l * 2048 + d];
        c[1 * 2048 + d] = pre_ffn_gain[l * 2048 + d] * (1.f + m[4]);
        c[2 * 2048 + d] = m[3];
        c[3 * 2048 + d] = m[5] * post_ffn_gain[l * 2048 + d];
        c[4 * 2048 + d] = pre_mix_gain[l * 2048 + d] * (1.f + m[1]);
        c[5 * 2048 + d] = m[0]; }
}
__device__ __forceinline__ void coef3_phase(FX_LAS unsigned char* lds_, const float* MODP, const float* ada_b, const float* pre_mix_gain, const float* post_mix_gain, const float* pre_ffn_gain, const float* post_ffn_gain, float* coef, int wg, int nwg, int tidp) {
    FX_LAS float* ms = (FX_LAS float*)lds_;
    int tid_ = tidp; asm volatile("" : "+v"(tid_));
    const int wid = __builtin_amdgcn_readfirstlane(tid_ >> 6), lane = tid_ & 63;
    for (int base = wg * 64; base < 2 * 4 * 2048; base += nwg * 64) {
        const int i = base + lane, d = i & 2047, b = (i >> 11) & 3, l = i >> 13;
        if (wid < 6) { const int j = wid; float pv[32];
#pragma unroll
            for (int kc = 0; kc < 32; ++kc) pv[kc] = MODP[(((size_t)l * 32 + kc) * 4 + b) * 12288 + j * 2048 + d];
            float s = ada_b[l * 12288 + j * 2048 + d];
#pragma unroll
            for (int kc = 0; kc < 32; ++kc) s += pv[kc];
            ms[j * 64 + lane] = s; }
        __syncthreads();
        if (wid == 0) { float m[6];
#pragma unroll
            for (int j = 0; j < 6; ++j) m[j] = ms[j * 64 + lane];
            float* c = coef + ((size_t)l * 4 + b) * 6 * 2048;
            c[0 * 2048 + d] = m[2] * post_mix_gain[l * 2048 + d];
            c[1 * 2048 + d] = pre_ffn_gain[l * 2048 + d] * (1.f + m[4]);
            c[2 * 2048 + d] = m[3];
            c[3 * 2048 + d] = m[5] * post_ffn_gain[l * 2048 + d];
            c[4 * 2048 + d] = pre_mix_gain[l * 2048 + d] * (1.f + m[1]);
            c[5 * 2048 + d] = m[0]; }
        __syncthreads();
    }
}
__device__ __forceinline__ void prenorm_phase(const float* x, const float* coef_l, bf16_t* HA, int wg, int nwg, int tidp) {
    int tid_ = tidp; asm volatile("" : "+v"(tid_));
    const int wid = tid_ >> 6, lane = tid_ & 63;
    for (int t = wg * 8 + wid; t < T; t += nwg * 8) {
        const float* cn = coef_l + (size_t)(t / S) * 6 * 2048;
        float xv[32]; float ss = 0.f;
#pragma unroll
        for (int i = 0; i < 4; ++i) { const int c = i * 512 + lane * 8; const f32x4 x0 = *(const f32x4*)(x + (size_t)t * 2048 + c), x1 = *(const f32x4*)(x + (size_t)t * 2048 + c + 4);
#pragma unroll
            for (int j = 0; j < 4; ++j) { xv[i * 8 + j] = x0[j]; xv[i * 8 + 4 + j] = x1[j]; ss += x0[j] * x0[j] + x1[j] * x1[j]; } }
        ss = wave_sum(ss); const float rx = rsqrtf(ss * (1.f / 2048.f) + EPS);
#pragma unroll
        for (int i = 0; i < 4; ++i) { const int c = i * 512 + lane * 8;
            const f32x4 e0 = *(const f32x4*)(cn + 4 * 2048 + c), e1 = *(const f32x4*)(cn + 4 * 2048 + c + 4), f0 = *(const f32x4*)(cn + 5 * 2048 + c), f1 = *(const f32x4*)(cn + 5 * 2048 + c + 4);
            float hv[8];
#pragma unroll
            for (int j = 0; j < 4; ++j) { hv[j] = xv[i * 8 + j] * rx * e0[j] + f0[j]; hv[4 + j] = xv[i * 8 + 4 + j] * rx * e1[j] + f1[j]; }
#ifdef FX_WIN8
            u32x2 w; w.x = cvt_pk4_fp8(hv[0], hv[1], hv[2], hv[3]); w.y = cvt_pk4_fp8(hv[4], hv[5], hv[6], hv[7]);
            *(u32x2*)((unsigned char*)HA + (size_t)t * 2048 + c) = w; }
#else
            u32x4 w; w.x = cvt_pk_bf16(hv[0], hv[1]); w.y = cvt_pk_bf16(hv[2], hv[3]); w.z = cvt_pk_bf16(hv[4], hv[5]); w.w = cvt_pk_bf16(hv[6], hv[7]);
            *(u32x4*)(HA + (size_t)t * 2048 + c) = w; }
#endif
    }
}

constexpr int LDS_ST = 139264, LDS_TOTAL = LDS_ST + 64 + EPI_LDS_BYTES;
static_assert(EPI_LDS_OFF == LDS_ST + 64 && LDS_TOTAL <= 160 * 1024, "LDS layout");
constexpr size_t WS_MODP = WS_R2;
#define FX_KAS __attribute__((address_space(4)))
template <class TY> __device__ __forceinline__ TY* fx_glob(TY* p) { __attribute__((address_space(1))) TY* g = (__attribute__((address_space(1))) TY*)p; asm volatile("" : "+s"(g)); return (TY*)g; }
struct MP {
    const float* x; const float* c; const float* ada_w; const float* ada_b; const float* pre_mix_gain; const float* w_in; const float* a_q_gain; const float* a_k_gain;
    const float* b_cq_gain; const float* b_ckv_gain; const float* w_uq; const float* w_ukv; const float* c_conv_w; const float* c_conv_b; const float* c_gate_b;
    const float* head_out_gain; const float* w_out; const float* post_mix_gain; const float* pre_ffn_gain; const float* router_w; const float* router_bias;
    const float* exp_w_gate; const float* exp_w_up; const float* exp_w_down; const float* sh_w_gate; const float* sh_w_up; const float* sh_w_down; const float* post_ffn_gain;
    char* ws; float* out;
};
#ifndef FX_NPHASE
#define FX_NPHASE 1000
#endif
#define PH_BEGIN const FX_KAS MP* pk = (const FX_KAS MP*)__builtin_amdgcn_kernarg_segment_ptr(); asm volatile("" : "+s"(pk)); char* ws = fx_glob(pk->ws); (void)ws; int gt_ = wid_s * 64 + fx_lane(); asm volatile("" : "+v"(gt_)); int wg_ = blockIdx.x, nwg_ = gridDim.x; asm volatile("" : "+s"(wg_), "+s"(nwg_)); const int wg = wg_, nwg = nwg_; (void)wg; (void)nwg; (void)gt_;
#define PH_BAR do { PH_BEGIN XcdBarrier b_; b_.bar = (unsigned*)(ws + WS_BAR); b_.x = xb_xcc_id(); b_.st = (volatile FX_LAS unsigned*)(lds + LDS_ST); xcd_barrier(b_, gt_); } while (0)
#define WSP(T_, off) ((T_*)(ws + (off)))
constexpr int QW_CNT = 3584;
constexpr unsigned HV_SLACK = 24;
__device__ __forceinline__ void harvest(FX_LAS unsigned char* lds, const FX_KAS MP* pk, char* ws, int tid, const unsigned nbar, const bool drain) {
    volatile FX_LAS unsigned* bw = (volatile FX_LAS unsigned*)(lds + LDS_ST);
    unsigned* bar = (unsigned*)(ws + WS_BAR);
    const int wave = tid >> 6; FX_LAS unsigned* my = (FX_LAS unsigned*)(lds) + wave * (64 * 33);
    CvtW a; a.w_in = fx_glob(pk->w_in) + (size_t)D * 4048; a.w_uq = fx_glob(pk->w_uq) + (size_t)384 * 1152; a.w_ukv = fx_glob(pk->w_ukv) + (size_t)256 * 1536; a.w_out = fx_glob(pk->w_out) + (size_t)D * D;
    a.eg = fx_glob(pk->exp_w_gate) + (size_t)NE * D * FF; a.eu = fx_glob(pk->exp_w_up) + (size_t)NE * D * FF; a.ed = fx_glob(pk->exp_w_down) + (size_t)NE * FF * D;
    a.sg = fx_glob(pk->sh_w_gate) + (size_t)D * FF; a.su = fx_glob(pk->sh_w_up) + (size_t)D * FF; a.sd = fx_glob(pk->sh_w_down) + (size_t)FF * D; a.W = (bf16_t*)(ws + WS_W + W_LAYER);
    __syncthreads();
    if (drain) {
        if (tid == 0) bw[3] = xb_ld(&bar[QW_CNT]);
        __syncthreads();
        const unsigned h = bw[3];
#pragma unroll 1
        for (unsigned g = h + (unsigned)(blockIdx.x * 8 + wave); g < (unsigned)CVT_TILES_PER_LAYER; g += gridDim.x * 8u) cvt_layer_one(a, my, (int)g);
        __syncthreads();
        return;
    }
#pragma unroll 1
    for (;;) {
        if (tid == 0) { unsigned nxt = 0xffffffffu; bool go = true;
            if (!drain) { unsigned sum = 0u;
#pragma unroll
                for (unsigned j = 0; j < 16; ++j) sum += xb_ld(&bar[XB_XSUB(j)]);
                const unsigned G = gridDim.x; go = (sum - nbar * G) + HV_SLACK < G; }
            if (go && xb_ld(&bar[QW_CNT]) < (unsigned)CVT_TILES_PER_LAYER) { const unsigned b0 = xb_add(&bar[QW_CNT], 8u); if (b0 < (unsigned)CVT_TILES_PER_LAYER) nxt = b0; }
            bw[3] = nxt; }
        __syncthreads();
        const unsigned base = bw[3];
        if (base == 0xffffffffu) break;
        const int g = (int)base + wave;
        if (g < CVT_TILES_PER_LAYER) cvt_layer_one(a, my, g);
        __syncthreads();
    }
    __syncthreads();
}
#ifndef FX_HARVEST
#define FX_HARVEST 1
#endif
#if FX_HARVEST && FX_YMPERM
#error "the work-queue conversion path does not implement the permuted w_out k order"
#endif
#define PH_HARVEST(n, dr) do { if (FX_HARVEST && l == 0 && ((dr) || FX_HARVEST == 1)) { PH_BEGIN harvest(lds, pk, ws, gt_, (n), (dr)); } } while (0)
#ifndef FX_DUP
#define FX_DUP -1
#endif
#define FX_NE ((FX_NOEPI && rep_ == 1) ? FX_NOEPI : 0)
#define FX_REP(n) _Pragma("unroll 1") for (int rep_ = 0; rep_ < ((FX_DUP == (n) && l == 0) ? 2 : 1); ++rep_)
template <int l> __device__ __forceinline__ void layer_body(FX_LAS unsigned char* lds, unsigned char* shm, const int wid_s) {
        FX_REP(2) { PH_BEGIN const bf16_t* W = WSP(const bf16_t, WS_W + (size_t)l * W_LAYER);
#ifdef FX_WIN8
          DenseSched Sc; Sc.init(T, 4096, nwg, wg, 2048, W + W_IN / 2, 2048, 1); EpiBf16 E; E.es = lds + EPI_LDS_OFF; E.O = WSP(bf16_t, WS_R1); E.gates = WSP(float, WS_GATES); E.ldc = 4096; E.scale = W8_INV;
          gemm_phase<EpiBf16, DenseSched, true>(lds, (const char*)WSP(bf16_t, WS_HA), 2048, Sc, E, gt_, FX_NE); }
#else
          DenseSched Sc; Sc.init(T, 4096, nwg, wg, 2048 * 2, W + W_IN / 2, 2048); EpiBf16 E; E.es = lds + EPI_LDS_OFF; E.O = WSP(bf16_t, WS_R1); E.gates = WSP(float, WS_GATES); E.ldc = 4096; E.scale = 1.f;
          gemm_phase<EpiBf16, DenseSched>(lds, (const char*)WSP(bf16_t, WS_HA), 2048, Sc, E, gt_); }
#endif
        PH_HARVEST(3u, false);
        PH_BAR;
        FX_REP(3) { PH_BEGIN char* R2 = ws + WS_R2; float* tab = WSP(float, WS_TAB);
          P3Args a; a.PROJ = WSP(bf16_t, WS_R1); a.GATES = WSP(float, WS_GATES); a.gate_b = fx_glob(pk->c_gate_b) + l * 16; a.conv_w = fx_glob(pk->c_conv_w) + (size_t)l * 5 * 1024; a.conv_b = fx_glob(pk->c_conv_b) + l * 1024;
          a.aq_gain = fx_glob(pk->a_q_gain) + l * 128; a.ak_gain = fx_glob(pk->a_k_gain) + l * 128; a.cq_gain = fx_glob(pk->b_cq_gain) + l * 384; a.ckv_gain = fx_glob(pk->b_ckv_gain) + l * 256;
          a.cosA = tab; a.sinA = tab + 2048; a.cosB = tab + 4096; a.sinB = tab + 5120;
          a.QA = (bf16_t*)(R2 + R2_QA); a.KA = (bf16_t*)(R2 + R2_KA); a.CQN = (bf16_t*)(R2 + R2_CQN); a.CKVN = (bf16_t*)(R2 + R2_CKVN); a.KR = (bf16_t*)(R2 + R2_KR); a.QC = (bf16_t*)(R2 + R2_QC); a.KC = (bf16_t*)(R2 + R2_KC);
          a.KCT = (bf16_t*)(R2 + R2_KCT); a.NLOC = WSP(float, WS_NLOC); a.GSC = WSP(float, WS_GSC);
          p3_phase(lds, a, wg, nwg, gt_); }
        PH_BAR;
        FX_REP(4) {
        { PH_BEGIN const bf16_t* W = WSP(const bf16_t, WS_W + (size_t)l * W_LAYER); char* R2 = ws + WS_R2; float* tab = WSP(float, WS_TAB);
          DenseSched Sc; Sc.init(T, 1280, nwg, wg, 384 * 2, W + W_UQ / 2, 384); EpiQB E; E.O = (bf16_t*)(R2 + R2_QB); E.cosB = tab + 4096; E.sinB = tab + 5120;
          gemm_phase<EpiQB, DenseSched>(lds, (const char*)(R2 + R2_CQN), 384, Sc, E, gt_); }
        { PH_BEGIN const bf16_t* W = WSP(const bf16_t, WS_W + (size_t)l * W_LAYER); char* R2 = ws + WS_R2;
          DenseSched Sc; Sc.init(T, 1536, nwg, (wg + nwg / 2) % nwg  , 256 * 2, W + W_UKV / 2, 256); EpiBf16 E; E.es = lds + EPI_LDS_OFF; E.O = (bf16_t*)(R2 + R2_KVB); E.gates = nullptr; E.ldc = 1536; E.scale = 1.f;
          gemm_phase<EpiBf16, DenseSched>(lds, (const char*)(R2 + R2_CKVN), 256, Sc, E, gt_); }
        { PH_BEGIN char* R2 = ws + WS_R2;
          scan_phase((const bf16_t*)(R2 + R2_KCT), WSP(float, WS_NLOC), WSP(float, WS_GSC), (bf16_t*)(R2 + R2_CPREV), WSP(float, WS_NPREV), WSP(float, WS_MPREV), wg * 512 + gt_, nwg * 512); }
        }
        PH_HARVEST(5u, false);
        PH_BAR;
        FX_REP(5) {
#pragma unroll 1
          for (int ui = 0; ui < 2; ++ui) { PH_BEGIN char* R2 = ws + WS_R2; int u;
              if (nwg == 256) { const int x = wg & 7, j = wg >> 3; if (ui == 1 && j >= 16) break; u = x * 48 + j + ui * 32; } else { u = wg + ui * nwg; if (u >= 384) break; }
              attn_gqa_unit(u, (const bf16_t*)(R2 + R2_QA), (const bf16_t*)(R2 + R2_KA), WSP(const bf16_t, WS_R1), WSP(bf16_t, WS_HA), fx_glob(pk->head_out_gain) + l * D, (char*)shm, gt_); }
#pragma unroll 1
          for (int ui = 0; ui < 2; ++ui) { PH_BEGIN char* R2 = ws + WS_R2; int u;
              if (nwg == 256) { const int x = wg & 7, j = wg >> 3; if (j < 16) { if (ui == 1) break; u = x * 48 + j; } else u = x * 48 + 16 + (j - 16) * 2 + ui; } else { u = wg + ui * nwg; if (u >= 384) break; }
              attn_mla_unit(u, (const bf16_t*)(R2 + R2_QB), (const bf16_t*)(R2 + R2_KVB), (const bf16_t*)(R2 + R2_KR), WSP(bf16_t, WS_HA), fx_glob(pk->head_out_gain) + l * D, (char*)shm, gt_); }
          { PH_BEGIN char* R2 = ws + WS_R2;
            McArgs a; a.PROJ = WSP(bf16_t, WS_R1); a.GATES = WSP(float, WS_GATES); a.gate_b = fx_glob(pk->c_gate_b) + l * 16; a.QC = (bf16_t*)(R2 + R2_QC); a.KC = (bf16_t*)(R2 + R2_KC); a.CPREV = (bf16_t*)(R2 + R2_CPREV);
            a.NPREV = WSP(float, WS_NPREV); a.MPREV = WSP(float, WS_MPREV); a.hog = fx_glob(pk->head_out_gain) + l * D; a.YM = WSP(bf16_t, WS_HA);
            mlstm_c_phase(lds, a, wg, nwg, gt_); } }
        PH_HARVEST(6u, false);
        PH_BAR;
        FX_REP(6) { PH_BEGIN const bf16_t* W = WSP(const bf16_t, WS_W + (size_t)l * W_LAYER);
#ifdef FX_WOUT8
          DenseSched Sc; Sc.init(T, 2048, nwg, wg, 2048, W + W_OUT / 2, 2048, 1); EpiBf16 E; E.es = lds + EPI_LDS_OFF; E.O = WSP(bf16_t, WS_R1); E.gates = nullptr; E.ldc = 2048; E.scale = W8_INV;
          gemm_phase<EpiBf16, DenseSched, true>(lds, (const char*)WSP(bf16_t, WS_HA), 2048, Sc, E, gt_, FX_NE); }
#else
          DenseSched Sc; Sc.init(T, 2048, nwg, wg, 2048 * 2, W + W_OUT / 2, 2048); EpiBf16 E; E.es = lds + EPI_LDS_OFF; E.O = WSP(bf16_t, WS_R1); E.gates = nullptr; E.ldc = 2048; E.scale = 1.f;
          gemm_phase<EpiBf16, DenseSched>(lds, (const char*)WSP(bf16_t, WS_HA), 2048, Sc, E, gt_); }
#endif
        PH_HARVEST(7u, false);
        PH_BAR;
        { PH_BEGIN p7_phase<(l != 0)>(lds, l == 0 ? (const void*)fx_glob(pk->x) : (const void*)WSP(const bf16_t, WS_XRES), WSP(const bf16_t, WS_R1), WSP(float, WS_COEF) + (size_t)l * 4 * 6 * 2048, fx_glob(pk->router_w) + (size_t)l * D * 64, fx_glob(pk->router_bias) + l * 64,
                            WSP(bf16_t, WS_XRES), WSP(unsigned char, WS_HA), WSP(int, WS_SELE), WSP(float, WS_SELG), WSP(int, WS_CNT) + l * 64, WSP(int, WS_WGBASE), wg, nwg, gt_); }
        PH_BAR;
        { PH_BEGIN p8_phase(lds, WSP(int, WS_SELE), WSP(float, WS_SELG), WSP(int, WS_CNT) + l * 64, WSP(int, WS_WGBASE), WSP(int, WS_ROWTOK), WSP(float, WS_ROWG), WSP(int, WS_SLOT), wg, nwg, gt_); }
        PH_BAR;
        FX_REP(9) { PH_BEGIN const bf16_t* W = WSP(const bf16_t, WS_W + (size_t)l * W_LAYER);
          p9_phase(lds, WSP(unsigned char, WS_HA), (const unsigned char*)(W + W_GU / 2), WSP(int, WS_CNT) + l * 64, WSP(int, WS_ROWTOK), WSP(unsigned char, WS_R1), wg, nwg, gt_, FX_NE); }
        PH_HARVEST(10u, false);
        PH_BAR;
        FX_REP(10) { PH_BEGIN const bf16_t* W = WSP(const bf16_t, WS_W + (size_t)l * W_LAYER);
          p10_phase(lds, WSP(unsigned char, WS_R1), (const unsigned char*)(W + W_DN / 2), WSP(int, WS_CNT) + l * 64, WSP(float, WS_ROWG), WSP(unsigned char, WS_R2), wg, nwg, gt_, FX_NE); }
        PH_HARVEST(11u, false);
        PH_BAR;
        { PH_BEGIN p11_phase<(l == 1)>(WSP(bf16_t, WS_XRES), WSP(unsigned char, WS_R2), WSP(int, WS_SLOT), WSP(float, WS_SELG), WSP(float, WS_COEF) + (size_t)l * 4 * 6 * 2048, l == 0 ? WSP(float, WS_COEF) + 4 * 6 * 2048 : nullptr,
                             l == 1 ? (void*)fx_glob(pk->out) : (void*)WSP(bf16_t, WS_XRES), WSP(bf16_t, WS_HA), wg, nwg, gt_); }
        PH_HARVEST(12u, true);
        if (l == 0) PH_BAR;
}
__global__ __launch_bounds__(512, 2) void mega(MP p_unused) {
    extern __shared__ __attribute__((aligned(16))) unsigned char shm[];
    FX_LAS unsigned char* lds = (FX_LAS unsigned char*)shm;
    const int wid_s = __builtin_amdgcn_readfirstlane((int)threadIdx.x >> 6);
    { volatile FX_LAS unsigned* st = (volatile FX_LAS unsigned*)(lds + LDS_ST);
      PH_BEGIN if (gt_ == 0) { st[0] = 0u; st[1] = 0u; st[2] = 0u; st[3] = 0u; }
      __syncthreads();
      (void)xcd_barrier_post((unsigned*)(ws + WS_BAR), st, gt_); }
    { PH_BEGIN const int wave = wid_s;     FX_LAS unsigned* my = (FX_LAS unsigned*)(lds) + wave * (64 * 33); int rot = 0;
#pragma unroll 1
      for (int l = 0; l < ((FX_DUP == 0) ? 4 : (FX_HARVEST ? 1 : 2)); ++l) { const int lw = l & 1; CvtW a; a.w_in = fx_glob(pk->w_in) + (size_t)lw * D * 4048; a.w_uq = fx_glob(pk->w_uq) + (size_t)lw * 384 * 1152; a.w_ukv = fx_glob(pk->w_ukv) + (size_t)lw * 256 * 1536; a.w_out = fx_glob(pk->w_out) + (size_t)lw * D * D;
          a.eg = fx_glob(pk->exp_w_gate) + (size_t)lw * NE * D * FF; a.eu = fx_glob(pk->exp_w_up) + (size_t)lw * NE * D * FF; a.ed = fx_glob(pk->exp_w_down) + (size_t)lw * NE * FF * D;
          a.sg = fx_glob(pk->sh_w_gate) + (size_t)lw * D * FF; a.su = fx_glob(pk->sh_w_up) + (size_t)lw * D * FF; a.sd = fx_glob(pk->sh_w_down) + (size_t)lw * FF * D; a.W = (bf16_t*)(ws + WS_W + (size_t)lw * W_LAYER);
          cvt_layer(a, my, wg * 8 + wave, nwg * 8, rot); }
      __syncthreads(); }
    { PH_BEGIN modp_phase(lds, fx_glob(pk->c), fx_glob(pk->ada_w), WSP(float, WS_MODP), wg, nwg, gt_); tab_phase(WSP(float, WS_TAB), wg * 512 + gt_); }
#if FX_DUP == 20
    { PH_BEGIN modp_phase(lds, fx_glob(pk->c), fx_glob(pk->ada_w), WSP(float, WS_MODP), wg, nwg, gt_); tab_phase(WSP(float, WS_TAB), wg * 512 + gt_); }
#endif
    PH_BAR;
    { PH_BEGIN coef3_phase(lds, WSP(float, WS_MODP), fx_glob(pk->ada_b), fx_glob(pk->pre_mix_gain), fx_glob(pk->post_mix_gain), fx_glob(pk->pre_ffn_gain), fx_glob(pk->post_ffn_gain), WSP(float, WS_COEF), wg, nwg, gt_); }
    PH_BAR;
    { PH_BEGIN prenorm_phase(fx_glob(pk->x), WSP(float, WS_COEF), WSP(bf16_t, WS_HA), wg, nwg, gt_); }
#if FX_DUP == 22
    { PH_BEGIN prenorm_phase(fx_glob(pk->x), WSP(float, WS_COEF), WSP(bf16_t, WS_HA), wg, nwg, gt_); }
#endif
    PH_BAR;
#if FX_DUP == 99
    PH_BAR; PH_BAR; PH_BAR; PH_BAR; PH_BAR; PH_BAR; PH_BAR; PH_BAR; PH_BAR; PH_BAR;
#endif
    layer_body<0>(lds, shm, wid_s);
    layer_body<1>(lds, shm, wid_s);
}
}

extern "C" void kernel_launch(void* const* d_in, const int* in_sizes, int n_in, void* d_out, int out_size, void* d_ws, size_t ws_size, hipStream_t stream) {
    using namespace fx;
    static int grid = 0;
    if (!grid) {
        int dev = 0, cus = 0, per_cu = 0;
        (void)hipGetDevice(&dev);
        (void)hipDeviceGetAttribute(&cus, hipDeviceAttributeMultiprocessorCount, dev);
        (void)hipFuncSetAttribute((const void*)mega, hipFuncAttributeMaxDynamicSharedMemorySize, LDS_TOTAL);
        (void)hipOccupancyMaxActiveBlocksPerMultiprocessor(&per_cu, (const void*)mega, 512, LDS_TOTAL);
        if (cus > 256) cus = 256;
        grid = per_cu >= 1 ? cus : 0;
    }
    if (!grid) return;
    (void)hipMemsetAsync((char*)d_ws + WS_BAR, 0, 16384, stream);
    static_assert(WS_CNT + 512 <= WS_BAR + 16384 && WS_CNT >= WS_BAR + (size_t)XCD_BAR_WORDS * 4 && WS_CNT >= WS_BAR + (size_t)(QW_CNT + 1) * 4, "counter block placement");
    MP p{};
    const float** q = (const float**)&p;
    for (int i = 0; i < 28; ++i) q[i] = (const float*)d_in[i];
    p.ws = (char*)d_ws; p.out = (float*)d_out;
    hipLaunchKernelGGL(mega, dim3(grid), dim3(512), LDS_TOTAL, stream, p);
}
```
